# Optimizing an MI355X kernel written in HIP

```python
import math
import jax, jax.numpy as jnp
from jax import lax
import numpy as np

D_MODEL = 1024
BATCH = 2
SEQ = 8192
DEPTH = 1

HEAD_DIM = 64
N_Q_HEADS = 8
N_KV_HEADS = 2
Q_PER_KV = N_Q_HEADS // N_KV_HEADS
ATTN_WIDTH = N_Q_HEADS * HEAD_DIM
KV_WIDTH = N_KV_HEADS * HEAD_DIM
WINDOW = 128
ATTN_BLOCK = 128
N_BUCKETS = 32
MAX_DISTANCE = 128
GMLP_GROUPS = 8
GMLP_GROUP_DIM = 64
GMLP_WIDTH = GMLP_GROUPS * GMLP_GROUP_DIM
GMLP_CHUNK = 128
N_BRANCH = 2
IN_WIDTH = ATTN_WIDTH + 2 * KV_WIDTH + 2 * GMLP_WIDTH + N_BRANCH * D_MODEL
PEER_HEADS = 8
PEER_NKEYS = 128
PEER_N_EXPERTS = PEER_NKEYS * PEER_NKEYS
PEER_KEY_DIM = 256
PEER_HALF = PEER_KEY_DIM // 2
PEER_TOPK = 16
PEER_TOKEN_BLOCK = 128
EPS = 1e-6
NEG_INF = -1e30

kernel_name = "hybrid_swa_gmlp_peer_block"


def rmsnorm(x, w):
    xf = x.astype(jnp.float32)
    y = xf * lax.rsqrt(jnp.mean(xf * xf, axis=-1, keepdims=True) + EPS)
    return (y * w.astype(jnp.float32)).astype(x.dtype)


def layernorm(x, w, b):
    xf = x.astype(jnp.float32)
    mu = jnp.mean(xf, axis=-1, keepdims=True)
    xc = xf - mu
    y = xc * lax.rsqrt(jnp.mean(xc * xc, axis=-1, keepdims=True) + EPS)
    return (y * w.astype(jnp.float32) + b.astype(jnp.float32)).astype(x.dtype)


def t5_causal_bucket(dist):
    n = np.maximum(dist, 0)
    max_exact = N_BUCKETS // 2
    large = max_exact + (np.log(np.maximum(n, 1) / max_exact) / np.log(MAX_DISTANCE / max_exact)
                         * (N_BUCKETS - max_exact)).astype(np.int32)
    large = np.minimum(large, N_BUCKETS - 1)
    return np.where(n < max_exact, n, large).astype(np.int32)


def sliding_window_gqa(q, k, v, rel_bias, sinks):
    B, S = q.shape[0], q.shape[1]
    nb = S // ATTN_BLOCK
    q = q.reshape(B, nb, ATTN_BLOCK, N_KV_HEADS, Q_PER_KV, HEAD_DIM)
    k = k.reshape(B, nb, ATTN_BLOCK, N_KV_HEADS, HEAD_DIM)
    v = v.reshape(B, nb, ATTN_BLOCK, N_KV_HEADS, HEAD_DIM)

    def band(t):
        prev = jnp.pad(t, ((0, 0), (1, 0), (0, 0), (0, 0), (0, 0)))[:, :-1]
        return jnp.concatenate([prev, t], axis=2)

    kb, vb = band(k), band(v)
    logits = jnp.einsum('bnqhgd,bnshd->bnhgqs', q, kb).astype(jnp.float32) * (HEAD_DIM ** -0.5)

    qi = np.arange(ATTN_BLOCK)[:, None]
    kj = np.arange(2 * ATTN_BLOCK)[None, :]
    dist = qi + ATTN_BLOCK - kj
    bias = rel_bias.astype(jnp.float32)[t5_causal_bucket(dist)]
    bias = bias.transpose(2, 0, 1).reshape(N_KV_HEADS, Q_PER_KV, ATTN_BLOCK, 2 * ATTN_BLOCK)
    in_window = (dist >= 0) & (dist < WINDOW)
    key_exists = (np.arange(nb)[:, None, None] > 0) | (kj >= ATTN_BLOCK)[None]
    valid = in_window[None] & key_exists
    logits = jnp.where(valid[None, :, None, None], logits + bias, NEG_INF)

    sink = jnp.broadcast_to(sinks.astype(jnp.float32).reshape(N_KV_HEADS, Q_PER_KV)[None, None, :, :, None, None],
                            logits.shape[:-1] + (1,))
    probs = jax.nn.softmax(jnp.concatenate([logits, sink], axis=-1), axis=-1)[..., :-1]
    out = jnp.einsum('bnhgqs,bnshd->bnqhgd', probs.astype(vb.dtype), vb)
    return out.reshape(B, S, ATTN_WIDTH)


def chunked_spatial_gating(u, v, ln_w, ln_b, w_s, b_s):
    B, S = u.shape[0], u.shape[1]
    nc = S // GMLP_CHUNK
    v = layernorm(v, ln_w, ln_b).reshape(B, nc, GMLP_CHUNK, GMLP_GROUPS, GMLP_GROUP_DIM)
    causal = np.tril(np.ones((GMLP_CHUNK, GMLP_CHUNK), dtype=bool))
    w = jnp.where(causal[None], w_s, 0).astype(v.dtype)
    s = jnp.einsum('gts,bcsgd->bctgd', w, v) + b_s.T.astype(v.dtype)[None, None, :, :, None]
    y = u.reshape(B, nc, GMLP_CHUNK, GMLP_GROUPS, GMLP_GROUP_DIM) * s
    return y.reshape(B, S, GMLP_WIDTH)


def peer_ffn(x, w_q, keys_1, keys_2, u_tab, v_tab):
    B, S, D = x.shape
    q = (x @ w_q).reshape(B, S, PEER_HEADS, PEER_KEY_DIM)
    s1 = jnp.einsum('bshd,nd->bshn', q[..., :PEER_HALF], keys_1).astype(jnp.float32)
    s2 = jnp.einsum('bshd,nd->bshn', q[..., PEER_HALF:], keys_2).astype(jnp.float32)
    v1, i1 = lax.top_k(s1, PEER_TOPK)
    v2, i2 = lax.top_k(s2, PEER_TOPK)
    cand_s = (v1[..., :, None] + v2[..., None, :]).reshape(B, S, PEER_HEADS, PEER_TOPK * PEER_TOPK)
    cand_i = (i1[..., :, None] * PEER_NKEYS + i2[..., None, :]).reshape(B, S, PEER_HEADS, PEER_TOPK * PEER_TOPK)
    top_s, pos = lax.top_k(cand_s, PEER_TOPK)
    idx = jnp.take_along_axis(cand_i, pos, axis=-1)
    gate = jax.nn.softmax(top_s, axis=-1).astype(x.dtype)

    n_blk = (B * S) // PEER_TOKEN_BLOCK
    xs = x.reshape(n_blk, PEER_TOKEN_BLOCK, D)
    idxs = idx.reshape(n_blk, PEER_TOKEN_BLOCK, PEER_HEADS, PEER_TOPK)
    gates = gate.reshape(n_blk, PEER_TOKEN_BLOCK, PEER_HEADS, PEER_TOPK)

    def token_block(args):
        xb, ib, gb = args
        ue = u_tab[ib]
        act = jax.nn.gelu(jnp.einsum('thkd,td->thk', ue, xb)) * gb
        ve = v_tab[ib]
        return jnp.einsum('thk,thkd->td', act, ve)

    y = lax.map(token_block, (xs, idxs, gates))
    return y.reshape(B, S, D)


def setup_inputs(seed: int = 0) -> dict:
    key = jax.random.key(seed)
    ks = jax.random.split(key, 20)
    f32 = jnp.float32
    L, D = DEPTH, D_MODEL
    nrm = lambda k, shape, scale: jax.random.normal(k, shape, f32) * scale
    return {
        "x": nrm(ks[0], (BATCH, SEQ, D), 1.0),
        "mix_norm_w": 1.0 + nrm(ks[1], (L, D), 0.02),
        "w_in": nrm(ks[2], (L, D, IN_WIDTH), D ** -0.5),
        "rel_bias": nrm(ks[3], (N_BUCKETS, N_Q_HEADS), 0.3),
        "attn_sinks": nrm(ks[4], (L, N_Q_HEADS), 0.5),
        "w_branch_attn": nrm(ks[5], (L, ATTN_WIDTH, D), ATTN_WIDTH ** -0.5),
        "gmlp_ln_w": 1.0 + nrm(ks[6], (L, GMLP_WIDTH), 0.02),
        "gmlp_ln_b": nrm(ks[7], (L, GMLP_WIDTH), 0.02),
        "gmlp_w_s": nrm(ks[8], (L, GMLP_GROUPS, GMLP_CHUNK, GMLP_CHUNK), GMLP_CHUNK ** -0.5),
        "gmlp_b_s": 1.0 + nrm(ks[9], (L, GMLP_GROUPS, GMLP_CHUNK), 0.1),
        "w_branch_gmlp": nrm(ks[10], (L, GMLP_WIDTH, D), GMLP_WIDTH ** -0.5),
        "w_out": nrm(ks[11], (L, D, D), D ** -0.5),
        "ffn_norm_w": 1.0 + nrm(ks[12], (L, D), 0.02),
        "peer_w_q": nrm(ks[13], (L, D, PEER_HEADS * PEER_KEY_DIM), D ** -0.5),
        "peer_keys_1": nrm(ks[14], (L, PEER_NKEYS, PEER_HALF), PEER_HALF ** -0.5),
        "peer_keys_2": nrm(ks[15], (L, PEER_NKEYS, PEER_HALF), PEER_HALF ** -0.5),
        "peer_u": nrm(ks[16], (L, PEER_N_EXPERTS, D), D ** -0.5),
        "peer_v": nrm(ks[17], (L, PEER_N_EXPERTS, D), PEER_HEADS ** -0.5),
        "final_norm_w": 1.0 + nrm(ks[18], (D,), 0.02),
    }


def reference(x, mix_norm_w, w_in, rel_bias, attn_sinks, w_branch_attn, gmlp_ln_w, gmlp_ln_b,
              gmlp_w_s, gmlp_b_s, w_branch_gmlp, w_out, ffn_norm_w, peer_w_q, peer_keys_1,
              peer_keys_2, peer_u, peer_v, final_norm_w):
    B, S, D = x.shape
    splits = np.cumsum([ATTN_WIDTH, KV_WIDTH, KV_WIDTH, GMLP_WIDTH, GMLP_WIDTH, D_MODEL])
    for l in range(DEPTH):
        h = rmsnorm(x, mix_norm_w[l])
        z = h @ w_in[l]
        q, k, v, gu, gv, gate_a, gate_b = jnp.split(z, splits, axis=-1)
        y_a = sliding_window_gqa(q.reshape(B, S, N_Q_HEADS, HEAD_DIM),
                                 k.reshape(B, S, N_KV_HEADS, HEAD_DIM),
                                 v.reshape(B, S, N_KV_HEADS, HEAD_DIM),
                                 rel_bias, attn_sinks[l]) @ w_branch_attn[l]
        y_b = chunked_spatial_gating(jax.nn.gelu(gu), jax.nn.gelu(gv), gmlp_ln_w[l], gmlp_ln_b[l],
                                     gmlp_w_s[l], gmlp_b_s[l]) @ w_branch_gmlp[l]
        merged = jax.nn.sigmoid(gate_a) * y_a + jax.nn.sigmoid(gate_b) * y_b
        x = x + merged @ w_out[l]
        x = x + peer_ffn(rmsnorm(x, ffn_norm_w[l]), peer_w_q[l], peer_keys_1[l], peer_keys_2[l],
                         peer_u[l], peer_v[l])
    return rmsnorm(x, final_norm_w)
```

```cpp
#include <hip/hip_runtime.h>
#include <cstdio>
#include <cstdint>
namespace pg8 {
#define PG8_LAS __attribute__((address_space(3)))
typedef unsigned short bf16_t;
typedef short bf16x8 __attribute__((ext_vector_type(8)));
typedef float f32x4 __attribute__((ext_vector_type(4)));
typedef unsigned u32x4 __attribute__((ext_vector_type(4)));
constexpr int BM = 256, BK = 64, HALF = 128, HTB = HALF * BK * 2  , STAGE_BYTES = 8 * HTB, NXCD = 8, WGM = 8;

__host__ __device__ __forceinline__ int lds_byte(int r, int c) { const int st = (r >> 4) * 2 + (c >> 5), rr = r & 15, cc = c & 31, ob = rr * 64 + cc * 2; return st * 1024 + (ob ^ (((ob >> 9) & 1) << 5)); }
__host__ __device__ __forceinline__ void stage_rc(int b, int& R, int& C) { const int st = b / 1024, sb = b % 1024, swz = sb ^ (((sb >> 9) & 1) << 5); R = (st >> 1) * 16 + swz / 64; C = (st & 1) * 32 + (swz % 64) / 2; }
__host__ __device__ __forceinline__ int perm32(int rho) { const int n = rho >> 4, i = rho & 15; return 8 * (i >> 2) + 4 * n + (i & 3); }

struct Unit { int pm, pn; };
struct Gemm { const bf16_t* A; const bf16_t* Bt; int M, N, K; };

struct StaticOrder {
    int nM, nN, nwg, G, c;
    __host__ __device__ void init(int M, int N, int G_, int c_) { nM = M / BM; nN = N / BM; nwg = nM * nN; G = G_; c = c_; }
    __host__ __device__ bool next(int i, Unit& u) const {
        const long L = (long)i * G + c; if (L >= nwg) return false;
        int wgid = (int)L; { const int q = nwg / NXCD, r = nwg % NXCD, xcd = wgid % NXCD, off = wgid / NXCD; wgid = (xcd < r ? xcd * (q + 1) : r * (q + 1) + (xcd - r) * q) + off; }
        const int nig = WGM * nN, gid = wgid / nig, fm = gid * WGM, gsz = (nM - fm) < WGM ? (nM - fm) : WGM;
        u.pm = fm + ((wgid % nig) % gsz); u.pn = (wgid % nig) / gsz; return true;
    }
    __device__ __forceinline__ void a_ready(const Unit&) const {}
    __device__ __forceinline__ void done(const Unit&) const {}
};

__device__ __forceinline__ unsigned cvt_pk_bf16(float lo, float hi) { unsigned r; asm volatile("v_cvt_pk_bf16_f32 %0, %1, %2" : "=v"(r) : "v"(lo), "v"(hi)); return r; }
typedef float f32x2 __attribute__((ext_vector_type(2)));
template <class Epi, class Sched, bool ALIGN_EPI = false, bool SP2 = false>
__device__ __forceinline__ void gemm_phase(PG8_LAS unsigned char* lds, const Gemm g, const Sched& S, const Epi& E) {
    const int tid = threadIdx.x, wid = __builtin_amdgcn_readfirstlane(tid >> 6), lane = tid & 63, wr = wid >> 2, wc = wid & 3, fr = lane & 15, fq = lane >> 4;
    const int K = g.K, nt = K / BK;
    unsigned voffA[2], voffB[2];
#pragma unroll
    for (int i = 0; i < 2; ++i) { int R, C; stage_rc(tid * 16 + i * 8192, R, C); const int Rb = Epi::PERM ? ((R & ~31) + perm32(R & 31)) : R;
        voffA[i] = (unsigned)(R * K + C) * 2u; voffB[i] = (unsigned)(Rb * K + C) * 2u; }
    const size_t kstep = (size_t)(BK * 2);
    const size_t hstep = (size_t)HALF * K * 2;
    const size_t tstep = 2 * hstep;
    const unsigned ldsw = (unsigned)wid * 1024u;
    const int aoff = lds_byte(wr * 64 + fr, fq * 8), boff = lds_byte(wc * 32 + fr, fq * 8);
#define PG8_SA(b, h) (((b) * 2 + (h)) * HTB)
#define PG8_SB(b, h) ((4 + (b) * 2 + (h)) * HTB)
#define PG8_STAGE(bufoff, gbase, voff) do { _Pragma("unroll") for (int _i = 0; _i < 2; ++_i) \
        __builtin_amdgcn_global_load_lds((const unsigned*)((const char*)(gbase) + (voff)[_i]), (PG8_LAS unsigned*)(lds + (bufoff) + ldsw + _i * 8192), 16, 0, 0); } while (0)
#define PG8_LDA(dst, b, h) do { _Pragma("unroll") for (int m = 0; m < 4; ++m) _Pragma("unroll") for (int k = 0; k < 2; ++k) dst[m][k] = *(const PG8_LAS bf16x8*)(lds + PG8_SA(b, h) + aoff + m * 2048 + k * 1024); } while (0)
#define PG8_LDB(dst, b, h) do { _Pragma("unroll") for (int n = 0; n < 2; ++n) _Pragma("unroll") for (int k = 0; k < 2; ++k) dst[n][k] = *(const PG8_LAS bf16x8*)(lds + PG8_SB(b, h) + boff + n * 2048 + k * 1024); } while (0)
#define PG8_MMA(ai, bj, At, Bt) do { __builtin_amdgcn_s_setprio(1); _Pragma("unroll") for (int m = 0; m < 4; ++m) _Pragma("unroll") for (int n = 0; n < 2; ++n) _Pragma("unroll") for (int k = 0; k < 2; ++k) \
        acc[ai][bj][m][n] = __builtin_amdgcn_mfma_f32_16x16x32_bf16(Bt[n][k], At[m][k], acc[ai][bj][m][n], 0, 0, 0); __builtin_amdgcn_s_setprio(0); } while (0)
#define PG8_WAIT_V(n) asm volatile("s_waitcnt vmcnt(" #n ")" ::: "memory")
#define PG8_WAIT_L(n) asm volatile("s_waitcnt lgkmcnt(" #n ")" ::: "memory")
#define PG8_BAR __builtin_amdgcn_s_barrier()
#define PG8_SCHED __builtin_amdgcn_sched_barrier(0)
    Unit cur, nxt; int ui = 0;
    if (!S.next(0, cur)) return;
    f32x4 acc[2][2][4][2];
#pragma unroll
    for (int a = 0; a < 2; ++a)
#pragma unroll
        for (int b = 0; b < 2; ++b)
#pragma unroll
            for (int m = 0; m < 4; ++m)
#pragma unroll
                for (int n = 0; n < 2; ++n) acc[a][b][m][n] = (f32x4){0.f, 0.f, 0.f, 0.f};
    bf16x8 At[4][2], B0[2][2], B1[2][2];
    const char* cA = (const char*)g.A + (size_t)cur.pm * tstep; const char* cB = (const char*)g.Bt + (size_t)cur.pn * tstep;
    S.a_ready(cur);
    if constexpr (SP2) {
        PG8_STAGE(PG8_SB(0, 0), cB, voffB); PG8_STAGE(PG8_SB(0, 1), cB + hstep, voffB); PG8_STAGE(PG8_SA(0, 0), cA, voffA); PG8_STAGE(PG8_SA(0, 1), cA + hstep, voffA);
        if (wr == 1) PG8_BAR;
        PG8_WAIT_V(2); PG8_BAR;
        PG8_STAGE(PG8_SB(1, 0), cB + kstep, voffB); PG8_STAGE(PG8_SA(1, 0), cA + kstep, voffA); PG8_STAGE(PG8_SB(1, 1), cB + hstep + kstep, voffB);
        PG8_WAIT_V(6); PG8_BAR;
    } else {
        PG8_STAGE(PG8_SB(0, 0), cB, voffB); PG8_STAGE(PG8_SA(0, 0), cA, voffA); PG8_STAGE(PG8_SB(0, 1), cB + hstep, voffB); PG8_STAGE(PG8_SA(0, 1), cA + hstep, voffA);
        if (wr == 1) PG8_BAR;
        PG8_WAIT_V(4); PG8_BAR;
        PG8_STAGE(PG8_SB(1, 0), cB + kstep, voffB); PG8_STAGE(PG8_SA(1, 0), cA + kstep, voffA); PG8_STAGE(PG8_SB(1, 1), cB + hstep + kstep, voffB);
        PG8_WAIT_V(6); PG8_BAR;
    }
    for (;;) {
        const bool has_next = S.next(ui + 1, nxt);
        const char* nA = has_next ? (const char*)g.A + (size_t)nxt.pm * tstep : cA; const char* nB = has_next ? (const char*)g.Bt + (size_t)nxt.pn * tstep : cB;
        for (int t = 0; t < nt; t += 2) {
            const bool last = (t == nt - 2);
            const char* a1 = cA + (size_t)(t + 1) * kstep;
            const char* a2 = last ? nA : cA + (size_t)(t + 2) * kstep; const char* b2 = last ? nB : cB + (size_t)(t + 2) * kstep;
            const char* a3 = a2 + kstep; const char* b3 = b2 + kstep;
            if (last && has_next) S.a_ready(nxt);
            if constexpr (SP2) {
            PG8_LDB(B0, 0, 0); PG8_LDB(B1, 0, 1); PG8_SCHED; PG8_LDA(At, 0, 0); PG8_STAGE(PG8_SA(1, 1), a1 + hstep, voffA);
            PG8_WAIT_V(8); PG8_WAIT_L(0); PG8_BAR; PG8_MMA(0, 0, At, B0); PG8_MMA(0, 1, At, B1); PG8_BAR; PG8_SCHED;
            PG8_LDA(At, 0, 1); PG8_STAGE(PG8_SB(0, 0), b2, voffB); PG8_STAGE(PG8_SB(0, 1), b2 + hstep, voffB); PG8_STAGE(PG8_SA(0, 0), a2, voffA);
            PG8_WAIT_V(8); PG8_WAIT_L(0); PG8_BAR; PG8_MMA(1, 0, At, B0); PG8_MMA(1, 1, At, B1); PG8_BAR; PG8_SCHED;
            PG8_LDB(B0, 1, 0); PG8_LDB(B1, 1, 1); PG8_SCHED; PG8_LDA(At, 1, 0); PG8_STAGE(PG8_SA(0, 1), a2 + hstep, voffA);
            PG8_WAIT_V(8); PG8_WAIT_L(0); PG8_BAR; PG8_MMA(0, 0, At, B0); PG8_MMA(0, 1, At, B1); PG8_BAR; PG8_SCHED;
            PG8_LDA(At, 1, 1); PG8_STAGE(PG8_SB(1, 0), b3, voffB); PG8_STAGE(PG8_SB(1, 1), b3 + hstep, voffB); PG8_STAGE(PG8_SA(1, 0), a3, voffA);
            PG8_WAIT_V(8); PG8_WAIT_L(0); PG8_BAR; PG8_MMA(1, 0, At, B0); PG8_MMA(1, 1, At, B1); PG8_BAR; PG8_SCHED;
            } else {
            PG8_LDB(B0, 0, 0); PG8_SCHED; PG8_LDA(At, 0, 0); PG8_STAGE(PG8_SA(1, 1), a1 + hstep, voffA);
            PG8_WAIT_L(8); PG8_BAR; PG8_WAIT_L(0); PG8_MMA(0, 0, At, B0); PG8_BAR; PG8_SCHED;
            PG8_LDB(B1, 0, 1); PG8_STAGE(PG8_SB(0, 0), b2, voffB);
            PG8_BAR; PG8_WAIT_L(0); PG8_MMA(0, 1, At, B1); PG8_BAR;
            PG8_LDA(At, 0, 1); PG8_STAGE(PG8_SA(0, 0), a2, voffA);
            PG8_BAR; PG8_WAIT_L(0); PG8_MMA(1, 0, At, B0); PG8_BAR; PG8_SCHED;
            PG8_STAGE(PG8_SB(0, 1), b2 + hstep, voffB);
            PG8_WAIT_V(6); PG8_BAR; PG8_MMA(1, 1, At, B1); PG8_BAR;
            PG8_LDB(B0, 1, 0); PG8_SCHED; PG8_LDA(At, 1, 0); PG8_STAGE(PG8_SA(0, 1), a2 + hstep, voffA);
            PG8_WAIT_L(8); PG8_BAR; PG8_WAIT_L(0); PG8_MMA(0, 0, At, B0); PG8_BAR; PG8_SCHED;
            PG8_LDB(B1, 1, 1); PG8_STAGE(PG8_SB(1, 0), b3, voffB);
            PG8_BAR; PG8_WAIT_L(0); PG8_MMA(0, 1, At, B1); PG8_BAR;
            PG8_LDA(At, 1, 1); PG8_STAGE(PG8_SA(1, 0), a3, voffA);
            PG8_BAR; PG8_WAIT_L(0); PG8_MMA(1, 0, At, B0); PG8_BAR; PG8_SCHED;
            PG8_STAGE(PG8_SB(1, 1), b3 + hstep, voffB);
            PG8_WAIT_V(6); PG8_BAR; PG8_MMA(1, 1, At, B1); PG8_BAR;
            }
        }
        if constexpr (ALIGN_EPI) { if (wr == 0) PG8_BAR; }
        if constexpr (!Epi::AFTER_DRAIN) { E(acc, cur, wr, wc, fr, fq); S.done(cur); }
        if (!has_next) break;
#pragma unroll
        for (int a = 0; a < 2; ++a)
#pragma unroll
            for (int b = 0; b < 2; ++b)
#pragma unroll
                for (int m = 0; m < 4; ++m)
#pragma unroll
                    for (int n = 0; n < 2; ++n) acc[a][b][m][n] = (f32x4){0.f, 0.f, 0.f, 0.f};
        cur = nxt; cA = nA; cB = nB; ++ui;
        if constexpr (ALIGN_EPI) { if (wr == 1) PG8_BAR; }
    }
    PG8_WAIT_V(0);
    if constexpr (!ALIGN_EPI) { if (wr == 0) PG8_BAR; }
    PG8_BAR;
    if constexpr (Epi::AFTER_DRAIN) { E.fused(acc, cur, wr, wc, fr, fq, lds, wid, lane); S.done(cur); }
#undef PG8_SA
#undef PG8_SB
#undef PG8_STAGE
#undef PG8_LDA
#undef PG8_LDB
#undef PG8_MMA
#undef PG8_WAIT_V
#undef PG8_WAIT_L
#undef PG8_BAR
#undef PG8_SCHED
}
}
#ifndef PG8_SP2
#define PG8_SP2 true
#endif
#ifndef PG8_ALIGN
#define PG8_ALIGN true
#endif

constexpr int NWAVES = 8;
#ifndef MK_N_LAUNCHES
#define MK_N_LAUNCHES 8
#endif
constexpr int N_PHASES = 8;

constexpr int NB = 2, SEQ = 8192, D = 1024, M = NB * SEQ;
constexpr int NZ = 3840;
constexpr float EPS = 1e-6f;

constexpr size_t MiB = 1u << 20;
constexpr size_t WS_CTL = 0, CTL_ZERO_BYTES = 65536;
constexpr size_t WS_WIN = 1 * MiB;
constexpr size_t WS_WPA = 9 * MiB;
constexpr size_t WS_WPB = 10 * MiB;
constexpr size_t WS_WOUT = 11 * MiB;
constexpr size_t WS_WQ = 13 * MiB;
constexpr size_t WS_K1 = 17 * MiB;
constexpr size_t WS_K2 = 17 * MiB + 32768;
constexpr size_t WS_WS = 17 * MiB + 65536;
constexpr size_t WS_U = 18 * MiB;
constexpr size_t WS_V = 50 * MiB;
constexpr size_t WS_R1 = 82 * MiB;
constexpr size_t WS_Q = 114 * MiB;
constexpr size_t WS_KV = 130 * MiB;
constexpr size_t WS_GU = 138 * MiB;
constexpr size_t WS_GV = 154 * MiB;
constexpr size_t WS_GA = 170 * MiB;
constexpr size_t WS_GB = 202 * MiB;
constexpr size_t WS_MERGED = 114 * MiB;
constexpr size_t WS_QP = 170 * MiB;
constexpr size_t WS_END = 234 * MiB;
constexpr int CW_BAR = 0;

constexpr int RING_BYTES = 131072;
constexpr int MISC_OFF = 143360;
constexpr int LDS_BYTES = 147456;

#define GAS __attribute__((address_space(1)))
#define LAS __attribute__((address_space(3)))
typedef unsigned short bf16;
typedef unsigned v4u __attribute__((ext_vector_type(4)));
typedef unsigned v2u __attribute__((ext_vector_type(2)));
typedef float f32x4 __attribute__((ext_vector_type(4)));
typedef GAS unsigned gu32;
typedef __bf16 bf16x2_t __attribute__((ext_vector_type(2)));
#define RLX_AGENT __ATOMIC_RELAXED, __HIP_MEMORY_SCOPE_AGENT
#define LDS_WAIT() asm volatile("s_waitcnt lgkmcnt(0)" ::: "memory")
#define VM_WAIT() asm volatile("s_waitcnt vmcnt(0)" ::: "memory")
__device__ __forceinline__ unsigned f2bf(float f) { unsigned u = __builtin_bit_cast(unsigned, f); return (u + 0x7fffu + ((u >> 16) & 1u)) >> 16; }
__device__ __forceinline__ unsigned pk2(float lo, float hi) { return f2bf(lo) | (f2bf(hi) << 16); }
__device__ __forceinline__ float bflo(unsigned w) { return __builtin_bit_cast(float, w << 16); }
__device__ __forceinline__ float bfhi(unsigned w) { return __builtin_bit_cast(float, w & 0xffff0000u); }
__device__ __forceinline__ float bf2f(bf16 h) { return __builtin_bit_cast(float, (unsigned)h << 16); }
__device__ __forceinline__ float dot2bf(unsigned a, unsigned b, float c) { return __builtin_amdgcn_fdot2_f32_bf16(__builtin_bit_cast(bf16x2_t, a), __builtin_bit_cast(bf16x2_t, b), c, false); }
__device__ __forceinline__ float gelu_tanh(float v) {
    const float t2 = v * (-2.302208198f + (-0.1029432397f) * v * v);
    return v * __builtin_amdgcn_rcpf(1.0f + __builtin_amdgcn_exp2f(t2));
}
__device__ __forceinline__ float sigmoid_f(float v) { return __builtin_amdgcn_rcpf(1.0f + __builtin_amdgcn_exp2f(-1.4426950409f * v)); }
__device__ __forceinline__ float wave_sum(float v) {
#pragma unroll
    for (int o = 1; o < 64; o <<= 1) v += __shfl_xor(v, o);
    return v;
}
__device__ const unsigned char T5B[128] = {0, 1, 2, 3, 4, 5, 6, 7, 8, 9, 10, 11, 12, 13, 14, 15, 16, 16, 16, 17, 17, 18, 18, 18, 19, 19, 19, 20, 20, 20, 20, 21, 21, 21, 21, 22, 22, 22, 22, 22, 23, 23, 23, 23, 23, 23, 24, 24, 24, 24, 24, 24, 25, 25, 25, 25, 25, 25, 25, 26, 26, 26, 26, 26, 26, 26, 26, 27, 27, 27, 27, 27, 27, 27, 27, 27, 27, 28, 28, 28, 28, 28, 28, 28, 28, 28, 28, 29, 29, 29, 29, 29, 29, 29, 29, 29, 29, 29, 29, 30, 30, 30, 30, 30, 30, 30, 30, 30, 30, 30, 30, 30, 30, 31, 31, 31, 31, 31, 31, 31, 31, 31, 31, 31, 31, 31, 31, 31};
#define XB_TMO      128
#define XB_XCNT(j)  (256  + 64 * (j))
#define XB_XSUB(j)  (1280 + 64 * (j))
#define XB_XGEN(j)  (2304 + 64 * (j))
#define XB_TOP      3328
#define XB_TOPGEN   3392
#define XCD_BAR_WORDS 3456
#define XB_SPIN_CAP (1u << 18)

__device__ __forceinline__ unsigned xb_ld(unsigned* p)              { return __hip_atomic_load(p, __ATOMIC_RELAXED, __HIP_MEMORY_SCOPE_AGENT); }
__device__ __forceinline__ unsigned xb_add(unsigned* p, unsigned v) { return __hip_atomic_fetch_add(p, v, __ATOMIC_RELAXED, __HIP_MEMORY_SCOPE_AGENT); }
__device__ __forceinline__ unsigned xb_xcc_id() { return (unsigned)__builtin_amdgcn_s_getreg((3 << 11) | 20) & 0xFu; }
#define XB_SPIN(cond, bar) do { unsigned _sp = 0; while (cond) { __builtin_amdgcn_s_sleep(1); \
    if ((++_sp & 255u) == 0u) { if (xb_ld(&(bar)[XB_TMO])) break; if (_sp > XB_SPIN_CAP) { atomicAdd(&(bar)[XB_TMO], 1u); break; } } } } while (0)

struct XcdBarrier {
    unsigned* bar; unsigned x;
    volatile LAS unsigned* st;
};

__device__ __forceinline__ XcdBarrier xcd_barrier_post(unsigned* bar, volatile LAS unsigned* st) {
    XcdBarrier b; b.bar = bar; b.x = xb_xcc_id(); b.st = st;
    if (threadIdx.x == 0) (void)xb_add(&bar[XB_XCNT(b.x)], 1u);
    return b;
}
__device__ __forceinline__ void xcd_barrier_complete(unsigned* bar, unsigned x, unsigned& nloc, unsigned& nx) {
    const unsigned G = gridDim.x * gridDim.y * gridDim.z;
    unsigned sum, cnt, mine, sp = 0u;
    for (;;) {
        sum = 0u; cnt = 0u; mine = 0u;
#pragma unroll
        for (unsigned j = 0; j < 16; ++j) { const unsigned c = xb_ld(&bar[XB_XCNT(j)]); sum += c; cnt += (c > 0u) ? 1u : 0u; mine = (j == x) ? c : mine; }
        if (sum == G) break;
        __builtin_amdgcn_s_sleep(1);
        if ((++sp & 255u) == 0u) { if (xb_ld(&bar[XB_TMO])) break; if (sp > XB_SPIN_CAP) { atomicAdd(&bar[XB_TMO], 1u); break; } }
    }
    nloc = mine > 0u ? mine : 1u; nx = cnt > 0u ? cnt : 1u;
}

__device__ __forceinline__ void xcd_barrier(const XcdBarrier& b) {
    asm volatile("s_waitcnt vmcnt(0)" ::: "memory");
    __syncthreads();
    if (threadIdx.x == 0) {
        unsigned* bar = b.bar;
        __builtin_amdgcn_s_waitcnt(0);
        unsigned nloc = b.st[0], nx = b.st[1];
        if (nloc == 0u) { xcd_barrier_complete(bar, b.x, nloc, nx); b.st[0] = nloc; b.st[1] = nx; }
        const unsigned old = xb_add(&bar[XB_XSUB(b.x)], 1u);
        const unsigned gen = old / nloc;
        if (old + 1u == (gen + 1u) * nloc) {
            __builtin_amdgcn_fence(__ATOMIC_RELEASE, "agent");
            asm volatile("s_waitcnt vmcnt(0)" ::: "memory");
            const unsigned og = xb_add(&bar[XB_TOP], 1u);
            const unsigned tg = og / nx;
            if (og + 1u == (tg + 1u) * nx) xb_add(&bar[XB_TOPGEN], 1u);
            else XB_SPIN(xb_ld(&bar[XB_TOPGEN]) == tg, bar);
            __builtin_amdgcn_fence(__ATOMIC_ACQUIRE, "agent");
            xb_add(&bar[XB_XGEN(b.x)], 1u);
            asm volatile("s_waitcnt vmcnt(0)" ::: "memory");
        } else {
            XB_SPIN(xb_ld(&bar[XB_XGEN(b.x)]) == gen, bar);
            __builtin_amdgcn_fence(__ATOMIC_ACQUIRE, "agent");
            asm volatile("s_waitcnt vmcnt(0)" ::: "memory");
        }
    }
    __syncthreads();
}
namespace pg8 {
struct EpiZ {
    static constexpr bool PERM = true, AFTER_DRAIN = false;
    bf16_t *Q, *KV, *GU, *GV, *GA, *GB;
    __device__ __forceinline__ void operator()(const f32x4 (&acc)[2][2][4][2], const Unit& u, int wr, int wc, int fr, int fq) const {
        const int pn = u.pn; bf16_t* base; int ldc, colt, act;
        if (pn < 2)       { base = Q;  ldc = 512;  colt = pn * 256;        act = 0; }
        else if (pn == 2) { base = KV; ldc = 256;  colt = 0;               act = 0; }
        else if (pn < 5)  { base = GU; ldc = 512;  colt = (pn - 3) * 256;  act = 1; }
        else if (pn < 7)  { base = GV; ldc = 512;  colt = (pn - 5) * 256;  act = 1; }
        else if (pn < 11) { base = GA; ldc = 1024; colt = (pn - 7) * 256;  act = 2; }
        else              { base = GB; ldc = 1024; colt = (pn - 11) * 256; act = 2; }
        const int row0 = u.pm * BM + wr * 64 + fr, col0 = colt + wc * 32 + 8 * fq;
#pragma unroll
        for (int ai = 0; ai < 2; ++ai)
#pragma unroll
            for (int m = 0; m < 4; ++m) { bf16_t* rowp = base + (size_t)(row0 + ai * HALF + m * 16) * ldc + col0;
#pragma unroll
                for (int bj = 0; bj < 2; ++bj) { f32x4 v0 = acc[ai][bj][m][0], v1 = acc[ai][bj][m][1];
                    if (act == 1) {
#pragma unroll
                        for (int e = 0; e < 4; ++e) { v0[e] = gelu_tanh(v0[e]); v1[e] = gelu_tanh(v1[e]); }
                    } else if (act == 2) {
#pragma unroll
                        for (int e = 0; e < 4; ++e) { v0[e] = sigmoid_f(v0[e]); v1[e] = sigmoid_f(v1[e]); }
                    }
                    u32x4 w; w.x = cvt_pk_bf16(v0[0], v0[1]); w.y = cvt_pk_bf16(v0[2], v0[3]); w.z = cvt_pk_bf16(v1[0], v1[1]); w.w = cvt_pk_bf16(v1[2], v1[3]);
                    *(u32x4*)(rowp + bj * HALF) = w; } }
    }
};
struct EpiGateTmp {
    static constexpr bool PERM = true, AFTER_DRAIN = false;
    const bf16_t* gate; float* tmp;
    __device__ __forceinline__ void operator()(const f32x4 (&acc)[2][2][4][2], const Unit& u, int wr, int wc, int fr, int fq) const {
        const int row0 = u.pm * BM + wr * 64 + fr, col0 = u.pn * BM + wc * 32 + 8 * fq;
#pragma unroll
        for (int ai = 0; ai < 2; ++ai)
#pragma unroll
            for (int m = 0; m < 4; ++m) { const size_t ro = (size_t)(row0 + ai * HALF + m * 16) * 1024 + col0;
#pragma unroll
                for (int bj = 0; bj < 2; ++bj) { const u32x4 g = *(const u32x4*)(gate + ro + bj * HALF); f32x4 v0 = acc[ai][bj][m][0], v1 = acc[ai][bj][m][1];
                    v0[0] *= bflo(g.x); v0[1] *= bfhi(g.x); v0[2] *= bflo(g.y); v0[3] *= bfhi(g.y); v1[0] *= bflo(g.z); v1[1] *= bfhi(g.z); v1[2] *= bflo(g.w); v1[3] *= bfhi(g.w);
                    *(f32x4*)(tmp + ro + bj * HALF) = v0; *(f32x4*)(tmp + ro + bj * HALF + 4) = v1; } }
    }
};
struct EpiMerge {
    static constexpr bool PERM = true, AFTER_DRAIN = false;
    const bf16_t* gate; const float* tmp; bf16_t* out;
    __device__ __forceinline__ void operator()(const f32x4 (&acc)[2][2][4][2], const Unit& u, int wr, int wc, int fr, int fq) const {
        const int row0 = u.pm * BM + wr * 64 + fr, col0 = u.pn * BM + wc * 32 + 8 * fq;
#pragma unroll
        for (int ai = 0; ai < 2; ++ai)
#pragma unroll
            for (int m = 0; m < 4; ++m) { const size_t ro = (size_t)(row0 + ai * HALF + m * 16) * 1024 + col0;
#pragma unroll
                for (int bj = 0; bj < 2; ++bj) { const u32x4 g = *(const u32x4*)(gate + ro + bj * HALF); f32x4 v0 = acc[ai][bj][m][0], v1 = acc[ai][bj][m][1];
                    const f32x4 t0 = *(const f32x4*)(tmp + ro + bj * HALF), t1 = *(const f32x4*)(tmp + ro + bj * HALF + 4);
                    v0[0] = t0[0] + v0[0] * bflo(g.x); v0[1] = t0[1] + v0[1] * bfhi(g.x); v0[2] = t0[2] + v0[2] * bflo(g.y); v0[3] = t0[3] + v0[3] * bfhi(g.y);
                    v1[0] = t1[0] + v1[0] * bflo(g.z); v1[1] = t1[1] + v1[1] * bfhi(g.z); v1[2] = t1[2] + v1[2] * bflo(g.w); v1[3] = t1[3] + v1[3] * bfhi(g.w);
                    u32x4 w; w.x = cvt_pk_bf16(v0[0], v0[1]); w.y = cvt_pk_bf16(v0[2], v0[3]); w.z = cvt_pk_bf16(v1[0], v1[1]); w.w = cvt_pk_bf16(v1[2], v1[3]);
                    *(u32x4*)(out + ro + bj * HALF) = w; } }
    }
};
struct EpiRes {
    static constexpr bool PERM = false, AFTER_DRAIN = false;
    const float* base; float* C;
    __device__ __forceinline__ void operator()(const f32x4 (&acc)[2][2][4][2], const Unit& u, int wr, int wc, int fr, int fq) const {
        const int row0 = u.pm * BM + wr * 64 + fr, col0 = u.pn * BM + wc * 32 + 4 * fq;
#pragma unroll
        for (int ai = 0; ai < 2; ++ai)
#pragma unroll
            for (int m = 0; m < 4; ++m) { const size_t ro = (size_t)(row0 + ai * HALF + m * 16) * 1024 + col0;
#pragma unroll
                for (int bj = 0; bj < 2; ++bj)
#pragma unroll
                    for (int n = 0; n < 2; ++n) *(f32x4*)(C + ro + bj * HALF + n * 16) = *(const f32x4*)(base + ro + bj * HALF + n * 16) + acc[ai][bj][m][n]; }
    }
};
struct EpiPlain {
    static constexpr bool PERM = true, AFTER_DRAIN = false;
    bf16_t* O; int ldc;
    __device__ __forceinline__ void operator()(const f32x4 (&acc)[2][2][4][2], const Unit& u, int wr, int wc, int fr, int fq) const {
        const int row0 = u.pm * BM + wr * 64 + fr, col0 = u.pn * BM + wc * 32 + 8 * fq;
#pragma unroll
        for (int ai = 0; ai < 2; ++ai)
#pragma unroll
            for (int m = 0; m < 4; ++m) { bf16_t* rowp = O + (size_t)(row0 + ai * HALF + m * 16) * ldc + col0;
#pragma unroll
                for (int bj = 0; bj < 2; ++bj) { const f32x4 v0 = acc[ai][bj][m][0], v1 = acc[ai][bj][m][1];
                    u32x4 w; w.x = cvt_pk_bf16(v0[0], v0[1]); w.y = cvt_pk_bf16(v0[2], v0[3]); w.z = cvt_pk_bf16(v1[0], v1[1]); w.w = cvt_pk_bf16(v1[2], v1[3]);
                    *(u32x4*)(rowp + bj * HALF) = w; } }
    }
};
}

__device__ __forceinline__ void p0_transpose_item(const float* W, int K, int N, bf16* WT, LAS float* scr, int item, int lane) {
    const int nblk = N / 32, kb = item / nblk, nb = item % nblk, k0 = 64 * kb, n0 = 32 * nb;
#pragma unroll 8
    for (int i = 0; i < 32; ++i) { const int kk = 2 * i + (lane >> 5); scr[kk * 33 + (lane & 31)] = W[(size_t)(k0 + kk) * N + n0 + (lane & 31)]; }
    LDS_WAIT(); asm volatile("" ::: "memory");
    const int c = lane & 7;
#pragma unroll
    for (int j = 0; j < 4; ++j) { const int n = (lane >> 3) + 8 * j; const LAS float* s = scr + (8 * c) * 33 + n;
        v4u o; o.x = pk2(s[0 * 33], s[1 * 33]); o.y = pk2(s[2 * 33], s[3 * 33]); o.z = pk2(s[4 * 33], s[5 * 33]); o.w = pk2(s[6 * 33], s[7 * 33]);
        *(v4u*)(WT + (size_t)(n0 + n) * K + k0 + 8 * c) = o; }
    LDS_WAIT(); asm volatile("" ::: "memory");
}
__device__ __forceinline__ void cvt_flat(const float* src, bf16* dst, size_t n, int gw, int NGW, int lane) {
    for (size_t i = (size_t)gw * 512 + lane * 8; i < n; i += (size_t)NGW * 512) {
        const f32x4 a = *(const f32x4*)(src + i), b = *(const f32x4*)(src + i + 4);
        v4u o; o.x = pk2(a[0], a[1]); o.y = pk2(a[2], a[3]); o.z = pk2(b[0], b[1]); o.w = pk2(b[2], b[3]);
        *(v4u*)(dst + i) = o;
    }
}
__device__ __forceinline__ void rms_row_to_bf16(const float* xrow, const float* w, bf16* orow, int lane) {
    const f32x4* xr = (const f32x4*)xrow + lane; const f32x4* wr = (const f32x4*)w + lane;
    f32x4 v[4]; float s = 0.f;
#pragma unroll
    for (int j = 0; j < 4; ++j) { v[j] = xr[64 * j]; s += (v[j][0] * v[j][0] + v[j][1] * v[j][1]) + (v[j][2] * v[j][2] + v[j][3] * v[j][3]); }
    const float rstd = 1.0f / sqrtf(wave_sum(s) * (1.0f / 1024.0f) + EPS);
    unsigned long long* o8 = (unsigned long long*)orow + lane;
#pragma unroll
    for (int j = 0; j < 4; ++j) { const f32x4 ww = wr[64 * j];
        o8[64 * j] = (unsigned long long)pk2(v[j][0] * rstd * ww[0], v[j][1] * rstd * ww[1]) | ((unsigned long long)pk2(v[j][2] * rstd * ww[2], v[j][3] * rstd * ww[3]) << 32); }
}

struct Ptrs {
    const float *x, *mix_w, *w_in, *rel_bias, *sinks, *w_pa, *ln_w, *ln_b, *w_s, *b_s, *w_pb, *w_out, *ffn_w, *w_q, *keys1, *keys2, *pu, *pv, *fin_w;
    float* out;
    bf16 *WIN, *WPA, *WPB, *WOUT, *WQ, *K1, *K2, *WS, *U, *V, *XN, *AOUT, *BOUT, *HN2, *Q, *KV, *GU, *GV, *GA, *GB, *MERGED, *QP;
};

__device__ __forceinline__ void p0_prologue(LAS unsigned char* lds, const Ptrs& P, int vcu, int G, int lane, int wave) {
    LAS float* scr = (LAS float*)(lds + wave * 16384);
    const int gw = vcu * NWAVES + wave, NGW = G * NWAVES;
    constexpr int I_IN = (1024 / 64) * (3840 / 32), I_PA = (512 / 64) * (1024 / 32), I_OUT = (1024 / 64) * (1024 / 32), I_WQ = (1024 / 64) * (2048 / 32);
    constexpr int NITEMS = I_IN + 2 * I_PA + I_OUT + I_WQ;
    for (int it = gw; it < NITEMS; it += NGW) {
        int r = it;
        if (r < I_IN) { p0_transpose_item(P.w_in, 1024, 3840, P.WIN, scr, r, lane); continue; } r -= I_IN;
        if (r < I_PA) { p0_transpose_item(P.w_pa, 512, 1024, P.WPA, scr, r, lane); continue; } r -= I_PA;
        if (r < I_PA) { p0_transpose_item(P.w_pb, 512, 1024, P.WPB, scr, r, lane); continue; } r -= I_PA;
        if (r < I_OUT) { p0_transpose_item(P.w_out, 1024, 1024, P.WOUT, scr, r, lane); continue; } r -= I_OUT;
        p0_transpose_item(P.w_q, 1024, 2048, P.WQ, scr, r, lane);
    }
    cvt_flat(P.keys1, P.K1, 128 * 128, gw, NGW, lane);
    cvt_flat(P.keys2, P.K2, 128 * 128, gw, NGW, lane);
    cvt_flat(P.pu, P.U, (size_t)16384 * 1024, gw, NGW, lane);
    cvt_flat(P.pv, P.V, (size_t)16384 * 1024, gw, NGW, lane);
    for (size_t i = (size_t)gw * 512 + lane * 8; i < (size_t)8 * 128 * 128; i += (size_t)NGW * 512) {
        const int t = (int)((i >> 7) & 127), s0 = (int)(i & 127);
        const f32x4 a = *(const f32x4*)(P.w_s + i), b = *(const f32x4*)(P.w_s + i + 4);
        float e[8] = {a[0], a[1], a[2], a[3], b[0], b[1], b[2], b[3]};
#pragma unroll
        for (int j = 0; j < 8; ++j) e[j] = (s0 + j <= t) ? e[j] : 0.f;
        v4u o; o.x = pk2(e[0], e[1]); o.y = pk2(e[2], e[3]); o.z = pk2(e[4], e[5]); o.w = pk2(e[6], e[7]);
        *(v4u*)(P.WS + i) = o;
    }
    for (int m = gw; m < M; m += NGW) rms_row_to_bf16(P.x + (size_t)m * D, P.mix_w, P.XN + (size_t)m * D, lane);
}

__device__ __forceinline__ void p2_attn_naive(LAS unsigned char* lds, const Ptrs& P, int vcu, int G, int tid, int lane, int wave) {
    LAS float* biasl = (LAS float*)lds;
    for (int i = tid; i < 1024; i += 512) { const int d = i >> 3, h = i & 7; biasl[i] = P.rel_bias[(int)T5B[d] * 8 + h]; }
    __syncthreads();
    const int h = wave, kvh = h >> 2;
    const float sink = P.sinks[h];
    for (int unit = vcu; unit < M / 64; unit += G) {
        const int t = unit * 64 + lane, pos = t & (SEQ - 1);
        float q[64], o[64];
        { const v4u* qp = (const v4u*)(P.Q + (size_t)t * 512 + h * 64);
#pragma unroll
          for (int c = 0; c < 8; ++c) { const v4u w = qp[c]; q[8 * c + 0] = bflo(w.x) * 0.125f; q[8 * c + 1] = bfhi(w.x) * 0.125f; q[8 * c + 2] = bflo(w.y) * 0.125f; q[8 * c + 3] = bfhi(w.y) * 0.125f;
              q[8 * c + 4] = bflo(w.z) * 0.125f; q[8 * c + 5] = bfhi(w.z) * 0.125f; q[8 * c + 6] = bflo(w.w) * 0.125f; q[8 * c + 7] = bfhi(w.w) * 0.125f; } }
#pragma unroll
        for (int i = 0; i < 64; ++i) o[i] = 0.f;
        float m = sink, l = 1.f;
        for (int d = 0; d < 128; ++d) {
            const bool valid = (pos - d) >= 0;
            const int tj = valid ? (t - d) : t;
            const v4u* kp = (const v4u*)(P.KV + (size_t)tj * 256 + kvh * 64);
            float dot = 0.f;
#pragma unroll
            for (int c = 0; c < 8; ++c) { const v4u w = kp[c];
                dot += q[8 * c + 0] * bflo(w.x) + q[8 * c + 1] * bfhi(w.x) + q[8 * c + 2] * bflo(w.y) + q[8 * c + 3] * bfhi(w.y) + q[8 * c + 4] * bflo(w.z) + q[8 * c + 5] * bfhi(w.z) + q[8 * c + 6] * bflo(w.w) + q[8 * c + 7] * bfhi(w.w); }
            const float s = valid ? dot + biasl[d * 8 + h] : -1e30f;
            const float mn = fmaxf(m, s), alpha = __expf(m - mn), p = __expf(s - mn);
            l = l * alpha + p; m = mn;
            const v4u* vp = kp + 16;
#pragma unroll
            for (int c = 0; c < 8; ++c) { const v4u w = vp[c];
                o[8 * c + 0] = o[8 * c + 0] * alpha + p * bflo(w.x); o[8 * c + 1] = o[8 * c + 1] * alpha + p * bfhi(w.x); o[8 * c + 2] = o[8 * c + 2] * alpha + p * bflo(w.y); o[8 * c + 3] = o[8 * c + 3] * alpha + p * bfhi(w.y);
                o[8 * c + 4] = o[8 * c + 4] * alpha + p * bflo(w.z); o[8 * c + 5] = o[8 * c + 5] * alpha + p * bfhi(w.z); o[8 * c + 6] = o[8 * c + 6] * alpha + p * bflo(w.w); o[8 * c + 7] = o[8 * c + 7] * alpha + p * bfhi(w.w); }
        }
        const float inv = 1.0f / l;
        v4u* op = (v4u*)(P.AOUT + (size_t)t * 512 + h * 64);
#pragma unroll
        for (int c = 0; c < 8; ++c) { v4u w; w.x = pk2(o[8 * c + 0] * inv, o[8 * c + 1] * inv); w.y = pk2(o[8 * c + 2] * inv, o[8 * c + 3] * inv); w.z = pk2(o[8 * c + 4] * inv, o[8 * c + 5] * inv); w.w = pk2(o[8 * c + 6] * inv, o[8 * c + 7] * inv); op[c] = w; }
    }
    __syncthreads();
}

__device__ __forceinline__ void p2_gmlp_naive(LAS unsigned char* lds, const Ptrs& P, int vcu, int G, int tid, int lane, int wave) {
    LAS bf16* vnl = (LAS bf16*)(lds + 8192);
    for (int unit = vcu; unit < 256; unit += G) {
        const int c = unit >> 1, hh = unit & 1;
        for (int i = 0; i < 16; ++i) {
            const int tt = wave * 16 + i; const size_t row = (size_t)c * 128 + tt;
            const v4u w = *((const v4u*)(P.GV + row * 512) + lane);
            float x[8] = {bflo(w.x), bfhi(w.x), bflo(w.y), bfhi(w.y), bflo(w.z), bfhi(w.z), bflo(w.w), bfhi(w.w)};
            float s = 0.f;
#pragma unroll
            for (int j = 0; j < 8; ++j) s += x[j];
            const float mean = wave_sum(s) * (1.0f / 512.0f);
            float ss = 0.f;
#pragma unroll
            for (int j = 0; j < 8; ++j) { x[j] -= mean; ss += x[j] * x[j]; }
            const float rstd = 1.0f / sqrtf(wave_sum(ss) * (1.0f / 512.0f) + EPS);
            if ((lane >> 5) == hh) {
                const f32x4 w0 = *(const f32x4*)(P.ln_w + lane * 8), w1 = *(const f32x4*)(P.ln_w + lane * 8 + 4), b0 = *(const f32x4*)(P.ln_b + lane * 8), b1 = *(const f32x4*)(P.ln_b + lane * 8 + 4);
                v4u o; o.x = pk2(x[0] * rstd * w0[0] + b0[0], x[1] * rstd * w0[1] + b0[1]); o.y = pk2(x[2] * rstd * w0[2] + b0[2], x[3] * rstd * w0[3] + b0[3]);
                o.z = pk2(x[4] * rstd * w1[0] + b1[0], x[5] * rstd * w1[1] + b1[1]); o.w = pk2(x[6] * rstd * w1[2] + b1[2], x[7] * rstd * w1[3] + b1[3]);
                *(LAS v4u*)(vnl + tt * 256 + (lane & 31) * 8) = o;
            }
        }
        __syncthreads();
        const int ch = tid & 255, th = tid >> 8, g = hh * 4 + (ch >> 6);
        for (int t = th * 64; t < th * 64 + 64; ++t) {
            const v4u* wrow = (const v4u*)(P.WS + ((size_t)g * 128 + t) * 128);
            float acc = 0.f;
            for (int s8 = 0; s8 <= (t >> 3); ++s8) {
                const v4u w = wrow[s8];
                const LAS bf16* vp = vnl + (s8 * 8) * 256 + ch;
                acc += bflo(w.x) * bf2f(vp[0]) + bfhi(w.x) * bf2f(vp[256]) + bflo(w.y) * bf2f(vp[512]) + bfhi(w.y) * bf2f(vp[768])
                     + bflo(w.z) * bf2f(vp[1024]) + bfhi(w.z) * bf2f(vp[1280]) + bflo(w.w) * bf2f(vp[1536]) + bfhi(w.w) * bf2f(vp[1792]);
            }
            const size_t row = (size_t)c * 128 + t;
            const float uval = bf2f(P.GU[row * 512 + hh * 256 + ch]);
            P.BOUT[row * 512 + hh * 256 + ch] = (bf16)f2bf(uval * (acc + P.b_s[g * 128 + t]));
        }
        __syncthreads();
    }
}

__device__ __forceinline__ void topk_half(const bf16* q, const LAS bf16* kl, float (&v)[16]) {
    v4u qv[16];
#pragma unroll
    for (int c = 0; c < 16; ++c) qv[c] = ((const v4u*)q)[c];
#pragma unroll
    for (int i = 0; i < 16; ++i) v[i] = -INFINITY;
    for (int n = 0; n < 128; ++n) {
        const LAS v4u* kr = (const LAS v4u*)(kl + n * 128);
        float a0 = 0.f, a1 = 0.f, a2 = 0.f, a3 = 0.f;
#pragma unroll
        for (int c = 0; c < 16; ++c) { const v4u kk = kr[c]; a0 = dot2bf(qv[c].x, kk.x, a0); a1 = dot2bf(qv[c].y, kk.y, a1); a2 = dot2bf(qv[c].z, kk.z, a2); a3 = dot2bf(qv[c].w, kk.w, a3); }
        const float acc = (a0 + a1) + (a2 + a3);
        float x = __builtin_bit_cast(float, (__builtin_bit_cast(unsigned, acc) & ~0x7Fu) | (unsigned)n);
#pragma unroll
        for (int i = 0; i < 16; ++i) { const float hi = fmaxf(v[i], x); x = fminf(v[i], x); v[i] = hi; }
    }
}

__device__ __forceinline__ void p7_peer(LAS unsigned char* lds, const Ptrs& P, int vcu, int G, int tid, int lane, int wave) {
    LAS bf16* k1l = (LAS bf16*)lds;
    LAS bf16* k2l = (LAS bf16*)(lds + 32768);
    LAS int* idxl = (LAS int*)(lds + 65536);
    LAS float* gatel = (LAS float*)(lds + 98304);
    LAS float* al = (LAS float*)(lds + 131072);
    for (int i = tid; i < 2048; i += 512) { ((LAS v4u*)k1l)[i] = ((const v4u*)P.K1)[i]; ((LAS v4u*)k2l)[i] = ((const v4u*)P.K2)[i]; }
    __syncthreads();
    for (int unit = vcu; unit < M / 64; unit += G) {
        {
            const int tl = tid >> 3, h = tid & 7;
            const bf16* qrow = P.QP + (size_t)(unit * 64 + tl) * 2048 + h * 256;
            float v1[16], v2[16];
            topk_half(qrow, k1l, v1);
            topk_half(qrow + 128, k2l, v2);
            float tv[16]; int tp[16];
#pragma unroll
            for (int k = 0; k < 16; ++k) { tv[k] = -INFINITY; tp[k] = 0; }
#pragma unroll
            for (int i = 0; i < 16; ++i)
#pragma unroll
                for (int j = 0; j < 16; ++j)
                    if ((i + 1) * (j + 1) <= 16) {
                        const unsigned b1 = __builtin_bit_cast(unsigned, v1[i]), b2 = __builtin_bit_cast(unsigned, v2[j]);
                        float x = __builtin_bit_cast(float, b1 & ~0x7Fu) + __builtin_bit_cast(float, b2 & ~0x7Fu);
                        int px = (int)((b1 & 0x7Fu) * 128u + (b2 & 0x7Fu));
#pragma unroll
                        for (int k = 0; k < 16; ++k) { const bool c = x > tv[k]; const float nv = c ? x : tv[k], nx = c ? tv[k] : x; const int np = c ? px : tp[k], npx = c ? tp[k] : px; tv[k] = nv; x = nx; tp[k] = np; px = npx; }
                    }
            float e[16], es = 0.f;
#pragma unroll
            for (int k = 0; k < 16; ++k) { e[k] = __expf(tv[k] - tv[0]); es += e[k]; }
            const float inv = 1.0f / es;
            LAS v4u* ip = (LAS v4u*)(idxl + tl * 128 + h * 16); LAS f32x4* gp = (LAS f32x4*)(gatel + tl * 128 + h * 16);
#pragma unroll
            for (int k = 0; k < 4; ++k) { v4u iv; iv.x = (unsigned)tp[4 * k]; iv.y = (unsigned)tp[4 * k + 1]; iv.z = (unsigned)tp[4 * k + 2]; iv.w = (unsigned)tp[4 * k + 3]; ip[k] = iv;
                f32x4 gv; gv[0] = e[4 * k] * inv; gv[1] = e[4 * k + 1] * inv; gv[2] = e[4 * k + 2] * inv; gv[3] = e[4 * k + 3] * inv; gp[k] = gv; }
        }
        __syncthreads();
        const int sub = lane & 15, grp = lane >> 4;
        for (int i = 0; i < 8; ++i) {
            const int tl = wave * 8 + i; const size_t t = (size_t)unit * 64 + tl;
            v4u hnr[8];
#pragma unroll
            for (int j = 0; j < 8; ++j) hnr[j] = *((const v4u*)(P.HN2 + t * 1024) + j * 16 + sub);
            for (int q = 0; q < 32; ++q) {
                const int row = idxl[tl * 128 + 4 * q + grp];
                const v4u* up = (const v4u*)(P.U + (size_t)row * 1024) + sub;
                float a0 = 0.f, a1 = 0.f, a2 = 0.f, a3 = 0.f;
#pragma unroll
                for (int j = 0; j < 8; ++j) { const v4u w = up[j * 16]; a0 = dot2bf(w.x, hnr[j].x, a0); a1 = dot2bf(w.y, hnr[j].y, a1); a2 = dot2bf(w.z, hnr[j].z, a2); a3 = dot2bf(w.w, hnr[j].w, a3); }
                float acc = (a0 + a1) + (a2 + a3);
                acc += __shfl_xor(acc, 8); acc += __shfl_xor(acc, 4); acc += __shfl_xor(acc, 2); acc += __shfl_xor(acc, 1);
                if (sub == 0) al[wave * 128 + 4 * q + grp] = acc;
            }
            LDS_WAIT();
            const float av0 = al[wave * 128 + lane], av1 = al[wave * 128 + 64 + lane];
            const float act0 = gelu_tanh(av0) * gatel[tl * 128 + lane], act1 = gelu_tanh(av1) * gatel[tl * 128 + 64 + lane];
            const int ix0 = idxl[tl * 128 + lane], ix1 = idxl[tl * 128 + 64 + lane];
            LDS_WAIT();
            float y[16];
#pragma unroll
            for (int k = 0; k < 16; ++k) y[k] = 0.f;
#pragma unroll 4
            for (int e = 0; e < 64; ++e) {
                const int row = __builtin_amdgcn_readlane(ix0, e); const float a = __builtin_bit_cast(float, __builtin_amdgcn_readlane(__builtin_bit_cast(int, act0), e));
                const v4u* vp = (const v4u*)(P.V + (size_t)row * 1024) + lane; const v4u w0 = vp[0], w1 = vp[64];
                y[0] += a * bflo(w0.x); y[1] += a * bfhi(w0.x); y[2] += a * bflo(w0.y); y[3] += a * bfhi(w0.y); y[4] += a * bflo(w0.z); y[5] += a * bfhi(w0.z); y[6] += a * bflo(w0.w); y[7] += a * bfhi(w0.w);
                y[8] += a * bflo(w1.x); y[9] += a * bfhi(w1.x); y[10] += a * bflo(w1.y); y[11] += a * bfhi(w1.y); y[12] += a * bflo(w1.z); y[13] += a * bfhi(w1.z); y[14] += a * bflo(w1.w); y[15] += a * bfhi(w1.w);
            }
#pragma unroll 4
            for (int e = 0; e < 64; ++e) {
                const int row = __builtin_amdgcn_readlane(ix1, e); const float a = __builtin_bit_cast(float, __builtin_amdgcn_readlane(__builtin_bit_cast(int, act1), e));
                const v4u* vp = (const v4u*)(P.V + (size_t)row * 1024) + lane; const v4u w0 = vp[0], w1 = vp[64];
                y[0] += a * bflo(w0.x); y[1] += a * bfhi(w0.x); y[2] += a * bflo(w0.y); y[3] += a * bfhi(w0.y); y[4] += a * bflo(w0.z); y[5] += a * bfhi(w0.z); y[6] += a * bflo(w0.w); y[7] += a * bfhi(w0.w);
                y[8] += a * bflo(w1.x); y[9] += a * bfhi(w1.x); y[10] += a * bflo(w1.y); y[11] += a * bfhi(w1.y); y[12] += a * bflo(w1.z); y[13] += a * bfhi(w1.z); y[14] += a * bflo(w1.w); y[15] += a * bfhi(w1.w);
            }
            float* xr = P.out + t * 1024;
            f32x4 x0 = *(const f32x4*)(xr + lane * 8), x1 = *(const f32x4*)(xr + lane * 8 + 4), x2 = *(const f32x4*)(xr + 512 + lane * 8), x3 = *(const f32x4*)(xr + 512 + lane * 8 + 4);
            x0[0] += y[0]; x0[1] += y[1]; x0[2] += y[2]; x0[3] += y[3]; x1[0] += y[4]; x1[1] += y[5]; x1[2] += y[6]; x1[3] += y[7];
            x2[0] += y[8]; x2[1] += y[9]; x2[2] += y[10]; x2[3] += y[11]; x3[0] += y[12]; x3[1] += y[13]; x3[2] += y[14]; x3[3] += y[15];
            float ss = 0.f;
#pragma unroll
            for (int k = 0; k < 4; ++k) ss += x0[k] * x0[k] + x1[k] * x1[k] + x2[k] * x2[k] + x3[k] * x3[k];
            const float rstd = 1.0f / sqrtf(wave_sum(ss) * (1.0f / 1024.0f) + EPS);
            const f32x4 w0 = *(const f32x4*)(P.fin_w + lane * 8), w1 = *(const f32x4*)(P.fin_w + lane * 8 + 4), w2 = *(const f32x4*)(P.fin_w + 512 + lane * 8), w3 = *(const f32x4*)(P.fin_w + 512 + lane * 8 + 4);
            *(f32x4*)(xr + lane * 8) = x0 * rstd * w0; *(f32x4*)(xr + lane * 8 + 4) = x1 * rstd * w1; *(f32x4*)(xr + 512 + lane * 8) = x2 * rstd * w2; *(f32x4*)(xr + 512 + lane * 8 + 4) = x3 * rstd * w3;
        }
        __syncthreads();
    }
}

struct Args { const float* in[19]; float* out; unsigned char* ws; int ph_lo, ph_hi; };
__global__ void __launch_bounds__(NWAVES * 64, 2) mega_fwd(Args args) {
    extern __shared__ __attribute__((aligned(16))) unsigned char lds_raw[];
    LAS unsigned char* lds = (LAS unsigned char*)lds_raw;
    const int tid = threadIdx.x, lane = tid & 63, wave = __builtin_amdgcn_readfirstlane(tid >> 6);
    const int G = gridDim.x; const int bx = blockIdx.x; const int vcu = (G % 8 == 0) ? (bx % 8) * (G / 8) + bx / 8 : bx;
    unsigned char* ws = args.ws;
    Ptrs P;
    P.x = args.in[0]; P.mix_w = args.in[1]; P.w_in = args.in[2]; P.rel_bias = args.in[3]; P.sinks = args.in[4]; P.w_pa = args.in[5]; P.ln_w = args.in[6]; P.ln_b = args.in[7];
    P.w_s = args.in[8]; P.b_s = args.in[9]; P.w_pb = args.in[10]; P.w_out = args.in[11]; P.ffn_w = args.in[12]; P.w_q = args.in[13]; P.keys1 = args.in[14]; P.keys2 = args.in[15];
    P.pu = args.in[16]; P.pv = args.in[17]; P.fin_w = args.in[18]; P.out = args.out;
    P.WIN = (bf16*)(ws + WS_WIN); P.WPA = (bf16*)(ws + WS_WPA); P.WPB = (bf16*)(ws + WS_WPB); P.WOUT = (bf16*)(ws + WS_WOUT); P.WQ = (bf16*)(ws + WS_WQ);
    P.K1 = (bf16*)(ws + WS_K1); P.K2 = (bf16*)(ws + WS_K2); P.WS = (bf16*)(ws + WS_WS); P.U = (bf16*)(ws + WS_U); P.V = (bf16*)(ws + WS_V);
    P.XN = (bf16*)(ws + WS_R1); P.AOUT = (bf16*)(ws + WS_R1); P.BOUT = (bf16*)(ws + WS_R1 + 16 * MiB); P.HN2 = (bf16*)(ws + WS_R1);
    P.Q = (bf16*)(ws + WS_Q); P.KV = (bf16*)(ws + WS_KV); P.GU = (bf16*)(ws + WS_GU); P.GV = (bf16*)(ws + WS_GV); P.GA = (bf16*)(ws + WS_GA); P.GB = (bf16*)(ws + WS_GB);
    P.MERGED = (bf16*)(ws + WS_MERGED); P.QP = (bf16*)(ws + WS_QP);

    for (int u = tid; u < (LDS_BYTES - MISC_OFF) / 4; u += NWAVES * 64) ((LAS unsigned*)(lds + MISC_OFF))[u] = 0u;
    __syncthreads();
    const int lo = args.ph_lo, hi = args.ph_hi;
    unsigned* barw = (unsigned*)(ws + WS_CTL) + CW_BAR;
    XcdBarrier bar; bar.bar = barw; bar.x = 0; bar.st = nullptr;
    if (hi - lo > 1) bar = xcd_barrier_post(barw, (volatile LAS unsigned*)(lds + MISC_OFF));
#define IN(k) (lo <= (k) && (k) < hi)
#define BOTH(k) (IN(k) && IN((k) + 1))
#define GRID_BAR() xcd_barrier(bar)

    if (IN(0)) { p0_prologue(lds, P, vcu, G, lane, wave); if (BOTH(0)) GRID_BAR(); }

    if (IN(1)) {
        pg8::Gemm g{P.XN, P.WIN, M, NZ, D}; pg8::StaticOrder S; S.init(M, NZ, G, bx);
        pg8::EpiZ E{P.Q, P.KV, P.GU, P.GV, P.GA, P.GB};
        pg8::gemm_phase<pg8::EpiZ, pg8::StaticOrder, PG8_ALIGN, PG8_SP2>(lds, g, S, E);
        if (BOTH(1)) GRID_BAR();
    }

    if (IN(2)) {
        p2_attn_naive(lds, P, vcu, G, tid, lane, wave);
        p2_gmlp_naive(lds, P, vcu, G, tid, lane, wave);
        if (BOTH(2)) GRID_BAR();
    }

    if (IN(3)) {
        { pg8::Gemm g{P.AOUT, P.WPA, M, D, 512}; pg8::StaticOrder S; S.init(M, D, G, bx);
          pg8::EpiGateTmp E{P.GA, P.out};
          pg8::gemm_phase<pg8::EpiGateTmp, pg8::StaticOrder, PG8_ALIGN, PG8_SP2>(lds, g, S, E); }
        { pg8::Gemm g{P.BOUT, P.WPB, M, D, 512}; pg8::StaticOrder S; S.init(M, D, G, bx);
          pg8::EpiMerge E{P.GB, P.out, P.MERGED};
          pg8::gemm_phase<pg8::EpiMerge, pg8::StaticOrder, PG8_ALIGN, PG8_SP2>(lds, g, S, E); }
        if (BOTH(3)) GRID_BAR();
    }

    if (IN(4)) {
        pg8::Gemm g{P.MERGED, P.WOUT, M, D, D}; pg8::StaticOrder S; S.init(M, D, G, bx);
        pg8::EpiRes E{P.x, P.out};
        pg8::gemm_phase<pg8::EpiRes, pg8::StaticOrder, PG8_ALIGN, PG8_SP2>(lds, g, S, E);
        if (BOTH(4)) GRID_BAR();
    }

    if (IN(5)) {
        const int gw = vcu * NWAVES + wave, NGW = G * NWAVES;
        for (int m = gw; m < M; m += NGW) rms_row_to_bf16(P.out + (size_t)m * D, P.ffn_w, P.HN2 + (size_t)m * D, lane);
        if (BOTH(5)) GRID_BAR();
    }

    if (IN(6)) {
        pg8::Gemm g{P.HN2, P.WQ, M, 2048, D}; pg8::StaticOrder S; S.init(M, 2048, G, bx);
        pg8::EpiPlain E{P.QP, 2048};
        pg8::gemm_phase<pg8::EpiPlain, pg8::StaticOrder, PG8_ALIGN, PG8_SP2>(lds, g, S, E);
        if (BOTH(6)) GRID_BAR();
    }

    if (IN(7)) p7_peer(lds, P, vcu, G, tid, lane, wave);
#undef IN
#undef BOTH
#undef GRID_BAR
}

extern "C" void kernel_launch(void* const* d_in, const int* in_sizes, int n_in, void* d_out, int out_size, void* d_ws, size_t ws_size, hipStream_t stream) {
    static int grid = 0;
    if (grid == 0) {
        if (n_in != 19 || out_size != M * D || ws_size < WS_END) { fprintf(stderr, "kernel_launch: unexpected shapes (n_in %d, out %d, ws %zu)\n", n_in, out_size, ws_size); grid = -1; return; }
        int dev = 0, cus = 0, per_cu = 0;
        if (hipGetDevice(&dev) != hipSuccess || hipDeviceGetAttribute(&cus, hipDeviceAttributeMultiprocessorCount, dev) != hipSuccess) { grid = -1; return; }
        if (hipFuncSetAttribute((const void*)mega_fwd, hipFuncAttributeMaxDynamicSharedMemorySize, LDS_BYTES) != hipSuccess) { fprintf(stderr, "kernel_launch: hipFuncSetAttribute failed\n"); grid = -1; return; }
        if (hipOccupancyMaxActiveBlocksPerMultiprocessor(&per_cu, (const void*)mega_fwd, NWAVES * 64, LDS_BYTES) != hipSuccess || per_cu < 1)
            fprintf(stderr, "kernel_launch: note: occupancy query reports %d workgroups per CU\n", per_cu);
        (void)hipGetLastError();
        grid = cus;
    }
    if (grid < 0) return;
    if (hipMemsetAsync((char*)d_ws + WS_CTL, 0, CTL_ZERO_BYTES, stream) != hipSuccess) return;
    Args a{};
    for (int i = 0; i < 19; ++i) a.in[i] = (const float*)d_in[i];
    a.out = (float*)d_out; a.ws = (unsigned char*)d_ws;
#if MK_N_LAUNCHES == 1
    a.ph_lo = 0; a.ph_hi = N_PHASES;
    hipLaunchKernelGGL(mega_fwd, dim3(grid), dim3(NWAVES * 64), LDS_BYTES, stream, a);
#else
    for (int li = 0; li < N_PHASES; ++li) { a.ph_lo = li; a.ph_hi = li + 1; hipLaunchKernelGGL(mega_fwd, dim3(grid), dim3(NWAVES * 64), LDS_BYTES, stream, a); }
#endif
}
```

```cpp
#include <hip/hip_runtime.h>
#include <cstdio>
#include <cstdint>
namespace pg8 {
#define PG8_LAS __attribute__((address_space(3)))
typedef unsigned short bf16_t;
typedef short bf16x8 __attribute__((ext_vector_type(8)));
typedef float f32x4 __attribute__((ext_vector_type(4)));
typedef unsigned u32x4 __attribute__((ext_vector_type(4)));
constexpr int BM = 256, BK = 64, HALF = 128, HTB = HALF * BK * 2  , STAGE_BYTES = 8 * HTB, NXCD = 8, WGM = 8;

__host__ __device__ __forceinline__ int lds_byte(int r, int c) { const int st = (r >> 4) * 2 + (c >> 5), rr = r & 15, cc = c & 31, ob = rr * 64 + cc * 2; return st * 1024 + (ob ^ (((ob >> 9) & 1) << 5)); }
__host__ __device__ __forceinline__ void stage_rc(int b, int& R, int& C) { const int st = b / 1024, sb = b % 1024, swz = sb ^ (((sb >> 9) & 1) << 5); R = (st >> 1) * 16 + swz / 64; C = (st & 1) * 32 + (swz % 64) / 2; }
__host__ __device__ __forceinline__ int perm32(int rho) { const int n = rho >> 4, i = rho & 15; return 8 * (i >> 2) + 4 * n + (i & 3); }

struct Unit { int pm, pn; };
struct Gemm { const bf16_t* A; const bf16_t* Bt; int M, N, K; };

struct StaticOrder {
    int nM, nN, nwg, G, c;
    __host__ __device__ void init(int M, int N, int G_, int c_) { nM = M / BM; nN = N / BM; nwg = nM * nN; G = G_; c = c_; }
    __host__ __device__ bool next(int i, Unit& u) const {
        const long L = (long)i * G + c; if (L >= nwg) return false;
        int wgid = (int)L; { const int q = nwg / NXCD, r = nwg % NXCD, xcd = wgid % NXCD, off = wgid / NXCD; wgid = (xcd < r ? xcd * (q + 1) : r * (q + 1) + (xcd - r) * q) + off; }
        const int nig = WGM * nN, gid = wgid / nig, fm = gid * WGM, gsz = (nM - fm) < WGM ? (nM - fm) : WGM;
        u.pm = fm + ((wgid % nig) % gsz); u.pn = (wgid % nig) / gsz; return true;
    }
    __device__ __forceinline__ void a_ready(const Unit&) const {}
    __device__ __forceinline__ void done(const Unit&) const {}
};

__device__ __forceinline__ unsigned cvt_pk_bf16(float lo, float hi) { unsigned r; asm volatile("v_cvt_pk_bf16_f32 %0, %1, %2" : "=v"(r) : "v"(lo), "v"(hi)); return r; }
typedef float f32x2 __attribute__((ext_vector_type(2)));
template <class Epi, class Sched, bool ALIGN_EPI = false, bool SP2 = false>
__device__ __forceinline__ void gemm_phase(PG8_LAS unsigned char* lds, const Gemm g, const Sched& S, const Epi& E) {
    const int tid = threadIdx.x, wid = __builtin_amdgcn_readfirstlane(tid >> 6), lane = tid & 63, wr = wid >> 2, wc = wid & 3, fr = lane & 15, fq = lane >> 4;
    const int K = g.K, nt = K / BK;
    unsigned voffA[2], voffB[2];
#pragma unroll
    for (int i = 0; i < 2; ++i) { int R, C; stage_rc(tid * 16 + i * 8192, R, C); const int Rb = Epi::PERM ? ((R & ~31) + perm32(R & 31)) : R;
        voffA[i] = (unsigned)(R * K + C) * 2u; voffB[i] = (unsigned)(Rb * K + C) * 2u; }
    const size_t kstep = (size_t)(BK * 2);
    const size_t hstep = (size_t)HALF * K * 2;
    const size_t tstep = 2 * hstep;
    const unsigned ldsw = (unsigned)wid * 1024u;
    const int aoff = lds_byte(wr * 64 + fr, fq * 8), boff = lds_byte(wc * 32 + fr, fq * 8);
#define PG8_SA(b, h) (((b) * 2 + (h)) * HTB)
#define PG8_SB(b, h) ((4 + (b) * 2 + (h)) * HTB)
#define PG8_STAGE(bufoff, gbase, voff) do { _Pragma("unroll") for (int _i = 0; _i < 2; ++_i) \
        __builtin_amdgcn_global_load_lds((const unsigned*)((const char*)(gbase) + (voff)[_i]), (PG8_LAS unsigned*)(lds + (bufoff) + ldsw + _i * 8192), 16, 0, 0); } while (0)
#define PG8_LDA(dst, b, h) do { _Pragma("unroll") for (int m = 0; m < 4; ++m) _Pragma("unroll") for (int k = 0; k < 2; ++k) dst[m][k] = *(const PG8_LAS bf16x8*)(lds + PG8_SA(b, h) + aoff + m * 2048 + k * 1024); } while (0)
#define PG8_LDB(dst, b, h) do { _Pragma("unroll") for (int n = 0; n < 2; ++n) _Pragma("unroll") for (int k = 0; k < 2; ++k) dst[n][k] = *(const PG8_LAS bf16x8*)(lds + PG8_SB(b, h) + boff + n * 2048 + k * 1024); } while (0)
#define PG8_MMA(ai, bj, At, Bt) do { __builtin_amdgcn_s_setprio(1); _Pragma("unroll") for (int m = 0; m < 4; ++m) _Pragma("unroll") for (int n = 0; n < 2; ++n) _Pragma("unroll") for (int k = 0; k < 2; ++k) \
        acc[ai][bj][m][n] = __builtin_amdgcn_mfma_f32_16x16x32_bf16(Bt[n][k], At[m][k], acc[ai][bj][m][n], 0, 0, 0); __builtin_amdgcn_s_setprio(0); } while (0)
#define PG8_WAIT_V(n) asm volatile("s_waitcnt vmcnt(" #n ")" ::: "memory")
#define PG8_WAIT_L(n) asm volatile("s_waitcnt lgkmcnt(" #n ")" ::: "memory")
#define PG8_BAR __builtin_amdgcn_s_barrier()
#define PG8_SCHED __builtin_amdgcn_sched_barrier(0)
    Unit cur, nxt; int ui = 0;
    if (!S.next(0, cur)) return;
    f32x4 acc[2][2][4][2];
#pragma unroll
    for (int a = 0; a < 2; ++a)
#pragma unroll
        for (int b = 0; b < 2; ++b)
#pragma unroll
            for (int m = 0; m < 4; ++m)
#pragma unroll
                for (int n = 0; n < 2; ++n) acc[a][b][m][n] = (f32x4){0.f, 0.f, 0.f, 0.f};
    bf16x8 At[4][2], B0[2][2], B1[2][2];
    const char* cA = (const char*)g.A + (size_t)cur.pm * tstep; const char* cB = (const char*)g.Bt + (size_t)cur.pn * tstep;
    S.a_ready(cur);
    if constexpr (SP2) {
        PG8_STAGE(PG8_SB(0, 0), cB, voffB); PG8_STAGE(PG8_SB(0, 1), cB + hstep, voffB); PG8_STAGE(PG8_SA(0, 0), cA, voffA); PG8_STAGE(PG8_SA(0, 1), cA + hstep, voffA);
        if (wr == 1) PG8_BAR;
        PG8_WAIT_V(2); PG8_BAR;
        PG8_STAGE(PG8_SB(1, 0), cB + kstep, voffB); PG8_STAGE(PG8_SA(1, 0), cA + kstep, voffA); PG8_STAGE(PG8_SB(1, 1), cB + hstep + kstep, voffB);
        PG8_WAIT_V(6); PG8_BAR;
    } else {
        PG8_STAGE(PG8_SB(0, 0), cB, voffB); PG8_STAGE(PG8_SA(0, 0), cA, voffA); PG8_STAGE(PG8_SB(0, 1), cB + hstep, voffB); PG8_STAGE(PG8_SA(0, 1), cA + hstep, voffA);
        if (wr == 1) PG8_BAR;
        PG8_WAIT_V(4); PG8_BAR;
        PG8_STAGE(PG8_SB(1, 0), cB + kstep, voffB); PG8_STAGE(PG8_SA(1, 0), cA + kstep, voffA); PG8_STAGE(PG8_SB(1, 1), cB + hstep + kstep, voffB);
        PG8_WAIT_V(6); PG8_BAR;
    }
    for (;;) {
        const bool has_next = S.next(ui + 1, nxt);
        const char* nA = has_next ? (const char*)g.A + (size_t)nxt.pm * tstep : cA; const char* nB = has_next ? (const char*)g.Bt + (size_t)nxt.pn * tstep : cB;
        for (int t = 0; t < nt; t += 2) {
            const bool last = (t == nt - 2);
            const char* a1 = cA + (size_t)(t + 1) * kstep;
            const char* a2 = last ? nA : cA + (size_t)(t + 2) * kstep; const char* b2 = last ? nB : cB + (size_t)(t + 2) * kstep;
            const char* a3 = a2 + kstep; const char* b3 = b2 + kstep;
            if (last && has_next) S.a_ready(nxt);
            if constexpr (SP2) {
            PG8_LDB(B0, 0, 0); PG8_LDB(B1, 0, 1); PG8_SCHED; PG8_LDA(At, 0, 0); PG8_STAGE(PG8_SA(1, 1), a1 + hstep, voffA);
            PG8_WAIT_V(8); PG8_WAIT_L(0); PG8_BAR; PG8_MMA(0, 0, At, B0); PG8_MMA(0, 1, At, B1); PG8_BAR; PG8_SCHED;
            PG8_LDA(At, 0, 1); PG8_STAGE(PG8_SB(0, 0), b2, voffB); PG8_STAGE(PG8_SB(0, 1), b2 + hstep, voffB); PG8_STAGE(PG8_SA(0, 0), a2, voffA);
            PG8_WAIT_V(8); PG8_WAIT_L(0); PG8_BAR; PG8_MMA(1, 0, At, B0); PG8_MMA(1, 1, At, B1); PG8_BAR; PG8_SCHED;
            PG8_LDB(B0, 1, 0); PG8_LDB(B1, 1, 1); PG8_SCHED; PG8_LDA(At, 1, 0); PG8_STAGE(PG8_SA(0, 1), a2 + hstep, voffA);
            PG8_WAIT_V(8); PG8_WAIT_L(0); PG8_BAR; PG8_MMA(0, 0, At, B0); PG8_MMA(0, 1, At, B1); PG8_BAR; PG8_SCHED;
            PG8_LDA(At, 1, 1); PG8_STAGE(PG8_SB(1, 0), b3, voffB); PG8_STAGE(PG8_SB(1, 1), b3 + hstep, voffB); PG8_STAGE(PG8_SA(1, 0), a3, voffA);
            PG8_WAIT_V(8); PG8_WAIT_L(0); PG8_BAR; PG8_MMA(1, 0, At, B0); PG8_MMA(1, 1, At, B1); PG8_BAR; PG8_SCHED;
            } else {
            PG8_LDB(B0, 0, 0); PG8_SCHED; PG8_LDA(At, 0, 0); PG8_STAGE(PG8_SA(1, 1), a1 + hstep, voffA);
            PG8_WAIT_L(8); PG8_BAR; PG8_WAIT_L(0); PG8_MMA(0, 0, At, B0); PG8_BAR; PG8_SCHED;
            PG8_LDB(B1, 0, 1); PG8_STAGE(PG8_SB(0, 0), b2, voffB);
            PG8_BAR; PG8_WAIT_L(0); PG8_MMA(0, 1, At, B1); PG8_BAR;
            PG8_LDA(At, 0, 1); PG8_STAGE(PG8_SA(0, 0), a2, voffA);
            PG8_BAR; PG8_WAIT_L(0); PG8_MMA(1, 0, At, B0); PG8_BAR; PG8_SCHED;
            PG8_STAGE(PG8_SB(0, 1), b2 + hstep, voffB);
            PG8_WAIT_V(6); PG8_BAR; PG8_MMA(1, 1, At, B1); PG8_BAR;
            PG8_LDB(B0, 1, 0); PG8_SCHED; PG8_LDA(At, 1, 0); PG8_STAGE(PG8_SA(0, 1), a2 + hstep, voffA);
            PG8_WAIT_L(8); PG8_BAR; PG8_WAIT_L(0); PG8_MMA(0, 0, At, B0); PG8_BAR; PG8_SCHED;
            PG8_LDB(B1, 1, 1); PG8_STAGE(PG8_SB(1, 0), b3, voffB);
            PG8_BAR; PG8_WAIT_L(0); PG8_MMA(0, 1, At, B1); PG8_BAR;
            PG8_LDA(At, 1, 1); PG8_STAGE(PG8_SA(1, 0), a3, voffA);
            PG8_BAR; PG8_WAIT_L(0); PG8_MMA(1, 0, At, B0); PG8_BAR; PG8_SCHED;
            PG8_STAGE(PG8_SB(1, 1), b3 + hstep, voffB);
            PG8_WAIT_V(6); PG8_BAR; PG8_MMA(1, 1, At, B1); PG8_BAR;
            }
        }
        if constexpr (ALIGN_EPI) { if (wr == 0) PG8_BAR; }
        if constexpr (!Epi::AFTER_DRAIN) { E(acc, cur, wr, wc, fr, fq); S.done(cur); }
        if (!has_next) break;
#pragma unroll
        for (int a = 0; a < 2; ++a)
#pragma unroll
            for (int b = 0; b < 2; ++b)
#pragma unroll
                for (int m = 0; m < 4; ++m)
#pragma unroll
                    for (int n = 0; n < 2; ++n) acc[a][b][m][n] = (f32x4){0.f, 0.f, 0.f, 0.f};
        cur = nxt; cA = nA; cB = nB; ++ui;
        if constexpr (ALIGN_EPI) { if (wr == 1) PG8_BAR; }
    }
    PG8_WAIT_V(0);
    if constexpr (!ALIGN_EPI) { if (wr == 0) PG8_BAR; }
    PG8_BAR;
    if constexpr (Epi::AFTER_DRAIN) { E.fused(acc, cur, wr, wc, fr, fq, lds, wid, lane); S.done(cur); }
#undef PG8_SA
#undef PG8_SB
#undef PG8_STAGE
#undef PG8_LDA
#undef PG8_LDB
#undef PG8_MMA
#undef PG8_WAIT_V
#undef PG8_WAIT_L
#undef PG8_BAR
#undef PG8_SCHED
}
}
#ifndef PG8_SP2
#define PG8_SP2 true
#endif
#ifndef PG8_ALIGN
#define PG8_ALIGN true
#endif

constexpr int NWAVES = 8;
#ifndef MK_N_LAUNCHES
#define MK_N_LAUNCHES 1
#endif
constexpr int N_PHASES = 8;

constexpr int NB = 2, SEQ = 8192, D = 1024, M = NB * SEQ;
constexpr int NZ = 3840;
constexpr float EPS = 1e-6f;

constexpr size_t MiB = 1u << 20;
constexpr size_t WS_CTL = 0, CTL_ZERO_BYTES = 65536;
constexpr size_t WS_WIN = 1 * MiB;
constexpr size_t WS_WPA = 9 * MiB;
constexpr size_t WS_WPB = 10 * MiB;
constexpr size_t WS_WOUT = 11 * MiB;
constexpr size_t WS_WQ = 13 * MiB;
constexpr size_t WS_K1 = 17 * MiB;
constexpr size_t WS_K2 = 17 * MiB + 32768;
constexpr size_t WS_WS = 17 * MiB + 65536;
constexpr size_t WS_U = 18 * MiB;
constexpr size_t WS_V = 50 * MiB;
constexpr size_t WS_R1 = 82 * MiB;
constexpr size_t WS_Q = 114 * MiB;
constexpr size_t WS_KV = 130 * MiB;
constexpr size_t WS_GU = 138 * MiB;
constexpr size_t WS_GV = 154 * MiB;
constexpr size_t WS_GA = 170 * MiB;
constexpr size_t WS_GB = 202 * MiB;
constexpr size_t WS_MERGED = 114 * MiB;
constexpr size_t WS_QP = 170 * MiB;
constexpr size_t WS_END = 234 * MiB;
constexpr int CW_BAR = 0;

constexpr int RING_BYTES = 131072;
constexpr int MISC_OFF = 143360;
constexpr int LDS_BYTES = 147456;

#define GAS __attribute__((address_space(1)))
#define LAS __attribute__((address_space(3)))
typedef unsigned short bf16;
typedef unsigned v4u __attribute__((ext_vector_type(4)));
typedef unsigned v2u __attribute__((ext_vector_type(2)));
typedef float f32x4 __attribute__((ext_vector_type(4)));
typedef GAS unsigned gu32;
typedef __bf16 bf16x2_t __attribute__((ext_vector_type(2)));
#define RLX_AGENT __ATOMIC_RELAXED, __HIP_MEMORY_SCOPE_AGENT
#define LDS_WAIT() asm volatile("s_waitcnt lgkmcnt(0)" ::: "memory")
#define VM_WAIT() asm volatile("s_waitcnt vmcnt(0)" ::: "memory")
__device__ __forceinline__ unsigned f2bf(float f) { unsigned u = __builtin_bit_cast(unsigned, f); return (u + 0x7fffu + ((u >> 16) & 1u)) >> 16; }
__device__ __forceinline__ unsigned pk2(float lo, float hi) { return f2bf(lo) | (f2bf(hi) << 16); }
__device__ __forceinline__ float bflo(unsigned w) { return __builtin_bit_cast(float, w << 16); }
__device__ __forceinline__ float bfhi(unsigned w) { return __builtin_bit_cast(float, w & 0xffff0000u); }
__device__ __forceinline__ float bf2f(bf16 h) { return __builtin_bit_cast(float, (unsigned)h << 16); }
__device__ __forceinline__ float dot2bf(unsigned a, unsigned b, float c) { return __builtin_amdgcn_fdot2_f32_bf16(__builtin_bit_cast(bf16x2_t, a), __builtin_bit_cast(bf16x2_t, b), c, false); }
__device__ __forceinline__ float gelu_tanh(float v) {
    const float t2 = v * (-2.302208198f + (-0.1029432397f) * v * v);
    return v * __builtin_amdgcn_rcpf(1.0f + __builtin_amdgcn_exp2f(t2));
}
__device__ __forceinline__ float sigmoid_f(float v) { return __builtin_amdgcn_rcpf(1.0f + __builtin_amdgcn_exp2f(-1.4426950409f * v)); }
__device__ __forceinline__ float wave_sum(float v) {
#pragma unroll
    for (int o = 1; o < 64; o <<= 1) v += __shfl_xor(v, o);
    return v;
}
__device__ const unsigned char T5B[128] = {0, 1, 2, 3, 4, 5, 6, 7, 8, 9, 10, 11, 12, 13, 14, 15, 16, 16, 16, 17, 17, 18, 18, 18, 19, 19, 19, 20, 20, 20, 20, 21, 21, 21, 21, 22, 22, 22, 22, 22, 23, 23, 23, 23, 23, 23, 24, 24, 24, 24, 24, 24, 25, 25, 25, 25, 25, 25, 25, 26, 26, 26, 26, 26, 26, 26, 26, 27, 27, 27, 27, 27, 27, 27, 27, 27, 27, 28, 28, 28, 28, 28, 28, 28, 28, 28, 28, 29, 29, 29, 29, 29, 29, 29, 29, 29, 29, 29, 29, 30, 30, 30, 30, 30, 30, 30, 30, 30, 30, 30, 30, 30, 30, 31, 31, 31, 31, 31, 31, 31, 31, 31, 31, 31, 31, 31, 31, 31};
#define XB_TMO      128
#define XB_XCNT(j)  (256  + 64 * (j))
#define XB_XSUB(j)  (1280 + 64 * (j))
#define XB_XGEN(j)  (2304 + 64 * (j))
#define XB_TOP      3328
#define XB_TOPGEN   3392
#define XCD_BAR_WORDS 3456
#define XB_SPIN_CAP (1u << 18)

__device__ __forceinline__ unsigned xb_ld(unsigned* p)              { return __hip_atomic_load(p, __ATOMIC_RELAXED, __HIP_MEMORY_SCOPE_AGENT); }
__device__ __forceinline__ unsigned xb_add(unsigned* p, unsigned v) { return __hip_atomic_fetch_add(p, v, __ATOMIC_RELAXED, __HIP_MEMORY_SCOPE_AGENT); }
__device__ __forceinline__ unsigned xb_xcc_id() { return (unsigned)__builtin_amdgcn_s_getreg((3 << 11) | 20) & 0xFu; }
#define XB_SPIN(cond, bar) do { unsigned _sp = 0; while (cond) { __builtin_amdgcn_s_sleep(1); \
    if ((++_sp & 255u) == 0u) { if (xb_ld(&(bar)[XB_TMO])) break; if (_sp > XB_SPIN_CAP) { atomicAdd(&(bar)[XB_TMO], 1u); break; } } } } while (0)

struct XcdBarrier {
    unsigned* bar; unsigned x;
    volatile LAS unsigned* st;
};

__device__ __forceinline__ XcdBarrier xcd_barrier_post(unsigned* bar, volatile LAS unsigned* st) {
    XcdBarrier b; b.bar = bar; b.x = xb_xcc_id(); b.st = st;
    if (threadIdx.x == 0) (void)xb_add(&bar[XB_XCNT(b.x)], 1u);
    return b;
}
__device__ __forceinline__ void xcd_barrier_complete(unsigned* bar, unsigned x, unsigned& nloc, unsigned& nx) {
    const unsigned G = gridDim.x * gridDim.y * gridDim.z;
    unsigned sum, cnt, mine, sp = 0u;
    for (;;) {
        sum = 0u; cnt = 0u; mine = 0u;
#pragma unroll
        for (unsigned j = 0; j < 16; ++j) { const unsigned c = xb_ld(&bar[XB_XCNT(j)]); sum += c; cnt += (c > 0u) ? 1u : 0u; mine = (j == x) ? c : mine; }
        if (sum == G) break;
        __builtin_amdgcn_s_sleep(1);
        if ((++sp & 255u) == 0u) { if (xb_ld(&bar[XB_TMO])) break; if (sp > XB_SPIN_CAP) { atomicAdd(&bar[XB_TMO], 1u); break; } }
    }
    nloc = mine > 0u ? mine : 1u; nx = cnt > 0u ? cnt : 1u;
}

__device__ __forceinline__ void xcd_barrier(const XcdBarrier& b) {
    asm volatile("s_waitcnt vmcnt(0)" ::: "memory");
    __syncthreads();
    if (threadIdx.x == 0) {
        unsigned* bar = b.bar;
        __builtin_amdgcn_s_waitcnt(0);
        unsigned nloc = b.st[0], nx = b.st[1];
        if (nloc == 0u) { xcd_barrier_complete(bar, b.x, nloc, nx); b.st[0] = nloc; b.st[1] = nx; }
        const unsigned old = xb_add(&bar[XB_XSUB(b.x)], 1u);
        const unsigned gen = old / nloc;
        if (old + 1u == (gen + 1u) * nloc) {
            __builtin_amdgcn_fence(__ATOMIC_RELEASE, "agent");
            asm volatile("s_waitcnt vmcnt(0)" ::: "memory");
            const unsigned og = xb_add(&bar[XB_TOP], 1u);
            const unsigned tg = og / nx;
            if (og + 1u == (tg + 1u) * nx) xb_add(&bar[XB_TOPGEN], 1u);
            else XB_SPIN(xb_ld(&bar[XB_TOPGEN]) == tg, bar);
            __builtin_amdgcn_fence(__ATOMIC_ACQUIRE, "agent");
            xb_add(&bar[XB_XGEN(b.x)], 1u);
            asm volatile("s_waitcnt vmcnt(0)" ::: "memory");
        } else {
            XB_SPIN(xb_ld(&bar[XB_XGEN(b.x)]) == gen, bar);
            __builtin_amdgcn_fence(__ATOMIC_ACQUIRE, "agent");
            asm volatile("s_waitcnt vmcnt(0)" ::: "memory");
        }
    }
    __syncthreads();
}
namespace pg8 {
struct EpiZ {
    static constexpr bool PERM = true, AFTER_DRAIN = false;
    bf16_t *Q, *KV, *GU, *GV, *GA, *GB;
    __device__ __forceinline__ void operator()(const f32x4 (&acc)[2][2][4][2], const Unit& u, int wr, int wc, int fr, int fq) const {
        const int pn = u.pn; bf16_t* base; int ldc, colt, act;
        if (pn < 2)       { base = Q;  ldc = 512;  colt = pn * 256;        act = 0; }
        else if (pn == 2) { base = KV; ldc = 256;  colt = 0;               act = 0; }
        else if (pn < 5)  { base = GU; ldc = 512;  colt = (pn - 3) * 256;  act = 1; }
        else if (pn < 7)  { base = GV; ldc = 512;  colt = (pn - 5) * 256;  act = 1; }
        else if (pn < 11) { base = GA; ldc = 1024; colt = (pn - 7) * 256;  act = 2; }
        else              { base = GB; ldc = 1024; colt = (pn - 11) * 256; act = 2; }
        const int row0 = u.pm * BM + wr * 64 + fr, col0 = colt + wc * 32 + 8 * fq;
#pragma unroll
        for (int ai = 0; ai < 2; ++ai)
#pragma unroll
            for (int m = 0; m < 4; ++m) { bf16_t* rowp = base + (size_t)(row0 + ai * HALF + m * 16) * ldc + col0;
#pragma unroll
                for (int bj = 0; bj < 2; ++bj) { f32x4 v0 = acc[ai][bj][m][0], v1 = acc[ai][bj][m][1];
                    if (act == 1) {
#pragma unroll
                        for (int e = 0; e < 4; ++e) { v0[e] = gelu_tanh(v0[e]); v1[e] = gelu_tanh(v1[e]); }
                    } else if (act == 2) {
#pragma unroll
                        for (int e = 0; e < 4; ++e) { v0[e] = sigmoid_f(v0[e]); v1[e] = sigmoid_f(v1[e]); }
                    }
                    u32x4 w; w.x = cvt_pk_bf16(v0[0], v0[1]); w.y = cvt_pk_bf16(v0[2], v0[3]); w.z = cvt_pk_bf16(v1[0], v1[1]); w.w = cvt_pk_bf16(v1[2], v1[3]);
                    *(u32x4*)(rowp + bj * HALF) = w; } }
    }
};
struct EpiGateTmp {
    static constexpr bool PERM = true, AFTER_DRAIN = false;
    const bf16_t* gate; float* tmp;
    __device__ __forceinline__ void operator()(const f32x4 (&acc)[2][2][4][2], const Unit& u, int wr, int wc, int fr, int fq) const {
        const int row0 = u.pm * BM + wr * 64 + fr, col0 = u.pn * BM + wc * 32 + 8 * fq;
#pragma unroll
        for (int ai = 0; ai < 2; ++ai)
#pragma unroll
            for (int m = 0; m < 4; ++m) { const size_t ro = (size_t)(row0 + ai * HALF + m * 16) * 1024 + col0;
#pragma unroll
                for (int bj = 0; bj < 2; ++bj) { const u32x4 g = *(const u32x4*)(gate + ro + bj * HALF); f32x4 v0 = acc[ai][bj][m][0], v1 = acc[ai][bj][m][1];
                    v0[0] *= bflo(g.x); v0[1] *= bfhi(g.x); v0[2] *= bflo(g.y); v0[3] *= bfhi(g.y); v1[0] *= bflo(g.z); v1[1] *= bfhi(g.z); v1[2] *= bflo(g.w); v1[3] *= bfhi(g.w);
                    *(f32x4*)(tmp + ro + bj * HALF) = v0; *(f32x4*)(tmp + ro + bj * HALF + 4) = v1; } }
    }
};
struct EpiMerge {
    static constexpr bool PERM = true, AFTER_DRAIN = false;
    const bf16_t* gate; const float* tmp; bf16_t* out;
    __device__ __forceinline__ void operator()(const f32x4 (&acc)[2][2][4][2], const Unit& u, int wr, int wc, int fr, int fq) const {
        const int row0 = u.pm * BM + wr * 64 + fr, col0 = u.pn * BM + wc * 32 + 8 * fq;
#pragma unroll
        for (int ai = 0; ai < 2; ++ai)
#pragma unroll
            for (int m = 0; m < 4; ++m) { const size_t ro = (size_t)(row0 + ai * HALF + m * 16) * 1024 + col0;
#pragma unroll
                for (int bj = 0; bj < 2; ++bj) { const u32x4 g = *(const u32x4*)(gate + ro + bj * HALF); f32x4 v0 = acc[ai][bj][m][0], v1 = acc[ai][bj][m][1];
                    const f32x4 t0 = *(const f32x4*)(tmp + ro + bj * HALF), t1 = *(const f32x4*)(tmp + ro + bj * HALF + 4);
                    v0[0] = t0[0] + v0[0] * bflo(g.x); v0[1] = t0[1] + v0[1] * bfhi(g.x); v0[2] = t0[2] + v0[2] * bflo(g.y); v0[3] = t0[3] + v0[3] * bfhi(g.y);
                    v1[0] = t1[0] + v1[0] * bflo(g.z); v1[1] = t1[1] + v1[1] * bfhi(g.z); v1[2] = t1[2] + v1[2] * bflo(g.w); v1[3] = t1[3] + v1[3] * bfhi(g.w);
                    u32x4 w; w.x = cvt_pk_bf16(v0[0], v0[1]); w.y = cvt_pk_bf16(v0[2], v0[3]); w.z = cvt_pk_bf16(v1[0], v1[1]); w.w = cvt_pk_bf16(v1[2], v1[3]);
                    *(u32x4*)(out + ro + bj * HALF) = w; } }
    }
};
struct EpiRes {
    static constexpr bool PERM = false, AFTER_DRAIN = false;
    const float* base; float* C;
    __device__ __forceinline__ void operator()(const f32x4 (&acc)[2][2][4][2], const Unit& u, int wr, int wc, int fr, int fq) const {
        const int row0 = u.pm * BM + wr * 64 + fr, col0 = u.pn * BM + wc * 32 + 4 * fq;
#pragma unroll
        for (int ai = 0; ai < 2; ++ai)
#pragma unroll
            for (int m = 0; m < 4; ++m) { const size_t ro = (size_t)(row0 + ai * HALF + m * 16) * 1024 + col0;
#pragma unroll
                for (int bj = 0; bj < 2; ++bj)
#pragma unroll
                    for (int n = 0; n < 2; ++n) *(f32x4*)(C + ro + bj * HALF + n * 16) = *(const f32x4*)(base + ro + bj * HALF + n * 16) + acc[ai][bj][m][n]; }
    }
};
struct EpiPlain {
    static constexpr bool PERM = true, AFTER_DRAIN = false;
    bf16_t* O; int ldc;
    __device__ __forceinline__ void operator()(const f32x4 (&acc)[2][2][4][2], const Unit& u, int wr, int wc, int fr, int fq) const {
        const int row0 = u.pm * BM + wr * 64 + fr, col0 = u.pn * BM + wc * 32 + 8 * fq;
#pragma unroll
        for (int ai = 0; ai < 2; ++ai)
#pragma unroll
            for (int m = 0; m < 4; ++m) { bf16_t* rowp = O + (size_t)(row0 + ai * HALF + m * 16) * ldc + col0;
#pragma unroll
                for (int bj = 0; bj < 2; ++bj) { const f32x4 v0 = acc[ai][bj][m][0], v1 = acc[ai][bj][m][1];
                    u32x4 w; w.x = cvt_pk_bf16(v0[0], v0[1]); w.y = cvt_pk_bf16(v0[2], v0[3]); w.z = cvt_pk_bf16(v1[0], v1[1]); w.w = cvt_pk_bf16(v1[2], v1[3]);
                    *(u32x4*)(rowp + bj * HALF) = w; } }
    }
};
}

__device__ __forceinline__ void p0_transpose_item(const float* W, int K, int N, bf16* WT, LAS float* scr, int item, int lane) {
    const int nblk = N / 32, kb = item / nblk, nb = item % nblk, k0 = 64 * kb, n0 = 32 * nb;
#pragma unroll 8
    for (int i = 0; i < 32; ++i) { const int kk = 2 * i + (lane >> 5); scr[kk * 33 + (lane & 31)] = W[(size_t)(k0 + kk) * N + n0 + (lane & 31)]; }
    LDS_WAIT(); asm volatile("" ::: "memory");
    const int c = lane & 7;
#pragma unroll
    for (int j = 0; j < 4; ++j) { const int n = (lane >> 3) + 8 * j; const LAS float* s = scr + (8 * c) * 33 + n;
        v4u o; o.x = pk2(s[0 * 33], s[1 * 33]); o.y = pk2(s[2 * 33], s[3 * 33]); o.z = pk2(s[4 * 33], s[5 * 33]); o.w = pk2(s[6 * 33], s[7 * 33]);
        *(v4u*)(WT + (size_t)(n0 + n) * K + k0 + 8 * c) = o; }
    LDS_WAIT(); asm volatile("" ::: "memory");
}
__device__ __forceinline__ void cvt_flat(const float* src, bf16* dst, size_t n, int gw, int NGW, int lane) {
    for (size_t i = (size_t)gw * 512 + lane * 8; i < n; i += (size_t)NGW * 512) {
        const f32x4 a = *(const f32x4*)(src + i), b = *(const f32x4*)(src + i + 4);
        v4u o; o.x = pk2(a[0], a[1]); o.y = pk2(a[2], a[3]); o.z = pk2(b[0], b[1]); o.w = pk2(b[2], b[3]);
        *(v4u*)(dst + i) = o;
    }
}
__device__ __forceinline__ void rms_row_to_bf16(const float* xrow, const float* w, bf16* orow, int lane) {
    const f32x4* xr = (const f32x4*)xrow + lane; const f32x4* wr = (const f32x4*)w + lane;
    f32x4 v[4]; float s = 0.f;
#pragma unroll
    for (int j = 0; j < 4; ++j) { v[j] = xr[64 * j]; s += (v[j][0] * v[j][0] + v[j][1] * v[j][1]) + (v[j][2] * v[j][2] + v[j][3] * v[j][3]); }
    const float rstd = 1.0f / sqrtf(wave_sum(s) * (1.0f / 1024.0f) + EPS);
    unsigned long long* o8 = (unsigned long long*)orow + lane;
#pragma unroll
    for (int j = 0; j < 4; ++j) { const f32x4 ww = wr[64 * j];
        o8[64 * j] = (unsigned long long)pk2(v[j][0] * rstd * ww[0], v[j][1] * rstd * ww[1]) | ((unsigned long long)pk2(v[j][2] * rstd * ww[2], v[j][3] * rstd * ww[3]) << 32); }
}

struct Ptrs {
    const float *x, *mix_w, *w_in, *rel_bias, *sinks, *w_pa, *ln_w, *ln_b, *w_s, *b_s, *w_pb, *w_out, *ffn_w, *w_q, *keys1, *keys2, *pu, *pv, *fin_w;
    float* out;
    bf16 *WIN, *WPA, *WPB, *WOUT, *WQ, *K1, *K2, *WS, *U, *V, *XN, *AOUT, *BOUT, *HN2, *Q, *KV, *GU, *GV, *GA, *GB, *MERGED, *QP;
};

__device__ __forceinline__ void p0_prologue(LAS unsigned char* lds, const Ptrs& P, int vcu, int G, int lane, int wave) {
    LAS float* scr = (LAS float*)(lds + wave * 16384);
    const int gw = vcu * NWAVES + wave, NGW = G * NWAVES;
    constexpr int I_IN = (1024 / 64) * (3840 / 32), I_PA = (512 / 64) * (1024 / 32), I_OUT = (1024 / 64) * (1024 / 32), I_WQ = (1024 / 64) * (2048 / 32);
    constexpr int NITEMS = I_IN + 2 * I_PA + I_OUT + I_WQ;
    for (int it = gw; it < NITEMS; it += NGW) {
        int r = it;
        if (r < I_IN) { p0_transpose_item(P.w_in, 1024, 3840, P.WIN, scr, r, lane); continue; } r -= I_IN;
        if (r < I_PA) { p0_transpose_item(P.w_pa, 512, 1024, P.WPA, scr, r, lane); continue; } r -= I_PA;
        if (r < I_PA) { p0_transpose_item(P.w_pb, 512, 1024, P.WPB, scr, r, lane); continue; } r -= I_PA;
        if (r < I_OUT) { p0_transpose_item(P.w_out, 1024, 1024, P.WOUT, scr, r, lane); continue; } r -= I_OUT;
        p0_transpose_item(P.w_q, 1024, 2048, P.WQ, scr, r, lane);
    }
    cvt_flat(P.keys1, P.K1, 128 * 128, gw, NGW, lane);
    cvt_flat(P.keys2, P.K2, 128 * 128, gw, NGW, lane);
    cvt_flat(P.pu, P.U, (size_t)16384 * 1024, gw, NGW, lane);
    cvt_flat(P.pv, P.V, (size_t)16384 * 1024, gw, NGW, lane);
    for (size_t i = (size_t)gw * 512 + lane * 8; i < (size_t)8 * 128 * 128; i += (size_t)NGW * 512) {
        const int t = (int)((i >> 7) & 127), s0 = (int)(i & 127);
        const f32x4 a = *(const f32x4*)(P.w_s + i), b = *(const f32x4*)(P.w_s + i + 4);
        float e[8] = {a[0], a[1], a[2], a[3], b[0], b[1], b[2], b[3]};
#pragma unroll
        for (int j = 0; j < 8; ++j) e[j] = (s0 + j <= t) ? e[j] : 0.f;
        v4u o; o.x = pk2(e[0], e[1]); o.y = pk2(e[2], e[3]); o.z = pk2(e[4], e[5]); o.w = pk2(e[6], e[7]);
        *(v4u*)(P.WS + i) = o;
    }
    for (int m = gw; m < M; m += NGW) rms_row_to_bf16(P.x + (size_t)m * D, P.mix_w, P.XN + (size_t)m * D, lane);
}

__device__ __forceinline__ void p2_attn_naive(LAS unsigned char* lds, const Ptrs& P, int vcu, int G, int tid, int lane, int wave) {
    LAS float* biasl = (LAS float*)lds;
    for (int i = tid; i < 1024; i += 512) { const int d = i >> 3, h = i & 7; biasl[i] = P.rel_bias[(int)T5B[d] * 8 + h]; }
    __syncthreads();
    const int h = wave, kvh = h >> 2;
    const float sink = P.sinks[h];
    for (int unit = vcu; unit < M / 64; unit += G) {
        const int t = unit * 64 + lane, pos = t & (SEQ - 1);
        float q[64], o[64];
        { const v4u* qp = (const v4u*)(P.Q + (size_t)t * 512 + h * 64);
#pragma unroll
          for (int c = 0; c < 8; ++c) { const v4u w = qp[c]; q[8 * c + 0] = bflo(w.x) * 0.125f; q[8 * c + 1] = bfhi(w.x) * 0.125f; q[8 * c + 2] = bflo(w.y) * 0.125f; q[8 * c + 3] = bfhi(w.y) * 0.125f;
              q[8 * c + 4] = bflo(w.z) * 0.125f; q[8 * c + 5] = bfhi(w.z) * 0.125f; q[8 * c + 6] = bflo(w.w) * 0.125f; q[8 * c + 7] = bfhi(w.w) * 0.125f; } }
#pragma unroll
        for (int i = 0; i < 64; ++i) o[i] = 0.f;
        float m = sink, l = 1.f;
        for (int d = 0; d < 128; ++d) {
            const bool valid = (pos - d) >= 0;
            const int tj = valid ? (t - d) : t;
            const v4u* kp = (const v4u*)(P.KV + (size_t)tj * 256 + kvh * 64);
            float dot = 0.f;
#pragma unroll
            for (int c = 0; c < 8; ++c) { const v4u w = kp[c];
                dot += q[8 * c + 0] * bflo(w.x) + q[8 * c + 1] * bfhi(w.x) + q[8 * c + 2] * bflo(w.y) + q[8 * c + 3] * bfhi(w.y) + q[8 * c + 4] * bflo(w.z) + q[8 * c + 5] * bfhi(w.z) + q[8 * c + 6] * bflo(w.w) + q[8 * c + 7] * bfhi(w.w); }
            const float s = valid ? dot + biasl[d * 8 + h] : -1e30f;
            const float mn = fmaxf(m, s), alpha = __expf(m - mn), p = __expf(s - mn);
            l = l * alpha + p; m = mn;
            const v4u* vp = kp + 16;
#pragma unroll
            for (int c = 0; c < 8; ++c) { const v4u w = vp[c];
                o[8 * c + 0] = o[8 * c + 0] * alpha + p * bflo(w.x); o[8 * c + 1] = o[8 * c + 1] * alpha + p * bfhi(w.x); o[8 * c + 2] = o[8 * c + 2] * alpha + p * bflo(w.y); o[8 * c + 3] = o[8 * c + 3] * alpha + p * bfhi(w.y);
                o[8 * c + 4] = o[8 * c + 4] * alpha + p * bflo(w.z); o[8 * c + 5] = o[8 * c + 5] * alpha + p * bfhi(w.z); o[8 * c + 6] = o[8 * c + 6] * alpha + p * bflo(w.w); o[8 * c + 7] = o[8 * c + 7] * alpha + p * bfhi(w.w); }
        }
        const float inv = 1.0f / l;
        v4u* op = (v4u*)(P.AOUT + (size_t)t * 512 + h * 64);
#pragma unroll
        for (int c = 0; c < 8; ++c) { v4u w; w.x = pk2(o[8 * c + 0] * inv, o[8 * c + 1] * inv); w.y = pk2(o[8 * c + 2] * inv, o[8 * c + 3] * inv); w.z = pk2(o[8 * c + 4] * inv, o[8 * c + 5] * inv); w.w = pk2(o[8 * c + 6] * inv, o[8 * c + 7] * inv); op[c] = w; }
    }
    __syncthreads();
}

__device__ __forceinline__ void p2_gmlp_naive(LAS unsigned char* lds, const Ptrs& P, int vcu, int G, int tid, int lane, int wave) {
    LAS bf16* vnl = (LAS bf16*)(lds + 8192);
    for (int unit = vcu; unit < 256; unit += G) {
        const int c = unit >> 1, hh = unit & 1;
        for (int i = 0; i < 16; ++i) {
            const int tt = wave * 16 + i; const size_t row = (size_t)c * 128 + tt;
            const v4u w = *((const v4u*)(P.GV + row * 512) + lane);
            float x[8] = {bflo(w.x), bfhi(w.x), bflo(w.y), bfhi(w.y), bflo(w.z), bfhi(w.z), bflo(w.w), bfhi(w.w)};
            float s = 0.f;
#pragma unroll
            for (int j = 0; j < 8; ++j) s += x[j];
            const float mean = wave_sum(s) * (1.0f / 512.0f);
            float ss = 0.f;
#pragma unroll
            for (int j = 0; j < 8; ++j) { x[j] -= mean; ss += x[j] * x[j]; }
            const float rstd = 1.0f / sqrtf(wave_sum(ss) * (1.0f / 512.0f) + EPS);
            if ((lane >> 5) == hh) {
                const f32x4 w0 = *(const f32x4*)(P.ln_w + lane * 8), w1 = *(const f32x4*)(P.ln_w + lane * 8 + 4), b0 = *(const f32x4*)(P.ln_b + lane * 8), b1 = *(const f32x4*)(P.ln_b + lane * 8 + 4);
                v4u o; o.x = pk2(x[0] * rstd * w0[0] + b0[0], x[1] * rstd * w0[1] + b0[1]); o.y = pk2(x[2] * rstd * w0[2] + b0[2], x[3] * rstd * w0[3] + b0[3]);
                o.z = pk2(x[4] * rstd * w1[0] + b1[0], x[5] * rstd * w1[1] + b1[1]); o.w = pk2(x[6] * rstd * w1[2] + b1[2], x[7] * rstd * w1[3] + b1[3]);
                *(LAS v4u*)(vnl + tt * 256 + (lane & 31) * 8) = o;
            }
        }
        __syncthreads();
        const int ch = tid & 255, th = tid >> 8, g = hh * 4 + (ch >> 6);
        for (int t = th * 64; t < th * 64 + 64; ++t) {
            const v4u* wrow = (const v4u*)(P.WS + ((size_t)g * 128 + t) * 128);
            float acc = 0.f;
            for (int s8 = 0; s8 <= (t >> 3); ++s8) {
                const v4u w = wrow[s8];
                const LAS bf16* vp = vnl + (s8 * 8) * 256 + ch;
                acc += bflo(w.x) * bf2f(vp[0]) + bfhi(w.x) * bf2f(vp[256]) + bflo(w.y) * bf2f(vp[512]) + bfhi(w.y) * bf2f(vp[768])
                     + bflo(w.z) * bf2f(vp[1024]) + bfhi(w.z) * bf2f(vp[1280]) + bflo(w.w) * bf2f(vp[1536]) + bfhi(w.w) * bf2f(vp[1792]);
            }
            const size_t row = (size_t)c * 128 + t;
            const float uval = bf2f(P.GU[row * 512 + hh * 256 + ch]);
            P.BOUT[row * 512 + hh * 256 + ch] = (bf16)f2bf(uval * (acc + P.b_s[g * 128 + t]));
        }
        __syncthreads();
    }
}

__device__ __forceinline__ void topk_half(const bf16* q, const LAS bf16* kl, float (&v)[16]) {
    v4u qv[16];
#pragma unroll
    for (int c = 0; c < 16; ++c) qv[c] = ((const v4u*)q)[c];
#pragma unroll
    for (int i = 0; i < 16; ++i) v[i] = -INFINITY;
    for (int n = 0; n < 128; ++n) {
        const LAS v4u* kr = (const LAS v4u*)(kl + n * 128);
        float a0 = 0.f, a1 = 0.f, a2 = 0.f, a3 = 0.f;
#pragma unroll
        for (int c = 0; c < 16; ++c) { const v4u kk = kr[c]; a0 = dot2bf(qv[c].x, kk.x, a0); a1 = dot2bf(qv[c].y, kk.y, a1); a2 = dot2bf(qv[c].z, kk.z, a2); a3 = dot2bf(qv[c].w, kk.w, a3); }
        const float acc = (a0 + a1) + (a2 + a3);
        float x = __builtin_bit_cast(float, (__builtin_bit_cast(unsigned, acc) & ~0x7Fu) | (unsigned)n);
#pragma unroll
        for (int i = 0; i < 16; ++i) { const float hi = fmaxf(v[i], x); x = fminf(v[i], x); v[i] = hi; }
    }
}

__device__ __forceinline__ void p7_peer(LAS unsigned char* lds, const Ptrs& P, int vcu, int G, int tid, int lane, int wave) {
    LAS bf16* k1l = (LAS bf16*)lds;
    LAS bf16* k2l = (LAS bf16*)(lds + 32768);
    LAS int* idxl = (LAS int*)(lds + 65536);
    LAS float* gatel = (LAS float*)(lds + 98304);
    LAS float* al = (LAS float*)(lds + 131072);
    for (int i = tid; i < 2048; i += 512) { ((LAS v4u*)k1l)[i] = ((const v4u*)P.K1)[i]; ((LAS v4u*)k2l)[i] = ((const v4u*)P.K2)[i]; }
    __syncthreads();
    for (int unit = vcu; unit < M / 64; unit += G) {
        {
            const int tl = tid >> 3, h = tid & 7;
            const bf16* qrow = P.QP + (size_t)(unit * 64 + tl) * 2048 + h * 256;
            float v1[16], v2[16];
            topk_half(qrow, k1l, v1);
            topk_half(qrow + 128, k2l, v2);
            float tv[16]; int tp[16];
#pragma unroll
            for (int k = 0; k < 16; ++k) { tv[k] = -INFINITY; tp[k] = 0; }
#pragma unroll
            for (int i = 0; i < 16; ++i)
#pragma unroll
                for (int j = 0; j < 16; ++j)
                    if ((i + 1) * (j + 1) <= 16) {
                        const unsigned b1 = __builtin_bit_cast(unsigned, v1[i]), b2 = __builtin_bit_cast(unsigned, v2[j]);
                        float x = __builtin_bit_cast(float, b1 & ~0x7Fu) + __builtin_bit_cast(float, b2 & ~0x7Fu);
                        int px = (int)((b1 & 0x7Fu) * 128u + (b2 & 0x7Fu));
#pragma unroll
                        for (int k = 0; k < 16; ++k) { const bool c = x > tv[k]; const float nv = c ? x : tv[k], nx = c ? tv[k] : x; const int np = c ? px : tp[k], npx = c ? tp[k] : px; tv[k] = nv; x = nx; tp[k] = np; px = npx; }
                    }
            float e[16], es = 0.f;
#pragma unroll
            for (int k = 0; k < 16; ++k) { e[k] = __expf(tv[k] - tv[0]); es += e[k]; }
            const float inv = 1.0f / es;
            LAS v4u* ip = (LAS v4u*)(idxl + tl * 128 + h * 16); LAS f32x4* gp = (LAS f32x4*)(gatel + tl * 128 + h * 16);
#pragma unroll
            for (int k = 0; k < 4; ++k) { v4u iv; iv.x = (unsigned)tp[4 * k]; iv.y = (unsigned)tp[4 * k + 1]; iv.z = (unsigned)tp[4 * k + 2]; iv.w = (unsigned)tp[4 * k + 3]; ip[k] = iv;
                f32x4 gv; gv[0] = e[4 * k] * inv; gv[1] = e[4 * k + 1] * inv; gv[2] = e[4 * k + 2] * inv; gv[3] = e[4 * k + 3] * inv; gp[k] = gv; }
        }
        __syncthreads();
        const int sub = lane & 15, grp = lane >> 4;
        for (int i = 0; i < 8; ++i) {
            const int tl = wave * 8 + i; const size_t t = (size_t)unit * 64 + tl;
            v4u hnr[8];
#pragma unroll
            for (int j = 0; j < 8; ++j) hnr[j] = *((const v4u*)(P.HN2 + t * 1024) + j * 16 + sub);
            for (int q = 0; q < 32; ++q) {
                const int row = idxl[tl * 128 + 4 * q + grp];
                const v4u* up = (const v4u*)(P.U + (size_t)row * 1024) + sub;
                float a0 = 0.f, a1 = 0.f, a2 = 0.f, a3 = 0.f;
#pragma unroll
                for (int j = 0; j < 8; ++j) { const v4u w = up[j * 16]; a0 = dot2bf(w.x, hnr[j].x, a0); a1 = dot2bf(w.y, hnr[j].y, a1); a2 = dot2bf(w.z, hnr[j].z, a2); a3 = dot2bf(w.w, hnr[j].w, a3); }
                float acc = (a0 + a1) + (a2 + a3);
                acc += __shfl_xor(acc, 8); acc += __shfl_xor(acc, 4); acc += __shfl_xor(acc, 2); acc += __shfl_xor(acc, 1);
                if (sub == 0) al[wave * 128 + 4 * q + grp] = acc;
            }
            LDS_WAIT();
            const float av0 = al[wave * 128 + lane], av1 = al[wave * 128 + 64 + lane];
            const float act0 = gelu_tanh(av0) * gatel[tl * 128 + lane], act1 = gelu_tanh(av1) * gatel[tl * 128 + 64 + lane];
            const int ix0 = idxl[tl * 128 + lane], ix1 = idxl[tl * 128 + 64 + lane];
            LDS_WAIT();
            float y[16];
#pragma unroll
            for (int k = 0; k < 16; ++k) y[k] = 0.f;
#pragma unroll 4
            for (int e = 0; e < 64; ++e) {
                const int row = __builtin_amdgcn_readlane(ix0, e); const float a = __builtin_bit_cast(float, __builtin_amdgcn_readlane(__builtin_bit_cast(int, act0), e));
                const v4u* vp = (const v4u*)(P.V + (size_t)row * 1024) + lane; const v4u w0 = vp[0], w1 = vp[64];
                y[0] += a * bflo(w0.x); y[1] += a * bfhi(w0.x); y[2] += a * bflo(w0.y); y[3] += a * bfhi(w0.y); y[4] += a * bflo(w0.z); y[5] += a * bfhi(w0.z); y[6] += a * bflo(w0.w); y[7] += a * bfhi(w0.w);
                y[8] += a * bflo(w1.x); y[9] += a * bfhi(w1.x); y[10] += a * bflo(w1.y); y[11] += a * bfhi(w1.y); y[12] += a * bflo(w1.z); y[13] += a * bfhi(w1.z); y[14] += a * bflo(w1.w); y[15] += a * bfhi(w1.w);
            }
#pragma unroll 4
            for (int e = 0; e < 64; ++e) {
                const int row = __builtin_amdgcn_readlane(ix1, e); const float a = __builtin_bit_cast(float, __builtin_amdgcn_readlane(__builtin_bit_cast(int, act1), e));
                const v4u* vp = (const v4u*)(P.V + (size_t)row * 1024) + lane; const v4u w0 = vp[0], w1 = vp[64];
                y[0] += a * bflo(w0.x); y[1] += a * bfhi(w0.x); y[2] += a * bflo(w0.y); y[3] += a * bfhi(w0.y); y[4] += a * bflo(w0.z); y[5] += a * bfhi(w0.z); y[6] += a * bflo(w0.w); y[7] += a * bfhi(w0.w);
                y[8] += a * bflo(w1.x); y[9] += a * bfhi(w1.x); y[10] += a * bflo(w1.y); y[11] += a * bfhi(w1.y); y[12] += a * bflo(w1.z); y[13] += a * bfhi(w1.z); y[14] += a * bflo(w1.w); y[15] += a * bfhi(w1.w);
            }
            float* xr = P.out + t * 1024;
            f32x4 x0 = *(const f32x4*)(xr + lane * 8), x1 = *(const f32x4*)(xr + lane * 8 + 4), x2 = *(const f32x4*)(xr + 512 + lane * 8), x3 = *(const f32x4*)(xr + 512 + lane * 8 + 4);
            x0[0] += y[0]; x0[1] += y[1]; x0[2] += y[2]; x0[3] += y[3]; x1[0] += y[4]; x1[1] += y[5]; x1[2] += y[6]; x1[3] += y[7];
            x2[0] += y[8]; x2[1] += y[9]; x2[2] += y[10]; x2[3] += y[11]; x3[0] += y[12]; x3[1] += y[13]; x3[2] += y[14]; x3[3] += y[15];
            float ss = 0.f;
#pragma unroll
            for (int k = 0; k < 4; ++k) ss += x0[k] * x0[k] + x1[k] * x1[k] + x2[k] * x2[k] + x3[k] * x3[k];
            const float rstd = 1.0f / sqrtf(wave_sum(ss) * (1.0f / 1024.0f) + EPS);
            const f32x4 w0 = *(const f32x4*)(P.fin_w + lane * 8), w1 = *(const f32x4*)(P.fin_w + lane * 8 + 4), w2 = *(const f32x4*)(P.fin_w + 512 + lane * 8), w3 = *(const f32x4*)(P.fin_w + 512 + lane * 8 + 4);
            *(f32x4*)(xr + lane * 8) = x0 * rstd * w0; *(f32x4*)(xr + lane * 8 + 4) = x1 * rstd * w1; *(f32x4*)(xr + 512 + lane * 8) = x2 * rstd * w2; *(f32x4*)(xr + 512 + lane * 8 + 4) = x3 * rstd * w3;
        }
        __syncthreads();
    }
}

struct Args { const float* in[19]; float* out; unsigned char* ws; int ph_lo, ph_hi; };
__global__ void __launch_bounds__(NWAVES * 64, 2) mega_fwd(Args args) {
    extern __shared__ __attribute__((aligned(16))) unsigned char lds_raw[];
    LAS unsigned char* lds = (LAS unsigned char*)lds_raw;
    const int tid = threadIdx.x, lane = tid & 63, wave = __builtin_amdgcn_readfirstlane(tid >> 6);
    const int G = gridDim.x; const int bx = blockIdx.x; const int vcu = (G % 8 == 0) ? (bx % 8) * (G / 8) + bx / 8 : bx;
    unsigned char* ws = args.ws;
    Ptrs P;
    P.x = args.in[0]; P.mix_w = args.in[1]; P.w_in = args.in[2]; P.rel_bias = args.in[3]; P.sinks = args.in[4]; P.w_pa = args.in[5]; P.ln_w = args.in[6]; P.ln_b = args.in[7];
    P.w_s = args.in[8]; P.b_s = args.in[9]; P.w_pb = args.in[10]; P.w_out = args.in[11]; P.ffn_w = args.in[12]; P.w_q = args.in[13]; P.keys1 = args.in[14]; P.keys2 = args.in[15];
    P.pu = args.in[16]; P.pv = args.in[17]; P.fin_w = args.in[18]; P.out = args.out;
    P.WIN = (bf16*)(ws + WS_WIN); P.WPA = (bf16*)(ws + WS_WPA); P.WPB = (bf16*)(ws + WS_WPB); P.WOUT = (bf16*)(ws + WS_WOUT); P.WQ = (bf16*)(ws + WS_WQ);
    P.K1 = (bf16*)(ws + WS_K1); P.K2 = (bf16*)(ws + WS_K2); P.WS = (bf16*)(ws + WS_WS); P.U = (bf16*)(ws + WS_U); P.V = (bf16*)(ws + WS_V);
    P.XN = (bf16*)(ws + WS_R1); P.AOUT = (bf16*)(ws + WS_R1); P.BOUT = (bf16*)(ws + WS_R1 + 16 * MiB); P.HN2 = (bf16*)(ws + WS_R1);
    P.Q = (bf16*)(ws + WS_Q); P.KV = (bf16*)(ws + WS_KV); P.GU = (bf16*)(ws + WS_GU); P.GV = (bf16*)(ws + WS_GV); P.GA = (bf16*)(ws + WS_GA); P.GB = (bf16*)(ws + WS_GB);
    P.MERGED = (bf16*)(ws + WS_MERGED); P.QP = (bf16*)(ws + WS_QP);

    for (int u = tid; u < (LDS_BYTES - MISC_OFF) / 4; u += NWAVES * 64) ((LAS unsigned*)(lds + MISC_OFF))[u] = 0u;
    __syncthreads();
    const int lo = args.ph_lo, hi = args.ph_hi;
    unsigned* barw = (unsigned*)(ws + WS_CTL) + CW_BAR;
    XcdBarrier bar; bar.bar = barw; bar.x = 0; bar.st = nullptr;
    if (hi - lo > 1) bar = xcd_barrier_post(barw, (volatile LAS unsigned*)(lds + MISC_OFF));
#define IN(k) (lo <= (k) && (k) < hi)
#define BOTH(k) (IN(k) && IN((k) + 1))
#define GRID_BAR() xcd_barrier(bar)

    if (IN(0)) { p0_prologue(lds, P, vcu, G, lane, wave); if (BOTH(0)) GRID_BAR(); }

    if (IN(1)) {
        pg8::Gemm g{P.XN, P.WIN, M, NZ, D}; pg8::StaticOrder S; S.init(M, NZ, G, bx);
        pg8::EpiZ E{P.Q, P.KV, P.GU, P.GV, P.GA, P.GB};
        pg8::gemm_phase<pg8::EpiZ, pg8::StaticOrder, PG8_ALIGN, PG8_SP2>(lds, g, S, E);
        if (BOTH(1)) GRID_BAR();
    }

    if (IN(2)) {
        p2_attn_naive(lds, P, vcu, G, tid, lane, wave);
        p2_gmlp_naive(lds, P, vcu, G, tid, lane, wave);
        if (BOTH(2)) GRID_BAR();
    }

    if (IN(3)) {
        { pg8::Gemm g{P.AOUT, P.WPA, M, D, 512}; pg8::StaticOrder S; S.init(M, D, G, bx);
          pg8::EpiGateTmp E{P.GA, P.out};
          pg8::gemm_phase<pg8::EpiGateTmp, pg8::StaticOrder, PG8_ALIGN, PG8_SP2>(lds, g, S, E); }
        { pg8::Gemm g{P.BOUT, P.WPB, M, D, 512}; pg8::StaticOrder S; S.init(M, D, G, bx);
          pg8::EpiMerge E{P.GB, P.out, P.MERGED};
          pg8::gemm_phase<pg8::EpiMerge, pg8::StaticOrder, PG8_ALIGN, PG8_SP2>(lds, g, S, E); }
        if (BOTH(3)) GRID_BAR();
    }

    if (IN(4)) {
        pg8::Gemm g{P.MERGED, P.WOUT, M, D, D}; pg8::StaticOrder S; S.init(M, D, G, bx);
        pg8::EpiRes E{P.x, P.out};
        pg8::gemm_phase<pg8::EpiRes, pg8::StaticOrder, PG8_ALIGN, PG8_SP2>(lds, g, S, E);
        if (BOTH(4)) GRID_BAR();
    }

    if (IN(5)) {
        const int gw = vcu * NWAVES + wave, NGW = G * NWAVES;
        for (int m = gw; m < M; m += NGW) rms_row_to_bf16(P.out + (size_t)m * D, P.ffn_w, P.HN2 + (size_t)m * D, lane);
        if (BOTH(5)) GRID_BAR();
    }

    if (IN(6)) {
        pg8::Gemm g{P.HN2, P.WQ, M, 2048, D}; pg8::StaticOrder S; S.init(M, 2048, G, bx);
        pg8::EpiPlain E{P.QP, 2048};
        pg8::gemm_phase<pg8::EpiPlain, pg8::StaticOrder, PG8_ALIGN, PG8_SP2>(lds, g, S, E);
        if (BOTH(6)) GRID_BAR();
    }

    if (IN(7)) p7_peer(lds, P, vcu, G, tid, lane, wave);
#undef IN
#undef BOTH
#undef GRID_BAR
}

extern "C" void kernel_launch(void* const* d_in, const int* in_sizes, int n_in, void* d_out, int out_size, void* d_ws, size_t ws_size, hipStream_t stream) {
    static int grid = 0;
    if (grid == 0) {
        if (n_in != 19 || out_size != M * D || ws_size < WS_END) { fprintf(stderr, "kernel_launch: unexpected shapes (n_in %d, out %d, ws %zu)\n", n_in, out_size, ws_size); grid = -1; return; }
        int dev = 0, cus = 0, per_cu = 0;
        if (hipGetDevice(&dev) != hipSuccess || hipDeviceGetAttribute(&cus, hipDeviceAttributeMultiprocessorCount, dev) != hipSuccess) { grid = -1; return; }
        if (hipFuncSetAttribute((const void*)mega_fwd, hipFuncAttributeMaxDynamicSharedMemorySize, LDS_BYTES) != hipSuccess) { fprintf(stderr, "kernel_launch: hipFuncSetAttribute failed\n"); grid = -1; return; }
        if (hipOccupancyMaxActiveBlocksPerMultiprocessor(&per_cu, (const void*)mega_fwd, NWAVES * 64, LDS_BYTES) != hipSuccess || per_cu < 1)
            fprintf(stderr, "kernel_launch: note: occupancy query reports %d workgroups per CU\n", per_cu);
        (void)hipGetLastError();
        grid = cus;
    }
    if (grid < 0) return;
    if (hipMemsetAsync((char*)d_ws + WS_CTL, 0, CTL_ZERO_BYTES, stream) != hipSuccess) return;
    Args a{};
    for (int i = 0; i < 19; ++i) a.in[i] = (const float*)d_in[i];
    a.out = (float*)d_out; a.ws = (unsigned char*)d_ws;
#if MK_N_LAUNCHES == 1
    a.ph_lo = 0; a.ph_hi = N_PHASES;
    hipLaunchKernelGGL(mega_fwd, dim3(grid), dim3(NWAVES * 64), LDS_BYTES, stream, a);
#else
    for (int li = 0; li < N_PHASES; ++li) { a.ph_lo = li; a.ph_hi = li + 1; hipLaunchKernelGGL(mega_fwd, dim3(grid), dim3(NWAVES * 64), LDS_BYTES, stream, a); }
#endif
}
```

```cpp
#include <hip/hip_runtime.h>
#include <cstdio>
#include <cstdint>
namespace pg8 {
#define PG8_LAS __attribute__((address_space(3)))
typedef unsigned short bf16_t;
typedef short bf16x8 __attribute__((ext_vector_type(8)));
typedef float f32x4 __attribute__((ext_vector_type(4)));
typedef unsigned u32x4 __attribute__((ext_vector_type(4)));
constexpr int BM = 256, BK = 64, HALF = 128, HTB = HALF * BK * 2  , STAGE_BYTES = 8 * HTB, NXCD = 8, WGM = 8;

__host__ __device__ __forceinline__ int lds_byte(int r, int c) { const int st = (r >> 4) * 2 + (c >> 5), rr = r & 15, cc = c & 31, ob = rr * 64 + cc * 2; return st * 1024 + (ob ^ (((ob >> 9) & 1) << 5)); }
__host__ __device__ __forceinline__ void stage_rc(int b, int& R, int& C) { const int st = b / 1024, sb = b % 1024, swz = sb ^ (((sb >> 9) & 1) << 5); R = (st >> 1) * 16 + swz / 64; C = (st & 1) * 32 + (swz % 64) / 2; }
__host__ __device__ __forceinline__ int perm32(int rho) { const int n = rho >> 4, i = rho & 15; return 8 * (i >> 2) + 4 * n + (i & 3); }

struct Unit { int pm, pn; };
struct Gemm { const bf16_t* A; const bf16_t* Bt; int M, N, K; };

struct StaticOrder {
    int nM, nN, nwg, G, c;
    __host__ __device__ void init(int M, int N, int G_, int c_) { nM = M / BM; nN = N / BM; nwg = nM * nN; G = G_; c = c_; }
    __host__ __device__ bool next(int i, Unit& u) const {
        const long L = (long)i * G + c; if (L >= nwg) return false;
        int wgid = (int)L; { const int q = nwg / NXCD, r = nwg % NXCD, xcd = wgid % NXCD, off = wgid / NXCD; wgid = (xcd < r ? xcd * (q + 1) : r * (q + 1) + (xcd - r) * q) + off; }
        const int nig = WGM * nN, gid = wgid / nig, fm = gid * WGM, gsz = (nM - fm) < WGM ? (nM - fm) : WGM;
        u.pm = fm + ((wgid % nig) % gsz); u.pn = (wgid % nig) / gsz; return true;
    }
    __device__ __forceinline__ void a_ready(const Unit&) const {}
    __device__ __forceinline__ void done(const Unit&) const {}
};

__device__ __forceinline__ unsigned cvt_pk_bf16(float lo, float hi) { unsigned r; asm volatile("v_cvt_pk_bf16_f32 %0, %1, %2" : "=v"(r) : "v"(lo), "v"(hi)); return r; }
typedef float f32x2 __attribute__((ext_vector_type(2)));
template <class Epi, class Sched, bool ALIGN_EPI = false, bool SP2 = false>
__device__ __forceinline__ void gemm_phase(PG8_LAS unsigned char* lds, const Gemm g, const Sched& S, const Epi& E) {
    const int tid = threadIdx.x, wid = __builtin_amdgcn_readfirstlane(tid >> 6), lane = tid & 63, wr = wid >> 2, wc = wid & 3, fr = lane & 15, fq = lane >> 4;
    const int K = g.K, nt = K / BK;
    unsigned voffA[2], voffB[2];
#pragma unroll
    for (int i = 0; i < 2; ++i) { int R, C; stage_rc(tid * 16 + i * 8192, R, C); const int Rb = Epi::PERM ? ((R & ~31) + perm32(R & 31)) : R;
        voffA[i] = (unsigned)(R * K + C) * 2u; voffB[i] = (unsigned)(Rb * K + C) * 2u; }
    const size_t kstep = (size_t)(BK * 2);
    const size_t hstep = (size_t)HALF * K * 2;
    const size_t tstep = 2 * hstep;
    const unsigned ldsw = (unsigned)wid * 1024u;
    const int aoff = lds_byte(wr * 64 + fr, fq * 8), boff = lds_byte(wc * 32 + fr, fq * 8);
#define PG8_SA(b, h) (((b) * 2 + (h)) * HTB)
#define PG8_SB(b, h) ((4 + (b) * 2 + (h)) * HTB)
#define PG8_STAGE(bufoff, gbase, voff) do { _Pragma("unroll") for (int _i = 0; _i < 2; ++_i) \
        __builtin_amdgcn_global_load_lds((const unsigned*)((const char*)(gbase) + (voff)[_i]), (PG8_LAS unsigned*)(lds + (bufoff) + ldsw + _i * 8192), 16, 0, 0); } while (0)
#define PG8_LDA(dst, b, h) do { _Pragma("unroll") for (int m = 0; m < 4; ++m) _Pragma("unroll") for (int k = 0; k < 2; ++k) dst[m][k] = *(const PG8_LAS bf16x8*)(lds + PG8_SA(b, h) + aoff + m * 2048 + k * 1024); } while (0)
#define PG8_LDB(dst, b, h) do { _Pragma("unroll") for (int n = 0; n < 2; ++n) _Pragma("unroll") for (int k = 0; k < 2; ++k) dst[n][k] = *(const PG8_LAS bf16x8*)(lds + PG8_SB(b, h) + boff + n * 2048 + k * 1024); } while (0)
#define PG8_MMA(ai, bj, At, Bt) do { __builtin_amdgcn_s_setprio(1); _Pragma("unroll") for (int m = 0; m < 4; ++m) _Pragma("unroll") for (int n = 0; n < 2; ++n) _Pragma("unroll") for (int k = 0; k < 2; ++k) \
        acc[ai][bj][m][n] = __builtin_amdgcn_mfma_f32_16x16x32_bf16(Bt[n][k], At[m][k], acc[ai][bj][m][n], 0, 0, 0); __builtin_amdgcn_s_setprio(0); } while (0)
#define PG8_WAIT_V(n) asm volatile("s_waitcnt vmcnt(" #n ")" ::: "memory")
#define PG8_WAIT_L(n) asm volatile("s_waitcnt lgkmcnt(" #n ")" ::: "memory")
#define PG8_BAR __builtin_amdgcn_s_barrier()
#define PG8_SCHED __builtin_amdgcn_sched_barrier(0)
    Unit cur, nxt; int ui = 0;
    if (!S.next(0, cur)) return;
    f32x4 acc[2][2][4][2];
#pragma unroll
    for (int a = 0; a < 2; ++a)
#pragma unroll
        for (int b = 0; b < 2; ++b)
#pragma unroll
            for (int m = 0; m < 4; ++m)
#pragma unroll
                for (int n = 0; n < 2; ++n) acc[a][b][m][n] = (f32x4){0.f, 0.f, 0.f, 0.f};
    bf16x8 At[4][2], B0[2][2], B1[2][2];
    const char* cA = (const char*)g.A + (size_t)cur.pm * tstep; const char* cB = (const char*)g.Bt + (size_t)cur.pn * tstep;
    S.a_ready(cur);
    if constexpr (SP2) {
        PG8_STAGE(PG8_SB(0, 0), cB, voffB); PG8_STAGE(PG8_SB(0, 1), cB + hstep, voffB); PG8_STAGE(PG8_SA(0, 0), cA, voffA); PG8_STAGE(PG8_SA(0, 1), cA + hstep, voffA);
        if (wr == 1) PG8_BAR;
        PG8_WAIT_V(2); PG8_BAR;
        PG8_STAGE(PG8_SB(1, 0), cB + kstep, voffB); PG8_STAGE(PG8_SA(1, 0), cA + kstep, voffA); PG8_STAGE(PG8_SB(1, 1), cB + hstep + kstep, voffB);
        PG8_WAIT_V(6); PG8_BAR;
    } else {
        PG8_STAGE(PG8_SB(0, 0), cB, voffB); PG8_STAGE(PG8_SA(0, 0), cA, voffA); PG8_STAGE(PG8_SB(0, 1), cB + hstep, voffB); PG8_STAGE(PG8_SA(0, 1), cA + hstep, voffA);
        if (wr == 1) PG8_BAR;
        PG8_WAIT_V(4); PG8_BAR;
        PG8_STAGE(PG8_SB(1, 0), cB + kstep, voffB); PG8_STAGE(PG8_SA(1, 0), cA + kstep, voffA); PG8_STAGE(PG8_SB(1, 1), cB + hstep + kstep, voffB);
        PG8_WAIT_V(6); PG8_BAR;
    }
    for (;;) {
        const bool has_next = S.next(ui + 1, nxt);
        const char* nA = has_next ? (const char*)g.A + (size_t)nxt.pm * tstep : cA; const char* nB = has_next ? (const char*)g.Bt + (size_t)nxt.pn * tstep : cB;
        for (int t = 0; t < nt; t += 2) {
            const bool last = (t == nt - 2);
            const char* a1 = cA + (size_t)(t + 1) * kstep;
            const char* a2 = last ? nA : cA + (size_t)(t + 2) * kstep; const char* b2 = last ? nB : cB + (size_t)(t + 2) * kstep;
            const char* a3 = a2 + kstep; const char* b3 = b2 + kstep;
            if (last && has_next) S.a_ready(nxt);
            if constexpr (SP2) {
            PG8_LDB(B0, 0, 0); PG8_LDB(B1, 0, 1); PG8_SCHED; PG8_LDA(At, 0, 0); PG8_STAGE(PG8_SA(1, 1), a1 + hstep, voffA);
            PG8_WAIT_V(8); PG8_WAIT_L(0); PG8_BAR; PG8_MMA(0, 0, At, B0); PG8_MMA(0, 1, At, B1); PG8_BAR; PG8_SCHED;
            PG8_LDA(At, 0, 1); PG8_STAGE(PG8_SB(0, 0), b2, voffB); PG8_STAGE(PG8_SB(0, 1), b2 + hstep, voffB); PG8_STAGE(PG8_SA(0, 0), a2, voffA);
            PG8_WAIT_V(8); PG8_WAIT_L(0); PG8_BAR; PG8_MMA(1, 0, At, B0); PG8_MMA(1, 1, At, B1); PG8_BAR; PG8_SCHED;
            PG8_LDB(B0, 1, 0); PG8_LDB(B1, 1, 1); PG8_SCHED; PG8_LDA(At, 1, 0); PG8_STAGE(PG8_SA(0, 1), a2 + hstep, voffA);
            PG8_WAIT_V(8); PG8_WAIT_L(0); PG8_BAR; PG8_MMA(0, 0, At, B0); PG8_MMA(0, 1, At, B1); PG8_BAR; PG8_SCHED;
            PG8_LDA(At, 1, 1); PG8_STAGE(PG8_SB(1, 0), b3, voffB); PG8_STAGE(PG8_SB(1, 1), b3 + hstep, voffB); PG8_STAGE(PG8_SA(1, 0), a3, voffA);
            PG8_WAIT_V(8); PG8_WAIT_L(0); PG8_BAR; PG8_MMA(1, 0, At, B0); PG8_MMA(1, 1, At, B1); PG8_BAR; PG8_SCHED;
            } else {
            PG8_LDB(B0, 0, 0); PG8_SCHED; PG8_LDA(At, 0, 0); PG8_STAGE(PG8_SA(1, 1), a1 + hstep, voffA);
            PG8_WAIT_L(8); PG8_BAR; PG8_WAIT_L(0); PG8_MMA(0, 0, At, B0); PG8_BAR; PG8_SCHED;
            PG8_LDB(B1, 0, 1); PG8_STAGE(PG8_SB(0, 0), b2, voffB);
            PG8_BAR; PG8_WAIT_L(0); PG8_MMA(0, 1, At, B1); PG8_BAR;
            PG8_LDA(At, 0, 1); PG8_STAGE(PG8_SA(0, 0), a2, voffA);
            PG8_BAR; PG8_WAIT_L(0); PG8_MMA(1, 0, At, B0); PG8_BAR; PG8_SCHED;
            PG8_STAGE(PG8_SB(0, 1), b2 + hstep, voffB);
            PG8_WAIT_V(6); PG8_BAR; PG8_MMA(1, 1, At, B1); PG8_BAR;
            PG8_LDB(B0, 1, 0); PG8_SCHED; PG8_LDA(At, 1, 0); PG8_STAGE(PG8_SA(0, 1), a2 + hstep, voffA);
            PG8_WAIT_L(8); PG8_BAR; PG8_WAIT_L(0); PG8_MMA(0, 0, At, B0); PG8_BAR; PG8_SCHED;
            PG8_LDB(B1, 1, 1); PG8_STAGE(PG8_SB(1, 0), b3, voffB);
            PG8_BAR; PG8_WAIT_L(0); PG8_MMA(0, 1, At, B1); PG8_BAR;
            PG8_LDA(At, 1, 1); PG8_STAGE(PG8_SA(1, 0), a3, voffA);
            PG8_BAR; PG8_WAIT_L(0); PG8_MMA(1, 0, At, B0); PG8_BAR; PG8_SCHED;
            PG8_STAGE(PG8_SB(1, 1), b3 + hstep, voffB);
            PG8_WAIT_V(6); PG8_BAR; PG8_MMA(1, 1, At, B1); PG8_BAR;
            }
        }
        if constexpr (ALIGN_EPI) { if (wr == 0) PG8_BAR; }
        if constexpr (!Epi::AFTER_DRAIN) { E(acc, cur, wr, wc, fr, fq); S.done(cur); }
        if (!has_next) break;
#pragma unroll
        for (int a = 0; a < 2; ++a)
#pragma unroll
            for (int b = 0; b < 2; ++b)
#pragma unroll
                for (int m = 0; m < 4; ++m)
#pragma unroll
                    for (int n = 0; n < 2; ++n) acc[a][b][m][n] = (f32x4){0.f, 0.f, 0.f, 0.f};
        cur = nxt; cA = nA; cB = nB; ++ui;
        if constexpr (ALIGN_EPI) { if (wr == 1) PG8_BAR; }
    }
    PG8_WAIT_V(0);
    if constexpr (!ALIGN_EPI) { if (wr == 0) PG8_BAR; }
    PG8_BAR;
    if constexpr (Epi::AFTER_DRAIN) { E.fused(acc, cur, wr, wc, fr, fq, lds, wid, lane); S.done(cur); }
#undef PG8_SA
#undef PG8_SB
#undef PG8_STAGE
#undef PG8_LDA
#undef PG8_LDB
#undef PG8_MMA
#undef PG8_WAIT_V
#undef PG8_WAIT_L
#undef PG8_BAR
#undef PG8_SCHED
}
}
#ifndef PG8_SP2
#define PG8_SP2 true
#endif
#ifndef PG8_ALIGN
#define PG8_ALIGN true
#endif

constexpr int NWAVES = 8;
#ifndef MK_N_LAUNCHES
#define MK_N_LAUNCHES 1
#endif
constexpr int N_PHASES = 8;
#ifndef ATTN_MFMA
#define ATTN_MFMA 1
#endif
#ifndef GMLP_MFMA
#define GMLP_MFMA 1
#endif
#ifndef PROBE_P2_REPS
#define PROBE_P2_REPS 1
#endif

constexpr int NB = 2, SEQ = 8192, D = 1024, M = NB * SEQ;
constexpr int NZ = 3840;
constexpr float EPS = 1e-6f;

constexpr size_t MiB = 1u << 20;
constexpr size_t WS_CTL = 0, CTL_ZERO_BYTES = 65536;
constexpr size_t WS_WIN = 1 * MiB;
constexpr size_t WS_WPA = 9 * MiB;
constexpr size_t WS_WPB = 10 * MiB;
constexpr size_t WS_WOUT = 11 * MiB;
constexpr size_t WS_WQ = 13 * MiB;
constexpr size_t WS_K1 = 17 * MiB;
constexpr size_t WS_K2 = 17 * MiB + 32768;
constexpr size_t WS_WS = 17 * MiB + 65536;
constexpr size_t WS_U = 18 * MiB;
constexpr size_t WS_V = 50 * MiB;
constexpr size_t WS_R1 = 82 * MiB;
constexpr size_t WS_Q = 114 * MiB;
constexpr size_t WS_KV = 130 * MiB;
constexpr size_t WS_GU = 138 * MiB;
constexpr size_t WS_GV = 154 * MiB;
constexpr size_t WS_GA = 170 * MiB;
constexpr size_t WS_GB = 202 * MiB;
constexpr size_t WS_MERGED = 114 * MiB;
constexpr size_t WS_QP = 170 * MiB;
constexpr size_t WS_END = 234 * MiB;
constexpr int CW_BAR = 0;

constexpr int RING_BYTES = 131072;
constexpr int MISC_OFF = 143360;
constexpr int LDS_BYTES = 147456;

#define GAS __attribute__((address_space(1)))
#define LAS __attribute__((address_space(3)))
typedef unsigned short bf16;
typedef unsigned v4u __attribute__((ext_vector_type(4)));
typedef unsigned v2u __attribute__((ext_vector_type(2)));
typedef float f32x4 __attribute__((ext_vector_type(4)));
typedef GAS unsigned gu32;
typedef __bf16 bf16x2_t __attribute__((ext_vector_type(2)));
#define RLX_AGENT __ATOMIC_RELAXED, __HIP_MEMORY_SCOPE_AGENT
#define LDS_WAIT() asm volatile("s_waitcnt lgkmcnt(0)" ::: "memory")
#define VM_WAIT() asm volatile("s_waitcnt vmcnt(0)" ::: "memory")
__device__ __forceinline__ unsigned f2bf(float f) { unsigned u = __builtin_bit_cast(unsigned, f); return (u + 0x7fffu + ((u >> 16) & 1u)) >> 16; }
__device__ __forceinline__ unsigned pk2(float lo, float hi) { return f2bf(lo) | (f2bf(hi) << 16); }
__device__ __forceinline__ float bflo(unsigned w) { return __builtin_bit_cast(float, w << 16); }
__device__ __forceinline__ float bfhi(unsigned w) { return __builtin_bit_cast(float, w & 0xffff0000u); }
__device__ __forceinline__ float bf2f(bf16 h) { return __builtin_bit_cast(float, (unsigned)h << 16); }
__device__ __forceinline__ float dot2bf(unsigned a, unsigned b, float c) { return __builtin_amdgcn_fdot2_f32_bf16(__builtin_bit_cast(bf16x2_t, a), __builtin_bit_cast(bf16x2_t, b), c, false); }
__device__ __forceinline__ float gelu_tanh(float v) {
    const float t2 = v * (-2.302208198f + (-0.1029432397f) * v * v);
    return v * __builtin_amdgcn_rcpf(1.0f + __builtin_amdgcn_exp2f(t2));
}
__device__ __forceinline__ float sigmoid_f(float v) { return __builtin_amdgcn_rcpf(1.0f + __builtin_amdgcn_exp2f(-1.4426950409f * v)); }
__device__ __forceinline__ float wave_sum(float v) {
#pragma unroll
    for (int o = 1; o < 64; o <<= 1) v += __shfl_xor(v, o);
    return v;
}
__device__ const unsigned char T5B[128] = {0, 1, 2, 3, 4, 5, 6, 7, 8, 9, 10, 11, 12, 13, 14, 15, 16, 16, 16, 17, 17, 18, 18, 18, 19, 19, 19, 20, 20, 20, 20, 21, 21, 21, 21, 22, 22, 22, 22, 22, 23, 23, 23, 23, 23, 23, 24, 24, 24, 24, 24, 24, 25, 25, 25, 25, 25, 25, 25, 26, 26, 26, 26, 26, 26, 26, 26, 27, 27, 27, 27, 27, 27, 27, 27, 27, 27, 28, 28, 28, 28, 28, 28, 28, 28, 28, 28, 29, 29, 29, 29, 29, 29, 29, 29, 29, 29, 29, 29, 30, 30, 30, 30, 30, 30, 30, 30, 30, 30, 30, 30, 30, 30, 31, 31, 31, 31, 31, 31, 31, 31, 31, 31, 31, 31, 31, 31, 31};
#define XB_TMO      128
#define XB_XCNT(j)  (256  + 64 * (j))
#define XB_XSUB(j)  (1280 + 64 * (j))
#define XB_XGEN(j)  (2304 + 64 * (j))
#define XB_TOP      3328
#define XB_TOPGEN   3392
#define XCD_BAR_WORDS 3456
#define XB_SPIN_CAP (1u << 18)

__device__ __forceinline__ unsigned xb_ld(unsigned* p)              { return __hip_atomic_load(p, __ATOMIC_RELAXED, __HIP_MEMORY_SCOPE_AGENT); }
__device__ __forceinline__ unsigned xb_add(unsigned* p, unsigned v) { return __hip_atomic_fetch_add(p, v, __ATOMIC_RELAXED, __HIP_MEMORY_SCOPE_AGENT); }
__device__ __forceinline__ unsigned xb_xcc_id() { return (unsigned)__builtin_amdgcn_s_getreg((3 << 11) | 20) & 0xFu; }
#define XB_SPIN(cond, bar) do { unsigned _sp = 0; while (cond) { __builtin_amdgcn_s_sleep(1); \
    if ((++_sp & 255u) == 0u) { if (xb_ld(&(bar)[XB_TMO])) break; if (_sp > XB_SPIN_CAP) { atomicAdd(&(bar)[XB_TMO], 1u); break; } } } } while (0)

struct XcdBarrier {
    unsigned* bar; unsigned x;
    volatile LAS unsigned* st;
};

__device__ __forceinline__ XcdBarrier xcd_barrier_post(unsigned* bar, volatile LAS unsigned* st) {
    XcdBarrier b; b.bar = bar; b.x = xb_xcc_id(); b.st = st;
    if (threadIdx.x == 0) (void)xb_add(&bar[XB_XCNT(b.x)], 1u);
    return b;
}
__device__ __forceinline__ void xcd_barrier_complete(unsigned* bar, unsigned x, unsigned& nloc, unsigned& nx) {
    const unsigned G = gridDim.x * gridDim.y * gridDim.z;
    unsigned sum, cnt, mine, sp = 0u;
    for (;;) {
        sum = 0u; cnt = 0u; mine = 0u;
#pragma unroll
        for (unsigned j = 0; j < 16; ++j) { const unsigned c = xb_ld(&bar[XB_XCNT(j)]); sum += c; cnt += (c > 0u) ? 1u : 0u; mine = (j == x) ? c : mine; }
        if (sum == G) break;
        __builtin_amdgcn_s_sleep(1);
        if ((++sp & 255u) == 0u) { if (xb_ld(&bar[XB_TMO])) break; if (sp > XB_SPIN_CAP) { atomicAdd(&bar[XB_TMO], 1u); break; } }
    }
    nloc = mine > 0u ? mine : 1u; nx = cnt > 0u ? cnt : 1u;
}

__device__ __forceinline__ void xcd_barrier(const XcdBarrier& b) {
    asm volatile("s_waitcnt vmcnt(0)" ::: "memory");
    __syncthreads();
    if (threadIdx.x == 0) {
        unsigned* bar = b.bar;
        __builtin_amdgcn_s_waitcnt(0);
        unsigned nloc = b.st[0], nx = b.st[1];
        if (nloc == 0u) { xcd_barrier_complete(bar, b.x, nloc, nx); b.st[0] = nloc; b.st[1] = nx; }
        const unsigned old = xb_add(&bar[XB_XSUB(b.x)], 1u);
        const unsigned gen = old / nloc;
        if (old + 1u == (gen + 1u) * nloc) {
            __builtin_amdgcn_fence(__ATOMIC_RELEASE, "agent");
            asm volatile("s_waitcnt vmcnt(0)" ::: "memory");
            const unsigned og = xb_add(&bar[XB_TOP], 1u);
            const unsigned tg = og / nx;
            if (og + 1u == (tg + 1u) * nx) xb_add(&bar[XB_TOPGEN], 1u);
            else XB_SPIN(xb_ld(&bar[XB_TOPGEN]) == tg, bar);
            __builtin_amdgcn_fence(__ATOMIC_ACQUIRE, "agent");
            xb_add(&bar[XB_XGEN(b.x)], 1u);
            asm volatile("s_waitcnt vmcnt(0)" ::: "memory");
        } else {
            XB_SPIN(xb_ld(&bar[XB_XGEN(b.x)]) == gen, bar);
            __builtin_amdgcn_fence(__ATOMIC_ACQUIRE, "agent");
            asm volatile("s_waitcnt vmcnt(0)" ::: "memory");
        }
    }
    __syncthreads();
}
namespace pg8 {
struct EpiZ {
    static constexpr bool PERM = true, AFTER_DRAIN = false;
    bf16_t *Q, *KV, *GU, *GV, *GA, *GB;
    __device__ __forceinline__ void operator()(const f32x4 (&acc)[2][2][4][2], const Unit& u, int wr, int wc, int fr, int fq) const {
        const int pn = u.pn; bf16_t* base; int ldc, colt, act;
        if (pn < 2)       { base = Q;  ldc = 512;  colt = pn * 256;        act = 0; }
        else if (pn == 2) { base = KV; ldc = 256;  colt = 0;               act = 0; }
        else if (pn < 5)  { base = GU; ldc = 512;  colt = (pn - 3) * 256;  act = 1; }
        else if (pn < 7)  { base = GV; ldc = 512;  colt = (pn - 5) * 256;  act = 1; }
        else if (pn < 11) { base = GA; ldc = 1024; colt = (pn - 7) * 256;  act = 2; }
        else              { base = GB; ldc = 1024; colt = (pn - 11) * 256; act = 2; }
        const int row0 = u.pm * BM + wr * 64 + fr, col0 = colt + wc * 32 + 8 * fq;
#pragma unroll
        for (int ai = 0; ai < 2; ++ai)
#pragma unroll
            for (int m = 0; m < 4; ++m) { bf16_t* rowp = base + (size_t)(row0 + ai * HALF + m * 16) * ldc + col0;
#pragma unroll
                for (int bj = 0; bj < 2; ++bj) { f32x4 v0 = acc[ai][bj][m][0], v1 = acc[ai][bj][m][1];
                    if (act == 1) {
#pragma unroll
                        for (int e = 0; e < 4; ++e) { v0[e] = gelu_tanh(v0[e]); v1[e] = gelu_tanh(v1[e]); }
                    } else if (act == 2) {
#pragma unroll
                        for (int e = 0; e < 4; ++e) { v0[e] = sigmoid_f(v0[e]); v1[e] = sigmoid_f(v1[e]); }
                    }
                    u32x4 w; w.x = cvt_pk_bf16(v0[0], v0[1]); w.y = cvt_pk_bf16(v0[2], v0[3]); w.z = cvt_pk_bf16(v1[0], v1[1]); w.w = cvt_pk_bf16(v1[2], v1[3]);
                    *(u32x4*)(rowp + bj * HALF) = w; } }
    }
};
struct EpiGateTmp {
    static constexpr bool PERM = true, AFTER_DRAIN = false;
    const bf16_t* gate; float* tmp;
    __device__ __forceinline__ void operator()(const f32x4 (&acc)[2][2][4][2], const Unit& u, int wr, int wc, int fr, int fq) const {
        const int row0 = u.pm * BM + wr * 64 + fr, col0 = u.pn * BM + wc * 32 + 8 * fq;
#pragma unroll
        for (int ai = 0; ai < 2; ++ai)
#pragma unroll
            for (int m = 0; m < 4; ++m) { const size_t ro = (size_t)(row0 + ai * HALF + m * 16) * 1024 + col0;
#pragma unroll
                for (int bj = 0; bj < 2; ++bj) { const u32x4 g = *(const u32x4*)(gate + ro + bj * HALF); f32x4 v0 = acc[ai][bj][m][0], v1 = acc[ai][bj][m][1];
                    v0[0] *= bflo(g.x); v0[1] *= bfhi(g.x); v0[2] *= bflo(g.y); v0[3] *= bfhi(g.y); v1[0] *= bflo(g.z); v1[1] *= bfhi(g.z); v1[2] *= bflo(g.w); v1[3] *= bfhi(g.w);
                    *(f32x4*)(tmp + ro + bj * HALF) = v0; *(f32x4*)(tmp + ro + bj * HALF + 4) = v1; } }
    }
};
struct EpiMerge {
    static constexpr bool PERM = true, AFTER_DRAIN = false;
    const bf16_t* gate; const float* tmp; bf16_t* out;
    __device__ __forceinline__ void operator()(const f32x4 (&acc)[2][2][4][2], const Unit& u, int wr, int wc, int fr, int fq) const {
        const int row0 = u.pm * BM + wr * 64 + fr, col0 = u.pn * BM + wc * 32 + 8 * fq;
#pragma unroll
        for (int ai = 0; ai < 2; ++ai)
#pragma unroll
            for (int m = 0; m < 4; ++m) { const size_t ro = (size_t)(row0 + ai * HALF + m * 16) * 1024 + col0;
#pragma unroll
                for (int bj = 0; bj < 2; ++bj) { const u32x4 g = *(const u32x4*)(gate + ro + bj * HALF); f32x4 v0 = acc[ai][bj][m][0], v1 = acc[ai][bj][m][1];
                    const f32x4 t0 = *(const f32x4*)(tmp + ro + bj * HALF), t1 = *(const f32x4*)(tmp + ro + bj * HALF + 4);
                    v0[0] = t0[0] + v0[0] * bflo(g.x); v0[1] = t0[1] + v0[1] * bfhi(g.x); v0[2] = t0[2] + v0[2] * bflo(g.y); v0[3] = t0[3] + v0[3] * bfhi(g.y);
                    v1[0] = t1[0] + v1[0] * bflo(g.z); v1[1] = t1[1] + v1[1] * bfhi(g.z); v1[2] = t1[2] + v1[2] * bflo(g.w); v1[3] = t1[3] + v1[3] * bfhi(g.w);
                    u32x4 w; w.x = cvt_pk_bf16(v0[0], v0[1]); w.y = cvt_pk_bf16(v0[2], v0[3]); w.z = cvt_pk_bf16(v1[0], v1[1]); w.w = cvt_pk_bf16(v1[2], v1[3]);
                    *(u32x4*)(out + ro + bj * HALF) = w; } }
    }
};
struct EpiRes {
    static constexpr bool PERM = false, AFTER_DRAIN = false;
    const float* base; float* C;
    __device__ __forceinline__ void operator()(const f32x4 (&acc)[2][2][4][2], const Unit& u, int wr, int wc, int fr, int fq) const {
        const int row0 = u.pm * BM + wr * 64 + fr, col0 = u.pn * BM + wc * 32 + 4 * fq;
#pragma unroll
        for (int ai = 0; ai < 2; ++ai)
#pragma unroll
            for (int m = 0; m < 4; ++m) { const size_t ro = (size_t)(row0 + ai * HALF + m * 16) * 1024 + col0;
#pragma unroll
                for (int bj = 0; bj < 2; ++bj)
#pragma unroll
                    for (int n = 0; n < 2; ++n) *(f32x4*)(C + ro + bj * HALF + n * 16) = *(const f32x4*)(base + ro + bj * HALF + n * 16) + acc[ai][bj][m][n]; }
    }
};
struct EpiPlain {
    static constexpr bool PERM = true, AFTER_DRAIN = false;
    bf16_t* O; int ldc;
    __device__ __forceinline__ void operator()(const f32x4 (&acc)[2][2][4][2], const Unit& u, int wr, int wc, int fr, int fq) const {
        const int row0 = u.pm * BM + wr * 64 + fr, col0 = u.pn * BM + wc * 32 + 8 * fq;
#pragma unroll
        for (int ai = 0; ai < 2; ++ai)
#pragma unroll
            for (int m = 0; m < 4; ++m) { bf16_t* rowp = O + (size_t)(row0 + ai * HALF + m * 16) * ldc + col0;
#pragma unroll
                for (int bj = 0; bj < 2; ++bj) { const f32x4 v0 = acc[ai][bj][m][0], v1 = acc[ai][bj][m][1];
                    u32x4 w; w.x = cvt_pk_bf16(v0[0], v0[1]); w.y = cvt_pk_bf16(v0[2], v0[3]); w.z = cvt_pk_bf16(v1[0], v1[1]); w.w = cvt_pk_bf16(v1[2], v1[3]);
                    *(u32x4*)(rowp + bj * HALF) = w; } }
    }
};
}

__device__ __forceinline__ void p0_transpose_item(const float* W, int K, int N, bf16* WT, LAS float* scr, int item, int lane) {
    const int nblk = N / 32, kb = item / nblk, nb = item % nblk, k0 = 64 * kb, n0 = 32 * nb;
#pragma unroll 8
    for (int i = 0; i < 32; ++i) { const int kk = 2 * i + (lane >> 5); scr[kk * 33 + (lane & 31)] = W[(size_t)(k0 + kk) * N + n0 + (lane & 31)]; }
    LDS_WAIT(); asm volatile("" ::: "memory");
    const int c = lane & 7;
#pragma unroll
    for (int j = 0; j < 4; ++j) { const int n = (lane >> 3) + 8 * j; const LAS float* s = scr + (8 * c) * 33 + n;
        v4u o; o.x = pk2(s[0 * 33], s[1 * 33]); o.y = pk2(s[2 * 33], s[3 * 33]); o.z = pk2(s[4 * 33], s[5 * 33]); o.w = pk2(s[6 * 33], s[7 * 33]);
        *(v4u*)(WT + (size_t)(n0 + n) * K + k0 + 8 * c) = o; }
    LDS_WAIT(); asm volatile("" ::: "memory");
}
__device__ __forceinline__ void cvt_flat(const float* src, bf16* dst, size_t n, int gw, int NGW, int lane) {
    for (size_t i = (size_t)gw * 512 + lane * 8; i < n; i += (size_t)NGW * 512) {
        const f32x4 a = *(const f32x4*)(src + i), b = *(const f32x4*)(src + i + 4);
        v4u o; o.x = pk2(a[0], a[1]); o.y = pk2(a[2], a[3]); o.z = pk2(b[0], b[1]); o.w = pk2(b[2], b[3]);
        *(v4u*)(dst + i) = o;
    }
}
__device__ __forceinline__ void rms_row_to_bf16(const float* xrow, const float* w, bf16* orow, int lane) {
    const f32x4* xr = (const f32x4*)xrow + lane; const f32x4* wr = (const f32x4*)w + lane;
    f32x4 v[4]; float s = 0.f;
#pragma unroll
    for (int j = 0; j < 4; ++j) { v[j] = xr[64 * j]; s += (v[j][0] * v[j][0] + v[j][1] * v[j][1]) + (v[j][2] * v[j][2] + v[j][3] * v[j][3]); }
    const float rstd = 1.0f / sqrtf(wave_sum(s) * (1.0f / 1024.0f) + EPS);
    unsigned long long* o8 = (unsigned long long*)orow + lane;
#pragma unroll
    for (int j = 0; j < 4; ++j) { const f32x4 ww = wr[64 * j];
        o8[64 * j] = (unsigned long long)pk2(v[j][0] * rstd * ww[0], v[j][1] * rstd * ww[1]) | ((unsigned long long)pk2(v[j][2] * rstd * ww[2], v[j][3] * rstd * ww[3]) << 32); }
}

struct Ptrs {
    const float *x, *mix_w, *w_in, *rel_bias, *sinks, *w_pa, *ln_w, *ln_b, *w_s, *b_s, *w_pb, *w_out, *ffn_w, *w_q, *keys1, *keys2, *pu, *pv, *fin_w;
    float* out;
    bf16 *WIN, *WPA, *WPB, *WOUT, *WQ, *K1, *K2, *WS, *U, *V, *XN, *AOUT, *BOUT, *HN2, *Q, *KV, *GU, *GV, *GA, *GB, *MERGED, *QP;
};

__device__ __forceinline__ void p0_prologue(LAS unsigned char* lds, const Ptrs& P, int vcu, int G, int lane, int wave) {
    LAS float* scr = (LAS float*)(lds + wave * 16384);
    const int gw = vcu * NWAVES + wave, NGW = G * NWAVES;
    constexpr int I_IN = (1024 / 64) * (3840 / 32), I_PA = (512 / 64) * (1024 / 32), I_OUT = (1024 / 64) * (1024 / 32), I_WQ = (1024 / 64) * (2048 / 32);
    constexpr int NITEMS = I_IN + 2 * I_PA + I_OUT + I_WQ;
    for (int it = gw; it < NITEMS; it += NGW) {
        int r = it;
        if (r < I_IN) { p0_transpose_item(P.w_in, 1024, 3840, P.WIN, scr, r, lane); continue; } r -= I_IN;
        if (r < I_PA) { p0_transpose_item(P.w_pa, 512, 1024, P.WPA, scr, r, lane); continue; } r -= I_PA;
        if (r < I_PA) { p0_transpose_item(P.w_pb, 512, 1024, P.WPB, scr, r, lane); continue; } r -= I_PA;
        if (r < I_OUT) { p0_transpose_item(P.w_out, 1024, 1024, P.WOUT, scr, r, lane); continue; } r -= I_OUT;
        p0_transpose_item(P.w_q, 1024, 2048, P.WQ, scr, r, lane);
    }
    cvt_flat(P.keys1, P.K1, 128 * 128, gw, NGW, lane);
    cvt_flat(P.keys2, P.K2, 128 * 128, gw, NGW, lane);
    cvt_flat(P.pu, P.U, (size_t)16384 * 1024, gw, NGW, lane);
    cvt_flat(P.pv, P.V, (size_t)16384 * 1024, gw, NGW, lane);
    for (size_t i = (size_t)gw * 512 + lane * 8; i < (size_t)8 * 128 * 128; i += (size_t)NGW * 512) {
        const int t = (int)((i >> 7) & 127), s0 = (int)(i & 127);
        const f32x4 a = *(const f32x4*)(P.w_s + i), b = *(const f32x4*)(P.w_s + i + 4);
        float e[8] = {a[0], a[1], a[2], a[3], b[0], b[1], b[2], b[3]};
#pragma unroll
        for (int j = 0; j < 8; ++j) e[j] = (s0 + j <= t) ? e[j] : 0.f;
        v4u o; o.x = pk2(e[0], e[1]); o.y = pk2(e[2], e[3]); o.z = pk2(e[4], e[5]); o.w = pk2(e[6], e[7]);
        *(v4u*)(P.WS + i) = o;
    }
    for (int m = gw; m < M; m += NGW) rms_row_to_bf16(P.x + (size_t)m * D, P.mix_w, P.XN + (size_t)m * D, lane);
}

__device__ __forceinline__ void p2_attn_naive(LAS unsigned char* lds, const Ptrs& P, int vcu, int G, int tid, int lane, int wave) {
    LAS float* biasl = (LAS float*)lds;
    for (int i = tid; i < 1024; i += 512) { const int d = i >> 3, h = i & 7; biasl[i] = P.rel_bias[(int)T5B[d] * 8 + h]; }
    __syncthreads();
    const int h = wave, kvh = h >> 2;
    const float sink = P.sinks[h];
    for (int unit = vcu; unit < M / 64; unit += G) {
        const int t = unit * 64 + lane, pos = t & (SEQ - 1);
        float q[64], o[64];
        { const v4u* qp = (const v4u*)(P.Q + (size_t)t * 512 + h * 64);
#pragma unroll
          for (int c = 0; c < 8; ++c) { const v4u w = qp[c]; q[8 * c + 0] = bflo(w.x) * 0.125f; q[8 * c + 1] = bfhi(w.x) * 0.125f; q[8 * c + 2] = bflo(w.y) * 0.125f; q[8 * c + 3] = bfhi(w.y) * 0.125f;
              q[8 * c + 4] = bflo(w.z) * 0.125f; q[8 * c + 5] = bfhi(w.z) * 0.125f; q[8 * c + 6] = bflo(w.w) * 0.125f; q[8 * c + 7] = bfhi(w.w) * 0.125f; } }
#pragma unroll
        for (int i = 0; i < 64; ++i) o[i] = 0.f;
        float m = sink, l = 1.f;
        for (int d = 0; d < 128; ++d) {
            const bool valid = (pos - d) >= 0;
            const int tj = valid ? (t - d) : t;
            const v4u* kp = (const v4u*)(P.KV + (size_t)tj * 256 + kvh * 64);
            float dot = 0.f;
#pragma unroll
            for (int c = 0; c < 8; ++c) { const v4u w = kp[c];
                dot += q[8 * c + 0] * bflo(w.x) + q[8 * c + 1] * bfhi(w.x) + q[8 * c + 2] * bflo(w.y) + q[8 * c + 3] * bfhi(w.y) + q[8 * c + 4] * bflo(w.z) + q[8 * c + 5] * bfhi(w.z) + q[8 * c + 6] * bflo(w.w) + q[8 * c + 7] * bfhi(w.w); }
            const float s = valid ? dot + biasl[d * 8 + h] : -1e30f;
            const float mn = fmaxf(m, s), alpha = __expf(m - mn), p = __expf(s - mn);
            l = l * alpha + p; m = mn;
            const v4u* vp = kp + 16;
#pragma unroll
            for (int c = 0; c < 8; ++c) { const v4u w = vp[c];
                o[8 * c + 0] = o[8 * c + 0] * alpha + p * bflo(w.x); o[8 * c + 1] = o[8 * c + 1] * alpha + p * bfhi(w.x); o[8 * c + 2] = o[8 * c + 2] * alpha + p * bflo(w.y); o[8 * c + 3] = o[8 * c + 3] * alpha + p * bfhi(w.y);
                o[8 * c + 4] = o[8 * c + 4] * alpha + p * bflo(w.z); o[8 * c + 5] = o[8 * c + 5] * alpha + p * bfhi(w.z); o[8 * c + 6] = o[8 * c + 6] * alpha + p * bflo(w.w); o[8 * c + 7] = o[8 * c + 7] * alpha + p * bfhi(w.w); }
        }
        const float inv = 1.0f / l;
        v4u* op = (v4u*)(P.AOUT + (size_t)t * 512 + h * 64);
#pragma unroll
        for (int c = 0; c < 8; ++c) { v4u w; w.x = pk2(o[8 * c + 0] * inv, o[8 * c + 1] * inv); w.y = pk2(o[8 * c + 2] * inv, o[8 * c + 3] * inv); w.z = pk2(o[8 * c + 4] * inv, o[8 * c + 5] * inv); w.w = pk2(o[8 * c + 6] * inv, o[8 * c + 7] * inv); op[c] = w; }
    }
    __syncthreads();
}

__device__ __forceinline__ void p2_gmlp_naive(LAS unsigned char* lds, const Ptrs& P, int vcu, int G, int tid, int lane, int wave) {
    LAS bf16* vnl = (LAS bf16*)(lds + 8192);
    for (int unit = vcu; unit < 256; unit += G) {
        const int c = unit >> 1, hh = unit & 1;
        for (int i = 0; i < 16; ++i) {
            const int tt = wave * 16 + i; const size_t row = (size_t)c * 128 + tt;
            const v4u w = *((const v4u*)(P.GV + row * 512) + lane);
            float x[8] = {bflo(w.x), bfhi(w.x), bflo(w.y), bfhi(w.y), bflo(w.z), bfhi(w.z), bflo(w.w), bfhi(w.w)};
            float s = 0.f;
#pragma unroll
            for (int j = 0; j < 8; ++j) s += x[j];
            const float mean = wave_sum(s) * (1.0f / 512.0f);
            float ss = 0.f;
#pragma unroll
            for (int j = 0; j < 8; ++j) { x[j] -= mean; ss += x[j] * x[j]; }
            const float rstd = 1.0f / sqrtf(wave_sum(ss) * (1.0f / 512.0f) + EPS);
            if ((lane >> 5) == hh) {
                const f32x4 w0 = *(const f32x4*)(P.ln_w + lane * 8), w1 = *(const f32x4*)(P.ln_w + lane * 8 + 4), b0 = *(const f32x4*)(P.ln_b + lane * 8), b1 = *(const f32x4*)(P.ln_b + lane * 8 + 4);
                v4u o; o.x = pk2(x[0] * rstd * w0[0] + b0[0], x[1] * rstd * w0[1] + b0[1]); o.y = pk2(x[2] * rstd * w0[2] + b0[2], x[3] * rstd * w0[3] + b0[3]);
                o.z = pk2(x[4] * rstd * w1[0] + b1[0], x[5] * rstd * w1[1] + b1[1]); o.w = pk2(x[6] * rstd * w1[2] + b1[2], x[7] * rstd * w1[3] + b1[3]);
                *(LAS v4u*)(vnl + tt * 256 + (lane & 31) * 8) = o;
            }
        }
        __syncthreads();
        const int ch = tid & 255, th = tid >> 8, g = hh * 4 + (ch >> 6);
        for (int t = th * 64; t < th * 64 + 64; ++t) {
            const v4u* wrow = (const v4u*)(P.WS + ((size_t)g * 128 + t) * 128);
            float acc = 0.f;
            for (int s8 = 0; s8 <= (t >> 3); ++s8) {
                const v4u w = wrow[s8];
                const LAS bf16* vp = vnl + (s8 * 8) * 256 + ch;
                acc += bflo(w.x) * bf2f(vp[0]) + bfhi(w.x) * bf2f(vp[256]) + bflo(w.y) * bf2f(vp[512]) + bfhi(w.y) * bf2f(vp[768])
                     + bflo(w.z) * bf2f(vp[1024]) + bfhi(w.z) * bf2f(vp[1280]) + bflo(w.w) * bf2f(vp[1536]) + bfhi(w.w) * bf2f(vp[1792]);
            }
            const size_t row = (size_t)c * 128 + t;
            const float uval = bf2f(P.GU[row * 512 + hh * 256 + ch]);
            P.BOUT[row * 512 + hh * 256 + ch] = (bf16)f2bf(uval * (acc + P.b_s[g * 128 + t]));
        }
        __syncthreads();
    }
}

typedef short s16x8 __attribute__((ext_vector_type(8)));
typedef short s16x4 __attribute__((ext_vector_type(4)));
typedef float f32x16 __attribute__((ext_vector_type(16)));
typedef float f32x2v __attribute__((ext_vector_type(2)));
#define MFMA32(a, b, c) __builtin_amdgcn_mfma_f32_32x32x16_bf16((a), (b), (c), 0, 0, 0)
__device__ __forceinline__ s16x4 tr16(const LAS unsigned char* p) { return __builtin_bit_cast(s16x4, __builtin_amdgcn_ds_read_tr16_b64_v4i16((LAS s16x4*)p)); }
__device__ __forceinline__ unsigned cvtpk(float lo, float hi) { f32x2v v = {lo, hi}; bf16x2_t b = __builtin_convertvector(v, bf16x2_t); return __builtin_bit_cast(unsigned, b); }
__device__ __forceinline__ int crow(int reg, int h) { return (reg & 3) + 8 * (reg >> 2) + 4 * h; }
constexpr float LOG2E = 1.4426950408889634f;

__device__ __forceinline__ void p2_attn_mfma(LAS unsigned char* lds, const Ptrs& P, int vcu, int G, int tid, int lane, int wave) {
    LAS unsigned char* Kl = lds;
    LAS unsigned char* Vl = lds + 32768;
    LAS float* biasl = (LAS float*)(lds + 32768 + 49152);
    const int r = lane & 31, h = lane >> 5, i16 = lane & 15, q4 = i16 >> 2, p4 = i16 & 3, blk = (lane >> 4) & 1;
    for (int unit = vcu; unit < 256; unit += G) {
        const int kvh = unit & 1, blkid = unit >> 1, nb = blkid & 63; const int tok0 = blkid * 128;
#pragma unroll
        for (int i = 0; i < 4; ++i) {
            const int cidx = tid + 512 * i, row = cidx >> 3, c = cidx & 7;
            v4u kw = {0u, 0u, 0u, 0u}, vw = {0u, 0u, 0u, 0u};
            if (nb > 0 || row >= 128) { const bf16* src = P.KV + (size_t)(tok0 - 128 + row) * 256 + kvh * 64 + c * 8; kw = *(const v4u*)src; vw = *(const v4u*)(src + 128); }
            *(LAS v4u*)(Kl + row * 128 + ((c ^ ((row >> 1) & 7)) << 4)) = kw;
            *(LAS v4u*)(Vl + row * 192 + c * 16) = vw;
        }
        biasl[tid] = P.rel_bias[(int)T5B[tid & 127] * 8 + kvh * 4 + (tid >> 7)] * LOG2E;
        __syncthreads();
        const int g = wave >> 1, qh = wave & 1, hq = kvh * 4 + g;
        const float sink2 = P.sinks[hq] * LOG2E;
#pragma unroll 1
        for (int qs = 0; qs < 2; ++qs) {
            const int qi0 = 64 * qh + 32 * qs, kt0 = 2 * qh + qs;
            s16x8 qf[4];
            { const bf16* qrow = P.Q + (size_t)(tok0 + qi0 + r) * 512 + hq * 64 + 8 * h;
#pragma unroll
              for (int ks = 0; ks < 4; ++ks) qf[ks] = *(const s16x8*)(qrow + 16 * ks); }
            f32x16 s[5];
#pragma unroll
            for (int i = 0; i < 5; ++i) {
#pragma unroll
                for (int e = 0; e < 16; ++e) s[i][e] = 0.f;
                const int key = 32 * (kt0 + i) + r; const LAS unsigned char* kp = Kl + key * 128; const int sw = (key >> 1) & 7;
#pragma unroll
                for (int ks = 0; ks < 4; ++ks) { const s16x8 kf = *(const LAS s16x8*)(kp + (((2 * ks + h) ^ sw) << 4)); s[i] = MFMA32(kf, qf[ks], s[i]); }
            }
            const int qi = qi0 + r;
            float mx = sink2;
#pragma unroll
            for (int i = 0; i < 5; ++i)
#pragma unroll
                for (int e = 0; e < 16; ++e) {
                    const int kj = 32 * (kt0 + i) + crow(e, h), dist = 128 + qi - kj;
                    const bool valid = (dist >= 0) && (dist < 128) && (nb > 0 || kj >= 128);
                    const float b = biasl[g * 128 + (dist & 127)];
                    const float v = valid ? s[i][e] * (0.125f * LOG2E) + b : -1e30f;
                    s[i][e] = v; mx = fmaxf(mx, v);
                }
            mx = fmaxf(mx, __shfl_xor(mx, 32));
            float l = 0.f;
#pragma unroll
            for (int i = 0; i < 5; ++i)
#pragma unroll
                for (int e = 0; e < 16; ++e) { const float p = __builtin_amdgcn_exp2f(s[i][e] - mx); s[i][e] = p; l += p; }
            l += __shfl_xor(l, 32);
            l += __builtin_amdgcn_exp2f(sink2 - mx);
            f32x16 o0, o1;
#pragma unroll
            for (int e = 0; e < 16; ++e) { o0[e] = 0.f; o1[e] = 0.f; }
#pragma unroll
            for (int i = 0; i < 5; ++i)
#pragma unroll
                for (int st = 0; st < 2; ++st) {
                    v4u pw; pw.x = cvtpk(s[i][8 * st], s[i][8 * st + 1]); pw.y = cvtpk(s[i][8 * st + 2], s[i][8 * st + 3]); pw.z = cvtpk(s[i][8 * st + 4], s[i][8 * st + 5]); pw.w = cvtpk(s[i][8 * st + 6], s[i][8 * st + 7]);
                    const s16x8 pf = __builtin_bit_cast(s16x8, pw);
                    const LAS unsigned char* vb = Vl + (32 * (kt0 + i) + 16 * st + 4 * h + q4) * 192 + 32 * blk + 8 * p4;
                    { const s16x4 lo = tr16(vb), hi = tr16(vb + 8 * 192); const s16x8 vf = __builtin_shufflevector(lo, hi, 0, 1, 2, 3, 4, 5, 6, 7); o0 = MFMA32(vf, pf, o0); }
                    { const s16x4 lo = tr16(vb + 64), hi = tr16(vb + 64 + 8 * 192); const s16x8 vf = __builtin_shufflevector(lo, hi, 0, 1, 2, 3, 4, 5, 6, 7); o1 = MFMA32(vf, pf, o1); }
                }
            const float inv = 1.0f / l;
            bf16* orow = P.AOUT + (size_t)(tok0 + qi) * 512 + hq * 64 + 4 * h;
#pragma unroll
            for (int r4 = 0; r4 < 4; ++r4) {
                v2u w0; w0.x = cvtpk(o0[4 * r4] * inv, o0[4 * r4 + 1] * inv); w0.y = cvtpk(o0[4 * r4 + 2] * inv, o0[4 * r4 + 3] * inv); *(v2u*)(orow + 8 * r4) = w0;
                v2u w1; w1.x = cvtpk(o1[4 * r4] * inv, o1[4 * r4 + 1] * inv); w1.y = cvtpk(o1[4 * r4 + 2] * inv, o1[4 * r4 + 3] * inv); *(v2u*)(orow + 32 + 8 * r4) = w1;
            }
        }
        __syncthreads();
    }
}

__device__ __forceinline__ void p2_gmlp_mfma(LAS unsigned char* lds, const Ptrs& P, int vcu, int G, int tid, int lane, int wave) {
    LAS unsigned char* vnl = lds;
    const int r = lane & 31, h = lane >> 5, i16 = lane & 15, q4 = i16 >> 2, p4 = i16 & 3, blk = (lane >> 4) & 1;
    for (int unit = vcu; unit < 256; unit += G) {
        const int c = unit >> 1, hh = unit & 1;
        for (int i = 0; i < 16; ++i) {
            const int tt = wave * 16 + i; const size_t row = (size_t)c * 128 + tt;
            const v4u w = *((const v4u*)(P.GV + row * 512) + lane);
            float x[8] = {bflo(w.x), bfhi(w.x), bflo(w.y), bfhi(w.y), bflo(w.z), bfhi(w.z), bflo(w.w), bfhi(w.w)};
            float s = 0.f;
#pragma unroll
            for (int j = 0; j < 8; ++j) s += x[j];
            const float mean = wave_sum(s) * (1.0f / 512.0f);
            float ss = 0.f;
#pragma unroll
            for (int j = 0; j < 8; ++j) { x[j] -= mean; ss += x[j] * x[j]; }
            const float rstd = 1.0f / sqrtf(wave_sum(ss) * (1.0f / 512.0f) + EPS);
            if ((lane >> 5) == hh) {
                const f32x4 w0 = *(const f32x4*)(P.ln_w + lane * 8), w1 = *(const f32x4*)(P.ln_w + lane * 8 + 4), b0 = *(const f32x4*)(P.ln_b + lane * 8), b1 = *(const f32x4*)(P.ln_b + lane * 8 + 4);
                v4u o; o.x = pk2(x[0] * rstd * w0[0] + b0[0], x[1] * rstd * w0[1] + b0[1]); o.y = pk2(x[2] * rstd * w0[2] + b0[2], x[3] * rstd * w0[3] + b0[3]);
                o.z = pk2(x[4] * rstd * w1[0] + b1[0], x[5] * rstd * w1[1] + b1[1]); o.w = pk2(x[6] * rstd * w1[2] + b1[2], x[7] * rstd * w1[3] + b1[3]);
                *(LAS v4u*)(vnl + tt * 576 + (lane & 31) * 16) = o;
            }
        }
        __syncthreads();
        const int gi = wave >> 1, dblk = wave & 1, g = hh * 4 + gi;
        s16x8 af[8];
#pragma unroll
        for (int ks = 0; ks < 8; ++ks) { const LAS unsigned char* vb = vnl + (16 * ks + 8 * h + q4) * 576 + (gi * 64 + dblk * 32 + 16 * blk) * 2 + 8 * p4;
            const s16x4 lo = tr16(vb), hi = tr16(vb + 4 * 576); af[ks] = __builtin_shufflevector(lo, hi, 0, 1, 2, 3, 4, 5, 6, 7); }
#pragma unroll
        for (int tt = 0; tt < 4; ++tt) {
            f32x16 acc;
#pragma unroll
            for (int e = 0; e < 16; ++e) acc[e] = 0.f;
            const bf16* wrow = P.WS + ((size_t)g * 128 + 32 * tt + r) * 128 + 8 * h;
#pragma unroll
            for (int ks = 0; ks < 2 * (tt + 1); ++ks) acc = MFMA32(af[ks], *(const s16x8*)(wrow + 16 * ks), acc);
            const int t = 32 * tt + r; const size_t row = (size_t)c * 128 + t; const float b = P.b_s[g * 128 + t];
#pragma unroll
            for (int r4 = 0; r4 < 4; ++r4) {
                const int ch = g * 64 + dblk * 32 + 8 * r4 + 4 * h;
                const v2u uw = *(const v2u*)(P.GU + row * 512 + ch);
                v2u ow; ow.x = cvtpk(bflo(uw.x) * (acc[4 * r4] + b), bfhi(uw.x) * (acc[4 * r4 + 1] + b)); ow.y = cvtpk(bflo(uw.y) * (acc[4 * r4 + 2] + b), bfhi(uw.y) * (acc[4 * r4 + 3] + b));
                *(v2u*)(P.BOUT + row * 512 + ch) = ow;
            }
        }
        __syncthreads();
    }
}

__device__ __forceinline__ void topk_half(const bf16* q, const LAS bf16* kl, float (&v)[16]) {
    v4u qv[16];
#pragma unroll
    for (int c = 0; c < 16; ++c) qv[c] = ((const v4u*)q)[c];
#pragma unroll
    for (int i = 0; i < 16; ++i) v[i] = -INFINITY;
    for (int n = 0; n < 128; ++n) {
        const LAS v4u* kr = (const LAS v4u*)(kl + n * 128);
        float a0 = 0.f, a1 = 0.f, a2 = 0.f, a3 = 0.f;
#pragma unroll
        for (int c = 0; c < 16; ++c) { const v4u kk = kr[c]; a0 = dot2bf(qv[c].x, kk.x, a0); a1 = dot2bf(qv[c].y, kk.y, a1); a2 = dot2bf(qv[c].z, kk.z, a2); a3 = dot2bf(qv[c].w, kk.w, a3); }
        const float acc = (a0 + a1) + (a2 + a3);
        float x = __builtin_bit_cast(float, (__builtin_bit_cast(unsigned, acc) & ~0x7Fu) | (unsigned)n);
#pragma unroll
        for (int i = 0; i < 16; ++i) { const float hi = fmaxf(v[i], x); x = fminf(v[i], x); v[i] = hi; }
    }
}

__device__ __forceinline__ void p7_peer(LAS unsigned char* lds, const Ptrs& P, int vcu, int G, int tid, int lane, int wave) {
    LAS bf16* k1l = (LAS bf16*)lds;
    LAS bf16* k2l = (LAS bf16*)(lds + 32768);
    LAS int* idxl = (LAS int*)(lds + 65536);
    LAS float* gatel = (LAS float*)(lds + 98304);
    LAS float* al = (LAS float*)(lds + 131072);
    for (int i = tid; i < 2048; i += 512) { ((LAS v4u*)k1l)[i] = ((const v4u*)P.K1)[i]; ((LAS v4u*)k2l)[i] = ((const v4u*)P.K2)[i]; }
    __syncthreads();
    for (int unit = vcu; unit < M / 64; unit += G) {
        {
            const int tl = tid >> 3, h = tid & 7;
            const bf16* qrow = P.QP + (size_t)(unit * 64 + tl) * 2048 + h * 256;
            float v1[16], v2[16];
            topk_half(qrow, k1l, v1);
            topk_half(qrow + 128, k2l, v2);
            float tv[16]; int tp[16];
#pragma unroll
            for (int k = 0; k < 16; ++k) { tv[k] = -INFINITY; tp[k] = 0; }
#pragma unroll
            for (int i = 0; i < 16; ++i)
#pragma unroll
                for (int j = 0; j < 16; ++j)
                    if ((i + 1) * (j + 1) <= 16) {
                        const unsigned b1 = __builtin_bit_cast(unsigned, v1[i]), b2 = __builtin_bit_cast(unsigned, v2[j]);
                        float x = __builtin_bit_cast(float, b1 & ~0x7Fu) + __builtin_bit_cast(float, b2 & ~0x7Fu);
                        int px = (int)((b1 & 0x7Fu) * 128u + (b2 & 0x7Fu));
#pragma unroll
                        for (int k = 0; k < 16; ++k) { const bool c = x > tv[k]; const float nv = c ? x : tv[k], nx = c ? tv[k] : x; const int np = c ? px : tp[k], npx = c ? tp[k] : px; tv[k] = nv; x = nx; tp[k] = np; px = npx; }
                    }
            float e[16], es = 0.f;
#pragma unroll
            for (int k = 0; k < 16; ++k) { e[k] = __expf(tv[k] - tv[0]); es += e[k]; }
            const float inv = 1.0f / es;
            LAS v4u* ip = (LAS v4u*)(idxl + tl * 128 + h * 16); LAS f32x4* gp = (LAS f32x4*)(gatel + tl * 128 + h * 16);
#pragma unroll
            for (int k = 0; k < 4; ++k) { v4u iv; iv.x = (unsigned)tp[4 * k]; iv.y = (unsigned)tp[4 * k + 1]; iv.z = (unsigned)tp[4 * k + 2]; iv.w = (unsigned)tp[4 * k + 3]; ip[k] = iv;
                f32x4 gv; gv[0] = e[4 * k] * inv; gv[1] = e[4 * k + 1] * inv; gv[2] = e[4 * k + 2] * inv; gv[3] = e[4 * k + 3] * inv; gp[k] = gv; }
        }
        __syncthreads();
        const int sub = lane & 15, grp = lane >> 4;
        for (int i = 0; i < 8; ++i) {
            const int tl = wave * 8 + i; const size_t t = (size_t)unit * 64 + tl;
            v4u hnr[8];
#pragma unroll
            for (int j = 0; j < 8; ++j) hnr[j] = *((const v4u*)(P.HN2 + t * 1024) + j * 16 + sub);
            for (int q = 0; q < 32; ++q) {
                const int row = idxl[tl * 128 + 4 * q + grp];
                const v4u* up = (const v4u*)(P.U + (size_t)row * 1024) + sub;
                float a0 = 0.f, a1 = 0.f, a2 = 0.f, a3 = 0.f;
#pragma unroll
                for (int j = 0; j < 8; ++j) { const v4u w = up[j * 16]; a0 = dot2bf(w.x, hnr[j].x, a0); a1 = dot2bf(w.y, hnr[j].y, a1); a2 = dot2bf(w.z, hnr[j].z, a2); a3 = dot2bf(w.w, hnr[j].w, a3); }
                float acc = (a0 + a1) + (a2 + a3);
                acc += __shfl_xor(acc, 8); acc += __shfl_xor(acc, 4); acc += __shfl_xor(acc, 2); acc += __shfl_xor(acc, 1);
                if (sub == 0) al[wave * 128 + 4 * q + grp] = acc;
            }
            LDS_WAIT();
            const float av0 = al[wave * 128 + lane], av1 = al[wave * 128 + 64 + lane];
            const float act0 = gelu_tanh(av0) * gatel[tl * 128 + lane], act1 = gelu_tanh(av1) * gatel[tl * 128 + 64 + lane];
            const int ix0 = idxl[tl * 128 + lane], ix1 = idxl[tl * 128 + 64 + lane];
            LDS_WAIT();
            float y[16];
#pragma unroll
            for (int k = 0; k < 16; ++k) y[k] = 0.f;
#pragma unroll 4
            for (int e = 0; e < 64; ++e) {
                const int row = __builtin_amdgcn_readlane(ix0, e); const float a = __builtin_bit_cast(float, __builtin_amdgcn_readlane(__builtin_bit_cast(int, act0), e));
                const v4u* vp = (const v4u*)(P.V + (size_t)row * 1024) + lane; const v4u w0 = vp[0], w1 = vp[64];
                y[0] += a * bflo(w0.x); y[1] += a * bfhi(w0.x); y[2] += a * bflo(w0.y); y[3] += a * bfhi(w0.y); y[4] += a * bflo(w0.z); y[5] += a * bfhi(w0.z); y[6] += a * bflo(w0.w); y[7] += a * bfhi(w0.w);
                y[8] += a * bflo(w1.x); y[9] += a * bfhi(w1.x); y[10] += a * bflo(w1.y); y[11] += a * bfhi(w1.y); y[12] += a * bflo(w1.z); y[13] += a * bfhi(w1.z); y[14] += a * bflo(w1.w); y[15] += a * bfhi(w1.w);
            }
#pragma unroll 4
            for (int e = 0; e < 64; ++e) {
                const int row = __builtin_amdgcn_readlane(ix1, e); const float a = __builtin_bit_cast(float, __builtin_amdgcn_readlane(__builtin_bit_cast(int, act1), e));
                const v4u* vp = (const v4u*)(P.V + (size_t)row * 1024) + lane; const v4u w0 = vp[0], w1 = vp[64];
                y[0] += a * bflo(w0.x); y[1] += a * bfhi(w0.x); y[2] += a * bflo(w0.y); y[3] += a * bfhi(w0.y); y[4] += a * bflo(w0.z); y[5] += a * bfhi(w0.z); y[6] += a * bflo(w0.w); y[7] += a * bfhi(w0.w);
                y[8] += a * bflo(w1.x); y[9] += a * bfhi(w1.x); y[10] += a * bflo(w1.y); y[11] += a * bfhi(w1.y); y[12] += a * bflo(w1.z); y[13] += a * bfhi(w1.z); y[14] += a * bflo(w1.w); y[15] += a * bfhi(w1.w);
            }
            float* xr = P.out + t * 1024;
            f32x4 x0 = *(const f32x4*)(xr + lane * 8), x1 = *(const f32x4*)(xr + lane * 8 + 4), x2 = *(const f32x4*)(xr + 512 + lane * 8), x3 = *(const f32x4*)(xr + 512 + lane * 8 + 4);
            x0[0] += y[0]; x0[1] += y[1]; x0[2] += y[2]; x0[3] += y[3]; x1[0] += y[4]; x1[1] += y[5]; x1[2] += y[6]; x1[3] += y[7];
            x2[0] += y[8]; x2[1] += y[9]; x2[2] += y[10]; x2[3] += y[11]; x3[0] += y[12]; x3[1] += y[13]; x3[2] += y[14]; x3[3] += y[15];
            float ss = 0.f;
#pragma unroll
            for (int k = 0; k < 4; ++k) ss += x0[k] * x0[k] + x1[k] * x1[k] + x2[k] * x2[k] + x3[k] * x3[k];
            const float rstd = 1.0f / sqrtf(wave_sum(ss) * (1.0f / 1024.0f) + EPS);
            const f32x4 w0 = *(const f32x4*)(P.fin_w + lane * 8), w1 = *(const f32x4*)(P.fin_w + lane * 8 + 4), w2 = *(const f32x4*)(P.fin_w + 512 + lane * 8), w3 = *(const f32x4*)(P.fin_w + 512 + lane * 8 + 4);
            *(f32x4*)(xr + lane * 8) = x0 * rstd * w0; *(f32x4*)(xr + lane * 8 + 4) = x1 * rstd * w1; *(f32x4*)(xr + 512 + lane * 8) = x2 * rstd * w2; *(f32x4*)(xr + 512 + lane * 8 + 4) = x3 * rstd * w3;
        }
        __syncthreads();
    }
}

struct Args { const float* in[19]; float* out; unsigned char* ws; int ph_lo, ph_hi; };
__global__ void __launch_bounds__(NWAVES * 64, 2) mega_fwd(Args args) {
    extern __shared__ __attribute__((aligned(16))) unsigned char lds_raw[];
    LAS unsigned char* lds = (LAS unsigned char*)lds_raw;
    const int tid = threadIdx.x, lane = tid & 63, wave = __builtin_amdgcn_readfirstlane(tid >> 6);
    const int G = gridDim.x; const int bx = blockIdx.x; const int vcu = (G % 8 == 0) ? (bx % 8) * (G / 8) + bx / 8 : bx;
    unsigned char* ws = args.ws;
    Ptrs P;
    P.x = args.in[0]; P.mix_w = args.in[1]; P.w_in = args.in[2]; P.rel_bias = args.in[3]; P.sinks = args.in[4]; P.w_pa = args.in[5]; P.ln_w = args.in[6]; P.ln_b = args.in[7];
    P.w_s = args.in[8]; P.b_s = args.in[9]; P.w_pb = args.in[10]; P.w_out = args.in[11]; P.ffn_w = args.in[12]; P.w_q = args.in[13]; P.keys1 = args.in[14]; P.keys2 = args.in[15];
    P.pu = args.in[16]; P.pv = args.in[17]; P.fin_w = args.in[18]; P.out = args.out;
    P.WIN = (bf16*)(ws + WS_WIN); P.WPA = (bf16*)(ws + WS_WPA); P.WPB = (bf16*)(ws + WS_WPB); P.WOUT = (bf16*)(ws + WS_WOUT); P.WQ = (bf16*)(ws + WS_WQ);
    P.K1 = (bf16*)(ws + WS_K1); P.K2 = (bf16*)(ws + WS_K2); P.WS = (bf16*)(ws + WS_WS); P.U = (bf16*)(ws + WS_U); P.V = (bf16*)(ws + WS_V);
    P.XN = (bf16*)(ws + WS_R1); P.AOUT = (bf16*)(ws + WS_R1); P.BOUT = (bf16*)(ws + WS_R1 + 16 * MiB); P.HN2 = (bf16*)(ws + WS_R1);
    P.Q = (bf16*)(ws + WS_Q); P.KV = (bf16*)(ws + WS_KV); P.GU = (bf16*)(ws + WS_GU); P.GV = (bf16*)(ws + WS_GV); P.GA = (bf16*)(ws + WS_GA); P.GB = (bf16*)(ws + WS_GB);
    P.MERGED = (bf16*)(ws + WS_MERGED); P.QP = (bf16*)(ws + WS_QP);

    for (int u = tid; u < (LDS_BYTES - MISC_OFF) / 4; u += NWAVES * 64) ((LAS unsigned*)(lds + MISC_OFF))[u] = 0u;
    __syncthreads();
    const int lo = args.ph_lo, hi = args.ph_hi;
    unsigned* barw = (unsigned*)(ws + WS_CTL) + CW_BAR;
    XcdBarrier bar; bar.bar = barw; bar.x = 0; bar.st = nullptr;
    if (hi - lo > 1) bar = xcd_barrier_post(barw, (volatile LAS unsigned*)(lds + MISC_OFF));
#define IN(k) (lo <= (k) && (k) < hi)
#define BOTH(k) (IN(k) && IN((k) + 1))
#define GRID_BAR() xcd_barrier(bar)

    if (IN(0)) { p0_prologue(lds, P, vcu, G, lane, wave); if (BOTH(0)) GRID_BAR(); }

    if (IN(1)) {
        pg8::Gemm g{P.XN, P.WIN, M, NZ, D}; pg8::StaticOrder S; S.init(M, NZ, G, bx);
        pg8::EpiZ E{P.Q, P.KV, P.GU, P.GV, P.GA, P.GB};
        pg8::gemm_phase<pg8::EpiZ, pg8::StaticOrder, PG8_ALIGN, PG8_SP2>(lds, g, S, E);
        if (BOTH(1)) GRID_BAR();
    }

    if (IN(2)) {
        for (int rep = 0; rep < PROBE_P2_REPS; ++rep) {
#if ATTN_MFMA
        p2_attn_mfma(lds, P, vcu, G, tid, lane, wave);
#else
        p2_attn_naive(lds, P, vcu, G, tid, lane, wave);
#endif
#if GMLP_MFMA
        p2_gmlp_mfma(lds, P, vcu, G, tid, lane, wave);
#else
        p2_gmlp_naive(lds, P, vcu, G, tid, lane, wave);
#endif
        }
        if (BOTH(2)) GRID_BAR();
    }

    if (IN(3)) {
        { pg8::Gemm g{P.AOUT, P.WPA, M, D, 512}; pg8::StaticOrder S; S.init(M, D, G, bx);
          pg8::EpiGateTmp E{P.GA, P.out};
          pg8::gemm_phase<pg8::EpiGateTmp, pg8::StaticOrder, PG8_ALIGN, PG8_SP2>(lds, g, S, E); }
        { pg8::Gemm g{P.BOUT, P.WPB, M, D, 512}; pg8::StaticOrder S; S.init(M, D, G, bx);
          pg8::EpiMerge E{P.GB, P.out, P.MERGED};
          pg8::gemm_phase<pg8::EpiMerge, pg8::StaticOrder, PG8_ALIGN, PG8_SP2>(lds, g, S, E); }
        if (BOTH(3)) GRID_BAR();
    }

    if (IN(4)) {
        pg8::Gemm g{P.MERGED, P.WOUT, M, D, D}; pg8::StaticOrder S; S.init(M, D, G, bx);
        pg8::EpiRes E{P.x, P.out};
        pg8::gemm_phase<pg8::EpiRes, pg8::StaticOrder, PG8_ALIGN, PG8_SP2>(lds, g, S, E);
        if (BOTH(4)) GRID_BAR();
    }

    if (IN(5)) {
        const int gw = vcu * NWAVES + wave, NGW = G * NWAVES;
        for (int m = gw; m < M; m += NGW) rms_row_to_bf16(P.out + (size_t)m * D, P.ffn_w, P.HN2 + (size_t)m * D, lane);
        if (BOTH(5)) GRID_BAR();
    }

    if (IN(6)) {
        pg8::Gemm g{P.HN2, P.WQ, M, 2048, D}; pg8::StaticOrder S; S.init(M, 2048, G, bx);
        pg8::EpiPlain E{P.QP, 2048};
        pg8::gemm_phase<pg8::EpiPlain, pg8::StaticOrder, PG8_ALIGN, PG8_SP2>(lds, g, S, E);
        if (BOTH(6)) GRID_BAR();
    }

    if (IN(7)) p7_peer(lds, P, vcu, G, tid, lane, wave);
#undef IN
#undef BOTH
#undef GRID_BAR
}

extern "C" void kernel_launch(void* const* d_in, const int* in_sizes, int n_in, void* d_out, int out_size, void* d_ws, size_t ws_size, hipStream_t stream) {
    static int grid = 0;
    if (grid == 0) {
        if (n_in != 19 || out_size != M * D || ws_size < WS_END) { fprintf(stderr, "kernel_launch: unexpected shapes (n_in %d, out %d, ws %zu)\n", n_in, out_size, ws_size); grid = -1; return; }
        int dev = 0, cus = 0, per_cu = 0;
        if (hipGetDevice(&dev) != hipSuccess || hipDeviceGetAttribute(&cus, hipDeviceAttributeMultiprocessorCount, dev) != hipSuccess) { grid = -1; return; }
        if (hipFuncSetAttribute((const void*)mega_fwd, hipFuncAttributeMaxDynamicSharedMemorySize, LDS_BYTES) != hipSuccess) { fprintf(stderr, "kernel_launch: hipFuncSetAttribute failed\n"); grid = -1; return; }
        if (hipOccupancyMaxActiveBlocksPerMultiprocessor(&per_cu, (const void*)mega_fwd, NWAVES * 64, LDS_BYTES) != hipSuccess || per_cu < 1)
            fprintf(stderr, "kernel_launch: note: occupancy query reports %d workgroups per CU\n", per_cu);
        (void)hipGetLastError();
        grid = cus;
    }
    if (grid < 0) return;
    if (hipMemsetAsync((char*)d_ws + WS_CTL, 0, CTL_ZERO_BYTES, stream) != hipSuccess) return;
    Args a{};
    for (int i = 0; i < 19; ++i) a.in[i] = (const float*)d_in[i];
    a.out = (float*)d_out; a.ws = (unsigned char*)d_ws;
#if MK_N_LAUNCHES == 1
    a.ph_lo = 0; a.ph_hi = N_PHASES;
    hipLaunchKernelGGL(mega_fwd, dim3(grid), dim3(NWAVES * 64), LDS_BYTES, stream, a);
#else
    for (int li = 0; li < N_PHASES; ++li) { a.ph_lo = li; a.ph_hi = li + 1; hipLaunchKernelGGL(mega_fwd, dim3(grid), dim3(NWAVES * 64), LDS_BYTES, stream, a); }
#endif
}
```

```cpp
#include <hip/hip_runtime.h>
#include <cstdio>
#include <cstdint>
namespace pg8 {
#define PG8_LAS __attribute__((address_space(3)))
typedef unsigned short bf16_t;
typedef short bf16x8 __attribute__((ext_vector_type(8)));
typedef float f32x4 __attribute__((ext_vector_type(4)));
typedef unsigned u32x4 __attribute__((ext_vector_type(4)));
constexpr int BM = 256, BK = 64, HALF = 128, HTB = HALF * BK * 2  , STAGE_BYTES = 8 * HTB, NXCD = 8, WGM = 8;

__host__ __device__ __forceinline__ int lds_byte(int r, int c) { const int st = (r >> 4) * 2 + (c >> 5), rr = r & 15, cc = c & 31, ob = rr * 64 + cc * 2; return st * 1024 + (ob ^ (((ob >> 9) & 1) << 5)); }
__host__ __device__ __forceinline__ void stage_rc(int b, int& R, int& C) { const int st = b / 1024, sb = b % 1024, swz = sb ^ (((sb >> 9) & 1) << 5); R = (st >> 1) * 16 + swz / 64; C = (st & 1) * 32 + (swz % 64) / 2; }
__host__ __device__ __forceinline__ int perm32(int rho) { const int n = rho >> 4, i = rho & 15; return 8 * (i >> 2) + 4 * n + (i & 3); }

struct Unit { int pm, pn; };
struct Gemm { const bf16_t* A; const bf16_t* Bt; int M, N, K; };

struct StaticOrder {
    int nM, nN, nwg, G, c;
    __host__ __device__ void init(int M, int N, int G_, int c_) { nM = M / BM; nN = N / BM; nwg = nM * nN; G = G_; c = c_; }
    __host__ __device__ bool next(int i, Unit& u) const {
        const long L = (long)i * G + c; if (L >= nwg) return false;
        int wgid = (int)L; { const int q = nwg / NXCD, r = nwg % NXCD, xcd = wgid % NXCD, off = wgid / NXCD; wgid = (xcd < r ? xcd * (q + 1) : r * (q + 1) + (xcd - r) * q) + off; }
        const int nig = WGM * nN, gid = wgid / nig, fm = gid * WGM, gsz = (nM - fm) < WGM ? (nM - fm) : WGM;
        u.pm = fm + ((wgid % nig) % gsz); u.pn = (wgid % nig) / gsz; return true;
    }
    __device__ __forceinline__ void a_ready(const Unit&) const {}
    __device__ __forceinline__ void done(const Unit&) const {}
};

__device__ __forceinline__ unsigned cvt_pk_bf16(float lo, float hi) { unsigned r; asm volatile("v_cvt_pk_bf16_f32 %0, %1, %2" : "=v"(r) : "v"(lo), "v"(hi)); return r; }
typedef float f32x2 __attribute__((ext_vector_type(2)));
template <class Epi, class Sched, bool ALIGN_EPI = false, bool SP2 = false>
__device__ __forceinline__ void gemm_phase(PG8_LAS unsigned char* lds, const Gemm g, const Sched& S, const Epi& E) {
    const int tid = threadIdx.x, wid = __builtin_amdgcn_readfirstlane(tid >> 6), lane = tid & 63, wr = wid >> 2, wc = wid & 3, fr = lane & 15, fq = lane >> 4;
    const int K = g.K, nt = K / BK;
    unsigned voffA[2], voffB[2];
#pragma unroll
    for (int i = 0; i < 2; ++i) { int R, C; stage_rc(tid * 16 + i * 8192, R, C); const int Rb = Epi::PERM ? ((R & ~31) + perm32(R & 31)) : R;
        voffA[i] = (unsigned)(R * K + C) * 2u; voffB[i] = (unsigned)(Rb * K + C) * 2u; }
    const size_t kstep = (size_t)(BK * 2);
    const size_t hstep = (size_t)HALF * K * 2;
    const size_t tstep = 2 * hstep;
    const unsigned ldsw = (unsigned)wid * 1024u;
    const int aoff = lds_byte(wr * 64 + fr, fq * 8), boff = lds_byte(wc * 32 + fr, fq * 8);
#define PG8_SA(b, h) (((b) * 2 + (h)) * HTB)
#define PG8_SB(b, h) ((4 + (b) * 2 + (h)) * HTB)
#define PG8_STAGE(bufoff, gbase, voff) do { _Pragma("unroll") for (int _i = 0; _i < 2; ++_i) \
        __builtin_amdgcn_global_load_lds((const unsigned*)((const char*)(gbase) + (voff)[_i]), (PG8_LAS unsigned*)(lds + (bufoff) + ldsw + _i * 8192), 16, 0, 0); } while (0)
#define PG8_LDA(dst, b, h) do { _Pragma("unroll") for (int m = 0; m < 4; ++m) _Pragma("unroll") for (int k = 0; k < 2; ++k) dst[m][k] = *(const PG8_LAS bf16x8*)(lds + PG8_SA(b, h) + aoff + m * 2048 + k * 1024); } while (0)
#define PG8_LDB(dst, b, h) do { _Pragma("unroll") for (int n = 0; n < 2; ++n) _Pragma("unroll") for (int k = 0; k < 2; ++k) dst[n][k] = *(const PG8_LAS bf16x8*)(lds + PG8_SB(b, h) + boff + n * 2048 + k * 1024); } while (0)
#define PG8_MMA(ai, bj, At, Bt) do { __builtin_amdgcn_s_setprio(1); _Pragma("unroll") for (int m = 0; m < 4; ++m) _Pragma("unroll") for (int n = 0; n < 2; ++n) _Pragma("unroll") for (int k = 0; k < 2; ++k) \
        acc[ai][bj][m][n] = __builtin_amdgcn_mfma_f32_16x16x32_bf16(Bt[n][k], At[m][k], acc[ai][bj][m][n], 0, 0, 0); __builtin_amdgcn_s_setprio(0); } while (0)
#define PG8_WAIT_V(n) asm volatile("s_waitcnt vmcnt(" #n ")" ::: "memory")
#define PG8_WAIT_L(n) asm volatile("s_waitcnt lgkmcnt(" #n ")" ::: "memory")
#define PG8_BAR __builtin_amdgcn_s_barrier()
#define PG8_SCHED __builtin_amdgcn_sched_barrier(0)
    Unit cur, nxt; int ui = 0;
    if (!S.next(0, cur)) return;
    f32x4 acc[2][2][4][2];
#pragma unroll
    for (int a = 0; a < 2; ++a)
#pragma unroll
        for (int b = 0; b < 2; ++b)
#pragma unroll
            for (int m = 0; m < 4; ++m)
#pragma unroll
                for (int n = 0; n < 2; ++n) acc[a][b][m][n] = (f32x4){0.f, 0.f, 0.f, 0.f};
    bf16x8 At[4][2], B0[2][2], B1[2][2];
    const char* cA = (const char*)g.A + (size_t)cur.pm * tstep; const char* cB = (const char*)g.Bt + (size_t)cur.pn * tstep;
    S.a_ready(cur);
    if constexpr (SP2) {
        PG8_STAGE(PG8_SB(0, 0), cB, voffB); PG8_STAGE(PG8_SB(0, 1), cB + hstep, voffB); PG8_STAGE(PG8_SA(0, 0), cA, voffA); PG8_STAGE(PG8_SA(0, 1), cA + hstep, voffA);
        if (wr == 1) PG8_BAR;
        PG8_WAIT_V(2); PG8_BAR;
        PG8_STAGE(PG8_SB(1, 0), cB + kstep, voffB); PG8_STAGE(PG8_SA(1, 0), cA + kstep, voffA); PG8_STAGE(PG8_SB(1, 1), cB + hstep + kstep, voffB);
        PG8_WAIT_V(6); PG8_BAR;
    } else {
        PG8_STAGE(PG8_SB(0, 0), cB, voffB); PG8_STAGE(PG8_SA(0, 0), cA, voffA); PG8_STAGE(PG8_SB(0, 1), cB + hstep, voffB); PG8_STAGE(PG8_SA(0, 1), cA + hstep, voffA);
        if (wr == 1) PG8_BAR;
        PG8_WAIT_V(4); PG8_BAR;
        PG8_STAGE(PG8_SB(1, 0), cB + kstep, voffB); PG8_STAGE(PG8_SA(1, 0), cA + kstep, voffA); PG8_STAGE(PG8_SB(1, 1), cB + hstep + kstep, voffB);
        PG8_WAIT_V(6); PG8_BAR;
    }
    for (;;) {
        const bool has_next = S.next(ui + 1, nxt);
        const char* nA = has_next ? (const char*)g.A + (size_t)nxt.pm * tstep : cA; const char* nB = has_next ? (const char*)g.Bt + (size_t)nxt.pn * tstep : cB;
        for (int t = 0; t < nt; t += 2) {
            const bool last = (t == nt - 2);
            const char* a1 = cA + (size_t)(t + 1) * kstep;
            const char* a2 = last ? nA : cA + (size_t)(t + 2) * kstep; const char* b2 = last ? nB : cB + (size_t)(t + 2) * kstep;
            const char* a3 = a2 + kstep; const char* b3 = b2 + kstep;
            if (last && has_next) S.a_ready(nxt);
            if constexpr (SP2) {
            PG8_LDB(B0, 0, 0); PG8_LDB(B1, 0, 1); PG8_SCHED; PG8_LDA(At, 0, 0); PG8_STAGE(PG8_SA(1, 1), a1 + hstep, voffA);
            PG8_WAIT_V(8); PG8_WAIT_L(0); PG8_BAR; PG8_MMA(0, 0, At, B0); PG8_MMA(0, 1, At, B1); PG8_BAR; PG8_SCHED;
            PG8_LDA(At, 0, 1); PG8_STAGE(PG8_SB(0, 0), b2, voffB); PG8_STAGE(PG8_SB(0, 1), b2 + hstep, voffB); PG8_STAGE(PG8_SA(0, 0), a2, voffA);
            PG8_WAIT_V(8); PG8_WAIT_L(0); PG8_BAR; PG8_MMA(1, 0, At, B0); PG8_MMA(1, 1, At, B1); PG8_BAR; PG8_SCHED;
            PG8_LDB(B0, 1, 0); PG8_LDB(B1, 1, 1); PG8_SCHED; PG8_LDA(At, 1, 0); PG8_STAGE(PG8_SA(0, 1), a2 + hstep, voffA);
            PG8_WAIT_V(8); PG8_WAIT_L(0); PG8_BAR; PG8_MMA(0, 0, At, B0); PG8_MMA(0, 1, At, B1); PG8_BAR; PG8_SCHED;
            PG8_LDA(At, 1, 1); PG8_STAGE(PG8_SB(1, 0), b3, voffB); PG8_STAGE(PG8_SB(1, 1), b3 + hstep, voffB); PG8_STAGE(PG8_SA(1, 0), a3, voffA);
            PG8_WAIT_V(8); PG8_WAIT_L(0); PG8_BAR; PG8_MMA(1, 0, At, B0); PG8_MMA(1, 1, At, B1); PG8_BAR; PG8_SCHED;
            } else {
            PG8_LDB(B0, 0, 0); PG8_SCHED; PG8_LDA(At, 0, 0); PG8_STAGE(PG8_SA(1, 1), a1 + hstep, voffA);
            PG8_WAIT_L(8); PG8_BAR; PG8_WAIT_L(0); PG8_MMA(0, 0, At, B0); PG8_BAR; PG8_SCHED;
            PG8_LDB(B1, 0, 1); PG8_STAGE(PG8_SB(0, 0), b2, voffB);
            PG8_BAR; PG8_WAIT_L(0); PG8_MMA(0, 1, At, B1); PG8_BAR;
            PG8_LDA(At, 0, 1); PG8_STAGE(PG8_SA(0, 0), a2, voffA);
            PG8_BAR; PG8_WAIT_L(0); PG8_MMA(1, 0, At, B0); PG8_BAR; PG8_SCHED;
            PG8_STAGE(PG8_SB(0, 1), b2 + hstep, voffB);
            PG8_WAIT_V(6); PG8_BAR; PG8_MMA(1, 1, At, B1); PG8_BAR;
            PG8_LDB(B0, 1, 0); PG8_SCHED; PG8_LDA(At, 1, 0); PG8_STAGE(PG8_SA(0, 1), a2 + hstep, voffA);
            PG8_WAIT_L(8); PG8_BAR; PG8_WAIT_L(0); PG8_MMA(0, 0, At, B0); PG8_BAR; PG8_SCHED;
            PG8_LDB(B1, 1, 1); PG8_STAGE(PG8_SB(1, 0), b3, voffB);
            PG8_BAR; PG8_WAIT_L(0); PG8_MMA(0, 1, At, B1); PG8_BAR;
            PG8_LDA(At, 1, 1); PG8_STAGE(PG8_SA(1, 0), a3, voffA);
            PG8_BAR; PG8_WAIT_L(0); PG8_MMA(1, 0, At, B0); PG8_BAR; PG8_SCHED;
            PG8_STAGE(PG8_SB(1, 1), b3 + hstep, voffB);
            PG8_WAIT_V(6); PG8_BAR; PG8_MMA(1, 1, At, B1); PG8_BAR;
            }
        }
        if constexpr (ALIGN_EPI) { if (wr == 0) PG8_BAR; }
        if constexpr (!Epi::AFTER_DRAIN) { E(acc, cur, wr, wc, fr, fq); S.done(cur); }
        if (!has_next) break;
#pragma unroll
        for (int a = 0; a < 2; ++a)
#pragma unroll
            for (int b = 0; b < 2; ++b)
#pragma unroll
                for (int m = 0; m < 4; ++m)
#pragma unroll
                    for (int n = 0; n < 2; ++n) acc[a][b][m][n] = (f32x4){0.f, 0.f, 0.f, 0.f};
        cur = nxt; cA = nA; cB = nB; ++ui;
        if constexpr (ALIGN_EPI) { if (wr == 1) PG8_BAR; }
    }
    PG8_WAIT_V(0);
    if constexpr (!ALIGN_EPI) { if (wr == 0) PG8_BAR; }
    PG8_BAR;
    if constexpr (Epi::AFTER_DRAIN) { E.fused(acc, cur, wr, wc, fr, fq, lds, wid, lane); S.done(cur); }
#undef PG8_SA
#undef PG8_SB
#undef PG8_STAGE
#undef PG8_LDA
#undef PG8_LDB
#undef PG8_MMA
#undef PG8_WAIT_V
#undef PG8_WAIT_L
#undef PG8_BAR
#undef PG8_SCHED
}
}
#ifndef PG8_SP2
#define PG8_SP2 true
#endif
#ifndef PG8_ALIGN
#define PG8_ALIGN true
#endif

constexpr int NWAVES = 8;
#ifndef MK_N_LAUNCHES
#define MK_N_LAUNCHES 1
#endif
constexpr int N_PHASES = 8;
#ifndef ATTN_MFMA
#define ATTN_MFMA 1
#endif
#ifndef GMLP_MFMA
#define GMLP_MFMA 1
#endif
#ifndef PEER_FP8
#define PEER_FP8 1
#endif
#ifndef PROBE_GATHER_REPS
#define PROBE_GATHER_REPS 1
#endif
#ifndef PROBE_TOPK_REPS
#define PROBE_TOPK_REPS 1
#endif
#ifndef PROBE_P2_REPS
#define PROBE_P2_REPS 1
#endif

constexpr int NB = 2, SEQ = 8192, D = 1024, M = NB * SEQ;
constexpr int NZ = 3840;
constexpr float EPS = 1e-6f;

constexpr size_t MiB = 1u << 20;
constexpr size_t WS_CTL = 0, CTL_ZERO_BYTES = 65536;
constexpr size_t WS_WIN = 1 * MiB;
constexpr size_t WS_WPA = 9 * MiB;
constexpr size_t WS_WPB = 10 * MiB;
constexpr size_t WS_WOUT = 11 * MiB;
constexpr size_t WS_WQ = 13 * MiB;
constexpr size_t WS_K1 = 17 * MiB;
constexpr size_t WS_K2 = 17 * MiB + 32768;
constexpr size_t WS_WS = 17 * MiB + 65536;
constexpr size_t WS_U = 18 * MiB;
constexpr size_t WS_V = 50 * MiB;
constexpr size_t WS_R1 = 82 * MiB;
constexpr size_t WS_Q = 114 * MiB;
constexpr size_t WS_KV = 130 * MiB;
constexpr size_t WS_GU = 138 * MiB;
constexpr size_t WS_GV = 154 * MiB;
constexpr size_t WS_GA = 170 * MiB;
constexpr size_t WS_GB = 202 * MiB;
constexpr size_t WS_MERGED = 114 * MiB;
constexpr size_t WS_QP = 170 * MiB;
constexpr size_t WS_END = 234 * MiB;
constexpr int CW_BAR = 0;

constexpr int RING_BYTES = 131072;
constexpr int MISC_OFF = 143360;
constexpr int LDS_BYTES = 147456;

#define GAS __attribute__((address_space(1)))
#define LAS __attribute__((address_space(3)))
typedef unsigned short bf16;
typedef unsigned v4u __attribute__((ext_vector_type(4)));
typedef unsigned v2u __attribute__((ext_vector_type(2)));
typedef float f32x4 __attribute__((ext_vector_type(4)));
typedef GAS unsigned gu32;
typedef __bf16 bf16x2_t __attribute__((ext_vector_type(2)));
#define RLX_AGENT __ATOMIC_RELAXED, __HIP_MEMORY_SCOPE_AGENT
#define LDS_WAIT() asm volatile("s_waitcnt lgkmcnt(0)" ::: "memory")
#define VM_WAIT() asm volatile("s_waitcnt vmcnt(0)" ::: "memory")
__device__ __forceinline__ unsigned f2bf(float f) { unsigned u = __builtin_bit_cast(unsigned, f); return (u + 0x7fffu + ((u >> 16) & 1u)) >> 16; }
__device__ __forceinline__ unsigned pk2(float lo, float hi) { return f2bf(lo) | (f2bf(hi) << 16); }
__device__ __forceinline__ float bflo(unsigned w) { return __builtin_bit_cast(float, w << 16); }
__device__ __forceinline__ float bfhi(unsigned w) { return __builtin_bit_cast(float, w & 0xffff0000u); }
__device__ __forceinline__ float bf2f(bf16 h) { return __builtin_bit_cast(float, (unsigned)h << 16); }
__device__ __forceinline__ float dot2bf(unsigned a, unsigned b, float c) { return __builtin_amdgcn_fdot2_f32_bf16(__builtin_bit_cast(bf16x2_t, a), __builtin_bit_cast(bf16x2_t, b), c, false); }
__device__ __forceinline__ float gelu_tanh(float v) {
    const float t2 = v * (-2.302208198f + (-0.1029432397f) * v * v);
    return v * __builtin_amdgcn_rcpf(1.0f + __builtin_amdgcn_exp2f(t2));
}
__device__ __forceinline__ float sigmoid_f(float v) { return __builtin_amdgcn_rcpf(1.0f + __builtin_amdgcn_exp2f(-1.4426950409f * v)); }
__device__ __forceinline__ float wave_sum(float v) {
#pragma unroll
    for (int o = 1; o < 64; o <<= 1) v += __shfl_xor(v, o);
    return v;
}
__device__ const unsigned char T5B[128] = {0, 1, 2, 3, 4, 5, 6, 7, 8, 9, 10, 11, 12, 13, 14, 15, 16, 16, 16, 17, 17, 18, 18, 18, 19, 19, 19, 20, 20, 20, 20, 21, 21, 21, 21, 22, 22, 22, 22, 22, 23, 23, 23, 23, 23, 23, 24, 24, 24, 24, 24, 24, 25, 25, 25, 25, 25, 25, 25, 26, 26, 26, 26, 26, 26, 26, 26, 27, 27, 27, 27, 27, 27, 27, 27, 27, 27, 28, 28, 28, 28, 28, 28, 28, 28, 28, 28, 29, 29, 29, 29, 29, 29, 29, 29, 29, 29, 29, 29, 30, 30, 30, 30, 30, 30, 30, 30, 30, 30, 30, 30, 30, 30, 31, 31, 31, 31, 31, 31, 31, 31, 31, 31, 31, 31, 31, 31, 31};
#define XB_TMO      128
#define XB_XCNT(j)  (256  + 64 * (j))
#define XB_XSUB(j)  (1280 + 64 * (j))
#define XB_XGEN(j)  (2304 + 64 * (j))
#define XB_TOP      3328
#define XB_TOPGEN   3392
#define XCD_BAR_WORDS 3456
#define XB_SPIN_CAP (1u << 18)

__device__ __forceinline__ unsigned xb_ld(unsigned* p)              { return __hip_atomic_load(p, __ATOMIC_RELAXED, __HIP_MEMORY_SCOPE_AGENT); }
__device__ __forceinline__ unsigned xb_add(unsigned* p, unsigned v) { return __hip_atomic_fetch_add(p, v, __ATOMIC_RELAXED, __HIP_MEMORY_SCOPE_AGENT); }
__device__ __forceinline__ unsigned xb_xcc_id() { return (unsigned)__builtin_amdgcn_s_getreg((3 << 11) | 20) & 0xFu; }
#define XB_SPIN(cond, bar) do { unsigned _sp = 0; while (cond) { __builtin_amdgcn_s_sleep(1); \
    if ((++_sp & 255u) == 0u) { if (xb_ld(&(bar)[XB_TMO])) break; if (_sp > XB_SPIN_CAP) { atomicAdd(&(bar)[XB_TMO], 1u); break; } } } } while (0)

struct XcdBarrier {
    unsigned* bar; unsigned x;
    volatile LAS unsigned* st;
};

__device__ __forceinline__ XcdBarrier xcd_barrier_post(unsigned* bar, volatile LAS unsigned* st) {
    XcdBarrier b; b.bar = bar; b.x = xb_xcc_id(); b.st = st;
    if (threadIdx.x == 0) (void)xb_add(&bar[XB_XCNT(b.x)], 1u);
    return b;
}
__device__ __forceinline__ void xcd_barrier_complete(unsigned* bar, unsigned x, unsigned& nloc, unsigned& nx) {
    const unsigned G = gridDim.x * gridDim.y * gridDim.z;
    unsigned sum, cnt, mine, sp = 0u;
    for (;;) {
        sum = 0u; cnt = 0u; mine = 0u;
#pragma unroll
        for (unsigned j = 0; j < 16; ++j) { const unsigned c = xb_ld(&bar[XB_XCNT(j)]); sum += c; cnt += (c > 0u) ? 1u : 0u; mine = (j == x) ? c : mine; }
        if (sum == G) break;
        __builtin_amdgcn_s_sleep(1);
        if ((++sp & 255u) == 0u) { if (xb_ld(&bar[XB_TMO])) break; if (sp > XB_SPIN_CAP) { atomicAdd(&bar[XB_TMO], 1u); break; } }
    }
    nloc = mine > 0u ? mine : 1u; nx = cnt > 0u ? cnt : 1u;
}

__device__ __forceinline__ void xcd_barrier(const XcdBarrier& b) {
    asm volatile("s_waitcnt vmcnt(0)" ::: "memory");
    __syncthreads();
    if (threadIdx.x == 0) {
        unsigned* bar = b.bar;
        __builtin_amdgcn_s_waitcnt(0);
        unsigned nloc = b.st[0], nx = b.st[1];
        if (nloc == 0u) { xcd_barrier_complete(bar, b.x, nloc, nx); b.st[0] = nloc; b.st[1] = nx; }
        const unsigned old = xb_add(&bar[XB_XSUB(b.x)], 1u);
        const unsigned gen = old / nloc;
        if (old + 1u == (gen + 1u) * nloc) {
            __builtin_amdgcn_fence(__ATOMIC_RELEASE, "agent");
            asm volatile("s_waitcnt vmcnt(0)" ::: "memory");
            const unsigned og = xb_add(&bar[XB_TOP], 1u);
            const unsigned tg = og / nx;
            if (og + 1u == (tg + 1u) * nx) xb_add(&bar[XB_TOPGEN], 1u);
            else XB_SPIN(xb_ld(&bar[XB_TOPGEN]) == tg, bar);
            __builtin_amdgcn_fence(__ATOMIC_ACQUIRE, "agent");
            xb_add(&bar[XB_XGEN(b.x)], 1u);
            asm volatile("s_waitcnt vmcnt(0)" ::: "memory");
        } else {
            XB_SPIN(xb_ld(&bar[XB_XGEN(b.x)]) == gen, bar);
            __builtin_amdgcn_fence(__ATOMIC_ACQUIRE, "agent");
            asm volatile("s_waitcnt vmcnt(0)" ::: "memory");
        }
    }
    __syncthreads();
}
namespace pg8 {
struct EpiZ {
    static constexpr bool PERM = true, AFTER_DRAIN = false;
    bf16_t *Q, *KV, *GU, *GV, *GA, *GB;
    __device__ __forceinline__ void operator()(const f32x4 (&acc)[2][2][4][2], const Unit& u, int wr, int wc, int fr, int fq) const {
        const int pn = u.pn; bf16_t* base; int ldc, colt, act;
        if (pn < 2)       { base = Q;  ldc = 512;  colt = pn * 256;        act = 0; }
        else if (pn == 2) { base = KV; ldc = 256;  colt = 0;               act = 0; }
        else if (pn < 5)  { base = GU; ldc = 512;  colt = (pn - 3) * 256;  act = 1; }
        else if (pn < 7)  { base = GV; ldc = 512;  colt = (pn - 5) * 256;  act = 1; }
        else if (pn < 11) { base = GA; ldc = 1024; colt = (pn - 7) * 256;  act = 2; }
        else              { base = GB; ldc = 1024; colt = (pn - 11) * 256; act = 2; }
        const int row0 = u.pm * BM + wr * 64 + fr, col0 = colt + wc * 32 + 8 * fq;
#pragma unroll
        for (int ai = 0; ai < 2; ++ai)
#pragma unroll
            for (int m = 0; m < 4; ++m) { bf16_t* rowp = base + (size_t)(row0 + ai * HALF + m * 16) * ldc + col0;
#pragma unroll
                for (int bj = 0; bj < 2; ++bj) { f32x4 v0 = acc[ai][bj][m][0], v1 = acc[ai][bj][m][1];
                    if (act == 1) {
#pragma unroll
                        for (int e = 0; e < 4; ++e) { v0[e] = gelu_tanh(v0[e]); v1[e] = gelu_tanh(v1[e]); }
                    } else if (act == 2) {
#pragma unroll
                        for (int e = 0; e < 4; ++e) { v0[e] = sigmoid_f(v0[e]); v1[e] = sigmoid_f(v1[e]); }
                    }
                    u32x4 w; w.x = cvt_pk_bf16(v0[0], v0[1]); w.y = cvt_pk_bf16(v0[2], v0[3]); w.z = cvt_pk_bf16(v1[0], v1[1]); w.w = cvt_pk_bf16(v1[2], v1[3]);
                    *(u32x4*)(rowp + bj * HALF) = w; } }
    }
};
struct EpiGateTmp {
    static constexpr bool PERM = true, AFTER_DRAIN = false;
    const bf16_t* gate; float* tmp;
    __device__ __forceinline__ void operator()(const f32x4 (&acc)[2][2][4][2], const Unit& u, int wr, int wc, int fr, int fq) const {
        const int row0 = u.pm * BM + wr * 64 + fr, col0 = u.pn * BM + wc * 32 + 8 * fq;
#pragma unroll
        for (int ai = 0; ai < 2; ++ai)
#pragma unroll
            for (int m = 0; m < 4; ++m) { const size_t ro = (size_t)(row0 + ai * HALF + m * 16) * 1024 + col0;
#pragma unroll
                for (int bj = 0; bj < 2; ++bj) { const u32x4 g = *(const u32x4*)(gate + ro + bj * HALF); f32x4 v0 = acc[ai][bj][m][0], v1 = acc[ai][bj][m][1];
                    v0[0] *= bflo(g.x); v0[1] *= bfhi(g.x); v0[2] *= bflo(g.y); v0[3] *= bfhi(g.y); v1[0] *= bflo(g.z); v1[1] *= bfhi(g.z); v1[2] *= bflo(g.w); v1[3] *= bfhi(g.w);
                    *(f32x4*)(tmp + ro + bj * HALF) = v0; *(f32x4*)(tmp + ro + bj * HALF + 4) = v1; } }
    }
};
struct EpiMerge {
    static constexpr bool PERM = true, AFTER_DRAIN = false;
    const bf16_t* gate; const float* tmp; bf16_t* out;
    __device__ __forceinline__ void operator()(const f32x4 (&acc)[2][2][4][2], const Unit& u, int wr, int wc, int fr, int fq) const {
        const int row0 = u.pm * BM + wr * 64 + fr, col0 = u.pn * BM + wc * 32 + 8 * fq;
#pragma unroll
        for (int ai = 0; ai < 2; ++ai)
#pragma unroll
            for (int m = 0; m < 4; ++m) { const size_t ro = (size_t)(row0 + ai * HALF + m * 16) * 1024 + col0;
#pragma unroll
                for (int bj = 0; bj < 2; ++bj) { const u32x4 g = *(const u32x4*)(gate + ro + bj * HALF); f32x4 v0 = acc[ai][bj][m][0], v1 = acc[ai][bj][m][1];
                    const f32x4 t0 = *(const f32x4*)(tmp + ro + bj * HALF), t1 = *(const f32x4*)(tmp + ro + bj * HALF + 4);
                    v0[0] = t0[0] + v0[0] * bflo(g.x); v0[1] = t0[1] + v0[1] * bfhi(g.x); v0[2] = t0[2] + v0[2] * bflo(g.y); v0[3] = t0[3] + v0[3] * bfhi(g.y);
                    v1[0] = t1[0] + v1[0] * bflo(g.z); v1[1] = t1[1] + v1[1] * bfhi(g.z); v1[2] = t1[2] + v1[2] * bflo(g.w); v1[3] = t1[3] + v1[3] * bfhi(g.w);
                    u32x4 w; w.x = cvt_pk_bf16(v0[0], v0[1]); w.y = cvt_pk_bf16(v0[2], v0[3]); w.z = cvt_pk_bf16(v1[0], v1[1]); w.w = cvt_pk_bf16(v1[2], v1[3]);
                    *(u32x4*)(out + ro + bj * HALF) = w; } }
    }
};
struct EpiRes {
    static constexpr bool PERM = false, AFTER_DRAIN = false;
    const float* base; float* C;
    __device__ __forceinline__ void operator()(const f32x4 (&acc)[2][2][4][2], const Unit& u, int wr, int wc, int fr, int fq) const {
        const int row0 = u.pm * BM + wr * 64 + fr, col0 = u.pn * BM + wc * 32 + 4 * fq;
#pragma unroll
        for (int ai = 0; ai < 2; ++ai)
#pragma unroll
            for (int m = 0; m < 4; ++m) { const size_t ro = (size_t)(row0 + ai * HALF + m * 16) * 1024 + col0;
#pragma unroll
                for (int bj = 0; bj < 2; ++bj)
#pragma unroll
                    for (int n = 0; n < 2; ++n) *(f32x4*)(C + ro + bj * HALF + n * 16) = *(const f32x4*)(base + ro + bj * HALF + n * 16) + acc[ai][bj][m][n]; }
    }
};
struct EpiPlain {
    static constexpr bool PERM = true, AFTER_DRAIN = false;
    bf16_t* O; int ldc;
    __device__ __forceinline__ void operator()(const f32x4 (&acc)[2][2][4][2], const Unit& u, int wr, int wc, int fr, int fq) const {
        const int row0 = u.pm * BM + wr * 64 + fr, col0 = u.pn * BM + wc * 32 + 8 * fq;
#pragma unroll
        for (int ai = 0; ai < 2; ++ai)
#pragma unroll
            for (int m = 0; m < 4; ++m) { bf16_t* rowp = O + (size_t)(row0 + ai * HALF + m * 16) * ldc + col0;
#pragma unroll
                for (int bj = 0; bj < 2; ++bj) { const f32x4 v0 = acc[ai][bj][m][0], v1 = acc[ai][bj][m][1];
                    u32x4 w; w.x = cvt_pk_bf16(v0[0], v0[1]); w.y = cvt_pk_bf16(v0[2], v0[3]); w.z = cvt_pk_bf16(v1[0], v1[1]); w.w = cvt_pk_bf16(v1[2], v1[3]);
                    *(u32x4*)(rowp + bj * HALF) = w; } }
    }
};
}

__device__ __forceinline__ void p0_transpose_item(const float* W, int K, int N, bf16* WT, LAS float* scr, int item, int lane) {
    const int nblk = N / 32, kb = item / nblk, nb = item % nblk, k0 = 64 * kb, n0 = 32 * nb;
#pragma unroll 8
    for (int i = 0; i < 32; ++i) { const int kk = 2 * i + (lane >> 5); scr[kk * 33 + (lane & 31)] = W[(size_t)(k0 + kk) * N + n0 + (lane & 31)]; }
    LDS_WAIT(); asm volatile("" ::: "memory");
    const int c = lane & 7;
#pragma unroll
    for (int j = 0; j < 4; ++j) { const int n = (lane >> 3) + 8 * j; const LAS float* s = scr + (8 * c) * 33 + n;
        v4u o; o.x = pk2(s[0 * 33], s[1 * 33]); o.y = pk2(s[2 * 33], s[3 * 33]); o.z = pk2(s[4 * 33], s[5 * 33]); o.w = pk2(s[6 * 33], s[7 * 33]);
        *(v4u*)(WT + (size_t)(n0 + n) * K + k0 + 8 * c) = o; }
    LDS_WAIT(); asm volatile("" ::: "memory");
}
__device__ __forceinline__ void cvt_flat(const float* src, bf16* dst, size_t n, int gw, int NGW, int lane) {
    for (size_t i = (size_t)gw * 512 + lane * 8; i < n; i += (size_t)NGW * 512) {
        const f32x4 a = *(const f32x4*)(src + i), b = *(const f32x4*)(src + i + 4);
        v4u o; o.x = pk2(a[0], a[1]); o.y = pk2(a[2], a[3]); o.z = pk2(b[0], b[1]); o.w = pk2(b[2], b[3]);
        *(v4u*)(dst + i) = o;
    }
}
__device__ __forceinline__ void rms_row_to_bf16(const float* xrow, const float* w, bf16* orow, int lane) {
    const f32x4* xr = (const f32x4*)xrow + lane; const f32x4* wr = (const f32x4*)w + lane;
    f32x4 v[4]; float s = 0.f;
#pragma unroll
    for (int j = 0; j < 4; ++j) { v[j] = xr[64 * j]; s += (v[j][0] * v[j][0] + v[j][1] * v[j][1]) + (v[j][2] * v[j][2] + v[j][3] * v[j][3]); }
    const float rstd = 1.0f / sqrtf(wave_sum(s) * (1.0f / 1024.0f) + EPS);
    unsigned long long* o8 = (unsigned long long*)orow + lane;
#pragma unroll
    for (int j = 0; j < 4; ++j) { const f32x4 ww = wr[64 * j];
        o8[64 * j] = (unsigned long long)pk2(v[j][0] * rstd * ww[0], v[j][1] * rstd * ww[1]) | ((unsigned long long)pk2(v[j][2] * rstd * ww[2], v[j][3] * rstd * ww[3]) << 32); }
}

struct Ptrs {
    const float *x, *mix_w, *w_in, *rel_bias, *sinks, *w_pa, *ln_w, *ln_b, *w_s, *b_s, *w_pb, *w_out, *ffn_w, *w_q, *keys1, *keys2, *pu, *pv, *fin_w;
    float* out;
    unsigned char *U8, *V8; float *USC, *VSC;
    bf16 *WIN, *WPA, *WPB, *WOUT, *WQ, *K1, *K2, *WS, *U, *V, *XN, *AOUT, *BOUT, *HN2, *Q, *KV, *GU, *GV, *GA, *GB, *MERGED, *QP;
};

__device__ __forceinline__ void p0_prologue(LAS unsigned char* lds, const Ptrs& P, int vcu, int G, int lane, int wave) {
    LAS float* scr = (LAS float*)(lds + wave * 16384);
    const int gw = vcu * NWAVES + wave, NGW = G * NWAVES;
    constexpr int I_IN = (1024 / 64) * (3840 / 32), I_PA = (512 / 64) * (1024 / 32), I_OUT = (1024 / 64) * (1024 / 32), I_WQ = (1024 / 64) * (2048 / 32);
    constexpr int NITEMS = I_IN + 2 * I_PA + I_OUT + I_WQ;
    for (int it = gw; it < NITEMS; it += NGW) {
        int r = it;
        if (r < I_IN) { p0_transpose_item(P.w_in, 1024, 3840, P.WIN, scr, r, lane); continue; } r -= I_IN;
        if (r < I_PA) { p0_transpose_item(P.w_pa, 512, 1024, P.WPA, scr, r, lane); continue; } r -= I_PA;
        if (r < I_PA) { p0_transpose_item(P.w_pb, 512, 1024, P.WPB, scr, r, lane); continue; } r -= I_PA;
        if (r < I_OUT) { p0_transpose_item(P.w_out, 1024, 1024, P.WOUT, scr, r, lane); continue; } r -= I_OUT;
        p0_transpose_item(P.w_q, 1024, 2048, P.WQ, scr, r, lane);
    }
    cvt_flat(P.keys1, P.K1, 128 * 128, gw, NGW, lane);
    cvt_flat(P.keys2, P.K2, 128 * 128, gw, NGW, lane);
#if PEER_FP8
    for (int rr = gw; rr < 2 * 16384; rr += NGW) {
        const int tab = rr >> 14, row = rr & 16383;
        const float* src = (tab ? P.pv : P.pu) + (size_t)row * 1024; unsigned char* dst = (tab ? P.V8 : P.U8) + (size_t)row * 1024;
        f32x4 v[4]; float mx = 0.f;
#pragma unroll
        for (int j = 0; j < 4; ++j) { v[j] = *(const f32x4*)(src + 4 * lane + 256 * j); mx = fmaxf(mx, fmaxf(fmaxf(fabsf(v[j][0]), fabsf(v[j][1])), fmaxf(fabsf(v[j][2]), fabsf(v[j][3])))); }
#pragma unroll
        for (int o = 1; o < 64; o <<= 1) mx = fmaxf(mx, __shfl_xor(mx, o));
        const int ex = (int)((__builtin_bit_cast(unsigned, mx) >> 23) & 0xffu);
        const bool tiny = ex < 32;
        const float scale = tiny ? 1.0f : __builtin_bit_cast(float, (unsigned)(254 + 7 - ex) << 23);
        const float inv = tiny ? 1.0f : __builtin_bit_cast(float, (unsigned)(ex - 7) << 23);
#pragma unroll
        for (int j = 0; j < 4; ++j) { int p = __builtin_amdgcn_cvt_pk_fp8_f32(v[j][0] * scale, v[j][1] * scale, 0, false); p = __builtin_amdgcn_cvt_pk_fp8_f32(v[j][2] * scale, v[j][3] * scale, p, true);
            *(int*)(dst + 4 * lane + 256 * j) = p; }
        if (lane == 0) (tab ? P.VSC : P.USC)[row] = inv;
    }
#else
    cvt_flat(P.pu, P.U, (size_t)16384 * 1024, gw, NGW, lane);
    cvt_flat(P.pv, P.V, (size_t)16384 * 1024, gw, NGW, lane);
#endif
    for (size_t i = (size_t)gw * 512 + lane * 8; i < (size_t)8 * 128 * 128; i += (size_t)NGW * 512) {
        const int t = (int)((i >> 7) & 127), s0 = (int)(i & 127);
        const f32x4 a = *(const f32x4*)(P.w_s + i), b = *(const f32x4*)(P.w_s + i + 4);
        float e[8] = {a[0], a[1], a[2], a[3], b[0], b[1], b[2], b[3]};
#pragma unroll
        for (int j = 0; j < 8; ++j) e[j] = (s0 + j <= t) ? e[j] : 0.f;
        v4u o; o.x = pk2(e[0], e[1]); o.y = pk2(e[2], e[3]); o.z = pk2(e[4], e[5]); o.w = pk2(e[6], e[7]);
        *(v4u*)(P.WS + i) = o;
    }
    for (int m = gw; m < M; m += NGW) rms_row_to_bf16(P.x + (size_t)m * D, P.mix_w, P.XN + (size_t)m * D, lane);
}

__device__ __forceinline__ void p2_attn_naive(LAS unsigned char* lds, const Ptrs& P, int vcu, int G, int tid, int lane, int wave) {
    LAS float* biasl = (LAS float*)lds;
    for (int i = tid; i < 1024; i += 512) { const int d = i >> 3, h = i & 7; biasl[i] = P.rel_bias[(int)T5B[d] * 8 + h]; }
    __syncthreads();
    const int h = wave, kvh = h >> 2;
    const float sink = P.sinks[h];
    for (int unit = vcu; unit < M / 64; unit += G) {
        const int t = unit * 64 + lane, pos = t & (SEQ - 1);
        float q[64], o[64];
        { const v4u* qp = (const v4u*)(P.Q + (size_t)t * 512 + h * 64);
#pragma unroll
          for (int c = 0; c < 8; ++c) { const v4u w = qp[c]; q[8 * c + 0] = bflo(w.x) * 0.125f; q[8 * c + 1] = bfhi(w.x) * 0.125f; q[8 * c + 2] = bflo(w.y) * 0.125f; q[8 * c + 3] = bfhi(w.y) * 0.125f;
              q[8 * c + 4] = bflo(w.z) * 0.125f; q[8 * c + 5] = bfhi(w.z) * 0.125f; q[8 * c + 6] = bflo(w.w) * 0.125f; q[8 * c + 7] = bfhi(w.w) * 0.125f; } }
#pragma unroll
        for (int i = 0; i < 64; ++i) o[i] = 0.f;
        float m = sink, l = 1.f;
        for (int d = 0; d < 128; ++d) {
            const bool valid = (pos - d) >= 0;
            const int tj = valid ? (t - d) : t;
            const v4u* kp = (const v4u*)(P.KV + (size_t)tj * 256 + kvh * 64);
            float dot = 0.f;
#pragma unroll
            for (int c = 0; c < 8; ++c) { const v4u w = kp[c];
                dot += q[8 * c + 0] * bflo(w.x) + q[8 * c + 1] * bfhi(w.x) + q[8 * c + 2] * bflo(w.y) + q[8 * c + 3] * bfhi(w.y) + q[8 * c + 4] * bflo(w.z) + q[8 * c + 5] * bfhi(w.z) + q[8 * c + 6] * bflo(w.w) + q[8 * c + 7] * bfhi(w.w); }
            const float s = valid ? dot + biasl[d * 8 + h] : -1e30f;
            const float mn = fmaxf(m, s), alpha = __expf(m - mn), p = __expf(s - mn);
            l = l * alpha + p; m = mn;
            const v4u* vp = kp + 16;
#pragma unroll
            for (int c = 0; c < 8; ++c) { const v4u w = vp[c];
                o[8 * c + 0] = o[8 * c + 0] * alpha + p * bflo(w.x); o[8 * c + 1] = o[8 * c + 1] * alpha + p * bfhi(w.x); o[8 * c + 2] = o[8 * c + 2] * alpha + p * bflo(w.y); o[8 * c + 3] = o[8 * c + 3] * alpha + p * bfhi(w.y);
                o[8 * c + 4] = o[8 * c + 4] * alpha + p * bflo(w.z); o[8 * c + 5] = o[8 * c + 5] * alpha + p * bfhi(w.z); o[8 * c + 6] = o[8 * c + 6] * alpha + p * bflo(w.w); o[8 * c + 7] = o[8 * c + 7] * alpha + p * bfhi(w.w); }
        }
        const float inv = 1.0f / l;
        v4u* op = (v4u*)(P.AOUT + (size_t)t * 512 + h * 64);
#pragma unroll
        for (int c = 0; c < 8; ++c) { v4u w; w.x = pk2(o[8 * c + 0] * inv, o[8 * c + 1] * inv); w.y = pk2(o[8 * c + 2] * inv, o[8 * c + 3] * inv); w.z = pk2(o[8 * c + 4] * inv, o[8 * c + 5] * inv); w.w = pk2(o[8 * c + 6] * inv, o[8 * c + 7] * inv); op[c] = w; }
    }
    __syncthreads();
}

__device__ __forceinline__ void p2_gmlp_naive(LAS unsigned char* lds, const Ptrs& P, int vcu, int G, int tid, int lane, int wave) {
    LAS bf16* vnl = (LAS bf16*)(lds + 8192);
    for (int unit = vcu; unit < 256; unit += G) {
        const int c = unit >> 1, hh = unit & 1;
        for (int i = 0; i < 16; ++i) {
            const int tt = wave * 16 + i; const size_t row = (size_t)c * 128 + tt;
            const v4u w = *((const v4u*)(P.GV + row * 512) + lane);
            float x[8] = {bflo(w.x), bfhi(w.x), bflo(w.y), bfhi(w.y), bflo(w.z), bfhi(w.z), bflo(w.w), bfhi(w.w)};
            float s = 0.f;
#pragma unroll
            for (int j = 0; j < 8; ++j) s += x[j];
            const float mean = wave_sum(s) * (1.0f / 512.0f);
            float ss = 0.f;
#pragma unroll
            for (int j = 0; j < 8; ++j) { x[j] -= mean; ss += x[j] * x[j]; }
            const float rstd = 1.0f / sqrtf(wave_sum(ss) * (1.0f / 512.0f) + EPS);
            if ((lane >> 5) == hh) {
                const f32x4 w0 = *(const f32x4*)(P.ln_w + lane * 8), w1 = *(const f32x4*)(P.ln_w + lane * 8 + 4), b0 = *(const f32x4*)(P.ln_b + lane * 8), b1 = *(const f32x4*)(P.ln_b + lane * 8 + 4);
                v4u o; o.x = pk2(x[0] * rstd * w0[0] + b0[0], x[1] * rstd * w0[1] + b0[1]); o.y = pk2(x[2] * rstd * w0[2] + b0[2], x[3] * rstd * w0[3] + b0[3]);
                o.z = pk2(x[4] * rstd * w1[0] + b1[0], x[5] * rstd * w1[1] + b1[1]); o.w = pk2(x[6] * rstd * w1[2] + b1[2], x[7] * rstd * w1[3] + b1[3]);
                *(LAS v4u*)(vnl + tt * 256 + (lane & 31) * 8) = o;
            }
        }
        __syncthreads();
        const int ch = tid & 255, th = tid >> 8, g = hh * 4 + (ch >> 6);
        for (int t = th * 64; t < th * 64 + 64; ++t) {
            const v4u* wrow = (const v4u*)(P.WS + ((size_t)g * 128 + t) * 128);
            float acc = 0.f;
            for (int s8 = 0; s8 <= (t >> 3); ++s8) {
                const v4u w = wrow[s8];
                const LAS bf16* vp = vnl + (s8 * 8) * 256 + ch;
                acc += bflo(w.x) * bf2f(vp[0]) + bfhi(w.x) * bf2f(vp[256]) + bflo(w.y) * bf2f(vp[512]) + bfhi(w.y) * bf2f(vp[768])
                     + bflo(w.z) * bf2f(vp[1024]) + bfhi(w.z) * bf2f(vp[1280]) + bflo(w.w) * bf2f(vp[1536]) + bfhi(w.w) * bf2f(vp[1792]);
            }
            const size_t row = (size_t)c * 128 + t;
            const float uval = bf2f(P.GU[row * 512 + hh * 256 + ch]);
            P.BOUT[row * 512 + hh * 256 + ch] = (bf16)f2bf(uval * (acc + P.b_s[g * 128 + t]));
        }
        __syncthreads();
    }
}

typedef short s16x8 __attribute__((ext_vector_type(8)));
typedef short s16x4 __attribute__((ext_vector_type(4)));
typedef float f32x16 __attribute__((ext_vector_type(16)));
typedef float f32x2v __attribute__((ext_vector_type(2)));
#define MFMA32(a, b, c) __builtin_amdgcn_mfma_f32_32x32x16_bf16((a), (b), (c), 0, 0, 0)
__device__ __forceinline__ s16x4 tr16(const LAS unsigned char* p) { return __builtin_bit_cast(s16x4, __builtin_amdgcn_ds_read_tr16_b64_v4i16((LAS s16x4*)p)); }
__device__ __forceinline__ unsigned cvtpk(float lo, float hi) { f32x2v v = {lo, hi}; bf16x2_t b = __builtin_convertvector(v, bf16x2_t); return __builtin_bit_cast(unsigned, b); }
__device__ __forceinline__ int crow(int reg, int h) { return (reg & 3) + 8 * (reg >> 2) + 4 * h; }
constexpr float LOG2E = 1.4426950408889634f;

__device__ __forceinline__ void p2_attn_mfma(LAS unsigned char* lds, const Ptrs& P, int vcu, int G, int tid, int lane, int wave) {
    LAS unsigned char* Kl = lds;
    LAS unsigned char* Vl = lds + 32768;
    LAS float* biasl = (LAS float*)(lds + 32768 + 49152);
    const int r = lane & 31, h = lane >> 5, i16 = lane & 15, q4 = i16 >> 2, p4 = i16 & 3, blk = (lane >> 4) & 1;
    for (int unit = vcu; unit < 256; unit += G) {
        const int kvh = unit & 1, blkid = unit >> 1, nb = blkid & 63; const int tok0 = blkid * 128;
#pragma unroll
        for (int i = 0; i < 4; ++i) {
            const int cidx = tid + 512 * i, row = cidx >> 3, c = cidx & 7;
            v4u kw = {0u, 0u, 0u, 0u}, vw = {0u, 0u, 0u, 0u};
            if (nb > 0 || row >= 128) { const bf16* src = P.KV + (size_t)(tok0 - 128 + row) * 256 + kvh * 64 + c * 8; kw = *(const v4u*)src; vw = *(const v4u*)(src + 128); }
            *(LAS v4u*)(Kl + row * 128 + ((c ^ ((row >> 1) & 7)) << 4)) = kw;
            *(LAS v4u*)(Vl + row * 192 + c * 16) = vw;
        }
        biasl[tid] = P.rel_bias[(int)T5B[tid & 127] * 8 + kvh * 4 + (tid >> 7)] * LOG2E;
        __syncthreads();
        const int g = wave >> 1, qh = wave & 1, hq = kvh * 4 + g;
        const float sink2 = P.sinks[hq] * LOG2E;
#pragma unroll 1
        for (int qs = 0; qs < 2; ++qs) {
            const int qi0 = 64 * qh + 32 * qs, kt0 = 2 * qh + qs;
            s16x8 qf[4];
            { const bf16* qrow = P.Q + (size_t)(tok0 + qi0 + r) * 512 + hq * 64 + 8 * h;
#pragma unroll
              for (int ks = 0; ks < 4; ++ks) qf[ks] = *(const s16x8*)(qrow + 16 * ks); }
            f32x16 s[5];
#pragma unroll
            for (int i = 0; i < 5; ++i) {
#pragma unroll
                for (int e = 0; e < 16; ++e) s[i][e] = 0.f;
                const int key = 32 * (kt0 + i) + r; const LAS unsigned char* kp = Kl + key * 128; const int sw = (key >> 1) & 7;
#pragma unroll
                for (int ks = 0; ks < 4; ++ks) { const s16x8 kf = *(const LAS s16x8*)(kp + (((2 * ks + h) ^ sw) << 4)); s[i] = MFMA32(kf, qf[ks], s[i]); }
            }
            const int qi = qi0 + r;
            float mx = sink2;
#pragma unroll
            for (int i = 0; i < 5; ++i)
#pragma unroll
                for (int e = 0; e < 16; ++e) {
                    const int kj = 32 * (kt0 + i) + crow(e, h), dist = 128 + qi - kj;
                    const bool valid = (dist >= 0) && (dist < 128) && (nb > 0 || kj >= 128);
                    const float b = biasl[g * 128 + (dist & 127)];
                    const float v = valid ? s[i][e] * (0.125f * LOG2E) + b : -1e30f;
                    s[i][e] = v; mx = fmaxf(mx, v);
                }
            mx = fmaxf(mx, __shfl_xor(mx, 32));
            float l = 0.f;
#pragma unroll
            for (int i = 0; i < 5; ++i)
#pragma unroll
                for (int e = 0; e < 16; ++e) { const float p = __builtin_amdgcn_exp2f(s[i][e] - mx); s[i][e] = p; l += p; }
            l += __shfl_xor(l, 32);
            l += __builtin_amdgcn_exp2f(sink2 - mx);
            f32x16 o0, o1;
#pragma unroll
            for (int e = 0; e < 16; ++e) { o0[e] = 0.f; o1[e] = 0.f; }
#pragma unroll
            for (int i = 0; i < 5; ++i)
#pragma unroll
                for (int st = 0; st < 2; ++st) {
                    v4u pw; pw.x = cvtpk(s[i][8 * st], s[i][8 * st + 1]); pw.y = cvtpk(s[i][8 * st + 2], s[i][8 * st + 3]); pw.z = cvtpk(s[i][8 * st + 4], s[i][8 * st + 5]); pw.w = cvtpk(s[i][8 * st + 6], s[i][8 * st + 7]);
                    const s16x8 pf = __builtin_bit_cast(s16x8, pw);
                    const LAS unsigned char* vb = Vl + (32 * (kt0 + i) + 16 * st + 4 * h + q4) * 192 + 32 * blk + 8 * p4;
                    { const s16x4 lo = tr16(vb), hi = tr16(vb + 8 * 192); const s16x8 vf = __builtin_shufflevector(lo, hi, 0, 1, 2, 3, 4, 5, 6, 7); o0 = MFMA32(vf, pf, o0); }
                    { const s16x4 lo = tr16(vb + 64), hi = tr16(vb + 64 + 8 * 192); const s16x8 vf = __builtin_shufflevector(lo, hi, 0, 1, 2, 3, 4, 5, 6, 7); o1 = MFMA32(vf, pf, o1); }
                }
            const float inv = 1.0f / l;
            bf16* orow = P.AOUT + (size_t)(tok0 + qi) * 512 + hq * 64 + 4 * h;
#pragma unroll
            for (int r4 = 0; r4 < 4; ++r4) {
                v2u w0; w0.x = cvtpk(o0[4 * r4] * inv, o0[4 * r4 + 1] * inv); w0.y = cvtpk(o0[4 * r4 + 2] * inv, o0[4 * r4 + 3] * inv); *(v2u*)(orow + 8 * r4) = w0;
                v2u w1; w1.x = cvtpk(o1[4 * r4] * inv, o1[4 * r4 + 1] * inv); w1.y = cvtpk(o1[4 * r4 + 2] * inv, o1[4 * r4 + 3] * inv); *(v2u*)(orow + 32 + 8 * r4) = w1;
            }
        }
        __syncthreads();
    }
}

__device__ __forceinline__ void p2_gmlp_mfma(LAS unsigned char* lds, const Ptrs& P, int vcu, int G, int tid, int lane, int wave) {
    LAS unsigned char* vnl = lds;
    const int r = lane & 31, h = lane >> 5, i16 = lane & 15, q4 = i16 >> 2, p4 = i16 & 3, blk = (lane >> 4) & 1;
    for (int unit = vcu; unit < 256; unit += G) {
        const int c = unit >> 1, hh = unit & 1;
        for (int i = 0; i < 16; ++i) {
            const int tt = wave * 16 + i; const size_t row = (size_t)c * 128 + tt;
            const v4u w = *((const v4u*)(P.GV + row * 512) + lane);
            float x[8] = {bflo(w.x), bfhi(w.x), bflo(w.y), bfhi(w.y), bflo(w.z), bfhi(w.z), bflo(w.w), bfhi(w.w)};
            float s = 0.f;
#pragma unroll
            for (int j = 0; j < 8; ++j) s += x[j];
            const float mean = wave_sum(s) * (1.0f / 512.0f);
            float ss = 0.f;
#pragma unroll
            for (int j = 0; j < 8; ++j) { x[j] -= mean; ss += x[j] * x[j]; }
            const float rstd = 1.0f / sqrtf(wave_sum(ss) * (1.0f / 512.0f) + EPS);
            if ((lane >> 5) == hh) {
                const f32x4 w0 = *(const f32x4*)(P.ln_w + lane * 8), w1 = *(const f32x4*)(P.ln_w + lane * 8 + 4), b0 = *(const f32x4*)(P.ln_b + lane * 8), b1 = *(const f32x4*)(P.ln_b + lane * 8 + 4);
                v4u o; o.x = pk2(x[0] * rstd * w0[0] + b0[0], x[1] * rstd * w0[1] + b0[1]); o.y = pk2(x[2] * rstd * w0[2] + b0[2], x[3] * rstd * w0[3] + b0[3]);
                o.z = pk2(x[4] * rstd * w1[0] + b1[0], x[5] * rstd * w1[1] + b1[1]); o.w = pk2(x[6] * rstd * w1[2] + b1[2], x[7] * rstd * w1[3] + b1[3]);
                *(LAS v4u*)(vnl + tt * 576 + (lane & 31) * 16) = o;
            }
        }
        __syncthreads();
        const int gi = wave >> 1, dblk = wave & 1, g = hh * 4 + gi;
        s16x8 af[8];
#pragma unroll
        for (int ks = 0; ks < 8; ++ks) { const LAS unsigned char* vb = vnl + (16 * ks + 8 * h + q4) * 576 + (gi * 64 + dblk * 32 + 16 * blk) * 2 + 8 * p4;
            const s16x4 lo = tr16(vb), hi = tr16(vb + 4 * 576); af[ks] = __builtin_shufflevector(lo, hi, 0, 1, 2, 3, 4, 5, 6, 7); }
#pragma unroll
        for (int tt = 0; tt < 4; ++tt) {
            f32x16 acc;
#pragma unroll
            for (int e = 0; e < 16; ++e) acc[e] = 0.f;
            const bf16* wrow = P.WS + ((size_t)g * 128 + 32 * tt + r) * 128 + 8 * h;
#pragma unroll
            for (int ks = 0; ks < 2 * (tt + 1); ++ks) acc = MFMA32(af[ks], *(const s16x8*)(wrow + 16 * ks), acc);
            const int t = 32 * tt + r; const size_t row = (size_t)c * 128 + t; const float b = P.b_s[g * 128 + t];
#pragma unroll
            for (int r4 = 0; r4 < 4; ++r4) {
                const int ch = g * 64 + dblk * 32 + 8 * r4 + 4 * h;
                const v2u uw = *(const v2u*)(P.GU + row * 512 + ch);
                v2u ow; ow.x = cvtpk(bflo(uw.x) * (acc[4 * r4] + b), bfhi(uw.x) * (acc[4 * r4 + 1] + b)); ow.y = cvtpk(bflo(uw.y) * (acc[4 * r4 + 2] + b), bfhi(uw.y) * (acc[4 * r4 + 3] + b));
                *(v2u*)(P.BOUT + row * 512 + ch) = ow;
            }
        }
        __syncthreads();
    }
}

__device__ __forceinline__ void topk_half(const bf16* q, const LAS bf16* kl, float (&v)[16]) {
    v4u qv[16];
#pragma unroll
    for (int c = 0; c < 16; ++c) qv[c] = ((const v4u*)q)[c];
#pragma unroll
    for (int i = 0; i < 16; ++i) v[i] = -INFINITY;
    for (int n = 0; n < 128; ++n) {
        const LAS v4u* kr = (const LAS v4u*)(kl + n * 128);
        float a0 = 0.f, a1 = 0.f, a2 = 0.f, a3 = 0.f;
#pragma unroll
        for (int c = 0; c < 16; ++c) { const v4u kk = kr[c]; a0 = dot2bf(qv[c].x, kk.x, a0); a1 = dot2bf(qv[c].y, kk.y, a1); a2 = dot2bf(qv[c].z, kk.z, a2); a3 = dot2bf(qv[c].w, kk.w, a3); }
        const float acc = (a0 + a1) + (a2 + a3);
        float x = __builtin_bit_cast(float, (__builtin_bit_cast(unsigned, acc) & ~0x7Fu) | (unsigned)n);
#pragma unroll
        for (int i = 0; i < 16; ++i) { const float hi = fmaxf(v[i], x); x = fminf(v[i], x); v[i] = hi; }
    }
}

__device__ __forceinline__ void peer_topk_unit(const Ptrs& P, const LAS bf16* k1l, const LAS bf16* k2l, LAS int* idxl, LAS float* gatel, int unit, int tid) {
    const int tl = tid >> 3, h = tid & 7;
    const bf16* qrow = P.QP + (size_t)(unit * 64 + tl) * 2048 + h * 256;
    float v1[16], v2[16];
    topk_half(qrow, k1l, v1);
    topk_half(qrow + 128, k2l, v2);
    float tv[16]; int tp[16];
#pragma unroll
    for (int k = 0; k < 16; ++k) { tv[k] = -INFINITY; tp[k] = 0; }
#pragma unroll
    for (int i = 0; i < 16; ++i)
#pragma unroll
        for (int j = 0; j < 16; ++j)
            if ((i + 1) * (j + 1) <= 16) {
                const unsigned b1 = __builtin_bit_cast(unsigned, v1[i]), b2 = __builtin_bit_cast(unsigned, v2[j]);
                float x = __builtin_bit_cast(float, b1 & ~0x7Fu) + __builtin_bit_cast(float, b2 & ~0x7Fu);
                int px = (int)((b1 & 0x7Fu) * 128u + (b2 & 0x7Fu));
#pragma unroll
                for (int k = 0; k < 16; ++k) { const bool c = x > tv[k]; const float nv = c ? x : tv[k], nx = c ? tv[k] : x; const int np = c ? px : tp[k], npx = c ? tp[k] : px; tv[k] = nv; x = nx; tp[k] = np; px = npx; }
            }
    float e[16], es = 0.f;
#pragma unroll
    for (int k = 0; k < 16; ++k) { e[k] = __expf(tv[k] - tv[0]); es += e[k]; }
    const float inv = 1.0f / es;
    LAS v4u* ip = (LAS v4u*)(idxl + tl * 128 + h * 16); LAS f32x4* gp = (LAS f32x4*)(gatel + tl * 128 + h * 16);
#pragma unroll
    for (int k = 0; k < 4; ++k) { v4u iv; iv.x = (unsigned)tp[4 * k]; iv.y = (unsigned)tp[4 * k + 1]; iv.z = (unsigned)tp[4 * k + 2]; iv.w = (unsigned)tp[4 * k + 3]; ip[k] = iv;
        f32x4 gv; gv[0] = e[4 * k] * inv; gv[1] = e[4 * k + 1] * inv; gv[2] = e[4 * k + 2] * inv; gv[3] = e[4 * k + 3] * inv; gp[k] = gv; }
}

#if PEER_FP8
typedef float f32x2p __attribute__((ext_vector_type(2)));
__device__ __forceinline__ unsigned fp8lo_bf16(unsigned w) { return __builtin_bit_cast(unsigned, __builtin_amdgcn_cvt_scalef32_pk_bf16_fp8((int)w, 1.0f, false)); }
__device__ __forceinline__ unsigned fp8hi_bf16(unsigned w) { return __builtin_bit_cast(unsigned, __builtin_amdgcn_cvt_scalef32_pk_bf16_fp8((int)w, 1.0f, true)); }
template <bool STORE> __device__ __forceinline__ void peer_gather_token(const Ptrs& P, const LAS int* idxl, const LAS float* gatel, LAS float* al, int tl, size_t t, int lane, int wave) {
    const int sub = lane & 15, grp = lane >> 4;
    v4u hnr[4][2];
#pragma unroll
    for (int j = 0; j < 4; ++j) { const v4u* hp = (const v4u*)(P.HN2 + t * 1024 + (j * 16 + sub) * 16); hnr[j][0] = hp[0]; hnr[j][1] = hp[1]; }
    const LAS int* myidx = idxl + tl * 128;
    v4u w[4][4]; float sc[4];
#define ULOAD(B, Q) do { const int row_ = myidx[4 * (Q) + grp]; const v4u* up_ = (const v4u*)(P.U8 + (size_t)row_ * 1024) + sub; \
        _Pragma("unroll") for (int j = 0; j < 4; ++j) w[B][j] = up_[j * 16]; sc[B] = P.USC[row_]; } while (0)
#define UCOMP(B, Q) do { float a0 = 0.f, a1 = 0.f, a2 = 0.f, a3 = 0.f; \
        _Pragma("unroll") for (int j = 0; j < 4; ++j) { const v4u x_ = w[B][j]; \
            a0 = dot2bf(fp8lo_bf16(x_.x), hnr[j][0].x, a0); a1 = dot2bf(fp8hi_bf16(x_.x), hnr[j][0].y, a1); a2 = dot2bf(fp8lo_bf16(x_.y), hnr[j][0].z, a2); a3 = dot2bf(fp8hi_bf16(x_.y), hnr[j][0].w, a3); \
            a0 = dot2bf(fp8lo_bf16(x_.z), hnr[j][1].x, a0); a1 = dot2bf(fp8hi_bf16(x_.z), hnr[j][1].y, a1); a2 = dot2bf(fp8lo_bf16(x_.w), hnr[j][1].z, a2); a3 = dot2bf(fp8hi_bf16(x_.w), hnr[j][1].w, a3); } \
        float acc_ = (a0 + a1) + (a2 + a3); acc_ += __shfl_xor(acc_, 8); acc_ += __shfl_xor(acc_, 4); acc_ += __shfl_xor(acc_, 2); acc_ += __shfl_xor(acc_, 1); \
        if (sub == 0) al[wave * 128 + 4 * (Q) + grp] = acc_ * sc[B]; } while (0)
    ULOAD(0, 0); ULOAD(1, 1); ULOAD(2, 2);
#pragma unroll 1
    for (int q = 0; q < 32; q += 4) {
        ULOAD(3, q + 3); UCOMP(0, q);
        if (q + 4 < 32) ULOAD(0, q + 4);
        UCOMP(1, q + 1);
        if (q + 4 < 32) ULOAD(1, q + 5);
        UCOMP(2, q + 2);
        if (q + 4 < 32) ULOAD(2, q + 6);
        UCOMP(3, q + 3);
    }
#undef ULOAD
#undef UCOMP
    LDS_WAIT();
    const int ix0 = myidx[lane], ix1 = myidx[64 + lane];
    const float av0 = al[wave * 128 + lane], av1 = al[wave * 128 + 64 + lane];
    const float act0 = gelu_tanh(av0) * gatel[tl * 128 + lane] * P.VSC[ix0], act1 = gelu_tanh(av1) * gatel[tl * 128 + 64 + lane] * P.VSC[ix1];
    LDS_WAIT();
    float y[16];
#pragma unroll
    for (int k = 0; k < 16; ++k) y[k] = 0.f;
    v4u vb[2][8];
#define VLOAD(B, IX, E0) do { _Pragma("unroll") for (int k = 0; k < 8; ++k) { const int row_ = __builtin_amdgcn_readlane(IX, (E0) + k); vb[B][k] = *((const v4u*)(P.V8 + (size_t)row_ * 1024) + lane); } } while (0)
#define VCOMP(B, ACT, E0) do { _Pragma("unroll") for (int k = 0; k < 8; ++k) { const float a_ = __builtin_bit_cast(float, __builtin_amdgcn_readlane(__builtin_bit_cast(int, ACT), (E0) + k)); const v4u x_ = vb[B][k]; \
        f32x2p d_; d_ = __builtin_amdgcn_cvt_pk_f32_fp8((int)x_.x, false); y[0] += a_ * d_[0]; y[1] += a_ * d_[1]; d_ = __builtin_amdgcn_cvt_pk_f32_fp8((int)x_.x, true); y[2] += a_ * d_[0]; y[3] += a_ * d_[1]; \
        d_ = __builtin_amdgcn_cvt_pk_f32_fp8((int)x_.y, false); y[4] += a_ * d_[0]; y[5] += a_ * d_[1]; d_ = __builtin_amdgcn_cvt_pk_f32_fp8((int)x_.y, true); y[6] += a_ * d_[0]; y[7] += a_ * d_[1]; \
        d_ = __builtin_amdgcn_cvt_pk_f32_fp8((int)x_.z, false); y[8] += a_ * d_[0]; y[9] += a_ * d_[1]; d_ = __builtin_amdgcn_cvt_pk_f32_fp8((int)x_.z, true); y[10] += a_ * d_[0]; y[11] += a_ * d_[1]; \
        d_ = __builtin_amdgcn_cvt_pk_f32_fp8((int)x_.w, false); y[12] += a_ * d_[0]; y[13] += a_ * d_[1]; d_ = __builtin_amdgcn_cvt_pk_f32_fp8((int)x_.w, true); y[14] += a_ * d_[0]; y[15] += a_ * d_[1]; } } while (0)
    VLOAD(0, ix0, 0);
#pragma unroll 1
    for (int e = 0; e < 64; e += 16) { VLOAD(1, ix0, e + 8); VCOMP(0, act0, e); if (e + 16 < 64) VLOAD(0, ix0, e + 16); else VLOAD(0, ix1, 0); VCOMP(1, act0, e + 8); }
#pragma unroll 1
    for (int e = 0; e < 64; e += 16) { VLOAD(1, ix1, e + 8); VCOMP(0, act1, e); if (e + 16 < 64) VLOAD(0, ix1, e + 16); VCOMP(1, act1, e + 8); }
#undef VLOAD
#undef VCOMP
    float* xr = P.out + t * 1024 + lane * 16;
    f32x4 x[4];
#pragma unroll
    for (int k = 0; k < 4; ++k) { x[k] = *(const f32x4*)(xr + 4 * k); x[k][0] += y[4 * k]; x[k][1] += y[4 * k + 1]; x[k][2] += y[4 * k + 2]; x[k][3] += y[4 * k + 3]; }
    float ss = 0.f;
#pragma unroll
    for (int k = 0; k < 4; ++k) ss += (x[k][0] * x[k][0] + x[k][1] * x[k][1]) + (x[k][2] * x[k][2] + x[k][3] * x[k][3]);
    const float rstd = 1.0f / sqrtf(wave_sum(ss) * (1.0f / 1024.0f) + EPS);
    if (STORE) {
#pragma unroll
        for (int k = 0; k < 4; ++k) { const f32x4 wv = *(const f32x4*)(P.fin_w + lane * 16 + 4 * k); *(f32x4*)(xr + 4 * k) = x[k] * rstd * wv; }
    } else { asm volatile("" :: "v"(rstd), "v"(x[0][0]), "v"(x[1][1]), "v"(x[2][2]), "v"(x[3][3])); }
}
#else
template <bool STORE> __device__ __forceinline__ void peer_gather_token(const Ptrs& P, const LAS int* idxl, const LAS float* gatel, LAS float* al, int tl, size_t t, int lane, int wave) {
    const int sub = lane & 15, grp = lane >> 4;
    v4u hnr[8];
#pragma unroll
    for (int j = 0; j < 8; ++j) hnr[j] = *((const v4u*)(P.HN2 + t * 1024) + j * 16 + sub);
    for (int q = 0; q < 32; ++q) {
        const int row = idxl[tl * 128 + 4 * q + grp];
        const v4u* up = (const v4u*)(P.U + (size_t)row * 1024) + sub;
        float a0 = 0.f, a1 = 0.f, a2 = 0.f, a3 = 0.f;
#pragma unroll
        for (int j = 0; j < 8; ++j) { const v4u w = up[j * 16]; a0 = dot2bf(w.x, hnr[j].x, a0); a1 = dot2bf(w.y, hnr[j].y, a1); a2 = dot2bf(w.z, hnr[j].z, a2); a3 = dot2bf(w.w, hnr[j].w, a3); }
        float acc = (a0 + a1) + (a2 + a3);
        acc += __shfl_xor(acc, 8); acc += __shfl_xor(acc, 4); acc += __shfl_xor(acc, 2); acc += __shfl_xor(acc, 1);
        if (sub == 0) al[wave * 128 + 4 * q + grp] = acc;
    }
    LDS_WAIT();
    const float av0 = al[wave * 128 + lane], av1 = al[wave * 128 + 64 + lane];
    const float act0 = gelu_tanh(av0) * gatel[tl * 128 + lane], act1 = gelu_tanh(av1) * gatel[tl * 128 + 64 + lane];
    const int ix0 = idxl[tl * 128 + lane], ix1 = idxl[tl * 128 + 64 + lane];
    LDS_WAIT();
    float y[16];
#pragma unroll
    for (int k = 0; k < 16; ++k) y[k] = 0.f;
#pragma unroll 4
    for (int e = 0; e < 64; ++e) {
        const int row = __builtin_amdgcn_readlane(ix0, e); const float a = __builtin_bit_cast(float, __builtin_amdgcn_readlane(__builtin_bit_cast(int, act0), e));
        const v4u* vp = (const v4u*)(P.V + (size_t)row * 1024) + lane; const v4u w0 = vp[0], w1 = vp[64];
        y[0] += a * bflo(w0.x); y[1] += a * bfhi(w0.x); y[2] += a * bflo(w0.y); y[3] += a * bfhi(w0.y); y[4] += a * bflo(w0.z); y[5] += a * bfhi(w0.z); y[6] += a * bflo(w0.w); y[7] += a * bfhi(w0.w);
        y[8] += a * bflo(w1.x); y[9] += a * bfhi(w1.x); y[10] += a * bflo(w1.y); y[11] += a * bfhi(w1.y); y[12] += a * bflo(w1.z); y[13] += a * bfhi(w1.z); y[14] += a * bflo(w1.w); y[15] += a * bfhi(w1.w);
    }
#pragma unroll 4
    for (int e = 0; e < 64; ++e) {
        const int row = __builtin_amdgcn_readlane(ix1, e); const float a = __builtin_bit_cast(float, __builtin_amdgcn_readlane(__builtin_bit_cast(int, act1), e));
        const v4u* vp = (const v4u*)(P.V + (size_t)row * 1024) + lane; const v4u w0 = vp[0], w1 = vp[64];
        y[0] += a * bflo(w0.x); y[1] += a * bfhi(w0.x); y[2] += a * bflo(w0.y); y[3] += a * bfhi(w0.y); y[4] += a * bflo(w0.z); y[5] += a * bfhi(w0.z); y[6] += a * bflo(w0.w); y[7] += a * bfhi(w0.w);
        y[8] += a * bflo(w1.x); y[9] += a * bfhi(w1.x); y[10] += a * bflo(w1.y); y[11] += a * bfhi(w1.y); y[12] += a * bflo(w1.z); y[13] += a * bfhi(w1.z); y[14] += a * bflo(w1.w); y[15] += a * bfhi(w1.w);
    }
    float* xr = P.out + t * 1024;
    f32x4 x0 = *(const f32x4*)(xr + lane * 8), x1 = *(const f32x4*)(xr + lane * 8 + 4), x2 = *(const f32x4*)(xr + 512 + lane * 8), x3 = *(const f32x4*)(xr + 512 + lane * 8 + 4);
    x0[0] += y[0]; x0[1] += y[1]; x0[2] += y[2]; x0[3] += y[3]; x1[0] += y[4]; x1[1] += y[5]; x1[2] += y[6]; x1[3] += y[7];
    x2[0] += y[8]; x2[1] += y[9]; x2[2] += y[10]; x2[3] += y[11]; x3[0] += y[12]; x3[1] += y[13]; x3[2] += y[14]; x3[3] += y[15];
    float ss = 0.f;
#pragma unroll
    for (int k = 0; k < 4; ++k) ss += x0[k] * x0[k] + x1[k] * x1[k] + x2[k] * x2[k] + x3[k] * x3[k];
    const float rstd = 1.0f / sqrtf(wave_sum(ss) * (1.0f / 1024.0f) + EPS);
    if (STORE) {
        const f32x4 w0 = *(const f32x4*)(P.fin_w + lane * 8), w1 = *(const f32x4*)(P.fin_w + lane * 8 + 4), w2 = *(const f32x4*)(P.fin_w + 512 + lane * 8), w3 = *(const f32x4*)(P.fin_w + 512 + lane * 8 + 4);
        *(f32x4*)(xr + lane * 8) = x0 * rstd * w0; *(f32x4*)(xr + lane * 8 + 4) = x1 * rstd * w1; *(f32x4*)(xr + 512 + lane * 8) = x2 * rstd * w2; *(f32x4*)(xr + 512 + lane * 8 + 4) = x3 * rstd * w3;
    } else { asm volatile("" :: "v"(rstd), "v"(x0[0]), "v"(x1[1]), "v"(x2[2]), "v"(x3[3])); }
}
#endif

__device__ __forceinline__ void p7_peer(LAS unsigned char* lds, const Ptrs& P, int vcu, int G, int tid, int lane, int wave) {
    LAS bf16* k1l = (LAS bf16*)lds;
    LAS bf16* k2l = (LAS bf16*)(lds + 32768);
    LAS int* idxl = (LAS int*)(lds + 65536);
    LAS float* gatel = (LAS float*)(lds + 98304);
    LAS float* al = (LAS float*)(lds + 131072);
    for (int i = tid; i < 2048; i += 512) { ((LAS v4u*)k1l)[i] = ((const v4u*)P.K1)[i]; ((LAS v4u*)k2l)[i] = ((const v4u*)P.K2)[i]; }
    __syncthreads();
    for (int unit = vcu; unit < M / 64; unit += G) {
        peer_topk_unit(P, k1l, k2l, idxl, gatel, unit, tid);
#if PROBE_TOPK_REPS > 1
        __syncthreads(); peer_topk_unit(P, k1l, k2l, idxl, gatel, unit, tid);
#endif
        __syncthreads();
#if PROBE_GATHER_REPS > 1
#pragma unroll 1
        for (int i = 0; i < 8; ++i) peer_gather_token<false>(P, idxl, gatel, al, wave * 8 + i, (size_t)unit * 64 + wave * 8 + i, lane, wave);
#endif
#pragma unroll 1
        for (int i = 0; i < 8; ++i) peer_gather_token<true>(P, idxl, gatel, al, wave * 8 + i, (size_t)unit * 64 + wave * 8 + i, lane, wave);
        __syncthreads();
    }
}

struct Args { const float* in[19]; float* out; unsigned char* ws; int ph_lo, ph_hi; };
__global__ void __launch_bounds__(NWAVES * 64, 2) mega_fwd(Args args) {
    extern __shared__ __attribute__((aligned(16))) unsigned char lds_raw[];
    LAS unsigned char* lds = (LAS unsigned char*)lds_raw;
    const int tid = threadIdx.x, lane = tid & 63, wave = __builtin_amdgcn_readfirstlane(tid >> 6);
    const int G = gridDim.x; const int bx = blockIdx.x; const int vcu = (G % 8 == 0) ? (bx % 8) * (G / 8) + bx / 8 : bx;
    unsigned char* ws = args.ws;
    Ptrs P;
    P.x = args.in[0]; P.mix_w = args.in[1]; P.w_in = args.in[2]; P.rel_bias = args.in[3]; P.sinks = args.in[4]; P.w_pa = args.in[5]; P.ln_w = args.in[6]; P.ln_b = args.in[7];
    P.w_s = args.in[8]; P.b_s = args.in[9]; P.w_pb = args.in[10]; P.w_out = args.in[11]; P.ffn_w = args.in[12]; P.w_q = args.in[13]; P.keys1 = args.in[14]; P.keys2 = args.in[15];
    P.pu = args.in[16]; P.pv = args.in[17]; P.fin_w = args.in[18]; P.out = args.out;
    P.WIN = (bf16*)(ws + WS_WIN); P.WPA = (bf16*)(ws + WS_WPA); P.WPB = (bf16*)(ws + WS_WPB); P.WOUT = (bf16*)(ws + WS_WOUT); P.WQ = (bf16*)(ws + WS_WQ);
    P.K1 = (bf16*)(ws + WS_K1); P.K2 = (bf16*)(ws + WS_K2); P.WS = (bf16*)(ws + WS_WS); P.U = (bf16*)(ws + WS_U); P.V = (bf16*)(ws + WS_V);
    P.U8 = ws + WS_U; P.V8 = ws + WS_U + 16 * MiB; P.USC = (float*)(ws + WS_V); P.VSC = (float*)(ws + WS_V + 65536);
    P.XN = (bf16*)(ws + WS_R1); P.AOUT = (bf16*)(ws + WS_R1); P.BOUT = (bf16*)(ws + WS_R1 + 16 * MiB); P.HN2 = (bf16*)(ws + WS_R1);
    P.Q = (bf16*)(ws + WS_Q); P.KV = (bf16*)(ws + WS_KV); P.GU = (bf16*)(ws + WS_GU); P.GV = (bf16*)(ws + WS_GV); P.GA = (bf16*)(ws + WS_GA); P.GB = (bf16*)(ws + WS_GB);
    P.MERGED = (bf16*)(ws + WS_MERGED); P.QP = (bf16*)(ws + WS_QP);

    for (int u = tid; u < (LDS_BYTES - MISC_OFF) / 4; u += NWAVES * 64) ((LAS unsigned*)(lds + MISC_OFF))[u] = 0u;
    __syncthreads();
    const int lo = args.ph_lo, hi = args.ph_hi;
    unsigned* barw = (unsigned*)(ws + WS_CTL) + CW_BAR;
    XcdBarrier bar; bar.bar = barw; bar.x = 0; bar.st = nullptr;
    if (hi - lo > 1) bar = xcd_barrier_post(barw, (volatile LAS unsigned*)(lds + MISC_OFF));
#define IN(k) (lo <= (k) && (k) < hi)
#define BOTH(k) (IN(k) && IN((k) + 1))
#define GRID_BAR() xcd_barrier(bar)

    if (IN(0)) { p0_prologue(lds, P, vcu, G, lane, wave); if (BOTH(0)) GRID_BAR(); }

    if (IN(1)) {
        pg8::Gemm g{P.XN, P.WIN, M, NZ, D}; pg8::StaticOrder S; S.init(M, NZ, G, bx);
        pg8::EpiZ E{P.Q, P.KV, P.GU, P.GV, P.GA, P.GB};
        pg8::gemm_phase<pg8::EpiZ, pg8::StaticOrder, PG8_ALIGN, PG8_SP2>(lds, g, S, E);
        if (BOTH(1)) GRID_BAR();
    }

    if (IN(2)) {
        for (int rep = 0; rep < PROBE_P2_REPS; ++rep) {
#if ATTN_MFMA
        p2_attn_mfma(lds, P, vcu, G, tid, lane, wave);
#else
        p2_attn_naive(lds, P, vcu, G, tid, lane, wave);
#endif
#if GMLP_MFMA
        p2_gmlp_mfma(lds, P, vcu, G, tid, lane, wave);
#else
        p2_gmlp_naive(lds, P, vcu, G, tid, lane, wave);
#endif
        }
        if (BOTH(2)) GRID_BAR();
    }

    if (IN(3)) {
        { pg8::Gemm g{P.AOUT, P.WPA, M, D, 512}; pg8::StaticOrder S; S.init(M, D, G, bx);
          pg8::EpiGateTmp E{P.GA, P.out};
          pg8::gemm_phase<pg8::EpiGateTmp, pg8::StaticOrder, PG8_ALIGN, PG8_SP2>(lds, g, S, E); }
        { pg8::Gemm g{P.BOUT, P.WPB, M, D, 512}; pg8::StaticOrder S; S.init(M, D, G, bx);
          pg8::EpiMerge E{P.GB, P.out, P.MERGED};
          pg8::gemm_phase<pg8::EpiMerge, pg8::StaticOrder, PG8_ALIGN, PG8_SP2>(lds, g, S, E); }
        if (BOTH(3)) GRID_BAR();
    }

    if (IN(4)) {
        pg8::Gemm g{P.MERGED, P.WOUT, M, D, D}; pg8::StaticOrder S; S.init(M, D, G, bx);
        pg8::EpiRes E{P.x, P.out};
        pg8::gemm_phase<pg8::EpiRes, pg8::StaticOrder, PG8_ALIGN, PG8_SP2>(lds, g, S, E);
        if (BOTH(4)) GRID_BAR();
    }

    if (IN(5)) {
        const int gw = vcu * NWAVES + wave, NGW = G * NWAVES;
        for (int m = gw; m < M; m += NGW) rms_row_to_bf16(P.out + (size_t)m * D, P.ffn_w, P.HN2 + (size_t)m * D, lane);
        if (BOTH(5)) GRID_BAR();
    }

    if (IN(6)) {
        pg8::Gemm g{P.HN2, P.WQ, M, 2048, D}; pg8::StaticOrder S; S.init(M, 2048, G, bx);
        pg8::EpiPlain E{P.QP, 2048};
        pg8::gemm_phase<pg8::EpiPlain, pg8::StaticOrder, PG8_ALIGN, PG8_SP2>(lds, g, S, E);
        if (BOTH(6)) GRID_BAR();
    }

    if (IN(7)) p7_peer(lds, P, vcu, G, tid, lane, wave);
#undef IN
#undef BOTH
#undef GRID_BAR
}

extern "C" void kernel_launch(void* const* d_in, const int* in_sizes, int n_in, void* d_out, int out_size, void* d_ws, size_t ws_size, hipStream_t stream) {
    static int grid = 0;
    if (grid == 0) {
        if (n_in != 19 || out_size != M * D || ws_size < WS_END) { fprintf(stderr, "kernel_launch: unexpected shapes (n_in %d, out %d, ws %zu)\n", n_in, out_size, ws_size); grid = -1; return; }
        int dev = 0, cus = 0, per_cu = 0;
        if (hipGetDevice(&dev) != hipSuccess || hipDeviceGetAttribute(&cus, hipDeviceAttributeMultiprocessorCount, dev) != hipSuccess) { grid = -1; return; }
        if (hipFuncSetAttribute((const void*)mega_fwd, hipFuncAttributeMaxDynamicSharedMemorySize, LDS_BYTES) != hipSuccess) { fprintf(stderr, "kernel_launch: hipFuncSetAttribute failed\n"); grid = -1; return; }
        if (hipOccupancyMaxActiveBlocksPerMultiprocessor(&per_cu, (const void*)mega_fwd, NWAVES * 64, LDS_BYTES) != hipSuccess || per_cu < 1)
            fprintf(stderr, "kernel_launch: note: occupancy query reports %d workgroups per CU\n", per_cu);
        (void)hipGetLastError();
        grid = cus;
    }
    if (grid < 0) return;
    if (hipMemsetAsync((char*)d_ws + WS_CTL, 0, CTL_ZERO_BYTES, stream) != hipSuccess) return;
    Args a{};
    for (int i = 0; i < 19; ++i) a.in[i] = (const float*)d_in[i];
    a.out = (float*)d_out; a.ws = (unsigned char*)d_ws;
#if MK_N_LAUNCHES == 1
    a.ph_lo = 0; a.ph_hi = N_PHASES;
    hipLaunchKernelGGL(mega_fwd, dim3(grid), dim3(NWAVES * 64), LDS_BYTES, stream, a);
#else
    for (int li = 0; li < N_PHASES; ++li) { a.ph_lo = li; a.ph_hi = li + 1; hipLaunchKernelGGL(mega_fwd, dim3(grid), dim3(NWAVES * 64), LDS_BYTES, stream, a); }
#endif
}
```

```cpp
#include <hip/hip_runtime.h>
#include <cstdio>
#include <cstdint>
namespace pg8 {
#define PG8_LAS __attribute__((address_space(3)))
typedef unsigned short bf16_t;
typedef short bf16x8 __attribute__((ext_vector_type(8)));
typedef float f32x4 __attribute__((ext_vector_type(4)));
typedef unsigned u32x4 __attribute__((ext_vector_type(4)));
constexpr int BM = 256, BK = 64, HALF = 128, HTB = HALF * BK * 2  , STAGE_BYTES = 8 * HTB, NXCD = 8, WGM = 8;

__host__ __device__ __forceinline__ int lds_byte(int r, int c) { const int st = (r >> 4) * 2 + (c >> 5), rr = r & 15, cc = c & 31, ob = rr * 64 + cc * 2; return st * 1024 + (ob ^ (((ob >> 9) & 1) << 5)); }
__host__ __device__ __forceinline__ void stage_rc(int b, int& R, int& C) { const int st = b / 1024, sb = b % 1024, swz = sb ^ (((sb >> 9) & 1) << 5); R = (st >> 1) * 16 + swz / 64; C = (st & 1) * 32 + (swz % 64) / 2; }
__host__ __device__ __forceinline__ int perm32(int rho) { const int n = rho >> 4, i = rho & 15; return 8 * (i >> 2) + 4 * n + (i & 3); }

struct Unit { int pm, pn; };
struct Gemm { const bf16_t* A; const bf16_t* Bt; int M, N, K; };

struct StaticOrder {
    int nM, nN, nwg, G, c;
    __host__ __device__ void init(int M, int N, int G_, int c_) { nM = M / BM; nN = N / BM; nwg = nM * nN; G = G_; c = c_; }
    __host__ __device__ bool next(int i, Unit& u) const {
        const long L = (long)i * G + c; if (L >= nwg) return false;
        int wgid = (int)L; { const int q = nwg / NXCD, r = nwg % NXCD, xcd = wgid % NXCD, off = wgid / NXCD; wgid = (xcd < r ? xcd * (q + 1) : r * (q + 1) + (xcd - r) * q) + off; }
        const int nig = WGM * nN, gid = wgid / nig, fm = gid * WGM, gsz = (nM - fm) < WGM ? (nM - fm) : WGM;
        u.pm = fm + ((wgid % nig) % gsz); u.pn = (wgid % nig) / gsz; return true;
    }
    __device__ __forceinline__ void a_ready(const Unit&) const {}
    __device__ __forceinline__ void done(const Unit&) const {}
};

__device__ __forceinline__ unsigned cvt_pk_bf16(float lo, float hi) { unsigned r; asm volatile("v_cvt_pk_bf16_f32 %0, %1, %2" : "=v"(r) : "v"(lo), "v"(hi)); return r; }
typedef float f32x2 __attribute__((ext_vector_type(2)));
template <class Epi, class Sched, bool ALIGN_EPI = false, bool SP2 = false>
__device__ __forceinline__ void gemm_phase(PG8_LAS unsigned char* lds, const Gemm g, const Sched& S, const Epi& E) {
    const int tid = threadIdx.x, wid = __builtin_amdgcn_readfirstlane(tid >> 6), lane = tid & 63, wr = wid >> 2, wc = wid & 3, fr = lane & 15, fq = lane >> 4;
    const int K = g.K, nt = K / BK;
    unsigned voffA[2], voffB[2];
#pragma unroll
    for (int i = 0; i < 2; ++i) { int R, C; stage_rc(tid * 16 + i * 8192, R, C); const int Rb = Epi::PERM ? ((R & ~31) + perm32(R & 31)) : R;
        voffA[i] = (unsigned)(R * K + C) * 2u; voffB[i] = (unsigned)(Rb * K + C) * 2u; }
    const size_t kstep = (size_t)(BK * 2);
    const size_t hstep = (size_t)HALF * K * 2;
    const size_t tstep = 2 * hstep;
    const unsigned ldsw = (unsigned)wid * 1024u;
    const int aoff = lds_byte(wr * 64 + fr, fq * 8), boff = lds_byte(wc * 32 + fr, fq * 8);
#define PG8_SA(b, h) (((b) * 2 + (h)) * HTB)
#define PG8_SB(b, h) ((4 + (b) * 2 + (h)) * HTB)
#define PG8_STAGE(bufoff, gbase, voff) do { _Pragma("unroll") for (int _i = 0; _i < 2; ++_i) \
        __builtin_amdgcn_global_load_lds((const unsigned*)((const char*)(gbase) + (voff)[_i]), (PG8_LAS unsigned*)(lds + (bufoff) + ldsw + _i * 8192), 16, 0, 0); } while (0)
#define PG8_LDA(dst, b, h) do { _Pragma("unroll") for (int m = 0; m < 4; ++m) _Pragma("unroll") for (int k = 0; k < 2; ++k) dst[m][k] = *(const PG8_LAS bf16x8*)(lds + PG8_SA(b, h) + aoff + m * 2048 + k * 1024); } while (0)
#define PG8_LDB(dst, b, h) do { _Pragma("unroll") for (int n = 0; n < 2; ++n) _Pragma("unroll") for (int k = 0; k < 2; ++k) dst[n][k] = *(const PG8_LAS bf16x8*)(lds + PG8_SB(b, h) + boff + n * 2048 + k * 1024); } while (0)
#define PG8_MMA(ai, bj, At, Bt) do { __builtin_amdgcn_s_setprio(1); _Pragma("unroll") for (int m = 0; m < 4; ++m) _Pragma("unroll") for (int n = 0; n < 2; ++n) _Pragma("unroll") for (int k = 0; k < 2; ++k) \
        acc[ai][bj][m][n] = __builtin_amdgcn_mfma_f32_16x16x32_bf16(Bt[n][k], At[m][k], acc[ai][bj][m][n], 0, 0, 0); __builtin_amdgcn_s_setprio(0); } while (0)
#define PG8_WAIT_V(n) asm volatile("s_waitcnt vmcnt(" #n ")" ::: "memory")
#define PG8_WAIT_L(n) asm volatile("s_waitcnt lgkmcnt(" #n ")" ::: "memory")
#define PG8_BAR __builtin_amdgcn_s_barrier()
#define PG8_SCHED __builtin_amdgcn_sched_barrier(0)
    Unit cur, nxt; int ui = 0;
    if (!S.next(0, cur)) return;
    f32x4 acc[2][2][4][2];
#pragma unroll
    for (int a = 0; a < 2; ++a)
#pragma unroll
        for (int b = 0; b < 2; ++b)
#pragma unroll
            for (int m = 0; m < 4; ++m)
#pragma unroll
                for (int n = 0; n < 2; ++n) acc[a][b][m][n] = (f32x4){0.f, 0.f, 0.f, 0.f};
    bf16x8 At[4][2], B0[2][2], B1[2][2];
    const char* cA = (const char*)g.A + (size_t)cur.pm * tstep; const char* cB = (const char*)g.Bt + (size_t)cur.pn * tstep;
    S.a_ready(cur);
    if constexpr (SP2) {
        PG8_STAGE(PG8_SB(0, 0), cB, voffB); PG8_STAGE(PG8_SB(0, 1), cB + hstep, voffB); PG8_STAGE(PG8_SA(0, 0), cA, voffA); PG8_STAGE(PG8_SA(0, 1), cA + hstep, voffA);
        if (wr == 1) PG8_BAR;
        PG8_WAIT_V(2); PG8_BAR;
        PG8_STAGE(PG8_SB(1, 0), cB + kstep, voffB); PG8_STAGE(PG8_SA(1, 0), cA + kstep, voffA); PG8_STAGE(PG8_SB(1, 1), cB + hstep + kstep, voffB);
        PG8_WAIT_V(6); PG8_BAR;
    } else {
        PG8_STAGE(PG8_SB(0, 0), cB, voffB); PG8_STAGE(PG8_SA(0, 0), cA, voffA); PG8_STAGE(PG8_SB(0, 1), cB + hstep, voffB); PG8_STAGE(PG8_SA(0, 1), cA + hstep, voffA);
        if (wr == 1) PG8_BAR;
        PG8_WAIT_V(4); PG8_BAR;
        PG8_STAGE(PG8_SB(1, 0), cB + kstep, voffB); PG8_STAGE(PG8_SA(1, 0), cA + kstep, voffA); PG8_STAGE(PG8_SB(1, 1), cB + hstep + kstep, voffB);
        PG8_WAIT_V(6); PG8_BAR;
    }
    for (;;) {
        const bool has_next = S.next(ui + 1, nxt);
        const char* nA = has_next ? (const char*)g.A + (size_t)nxt.pm * tstep : cA; const char* nB = has_next ? (const char*)g.Bt + (size_t)nxt.pn * tstep : cB;
        for (int t = 0; t < nt; t += 2) {
            const bool last = (t == nt - 2);
            const char* a1 = cA + (size_t)(t + 1) * kstep;
            const char* a2 = last ? nA : cA + (size_t)(t + 2) * kstep; const char* b2 = last ? nB : cB + (size_t)(t + 2) * kstep;
            const char* a3 = a2 + kstep; const char* b3 = b2 + kstep;
            if (last && has_next) S.a_ready(nxt);
            if constexpr (SP2) {
            PG8_LDB(B0, 0, 0); PG8_LDB(B1, 0, 1); PG8_SCHED; PG8_LDA(At, 0, 0); PG8_STAGE(PG8_SA(1, 1), a1 + hstep, voffA);
            PG8_WAIT_V(8); PG8_WAIT_L(0); PG8_BAR; PG8_MMA(0, 0, At, B0); PG8_MMA(0, 1, At, B1); PG8_BAR; PG8_SCHED;
            PG8_LDA(At, 0, 1); PG8_STAGE(PG8_SB(0, 0), b2, voffB); PG8_STAGE(PG8_SB(0, 1), b2 + hstep, voffB); PG8_STAGE(PG8_SA(0, 0), a2, voffA);
            PG8_WAIT_V(8); PG8_WAIT_L(0); PG8_BAR; PG8_MMA(1, 0, At, B0); PG8_MMA(1, 1, At, B1); PG8_BAR; PG8_SCHED;
            PG8_LDB(B0, 1, 0); PG8_LDB(B1, 1, 1); PG8_SCHED; PG8_LDA(At, 1, 0); PG8_STAGE(PG8_SA(0, 1), a2 + hstep, voffA);
            PG8_WAIT_V(8); PG8_WAIT_L(0); PG8_BAR; PG8_MMA(0, 0, At, B0); PG8_MMA(0, 1, At, B1); PG8_BAR; PG8_SCHED;
            PG8_LDA(At, 1, 1); PG8_STAGE(PG8_SB(1, 0), b3, voffB); PG8_STAGE(PG8_SB(1, 1), b3 + hstep, voffB); PG8_STAGE(PG8_SA(1, 0), a3, voffA);
            PG8_WAIT_V(8); PG8_WAIT_L(0); PG8_BAR; PG8_MMA(1, 0, At, B0); PG8_MMA(1, 1, At, B1); PG8_BAR; PG8_SCHED;
            } else {
            PG8_LDB(B0, 0, 0); PG8_SCHED; PG8_LDA(At, 0, 0); PG8_STAGE(PG8_SA(1, 1), a1 + hstep, voffA);
            PG8_WAIT_L(8); PG8_BAR; PG8_WAIT_L(0); PG8_MMA(0, 0, At, B0); PG8_BAR; PG8_SCHED;
            PG8_LDB(B1, 0, 1); PG8_STAGE(PG8_SB(0, 0), b2, voffB);
            PG8_BAR; PG8_WAIT_L(0); PG8_MMA(0, 1, At, B1); PG8_BAR;
            PG8_LDA(At, 0, 1); PG8_STAGE(PG8_SA(0, 0), a2, voffA);
            PG8_BAR; PG8_WAIT_L(0); PG8_MMA(1, 0, At, B0); PG8_BAR; PG8_SCHED;
            PG8_STAGE(PG8_SB(0, 1), b2 + hstep, voffB);
            PG8_WAIT_V(6); PG8_BAR; PG8_MMA(1, 1, At, B1); PG8_BAR;
            PG8_LDB(B0, 1, 0); PG8_SCHED; PG8_LDA(At, 1, 0); PG8_STAGE(PG8_SA(0, 1), a2 + hstep, voffA);
            PG8_WAIT_L(8); PG8_BAR; PG8_WAIT_L(0); PG8_MMA(0, 0, At, B0); PG8_BAR; PG8_SCHED;
            PG8_LDB(B1, 1, 1); PG8_STAGE(PG8_SB(1, 0), b3, voffB);
            PG8_BAR; PG8_WAIT_L(0); PG8_MMA(0, 1, At, B1); PG8_BAR;
            PG8_LDA(At, 1, 1); PG8_STAGE(PG8_SA(1, 0), a3, voffA);
            PG8_BAR; PG8_WAIT_L(0); PG8_MMA(1, 0, At, B0); PG8_BAR; PG8_SCHED;
            PG8_STAGE(PG8_SB(1, 1), b3 + hstep, voffB);
            PG8_WAIT_V(6); PG8_BAR; PG8_MMA(1, 1, At, B1); PG8_BAR;
            }
        }
        if constexpr (ALIGN_EPI) { if (wr == 0) PG8_BAR; }
        if constexpr (!Epi::AFTER_DRAIN) { E(acc, cur, wr, wc, fr, fq); S.done(cur); }
        if (!has_next) break;
#pragma unroll
        for (int a = 0; a < 2; ++a)
#pragma unroll
            for (int b = 0; b < 2; ++b)
#pragma unroll
                for (int m = 0; m < 4; ++m)
#pragma unroll
                    for (int n = 0; n < 2; ++n) acc[a][b][m][n] = (f32x4){0.f, 0.f, 0.f, 0.f};
        cur = nxt; cA = nA; cB = nB; ++ui;
        if constexpr (ALIGN_EPI) { if (wr == 1) PG8_BAR; }
    }
    PG8_WAIT_V(0);
    if constexpr (!ALIGN_EPI) { if (wr == 0) PG8_BAR; }
    PG8_BAR;
    if constexpr (Epi::AFTER_DRAIN) { E.fused(acc, cur, wr, wc, fr, fq, lds, wid, lane); S.done(cur); }
#undef PG8_SA
#undef PG8_SB
#undef PG8_STAGE
#undef PG8_LDA
#undef PG8_LDB
#undef PG8_MMA
#undef PG8_WAIT_V
#undef PG8_WAIT_L
#undef PG8_BAR
#undef PG8_SCHED
}
}
#ifndef PG8_SP2
#define PG8_SP2 true
#endif
#ifndef PG8_ALIGN
#define PG8_ALIGN true
#endif

constexpr int NWAVES = 8;
#ifndef MK_N_LAUNCHES
#define MK_N_LAUNCHES 1
#endif
constexpr int N_PHASES = 8;
#ifndef ATTN_MFMA
#define ATTN_MFMA 1
#endif
#ifndef GMLP_MFMA
#define GMLP_MFMA 1
#endif
#ifndef TOPK_DBG_GATES_ONLY
#define TOPK_DBG_GATES_ONLY 0
#endif
#ifndef DBG_SHFL_WAVESUM
#define DBG_SHFL_WAVESUM 0
#endif
#ifndef TOPK_DBG_COMPARE
#define TOPK_DBG_COMPARE 0
#endif
#ifndef TOPK_DBG_SEL
#define TOPK_DBG_SEL 0
#endif
#ifndef TOPK_DBG_K0
#define TOPK_DBG_K0 0
#endif
#ifndef TOPK_DBG_K1
#define TOPK_DBG_K1 16
#endif
#ifndef TOPK_DBG_BRUTE
#define TOPK_DBG_BRUTE 0
#endif
#ifndef TOPK_DBG_INSERT
#define TOPK_DBG_INSERT 0
#endif
#ifndef TOPK_DBG_VALU_SCORES
#define TOPK_DBG_VALU_SCORES 0
#endif
#ifndef KEY_SWZ
#define KEY_SWZ (!TOPK_DBG_GATES_ONLY && !TOPK_DBG_VALU_SCORES && !TOPK_DBG_COMPARE && !TOPK_DBG_BRUTE && TOPK_DBG_INSERT != 3)
#endif
#ifndef TOPK_MFMA
#define TOPK_MFMA 1
#endif
#ifndef PEER_FP8
#define PEER_FP8 1
#endif
#ifndef PROBE_GATHER_REPS
#define PROBE_GATHER_REPS 1
#endif
#ifndef PROBE_TOPK_REPS
#define PROBE_TOPK_REPS 1
#endif
#ifndef PROBE_P2_REPS
#define PROBE_P2_REPS 1
#endif

constexpr int NB = 2, SEQ = 8192, D = 1024, M = NB * SEQ;
constexpr int NZ = 3840;
constexpr float EPS = 1e-6f;

constexpr size_t MiB = 1u << 20;
constexpr size_t WS_CTL = 0, CTL_ZERO_BYTES = 65536;
constexpr size_t WS_WIN = 1 * MiB;
constexpr size_t WS_WPA = 9 * MiB;
constexpr size_t WS_WPB = 10 * MiB;
constexpr size_t WS_WOUT = 11 * MiB;
constexpr size_t WS_WQ = 13 * MiB;
constexpr size_t WS_K1 = 17 * MiB;
constexpr size_t WS_K2 = 17 * MiB + 32768;
constexpr size_t WS_WS = 17 * MiB + 65536;
constexpr size_t WS_U = 18 * MiB;
constexpr size_t WS_V = 50 * MiB;
constexpr size_t WS_R1 = 82 * MiB;
constexpr size_t WS_Q = 114 * MiB;
constexpr size_t WS_KV = 130 * MiB;
constexpr size_t WS_GU = 138 * MiB;
constexpr size_t WS_GV = 154 * MiB;
constexpr size_t WS_GA = 170 * MiB;
constexpr size_t WS_GB = 202 * MiB;
constexpr size_t WS_MERGED = 114 * MiB;
constexpr size_t WS_QP = 170 * MiB;
constexpr size_t WS_END = 234 * MiB;
constexpr int CW_BAR = 0;

constexpr int RING_BYTES = 131072;
constexpr int MISC_OFF = 143360;
constexpr int LDS_BYTES = 147456;

#define GAS __attribute__((address_space(1)))
#define LAS __attribute__((address_space(3)))
typedef unsigned short bf16;
typedef unsigned v4u __attribute__((ext_vector_type(4)));
typedef unsigned v2u __attribute__((ext_vector_type(2)));
typedef float f32x4 __attribute__((ext_vector_type(4)));
typedef GAS unsigned gu32;
typedef __bf16 bf16x2_t __attribute__((ext_vector_type(2)));
#define RLX_AGENT __ATOMIC_RELAXED, __HIP_MEMORY_SCOPE_AGENT
#define LDS_WAIT() asm volatile("s_waitcnt lgkmcnt(0)" ::: "memory")
#define VM_WAIT() asm volatile("s_waitcnt vmcnt(0)" ::: "memory")
__device__ __forceinline__ unsigned f2bf(float f) { unsigned u = __builtin_bit_cast(unsigned, f); return (u + 0x7fffu + ((u >> 16) & 1u)) >> 16; }
__device__ __forceinline__ unsigned pk2(float lo, float hi) { return f2bf(lo) | (f2bf(hi) << 16); }
__device__ __forceinline__ float bflo(unsigned w) { return __builtin_bit_cast(float, w << 16); }
__device__ __forceinline__ float bfhi(unsigned w) { return __builtin_bit_cast(float, w & 0xffff0000u); }
__device__ __forceinline__ float bf2f(bf16 h) { return __builtin_bit_cast(float, (unsigned)h << 16); }
__device__ __forceinline__ float dot2bf(unsigned a, unsigned b, float c) { return __builtin_amdgcn_fdot2_f32_bf16(__builtin_bit_cast(bf16x2_t, a), __builtin_bit_cast(bf16x2_t, b), c, false); }
__device__ __forceinline__ float gelu_tanh(float v) {
    const float t2 = v * (-2.302208198f + (-0.1029432397f) * v * v);
    return v * __builtin_amdgcn_rcpf(1.0f + __builtin_amdgcn_exp2f(t2));
}
__device__ __forceinline__ float sigmoid_f(float v) { return __builtin_amdgcn_rcpf(1.0f + __builtin_amdgcn_exp2f(-1.4426950409f * v)); }
template <int CTRL> __device__ __forceinline__ float dppmov(float v) { return __builtin_bit_cast(float, __builtin_amdgcn_update_dpp(0, __builtin_bit_cast(int, v), CTRL, 0xF, 0xF, false)); }
__device__ __forceinline__ float row16_sum(float v) {
    v += dppmov<0xB1>(v);
    v += dppmov<0x4E>(v);
    v += dppmov<0x141>(v);
    v += dppmov<0x140>(v);
    return v;
}
__device__ __forceinline__ float xor32_f(float v) {
    const unsigned u = __builtin_bit_cast(unsigned, v);
    auto rr = __builtin_amdgcn_permlane32_swap(u, u, false, false);
    const unsigned r0 = rr[0], r1 = rr[1];
    return __builtin_bit_cast(float, (__lane_id() & 32) ? r0 : r1);
}
__device__ __forceinline__ float wave_sum(float v) {
#if DBG_SHFL_WAVESUM
#pragma unroll
    for (int o = 1; o < 64; o <<= 1) v += __shfl_xor(v, o);
    return v;
#endif
    v = row16_sum(v);
    v += __builtin_bit_cast(float, __builtin_amdgcn_ds_swizzle(__builtin_bit_cast(int, v), 0x401F));
    const unsigned u = __builtin_bit_cast(unsigned, v);
    auto rr = __builtin_amdgcn_permlane32_swap(u, u, false, false);
    const unsigned r0 = rr[0], r1 = rr[1];
    return __builtin_bit_cast(float, r0) + __builtin_bit_cast(float, r1);
}
__device__ const unsigned char T5B[128] = {0, 1, 2, 3, 4, 5, 6, 7, 8, 9, 10, 11, 12, 13, 14, 15, 16, 16, 16, 17, 17, 18, 18, 18, 19, 19, 19, 20, 20, 20, 20, 21, 21, 21, 21, 22, 22, 22, 22, 22, 23, 23, 23, 23, 23, 23, 24, 24, 24, 24, 24, 24, 25, 25, 25, 25, 25, 25, 25, 26, 26, 26, 26, 26, 26, 26, 26, 27, 27, 27, 27, 27, 27, 27, 27, 27, 27, 28, 28, 28, 28, 28, 28, 28, 28, 28, 28, 29, 29, 29, 29, 29, 29, 29, 29, 29, 29, 29, 29, 30, 30, 30, 30, 30, 30, 30, 30, 30, 30, 30, 30, 30, 30, 31, 31, 31, 31, 31, 31, 31, 31, 31, 31, 31, 31, 31, 31, 31};
#define XB_TMO      128
#define XB_XCNT(j)  (256  + 64 * (j))
#define XB_XSUB(j)  (1280 + 64 * (j))
#define XB_XGEN(j)  (2304 + 64 * (j))
#define XB_TOP      3328
#define XB_TOPGEN   3392
#define XCD_BAR_WORDS 3456
#define XB_SPIN_CAP (1u << 18)

__device__ __forceinline__ unsigned xb_ld(unsigned* p)              { return __hip_atomic_load(p, __ATOMIC_RELAXED, __HIP_MEMORY_SCOPE_AGENT); }
__device__ __forceinline__ unsigned xb_add(unsigned* p, unsigned v) { return __hip_atomic_fetch_add(p, v, __ATOMIC_RELAXED, __HIP_MEMORY_SCOPE_AGENT); }
__device__ __forceinline__ unsigned xb_xcc_id() { return (unsigned)__builtin_amdgcn_s_getreg((3 << 11) | 20) & 0xFu; }
#define XB_SPIN(cond, bar) do { unsigned _sp = 0; while (cond) { __builtin_amdgcn_s_sleep(1); \
    if ((++_sp & 255u) == 0u) { if (xb_ld(&(bar)[XB_TMO])) break; if (_sp > XB_SPIN_CAP) { atomicAdd(&(bar)[XB_TMO], 1u); break; } } } } while (0)

struct XcdBarrier {
    unsigned* bar; unsigned x;
    volatile LAS unsigned* st;
};

__device__ __forceinline__ XcdBarrier xcd_barrier_post(unsigned* bar, volatile LAS unsigned* st) {
    XcdBarrier b; b.bar = bar; b.x = xb_xcc_id(); b.st = st;
    if (threadIdx.x == 0) (void)xb_add(&bar[XB_XCNT(b.x)], 1u);
    return b;
}
__device__ __forceinline__ void xcd_barrier_complete(unsigned* bar, unsigned x, unsigned& nloc, unsigned& nx) {
    const unsigned G = gridDim.x * gridDim.y * gridDim.z;
    unsigned sum, cnt, mine, sp = 0u;
    for (;;) {
        sum = 0u; cnt = 0u; mine = 0u;
#pragma unroll
        for (unsigned j = 0; j < 16; ++j) { const unsigned c = xb_ld(&bar[XB_XCNT(j)]); sum += c; cnt += (c > 0u) ? 1u : 0u; mine = (j == x) ? c : mine; }
        if (sum == G) break;
        __builtin_amdgcn_s_sleep(1);
        if ((++sp & 255u) == 0u) { if (xb_ld(&bar[XB_TMO])) break; if (sp > XB_SPIN_CAP) { atomicAdd(&bar[XB_TMO], 1u); break; } }
    }
    nloc = mine > 0u ? mine : 1u; nx = cnt > 0u ? cnt : 1u;
}

__device__ __forceinline__ void xcd_barrier(const XcdBarrier& b) {
    asm volatile("s_waitcnt vmcnt(0)" ::: "memory");
    __syncthreads();
    if (threadIdx.x == 0) {
        unsigned* bar = b.bar;
        __builtin_amdgcn_s_waitcnt(0);
        unsigned nloc = b.st[0], nx = b.st[1];
        if (nloc == 0u) { xcd_barrier_complete(bar, b.x, nloc, nx); b.st[0] = nloc; b.st[1] = nx; }
        const unsigned old = xb_add(&bar[XB_XSUB(b.x)], 1u);
        const unsigned gen = old / nloc;
        if (old + 1u == (gen + 1u) * nloc) {
            __builtin_amdgcn_fence(__ATOMIC_RELEASE, "agent");
            asm volatile("s_waitcnt vmcnt(0)" ::: "memory");
            const unsigned og = xb_add(&bar[XB_TOP], 1u);
            const unsigned tg = og / nx;
            if (og + 1u == (tg + 1u) * nx) xb_add(&bar[XB_TOPGEN], 1u);
            else XB_SPIN(xb_ld(&bar[XB_TOPGEN]) == tg, bar);
            __builtin_amdgcn_fence(__ATOMIC_ACQUIRE, "agent");
            xb_add(&bar[XB_XGEN(b.x)], 1u);
            asm volatile("s_waitcnt vmcnt(0)" ::: "memory");
        } else {
            XB_SPIN(xb_ld(&bar[XB_XGEN(b.x)]) == gen, bar);
            __builtin_amdgcn_fence(__ATOMIC_ACQUIRE, "agent");
            asm volatile("s_waitcnt vmcnt(0)" ::: "memory");
        }
    }
    __syncthreads();
}
namespace pg8 {
struct EpiZ {
    static constexpr bool PERM = true, AFTER_DRAIN = false;
    bf16_t *Q, *KV, *GU, *GV, *GA, *GB;
    __device__ __forceinline__ void operator()(const f32x4 (&acc)[2][2][4][2], const Unit& u, int wr, int wc, int fr, int fq) const {
        const int pn = u.pn; bf16_t* base; int ldc, colt, act;
        if (pn < 2)       { base = Q;  ldc = 512;  colt = pn * 256;        act = 0; }
        else if (pn == 2) { base = KV; ldc = 256;  colt = 0;               act = 0; }
        else if (pn < 5)  { base = GU; ldc = 512;  colt = (pn - 3) * 256;  act = 1; }
        else if (pn < 7)  { base = GV; ldc = 512;  colt = (pn - 5) * 256;  act = 1; }
        else if (pn < 11) { base = GA; ldc = 1024; colt = (pn - 7) * 256;  act = 2; }
        else              { base = GB; ldc = 1024; colt = (pn - 11) * 256; act = 2; }
        const int row0 = u.pm * BM + wr * 64 + fr, col0 = colt + wc * 32 + 8 * fq;
#pragma unroll
        for (int ai = 0; ai < 2; ++ai)
#pragma unroll
            for (int m = 0; m < 4; ++m) { bf16_t* rowp = base + (size_t)(row0 + ai * HALF + m * 16) * ldc + col0;
#pragma unroll
                for (int bj = 0; bj < 2; ++bj) { f32x4 v0 = acc[ai][bj][m][0], v1 = acc[ai][bj][m][1];
                    if (act == 1) {
#pragma unroll
                        for (int e = 0; e < 4; ++e) { v0[e] = gelu_tanh(v0[e]); v1[e] = gelu_tanh(v1[e]); }
                    } else if (act == 2) {
#pragma unroll
                        for (int e = 0; e < 4; ++e) { v0[e] = sigmoid_f(v0[e]); v1[e] = sigmoid_f(v1[e]); }
                    }
                    u32x4 w; w.x = cvt_pk_bf16(v0[0], v0[1]); w.y = cvt_pk_bf16(v0[2], v0[3]); w.z = cvt_pk_bf16(v1[0], v1[1]); w.w = cvt_pk_bf16(v1[2], v1[3]);
                    *(u32x4*)(rowp + bj * HALF) = w; } }
    }
};
struct EpiGateTmp {
    static constexpr bool PERM = true, AFTER_DRAIN = false;
    const bf16_t* gate; float* tmp;
    __device__ __forceinline__ void operator()(const f32x4 (&acc)[2][2][4][2], const Unit& u, int wr, int wc, int fr, int fq) const {
        const int row0 = u.pm * BM + wr * 64 + fr, col0 = u.pn * BM + wc * 32 + 8 * fq;
#pragma unroll
        for (int ai = 0; ai < 2; ++ai)
#pragma unroll
            for (int m = 0; m < 4; ++m) { const size_t ro = (size_t)(row0 + ai * HALF + m * 16) * 1024 + col0;
#pragma unroll
                for (int bj = 0; bj < 2; ++bj) { const u32x4 g = *(const u32x4*)(gate + ro + bj * HALF); f32x4 v0 = acc[ai][bj][m][0], v1 = acc[ai][bj][m][1];
                    v0[0] *= bflo(g.x); v0[1] *= bfhi(g.x); v0[2] *= bflo(g.y); v0[3] *= bfhi(g.y); v1[0] *= bflo(g.z); v1[1] *= bfhi(g.z); v1[2] *= bflo(g.w); v1[3] *= bfhi(g.w);
                    *(f32x4*)(tmp + ro + bj * HALF) = v0; *(f32x4*)(tmp + ro + bj * HALF + 4) = v1; } }
    }
};
struct EpiMerge {
    static constexpr bool PERM = true, AFTER_DRAIN = false;
    const bf16_t* gate; const float* tmp; bf16_t* out;
    __device__ __forceinline__ void operator()(const f32x4 (&acc)[2][2][4][2], const Unit& u, int wr, int wc, int fr, int fq) const {
        const int row0 = u.pm * BM + wr * 64 + fr, col0 = u.pn * BM + wc * 32 + 8 * fq;
#pragma unroll
        for (int ai = 0; ai < 2; ++ai)
#pragma unroll
            for (int m = 0; m < 4; ++m) { const size_t ro = (size_t)(row0 + ai * HALF + m * 16) * 1024 + col0;
#pragma unroll
                for (int bj = 0; bj < 2; ++bj) { const u32x4 g = *(const u32x4*)(gate + ro + bj * HALF); f32x4 v0 = acc[ai][bj][m][0], v1 = acc[ai][bj][m][1];
                    const f32x4 t0 = *(const f32x4*)(tmp + ro + bj * HALF), t1 = *(const f32x4*)(tmp + ro + bj * HALF + 4);
                    v0[0] = t0[0] + v0[0] * bflo(g.x); v0[1] = t0[1] + v0[1] * bfhi(g.x); v0[2] = t0[2] + v0[2] * bflo(g.y); v0[3] = t0[3] + v0[3] * bfhi(g.y);
                    v1[0] = t1[0] + v1[0] * bflo(g.z); v1[1] = t1[1] + v1[1] * bfhi(g.z); v1[2] = t1[2] + v1[2] * bflo(g.w); v1[3] = t1[3] + v1[3] * bfhi(g.w);
                    u32x4 w; w.x = cvt_pk_bf16(v0[0], v0[1]); w.y = cvt_pk_bf16(v0[2], v0[3]); w.z = cvt_pk_bf16(v1[0], v1[1]); w.w = cvt_pk_bf16(v1[2], v1[3]);
                    *(u32x4*)(out + ro + bj * HALF) = w; } }
    }
};
struct EpiRes {
    static constexpr bool PERM = false, AFTER_DRAIN = false;
    const float* base; float* C;
    __device__ __forceinline__ void operator()(const f32x4 (&acc)[2][2][4][2], const Unit& u, int wr, int wc, int fr, int fq) const {
        const int row0 = u.pm * BM + wr * 64 + fr, col0 = u.pn * BM + wc * 32 + 4 * fq;
#pragma unroll
        for (int ai = 0; ai < 2; ++ai)
#pragma unroll
            for (int m = 0; m < 4; ++m) { const size_t ro = (size_t)(row0 + ai * HALF + m * 16) * 1024 + col0;
#pragma unroll
                for (int bj = 0; bj < 2; ++bj)
#pragma unroll
                    for (int n = 0; n < 2; ++n) *(f32x4*)(C + ro + bj * HALF + n * 16) = *(const f32x4*)(base + ro + bj * HALF + n * 16) + acc[ai][bj][m][n]; }
    }
};
struct EpiPlain {
    static constexpr bool PERM = true, AFTER_DRAIN = false;
    bf16_t* O; int ldc;
    __device__ __forceinline__ void operator()(const f32x4 (&acc)[2][2][4][2], const Unit& u, int wr, int wc, int fr, int fq) const {
        const int row0 = u.pm * BM + wr * 64 + fr, col0 = u.pn * BM + wc * 32 + 8 * fq;
#pragma unroll
        for (int ai = 0; ai < 2; ++ai)
#pragma unroll
            for (int m = 0; m < 4; ++m) { bf16_t* rowp = O + (size_t)(row0 + ai * HALF + m * 16) * ldc + col0;
#pragma unroll
                for (int bj = 0; bj < 2; ++bj) { const f32x4 v0 = acc[ai][bj][m][0], v1 = acc[ai][bj][m][1];
                    u32x4 w; w.x = cvt_pk_bf16(v0[0], v0[1]); w.y = cvt_pk_bf16(v0[2], v0[3]); w.z = cvt_pk_bf16(v1[0], v1[1]); w.w = cvt_pk_bf16(v1[2], v1[3]);
                    *(u32x4*)(rowp + bj * HALF) = w; } }
    }
};
}

__device__ __forceinline__ void p0_transpose_item(const float* W, int K, int N, bf16* WT, LAS float* scr, int item, int lane) {
    const int nblk = N / 32, kb = item / nblk, nb = item % nblk, k0 = 64 * kb, n0 = 32 * nb;
#pragma unroll 8
    for (int i = 0; i < 32; ++i) { const int kk = 2 * i + (lane >> 5); scr[kk * 33 + (lane & 31)] = W[(size_t)(k0 + kk) * N + n0 + (lane & 31)]; }
    LDS_WAIT(); asm volatile("" ::: "memory");
    const int c = lane & 7;
#pragma unroll
    for (int j = 0; j < 4; ++j) { const int n = (lane >> 3) + 8 * j; const LAS float* s = scr + (8 * c) * 33 + n;
        v4u o; o.x = pk2(s[0 * 33], s[1 * 33]); o.y = pk2(s[2 * 33], s[3 * 33]); o.z = pk2(s[4 * 33], s[5 * 33]); o.w = pk2(s[6 * 33], s[7 * 33]);
        *(v4u*)(WT + (size_t)(n0 + n) * K + k0 + 8 * c) = o; }
    LDS_WAIT(); asm volatile("" ::: "memory");
}
__device__ __forceinline__ void cvt_flat(const float* src, bf16* dst, size_t n, int gw, int NGW, int lane) {
    for (size_t i = (size_t)gw * 512 + lane * 8; i < n; i += (size_t)NGW * 512) {
        const f32x4 a = *(const f32x4*)(src + i), b = *(const f32x4*)(src + i + 4);
        v4u o; o.x = pk2(a[0], a[1]); o.y = pk2(a[2], a[3]); o.z = pk2(b[0], b[1]); o.w = pk2(b[2], b[3]);
        *(v4u*)(dst + i) = o;
    }
}
__device__ __forceinline__ void rms_row_to_bf16(const float* xrow, const float* w, bf16* orow, int lane) {
    const f32x4* xr = (const f32x4*)xrow + lane; const f32x4* wr = (const f32x4*)w + lane;
    f32x4 v[4]; float s = 0.f;
#pragma unroll
    for (int j = 0; j < 4; ++j) { v[j] = xr[64 * j]; s += (v[j][0] * v[j][0] + v[j][1] * v[j][1]) + (v[j][2] * v[j][2] + v[j][3] * v[j][3]); }
    const float rstd = 1.0f / sqrtf(wave_sum(s) * (1.0f / 1024.0f) + EPS);
    unsigned long long* o8 = (unsigned long long*)orow + lane;
#pragma unroll
    for (int j = 0; j < 4; ++j) { const f32x4 ww = wr[64 * j];
        o8[64 * j] = (unsigned long long)pk2(v[j][0] * rstd * ww[0], v[j][1] * rstd * ww[1]) | ((unsigned long long)pk2(v[j][2] * rstd * ww[2], v[j][3] * rstd * ww[3]) << 32); }
}

struct Ptrs {
    const float *x, *mix_w, *w_in, *rel_bias, *sinks, *w_pa, *ln_w, *ln_b, *w_s, *b_s, *w_pb, *w_out, *ffn_w, *w_q, *keys1, *keys2, *pu, *pv, *fin_w;
    float* out;
    unsigned char *U8, *V8; float *USC, *VSC;
    bf16 *WIN, *WPA, *WPB, *WOUT, *WQ, *K1, *K2, *WS, *U, *V, *XN, *AOUT, *BOUT, *HN2, *Q, *KV, *GU, *GV, *GA, *GB, *MERGED, *QP;
};

__device__ __forceinline__ void p0_prologue(LAS unsigned char* lds, const Ptrs& P, int vcu, int G, int lane, int wave) {
    LAS float* scr = (LAS float*)(lds + wave * 16384);
    const int gw = vcu * NWAVES + wave, NGW = G * NWAVES;
    constexpr int I_IN = (1024 / 64) * (3840 / 32), I_PA = (512 / 64) * (1024 / 32), I_OUT = (1024 / 64) * (1024 / 32), I_WQ = (1024 / 64) * (2048 / 32);
    constexpr int NITEMS = I_IN + 2 * I_PA + I_OUT + I_WQ;
    for (int it = gw; it < NITEMS; it += NGW) {
        int r = it;
        if (r < I_IN) { p0_transpose_item(P.w_in, 1024, 3840, P.WIN, scr, r, lane); continue; } r -= I_IN;
        if (r < I_PA) { p0_transpose_item(P.w_pa, 512, 1024, P.WPA, scr, r, lane); continue; } r -= I_PA;
        if (r < I_PA) { p0_transpose_item(P.w_pb, 512, 1024, P.WPB, scr, r, lane); continue; } r -= I_PA;
        if (r < I_OUT) { p0_transpose_item(P.w_out, 1024, 1024, P.WOUT, scr, r, lane); continue; } r -= I_OUT;
        p0_transpose_item(P.w_q, 1024, 2048, P.WQ, scr, r, lane);
    }
    cvt_flat(P.keys1, P.K1, 128 * 128, gw, NGW, lane);
    cvt_flat(P.keys2, P.K2, 128 * 128, gw, NGW, lane);
#if PEER_FP8
    for (int rr = gw; rr < 2 * 16384; rr += NGW) {
        const int tab = rr >> 14, row = rr & 16383;
        const float* src = (tab ? P.pv : P.pu) + (size_t)row * 1024; unsigned char* dst = (tab ? P.V8 : P.U8) + (size_t)row * 1024;
        f32x4 v[4]; float mx = 0.f;
#pragma unroll
        for (int j = 0; j < 4; ++j) { v[j] = *(const f32x4*)(src + 4 * lane + 256 * j); mx = fmaxf(mx, fmaxf(fmaxf(fabsf(v[j][0]), fabsf(v[j][1])), fmaxf(fabsf(v[j][2]), fabsf(v[j][3])))); }
#pragma unroll
        for (int o = 1; o < 64; o <<= 1) mx = fmaxf(mx, __shfl_xor(mx, o));
        const int ex = (int)((__builtin_bit_cast(unsigned, mx) >> 23) & 0xffu);
        const bool tiny = ex < 32;
        const float scale = tiny ? 1.0f : __builtin_bit_cast(float, (unsigned)(254 + 7 - ex) << 23);
        const float inv = tiny ? 1.0f : __builtin_bit_cast(float, (unsigned)(ex - 7) << 23);
#pragma unroll
        for (int j = 0; j < 4; ++j) { int p = __builtin_amdgcn_cvt_pk_fp8_f32(v[j][0] * scale, v[j][1] * scale, 0, false); p = __builtin_amdgcn_cvt_pk_fp8_f32(v[j][2] * scale, v[j][3] * scale, p, true);
            *(int*)(dst + 4 * lane + 256 * j) = p; }
        if (lane == 0) (tab ? P.VSC : P.USC)[row] = inv;
    }
#else
    cvt_flat(P.pu, P.U, (size_t)16384 * 1024, gw, NGW, lane);
    cvt_flat(P.pv, P.V, (size_t)16384 * 1024, gw, NGW, lane);
#endif
    for (size_t i = (size_t)gw * 512 + lane * 8; i < (size_t)8 * 128 * 128; i += (size_t)NGW * 512) {
        const int t = (int)((i >> 7) & 127), s0 = (int)(i & 127);
        const f32x4 a = *(const f32x4*)(P.w_s + i), b = *(const f32x4*)(P.w_s + i + 4);
        float e[8] = {a[0], a[1], a[2], a[3], b[0], b[1], b[2], b[3]};
#pragma unroll
        for (int j = 0; j < 8; ++j) e[j] = (s0 + j <= t) ? e[j] : 0.f;
        v4u o; o.x = pk2(e[0], e[1]); o.y = pk2(e[2], e[3]); o.z = pk2(e[4], e[5]); o.w = pk2(e[6], e[7]);
        *(v4u*)(P.WS + i) = o;
    }
    for (int m = gw; m < M; m += NGW) rms_row_to_bf16(P.x + (size_t)m * D, P.mix_w, P.XN + (size_t)m * D, lane);
}

__device__ __forceinline__ void p2_attn_naive(LAS unsigned char* lds, const Ptrs& P, int vcu, int G, int tid, int lane, int wave) {
    LAS float* biasl = (LAS float*)lds;
    for (int i = tid; i < 1024; i += 512) { const int d = i >> 3, h = i & 7; biasl[i] = P.rel_bias[(int)T5B[d] * 8 + h]; }
    __syncthreads();
    const int h = wave, kvh = h >> 2;
    const float sink = P.sinks[h];
    for (int unit = vcu; unit < M / 64; unit += G) {
        const int t = unit * 64 + lane, pos = t & (SEQ - 1);
        float q[64], o[64];
        { const v4u* qp = (const v4u*)(P.Q + (size_t)t * 512 + h * 64);
#pragma unroll
          for (int c = 0; c < 8; ++c) { const v4u w = qp[c]; q[8 * c + 0] = bflo(w.x) * 0.125f; q[8 * c + 1] = bfhi(w.x) * 0.125f; q[8 * c + 2] = bflo(w.y) * 0.125f; q[8 * c + 3] = bfhi(w.y) * 0.125f;
              q[8 * c + 4] = bflo(w.z) * 0.125f; q[8 * c + 5] = bfhi(w.z) * 0.125f; q[8 * c + 6] = bflo(w.w) * 0.125f; q[8 * c + 7] = bfhi(w.w) * 0.125f; } }
#pragma unroll
        for (int i = 0; i < 64; ++i) o[i] = 0.f;
        float m = sink, l = 1.f;
        for (int d = 0; d < 128; ++d) {
            const bool valid = (pos - d) >= 0;
            const int tj = valid ? (t - d) : t;
            const v4u* kp = (const v4u*)(P.KV + (size_t)tj * 256 + kvh * 64);
            float dot = 0.f;
#pragma unroll
            for (int c = 0; c < 8; ++c) { const v4u w = kp[c];
                dot += q[8 * c + 0] * bflo(w.x) + q[8 * c + 1] * bfhi(w.x) + q[8 * c + 2] * bflo(w.y) + q[8 * c + 3] * bfhi(w.y) + q[8 * c + 4] * bflo(w.z) + q[8 * c + 5] * bfhi(w.z) + q[8 * c + 6] * bflo(w.w) + q[8 * c + 7] * bfhi(w.w); }
            const float s = valid ? dot + biasl[d * 8 + h] : -1e30f;
            const float mn = fmaxf(m, s), alpha = __expf(m - mn), p = __expf(s - mn);
            l = l * alpha + p; m = mn;
            const v4u* vp = kp + 16;
#pragma unroll
            for (int c = 0; c < 8; ++c) { const v4u w = vp[c];
                o[8 * c + 0] = o[8 * c + 0] * alpha + p * bflo(w.x); o[8 * c + 1] = o[8 * c + 1] * alpha + p * bfhi(w.x); o[8 * c + 2] = o[8 * c + 2] * alpha + p * bflo(w.y); o[8 * c + 3] = o[8 * c + 3] * alpha + p * bfhi(w.y);
                o[8 * c + 4] = o[8 * c + 4] * alpha + p * bflo(w.z); o[8 * c + 5] = o[8 * c + 5] * alpha + p * bfhi(w.z); o[8 * c + 6] = o[8 * c + 6] * alpha + p * bflo(w.w); o[8 * c + 7] = o[8 * c + 7] * alpha + p * bfhi(w.w); }
        }
        const float inv = 1.0f / l;
        v4u* op = (v4u*)(P.AOUT + (size_t)t * 512 + h * 64);
#pragma unroll
        for (int c = 0; c < 8; ++c) { v4u w; w.x = pk2(o[8 * c + 0] * inv, o[8 * c + 1] * inv); w.y = pk2(o[8 * c + 2] * inv, o[8 * c + 3] * inv); w.z = pk2(o[8 * c + 4] * inv, o[8 * c + 5] * inv); w.w = pk2(o[8 * c + 6] * inv, o[8 * c + 7] * inv); op[c] = w; }
    }
    __syncthreads();
}

__device__ __forceinline__ void p2_gmlp_naive(LAS unsigned char* lds, const Ptrs& P, int vcu, int G, int tid, int lane, int wave) {
    LAS bf16* vnl = (LAS bf16*)(lds + 8192);
    for (int unit = vcu; unit < 256; unit += G) {
        const int c = unit >> 1, hh = unit & 1;
        for (int i = 0; i < 16; ++i) {
            const int tt = wave * 16 + i; const size_t row = (size_t)c * 128 + tt;
            const v4u w = *((const v4u*)(P.GV + row * 512) + lane);
            float x[8] = {bflo(w.x), bfhi(w.x), bflo(w.y), bfhi(w.y), bflo(w.z), bfhi(w.z), bflo(w.w), bfhi(w.w)};
            float s = 0.f;
#pragma unroll
            for (int j = 0; j < 8; ++j) s += x[j];
            const float mean = wave_sum(s) * (1.0f / 512.0f);
            float ss = 0.f;
#pragma unroll
            for (int j = 0; j < 8; ++j) { x[j] -= mean; ss += x[j] * x[j]; }
            const float rstd = 1.0f / sqrtf(wave_sum(ss) * (1.0f / 512.0f) + EPS);
            if ((lane >> 5) == hh) {
                const f32x4 w0 = *(const f32x4*)(P.ln_w + lane * 8), w1 = *(const f32x4*)(P.ln_w + lane * 8 + 4), b0 = *(const f32x4*)(P.ln_b + lane * 8), b1 = *(const f32x4*)(P.ln_b + lane * 8 + 4);
                v4u o; o.x = pk2(x[0] * rstd * w0[0] + b0[0], x[1] * rstd * w0[1] + b0[1]); o.y = pk2(x[2] * rstd * w0[2] + b0[2], x[3] * rstd * w0[3] + b0[3]);
                o.z = pk2(x[4] * rstd * w1[0] + b1[0], x[5] * rstd * w1[1] + b1[1]); o.w = pk2(x[6] * rstd * w1[2] + b1[2], x[7] * rstd * w1[3] + b1[3]);
                *(LAS v4u*)(vnl + tt * 256 + (lane & 31) * 8) = o;
            }
        }
        __syncthreads();
        const int ch = tid & 255, th = tid >> 8, g = hh * 4 + (ch >> 6);
        for (int t = th * 64; t < th * 64 + 64; ++t) {
            const v4u* wrow = (const v4u*)(P.WS + ((size_t)g * 128 + t) * 128);
            float acc = 0.f;
            for (int s8 = 0; s8 <= (t >> 3); ++s8) {
                const v4u w = wrow[s8];
                const LAS bf16* vp = vnl + (s8 * 8) * 256 + ch;
                acc += bflo(w.x) * bf2f(vp[0]) + bfhi(w.x) * bf2f(vp[256]) + bflo(w.y) * bf2f(vp[512]) + bfhi(w.y) * bf2f(vp[768])
                     + bflo(w.z) * bf2f(vp[1024]) + bfhi(w.z) * bf2f(vp[1280]) + bflo(w.w) * bf2f(vp[1536]) + bfhi(w.w) * bf2f(vp[1792]);
            }
            const size_t row = (size_t)c * 128 + t;
            const float uval = bf2f(P.GU[row * 512 + hh * 256 + ch]);
            P.BOUT[row * 512 + hh * 256 + ch] = (bf16)f2bf(uval * (acc + P.b_s[g * 128 + t]));
        }
        __syncthreads();
    }
}

typedef short s16x8 __attribute__((ext_vector_type(8)));
typedef short s16x4 __attribute__((ext_vector_type(4)));
typedef float f32x16 __attribute__((ext_vector_type(16)));
typedef float f32x2v __attribute__((ext_vector_type(2)));
#define MFMA32(a, b, c) __builtin_amdgcn_mfma_f32_32x32x16_bf16((a), (b), (c), 0, 0, 0)
__device__ __forceinline__ s16x4 tr16(const LAS unsigned char* p) { return __builtin_bit_cast(s16x4, __builtin_amdgcn_ds_read_tr16_b64_v4i16((LAS s16x4*)p)); }
__device__ __forceinline__ unsigned cvtpk(float lo, float hi) { f32x2v v = {lo, hi}; bf16x2_t b = __builtin_convertvector(v, bf16x2_t); return __builtin_bit_cast(unsigned, b); }
__device__ __forceinline__ int crow(int reg, int h) { return (reg & 3) + 8 * (reg >> 2) + 4 * h; }
constexpr float LOG2E = 1.4426950408889634f;

__device__ __forceinline__ void p2_attn_mfma(LAS unsigned char* lds, const Ptrs& P, int vcu, int G, int tid, int lane, int wave) {
    LAS unsigned char* Kl = lds;
    LAS unsigned char* Vl = lds + 32768;
    LAS float* biasl = (LAS float*)(lds + 32768 + 49152);
    const int r = lane & 31, h = lane >> 5, i16 = lane & 15, q4 = i16 >> 2, p4 = i16 & 3, blk = (lane >> 4) & 1;
    for (int unit = vcu; unit < 256; unit += G) {
        const int kvh = unit & 1, blkid = unit >> 1, nb = blkid & 63; const int tok0 = blkid * 128;
#pragma unroll
        for (int i = 0; i < 4; ++i) {
            const int cidx = tid + 512 * i, row = cidx >> 3, c = cidx & 7;
            v4u kw = {0u, 0u, 0u, 0u}, vw = {0u, 0u, 0u, 0u};
            if (nb > 0 || row >= 128) { const bf16* src = P.KV + (size_t)(tok0 - 128 + row) * 256 + kvh * 64 + c * 8; kw = *(const v4u*)src; vw = *(const v4u*)(src + 128); }
            *(LAS v4u*)(Kl + row * 128 + ((c ^ ((row >> 1) & 7)) << 4)) = kw;
            *(LAS v4u*)(Vl + row * 192 + c * 16) = vw;
        }
        biasl[tid] = P.rel_bias[(int)T5B[tid & 127] * 8 + kvh * 4 + (tid >> 7)] * LOG2E;
        __syncthreads();
        const int g = wave >> 1, qh = wave & 1, hq = kvh * 4 + g;
        const float sink2 = P.sinks[hq] * LOG2E;
#pragma unroll 1
        for (int qs = 0; qs < 2; ++qs) {
            const int qi0 = 64 * qh + 32 * qs, kt0 = 2 * qh + qs;
            s16x8 qf[4];
            { const bf16* qrow = P.Q + (size_t)(tok0 + qi0 + r) * 512 + hq * 64 + 8 * h;
#pragma unroll
              for (int ks = 0; ks < 4; ++ks) qf[ks] = *(const s16x8*)(qrow + 16 * ks); }
            f32x16 s[5];
#pragma unroll
            for (int i = 0; i < 5; ++i) {
#pragma unroll
                for (int e = 0; e < 16; ++e) s[i][e] = 0.f;
                const int key = 32 * (kt0 + i) + r; const LAS unsigned char* kp = Kl + key * 128; const int sw = (key >> 1) & 7;
#pragma unroll
                for (int ks = 0; ks < 4; ++ks) { const s16x8 kf = *(const LAS s16x8*)(kp + (((2 * ks + h) ^ sw) << 4)); s[i] = MFMA32(kf, qf[ks], s[i]); }
            }
            const int qi = qi0 + r;
            float mx = sink2;
#pragma unroll
            for (int i = 0; i < 5; ++i)
#pragma unroll
                for (int e = 0; e < 16; ++e) {
                    const int kj = 32 * (kt0 + i) + crow(e, h), dist = 128 + qi - kj;
                    const bool valid = (dist >= 0) && (dist < 128) && (nb > 0 || kj >= 128);
                    const float b = biasl[g * 128 + (dist & 127)];
                    const float v = valid ? s[i][e] * (0.125f * LOG2E) + b : -1e30f;
                    s[i][e] = v; mx = fmaxf(mx, v);
                }
            mx = fmaxf(mx, xor32_f(mx));
            float l = 0.f;
#pragma unroll
            for (int i = 0; i < 5; ++i)
#pragma unroll
                for (int e = 0; e < 16; ++e) { const float p = __builtin_amdgcn_exp2f(s[i][e] - mx); s[i][e] = p; l += p; }
            l += xor32_f(l);
            l += __builtin_amdgcn_exp2f(sink2 - mx);
            f32x16 o0, o1;
#pragma unroll
            for (int e = 0; e < 16; ++e) { o0[e] = 0.f; o1[e] = 0.f; }
#pragma unroll
            for (int i = 0; i < 5; ++i)
#pragma unroll
                for (int st = 0; st < 2; ++st) {
                    v4u pw; pw.x = cvtpk(s[i][8 * st], s[i][8 * st + 1]); pw.y = cvtpk(s[i][8 * st + 2], s[i][8 * st + 3]); pw.z = cvtpk(s[i][8 * st + 4], s[i][8 * st + 5]); pw.w = cvtpk(s[i][8 * st + 6], s[i][8 * st + 7]);
                    const s16x8 pf = __builtin_bit_cast(s16x8, pw);
                    const LAS unsigned char* vb = Vl + (32 * (kt0 + i) + 16 * st + 4 * h + q4) * 192 + 32 * blk + 8 * p4;
                    { const s16x4 lo = tr16(vb), hi = tr16(vb + 8 * 192); const s16x8 vf = __builtin_shufflevector(lo, hi, 0, 1, 2, 3, 4, 5, 6, 7); o0 = MFMA32(vf, pf, o0); }
                    { const s16x4 lo = tr16(vb + 64), hi = tr16(vb + 64 + 8 * 192); const s16x8 vf = __builtin_shufflevector(lo, hi, 0, 1, 2, 3, 4, 5, 6, 7); o1 = MFMA32(vf, pf, o1); }
                }
            const float inv = 1.0f / l;
            bf16* orow = P.AOUT + (size_t)(tok0 + qi) * 512 + hq * 64 + 4 * h;
#pragma unroll
            for (int r4 = 0; r4 < 4; ++r4) {
                v2u w0; w0.x = cvtpk(o0[4 * r4] * inv, o0[4 * r4 + 1] * inv); w0.y = cvtpk(o0[4 * r4 + 2] * inv, o0[4 * r4 + 3] * inv); *(v2u*)(orow + 8 * r4) = w0;
                v2u w1; w1.x = cvtpk(o1[4 * r4] * inv, o1[4 * r4 + 1] * inv); w1.y = cvtpk(o1[4 * r4 + 2] * inv, o1[4 * r4 + 3] * inv); *(v2u*)(orow + 32 + 8 * r4) = w1;
            }
        }
        __syncthreads();
    }
}

__device__ __forceinline__ void p2_gmlp_mfma(LAS unsigned char* lds, const Ptrs& P, int vcu, int G, int tid, int lane, int wave) {
    LAS unsigned char* vnl = lds;
    const int r = lane & 31, h = lane >> 5, i16 = lane & 15, q4 = i16 >> 2, p4 = i16 & 3, blk = (lane >> 4) & 1;
    for (int unit = vcu; unit < 256; unit += G) {
        const int c = unit >> 1, hh = unit & 1;
        for (int i = 0; i < 16; ++i) {
            const int tt = wave * 16 + i; const size_t row = (size_t)c * 128 + tt;
            const v4u w = *((const v4u*)(P.GV + row * 512) + lane);
            float x[8] = {bflo(w.x), bfhi(w.x), bflo(w.y), bfhi(w.y), bflo(w.z), bfhi(w.z), bflo(w.w), bfhi(w.w)};
            float s = 0.f;
#pragma unroll
            for (int j = 0; j < 8; ++j) s += x[j];
            const float mean = wave_sum(s) * (1.0f / 512.0f);
            float ss = 0.f;
#pragma unroll
            for (int j = 0; j < 8; ++j) { x[j] -= mean; ss += x[j] * x[j]; }
            const float rstd = 1.0f / sqrtf(wave_sum(ss) * (1.0f / 512.0f) + EPS);
            if ((lane >> 5) == hh) {
                const f32x4 w0 = *(const f32x4*)(P.ln_w + lane * 8), w1 = *(const f32x4*)(P.ln_w + lane * 8 + 4), b0 = *(const f32x4*)(P.ln_b + lane * 8), b1 = *(const f32x4*)(P.ln_b + lane * 8 + 4);
                v4u o; o.x = pk2(x[0] * rstd * w0[0] + b0[0], x[1] * rstd * w0[1] + b0[1]); o.y = pk2(x[2] * rstd * w0[2] + b0[2], x[3] * rstd * w0[3] + b0[3]);
                o.z = pk2(x[4] * rstd * w1[0] + b1[0], x[5] * rstd * w1[1] + b1[1]); o.w = pk2(x[6] * rstd * w1[2] + b1[2], x[7] * rstd * w1[3] + b1[3]);
                *(LAS v4u*)(vnl + tt * 576 + (lane & 31) * 16) = o;
            }
        }
        __syncthreads();
        const int gi = wave >> 1, dblk = wave & 1, g = hh * 4 + gi;
        s16x8 af[8];
#pragma unroll
        for (int ks = 0; ks < 8; ++ks) { const LAS unsigned char* vb = vnl + (16 * ks + 8 * h + q4) * 576 + (gi * 64 + dblk * 32 + 16 * blk) * 2 + 8 * p4;
            const s16x4 lo = tr16(vb), hi = tr16(vb + 4 * 576); af[ks] = __builtin_shufflevector(lo, hi, 0, 1, 2, 3, 4, 5, 6, 7); }
#pragma unroll
        for (int tt = 0; tt < 4; ++tt) {
            f32x16 acc;
#pragma unroll
            for (int e = 0; e < 16; ++e) acc[e] = 0.f;
            const bf16* wrow = P.WS + ((size_t)g * 128 + 32 * tt + r) * 128 + 8 * h;
#pragma unroll
            for (int ks = 0; ks < 2 * (tt + 1); ++ks) acc = MFMA32(af[ks], *(const s16x8*)(wrow + 16 * ks), acc);
            const int t = 32 * tt + r; const size_t row = (size_t)c * 128 + t; const float b = P.b_s[g * 128 + t];
#pragma unroll
            for (int r4 = 0; r4 < 4; ++r4) {
                const int ch = g * 64 + dblk * 32 + 8 * r4 + 4 * h;
                const v2u uw = *(const v2u*)(P.GU + row * 512 + ch);
                v2u ow; ow.x = cvtpk(bflo(uw.x) * (acc[4 * r4] + b), bfhi(uw.x) * (acc[4 * r4 + 1] + b)); ow.y = cvtpk(bflo(uw.y) * (acc[4 * r4 + 2] + b), bfhi(uw.y) * (acc[4 * r4 + 3] + b));
                *(v2u*)(P.BOUT + row * 512 + ch) = ow;
            }
        }
        __syncthreads();
    }
}

__device__ __forceinline__ void topk_half(const bf16* q, const LAS bf16* kl, float (&v)[16]) {
    v4u qv[16];
#pragma unroll
    for (int c = 0; c < 16; ++c) qv[c] = ((const v4u*)q)[c];
#pragma unroll
    for (int i = 0; i < 16; ++i) v[i] = -INFINITY;
    for (int n = 0; n < 128; ++n) {
        const LAS v4u* kr = (const LAS v4u*)(kl + n * 128);
        float a0 = 0.f, a1 = 0.f, a2 = 0.f, a3 = 0.f;
#pragma unroll
        for (int c = 0; c < 16; ++c) { const v4u kk = kr[c]; a0 = dot2bf(qv[c].x, kk.x, a0); a1 = dot2bf(qv[c].y, kk.y, a1); a2 = dot2bf(qv[c].z, kk.z, a2); a3 = dot2bf(qv[c].w, kk.w, a3); }
        const float acc = (a0 + a1) + (a2 + a3);
        float x = __builtin_bit_cast(float, (__builtin_bit_cast(unsigned, acc) & ~0x7Fu) | (unsigned)n);
#pragma unroll
        for (int i = 0; i < 16; ++i) { const float hi = fmaxf(v[i], x); x = fminf(v[i], x); v[i] = hi; }
    }
}

__host__ __device__ constexpr int cand_slot(int i, int j) { int c = 0; for (int a = 0; a < 16; ++a) for (int b = 0; b < 16; ++b) { if (a == i && b == j) return c; if ((a + 1) * (b + 1) <= 16) ++c; } return c; }
#define CE_DESC(a, b) do { const float hi_ = fmaxf((a), (b)); const float lo_ = fminf((a), (b)); (a) = hi_; (b) = lo_; } while (0)
__device__ __forceinline__ void sort16_desc(float (&v)[16]) {
    CE_DESC(v[0], v[1]); CE_DESC(v[3], v[2]); CE_DESC(v[4], v[5]); CE_DESC(v[7], v[6]); CE_DESC(v[8], v[9]); CE_DESC(v[11], v[10]); CE_DESC(v[12], v[13]); CE_DESC(v[15], v[14]); CE_DESC(v[0], v[2]); CE_DESC(v[1], v[3]); CE_DESC(v[6], v[4]); CE_DESC(v[7], v[5]); CE_DESC(v[8], v[10]); CE_DESC(v[9], v[11]); CE_DESC(v[14], v[12]); CE_DESC(v[15], v[13]); CE_DESC(v[0], v[1]); CE_DESC(v[2], v[3]); CE_DESC(v[5], v[4]); CE_DESC(v[7], v[6]); CE_DESC(v[8], v[9]); CE_DESC(v[10], v[11]); CE_DESC(v[13], v[12]); CE_DESC(v[15], v[14]); CE_DESC(v[0], v[4]); CE_DESC(v[1], v[5]); CE_DESC(v[2], v[6]); CE_DESC(v[3], v[7]); CE_DESC(v[12], v[8]); CE_DESC(v[13], v[9]); CE_DESC(v[14], v[10]); CE_DESC(v[15], v[11]); CE_DESC(v[0], v[2]); CE_DESC(v[1], v[3]); CE_DESC(v[4], v[6]); CE_DESC(v[5], v[7]); CE_DESC(v[10], v[8]); CE_DESC(v[11], v[9]); CE_DESC(v[14], v[12]); CE_DESC(v[15], v[13]); CE_DESC(v[0], v[1]); CE_DESC(v[2], v[3]); CE_DESC(v[4], v[5]); CE_DESC(v[6], v[7]); CE_DESC(v[9], v[8]); CE_DESC(v[11], v[10]); CE_DESC(v[13], v[12]); CE_DESC(v[15], v[14]); CE_DESC(v[0], v[8]); CE_DESC(v[1], v[9]); CE_DESC(v[2], v[10]); CE_DESC(v[3], v[11]); CE_DESC(v[4], v[12]); CE_DESC(v[5], v[13]); CE_DESC(v[6], v[14]); CE_DESC(v[7], v[15]); CE_DESC(v[0], v[4]); CE_DESC(v[1], v[5]); CE_DESC(v[2], v[6]); CE_DESC(v[3], v[7]); CE_DESC(v[8], v[12]); CE_DESC(v[9], v[13]); CE_DESC(v[10], v[14]); CE_DESC(v[11], v[15]); CE_DESC(v[0], v[2]); CE_DESC(v[1], v[3]); CE_DESC(v[4], v[6]); CE_DESC(v[5], v[7]); CE_DESC(v[8], v[10]); CE_DESC(v[9], v[11]); CE_DESC(v[12], v[14]); CE_DESC(v[13], v[15]); CE_DESC(v[0], v[1]); CE_DESC(v[2], v[3]); CE_DESC(v[4], v[5]); CE_DESC(v[6], v[7]); CE_DESC(v[8], v[9]); CE_DESC(v[10], v[11]); CE_DESC(v[12], v[13]); CE_DESC(v[14], v[15]);
}
__device__ __forceinline__ void merge_top16(float (&a)[16], const float (&b)[16]) {
    a[0] = fmaxf(a[0], b[15]); a[1] = fmaxf(a[1], b[14]); a[2] = fmaxf(a[2], b[13]); a[3] = fmaxf(a[3], b[12]); a[4] = fmaxf(a[4], b[11]); a[5] = fmaxf(a[5], b[10]); a[6] = fmaxf(a[6], b[9]); a[7] = fmaxf(a[7], b[8]); a[8] = fmaxf(a[8], b[7]); a[9] = fmaxf(a[9], b[6]); a[10] = fmaxf(a[10], b[5]); a[11] = fmaxf(a[11], b[4]); a[12] = fmaxf(a[12], b[3]); a[13] = fmaxf(a[13], b[2]); a[14] = fmaxf(a[14], b[1]); a[15] = fmaxf(a[15], b[0]); CE_DESC(a[0], a[8]); CE_DESC(a[1], a[9]); CE_DESC(a[2], a[10]); CE_DESC(a[3], a[11]); CE_DESC(a[4], a[12]); CE_DESC(a[5], a[13]); CE_DESC(a[6], a[14]); CE_DESC(a[7], a[15]); CE_DESC(a[0], a[4]); CE_DESC(a[1], a[5]); CE_DESC(a[2], a[6]); CE_DESC(a[3], a[7]); CE_DESC(a[8], a[12]); CE_DESC(a[9], a[13]); CE_DESC(a[10], a[14]); CE_DESC(a[11], a[15]); CE_DESC(a[0], a[2]); CE_DESC(a[1], a[3]); CE_DESC(a[4], a[6]); CE_DESC(a[5], a[7]); CE_DESC(a[8], a[10]); CE_DESC(a[9], a[11]); CE_DESC(a[12], a[14]); CE_DESC(a[13], a[15]); CE_DESC(a[0], a[1]); CE_DESC(a[2], a[3]); CE_DESC(a[4], a[5]); CE_DESC(a[6], a[7]); CE_DESC(a[8], a[9]); CE_DESC(a[10], a[11]); CE_DESC(a[12], a[13]); CE_DESC(a[14], a[15]);
}
__device__ __forceinline__ void scores_top16(const bf16* qbase, const LAS unsigned char* kl, int r, int h, float (&t)[16]) {
#if TOPK_DBG_INSERT == 3
#pragma unroll
    for (int k = 0; k < 16; ++k) t[k] = -1e30f;
#pragma unroll 1
    for (int key = 0; key < 128; ++key) { float a = 0.f;
        if (((key >> 2) & 1) != h) continue;
        for (int c = 0; c < 16; ++c) { const v4u q1 = *(const v4u*)(qbase + (size_t)r * 256 + 8 * c); const v4u kk1 = *(const LAS v4u*)(kl + key * 256 + 16 * c);
            a = dot2bf(q1.x, kk1.x, a); a = dot2bf(q1.y, kk1.y, a); a = dot2bf(q1.z, kk1.z, a); a = dot2bf(q1.w, kk1.w, a); }
        float x = __builtin_bit_cast(float, (__builtin_bit_cast(unsigned, a) & ~0x7Fu) | (unsigned)key);
#pragma unroll
        for (int i = 0; i < 16; ++i) { const float hi = fmaxf(t[i], x); x = fminf(t[i], x); t[i] = hi; } }
    return;
#endif
    f32x16 acc[4];
#pragma unroll
    for (int kt = 0; kt < 4; ++kt)
#pragma unroll
        for (int e = 0; e < 16; ++e) acc[kt][e] = 0.f;
    const LAS unsigned char* kp0 = kl + r * 256; const int sw = KEY_SWZ ? (r & 15) : 0;
#pragma unroll
    for (int ks = 0; ks < 8; ++ks) {
        const s16x8 qf = *(const s16x8*)(qbase + (size_t)r * 256 + 16 * ks + 8 * h);
#pragma unroll
        for (int kt = 0; kt < 4; ++kt) { const s16x8 kf = *(const LAS s16x8*)(kp0 + kt * 8192 + (((2 * ks + h) ^ sw) << 4)); acc[kt] = MFMA32(kf, qf, acc[kt]); }
    }
    float g[4][16];
#pragma unroll
    for (int kt = 0; kt < 4; ++kt) {
#pragma unroll
        for (int e = 0; e < 16; ++e) { const float av_ = acc[kt][e];
            g[kt][e] = __builtin_bit_cast(float, (__builtin_bit_cast(unsigned, av_) & ~0x7Fu) | (unsigned)(32 * kt + (e & 3) + 8 * (e >> 2))); }
#if !TOPK_DBG_INSERT
        sort16_desc(g[kt]);
#endif
    }
#if TOPK_DBG_INSERT == 2
#pragma unroll
    for (int k = 0; k < 16; ++k) t[k] = -1e30f;
#pragma unroll
    for (int kt = 0; kt < 4; ++kt)
#pragma unroll
        for (int e = 0; e < 16; ++e) t[0] = fmaxf(t[0], g[kt][e]);
#elif TOPK_DBG_INSERT
#pragma unroll
    for (int k = 0; k < 16; ++k) t[k] = -1e30f;
#pragma unroll
    for (int kt = 0; kt < 4; ++kt)
#pragma unroll
        for (int e = 0; e < 16; ++e) { float x = g[kt][e];
#pragma unroll
            for (int i = 0; i < 16; ++i) { const float hi = fmaxf(t[i], x); x = fminf(t[i], x); t[i] = hi; } }
#else
    merge_top16(g[0], g[1]); merge_top16(g[2], g[3]); merge_top16(g[0], g[2]);
#pragma unroll
    for (int k = 0; k < 16; ++k) t[k] = __builtin_bit_cast(float, __builtin_bit_cast(unsigned, g[0][k]) | ((unsigned)h << 2));
#endif
}
__device__ __forceinline__ void peer_topk_unit_mfma(const Ptrs& P, const LAS unsigned char* k1l, const LAS unsigned char* k2l, LAS int* idxl, LAS float* gatel, int unit, int lane, int wave) {
    const int r = lane & 31, h = lane >> 5;
#pragma unroll 1
    for (int rbi = 0; rbi < 2; ++rbi) {
        const int rb = wave * 2 + rbi, R = rb * 32 + r;
        const bf16* qbase = P.QP + ((size_t)unit * 512 + rb * 32) * 256;
        float t1[16], t2[16];
#if TOPK_DBG_BRUTE
#pragma unroll
        for (int k = 0; k < 16; ++k) { t1[k] = -1e30f; t2[k] = -1e30f; }
#pragma unroll 1
        for (int key = 0; key < 128; ++key) { float a = 0.f, b = 0.f;
            if (((key >> 2) & 1) != h) continue;
            for (int c = 0; c < 16; ++c) { const v4u q1 = *(const v4u*)(qbase + (size_t)r * 256 + 8 * c), q2 = *(const v4u*)(qbase + 128 + (size_t)r * 256 + 8 * c);
                const v4u kk1 = *(const LAS v4u*)(k1l + key * 256 + 16 * c), kk2 = *(const LAS v4u*)(k2l + key * 256 + 16 * c);
                a = dot2bf(q1.x, kk1.x, a); a = dot2bf(q1.y, kk1.y, a); a = dot2bf(q1.z, kk1.z, a); a = dot2bf(q1.w, kk1.w, a);
                b = dot2bf(q2.x, kk2.x, b); b = dot2bf(q2.y, kk2.y, b); b = dot2bf(q2.z, kk2.z, b); b = dot2bf(q2.w, kk2.w, b); }
            float x = __builtin_bit_cast(float, (__builtin_bit_cast(unsigned, a) & ~0x7Fu) | (unsigned)key), y = __builtin_bit_cast(float, (__builtin_bit_cast(unsigned, b) & ~0x7Fu) | (unsigned)key);
#pragma unroll
            for (int i = 0; i < 16; ++i) { const float hi = fmaxf(t1[i], x); x = fminf(t1[i], x); t1[i] = hi; const float hj = fmaxf(t2[i], y); y = fminf(t2[i], y); t2[i] = hj; } }
#else
        scores_top16(qbase, k1l, r, h, t1);
        __builtin_amdgcn_sched_barrier(0);
        scores_top16(qbase + 128, k2l, r, h, t2);
        __builtin_amdgcn_sched_barrier(0);
#endif
        float F[16], recv[16];
#pragma unroll
        for (int k = 0; k < 16; ++k) { auto rr = __builtin_amdgcn_permlane32_swap(__builtin_bit_cast(unsigned, t1[k]), __builtin_bit_cast(unsigned, t2[k]), false, false);
            const unsigned r0 = rr[0], r1 = rr[1]; F[k] = __builtin_bit_cast(float, r0); recv[k] = __builtin_bit_cast(float, r1); }
        merge_top16(F, recv);
        LAS unsigned char* slot = (LAS unsigned char*)(idxl + R * 16);
        { v4u b;
          b.x = (__builtin_bit_cast(unsigned, F[0]) & 0x7Fu) | ((__builtin_bit_cast(unsigned, F[1]) & 0x7Fu) << 8) | ((__builtin_bit_cast(unsigned, F[2]) & 0x7Fu) << 16) | ((__builtin_bit_cast(unsigned, F[3]) & 0x7Fu) << 24);
          b.y = (__builtin_bit_cast(unsigned, F[4]) & 0x7Fu) | ((__builtin_bit_cast(unsigned, F[5]) & 0x7Fu) << 8) | ((__builtin_bit_cast(unsigned, F[6]) & 0x7Fu) << 16) | ((__builtin_bit_cast(unsigned, F[7]) & 0x7Fu) << 24);
          b.z = (__builtin_bit_cast(unsigned, F[8]) & 0x7Fu) | ((__builtin_bit_cast(unsigned, F[9]) & 0x7Fu) << 8) | ((__builtin_bit_cast(unsigned, F[10]) & 0x7Fu) << 16) | ((__builtin_bit_cast(unsigned, F[11]) & 0x7Fu) << 24);
          b.w = (__builtin_bit_cast(unsigned, F[12]) & 0x7Fu) | ((__builtin_bit_cast(unsigned, F[13]) & 0x7Fu) << 8) | ((__builtin_bit_cast(unsigned, F[14]) & 0x7Fu) << 16) | ((__builtin_bit_cast(unsigned, F[15]) & 0x7Fu) << 24);
#if !TOPK_DBG_GATES_ONLY
          *(LAS v4u*)(slot + 16 * h) = b;
#endif
          (void)b; }
#if TOPK_DBG_COMPARE == 7 || TOPK_DBG_COMPARE == 8
        { float best1 = -1e30f, best2 = -1e30f;
#pragma unroll 1
          for (int key = 0; key < 128; ++key) { float a = 0.f, b = 0.f;
              if (TOPK_DBG_COMPARE == 8 && ((key >> 2) & 1) != h) continue;
              for (int c = 0; c < 16; ++c) { const v4u q1 = *(const v4u*)(qbase + (size_t)r * 256 + 8 * c), q2 = *(const v4u*)(qbase + 128 + (size_t)r * 256 + 8 * c);
                  const v4u kk1 = *(const LAS v4u*)(k1l + key * 256 + 16 * c), kk2 = *(const LAS v4u*)(k2l + key * 256 + 16 * c);
                  a = dot2bf(q1.x, kk1.x, a); a = dot2bf(q1.y, kk1.y, a); a = dot2bf(q1.z, kk1.z, a); a = dot2bf(q1.w, kk1.w, a);
                  b = dot2bf(q2.x, kk2.x, b); b = dot2bf(q2.y, kk2.y, b); b = dot2bf(q2.z, kk2.z, b); b = dot2bf(q2.w, kk2.w, b); }
              best1 = fmaxf(best1, __builtin_bit_cast(float, (__builtin_bit_cast(unsigned, a) & ~0x7Fu) | (unsigned)key));
              best2 = fmaxf(best2, __builtin_bit_cast(float, (__builtin_bit_cast(unsigned, b) & ~0x7Fu) | (unsigned)key)); }
          *(LAS unsigned*)((LAS unsigned char*)idxl + 65536 + R * 8 + 4 * h) = (__builtin_bit_cast(unsigned, best1) & 0x7Fu) | ((__builtin_bit_cast(unsigned, best2) & 0x7Fu) << 16); }
#endif
#if TOPK_DBG_COMPARE == 9
        { float m1 = t1[0], m2 = t2[0];
#pragma unroll
          for (int k = 1; k < 16; ++k) { m1 = fmaxf(m1, t1[k]); m2 = fmaxf(m2, t2[k]); }
          *(LAS unsigned*)((LAS unsigned char*)idxl + 65536 + R * 8 + 4 * h) = (__builtin_bit_cast(unsigned, m1) & 0x7Fu) | ((__builtin_bit_cast(unsigned, m2) & 0x7Fu) << 16); }
#endif
#if TOPK_DBG_COMPARE == 6
        *(LAS unsigned*)((LAS unsigned char*)idxl + 65536 + R * 8 + 4 * h) = (__builtin_bit_cast(unsigned, t1[0]) & 0x7Fu) | ((__builtin_bit_cast(unsigned, t1[1]) & 0x7Fu) << 8) | ((__builtin_bit_cast(unsigned, t2[0]) & 0x7Fu) << 16) | ((__builtin_bit_cast(unsigned, t2[1]) & 0x7Fu) << 24);
#endif
#if TOPK_DBG_COMPARE == 4
        *(LAS unsigned*)((LAS unsigned char*)idxl + 65536 + R * 8 + 4 * h) = (__builtin_bit_cast(unsigned, F[TOPK_DBG_K0]) & 0x7Fu) | ((__builtin_bit_cast(unsigned, F[TOPK_DBG_K0 + 1]) & 0x7Fu) << 8) | ((__builtin_bit_cast(unsigned, F[TOPK_DBG_K0 + 2]) & 0x7Fu) << 16) | ((__builtin_bit_cast(unsigned, F[TOPK_DBG_K0 + 3]) & 0x7Fu) << 24);
#endif
        float v1[16], v2[16];
#pragma unroll
        for (int k = 0; k < 16; ++k) { auto rr = __builtin_amdgcn_permlane32_swap(__builtin_bit_cast(unsigned, F[k]), __builtin_bit_cast(unsigned, F[k]), false, false);
            const unsigned r0 = rr[0], r1 = rr[1]; v1[k] = __builtin_bit_cast(float, r0 & ~0x7Fu); v2[k] = __builtin_bit_cast(float, r1 & ~0x7Fu); }
        float cg[4][16];
#pragma unroll
        for (int a = 0; a < 4; ++a)
#pragma unroll
            for (int k = 0; k < 16; ++k) cg[a][k] = -1e30f;
#define CAND(i, j) __builtin_bit_cast(float, (__builtin_bit_cast(unsigned, v1[i] + v2[j]) & ~0xFFu) | (unsigned)((i) * 16 + (j)))
        cg[0][0] = CAND(0, 0);
        cg[0][1] = CAND(0, 1);
        cg[0][2] = CAND(0, 2);
        cg[0][3] = CAND(0, 3);
        cg[0][4] = CAND(0, 4);
        cg[0][5] = CAND(0, 5);
        cg[0][6] = CAND(0, 6);
        cg[0][7] = CAND(0, 7);
        cg[0][8] = CAND(0, 8);
        cg[0][9] = CAND(0, 9);
        cg[0][10] = CAND(0, 10);
        cg[0][11] = CAND(0, 11);
        cg[0][12] = CAND(0, 12);
        cg[0][13] = CAND(0, 13);
        cg[0][14] = CAND(0, 14);
        cg[0][15] = CAND(0, 15);
        cg[1][0] = CAND(1, 0);
        cg[1][1] = CAND(1, 1);
        cg[1][2] = CAND(1, 2);
        cg[1][3] = CAND(1, 3);
        cg[1][4] = CAND(1, 4);
        cg[1][5] = CAND(1, 5);
        cg[1][6] = CAND(1, 6);
        cg[1][7] = CAND(1, 7);
        cg[1][8] = CAND(2, 0);
        cg[1][9] = CAND(2, 1);
        cg[1][10] = CAND(2, 2);
        cg[1][11] = CAND(2, 3);
        cg[1][12] = CAND(2, 4);
        cg[1][13] = CAND(3, 0);
        cg[1][14] = CAND(3, 1);
        cg[1][15] = CAND(3, 2);
        cg[2][0] = CAND(3, 3);
        cg[2][1] = CAND(4, 0);
        cg[2][2] = CAND(4, 1);
        cg[2][3] = CAND(4, 2);
        cg[2][4] = CAND(5, 0);
        cg[2][5] = CAND(5, 1);
        cg[2][6] = CAND(6, 0);
        cg[2][7] = CAND(6, 1);
        cg[2][8] = CAND(7, 0);
        cg[2][9] = CAND(7, 1);
        cg[2][10] = CAND(8, 0);
        cg[2][11] = CAND(9, 0);
        cg[2][12] = CAND(10, 0);
        cg[2][13] = CAND(11, 0);
        cg[2][14] = CAND(12, 0);
        cg[2][15] = CAND(13, 0);
        cg[3][0] = CAND(14, 0);
        cg[3][1] = CAND(15, 0);
#undef CAND
        sort16_desc(cg[0]); sort16_desc(cg[1]); sort16_desc(cg[2]); sort16_desc(cg[3]);
        merge_top16(cg[0], cg[1]); merge_top16(cg[2], cg[3]); merge_top16(cg[0], cg[2]);
        float es = 0.f, e[16];
        const float top = __builtin_bit_cast(float, __builtin_bit_cast(unsigned, cg[0][0]) & ~0xFFu);
#pragma unroll
        for (int k = 0; k < 16; ++k) { e[k] = __expf(__builtin_bit_cast(float, __builtin_bit_cast(unsigned, cg[0][k]) & ~0xFFu) - top); es += e[k]; }
        const float inv = 1.0f / es;
        LDS_WAIT();
        unsigned id[8]; float gt[8];
#pragma unroll
        for (int k = 0; k < 8; ++k) { const float clo_ = cg[0][k], chi_ = cg[0][8 + k], elo_ = e[k], ehi_ = e[8 + k]; const unsigned code = __builtin_bit_cast(unsigned, h ? chi_ : clo_) & 0xFFu; gt[k] = (h ? ehi_ : elo_) * inv;
            id[k] = (unsigned)slot[code >> 4] * 128u + (unsigned)slot[16 + (code & 15u)]; }
        LDS_WAIT();
        LAS v4u* ip = (LAS v4u*)(idxl + R * 16 + 8 * h); LAS f32x4* gp = (LAS f32x4*)(gatel + R * 16 + 8 * h);
#if !TOPK_DBG_GATES_ONLY
        { v4u a; a.x = id[0]; a.y = id[1]; a.z = id[2]; a.w = id[3]; ip[0] = a; v4u b; b.x = id[4]; b.y = id[5]; b.z = id[6]; b.w = id[7]; ip[1] = b; }
#else
        (void)ip;
#endif
        { f32x4 a; a[0] = gt[0]; a[1] = gt[1]; a[2] = gt[2]; a[3] = gt[3]; gp[0] = a; f32x4 b; b[0] = gt[4]; b[1] = gt[5]; b[2] = gt[6]; b[3] = gt[7]; gp[1] = b; }
    }
}

__device__ __forceinline__ void peer_topk_unit(const Ptrs& P, const LAS bf16* k1l, const LAS bf16* k2l, LAS int* idxl, LAS float* gatel, int unit, int tid) {
    const int tl = tid >> 3, h = tid & 7;
    const bf16* qrow = P.QP + (size_t)(unit * 64 + tl) * 2048 + h * 256;
    float v1[16], v2[16];
    topk_half(qrow, k1l, v1);
    topk_half(qrow + 128, k2l, v2);
    int bad4 = 0;
#if TOPK_DBG_COMPARE == 4
    { const LAS unsigned char* sl = (const LAS unsigned char*)idxl + 65536 + tid * 8;
#pragma unroll
      for (int k = 0; k < 4; ++k) {
          if (TOPK_DBG_SEL != 2 && (unsigned)sl[k] != (__builtin_bit_cast(unsigned, v1[TOPK_DBG_K0 + k]) & 0x7Fu)) bad4 = 1;
          if (TOPK_DBG_SEL != 1 && (unsigned)sl[4 + k] != (__builtin_bit_cast(unsigned, v2[TOPK_DBG_K0 + k]) & 0x7Fu)) bad4 = 1; }
      LDS_WAIT(); }
#endif
#if TOPK_DBG_COMPARE >= 6
    { const LAS unsigned char* sl = (const LAS unsigned char*)idxl + 65536 + tid * 8;
      const unsigned a1 = __builtin_bit_cast(unsigned, v1[0]) & 0x7Fu, a2 = __builtin_bit_cast(unsigned, v2[0]) & 0x7Fu;
      if (TOPK_DBG_SEL != 2 && a1 != (unsigned)sl[0] && a1 != (unsigned)sl[4]) bad4 = 1;
      if (TOPK_DBG_SEL != 1 && a2 != (unsigned)sl[2] && a2 != (unsigned)sl[6]) bad4 = 1;
      LDS_WAIT(); }
#endif
    (void)bad4;
    float tv[16]; int tp[16];
#pragma unroll
    for (int k = 0; k < 16; ++k) { tv[k] = -INFINITY; tp[k] = 0; }
#pragma unroll
    for (int i = 0; i < 16; ++i)
#pragma unroll
        for (int j = 0; j < 16; ++j)
            if ((i + 1) * (j + 1) <= 16) {
                const unsigned b1 = __builtin_bit_cast(unsigned, v1[i]), b2 = __builtin_bit_cast(unsigned, v2[j]);
                float x = __builtin_bit_cast(float, b1 & ~0x7Fu) + __builtin_bit_cast(float, b2 & ~0x7Fu);
                int px = (int)((b1 & 0x7Fu) * 128u + (b2 & 0x7Fu));
#pragma unroll
                for (int k = 0; k < 16; ++k) { const bool c = x > tv[k]; const float nv = c ? x : tv[k], nx = c ? tv[k] : x; const int np = c ? px : tp[k], npx = c ? tp[k] : px; tv[k] = nv; x = nx; tp[k] = np; px = npx; }
            }
    float e[16], es = 0.f;
#pragma unroll
    for (int k = 0; k < 16; ++k) { e[k] = __expf(tv[k] - tv[0]); es += e[k]; }
    const float inv = 1.0f / es;
    LAS v4u* ip = (LAS v4u*)(idxl + tl * 128 + h * 16); LAS f32x4* gp = (LAS f32x4*)(gatel + tl * 128 + h * 16);
#if TOPK_DBG_COMPARE
    { int bad = bad4; unsigned hs_old = 0, hs_new = 0, hx_old = 0, hx_new = 0;
#pragma unroll
      for (int k = 0; k < 16; ++k) { const int ni = idxl[tl * 128 + h * 16 + k]; const float ng = gatel[tl * 128 + h * 16 + k];
          hs_old += (unsigned)tp[k]; hs_new += (unsigned)ni; hx_old ^= (unsigned)tp[k] * 2654435761u; hx_new ^= (unsigned)ni * 2654435761u;
          if (TOPK_DBG_COMPARE == 1 && (k >= TOPK_DBG_K0 && k < TOPK_DBG_K1) && ni != tp[k]) bad = 1;
          if (TOPK_DBG_COMPARE == 3 && (k >= TOPK_DBG_K0 && k < TOPK_DBG_K1) && fabsf(ng - e[k] * inv) > 2e-3f) bad = 1; }
      if (TOPK_DBG_COMPARE == 2 && (hs_old != hs_new || hx_old != hx_new)) bad = 1;
      ((LAS int*)((LAS unsigned char*)idxl + 65536 + 4096))[tid] = bad; }
#endif
#pragma unroll
    for (int k = 0; k < 4; ++k) { v4u iv; iv.x = (unsigned)tp[4 * k]; iv.y = (unsigned)tp[4 * k + 1]; iv.z = (unsigned)tp[4 * k + 2]; iv.w = (unsigned)tp[4 * k + 3]; ip[k] = iv;
        f32x4 gv; gv[0] = e[4 * k] * inv; gv[1] = e[4 * k + 1] * inv; gv[2] = e[4 * k + 2] * inv; gv[3] = e[4 * k + 3] * inv; gp[k] = gv; }
}

#if PEER_FP8
typedef float f32x2p __attribute__((ext_vector_type(2)));
__device__ __forceinline__ unsigned fp8lo_bf16(unsigned w) { return __builtin_bit_cast(unsigned, __builtin_amdgcn_cvt_scalef32_pk_bf16_fp8((int)w, 1.0f, false)); }
__device__ __forceinline__ unsigned fp8hi_bf16(unsigned w) { return __builtin_bit_cast(unsigned, __builtin_amdgcn_cvt_scalef32_pk_bf16_fp8((int)w, 1.0f, true)); }
template <bool STORE> __device__ __forceinline__ void peer_gather_token(const Ptrs& P, const LAS int* idxl, const LAS float* gatel, LAS float* al, int tl, size_t t, int lane, int wave) {
    asm volatile("" : "+v"(lane));
    const int sub = lane & 15, grp = lane >> 4;
    v4u hnr[4][2];
#pragma unroll
    for (int j = 0; j < 4; ++j) { const v4u* hp = (const v4u*)(P.HN2 + t * 1024 + (j * 16 + sub) * 16); hnr[j][0] = hp[0]; hnr[j][1] = hp[1]; }
    const LAS int* myidx = idxl + tl * 128;
    v4u w[4][4]; float sc[4];
#define ULOAD(B, Q) do { const int row_ = myidx[4 * (Q) + grp]; const v4u* up_ = (const v4u*)(P.U8 + (size_t)row_ * 1024) + sub; \
        _Pragma("unroll") for (int j = 0; j < 4; ++j) w[B][j] = up_[j * 16]; sc[B] = P.USC[row_]; } while (0)
#define UCOMP(B, Q) do { float a0 = 0.f, a1 = 0.f, a2 = 0.f, a3 = 0.f; \
        _Pragma("unroll") for (int j = 0; j < 4; ++j) { const v4u x_ = w[B][j]; \
            a0 = dot2bf(fp8lo_bf16(x_.x), hnr[j][0].x, a0); a1 = dot2bf(fp8hi_bf16(x_.x), hnr[j][0].y, a1); a2 = dot2bf(fp8lo_bf16(x_.y), hnr[j][0].z, a2); a3 = dot2bf(fp8hi_bf16(x_.y), hnr[j][0].w, a3); \
            a0 = dot2bf(fp8lo_bf16(x_.z), hnr[j][1].x, a0); a1 = dot2bf(fp8hi_bf16(x_.z), hnr[j][1].y, a1); a2 = dot2bf(fp8lo_bf16(x_.w), hnr[j][1].z, a2); a3 = dot2bf(fp8hi_bf16(x_.w), hnr[j][1].w, a3); } \
        float acc_ = row16_sum((a0 + a1) + (a2 + a3)); \
        if (sub == 0) al[wave * 128 + 4 * (Q) + grp] = acc_ * sc[B]; } while (0)
    ULOAD(0, 0); ULOAD(1, 1); ULOAD(2, 2);
#pragma unroll 1
    for (int q = 0; q < 32; q += 4) {
        ULOAD(3, q + 3); UCOMP(0, q);
        if (q + 4 < 32) ULOAD(0, q + 4);
        UCOMP(1, q + 1);
        if (q + 4 < 32) ULOAD(1, q + 5);
        UCOMP(2, q + 2);
        if (q + 4 < 32) ULOAD(2, q + 6);
        UCOMP(3, q + 3);
    }
#undef ULOAD
#undef UCOMP
    LDS_WAIT();
    const int ix0 = myidx[lane], ix1 = myidx[64 + lane];
    const float av0 = al[wave * 128 + lane], av1 = al[wave * 128 + 64 + lane];
    const float act0 = gelu_tanh(av0) * gatel[tl * 128 + lane] * P.VSC[ix0], act1 = gelu_tanh(av1) * gatel[tl * 128 + 64 + lane] * P.VSC[ix1];
    LDS_WAIT();
    float y[16];
#pragma unroll
    for (int k = 0; k < 16; ++k) y[k] = 0.f;
    v4u vb[2][8];
#define VLOAD(B, IX, E0) do { _Pragma("unroll") for (int k = 0; k < 8; ++k) { const int row_ = __builtin_amdgcn_readlane(IX, (E0) + k); vb[B][k] = *((const v4u*)(P.V8 + (size_t)row_ * 1024) + lane); } } while (0)
#define VCOMP(B, ACT, E0) do { _Pragma("unroll") for (int k = 0; k < 8; ++k) { const float a_ = __builtin_bit_cast(float, __builtin_amdgcn_readlane(__builtin_bit_cast(int, ACT), (E0) + k)); const v4u x_ = vb[B][k]; \
        f32x2p d_; d_ = __builtin_amdgcn_cvt_pk_f32_fp8((int)x_.x, false); y[0] += a_ * d_[0]; y[1] += a_ * d_[1]; d_ = __builtin_amdgcn_cvt_pk_f32_fp8((int)x_.x, true); y[2] += a_ * d_[0]; y[3] += a_ * d_[1]; \
        d_ = __builtin_amdgcn_cvt_pk_f32_fp8((int)x_.y, false); y[4] += a_ * d_[0]; y[5] += a_ * d_[1]; d_ = __builtin_amdgcn_cvt_pk_f32_fp8((int)x_.y, true); y[6] += a_ * d_[0]; y[7] += a_ * d_[1]; \
        d_ = __builtin_amdgcn_cvt_pk_f32_fp8((int)x_.z, false); y[8] += a_ * d_[0]; y[9] += a_ * d_[1]; d_ = __builtin_amdgcn_cvt_pk_f32_fp8((int)x_.z, true); y[10] += a_ * d_[0]; y[11] += a_ * d_[1]; \
        d_ = __builtin_amdgcn_cvt_pk_f32_fp8((int)x_.w, false); y[12] += a_ * d_[0]; y[13] += a_ * d_[1]; d_ = __builtin_amdgcn_cvt_pk_f32_fp8((int)x_.w, true); y[14] += a_ * d_[0]; y[15] += a_ * d_[1]; } } while (0)
    VLOAD(0, ix0, 0);
#pragma unroll 1
    for (int e = 0; e < 64; e += 16) { VLOAD(1, ix0, e + 8); VCOMP(0, act0, e); if (e + 16 < 64) VLOAD(0, ix0, e + 16); else VLOAD(0, ix1, 0); VCOMP(1, act0, e + 8); }
#pragma unroll 1
    for (int e = 0; e < 64; e += 16) { VLOAD(1, ix1, e + 8); VCOMP(0, act1, e); if (e + 16 < 64) VLOAD(0, ix1, e + 16); VCOMP(1, act1, e + 8); }
#undef VLOAD
#undef VCOMP
    float* xr = P.out + t * 1024 + lane * 16;
    f32x4 x[4];
#pragma unroll
    for (int k = 0; k < 4; ++k) { x[k] = *(const f32x4*)(xr + 4 * k); x[k][0] += y[4 * k]; x[k][1] += y[4 * k + 1]; x[k][2] += y[4 * k + 2]; x[k][3] += y[4 * k + 3]; }
    float ss = 0.f;
#pragma unroll
    for (int k = 0; k < 4; ++k) ss += (x[k][0] * x[k][0] + x[k][1] * x[k][1]) + (x[k][2] * x[k][2] + x[k][3] * x[k][3]);
    const float rstd = 1.0f / sqrtf(wave_sum(ss) * (1.0f / 1024.0f) + EPS);
    if (STORE) {
#if TOPK_DBG_COMPARE
        { const LAS int* fl = (const LAS int*)((const LAS unsigned char*)idxl + 65536 + 4096) + tl * 8; int bad = 0;
#pragma unroll
          for (int hh = 0; hh < 8; ++hh) bad |= fl[hh];
          if (bad) {
#pragma unroll
              for (int k = 0; k < 4; ++k) x[k] = x[k] * 0.f; } }
#endif
#pragma unroll
        for (int k = 0; k < 4; ++k) { const f32x4 wv = *(const f32x4*)(P.fin_w + lane * 16 + 4 * k); *(f32x4*)(xr + 4 * k) = x[k] * rstd * wv; }
    } else { asm volatile("" :: "v"(rstd), "v"(x[0][0]), "v"(x[1][1]), "v"(x[2][2]), "v"(x[3][3])); }
}
#else
template <bool STORE> __device__ __forceinline__ void peer_gather_token(const Ptrs& P, const LAS int* idxl, const LAS float* gatel, LAS float* al, int tl, size_t t, int lane, int wave) {
    const int sub = lane & 15, grp = lane >> 4;
    v4u hnr[8];
#pragma unroll
    for (int j = 0; j < 8; ++j) hnr[j] = *((const v4u*)(P.HN2 + t * 1024) + j * 16 + sub);
    for (int q = 0; q < 32; ++q) {
        const int row = idxl[tl * 128 + 4 * q + grp];
        const v4u* up = (const v4u*)(P.U + (size_t)row * 1024) + sub;
        float a0 = 0.f, a1 = 0.f, a2 = 0.f, a3 = 0.f;
#pragma unroll
        for (int j = 0; j < 8; ++j) { const v4u w = up[j * 16]; a0 = dot2bf(w.x, hnr[j].x, a0); a1 = dot2bf(w.y, hnr[j].y, a1); a2 = dot2bf(w.z, hnr[j].z, a2); a3 = dot2bf(w.w, hnr[j].w, a3); }
        float acc = (a0 + a1) + (a2 + a3);
        acc += __shfl_xor(acc, 8); acc += __shfl_xor(acc, 4); acc += __shfl_xor(acc, 2); acc += __shfl_xor(acc, 1);
        if (sub == 0) al[wave * 128 + 4 * q + grp] = acc;
    }
    LDS_WAIT();
    const float av0 = al[wave * 128 + lane], av1 = al[wave * 128 + 64 + lane];
    const float act0 = gelu_tanh(av0) * gatel[tl * 128 + lane], act1 = gelu_tanh(av1) * gatel[tl * 128 + 64 + lane];
    const int ix0 = idxl[tl * 128 + lane], ix1 = idxl[tl * 128 + 64 + lane];
    LDS_WAIT();
    float y[16];
#pragma unroll
    for (int k = 0; k < 16; ++k) y[k] = 0.f;
#pragma unroll 4
    for (int e = 0; e < 64; ++e) {
        const int row = __builtin_amdgcn_readlane(ix0, e); const float a = __builtin_bit_cast(float, __builtin_amdgcn_readlane(__builtin_bit_cast(int, act0), e));
        const v4u* vp = (const v4u*)(P.V + (size_t)row * 1024) + lane; const v4u w0 = vp[0], w1 = vp[64];
        y[0] += a * bflo(w0.x); y[1] += a * bfhi(w0.x); y[2] += a * bflo(w0.y); y[3] += a * bfhi(w0.y); y[4] += a * bflo(w0.z); y[5] += a * bfhi(w0.z); y[6] += a * bflo(w0.w); y[7] += a * bfhi(w0.w);
        y[8] += a * bflo(w1.x); y[9] += a * bfhi(w1.x); y[10] += a * bflo(w1.y); y[11] += a * bfhi(w1.y); y[12] += a * bflo(w1.z); y[13] += a * bfhi(w1.z); y[14] += a * bflo(w1.w); y[15] += a * bfhi(w1.w);
    }
#pragma unroll 4
    for (int e = 0; e < 64; ++e) {
        const int row = __builtin_amdgcn_readlane(ix1, e); const float a = __builtin_bit_cast(float, __builtin_amdgcn_readlane(__builtin_bit_cast(int, act1), e));
        const v4u* vp = (const v4u*)(P.V + (size_t)row * 1024) + lane; const v4u w0 = vp[0], w1 = vp[64];
        y[0] += a * bflo(w0.x); y[1] += a * bfhi(w0.x); y[2] += a * bflo(w0.y); y[3] += a * bfhi(w0.y); y[4] += a * bflo(w0.z); y[5] += a * bfhi(w0.z); y[6] += a * bflo(w0.w); y[7] += a * bfhi(w0.w);
        y[8] += a * bflo(w1.x); y[9] += a * bfhi(w1.x); y[10] += a * bflo(w1.y); y[11] += a * bfhi(w1.y); y[12] += a * bflo(w1.z); y[13] += a * bfhi(w1.z); y[14] += a * bflo(w1.w); y[15] += a * bfhi(w1.w);
    }
    float* xr = P.out + t * 1024;
    f32x4 x0 = *(const f32x4*)(xr + lane * 8), x1 = *(const f32x4*)(xr + lane * 8 + 4), x2 = *(const f32x4*)(xr + 512 + lane * 8), x3 = *(const f32x4*)(xr + 512 + lane * 8 + 4);
    x0[0] += y[0]; x0[1] += y[1]; x0[2] += y[2]; x0[3] += y[3]; x1[0] += y[4]; x1[1] += y[5]; x1[2] += y[6]; x1[3] += y[7];
    x2[0] += y[8]; x2[1] += y[9]; x2[2] += y[10]; x2[3] += y[11]; x3[0] += y[12]; x3[1] += y[13]; x3[2] += y[14]; x3[3] += y[15];
    float ss = 0.f;
#pragma unroll
    for (int k = 0; k < 4; ++k) ss += x0[k] * x0[k] + x1[k] * x1[k] + x2[k] * x2[k] + x3[k] * x3[k];
    const float rstd = 1.0f / sqrtf(wave_sum(ss) * (1.0f / 1024.0f) + EPS);
    if (STORE) {
        const f32x4 w0 = *(const f32x4*)(P.fin_w + lane * 8), w1 = *(const f32x4*)(P.fin_w + lane * 8 + 4), w2 = *(const f32x4*)(P.fin_w + 512 + lane * 8), w3 = *(const f32x4*)(P.fin_w + 512 + lane * 8 + 4);
        *(f32x4*)(xr + lane * 8) = x0 * rstd * w0; *(f32x4*)(xr + lane * 8 + 4) = x1 * rstd * w1; *(f32x4*)(xr + 512 + lane * 8) = x2 * rstd * w2; *(f32x4*)(xr + 512 + lane * 8 + 4) = x3 * rstd * w3;
    } else { asm volatile("" :: "v"(rstd), "v"(x0[0]), "v"(x1[1]), "v"(x2[2]), "v"(x3[3])); }
}
#endif

__device__ __forceinline__ void p7_peer(LAS unsigned char* lds, const Ptrs& P, int vcu, int G, int tid, int lane, int wave) {
    LAS bf16* k1l = (LAS bf16*)lds;
    LAS bf16* k2l = (LAS bf16*)(lds + 32768);
    LAS int* idxl = (LAS int*)(lds + 65536);
    LAS float* gatel = (LAS float*)(lds + 98304);
    LAS float* al = (LAS float*)(lds + 131072);
#if TOPK_MFMA && KEY_SWZ
    for (int i = tid; i < 2048; i += 512) { const int n = i >> 4, c = i & 15, d = n * 16 + (c ^ (n & 15)); ((LAS v4u*)k1l)[d] = ((const v4u*)P.K1)[i]; ((LAS v4u*)k2l)[d] = ((const v4u*)P.K2)[i]; }
#else
    for (int i = tid; i < 2048; i += 512) { ((LAS v4u*)k1l)[i] = ((const v4u*)P.K1)[i]; ((LAS v4u*)k2l)[i] = ((const v4u*)P.K2)[i]; }
#endif
    __syncthreads();
    for (int unit = vcu; unit < M / 64; unit += G) {
#if TOPK_DBG_COMPARE
        peer_topk_unit_mfma(P, (const LAS unsigned char*)k1l, (const LAS unsigned char*)k2l, idxl, gatel, unit, lane, wave);
        __syncthreads();
        peer_topk_unit(P, k1l, k2l, idxl, gatel, unit, tid);
#elif TOPK_DBG_GATES_ONLY
        peer_topk_unit(P, k1l, k2l, idxl, gatel, unit, tid);
        __syncthreads();
        peer_topk_unit_mfma(P, (const LAS unsigned char*)k1l, (const LAS unsigned char*)k2l, idxl, gatel, unit, lane, wave);
#elif TOPK_MFMA
        peer_topk_unit_mfma(P, (const LAS unsigned char*)k1l, (const LAS unsigned char*)k2l, idxl, gatel, unit, lane, wave);
#else
        peer_topk_unit(P, k1l, k2l, idxl, gatel, unit, tid);
#endif
#if PROBE_TOPK_REPS > 1
        __syncthreads();
#if TOPK_MFMA
        peer_topk_unit_mfma(P, (const LAS unsigned char*)k1l, (const LAS unsigned char*)k2l, idxl, gatel, unit, lane, wave);
#else
        peer_topk_unit(P, k1l, k2l, idxl, gatel, unit, tid);
#endif
#endif
        __syncthreads();
#if PROBE_GATHER_REPS > 1
#pragma unroll 1
        for (int i = 0; i < 8; ++i) peer_gather_token<false>(P, idxl, gatel, al, wave * 8 + i, (size_t)unit * 64 + wave * 8 + i, lane, wave);
#endif
#pragma unroll 1
        for (int i = 0; i < 8; ++i) peer_gather_token<true>(P, idxl, gatel, al, wave * 8 + i, (size_t)unit * 64 + wave * 8 + i, lane, wave);
        __syncthreads();
    }
}

struct Args { const float* in[19]; float* out; unsigned char* ws; int ph_lo, ph_hi; };
__global__ void __launch_bounds__(NWAVES * 64, 2) mega_fwd(Args args) {
    extern __shared__ __attribute__((aligned(16))) unsigned char lds_raw[];
    LAS unsigned char* lds = (LAS unsigned char*)lds_raw;
    const int tid = threadIdx.x, lane = tid & 63, wave = __builtin_amdgcn_readfirstlane(tid >> 6);
    const int G = gridDim.x; const int bx = blockIdx.x; const int vcu = (G % 8 == 0) ? (bx % 8) * (G / 8) + bx / 8 : bx;
    unsigned char* ws = args.ws;
    Ptrs P;
    P.x = args.in[0]; P.mix_w = args.in[1]; P.w_in = args.in[2]; P.rel_bias = args.in[3]; P.sinks = args.in[4]; P.w_pa = args.in[5]; P.ln_w = args.in[6]; P.ln_b = args.in[7];
    P.w_s = args.in[8]; P.b_s = args.in[9]; P.w_pb = args.in[10]; P.w_out = args.in[11]; P.ffn_w = args.in[12]; P.w_q = args.in[13]; P.keys1 = args.in[14]; P.keys2 = args.in[15];
    P.pu = args.in[16]; P.pv = args.in[17]; P.fin_w = args.in[18]; P.out = args.out;
    P.WIN = (bf16*)(ws + WS_WIN); P.WPA = (bf16*)(ws + WS_WPA); P.WPB = (bf16*)(ws + WS_WPB); P.WOUT = (bf16*)(ws + WS_WOUT); P.WQ = (bf16*)(ws + WS_WQ);
    P.K1 = (bf16*)(ws + WS_K1); P.K2 = (bf16*)(ws + WS_K2); P.WS = (bf16*)(ws + WS_WS); P.U = (bf16*)(ws + WS_U); P.V = (bf16*)(ws + WS_V);
    P.U8 = ws + WS_U; P.V8 = ws + WS_U + 16 * MiB; P.USC = (float*)(ws + WS_V); P.VSC = (float*)(ws + WS_V + 65536);
    P.XN = (bf16*)(ws + WS_R1); P.AOUT = (bf16*)(ws + WS_R1); P.BOUT = (bf16*)(ws + WS_R1 + 16 * MiB); P.HN2 = (bf16*)(ws + WS_R1);
    P.Q = (bf16*)(ws + WS_Q); P.KV = (bf16*)(ws + WS_KV); P.GU = (bf16*)(ws + WS_GU); P.GV = (bf16*)(ws + WS_GV); P.GA = (bf16*)(ws + WS_GA); P.GB = (bf16*)(ws + WS_GB);
    P.MERGED = (bf16*)(ws + WS_MERGED); P.QP = (bf16*)(ws + WS_QP);

    for (int u = tid; u < (LDS_BYTES - MISC_OFF) / 4; u += NWAVES * 64) ((LAS unsigned*)(lds + MISC_OFF))[u] = 0u;
    __syncthreads();
    const int lo = args.ph_lo, hi = args.ph_hi;
    unsigned* barw = (unsigned*)(ws + WS_CTL) + CW_BAR;
    XcdBarrier bar; bar.bar = barw; bar.x = 0; bar.st = nullptr;
    if (hi - lo > 1) bar = xcd_barrier_post(barw, (volatile LAS unsigned*)(lds + MISC_OFF));
#define IN(k) (lo <= (k) && (k) < hi)
#define BOTH(k) (IN(k) && IN((k) + 1))
#define GRID_BAR() xcd_barrier(bar)

    if (IN(0)) { p0_prologue(lds, P, vcu, G, lane, wave); if (BOTH(0)) GRID_BAR(); }

    if (IN(1)) {
        pg8::Gemm g{P.XN, P.WIN, M, NZ, D}; pg8::StaticOrder S; S.init(M, NZ, G, bx);
        pg8::EpiZ E{P.Q, P.KV, P.GU, P.GV, P.GA, P.GB};
        pg8::gemm_phase<pg8::EpiZ, pg8::StaticOrder, PG8_ALIGN, PG8_SP2>(lds, g, S, E);
        if (BOTH(1)) GRID_BAR();
    }

    if (IN(2)) {
        for (int rep = 0; rep < PROBE_P2_REPS; ++rep) {
#if ATTN_MFMA
        p2_attn_mfma(lds, P, vcu, G, tid, lane, wave);
#else
        p2_attn_naive(lds, P, vcu, G, tid, lane, wave);
#endif
#if GMLP_MFMA
        p2_gmlp_mfma(lds, P, vcu, G, tid, lane, wave);
#else
        p2_gmlp_naive(lds, P, vcu, G, tid, lane, wave);
#endif
        }
        if (BOTH(2)) GRID_BAR();
    }

    if (IN(3)) {
        { pg8::Gemm g{P.AOUT, P.WPA, M, D, 512}; pg8::StaticOrder S; S.init(M, D, G, bx);
          pg8::EpiGateTmp E{P.GA, P.out};
          pg8::gemm_phase<pg8::EpiGateTmp, pg8::StaticOrder, PG8_ALIGN, PG8_SP2>(lds, g, S, E); }
        { pg8::Gemm g{P.BOUT, P.WPB, M, D, 512}; pg8::StaticOrder S; S.init(M, D, G, bx);
          pg8::EpiMerge E{P.GB, P.out, P.MERGED};
          pg8::gemm_phase<pg8::EpiMerge, pg8::StaticOrder, PG8_ALIGN, PG8_SP2>(lds, g, S, E); }
        if (BOTH(3)) GRID_BAR();
    }

    if (IN(4)) {
        pg8::Gemm g{P.MERGED, P.WOUT, M, D, D}; pg8::StaticOrder S; S.init(M, D, G, bx);
        pg8::EpiRes E{P.x, P.out};
        pg8::gemm_phase<pg8::EpiRes, pg8::StaticOrder, PG8_ALIGN, PG8_SP2>(lds, g, S, E);
        if (BOTH(4)) GRID_BAR();
    }

    if (IN(5)) {
        const int gw = vcu * NWAVES + wave, NGW = G * NWAVES;
        for (int m = gw; m < M; m += NGW) rms_row_to_bf16(P.out + (size_t)m * D, P.ffn_w, P.HN2 + (size_t)m * D, lane);
        if (BOTH(5)) GRID_BAR();
    }

    if (IN(6)) {
        pg8::Gemm g{P.HN2, P.WQ, M, 2048, D}; pg8::StaticOrder S; S.init(M, 2048, G, bx);
        pg8::EpiPlain E{P.QP, 2048};
        pg8::gemm_phase<pg8::EpiPlain, pg8::StaticOrder, PG8_ALIGN, PG8_SP2>(lds, g, S, E);
        if (BOTH(6)) GRID_BAR();
    }

    if (IN(7)) p7_peer(lds, P, vcu, G, tid, lane, wave);
#undef IN
#undef BOTH
#undef GRID_BAR
}

extern "C" void kernel_launch(void* const* d_in, const int* in_sizes, int n_in, void* d_out, int out_size, void* d_ws, size_t ws_size, hipStream_t stream) {
    static int grid = 0;
    if (grid == 0) {
        if (n_in != 19 || out_size != M * D || ws_size < WS_END) { fprintf(stderr, "kernel_launch: unexpected shapes (n_in %d, out %d, ws %zu)\n", n_in, out_size, ws_size); grid = -1; return; }
        int dev = 0, cus = 0, per_cu = 0;
        if (hipGetDevice(&dev) != hipSuccess || hipDeviceGetAttribute(&cus, hipDeviceAttributeMultiprocessorCount, dev) != hipSuccess) { grid = -1; return; }
        if (hipFuncSetAttribute((const void*)mega_fwd, hipFuncAttributeMaxDynamicSharedMemorySize, LDS_BYTES) != hipSuccess) { fprintf(stderr, "kernel_launch: hipFuncSetAttribute failed\n"); grid = -1; return; }
        if (hipOccupancyMaxActiveBlocksPerMultiprocessor(&per_cu, (const void*)mega_fwd, NWAVES * 64, LDS_BYTES) != hipSuccess || per_cu < 1)
            fprintf(stderr, "kernel_launch: note: occupancy query reports %d workgroups per CU\n", per_cu);
        (void)hipGetLastError();
        grid = cus;
    }
    if (grid < 0) return;
    if (hipMemsetAsync((char*)d_ws + WS_CTL, 0, CTL_ZERO_BYTES, stream) != hipSuccess) return;
    Args a{};
    for (int i = 0; i < 19; ++i) a.in[i] = (const float*)d_in[i];
    a.out = (float*)d_out; a.ws = (unsigned char*)d_ws;
#if MK_N_LAUNCHES == 1
    a.ph_lo = 0; a.ph_hi = N_PHASES;
    hipLaunchKernelGGL(mega_fwd, dim3(grid), dim3(NWAVES * 64), LDS_BYTES, stream, a);
#else
    for (int li = 0; li < N_PHASES; ++li) { a.ph_lo = li; a.ph_hi = li + 1; hipLaunchKernelGGL(mega_fwd, dim3(grid), dim3(NWAVES * 64), LDS_BYTES, stream, a); }
#endif
}
```

```cpp
#include <hip/hip_runtime.h>
#include <cstdio>
#include <cstdint>
namespace pg8 {
#define PG8_LAS __attribute__((address_space(3)))
typedef unsigned short bf16_t;
typedef short bf16x8 __attribute__((ext_vector_type(8)));
typedef float f32x4 __attribute__((ext_vector_type(4)));
typedef unsigned u32x4 __attribute__((ext_vector_type(4)));
constexpr int BM = 256, BK = 64, HALF = 128, HTB = HALF * BK * 2  , STAGE_BYTES = 8 * HTB, NXCD = 8, WGM = 8;

__host__ __device__ __forceinline__ int lds_byte(int r, int c) { const int st = (r >> 4) * 2 + (c >> 5), rr = r & 15, cc = c & 31, ob = rr * 64 + cc * 2; return st * 1024 + (ob ^ (((ob >> 9) & 1) << 5)); }
__host__ __device__ __forceinline__ void stage_rc(int b, int& R, int& C) { const int st = b / 1024, sb = b % 1024, swz = sb ^ (((sb >> 9) & 1) << 5); R = (st >> 1) * 16 + swz / 64; C = (st & 1) * 32 + (swz % 64) / 2; }
__host__ __device__ __forceinline__ int perm32(int rho) { const int n = rho >> 4, i = rho & 15; return 8 * (i >> 2) + 4 * n + (i & 3); }

struct Unit { int pm, pn; };
struct Gemm { const bf16_t* A; const bf16_t* Bt; int M, N, K; };

struct StaticOrder {
    int nM, nN, nwg, G, c;
    __host__ __device__ void init(int M, int N, int G_, int c_) { nM = M / BM; nN = N / BM; nwg = nM * nN; G = G_; c = c_; }
    __host__ __device__ bool next(int i, Unit& u) const {
        const long L = (long)i * G + c; if (L >= nwg) return false;
        int wgid = (int)L; { const int q = nwg / NXCD, r = nwg % NXCD, xcd = wgid % NXCD, off = wgid / NXCD; wgid = (xcd < r ? xcd * (q + 1) : r * (q + 1) + (xcd - r) * q) + off; }
        const int nig = WGM * nN, gid = wgid / nig, fm = gid * WGM, gsz = (nM - fm) < WGM ? (nM - fm) : WGM;
        u.pm = fm + ((wgid % nig) % gsz); u.pn = (wgid % nig) / gsz; return true;
    }
    __device__ __forceinline__ void a_ready(const Unit&) const {}
    __device__ __forceinline__ void done(const Unit&) const {}
};

__device__ __forceinline__ unsigned cvt_pk_bf16(float lo, float hi) { unsigned r; asm volatile("v_cvt_pk_bf16_f32 %0, %1, %2" : "=v"(r) : "v"(lo), "v"(hi)); return r; }
typedef float f32x2 __attribute__((ext_vector_type(2)));
template <class Epi, class Sched, bool ALIGN_EPI = false, bool SP2 = false>
__device__ __forceinline__ void gemm_phase(PG8_LAS unsigned char* lds, const Gemm g, const Sched& S, const Epi& E) {
    const int tid = threadIdx.x, wid = __builtin_amdgcn_readfirstlane(tid >> 6), lane = tid & 63, wr = wid >> 2, wc = wid & 3, fr = lane & 15, fq = lane >> 4;
    const int K = g.K, nt = K / BK;
    unsigned voffA[2], voffB[2];
#pragma unroll
    for (int i = 0; i < 2; ++i) { int R, C; stage_rc(tid * 16 + i * 8192, R, C); const int Rb = Epi::PERM ? ((R & ~31) + perm32(R & 31)) : R;
        voffA[i] = (unsigned)(R * K + C) * 2u; voffB[i] = (unsigned)(Rb * K + C) * 2u; }
    const size_t kstep = (size_t)(BK * 2);
    const size_t hstep = (size_t)HALF * K * 2;
    const size_t tstep = 2 * hstep;
    const unsigned ldsw = (unsigned)wid * 1024u;
    const int aoff = lds_byte(wr * 64 + fr, fq * 8), boff = lds_byte(wc * 32 + fr, fq * 8);
#define PG8_SA(b, h) (((b) * 2 + (h)) * HTB)
#define PG8_SB(b, h) ((4 + (b) * 2 + (h)) * HTB)
#define PG8_STAGE(bufoff, gbase, voff) do { _Pragma("unroll") for (int _i = 0; _i < 2; ++_i) \
        __builtin_amdgcn_global_load_lds((const unsigned*)((const char*)(gbase) + (voff)[_i]), (PG8_LAS unsigned*)(lds + (bufoff) + ldsw + _i * 8192), 16, 0, 0); } while (0)
#define PG8_LDA(dst, b, h) do { _Pragma("unroll") for (int m = 0; m < 4; ++m) _Pragma("unroll") for (int k = 0; k < 2; ++k) dst[m][k] = *(const PG8_LAS bf16x8*)(lds + PG8_SA(b, h) + aoff + m * 2048 + k * 1024); } while (0)
#define PG8_LDB(dst, b, h) do { _Pragma("unroll") for (int n = 0; n < 2; ++n) _Pragma("unroll") for (int k = 0; k < 2; ++k) dst[n][k] = *(const PG8_LAS bf16x8*)(lds + PG8_SB(b, h) + boff + n * 2048 + k * 1024); } while (0)
#define PG8_MMA(ai, bj, At, Bt) do { __builtin_amdgcn_s_setprio(1); _Pragma("unroll") for (int m = 0; m < 4; ++m) _Pragma("unroll") for (int n = 0; n < 2; ++n) _Pragma("unroll") for (int k = 0; k < 2; ++k) \
        acc[ai][bj][m][n] = __builtin_amdgcn_mfma_f32_16x16x32_bf16(Bt[n][k], At[m][k], acc[ai][bj][m][n], 0, 0, 0); __builtin_amdgcn_s_setprio(0); } while (0)
#define PG8_WAIT_V(n) asm volatile("s_waitcnt vmcnt(" #n ")" ::: "memory")
#define PG8_WAIT_L(n) asm volatile("s_waitcnt lgkmcnt(" #n ")" ::: "memory")
#define PG8_BAR __builtin_amdgcn_s_barrier()
#define PG8_SCHED __builtin_amdgcn_sched_barrier(0)
    Unit cur, nxt; int ui = 0;
    if (!S.next(0, cur)) return;
    f32x4 acc[2][2][4][2];
#pragma unroll
    for (int a = 0; a < 2; ++a)
#pragma unroll
        for (int b = 0; b < 2; ++b)
#pragma unroll
            for (int m = 0; m < 4; ++m)
#pragma unroll
                for (int n = 0; n < 2; ++n) acc[a][b][m][n] = (f32x4){0.f, 0.f, 0.f, 0.f};
    bf16x8 At[4][2], B0[2][2], B1[2][2];
    const char* cA = (const char*)g.A + (size_t)cur.pm * tstep; const char* cB = (const char*)g.Bt + (size_t)cur.pn * tstep;
    S.a_ready(cur);
    if constexpr (SP2) {
        PG8_STAGE(PG8_SB(0, 0), cB, voffB); PG8_STAGE(PG8_SB(0, 1), cB + hstep, voffB); PG8_STAGE(PG8_SA(0, 0), cA, voffA); PG8_STAGE(PG8_SA(0, 1), cA + hstep, voffA);
        if (wr == 1) PG8_BAR;
        PG8_WAIT_V(2); PG8_BAR;
        PG8_STAGE(PG8_SB(1, 0), cB + kstep, voffB); PG8_STAGE(PG8_SA(1, 0), cA + kstep, voffA); PG8_STAGE(PG8_SB(1, 1), cB + hstep + kstep, voffB);
        PG8_WAIT_V(6); PG8_BAR;
    } else {
        PG8_STAGE(PG8_SB(0, 0), cB, voffB); PG8_STAGE(PG8_SA(0, 0), cA, voffA); PG8_STAGE(PG8_SB(0, 1), cB + hstep, voffB); PG8_STAGE(PG8_SA(0, 1), cA + hstep, voffA);
        if (wr == 1) PG8_BAR;
        PG8_WAIT_V(4); PG8_BAR;
        PG8_STAGE(PG8_SB(1, 0), cB + kstep, voffB); PG8_STAGE(PG8_SA(1, 0), cA + kstep, voffA); PG8_STAGE(PG8_SB(1, 1), cB + hstep + kstep, voffB);
        PG8_WAIT_V(6); PG8_BAR;
    }
    for (;;) {
        const bool has_next = S.next(ui + 1, nxt);
        const char* nA = has_next ? (const char*)g.A + (size_t)nxt.pm * tstep : cA; const char* nB = has_next ? (const char*)g.Bt + (size_t)nxt.pn * tstep : cB;
        for (int t = 0; t < nt; t += 2) {
            if constexpr (Epi::HAS_MID) { if (t == (nt >> 1)) E.mid(acc, cur, wr, wc, fr, fq); }
            const bool last = (t == nt - 2);
            const char* a1 = cA + (size_t)(t + 1) * kstep;
            const char* a2 = last ? nA : cA + (size_t)(t + 2) * kstep; const char* b2 = last ? nB : cB + (size_t)(t + 2) * kstep;
            const char* a3 = a2 + kstep; const char* b3 = b2 + kstep;
            if (last && has_next) S.a_ready(nxt);
            if constexpr (SP2) {
            PG8_LDB(B0, 0, 0); PG8_LDB(B1, 0, 1); PG8_SCHED; PG8_LDA(At, 0, 0); PG8_STAGE(PG8_SA(1, 1), a1 + hstep, voffA);
            PG8_WAIT_V(8); PG8_WAIT_L(0); PG8_BAR; PG8_MMA(0, 0, At, B0); PG8_MMA(0, 1, At, B1); PG8_BAR; PG8_SCHED;
            PG8_LDA(At, 0, 1); PG8_STAGE(PG8_SB(0, 0), b2, voffB); PG8_STAGE(PG8_SB(0, 1), b2 + hstep, voffB); PG8_STAGE(PG8_SA(0, 0), a2, voffA);
            PG8_WAIT_V(8); PG8_WAIT_L(0); PG8_BAR; PG8_MMA(1, 0, At, B0); PG8_MMA(1, 1, At, B1); PG8_BAR; PG8_SCHED;
            PG8_LDB(B0, 1, 0); PG8_LDB(B1, 1, 1); PG8_SCHED; PG8_LDA(At, 1, 0); PG8_STAGE(PG8_SA(0, 1), a2 + hstep, voffA);
            PG8_WAIT_V(8); PG8_WAIT_L(0); PG8_BAR; PG8_MMA(0, 0, At, B0); PG8_MMA(0, 1, At, B1); PG8_BAR; PG8_SCHED;
            PG8_LDA(At, 1, 1); PG8_STAGE(PG8_SB(1, 0), b3, voffB); PG8_STAGE(PG8_SB(1, 1), b3 + hstep, voffB); PG8_STAGE(PG8_SA(1, 0), a3, voffA);
            PG8_WAIT_V(8); PG8_WAIT_L(0); PG8_BAR; PG8_MMA(1, 0, At, B0); PG8_MMA(1, 1, At, B1); PG8_BAR; PG8_SCHED;
            } else {
            PG8_LDB(B0, 0, 0); PG8_SCHED; PG8_LDA(At, 0, 0); PG8_STAGE(PG8_SA(1, 1), a1 + hstep, voffA);
            PG8_WAIT_L(8); PG8_BAR; PG8_WAIT_L(0); PG8_MMA(0, 0, At, B0); PG8_BAR; PG8_SCHED;
            PG8_LDB(B1, 0, 1); PG8_STAGE(PG8_SB(0, 0), b2, voffB);
            PG8_BAR; PG8_WAIT_L(0); PG8_MMA(0, 1, At, B1); PG8_BAR;
            PG8_LDA(At, 0, 1); PG8_STAGE(PG8_SA(0, 0), a2, voffA);
            PG8_BAR; PG8_WAIT_L(0); PG8_MMA(1, 0, At, B0); PG8_BAR; PG8_SCHED;
            PG8_STAGE(PG8_SB(0, 1), b2 + hstep, voffB);
            PG8_WAIT_V(6); PG8_BAR; PG8_MMA(1, 1, At, B1); PG8_BAR;
            PG8_LDB(B0, 1, 0); PG8_SCHED; PG8_LDA(At, 1, 0); PG8_STAGE(PG8_SA(0, 1), a2 + hstep, voffA);
            PG8_WAIT_L(8); PG8_BAR; PG8_WAIT_L(0); PG8_MMA(0, 0, At, B0); PG8_BAR; PG8_SCHED;
            PG8_LDB(B1, 1, 1); PG8_STAGE(PG8_SB(1, 0), b3, voffB);
            PG8_BAR; PG8_WAIT_L(0); PG8_MMA(0, 1, At, B1); PG8_BAR;
            PG8_LDA(At, 1, 1); PG8_STAGE(PG8_SA(1, 0), a3, voffA);
            PG8_BAR; PG8_WAIT_L(0); PG8_MMA(1, 0, At, B0); PG8_BAR; PG8_SCHED;
            PG8_STAGE(PG8_SB(1, 1), b3 + hstep, voffB);
            PG8_WAIT_V(6); PG8_BAR; PG8_MMA(1, 1, At, B1); PG8_BAR;
            }
        }
        if constexpr (ALIGN_EPI) { if (wr == 0) PG8_BAR; }
        if constexpr (!Epi::AFTER_DRAIN) { E(acc, cur, wr, wc, fr, fq); S.done(cur); }
        if (!has_next) break;
#pragma unroll
        for (int a = 0; a < 2; ++a)
#pragma unroll
            for (int b = 0; b < 2; ++b)
#pragma unroll
                for (int m = 0; m < 4; ++m)
#pragma unroll
                    for (int n = 0; n < 2; ++n) acc[a][b][m][n] = (f32x4){0.f, 0.f, 0.f, 0.f};
        cur = nxt; cA = nA; cB = nB; ++ui;
        if constexpr (ALIGN_EPI) { if (wr == 1) PG8_BAR; }
    }
    PG8_WAIT_V(0);
    if constexpr (!ALIGN_EPI) { if (wr == 0) PG8_BAR; }
    PG8_BAR;
    if constexpr (Epi::AFTER_DRAIN) { E.fused(acc, cur, wr, wc, fr, fq, lds, wid, lane); S.done(cur); }
#undef PG8_SA
#undef PG8_SB
#undef PG8_STAGE
#undef PG8_LDA
#undef PG8_LDB
#undef PG8_MMA
#undef PG8_WAIT_V
#undef PG8_WAIT_L
#undef PG8_BAR
#undef PG8_SCHED
}
}
#ifndef PG8_SP2
#define PG8_SP2 true
#endif
#ifndef PG8_ALIGN
#define PG8_ALIGN true
#endif

constexpr int NWAVES = 8;
#ifndef MK_N_LAUNCHES
#define MK_N_LAUNCHES 1
#endif
constexpr int N_PHASES = 8;
#ifndef ATTN_MFMA
#define ATTN_MFMA 1
#endif
#ifndef GMLP_MFMA
#define GMLP_MFMA 1
#endif
#ifndef TOPK_DBG_GATES_ONLY
#define TOPK_DBG_GATES_ONLY 0
#endif
#ifndef DBG_SHFL_WAVESUM
#define DBG_SHFL_WAVESUM 0
#endif
#ifndef TOPK_DBG_COMPARE
#define TOPK_DBG_COMPARE 0
#endif
#ifndef TOPK_DBG_SEL
#define TOPK_DBG_SEL 0
#endif
#ifndef TOPK_DBG_K0
#define TOPK_DBG_K0 0
#endif
#ifndef TOPK_DBG_K1
#define TOPK_DBG_K1 16
#endif
#ifndef TOPK_DBG_BRUTE
#define TOPK_DBG_BRUTE 0
#endif
#ifndef TOPK_DBG_INSERT
#define TOPK_DBG_INSERT 0
#endif
#ifndef TOPK_DBG_VALU_SCORES
#define TOPK_DBG_VALU_SCORES 0
#endif
#ifndef KEY_SWZ
#define KEY_SWZ (!TOPK_DBG_GATES_ONLY && !TOPK_DBG_VALU_SCORES && !TOPK_DBG_COMPARE && !TOPK_DBG_BRUTE && TOPK_DBG_INSERT != 3)
#endif
#ifndef TOPK_MFMA
#define TOPK_MFMA 1
#endif
#ifndef PROBE_V_PASSES
#define PROBE_V_PASSES 1
#endif
#ifndef PROBE_U_PASSES
#define PROBE_U_PASSES 1
#endif
#ifndef GATHER_STAGGER
#define GATHER_STAGGER 0
#endif
#ifndef P5_ELIM
#define P5_ELIM 0
#endif
#ifndef P3_FUSED
#define P3_FUSED 0
#endif
#ifndef U_INT8
#define U_INT8 1
#endif
#ifndef U_DOT2
#define U_DOT2 1
#endif
#ifndef U_MFMA
#define U_MFMA 0
#endif
#ifndef GATHER_SORTED
#define GATHER_SORTED 2
#endif
#ifndef PEER_FP8
#define PEER_FP8 1
#endif
#ifndef PROBE_GATHER_REPS
#define PROBE_GATHER_REPS 1
#endif
#ifndef PROBE_TOPK_REPS
#define PROBE_TOPK_REPS 1
#endif
#ifndef PROBE_BAR2
#define PROBE_BAR2 0
#endif
#ifndef PROBE_PHASE
#define PROBE_PHASE -1
#endif
#ifndef PROBE_P2_REPS
#define PROBE_P2_REPS 1
#endif

constexpr int NB = 2, SEQ = 8192, D = 1024, M = NB * SEQ;
constexpr int NZ = 3840;
constexpr float EPS = 1e-6f;
constexpr int AB_LD = P3_FUSED ? 1024 : 512;

constexpr size_t MiB = 1u << 20;
constexpr size_t WS_CTL = 0, CTL_ZERO_BYTES = 65536;
constexpr size_t WS_WIN = 1 * MiB;
constexpr size_t WS_WPA = 9 * MiB;
constexpr size_t WS_WPB = 10 * MiB;
constexpr size_t WS_WOUT = 11 * MiB;
constexpr size_t WS_WQ = 13 * MiB;
constexpr size_t WS_K1 = 17 * MiB;
constexpr size_t WS_K2 = 17 * MiB + 32768;
constexpr size_t WS_WS = 17 * MiB + 65536;
constexpr size_t WS_U = 18 * MiB;
constexpr size_t WS_V = 50 * MiB;
constexpr size_t WS_R1 = 82 * MiB;
constexpr size_t WS_Q = 114 * MiB;
constexpr size_t WS_KV = 130 * MiB;
constexpr size_t WS_GU = 138 * MiB;
constexpr size_t WS_GV = 154 * MiB;
constexpr size_t WS_GA = 170 * MiB;
constexpr size_t WS_GB = 202 * MiB;
constexpr size_t WS_MERGED = 114 * MiB;
constexpr size_t WS_QP = 170 * MiB;
constexpr size_t WS_HN8 = 146 * MiB;
constexpr size_t WS_HSC = 162 * MiB;
constexpr size_t WS_END = 234 * MiB;
constexpr int CW_BAR = 0;

constexpr int RING_BYTES = 131072;
constexpr int MISC_OFF = 143360;
constexpr int LDS_BYTES = 147456;

#define GAS __attribute__((address_space(1)))
#define LAS __attribute__((address_space(3)))
typedef unsigned short bf16;
typedef unsigned v4u __attribute__((ext_vector_type(4)));
typedef unsigned v2u __attribute__((ext_vector_type(2)));
typedef float f32x4 __attribute__((ext_vector_type(4)));
typedef GAS unsigned gu32;
typedef __bf16 bf16x2_t __attribute__((ext_vector_type(2)));
#define RLX_AGENT __ATOMIC_RELAXED, __HIP_MEMORY_SCOPE_AGENT
#define LDS_WAIT() asm volatile("s_waitcnt lgkmcnt(0)" ::: "memory")
#define VM_WAIT() asm volatile("s_waitcnt vmcnt(0)" ::: "memory")
__device__ __forceinline__ unsigned f2bf(float f) { unsigned u = __builtin_bit_cast(unsigned, f); return (u + 0x7fffu + ((u >> 16) & 1u)) >> 16; }
__device__ __forceinline__ unsigned pk2(float lo, float hi) { return f2bf(lo) | (f2bf(hi) << 16); }
__device__ __forceinline__ float bflo(unsigned w) { return __builtin_bit_cast(float, w << 16); }
__device__ __forceinline__ float bfhi(unsigned w) { return __builtin_bit_cast(float, w & 0xffff0000u); }
__device__ __forceinline__ float bf2f(bf16 h) { return __builtin_bit_cast(float, (unsigned)h << 16); }
__device__ __forceinline__ float dot2bf(unsigned a, unsigned b, float c) { return __builtin_amdgcn_fdot2_f32_bf16(__builtin_bit_cast(bf16x2_t, a), __builtin_bit_cast(bf16x2_t, b), c, false); }
__device__ __forceinline__ float gelu_tanh(float v) {
    const float t2 = v * (-2.302208198f + (-0.1029432397f) * v * v);
    return v * __builtin_amdgcn_rcpf(1.0f + __builtin_amdgcn_exp2f(t2));
}
__device__ __forceinline__ float sigmoid_f(float v) { return __builtin_amdgcn_rcpf(1.0f + __builtin_amdgcn_exp2f(-1.4426950409f * v)); }
template <int CTRL> __device__ __forceinline__ float dppmov(float v) { return __builtin_bit_cast(float, __builtin_amdgcn_update_dpp(0, __builtin_bit_cast(int, v), CTRL, 0xF, 0xF, false)); }
__device__ __forceinline__ float row16_sum(float v) {
    v += dppmov<0xB1>(v);
    v += dppmov<0x4E>(v);
    v += dppmov<0x141>(v);
    v += dppmov<0x140>(v);
    return v;
}
__device__ __forceinline__ float xor32_f(float v) {
    const unsigned u = __builtin_bit_cast(unsigned, v);
    auto rr = __builtin_amdgcn_permlane32_swap(u, u, false, false);
    const unsigned r0 = rr[0], r1 = rr[1];
    return __builtin_bit_cast(float, (__lane_id() & 32) ? r0 : r1);
}
__device__ __forceinline__ float wave_sum(float v) {
#if DBG_SHFL_WAVESUM
#pragma unroll
    for (int o = 1; o < 64; o <<= 1) v += __shfl_xor(v, o);
    return v;
#endif
    v = row16_sum(v);
    v += __builtin_bit_cast(float, __builtin_amdgcn_ds_swizzle(__builtin_bit_cast(int, v), 0x401F));
    const unsigned u = __builtin_bit_cast(unsigned, v);
    auto rr = __builtin_amdgcn_permlane32_swap(u, u, false, false);
    const unsigned r0 = rr[0], r1 = rr[1];
    return __builtin_bit_cast(float, r0) + __builtin_bit_cast(float, r1);
}
__device__ const unsigned char T5B[128] = {0, 1, 2, 3, 4, 5, 6, 7, 8, 9, 10, 11, 12, 13, 14, 15, 16, 16, 16, 17, 17, 18, 18, 18, 19, 19, 19, 20, 20, 20, 20, 21, 21, 21, 21, 22, 22, 22, 22, 22, 23, 23, 23, 23, 23, 23, 24, 24, 24, 24, 24, 24, 25, 25, 25, 25, 25, 25, 25, 26, 26, 26, 26, 26, 26, 26, 26, 27, 27, 27, 27, 27, 27, 27, 27, 27, 27, 28, 28, 28, 28, 28, 28, 28, 28, 28, 28, 29, 29, 29, 29, 29, 29, 29, 29, 29, 29, 29, 29, 30, 30, 30, 30, 30, 30, 30, 30, 30, 30, 30, 30, 30, 30, 31, 31, 31, 31, 31, 31, 31, 31, 31, 31, 31, 31, 31, 31, 31};
#define XB_TMO      128
#define XB_XCNT(j)  (256  + 64 * (j))
#define XB_XSUB(j)  (1280 + 64 * (j))
#define XB_XGEN(j)  (2304 + 64 * (j))
#define XB_TOP      3328
#define XB_TOPGEN   3392
#define XCD_BAR_WORDS 3456
#define XB_SPIN_CAP (1u << 18)

__device__ __forceinline__ unsigned xb_ld(unsigned* p)              { return __hip_atomic_load(p, __ATOMIC_RELAXED, __HIP_MEMORY_SCOPE_AGENT); }
__device__ __forceinline__ unsigned xb_add(unsigned* p, unsigned v) { return __hip_atomic_fetch_add(p, v, __ATOMIC_RELAXED, __HIP_MEMORY_SCOPE_AGENT); }
__device__ __forceinline__ unsigned xb_xcc_id() { return (unsigned)__builtin_amdgcn_s_getreg((3 << 11) | 20) & 0xFu; }
#define XB_SPIN(cond, bar) do { unsigned _sp = 0; while (cond) { __builtin_amdgcn_s_sleep(1); \
    if ((++_sp & 255u) == 0u) { if (xb_ld(&(bar)[XB_TMO])) break; if (_sp > XB_SPIN_CAP) { atomicAdd(&(bar)[XB_TMO], 1u); break; } } } } while (0)

struct XcdBarrier {
    unsigned* bar; unsigned x;
    volatile LAS unsigned* st;
};

__device__ __forceinline__ XcdBarrier xcd_barrier_post(unsigned* bar, volatile LAS unsigned* st) {
    XcdBarrier b; b.bar = bar; b.x = xb_xcc_id(); b.st = st;
    if (threadIdx.x == 0) (void)xb_add(&bar[XB_XCNT(b.x)], 1u);
    return b;
}
__device__ __forceinline__ void xcd_barrier_complete(unsigned* bar, unsigned x, unsigned& nloc, unsigned& nx) {
    const unsigned G = gridDim.x * gridDim.y * gridDim.z;
    unsigned sum, cnt, mine, sp = 0u;
    for (;;) {
        sum = 0u; cnt = 0u; mine = 0u;
#pragma unroll
        for (unsigned j = 0; j < 16; ++j) { const unsigned c = xb_ld(&bar[XB_XCNT(j)]); sum += c; cnt += (c > 0u) ? 1u : 0u; mine = (j == x) ? c : mine; }
        if (sum == G) break;
        __builtin_amdgcn_s_sleep(1);
        if ((++sp & 255u) == 0u) { if (xb_ld(&bar[XB_TMO])) break; if (sp > XB_SPIN_CAP) { atomicAdd(&bar[XB_TMO], 1u); break; } }
    }
    nloc = mine > 0u ? mine : 1u; nx = cnt > 0u ? cnt : 1u;
}

__device__ __forceinline__ void xcd_barrier(const XcdBarrier& b) {
    asm volatile("s_waitcnt vmcnt(0)" ::: "memory");
    __syncthreads();
    if (threadIdx.x == 0) {
        unsigned* bar = b.bar;
        __builtin_amdgcn_s_waitcnt(0);
        unsigned nloc = b.st[0], nx = b.st[1];
        if (nloc == 0u) { xcd_barrier_complete(bar, b.x, nloc, nx); b.st[0] = nloc; b.st[1] = nx; }
        const unsigned old = xb_add(&bar[XB_XSUB(b.x)], 1u);
        const unsigned gen = old / nloc;
        if (old + 1u == (gen + 1u) * nloc) {
            __builtin_amdgcn_fence(__ATOMIC_RELEASE, "agent");
            asm volatile("s_waitcnt vmcnt(0)" ::: "memory");
            const unsigned og = xb_add(&bar[XB_TOP], 1u);
            const unsigned tg = og / nx;
            if (og + 1u == (tg + 1u) * nx) xb_add(&bar[XB_TOPGEN], 1u);
            else XB_SPIN(xb_ld(&bar[XB_TOPGEN]) == tg, bar);
            __builtin_amdgcn_fence(__ATOMIC_ACQUIRE, "agent");
            xb_add(&bar[XB_XGEN(b.x)], 1u);
            asm volatile("s_waitcnt vmcnt(0)" ::: "memory");
        } else {
            XB_SPIN(xb_ld(&bar[XB_XGEN(b.x)]) == gen, bar);
            __builtin_amdgcn_fence(__ATOMIC_ACQUIRE, "agent");
            asm volatile("s_waitcnt vmcnt(0)" ::: "memory");
        }
    }
    __syncthreads();
}
namespace pg8 {
struct EpiZ {
    static constexpr bool PERM = true, AFTER_DRAIN = false, HAS_MID = false;
    bf16_t *Q, *KV, *GU, *GV, *GA, *GB;
    __device__ __forceinline__ void operator()(const f32x4 (&acc)[2][2][4][2], const Unit& u, int wr, int wc, int fr, int fq) const {
        const int pn = u.pn; bf16_t* base; int ldc, colt, act;
        if (pn < 2)       { base = Q;  ldc = 512;  colt = pn * 256;        act = 0; }
        else if (pn == 2) { base = KV; ldc = 256;  colt = 0;               act = 0; }
        else if (pn < 5)  { base = GU; ldc = 512;  colt = (pn - 3) * 256;  act = 1; }
        else if (pn < 7)  { base = GV; ldc = 512;  colt = (pn - 5) * 256;  act = 1; }
        else if (pn < 11) { base = GA; ldc = 1024; colt = (pn - 7) * 256;  act = 2; }
        else              { base = GB; ldc = 1024; colt = (pn - 11) * 256; act = 2; }
        const int row0 = u.pm * BM + wr * 64 + fr, col0 = colt + wc * 32 + 8 * fq;
#pragma unroll
        for (int ai = 0; ai < 2; ++ai)
#pragma unroll
            for (int m = 0; m < 4; ++m) { bf16_t* rowp = base + (size_t)(row0 + ai * HALF + m * 16) * ldc + col0;
#pragma unroll
                for (int bj = 0; bj < 2; ++bj) { f32x4 v0 = acc[ai][bj][m][0], v1 = acc[ai][bj][m][1];
                    if (act == 1) {
#pragma unroll
                        for (int e = 0; e < 4; ++e) { v0[e] = gelu_tanh(v0[e]); v1[e] = gelu_tanh(v1[e]); }
                    } else if (act == 2) {
#pragma unroll
                        for (int e = 0; e < 4; ++e) { v0[e] = sigmoid_f(v0[e]); v1[e] = sigmoid_f(v1[e]); }
                    }
                    u32x4 w; w.x = cvt_pk_bf16(v0[0], v0[1]); w.y = cvt_pk_bf16(v0[2], v0[3]); w.z = cvt_pk_bf16(v1[0], v1[1]); w.w = cvt_pk_bf16(v1[2], v1[3]);
                    *(u32x4*)(rowp + bj * HALF) = w; } }
    }
};
struct EpiGateTmp {
    static constexpr bool PERM = true, AFTER_DRAIN = false, HAS_MID = false;
    const bf16_t* gate; float* tmp;
    __device__ __forceinline__ void operator()(const f32x4 (&acc)[2][2][4][2], const Unit& u, int wr, int wc, int fr, int fq) const {
        const int row0 = u.pm * BM + wr * 64 + fr, col0 = u.pn * BM + wc * 32 + 8 * fq;
#pragma unroll
        for (int ai = 0; ai < 2; ++ai)
#pragma unroll
            for (int m = 0; m < 4; ++m) { const size_t ro = (size_t)(row0 + ai * HALF + m * 16) * 1024 + col0;
#pragma unroll
                for (int bj = 0; bj < 2; ++bj) { const u32x4 g = *(const u32x4*)(gate + ro + bj * HALF); f32x4 v0 = acc[ai][bj][m][0], v1 = acc[ai][bj][m][1];
                    v0[0] *= bflo(g.x); v0[1] *= bfhi(g.x); v0[2] *= bflo(g.y); v0[3] *= bfhi(g.y); v1[0] *= bflo(g.z); v1[1] *= bfhi(g.z); v1[2] *= bflo(g.w); v1[3] *= bfhi(g.w);
                    *(f32x4*)(tmp + ro + bj * HALF) = v0; *(f32x4*)(tmp + ro + bj * HALF + 4) = v1; } }
    }
};
struct EpiMerge {
    static constexpr bool PERM = true, AFTER_DRAIN = false, HAS_MID = false;
    const bf16_t* gate; const float* tmp; bf16_t* out;
    __device__ __forceinline__ void operator()(const f32x4 (&acc)[2][2][4][2], const Unit& u, int wr, int wc, int fr, int fq) const {
        const int row0 = u.pm * BM + wr * 64 + fr, col0 = u.pn * BM + wc * 32 + 8 * fq;
#pragma unroll
        for (int ai = 0; ai < 2; ++ai)
#pragma unroll
            for (int m = 0; m < 4; ++m) { const size_t ro = (size_t)(row0 + ai * HALF + m * 16) * 1024 + col0;
#pragma unroll
                for (int bj = 0; bj < 2; ++bj) { const u32x4 g = *(const u32x4*)(gate + ro + bj * HALF); f32x4 v0 = acc[ai][bj][m][0], v1 = acc[ai][bj][m][1];
                    const f32x4 t0 = *(const f32x4*)(tmp + ro + bj * HALF), t1 = *(const f32x4*)(tmp + ro + bj * HALF + 4);
                    v0[0] = t0[0] + v0[0] * bflo(g.x); v0[1] = t0[1] + v0[1] * bfhi(g.x); v0[2] = t0[2] + v0[2] * bflo(g.y); v0[3] = t0[3] + v0[3] * bfhi(g.y);
                    v1[0] = t1[0] + v1[0] * bflo(g.z); v1[1] = t1[1] + v1[1] * bfhi(g.z); v1[2] = t1[2] + v1[2] * bflo(g.w); v1[3] = t1[3] + v1[3] * bfhi(g.w);
                    u32x4 w; w.x = cvt_pk_bf16(v0[0], v0[1]); w.y = cvt_pk_bf16(v0[2], v0[3]); w.z = cvt_pk_bf16(v1[0], v1[1]); w.w = cvt_pk_bf16(v1[2], v1[3]);
                    *(u32x4*)(out + ro + bj * HALF) = w; } }
    }
};
struct EpiMerge2 {
    static constexpr bool PERM = true, AFTER_DRAIN = false, HAS_MID = true;
    const bf16_t* ga; const bf16_t* gb; bf16_t* out;
    __device__ __forceinline__ void mid(f32x4 (&acc)[2][2][4][2], const Unit& u, int wr, int wc, int fr, int fq) const {
        const int row0 = u.pm * BM + wr * 64 + fr, col0 = u.pn * BM + wc * 32 + 8 * fq;
#pragma unroll
        for (int ai = 0; ai < 2; ++ai)
#pragma unroll
            for (int m = 0; m < 4; ++m) { const size_t ro = (size_t)(row0 + ai * HALF + m * 16) * 1024 + col0;
#pragma unroll
                for (int bj = 0; bj < 2; ++bj) { const u32x4 a = *(const u32x4*)(ga + ro + bj * HALF), b = *(const u32x4*)(gb + ro + bj * HALF);
                    f32x4 r0, r1;
                    r0[0] = bflo(a.x) * __builtin_amdgcn_rcpf(fmaxf(bflo(b.x), 1e-20f)); r0[1] = bfhi(a.x) * __builtin_amdgcn_rcpf(fmaxf(bfhi(b.x), 1e-20f)); r0[2] = bflo(a.y) * __builtin_amdgcn_rcpf(fmaxf(bflo(b.y), 1e-20f)); r0[3] = bfhi(a.y) * __builtin_amdgcn_rcpf(fmaxf(bfhi(b.y), 1e-20f));
                    r1[0] = bflo(a.z) * __builtin_amdgcn_rcpf(fmaxf(bflo(b.z), 1e-20f)); r1[1] = bfhi(a.z) * __builtin_amdgcn_rcpf(fmaxf(bfhi(b.z), 1e-20f)); r1[2] = bflo(a.w) * __builtin_amdgcn_rcpf(fmaxf(bflo(b.w), 1e-20f)); r1[3] = bfhi(a.w) * __builtin_amdgcn_rcpf(fmaxf(bfhi(b.w), 1e-20f));
                    acc[ai][bj][m][0] = acc[ai][bj][m][0] * r0; acc[ai][bj][m][1] = acc[ai][bj][m][1] * r1; } }
    }
    __device__ __forceinline__ void operator()(const f32x4 (&acc)[2][2][4][2], const Unit& u, int wr, int wc, int fr, int fq) const {
        const int row0 = u.pm * BM + wr * 64 + fr, col0 = u.pn * BM + wc * 32 + 8 * fq;
#pragma unroll
        for (int ai = 0; ai < 2; ++ai)
#pragma unroll
            for (int m = 0; m < 4; ++m) { const size_t ro = (size_t)(row0 + ai * HALF + m * 16) * 1024 + col0;
#pragma unroll
                for (int bj = 0; bj < 2; ++bj) { const u32x4 b = *(const u32x4*)(gb + ro + bj * HALF); f32x4 v0 = acc[ai][bj][m][0], v1 = acc[ai][bj][m][1];
                    v0[0] *= fmaxf(bflo(b.x), 1e-20f); v0[1] *= fmaxf(bfhi(b.x), 1e-20f); v0[2] *= fmaxf(bflo(b.y), 1e-20f); v0[3] *= fmaxf(bfhi(b.y), 1e-20f);
                    v1[0] *= fmaxf(bflo(b.z), 1e-20f); v1[1] *= fmaxf(bfhi(b.z), 1e-20f); v1[2] *= fmaxf(bflo(b.w), 1e-20f); v1[3] *= fmaxf(bfhi(b.w), 1e-20f);
                    u32x4 w; w.x = cvt_pk_bf16(v0[0], v0[1]); w.y = cvt_pk_bf16(v0[2], v0[3]); w.z = cvt_pk_bf16(v1[0], v1[1]); w.w = cvt_pk_bf16(v1[2], v1[3]);
                    *(u32x4*)(out + ro + bj * HALF) = w; } }
    }
};
struct EpiRes {
    static constexpr bool PERM = false, AFTER_DRAIN = false, HAS_MID = false;
    const float* base; float* C;
    __device__ __forceinline__ void operator()(const f32x4 (&acc)[2][2][4][2], const Unit& u, int wr, int wc, int fr, int fq) const {
        const int row0 = u.pm * BM + wr * 64 + fr, col0 = u.pn * BM + wc * 32 + 4 * fq;
#pragma unroll
        for (int ai = 0; ai < 2; ++ai)
#pragma unroll
            for (int m = 0; m < 4; ++m) { const size_t ro = (size_t)(row0 + ai * HALF + m * 16) * 1024 + col0;
#pragma unroll
                for (int bj = 0; bj < 2; ++bj)
#pragma unroll
                    for (int n = 0; n < 2; ++n) *(f32x4*)(C + ro + bj * HALF + n * 16) = *(const f32x4*)(base + ro + bj * HALF + n * 16) + acc[ai][bj][m][n]; }
    }
};
struct EpiResStats {
    static constexpr bool PERM = false, AFTER_DRAIN = false, HAS_MID = false;
    const float* base; float* C; bf16_t* Cb; const float* w; float* rowss; unsigned* rowamax;
    __device__ __forceinline__ void operator()(const f32x4 (&acc)[2][2][4][2], const Unit& u, int wr, int wc, int fr, int fq) const {
        const int row0 = u.pm * BM + wr * 64 + fr, col0 = u.pn * BM + wc * 32 + 4 * fq;
        f32x4 wv[2][2];
#pragma unroll
        for (int bj = 0; bj < 2; ++bj)
#pragma unroll
            for (int n = 0; n < 2; ++n) wv[bj][n] = *(const f32x4*)(w + col0 + bj * HALF + n * 16);
#pragma unroll
        for (int ai = 0; ai < 2; ++ai)
#pragma unroll
            for (int m = 0; m < 4; ++m) { const int row = row0 + ai * HALF + m * 16; const size_t ro = (size_t)row * 1024 + col0; float ss = 0.f, am = 0.f;
#pragma unroll
                for (int bj = 0; bj < 2; ++bj)
#pragma unroll
                    for (int n = 0; n < 2; ++n) { const f32x4 v = *(const f32x4*)(base + ro + bj * HALF + n * 16) + acc[ai][bj][m][n];
                        *(f32x4*)(C + ro + bj * HALF + n * 16) = v;
                        typedef unsigned u32x2 __attribute__((ext_vector_type(2))); u32x2 pb; pb.x = cvt_pk_bf16(v[0], v[1]); pb.y = cvt_pk_bf16(v[2], v[3]); *(u32x2*)(Cb + ro + bj * HALF + n * 16) = pb;
                        ss += (v[0] * v[0] + v[1] * v[1]) + (v[2] * v[2] + v[3] * v[3]);
                        const f32x4 t = v * wv[bj][n]; am = fmaxf(am, fmaxf(fmaxf(fabsf(t[0]), fabsf(t[1])), fmaxf(fabsf(t[2]), fabsf(t[3])))); }
                ss += __shfl_xor(ss, 16); ss += __shfl_xor(ss, 32); am = fmaxf(am, __shfl_xor(am, 16)); am = fmaxf(am, __shfl_xor(am, 32));
                if (fq == 0) { rowss[(size_t)row * 16 + u.pn * 4 + wc] = ss; rowamax[(size_t)row * 16 + u.pn * 4 + wc] = __builtin_bit_cast(unsigned, am); } }
    }
};
struct EpiPlainRstd {
    static constexpr bool PERM = true, AFTER_DRAIN = false, HAS_MID = false;
    bf16_t* O; int ldc; const float* rowss;
    __device__ __forceinline__ void operator()(const f32x4 (&acc)[2][2][4][2], const Unit& u, int wr, int wc, int fr, int fq) const {
        const int row0 = u.pm * BM + wr * 64 + fr, col0 = u.pn * BM + wc * 32 + 8 * fq;
#pragma unroll
        for (int ai = 0; ai < 2; ++ai)
#pragma unroll
            for (int m = 0; m < 4; ++m) { const int row = row0 + ai * HALF + m * 16; bf16_t* rowp = O + (size_t)row * ldc + col0;
                const f32x4* rp_ = (const f32x4*)(rowss + (size_t)row * 16); const f32x4 q_ = (rp_[0] + rp_[1]) + (rp_[2] + rp_[3]);
                const float rstd = 1.0f / sqrtf(((q_[0] + q_[1]) + (q_[2] + q_[3])) * (1.0f / 1024.0f) + 1e-6f);
#pragma unroll
                for (int bj = 0; bj < 2; ++bj) { const f32x4 v0 = acc[ai][bj][m][0] * rstd, v1 = acc[ai][bj][m][1] * rstd;
                    u32x4 w; w.x = cvt_pk_bf16(v0[0], v0[1]); w.y = cvt_pk_bf16(v0[2], v0[3]); w.z = cvt_pk_bf16(v1[0], v1[1]); w.w = cvt_pk_bf16(v1[2], v1[3]);
                    *(u32x4*)(rowp + bj * HALF) = w; } }
    }
};
struct EpiPlain {
    static constexpr bool PERM = true, AFTER_DRAIN = false, HAS_MID = false;
    bf16_t* O; int ldc;
    __device__ __forceinline__ void operator()(const f32x4 (&acc)[2][2][4][2], const Unit& u, int wr, int wc, int fr, int fq) const {
        const int row0 = u.pm * BM + wr * 64 + fr, col0 = u.pn * BM + wc * 32 + 8 * fq;
#pragma unroll
        for (int ai = 0; ai < 2; ++ai)
#pragma unroll
            for (int m = 0; m < 4; ++m) { bf16_t* rowp = O + (size_t)(row0 + ai * HALF + m * 16) * ldc + col0;
#pragma unroll
                for (int bj = 0; bj < 2; ++bj) { const f32x4 v0 = acc[ai][bj][m][0], v1 = acc[ai][bj][m][1];
                    u32x4 w; w.x = cvt_pk_bf16(v0[0], v0[1]); w.y = cvt_pk_bf16(v0[2], v0[3]); w.z = cvt_pk_bf16(v1[0], v1[1]); w.w = cvt_pk_bf16(v1[2], v1[3]);
                    *(u32x4*)(rowp + bj * HALF) = w; } }
    }
};
}

__device__ __forceinline__ void p0_transpose_item(const float* W, int K, int N, bf16* WT, LAS float* scr, int item, int lane, int ldk = 0, int koff = 0, const float* kscale = nullptr) {
    if (ldk == 0) ldk = K;
    const int nblk = N / 32, kb = item / nblk, nb = item % nblk, k0 = 64 * kb, n0 = 32 * nb;
#pragma unroll 8
    for (int i = 0; i < 32; ++i) { const int kk = 2 * i + (lane >> 5); scr[kk * 33 + (lane & 31)] = W[(size_t)(k0 + kk) * N + n0 + (lane & 31)] * (kscale ? kscale[k0 + kk] : 1.0f); }
    LDS_WAIT(); asm volatile("" ::: "memory");
    const int c = lane & 7;
#pragma unroll
    for (int j = 0; j < 4; ++j) { const int n = (lane >> 3) + 8 * j; const LAS float* s = scr + (8 * c) * 33 + n;
        v4u o; o.x = pk2(s[0 * 33], s[1 * 33]); o.y = pk2(s[2 * 33], s[3 * 33]); o.z = pk2(s[4 * 33], s[5 * 33]); o.w = pk2(s[6 * 33], s[7 * 33]);
        *(v4u*)(WT + (size_t)(n0 + n) * ldk + koff + k0 + 8 * c) = o; }
    LDS_WAIT(); asm volatile("" ::: "memory");
}
__device__ __forceinline__ void cvt_flat(const float* src, bf16* dst, size_t n, int gw, int NGW, int lane) {
    for (size_t i = (size_t)gw * 512 + lane * 8; i < n; i += (size_t)NGW * 512) {
        const f32x4 a = *(const f32x4*)(src + i), b = *(const f32x4*)(src + i + 4);
        v4u o; o.x = pk2(a[0], a[1]); o.y = pk2(a[2], a[3]); o.z = pk2(b[0], b[1]); o.w = pk2(b[2], b[3]);
        *(v4u*)(dst + i) = o;
    }
}
__device__ __forceinline__ void rms_row_to_bf16(const float* xrow, const float* w, bf16* orow, int lane) {
    const f32x4* xr = (const f32x4*)xrow + lane; const f32x4* wr = (const f32x4*)w + lane;
    f32x4 v[4]; float s = 0.f;
#pragma unroll
    for (int j = 0; j < 4; ++j) { v[j] = xr[64 * j]; s += (v[j][0] * v[j][0] + v[j][1] * v[j][1]) + (v[j][2] * v[j][2] + v[j][3] * v[j][3]); }
    const float rstd = 1.0f / sqrtf(wave_sum(s) * (1.0f / 1024.0f) + EPS);
    unsigned long long* o8 = (unsigned long long*)orow + lane;
#pragma unroll
    for (int j = 0; j < 4; ++j) { const f32x4 ww = wr[64 * j];
        o8[64 * j] = (unsigned long long)pk2(v[j][0] * rstd * ww[0], v[j][1] * rstd * ww[1]) | ((unsigned long long)pk2(v[j][2] * rstd * ww[2], v[j][3] * rstd * ww[3]) << 32); }
}

__device__ __forceinline__ int pack_i8x4(float a, float b, float c, float d) {
    const int qa = (int)__builtin_rintf(a), qb = (int)__builtin_rintf(b), qc = (int)__builtin_rintf(c), qd = (int)__builtin_rintf(d);
    return (qa & 255) | ((qb & 255) << 8) | ((qc & 255) << 16) | ((int)((unsigned)qd << 24));
}
__device__ __forceinline__ void rms_row_to_bf16_fp8(const float* xrow, const float* w, bf16* orow, unsigned char* o8row, float* oinv, int lane) {
    const f32x4* xr = (const f32x4*)xrow + lane; const f32x4* wr = (const f32x4*)w + lane;
    f32x4 v[4]; float s = 0.f;
#pragma unroll
    for (int j = 0; j < 4; ++j) { v[j] = xr[64 * j]; s += (v[j][0] * v[j][0] + v[j][1] * v[j][1]) + (v[j][2] * v[j][2] + v[j][3] * v[j][3]); }
    const float rstd = 1.0f / sqrtf(wave_sum(s) * (1.0f / 1024.0f) + EPS);
    unsigned long long* o8 = (unsigned long long*)orow + lane; float mx = 0.f;
#pragma unroll
    for (int j = 0; j < 4; ++j) { const f32x4 ww = wr[64 * j]; v[j] = v[j] * rstd * ww;
        o8[64 * j] = (unsigned long long)pk2(v[j][0], v[j][1]) | ((unsigned long long)pk2(v[j][2], v[j][3]) << 32);
        mx = fmaxf(mx, fmaxf(fmaxf(fabsf(v[j][0]), fabsf(v[j][1])), fmaxf(fabsf(v[j][2]), fabsf(v[j][3])))); }
#pragma unroll
    for (int o = 1; o < 64; o <<= 1) mx = fmaxf(mx, __shfl_xor(mx, o));
#if U_INT8
    const bool tiny = mx < 1e-30f;
    const float scale = tiny ? 0.f : 127.0f / mx, inv = tiny ? 0.f : mx * (1.0f / 127.0f);
#pragma unroll
    for (int j = 0; j < 4; ++j) *(int*)(o8row + 4 * lane + 256 * j) = pack_i8x4(v[j][0] * scale, v[j][1] * scale, v[j][2] * scale, v[j][3] * scale);
#else
    const int ex = (int)((__builtin_bit_cast(unsigned, mx) >> 23) & 0xffu);
    const bool tiny = ex < 32;
    const float scale = tiny ? 1.0f : __builtin_bit_cast(float, (unsigned)(254 + 7 - ex) << 23);
    const float inv = tiny ? 1.0f : __builtin_bit_cast(float, (unsigned)(ex - 7) << 23);
#pragma unroll
    for (int j = 0; j < 4; ++j) { int p = __builtin_amdgcn_cvt_pk_fp8_f32(v[j][0] * scale, v[j][1] * scale, 0, false); p = __builtin_amdgcn_cvt_pk_fp8_f32(v[j][2] * scale, v[j][3] * scale, p, true);
        *(int*)(o8row + 4 * lane + 256 * j) = p; }
#endif
    if (lane == 0) *oinv = inv;
}

struct Ptrs {
    const float *x, *mix_w, *w_in, *rel_bias, *sinks, *w_pa, *ln_w, *ln_b, *w_s, *b_s, *w_pb, *w_out, *ffn_w, *w_q, *keys1, *keys2, *pu, *pv, *fin_w;
    float* out;
    unsigned char *U8, *V8, *HN8; float *USC, *VSC, *HSC; float* rowss; unsigned* rowamax;
    bf16 *WIN, *WPA, *WPB, *WOUT, *WQ, *K1, *K2, *WS, *U, *V, *XN, *AOUT, *BOUT, *HN2, *Q, *KV, *GU, *GV, *GA, *GB, *MERGED, *QP;
};

__device__ __forceinline__ void p0_prologue(LAS unsigned char* lds, const Ptrs& P, int vcu, int G, int lane, int wave) {
    LAS float* scr = (LAS float*)(lds + wave * 16384);
    const int gw = vcu * NWAVES + wave, NGW = G * NWAVES;
    constexpr int I_IN = (1024 / 64) * (3840 / 32), I_PA = (512 / 64) * (1024 / 32), I_OUT = (1024 / 64) * (1024 / 32), I_WQ = (1024 / 64) * (2048 / 32);
    constexpr int NITEMS = I_IN + 2 * I_PA + I_OUT + I_WQ;
    for (int it = gw; it < NITEMS; it += NGW) {
        int r = it;
        if (r < I_IN) { p0_transpose_item(P.w_in, 1024, 3840, P.WIN, scr, r, lane); continue; } r -= I_IN;
        if (r < I_PA) { if (P3_FUSED) p0_transpose_item(P.w_pa, 512, 1024, P.WPA, scr, r, lane, 1024, 0); else p0_transpose_item(P.w_pa, 512, 1024, P.WPA, scr, r, lane); continue; } r -= I_PA;
        if (r < I_PA) { if (P3_FUSED) p0_transpose_item(P.w_pb, 512, 1024, P.WPA, scr, r, lane, 1024, 512); else p0_transpose_item(P.w_pb, 512, 1024, P.WPB, scr, r, lane); continue; } r -= I_PA;
        if (r < I_OUT) { p0_transpose_item(P.w_out, 1024, 1024, P.WOUT, scr, r, lane); continue; } r -= I_OUT;
        p0_transpose_item(P.w_q, 1024, 2048, P.WQ, scr, r, lane, 0, 0, P5_ELIM ? P.ffn_w : nullptr);
    }
    cvt_flat(P.keys1, P.K1, 128 * 128, gw, NGW, lane);
    cvt_flat(P.keys2, P.K2, 128 * 128, gw, NGW, lane);
#if PEER_FP8
    for (int rr = gw; rr < 2 * 16384; rr += NGW) {
        const int tab = rr >> 14, row = rr & 16383;
        const float* src = (tab ? P.pv : P.pu) + (size_t)row * 1024; unsigned char* dst = (tab ? P.V8 : P.U8) + (size_t)row * 1024;
        f32x4 v[4]; float mx = 0.f;
#pragma unroll
        for (int j = 0; j < 4; ++j) { v[j] = *(const f32x4*)(src + 4 * lane + 256 * j); mx = fmaxf(mx, fmaxf(fmaxf(fabsf(v[j][0]), fabsf(v[j][1])), fmaxf(fabsf(v[j][2]), fabsf(v[j][3])))); }
#pragma unroll
        for (int o = 1; o < 64; o <<= 1) mx = fmaxf(mx, __shfl_xor(mx, o));
        const int ex = (int)((__builtin_bit_cast(unsigned, mx) >> 23) & 0xffu);
        const bool tiny = ex < 32;
        float scale = tiny ? 1.0f : __builtin_bit_cast(float, (unsigned)(254 + 7 - ex) << 23);
        float inv = tiny ? 1.0f : __builtin_bit_cast(float, (unsigned)(ex - 7) << 23);
        if (U_INT8 && tab == 0) { scale = tiny ? 0.f : 127.0f / mx; inv = tiny ? 0.f : mx * (1.0f / 127.0f); }
#pragma unroll
        for (int j = 0; j < 4; ++j) { int p = __builtin_amdgcn_cvt_pk_fp8_f32(v[j][0] * scale, v[j][1] * scale, 0, false); p = __builtin_amdgcn_cvt_pk_fp8_f32(v[j][2] * scale, v[j][3] * scale, p, true);
            if (U_INT8 && tab == 0) p = pack_i8x4(v[j][0] * scale, v[j][1] * scale, v[j][2] * scale, v[j][3] * scale);
            const int c_ = 4 * lane + 256 * j;
            const int o_ = (U_MFMA && tab == 0) ? ((c_ >> 6) * 64 + ((c_ >> 3) & 3) * 16 + ((c_ >> 5) & 1) * 8 + (c_ & 7)) : c_;
            *(int*)(dst + o_) = p; }
        if (lane == 0) (tab ? P.VSC : P.USC)[row] = inv;
    }
#else
    cvt_flat(P.pu, P.U, (size_t)16384 * 1024, gw, NGW, lane);
    cvt_flat(P.pv, P.V, (size_t)16384 * 1024, gw, NGW, lane);
#endif
    for (size_t i = (size_t)gw * 512 + lane * 8; i < (size_t)8 * 128 * 128; i += (size_t)NGW * 512) {
        const int t = (int)((i >> 7) & 127), s0 = (int)(i & 127);
        const f32x4 a = *(const f32x4*)(P.w_s + i), b = *(const f32x4*)(P.w_s + i + 4);
        float e[8] = {a[0], a[1], a[2], a[3], b[0], b[1], b[2], b[3]};
#pragma unroll
        for (int j = 0; j < 8; ++j) e[j] = (s0 + j <= t) ? e[j] : 0.f;
        v4u o; o.x = pk2(e[0], e[1]); o.y = pk2(e[2], e[3]); o.z = pk2(e[4], e[5]); o.w = pk2(e[6], e[7]);
        *(v4u*)(P.WS + i) = o;
    }
    for (int m = gw; m < M; m += NGW) rms_row_to_bf16(P.x + (size_t)m * D, P.mix_w, P.XN + (size_t)m * D, lane);
}

__device__ __forceinline__ void p2_attn_naive(LAS unsigned char* lds, const Ptrs& P, int vcu, int G, int tid, int lane, int wave) {
    LAS float* biasl = (LAS float*)lds;
    for (int i = tid; i < 1024; i += 512) { const int d = i >> 3, h = i & 7; biasl[i] = P.rel_bias[(int)T5B[d] * 8 + h]; }
    __syncthreads();
    const int h = wave, kvh = h >> 2;
    const float sink = P.sinks[h];
    for (int unit = vcu; unit < M / 64; unit += G) {
        const int t = unit * 64 + lane, pos = t & (SEQ - 1);
        float q[64], o[64];
        { const v4u* qp = (const v4u*)(P.Q + (size_t)t * 512 + h * 64);
#pragma unroll
          for (int c = 0; c < 8; ++c) { const v4u w = qp[c]; q[8 * c + 0] = bflo(w.x) * 0.125f; q[8 * c + 1] = bfhi(w.x) * 0.125f; q[8 * c + 2] = bflo(w.y) * 0.125f; q[8 * c + 3] = bfhi(w.y) * 0.125f;
              q[8 * c + 4] = bflo(w.z) * 0.125f; q[8 * c + 5] = bfhi(w.z) * 0.125f; q[8 * c + 6] = bflo(w.w) * 0.125f; q[8 * c + 7] = bfhi(w.w) * 0.125f; } }
#pragma unroll
        for (int i = 0; i < 64; ++i) o[i] = 0.f;
        float m = sink, l = 1.f;
        for (int d = 0; d < 128; ++d) {
            const bool valid = (pos - d) >= 0;
            const int tj = valid ? (t - d) : t;
            const v4u* kp = (const v4u*)(P.KV + (size_t)tj * 256 + kvh * 64);
            float dot = 0.f;
#pragma unroll
            for (int c = 0; c < 8; ++c) { const v4u w = kp[c];
                dot += q[8 * c + 0] * bflo(w.x) + q[8 * c + 1] * bfhi(w.x) + q[8 * c + 2] * bflo(w.y) + q[8 * c + 3] * bfhi(w.y) + q[8 * c + 4] * bflo(w.z) + q[8 * c + 5] * bfhi(w.z) + q[8 * c + 6] * bflo(w.w) + q[8 * c + 7] * bfhi(w.w); }
            const float s = valid ? dot + biasl[d * 8 + h] : -1e30f;
            const float mn = fmaxf(m, s), alpha = __expf(m - mn), p = __expf(s - mn);
            l = l * alpha + p; m = mn;
            const v4u* vp = kp + 16;
#pragma unroll
            for (int c = 0; c < 8; ++c) { const v4u w = vp[c];
                o[8 * c + 0] = o[8 * c + 0] * alpha + p * bflo(w.x); o[8 * c + 1] = o[8 * c + 1] * alpha + p * bfhi(w.x); o[8 * c + 2] = o[8 * c + 2] * alpha + p * bflo(w.y); o[8 * c + 3] = o[8 * c + 3] * alpha + p * bfhi(w.y);
                o[8 * c + 4] = o[8 * c + 4] * alpha + p * bflo(w.z); o[8 * c + 5] = o[8 * c + 5] * alpha + p * bfhi(w.z); o[8 * c + 6] = o[8 * c + 6] * alpha + p * bflo(w.w); o[8 * c + 7] = o[8 * c + 7] * alpha + p * bfhi(w.w); }
        }
        const float inv = 1.0f / l;
        v4u* op = (v4u*)(P.AOUT + (size_t)t * AB_LD + h * 64);
#pragma unroll
        for (int c = 0; c < 8; ++c) { v4u w; w.x = pk2(o[8 * c + 0] * inv, o[8 * c + 1] * inv); w.y = pk2(o[8 * c + 2] * inv, o[8 * c + 3] * inv); w.z = pk2(o[8 * c + 4] * inv, o[8 * c + 5] * inv); w.w = pk2(o[8 * c + 6] * inv, o[8 * c + 7] * inv); op[c] = w; }
    }
    __syncthreads();
}

__device__ __forceinline__ void p2_gmlp_naive(LAS unsigned char* lds, const Ptrs& P, int vcu, int G, int tid, int lane, int wave) {
    LAS bf16* vnl = (LAS bf16*)(lds + 8192);
    for (int unit = vcu; unit < 256; unit += G) {
        const int c = unit >> 1, hh = unit & 1;
        for (int i = 0; i < 16; ++i) {
            const int tt = wave * 16 + i; const size_t row = (size_t)c * 128 + tt;
            const v4u w = *((const v4u*)(P.GV + row * 512) + lane);
            float x[8] = {bflo(w.x), bfhi(w.x), bflo(w.y), bfhi(w.y), bflo(w.z), bfhi(w.z), bflo(w.w), bfhi(w.w)};
            float s = 0.f;
#pragma unroll
            for (int j = 0; j < 8; ++j) s += x[j];
            const float mean = wave_sum(s) * (1.0f / 512.0f);
            float ss = 0.f;
#pragma unroll
            for (int j = 0; j < 8; ++j) { x[j] -= mean; ss += x[j] * x[j]; }
            const float rstd = 1.0f / sqrtf(wave_sum(ss) * (1.0f / 512.0f) + EPS);
            if ((lane >> 5) == hh) {
                const f32x4 w0 = *(const f32x4*)(P.ln_w + lane * 8), w1 = *(const f32x4*)(P.ln_w + lane * 8 + 4), b0 = *(const f32x4*)(P.ln_b + lane * 8), b1 = *(const f32x4*)(P.ln_b + lane * 8 + 4);
                v4u o; o.x = pk2(x[0] * rstd * w0[0] + b0[0], x[1] * rstd * w0[1] + b0[1]); o.y = pk2(x[2] * rstd * w0[2] + b0[2], x[3] * rstd * w0[3] + b0[3]);
                o.z = pk2(x[4] * rstd * w1[0] + b1[0], x[5] * rstd * w1[1] + b1[1]); o.w = pk2(x[6] * rstd * w1[2] + b1[2], x[7] * rstd * w1[3] + b1[3]);
                *(LAS v4u*)(vnl + tt * 256 + (lane & 31) * 8) = o;
            }
        }
        __syncthreads();
        const int ch = tid & 255, th = tid >> 8, g = hh * 4 + (ch >> 6);
        for (int t = th * 64; t < th * 64 + 64; ++t) {
            const v4u* wrow = (const v4u*)(P.WS + ((size_t)g * 128 + t) * 128);
            float acc = 0.f;
            for (int s8 = 0; s8 <= (t >> 3); ++s8) {
                const v4u w = wrow[s8];
                const LAS bf16* vp = vnl + (s8 * 8) * 256 + ch;
                acc += bflo(w.x) * bf2f(vp[0]) + bfhi(w.x) * bf2f(vp[256]) + bflo(w.y) * bf2f(vp[512]) + bfhi(w.y) * bf2f(vp[768])
                     + bflo(w.z) * bf2f(vp[1024]) + bfhi(w.z) * bf2f(vp[1280]) + bflo(w.w) * bf2f(vp[1536]) + bfhi(w.w) * bf2f(vp[1792]);
            }
            const size_t row = (size_t)c * 128 + t;
            const float uval = bf2f(P.GU[row * 512 + hh * 256 + ch]);
            P.BOUT[row * AB_LD + hh * 256 + ch] = (bf16)f2bf(uval * (acc + P.b_s[g * 128 + t]));
        }
        __syncthreads();
    }
}

typedef short s16x8 __attribute__((ext_vector_type(8)));
typedef short s16x4 __attribute__((ext_vector_type(4)));
typedef float f32x16 __attribute__((ext_vector_type(16)));
typedef float f32x2v __attribute__((ext_vector_type(2)));
#define MFMA32(a, b, c) __builtin_amdgcn_mfma_f32_32x32x16_bf16((a), (b), (c), 0, 0, 0)
__device__ __forceinline__ s16x4 tr16(const LAS unsigned char* p) { return __builtin_bit_cast(s16x4, __builtin_amdgcn_ds_read_tr16_b64_v4i16((LAS s16x4*)p)); }
__device__ __forceinline__ unsigned cvtpk(float lo, float hi) { f32x2v v = {lo, hi}; bf16x2_t b = __builtin_convertvector(v, bf16x2_t); return __builtin_bit_cast(unsigned, b); }
__device__ __forceinline__ int crow(int reg, int h) { return (reg & 3) + 8 * (reg >> 2) + 4 * h; }
constexpr float LOG2E = 1.4426950408889634f;

__device__ __forceinline__ void p2_attn_mfma(LAS unsigned char* lds, const Ptrs& P, int vcu, int G, int tid, int lane, int wave) {
    LAS unsigned char* Kl = lds;
    LAS unsigned char* Vl = lds + 32768;
    LAS float* biasl = (LAS float*)(lds + 32768 + 49152);
    const int r = lane & 31, h = lane >> 5, i16 = lane & 15, q4 = i16 >> 2, p4 = i16 & 3, blk = (lane >> 4) & 1;
    for (int unit = vcu; unit < 256; unit += G) {
        const int kvh = unit & 1, blkid = unit >> 1, nb = blkid & 63; const int tok0 = blkid * 128;
#pragma unroll
        for (int i = 0; i < 4; ++i) {
            const int cidx = tid + 512 * i, row = cidx >> 3, c = cidx & 7;
            v4u kw = {0u, 0u, 0u, 0u}, vw = {0u, 0u, 0u, 0u};
            if (nb > 0 || row >= 128) { const bf16* src = P.KV + (size_t)(tok0 - 128 + row) * 256 + kvh * 64 + c * 8; kw = *(const v4u*)src; vw = *(const v4u*)(src + 128); }
            *(LAS v4u*)(Kl + row * 128 + ((c ^ ((row >> 1) & 7)) << 4)) = kw;
            *(LAS v4u*)(Vl + row * 192 + c * 16) = vw;
        }
        biasl[tid] = P.rel_bias[(int)T5B[tid & 127] * 8 + kvh * 4 + (tid >> 7)] * LOG2E;
        __syncthreads();
        const int g = wave >> 1, qh = wave & 1, hq = kvh * 4 + g;
        const float sink2 = P.sinks[hq] * LOG2E;
#pragma unroll 1
        for (int qs = 0; qs < 2; ++qs) {
            const int qi0 = 64 * qh + 32 * qs, kt0 = 2 * qh + qs;
            s16x8 qf[4];
            { const bf16* qrow = P.Q + (size_t)(tok0 + qi0 + r) * 512 + hq * 64 + 8 * h;
#pragma unroll
              for (int ks = 0; ks < 4; ++ks) qf[ks] = *(const s16x8*)(qrow + 16 * ks); }
            f32x16 s[5];
#pragma unroll
            for (int i = 0; i < 5; ++i) {
#pragma unroll
                for (int e = 0; e < 16; ++e) s[i][e] = 0.f;
                const int key = 32 * (kt0 + i) + r; const LAS unsigned char* kp = Kl + key * 128; const int sw = (key >> 1) & 7;
#pragma unroll
                for (int ks = 0; ks < 4; ++ks) { const s16x8 kf = *(const LAS s16x8*)(kp + (((2 * ks + h) ^ sw) << 4)); s[i] = MFMA32(kf, qf[ks], s[i]); }
            }
            const int qi = qi0 + r;
            float mx = sink2;
#pragma unroll
            for (int i = 0; i < 5; ++i)
#pragma unroll
                for (int e = 0; e < 16; ++e) {
                    const int kj = 32 * (kt0 + i) + crow(e, h), dist = 128 + qi - kj;
                    const bool valid = (dist >= 0) && (dist < 128) && (nb > 0 || kj >= 128);
                    const float b = biasl[g * 128 + (dist & 127)];
                    const float v = valid ? s[i][e] * (0.125f * LOG2E) + b : -1e30f;
                    s[i][e] = v; mx = fmaxf(mx, v);
                }
            mx = fmaxf(mx, xor32_f(mx));
            float l = 0.f;
#pragma unroll
            for (int i = 0; i < 5; ++i)
#pragma unroll
                for (int e = 0; e < 16; ++e) { const float p = __builtin_amdgcn_exp2f(s[i][e] - mx); s[i][e] = p; l += p; }
            l += xor32_f(l);
            l += __builtin_amdgcn_exp2f(sink2 - mx);
            f32x16 o0, o1;
#pragma unroll
            for (int e = 0; e < 16; ++e) { o0[e] = 0.f; o1[e] = 0.f; }
#pragma unroll
            for (int i = 0; i < 5; ++i)
#pragma unroll
                for (int st = 0; st < 2; ++st) {
                    v4u pw; pw.x = cvtpk(s[i][8 * st], s[i][8 * st + 1]); pw.y = cvtpk(s[i][8 * st + 2], s[i][8 * st + 3]); pw.z = cvtpk(s[i][8 * st + 4], s[i][8 * st + 5]); pw.w = cvtpk(s[i][8 * st + 6], s[i][8 * st + 7]);
                    const s16x8 pf = __builtin_bit_cast(s16x8, pw);
                    const LAS unsigned char* vb = Vl + (32 * (kt0 + i) + 16 * st + 4 * h + q4) * 192 + 32 * blk + 8 * p4;
                    { const s16x4 lo = tr16(vb), hi = tr16(vb + 8 * 192); const s16x8 vf = __builtin_shufflevector(lo, hi, 0, 1, 2, 3, 4, 5, 6, 7); o0 = MFMA32(vf, pf, o0); }
                    { const s16x4 lo = tr16(vb + 64), hi = tr16(vb + 64 + 8 * 192); const s16x8 vf = __builtin_shufflevector(lo, hi, 0, 1, 2, 3, 4, 5, 6, 7); o1 = MFMA32(vf, pf, o1); }
                }
            const float inv = 1.0f / l;
            bf16* orow = P.AOUT + (size_t)(tok0 + qi) * AB_LD + hq * 64 + 4 * h;
#pragma unroll
            for (int r4 = 0; r4 < 4; ++r4) {
                v2u w0; w0.x = cvtpk(o0[4 * r4] * inv, o0[4 * r4 + 1] * inv); w0.y = cvtpk(o0[4 * r4 + 2] * inv, o0[4 * r4 + 3] * inv); *(v2u*)(orow + 8 * r4) = w0;
                v2u w1; w1.x = cvtpk(o1[4 * r4] * inv, o1[4 * r4 + 1] * inv); w1.y = cvtpk(o1[4 * r4 + 2] * inv, o1[4 * r4 + 3] * inv); *(v2u*)(orow + 32 + 8 * r4) = w1;
            }
        }
        __syncthreads();
    }
}

__device__ __forceinline__ void p2_gmlp_mfma(LAS unsigned char* lds, const Ptrs& P, int vcu, int G, int tid, int lane, int wave) {
    LAS unsigned char* vnl = lds;
    const int r = lane & 31, h = lane >> 5, i16 = lane & 15, q4 = i16 >> 2, p4 = i16 & 3, blk = (lane >> 4) & 1;
    for (int unit = vcu; unit < 256; unit += G) {
        const int c = unit >> 1, hh = unit & 1;
        for (int i = 0; i < 16; ++i) {
            const int tt = wave * 16 + i; const size_t row = (size_t)c * 128 + tt;
            const v4u w = *((const v4u*)(P.GV + row * 512) + lane);
            float x[8] = {bflo(w.x), bfhi(w.x), bflo(w.y), bfhi(w.y), bflo(w.z), bfhi(w.z), bflo(w.w), bfhi(w.w)};
            float s = 0.f;
#pragma unroll
            for (int j = 0; j < 8; ++j) s += x[j];
            const float mean = wave_sum(s) * (1.0f / 512.0f);
            float ss = 0.f;
#pragma unroll
            for (int j = 0; j < 8; ++j) { x[j] -= mean; ss += x[j] * x[j]; }
            const float rstd = 1.0f / sqrtf(wave_sum(ss) * (1.0f / 512.0f) + EPS);
            if ((lane >> 5) == hh) {
                const f32x4 w0 = *(const f32x4*)(P.ln_w + lane * 8), w1 = *(const f32x4*)(P.ln_w + lane * 8 + 4), b0 = *(const f32x4*)(P.ln_b + lane * 8), b1 = *(const f32x4*)(P.ln_b + lane * 8 + 4);
                v4u o; o.x = pk2(x[0] * rstd * w0[0] + b0[0], x[1] * rstd * w0[1] + b0[1]); o.y = pk2(x[2] * rstd * w0[2] + b0[2], x[3] * rstd * w0[3] + b0[3]);
                o.z = pk2(x[4] * rstd * w1[0] + b1[0], x[5] * rstd * w1[1] + b1[1]); o.w = pk2(x[6] * rstd * w1[2] + b1[2], x[7] * rstd * w1[3] + b1[3]);
                *(LAS v4u*)(vnl + tt * 576 + (lane & 31) * 16) = o;
            }
        }
        __syncthreads();
        const int gi = wave >> 1, dblk = wave & 1, g = hh * 4 + gi;
        s16x8 af[8];
#pragma unroll
        for (int ks = 0; ks < 8; ++ks) { const LAS unsigned char* vb = vnl + (16 * ks + 8 * h + q4) * 576 + (gi * 64 + dblk * 32 + 16 * blk) * 2 + 8 * p4;
            const s16x4 lo = tr16(vb), hi = tr16(vb + 4 * 576); af[ks] = __builtin_shufflevector(lo, hi, 0, 1, 2, 3, 4, 5, 6, 7); }
#pragma unroll
        for (int tt = 0; tt < 4; ++tt) {
            f32x16 acc;
#pragma unroll
            for (int e = 0; e < 16; ++e) acc[e] = 0.f;
            const bf16* wrow = P.WS + ((size_t)g * 128 + 32 * tt + r) * 128 + 8 * h;
#pragma unroll
            for (int ks = 0; ks < 2 * (tt + 1); ++ks) acc = MFMA32(af[ks], *(const s16x8*)(wrow + 16 * ks), acc);
            const int t = 32 * tt + r; const size_t row = (size_t)c * 128 + t; const float b = P.b_s[g * 128 + t];
#pragma unroll
            for (int r4 = 0; r4 < 4; ++r4) {
                const int ch = g * 64 + dblk * 32 + 8 * r4 + 4 * h;
                const v2u uw = *(const v2u*)(P.GU + row * 512 + ch);
                v2u ow; ow.x = cvtpk(bflo(uw.x) * (acc[4 * r4] + b), bfhi(uw.x) * (acc[4 * r4 + 1] + b)); ow.y = cvtpk(bflo(uw.y) * (acc[4 * r4 + 2] + b), bfhi(uw.y) * (acc[4 * r4 + 3] + b));
                *(v2u*)(P.BOUT + row * AB_LD + ch) = ow;
            }
        }
        __syncthreads();
    }
}

__device__ __forceinline__ void topk_half(const bf16* q, const LAS bf16* kl, float (&v)[16]) {
    v4u qv[16];
#pragma unroll
    for (int c = 0; c < 16; ++c) qv[c] = ((const v4u*)q)[c];
#pragma unroll
    for (int i = 0; i < 16; ++i) v[i] = -INFINITY;
    for (int n = 0; n < 128; ++n) {
        const LAS v4u* kr = (const LAS v4u*)(kl + n * 128);
        float a0 = 0.f, a1 = 0.f, a2 = 0.f, a3 = 0.f;
#pragma unroll
        for (int c = 0; c < 16; ++c) { const v4u kk = kr[c]; a0 = dot2bf(qv[c].x, kk.x, a0); a1 = dot2bf(qv[c].y, kk.y, a1); a2 = dot2bf(qv[c].z, kk.z, a2); a3 = dot2bf(qv[c].w, kk.w, a3); }
        const float acc = (a0 + a1) + (a2 + a3);
        float x = __builtin_bit_cast(float, (__builtin_bit_cast(unsigned, acc) & ~0x7Fu) | (unsigned)n);
#pragma unroll
        for (int i = 0; i < 16; ++i) { const float hi = fmaxf(v[i], x); x = fminf(v[i], x); v[i] = hi; }
    }
}

__host__ __device__ constexpr int cand_slot(int i, int j) { int c = 0; for (int a = 0; a < 16; ++a) for (int b = 0; b < 16; ++b) { if (a == i && b == j) return c; if ((a + 1) * (b + 1) <= 16) ++c; } return c; }
#define CE_DESC(a, b) do { const float hi_ = fmaxf((a), (b)); const float lo_ = fminf((a), (b)); (a) = hi_; (b) = lo_; } while (0)
__device__ __forceinline__ void sort16_desc(float (&v)[16]) {
    CE_DESC(v[0], v[1]); CE_DESC(v[3], v[2]); CE_DESC(v[4], v[5]); CE_DESC(v[7], v[6]); CE_DESC(v[8], v[9]); CE_DESC(v[11], v[10]); CE_DESC(v[12], v[13]); CE_DESC(v[15], v[14]); CE_DESC(v[0], v[2]); CE_DESC(v[1], v[3]); CE_DESC(v[6], v[4]); CE_DESC(v[7], v[5]); CE_DESC(v[8], v[10]); CE_DESC(v[9], v[11]); CE_DESC(v[14], v[12]); CE_DESC(v[15], v[13]); CE_DESC(v[0], v[1]); CE_DESC(v[2], v[3]); CE_DESC(v[5], v[4]); CE_DESC(v[7], v[6]); CE_DESC(v[8], v[9]); CE_DESC(v[10], v[11]); CE_DESC(v[13], v[12]); CE_DESC(v[15], v[14]); CE_DESC(v[0], v[4]); CE_DESC(v[1], v[5]); CE_DESC(v[2], v[6]); CE_DESC(v[3], v[7]); CE_DESC(v[12], v[8]); CE_DESC(v[13], v[9]); CE_DESC(v[14], v[10]); CE_DESC(v[15], v[11]); CE_DESC(v[0], v[2]); CE_DESC(v[1], v[3]); CE_DESC(v[4], v[6]); CE_DESC(v[5], v[7]); CE_DESC(v[10], v[8]); CE_DESC(v[11], v[9]); CE_DESC(v[14], v[12]); CE_DESC(v[15], v[13]); CE_DESC(v[0], v[1]); CE_DESC(v[2], v[3]); CE_DESC(v[4], v[5]); CE_DESC(v[6], v[7]); CE_DESC(v[9], v[8]); CE_DESC(v[11], v[10]); CE_DESC(v[13], v[12]); CE_DESC(v[15], v[14]); CE_DESC(v[0], v[8]); CE_DESC(v[1], v[9]); CE_DESC(v[2], v[10]); CE_DESC(v[3], v[11]); CE_DESC(v[4], v[12]); CE_DESC(v[5], v[13]); CE_DESC(v[6], v[14]); CE_DESC(v[7], v[15]); CE_DESC(v[0], v[4]); CE_DESC(v[1], v[5]); CE_DESC(v[2], v[6]); CE_DESC(v[3], v[7]); CE_DESC(v[8], v[12]); CE_DESC(v[9], v[13]); CE_DESC(v[10], v[14]); CE_DESC(v[11], v[15]); CE_DESC(v[0], v[2]); CE_DESC(v[1], v[3]); CE_DESC(v[4], v[6]); CE_DESC(v[5], v[7]); CE_DESC(v[8], v[10]); CE_DESC(v[9], v[11]); CE_DESC(v[12], v[14]); CE_DESC(v[13], v[15]); CE_DESC(v[0], v[1]); CE_DESC(v[2], v[3]); CE_DESC(v[4], v[5]); CE_DESC(v[6], v[7]); CE_DESC(v[8], v[9]); CE_DESC(v[10], v[11]); CE_DESC(v[12], v[13]); CE_DESC(v[14], v[15]);
}
__device__ __forceinline__ void merge_top16(float (&a)[16], const float (&b)[16]) {
    a[0] = fmaxf(a[0], b[15]); a[1] = fmaxf(a[1], b[14]); a[2] = fmaxf(a[2], b[13]); a[3] = fmaxf(a[3], b[12]); a[4] = fmaxf(a[4], b[11]); a[5] = fmaxf(a[5], b[10]); a[6] = fmaxf(a[6], b[9]); a[7] = fmaxf(a[7], b[8]); a[8] = fmaxf(a[8], b[7]); a[9] = fmaxf(a[9], b[6]); a[10] = fmaxf(a[10], b[5]); a[11] = fmaxf(a[11], b[4]); a[12] = fmaxf(a[12], b[3]); a[13] = fmaxf(a[13], b[2]); a[14] = fmaxf(a[14], b[1]); a[15] = fmaxf(a[15], b[0]); CE_DESC(a[0], a[8]); CE_DESC(a[1], a[9]); CE_DESC(a[2], a[10]); CE_DESC(a[3], a[11]); CE_DESC(a[4], a[12]); CE_DESC(a[5], a[13]); CE_DESC(a[6], a[14]); CE_DESC(a[7], a[15]); CE_DESC(a[0], a[4]); CE_DESC(a[1], a[5]); CE_DESC(a[2], a[6]); CE_DESC(a[3], a[7]); CE_DESC(a[8], a[12]); CE_DESC(a[9], a[13]); CE_DESC(a[10], a[14]); CE_DESC(a[11], a[15]); CE_DESC(a[0], a[2]); CE_DESC(a[1], a[3]); CE_DESC(a[4], a[6]); CE_DESC(a[5], a[7]); CE_DESC(a[8], a[10]); CE_DESC(a[9], a[11]); CE_DESC(a[12], a[14]); CE_DESC(a[13], a[15]); CE_DESC(a[0], a[1]); CE_DESC(a[2], a[3]); CE_DESC(a[4], a[5]); CE_DESC(a[6], a[7]); CE_DESC(a[8], a[9]); CE_DESC(a[10], a[11]); CE_DESC(a[12], a[13]); CE_DESC(a[14], a[15]);
}
__device__ __forceinline__ void scores_top16(const bf16* qbase, const LAS unsigned char* kl, int r, int h, float (&t)[16]) {
#if TOPK_DBG_INSERT == 3
#pragma unroll
    for (int k = 0; k < 16; ++k) t[k] = -1e30f;
#pragma unroll 1
    for (int key = 0; key < 128; ++key) { float a = 0.f;
        if (((key >> 2) & 1) != h) continue;
        for (int c = 0; c < 16; ++c) { const v4u q1 = *(const v4u*)(qbase + (size_t)r * 256 + 8 * c); const v4u kk1 = *(const LAS v4u*)(kl + key * 256 + 16 * c);
            a = dot2bf(q1.x, kk1.x, a); a = dot2bf(q1.y, kk1.y, a); a = dot2bf(q1.z, kk1.z, a); a = dot2bf(q1.w, kk1.w, a); }
        float x = __builtin_bit_cast(float, (__builtin_bit_cast(unsigned, a) & ~0x7Fu) | (unsigned)key);
#pragma unroll
        for (int i = 0; i < 16; ++i) { const float hi = fmaxf(t[i], x); x = fminf(t[i], x); t[i] = hi; } }
    return;
#endif
    f32x16 acc[4];
#pragma unroll
    for (int kt = 0; kt < 4; ++kt)
#pragma unroll
        for (int e = 0; e < 16; ++e) acc[kt][e] = 0.f;
    const LAS unsigned char* kp0 = kl + r * 256; const int sw = KEY_SWZ ? (r & 15) : 0;
#pragma unroll
    for (int ks = 0; ks < 8; ++ks) {
        const s16x8 qf = *(const s16x8*)(qbase + (size_t)r * 256 + 16 * ks + 8 * h);
#pragma unroll
        for (int kt = 0; kt < 4; ++kt) { const s16x8 kf = *(const LAS s16x8*)(kp0 + kt * 8192 + (((2 * ks + h) ^ sw) << 4)); acc[kt] = MFMA32(kf, qf, acc[kt]); }
    }
    float g[4][16];
#pragma unroll
    for (int kt = 0; kt < 4; ++kt) {
#pragma unroll
        for (int e = 0; e < 16; ++e) { const float av_ = acc[kt][e];
            g[kt][e] = __builtin_bit_cast(float, (__builtin_bit_cast(unsigned, av_) & ~0x7Fu) | (unsigned)(32 * kt + (e & 3) + 8 * (e >> 2))); }
#if !TOPK_DBG_INSERT
        sort16_desc(g[kt]);
#endif
    }
#if TOPK_DBG_INSERT == 2
#pragma unroll
    for (int k = 0; k < 16; ++k) t[k] = -1e30f;
#pragma unroll
    for (int kt = 0; kt < 4; ++kt)
#pragma unroll
        for (int e = 0; e < 16; ++e) t[0] = fmaxf(t[0], g[kt][e]);
#elif TOPK_DBG_INSERT
#pragma unroll
    for (int k = 0; k < 16; ++k) t[k] = -1e30f;
#pragma unroll
    for (int kt = 0; kt < 4; ++kt)
#pragma unroll
        for (int e = 0; e < 16; ++e) { float x = g[kt][e];
#pragma unroll
            for (int i = 0; i < 16; ++i) { const float hi = fmaxf(t[i], x); x = fminf(t[i], x); t[i] = hi; } }
#else
    merge_top16(g[0], g[1]); merge_top16(g[2], g[3]); merge_top16(g[0], g[2]);
#pragma unroll
    for (int k = 0; k < 16; ++k) t[k] = __builtin_bit_cast(float, __builtin_bit_cast(unsigned, g[0][k]) | ((unsigned)h << 2));
#endif
}
__device__ __forceinline__ void peer_topk_unit_mfma(const Ptrs& P, const LAS unsigned char* k1l, const LAS unsigned char* k2l, LAS int* idxl, LAS float* gatel, int unit, int lane, int wave) {
    asm volatile("" : "+v"(lane));
    const int r = lane & 31, h = lane >> 5;
#pragma unroll 1
    for (int rbi = 0; rbi < 2; ++rbi) {
        const int rb = wave * 2 + rbi, R = rb * 32 + r;
        const bf16* qbase = P.QP + ((size_t)unit * 512 + rb * 32) * 256;
        float t1[16], t2[16];
#if TOPK_DBG_BRUTE
#pragma unroll
        for (int k = 0; k < 16; ++k) { t1[k] = -1e30f; t2[k] = -1e30f; }
#pragma unroll 1
        for (int key = 0; key < 128; ++key) { float a = 0.f, b = 0.f;
            if (((key >> 2) & 1) != h) continue;
            for (int c = 0; c < 16; ++c) { const v4u q1 = *(const v4u*)(qbase + (size_t)r * 256 + 8 * c), q2 = *(const v4u*)(qbase + 128 + (size_t)r * 256 + 8 * c);
                const v4u kk1 = *(const LAS v4u*)(k1l + key * 256 + 16 * c), kk2 = *(const LAS v4u*)(k2l + key * 256 + 16 * c);
                a = dot2bf(q1.x, kk1.x, a); a = dot2bf(q1.y, kk1.y, a); a = dot2bf(q1.z, kk1.z, a); a = dot2bf(q1.w, kk1.w, a);
                b = dot2bf(q2.x, kk2.x, b); b = dot2bf(q2.y, kk2.y, b); b = dot2bf(q2.z, kk2.z, b); b = dot2bf(q2.w, kk2.w, b); }
            float x = __builtin_bit_cast(float, (__builtin_bit_cast(unsigned, a) & ~0x7Fu) | (unsigned)key), y = __builtin_bit_cast(float, (__builtin_bit_cast(unsigned, b) & ~0x7Fu) | (unsigned)key);
#pragma unroll
            for (int i = 0; i < 16; ++i) { const float hi = fmaxf(t1[i], x); x = fminf(t1[i], x); t1[i] = hi; const float hj = fmaxf(t2[i], y); y = fminf(t2[i], y); t2[i] = hj; } }
#else
        scores_top16(qbase, k1l, r, h, t1);
        __builtin_amdgcn_sched_barrier(0);
        scores_top16(qbase + 128, k2l, r, h, t2);
        __builtin_amdgcn_sched_barrier(0);
#endif
        float F[16], recv[16];
#pragma unroll
        for (int k = 0; k < 16; ++k) { auto rr = __builtin_amdgcn_permlane32_swap(__builtin_bit_cast(unsigned, t1[k]), __builtin_bit_cast(unsigned, t2[k]), false, false);
            const unsigned r0 = rr[0], r1 = rr[1]; F[k] = __builtin_bit_cast(float, r0); recv[k] = __builtin_bit_cast(float, r1); }
        merge_top16(F, recv);
        LAS unsigned char* slot = (LAS unsigned char*)(idxl + R * 16);
        { v4u b;
          b.x = (__builtin_bit_cast(unsigned, F[0]) & 0x7Fu) | ((__builtin_bit_cast(unsigned, F[1]) & 0x7Fu) << 8) | ((__builtin_bit_cast(unsigned, F[2]) & 0x7Fu) << 16) | ((__builtin_bit_cast(unsigned, F[3]) & 0x7Fu) << 24);
          b.y = (__builtin_bit_cast(unsigned, F[4]) & 0x7Fu) | ((__builtin_bit_cast(unsigned, F[5]) & 0x7Fu) << 8) | ((__builtin_bit_cast(unsigned, F[6]) & 0x7Fu) << 16) | ((__builtin_bit_cast(unsigned, F[7]) & 0x7Fu) << 24);
          b.z = (__builtin_bit_cast(unsigned, F[8]) & 0x7Fu) | ((__builtin_bit_cast(unsigned, F[9]) & 0x7Fu) << 8) | ((__builtin_bit_cast(unsigned, F[10]) & 0x7Fu) << 16) | ((__builtin_bit_cast(unsigned, F[11]) & 0x7Fu) << 24);
          b.w = (__builtin_bit_cast(unsigned, F[12]) & 0x7Fu) | ((__builtin_bit_cast(unsigned, F[13]) & 0x7Fu) << 8) | ((__builtin_bit_cast(unsigned, F[14]) & 0x7Fu) << 16) | ((__builtin_bit_cast(unsigned, F[15]) & 0x7Fu) << 24);
#if !TOPK_DBG_GATES_ONLY
          *(LAS v4u*)(slot + 16 * h) = b;
#endif
          (void)b; }
#if TOPK_DBG_COMPARE == 7 || TOPK_DBG_COMPARE == 8
        { float best1 = -1e30f, best2 = -1e30f;
#pragma unroll 1
          for (int key = 0; key < 128; ++key) { float a = 0.f, b = 0.f;
              if (TOPK_DBG_COMPARE == 8 && ((key >> 2) & 1) != h) continue;
              for (int c = 0; c < 16; ++c) { const v4u q1 = *(const v4u*)(qbase + (size_t)r * 256 + 8 * c), q2 = *(const v4u*)(qbase + 128 + (size_t)r * 256 + 8 * c);
                  const v4u kk1 = *(const LAS v4u*)(k1l + key * 256 + 16 * c), kk2 = *(const LAS v4u*)(k2l + key * 256 + 16 * c);
                  a = dot2bf(q1.x, kk1.x, a); a = dot2bf(q1.y, kk1.y, a); a = dot2bf(q1.z, kk1.z, a); a = dot2bf(q1.w, kk1.w, a);
                  b = dot2bf(q2.x, kk2.x, b); b = dot2bf(q2.y, kk2.y, b); b = dot2bf(q2.z, kk2.z, b); b = dot2bf(q2.w, kk2.w, b); }
              best1 = fmaxf(best1, __builtin_bit_cast(float, (__builtin_bit_cast(unsigned, a) & ~0x7Fu) | (unsigned)key));
              best2 = fmaxf(best2, __builtin_bit_cast(float, (__builtin_bit_cast(unsigned, b) & ~0x7Fu) | (unsigned)key)); }
          *(LAS unsigned*)((LAS unsigned char*)idxl + 65536 + R * 8 + 4 * h) = (__builtin_bit_cast(unsigned, best1) & 0x7Fu) | ((__builtin_bit_cast(unsigned, best2) & 0x7Fu) << 16); }
#endif
#if TOPK_DBG_COMPARE == 9
        { float m1 = t1[0], m2 = t2[0];
#pragma unroll
          for (int k = 1; k < 16; ++k) { m1 = fmaxf(m1, t1[k]); m2 = fmaxf(m2, t2[k]); }
          *(LAS unsigned*)((LAS unsigned char*)idxl + 65536 + R * 8 + 4 * h) = (__builtin_bit_cast(unsigned, m1) & 0x7Fu) | ((__builtin_bit_cast(unsigned, m2) & 0x7Fu) << 16); }
#endif
#if TOPK_DBG_COMPARE == 6
        *(LAS unsigned*)((LAS unsigned char*)idxl + 65536 + R * 8 + 4 * h) = (__builtin_bit_cast(unsigned, t1[0]) & 0x7Fu) | ((__builtin_bit_cast(unsigned, t1[1]) & 0x7Fu) << 8) | ((__builtin_bit_cast(unsigned, t2[0]) & 0x7Fu) << 16) | ((__builtin_bit_cast(unsigned, t2[1]) & 0x7Fu) << 24);
#endif
#if TOPK_DBG_COMPARE == 4
        *(LAS unsigned*)((LAS unsigned char*)idxl + 65536 + R * 8 + 4 * h) = (__builtin_bit_cast(unsigned, F[TOPK_DBG_K0]) & 0x7Fu) | ((__builtin_bit_cast(unsigned, F[TOPK_DBG_K0 + 1]) & 0x7Fu) << 8) | ((__builtin_bit_cast(unsigned, F[TOPK_DBG_K0 + 2]) & 0x7Fu) << 16) | ((__builtin_bit_cast(unsigned, F[TOPK_DBG_K0 + 3]) & 0x7Fu) << 24);
#endif
        float v1[16], v2[16];
#pragma unroll
        for (int k = 0; k < 16; ++k) { auto rr = __builtin_amdgcn_permlane32_swap(__builtin_bit_cast(unsigned, F[k]), __builtin_bit_cast(unsigned, F[k]), false, false);
            const unsigned r0 = rr[0], r1 = rr[1]; v1[k] = __builtin_bit_cast(float, r0 & ~0x7Fu); v2[k] = __builtin_bit_cast(float, r1 & ~0x7Fu); }
        float cg[4][16];
#pragma unroll
        for (int a = 0; a < 4; ++a)
#pragma unroll
            for (int k = 0; k < 16; ++k) cg[a][k] = -1e30f;
#define CAND(i, j) __builtin_bit_cast(float, (__builtin_bit_cast(unsigned, v1[i] + v2[j]) & ~0xFFu) | (unsigned)((i) * 16 + (j)))
        cg[0][0] = CAND(0, 0);
        cg[0][1] = CAND(0, 1);
        cg[0][2] = CAND(0, 2);
        cg[0][3] = CAND(0, 3);
        cg[0][4] = CAND(0, 4);
        cg[0][5] = CAND(0, 5);
        cg[0][6] = CAND(0, 6);
        cg[0][7] = CAND(0, 7);
        cg[0][8] = CAND(0, 8);
        cg[0][9] = CAND(0, 9);
        cg[0][10] = CAND(0, 10);
        cg[0][11] = CAND(0, 11);
        cg[0][12] = CAND(0, 12);
        cg[0][13] = CAND(0, 13);
        cg[0][14] = CAND(0, 14);
        cg[0][15] = CAND(0, 15);
        cg[1][0] = CAND(1, 0);
        cg[1][1] = CAND(1, 1);
        cg[1][2] = CAND(1, 2);
        cg[1][3] = CAND(1, 3);
        cg[1][4] = CAND(1, 4);
        cg[1][5] = CAND(1, 5);
        cg[1][6] = CAND(1, 6);
        cg[1][7] = CAND(1, 7);
        cg[1][8] = CAND(2, 0);
        cg[1][9] = CAND(2, 1);
        cg[1][10] = CAND(2, 2);
        cg[1][11] = CAND(2, 3);
        cg[1][12] = CAND(2, 4);
        cg[1][13] = CAND(3, 0);
        cg[1][14] = CAND(3, 1);
        cg[1][15] = CAND(3, 2);
        cg[2][0] = CAND(3, 3);
        cg[2][1] = CAND(4, 0);
        cg[2][2] = CAND(4, 1);
        cg[2][3] = CAND(4, 2);
        cg[2][4] = CAND(5, 0);
        cg[2][5] = CAND(5, 1);
        cg[2][6] = CAND(6, 0);
        cg[2][7] = CAND(6, 1);
        cg[2][8] = CAND(7, 0);
        cg[2][9] = CAND(7, 1);
        cg[2][10] = CAND(8, 0);
        cg[2][11] = CAND(9, 0);
        cg[2][12] = CAND(10, 0);
        cg[2][13] = CAND(11, 0);
        cg[2][14] = CAND(12, 0);
        cg[2][15] = CAND(13, 0);
        cg[3][0] = CAND(14, 0);
        cg[3][1] = CAND(15, 0);
#undef CAND
        sort16_desc(cg[0]); sort16_desc(cg[1]); sort16_desc(cg[2]); sort16_desc(cg[3]);
        merge_top16(cg[0], cg[1]); merge_top16(cg[2], cg[3]); merge_top16(cg[0], cg[2]);
        float es = 0.f, e[16];
        const float top = __builtin_bit_cast(float, __builtin_bit_cast(unsigned, cg[0][0]) & ~0xFFu);
#pragma unroll
        for (int k = 0; k < 16; ++k) { e[k] = __expf(__builtin_bit_cast(float, __builtin_bit_cast(unsigned, cg[0][k]) & ~0xFFu) - top); es += e[k]; }
        const float inv = 1.0f / es;
        LDS_WAIT();
        unsigned id[8]; float gt[8];
#pragma unroll
        for (int k = 0; k < 8; ++k) { const float clo_ = cg[0][k], chi_ = cg[0][8 + k], elo_ = e[k], ehi_ = e[8 + k]; const unsigned code = __builtin_bit_cast(unsigned, h ? chi_ : clo_) & 0xFFu; gt[k] = (h ? ehi_ : elo_) * inv;
            id[k] = (unsigned)slot[code >> 4] * 128u + (unsigned)slot[16 + (code & 15u)]; }
        LDS_WAIT();
        LAS v4u* ip = (LAS v4u*)(idxl + R * 16 + 8 * h); LAS f32x4* gp = (LAS f32x4*)(gatel + R * 16 + 8 * h);
#if !TOPK_DBG_GATES_ONLY
        { v4u a; a.x = id[0]; a.y = id[1]; a.z = id[2]; a.w = id[3]; ip[0] = a; v4u b; b.x = id[4]; b.y = id[5]; b.z = id[6]; b.w = id[7]; ip[1] = b; }
#else
        (void)ip;
#endif
        { f32x4 a; a[0] = gt[0]; a[1] = gt[1]; a[2] = gt[2]; a[3] = gt[3]; gp[0] = a; f32x4 b; b[0] = gt[4]; b[1] = gt[5]; b[2] = gt[6]; b[3] = gt[7]; gp[1] = b; }
    }
}

__device__ __forceinline__ void peer_topk_unit(const Ptrs& P, const LAS bf16* k1l, const LAS bf16* k2l, LAS int* idxl, LAS float* gatel, int unit, int tid) {
    const int tl = tid >> 3, h = tid & 7;
    const bf16* qrow = P.QP + (size_t)(unit * 64 + tl) * 2048 + h * 256;
    float v1[16], v2[16];
    topk_half(qrow, k1l, v1);
    topk_half(qrow + 128, k2l, v2);
    int bad4 = 0;
#if TOPK_DBG_COMPARE == 4
    { const LAS unsigned char* sl = (const LAS unsigned char*)idxl + 65536 + tid * 8;
#pragma unroll
      for (int k = 0; k < 4; ++k) {
          if (TOPK_DBG_SEL != 2 && (unsigned)sl[k] != (__builtin_bit_cast(unsigned, v1[TOPK_DBG_K0 + k]) & 0x7Fu)) bad4 = 1;
          if (TOPK_DBG_SEL != 1 && (unsigned)sl[4 + k] != (__builtin_bit_cast(unsigned, v2[TOPK_DBG_K0 + k]) & 0x7Fu)) bad4 = 1; }
      LDS_WAIT(); }
#endif
#if TOPK_DBG_COMPARE >= 6
    { const LAS unsigned char* sl = (const LAS unsigned char*)idxl + 65536 + tid * 8;
      const unsigned a1 = __builtin_bit_cast(unsigned, v1[0]) & 0x7Fu, a2 = __builtin_bit_cast(unsigned, v2[0]) & 0x7Fu;
      if (TOPK_DBG_SEL != 2 && a1 != (unsigned)sl[0] && a1 != (unsigned)sl[4]) bad4 = 1;
      if (TOPK_DBG_SEL != 1 && a2 != (unsigned)sl[2] && a2 != (unsigned)sl[6]) bad4 = 1;
      LDS_WAIT(); }
#endif
    (void)bad4;
    float tv[16]; int tp[16];
#pragma unroll
    for (int k = 0; k < 16; ++k) { tv[k] = -INFINITY; tp[k] = 0; }
#pragma unroll
    for (int i = 0; i < 16; ++i)
#pragma unroll
        for (int j = 0; j < 16; ++j)
            if ((i + 1) * (j + 1) <= 16) {
                const unsigned b1 = __builtin_bit_cast(unsigned, v1[i]), b2 = __builtin_bit_cast(unsigned, v2[j]);
                float x = __builtin_bit_cast(float, b1 & ~0x7Fu) + __builtin_bit_cast(float, b2 & ~0x7Fu);
                int px = (int)((b1 & 0x7Fu) * 128u + (b2 & 0x7Fu));
#pragma unroll
                for (int k = 0; k < 16; ++k) { const bool c = x > tv[k]; const float nv = c ? x : tv[k], nx = c ? tv[k] : x; const int np = c ? px : tp[k], npx = c ? tp[k] : px; tv[k] = nv; x = nx; tp[k] = np; px = npx; }
            }
    float e[16], es = 0.f;
#pragma unroll
    for (int k = 0; k < 16; ++k) { e[k] = __expf(tv[k] - tv[0]); es += e[k]; }
    const float inv = 1.0f / es;
    LAS v4u* ip = (LAS v4u*)(idxl + tl * 128 + h * 16); LAS f32x4* gp = (LAS f32x4*)(gatel + tl * 128 + h * 16);
#if TOPK_DBG_COMPARE
    { int bad = bad4; unsigned hs_old = 0, hs_new = 0, hx_old = 0, hx_new = 0;
#pragma unroll
      for (int k = 0; k < 16; ++k) { const int ni = idxl[tl * 128 + h * 16 + k]; const float ng = gatel[tl * 128 + h * 16 + k];
          hs_old += (unsigned)tp[k]; hs_new += (unsigned)ni; hx_old ^= (unsigned)tp[k] * 2654435761u; hx_new ^= (unsigned)ni * 2654435761u;
          if (TOPK_DBG_COMPARE == 1 && (k >= TOPK_DBG_K0 && k < TOPK_DBG_K1) && ni != tp[k]) bad = 1;
          if (TOPK_DBG_COMPARE == 3 && (k >= TOPK_DBG_K0 && k < TOPK_DBG_K1) && fabsf(ng - e[k] * inv) > 2e-3f) bad = 1; }
      if (TOPK_DBG_COMPARE == 2 && (hs_old != hs_new || hx_old != hx_new)) bad = 1;
      ((LAS int*)((LAS unsigned char*)idxl + 65536 + 4096))[tid] = bad; }
#endif
#pragma unroll
    for (int k = 0; k < 4; ++k) { v4u iv; iv.x = (unsigned)tp[4 * k]; iv.y = (unsigned)tp[4 * k + 1]; iv.z = (unsigned)tp[4 * k + 2]; iv.w = (unsigned)tp[4 * k + 3]; ip[k] = iv;
        f32x4 gv; gv[0] = e[4 * k] * inv; gv[1] = e[4 * k + 1] * inv; gv[2] = e[4 * k + 2] * inv; gv[3] = e[4 * k + 3] * inv; gp[k] = gv; }
}

#if PEER_FP8
typedef float f32x2p __attribute__((ext_vector_type(2)));
__device__ __forceinline__ unsigned fp8lo_bf16(unsigned w) { return __builtin_bit_cast(unsigned, __builtin_amdgcn_cvt_scalef32_pk_bf16_fp8((int)w, 1.0f, false)); }
__device__ __forceinline__ unsigned fp8hi_bf16(unsigned w) { return __builtin_bit_cast(unsigned, __builtin_amdgcn_cvt_scalef32_pk_bf16_fp8((int)w, 1.0f, true)); }
template <bool STORE> __device__ __forceinline__ void peer_gather_token(const Ptrs& P, const LAS int* idxl, const LAS float* gatel, LAS float* al, int tl, size_t t, int lane, int wave) {
    asm volatile("" : "+v"(lane));
    const int sub = lane & 15, grp = lane >> 4;
    v4u hnr[4][2];
#pragma unroll
    for (int j = 0; j < 4; ++j) { const v4u* hp = (const v4u*)(P.HN2 + t * 1024 + (j * 16 + sub) * 16); hnr[j][0] = hp[0]; hnr[j][1] = hp[1]; }
    const LAS int* myidx = idxl + tl * 128;
    v4u w[4][4]; float sc[4];
#define ULOAD(B, Q) do { const int row_ = myidx[4 * (Q) + grp]; const v4u* up_ = (const v4u*)(P.U8 + (size_t)row_ * 1024) + sub; \
        _Pragma("unroll") for (int j = 0; j < 4; ++j) w[B][j] = up_[j * 16]; sc[B] = P.USC[row_]; } while (0)
#define UCOMP(B, Q) do { float a0 = 0.f, a1 = 0.f, a2 = 0.f, a3 = 0.f; \
        _Pragma("unroll") for (int j = 0; j < 4; ++j) { const v4u x_ = w[B][j]; \
            a0 = dot2bf(fp8lo_bf16(x_.x), hnr[j][0].x, a0); a1 = dot2bf(fp8hi_bf16(x_.x), hnr[j][0].y, a1); a2 = dot2bf(fp8lo_bf16(x_.y), hnr[j][0].z, a2); a3 = dot2bf(fp8hi_bf16(x_.y), hnr[j][0].w, a3); \
            a0 = dot2bf(fp8lo_bf16(x_.z), hnr[j][1].x, a0); a1 = dot2bf(fp8hi_bf16(x_.z), hnr[j][1].y, a1); a2 = dot2bf(fp8lo_bf16(x_.w), hnr[j][1].z, a2); a3 = dot2bf(fp8hi_bf16(x_.w), hnr[j][1].w, a3); } \
        float acc_ = row16_sum((a0 + a1) + (a2 + a3)); \
        if (sub == 0) al[wave * 128 + 4 * (Q) + grp] = acc_ * sc[B]; } while (0)
    ULOAD(0, 0); ULOAD(1, 1); ULOAD(2, 2);
#pragma unroll 1
    for (int q = 0; q < 32; q += 4) {
        ULOAD(3, q + 3); UCOMP(0, q);
        if (q + 4 < 32) ULOAD(0, q + 4);
        UCOMP(1, q + 1);
        if (q + 4 < 32) ULOAD(1, q + 5);
        UCOMP(2, q + 2);
        if (q + 4 < 32) ULOAD(2, q + 6);
        UCOMP(3, q + 3);
    }
#undef ULOAD
#undef UCOMP
    LDS_WAIT();
    const int ix0 = myidx[lane], ix1 = myidx[64 + lane];
    const float av0 = al[wave * 128 + lane], av1 = al[wave * 128 + 64 + lane];
    const float act0 = gelu_tanh(av0) * gatel[tl * 128 + lane] * P.VSC[ix0], act1 = gelu_tanh(av1) * gatel[tl * 128 + 64 + lane] * P.VSC[ix1];
    LDS_WAIT();
    float y[16];
#pragma unroll
    for (int k = 0; k < 16; ++k) y[k] = 0.f;
    v4u vb[2][8];
#define VLOAD(B, IX, E0) do { _Pragma("unroll") for (int k = 0; k < 8; ++k) { const int row_ = __builtin_amdgcn_readlane(IX, (E0) + k); vb[B][k] = *((const v4u*)(P.V8 + (size_t)row_ * 1024) + lane); } } while (0)
#define VCOMP(B, ACT, E0) do { _Pragma("unroll") for (int k = 0; k < 8; ++k) { const float a_ = __builtin_bit_cast(float, __builtin_amdgcn_readlane(__builtin_bit_cast(int, ACT), (E0) + k)); const v4u x_ = vb[B][k]; \
        f32x2p d_; d_ = __builtin_amdgcn_cvt_pk_f32_fp8((int)x_.x, false); y[0] += a_ * d_[0]; y[1] += a_ * d_[1]; d_ = __builtin_amdgcn_cvt_pk_f32_fp8((int)x_.x, true); y[2] += a_ * d_[0]; y[3] += a_ * d_[1]; \
        d_ = __builtin_amdgcn_cvt_pk_f32_fp8((int)x_.y, false); y[4] += a_ * d_[0]; y[5] += a_ * d_[1]; d_ = __builtin_amdgcn_cvt_pk_f32_fp8((int)x_.y, true); y[6] += a_ * d_[0]; y[7] += a_ * d_[1]; \
        d_ = __builtin_amdgcn_cvt_pk_f32_fp8((int)x_.z, false); y[8] += a_ * d_[0]; y[9] += a_ * d_[1]; d_ = __builtin_amdgcn_cvt_pk_f32_fp8((int)x_.z, true); y[10] += a_ * d_[0]; y[11] += a_ * d_[1]; \
        d_ = __builtin_amdgcn_cvt_pk_f32_fp8((int)x_.w, false); y[12] += a_ * d_[0]; y[13] += a_ * d_[1]; d_ = __builtin_amdgcn_cvt_pk_f32_fp8((int)x_.w, true); y[14] += a_ * d_[0]; y[15] += a_ * d_[1]; } } while (0)
    VLOAD(0, ix0, 0);
#pragma unroll 1
    for (int e = 0; e < 64; e += 16) { VLOAD(1, ix0, e + 8); VCOMP(0, act0, e); if (e + 16 < 64) VLOAD(0, ix0, e + 16); else VLOAD(0, ix1, 0); VCOMP(1, act0, e + 8); }
#pragma unroll 1
    for (int e = 0; e < 64; e += 16) { VLOAD(1, ix1, e + 8); VCOMP(0, act1, e); if (e + 16 < 64) VLOAD(0, ix1, e + 16); VCOMP(1, act1, e + 8); }
#undef VLOAD
#undef VCOMP
    float* xr = P.out + t * 1024 + lane * 16;
    f32x4 x[4];
#pragma unroll
    for (int k = 0; k < 4; ++k) { x[k] = *(const f32x4*)(xr + 4 * k); x[k][0] += y[4 * k]; x[k][1] += y[4 * k + 1]; x[k][2] += y[4 * k + 2]; x[k][3] += y[4 * k + 3]; }
    float ss = 0.f;
#pragma unroll
    for (int k = 0; k < 4; ++k) ss += (x[k][0] * x[k][0] + x[k][1] * x[k][1]) + (x[k][2] * x[k][2] + x[k][3] * x[k][3]);
    const float rstd = 1.0f / sqrtf(wave_sum(ss) * (1.0f / 1024.0f) + EPS);
    if (STORE) {
#if TOPK_DBG_COMPARE
        { const LAS int* fl = (const LAS int*)((const LAS unsigned char*)idxl + 65536 + 4096) + tl * 8; int bad = 0;
#pragma unroll
          for (int hh = 0; hh < 8; ++hh) bad |= fl[hh];
          if (bad) {
#pragma unroll
              for (int k = 0; k < 4; ++k) x[k] = x[k] * 0.f; } }
#endif
#pragma unroll
        for (int k = 0; k < 4; ++k) { const f32x4 wv = *(const f32x4*)(P.fin_w + lane * 16 + 4 * k); *(f32x4*)(xr + 4 * k) = x[k] * rstd * wv; }
    } else { asm volatile("" :: "v"(rstd), "v"(x[0][0]), "v"(x[1][1]), "v"(x[2][2]), "v"(x[3][3])); }
}
#else
template <bool STORE> __device__ __forceinline__ void peer_gather_token(const Ptrs& P, const LAS int* idxl, const LAS float* gatel, LAS float* al, int tl, size_t t, int lane, int wave) {
    const int sub = lane & 15, grp = lane >> 4;
    v4u hnr[8];
#pragma unroll
    for (int j = 0; j < 8; ++j) hnr[j] = *((const v4u*)(P.HN2 + t * 1024) + j * 16 + sub);
    for (int q = 0; q < 32; ++q) {
        const int row = idxl[tl * 128 + 4 * q + grp];
        const v4u* up = (const v4u*)(P.U + (size_t)row * 1024) + sub;
        float a0 = 0.f, a1 = 0.f, a2 = 0.f, a3 = 0.f;
#pragma unroll
        for (int j = 0; j < 8; ++j) { const v4u w = up[j * 16]; a0 = dot2bf(w.x, hnr[j].x, a0); a1 = dot2bf(w.y, hnr[j].y, a1); a2 = dot2bf(w.z, hnr[j].z, a2); a3 = dot2bf(w.w, hnr[j].w, a3); }
        float acc = (a0 + a1) + (a2 + a3);
        acc += __shfl_xor(acc, 8); acc += __shfl_xor(acc, 4); acc += __shfl_xor(acc, 2); acc += __shfl_xor(acc, 1);
        if (sub == 0) al[wave * 128 + 4 * q + grp] = acc;
    }
    LDS_WAIT();
    const float av0 = al[wave * 128 + lane], av1 = al[wave * 128 + 64 + lane];
    const float act0 = gelu_tanh(av0) * gatel[tl * 128 + lane], act1 = gelu_tanh(av1) * gatel[tl * 128 + 64 + lane];
    const int ix0 = idxl[tl * 128 + lane], ix1 = idxl[tl * 128 + 64 + lane];
    LDS_WAIT();
    float y[16];
#pragma unroll
    for (int k = 0; k < 16; ++k) y[k] = 0.f;
#pragma unroll 4
    for (int e = 0; e < 64; ++e) {
        const int row = __builtin_amdgcn_readlane(ix0, e); const float a = __builtin_bit_cast(float, __builtin_amdgcn_readlane(__builtin_bit_cast(int, act0), e));
        const v4u* vp = (const v4u*)(P.V + (size_t)row * 1024) + lane; const v4u w0 = vp[0], w1 = vp[64];
        y[0] += a * bflo(w0.x); y[1] += a * bfhi(w0.x); y[2] += a * bflo(w0.y); y[3] += a * bfhi(w0.y); y[4] += a * bflo(w0.z); y[5] += a * bfhi(w0.z); y[6] += a * bflo(w0.w); y[7] += a * bfhi(w0.w);
        y[8] += a * bflo(w1.x); y[9] += a * bfhi(w1.x); y[10] += a * bflo(w1.y); y[11] += a * bfhi(w1.y); y[12] += a * bflo(w1.z); y[13] += a * bfhi(w1.z); y[14] += a * bflo(w1.w); y[15] += a * bfhi(w1.w);
    }
#pragma unroll 4
    for (int e = 0; e < 64; ++e) {
        const int row = __builtin_amdgcn_readlane(ix1, e); const float a = __builtin_bit_cast(float, __builtin_amdgcn_readlane(__builtin_bit_cast(int, act1), e));
        const v4u* vp = (const v4u*)(P.V + (size_t)row * 1024) + lane; const v4u w0 = vp[0], w1 = vp[64];
        y[0] += a * bflo(w0.x); y[1] += a * bfhi(w0.x); y[2] += a * bflo(w0.y); y[3] += a * bfhi(w0.y); y[4] += a * bflo(w0.z); y[5] += a * bfhi(w0.z); y[6] += a * bflo(w0.w); y[7] += a * bfhi(w0.w);
        y[8] += a * bflo(w1.x); y[9] += a * bfhi(w1.x); y[10] += a * bflo(w1.y); y[11] += a * bfhi(w1.y); y[12] += a * bflo(w1.z); y[13] += a * bfhi(w1.z); y[14] += a * bflo(w1.w); y[15] += a * bfhi(w1.w);
    }
    float* xr = P.out + t * 1024;
    f32x4 x0 = *(const f32x4*)(xr + lane * 8), x1 = *(const f32x4*)(xr + lane * 8 + 4), x2 = *(const f32x4*)(xr + 512 + lane * 8), x3 = *(const f32x4*)(xr + 512 + lane * 8 + 4);
    x0[0] += y[0]; x0[1] += y[1]; x0[2] += y[2]; x0[3] += y[3]; x1[0] += y[4]; x1[1] += y[5]; x1[2] += y[6]; x1[3] += y[7];
    x2[0] += y[8]; x2[1] += y[9]; x2[2] += y[10]; x2[3] += y[11]; x3[0] += y[12]; x3[1] += y[13]; x3[2] += y[14]; x3[3] += y[15];
    float ss = 0.f;
#pragma unroll
    for (int k = 0; k < 4; ++k) ss += x0[k] * x0[k] + x1[k] * x1[k] + x2[k] * x2[k] + x3[k] * x3[k];
    const float rstd = 1.0f / sqrtf(wave_sum(ss) * (1.0f / 1024.0f) + EPS);
    if (STORE) {
        const f32x4 w0 = *(const f32x4*)(P.fin_w + lane * 8), w1 = *(const f32x4*)(P.fin_w + lane * 8 + 4), w2 = *(const f32x4*)(P.fin_w + 512 + lane * 8), w3 = *(const f32x4*)(P.fin_w + 512 + lane * 8 + 4);
        *(f32x4*)(xr + lane * 8) = x0 * rstd * w0; *(f32x4*)(xr + lane * 8 + 4) = x1 * rstd * w1; *(f32x4*)(xr + 512 + lane * 8) = x2 * rstd * w2; *(f32x4*)(xr + 512 + lane * 8 + 4) = x3 * rstd * w3;
    } else { asm volatile("" :: "v"(rstd), "v"(x0[0]), "v"(x1[1]), "v"(x2[2]), "v"(x3[3])); }
}
#endif

__device__ __forceinline__ void peer_u_token(const Ptrs& P, const LAS int* idxl, LAS float* gatel, LAS float* al, int tl, size_t t, int lane, int wave) {
    asm volatile("" : "+v"(lane));
    const int sub = lane & 15, grp = lane >> 4;
    v4u hnr[4][2];
#pragma unroll
    for (int j = 0; j < 4; ++j) { const v4u* hp = (const v4u*)(P.HN2 + t * 1024 + (j * 16 + sub) * 16); hnr[j][0] = hp[0]; hnr[j][1] = hp[1]; }
    const LAS int* myidx = idxl + tl * 128;
    v4u w[4][4]; float sc[4];
#define ULOAD(B, Q) do { const int row_ = myidx[4 * (Q) + grp]; const v4u* up_ = (const v4u*)(P.U8 + (size_t)row_ * 1024) + sub; \
        _Pragma("unroll") for (int j = 0; j < 4; ++j) w[B][j] = up_[j * 16]; sc[B] = P.USC[row_]; } while (0)
#define UCOMP(B, Q) do { float a0 = 0.f, a1 = 0.f, a2 = 0.f, a3 = 0.f; \
        _Pragma("unroll") for (int j = 0; j < 4; ++j) { const v4u x_ = w[B][j]; \
            a0 = dot2bf(fp8lo_bf16(x_.x), hnr[j][0].x, a0); a1 = dot2bf(fp8hi_bf16(x_.x), hnr[j][0].y, a1); a2 = dot2bf(fp8lo_bf16(x_.y), hnr[j][0].z, a2); a3 = dot2bf(fp8hi_bf16(x_.y), hnr[j][0].w, a3); \
            a0 = dot2bf(fp8lo_bf16(x_.z), hnr[j][1].x, a0); a1 = dot2bf(fp8hi_bf16(x_.z), hnr[j][1].y, a1); a2 = dot2bf(fp8lo_bf16(x_.w), hnr[j][1].z, a2); a3 = dot2bf(fp8hi_bf16(x_.w), hnr[j][1].w, a3); } \
        float acc_ = row16_sum((a0 + a1) + (a2 + a3)); \
        if (sub == 0) al[wave * 128 + 4 * (Q) + grp] = acc_ * sc[B]; } while (0)
    ULOAD(0, 0); ULOAD(1, 1); ULOAD(2, 2);
#pragma unroll 1
    for (int q = 0; q < 32; q += 4) {
        ULOAD(3, q + 3); UCOMP(0, q);
        if (q + 4 < 32) ULOAD(0, q + 4);
        UCOMP(1, q + 1);
        if (q + 4 < 32) ULOAD(1, q + 5);
        UCOMP(2, q + 2);
        if (q + 4 < 32) ULOAD(2, q + 6);
        UCOMP(3, q + 3);
    }
#undef ULOAD
#undef UCOMP
    LDS_WAIT();
    const int ix0 = myidx[lane], ix1 = myidx[64 + lane];
    const float av0 = al[wave * 128 + lane], av1 = al[wave * 128 + 64 + lane];
    const float act0 = gelu_tanh(av0) * gatel[tl * 128 + lane] * P.VSC[ix0], act1 = gelu_tanh(av1) * gatel[tl * 128 + 64 + lane] * P.VSC[ix1];
    gatel[tl * 128 + lane] = act0; gatel[tl * 128 + 64 + lane] = act1;
    LDS_WAIT();
}

#if PEER_FP8
#define PK8(OUT, X) do { OUT[0] = __builtin_amdgcn_cvt_pk_f32_fp8((int)(X).x, false); OUT[1] = __builtin_amdgcn_cvt_pk_f32_fp8((int)(X).x, true); OUT[2] = __builtin_amdgcn_cvt_pk_f32_fp8((int)(X).y, false); OUT[3] = __builtin_amdgcn_cvt_pk_f32_fp8((int)(X).y, true); \
        OUT[4] = __builtin_amdgcn_cvt_pk_f32_fp8((int)(X).z, false); OUT[5] = __builtin_amdgcn_cvt_pk_f32_fp8((int)(X).z, true); OUT[6] = __builtin_amdgcn_cvt_pk_f32_fp8((int)(X).w, false); OUT[7] = __builtin_amdgcn_cvt_pk_f32_fp8((int)(X).w, true); } while (0)
#define ROW_ISSUE(BUF, TAB, W) do { const unsigned char* rp_ = (TAB) + (size_t)((W) & rowand) * 1024; asm volatile("s_nop 4\n\tglobal_load_dwordx4 %0, %1, %2" : "=v"(BUF) : "v"(loff), "s"(rp_) : "memory"); } while (0)
#define ML(d) (16 * ((((d) & 3) == 1) ? 2 : (((d) & 3) == 2) ? 1 : ((d) & 3)) + ((d) >> 2))
__device__ __forceinline__ void peer_gather_sorted(const Ptrs& P, LAS unsigned char* lds, int unit, int lane, int wave) {
    asm volatile("" : "+v"(lane));
    const size_t t0 = (size_t)unit * 64 + wave * 8;
#pragma unroll 1
    for (int gq = 0; gq < 2; ++gq) {
        int lq = lane; asm volatile("" : "+v"(lq));
        const unsigned loff = (unsigned)lq * 16u;
        LAS int* idxl = (LAS int*)(lds + 65536) + wave * 1024 + gq * 512;
        const LAS float* gatel = (const LAS float*)(lds + 98304) + wave * 1024 + gq * 512;
        LAS v2u* sortl = (LAS v2u*)lds + wave * 1024 + gq * 512;
        LAS float* uscl = (LAS float*)idxl;
        LAS int* startl = (LAS int*)(lds + 131072 + 4096) + wave * 32;
        {
            int ent[8]; float gv[8], us[8];
#pragma unroll
            for (int j = 0; j < 8; ++j) { ent[j] = idxl[(j >> 1) * 128 + (j & 1) * 64 + lq]; gv[j] = gatel[(j >> 1) * 128 + (j & 1) * 64 + lq]; }
#pragma unroll
            for (int j = 0; j < 8; ++j) { us[j] = P.USC[ent[j]]; gv[j] *= P.VSC[ent[j]]; }
            LDS_WAIT();
            int rk[8]; int run[16];
#pragma unroll
            for (int b = 0; b < 16; ++b) run[b] = 0;
#pragma unroll
            for (int j = 0; j < 8; ++j) { const int bj = ent[j] >> 10; int r = 0;
#pragma unroll
                for (int b = 0; b < 16; ++b) { const unsigned long long m = __ballot(bj == b);
                    const int below = (int)__builtin_amdgcn_mbcnt_hi((unsigned)(m >> 32), __builtin_amdgcn_mbcnt_lo((unsigned)m, 0u));
                    r = (bj == b) ? run[b] + below : r; run[b] += (int)__builtin_popcountll(m); }
                rk[j] = r; }
            { int st = 0;
#pragma unroll
              for (int b = 0; b < 16; ++b) { if (lq == b) startl[b] = st; st += run[b]; } }
            LDS_WAIT();
#pragma unroll
            for (int j = 0; j < 8; ++j) { const int pos = startl[ent[j] >> 10] + rk[j]; v2u rec; rec.x = (unsigned)ent[j] | ((unsigned)(j >> 1) << 14); rec.y = __builtin_bit_cast(unsigned, gv[j]); sortl[pos] = rec; uscl[pos] = us[j]; }
            LDS_WAIT();
        }
        __syncthreads();
#if U_MFMA
        {
            const int n = lq & 15, kg = lq >> 4;
            v2u hb[32];
            { const unsigned char* hp = P.HN8 + (t0 + gq * 4 + (n & 3)) * 1024 + 8 * kg;
#pragma unroll
              for (int ks = 0; ks < 32; ++ks) { v2u v = *(const v2u*)(hp + 32 * ks); if (n >= 4) { v.x = 0u; v.y = 0u; } hb[ks] = v; } }
            LAS float* xl = (LAS float*)(lds + 131072) + wave * 128;
            if (lq < 4) xl[64 + lq] = P.HSC[t0 + gq * 4 + lq];
            v4u ua[16], ub[16];
            unsigned mw_a, mw_b; float mg_a, mg_b, mu_a, mu_b;
#define UM_META(i0, W, G, U) do { const v2u e_ = sortl[(i0) + n]; W = e_.x; const unsigned g_ = e_.y; G = __builtin_bit_cast(float, g_); U = uscl[(i0) + n]; } while (0)
#define UM_LOAD(BUF, W) do { const unsigned char* rp_ = P.U8 + (size_t)((W) & umask) * 1024 + 16 * kg; \
        _Pragma("unroll") for (int m = 0; m < 16; ++m) BUF[m] = *(const v4u*)(rp_ + 64 * m); } while (0)
#define UM_COMP(BUF, W, G, U, i0) do { f32x4 acc = {0.f, 0.f, 0.f, 0.f}; \
        _Pragma("unroll") for (int m = 0; m < 16; ++m) { \
            const long a0_ = (long)(((unsigned long long)BUF[m].y << 32) | BUF[m].x), a1_ = (long)(((unsigned long long)BUF[m].w << 32) | BUF[m].z); \
            const long b0_ = (long)(((unsigned long long)hb[2 * m].y << 32) | hb[2 * m].x), b1_ = (long)(((unsigned long long)hb[2 * m + 1].y << 32) | hb[2 * m + 1].x); \
            acc = __builtin_amdgcn_mfma_f32_16x16x32_fp8_fp8(a0_, b0_, acc, 0, 0, 0); acc = __builtin_amdgcn_mfma_f32_16x16x32_fp8_fp8(a1_, b1_, acc, 0, 0, 0); } \
        if (n < 4) { xl[(4 * kg + 0) * 4 + n] = acc[0]; xl[(4 * kg + 1) * 4 + n] = acc[1]; xl[(4 * kg + 2) * 4 + n] = acc[2]; xl[(4 * kg + 3) * 4 + n] = acc[3]; } \
        LDS_WAIT(); \
        { const unsigned tok_ = ((W) >> 14) & 3u; const float a_ = xl[n * 4 + tok_] * (U) * xl[64 + tok_]; const float act_ = gelu_tanh(a_) * (G); \
          if (lq < 16 && pass + 1 == PROBE_U_PASSES) sortl[(i0) + n].y = __builtin_bit_cast(unsigned, act_); asm volatile("" :: "v"(act_)); } \
        LDS_WAIT(); } while (0)
            LDS_WAIT();
#pragma unroll 1
            for (int pass = 0; pass < PROBE_U_PASSES; ++pass) {
            const unsigned umask = (pass + 1 < PROBE_U_PASSES) ? 63u : 16383u;
            UM_META(0, mw_a, mg_a, mu_a); UM_LOAD(ua, mw_a);
#pragma unroll 1
            for (int i0 = 0; i0 < 512; i0 += 32) {
                UM_META(i0 + 16, mw_b, mg_b, mu_b); UM_LOAD(ub, mw_b);
                UM_COMP(ua, mw_a, mg_a, mu_a, i0);
                if (i0 + 32 < 512) { UM_META(i0 + 32, mw_a, mg_a, mu_a); UM_LOAD(ua, mw_a); }
                UM_COMP(ub, mw_b, mg_b, mu_b, i0 + 16);
            }
            }
#undef UM_META
#undef UM_LOAD
#undef UM_COMP
        }
        LDS_WAIT();
        __syncthreads();
#else
        {
#if U_INT8
            int hf[4][4];
            float hsc[4];
#if P5_ELIM
            { f32x4 wn[4];
#pragma unroll
              for (int k = 0; k < 4; ++k) wn[k] = *(const f32x4*)(P.ffn_w + loff + 4 * k);
#pragma unroll
              for (int tk = 0; tk < 4; ++tk) { const size_t row = t0 + gq * 4 + tk; const float* xr = P.out + row * 1024 + loff;
                  const f32x4* sp_ = (const f32x4*)(P.rowss + row * 16); const f32x4* ap_ = (const f32x4*)(P.rowamax + row * 16);
                  const f32x4 sq_ = (sp_[0] + sp_[1]) + (sp_[2] + sp_[3]); const f32x4 a0_ = ap_[0], a1_ = ap_[1], a2_ = ap_[2], a3_ = ap_[3];
                  float am = 0.f;
#pragma unroll
                  for (int k = 0; k < 4; ++k) am = fmaxf(am, fmaxf(fmaxf(a0_[k], a1_[k]), fmaxf(a2_[k], a3_[k])));
                  const float qs = (am > 1e-30f) ? 127.0f / am : 0.f;
                  const float rstd = 1.0f / sqrtf(((sq_[0] + sq_[1]) + (sq_[2] + sq_[3])) * (1.0f / 1024.0f) + EPS);
                  hsc[tk] = am * rstd * (1.0f / 127.0f);
#pragma unroll
                  for (int k = 0; k < 4; ++k) { const f32x4 v = *(const f32x4*)(xr + 4 * k) * wn[k] * qs; hf[tk][k] = pack_i8x4(v[0], v[1], v[2], v[3]); } } }
#else
#pragma unroll
            for (int tk = 0; tk < 4; ++tk) { const v4u h0 = *(const v4u*)(P.HN8 + (t0 + gq * 4 + tk) * 1024 + loff); hf[tk][0] = (int)h0.x; hf[tk][1] = (int)h0.y; hf[tk][2] = (int)h0.z; hf[tk][3] = (int)h0.w; hsc[tk] = P.HSC[t0 + gq * 4 + tk]; }
#endif
#elif U_DOT2
            unsigned hf[4][8];
#pragma unroll
            for (int tk = 0; tk < 4; ++tk) { const v4u* hp = (const v4u*)((const unsigned char*)(P.HN2 + (t0 + gq * 4 + tk) * 1024) + 2u * loff); const v4u h0 = hp[0], h1 = hp[1];
                hf[tk][0] = h0.x; hf[tk][1] = h0.y; hf[tk][2] = h0.z; hf[tk][3] = h0.w; hf[tk][4] = h1.x; hf[tk][5] = h1.y; hf[tk][6] = h1.z; hf[tk][7] = h1.w; }
#else
            f32x2p hf[4][8];
#pragma unroll
            for (int tk = 0; tk < 4; ++tk) { const v4u* hp = (const v4u*)((const unsigned char*)(P.HN2 + (t0 + gq * 4 + tk) * 1024) + 2u * loff); const v4u h0 = hp[0], h1 = hp[1];
                hf[tk][0][0] = bflo(h0.x); hf[tk][0][1] = bfhi(h0.x); hf[tk][1][0] = bflo(h0.y); hf[tk][1][1] = bfhi(h0.y); hf[tk][2][0] = bflo(h0.z); hf[tk][2][1] = bfhi(h0.z); hf[tk][3][0] = bflo(h0.w); hf[tk][3][1] = bfhi(h0.w);
                hf[tk][4][0] = bflo(h1.x); hf[tk][4][1] = bfhi(h1.x); hf[tk][5][0] = bflo(h1.y); hf[tk][5][1] = bfhi(h1.y); hf[tk][6][0] = bflo(h1.z); hf[tk][6][1] = bfhi(h1.z); hf[tk][7][0] = bflo(h1.w); hf[tk][7][1] = bfhi(h1.w); }
#endif
            v4u ub[16]; float p[16];
            const int c4 = lq & 15, rho = lq >> 4;
            const int me = (c4 < 4) ? 4 * c4 + ((rho == 1) ? 2 : (rho == 2) ? 1 : rho) : 0;
            unsigned mw_c, mw_n; float mg_c, mg_n, mu_c, mu_n;
#if U_INT8
#define HSC_OF(W) ((((W) >> 14) & 3u) == 0u ? hsc[0] : (((W) >> 14) & 3u) == 1u ? hsc[1] : (((W) >> 14) & 3u) == 2u ? hsc[2] : hsc[3])
#else
#define HSC_OF(W) 1.0f
#endif
#define U_META(i0, W, G, U) do { const v2u e_ = sortl[(i0) + me]; W = e_.x; const unsigned g_ = e_.y; G = __builtin_bit_cast(float, g_); U = uscl[(i0) + me]; } while (0)
#if U_INT8
#define U_DOT(tk) asm volatile("s_cmp_lg_u32 %10, " #tk "\n\ts_cbranch_scc1 .LUSK%=\n\t" \
        "v_dot4c_i32_i8 %0, %2, %6\n\tv_dot4c_i32_i8 %1, %3, %7\n\tv_dot4c_i32_i8 %0, %4, %8\n\tv_dot4c_i32_i8 %1, %5, %9\n\ts_nop 2\n.LUSK%=:" \
        : "+v"(a0_), "+v"(a1_) : "v"(x_.x), "v"(x_.y), "v"(x_.z), "v"(x_.w), "v"(hf[tk][0]), "v"(hf[tk][1]), "v"(hf[tk][2]), "v"(hf[tk][3]), "s"(tok) : "scc")
#define U_STEP(d, CNT, ISSUE) do { asm volatile("s_waitcnt vmcnt(" #CNT ")" : "+v"(ub[d]) :: "memory"); \
        { const v4u x_ = ub[d]; \
          const unsigned tok = ((unsigned)__builtin_amdgcn_readlane((int)mw_c, ML(d)) >> 14) & 3u; \
          int a0_ = 0, a1_ = 0; \
          U_DOT(0); U_DOT(1); U_DOT(2); U_DOT(3); \
          p[d] = (float)(a0_ + a1_); } \
        if (ISSUE) ROW_ISSUE(ub[d], P.U8, (unsigned)__builtin_amdgcn_readlane((int)mw_n, ML(d))); } while (0)
#elif U_DOT2
#define U_DOT(tk) asm volatile("s_cmp_lg_u32 %20, " #tk "\n\ts_cbranch_scc1 .LUSK%=\n\t" \
        "v_dot2c_f32_bf16 %0, %4, %12\n\tv_dot2c_f32_bf16 %1, %5, %13\n\tv_dot2c_f32_bf16 %2, %6, %14\n\tv_dot2c_f32_bf16 %3, %7, %15\n\t" \
        "v_dot2c_f32_bf16 %0, %8, %16\n\tv_dot2c_f32_bf16 %1, %9, %17\n\tv_dot2c_f32_bf16 %2, %10, %18\n\tv_dot2c_f32_bf16 %3, %11, %19\n\ts_nop 2\n.LUSK%=:" \
        : "+v"(a0_), "+v"(a1_), "+v"(a2_), "+v"(a3_) \
        : "v"(dk_[0]), "v"(dk_[1]), "v"(dk_[2]), "v"(dk_[3]), "v"(dk_[4]), "v"(dk_[5]), "v"(dk_[6]), "v"(dk_[7]), \
          "v"(hf[tk][0]), "v"(hf[tk][1]), "v"(hf[tk][2]), "v"(hf[tk][3]), "v"(hf[tk][4]), "v"(hf[tk][5]), "v"(hf[tk][6]), "v"(hf[tk][7]), "s"(tok) : "scc")
#define U_STEP(d, CNT, ISSUE) do { asm volatile("s_waitcnt vmcnt(" #CNT ")" : "+v"(ub[d]) :: "memory"); \
        { const v4u x_ = ub[d]; unsigned dk_[8]; dk_[0] = fp8lo_bf16(x_.x); dk_[1] = fp8hi_bf16(x_.x); dk_[2] = fp8lo_bf16(x_.y); dk_[3] = fp8hi_bf16(x_.y); dk_[4] = fp8lo_bf16(x_.z); dk_[5] = fp8hi_bf16(x_.z); dk_[6] = fp8lo_bf16(x_.w); dk_[7] = fp8hi_bf16(x_.w); \
          const unsigned tok = ((unsigned)__builtin_amdgcn_readlane((int)mw_c, ML(d)) >> 14) & 3u; \
          float a0_ = 0.f, a1_ = 0.f, a2_ = 0.f, a3_ = 0.f; \
          U_DOT(0); U_DOT(1); U_DOT(2); U_DOT(3); \
          p[d] = (a0_ + a1_) + (a2_ + a3_); } \
        if (ISSUE) ROW_ISSUE(ub[d], P.U8, (unsigned)__builtin_amdgcn_readlane((int)mw_n, ML(d))); } while (0)
#else
#define U_DOT(tk) asm volatile("s_cmp_lg_u32 %20, " #tk "\n\ts_cbranch_scc1 .LUSK%=\n\t" \
        "v_pk_fma_f32 %0, %4, %12, %0\n\tv_pk_fma_f32 %1, %5, %13, %1\n\tv_pk_fma_f32 %2, %6, %14, %2\n\tv_pk_fma_f32 %3, %7, %15, %3\n\t" \
        "v_pk_fma_f32 %0, %8, %16, %0\n\tv_pk_fma_f32 %1, %9, %17, %1\n\tv_pk_fma_f32 %2, %10, %18, %2\n\tv_pk_fma_f32 %3, %11, %19, %3\n.LUSK%=:" \
        : "+v"(a0_), "+v"(a1_), "+v"(a2_), "+v"(a3_) \
        : "v"(dk_[0]), "v"(dk_[1]), "v"(dk_[2]), "v"(dk_[3]), "v"(dk_[4]), "v"(dk_[5]), "v"(dk_[6]), "v"(dk_[7]), \
          "v"(hf[tk][0]), "v"(hf[tk][1]), "v"(hf[tk][2]), "v"(hf[tk][3]), "v"(hf[tk][4]), "v"(hf[tk][5]), "v"(hf[tk][6]), "v"(hf[tk][7]), "s"(tok) : "scc")
#define U_STEP(d, CNT, ISSUE) do { asm volatile("s_waitcnt vmcnt(" #CNT ")" : "+v"(ub[d]) :: "memory"); \
        { const v4u x_ = ub[d]; f32x2p dk_[8]; PK8(dk_, x_); \
          const unsigned tok = ((unsigned)__builtin_amdgcn_readlane((int)mw_c, ML(d)) >> 14) & 3u; \
          f32x2p a0_, a1_, a2_, a3_; a0_[0] = 0.f; a0_[1] = 0.f; a1_ = a0_; a2_ = a0_; a3_ = a0_; \
          U_DOT(0); U_DOT(1); U_DOT(2); U_DOT(3); \
          const f32x2p s_ = (a0_ + a1_) + (a2_ + a3_); p[d] = s_[0] + s_[1]; } \
        if (ISSUE) ROW_ISSUE(ub[d], P.U8, (unsigned)__builtin_amdgcn_readlane((int)mw_n, ML(d))); } while (0)
#endif
#pragma unroll 1
            for (int pass = 0; pass < PROBE_U_PASSES; ++pass) {
            const unsigned rowand = (pass + 1 < PROBE_U_PASSES) ? 63u : 16383u;
            asm volatile("s_waitcnt vmcnt(0)" ::: "memory");
            U_META(0, mw_c, mg_c, mu_c);
#define U_ISSUE0(d) ROW_ISSUE(ub[d], P.U8, (unsigned)__builtin_amdgcn_readlane((int)mw_c, ML(d)))
            U_ISSUE0(0); U_ISSUE0(1); U_ISSUE0(2); U_ISSUE0(3); U_ISSUE0(4); U_ISSUE0(5); U_ISSUE0(6); U_ISSUE0(7); U_ISSUE0(8); U_ISSUE0(9); U_ISSUE0(10); U_ISSUE0(11); U_ISSUE0(12); U_ISSUE0(13); U_ISSUE0(14); U_ISSUE0(15);
#undef U_ISSUE0
#define U_FINISH(i0) do { float q_[8], r_[4]; \
        _Pragma("unroll") for (int j = 0; j < 8; ++j) { auto rr = __builtin_amdgcn_permlane32_swap(__builtin_bit_cast(unsigned, p[2 * j]), __builtin_bit_cast(unsigned, p[2 * j + 1]), false, false); const unsigned r0 = rr[0], r1 = rr[1]; q_[j] = __builtin_bit_cast(float, r0) + __builtin_bit_cast(float, r1); } \
        _Pragma("unroll") for (int j = 0; j < 4; ++j) { auto rr = __builtin_amdgcn_permlane16_swap(__builtin_bit_cast(unsigned, q_[2 * j]), __builtin_bit_cast(unsigned, q_[2 * j + 1]), false, false); const unsigned r0 = rr[0], r1 = rr[1]; r_[j] = row16_sum(__builtin_bit_cast(float, r0) + __builtin_bit_cast(float, r1)); } \
        const float acol = (c4 == 0) ? r_[0] : (c4 == 1) ? r_[1] : (c4 == 2) ? r_[2] : r_[3]; \
        const float act = gelu_tanh(acol * mu_c * HSC_OF(mw_c)) * mg_c; \
        if (c4 < 4 && pass + 1 == PROBE_U_PASSES) sortl[(i0) + me].y = __builtin_bit_cast(unsigned, act); asm volatile("" :: "v"(act)); } while (0)
#pragma unroll 1
            for (int i0 = 0; i0 < 512 - 16; i0 += 16) {
                U_META(i0 + 16, mw_n, mg_n, mu_n);
                U_STEP(0, 15, 1); U_STEP(1, 15, 1); U_STEP(2, 15, 1); U_STEP(3, 15, 1); U_STEP(4, 15, 1); U_STEP(5, 15, 1); U_STEP(6, 15, 1); U_STEP(7, 15, 1);
                U_STEP(8, 15, 1); U_STEP(9, 15, 1); U_STEP(10, 15, 1); U_STEP(11, 15, 1); U_STEP(12, 15, 1); U_STEP(13, 15, 1); U_STEP(14, 15, 1); U_STEP(15, 15, 1);
                U_FINISH(i0);
                mw_c = mw_n; mg_c = mg_n; mu_c = mu_n;
            }
            mw_n = mw_c;
            U_STEP(0, 15, 0); U_STEP(1, 14, 0); U_STEP(2, 13, 0); U_STEP(3, 12, 0); U_STEP(4, 11, 0); U_STEP(5, 10, 0); U_STEP(6, 9, 0); U_STEP(7, 8, 0);
            U_STEP(8, 7, 0); U_STEP(9, 6, 0); U_STEP(10, 5, 0); U_STEP(11, 4, 0); U_STEP(12, 3, 0); U_STEP(13, 2, 0); U_STEP(14, 1, 0); U_STEP(15, 0, 0);
            U_FINISH(512 - 16);
            }
#undef U_FINISH
#undef U_STEP
#undef U_DOT
#undef U_META
        }
        LDS_WAIT();
        __syncthreads();
#endif
        f32x2p y[4][8];
#pragma unroll
        for (int tk = 0; tk < 4; ++tk)
#pragma unroll
            for (int k = 0; k < 8; ++k) { y[tk][k][0] = 0.f; y[tk][k][1] = 0.f; }
        {
            v4u vb[16]; const int ml = lq & 15;
            unsigned mw_c, mw_n, ma_c, ma_n;
#define V_META(i0, W, A) do { const v2u e_ = sortl[(i0) + ml]; W = e_.x; A = e_.y; } while (0)
#define V_FMA(tk) asm volatile("s_cmp_lg_u32 %17, " #tk "\n\ts_cbranch_scc1 .LVSK%=\n\t" \
        "v_pk_fma_f32 %0, %8, %16, %0\n\tv_pk_fma_f32 %1, %9, %16, %1\n\tv_pk_fma_f32 %2, %10, %16, %2\n\tv_pk_fma_f32 %3, %11, %16, %3\n\t" \
        "v_pk_fma_f32 %4, %12, %16, %4\n\tv_pk_fma_f32 %5, %13, %16, %5\n\tv_pk_fma_f32 %6, %14, %16, %6\n\tv_pk_fma_f32 %7, %15, %16, %7\n.LVSK%=:" \
        : "+v"(y[tk][0]), "+v"(y[tk][1]), "+v"(y[tk][2]), "+v"(y[tk][3]), "+v"(y[tk][4]), "+v"(y[tk][5]), "+v"(y[tk][6]), "+v"(y[tk][7]) \
        : "v"(dk_[0]), "v"(dk_[1]), "v"(dk_[2]), "v"(dk_[3]), "v"(dk_[4]), "v"(dk_[5]), "v"(dk_[6]), "v"(dk_[7]), "v"(a2_), "s"(tok) : "scc")
#define V_NOFMA(tk) asm volatile("s_cmp_lg_u32 %17, " #tk "\n\ts_cbranch_scc1 .LVSK%=\n\ts_nop 0\n.LVSK%=:" \
        : "+v"(y[tk][0]), "+v"(y[tk][1]), "+v"(y[tk][2]), "+v"(y[tk][3]), "+v"(y[tk][4]), "+v"(y[tk][5]), "+v"(y[tk][6]), "+v"(y[tk][7]) \
        : "v"(dk_[0]), "v"(dk_[1]), "v"(dk_[2]), "v"(dk_[3]), "v"(dk_[4]), "v"(dk_[5]), "v"(dk_[6]), "v"(dk_[7]), "v"(a2_), "s"(tok) : "scc")
#define V_STEP(d, CNT, ISSUE, FM) do { asm volatile("s_waitcnt vmcnt(" #CNT ")" : "+v"(vb[d]) :: "memory"); \
        { const v4u x_ = vb[d]; f32x2p dk_[8]; PK8(dk_, x_); \
          const unsigned tok = ((unsigned)__builtin_amdgcn_readlane((int)mw_c, d) >> 14) & 3u; const float a_ = __builtin_bit_cast(float, __builtin_amdgcn_readlane((int)ma_c, d)); f32x2p a2_; a2_[0] = a_; a2_[1] = a_; \
          if (FM) { V_FMA(0); V_FMA(1); V_FMA(2); V_FMA(3); } else { V_NOFMA(0); V_NOFMA(1); V_NOFMA(2); V_NOFMA(3); } } \
        if (ISSUE) ROW_ISSUE(vb[d], P.V8, (unsigned)__builtin_amdgcn_readlane((int)mw_n, d)); } while (0)
#pragma unroll 1
            for (int pass = 0; pass < PROBE_V_PASSES; ++pass) {
            const unsigned rowand = (pass + 1 < PROBE_V_PASSES) ? 63u : 16383u;
#define V_BODY(FM) do { \
            asm volatile("s_waitcnt vmcnt(0)" ::: "memory"); \
            V_META(0, mw_c, ma_c); \
            V_ISSUE0(0); V_ISSUE0(1); V_ISSUE0(2); V_ISSUE0(3); V_ISSUE0(4); V_ISSUE0(5); V_ISSUE0(6); V_ISSUE0(7); V_ISSUE0(8); V_ISSUE0(9); V_ISSUE0(10); V_ISSUE0(11); V_ISSUE0(12); V_ISSUE0(13); V_ISSUE0(14); V_ISSUE0(15); \
            _Pragma("unroll 1") for (int i0 = 0; i0 < 512 - 16; i0 += 16) { \
                V_META(i0 + 16, mw_n, ma_n); \
                V_STEP(0, 15, 1, FM); V_STEP(1, 15, 1, FM); V_STEP(2, 15, 1, FM); V_STEP(3, 15, 1, FM); V_STEP(4, 15, 1, FM); V_STEP(5, 15, 1, FM); V_STEP(6, 15, 1, FM); V_STEP(7, 15, 1, FM); \
                V_STEP(8, 15, 1, FM); V_STEP(9, 15, 1, FM); V_STEP(10, 15, 1, FM); V_STEP(11, 15, 1, FM); V_STEP(12, 15, 1, FM); V_STEP(13, 15, 1, FM); V_STEP(14, 15, 1, FM); V_STEP(15, 15, 1, FM); \
                mw_c = mw_n; ma_c = ma_n; } \
            mw_n = mw_c; \
            V_STEP(0, 15, 0, FM); V_STEP(1, 14, 0, FM); V_STEP(2, 13, 0, FM); V_STEP(3, 12, 0, FM); V_STEP(4, 11, 0, FM); V_STEP(5, 10, 0, FM); V_STEP(6, 9, 0, FM); V_STEP(7, 8, 0, FM); \
            V_STEP(8, 7, 0, FM); V_STEP(9, 6, 0, FM); V_STEP(10, 5, 0, FM); V_STEP(11, 4, 0, FM); V_STEP(12, 3, 0, FM); V_STEP(13, 2, 0, FM); V_STEP(14, 1, 0, FM); V_STEP(15, 0, 0, FM); } while (0)
#define V_ISSUE0(d) ROW_ISSUE(vb[d], P.V8, (unsigned)__builtin_amdgcn_readlane((int)mw_c, d))
            if (pass + 1 < PROBE_V_PASSES) V_BODY(0); else V_BODY(1);
#undef V_ISSUE0
#undef V_BODY
            }
#undef V_STEP
#undef V_META
#undef V_FMA
#undef V_NOFMA
        }
#pragma unroll
        for (int tk = 0; tk < 4; ++tk) {
            float* xr = P.out + (t0 + gq * 4 + tk) * 1024 + loff;
            f32x4 x[4];
#pragma unroll
            for (int k = 0; k < 4; ++k) { x[k] = *(const f32x4*)(xr + 4 * k); x[k][0] += y[tk][2 * k][0]; x[k][1] += y[tk][2 * k][1]; x[k][2] += y[tk][2 * k + 1][0]; x[k][3] += y[tk][2 * k + 1][1]; }
            float ss = 0.f;
#pragma unroll
            for (int k = 0; k < 4; ++k) ss += (x[k][0] * x[k][0] + x[k][1] * x[k][1]) + (x[k][2] * x[k][2] + x[k][3] * x[k][3]);
            const float rstd = 1.0f / sqrtf(wave_sum(ss) * (1.0f / 1024.0f) + EPS);
#pragma unroll
            for (int k = 0; k < 4; ++k) { const f32x4 wv = *(const f32x4*)(P.fin_w + (loff + 4 * k)); *(f32x4*)(xr + 4 * k) = x[k] * rstd * wv; }
        }
    }
}
#undef ML
#undef ROW_ISSUE
#undef PK8
#endif

__device__ __forceinline__ void p7_peer(LAS unsigned char* lds, const Ptrs& P, int vcu, int G, int tid, int lane, int wave) {
    LAS bf16* k1l = (LAS bf16*)lds;
    LAS bf16* k2l = (LAS bf16*)(lds + 32768);
    LAS int* idxl = (LAS int*)(lds + 65536);
    LAS float* gatel = (LAS float*)(lds + 98304);
    LAS float* al = (LAS float*)(lds + 131072);
#if TOPK_MFMA && KEY_SWZ
    for (int i = tid; i < 2048; i += 512) { const int n = i >> 4, c = i & 15, d = n * 16 + (c ^ (n & 15)); ((LAS v4u*)k1l)[d] = ((const v4u*)P.K1)[i]; ((LAS v4u*)k2l)[d] = ((const v4u*)P.K2)[i]; }
#else
    for (int i = tid; i < 2048; i += 512) { ((LAS v4u*)k1l)[i] = ((const v4u*)P.K1)[i]; ((LAS v4u*)k2l)[i] = ((const v4u*)P.K2)[i]; }
#endif
    __syncthreads();
    for (int unit = vcu; unit < M / 64; unit += G) {
#if TOPK_DBG_COMPARE
        peer_topk_unit_mfma(P, (const LAS unsigned char*)k1l, (const LAS unsigned char*)k2l, idxl, gatel, unit, lane, wave);
        __syncthreads();
        peer_topk_unit(P, k1l, k2l, idxl, gatel, unit, tid);
#elif TOPK_DBG_GATES_ONLY
        peer_topk_unit(P, k1l, k2l, idxl, gatel, unit, tid);
        __syncthreads();
        peer_topk_unit_mfma(P, (const LAS unsigned char*)k1l, (const LAS unsigned char*)k2l, idxl, gatel, unit, lane, wave);
#elif TOPK_MFMA
        peer_topk_unit_mfma(P, (const LAS unsigned char*)k1l, (const LAS unsigned char*)k2l, idxl, gatel, unit, lane, wave);
#else
        peer_topk_unit(P, k1l, k2l, idxl, gatel, unit, tid);
#endif
#if PROBE_TOPK_REPS > 1
        __syncthreads();
#if TOPK_MFMA
        peer_topk_unit_mfma(P, (const LAS unsigned char*)k1l, (const LAS unsigned char*)k2l, idxl, gatel, unit, lane, wave);
#else
        peer_topk_unit(P, k1l, k2l, idxl, gatel, unit, tid);
#endif
#endif
        __syncthreads();
#if PROBE_GATHER_REPS > 1
#pragma unroll 1
        for (int i = 0; i < 8; ++i) peer_gather_token<false>(P, idxl, gatel, al, wave * 8 + i, (size_t)unit * 64 + wave * 8 + i, lane, wave);
#endif
#if GATHER_SORTED
        peer_gather_sorted(P, lds, unit, lane, wave);
#else
#pragma unroll 1
        for (int i = 0; i < 8; ++i) peer_gather_token<true>(P, idxl, gatel, al, wave * 8 + i, (size_t)unit * 64 + wave * 8 + i, lane, wave);
#endif
        __syncthreads();
    }
}

struct Args { const float* in[19]; float* out; unsigned char* ws; int ph_lo, ph_hi; };
__global__ void __launch_bounds__(NWAVES * 64, 2) mega_fwd(Args args) {
    extern __shared__ __attribute__((aligned(16))) unsigned char lds_raw[];
    LAS unsigned char* lds = (LAS unsigned char*)lds_raw;
    const int tid = threadIdx.x, lane = tid & 63, wave = __builtin_amdgcn_readfirstlane(tid >> 6);
    const int G = gridDim.x; const int bx = blockIdx.x; const int vcu = (G % 8 == 0) ? (bx % 8) * (G / 8) + bx / 8 : bx;
    unsigned char* ws = args.ws;
    Ptrs P;
    P.x = args.in[0]; P.mix_w = args.in[1]; P.w_in = args.in[2]; P.rel_bias = args.in[3]; P.sinks = args.in[4]; P.w_pa = args.in[5]; P.ln_w = args.in[6]; P.ln_b = args.in[7];
    P.w_s = args.in[8]; P.b_s = args.in[9]; P.w_pb = args.in[10]; P.w_out = args.in[11]; P.ffn_w = args.in[12]; P.w_q = args.in[13]; P.keys1 = args.in[14]; P.keys2 = args.in[15];
    P.pu = args.in[16]; P.pv = args.in[17]; P.fin_w = args.in[18]; P.out = args.out;
    P.WIN = (bf16*)(ws + WS_WIN); P.WPA = (bf16*)(ws + WS_WPA); P.WPB = (bf16*)(ws + WS_WPB); P.WOUT = (bf16*)(ws + WS_WOUT); P.WQ = (bf16*)(ws + WS_WQ);
    P.K1 = (bf16*)(ws + WS_K1); P.K2 = (bf16*)(ws + WS_K2); P.WS = (bf16*)(ws + WS_WS); P.U = (bf16*)(ws + WS_U); P.V = (bf16*)(ws + WS_V);
    P.U8 = ws + WS_U; P.V8 = ws + WS_U + 16 * MiB; P.USC = (float*)(ws + WS_V); P.VSC = (float*)(ws + WS_V + 65536); P.HN8 = ws + WS_HN8; P.HSC = (float*)(ws + WS_HSC); P.rowss = (float*)(ws + WS_HN8); P.rowamax = (unsigned*)(ws + WS_HN8 + 2 * MiB);
    P.XN = (bf16*)(ws + WS_R1); P.AOUT = (bf16*)(ws + WS_R1); P.BOUT = P3_FUSED ? (bf16*)(ws + WS_R1) + 512 : (bf16*)(ws + WS_R1 + 16 * MiB); P.HN2 = (bf16*)(ws + WS_R1);
    P.Q = (bf16*)(ws + WS_Q); P.KV = (bf16*)(ws + WS_KV); P.GU = (bf16*)(ws + WS_GU); P.GV = (bf16*)(ws + WS_GV); P.GA = (bf16*)(ws + WS_GA); P.GB = (bf16*)(ws + WS_GB);
    P.MERGED = (bf16*)(ws + WS_MERGED); P.QP = (bf16*)(ws + WS_QP);

    for (int u = tid; u < (LDS_BYTES - MISC_OFF) / 4; u += NWAVES * 64) ((LAS unsigned*)(lds + MISC_OFF))[u] = 0u;
    __syncthreads();
    const int lo = args.ph_lo, hi = args.ph_hi;
    unsigned* barw = (unsigned*)(ws + WS_CTL) + CW_BAR;
    XcdBarrier bar; bar.bar = barw; bar.x = 0; bar.st = nullptr;
    if (hi - lo > 1) bar = xcd_barrier_post(barw, (volatile LAS unsigned*)(lds + MISC_OFF));
#define IN(k) (lo <= (k) && (k) < hi)
#define BOTH(k) (IN(k) && IN((k) + 1))
#define GRID_BAR() do { xcd_barrier(bar); if (PROBE_BAR2) xcd_barrier(bar); } while (0)
#define REPS(k) ((k) == PROBE_PHASE ? 2 : 1)

    if (IN(0)) {
#pragma unroll
        for (int rep = 0; rep < REPS(0); ++rep) { p0_prologue(lds, P, vcu, G, lane, wave); __syncthreads(); }
        if (BOTH(0)) GRID_BAR(); }

    if (IN(1)) {
        pg8::Gemm g{P.XN, P.WIN, M, NZ, D}; pg8::StaticOrder S; S.init(M, NZ, G, bx);
        pg8::EpiZ E{P.Q, P.KV, P.GU, P.GV, P.GA, P.GB};
#pragma unroll
        for (int rep = 0; rep < REPS(1); ++rep) pg8::gemm_phase<pg8::EpiZ, pg8::StaticOrder, PG8_ALIGN, PG8_SP2>(lds, g, S, E);
        if (BOTH(1)) GRID_BAR();
    }

    if (IN(2)) {
        for (int rep = 0; rep < REPS(2); ++rep) {
#if ATTN_MFMA
        p2_attn_mfma(lds, P, vcu, G, tid, lane, wave);
#else
        p2_attn_naive(lds, P, vcu, G, tid, lane, wave);
#endif
#if GMLP_MFMA
        p2_gmlp_mfma(lds, P, vcu, G, tid, lane, wave);
#else
        p2_gmlp_naive(lds, P, vcu, G, tid, lane, wave);
#endif
        }
        if (BOTH(2)) GRID_BAR();
    }

    if (IN(3)) {
#pragma unroll
      for (int rep = 0; rep < REPS(3); ++rep) {
#if P3_FUSED
        { pg8::Gemm g{P.AOUT, P.WPA, M, D, 1024}; pg8::StaticOrder S; S.init(M, D, G, bx);
          pg8::EpiMerge2 E{P.GA, P.GB, P.MERGED};
          pg8::gemm_phase<pg8::EpiMerge2, pg8::StaticOrder, PG8_ALIGN, PG8_SP2>(lds, g, S, E); }
#else
        { pg8::Gemm g{P.AOUT, P.WPA, M, D, 512}; pg8::StaticOrder S; S.init(M, D, G, bx);
          pg8::EpiGateTmp E{P.GA, P.out};
          pg8::gemm_phase<pg8::EpiGateTmp, pg8::StaticOrder, PG8_ALIGN, PG8_SP2>(lds, g, S, E); }
        { pg8::Gemm g{P.BOUT, P.WPB, M, D, 512}; pg8::StaticOrder S; S.init(M, D, G, bx);
          pg8::EpiMerge E{P.GB, P.out, P.MERGED};
          pg8::gemm_phase<pg8::EpiMerge, pg8::StaticOrder, PG8_ALIGN, PG8_SP2>(lds, g, S, E); }
#endif
      }
        if (BOTH(3)) GRID_BAR();
    }

    if (IN(4)) {
        pg8::Gemm g{P.MERGED, P.WOUT, M, D, D}; pg8::StaticOrder S; S.init(M, D, G, bx);
#if P5_ELIM
        pg8::EpiResStats E{P.x, P.out, P.HN2, P.ffn_w, P.rowss, P.rowamax};
        pg8::gemm_phase<pg8::EpiResStats, pg8::StaticOrder, PG8_ALIGN, PG8_SP2>(lds, g, S, E);
#else
        pg8::EpiRes E{P.x, P.out};
#pragma unroll
        for (int rep = 0; rep < REPS(4); ++rep) pg8::gemm_phase<pg8::EpiRes, pg8::StaticOrder, PG8_ALIGN, PG8_SP2>(lds, g, S, E);
#endif
        if (BOTH(4)) GRID_BAR();
    }

    if (IN(5) && !P5_ELIM) {
        const int gw = vcu * NWAVES + wave, NGW = G * NWAVES;
#pragma unroll
        for (int rep = 0; rep < REPS(5); ++rep)
        for (int m = gw; m < M; m += NGW) rms_row_to_bf16_fp8(P.out + (size_t)m * D, P.ffn_w, P.HN2 + (size_t)m * D, P.HN8 + (size_t)m * D, P.HSC + m, lane);
        if (BOTH(5)) GRID_BAR();
    }

    if (IN(6)) {
        pg8::Gemm g{P.HN2, P.WQ, M, 2048, D}; pg8::StaticOrder S; S.init(M, 2048, G, bx);
#if P5_ELIM
        pg8::EpiPlainRstd E{P.QP, 2048, P.rowss};
#pragma unroll
        for (int rep = 0; rep < REPS(6); ++rep) pg8::gemm_phase<pg8::EpiPlainRstd, pg8::StaticOrder, PG8_ALIGN, PG8_SP2>(lds, g, S, E);
#else
        pg8::EpiPlain E{P.QP, 2048};
#pragma unroll
        for (int rep = 0; rep < REPS(6); ++rep) pg8::gemm_phase<pg8::EpiPlain, pg8::StaticOrder, PG8_ALIGN, PG8_SP2>(lds, g, S, E);
#endif
        if (BOTH(6)) GRID_BAR();
    }

    if (IN(7)) p7_peer(lds, P, vcu, G, tid, lane, wave);
#undef IN
#undef BOTH
#undef GRID_BAR
}

extern "C" void kernel_launch(void* const* d_in, const int* in_sizes, int n_in, void* d_out, int out_size, void* d_ws, size_t ws_size, hipStream_t stream) {
    static int grid = 0;
    if (grid == 0) {
        if (n_in != 19 || out_size != M * D || ws_size < WS_END) { fprintf(stderr, "kernel_launch: unexpected shapes (n_in %d, out %d, ws %zu)\n", n_in, out_size, ws_size); grid = -1; return; }
        int dev = 0, cus = 0, per_cu = 0;
        if (hipGetDevice(&dev) != hipSuccess || hipDeviceGetAttribute(&cus, hipDeviceAttributeMultiprocessorCount, dev) != hipSuccess) { grid = -1; return; }
        if (hipFuncSetAttribute((const void*)mega_fwd, hipFuncAttributeMaxDynamicSharedMemorySize, LDS_BYTES) != hipSuccess) { fprintf(stderr, "kernel_launch: hipFuncSetAttribute failed\n"); grid = -1; return; }
        if (hipOccupancyMaxActiveBlocksPerMultiprocessor(&per_cu, (const void*)mega_fwd, NWAVES * 64, LDS_BYTES) != hipSuccess || per_cu < 1)
            fprintf(stderr, "kernel_launch: note: occupancy query reports %d workgroups per CU\n", per_cu);
        (void)hipGetLastError();
        grid = cus;
    }
    if (grid < 0) return;
    if (hipMemsetAsync((char*)d_ws + WS_CTL, 0, CTL_ZERO_BYTES, stream) != hipSuccess) return;
    Args a{};
    for (int i = 0; i < 19; ++i) a.in[i] = (const float*)d_in[i];
    a.out = (float*)d_out; a.ws = (unsigned char*)d_ws;
#if MK_N_LAUNCHES == 1
    a.ph_lo = 0; a.ph_hi = N_PHASES;
    hipLaunchKernelGGL(mega_fwd, dim3(grid), dim3(NWAVES * 64), LDS_BYTES, stream, a);
#else
    for (int li = 0; li < N_PHASES; ++li) { a.ph_lo = li; a.ph_hi = li + 1; hipLaunchKernelGGL(mega_fwd, dim3(grid), dim3(NWAVES * 64), LDS_BYTES, stream, a); }
#endif
}
```

```cpp
#include <hip/hip_runtime.h>
#include <cstdio>
#include <cstdint>
namespace pg8 {
#define PG8_LAS __attribute__((address_space(3)))
typedef unsigned short bf16_t;
typedef short bf16x8 __attribute__((ext_vector_type(8)));
typedef float f32x4 __attribute__((ext_vector_type(4)));
typedef unsigned u32x4 __attribute__((ext_vector_type(4)));
constexpr int BM = 256, BK = 64, HALF = 128, HTB = HALF * BK * 2  , STAGE_BYTES = 8 * HTB, NXCD = 8, WGM = 8;

__host__ __device__ __forceinline__ int lds_byte(int r, int c) { const int st = (r >> 4) * 2 + (c >> 5), rr = r & 15, cc = c & 31, ob = rr * 64 + cc * 2; return st * 1024 + (ob ^ (((ob >> 9) & 1) << 5)); }
__host__ __device__ __forceinline__ void stage_rc(int b, int& R, int& C) { const int st = b / 1024, sb = b % 1024, swz = sb ^ (((sb >> 9) & 1) << 5); R = (st >> 1) * 16 + swz / 64; C = (st & 1) * 32 + (swz % 64) / 2; }
__host__ __device__ __forceinline__ int perm32(int rho) { const int n = rho >> 4, i = rho & 15; return 8 * (i >> 2) + 4 * n + (i & 3); }

struct Unit { int pm, pn; };
struct Gemm { const bf16_t* A; const bf16_t* Bt; int M, N, K; };

struct StaticOrder {
    int nM, nN, nwg, G, c;
    __host__ __device__ void init(int M, int N, int G_, int c_) { nM = M / BM; nN = N / BM; nwg = nM * nN; G = G_; c = c_; }
    __host__ __device__ bool next(int i, Unit& u) const {
        const long L = (long)i * G + c; if (L >= nwg) return false;
        int wgid = (int)L; { const int q = nwg / NXCD, r = nwg % NXCD, xcd = wgid % NXCD, off = wgid / NXCD; wgid = (xcd < r ? xcd * (q + 1) : r * (q + 1) + (xcd - r) * q) + off; }
        const int nig = WGM * nN, gid = wgid / nig, fm = gid * WGM, gsz = (nM - fm) < WGM ? (nM - fm) : WGM;
        u.pm = fm + ((wgid % nig) % gsz); u.pn = (wgid % nig) / gsz; return true;
    }
    __device__ __forceinline__ void a_ready(const Unit&) const {}
    __device__ __forceinline__ void done(const Unit&) const {}
};

__device__ __forceinline__ unsigned cvt_pk_bf16(float lo, float hi) { unsigned r; asm volatile("v_cvt_pk_bf16_f32 %0, %1, %2" : "=v"(r) : "v"(lo), "v"(hi)); return r; }
typedef float f32x2 __attribute__((ext_vector_type(2)));
template <class Epi, class Sched, bool ALIGN_EPI = false, bool SP2 = false>
__device__ __forceinline__ void gemm_phase(PG8_LAS unsigned char* lds, const Gemm g, const Sched& S, const Epi& E) {
    const int tid = threadIdx.x, wid = __builtin_amdgcn_readfirstlane(tid >> 6), lane = tid & 63, wr = wid >> 2, wc = wid & 3, fr = lane & 15, fq = lane >> 4;
    const int K = g.K, nt = K / BK;
    unsigned voffA[2], voffB[2];
#pragma unroll
    for (int i = 0; i < 2; ++i) { int R, C; stage_rc(tid * 16 + i * 8192, R, C); const int Rb = Epi::PERM ? ((R & ~31) + perm32(R & 31)) : R;
        voffA[i] = (unsigned)(R * K + C) * 2u; voffB[i] = (unsigned)(Rb * K + C) * 2u; }
    const size_t kstep = (size_t)(BK * 2);
    const size_t hstep = (size_t)HALF * K * 2;
    const size_t tstep = 2 * hstep;
    const unsigned ldsw = (unsigned)wid * 1024u;
    const int aoff = lds_byte(wr * 64 + fr, fq * 8), boff = lds_byte(wc * 32 + fr, fq * 8);
#define PG8_SA(b, h) (((b) * 2 + (h)) * HTB)
#define PG8_SB(b, h) ((4 + (b) * 2 + (h)) * HTB)
#define PG8_STAGE(bufoff, gbase, voff) do { _Pragma("unroll") for (int _i = 0; _i < 2; ++_i) \
        __builtin_amdgcn_global_load_lds((const unsigned*)((const char*)(gbase) + (voff)[_i]), (PG8_LAS unsigned*)(lds + (bufoff) + ldsw + _i * 8192), 16, 0, 0); } while (0)
#define PG8_LDA(dst, b, h) do { _Pragma("unroll") for (int m = 0; m < 4; ++m) _Pragma("unroll") for (int k = 0; k < 2; ++k) dst[m][k] = *(const PG8_LAS bf16x8*)(lds + PG8_SA(b, h) + aoff + m * 2048 + k * 1024); } while (0)
#define PG8_LDB(dst, b, h) do { _Pragma("unroll") for (int n = 0; n < 2; ++n) _Pragma("unroll") for (int k = 0; k < 2; ++k) dst[n][k] = *(const PG8_LAS bf16x8*)(lds + PG8_SB(b, h) + boff + n * 2048 + k * 1024); } while (0)
#define PG8_MMA(ai, bj, At, Bt) do { __builtin_amdgcn_s_setprio(1); _Pragma("unroll") for (int m = 0; m < 4; ++m) _Pragma("unroll") for (int n = 0; n < 2; ++n) _Pragma("unroll") for (int k = 0; k < 2; ++k) \
        acc[ai][bj][m][n] = __builtin_amdgcn_mfma_f32_16x16x32_bf16(Bt[n][k], At[m][k], acc[ai][bj][m][n], 0, 0, 0); __builtin_amdgcn_s_setprio(0); } while (0)
#define PG8_WAIT_V(n) asm volatile("s_waitcnt vmcnt(" #n ")" ::: "memory")
#define PG8_WAIT_L(n) asm volatile("s_waitcnt lgkmcnt(" #n ")" ::: "memory")
#define PG8_BAR __builtin_amdgcn_s_barrier()
#define PG8_SCHED __builtin_amdgcn_sched_barrier(0)
    Unit cur, nxt; int ui = 0;
    if (!S.next(0, cur)) return;
    f32x4 acc[2][2][4][2];
#pragma unroll
    for (int a = 0; a < 2; ++a)
#pragma unroll
        for (int b = 0; b < 2; ++b)
#pragma unroll
            for (int m = 0; m < 4; ++m)
#pragma unroll
                for (int n = 0; n < 2; ++n) acc[a][b][m][n] = (f32x4){0.f, 0.f, 0.f, 0.f};
    bf16x8 At[4][2], B0[2][2], B1[2][2];
    const char* cA = (const char*)g.A + (size_t)cur.pm * tstep; const char* cB = (const char*)g.Bt + (size_t)cur.pn * tstep;
    S.a_ready(cur);
    if constexpr (SP2) {
        PG8_STAGE(PG8_SB(0, 0), cB, voffB); PG8_STAGE(PG8_SB(0, 1), cB + hstep, voffB); PG8_STAGE(PG8_SA(0, 0), cA, voffA); PG8_STAGE(PG8_SA(0, 1), cA + hstep, voffA);
        if (wr == 1) PG8_BAR;
        PG8_WAIT_V(2); PG8_BAR;
        PG8_STAGE(PG8_SB(1, 0), cB + kstep, voffB); PG8_STAGE(PG8_SA(1, 0), cA + kstep, voffA); PG8_STAGE(PG8_SB(1, 1), cB + hstep + kstep, voffB);
        PG8_WAIT_V(6); PG8_BAR;
    } else {
        PG8_STAGE(PG8_SB(0, 0), cB, voffB); PG8_STAGE(PG8_SA(0, 0), cA, voffA); PG8_STAGE(PG8_SB(0, 1), cB + hstep, voffB); PG8_STAGE(PG8_SA(0, 1), cA + hstep, voffA);
        if (wr == 1) PG8_BAR;
        PG8_WAIT_V(4); PG8_BAR;
        PG8_STAGE(PG8_SB(1, 0), cB + kstep, voffB); PG8_STAGE(PG8_SA(1, 0), cA + kstep, voffA); PG8_STAGE(PG8_SB(1, 1), cB + hstep + kstep, voffB);
        PG8_WAIT_V(6); PG8_BAR;
    }
    for (;;) {
        const bool has_next = S.next(ui + 1, nxt);
        const char* nA = has_next ? (const char*)g.A + (size_t)nxt.pm * tstep : cA; const char* nB = has_next ? (const char*)g.Bt + (size_t)nxt.pn * tstep : cB;
        for (int t = 0; t < nt; t += 2) {
            if constexpr (Epi::HAS_MID) { if (t == (nt >> 1)) E.mid(acc, cur, wr, wc, fr, fq); }
            const bool last = (t == nt - 2);
            const char* a1 = cA + (size_t)(t + 1) * kstep;
            const char* a2 = last ? nA : cA + (size_t)(t + 2) * kstep; const char* b2 = last ? nB : cB + (size_t)(t + 2) * kstep;
            const char* a3 = a2 + kstep; const char* b3 = b2 + kstep;
            if (last && has_next) S.a_ready(nxt);
            if constexpr (SP2) {
            PG8_LDB(B0, 0, 0); PG8_LDB(B1, 0, 1); PG8_SCHED; PG8_LDA(At, 0, 0); PG8_STAGE(PG8_SA(1, 1), a1 + hstep, voffA);
            PG8_WAIT_V(8); PG8_WAIT_L(0); PG8_BAR; PG8_MMA(0, 0, At, B0); PG8_MMA(0, 1, At, B1); PG8_BAR; PG8_SCHED;
            PG8_LDA(At, 0, 1); PG8_STAGE(PG8_SB(0, 0), b2, voffB); PG8_STAGE(PG8_SB(0, 1), b2 + hstep, voffB); PG8_STAGE(PG8_SA(0, 0), a2, voffA);
            PG8_WAIT_V(8); PG8_WAIT_L(0); PG8_BAR; PG8_MMA(1, 0, At, B0); PG8_MMA(1, 1, At, B1); PG8_BAR; PG8_SCHED;
            PG8_LDB(B0, 1, 0); PG8_LDB(B1, 1, 1); PG8_SCHED; PG8_LDA(At, 1, 0); PG8_STAGE(PG8_SA(0, 1), a2 + hstep, voffA);
            PG8_WAIT_V(8); PG8_WAIT_L(0); PG8_BAR; PG8_MMA(0, 0, At, B0); PG8_MMA(0, 1, At, B1); PG8_BAR; PG8_SCHED;
            PG8_LDA(At, 1, 1); PG8_STAGE(PG8_SB(1, 0), b3, voffB); PG8_STAGE(PG8_SB(1, 1), b3 + hstep, voffB); PG8_STAGE(PG8_SA(1, 0), a3, voffA);
            PG8_WAIT_V(8); PG8_WAIT_L(0); PG8_BAR; PG8_MMA(1, 0, At, B0); PG8_MMA(1, 1, At, B1); PG8_BAR; PG8_SCHED;
            } else {
            PG8_LDB(B0, 0, 0); PG8_SCHED; PG8_LDA(At, 0, 0); PG8_STAGE(PG8_SA(1, 1), a1 + hstep, voffA);
            PG8_WAIT_L(8); PG8_BAR; PG8_WAIT_L(0); PG8_MMA(0, 0, At, B0); PG8_BAR; PG8_SCHED;
            PG8_LDB(B1, 0, 1); PG8_STAGE(PG8_SB(0, 0), b2, voffB);
            PG8_BAR; PG8_WAIT_L(0); PG8_MMA(0, 1, At, B1); PG8_BAR;
            PG8_LDA(At, 0, 1); PG8_STAGE(PG8_SA(0, 0), a2, voffA);
            PG8_BAR; PG8_WAIT_L(0); PG8_MMA(1, 0, At, B0); PG8_BAR; PG8_SCHED;
            PG8_STAGE(PG8_SB(0, 1), b2 + hstep, voffB);
            PG8_WAIT_V(6); PG8_BAR; PG8_MMA(1, 1, At, B1); PG8_BAR;
            PG8_LDB(B0, 1, 0); PG8_SCHED; PG8_LDA(At, 1, 0); PG8_STAGE(PG8_SA(0, 1), a2 + hstep, voffA);
            PG8_WAIT_L(8); PG8_BAR; PG8_WAIT_L(0); PG8_MMA(0, 0, At, B0); PG8_BAR; PG8_SCHED;
            PG8_LDB(B1, 1, 1); PG8_STAGE(PG8_SB(1, 0), b3, voffB);
            PG8_BAR; PG8_WAIT_L(0); PG8_MMA(0, 1, At, B1); PG8_BAR;
            PG8_LDA(At, 1, 1); PG8_STAGE(PG8_SA(1, 0), a3, voffA);
            PG8_BAR; PG8_WAIT_L(0); PG8_MMA(1, 0, At, B0); PG8_BAR; PG8_SCHED;
            PG8_STAGE(PG8_SB(1, 1), b3 + hstep, voffB);
            PG8_WAIT_V(6); PG8_BAR; PG8_MMA(1, 1, At, B1); PG8_BAR;
            }
        }
        if constexpr (ALIGN_EPI) { if (wr == 0) PG8_BAR; }
        if constexpr (!Epi::AFTER_DRAIN) { E(acc, cur, wr, wc, fr, fq); S.done(cur); }
        if (!has_next) break;
#pragma unroll
        for (int a = 0; a < 2; ++a)
#pragma unroll
            for (int b = 0; b < 2; ++b)
#pragma unroll
                for (int m = 0; m < 4; ++m)
#pragma unroll
                    for (int n = 0; n < 2; ++n) acc[a][b][m][n] = (f32x4){0.f, 0.f, 0.f, 0.f};
        cur = nxt; cA = nA; cB = nB; ++ui;
        if constexpr (ALIGN_EPI) { if (wr == 1) PG8_BAR; }
    }
    PG8_WAIT_V(0);
    if constexpr (!ALIGN_EPI) { if (wr == 0) PG8_BAR; }
    PG8_BAR;
    if constexpr (Epi::AFTER_DRAIN) { E.fused(acc, cur, wr, wc, fr, fq, lds, wid, lane); S.done(cur); }
#undef PG8_SA
#undef PG8_SB
#undef PG8_STAGE
#undef PG8_LDA
#undef PG8_LDB
#undef PG8_MMA
#undef PG8_WAIT_V
#undef PG8_WAIT_L
#undef PG8_BAR
#undef PG8_SCHED
}
}
#ifndef PG8_SP2
#define PG8_SP2 true
#endif
#ifndef PG8_ALIGN
#define PG8_ALIGN true
#endif

constexpr int NWAVES = 8;
#ifndef MK_N_LAUNCHES
#define MK_N_LAUNCHES 1
#endif
constexpr int N_PHASES = 8;
#ifndef ATTN_MFMA
#define ATTN_MFMA 1
#endif
#ifndef GMLP_MFMA
#define GMLP_MFMA 1
#endif
#ifndef TOPK_DBG_GATES_ONLY
#define TOPK_DBG_GATES_ONLY 0
#endif
#ifndef DBG_SHFL_WAVESUM
#define DBG_SHFL_WAVESUM 0
#endif
#ifndef TOPK_DBG_COMPARE
#define TOPK_DBG_COMPARE 0
#endif
#ifndef TOPK_DBG_SEL
#define TOPK_DBG_SEL 0
#endif
#ifndef TOPK_DBG_K0
#define TOPK_DBG_K0 0
#endif
#ifndef TOPK_DBG_K1
#define TOPK_DBG_K1 16
#endif
#ifndef TOPK_DBG_BRUTE
#define TOPK_DBG_BRUTE 0
#endif
#ifndef TOPK_DBG_INSERT
#define TOPK_DBG_INSERT 0
#endif
#ifndef TOPK_DBG_VALU_SCORES
#define TOPK_DBG_VALU_SCORES 0
#endif
#ifndef KEY_SWZ
#define KEY_SWZ (!TOPK_DBG_GATES_ONLY && !TOPK_DBG_VALU_SCORES && !TOPK_DBG_COMPARE && !TOPK_DBG_BRUTE && TOPK_DBG_INSERT != 3)
#endif
#ifndef TOPK_MFMA
#define TOPK_MFMA 1
#endif
#ifndef SWEEP_SYNC
#define SWEEP_SYNC 0
#endif
#ifndef NSL
#define NSL 8
#endif
#define SLSH (NSL == 64 ? 8 : NSL == 32 ? 9 : NSL == 16 ? 10 : 11)
#ifndef PROBE_ROWAND
#define PROBE_ROWAND 16383u
#endif
#ifndef PROBE_V_PASSES
#define PROBE_V_PASSES 1
#endif
#ifndef PROBE_U_PASSES
#define PROBE_U_PASSES 1
#endif
#ifndef GATHER_STAGGER
#define GATHER_STAGGER 0
#endif
#ifndef WT_STORES
#define WT_STORES 0
#endif
#ifndef P5_ELIM
#define P5_ELIM 0
#endif
#ifndef P3_FUSED
#define P3_FUSED 0
#endif
#ifndef U_INT8
#define U_INT8 1
#endif
#ifndef U_DOT2
#define U_DOT2 1
#endif
#ifndef U_MFMA
#define U_MFMA 0
#endif
#ifndef GATHER_SORTED
#define GATHER_SORTED 2
#endif
#ifndef PEER_FP8
#define PEER_FP8 1
#endif
#ifndef PROBE_GATHER_REPS
#define PROBE_GATHER_REPS 1
#endif
#ifndef PROBE_TOPK_REPS
#define PROBE_TOPK_REPS 1
#endif
#ifndef PROBE_BAR2
#define PROBE_BAR2 0
#endif
#ifndef PROBE_PHASE
#define PROBE_PHASE -1
#endif
#ifndef PROBE_P2_REPS
#define PROBE_P2_REPS 1
#endif

constexpr int NB = 2, SEQ = 8192, D = 1024, M = NB * SEQ;
constexpr int NZ = 3840;
constexpr float EPS = 1e-6f;
constexpr int AB_LD = P3_FUSED ? 1024 : 512;

constexpr size_t MiB = 1u << 20;
constexpr size_t WS_CTL = 0, CTL_ZERO_BYTES = 65536;
constexpr size_t WS_WIN = 1 * MiB;
constexpr size_t WS_WPA = 9 * MiB;
constexpr size_t WS_WPB = 10 * MiB;
constexpr size_t WS_WOUT = 11 * MiB;
constexpr size_t WS_WQ = 13 * MiB;
constexpr size_t WS_K1 = 17 * MiB;
constexpr size_t WS_K2 = 17 * MiB + 32768;
constexpr size_t WS_WS = 17 * MiB + 65536;
constexpr size_t WS_U = 18 * MiB;
constexpr size_t WS_V = 50 * MiB;
constexpr size_t WS_R1 = 82 * MiB;
constexpr size_t WS_Q = 114 * MiB;
constexpr size_t WS_KV = 130 * MiB;
constexpr size_t WS_GU = 138 * MiB;
constexpr size_t WS_GV = 154 * MiB;
constexpr size_t WS_GA = 170 * MiB;
constexpr size_t WS_GB = 202 * MiB;
constexpr size_t WS_MERGED = 114 * MiB;
constexpr size_t WS_QP = 170 * MiB;
constexpr size_t WS_HN8 = 146 * MiB;
constexpr size_t WS_HSC = 162 * MiB;
constexpr size_t WS_END = 234 * MiB;
constexpr int CW_BAR = 0;

constexpr int RING_BYTES = 131072;
constexpr int MISC_OFF = 143360;
constexpr int LDS_BYTES = 147456;

#define GAS __attribute__((address_space(1)))
#define LAS __attribute__((address_space(3)))
typedef unsigned short bf16;
typedef unsigned v4u __attribute__((ext_vector_type(4)));
typedef unsigned v2u __attribute__((ext_vector_type(2)));
typedef float f32x4 __attribute__((ext_vector_type(4)));
typedef GAS unsigned gu32;
typedef __bf16 bf16x2_t __attribute__((ext_vector_type(2)));
#define RLX_AGENT __ATOMIC_RELAXED, __HIP_MEMORY_SCOPE_AGENT
#define LDS_WAIT() asm volatile("s_waitcnt lgkmcnt(0)" ::: "memory")
#define VM_WAIT() asm volatile("s_waitcnt vmcnt(0)" ::: "memory")
__device__ __forceinline__ unsigned f2bf(float f) { unsigned u = __builtin_bit_cast(unsigned, f); return (u + 0x7fffu + ((u >> 16) & 1u)) >> 16; }
__device__ __forceinline__ unsigned pk2(float lo, float hi) { return f2bf(lo) | (f2bf(hi) << 16); }
__device__ __forceinline__ float bflo(unsigned w) { return __builtin_bit_cast(float, w << 16); }
__device__ __forceinline__ float bfhi(unsigned w) { return __builtin_bit_cast(float, w & 0xffff0000u); }
__device__ __forceinline__ float bf2f(bf16 h) { return __builtin_bit_cast(float, (unsigned)h << 16); }
__device__ __forceinline__ float dot2bf(unsigned a, unsigned b, float c) { return __builtin_amdgcn_fdot2_f32_bf16(__builtin_bit_cast(bf16x2_t, a), __builtin_bit_cast(bf16x2_t, b), c, false); }
__device__ __forceinline__ float gelu_tanh(float v) {
    const float t2 = v * (-2.302208198f + (-0.1029432397f) * v * v);
    return v * __builtin_amdgcn_rcpf(1.0f + __builtin_amdgcn_exp2f(t2));
}
__device__ __forceinline__ float sigmoid_f(float v) { return __builtin_amdgcn_rcpf(1.0f + __builtin_amdgcn_exp2f(-1.4426950409f * v)); }
template <int CTRL> __device__ __forceinline__ float dppmov(float v) { return __builtin_bit_cast(float, __builtin_amdgcn_update_dpp(0, __builtin_bit_cast(int, v), CTRL, 0xF, 0xF, false)); }
__device__ __forceinline__ float row16_sum(float v) {
    v += dppmov<0xB1>(v);
    v += dppmov<0x4E>(v);
    v += dppmov<0x141>(v);
    v += dppmov<0x140>(v);
    return v;
}
__device__ __forceinline__ float xor32_f(float v) {
    const unsigned u = __builtin_bit_cast(unsigned, v);
    auto rr = __builtin_amdgcn_permlane32_swap(u, u, false, false);
    const unsigned r0 = rr[0], r1 = rr[1];
    return __builtin_bit_cast(float, (__lane_id() & 32) ? r0 : r1);
}
__device__ __forceinline__ float wave_sum(float v) {
#if DBG_SHFL_WAVESUM
#pragma unroll
    for (int o = 1; o < 64; o <<= 1) v += __shfl_xor(v, o);
    return v;
#endif
    v = row16_sum(v);
    v += __builtin_bit_cast(float, __builtin_amdgcn_ds_swizzle(__builtin_bit_cast(int, v), 0x401F));
    const unsigned u = __builtin_bit_cast(unsigned, v);
    auto rr = __builtin_amdgcn_permlane32_swap(u, u, false, false);
    const unsigned r0 = rr[0], r1 = rr[1];
    return __builtin_bit_cast(float, r0) + __builtin_bit_cast(float, r1);
}
__device__ const unsigned char T5B[128] = {0, 1, 2, 3, 4, 5, 6, 7, 8, 9, 10, 11, 12, 13, 14, 15, 16, 16, 16, 17, 17, 18, 18, 18, 19, 19, 19, 20, 20, 20, 20, 21, 21, 21, 21, 22, 22, 22, 22, 22, 23, 23, 23, 23, 23, 23, 24, 24, 24, 24, 24, 24, 25, 25, 25, 25, 25, 25, 25, 26, 26, 26, 26, 26, 26, 26, 26, 27, 27, 27, 27, 27, 27, 27, 27, 27, 27, 28, 28, 28, 28, 28, 28, 28, 28, 28, 28, 29, 29, 29, 29, 29, 29, 29, 29, 29, 29, 29, 29, 30, 30, 30, 30, 30, 30, 30, 30, 30, 30, 30, 30, 30, 30, 31, 31, 31, 31, 31, 31, 31, 31, 31, 31, 31, 31, 31, 31, 31};
#define XB_TMO      128
#define XB_XCNT(j)  (256  + 64 * (j))
#define XB_XSUB(j)  (1280 + 64 * (j))
#define XB_XGEN(j)  (2304 + 64 * (j))
#define XB_TOP      3328
#define XB_TOPGEN   3392
#define XCD_BAR_WORDS 3456
#define XB_SPIN_CAP (1u << 18)

__device__ __forceinline__ unsigned xb_ld(unsigned* p)              { return __hip_atomic_load(p, __ATOMIC_RELAXED, __HIP_MEMORY_SCOPE_AGENT); }
__device__ __forceinline__ unsigned xb_add(unsigned* p, unsigned v) { return __hip_atomic_fetch_add(p, v, __ATOMIC_RELAXED, __HIP_MEMORY_SCOPE_AGENT); }
__device__ __forceinline__ unsigned xb_xcc_id() { return (unsigned)__builtin_amdgcn_s_getreg((3 << 11) | 20) & 0xFu; }
#define XB_SPIN(cond, bar) do { unsigned _sp = 0; while (cond) { __builtin_amdgcn_s_sleep(1); \
    if ((++_sp & 255u) == 0u) { if (xb_ld(&(bar)[XB_TMO])) break; if (_sp > XB_SPIN_CAP) { atomicAdd(&(bar)[XB_TMO], 1u); break; } } } } while (0)

struct XcdBarrier {
    unsigned* bar; unsigned x;
    volatile LAS unsigned* st;
};

__device__ __forceinline__ XcdBarrier xcd_barrier_post(unsigned* bar, volatile LAS unsigned* st) {
    XcdBarrier b; b.bar = bar; b.x = xb_xcc_id(); b.st = st;
    if (threadIdx.x == 0) (void)xb_add(&bar[XB_XCNT(b.x)], 1u);
    return b;
}
__device__ __forceinline__ void xcd_barrier_complete(unsigned* bar, unsigned x, unsigned& nloc, unsigned& nx) {
    const unsigned G = gridDim.x * gridDim.y * gridDim.z;
    unsigned sum, cnt, mine, sp = 0u;
    for (;;) {
        sum = 0u; cnt = 0u; mine = 0u;
#pragma unroll
        for (unsigned j = 0; j < 16; ++j) { const unsigned c = xb_ld(&bar[XB_XCNT(j)]); sum += c; cnt += (c > 0u) ? 1u : 0u; mine = (j == x) ? c : mine; }
        if (sum == G) break;
        __builtin_amdgcn_s_sleep(1);
        if ((++sp & 255u) == 0u) { if (xb_ld(&bar[XB_TMO])) break; if (sp > XB_SPIN_CAP) { atomicAdd(&bar[XB_TMO], 1u); break; } }
    }
    nloc = mine > 0u ? mine : 1u; nx = cnt > 0u ? cnt : 1u;
}

__device__ __forceinline__ void xcd_barrier(const XcdBarrier& b) {
    asm volatile("s_waitcnt vmcnt(0)" ::: "memory");
    __syncthreads();
    if (threadIdx.x == 0) {
        unsigned* bar = b.bar;
        __builtin_amdgcn_s_waitcnt(0);
        unsigned nloc = b.st[0], nx = b.st[1];
        if (nloc == 0u) { xcd_barrier_complete(bar, b.x, nloc, nx); b.st[0] = nloc; b.st[1] = nx; }
        const unsigned old = xb_add(&bar[XB_XSUB(b.x)], 1u);
        const unsigned gen = old / nloc;
        if (old + 1u == (gen + 1u) * nloc) {
            __builtin_amdgcn_fence(__ATOMIC_RELEASE, "agent");
            asm volatile("s_waitcnt vmcnt(0)" ::: "memory");
            const unsigned og = xb_add(&bar[XB_TOP], 1u);
            const unsigned tg = og / nx;
            if (og + 1u == (tg + 1u) * nx) xb_add(&bar[XB_TOPGEN], 1u);
            else XB_SPIN(xb_ld(&bar[XB_TOPGEN]) == tg, bar);
            __builtin_amdgcn_fence(__ATOMIC_ACQUIRE, "agent");
            xb_add(&bar[XB_XGEN(b.x)], 1u);
            asm volatile("s_waitcnt vmcnt(0)" ::: "memory");
        } else {
            XB_SPIN(xb_ld(&bar[XB_XGEN(b.x)]) == gen, bar);
            __builtin_amdgcn_fence(__ATOMIC_ACQUIRE, "agent");
            asm volatile("s_waitcnt vmcnt(0)" ::: "memory");
        }
    }
    __syncthreads();
}
#if WT_STORES
#define ST16(PTR, VAL) asm volatile("global_store_dwordx4 %0, %1, off sc1\n\ts_nop 1" :: "v"(PTR), "v"(VAL) : "memory")
#else
#define ST16(PTR, VAL) (*(PTR) = (VAL))
#endif
namespace pg8 {
struct EpiZ {
    static constexpr bool PERM = true, AFTER_DRAIN = false, HAS_MID = false;
    bf16_t *Q, *KV, *GU, *GV, *GA, *GB;
    __device__ __forceinline__ void operator()(const f32x4 (&acc)[2][2][4][2], const Unit& u, int wr, int wc, int fr, int fq) const {
        const int pn = u.pn; bf16_t* base; int ldc, colt, act;
        if (pn < 2)       { base = Q;  ldc = 512;  colt = pn * 256;        act = 0; }
        else if (pn == 2) { base = KV; ldc = 256;  colt = 0;               act = 0; }
        else if (pn < 5)  { base = GU; ldc = 512;  colt = (pn - 3) * 256;  act = 1; }
        else if (pn < 7)  { base = GV; ldc = 512;  colt = (pn - 5) * 256;  act = 1; }
        else if (pn < 11) { base = GA; ldc = 1024; colt = (pn - 7) * 256;  act = 2; }
        else              { base = GB; ldc = 1024; colt = (pn - 11) * 256; act = 2; }
        const int row0 = u.pm * BM + wr * 64 + fr, col0 = colt + wc * 32 + 8 * fq;
#pragma unroll
        for (int ai = 0; ai < 2; ++ai)
#pragma unroll
            for (int m = 0; m < 4; ++m) { bf16_t* rowp = base + (size_t)(row0 + ai * HALF + m * 16) * ldc + col0;
#pragma unroll
                for (int bj = 0; bj < 2; ++bj) { f32x4 v0 = acc[ai][bj][m][0], v1 = acc[ai][bj][m][1];
                    if (act == 1) {
#pragma unroll
                        for (int e = 0; e < 4; ++e) { v0[e] = gelu_tanh(v0[e]); v1[e] = gelu_tanh(v1[e]); }
                    } else if (act == 2) {
#pragma unroll
                        for (int e = 0; e < 4; ++e) { v0[e] = sigmoid_f(v0[e]); v1[e] = sigmoid_f(v1[e]); }
                    }
                    u32x4 w; w.x = cvt_pk_bf16(v0[0], v0[1]); w.y = cvt_pk_bf16(v0[2], v0[3]); w.z = cvt_pk_bf16(v1[0], v1[1]); w.w = cvt_pk_bf16(v1[2], v1[3]);
                    ST16((u32x4*)(rowp + bj * HALF), w); } }
    }
};
struct EpiGateTmp {
    static constexpr bool PERM = true, AFTER_DRAIN = false, HAS_MID = false;
    const bf16_t* gate; float* tmp;
    __device__ __forceinline__ void operator()(const f32x4 (&acc)[2][2][4][2], const Unit& u, int wr, int wc, int fr, int fq) const {
        const int row0 = u.pm * BM + wr * 64 + fr, col0 = u.pn * BM + wc * 32 + 8 * fq;
#pragma unroll
        for (int ai = 0; ai < 2; ++ai)
#pragma unroll
            for (int m = 0; m < 4; ++m) { const size_t ro = (size_t)(row0 + ai * HALF + m * 16) * 1024 + col0;
#pragma unroll
                for (int bj = 0; bj < 2; ++bj) { const u32x4 g = *(const u32x4*)(gate + ro + bj * HALF); f32x4 v0 = acc[ai][bj][m][0], v1 = acc[ai][bj][m][1];
                    v0[0] *= bflo(g.x); v0[1] *= bfhi(g.x); v0[2] *= bflo(g.y); v0[3] *= bfhi(g.y); v1[0] *= bflo(g.z); v1[1] *= bfhi(g.z); v1[2] *= bflo(g.w); v1[3] *= bfhi(g.w);
                    ST16((f32x4*)(tmp + ro + bj * HALF), v0); ST16((f32x4*)(tmp + ro + bj * HALF + 4), v1); } }
    }
};
struct EpiMerge {
    static constexpr bool PERM = true, AFTER_DRAIN = false, HAS_MID = false;
    const bf16_t* gate; const float* tmp; bf16_t* out;
    __device__ __forceinline__ void operator()(const f32x4 (&acc)[2][2][4][2], const Unit& u, int wr, int wc, int fr, int fq) const {
        const int row0 = u.pm * BM + wr * 64 + fr, col0 = u.pn * BM + wc * 32 + 8 * fq;
#pragma unroll
        for (int ai = 0; ai < 2; ++ai)
#pragma unroll
            for (int m = 0; m < 4; ++m) { const size_t ro = (size_t)(row0 + ai * HALF + m * 16) * 1024 + col0;
#pragma unroll
                for (int bj = 0; bj < 2; ++bj) { const u32x4 g = *(const u32x4*)(gate + ro + bj * HALF); f32x4 v0 = acc[ai][bj][m][0], v1 = acc[ai][bj][m][1];
                    const f32x4 t0 = *(const f32x4*)(tmp + ro + bj * HALF), t1 = *(const f32x4*)(tmp + ro + bj * HALF + 4);
                    v0[0] = t0[0] + v0[0] * bflo(g.x); v0[1] = t0[1] + v0[1] * bfhi(g.x); v0[2] = t0[2] + v0[2] * bflo(g.y); v0[3] = t0[3] + v0[3] * bfhi(g.y);
                    v1[0] = t1[0] + v1[0] * bflo(g.z); v1[1] = t1[1] + v1[1] * bfhi(g.z); v1[2] = t1[2] + v1[2] * bflo(g.w); v1[3] = t1[3] + v1[3] * bfhi(g.w);
                    u32x4 w; w.x = cvt_pk_bf16(v0[0], v0[1]); w.y = cvt_pk_bf16(v0[2], v0[3]); w.z = cvt_pk_bf16(v1[0], v1[1]); w.w = cvt_pk_bf16(v1[2], v1[3]);
                    ST16((u32x4*)(out + ro + bj * HALF), w); } }
    }
};
struct EpiMerge2 {
    static constexpr bool PERM = true, AFTER_DRAIN = false, HAS_MID = true;
    const bf16_t* ga; const bf16_t* gb; bf16_t* out;
    __device__ __forceinline__ void mid(f32x4 (&acc)[2][2][4][2], const Unit& u, int wr, int wc, int fr, int fq) const {
        const int row0 = u.pm * BM + wr * 64 + fr, col0 = u.pn * BM + wc * 32 + 8 * fq;
#pragma unroll
        for (int ai = 0; ai < 2; ++ai)
#pragma unroll
            for (int m = 0; m < 4; ++m) { const size_t ro = (size_t)(row0 + ai * HALF + m * 16) * 1024 + col0;
#pragma unroll
                for (int bj = 0; bj < 2; ++bj) { const u32x4 a = *(const u32x4*)(ga + ro + bj * HALF), b = *(const u32x4*)(gb + ro + bj * HALF);
                    f32x4 r0, r1;
                    r0[0] = bflo(a.x) * __builtin_amdgcn_rcpf(fmaxf(bflo(b.x), 1e-20f)); r0[1] = bfhi(a.x) * __builtin_amdgcn_rcpf(fmaxf(bfhi(b.x), 1e-20f)); r0[2] = bflo(a.y) * __builtin_amdgcn_rcpf(fmaxf(bflo(b.y), 1e-20f)); r0[3] = bfhi(a.y) * __builtin_amdgcn_rcpf(fmaxf(bfhi(b.y), 1e-20f));
                    r1[0] = bflo(a.z) * __builtin_amdgcn_rcpf(fmaxf(bflo(b.z), 1e-20f)); r1[1] = bfhi(a.z) * __builtin_amdgcn_rcpf(fmaxf(bfhi(b.z), 1e-20f)); r1[2] = bflo(a.w) * __builtin_amdgcn_rcpf(fmaxf(bflo(b.w), 1e-20f)); r1[3] = bfhi(a.w) * __builtin_amdgcn_rcpf(fmaxf(bfhi(b.w), 1e-20f));
                    acc[ai][bj][m][0] = acc[ai][bj][m][0] * r0; acc[ai][bj][m][1] = acc[ai][bj][m][1] * r1; } }
    }
    __device__ __forceinline__ void operator()(const f32x4 (&acc)[2][2][4][2], const Unit& u, int wr, int wc, int fr, int fq) const {
        const int row0 = u.pm * BM + wr * 64 + fr, col0 = u.pn * BM + wc * 32 + 8 * fq;
#pragma unroll
        for (int ai = 0; ai < 2; ++ai)
#pragma unroll
            for (int m = 0; m < 4; ++m) { const size_t ro = (size_t)(row0 + ai * HALF + m * 16) * 1024 + col0;
#pragma unroll
                for (int bj = 0; bj < 2; ++bj) { const u32x4 b = *(const u32x4*)(gb + ro + bj * HALF); f32x4 v0 = acc[ai][bj][m][0], v1 = acc[ai][bj][m][1];
                    v0[0] *= fmaxf(bflo(b.x), 1e-20f); v0[1] *= fmaxf(bfhi(b.x), 1e-20f); v0[2] *= fmaxf(bflo(b.y), 1e-20f); v0[3] *= fmaxf(bfhi(b.y), 1e-20f);
                    v1[0] *= fmaxf(bflo(b.z), 1e-20f); v1[1] *= fmaxf(bfhi(b.z), 1e-20f); v1[2] *= fmaxf(bflo(b.w), 1e-20f); v1[3] *= fmaxf(bfhi(b.w), 1e-20f);
                    u32x4 w; w.x = cvt_pk_bf16(v0[0], v0[1]); w.y = cvt_pk_bf16(v0[2], v0[3]); w.z = cvt_pk_bf16(v1[0], v1[1]); w.w = cvt_pk_bf16(v1[2], v1[3]);
                    ST16((u32x4*)(out + ro + bj * HALF), w); } }
    }
};
struct EpiRes {
    static constexpr bool PERM = false, AFTER_DRAIN = false, HAS_MID = false;
    const float* base; float* C;
    __device__ __forceinline__ void operator()(const f32x4 (&acc)[2][2][4][2], const Unit& u, int wr, int wc, int fr, int fq) const {
        const int row0 = u.pm * BM + wr * 64 + fr, col0 = u.pn * BM + wc * 32 + 4 * fq;
#pragma unroll
        for (int ai = 0; ai < 2; ++ai)
#pragma unroll
            for (int m = 0; m < 4; ++m) { const size_t ro = (size_t)(row0 + ai * HALF + m * 16) * 1024 + col0;
#pragma unroll
                for (int bj = 0; bj < 2; ++bj)
#pragma unroll
                    for (int n = 0; n < 2; ++n) { const f32x4 v_ = *(const f32x4*)(base + ro + bj * HALF + n * 16) + acc[ai][bj][m][n]; ST16((f32x4*)(C + ro + bj * HALF + n * 16), v_); } }
    }
};
struct EpiResStats {
    static constexpr bool PERM = false, AFTER_DRAIN = false, HAS_MID = false;
    const float* base; float* C; bf16_t* Cb; const float* w; float* rowss; unsigned* rowamax;
    __device__ __forceinline__ void operator()(const f32x4 (&acc)[2][2][4][2], const Unit& u, int wr, int wc, int fr, int fq) const {
        const int row0 = u.pm * BM + wr * 64 + fr, col0 = u.pn * BM + wc * 32 + 4 * fq;
        f32x4 wv[2][2];
#pragma unroll
        for (int bj = 0; bj < 2; ++bj)
#pragma unroll
            for (int n = 0; n < 2; ++n) wv[bj][n] = *(const f32x4*)(w + col0 + bj * HALF + n * 16);
#pragma unroll
        for (int ai = 0; ai < 2; ++ai)
#pragma unroll
            for (int m = 0; m < 4; ++m) { const int row = row0 + ai * HALF + m * 16; const size_t ro = (size_t)row * 1024 + col0; float ss = 0.f, am = 0.f;
#pragma unroll
                for (int bj = 0; bj < 2; ++bj)
#pragma unroll
                    for (int n = 0; n < 2; ++n) { const f32x4 v = *(const f32x4*)(base + ro + bj * HALF + n * 16) + acc[ai][bj][m][n];
                        *(f32x4*)(C + ro + bj * HALF + n * 16) = v;
                        typedef unsigned u32x2 __attribute__((ext_vector_type(2))); u32x2 pb; pb.x = cvt_pk_bf16(v[0], v[1]); pb.y = cvt_pk_bf16(v[2], v[3]); *(u32x2*)(Cb + ro + bj * HALF + n * 16) = pb;
                        ss += (v[0] * v[0] + v[1] * v[1]) + (v[2] * v[2] + v[3] * v[3]);
                        const f32x4 t = v * wv[bj][n]; am = fmaxf(am, fmaxf(fmaxf(fabsf(t[0]), fabsf(t[1])), fmaxf(fabsf(t[2]), fabsf(t[3])))); }
                ss += __shfl_xor(ss, 16); ss += __shfl_xor(ss, 32); am = fmaxf(am, __shfl_xor(am, 16)); am = fmaxf(am, __shfl_xor(am, 32));
                if (fq == 0) { rowss[(size_t)row * 16 + u.pn * 4 + wc] = ss; rowamax[(size_t)row * 16 + u.pn * 4 + wc] = __builtin_bit_cast(unsigned, am); } }
    }
};
struct EpiPlainRstd {
    static constexpr bool PERM = true, AFTER_DRAIN = false, HAS_MID = false;
    bf16_t* O; int ldc; const float* rowss;
    __device__ __forceinline__ void operator()(const f32x4 (&acc)[2][2][4][2], const Unit& u, int wr, int wc, int fr, int fq) const {
        const int row0 = u.pm * BM + wr * 64 + fr, col0 = u.pn * BM + wc * 32 + 8 * fq;
#pragma unroll
        for (int ai = 0; ai < 2; ++ai)
#pragma unroll
            for (int m = 0; m < 4; ++m) { const int row = row0 + ai * HALF + m * 16; bf16_t* rowp = O + (size_t)row * ldc + col0;
                const f32x4* rp_ = (const f32x4*)(rowss + (size_t)row * 16); const f32x4 q_ = (rp_[0] + rp_[1]) + (rp_[2] + rp_[3]);
                const float rstd = 1.0f / sqrtf(((q_[0] + q_[1]) + (q_[2] + q_[3])) * (1.0f / 1024.0f) + 1e-6f);
#pragma unroll
                for (int bj = 0; bj < 2; ++bj) { const f32x4 v0 = acc[ai][bj][m][0] * rstd, v1 = acc[ai][bj][m][1] * rstd;
                    u32x4 w; w.x = cvt_pk_bf16(v0[0], v0[1]); w.y = cvt_pk_bf16(v0[2], v0[3]); w.z = cvt_pk_bf16(v1[0], v1[1]); w.w = cvt_pk_bf16(v1[2], v1[3]);
                    ST16((u32x4*)(rowp + bj * HALF), w); } }
    }
};
struct EpiPlain {
    static constexpr bool PERM = true, AFTER_DRAIN = false, HAS_MID = false;
    bf16_t* O; int ldc;
    __device__ __forceinline__ void operator()(const f32x4 (&acc)[2][2][4][2], const Unit& u, int wr, int wc, int fr, int fq) const {
        const int row0 = u.pm * BM + wr * 64 + fr, col0 = u.pn * BM + wc * 32 + 8 * fq;
#pragma unroll
        for (int ai = 0; ai < 2; ++ai)
#pragma unroll
            for (int m = 0; m < 4; ++m) { bf16_t* rowp = O + (size_t)(row0 + ai * HALF + m * 16) * ldc + col0;
#pragma unroll
                for (int bj = 0; bj < 2; ++bj) { const f32x4 v0 = acc[ai][bj][m][0], v1 = acc[ai][bj][m][1];
                    u32x4 w; w.x = cvt_pk_bf16(v0[0], v0[1]); w.y = cvt_pk_bf16(v0[2], v0[3]); w.z = cvt_pk_bf16(v1[0], v1[1]); w.w = cvt_pk_bf16(v1[2], v1[3]);
                    ST16((u32x4*)(rowp + bj * HALF), w); } }
    }
};
}

__device__ __forceinline__ void p0_transpose_item(const float* W, int K, int N, bf16* WT, LAS float* scr, int item, int lane, int ldk = 0, int koff = 0, const float* kscale = nullptr) {
    if (ldk == 0) ldk = K;
    const int nblk = N / 32, kb = item / nblk, nb = item % nblk, k0 = 64 * kb, n0 = 32 * nb;
#pragma unroll 8
    for (int i = 0; i < 32; ++i) { const int kk = 2 * i + (lane >> 5); scr[kk * 33 + (lane & 31)] = W[(size_t)(k0 + kk) * N + n0 + (lane & 31)] * (kscale ? kscale[k0 + kk] : 1.0f); }
    LDS_WAIT(); asm volatile("" ::: "memory");
    const int c = lane & 7;
#pragma unroll
    for (int j = 0; j < 4; ++j) { const int n = (lane >> 3) + 8 * j; const LAS float* s = scr + (8 * c) * 33 + n;
        v4u o; o.x = pk2(s[0 * 33], s[1 * 33]); o.y = pk2(s[2 * 33], s[3 * 33]); o.z = pk2(s[4 * 33], s[5 * 33]); o.w = pk2(s[6 * 33], s[7 * 33]);
        *(v4u*)(WT + (size_t)(n0 + n) * ldk + koff + k0 + 8 * c) = o; }
    LDS_WAIT(); asm volatile("" ::: "memory");
}
__device__ __forceinline__ void cvt_flat(const float* src, bf16* dst, size_t n, int gw, int NGW, int lane) {
    for (size_t i = (size_t)gw * 512 + lane * 8; i < n; i += (size_t)NGW * 512) {
        const f32x4 a = *(const f32x4*)(src + i), b = *(const f32x4*)(src + i + 4);
        v4u o; o.x = pk2(a[0], a[1]); o.y = pk2(a[2], a[3]); o.z = pk2(b[0], b[1]); o.w = pk2(b[2], b[3]);
        *(v4u*)(dst + i) = o;
    }
}
__device__ __forceinline__ void rms_row_to_bf16(const float* xrow, const float* w, bf16* orow, int lane) {
    const f32x4* xr = (const f32x4*)xrow + lane; const f32x4* wr = (const f32x4*)w + lane;
    f32x4 v[4]; float s = 0.f;
#pragma unroll
    for (int j = 0; j < 4; ++j) { v[j] = xr[64 * j]; s += (v[j][0] * v[j][0] + v[j][1] * v[j][1]) + (v[j][2] * v[j][2] + v[j][3] * v[j][3]); }
    const float rstd = 1.0f / sqrtf(wave_sum(s) * (1.0f / 1024.0f) + EPS);
    unsigned long long* o8 = (unsigned long long*)orow + lane;
#pragma unroll
    for (int j = 0; j < 4; ++j) { const f32x4 ww = wr[64 * j];
        o8[64 * j] = (unsigned long long)pk2(v[j][0] * rstd * ww[0], v[j][1] * rstd * ww[1]) | ((unsigned long long)pk2(v[j][2] * rstd * ww[2], v[j][3] * rstd * ww[3]) << 32); }
}

__device__ __forceinline__ int pack_i8x4(float a, float b, float c, float d) {
    const int qa = (int)__builtin_rintf(a), qb = (int)__builtin_rintf(b), qc = (int)__builtin_rintf(c), qd = (int)__builtin_rintf(d);
    return (qa & 255) | ((qb & 255) << 8) | ((qc & 255) << 16) | ((int)((unsigned)qd << 24));
}
__device__ __forceinline__ void rms_row_to_bf16_fp8(const float* xrow, const float* w, bf16* orow, unsigned char* o8row, float* oinv, int lane) {
    const f32x4* xr = (const f32x4*)xrow + lane; const f32x4* wr = (const f32x4*)w + lane;
    f32x4 v[4]; float s = 0.f;
#pragma unroll
    for (int j = 0; j < 4; ++j) { v[j] = xr[64 * j]; s += (v[j][0] * v[j][0] + v[j][1] * v[j][1]) + (v[j][2] * v[j][2] + v[j][3] * v[j][3]); }
    const float rstd = 1.0f / sqrtf(wave_sum(s) * (1.0f / 1024.0f) + EPS);
    unsigned long long* o8 = (unsigned long long*)orow + lane; float mx = 0.f;
#pragma unroll
    for (int j = 0; j < 4; ++j) { const f32x4 ww = wr[64 * j]; v[j] = v[j] * rstd * ww;
        o8[64 * j] = (unsigned long long)pk2(v[j][0], v[j][1]) | ((unsigned long long)pk2(v[j][2], v[j][3]) << 32);
        mx = fmaxf(mx, fmaxf(fmaxf(fabsf(v[j][0]), fabsf(v[j][1])), fmaxf(fabsf(v[j][2]), fabsf(v[j][3])))); }
#pragma unroll
    for (int o = 1; o < 64; o <<= 1) mx = fmaxf(mx, __shfl_xor(mx, o));
#if U_INT8
    const bool tiny = mx < 1e-30f;
    const float scale = tiny ? 0.f : 127.0f / mx, inv = tiny ? 0.f : mx * (1.0f / 127.0f);
#pragma unroll
    for (int j = 0; j < 4; ++j) *(int*)(o8row + 4 * lane + 256 * j) = pack_i8x4(v[j][0] * scale, v[j][1] * scale, v[j][2] * scale, v[j][3] * scale);
#else
    const int ex = (int)((__builtin_bit_cast(unsigned, mx) >> 23) & 0xffu);
    const bool tiny = ex < 32;
    const float scale = tiny ? 1.0f : __builtin_bit_cast(float, (unsigned)(254 + 7 - ex) << 23);
    const float inv = tiny ? 1.0f : __builtin_bit_cast(float, (unsigned)(ex - 7) << 23);
#pragma unroll
    for (int j = 0; j < 4; ++j) { int p = __builtin_amdgcn_cvt_pk_fp8_f32(v[j][0] * scale, v[j][1] * scale, 0, false); p = __builtin_amdgcn_cvt_pk_fp8_f32(v[j][2] * scale, v[j][3] * scale, p, true);
        *(int*)(o8row + 4 * lane + 256 * j) = p; }
#endif
    if (lane == 0) *oinv = inv;
}

struct Ptrs {
    const float *x, *mix_w, *w_in, *rel_bias, *sinks, *w_pa, *ln_w, *ln_b, *w_s, *b_s, *w_pb, *w_out, *ffn_w, *w_q, *keys1, *keys2, *pu, *pv, *fin_w;
    float* out;
    unsigned char *U8, *V8, *HN8; float *USC, *VSC, *HSC; float* rowss; unsigned* rowamax;
    bf16 *WIN, *WPA, *WPB, *WOUT, *WQ, *K1, *K2, *WS, *U, *V, *XN, *AOUT, *BOUT, *HN2, *Q, *KV, *GU, *GV, *GA, *GB, *MERGED, *QP;
};

__device__ __forceinline__ void p0_prologue(LAS unsigned char* lds, const Ptrs& P, int vcu, int G, int lane, int wave) {
    LAS float* scr = (LAS float*)(lds + wave * 16384);
    const int gw = vcu * NWAVES + wave, NGW = G * NWAVES;
    constexpr int I_IN = (1024 / 64) * (3840 / 32), I_PA = (512 / 64) * (1024 / 32), I_OUT = (1024 / 64) * (1024 / 32), I_WQ = (1024 / 64) * (2048 / 32);
    constexpr int NITEMS = I_IN + 2 * I_PA + I_OUT + I_WQ;
    for (int it = gw; it < NITEMS; it += NGW) {
        int r = it;
        if (r < I_IN) { p0_transpose_item(P.w_in, 1024, 3840, P.WIN, scr, r, lane); continue; } r -= I_IN;
        if (r < I_PA) { if (P3_FUSED) p0_transpose_item(P.w_pa, 512, 1024, P.WPA, scr, r, lane, 1024, 0); else p0_transpose_item(P.w_pa, 512, 1024, P.WPA, scr, r, lane); continue; } r -= I_PA;
        if (r < I_PA) { if (P3_FUSED) p0_transpose_item(P.w_pb, 512, 1024, P.WPA, scr, r, lane, 1024, 512); else p0_transpose_item(P.w_pb, 512, 1024, P.WPB, scr, r, lane); continue; } r -= I_PA;
        if (r < I_OUT) { p0_transpose_item(P.w_out, 1024, 1024, P.WOUT, scr, r, lane); continue; } r -= I_OUT;
        p0_transpose_item(P.w_q, 1024, 2048, P.WQ, scr, r, lane, 0, 0, P5_ELIM ? P.ffn_w : nullptr);
    }
    cvt_flat(P.keys1, P.K1, 128 * 128, gw, NGW, lane);
    cvt_flat(P.keys2, P.K2, 128 * 128, gw, NGW, lane);
#if PEER_FP8
    for (int rr = gw; rr < 2 * 16384; rr += NGW) {
        const int tab = rr >> 14, row = rr & 16383;
        const float* src = (tab ? P.pv : P.pu) + (size_t)row * 1024; unsigned char* dst = (tab ? P.V8 : P.U8) + (size_t)row * 1024;
        f32x4 v[4]; float mx = 0.f;
#pragma unroll
        for (int j = 0; j < 4; ++j) { v[j] = *(const f32x4*)(src + 4 * lane + 256 * j); mx = fmaxf(mx, fmaxf(fmaxf(fabsf(v[j][0]), fabsf(v[j][1])), fmaxf(fabsf(v[j][2]), fabsf(v[j][3])))); }
#pragma unroll
        for (int o = 1; o < 64; o <<= 1) mx = fmaxf(mx, __shfl_xor(mx, o));
        const int ex = (int)((__builtin_bit_cast(unsigned, mx) >> 23) & 0xffu);
        const bool tiny = ex < 32;
        float scale = tiny ? 1.0f : __builtin_bit_cast(float, (unsigned)(254 + 7 - ex) << 23);
        float inv = tiny ? 1.0f : __builtin_bit_cast(float, (unsigned)(ex - 7) << 23);
        if (U_INT8 && tab == 0) { scale = tiny ? 0.f : 127.0f / mx; inv = tiny ? 0.f : mx * (1.0f / 127.0f); }
#pragma unroll
        for (int j = 0; j < 4; ++j) { int p = __builtin_amdgcn_cvt_pk_fp8_f32(v[j][0] * scale, v[j][1] * scale, 0, false); p = __builtin_amdgcn_cvt_pk_fp8_f32(v[j][2] * scale, v[j][3] * scale, p, true);
            if (U_INT8 && tab == 0) p = pack_i8x4(v[j][0] * scale, v[j][1] * scale, v[j][2] * scale, v[j][3] * scale);
            const int c_ = 4 * lane + 256 * j;
            const int o_ = (U_MFMA && tab == 0) ? ((c_ >> 6) * 64 + ((c_ >> 3) & 3) * 16 + ((c_ >> 5) & 1) * 8 + (c_ & 7)) : c_;
            *(int*)(dst + o_) = p; }
        if (lane == 0) (tab ? P.VSC : P.USC)[row] = inv;
    }
#else
    cvt_flat(P.pu, P.U, (size_t)16384 * 1024, gw, NGW, lane);
    cvt_flat(P.pv, P.V, (size_t)16384 * 1024, gw, NGW, lane);
#endif
    for (size_t i = (size_t)gw * 512 + lane * 8; i < (size_t)8 * 128 * 128; i += (size_t)NGW * 512) {
        const int t = (int)((i >> 7) & 127), s0 = (int)(i & 127);
        const f32x4 a = *(const f32x4*)(P.w_s + i), b = *(const f32x4*)(P.w_s + i + 4);
        float e[8] = {a[0], a[1], a[2], a[3], b[0], b[1], b[2], b[3]};
#pragma unroll
        for (int j = 0; j < 8; ++j) e[j] = (s0 + j <= t) ? e[j] : 0.f;
        v4u o; o.x = pk2(e[0], e[1]); o.y = pk2(e[2], e[3]); o.z = pk2(e[4], e[5]); o.w = pk2(e[6], e[7]);
        *(v4u*)(P.WS + i) = o;
    }
    for (int m = gw; m < M; m += NGW) rms_row_to_bf16(P.x + (size_t)m * D, P.mix_w, P.XN + (size_t)m * D, lane);
}

__device__ __forceinline__ void p2_attn_naive(LAS unsigned char* lds, const Ptrs& P, int vcu, int G, int tid, int lane, int wave) {
    LAS float* biasl = (LAS float*)lds;
    for (int i = tid; i < 1024; i += 512) { const int d = i >> 3, h = i & 7; biasl[i] = P.rel_bias[(int)T5B[d] * 8 + h]; }
    __syncthreads();
    const int h = wave, kvh = h >> 2;
    const float sink = P.sinks[h];
    for (int unit = vcu; unit < M / 64; unit += G) {
        const int t = unit * 64 + lane, pos = t & (SEQ - 1);
        float q[64], o[64];
        { const v4u* qp = (const v4u*)(P.Q + (size_t)t * 512 + h * 64);
#pragma unroll
          for (int c = 0; c < 8; ++c) { const v4u w = qp[c]; q[8 * c + 0] = bflo(w.x) * 0.125f; q[8 * c + 1] = bfhi(w.x) * 0.125f; q[8 * c + 2] = bflo(w.y) * 0.125f; q[8 * c + 3] = bfhi(w.y) * 0.125f;
              q[8 * c + 4] = bflo(w.z) * 0.125f; q[8 * c + 5] = bfhi(w.z) * 0.125f; q[8 * c + 6] = bflo(w.w) * 0.125f; q[8 * c + 7] = bfhi(w.w) * 0.125f; } }
#pragma unroll
        for (int i = 0; i < 64; ++i) o[i] = 0.f;
        float m = sink, l = 1.f;
        for (int d = 0; d < 128; ++d) {
            const bool valid = (pos - d) >= 0;
            const int tj = valid ? (t - d) : t;
            const v4u* kp = (const v4u*)(P.KV + (size_t)tj * 256 + kvh * 64);
            float dot = 0.f;
#pragma unroll
            for (int c = 0; c < 8; ++c) { const v4u w = kp[c];
                dot += q[8 * c + 0] * bflo(w.x) + q[8 * c + 1] * bfhi(w.x) + q[8 * c + 2] * bflo(w.y) + q[8 * c + 3] * bfhi(w.y) + q[8 * c + 4] * bflo(w.z) + q[8 * c + 5] * bfhi(w.z) + q[8 * c + 6] * bflo(w.w) + q[8 * c + 7] * bfhi(w.w); }
            const float s = valid ? dot + biasl[d * 8 + h] : -1e30f;
            const float mn = fmaxf(m, s), alpha = __expf(m - mn), p = __expf(s - mn);
            l = l * alpha + p; m = mn;
            const v4u* vp = kp + 16;
#pragma unroll
            for (int c = 0; c < 8; ++c) { const v4u w = vp[c];
                o[8 * c + 0] = o[8 * c + 0] * alpha + p * bflo(w.x); o[8 * c + 1] = o[8 * c + 1] * alpha + p * bfhi(w.x); o[8 * c + 2] = o[8 * c + 2] * alpha + p * bflo(w.y); o[8 * c + 3] = o[8 * c + 3] * alpha + p * bfhi(w.y);
                o[8 * c + 4] = o[8 * c + 4] * alpha + p * bflo(w.z); o[8 * c + 5] = o[8 * c + 5] * alpha + p * bfhi(w.z); o[8 * c + 6] = o[8 * c + 6] * alpha + p * bflo(w.w); o[8 * c + 7] = o[8 * c + 7] * alpha + p * bfhi(w.w); }
        }
        const float inv = 1.0f / l;
        v4u* op = (v4u*)(P.AOUT + (size_t)t * AB_LD + h * 64);
#pragma unroll
        for (int c = 0; c < 8; ++c) { v4u w; w.x = pk2(o[8 * c + 0] * inv, o[8 * c + 1] * inv); w.y = pk2(o[8 * c + 2] * inv, o[8 * c + 3] * inv); w.z = pk2(o[8 * c + 4] * inv, o[8 * c + 5] * inv); w.w = pk2(o[8 * c + 6] * inv, o[8 * c + 7] * inv); op[c] = w; }
    }
    __syncthreads();
}

__device__ __forceinline__ void p2_gmlp_naive(LAS unsigned char* lds, const Ptrs& P, int vcu, int G, int tid, int lane, int wave) {
    LAS bf16* vnl = (LAS bf16*)(lds + 8192);
    for (int unit = vcu; unit < 256; unit += G) {
        const int c = unit >> 1, hh = unit & 1;
        for (int i = 0; i < 16; ++i) {
            const int tt = wave * 16 + i; const size_t row = (size_t)c * 128 + tt;
            const v4u w = *((const v4u*)(P.GV + row * 512) + lane);
            float x[8] = {bflo(w.x), bfhi(w.x), bflo(w.y), bfhi(w.y), bflo(w.z), bfhi(w.z), bflo(w.w), bfhi(w.w)};
            float s = 0.f;
#pragma unroll
            for (int j = 0; j < 8; ++j) s += x[j];
            const float mean = wave_sum(s) * (1.0f / 512.0f);
            float ss = 0.f;
#pragma unroll
            for (int j = 0; j < 8; ++j) { x[j] -= mean; ss += x[j] * x[j]; }
            const float rstd = 1.0f / sqrtf(wave_sum(ss) * (1.0f / 512.0f) + EPS);
            if ((lane >> 5) == hh) {
                const f32x4 w0 = *(const f32x4*)(P.ln_w + lane * 8), w1 = *(const f32x4*)(P.ln_w + lane * 8 + 4), b0 = *(const f32x4*)(P.ln_b + lane * 8), b1 = *(const f32x4*)(P.ln_b + lane * 8 + 4);
                v4u o; o.x = pk2(x[0] * rstd * w0[0] + b0[0], x[1] * rstd * w0[1] + b0[1]); o.y = pk2(x[2] * rstd * w0[2] + b0[2], x[3] * rstd * w0[3] + b0[3]);
                o.z = pk2(x[4] * rstd * w1[0] + b1[0], x[5] * rstd * w1[1] + b1[1]); o.w = pk2(x[6] * rstd * w1[2] + b1[2], x[7] * rstd * w1[3] + b1[3]);
                *(LAS v4u*)(vnl + tt * 256 + (lane & 31) * 8) = o;
            }
        }
        __syncthreads();
        const int ch = tid & 255, th = tid >> 8, g = hh * 4 + (ch >> 6);
        for (int t = th * 64; t < th * 64 + 64; ++t) {
            const v4u* wrow = (const v4u*)(P.WS + ((size_t)g * 128 + t) * 128);
            float acc = 0.f;
            for (int s8 = 0; s8 <= (t >> 3); ++s8) {
                const v4u w = wrow[s8];
                const LAS bf16* vp = vnl + (s8 * 8) * 256 + ch;
                acc += bflo(w.x) * bf2f(vp[0]) + bfhi(w.x) * bf2f(vp[256]) + bflo(w.y) * bf2f(vp[512]) + bfhi(w.y) * bf2f(vp[768])
                     + bflo(w.z) * bf2f(vp[1024]) + bfhi(w.z) * bf2f(vp[1280]) + bflo(w.w) * bf2f(vp[1536]) + bfhi(w.w) * bf2f(vp[1792]);
            }
            const size_t row = (size_t)c * 128 + t;
            const float uval = bf2f(P.GU[row * 512 + hh * 256 + ch]);
            P.BOUT[row * AB_LD + hh * 256 + ch] = (bf16)f2bf(uval * (acc + P.b_s[g * 128 + t]));
        }
        __syncthreads();
    }
}

typedef short s16x8 __attribute__((ext_vector_type(8)));
typedef short s16x4 __attribute__((ext_vector_type(4)));
typedef float f32x16 __attribute__((ext_vector_type(16)));
typedef float f32x2v __attribute__((ext_vector_type(2)));
#define MFMA32(a, b, c) __builtin_amdgcn_mfma_f32_32x32x16_bf16((a), (b), (c), 0, 0, 0)
__device__ __forceinline__ s16x4 tr16(const LAS unsigned char* p) { return __builtin_bit_cast(s16x4, __builtin_amdgcn_ds_read_tr16_b64_v4i16((LAS s16x4*)p)); }
__device__ __forceinline__ unsigned cvtpk(float lo, float hi) { f32x2v v = {lo, hi}; bf16x2_t b = __builtin_convertvector(v, bf16x2_t); return __builtin_bit_cast(unsigned, b); }
__device__ __forceinline__ int crow(int reg, int h) { return (reg & 3) + 8 * (reg >> 2) + 4 * h; }
constexpr float LOG2E = 1.4426950408889634f;

__device__ __forceinline__ void p2_attn_mfma(LAS unsigned char* lds, const Ptrs& P, int vcu, int G, int tid, int lane, int wave) {
    LAS unsigned char* Kl = lds;
    LAS unsigned char* Vl = lds + 32768;
    LAS float* biasl = (LAS float*)(lds + 32768 + 49152);
    const int r = lane & 31, h = lane >> 5, i16 = lane & 15, q4 = i16 >> 2, p4 = i16 & 3, blk = (lane >> 4) & 1;
    for (int unit = vcu; unit < 256; unit += G) {
        const int kvh = unit & 1, blkid = unit >> 1, nb = blkid & 63; const int tok0 = blkid * 128;
#pragma unroll
        for (int i = 0; i < 4; ++i) {
            const int cidx = tid + 512 * i, row = cidx >> 3, c = cidx & 7;
            v4u kw = {0u, 0u, 0u, 0u}, vw = {0u, 0u, 0u, 0u};
            if (nb > 0 || row >= 128) { const bf16* src = P.KV + (size_t)(tok0 - 128 + row) * 256 + kvh * 64 + c * 8; kw = *(const v4u*)src; vw = *(const v4u*)(src + 128); }
            *(LAS v4u*)(Kl + row * 128 + ((c ^ ((row >> 1) & 7)) << 4)) = kw;
            *(LAS v4u*)(Vl + row * 192 + c * 16) = vw;
        }
        biasl[tid] = P.rel_bias[(int)T5B[tid & 127] * 8 + kvh * 4 + (tid >> 7)] * LOG2E;
        __syncthreads();
        const int g = wave >> 1, qh = wave & 1, hq = kvh * 4 + g;
        const float sink2 = P.sinks[hq] * LOG2E;
#pragma unroll 1
        for (int qs = 0; qs < 2; ++qs) {
            const int qi0 = 64 * qh + 32 * qs, kt0 = 2 * qh + qs;
            s16x8 qf[4];
            { const bf16* qrow = P.Q + (size_t)(tok0 + qi0 + r) * 512 + hq * 64 + 8 * h;
#pragma unroll
              for (int ks = 0; ks < 4; ++ks) qf[ks] = *(const s16x8*)(qrow + 16 * ks); }
            f32x16 s[5];
#pragma unroll
            for (int i = 0; i < 5; ++i) {
#pragma unroll
                for (int e = 0; e < 16; ++e) s[i][e] = 0.f;
                const int key = 32 * (kt0 + i) + r; const LAS unsigned char* kp = Kl + key * 128; const int sw = (key >> 1) & 7;
#pragma unroll
                for (int ks = 0; ks < 4; ++ks) { const s16x8 kf = *(const LAS s16x8*)(kp + (((2 * ks + h) ^ sw) << 4)); s[i] = MFMA32(kf, qf[ks], s[i]); }
            }
            const int qi = qi0 + r;
            float mx = sink2;
#pragma unroll
            for (int i = 0; i < 5; ++i)
#pragma unroll
                for (int e = 0; e < 16; ++e) {
                    const int kj = 32 * (kt0 + i) + crow(e, h), dist = 128 + qi - kj;
                    const bool valid = (dist >= 0) && (dist < 128) && (nb > 0 || kj >= 128);
                    const float b = biasl[g * 128 + (dist & 127)];
                    const float v = valid ? s[i][e] * (0.125f * LOG2E) + b : -1e30f;
                    s[i][e] = v; mx = fmaxf(mx, v);
                }
            mx = fmaxf(mx, xor32_f(mx));
            float l = 0.f;
#pragma unroll
            for (int i = 0; i < 5; ++i)
#pragma unroll
                for (int e = 0; e < 16; ++e) { const float p = __builtin_amdgcn_exp2f(s[i][e] - mx); s[i][e] = p; l += p; }
            l += xor32_f(l);
            l += __builtin_amdgcn_exp2f(sink2 - mx);
            f32x16 o0, o1;
#pragma unroll
            for (int e = 0; e < 16; ++e) { o0[e] = 0.f; o1[e] = 0.f; }
#pragma unroll
            for (int i = 0; i < 5; ++i)
#pragma unroll
                for (int st = 0; st < 2; ++st) {
                    v4u pw; pw.x = cvtpk(s[i][8 * st], s[i][8 * st + 1]); pw.y = cvtpk(s[i][8 * st + 2], s[i][8 * st + 3]); pw.z = cvtpk(s[i][8 * st + 4], s[i][8 * st + 5]); pw.w = cvtpk(s[i][8 * st + 6], s[i][8 * st + 7]);
                    const s16x8 pf = __builtin_bit_cast(s16x8, pw);
                    const LAS unsigned char* vb = Vl + (32 * (kt0 + i) + 16 * st + 4 * h + q4) * 192 + 32 * blk + 8 * p4;
                    { const s16x4 lo = tr16(vb), hi = tr16(vb + 8 * 192); const s16x8 vf = __builtin_shufflevector(lo, hi, 0, 1, 2, 3, 4, 5, 6, 7); o0 = MFMA32(vf, pf, o0); }
                    { const s16x4 lo = tr16(vb + 64), hi = tr16(vb + 64 + 8 * 192); const s16x8 vf = __builtin_shufflevector(lo, hi, 0, 1, 2, 3, 4, 5, 6, 7); o1 = MFMA32(vf, pf, o1); }
                }
            const float inv = 1.0f / l;
            bf16* orow = P.AOUT + (size_t)(tok0 + qi) * AB_LD + hq * 64 + 4 * h;
#pragma unroll
            for (int r4 = 0; r4 < 4; ++r4) {
                v2u w0; w0.x = cvtpk(o0[4 * r4] * inv, o0[4 * r4 + 1] * inv); w0.y = cvtpk(o0[4 * r4 + 2] * inv, o0[4 * r4 + 3] * inv); *(v2u*)(orow + 8 * r4) = w0;
                v2u w1; w1.x = cvtpk(o1[4 * r4] * inv, o1[4 * r4 + 1] * inv); w1.y = cvtpk(o1[4 * r4 + 2] * inv, o1[4 * r4 + 3] * inv); *(v2u*)(orow + 32 + 8 * r4) = w1;
            }
        }
        __syncthreads();
    }
}

__device__ __forceinline__ void p2_gmlp_mfma(LAS unsigned char* lds, const Ptrs& P, int vcu, int G, int tid, int lane, int wave) {
    LAS unsigned char* vnl = lds;
    const int r = lane & 31, h = lane >> 5, i16 = lane & 15, q4 = i16 >> 2, p4 = i16 & 3, blk = (lane >> 4) & 1;
    for (int unit = vcu; unit < 256; unit += G) {
        const int c = unit >> 1, hh = unit & 1;
        v4u gvw[16];
#pragma unroll
        for (int i = 0; i < 16; ++i) gvw[i] = *((const v4u*)(P.GV + ((size_t)c * 128 + wave * 16 + i) * 512) + lane);
        const f32x4 lw0 = *(const f32x4*)(P.ln_w + lane * 8), lw1 = *(const f32x4*)(P.ln_w + lane * 8 + 4), lb0 = *(const f32x4*)(P.ln_b + lane * 8), lb1 = *(const f32x4*)(P.ln_b + lane * 8 + 4);
#pragma unroll
        for (int i = 0; i < 16; ++i) {
            const int tt = wave * 16 + i;
            const v4u w = gvw[i];
            float x[8] = {bflo(w.x), bfhi(w.x), bflo(w.y), bfhi(w.y), bflo(w.z), bfhi(w.z), bflo(w.w), bfhi(w.w)};
            float s = 0.f;
#pragma unroll
            for (int j = 0; j < 8; ++j) s += x[j];
            const float mean = wave_sum(s) * (1.0f / 512.0f);
            float ss = 0.f;
#pragma unroll
            for (int j = 0; j < 8; ++j) { x[j] -= mean; ss += x[j] * x[j]; }
            const float rstd = 1.0f / sqrtf(wave_sum(ss) * (1.0f / 512.0f) + EPS);
            if ((lane >> 5) == hh) {
                const f32x4 w0 = lw0, w1 = lw1, b0 = lb0, b1 = lb1;
                v4u o; o.x = pk2(x[0] * rstd * w0[0] + b0[0], x[1] * rstd * w0[1] + b0[1]); o.y = pk2(x[2] * rstd * w0[2] + b0[2], x[3] * rstd * w0[3] + b0[3]);
                o.z = pk2(x[4] * rstd * w1[0] + b1[0], x[5] * rstd * w1[1] + b1[1]); o.w = pk2(x[6] * rstd * w1[2] + b1[2], x[7] * rstd * w1[3] + b1[3]);
                *(LAS v4u*)(vnl + tt * 576 + (lane & 31) * 16) = o;
            }
        }
        __syncthreads();
        const int gi = wave >> 1, dblk = wave & 1, g = hh * 4 + gi;
        s16x8 af[8];
#pragma unroll
        for (int ks = 0; ks < 8; ++ks) { const LAS unsigned char* vb = vnl + (16 * ks + 8 * h + q4) * 576 + (gi * 64 + dblk * 32 + 16 * blk) * 2 + 8 * p4;
            const s16x4 lo = tr16(vb), hi = tr16(vb + 4 * 576); af[ks] = __builtin_shufflevector(lo, hi, 0, 1, 2, 3, 4, 5, 6, 7); }
#pragma unroll
        for (int tt = 0; tt < 4; ++tt) {
            f32x16 acc;
#pragma unroll
            for (int e = 0; e < 16; ++e) acc[e] = 0.f;
            const bf16* wrow = P.WS + ((size_t)g * 128 + 32 * tt + r) * 128 + 8 * h;
#pragma unroll
            for (int ks = 0; ks < 2 * (tt + 1); ++ks) acc = MFMA32(af[ks], *(const s16x8*)(wrow + 16 * ks), acc);
            const int t = 32 * tt + r; const size_t row = (size_t)c * 128 + t; const float b = P.b_s[g * 128 + t];
#pragma unroll
            for (int r4 = 0; r4 < 4; ++r4) {
                const int ch = g * 64 + dblk * 32 + 8 * r4 + 4 * h;
                const v2u uw = *(const v2u*)(P.GU + row * 512 + ch);
                v2u ow; ow.x = cvtpk(bflo(uw.x) * (acc[4 * r4] + b), bfhi(uw.x) * (acc[4 * r4 + 1] + b)); ow.y = cvtpk(bflo(uw.y) * (acc[4 * r4 + 2] + b), bfhi(uw.y) * (acc[4 * r4 + 3] + b));
                *(v2u*)(P.BOUT + row * AB_LD + ch) = ow;
            }
        }
        __syncthreads();
    }
}

__device__ __forceinline__ void topk_half(const bf16* q, const LAS bf16* kl, float (&v)[16]) {
    v4u qv[16];
#pragma unroll
    for (int c = 0; c < 16; ++c) qv[c] = ((const v4u*)q)[c];
#pragma unroll
    for (int i = 0; i < 16; ++i) v[i] = -INFINITY;
    for (int n = 0; n < 128; ++n) {
        const LAS v4u* kr = (const LAS v4u*)(kl + n * 128);
        float a0 = 0.f, a1 = 0.f, a2 = 0.f, a3 = 0.f;
#pragma unroll
        for (int c = 0; c < 16; ++c) { const v4u kk = kr[c]; a0 = dot2bf(qv[c].x, kk.x, a0); a1 = dot2bf(qv[c].y, kk.y, a1); a2 = dot2bf(qv[c].z, kk.z, a2); a3 = dot2bf(qv[c].w, kk.w, a3); }
        const float acc = (a0 + a1) + (a2 + a3);
        float x = __builtin_bit_cast(float, (__builtin_bit_cast(unsigned, acc) & ~0x7Fu) | (unsigned)n);
#pragma unroll
        for (int i = 0; i < 16; ++i) { const float hi = fmaxf(v[i], x); x = fminf(v[i], x); v[i] = hi; }
    }
}

__host__ __device__ constexpr int cand_slot(int i, int j) { int c = 0; for (int a = 0; a < 16; ++a) for (int b = 0; b < 16; ++b) { if (a == i && b == j) return c; if ((a + 1) * (b + 1) <= 16) ++c; } return c; }
#define CE_DESC(a, b) do { const float hi_ = fmaxf((a), (b)); const float lo_ = fminf((a), (b)); (a) = hi_; (b) = lo_; } while (0)
__device__ __forceinline__ void sort16_desc(float (&v)[16]) {
    CE_DESC(v[0], v[1]); CE_DESC(v[3], v[2]); CE_DESC(v[4], v[5]); CE_DESC(v[7], v[6]); CE_DESC(v[8], v[9]); CE_DESC(v[11], v[10]); CE_DESC(v[12], v[13]); CE_DESC(v[15], v[14]); CE_DESC(v[0], v[2]); CE_DESC(v[1], v[3]); CE_DESC(v[6], v[4]); CE_DESC(v[7], v[5]); CE_DESC(v[8], v[10]); CE_DESC(v[9], v[11]); CE_DESC(v[14], v[12]); CE_DESC(v[15], v[13]); CE_DESC(v[0], v[1]); CE_DESC(v[2], v[3]); CE_DESC(v[5], v[4]); CE_DESC(v[7], v[6]); CE_DESC(v[8], v[9]); CE_DESC(v[10], v[11]); CE_DESC(v[13], v[12]); CE_DESC(v[15], v[14]); CE_DESC(v[0], v[4]); CE_DESC(v[1], v[5]); CE_DESC(v[2], v[6]); CE_DESC(v[3], v[7]); CE_DESC(v[12], v[8]); CE_DESC(v[13], v[9]); CE_DESC(v[14], v[10]); CE_DESC(v[15], v[11]); CE_DESC(v[0], v[2]); CE_DESC(v[1], v[3]); CE_DESC(v[4], v[6]); CE_DESC(v[5], v[7]); CE_DESC(v[10], v[8]); CE_DESC(v[11], v[9]); CE_DESC(v[14], v[12]); CE_DESC(v[15], v[13]); CE_DESC(v[0], v[1]); CE_DESC(v[2], v[3]); CE_DESC(v[4], v[5]); CE_DESC(v[6], v[7]); CE_DESC(v[9], v[8]); CE_DESC(v[11], v[10]); CE_DESC(v[13], v[12]); CE_DESC(v[15], v[14]); CE_DESC(v[0], v[8]); CE_DESC(v[1], v[9]); CE_DESC(v[2], v[10]); CE_DESC(v[3], v[11]); CE_DESC(v[4], v[12]); CE_DESC(v[5], v[13]); CE_DESC(v[6], v[14]); CE_DESC(v[7], v[15]); CE_DESC(v[0], v[4]); CE_DESC(v[1], v[5]); CE_DESC(v[2], v[6]); CE_DESC(v[3], v[7]); CE_DESC(v[8], v[12]); CE_DESC(v[9], v[13]); CE_DESC(v[10], v[14]); CE_DESC(v[11], v[15]); CE_DESC(v[0], v[2]); CE_DESC(v[1], v[3]); CE_DESC(v[4], v[6]); CE_DESC(v[5], v[7]); CE_DESC(v[8], v[10]); CE_DESC(v[9], v[11]); CE_DESC(v[12], v[14]); CE_DESC(v[13], v[15]); CE_DESC(v[0], v[1]); CE_DESC(v[2], v[3]); CE_DESC(v[4], v[5]); CE_DESC(v[6], v[7]); CE_DESC(v[8], v[9]); CE_DESC(v[10], v[11]); CE_DESC(v[12], v[13]); CE_DESC(v[14], v[15]);
}
__device__ __forceinline__ void merge_top16(float (&a)[16], const float (&b)[16]) {
    a[0] = fmaxf(a[0], b[15]); a[1] = fmaxf(a[1], b[14]); a[2] = fmaxf(a[2], b[13]); a[3] = fmaxf(a[3], b[12]); a[4] = fmaxf(a[4], b[11]); a[5] = fmaxf(a[5], b[10]); a[6] = fmaxf(a[6], b[9]); a[7] = fmaxf(a[7], b[8]); a[8] = fmaxf(a[8], b[7]); a[9] = fmaxf(a[9], b[6]); a[10] = fmaxf(a[10], b[5]); a[11] = fmaxf(a[11], b[4]); a[12] = fmaxf(a[12], b[3]); a[13] = fmaxf(a[13], b[2]); a[14] = fmaxf(a[14], b[1]); a[15] = fmaxf(a[15], b[0]); CE_DESC(a[0], a[8]); CE_DESC(a[1], a[9]); CE_DESC(a[2], a[10]); CE_DESC(a[3], a[11]); CE_DESC(a[4], a[12]); CE_DESC(a[5], a[13]); CE_DESC(a[6], a[14]); CE_DESC(a[7], a[15]); CE_DESC(a[0], a[4]); CE_DESC(a[1], a[5]); CE_DESC(a[2], a[6]); CE_DESC(a[3], a[7]); CE_DESC(a[8], a[12]); CE_DESC(a[9], a[13]); CE_DESC(a[10], a[14]); CE_DESC(a[11], a[15]); CE_DESC(a[0], a[2]); CE_DESC(a[1], a[3]); CE_DESC(a[4], a[6]); CE_DESC(a[5], a[7]); CE_DESC(a[8], a[10]); CE_DESC(a[9], a[11]); CE_DESC(a[12], a[14]); CE_DESC(a[13], a[15]); CE_DESC(a[0], a[1]); CE_DESC(a[2], a[3]); CE_DESC(a[4], a[5]); CE_DESC(a[6], a[7]); CE_DESC(a[8], a[9]); CE_DESC(a[10], a[11]); CE_DESC(a[12], a[13]); CE_DESC(a[14], a[15]);
}
__device__ __forceinline__ void scores_top16(const bf16* qbase, const LAS unsigned char* kl, int r, int h, float (&t)[16]) {
#if TOPK_DBG_INSERT == 3
#pragma unroll
    for (int k = 0; k < 16; ++k) t[k] = -1e30f;
#pragma unroll 1
    for (int key = 0; key < 128; ++key) { float a = 0.f;
        if (((key >> 2) & 1) != h) continue;
        for (int c = 0; c < 16; ++c) { const v4u q1 = *(const v4u*)(qbase + (size_t)r * 256 + 8 * c); const v4u kk1 = *(const LAS v4u*)(kl + key * 256 + 16 * c);
            a = dot2bf(q1.x, kk1.x, a); a = dot2bf(q1.y, kk1.y, a); a = dot2bf(q1.z, kk1.z, a); a = dot2bf(q1.w, kk1.w, a); }
        float x = __builtin_bit_cast(float, (__builtin_bit_cast(unsigned, a) & ~0x7Fu) | (unsigned)key);
#pragma unroll
        for (int i = 0; i < 16; ++i) { const float hi = fmaxf(t[i], x); x = fminf(t[i], x); t[i] = hi; } }
    return;
#endif
    f32x16 acc[4];
#pragma unroll
    for (int kt = 0; kt < 4; ++kt)
#pragma unroll
        for (int e = 0; e < 16; ++e) acc[kt][e] = 0.f;
    const LAS unsigned char* kp0 = kl + r * 256; const int sw = KEY_SWZ ? (r & 15) : 0;
#pragma unroll
    for (int ks = 0; ks < 8; ++ks) {
        const s16x8 qf = *(const s16x8*)(qbase + (size_t)r * 256 + 16 * ks + 8 * h);
#pragma unroll
        for (int kt = 0; kt < 4; ++kt) { const s16x8 kf = *(const LAS s16x8*)(kp0 + kt * 8192 + (((2 * ks + h) ^ sw) << 4)); acc[kt] = MFMA32(kf, qf, acc[kt]); }
    }
    float g[4][16];
#pragma unroll
    for (int kt = 0; kt < 4; ++kt) {
#pragma unroll
        for (int e = 0; e < 16; ++e) { const float av_ = acc[kt][e];
            g[kt][e] = __builtin_bit_cast(float, (__builtin_bit_cast(unsigned, av_) & ~0x7Fu) | (unsigned)(32 * kt + (e & 3) + 8 * (e >> 2))); }
#if !TOPK_DBG_INSERT
        sort16_desc(g[kt]);
#endif
    }
#if TOPK_DBG_INSERT == 2
#pragma unroll
    for (int k = 0; k < 16; ++k) t[k] = -1e30f;
#pragma unroll
    for (int kt = 0; kt < 4; ++kt)
#pragma unroll
        for (int e = 0; e < 16; ++e) t[0] = fmaxf(t[0], g[kt][e]);
#elif TOPK_DBG_INSERT
#pragma unroll
    for (int k = 0; k < 16; ++k) t[k] = -1e30f;
#pragma unroll
    for (int kt = 0; kt < 4; ++kt)
#pragma unroll
        for (int e = 0; e < 16; ++e) { float x = g[kt][e];
#pragma unroll
            for (int i = 0; i < 16; ++i) { const float hi = fmaxf(t[i], x); x = fminf(t[i], x); t[i] = hi; } }
#else
    merge_top16(g[0], g[1]); merge_top16(g[2], g[3]); merge_top16(g[0], g[2]);
#pragma unroll
    for (int k = 0; k < 16; ++k) t[k] = __builtin_bit_cast(float, __builtin_bit_cast(unsigned, g[0][k]) | ((unsigned)h << 2));
#endif
}
__device__ __forceinline__ void peer_topk_unit_mfma(const Ptrs& P, const LAS unsigned char* k1l, const LAS unsigned char* k2l, LAS int* idxl, LAS float* gatel, int unit, int lane, int wave) {
    asm volatile("" : "+v"(lane));
    const int r = lane & 31, h = lane >> 5;
#pragma unroll 1
    for (int rbi = 0; rbi < 2; ++rbi) {
        const int rb = wave * 2 + rbi, R = rb * 32 + r;
        const bf16* qbase = P.QP + ((size_t)unit * 512 + rb * 32) * 256;
        float t1[16], t2[16];
#if TOPK_DBG_BRUTE
#pragma unroll
        for (int k = 0; k < 16; ++k) { t1[k] = -1e30f; t2[k] = -1e30f; }
#pragma unroll 1
        for (int key = 0; key < 128; ++key) { float a = 0.f, b = 0.f;
            if (((key >> 2) & 1) != h) continue;
            for (int c = 0; c < 16; ++c) { const v4u q1 = *(const v4u*)(qbase + (size_t)r * 256 + 8 * c), q2 = *(const v4u*)(qbase + 128 + (size_t)r * 256 + 8 * c);
                const v4u kk1 = *(const LAS v4u*)(k1l + key * 256 + 16 * c), kk2 = *(const LAS v4u*)(k2l + key * 256 + 16 * c);
                a = dot2bf(q1.x, kk1.x, a); a = dot2bf(q1.y, kk1.y, a); a = dot2bf(q1.z, kk1.z, a); a = dot2bf(q1.w, kk1.w, a);
                b = dot2bf(q2.x, kk2.x, b); b = dot2bf(q2.y, kk2.y, b); b = dot2bf(q2.z, kk2.z, b); b = dot2bf(q2.w, kk2.w, b); }
            float x = __builtin_bit_cast(float, (__builtin_bit_cast(unsigned, a) & ~0x7Fu) | (unsigned)key), y = __builtin_bit_cast(float, (__builtin_bit_cast(unsigned, b) & ~0x7Fu) | (unsigned)key);
#pragma unroll
            for (int i = 0; i < 16; ++i) { const float hi = fmaxf(t1[i], x); x = fminf(t1[i], x); t1[i] = hi; const float hj = fmaxf(t2[i], y); y = fminf(t2[i], y); t2[i] = hj; } }
#else
        scores_top16(qbase, k1l, r, h, t1);
        __builtin_amdgcn_sched_barrier(0);
        scores_top16(qbase + 128, k2l, r, h, t2);
        __builtin_amdgcn_sched_barrier(0);
#endif
        float F[16], recv[16];
#pragma unroll
        for (int k = 0; k < 16; ++k) { auto rr = __builtin_amdgcn_permlane32_swap(__builtin_bit_cast(unsigned, t1[k]), __builtin_bit_cast(unsigned, t2[k]), false, false);
            const unsigned r0 = rr[0], r1 = rr[1]; F[k] = __builtin_bit_cast(float, r0); recv[k] = __builtin_bit_cast(float, r1); }
        merge_top16(F, recv);
        LAS unsigned char* slot = (LAS unsigned char*)(idxl + R * 16);
        { v4u b;
          b.x = (__builtin_bit_cast(unsigned, F[0]) & 0x7Fu) | ((__builtin_bit_cast(unsigned, F[1]) & 0x7Fu) << 8) | ((__builtin_bit_cast(unsigned, F[2]) & 0x7Fu) << 16) | ((__builtin_bit_cast(unsigned, F[3]) & 0x7Fu) << 24);
          b.y = (__builtin_bit_cast(unsigned, F[4]) & 0x7Fu) | ((__builtin_bit_cast(unsigned, F[5]) & 0x7Fu) << 8) | ((__builtin_bit_cast(unsigned, F[6]) & 0x7Fu) << 16) | ((__builtin_bit_cast(unsigned, F[7]) & 0x7Fu) << 24);
          b.z = (__builtin_bit_cast(unsigned, F[8]) & 0x7Fu) | ((__builtin_bit_cast(unsigned, F[9]) & 0x7Fu) << 8) | ((__builtin_bit_cast(unsigned, F[10]) & 0x7Fu) << 16) | ((__builtin_bit_cast(unsigned, F[11]) & 0x7Fu) << 24);
          b.w = (__builtin_bit_cast(unsigned, F[12]) & 0x7Fu) | ((__builtin_bit_cast(unsigned, F[13]) & 0x7Fu) << 8) | ((__builtin_bit_cast(unsigned, F[14]) & 0x7Fu) << 16) | ((__builtin_bit_cast(unsigned, F[15]) & 0x7Fu) << 24);
#if !TOPK_DBG_GATES_ONLY
          *(LAS v4u*)(slot + 16 * h) = b;
#endif
          (void)b; }
#if TOPK_DBG_COMPARE == 7 || TOPK_DBG_COMPARE == 8
        { float best1 = -1e30f, best2 = -1e30f;
#pragma unroll 1
          for (int key = 0; key < 128; ++key) { float a = 0.f, b = 0.f;
              if (TOPK_DBG_COMPARE == 8 && ((key >> 2) & 1) != h) continue;
              for (int c = 0; c < 16; ++c) { const v4u q1 = *(const v4u*)(qbase + (size_t)r * 256 + 8 * c), q2 = *(const v4u*)(qbase + 128 + (size_t)r * 256 + 8 * c);
                  const v4u kk1 = *(const LAS v4u*)(k1l + key * 256 + 16 * c), kk2 = *(const LAS v4u*)(k2l + key * 256 + 16 * c);
                  a = dot2bf(q1.x, kk1.x, a); a = dot2bf(q1.y, kk1.y, a); a = dot2bf(q1.z, kk1.z, a); a = dot2bf(q1.w, kk1.w, a);
                  b = dot2bf(q2.x, kk2.x, b); b = dot2bf(q2.y, kk2.y, b); b = dot2bf(q2.z, kk2.z, b); b = dot2bf(q2.w, kk2.w, b); }
              best1 = fmaxf(best1, __builtin_bit_cast(float, (__builtin_bit_cast(unsigned, a) & ~0x7Fu) | (unsigned)key));
              best2 = fmaxf(best2, __builtin_bit_cast(float, (__builtin_bit_cast(unsigned, b) & ~0x7Fu) | (unsigned)key)); }
          *(LAS unsigned*)((LAS unsigned char*)idxl + 65536 + R * 8 + 4 * h) = (__builtin_bit_cast(unsigned, best1) & 0x7Fu) | ((__builtin_bit_cast(unsigned, best2) & 0x7Fu) << 16); }
#endif
#if TOPK_DBG_COMPARE == 9
        { float m1 = t1[0], m2 = t2[0];
#pragma unroll
          for (int k = 1; k < 16; ++k) { m1 = fmaxf(m1, t1[k]); m2 = fmaxf(m2, t2[k]); }
          *(LAS unsigned*)((LAS unsigned char*)idxl + 65536 + R * 8 + 4 * h) = (__builtin_bit_cast(unsigned, m1) & 0x7Fu) | ((__builtin_bit_cast(unsigned, m2) & 0x7Fu) << 16); }
#endif
#if TOPK_DBG_COMPARE == 6
        *(LAS unsigned*)((LAS unsigned char*)idxl + 65536 + R * 8 + 4 * h) = (__builtin_bit_cast(unsigned, t1[0]) & 0x7Fu) | ((__builtin_bit_cast(unsigned, t1[1]) & 0x7Fu) << 8) | ((__builtin_bit_cast(unsigned, t2[0]) & 0x7Fu) << 16) | ((__builtin_bit_cast(unsigned, t2[1]) & 0x7Fu) << 24);
#endif
#if TOPK_DBG_COMPARE == 4
        *(LAS unsigned*)((LAS unsigned char*)idxl + 65536 + R * 8 + 4 * h) = (__builtin_bit_cast(unsigned, F[TOPK_DBG_K0]) & 0x7Fu) | ((__builtin_bit_cast(unsigned, F[TOPK_DBG_K0 + 1]) & 0x7Fu) << 8) | ((__builtin_bit_cast(unsigned, F[TOPK_DBG_K0 + 2]) & 0x7Fu) << 16) | ((__builtin_bit_cast(unsigned, F[TOPK_DBG_K0 + 3]) & 0x7Fu) << 24);
#endif
        float v1[16], v2[16];
#pragma unroll
        for (int k = 0; k < 16; ++k) { auto rr = __builtin_amdgcn_permlane32_swap(__builtin_bit_cast(unsigned, F[k]), __builtin_bit_cast(unsigned, F[k]), false, false);
            const unsigned r0 = rr[0], r1 = rr[1]; v1[k] = __builtin_bit_cast(float, r0 & ~0x7Fu); v2[k] = __builtin_bit_cast(float, r1 & ~0x7Fu); }
        float cg[4][16];
#pragma unroll
        for (int a = 0; a < 4; ++a)
#pragma unroll
            for (int k = 0; k < 16; ++k) cg[a][k] = -1e30f;
#define CAND(i, j) __builtin_bit_cast(float, (__builtin_bit_cast(unsigned, v1[i] + v2[j]) & ~0xFFu) | (unsigned)((i) * 16 + (j)))
        cg[0][0] = CAND(0, 0);
        cg[0][1] = CAND(0, 1);
        cg[0][2] = CAND(0, 2);
        cg[0][3] = CAND(0, 3);
        cg[0][4] = CAND(0, 4);
        cg[0][5] = CAND(0, 5);
        cg[0][6] = CAND(0, 6);
        cg[0][7] = CAND(0, 7);
        cg[0][8] = CAND(0, 8);
        cg[0][9] = CAND(0, 9);
        cg[0][10] = CAND(0, 10);
        cg[0][11] = CAND(0, 11);
        cg[0][12] = CAND(0, 12);
        cg[0][13] = CAND(0, 13);
        cg[0][14] = CAND(0, 14);
        cg[0][15] = CAND(0, 15);
        cg[1][0] = CAND(1, 0);
        cg[1][1] = CAND(1, 1);
        cg[1][2] = CAND(1, 2);
        cg[1][3] = CAND(1, 3);
        cg[1][4] = CAND(1, 4);
        cg[1][5] = CAND(1, 5);
        cg[1][6] = CAND(1, 6);
        cg[1][7] = CAND(1, 7);
        cg[1][8] = CAND(2, 0);
        cg[1][9] = CAND(2, 1);
        cg[1][10] = CAND(2, 2);
        cg[1][11] = CAND(2, 3);
        cg[1][12] = CAND(2, 4);
        cg[1][13] = CAND(3, 0);
        cg[1][14] = CAND(3, 1);
        cg[1][15] = CAND(3, 2);
        cg[2][0] = CAND(3, 3);
        cg[2][1] = CAND(4, 0);
        cg[2][2] = CAND(4, 1);
        cg[2][3] = CAND(4, 2);
        cg[2][4] = CAND(5, 0);
        cg[2][5] = CAND(5, 1);
        cg[2][6] = CAND(6, 0);
        cg[2][7] = CAND(6, 1);
        cg[2][8] = CAND(7, 0);
        cg[2][9] = CAND(7, 1);
        cg[2][10] = CAND(8, 0);
        cg[2][11] = CAND(9, 0);
        cg[2][12] = CAND(10, 0);
        cg[2][13] = CAND(11, 0);
        cg[2][14] = CAND(12, 0);
        cg[2][15] = CAND(13, 0);
        cg[3][0] = CAND(14, 0);
        cg[3][1] = CAND(15, 0);
#undef CAND
        sort16_desc(cg[0]); sort16_desc(cg[1]); sort16_desc(cg[2]); sort16_desc(cg[3]);
        merge_top16(cg[0], cg[1]); merge_top16(cg[2], cg[3]); merge_top16(cg[0], cg[2]);
        float es = 0.f, e[16];
        const float top = __builtin_bit_cast(float, __builtin_bit_cast(unsigned, cg[0][0]) & ~0xFFu);
#pragma unroll
        for (int k = 0; k < 16; ++k) { e[k] = __expf(__builtin_bit_cast(float, __builtin_bit_cast(unsigned, cg[0][k]) & ~0xFFu) - top); es += e[k]; }
        const float inv = 1.0f / es;
        LDS_WAIT();
        unsigned id[8]; float gt[8];
#pragma unroll
        for (int k = 0; k < 8; ++k) { const float clo_ = cg[0][k], chi_ = cg[0][8 + k], elo_ = e[k], ehi_ = e[8 + k]; const unsigned code = __builtin_bit_cast(unsigned, h ? chi_ : clo_) & 0xFFu; gt[k] = (h ? ehi_ : elo_) * inv;
            id[k] = (unsigned)slot[code >> 4] * 128u + (unsigned)slot[16 + (code & 15u)]; }
        LDS_WAIT();
        LAS v4u* ip = (LAS v4u*)(idxl + R * 16 + 8 * h); LAS f32x4* gp = (LAS f32x4*)(gatel + R * 16 + 8 * h);
#if !TOPK_DBG_GATES_ONLY
        { v4u a; a.x = id[0]; a.y = id[1]; a.z = id[2]; a.w = id[3]; ip[0] = a; v4u b; b.x = id[4]; b.y = id[5]; b.z = id[6]; b.w = id[7]; ip[1] = b; }
#else
        (void)ip;
#endif
        { f32x4 a; a[0] = gt[0]; a[1] = gt[1]; a[2] = gt[2]; a[3] = gt[3]; gp[0] = a; f32x4 b; b[0] = gt[4]; b[1] = gt[5]; b[2] = gt[6]; b[3] = gt[7]; gp[1] = b; }
    }
}

__device__ __forceinline__ void peer_topk_unit(const Ptrs& P, const LAS bf16* k1l, const LAS bf16* k2l, LAS int* idxl, LAS float* gatel, int unit, int tid) {
    const int tl = tid >> 3, h = tid & 7;
    const bf16* qrow = P.QP + (size_t)(unit * 64 + tl) * 2048 + h * 256;
    float v1[16], v2[16];
    topk_half(qrow, k1l, v1);
    topk_half(qrow + 128, k2l, v2);
    int bad4 = 0;
#if TOPK_DBG_COMPARE == 4
    { const LAS unsigned char* sl = (const LAS unsigned char*)idxl + 65536 + tid * 8;
#pragma unroll
      for (int k = 0; k < 4; ++k) {
          if (TOPK_DBG_SEL != 2 && (unsigned)sl[k] != (__builtin_bit_cast(unsigned, v1[TOPK_DBG_K0 + k]) & 0x7Fu)) bad4 = 1;
          if (TOPK_DBG_SEL != 1 && (unsigned)sl[4 + k] != (__builtin_bit_cast(unsigned, v2[TOPK_DBG_K0 + k]) & 0x7Fu)) bad4 = 1; }
      LDS_WAIT(); }
#endif
#if TOPK_DBG_COMPARE >= 6
    { const LAS unsigned char* sl = (const LAS unsigned char*)idxl + 65536 + tid * 8;
      const unsigned a1 = __builtin_bit_cast(unsigned, v1[0]) & 0x7Fu, a2 = __builtin_bit_cast(unsigned, v2[0]) & 0x7Fu;
      if (TOPK_DBG_SEL != 2 && a1 != (unsigned)sl[0] && a1 != (unsigned)sl[4]) bad4 = 1;
      if (TOPK_DBG_SEL != 1 && a2 != (unsigned)sl[2] && a2 != (unsigned)sl[6]) bad4 = 1;
      LDS_WAIT(); }
#endif
    (void)bad4;
    float tv[16]; int tp[16];
#pragma unroll
    for (int k = 0; k < 16; ++k) { tv[k] = -INFINITY; tp[k] = 0; }
#pragma unroll
    for (int i = 0; i < 16; ++i)
#pragma unroll
        for (int j = 0; j < 16; ++j)
            if ((i + 1) * (j + 1) <= 16) {
                const unsigned b1 = __builtin_bit_cast(unsigned, v1[i]), b2 = __builtin_bit_cast(unsigned, v2[j]);
                float x = __builtin_bit_cast(float, b1 & ~0x7Fu) + __builtin_bit_cast(float, b2 & ~0x7Fu);
                int px = (int)((b1 & 0x7Fu) * 128u + (b2 & 0x7Fu));
#pragma unroll
                for (int k = 0; k < 16; ++k) { const bool c = x > tv[k]; const float nv = c ? x : tv[k], nx = c ? tv[k] : x; const int np = c ? px : tp[k], npx = c ? tp[k] : px; tv[k] = nv; x = nx; tp[k] = np; px = npx; }
            }
    float e[16], es = 0.f;
#pragma unroll
    for (int k = 0; k < 16; ++k) { e[k] = __expf(tv[k] - tv[0]); es += e[k]; }
    const float inv = 1.0f / es;
    LAS v4u* ip = (LAS v4u*)(idxl + tl * 128 + h * 16); LAS f32x4* gp = (LAS f32x4*)(gatel + tl * 128 + h * 16);
#if TOPK_DBG_COMPARE
    { int bad = bad4; unsigned hs_old = 0, hs_new = 0, hx_old = 0, hx_new = 0;
#pragma unroll
      for (int k = 0; k < 16; ++k) { const int ni = idxl[tl * 128 + h * 16 + k]; const float ng = gatel[tl * 128 + h * 16 + k];
          hs_old += (unsigned)tp[k]; hs_new += (unsigned)ni; hx_old ^= (unsigned)tp[k] * 2654435761u; hx_new ^= (unsigned)ni * 2654435761u;
          if (TOPK_DBG_COMPARE == 1 && (k >= TOPK_DBG_K0 && k < TOPK_DBG_K1) && ni != tp[k]) bad = 1;
          if (TOPK_DBG_COMPARE == 3 && (k >= TOPK_DBG_K0 && k < TOPK_DBG_K1) && fabsf(ng - e[k] * inv) > 2e-3f) bad = 1; }
      if (TOPK_DBG_COMPARE == 2 && (hs_old != hs_new || hx_old != hx_new)) bad = 1;
      ((LAS int*)((LAS unsigned char*)idxl + 65536 + 4096))[tid] = bad; }
#endif
#pragma unroll
    for (int k = 0; k < 4; ++k) { v4u iv; iv.x = (unsigned)tp[4 * k]; iv.y = (unsigned)tp[4 * k + 1]; iv.z = (unsigned)tp[4 * k + 2]; iv.w = (unsigned)tp[4 * k + 3]; ip[k] = iv;
        f32x4 gv; gv[0] = e[4 * k] * inv; gv[1] = e[4 * k + 1] * inv; gv[2] = e[4 * k + 2] * inv; gv[3] = e[4 * k + 3] * inv; gp[k] = gv; }
}

#if PEER_FP8
typedef float f32x2p __attribute__((ext_vector_type(2)));
__device__ __forceinline__ unsigned fp8lo_bf16(unsigned w) { return __builtin_bit_cast(unsigned, __builtin_amdgcn_cvt_scalef32_pk_bf16_fp8((int)w, 1.0f, false)); }
__device__ __forceinline__ unsigned fp8hi_bf16(unsigned w) { return __builtin_bit_cast(unsigned, __builtin_amdgcn_cvt_scalef32_pk_bf16_fp8((int)w, 1.0f, true)); }
template <bool STORE> __device__ __forceinline__ void peer_gather_token(const Ptrs& P, const LAS int* idxl, const LAS float* gatel, LAS float* al, int tl, size_t t, int lane, int wave) {
    asm volatile("" : "+v"(lane));
    const int sub = lane & 15, grp = lane >> 4;
    v4u hnr[4][2];
#pragma unroll
    for (int j = 0; j < 4; ++j) { const v4u* hp = (const v4u*)(P.HN2 + t * 1024 + (j * 16 + sub) * 16); hnr[j][0] = hp[0]; hnr[j][1] = hp[1]; }
    const LAS int* myidx = idxl + tl * 128;
    v4u w[4][4]; float sc[4];
#define ULOAD(B, Q) do { const int row_ = myidx[4 * (Q) + grp]; const v4u* up_ = (const v4u*)(P.U8 + (size_t)row_ * 1024) + sub; \
        _Pragma("unroll") for (int j = 0; j < 4; ++j) w[B][j] = up_[j * 16]; sc[B] = P.USC[row_]; } while (0)
#define UCOMP(B, Q) do { float a0 = 0.f, a1 = 0.f, a2 = 0.f, a3 = 0.f; \
        _Pragma("unroll") for (int j = 0; j < 4; ++j) { const v4u x_ = w[B][j]; \
            a0 = dot2bf(fp8lo_bf16(x_.x), hnr[j][0].x, a0); a1 = dot2bf(fp8hi_bf16(x_.x), hnr[j][0].y, a1); a2 = dot2bf(fp8lo_bf16(x_.y), hnr[j][0].z, a2); a3 = dot2bf(fp8hi_bf16(x_.y), hnr[j][0].w, a3); \
            a0 = dot2bf(fp8lo_bf16(x_.z), hnr[j][1].x, a0); a1 = dot2bf(fp8hi_bf16(x_.z), hnr[j][1].y, a1); a2 = dot2bf(fp8lo_bf16(x_.w), hnr[j][1].z, a2); a3 = dot2bf(fp8hi_bf16(x_.w), hnr[j][1].w, a3); } \
        float acc_ = row16_sum((a0 + a1) + (a2 + a3)); \
        if (sub == 0) al[wave * 128 + 4 * (Q) + grp] = acc_ * sc[B]; } while (0)
    ULOAD(0, 0); ULOAD(1, 1); ULOAD(2, 2);
#pragma unroll 1
    for (int q = 0; q < 32; q += 4) {
        ULOAD(3, q + 3); UCOMP(0, q);
        if (q + 4 < 32) ULOAD(0, q + 4);
        UCOMP(1, q + 1);
        if (q + 4 < 32) ULOAD(1, q + 5);
        UCOMP(2, q + 2);
        if (q + 4 < 32) ULOAD(2, q + 6);
        UCOMP(3, q + 3);
    }
#undef ULOAD
#undef UCOMP
    LDS_WAIT();
    const int ix0 = myidx[lane], ix1 = myidx[64 + lane];
    const float av0 = al[wave * 128 + lane], av1 = al[wave * 128 + 64 + lane];
    const float act0 = gelu_tanh(av0) * gatel[tl * 128 + lane] * P.VSC[ix0], act1 = gelu_tanh(av1) * gatel[tl * 128 + 64 + lane] * P.VSC[ix1];
    LDS_WAIT();
    float y[16];
#pragma unroll
    for (int k = 0; k < 16; ++k) y[k] = 0.f;
    v4u vb[2][8];
#define VLOAD(B, IX, E0) do { _Pragma("unroll") for (int k = 0; k < 8; ++k) { const int row_ = __builtin_amdgcn_readlane(IX, (E0) + k); vb[B][k] = *((const v4u*)(P.V8 + (size_t)row_ * 1024) + lane); } } while (0)
#define VCOMP(B, ACT, E0) do { _Pragma("unroll") for (int k = 0; k < 8; ++k) { const float a_ = __builtin_bit_cast(float, __builtin_amdgcn_readlane(__builtin_bit_cast(int, ACT), (E0) + k)); const v4u x_ = vb[B][k]; \
        f32x2p d_; d_ = __builtin_amdgcn_cvt_pk_f32_fp8((int)x_.x, false); y[0] += a_ * d_[0]; y[1] += a_ * d_[1]; d_ = __builtin_amdgcn_cvt_pk_f32_fp8((int)x_.x, true); y[2] += a_ * d_[0]; y[3] += a_ * d_[1]; \
        d_ = __builtin_amdgcn_cvt_pk_f32_fp8((int)x_.y, false); y[4] += a_ * d_[0]; y[5] += a_ * d_[1]; d_ = __builtin_amdgcn_cvt_pk_f32_fp8((int)x_.y, true); y[6] += a_ * d_[0]; y[7] += a_ * d_[1]; \
        d_ = __builtin_amdgcn_cvt_pk_f32_fp8((int)x_.z, false); y[8] += a_ * d_[0]; y[9] += a_ * d_[1]; d_ = __builtin_amdgcn_cvt_pk_f32_fp8((int)x_.z, true); y[10] += a_ * d_[0]; y[11] += a_ * d_[1]; \
        d_ = __builtin_amdgcn_cvt_pk_f32_fp8((int)x_.w, false); y[12] += a_ * d_[0]; y[13] += a_ * d_[1]; d_ = __builtin_amdgcn_cvt_pk_f32_fp8((int)x_.w, true); y[14] += a_ * d_[0]; y[15] += a_ * d_[1]; } } while (0)
    VLOAD(0, ix0, 0);
#pragma unroll 1
    for (int e = 0; e < 64; e += 16) { VLOAD(1, ix0, e + 8); VCOMP(0, act0, e); if (e + 16 < 64) VLOAD(0, ix0, e + 16); else VLOAD(0, ix1, 0); VCOMP(1, act0, e + 8); }
#pragma unroll 1
    for (int e = 0; e < 64; e += 16) { VLOAD(1, ix1, e + 8); VCOMP(0, act1, e); if (e + 16 < 64) VLOAD(0, ix1, e + 16); VCOMP(1, act1, e + 8); }
#undef VLOAD
#undef VCOMP
    float* xr = P.out + t * 1024 + lane * 16;
    f32x4 x[4];
#pragma unroll
    for (int k = 0; k < 4; ++k) { x[k] = *(const f32x4*)(xr + 4 * k); x[k][0] += y[4 * k]; x[k][1] += y[4 * k + 1]; x[k][2] += y[4 * k + 2]; x[k][3] += y[4 * k + 3]; }
    float ss = 0.f;
#pragma unroll
    for (int k = 0; k < 4; ++k) ss += (x[k][0] * x[k][0] + x[k][1] * x[k][1]) + (x[k][2] * x[k][2] + x[k][3] * x[k][3]);
    const float rstd = 1.0f / sqrtf(wave_sum(ss) * (1.0f / 1024.0f) + EPS);
    if (STORE) {
#if TOPK_DBG_COMPARE
        { const LAS int* fl = (const LAS int*)((const LAS unsigned char*)idxl + 65536 + 4096) + tl * 8; int bad = 0;
#pragma unroll
          for (int hh = 0; hh < 8; ++hh) bad |= fl[hh];
          if (bad) {
#pragma unroll
              for (int k = 0; k < 4; ++k) x[k] = x[k] * 0.f; } }
#endif
#pragma unroll
        for (int k = 0; k < 4; ++k) { const f32x4 wv = *(const f32x4*)(P.fin_w + lane * 16 + 4 * k); *(f32x4*)(xr + 4 * k) = x[k] * rstd * wv; }
    } else { asm volatile("" :: "v"(rstd), "v"(x[0][0]), "v"(x[1][1]), "v"(x[2][2]), "v"(x[3][3])); }
}
#else
template <bool STORE> __device__ __forceinline__ void peer_gather_token(const Ptrs& P, const LAS int* idxl, const LAS float* gatel, LAS float* al, int tl, size_t t, int lane, int wave) {
    const int sub = lane & 15, grp = lane >> 4;
    v4u hnr[8];
#pragma unroll
    for (int j = 0; j < 8; ++j) hnr[j] = *((const v4u*)(P.HN2 + t * 1024) + j * 16 + sub);
    for (int q = 0; q < 32; ++q) {
        const int row = idxl[tl * 128 + 4 * q + grp];
        const v4u* up = (const v4u*)(P.U + (size_t)row * 1024) + sub;
        float a0 = 0.f, a1 = 0.f, a2 = 0.f, a3 = 0.f;
#pragma unroll
        for (int j = 0; j < 8; ++j) { const v4u w = up[j * 16]; a0 = dot2bf(w.x, hnr[j].x, a0); a1 = dot2bf(w.y, hnr[j].y, a1); a2 = dot2bf(w.z, hnr[j].z, a2); a3 = dot2bf(w.w, hnr[j].w, a3); }
        float acc = (a0 + a1) + (a2 + a3);
        acc += __shfl_xor(acc, 8); acc += __shfl_xor(acc, 4); acc += __shfl_xor(acc, 2); acc += __shfl_xor(acc, 1);
        if (sub == 0) al[wave * 128 + 4 * q + grp] = acc;
    }
    LDS_WAIT();
    const float av0 = al[wave * 128 + lane], av1 = al[wave * 128 + 64 + lane];
    const float act0 = gelu_tanh(av0) * gatel[tl * 128 + lane], act1 = gelu_tanh(av1) * gatel[tl * 128 + 64 + lane];
    const int ix0 = idxl[tl * 128 + lane], ix1 = idxl[tl * 128 + 64 + lane];
    LDS_WAIT();
    float y[16];
#pragma unroll
    for (int k = 0; k < 16; ++k) y[k] = 0.f;
#pragma unroll 4
    for (int e = 0; e < 64; ++e) {
        const int row = __builtin_amdgcn_readlane(ix0, e); const float a = __builtin_bit_cast(float, __builtin_amdgcn_readlane(__builtin_bit_cast(int, act0), e));
        const v4u* vp = (const v4u*)(P.V + (size_t)row * 1024) + lane; const v4u w0 = vp[0], w1 = vp[64];
        y[0] += a * bflo(w0.x); y[1] += a * bfhi(w0.x); y[2] += a * bflo(w0.y); y[3] += a * bfhi(w0.y); y[4] += a * bflo(w0.z); y[5] += a * bfhi(w0.z); y[6] += a * bflo(w0.w); y[7] += a * bfhi(w0.w);
        y[8] += a * bflo(w1.x); y[9] += a * bfhi(w1.x); y[10] += a * bflo(w1.y); y[11] += a * bfhi(w1.y); y[12] += a * bflo(w1.z); y[13] += a * bfhi(w1.z); y[14] += a * bflo(w1.w); y[15] += a * bfhi(w1.w);
    }
#pragma unroll 4
    for (int e = 0; e < 64; ++e) {
        const int row = __builtin_amdgcn_readlane(ix1, e); const float a = __builtin_bit_cast(float, __builtin_amdgcn_readlane(__builtin_bit_cast(int, act1), e));
        const v4u* vp = (const v4u*)(P.V + (size_t)row * 1024) + lane; const v4u w0 = vp[0], w1 = vp[64];
        y[0] += a * bflo(w0.x); y[1] += a * bfhi(w0.x); y[2] += a * bflo(w0.y); y[3] += a * bfhi(w0.y); y[4] += a * bflo(w0.z); y[5] += a * bfhi(w0.z); y[6] += a * bflo(w0.w); y[7] += a * bfhi(w0.w);
        y[8] += a * bflo(w1.x); y[9] += a * bfhi(w1.x); y[10] += a * bflo(w1.y); y[11] += a * bfhi(w1.y); y[12] += a * bflo(w1.z); y[13] += a * bfhi(w1.z); y[14] += a * bflo(w1.w); y[15] += a * bfhi(w1.w);
    }
    float* xr = P.out + t * 1024;
    f32x4 x0 = *(const f32x4*)(xr + lane * 8), x1 = *(const f32x4*)(xr + lane * 8 + 4), x2 = *(const f32x4*)(xr + 512 + lane * 8), x3 = *(const f32x4*)(xr + 512 + lane * 8 + 4);
    x0[0] += y[0]; x0[1] += y[1]; x0[2] += y[2]; x0[3] += y[3]; x1[0] += y[4]; x1[1] += y[5]; x1[2] += y[6]; x1[3] += y[7];
    x2[0] += y[8]; x2[1] += y[9]; x2[2] += y[10]; x2[3] += y[11]; x3[0] += y[12]; x3[1] += y[13]; x3[2] += y[14]; x3[3] += y[15];
    float ss = 0.f;
#pragma unroll
    for (int k = 0; k < 4; ++k) ss += x0[k] * x0[k] + x1[k] * x1[k] + x2[k] * x2[k] + x3[k] * x3[k];
    const float rstd = 1.0f / sqrtf(wave_sum(ss) * (1.0f / 1024.0f) + EPS);
    if (STORE) {
        const f32x4 w0 = *(const f32x4*)(P.fin_w + lane * 8), w1 = *(const f32x4*)(P.fin_w + lane * 8 + 4), w2 = *(const f32x4*)(P.fin_w + 512 + lane * 8), w3 = *(const f32x4*)(P.fin_w + 512 + lane * 8 + 4);
        *(f32x4*)(xr + lane * 8) = x0 * rstd * w0; *(f32x4*)(xr + lane * 8 + 4) = x1 * rstd * w1; *(f32x4*)(xr + 512 + lane * 8) = x2 * rstd * w2; *(f32x4*)(xr + 512 + lane * 8 + 4) = x3 * rstd * w3;
    } else { asm volatile("" :: "v"(rstd), "v"(x0[0]), "v"(x1[1]), "v"(x2[2]), "v"(x3[3])); }
}
#endif

__device__ __forceinline__ void peer_u_token(const Ptrs& P, const LAS int* idxl, LAS float* gatel, LAS float* al, int tl, size_t t, int lane, int wave) {
    asm volatile("" : "+v"(lane));
    const int sub = lane & 15, grp = lane >> 4;
    v4u hnr[4][2];
#pragma unroll
    for (int j = 0; j < 4; ++j) { const v4u* hp = (const v4u*)(P.HN2 + t * 1024 + (j * 16 + sub) * 16); hnr[j][0] = hp[0]; hnr[j][1] = hp[1]; }
    const LAS int* myidx = idxl + tl * 128;
    v4u w[4][4]; float sc[4];
#define ULOAD(B, Q) do { const int row_ = myidx[4 * (Q) + grp]; const v4u* up_ = (const v4u*)(P.U8 + (size_t)row_ * 1024) + sub; \
        _Pragma("unroll") for (int j = 0; j < 4; ++j) w[B][j] = up_[j * 16]; sc[B] = P.USC[row_]; } while (0)
#define UCOMP(B, Q) do { float a0 = 0.f, a1 = 0.f, a2 = 0.f, a3 = 0.f; \
        _Pragma("unroll") for (int j = 0; j < 4; ++j) { const v4u x_ = w[B][j]; \
            a0 = dot2bf(fp8lo_bf16(x_.x), hnr[j][0].x, a0); a1 = dot2bf(fp8hi_bf16(x_.x), hnr[j][0].y, a1); a2 = dot2bf(fp8lo_bf16(x_.y), hnr[j][0].z, a2); a3 = dot2bf(fp8hi_bf16(x_.y), hnr[j][0].w, a3); \
            a0 = dot2bf(fp8lo_bf16(x_.z), hnr[j][1].x, a0); a1 = dot2bf(fp8hi_bf16(x_.z), hnr[j][1].y, a1); a2 = dot2bf(fp8lo_bf16(x_.w), hnr[j][1].z, a2); a3 = dot2bf(fp8hi_bf16(x_.w), hnr[j][1].w, a3); } \
        float acc_ = row16_sum((a0 + a1) + (a2 + a3)); \
        if (sub == 0) al[wave * 128 + 4 * (Q) + grp] = acc_ * sc[B]; } while (0)
    ULOAD(0, 0); ULOAD(1, 1); ULOAD(2, 2);
#pragma unroll 1
    for (int q = 0; q < 32; q += 4) {
        ULOAD(3, q + 3); UCOMP(0, q);
        if (q + 4 < 32) ULOAD(0, q + 4);
        UCOMP(1, q + 1);
        if (q + 4 < 32) ULOAD(1, q + 5);
        UCOMP(2, q + 2);
        if (q + 4 < 32) ULOAD(2, q + 6);
        UCOMP(3, q + 3);
    }
#undef ULOAD
#undef UCOMP
    LDS_WAIT();
    const int ix0 = myidx[lane], ix1 = myidx[64 + lane];
    const float av0 = al[wave * 128 + lane], av1 = al[wave * 128 + 64 + lane];
    const float act0 = gelu_tanh(av0) * gatel[tl * 128 + lane] * P.VSC[ix0], act1 = gelu_tanh(av1) * gatel[tl * 128 + 64 + lane] * P.VSC[ix1];
    gatel[tl * 128 + lane] = act0; gatel[tl * 128 + 64 + lane] = act1;
    LDS_WAIT();
}

#if PEER_FP8
#define PK8(OUT, X) do { OUT[0] = __builtin_amdgcn_cvt_pk_f32_fp8((int)(X).x, false); OUT[1] = __builtin_amdgcn_cvt_pk_f32_fp8((int)(X).x, true); OUT[2] = __builtin_amdgcn_cvt_pk_f32_fp8((int)(X).y, false); OUT[3] = __builtin_amdgcn_cvt_pk_f32_fp8((int)(X).y, true); \
        OUT[4] = __builtin_amdgcn_cvt_pk_f32_fp8((int)(X).z, false); OUT[5] = __builtin_amdgcn_cvt_pk_f32_fp8((int)(X).z, true); OUT[6] = __builtin_amdgcn_cvt_pk_f32_fp8((int)(X).w, false); OUT[7] = __builtin_amdgcn_cvt_pk_f32_fp8((int)(X).w, true); } while (0)
#define ROW_ISSUE(BUF, TAB, W) do { const unsigned char* rp_ = (TAB) + (size_t)((W) & rowand) * 1024; asm volatile("s_nop 4\n\tglobal_load_dwordx4 %0, %1, %2" : "=v"(BUF) : "v"(loff), "s"(rp_) : "memory"); } while (0)
#define ML(d) (16 * ((((d) & 3) == 1) ? 2 : (((d) & 3) == 2) ? 1 : ((d) & 3)) + ((d) >> 2))
__device__ __forceinline__ void peer_gather_sorted(const Ptrs& P, LAS unsigned char* lds, int unit, int lane, int wave) {
    asm volatile("" : "+v"(lane));
    const size_t t0 = (size_t)unit * 64 + wave * 8;
#pragma unroll 1
    for (int gq = 0; gq < 2; ++gq) {
        int lq = lane; asm volatile("" : "+v"(lq));
        const unsigned loff = (unsigned)lq * 16u;
        LAS int* idxl = (LAS int*)(lds + 65536) + wave * 1024 + gq * 512;
        const LAS float* gatel = (const LAS float*)(lds + 98304) + wave * 1024 + gq * 512;
        LAS v2u* sortl = (LAS v2u*)lds + wave * 1024 + gq * 512;
        LAS float* uscl = (LAS float*)idxl;
        LAS int* startl = (LAS int*)(lds + 131072 + 4096) + wave * 64;
        {
            int ent[8]; float gv[8], us[8];
#pragma unroll
            for (int j = 0; j < 8; ++j) { ent[j] = idxl[(j >> 1) * 128 + (j & 1) * 64 + lq]; gv[j] = gatel[(j >> 1) * 128 + (j & 1) * 64 + lq]; }
#pragma unroll
            for (int j = 0; j < 8; ++j) { us[j] = P.USC[ent[j]]; gv[j] *= P.VSC[ent[j]]; }
            LDS_WAIT();
            int rk[8]; int run[NSL];
#pragma unroll
            for (int b = 0; b < NSL; ++b) run[b] = 0;
#pragma unroll
            for (int j = 0; j < 8; ++j) { const int bj = ent[j] >> SLSH; int r = 0;
#pragma unroll
                for (int b = 0; b < NSL; ++b) { const unsigned long long m = __ballot(bj == b);
                    const int below = (int)__builtin_amdgcn_mbcnt_hi((unsigned)(m >> 32), __builtin_amdgcn_mbcnt_lo((unsigned)m, 0u));
                    r = (bj == b) ? run[b] + below : r; run[b] += (int)__builtin_popcountll(m); }
                rk[j] = r; }
            { int st = 0;
#pragma unroll
              for (int b = 0; b < NSL; ++b) { if (lq == b) startl[b] = st; st += run[b]; } }
            LDS_WAIT();
#pragma unroll
            for (int j = 0; j < 8; ++j) { const int pos = startl[ent[j] >> SLSH] + rk[j]; v2u rec; rec.x = (unsigned)ent[j] | ((unsigned)(j >> 1) << 14); rec.y = __builtin_bit_cast(unsigned, gv[j]); sortl[pos] = rec; uscl[pos] = us[j]; }
            LDS_WAIT();
        }
        if (SWEEP_SYNC) __syncthreads();
#if U_MFMA
        {
            const int n = lq & 15, kg = lq >> 4;
            v2u hb[32];
            { const unsigned char* hp = P.HN8 + (t0 + gq * 4 + (n & 3)) * 1024 + 8 * kg;
#pragma unroll
              for (int ks = 0; ks < 32; ++ks) { v2u v = *(const v2u*)(hp + 32 * ks); if (n >= 4) { v.x = 0u; v.y = 0u; } hb[ks] = v; } }
            LAS float* xl = (LAS float*)(lds + 131072) + wave * 128;
            if (lq < 4) xl[64 + lq] = P.HSC[t0 + gq * 4 + lq];
            v4u ua[16], ub[16];
            unsigned mw_a, mw_b; float mg_a, mg_b, mu_a, mu_b;
#define UM_META(i0, W, G, U) do { const v2u e_ = sortl[(i0) + n]; W = e_.x; const unsigned g_ = e_.y; G = __builtin_bit_cast(float, g_); U = uscl[(i0) + n]; } while (0)
#define UM_LOAD(BUF, W) do { const unsigned char* rp_ = P.U8 + (size_t)((W) & umask) * 1024 + 16 * kg; \
        _Pragma("unroll") for (int m = 0; m < 16; ++m) BUF[m] = *(const v4u*)(rp_ + 64 * m); } while (0)
#define UM_COMP(BUF, W, G, U, i0) do { f32x4 acc = {0.f, 0.f, 0.f, 0.f}; \
        _Pragma("unroll") for (int m = 0; m < 16; ++m) { \
            const long a0_ = (long)(((unsigned long long)BUF[m].y << 32) | BUF[m].x), a1_ = (long)(((unsigned long long)BUF[m].w << 32) | BUF[m].z); \
            const long b0_ = (long)(((unsigned long long)hb[2 * m].y << 32) | hb[2 * m].x), b1_ = (long)(((unsigned long long)hb[2 * m + 1].y << 32) | hb[2 * m + 1].x); \
            acc = __builtin_amdgcn_mfma_f32_16x16x32_fp8_fp8(a0_, b0_, acc, 0, 0, 0); acc = __builtin_amdgcn_mfma_f32_16x16x32_fp8_fp8(a1_, b1_, acc, 0, 0, 0); } \
        if (n < 4) { xl[(4 * kg + 0) * 4 + n] = acc[0]; xl[(4 * kg + 1) * 4 + n] = acc[1]; xl[(4 * kg + 2) * 4 + n] = acc[2]; xl[(4 * kg + 3) * 4 + n] = acc[3]; } \
        LDS_WAIT(); \
        { const unsigned tok_ = ((W) >> 14) & 3u; const float a_ = xl[n * 4 + tok_] * (U) * xl[64 + tok_]; const float act_ = gelu_tanh(a_) * (G); \
          if (lq < 16 && pass + 1 == PROBE_U_PASSES) sortl[(i0) + n].y = __builtin_bit_cast(unsigned, act_); asm volatile("" :: "v"(act_)); } \
        LDS_WAIT(); } while (0)
            LDS_WAIT();
#pragma unroll 1
            for (int pass = 0; pass < PROBE_U_PASSES; ++pass) {
            const unsigned umask = (pass + 1 < PROBE_U_PASSES) ? 63u : 16383u;
            UM_META(0, mw_a, mg_a, mu_a); UM_LOAD(ua, mw_a);
#pragma unroll 1
            for (int i0 = 0; i0 < 512; i0 += 32) {
                UM_META(i0 + 16, mw_b, mg_b, mu_b); UM_LOAD(ub, mw_b);
                UM_COMP(ua, mw_a, mg_a, mu_a, i0);
                if (i0 + 32 < 512) { UM_META(i0 + 32, mw_a, mg_a, mu_a); UM_LOAD(ua, mw_a); }
                UM_COMP(ub, mw_b, mg_b, mu_b, i0 + 16);
            }
            }
#undef UM_META
#undef UM_LOAD
#undef UM_COMP
        }
        LDS_WAIT();
        if (SWEEP_SYNC) __syncthreads();
#else
        {
#if U_INT8
            int hf[4][4];
            float hsc[4];
#if P5_ELIM
            { f32x4 wn[4];
#pragma unroll
              for (int k = 0; k < 4; ++k) wn[k] = *(const f32x4*)(P.ffn_w + loff + 4 * k);
#pragma unroll
              for (int tk = 0; tk < 4; ++tk) { const size_t row = t0 + gq * 4 + tk; const float* xr = P.out + row * 1024 + loff;
                  const f32x4* sp_ = (const f32x4*)(P.rowss + row * 16); const f32x4* ap_ = (const f32x4*)(P.rowamax + row * 16);
                  const f32x4 sq_ = (sp_[0] + sp_[1]) + (sp_[2] + sp_[3]); const f32x4 a0_ = ap_[0], a1_ = ap_[1], a2_ = ap_[2], a3_ = ap_[3];
                  float am = 0.f;
#pragma unroll
                  for (int k = 0; k < 4; ++k) am = fmaxf(am, fmaxf(fmaxf(a0_[k], a1_[k]), fmaxf(a2_[k], a3_[k])));
                  const float qs = (am > 1e-30f) ? 127.0f / am : 0.f;
                  const float rstd = 1.0f / sqrtf(((sq_[0] + sq_[1]) + (sq_[2] + sq_[3])) * (1.0f / 1024.0f) + EPS);
                  hsc[tk] = am * rstd * (1.0f / 127.0f);
#pragma unroll
                  for (int k = 0; k < 4; ++k) { const f32x4 v = *(const f32x4*)(xr + 4 * k) * wn[k] * qs; hf[tk][k] = pack_i8x4(v[0], v[1], v[2], v[3]); } } }
#else
#pragma unroll
            for (int tk = 0; tk < 4; ++tk) { const v4u h0 = *(const v4u*)(P.HN8 + (t0 + gq * 4 + tk) * 1024 + loff); hf[tk][0] = (int)h0.x; hf[tk][1] = (int)h0.y; hf[tk][2] = (int)h0.z; hf[tk][3] = (int)h0.w; hsc[tk] = P.HSC[t0 + gq * 4 + tk]; }
#endif
#elif U_DOT2
            unsigned hf[4][8];
#pragma unroll
            for (int tk = 0; tk < 4; ++tk) { const v4u* hp = (const v4u*)((const unsigned char*)(P.HN2 + (t0 + gq * 4 + tk) * 1024) + 2u * loff); const v4u h0 = hp[0], h1 = hp[1];
                hf[tk][0] = h0.x; hf[tk][1] = h0.y; hf[tk][2] = h0.z; hf[tk][3] = h0.w; hf[tk][4] = h1.x; hf[tk][5] = h1.y; hf[tk][6] = h1.z; hf[tk][7] = h1.w; }
#else
            f32x2p hf[4][8];
#pragma unroll
            for (int tk = 0; tk < 4; ++tk) { const v4u* hp = (const v4u*)((const unsigned char*)(P.HN2 + (t0 + gq * 4 + tk) * 1024) + 2u * loff); const v4u h0 = hp[0], h1 = hp[1];
                hf[tk][0][0] = bflo(h0.x); hf[tk][0][1] = bfhi(h0.x); hf[tk][1][0] = bflo(h0.y); hf[tk][1][1] = bfhi(h0.y); hf[tk][2][0] = bflo(h0.z); hf[tk][2][1] = bfhi(h0.z); hf[tk][3][0] = bflo(h0.w); hf[tk][3][1] = bfhi(h0.w);
                hf[tk][4][0] = bflo(h1.x); hf[tk][4][1] = bfhi(h1.x); hf[tk][5][0] = bflo(h1.y); hf[tk][5][1] = bfhi(h1.y); hf[tk][6][0] = bflo(h1.z); hf[tk][6][1] = bfhi(h1.z); hf[tk][7][0] = bflo(h1.w); hf[tk][7][1] = bfhi(h1.w); }
#endif
            v4u ub[16]; float p[16];
            const int c4 = lq & 15, rho = lq >> 4;
            const int me = (c4 < 4) ? 4 * c4 + ((rho == 1) ? 2 : (rho == 2) ? 1 : rho) : 0;
            unsigned mw_c, mw_n; float mg_c, mg_n, mu_c, mu_n;
#if U_INT8
#define HSC_OF(W) ((((W) >> 14) & 3u) == 0u ? hsc[0] : (((W) >> 14) & 3u) == 1u ? hsc[1] : (((W) >> 14) & 3u) == 2u ? hsc[2] : hsc[3])
#else
#define HSC_OF(W) 1.0f
#endif
#define U_META(i0, W, G, U) do { const v2u e_ = sortl[(i0) + me]; W = e_.x; const unsigned g_ = e_.y; G = __builtin_bit_cast(float, g_); U = uscl[(i0) + me]; } while (0)
#if U_INT8
#define U_DOT(tk) asm volatile("s_cmp_lg_u32 %10, " #tk "\n\ts_cbranch_scc1 .LUSK%=\n\t" \
        "v_dot4c_i32_i8 %0, %2, %6\n\tv_dot4c_i32_i8 %1, %3, %7\n\tv_dot4c_i32_i8 %0, %4, %8\n\tv_dot4c_i32_i8 %1, %5, %9\n\ts_nop 2\n.LUSK%=:" \
        : "+v"(a0_), "+v"(a1_) : "v"(x_.x), "v"(x_.y), "v"(x_.z), "v"(x_.w), "v"(hf[tk][0]), "v"(hf[tk][1]), "v"(hf[tk][2]), "v"(hf[tk][3]), "s"(tok) : "scc")
#define U_STEP(d, CNT, ISSUE) do { asm volatile("s_waitcnt vmcnt(" #CNT ")" : "+v"(ub[d]) :: "memory"); \
        { const v4u x_ = ub[d]; \
          const unsigned tok = ((unsigned)__builtin_amdgcn_readlane((int)mw_c, ML(d)) >> 14) & 3u; \
          int a0_ = 0, a1_ = 0; \
          U_DOT(0); U_DOT(1); U_DOT(2); U_DOT(3); \
          p[d] = (float)(a0_ + a1_); } \
        if (ISSUE) ROW_ISSUE(ub[d], P.U8, (unsigned)__builtin_amdgcn_readlane((int)mw_n, ML(d))); } while (0)
#elif U_DOT2
#define U_DOT(tk) asm volatile("s_cmp_lg_u32 %20, " #tk "\n\ts_cbranch_scc1 .LUSK%=\n\t" \
        "v_dot2c_f32_bf16 %0, %4, %12\n\tv_dot2c_f32_bf16 %1, %5, %13\n\tv_dot2c_f32_bf16 %2, %6, %14\n\tv_dot2c_f32_bf16 %3, %7, %15\n\t" \
        "v_dot2c_f32_bf16 %0, %8, %16\n\tv_dot2c_f32_bf16 %1, %9, %17\n\tv_dot2c_f32_bf16 %2, %10, %18\n\tv_dot2c_f32_bf16 %3, %11, %19\n\ts_nop 2\n.LUSK%=:" \
        : "+v"(a0_), "+v"(a1_), "+v"(a2_), "+v"(a3_) \
        : "v"(dk_[0]), "v"(dk_[1]), "v"(dk_[2]), "v"(dk_[3]), "v"(dk_[4]), "v"(dk_[5]), "v"(dk_[6]), "v"(dk_[7]), \
          "v"(hf[tk][0]), "v"(hf[tk][1]), "v"(hf[tk][2]), "v"(hf[tk][3]), "v"(hf[tk][4]), "v"(hf[tk][5]), "v"(hf[tk][6]), "v"(hf[tk][7]), "s"(tok) : "scc")
#define U_STEP(d, CNT, ISSUE) do { asm volatile("s_waitcnt vmcnt(" #CNT ")" : "+v"(ub[d]) :: "memory"); \
        { const v4u x_ = ub[d]; unsigned dk_[8]; dk_[0] = fp8lo_bf16(x_.x); dk_[1] = fp8hi_bf16(x_.x); dk_[2] = fp8lo_bf16(x_.y); dk_[3] = fp8hi_bf16(x_.y); dk_[4] = fp8lo_bf16(x_.z); dk_[5] = fp8hi_bf16(x_.z); dk_[6] = fp8lo_bf16(x_.w); dk_[7] = fp8hi_bf16(x_.w); \
          const unsigned tok = ((unsigned)__builtin_amdgcn_readlane((int)mw_c, ML(d)) >> 14) & 3u; \
          float a0_ = 0.f, a1_ = 0.f, a2_ = 0.f, a3_ = 0.f; \
          U_DOT(0); U_DOT(1); U_DOT(2); U_DOT(3); \
          p[d] = (a0_ + a1_) + (a2_ + a3_); } \
        if (ISSUE) ROW_ISSUE(ub[d], P.U8, (unsigned)__builtin_amdgcn_readlane((int)mw_n, ML(d))); } while (0)
#else
#define U_DOT(tk) asm volatile("s_cmp_lg_u32 %20, " #tk "\n\ts_cbranch_scc1 .LUSK%=\n\t" \
        "v_pk_fma_f32 %0, %4, %12, %0\n\tv_pk_fma_f32 %1, %5, %13, %1\n\tv_pk_fma_f32 %2, %6, %14, %2\n\tv_pk_fma_f32 %3, %7, %15, %3\n\t" \
        "v_pk_fma_f32 %0, %8, %16, %0\n\tv_pk_fma_f32 %1, %9, %17, %1\n\tv_pk_fma_f32 %2, %10, %18, %2\n\tv_pk_fma_f32 %3, %11, %19, %3\n.LUSK%=:" \
        : "+v"(a0_), "+v"(a1_), "+v"(a2_), "+v"(a3_) \
        : "v"(dk_[0]), "v"(dk_[1]), "v"(dk_[2]), "v"(dk_[3]), "v"(dk_[4]), "v"(dk_[5]), "v"(dk_[6]), "v"(dk_[7]), \
          "v"(hf[tk][0]), "v"(hf[tk][1]), "v"(hf[tk][2]), "v"(hf[tk][3]), "v"(hf[tk][4]), "v"(hf[tk][5]), "v"(hf[tk][6]), "v"(hf[tk][7]), "s"(tok) : "scc")
#define U_STEP(d, CNT, ISSUE) do { asm volatile("s_waitcnt vmcnt(" #CNT ")" : "+v"(ub[d]) :: "memory"); \
        { const v4u x_ = ub[d]; f32x2p dk_[8]; PK8(dk_, x_); \
          const unsigned tok = ((unsigned)__builtin_amdgcn_readlane((int)mw_c, ML(d)) >> 14) & 3u; \
          f32x2p a0_, a1_, a2_, a3_; a0_[0] = 0.f; a0_[1] = 0.f; a1_ = a0_; a2_ = a0_; a3_ = a0_; \
          U_DOT(0); U_DOT(1); U_DOT(2); U_DOT(3); \
          const f32x2p s_ = (a0_ + a1_) + (a2_ + a3_); p[d] = s_[0] + s_[1]; } \
        if (ISSUE) ROW_ISSUE(ub[d], P.U8, (unsigned)__builtin_amdgcn_readlane((int)mw_n, ML(d))); } while (0)
#endif
#pragma unroll 1
            for (int pass = 0; pass < PROBE_U_PASSES; ++pass) {
            const unsigned rowand = (pass + 1 < PROBE_U_PASSES) ? PROBE_ROWAND : 16383u;
            asm volatile("s_waitcnt vmcnt(0)" ::: "memory");
            U_META(0, mw_c, mg_c, mu_c);
#define U_ISSUE0(d) ROW_ISSUE(ub[d], P.U8, (unsigned)__builtin_amdgcn_readlane((int)mw_c, ML(d)))
            U_ISSUE0(0); U_ISSUE0(1); U_ISSUE0(2); U_ISSUE0(3); U_ISSUE0(4); U_ISSUE0(5); U_ISSUE0(6); U_ISSUE0(7); U_ISSUE0(8); U_ISSUE0(9); U_ISSUE0(10); U_ISSUE0(11); U_ISSUE0(12); U_ISSUE0(13); U_ISSUE0(14); U_ISSUE0(15);
#undef U_ISSUE0
#define U_FINISH(i0) do { float q_[8], r_[4]; \
        _Pragma("unroll") for (int j = 0; j < 8; ++j) { auto rr = __builtin_amdgcn_permlane32_swap(__builtin_bit_cast(unsigned, p[2 * j]), __builtin_bit_cast(unsigned, p[2 * j + 1]), false, false); const unsigned r0 = rr[0], r1 = rr[1]; q_[j] = __builtin_bit_cast(float, r0) + __builtin_bit_cast(float, r1); } \
        _Pragma("unroll") for (int j = 0; j < 4; ++j) { auto rr = __builtin_amdgcn_permlane16_swap(__builtin_bit_cast(unsigned, q_[2 * j]), __builtin_bit_cast(unsigned, q_[2 * j + 1]), false, false); const unsigned r0 = rr[0], r1 = rr[1]; r_[j] = row16_sum(__builtin_bit_cast(float, r0) + __builtin_bit_cast(float, r1)); } \
        const float acol = (c4 == 0) ? r_[0] : (c4 == 1) ? r_[1] : (c4 == 2) ? r_[2] : r_[3]; \
        const float act = gelu_tanh(acol * mu_c * HSC_OF(mw_c)) * mg_c; \
        if (c4 < 4 && pass + 1 == PROBE_U_PASSES) sortl[(i0) + me].y = __builtin_bit_cast(unsigned, act); asm volatile("" :: "v"(act)); } while (0)
#pragma unroll 1
            for (int i0 = 0; i0 < 512 - 16; i0 += 16) {
                U_META(i0 + 16, mw_n, mg_n, mu_n);
                U_STEP(0, 15, 1); U_STEP(1, 15, 1); U_STEP(2, 15, 1); U_STEP(3, 15, 1); U_STEP(4, 15, 1); U_STEP(5, 15, 1); U_STEP(6, 15, 1); U_STEP(7, 15, 1);
                U_STEP(8, 15, 1); U_STEP(9, 15, 1); U_STEP(10, 15, 1); U_STEP(11, 15, 1); U_STEP(12, 15, 1); U_STEP(13, 15, 1); U_STEP(14, 15, 1); U_STEP(15, 15, 1);
                U_FINISH(i0);
                mw_c = mw_n; mg_c = mg_n; mu_c = mu_n;
            }
            mw_n = mw_c;
            U_STEP(0, 15, 0); U_STEP(1, 14, 0); U_STEP(2, 13, 0); U_STEP(3, 12, 0); U_STEP(4, 11, 0); U_STEP(5, 10, 0); U_STEP(6, 9, 0); U_STEP(7, 8, 0);
            U_STEP(8, 7, 0); U_STEP(9, 6, 0); U_STEP(10, 5, 0); U_STEP(11, 4, 0); U_STEP(12, 3, 0); U_STEP(13, 2, 0); U_STEP(14, 1, 0); U_STEP(15, 0, 0);
            U_FINISH(512 - 16);
            }
#undef U_FINISH
#undef U_STEP
#undef U_DOT
#undef U_META
        }
        LDS_WAIT();
        if (SWEEP_SYNC) __syncthreads();
#endif
        f32x2p y[4][8];
#pragma unroll
        for (int tk = 0; tk < 4; ++tk)
#pragma unroll
            for (int k = 0; k < 8; ++k) { y[tk][k][0] = 0.f; y[tk][k][1] = 0.f; }
        {
            v4u vb[16]; const int ml = lq & 15;
            unsigned mw_c, mw_n, ma_c, ma_n;
#define V_META(i0, W, A) do { const v2u e_ = sortl[(i0) + ml]; W = e_.x; A = e_.y; } while (0)
#define V_FMA(tk) asm volatile("s_cmp_lg_u32 %17, " #tk "\n\ts_cbranch_scc1 .LVSK%=\n\t" \
        "v_pk_fma_f32 %0, %8, %16, %0\n\tv_pk_fma_f32 %1, %9, %16, %1\n\tv_pk_fma_f32 %2, %10, %16, %2\n\tv_pk_fma_f32 %3, %11, %16, %3\n\t" \
        "v_pk_fma_f32 %4, %12, %16, %4\n\tv_pk_fma_f32 %5, %13, %16, %5\n\tv_pk_fma_f32 %6, %14, %16, %6\n\tv_pk_fma_f32 %7, %15, %16, %7\n.LVSK%=:" \
        : "+v"(y[tk][0]), "+v"(y[tk][1]), "+v"(y[tk][2]), "+v"(y[tk][3]), "+v"(y[tk][4]), "+v"(y[tk][5]), "+v"(y[tk][6]), "+v"(y[tk][7]) \
        : "v"(dk_[0]), "v"(dk_[1]), "v"(dk_[2]), "v"(dk_[3]), "v"(dk_[4]), "v"(dk_[5]), "v"(dk_[6]), "v"(dk_[7]), "v"(a2_), "s"(tok) : "scc")
#define V_NOFMA(tk) asm volatile("s_cmp_lg_u32 %17, " #tk "\n\ts_cbranch_scc1 .LVSK%=\n\ts_nop 0\n.LVSK%=:" \
        : "+v"(y[tk][0]), "+v"(y[tk][1]), "+v"(y[tk][2]), "+v"(y[tk][3]), "+v"(y[tk][4]), "+v"(y[tk][5]), "+v"(y[tk][6]), "+v"(y[tk][7]) \
        : "v"(dk_[0]), "v"(dk_[1]), "v"(dk_[2]), "v"(dk_[3]), "v"(dk_[4]), "v"(dk_[5]), "v"(dk_[6]), "v"(dk_[7]), "v"(a2_), "s"(tok) : "scc")
#define V_STEP(d, CNT, ISSUE, FM) do { asm volatile("s_waitcnt vmcnt(" #CNT ")" : "+v"(vb[d]) :: "memory"); \
        { const v4u x_ = vb[d]; f32x2p dk_[8]; PK8(dk_, x_); \
          const unsigned tok = ((unsigned)__builtin_amdgcn_readlane((int)mw_c, d) >> 14) & 3u; const float a_ = __builtin_bit_cast(float, __builtin_amdgcn_readlane((int)ma_c, d)); f32x2p a2_; a2_[0] = a_; a2_[1] = a_; \
          if (FM) { V_FMA(0); V_FMA(1); V_FMA(2); V_FMA(3); } else { V_NOFMA(0); V_NOFMA(1); V_NOFMA(2); V_NOFMA(3); } } \
        if (ISSUE) ROW_ISSUE(vb[d], P.V8, (unsigned)__builtin_amdgcn_readlane((int)mw_n, d)); } while (0)
#pragma unroll 1
            for (int pass = 0; pass < PROBE_V_PASSES; ++pass) {
            const unsigned rowand = (pass + 1 < PROBE_V_PASSES) ? PROBE_ROWAND : 16383u;
#define V_BODY(FM) do { \
            asm volatile("s_waitcnt vmcnt(0)" ::: "memory"); \
            V_META(0, mw_c, ma_c); \
            V_ISSUE0(0); V_ISSUE0(1); V_ISSUE0(2); V_ISSUE0(3); V_ISSUE0(4); V_ISSUE0(5); V_ISSUE0(6); V_ISSUE0(7); V_ISSUE0(8); V_ISSUE0(9); V_ISSUE0(10); V_ISSUE0(11); V_ISSUE0(12); V_ISSUE0(13); V_ISSUE0(14); V_ISSUE0(15); \
            _Pragma("unroll 1") for (int i0 = 0; i0 < 512 - 16; i0 += 16) { \
                V_META(i0 + 16, mw_n, ma_n); \
                V_STEP(0, 15, 1, FM); V_STEP(1, 15, 1, FM); V_STEP(2, 15, 1, FM); V_STEP(3, 15, 1, FM); V_STEP(4, 15, 1, FM); V_STEP(5, 15, 1, FM); V_STEP(6, 15, 1, FM); V_STEP(7, 15, 1, FM); \
                V_STEP(8, 15, 1, FM); V_STEP(9, 15, 1, FM); V_STEP(10, 15, 1, FM); V_STEP(11, 15, 1, FM); V_STEP(12, 15, 1, FM); V_STEP(13, 15, 1, FM); V_STEP(14, 15, 1, FM); V_STEP(15, 15, 1, FM); \
                mw_c = mw_n; ma_c = ma_n; } \
            mw_n = mw_c; \
            V_STEP(0, 15, 0, FM); V_STEP(1, 14, 0, FM); V_STEP(2, 13, 0, FM); V_STEP(3, 12, 0, FM); V_STEP(4, 11, 0, FM); V_STEP(5, 10, 0, FM); V_STEP(6, 9, 0, FM); V_STEP(7, 8, 0, FM); \
            V_STEP(8, 7, 0, FM); V_STEP(9, 6, 0, FM); V_STEP(10, 5, 0, FM); V_STEP(11, 4, 0, FM); V_STEP(12, 3, 0, FM); V_STEP(13, 2, 0, FM); V_STEP(14, 1, 0, FM); V_STEP(15, 0, 0, FM); } while (0)
#define V_ISSUE0(d) ROW_ISSUE(vb[d], P.V8, (unsigned)__builtin_amdgcn_readlane((int)mw_c, d))
            if (pass + 1 < PROBE_V_PASSES) V_BODY(0); else V_BODY(1);
#undef V_ISSUE0
#undef V_BODY
            }
#undef V_STEP
#undef V_META
#undef V_FMA
#undef V_NOFMA
        }
#pragma unroll
        for (int tk = 0; tk < 4; ++tk) {
            float* xr = P.out + (t0 + gq * 4 + tk) * 1024 + loff;
            f32x4 x[4];
#pragma unroll
            for (int k = 0; k < 4; ++k) { x[k] = *(const f32x4*)(xr + 4 * k); x[k][0] += y[tk][2 * k][0]; x[k][1] += y[tk][2 * k][1]; x[k][2] += y[tk][2 * k + 1][0]; x[k][3] += y[tk][2 * k + 1][1]; }
            float ss = 0.f;
#pragma unroll
            for (int k = 0; k < 4; ++k) ss += (x[k][0] * x[k][0] + x[k][1] * x[k][1]) + (x[k][2] * x[k][2] + x[k][3] * x[k][3]);
            const float rstd = 1.0f / sqrtf(wave_sum(ss) * (1.0f / 1024.0f) + EPS);
#pragma unroll
            for (int k = 0; k < 4; ++k) { const f32x4 wv = *(const f32x4*)(P.fin_w + (loff + 4 * k)); *(f32x4*)(xr + 4 * k) = x[k] * rstd * wv; }
        }
    }
}
#undef ML
#undef ROW_ISSUE
#undef PK8
#endif

__device__ __forceinline__ void p7_peer(LAS unsigned char* lds, const Ptrs& P, int vcu, int G, int tid, int lane, int wave) {
    LAS bf16* k1l = (LAS bf16*)lds;
    LAS bf16* k2l = (LAS bf16*)(lds + 32768);
    LAS int* idxl = (LAS int*)(lds + 65536);
    LAS float* gatel = (LAS float*)(lds + 98304);
    LAS float* al = (LAS float*)(lds + 131072);
#if TOPK_MFMA && KEY_SWZ
    for (int i = tid; i < 2048; i += 512) { const int n = i >> 4, c = i & 15, d = n * 16 + (c ^ (n & 15)); ((LAS v4u*)k1l)[d] = ((const v4u*)P.K1)[i]; ((LAS v4u*)k2l)[d] = ((const v4u*)P.K2)[i]; }
#else
    for (int i = tid; i < 2048; i += 512) { ((LAS v4u*)k1l)[i] = ((const v4u*)P.K1)[i]; ((LAS v4u*)k2l)[i] = ((const v4u*)P.K2)[i]; }
#endif
    __syncthreads();
    for (int unit = vcu; unit < M / 64; unit += G) {
#if TOPK_DBG_COMPARE
        peer_topk_unit_mfma(P, (const LAS unsigned char*)k1l, (const LAS unsigned char*)k2l, idxl, gatel, unit, lane, wave);
        __syncthreads();
        peer_topk_unit(P, k1l, k2l, idxl, gatel, unit, tid);
#elif TOPK_DBG_GATES_ONLY
        peer_topk_unit(P, k1l, k2l, idxl, gatel, unit, tid);
        __syncthreads();
        peer_topk_unit_mfma(P, (const LAS unsigned char*)k1l, (const LAS unsigned char*)k2l, idxl, gatel, unit, lane, wave);
#elif TOPK_MFMA
        peer_topk_unit_mfma(P, (const LAS unsigned char*)k1l, (const LAS unsigned char*)k2l, idxl, gatel, unit, lane, wave);
#else
        peer_topk_unit(P, k1l, k2l, idxl, gatel, unit, tid);
#endif
#if PROBE_TOPK_REPS > 1
        __syncthreads();
#if TOPK_MFMA
        peer_topk_unit_mfma(P, (const LAS unsigned char*)k1l, (const LAS unsigned char*)k2l, idxl, gatel, unit, lane, wave);
#else
        peer_topk_unit(P, k1l, k2l, idxl, gatel, unit, tid);
#endif
#endif
        __syncthreads();
#if PROBE_GATHER_REPS > 1
#pragma unroll 1
        for (int i = 0; i < 8; ++i) peer_gather_token<false>(P, idxl, gatel, al, wave * 8 + i, (size_t)unit * 64 + wave * 8 + i, lane, wave);
#endif
#if GATHER_SORTED
        peer_gather_sorted(P, lds, unit, lane, wave);
#else
#pragma unroll 1
        for (int i = 0; i < 8; ++i) peer_gather_token<true>(P, idxl, gatel, al, wave * 8 + i, (size_t)unit * 64 + wave * 8 + i, lane, wave);
#endif
        __syncthreads();
    }
}

struct Args { const float* in[19]; float* out; unsigned char* ws; int ph_lo, ph_hi; };
__global__ void __launch_bounds__(NWAVES * 64, 2) mega_fwd(Args args) {
    extern __shared__ __attribute__((aligned(16))) unsigned char lds_raw[];
    LAS unsigned char* lds = (LAS unsigned char*)lds_raw;
    const int tid = threadIdx.x, lane = tid & 63, wave = __builtin_amdgcn_readfirstlane(tid >> 6);
    const int G = gridDim.x; const int bx = blockIdx.x; const int vcu = (G % 8 == 0) ? (bx % 8) * (G / 8) + bx / 8 : bx;
    unsigned char* ws = args.ws;
    Ptrs P;
    P.x = args.in[0]; P.mix_w = args.in[1]; P.w_in = args.in[2]; P.rel_bias = args.in[3]; P.sinks = args.in[4]; P.w_pa = args.in[5]; P.ln_w = args.in[6]; P.ln_b = args.in[7];
    P.w_s = args.in[8]; P.b_s = args.in[9]; P.w_pb = args.in[10]; P.w_out = args.in[11]; P.ffn_w = args.in[12]; P.w_q = args.in[13]; P.keys1 = args.in[14]; P.keys2 = args.in[15];
    P.pu = args.in[16]; P.pv = args.in[17]; P.fin_w = args.in[18]; P.out = args.out;
    P.WIN = (bf16*)(ws + WS_WIN); P.WPA = (bf16*)(ws + WS_WPA); P.WPB = (bf16*)(ws + WS_WPB); P.WOUT = (bf16*)(ws + WS_WOUT); P.WQ = (bf16*)(ws + WS_WQ);
    P.K1 = (bf16*)(ws + WS_K1); P.K2 = (bf16*)(ws + WS_K2); P.WS = (bf16*)(ws + WS_WS); P.U = (bf16*)(ws + WS_U); P.V = (bf16*)(ws + WS_V);
    P.U8 = ws + WS_U; P.V8 = ws + WS_U + 16 * MiB; P.USC = (float*)(ws + WS_V); P.VSC = (float*)(ws + WS_V + 65536); P.HN8 = ws + WS_HN8; P.HSC = (float*)(ws + WS_HSC); P.rowss = (float*)(ws + WS_HN8); P.rowamax = (unsigned*)(ws + WS_HN8 + 2 * MiB);
    P.XN = (bf16*)(ws + WS_R1); P.AOUT = (bf16*)(ws + WS_R1); P.BOUT = P3_FUSED ? (bf16*)(ws + WS_R1) + 512 : (bf16*)(ws + WS_R1 + 16 * MiB); P.HN2 = (bf16*)(ws + WS_R1);
    P.Q = (bf16*)(ws + WS_Q); P.KV = (bf16*)(ws + WS_KV); P.GU = (bf16*)(ws + WS_GU); P.GV = (bf16*)(ws + WS_GV); P.GA = (bf16*)(ws + WS_GA); P.GB = (bf16*)(ws + WS_GB);
    P.MERGED = (bf16*)(ws + WS_MERGED); P.QP = (bf16*)(ws + WS_QP);

    for (int u = tid; u < (LDS_BYTES - MISC_OFF) / 4; u += NWAVES * 64) ((LAS unsigned*)(lds + MISC_OFF))[u] = 0u;
    __syncthreads();
    const int lo = args.ph_lo, hi = args.ph_hi;
    unsigned* barw = (unsigned*)(ws + WS_CTL) + CW_BAR;
    XcdBarrier bar; bar.bar = barw; bar.x = 0; bar.st = nullptr;
    if (hi - lo > 1) bar = xcd_barrier_post(barw, (volatile LAS unsigned*)(lds + MISC_OFF));
#define IN(k) (lo <= (k) && (k) < hi)
#define BOTH(k) (IN(k) && IN((k) + 1))
#define GRID_BAR() do { xcd_barrier(bar); if (PROBE_BAR2) xcd_barrier(bar); } while (0)
#define REPS(k) ((k) == PROBE_PHASE ? 2 : 1)

    if (IN(0)) {
#pragma unroll
        for (int rep = 0; rep < REPS(0); ++rep) { p0_prologue(lds, P, vcu, G, lane, wave); __syncthreads(); }
        if (BOTH(0)) GRID_BAR(); }

    if (IN(1)) {
        pg8::Gemm g{P.XN, P.WIN, M, NZ, D}; pg8::StaticOrder S; S.init(M, NZ, G, bx);
        pg8::EpiZ E{P.Q, P.KV, P.GU, P.GV, P.GA, P.GB};
#pragma unroll
        for (int rep = 0; rep < REPS(1); ++rep) pg8::gemm_phase<pg8::EpiZ, pg8::StaticOrder, PG8_ALIGN, PG8_SP2>(lds, g, S, E);
        if (BOTH(1)) GRID_BAR();
    }

    if (IN(2)) {
        for (int rep = 0; rep < REPS(2); ++rep) {
#if ATTN_MFMA
        p2_attn_mfma(lds, P, vcu, G, tid, lane, wave);
#else
        p2_attn_naive(lds, P, vcu, G, tid, lane, wave);
#endif
#if GMLP_MFMA
        p2_gmlp_mfma(lds, P, vcu, G, tid, lane, wave);
#else
        p2_gmlp_naive(lds, P, vcu, G, tid, lane, wave);
#endif
        }
        if (BOTH(2)) GRID_BAR();
    }

    if (IN(3)) {
#pragma unroll
      for (int rep = 0; rep < REPS(3); ++rep) {
#if P3_FUSED
        { pg8::Gemm g{P.AOUT, P.WPA, M, D, 1024}; pg8::StaticOrder S; S.init(M, D, G, bx);
          pg8::EpiMerge2 E{P.GA, P.GB, P.MERGED};
          pg8::gemm_phase<pg8::EpiMerge2, pg8::StaticOrder, PG8_ALIGN, PG8_SP2>(lds, g, S, E); }
#else
        { pg8::Gemm g{P.AOUT, P.WPA, M, D, 512}; pg8::StaticOrder S; S.init(M, D, G, bx);
          pg8::EpiGateTmp E{P.GA, P.out};
          pg8::gemm_phase<pg8::EpiGateTmp, pg8::StaticOrder, PG8_ALIGN, PG8_SP2>(lds, g, S, E); }
        { pg8::Gemm g{P.BOUT, P.WPB, M, D, 512}; pg8::StaticOrder S; S.init(M, D, G, bx);
          pg8::EpiMerge E{P.GB, P.out, P.MERGED};
          pg8::gemm_phase<pg8::EpiMerge, pg8::StaticOrder, PG8_ALIGN, PG8_SP2>(lds, g, S, E); }
#endif
      }
        if (BOTH(3)) GRID_BAR();
    }

    if (IN(4)) {
        pg8::Gemm g{P.MERGED, P.WOUT, M, D, D}; pg8::StaticOrder S; S.init(M, D, G, bx);
#if P5_ELIM
        pg8::EpiResStats E{P.x, P.out, P.HN2, P.ffn_w, P.rowss, P.rowamax};
        pg8::gemm_phase<pg8::EpiResStats, pg8::StaticOrder, PG8_ALIGN, PG8_SP2>(lds, g, S, E);
#else
        pg8::EpiRes E{P.x, P.out};
#pragma unroll
        for (int rep = 0; rep < REPS(4); ++rep) pg8::gemm_phase<pg8::EpiRes, pg8::StaticOrder, PG8_ALIGN, PG8_SP2>(lds, g, S, E);
#endif
        if (BOTH(4)) GRID_BAR();
    }

    if (IN(5) && !P5_ELIM) {
        const int gw = vcu * NWAVES + wave, NGW = G * NWAVES;
#pragma unroll
        for (int rep = 0; rep < REPS(5); ++rep)
        for (int m = gw; m < M; m += NGW) rms_row_to_bf16_fp8(P.out + (size_t)m * D, P.ffn_w, P.HN2 + (size_t)m * D, P.HN8 + (size_t)m * D, P.HSC + m, lane);
        if (BOTH(5)) GRID_BAR();
    }

    if (IN(6)) {
        pg8::Gemm g{P.HN2, P.WQ, M, 2048, D}; pg8::StaticOrder S; S.init(M, 2048, G, bx);
#if P5_ELIM
        pg8::EpiPlainRstd E{P.QP, 2048, P.rowss};
#pragma unroll
        for (int rep = 0; rep < REPS(6); ++rep) pg8::gemm_phase<pg8::EpiPlainRstd, pg8::StaticOrder, PG8_ALIGN, PG8_SP2>(lds, g, S, E);
#else
        pg8::EpiPlain E{P.QP, 2048};
#pragma unroll
        for (int rep = 0; rep < REPS(6); ++rep) pg8::gemm_phase<pg8::EpiPlain, pg8::StaticOrder, PG8_ALIGN, PG8_SP2>(lds, g, S, E);
#endif
        if (BOTH(6)) GRID_BAR();
    }

    if (IN(7)) p7_peer(lds, P, vcu, G, tid, lane, wave);
#undef IN
#undef BOTH
#undef GRID_BAR
}

extern "C" void kernel_launch(void* const* d_in, const int* in_sizes, int n_in, void* d_out, int out_size, void* d_ws, size_t ws_size, hipStream_t stream) {
    static int grid = 0;
    if (grid == 0) {
        if (n_in != 19 || out_size != M * D || ws_size < WS_END) { fprintf(stderr, "kernel_launch: unexpected shapes (n_in %d, out %d, ws %zu)\n", n_in, out_size, ws_size); grid = -1; return; }
        int dev = 0, cus = 0, per_cu = 0;
        if (hipGetDevice(&dev) != hipSuccess || hipDeviceGetAttribute(&cus, hipDeviceAttributeMultiprocessorCount, dev) != hipSuccess) { grid = -1; return; }
        if (hipFuncSetAttribute((const void*)mega_fwd, hipFuncAttributeMaxDynamicSharedMemorySize, LDS_BYTES) != hipSuccess) { fprintf(stderr, "kernel_launch: hipFuncSetAttribute failed\n"); grid = -1; return; }
        if (hipOccupancyMaxActiveBlocksPerMultiprocessor(&per_cu, (const void*)mega_fwd, NWAVES * 64, LDS_BYTES) != hipSuccess || per_cu < 1)
            fprintf(stderr, "kernel_launch: note: occupancy query reports %d workgroups per CU\n", per_cu);
        (void)hipGetLastError();
        grid = cus;
    }
    if (grid < 0) return;
    if (hipMemsetAsync((char*)d_ws + WS_CTL, 0, CTL_ZERO_BYTES, stream) != hipSuccess) return;
    Args a{};
    for (int i = 0; i < 19; ++i) a.in[i] = (const float*)d_in[i];
    a.out = (float*)d_out; a.ws = (unsigned char*)d_ws;
#if MK_N_LAUNCHES == 1
    a.ph_lo = 0; a.ph_hi = N_PHASES;
    hipLaunchKernelGGL(mega_fwd, dim3(grid), dim3(NWAVES * 64), LDS_BYTES, stream, a);
#else
    for (int li = 0; li < N_PHASES; ++li) { a.ph_lo = li; a.ph_hi = li + 1; hipLaunchKernelGGL(mega_fwd, dim3(grid), dim3(NWAVES * 64), LDS_BYTES, stream, a); }
#endif
}
```

```cpp
#include <hip/hip_runtime.h>
#include <cstdio>
#include <cstdint>
namespace pg8 {
#define PG8_LAS __attribute__((address_space(3)))
typedef unsigned short bf16_t;
typedef short bf16x8 __attribute__((ext_vector_type(8)));
typedef float f32x4 __attribute__((ext_vector_type(4)));
typedef unsigned u32x4 __attribute__((ext_vector_type(4)));
constexpr int BM = 256, BK = 64, HALF = 128, HTB = HALF * BK * 2  , STAGE_BYTES = 8 * HTB, NXCD = 8, WGM = 8;

__host__ __device__ __forceinline__ int lds_byte(int r, int c) { const int st = (r >> 4) * 2 + (c >> 5), rr = r & 15, cc = c & 31, ob = rr * 64 + cc * 2; return st * 1024 + (ob ^ (((ob >> 9) & 1) << 5)); }
__host__ __device__ __forceinline__ void stage_rc(int b, int& R, int& C) { const int st = b / 1024, sb = b % 1024, swz = sb ^ (((sb >> 9) & 1) << 5); R = (st >> 1) * 16 + swz / 64; C = (st & 1) * 32 + (swz % 64) / 2; }
__host__ __device__ __forceinline__ int perm32(int rho) { const int n = rho >> 4, i = rho & 15; return 8 * (i >> 2) + 4 * n + (i & 3); }

struct Unit { int pm, pn; };
struct Gemm { const bf16_t* A; const bf16_t* Bt; int M, N, K; };

struct StaticOrder {
    int nM, nN, nwg, G, c;
    __host__ __device__ void init(int M, int N, int G_, int c_) { nM = M / BM; nN = N / BM; nwg = nM * nN; G = G_; c = c_; }
    __host__ __device__ bool next(int i, Unit& u) const {
        const long L = (long)i * G + c; if (L >= nwg) return false;
        int wgid = (int)L; { const int q = nwg / NXCD, r = nwg % NXCD, xcd = wgid % NXCD, off = wgid / NXCD; wgid = (xcd < r ? xcd * (q + 1) : r * (q + 1) + (xcd - r) * q) + off; }
        const int nig = WGM * nN, gid = wgid / nig, fm = gid * WGM, gsz = (nM - fm) < WGM ? (nM - fm) : WGM;
        u.pm = fm + ((wgid % nig) % gsz); u.pn = (wgid % nig) / gsz; return true;
    }
    __device__ __forceinline__ void a_ready(const Unit&) const {}
    __device__ __forceinline__ void done(const Unit&) const {}
};

__device__ __forceinline__ unsigned cvt_pk_bf16(float lo, float hi) { unsigned r; asm volatile("v_cvt_pk_bf16_f32 %0, %1, %2" : "=v"(r) : "v"(lo), "v"(hi)); return r; }
typedef float f32x2 __attribute__((ext_vector_type(2)));
template <class Epi, class Sched, bool ALIGN_EPI = false, bool SP2 = false>
__device__ __forceinline__ void gemm_phase(PG8_LAS unsigned char* lds, const Gemm g, const Sched& S, const Epi& E) {
    const int tid = threadIdx.x, wid = __builtin_amdgcn_readfirstlane(tid >> 6), lane = tid & 63, wr = wid >> 2, wc = wid & 3, fr = lane & 15, fq = lane >> 4;
    const int K = g.K, nt = K / BK;
    unsigned voffA[2], voffB[2];
#pragma unroll
    for (int i = 0; i < 2; ++i) { int R, C; stage_rc(tid * 16 + i * 8192, R, C); const int Rb = Epi::PERM ? ((R & ~31) + perm32(R & 31)) : R;
        voffA[i] = (unsigned)(R * K + C) * 2u; voffB[i] = (unsigned)(Rb * K + C) * 2u; }
    const size_t kstep = (size_t)(BK * 2);
    const size_t hstep = (size_t)HALF * K * 2;
    const size_t tstep = 2 * hstep;
    const unsigned ldsw = (unsigned)wid * 1024u;
    const int aoff = lds_byte(wr * 64 + fr, fq * 8), boff = lds_byte(wc * 32 + fr, fq * 8);
#define PG8_SA(b, h) (((b) * 2 + (h)) * HTB)
#define PG8_SB(b, h) ((4 + (b) * 2 + (h)) * HTB)
#define PG8_STAGE(bufoff, gbase, voff) do { _Pragma("unroll") for (int _i = 0; _i < 2; ++_i) \
        __builtin_amdgcn_global_load_lds((const unsigned*)((const char*)(gbase) + (voff)[_i]), (PG8_LAS unsigned*)(lds + (bufoff) + ldsw + _i * 8192), 16, 0, 0); } while (0)
#define PG8_LDA(dst, b, h) do { _Pragma("unroll") for (int m = 0; m < 4; ++m) _Pragma("unroll") for (int k = 0; k < 2; ++k) dst[m][k] = *(const PG8_LAS bf16x8*)(lds + PG8_SA(b, h) + aoff + m * 2048 + k * 1024); } while (0)
#define PG8_LDB(dst, b, h) do { _Pragma("unroll") for (int n = 0; n < 2; ++n) _Pragma("unroll") for (int k = 0; k < 2; ++k) dst[n][k] = *(const PG8_LAS bf16x8*)(lds + PG8_SB(b, h) + boff + n * 2048 + k * 1024); } while (0)
#define PG8_MMA(ai, bj, At, Bt) do { __builtin_amdgcn_s_setprio(1); _Pragma("unroll") for (int m = 0; m < 4; ++m) _Pragma("unroll") for (int n = 0; n < 2; ++n) _Pragma("unroll") for (int k = 0; k < 2; ++k) \
        acc[ai][bj][m][n] = __builtin_amdgcn_mfma_f32_16x16x32_bf16(Bt[n][k], At[m][k], acc[ai][bj][m][n], 0, 0, 0); __builtin_amdgcn_s_setprio(0); } while (0)
#define PG8_WAIT_V(n) asm volatile("s_waitcnt vmcnt(" #n ")" ::: "memory")
#define PG8_WAIT_L(n) asm volatile("s_waitcnt lgkmcnt(" #n ")" ::: "memory")
#define PG8_BAR __builtin_amdgcn_s_barrier()
#define PG8_SCHED __builtin_amdgcn_sched_barrier(0)
    Unit cur, nxt; int ui = 0;
    if (!S.next(0, cur)) return;
    f32x4 acc[2][2][4][2];
#pragma unroll
    for (int a = 0; a < 2; ++a)
#pragma unroll
        for (int b = 0; b < 2; ++b)
#pragma unroll
            for (int m = 0; m < 4; ++m)
#pragma unroll
                for (int n = 0; n < 2; ++n) acc[a][b][m][n] = (f32x4){0.f, 0.f, 0.f, 0.f};
    bf16x8 At[4][2], B0[2][2], B1[2][2];
    const char* cA = (const char*)g.A + (size_t)cur.pm * tstep; const char* cB = (const char*)g.Bt + (size_t)cur.pn * tstep;
    S.a_ready(cur);
    if constexpr (SP2) {
        PG8_STAGE(PG8_SB(0, 0), cB, voffB); PG8_STAGE(PG8_SB(0, 1), cB + hstep, voffB); PG8_STAGE(PG8_SA(0, 0), cA, voffA); PG8_STAGE(PG8_SA(0, 1), cA + hstep, voffA);
        if (wr == 1) PG8_BAR;
        PG8_WAIT_V(2); PG8_BAR;
        PG8_STAGE(PG8_SB(1, 0), cB + kstep, voffB); PG8_STAGE(PG8_SA(1, 0), cA + kstep, voffA); PG8_STAGE(PG8_SB(1, 1), cB + hstep + kstep, voffB);
        PG8_WAIT_V(6); PG8_BAR;
    } else {
        PG8_STAGE(PG8_SB(0, 0), cB, voffB); PG8_STAGE(PG8_SA(0, 0), cA, voffA); PG8_STAGE(PG8_SB(0, 1), cB + hstep, voffB); PG8_STAGE(PG8_SA(0, 1), cA + hstep, voffA);
        if (wr == 1) PG8_BAR;
        PG8_WAIT_V(4); PG8_BAR;
        PG8_STAGE(PG8_SB(1, 0), cB + kstep, voffB); PG8_STAGE(PG8_SA(1, 0), cA + kstep, voffA); PG8_STAGE(PG8_SB(1, 1), cB + hstep + kstep, voffB);
        PG8_WAIT_V(6); PG8_BAR;
    }
    for (;;) {
        const bool has_next = S.next(ui + 1, nxt);
        const char* nA = has_next ? (const char*)g.A + (size_t)nxt.pm * tstep : cA; const char* nB = has_next ? (const char*)g.Bt + (size_t)nxt.pn * tstep : cB;
        for (int t = 0; t < nt; t += 2) {
            if constexpr (Epi::HAS_MID) { if (t == (nt >> 1)) E.mid(acc, cur, wr, wc, fr, fq); }
            const bool last = (t == nt - 2);
            const char* a1 = cA + (size_t)(t + 1) * kstep;
            const char* a2 = last ? nA : cA + (size_t)(t + 2) * kstep; const char* b2 = last ? nB : cB + (size_t)(t + 2) * kstep;
            const char* a3 = a2 + kstep; const char* b3 = b2 + kstep;
            if (last && has_next) S.a_ready(nxt);
            if constexpr (SP2) {
            PG8_LDB(B0, 0, 0); PG8_LDB(B1, 0, 1); PG8_SCHED; PG8_LDA(At, 0, 0); PG8_STAGE(PG8_SA(1, 1), a1 + hstep, voffA);
            PG8_WAIT_V(8); PG8_WAIT_L(0); PG8_BAR; PG8_MMA(0, 0, At, B0); PG8_MMA(0, 1, At, B1); PG8_BAR; PG8_SCHED;
            PG8_LDA(At, 0, 1); PG8_STAGE(PG8_SB(0, 0), b2, voffB); PG8_STAGE(PG8_SB(0, 1), b2 + hstep, voffB); PG8_STAGE(PG8_SA(0, 0), a2, voffA);
            PG8_WAIT_V(8); PG8_WAIT_L(0); PG8_BAR; PG8_MMA(1, 0, At, B0); PG8_MMA(1, 1, At, B1); PG8_BAR; PG8_SCHED;
            PG8_LDB(B0, 1, 0); PG8_LDB(B1, 1, 1); PG8_SCHED; PG8_LDA(At, 1, 0); PG8_STAGE(PG8_SA(0, 1), a2 + hstep, voffA);
            PG8_WAIT_V(8); PG8_WAIT_L(0); PG8_BAR; PG8_MMA(0, 0, At, B0); PG8_MMA(0, 1, At, B1); PG8_BAR; PG8_SCHED;
            PG8_LDA(At, 1, 1); PG8_STAGE(PG8_SB(1, 0), b3, voffB); PG8_STAGE(PG8_SB(1, 1), b3 + hstep, voffB); PG8_STAGE(PG8_SA(1, 0), a3, voffA);
            PG8_WAIT_V(8); PG8_WAIT_L(0); PG8_BAR; PG8_MMA(1, 0, At, B0); PG8_MMA(1, 1, At, B1); PG8_BAR; PG8_SCHED;
            } else {
            PG8_LDB(B0, 0, 0); PG8_SCHED; PG8_LDA(At, 0, 0); PG8_STAGE(PG8_SA(1, 1), a1 + hstep, voffA);
            PG8_WAIT_L(8); PG8_BAR; PG8_WAIT_L(0); PG8_MMA(0, 0, At, B0); PG8_BAR; PG8_SCHED;
            PG8_LDB(B1, 0, 1); PG8_STAGE(PG8_SB(0, 0), b2, voffB);
            PG8_BAR; PG8_WAIT_L(0); PG8_MMA(0, 1, At, B1); PG8_BAR;
            PG8_LDA(At, 0, 1); PG8_STAGE(PG8_SA(0, 0), a2, voffA);
            PG8_BAR; PG8_WAIT_L(0); PG8_MMA(1, 0, At, B0); PG8_BAR; PG8_SCHED;
            PG8_STAGE(PG8_SB(0, 1), b2 + hstep, voffB);
            PG8_WAIT_V(6); PG8_BAR; PG8_MMA(1, 1, At, B1); PG8_BAR;
            PG8_LDB(B0, 1, 0); PG8_SCHED; PG8_LDA(At, 1, 0); PG8_STAGE(PG8_SA(0, 1), a2 + hstep, voffA);
            PG8_WAIT_L(8); PG8_BAR; PG8_WAIT_L(0); PG8_MMA(0, 0, At, B0); PG8_BAR; PG8_SCHED;
            PG8_LDB(B1, 1, 1); PG8_STAGE(PG8_SB(1, 0), b3, voffB);
            PG8_BAR; PG8_WAIT_L(0); PG8_MMA(0, 1, At, B1); PG8_BAR;
            PG8_LDA(At, 1, 1); PG8_STAGE(PG8_SA(1, 0), a3, voffA);
            PG8_BAR; PG8_WAIT_L(0); PG8_MMA(1, 0, At, B0); PG8_BAR; PG8_SCHED;
            PG8_STAGE(PG8_SB(1, 1), b3 + hstep, voffB);
            PG8_WAIT_V(6); PG8_BAR; PG8_MMA(1, 1, At, B1); PG8_BAR;
            }
        }
        if constexpr (ALIGN_EPI) { if (wr == 0) PG8_BAR; }
        if constexpr (!Epi::AFTER_DRAIN) { E(acc, cur, wr, wc, fr, fq); S.done(cur); }
        if (!has_next) break;
#pragma unroll
        for (int a = 0; a < 2; ++a)
#pragma unroll
            for (int b = 0; b < 2; ++b)
#pragma unroll
                for (int m = 0; m < 4; ++m)
#pragma unroll
                    for (int n = 0; n < 2; ++n) acc[a][b][m][n] = (f32x4){0.f, 0.f, 0.f, 0.f};
        cur = nxt; cA = nA; cB = nB; ++ui;
        if constexpr (ALIGN_EPI) { if (wr == 1) PG8_BAR; }
    }
    PG8_WAIT_V(0);
    if constexpr (!ALIGN_EPI) { if (wr == 0) PG8_BAR; }
    PG8_BAR;
    if constexpr (Epi::AFTER_DRAIN) { E.fused(acc, cur, wr, wc, fr, fq, lds, wid, lane); S.done(cur); }
#undef PG8_SA
#undef PG8_SB
#undef PG8_STAGE
#undef PG8_LDA
#undef PG8_LDB
#undef PG8_MMA
#undef PG8_WAIT_V
#undef PG8_WAIT_L
#undef PG8_BAR
#undef PG8_SCHED
}
}
#ifndef PG8_SP2
#define PG8_SP2 true
#endif
#ifndef PG8_ALIGN
#define PG8_ALIGN true
#endif

constexpr int NWAVES = 8;
#ifndef MK_N_LAUNCHES
#define MK_N_LAUNCHES 1
#endif
constexpr int N_PHASES = 8;
#ifndef ATTN_MFMA
#define ATTN_MFMA 1
#endif
#ifndef GMLP_MFMA
#define GMLP_MFMA 1
#endif
#ifndef TOPK_DBG_GATES_ONLY
#define TOPK_DBG_GATES_ONLY 0
#endif
#ifndef DBG_SHFL_WAVESUM
#define DBG_SHFL_WAVESUM 0
#endif
#ifndef TOPK_DBG_COMPARE
#define TOPK_DBG_COMPARE 0
#endif
#ifndef TOPK_DBG_SEL
#define TOPK_DBG_SEL 0
#endif
#ifndef TOPK_DBG_K0
#define TOPK_DBG_K0 0
#endif
#ifndef TOPK_DBG_K1
#define TOPK_DBG_K1 16
#endif
#ifndef TOPK_DBG_BRUTE
#define TOPK_DBG_BRUTE 0
#endif
#ifndef TOPK_DBG_INSERT
#define TOPK_DBG_INSERT 0
#endif
#ifndef TOPK_DBG_VALU_SCORES
#define TOPK_DBG_VALU_SCORES 0
#endif
#ifndef KEY_SWZ
#define KEY_SWZ (!TOPK_DBG_GATES_ONLY && !TOPK_DBG_VALU_SCORES && !TOPK_DBG_COMPARE && !TOPK_DBG_BRUTE && TOPK_DBG_INSERT != 3)
#endif
#ifndef TOPK_MFMA
#define TOPK_MFMA 1
#endif
#ifndef U_INT4
#define U_INT4 1
#endif
#ifndef GATHER_HALF
#define GATHER_HALF 1
#endif
#ifndef FP4_SELFCHECK
#define FP4_SELFCHECK 0
#endif
#ifndef Q4_USTEP
#define Q4_USTEP 0.36f
#endif
#ifndef Q4_VUNIT
#define Q4_VUNIT 0.5f
#endif
#ifndef FAKEQ_U
#define FAKEQ_U 0
#endif
#ifndef FAKEQ_V
#define FAKEQ_V 0
#endif
#ifndef P7_STAGGER
#define P7_STAGGER 0
#endif
#ifndef SWEEP_SYNC
#define SWEEP_SYNC 0
#endif
#ifndef NSL
#define NSL 8
#endif
#define SLSH (NSL == 64 ? 8 : NSL == 32 ? 9 : NSL == 16 ? 10 : 11)
#ifndef PROBE_ROWAND
#define PROBE_ROWAND 16383u
#endif
#ifndef PROBE_V_PASSES
#define PROBE_V_PASSES 1
#endif
#ifndef PROBE_U_PASSES
#define PROBE_U_PASSES 1
#endif
#ifndef GATHER_STAGGER
#define GATHER_STAGGER 0
#endif
#ifndef WT_STORES
#define WT_STORES 0
#endif
#ifndef P5_ELIM
#define P5_ELIM 0
#endif
#ifndef P3_FUSED
#define P3_FUSED 0
#endif
#ifndef U_INT8
#define U_INT8 1
#endif
#ifndef U_DOT2
#define U_DOT2 1
#endif
#ifndef U_MFMA
#define U_MFMA 0
#endif
#ifndef GATHER_SORTED
#define GATHER_SORTED 2
#endif
#ifndef PEER_FP8
#define PEER_FP8 1
#endif
#ifndef PROBE_GATHER_REPS
#define PROBE_GATHER_REPS 1
#endif
#ifndef PROBE_TOPK_REPS
#define PROBE_TOPK_REPS 1
#endif
#ifndef PROBE_BAR2
#define PROBE_BAR2 0
#endif
#ifndef PROBE_PHASE
#define PROBE_PHASE -1
#endif
#ifndef PROBE_P2_REPS
#define PROBE_P2_REPS 1
#endif

constexpr int NB = 2, SEQ = 8192, D = 1024, M = NB * SEQ;
constexpr int NZ = 3840;
constexpr float EPS = 1e-6f;
constexpr int AB_LD = P3_FUSED ? 1024 : 512;

constexpr size_t MiB = 1u << 20;
constexpr size_t WS_CTL = 0, CTL_ZERO_BYTES = 65536;
constexpr size_t WS_WIN = 1 * MiB;
constexpr size_t WS_WPA = 9 * MiB;
constexpr size_t WS_WPB = 10 * MiB;
constexpr size_t WS_WOUT = 11 * MiB;
constexpr size_t WS_WQ = 13 * MiB;
constexpr size_t WS_K1 = 17 * MiB;
constexpr size_t WS_K2 = 17 * MiB + 32768;
constexpr size_t WS_WS = 17 * MiB + 65536;
constexpr size_t WS_U = 18 * MiB;
constexpr size_t WS_V = 50 * MiB;
constexpr size_t WS_R1 = 82 * MiB;
constexpr size_t WS_Q = 114 * MiB;
constexpr size_t WS_KV = 130 * MiB;
constexpr size_t WS_GU = 138 * MiB;
constexpr size_t WS_GV = 154 * MiB;
constexpr size_t WS_GA = 170 * MiB;
constexpr size_t WS_GB = 202 * MiB;
constexpr size_t WS_MERGED = 114 * MiB;
constexpr size_t WS_QP = 170 * MiB;
constexpr size_t WS_HN8 = 146 * MiB;
constexpr size_t WS_HSC = 162 * MiB;
constexpr size_t WS_END = 234 * MiB;
constexpr int CW_BAR = 0;

constexpr int RING_BYTES = 131072;
constexpr int MISC_OFF = 143360;
constexpr int LDS_BYTES = 147456;

#define GAS __attribute__((address_space(1)))
#define LAS __attribute__((address_space(3)))
typedef unsigned short bf16;
typedef unsigned v4u __attribute__((ext_vector_type(4)));
typedef unsigned v2u __attribute__((ext_vector_type(2)));
typedef float f32x4 __attribute__((ext_vector_type(4)));
typedef _Float16 h2 __attribute__((ext_vector_type(2)));
typedef GAS unsigned gu32;
typedef __bf16 bf16x2_t __attribute__((ext_vector_type(2)));
#define RLX_AGENT __ATOMIC_RELAXED, __HIP_MEMORY_SCOPE_AGENT
#define LDS_WAIT() asm volatile("s_waitcnt lgkmcnt(0)" ::: "memory")
#define VM_WAIT() asm volatile("s_waitcnt vmcnt(0)" ::: "memory")
__device__ __forceinline__ unsigned f2bf(float f) { unsigned u = __builtin_bit_cast(unsigned, f); return (u + 0x7fffu + ((u >> 16) & 1u)) >> 16; }
__device__ __forceinline__ unsigned pk2(float lo, float hi) { return f2bf(lo) | (f2bf(hi) << 16); }
__device__ __forceinline__ float bflo(unsigned w) { return __builtin_bit_cast(float, w << 16); }
__device__ __forceinline__ float bfhi(unsigned w) { return __builtin_bit_cast(float, w & 0xffff0000u); }
__device__ __forceinline__ float bf2f(bf16 h) { return __builtin_bit_cast(float, (unsigned)h << 16); }
__device__ __forceinline__ float dot2bf(unsigned a, unsigned b, float c) { return __builtin_amdgcn_fdot2_f32_bf16(__builtin_bit_cast(bf16x2_t, a), __builtin_bit_cast(bf16x2_t, b), c, false); }
__device__ __forceinline__ float gelu_tanh(float v) {
    const float t2 = v * (-2.302208198f + (-0.1029432397f) * v * v);
    return v * __builtin_amdgcn_rcpf(1.0f + __builtin_amdgcn_exp2f(t2));
}
__device__ __forceinline__ float sigmoid_f(float v) { return __builtin_amdgcn_rcpf(1.0f + __builtin_amdgcn_exp2f(-1.4426950409f * v)); }
template <int CTRL> __device__ __forceinline__ float dppmov(float v) { return __builtin_bit_cast(float, __builtin_amdgcn_update_dpp(0, __builtin_bit_cast(int, v), CTRL, 0xF, 0xF, false)); }
__device__ __forceinline__ float row16_sum(float v) {
    v += dppmov<0xB1>(v);
    v += dppmov<0x4E>(v);
    v += dppmov<0x141>(v);
    v += dppmov<0x140>(v);
    return v;
}
__device__ __forceinline__ float xor32_f(float v) {
    const unsigned u = __builtin_bit_cast(unsigned, v);
    auto rr = __builtin_amdgcn_permlane32_swap(u, u, false, false);
    const unsigned r0 = rr[0], r1 = rr[1];
    return __builtin_bit_cast(float, (__lane_id() & 32) ? r0 : r1);
}
__device__ __forceinline__ float wave_sum(float v) {
#if DBG_SHFL_WAVESUM
#pragma unroll
    for (int o = 1; o < 64; o <<= 1) v += __shfl_xor(v, o);
    return v;
#endif
    v = row16_sum(v);
    v += __builtin_bit_cast(float, __builtin_amdgcn_ds_swizzle(__builtin_bit_cast(int, v), 0x401F));
    const unsigned u = __builtin_bit_cast(unsigned, v);
    auto rr = __builtin_amdgcn_permlane32_swap(u, u, false, false);
    const unsigned r0 = rr[0], r1 = rr[1];
    return __builtin_bit_cast(float, r0) + __builtin_bit_cast(float, r1);
}
__device__ const unsigned char T5B[128] = {0, 1, 2, 3, 4, 5, 6, 7, 8, 9, 10, 11, 12, 13, 14, 15, 16, 16, 16, 17, 17, 18, 18, 18, 19, 19, 19, 20, 20, 20, 20, 21, 21, 21, 21, 22, 22, 22, 22, 22, 23, 23, 23, 23, 23, 23, 24, 24, 24, 24, 24, 24, 25, 25, 25, 25, 25, 25, 25, 26, 26, 26, 26, 26, 26, 26, 26, 27, 27, 27, 27, 27, 27, 27, 27, 27, 27, 28, 28, 28, 28, 28, 28, 28, 28, 28, 28, 29, 29, 29, 29, 29, 29, 29, 29, 29, 29, 29, 29, 30, 30, 30, 30, 30, 30, 30, 30, 30, 30, 30, 30, 30, 30, 31, 31, 31, 31, 31, 31, 31, 31, 31, 31, 31, 31, 31, 31, 31};
#define XB_TMO      128
#define XB_XCNT(j)  (256  + 64 * (j))
#define XB_XSUB(j)  (1280 + 64 * (j))
#define XB_XGEN(j)  (2304 + 64 * (j))
#define XB_TOP      3328
#define XB_TOPGEN   3392
#define XCD_BAR_WORDS 3456
#define XB_SPIN_CAP (1u << 18)

__device__ __forceinline__ unsigned xb_ld(unsigned* p)              { return __hip_atomic_load(p, __ATOMIC_RELAXED, __HIP_MEMORY_SCOPE_AGENT); }
__device__ __forceinline__ unsigned xb_add(unsigned* p, unsigned v) { return __hip_atomic_fetch_add(p, v, __ATOMIC_RELAXED, __HIP_MEMORY_SCOPE_AGENT); }
__device__ __forceinline__ unsigned xb_xcc_id() { return (unsigned)__builtin_amdgcn_s_getreg((3 << 11) | 20) & 0xFu; }
#define XB_SPIN(cond, bar) do { unsigned _sp = 0; while (cond) { __builtin_amdgcn_s_sleep(1); \
    if ((++_sp & 255u) == 0u) { if (xb_ld(&(bar)[XB_TMO])) break; if (_sp > XB_SPIN_CAP) { atomicAdd(&(bar)[XB_TMO], 1u); break; } } } } while (0)

struct XcdBarrier {
    unsigned* bar; unsigned x;
    volatile LAS unsigned* st;
};

__device__ __forceinline__ XcdBarrier xcd_barrier_post(unsigned* bar, volatile LAS unsigned* st) {
    XcdBarrier b; b.bar = bar; b.x = xb_xcc_id(); b.st = st;
    if (threadIdx.x == 0) (void)xb_add(&bar[XB_XCNT(b.x)], 1u);
    return b;
}
__device__ __forceinline__ void xcd_barrier_complete(unsigned* bar, unsigned x, unsigned& nloc, unsigned& nx) {
    const unsigned G = gridDim.x * gridDim.y * gridDim.z;
    unsigned sum, cnt, mine, sp = 0u;
    for (;;) {
        sum = 0u; cnt = 0u; mine = 0u;
#pragma unroll
        for (unsigned j = 0; j < 16; ++j) { const unsigned c = xb_ld(&bar[XB_XCNT(j)]); sum += c; cnt += (c > 0u) ? 1u : 0u; mine = (j == x) ? c : mine; }
        if (sum == G) break;
        __builtin_amdgcn_s_sleep(1);
        if ((++sp & 255u) == 0u) { if (xb_ld(&bar[XB_TMO])) break; if (sp > XB_SPIN_CAP) { atomicAdd(&bar[XB_TMO], 1u); break; } }
    }
    nloc = mine > 0u ? mine : 1u; nx = cnt > 0u ? cnt : 1u;
}

__device__ __forceinline__ void xcd_barrier(const XcdBarrier& b) {
    asm volatile("s_waitcnt vmcnt(0)" ::: "memory");
    __syncthreads();
    if (threadIdx.x == 0) {
        unsigned* bar = b.bar;
        __builtin_amdgcn_s_waitcnt(0);
        unsigned nloc = b.st[0], nx = b.st[1];
        if (nloc == 0u) { xcd_barrier_complete(bar, b.x, nloc, nx); b.st[0] = nloc; b.st[1] = nx; }
        const unsigned old = xb_add(&bar[XB_XSUB(b.x)], 1u);
        const unsigned gen = old / nloc;
        if (old + 1u == (gen + 1u) * nloc) {
            __builtin_amdgcn_fence(__ATOMIC_RELEASE, "agent");
            asm volatile("s_waitcnt vmcnt(0)" ::: "memory");
            const unsigned og = xb_add(&bar[XB_TOP], 1u);
            const unsigned tg = og / nx;
            if (og + 1u == (tg + 1u) * nx) xb_add(&bar[XB_TOPGEN], 1u);
            else XB_SPIN(xb_ld(&bar[XB_TOPGEN]) == tg, bar);
            __builtin_amdgcn_fence(__ATOMIC_ACQUIRE, "agent");
            xb_add(&bar[XB_XGEN(b.x)], 1u);
            asm volatile("s_waitcnt vmcnt(0)" ::: "memory");
        } else {
            XB_SPIN(xb_ld(&bar[XB_XGEN(b.x)]) == gen, bar);
            __builtin_amdgcn_fence(__ATOMIC_ACQUIRE, "agent");
            asm volatile("s_waitcnt vmcnt(0)" ::: "memory");
        }
    }
    __syncthreads();
}
#if WT_STORES
#define ST16(PTR, VAL) asm volatile("global_store_dwordx4 %0, %1, off sc1\n\ts_nop 1" :: "v"(PTR), "v"(VAL) : "memory")
#else
#define ST16(PTR, VAL) (*(PTR) = (VAL))
#endif
namespace pg8 {
struct EpiZ {
    static constexpr bool PERM = true, AFTER_DRAIN = false, HAS_MID = false;
    bf16_t *Q, *KV, *GU, *GV, *GA, *GB;
    __device__ __forceinline__ void operator()(const f32x4 (&acc)[2][2][4][2], const Unit& u, int wr, int wc, int fr, int fq) const {
        const int pn = u.pn; bf16_t* base; int ldc, colt, act;
        if (pn < 2)       { base = Q;  ldc = 512;  colt = pn * 256;        act = 0; }
        else if (pn == 2) { base = KV; ldc = 256;  colt = 0;               act = 0; }
        else if (pn < 5)  { base = GU; ldc = 512;  colt = (pn - 3) * 256;  act = 1; }
        else if (pn < 7)  { base = GV; ldc = 512;  colt = (pn - 5) * 256;  act = 1; }
        else if (pn < 11) { base = GA; ldc = 1024; colt = (pn - 7) * 256;  act = 2; }
        else              { base = GB; ldc = 1024; colt = (pn - 11) * 256; act = 2; }
        const int row0 = u.pm * BM + wr * 64 + fr, col0 = colt + wc * 32 + 8 * fq;
#pragma unroll
        for (int ai = 0; ai < 2; ++ai)
#pragma unroll
            for (int m = 0; m < 4; ++m) { bf16_t* rowp = base + (size_t)(row0 + ai * HALF + m * 16) * ldc + col0;
#pragma unroll
                for (int bj = 0; bj < 2; ++bj) { f32x4 v0 = acc[ai][bj][m][0], v1 = acc[ai][bj][m][1];
                    if (act == 1) {
#pragma unroll
                        for (int e = 0; e < 4; ++e) { v0[e] = gelu_tanh(v0[e]); v1[e] = gelu_tanh(v1[e]); }
                    } else if (act == 2) {
#pragma unroll
                        for (int e = 0; e < 4; ++e) { v0[e] = sigmoid_f(v0[e]); v1[e] = sigmoid_f(v1[e]); }
                    }
                    u32x4 w; w.x = cvt_pk_bf16(v0[0], v0[1]); w.y = cvt_pk_bf16(v0[2], v0[3]); w.z = cvt_pk_bf16(v1[0], v1[1]); w.w = cvt_pk_bf16(v1[2], v1[3]);
                    ST16((u32x4*)(rowp + bj * HALF), w); } }
    }
};
struct EpiGateTmp {
    static constexpr bool PERM = true, AFTER_DRAIN = false, HAS_MID = false;
    const bf16_t* gate; float* tmp;
    __device__ __forceinline__ void operator()(const f32x4 (&acc)[2][2][4][2], const Unit& u, int wr, int wc, int fr, int fq) const {
        const int row0 = u.pm * BM + wr * 64 + fr, col0 = u.pn * BM + wc * 32 + 8 * fq;
#pragma unroll
        for (int ai = 0; ai < 2; ++ai)
#pragma unroll
            for (int m = 0; m < 4; ++m) { const size_t ro = (size_t)(row0 + ai * HALF + m * 16) * 1024 + col0;
#pragma unroll
                for (int bj = 0; bj < 2; ++bj) { const u32x4 g = *(const u32x4*)(gate + ro + bj * HALF); f32x4 v0 = acc[ai][bj][m][0], v1 = acc[ai][bj][m][1];
                    v0[0] *= bflo(g.x); v0[1] *= bfhi(g.x); v0[2] *= bflo(g.y); v0[3] *= bfhi(g.y); v1[0] *= bflo(g.z); v1[1] *= bfhi(g.z); v1[2] *= bflo(g.w); v1[3] *= bfhi(g.w);
                    ST16((f32x4*)(tmp + ro + bj * HALF), v0); ST16((f32x4*)(tmp + ro + bj * HALF + 4), v1); } }
    }
};
struct EpiMerge {
    static constexpr bool PERM = true, AFTER_DRAIN = false, HAS_MID = false;
    const bf16_t* gate; const float* tmp; bf16_t* out;
    __device__ __forceinline__ void operator()(const f32x4 (&acc)[2][2][4][2], const Unit& u, int wr, int wc, int fr, int fq) const {
        const int row0 = u.pm * BM + wr * 64 + fr, col0 = u.pn * BM + wc * 32 + 8 * fq;
#pragma unroll
        for (int ai = 0; ai < 2; ++ai)
#pragma unroll
            for (int m = 0; m < 4; ++m) { const size_t ro = (size_t)(row0 + ai * HALF + m * 16) * 1024 + col0;
#pragma unroll
                for (int bj = 0; bj < 2; ++bj) { const u32x4 g = *(const u32x4*)(gate + ro + bj * HALF); f32x4 v0 = acc[ai][bj][m][0], v1 = acc[ai][bj][m][1];
                    const f32x4 t0 = *(const f32x4*)(tmp + ro + bj * HALF), t1 = *(const f32x4*)(tmp + ro + bj * HALF + 4);
                    v0[0] = t0[0] + v0[0] * bflo(g.x); v0[1] = t0[1] + v0[1] * bfhi(g.x); v0[2] = t0[2] + v0[2] * bflo(g.y); v0[3] = t0[3] + v0[3] * bfhi(g.y);
                    v1[0] = t1[0] + v1[0] * bflo(g.z); v1[1] = t1[1] + v1[1] * bfhi(g.z); v1[2] = t1[2] + v1[2] * bflo(g.w); v1[3] = t1[3] + v1[3] * bfhi(g.w);
                    u32x4 w; w.x = cvt_pk_bf16(v0[0], v0[1]); w.y = cvt_pk_bf16(v0[2], v0[3]); w.z = cvt_pk_bf16(v1[0], v1[1]); w.w = cvt_pk_bf16(v1[2], v1[3]);
                    ST16((u32x4*)(out + ro + bj * HALF), w); } }
    }
};
struct EpiMerge2 {
    static constexpr bool PERM = true, AFTER_DRAIN = false, HAS_MID = true;
    const bf16_t* ga; const bf16_t* gb; bf16_t* out;
    __device__ __forceinline__ void mid(f32x4 (&acc)[2][2][4][2], const Unit& u, int wr, int wc, int fr, int fq) const {
        const int row0 = u.pm * BM + wr * 64 + fr, col0 = u.pn * BM + wc * 32 + 8 * fq;
#pragma unroll
        for (int ai = 0; ai < 2; ++ai)
#pragma unroll
            for (int m = 0; m < 4; ++m) { const size_t ro = (size_t)(row0 + ai * HALF + m * 16) * 1024 + col0;
#pragma unroll
                for (int bj = 0; bj < 2; ++bj) { const u32x4 a = *(const u32x4*)(ga + ro + bj * HALF), b = *(const u32x4*)(gb + ro + bj * HALF);
                    f32x4 r0, r1;
                    r0[0] = bflo(a.x) * __builtin_amdgcn_rcpf(fmaxf(bflo(b.x), 1e-20f)); r0[1] = bfhi(a.x) * __builtin_amdgcn_rcpf(fmaxf(bfhi(b.x), 1e-20f)); r0[2] = bflo(a.y) * __builtin_amdgcn_rcpf(fmaxf(bflo(b.y), 1e-20f)); r0[3] = bfhi(a.y) * __builtin_amdgcn_rcpf(fmaxf(bfhi(b.y), 1e-20f));
                    r1[0] = bflo(a.z) * __builtin_amdgcn_rcpf(fmaxf(bflo(b.z), 1e-20f)); r1[1] = bfhi(a.z) * __builtin_amdgcn_rcpf(fmaxf(bfhi(b.z), 1e-20f)); r1[2] = bflo(a.w) * __builtin_amdgcn_rcpf(fmaxf(bflo(b.w), 1e-20f)); r1[3] = bfhi(a.w) * __builtin_amdgcn_rcpf(fmaxf(bfhi(b.w), 1e-20f));
                    acc[ai][bj][m][0] = acc[ai][bj][m][0] * r0; acc[ai][bj][m][1] = acc[ai][bj][m][1] * r1; } }
    }
    __device__ __forceinline__ void operator()(const f32x4 (&acc)[2][2][4][2], const Unit& u, int wr, int wc, int fr, int fq) const {
        const int row0 = u.pm * BM + wr * 64 + fr, col0 = u.pn * BM + wc * 32 + 8 * fq;
#pragma unroll
        for (int ai = 0; ai < 2; ++ai)
#pragma unroll
            for (int m = 0; m < 4; ++m) { const size_t ro = (size_t)(row0 + ai * HALF + m * 16) * 1024 + col0;
#pragma unroll
                for (int bj = 0; bj < 2; ++bj) { const u32x4 b = *(const u32x4*)(gb + ro + bj * HALF); f32x4 v0 = acc[ai][bj][m][0], v1 = acc[ai][bj][m][1];
                    v0[0] *= fmaxf(bflo(b.x), 1e-20f); v0[1] *= fmaxf(bfhi(b.x), 1e-20f); v0[2] *= fmaxf(bflo(b.y), 1e-20f); v0[3] *= fmaxf(bfhi(b.y), 1e-20f);
                    v1[0] *= fmaxf(bflo(b.z), 1e-20f); v1[1] *= fmaxf(bfhi(b.z), 1e-20f); v1[2] *= fmaxf(bflo(b.w), 1e-20f); v1[3] *= fmaxf(bfhi(b.w), 1e-20f);
                    u32x4 w; w.x = cvt_pk_bf16(v0[0], v0[1]); w.y = cvt_pk_bf16(v0[2], v0[3]); w.z = cvt_pk_bf16(v1[0], v1[1]); w.w = cvt_pk_bf16(v1[2], v1[3]);
                    ST16((u32x4*)(out + ro + bj * HALF), w); } }
    }
};
struct EpiRes {
    static constexpr bool PERM = false, AFTER_DRAIN = false, HAS_MID = false;
    const float* base; float* C;
    __device__ __forceinline__ void operator()(const f32x4 (&acc)[2][2][4][2], const Unit& u, int wr, int wc, int fr, int fq) const {
        const int row0 = u.pm * BM + wr * 64 + fr, col0 = u.pn * BM + wc * 32 + 4 * fq;
#pragma unroll
        for (int ai = 0; ai < 2; ++ai)
#pragma unroll
            for (int m = 0; m < 4; ++m) { const size_t ro = (size_t)(row0 + ai * HALF + m * 16) * 1024 + col0;
#pragma unroll
                for (int bj = 0; bj < 2; ++bj)
#pragma unroll
                    for (int n = 0; n < 2; ++n) { const f32x4 v_ = *(const f32x4*)(base + ro + bj * HALF + n * 16) + acc[ai][bj][m][n]; ST16((f32x4*)(C + ro + bj * HALF + n * 16), v_); } }
    }
};
struct EpiResStats {
    static constexpr bool PERM = false, AFTER_DRAIN = false, HAS_MID = false;
    const float* base; float* C; bf16_t* Cb; const float* w; float* rowss; unsigned* rowamax;
    __device__ __forceinline__ void operator()(const f32x4 (&acc)[2][2][4][2], const Unit& u, int wr, int wc, int fr, int fq) const {
        const int row0 = u.pm * BM + wr * 64 + fr, col0 = u.pn * BM + wc * 32 + 4 * fq;
        f32x4 wv[2][2];
#pragma unroll
        for (int bj = 0; bj < 2; ++bj)
#pragma unroll
            for (int n = 0; n < 2; ++n) wv[bj][n] = *(const f32x4*)(w + col0 + bj * HALF + n * 16);
#pragma unroll
        for (int ai = 0; ai < 2; ++ai)
#pragma unroll
            for (int m = 0; m < 4; ++m) { const int row = row0 + ai * HALF + m * 16; const size_t ro = (size_t)row * 1024 + col0; float ss = 0.f, am = 0.f;
#pragma unroll
                for (int bj = 0; bj < 2; ++bj)
#pragma unroll
                    for (int n = 0; n < 2; ++n) { const f32x4 v = *(const f32x4*)(base + ro + bj * HALF + n * 16) + acc[ai][bj][m][n];
                        *(f32x4*)(C + ro + bj * HALF + n * 16) = v;
                        typedef unsigned u32x2 __attribute__((ext_vector_type(2))); u32x2 pb; pb.x = cvt_pk_bf16(v[0], v[1]); pb.y = cvt_pk_bf16(v[2], v[3]); *(u32x2*)(Cb + ro + bj * HALF + n * 16) = pb;
                        ss += (v[0] * v[0] + v[1] * v[1]) + (v[2] * v[2] + v[3] * v[3]);
                        const f32x4 t = v * wv[bj][n]; am = fmaxf(am, fmaxf(fmaxf(fabsf(t[0]), fabsf(t[1])), fmaxf(fabsf(t[2]), fabsf(t[3])))); }
                ss += __shfl_xor(ss, 16); ss += __shfl_xor(ss, 32); am = fmaxf(am, __shfl_xor(am, 16)); am = fmaxf(am, __shfl_xor(am, 32));
                if (fq == 0) { rowss[(size_t)row * 16 + u.pn * 4 + wc] = ss; rowamax[(size_t)row * 16 + u.pn * 4 + wc] = __builtin_bit_cast(unsigned, am); } }
    }
};
struct EpiPlainRstd {
    static constexpr bool PERM = true, AFTER_DRAIN = false, HAS_MID = false;
    bf16_t* O; int ldc; const float* rowss;
    __device__ __forceinline__ void operator()(const f32x4 (&acc)[2][2][4][2], const Unit& u, int wr, int wc, int fr, int fq) const {
        const int row0 = u.pm * BM + wr * 64 + fr, col0 = u.pn * BM + wc * 32 + 8 * fq;
#pragma unroll
        for (int ai = 0; ai < 2; ++ai)
#pragma unroll
            for (int m = 0; m < 4; ++m) { const int row = row0 + ai * HALF + m * 16; bf16_t* rowp = O + (size_t)row * ldc + col0;
                const f32x4* rp_ = (const f32x4*)(rowss + (size_t)row * 16); const f32x4 q_ = (rp_[0] + rp_[1]) + (rp_[2] + rp_[3]);
                const float rstd = 1.0f / sqrtf(((q_[0] + q_[1]) + (q_[2] + q_[3])) * (1.0f / 1024.0f) + 1e-6f);
#pragma unroll
                for (int bj = 0; bj < 2; ++bj) { const f32x4 v0 = acc[ai][bj][m][0] * rstd, v1 = acc[ai][bj][m][1] * rstd;
                    u32x4 w; w.x = cvt_pk_bf16(v0[0], v0[1]); w.y = cvt_pk_bf16(v0[2], v0[3]); w.z = cvt_pk_bf16(v1[0], v1[1]); w.w = cvt_pk_bf16(v1[2], v1[3]);
                    ST16((u32x4*)(rowp + bj * HALF), w); } }
    }
};
struct EpiPlain {
    static constexpr bool PERM = true, AFTER_DRAIN = false, HAS_MID = false;
    bf16_t* O; int ldc;
    __device__ __forceinline__ void operator()(const f32x4 (&acc)[2][2][4][2], const Unit& u, int wr, int wc, int fr, int fq) const {
        const int row0 = u.pm * BM + wr * 64 + fr, col0 = u.pn * BM + wc * 32 + 8 * fq;
#pragma unroll
        for (int ai = 0; ai < 2; ++ai)
#pragma unroll
            for (int m = 0; m < 4; ++m) { bf16_t* rowp = O + (size_t)(row0 + ai * HALF + m * 16) * ldc + col0;
#pragma unroll
                for (int bj = 0; bj < 2; ++bj) { const f32x4 v0 = acc[ai][bj][m][0], v1 = acc[ai][bj][m][1];
                    u32x4 w; w.x = cvt_pk_bf16(v0[0], v0[1]); w.y = cvt_pk_bf16(v0[2], v0[3]); w.z = cvt_pk_bf16(v1[0], v1[1]); w.w = cvt_pk_bf16(v1[2], v1[3]);
                    ST16((u32x4*)(rowp + bj * HALF), w); } }
    }
};
}

__device__ __forceinline__ void p0_transpose_item(const float* W, int K, int N, bf16* WT, LAS float* scr, int item, int lane, int ldk = 0, int koff = 0, const float* kscale = nullptr) {
    if (ldk == 0) ldk = K;
    const int nblk = N / 32, kb = item / nblk, nb = item % nblk, k0 = 64 * kb, n0 = 32 * nb;
#pragma unroll 8
    for (int i = 0; i < 32; ++i) { const int kk = 2 * i + (lane >> 5); scr[kk * 33 + (lane & 31)] = W[(size_t)(k0 + kk) * N + n0 + (lane & 31)] * (kscale ? kscale[k0 + kk] : 1.0f); }
    LDS_WAIT(); asm volatile("" ::: "memory");
    const int c = lane & 7;
#pragma unroll
    for (int j = 0; j < 4; ++j) { const int n = (lane >> 3) + 8 * j; const LAS float* s = scr + (8 * c) * 33 + n;
        v4u o; o.x = pk2(s[0 * 33], s[1 * 33]); o.y = pk2(s[2 * 33], s[3 * 33]); o.z = pk2(s[4 * 33], s[5 * 33]); o.w = pk2(s[6 * 33], s[7 * 33]);
        *(v4u*)(WT + (size_t)(n0 + n) * ldk + koff + k0 + 8 * c) = o; }
    LDS_WAIT(); asm volatile("" ::: "memory");
}
__device__ __forceinline__ void cvt_flat(const float* src, bf16* dst, size_t n, int gw, int NGW, int lane) {
    for (size_t i = (size_t)gw * 512 + lane * 8; i < n; i += (size_t)NGW * 512) {
        const f32x4 a = *(const f32x4*)(src + i), b = *(const f32x4*)(src + i + 4);
        v4u o; o.x = pk2(a[0], a[1]); o.y = pk2(a[2], a[3]); o.z = pk2(b[0], b[1]); o.w = pk2(b[2], b[3]);
        *(v4u*)(dst + i) = o;
    }
}
__device__ __forceinline__ void rms_row_to_bf16(const float* xrow, const float* w, bf16* orow, int lane) {
    const f32x4* xr = (const f32x4*)xrow + lane; const f32x4* wr = (const f32x4*)w + lane;
    f32x4 v[4]; float s = 0.f;
#pragma unroll
    for (int j = 0; j < 4; ++j) { v[j] = xr[64 * j]; s += (v[j][0] * v[j][0] + v[j][1] * v[j][1]) + (v[j][2] * v[j][2] + v[j][3] * v[j][3]); }
    const float rstd = 1.0f / sqrtf(wave_sum(s) * (1.0f / 1024.0f) + EPS);
    unsigned long long* o8 = (unsigned long long*)orow + lane;
#pragma unroll
    for (int j = 0; j < 4; ++j) { const f32x4 ww = wr[64 * j];
        o8[64 * j] = (unsigned long long)pk2(v[j][0] * rstd * ww[0], v[j][1] * rstd * ww[1]) | ((unsigned long long)pk2(v[j][2] * rstd * ww[2], v[j][3] * rstd * ww[3]) << 32); }
}

__device__ __forceinline__ int pack_i8x4(float a, float b, float c, float d) {
    const int qa = (int)__builtin_rintf(a), qb = (int)__builtin_rintf(b), qc = (int)__builtin_rintf(c), qd = (int)__builtin_rintf(d);
    return (qa & 255) | ((qb & 255) << 8) | ((qc & 255) << 16) | ((int)((unsigned)qd << 24));
}
__device__ __forceinline__ void rms_row_to_bf16_fp8(const float* xrow, const float* w, bf16* orow, unsigned char* o8row, float* oinv, int lane) {
    const f32x4* xr = (const f32x4*)xrow + lane; const f32x4* wr = (const f32x4*)w + lane;
    f32x4 v[4]; float s = 0.f;
#pragma unroll
    for (int j = 0; j < 4; ++j) { v[j] = xr[64 * j]; s += (v[j][0] * v[j][0] + v[j][1] * v[j][1]) + (v[j][2] * v[j][2] + v[j][3] * v[j][3]); }
    const float rstd = 1.0f / sqrtf(wave_sum(s) * (1.0f / 1024.0f) + EPS);
    unsigned long long* o8 = (unsigned long long*)orow + lane; float mx = 0.f;
#pragma unroll
    for (int j = 0; j < 4; ++j) { const f32x4 ww = wr[64 * j]; v[j] = v[j] * rstd * ww;
        o8[64 * j] = (unsigned long long)pk2(v[j][0], v[j][1]) | ((unsigned long long)pk2(v[j][2], v[j][3]) << 32);
        mx = fmaxf(mx, fmaxf(fmaxf(fabsf(v[j][0]), fabsf(v[j][1])), fmaxf(fabsf(v[j][2]), fabsf(v[j][3])))); }
#pragma unroll
    for (int o = 1; o < 64; o <<= 1) mx = fmaxf(mx, __shfl_xor(mx, o));
#if U_INT4
    const bool tiny = mx < 1e-30f;
    const float scale = tiny ? 0.f : 119.0f / mx, inv = tiny ? 0.f : mx * (1.0f / 119.0f);
#pragma unroll
    for (int j = 0; j < 4; ++j) {
        unsigned pa = 0u, pb = 0u;
#pragma unroll
        for (int e = 0; e < 4; ++e) { const int q = (int)__builtin_rintf(v[j][e] * scale); const int b = ((q + 8) & 15) - 8; const int a = (q - b) >> 4;
            pa |= (unsigned)(a & 15) << (4 * e); pb |= (unsigned)(b & 15) << (4 * e); }
        const unsigned na = (unsigned)__shfl_xor((int)pa, 1), nb = (unsigned)__shfl_xor((int)pb, 1);
        const unsigned da = (lane & 1) ? (na | (pa << 16)) : (pa | (na << 16)), db = (lane & 1) ? (nb | (pb << 16)) : (pb | (nb << 16));
        *(unsigned*)(o8row + 32 * ((lane >> 3) + 8 * j) + 4 * ((lane & 7) >> 1) + ((lane & 1) ? 16 : 0)) = (lane & 1) ? db : da;
    }
#elif U_INT8
    const bool tiny = mx < 1e-30f;
    const float scale = tiny ? 0.f : 127.0f / mx, inv = tiny ? 0.f : mx * (1.0f / 127.0f);
#pragma unroll
    for (int j = 0; j < 4; ++j) *(int*)(o8row + 4 * lane + 256 * j) = pack_i8x4(v[j][0] * scale, v[j][1] * scale, v[j][2] * scale, v[j][3] * scale);
#else
    const int ex = (int)((__builtin_bit_cast(unsigned, mx) >> 23) & 0xffu);
    const bool tiny = ex < 32;
    const float scale = tiny ? 1.0f : __builtin_bit_cast(float, (unsigned)(254 + 7 - ex) << 23);
    const float inv = tiny ? 1.0f : __builtin_bit_cast(float, (unsigned)(ex - 7) << 23);
#pragma unroll
    for (int j = 0; j < 4; ++j) { int p = __builtin_amdgcn_cvt_pk_fp8_f32(v[j][0] * scale, v[j][1] * scale, 0, false); p = __builtin_amdgcn_cvt_pk_fp8_f32(v[j][2] * scale, v[j][3] * scale, p, true);
        *(int*)(o8row + 4 * lane + 256 * j) = p; }
#endif
    if (lane == 0) *oinv = inv;
}

struct Ptrs {
    const float *x, *mix_w, *w_in, *rel_bias, *sinks, *w_pa, *ln_w, *ln_b, *w_s, *b_s, *w_pb, *w_out, *ffn_w, *w_q, *keys1, *keys2, *pu, *pv, *fin_w;
    float* out;
    unsigned char *U8, *V8, *HN8; float *USC, *VSC, *HSC; float* rowss; unsigned* rowamax;
    bf16 *WIN, *WPA, *WPB, *WOUT, *WQ, *K1, *K2, *WS, *U, *V, *XN, *AOUT, *BOUT, *HN2, *Q, *KV, *GU, *GV, *GA, *GB, *MERGED, *QP;
};

__device__ __forceinline__ void p0_prologue(LAS unsigned char* lds, const Ptrs& P, int vcu, int G, int lane, int wave) {
    LAS float* scr = (LAS float*)(lds + wave * 16384);
    const int gw = vcu * NWAVES + wave, NGW = G * NWAVES;
    constexpr int I_IN = (1024 / 64) * (3840 / 32), I_PA = (512 / 64) * (1024 / 32), I_OUT = (1024 / 64) * (1024 / 32), I_WQ = (1024 / 64) * (2048 / 32);
    constexpr int NITEMS = I_IN + 2 * I_PA + I_OUT + I_WQ;
    for (int it = gw; it < NITEMS; it += NGW) {
        int r = it;
        if (r < I_IN) { p0_transpose_item(P.w_in, 1024, 3840, P.WIN, scr, r, lane); continue; } r -= I_IN;
        if (r < I_PA) { if (P3_FUSED) p0_transpose_item(P.w_pa, 512, 1024, P.WPA, scr, r, lane, 1024, 0); else p0_transpose_item(P.w_pa, 512, 1024, P.WPA, scr, r, lane); continue; } r -= I_PA;
        if (r < I_PA) { if (P3_FUSED) p0_transpose_item(P.w_pb, 512, 1024, P.WPA, scr, r, lane, 1024, 512); else p0_transpose_item(P.w_pb, 512, 1024, P.WPB, scr, r, lane); continue; } r -= I_PA;
        if (r < I_OUT) { p0_transpose_item(P.w_out, 1024, 1024, P.WOUT, scr, r, lane); continue; } r -= I_OUT;
        p0_transpose_item(P.w_q, 1024, 2048, P.WQ, scr, r, lane, 0, 0, P5_ELIM ? P.ffn_w : nullptr);
    }
    cvt_flat(P.keys1, P.K1, 128 * 128, gw, NGW, lane);
    cvt_flat(P.keys2, P.K2, 128 * 128, gw, NGW, lane);
#if PEER_FP8
    for (int rr = gw; rr < 2 * 16384; rr += NGW) {
        const int tab = rr >> 14, row = rr & 16383;
        const float* src = (tab ? P.pv : P.pu) + (size_t)row * 1024; unsigned char* dst = (tab ? P.V8 : P.U8) + (size_t)row * 1024;
        f32x4 v[4]; float mx = 0.f;
#pragma unroll
        for (int j = 0; j < 4; ++j) { v[j] = *(const f32x4*)(src + 4 * lane + 256 * j); mx = fmaxf(mx, fmaxf(fmaxf(fabsf(v[j][0]), fabsf(v[j][1])), fmaxf(fabsf(v[j][2]), fabsf(v[j][3])))); }
#pragma unroll
        for (int o = 1; o < 64; o <<= 1) mx = fmaxf(mx, __shfl_xor(mx, o));
        const int ex = (int)((__builtin_bit_cast(unsigned, mx) >> 23) & 0xffu);
        const bool tiny = ex < 32;
        float scale = tiny ? 1.0f : __builtin_bit_cast(float, (unsigned)(254 + 7 - ex) << 23);
        float inv = tiny ? 1.0f : __builtin_bit_cast(float, (unsigned)(ex - 7) << 23);
        if (U_INT8 && tab == 0) { scale = tiny ? 0.f : 127.0f / mx; inv = tiny ? 0.f : mx * (1.0f / 127.0f); }
#if FAKEQ_U || FAKEQ_V
        {
            const int fq = tab ? FAKEQ_V : FAKEQ_U;
            if (fq) {
#pragma unroll
                for (int j = 0; j < 4; ++j) {
                    float bm = fmaxf(fmaxf(fabsf(v[j][0]), fabsf(v[j][1])), fmaxf(fabsf(v[j][2]), fabsf(v[j][3])));
                    if (fq == 2 || fq == 3) { bm = fmaxf(bm, __shfl_xor(bm, 1)); bm = fmaxf(bm, __shfl_xor(bm, 2)); }
                    if (fq == 4 || fq == 5) { bm = fmaxf(bm, __shfl_xor(bm, 1)); bm = fmaxf(bm, __shfl_xor(bm, 2)); bm = fmaxf(bm, __shfl_xor(bm, 4)); }
                    if (fq == 1) bm = mx;
                    if (fq == 1 || fq == 2 || fq == 4) {
                        const float qs = bm > 1e-30f ? 7.0f / bm : 0.f, dq = bm * (1.0f / 7.0f);
#pragma unroll
                        for (int e = 0; e < 4; ++e) v[j][e] = __builtin_rintf(v[j][e] * qs) * dq;
                    } else {
                        float sc = bm * (1.0f / 6.0f);
                        if (fq == 5) { const int eb = (int)((__builtin_bit_cast(unsigned, bm) >> 23) & 0xffu); sc = __builtin_bit_cast(float, (unsigned)(eb - 2) << 23); }
                        const float qs = bm > 1e-30f ? 1.0f / sc : 0.f;
#pragma unroll
                        for (int e = 0; e < 4; ++e) { const float a = fabsf(v[j][e]) * qs; float q;
                            if (a < 2.0f) q = __builtin_rintf(a * 2.0f) * 0.5f; else if (a < 4.0f) q = __builtin_rintf(a); else q = fminf(__builtin_rintf(a * 0.5f) * 2.0f, 6.0f);
                            v[j][e] = copysignf(q * sc, v[j][e]); }
                    }
                }
            }
        }
#endif
#if U_INT4
        {
            float ssq = 0.f;
#pragma unroll
            for (int j = 0; j < 4; ++j) ssq += (v[j][0] * v[j][0] + v[j][1] * v[j][1]) + (v[j][2] * v[j][2] + v[j][3] * v[j][3]);
#pragma unroll
            for (int o = 1; o < 64; o <<= 1) ssq += __shfl_xor(ssq, o);
            const float sd = sqrtf(ssq * (1.0f / 1024.0f));
            if (tab == 0) {
                const float step = fmaxf(Q4_USTEP * sd, mx * (1.0f / 14.0f)); const float qs = step > 1e-30f ? 1.0f / step : 0.f;
#pragma unroll
                for (int j = 0; j < 4; ++j) { unsigned pq = 0u;
#pragma unroll
                    for (int e = 0; e < 4; ++e) pq |= (unsigned)((int)fminf(fmaxf(__builtin_rintf(v[j][e] * qs), -7.0f), 7.0f) & 15) << (4 * e);
                    const unsigned nq = (unsigned)__shfl_xor((int)pq, 1);
                    if ((lane & 1) == 0) *(unsigned*)(P.U8 + (size_t)row * 512 + 128 * j + 2 * lane) = pq | (nq << 16); }
                if (lane == 0) P.USC[row] = step;
            } else {
                const float un = fmaxf(Q4_VUNIT * sd, mx * (1.0f / 12.0f)); const float qs = un > 1e-30f ? 1.0f / un : 0.f;
                bool bad = false;
#pragma unroll
                for (int j = 0; j < 4; ++j) { unsigned pq = 0u;
#pragma unroll
                    for (int e = 0; e < 4; ++e) { const float a = fabsf(v[j][e]) * qs;
                        const int c = (int)(a >= 0.25f) + (int)(a >= 0.75f) + (int)(a >= 1.25f) + (int)(a >= 1.75f) + (int)(a >= 2.5f) + (int)(a >= 3.5f) + (int)(a >= 5.0f);
                        pq |= (unsigned)(c | (v[j][e] < 0.f ? 8 : 0)) << (4 * e); }
                    const unsigned nq = (unsigned)__shfl_xor((int)pq, 1);
                    const unsigned wq = pq | (nq << 16);
#if FP4_SELFCHECK
#pragma unroll
                    for (int b = 0; b < 4; ++b) { const h2 dv = b == 0 ? __builtin_amdgcn_cvt_scalef32_pk_f16_fp4(wq, 1.0f, 0) : b == 1 ? __builtin_amdgcn_cvt_scalef32_pk_f16_fp4(wq, 1.0f, 1) : b == 2 ? __builtin_amdgcn_cvt_scalef32_pk_f16_fp4(wq, 1.0f, 2) : __builtin_amdgcn_cvt_scalef32_pk_f16_fp4(wq, 1.0f, 3);
#pragma unroll
                        for (int n = 0; n < 2; ++n) { const unsigned c = (wq >> (8 * b + 4 * n)) & 15u; const unsigned m = c & 7u;
                            const float lv = m == 0 ? 0.f : m == 1 ? 0.5f : m == 2 ? 1.0f : m == 3 ? 1.5f : m == 4 ? 2.0f : m == 5 ? 3.0f : m == 6 ? 4.0f : 6.0f;
                            const float ex_ = (c & 8u) ? -lv : lv; if ((float)dv[n] != ex_) bad = true; } }
#endif
                    if ((lane & 1) == 0) *(unsigned*)(P.V8 + (size_t)row * 512 + 128 * j + 2 * lane) = wq; }
                if (FP4_SELFCHECK && __ballot(bad) != 0ull) { if (lane == 0) P.VSC[row] = __builtin_nanf(""); }
                else if (lane == 0) P.VSC[row] = un;
            }
            continue;
        }
#endif
#pragma unroll
        for (int j = 0; j < 4; ++j) { int p = __builtin_amdgcn_cvt_pk_fp8_f32(v[j][0] * scale, v[j][1] * scale, 0, false); p = __builtin_amdgcn_cvt_pk_fp8_f32(v[j][2] * scale, v[j][3] * scale, p, true);
            if (U_INT8 && tab == 0) p = pack_i8x4(v[j][0] * scale, v[j][1] * scale, v[j][2] * scale, v[j][3] * scale);
            const int c_ = 4 * lane + 256 * j;
            const int o_ = (U_MFMA && tab == 0) ? ((c_ >> 6) * 64 + ((c_ >> 3) & 3) * 16 + ((c_ >> 5) & 1) * 8 + (c_ & 7)) : c_;
            *(int*)(dst + o_) = p; }
        if (lane == 0) (tab ? P.VSC : P.USC)[row] = inv;
    }
#else
    cvt_flat(P.pu, P.U, (size_t)16384 * 1024, gw, NGW, lane);
    cvt_flat(P.pv, P.V, (size_t)16384 * 1024, gw, NGW, lane);
#endif
    for (size_t i = (size_t)gw * 512 + lane * 8; i < (size_t)8 * 128 * 128; i += (size_t)NGW * 512) {
        const int t = (int)((i >> 7) & 127), s0 = (int)(i & 127);
        const f32x4 a = *(const f32x4*)(P.w_s + i), b = *(const f32x4*)(P.w_s + i + 4);
        float e[8] = {a[0], a[1], a[2], a[3], b[0], b[1], b[2], b[3]};
#pragma unroll
        for (int j = 0; j < 8; ++j) e[j] = (s0 + j <= t) ? e[j] : 0.f;
        v4u o; o.x = pk2(e[0], e[1]); o.y = pk2(e[2], e[3]); o.z = pk2(e[4], e[5]); o.w = pk2(e[6], e[7]);
        *(v4u*)(P.WS + i) = o;
    }
    for (int m = gw; m < M; m += NGW) rms_row_to_bf16(P.x + (size_t)m * D, P.mix_w, P.XN + (size_t)m * D, lane);
}

__device__ __forceinline__ void p2_attn_naive(LAS unsigned char* lds, const Ptrs& P, int vcu, int G, int tid, int lane, int wave) {
    LAS float* biasl = (LAS float*)lds;
    for (int i = tid; i < 1024; i += 512) { const int d = i >> 3, h = i & 7; biasl[i] = P.rel_bias[(int)T5B[d] * 8 + h]; }
    __syncthreads();
    const int h = wave, kvh = h >> 2;
    const float sink = P.sinks[h];
    for (int unit = vcu; unit < M / 64; unit += G) {
        const int t = unit * 64 + lane, pos = t & (SEQ - 1);
        float q[64], o[64];
        { const v4u* qp = (const v4u*)(P.Q + (size_t)t * 512 + h * 64);
#pragma unroll
          for (int c = 0; c < 8; ++c) { const v4u w = qp[c]; q[8 * c + 0] = bflo(w.x) * 0.125f; q[8 * c + 1] = bfhi(w.x) * 0.125f; q[8 * c + 2] = bflo(w.y) * 0.125f; q[8 * c + 3] = bfhi(w.y) * 0.125f;
              q[8 * c + 4] = bflo(w.z) * 0.125f; q[8 * c + 5] = bfhi(w.z) * 0.125f; q[8 * c + 6] = bflo(w.w) * 0.125f; q[8 * c + 7] = bfhi(w.w) * 0.125f; } }
#pragma unroll
        for (int i = 0; i < 64; ++i) o[i] = 0.f;
        float m = sink, l = 1.f;
        for (int d = 0; d < 128; ++d) {
            const bool valid = (pos - d) >= 0;
            const int tj = valid ? (t - d) : t;
            const v4u* kp = (const v4u*)(P.KV + (size_t)tj * 256 + kvh * 64);
            float dot = 0.f;
#pragma unroll
            for (int c = 0; c < 8; ++c) { const v4u w = kp[c];
                dot += q[8 * c + 0] * bflo(w.x) + q[8 * c + 1] * bfhi(w.x) + q[8 * c + 2] * bflo(w.y) + q[8 * c + 3] * bfhi(w.y) + q[8 * c + 4] * bflo(w.z) + q[8 * c + 5] * bfhi(w.z) + q[8 * c + 6] * bflo(w.w) + q[8 * c + 7] * bfhi(w.w); }
            const float s = valid ? dot + biasl[d * 8 + h] : -1e30f;
            const float mn = fmaxf(m, s), alpha = __expf(m - mn), p = __expf(s - mn);
            l = l * alpha + p; m = mn;
            const v4u* vp = kp + 16;
#pragma unroll
            for (int c = 0; c < 8; ++c) { const v4u w = vp[c];
                o[8 * c + 0] = o[8 * c + 0] * alpha + p * bflo(w.x); o[8 * c + 1] = o[8 * c + 1] * alpha + p * bfhi(w.x); o[8 * c + 2] = o[8 * c + 2] * alpha + p * bflo(w.y); o[8 * c + 3] = o[8 * c + 3] * alpha + p * bfhi(w.y);
                o[8 * c + 4] = o[8 * c + 4] * alpha + p * bflo(w.z); o[8 * c + 5] = o[8 * c + 5] * alpha + p * bfhi(w.z); o[8 * c + 6] = o[8 * c + 6] * alpha + p * bflo(w.w); o[8 * c + 7] = o[8 * c + 7] * alpha + p * bfhi(w.w); }
        }
        const float inv = 1.0f / l;
        v4u* op = (v4u*)(P.AOUT + (size_t)t * AB_LD + h * 64);
#pragma unroll
        for (int c = 0; c < 8; ++c) { v4u w; w.x = pk2(o[8 * c + 0] * inv, o[8 * c + 1] * inv); w.y = pk2(o[8 * c + 2] * inv, o[8 * c + 3] * inv); w.z = pk2(o[8 * c + 4] * inv, o[8 * c + 5] * inv); w.w = pk2(o[8 * c + 6] * inv, o[8 * c + 7] * inv); op[c] = w; }
    }
    __syncthreads();
}

__device__ __forceinline__ void p2_gmlp_naive(LAS unsigned char* lds, const Ptrs& P, int vcu, int G, int tid, int lane, int wave) {
    LAS bf16* vnl = (LAS bf16*)(lds + 8192);
    for (int unit = vcu; unit < 256; unit += G) {
        const int c = unit >> 1, hh = unit & 1;
        for (int i = 0; i < 16; ++i) {
            const int tt = wave * 16 + i; const size_t row = (size_t)c * 128 + tt;
            const v4u w = *((const v4u*)(P.GV + row * 512) + lane);
            float x[8] = {bflo(w.x), bfhi(w.x), bflo(w.y), bfhi(w.y), bflo(w.z), bfhi(w.z), bflo(w.w), bfhi(w.w)};
            float s = 0.f;
#pragma unroll
            for (int j = 0; j < 8; ++j) s += x[j];
            const float mean = wave_sum(s) * (1.0f / 512.0f);
            float ss = 0.f;
#pragma unroll
            for (int j = 0; j < 8; ++j) { x[j] -= mean; ss += x[j] * x[j]; }
            const float rstd = 1.0f / sqrtf(wave_sum(ss) * (1.0f / 512.0f) + EPS);
            if ((lane >> 5) == hh) {
                const f32x4 w0 = *(const f32x4*)(P.ln_w + lane * 8), w1 = *(const f32x4*)(P.ln_w + lane * 8 + 4), b0 = *(const f32x4*)(P.ln_b + lane * 8), b1 = *(const f32x4*)(P.ln_b + lane * 8 + 4);
                v4u o; o.x = pk2(x[0] * rstd * w0[0] + b0[0], x[1] * rstd * w0[1] + b0[1]); o.y = pk2(x[2] * rstd * w0[2] + b0[2], x[3] * rstd * w0[3] + b0[3]);
                o.z = pk2(x[4] * rstd * w1[0] + b1[0], x[5] * rstd * w1[1] + b1[1]); o.w = pk2(x[6] * rstd * w1[2] + b1[2], x[7] * rstd * w1[3] + b1[3]);
                *(LAS v4u*)(vnl + tt * 256 + (lane & 31) * 8) = o;
            }
        }
        __syncthreads();
        const int ch = tid & 255, th = tid >> 8, g = hh * 4 + (ch >> 6);
        for (int t = th * 64; t < th * 64 + 64; ++t) {
            const v4u* wrow = (const v4u*)(P.WS + ((size_t)g * 128 + t) * 128);
            float acc = 0.f;
            for (int s8 = 0; s8 <= (t >> 3); ++s8) {
                const v4u w = wrow[s8];
                const LAS bf16* vp = vnl + (s8 * 8) * 256 + ch;
                acc += bflo(w.x) * bf2f(vp[0]) + bfhi(w.x) * bf2f(vp[256]) + bflo(w.y) * bf2f(vp[512]) + bfhi(w.y) * bf2f(vp[768])
                     + bflo(w.z) * bf2f(vp[1024]) + bfhi(w.z) * bf2f(vp[1280]) + bflo(w.w) * bf2f(vp[1536]) + bfhi(w.w) * bf2f(vp[1792]);
            }
            const size_t row = (size_t)c * 128 + t;
            const float uval = bf2f(P.GU[row * 512 + hh * 256 + ch]);
            P.BOUT[row * AB_LD + hh * 256 + ch] = (bf16)f2bf(uval * (acc + P.b_s[g * 128 + t]));
        }
        __syncthreads();
    }
}

typedef short s16x8 __attribute__((ext_vector_type(8)));
typedef short s16x4 __attribute__((ext_vector_type(4)));
typedef float f32x16 __attribute__((ext_vector_type(16)));
typedef float f32x2v __attribute__((ext_vector_type(2)));
#define MFMA32(a, b, c) __builtin_amdgcn_mfma_f32_32x32x16_bf16((a), (b), (c), 0, 0, 0)
__device__ __forceinline__ s16x4 tr16(const LAS unsigned char* p) { return __builtin_bit_cast(s16x4, __builtin_amdgcn_ds_read_tr16_b64_v4i16((LAS s16x4*)p)); }
__device__ __forceinline__ unsigned cvtpk(float lo, float hi) { f32x2v v = {lo, hi}; bf16x2_t b = __builtin_convertvector(v, bf16x2_t); return __builtin_bit_cast(unsigned, b); }
__device__ __forceinline__ int crow(int reg, int h) { return (reg & 3) + 8 * (reg >> 2) + 4 * h; }
constexpr float LOG2E = 1.4426950408889634f;

__device__ __forceinline__ void p2_attn_mfma(LAS unsigned char* lds, const Ptrs& P, int vcu, int G, int tid, int lane, int wave) {
    LAS unsigned char* Kl = lds;
    LAS unsigned char* Vl = lds + 32768;
    LAS float* biasl = (LAS float*)(lds + 32768 + 49152);
    const int r = lane & 31, h = lane >> 5, i16 = lane & 15, q4 = i16 >> 2, p4 = i16 & 3, blk = (lane >> 4) & 1;
    for (int unit = vcu; unit < 256; unit += G) {
        const int kvh = unit & 1, blkid = unit >> 1, nb = blkid & 63; const int tok0 = blkid * 128;
#pragma unroll
        for (int i = 0; i < 4; ++i) {
            const int cidx = tid + 512 * i, row = cidx >> 3, c = cidx & 7;
            v4u kw = {0u, 0u, 0u, 0u}, vw = {0u, 0u, 0u, 0u};
            if (nb > 0 || row >= 128) { const bf16* src = P.KV + (size_t)(tok0 - 128 + row) * 256 + kvh * 64 + c * 8; kw = *(const v4u*)src; vw = *(const v4u*)(src + 128); }
            *(LAS v4u*)(Kl + row * 128 + ((c ^ ((row >> 1) & 7)) << 4)) = kw;
            *(LAS v4u*)(Vl + row * 192 + c * 16) = vw;
        }
        biasl[tid] = P.rel_bias[(int)T5B[tid & 127] * 8 + kvh * 4 + (tid >> 7)] * LOG2E;
        __syncthreads();
        const int g = wave >> 1, qh = wave & 1, hq = kvh * 4 + g;
        const float sink2 = P.sinks[hq] * LOG2E;
#pragma unroll 1
        for (int qs = 0; qs < 2; ++qs) {
            const int qi0 = 64 * qh + 32 * qs, kt0 = 2 * qh + qs;
            s16x8 qf[4];
            { const bf16* qrow = P.Q + (size_t)(tok0 + qi0 + r) * 512 + hq * 64 + 8 * h;
#pragma unroll
              for (int ks = 0; ks < 4; ++ks) qf[ks] = *(const s16x8*)(qrow + 16 * ks); }
            f32x16 s[5];
#pragma unroll
            for (int i = 0; i < 5; ++i) {
#pragma unroll
                for (int e = 0; e < 16; ++e) s[i][e] = 0.f;
                const int key = 32 * (kt0 + i) + r; const LAS unsigned char* kp = Kl + key * 128; const int sw = (key >> 1) & 7;
#pragma unroll
                for (int ks = 0; ks < 4; ++ks) { const s16x8 kf = *(const LAS s16x8*)(kp + (((2 * ks + h) ^ sw) << 4)); s[i] = MFMA32(kf, qf[ks], s[i]); }
            }
            const int qi = qi0 + r;
            float mx = sink2;
#pragma unroll
            for (int i = 0; i < 5; ++i)
#pragma unroll
                for (int e = 0; e < 16; ++e) {
                    const int kj = 32 * (kt0 + i) + crow(e, h), dist = 128 + qi - kj;
                    const bool valid = (dist >= 0) && (dist < 128) && (nb > 0 || kj >= 128);
                    const float b = biasl[g * 128 + (dist & 127)];
                    const float v = valid ? s[i][e] * (0.125f * LOG2E) + b : -1e30f;
                    s[i][e] = v; mx = fmaxf(mx, v);
                }
            mx = fmaxf(mx, xor32_f(mx));
            float l = 0.f;
#pragma unroll
            for (int i = 0; i < 5; ++i)
#pragma unroll
                for (int e = 0; e < 16; ++e) { const float p = __builtin_amdgcn_exp2f(s[i][e] - mx); s[i][e] = p; l += p; }
            l += xor32_f(l);
            l += __builtin_amdgcn_exp2f(sink2 - mx);
            f32x16 o0, o1;
#pragma unroll
            for (int e = 0; e < 16; ++e) { o0[e] = 0.f; o1[e] = 0.f; }
#pragma unroll
            for (int i = 0; i < 5; ++i)
#pragma unroll
                for (int st = 0; st < 2; ++st) {
                    v4u pw; pw.x = cvtpk(s[i][8 * st], s[i][8 * st + 1]); pw.y = cvtpk(s[i][8 * st + 2], s[i][8 * st + 3]); pw.z = cvtpk(s[i][8 * st + 4], s[i][8 * st + 5]); pw.w = cvtpk(s[i][8 * st + 6], s[i][8 * st + 7]);
                    const s16x8 pf = __builtin_bit_cast(s16x8, pw);
                    const LAS unsigned char* vb = Vl + (32 * (kt0 + i) + 16 * st + 4 * h + q4) * 192 + 32 * blk + 8 * p4;
                    { const s16x4 lo = tr16(vb), hi = tr16(vb + 8 * 192); const s16x8 vf = __builtin_shufflevector(lo, hi, 0, 1, 2, 3, 4, 5, 6, 7); o0 = MFMA32(vf, pf, o0); }
                    { const s16x4 lo = tr16(vb + 64), hi = tr16(vb + 64 + 8 * 192); const s16x8 vf = __builtin_shufflevector(lo, hi, 0, 1, 2, 3, 4, 5, 6, 7); o1 = MFMA32(vf, pf, o1); }
                }
            const float inv = 1.0f / l;
            bf16* orow = P.AOUT + (size_t)(tok0 + qi) * AB_LD + hq * 64 + 4 * h;
#pragma unroll
            for (int r4 = 0; r4 < 4; ++r4) {
                v2u w0; w0.x = cvtpk(o0[4 * r4] * inv, o0[4 * r4 + 1] * inv); w0.y = cvtpk(o0[4 * r4 + 2] * inv, o0[4 * r4 + 3] * inv); *(v2u*)(orow + 8 * r4) = w0;
                v2u w1; w1.x = cvtpk(o1[4 * r4] * inv, o1[4 * r4 + 1] * inv); w1.y = cvtpk(o1[4 * r4 + 2] * inv, o1[4 * r4 + 3] * inv); *(v2u*)(orow + 32 + 8 * r4) = w1;
            }
        }
        __syncthreads();
    }
}

__device__ __forceinline__ void p2_gmlp_mfma(LAS unsigned char* lds, const Ptrs& P, int vcu, int G, int tid, int lane, int wave) {
    LAS unsigned char* vnl = lds;
    const int r = lane & 31, h = lane >> 5, i16 = lane & 15, q4 = i16 >> 2, p4 = i16 & 3, blk = (lane >> 4) & 1;
    for (int unit = vcu; unit < 256; unit += G) {
        const int c = unit >> 1, hh = unit & 1;
        v4u gvw[16];
#pragma unroll
        for (int i = 0; i < 16; ++i) gvw[i] = *((const v4u*)(P.GV + ((size_t)c * 128 + wave * 16 + i) * 512) + lane);
        const f32x4 lw0 = *(const f32x4*)(P.ln_w + lane * 8), lw1 = *(const f32x4*)(P.ln_w + lane * 8 + 4), lb0 = *(const f32x4*)(P.ln_b + lane * 8), lb1 = *(const f32x4*)(P.ln_b + lane * 8 + 4);
#pragma unroll
        for (int i = 0; i < 16; ++i) {
            const int tt = wave * 16 + i;
            const v4u w = gvw[i];
            float x[8] = {bflo(w.x), bfhi(w.x), bflo(w.y), bfhi(w.y), bflo(w.z), bfhi(w.z), bflo(w.w), bfhi(w.w)};
            float s = 0.f;
#pragma unroll
            for (int j = 0; j < 8; ++j) s += x[j];
            const float mean = wave_sum(s) * (1.0f / 512.0f);
            float ss = 0.f;
#pragma unroll
            for (int j = 0; j < 8; ++j) { x[j] -= mean; ss += x[j] * x[j]; }
            const float rstd = 1.0f / sqrtf(wave_sum(ss) * (1.0f / 512.0f) + EPS);
            if ((lane >> 5) == hh) {
                const f32x4 w0 = lw0, w1 = lw1, b0 = lb0, b1 = lb1;
                v4u o; o.x = pk2(x[0] * rstd * w0[0] + b0[0], x[1] * rstd * w0[1] + b0[1]); o.y = pk2(x[2] * rstd * w0[2] + b0[2], x[3] * rstd * w0[3] + b0[3]);
                o.z = pk2(x[4] * rstd * w1[0] + b1[0], x[5] * rstd * w1[1] + b1[1]); o.w = pk2(x[6] * rstd * w1[2] + b1[2], x[7] * rstd * w1[3] + b1[3]);
                *(LAS v4u*)(vnl + tt * 576 + (lane & 31) * 16) = o;
            }
        }
        __syncthreads();
        const int gi = wave >> 1, dblk = wave & 1, g = hh * 4 + gi;
        s16x8 af[8];
#pragma unroll
        for (int ks = 0; ks < 8; ++ks) { const LAS unsigned char* vb = vnl + (16 * ks + 8 * h + q4) * 576 + (gi * 64 + dblk * 32 + 16 * blk) * 2 + 8 * p4;
            const s16x4 lo = tr16(vb), hi = tr16(vb + 4 * 576); af[ks] = __builtin_shufflevector(lo, hi, 0, 1, 2, 3, 4, 5, 6, 7); }
#pragma unroll
        for (int tt = 0; tt < 4; ++tt) {
            f32x16 acc;
#pragma unroll
            for (int e = 0; e < 16; ++e) acc[e] = 0.f;
            const bf16* wrow = P.WS + ((size_t)g * 128 + 32 * tt + r) * 128 + 8 * h;
#pragma unroll
            for (int ks = 0; ks < 2 * (tt + 1); ++ks) acc = MFMA32(af[ks], *(const s16x8*)(wrow + 16 * ks), acc);
            const int t = 32 * tt + r; const size_t row = (size_t)c * 128 + t; const float b = P.b_s[g * 128 + t];
#pragma unroll
            for (int r4 = 0; r4 < 4; ++r4) {
                const int ch = g * 64 + dblk * 32 + 8 * r4 + 4 * h;
                const v2u uw = *(const v2u*)(P.GU + row * 512 + ch);
                v2u ow; ow.x = cvtpk(bflo(uw.x) * (acc[4 * r4] + b), bfhi(uw.x) * (acc[4 * r4 + 1] + b)); ow.y = cvtpk(bflo(uw.y) * (acc[4 * r4 + 2] + b), bfhi(uw.y) * (acc[4 * r4 + 3] + b));
                *(v2u*)(P.BOUT + row * AB_LD + ch) = ow;
            }
        }
        __syncthreads();
    }
}

__device__ __forceinline__ void topk_half(const bf16* q, const LAS bf16* kl, float (&v)[16]) {
    v4u qv[16];
#pragma unroll
    for (int c = 0; c < 16; ++c) qv[c] = ((const v4u*)q)[c];
#pragma unroll
    for (int i = 0; i < 16; ++i) v[i] = -INFINITY;
    for (int n = 0; n < 128; ++n) {
        const LAS v4u* kr = (const LAS v4u*)(kl + n * 128);
        float a0 = 0.f, a1 = 0.f, a2 = 0.f, a3 = 0.f;
#pragma unroll
        for (int c = 0; c < 16; ++c) { const v4u kk = kr[c]; a0 = dot2bf(qv[c].x, kk.x, a0); a1 = dot2bf(qv[c].y, kk.y, a1); a2 = dot2bf(qv[c].z, kk.z, a2); a3 = dot2bf(qv[c].w, kk.w, a3); }
        const float acc = (a0 + a1) + (a2 + a3);
        float x = __builtin_bit_cast(float, (__builtin_bit_cast(unsigned, acc) & ~0x7Fu) | (unsigned)n);
#pragma unroll
        for (int i = 0; i < 16; ++i) { const float hi = fmaxf(v[i], x); x = fminf(v[i], x); v[i] = hi; }
    }
}

__host__ __device__ constexpr int cand_slot(int i, int j) { int c = 0; for (int a = 0; a < 16; ++a) for (int b = 0; b < 16; ++b) { if (a == i && b == j) return c; if ((a + 1) * (b + 1) <= 16) ++c; } return c; }
#define CE_DESC(a, b) do { const float hi_ = fmaxf((a), (b)); const float lo_ = fminf((a), (b)); (a) = hi_; (b) = lo_; } while (0)
__device__ __forceinline__ void sort16_desc(float (&v)[16]) {
    CE_DESC(v[0], v[1]); CE_DESC(v[3], v[2]); CE_DESC(v[4], v[5]); CE_DESC(v[7], v[6]); CE_DESC(v[8], v[9]); CE_DESC(v[11], v[10]); CE_DESC(v[12], v[13]); CE_DESC(v[15], v[14]); CE_DESC(v[0], v[2]); CE_DESC(v[1], v[3]); CE_DESC(v[6], v[4]); CE_DESC(v[7], v[5]); CE_DESC(v[8], v[10]); CE_DESC(v[9], v[11]); CE_DESC(v[14], v[12]); CE_DESC(v[15], v[13]); CE_DESC(v[0], v[1]); CE_DESC(v[2], v[3]); CE_DESC(v[5], v[4]); CE_DESC(v[7], v[6]); CE_DESC(v[8], v[9]); CE_DESC(v[10], v[11]); CE_DESC(v[13], v[12]); CE_DESC(v[15], v[14]); CE_DESC(v[0], v[4]); CE_DESC(v[1], v[5]); CE_DESC(v[2], v[6]); CE_DESC(v[3], v[7]); CE_DESC(v[12], v[8]); CE_DESC(v[13], v[9]); CE_DESC(v[14], v[10]); CE_DESC(v[15], v[11]); CE_DESC(v[0], v[2]); CE_DESC(v[1], v[3]); CE_DESC(v[4], v[6]); CE_DESC(v[5], v[7]); CE_DESC(v[10], v[8]); CE_DESC(v[11], v[9]); CE_DESC(v[14], v[12]); CE_DESC(v[15], v[13]); CE_DESC(v[0], v[1]); CE_DESC(v[2], v[3]); CE_DESC(v[4], v[5]); CE_DESC(v[6], v[7]); CE_DESC(v[9], v[8]); CE_DESC(v[11], v[10]); CE_DESC(v[13], v[12]); CE_DESC(v[15], v[14]); CE_DESC(v[0], v[8]); CE_DESC(v[1], v[9]); CE_DESC(v[2], v[10]); CE_DESC(v[3], v[11]); CE_DESC(v[4], v[12]); CE_DESC(v[5], v[13]); CE_DESC(v[6], v[14]); CE_DESC(v[7], v[15]); CE_DESC(v[0], v[4]); CE_DESC(v[1], v[5]); CE_DESC(v[2], v[6]); CE_DESC(v[3], v[7]); CE_DESC(v[8], v[12]); CE_DESC(v[9], v[13]); CE_DESC(v[10], v[14]); CE_DESC(v[11], v[15]); CE_DESC(v[0], v[2]); CE_DESC(v[1], v[3]); CE_DESC(v[4], v[6]); CE_DESC(v[5], v[7]); CE_DESC(v[8], v[10]); CE_DESC(v[9], v[11]); CE_DESC(v[12], v[14]); CE_DESC(v[13], v[15]); CE_DESC(v[0], v[1]); CE_DESC(v[2], v[3]); CE_DESC(v[4], v[5]); CE_DESC(v[6], v[7]); CE_DESC(v[8], v[9]); CE_DESC(v[10], v[11]); CE_DESC(v[12], v[13]); CE_DESC(v[14], v[15]);
}
__device__ __forceinline__ void merge_top16(float (&a)[16], const float (&b)[16]) {
    a[0] = fmaxf(a[0], b[15]); a[1] = fmaxf(a[1], b[14]); a[2] = fmaxf(a[2], b[13]); a[3] = fmaxf(a[3], b[12]); a[4] = fmaxf(a[4], b[11]); a[5] = fmaxf(a[5], b[10]); a[6] = fmaxf(a[6], b[9]); a[7] = fmaxf(a[7], b[8]); a[8] = fmaxf(a[8], b[7]); a[9] = fmaxf(a[9], b[6]); a[10] = fmaxf(a[10], b[5]); a[11] = fmaxf(a[11], b[4]); a[12] = fmaxf(a[12], b[3]); a[13] = fmaxf(a[13], b[2]); a[14] = fmaxf(a[14], b[1]); a[15] = fmaxf(a[15], b[0]); CE_DESC(a[0], a[8]); CE_DESC(a[1], a[9]); CE_DESC(a[2], a[10]); CE_DESC(a[3], a[11]); CE_DESC(a[4], a[12]); CE_DESC(a[5], a[13]); CE_DESC(a[6], a[14]); CE_DESC(a[7], a[15]); CE_DESC(a[0], a[4]); CE_DESC(a[1], a[5]); CE_DESC(a[2], a[6]); CE_DESC(a[3], a[7]); CE_DESC(a[8], a[12]); CE_DESC(a[9], a[13]); CE_DESC(a[10], a[14]); CE_DESC(a[11], a[15]); CE_DESC(a[0], a[2]); CE_DESC(a[1], a[3]); CE_DESC(a[4], a[6]); CE_DESC(a[5], a[7]); CE_DESC(a[8], a[10]); CE_DESC(a[9], a[11]); CE_DESC(a[12], a[14]); CE_DESC(a[13], a[15]); CE_DESC(a[0], a[1]); CE_DESC(a[2], a[3]); CE_DESC(a[4], a[5]); CE_DESC(a[6], a[7]); CE_DESC(a[8], a[9]); CE_DESC(a[10], a[11]); CE_DESC(a[12], a[13]); CE_DESC(a[14], a[15]);
}
__device__ __forceinline__ void scores_top16(const bf16* qbase, const LAS unsigned char* kl, int r, int h, float (&t)[16]) {
#if TOPK_DBG_INSERT == 3
#pragma unroll
    for (int k = 0; k < 16; ++k) t[k] = -1e30f;
#pragma unroll 1
    for (int key = 0; key < 128; ++key) { float a = 0.f;
        if (((key >> 2) & 1) != h) continue;
        for (int c = 0; c < 16; ++c) { const v4u q1 = *(const v4u*)(qbase + (size_t)r * 256 + 8 * c); const v4u kk1 = *(const LAS v4u*)(kl + key * 256 + 16 * c);
            a = dot2bf(q1.x, kk1.x, a); a = dot2bf(q1.y, kk1.y, a); a = dot2bf(q1.z, kk1.z, a); a = dot2bf(q1.w, kk1.w, a); }
        float x = __builtin_bit_cast(float, (__builtin_bit_cast(unsigned, a) & ~0x7Fu) | (unsigned)key);
#pragma unroll
        for (int i = 0; i < 16; ++i) { const float hi = fmaxf(t[i], x); x = fminf(t[i], x); t[i] = hi; } }
    return;
#endif
    f32x16 acc[4];
#pragma unroll
    for (int kt = 0; kt < 4; ++kt)
#pragma unroll
        for (int e = 0; e < 16; ++e) acc[kt][e] = 0.f;
    const LAS unsigned char* kp0 = kl + r * 256; const int sw = KEY_SWZ ? (r & 15) : 0;
#pragma unroll
    for (int ks = 0; ks < 8; ++ks) {
        const s16x8 qf = *(const s16x8*)(qbase + (size_t)r * 256 + 16 * ks + 8 * h);
#pragma unroll
        for (int kt = 0; kt < 4; ++kt) { const s16x8 kf = *(const LAS s16x8*)(kp0 + kt * 8192 + (((2 * ks + h) ^ sw) << 4)); acc[kt] = MFMA32(kf, qf, acc[kt]); }
    }
    float g[4][16];
#pragma unroll
    for (int kt = 0; kt < 4; ++kt) {
#pragma unroll
        for (int e = 0; e < 16; ++e) { const float av_ = acc[kt][e];
            g[kt][e] = __builtin_bit_cast(float, (__builtin_bit_cast(unsigned, av_) & ~0x7Fu) | (unsigned)(32 * kt + (e & 3) + 8 * (e >> 2))); }
#if !TOPK_DBG_INSERT
        sort16_desc(g[kt]);
#endif
    }
#if TOPK_DBG_INSERT == 2
#pragma unroll
    for (int k = 0; k < 16; ++k) t[k] = -1e30f;
#pragma unroll
    for (int kt = 0; kt < 4; ++kt)
#pragma unroll
        for (int e = 0; e < 16; ++e) t[0] = fmaxf(t[0], g[kt][e]);
#elif TOPK_DBG_INSERT
#pragma unroll
    for (int k = 0; k < 16; ++k) t[k] = -1e30f;
#pragma unroll
    for (int kt = 0; kt < 4; ++kt)
#pragma unroll
        for (int e = 0; e < 16; ++e) { float x = g[kt][e];
#pragma unroll
            for (int i = 0; i < 16; ++i) { const float hi = fmaxf(t[i], x); x = fminf(t[i], x); t[i] = hi; } }
#else
    merge_top16(g[0], g[1]); merge_top16(g[2], g[3]); merge_top16(g[0], g[2]);
#pragma unroll
    for (int k = 0; k < 16; ++k) t[k] = __builtin_bit_cast(float, __builtin_bit_cast(unsigned, g[0][k]) | ((unsigned)h << 2));
#endif
}
__device__ __forceinline__ void peer_topk_unit_mfma(const Ptrs& P, const LAS unsigned char* k1l, const LAS unsigned char* k2l, LAS int* idxl, LAS float* gatel, int unit, int lane, int wave, int rb_lo = 0, int rb_hi = 2) {
    asm volatile("" : "+v"(lane));
    const int r = lane & 31, h = lane >> 5;
#pragma unroll 1
    for (int rbi = rb_lo; rbi < rb_hi; ++rbi) {
        const int rb = wave * 2 + rbi, R = rb * 32 + r;
        const bf16* qbase = P.QP + ((size_t)unit * 512 + rb * 32) * 256;
        float t1[16], t2[16];
#if TOPK_DBG_BRUTE
#pragma unroll
        for (int k = 0; k < 16; ++k) { t1[k] = -1e30f; t2[k] = -1e30f; }
#pragma unroll 1
        for (int key = 0; key < 128; ++key) { float a = 0.f, b = 0.f;
            if (((key >> 2) & 1) != h) continue;
            for (int c = 0; c < 16; ++c) { const v4u q1 = *(const v4u*)(qbase + (size_t)r * 256 + 8 * c), q2 = *(const v4u*)(qbase + 128 + (size_t)r * 256 + 8 * c);
                const v4u kk1 = *(const LAS v4u*)(k1l + key * 256 + 16 * c), kk2 = *(const LAS v4u*)(k2l + key * 256 + 16 * c);
                a = dot2bf(q1.x, kk1.x, a); a = dot2bf(q1.y, kk1.y, a); a = dot2bf(q1.z, kk1.z, a); a = dot2bf(q1.w, kk1.w, a);
                b = dot2bf(q2.x, kk2.x, b); b = dot2bf(q2.y, kk2.y, b); b = dot2bf(q2.z, kk2.z, b); b = dot2bf(q2.w, kk2.w, b); }
            float x = __builtin_bit_cast(float, (__builtin_bit_cast(unsigned, a) & ~0x7Fu) | (unsigned)key), y = __builtin_bit_cast(float, (__builtin_bit_cast(unsigned, b) & ~0x7Fu) | (unsigned)key);
#pragma unroll
            for (int i = 0; i < 16; ++i) { const float hi = fmaxf(t1[i], x); x = fminf(t1[i], x); t1[i] = hi; const float hj = fmaxf(t2[i], y); y = fminf(t2[i], y); t2[i] = hj; } }
#else
        scores_top16(qbase, k1l, r, h, t1);
        __builtin_amdgcn_sched_barrier(0);
        scores_top16(qbase + 128, k2l, r, h, t2);
        __builtin_amdgcn_sched_barrier(0);
#endif
        float F[16], recv[16];
#pragma unroll
        for (int k = 0; k < 16; ++k) { auto rr = __builtin_amdgcn_permlane32_swap(__builtin_bit_cast(unsigned, t1[k]), __builtin_bit_cast(unsigned, t2[k]), false, false);
            const unsigned r0 = rr[0], r1 = rr[1]; F[k] = __builtin_bit_cast(float, r0); recv[k] = __builtin_bit_cast(float, r1); }
        merge_top16(F, recv);
        LAS unsigned char* slot = (LAS unsigned char*)(idxl + R * 16);
        { v4u b;
          b.x = (__builtin_bit_cast(unsigned, F[0]) & 0x7Fu) | ((__builtin_bit_cast(unsigned, F[1]) & 0x7Fu) << 8) | ((__builtin_bit_cast(unsigned, F[2]) & 0x7Fu) << 16) | ((__builtin_bit_cast(unsigned, F[3]) & 0x7Fu) << 24);
          b.y = (__builtin_bit_cast(unsigned, F[4]) & 0x7Fu) | ((__builtin_bit_cast(unsigned, F[5]) & 0x7Fu) << 8) | ((__builtin_bit_cast(unsigned, F[6]) & 0x7Fu) << 16) | ((__builtin_bit_cast(unsigned, F[7]) & 0x7Fu) << 24);
          b.z = (__builtin_bit_cast(unsigned, F[8]) & 0x7Fu) | ((__builtin_bit_cast(unsigned, F[9]) & 0x7Fu) << 8) | ((__builtin_bit_cast(unsigned, F[10]) & 0x7Fu) << 16) | ((__builtin_bit_cast(unsigned, F[11]) & 0x7Fu) << 24);
          b.w = (__builtin_bit_cast(unsigned, F[12]) & 0x7Fu) | ((__builtin_bit_cast(unsigned, F[13]) & 0x7Fu) << 8) | ((__builtin_bit_cast(unsigned, F[14]) & 0x7Fu) << 16) | ((__builtin_bit_cast(unsigned, F[15]) & 0x7Fu) << 24);
#if !TOPK_DBG_GATES_ONLY
          *(LAS v4u*)(slot + 16 * h) = b;
#endif
          (void)b; }
#if TOPK_DBG_COMPARE == 7 || TOPK_DBG_COMPARE == 8
        { float best1 = -1e30f, best2 = -1e30f;
#pragma unroll 1
          for (int key = 0; key < 128; ++key) { float a = 0.f, b = 0.f;
              if (TOPK_DBG_COMPARE == 8 && ((key >> 2) & 1) != h) continue;
              for (int c = 0; c < 16; ++c) { const v4u q1 = *(const v4u*)(qbase + (size_t)r * 256 + 8 * c), q2 = *(const v4u*)(qbase + 128 + (size_t)r * 256 + 8 * c);
                  const v4u kk1 = *(const LAS v4u*)(k1l + key * 256 + 16 * c), kk2 = *(const LAS v4u*)(k2l + key * 256 + 16 * c);
                  a = dot2bf(q1.x, kk1.x, a); a = dot2bf(q1.y, kk1.y, a); a = dot2bf(q1.z, kk1.z, a); a = dot2bf(q1.w, kk1.w, a);
                  b = dot2bf(q2.x, kk2.x, b); b = dot2bf(q2.y, kk2.y, b); b = dot2bf(q2.z, kk2.z, b); b = dot2bf(q2.w, kk2.w, b); }
              best1 = fmaxf(best1, __builtin_bit_cast(float, (__builtin_bit_cast(unsigned, a) & ~0x7Fu) | (unsigned)key));
              best2 = fmaxf(best2, __builtin_bit_cast(float, (__builtin_bit_cast(unsigned, b) & ~0x7Fu) | (unsigned)key)); }
          *(LAS unsigned*)((LAS unsigned char*)idxl + 65536 + R * 8 + 4 * h) = (__builtin_bit_cast(unsigned, best1) & 0x7Fu) | ((__builtin_bit_cast(unsigned, best2) & 0x7Fu) << 16); }
#endif
#if TOPK_DBG_COMPARE == 9
        { float m1 = t1[0], m2 = t2[0];
#pragma unroll
          for (int k = 1; k < 16; ++k) { m1 = fmaxf(m1, t1[k]); m2 = fmaxf(m2, t2[k]); }
          *(LAS unsigned*)((LAS unsigned char*)idxl + 65536 + R * 8 + 4 * h) = (__builtin_bit_cast(unsigned, m1) & 0x7Fu) | ((__builtin_bit_cast(unsigned, m2) & 0x7Fu) << 16); }
#endif
#if TOPK_DBG_COMPARE == 6
        *(LAS unsigned*)((LAS unsigned char*)idxl + 65536 + R * 8 + 4 * h) = (__builtin_bit_cast(unsigned, t1[0]) & 0x7Fu) | ((__builtin_bit_cast(unsigned, t1[1]) & 0x7Fu) << 8) | ((__builtin_bit_cast(unsigned, t2[0]) & 0x7Fu) << 16) | ((__builtin_bit_cast(unsigned, t2[1]) & 0x7Fu) << 24);
#endif
#if TOPK_DBG_COMPARE == 4
        *(LAS unsigned*)((LAS unsigned char*)idxl + 65536 + R * 8 + 4 * h) = (__builtin_bit_cast(unsigned, F[TOPK_DBG_K0]) & 0x7Fu) | ((__builtin_bit_cast(unsigned, F[TOPK_DBG_K0 + 1]) & 0x7Fu) << 8) | ((__builtin_bit_cast(unsigned, F[TOPK_DBG_K0 + 2]) & 0x7Fu) << 16) | ((__builtin_bit_cast(unsigned, F[TOPK_DBG_K0 + 3]) & 0x7Fu) << 24);
#endif
        float v1[16], v2[16];
#pragma unroll
        for (int k = 0; k < 16; ++k) { auto rr = __builtin_amdgcn_permlane32_swap(__builtin_bit_cast(unsigned, F[k]), __builtin_bit_cast(unsigned, F[k]), false, false);
            const unsigned r0 = rr[0], r1 = rr[1]; v1[k] = __builtin_bit_cast(float, r0 & ~0x7Fu); v2[k] = __builtin_bit_cast(float, r1 & ~0x7Fu); }
        float cg[4][16];
#pragma unroll
        for (int a = 0; a < 4; ++a)
#pragma unroll
            for (int k = 0; k < 16; ++k) cg[a][k] = -1e30f;
#define CAND(i, j) __builtin_bit_cast(float, (__builtin_bit_cast(unsigned, v1[i] + v2[j]) & ~0xFFu) | (unsigned)((i) * 16 + (j)))
        cg[0][0] = CAND(0, 0);
        cg[0][1] = CAND(0, 1);
        cg[0][2] = CAND(0, 2);
        cg[0][3] = CAND(0, 3);
        cg[0][4] = CAND(0, 4);
        cg[0][5] = CAND(0, 5);
        cg[0][6] = CAND(0, 6);
        cg[0][7] = CAND(0, 7);
        cg[0][8] = CAND(0, 8);
        cg[0][9] = CAND(0, 9);
        cg[0][10] = CAND(0, 10);
        cg[0][11] = CAND(0, 11);
        cg[0][12] = CAND(0, 12);
        cg[0][13] = CAND(0, 13);
        cg[0][14] = CAND(0, 14);
        cg[0][15] = CAND(0, 15);
        cg[1][0] = CAND(1, 0);
        cg[1][1] = CAND(1, 1);
        cg[1][2] = CAND(1, 2);
        cg[1][3] = CAND(1, 3);
        cg[1][4] = CAND(1, 4);
        cg[1][5] = CAND(1, 5);
        cg[1][6] = CAND(1, 6);
        cg[1][7] = CAND(1, 7);
        cg[1][8] = CAND(2, 0);
        cg[1][9] = CAND(2, 1);
        cg[1][10] = CAND(2, 2);
        cg[1][11] = CAND(2, 3);
        cg[1][12] = CAND(2, 4);
        cg[1][13] = CAND(3, 0);
        cg[1][14] = CAND(3, 1);
        cg[1][15] = CAND(3, 2);
        cg[2][0] = CAND(3, 3);
        cg[2][1] = CAND(4, 0);
        cg[2][2] = CAND(4, 1);
        cg[2][3] = CAND(4, 2);
        cg[2][4] = CAND(5, 0);
        cg[2][5] = CAND(5, 1);
        cg[2][6] = CAND(6, 0);
        cg[2][7] = CAND(6, 1);
        cg[2][8] = CAND(7, 0);
        cg[2][9] = CAND(7, 1);
        cg[2][10] = CAND(8, 0);
        cg[2][11] = CAND(9, 0);
        cg[2][12] = CAND(10, 0);
        cg[2][13] = CAND(11, 0);
        cg[2][14] = CAND(12, 0);
        cg[2][15] = CAND(13, 0);
        cg[3][0] = CAND(14, 0);
        cg[3][1] = CAND(15, 0);
#undef CAND
        sort16_desc(cg[0]); sort16_desc(cg[1]); sort16_desc(cg[2]); sort16_desc(cg[3]);
        merge_top16(cg[0], cg[1]); merge_top16(cg[2], cg[3]); merge_top16(cg[0], cg[2]);
        float es = 0.f, e[16];
        const float top = __builtin_bit_cast(float, __builtin_bit_cast(unsigned, cg[0][0]) & ~0xFFu);
#pragma unroll
        for (int k = 0; k < 16; ++k) { e[k] = __expf(__builtin_bit_cast(float, __builtin_bit_cast(unsigned, cg[0][k]) & ~0xFFu) - top); es += e[k]; }
        const float inv = 1.0f / es;
        LDS_WAIT();
        unsigned id[8]; float gt[8];
#pragma unroll
        for (int k = 0; k < 8; ++k) { const float clo_ = cg[0][k], chi_ = cg[0][8 + k], elo_ = e[k], ehi_ = e[8 + k]; const unsigned code = __builtin_bit_cast(unsigned, h ? chi_ : clo_) & 0xFFu; gt[k] = (h ? ehi_ : elo_) * inv;
            id[k] = (unsigned)slot[code >> 4] * 128u + (unsigned)slot[16 + (code & 15u)]; }
        LDS_WAIT();
        LAS v4u* ip = (LAS v4u*)(idxl + R * 16 + 8 * h); LAS f32x4* gp = (LAS f32x4*)(gatel + R * 16 + 8 * h);
#if !TOPK_DBG_GATES_ONLY
        { v4u a; a.x = id[0]; a.y = id[1]; a.z = id[2]; a.w = id[3]; ip[0] = a; v4u b; b.x = id[4]; b.y = id[5]; b.z = id[6]; b.w = id[7]; ip[1] = b; }
#else
        (void)ip;
#endif
        { f32x4 a; a[0] = gt[0]; a[1] = gt[1]; a[2] = gt[2]; a[3] = gt[3]; gp[0] = a; f32x4 b; b[0] = gt[4]; b[1] = gt[5]; b[2] = gt[6]; b[3] = gt[7]; gp[1] = b; }
    }
}

__device__ __forceinline__ void peer_topk_unit(const Ptrs& P, const LAS bf16* k1l, const LAS bf16* k2l, LAS int* idxl, LAS float* gatel, int unit, int tid) {
    const int tl = tid >> 3, h = tid & 7;
    const bf16* qrow = P.QP + (size_t)(unit * 64 + tl) * 2048 + h * 256;
    float v1[16], v2[16];
    topk_half(qrow, k1l, v1);
    topk_half(qrow + 128, k2l, v2);
    int bad4 = 0;
#if TOPK_DBG_COMPARE == 4
    { const LAS unsigned char* sl = (const LAS unsigned char*)idxl + 65536 + tid * 8;
#pragma unroll
      for (int k = 0; k < 4; ++k) {
          if (TOPK_DBG_SEL != 2 && (unsigned)sl[k] != (__builtin_bit_cast(unsigned, v1[TOPK_DBG_K0 + k]) & 0x7Fu)) bad4 = 1;
          if (TOPK_DBG_SEL != 1 && (unsigned)sl[4 + k] != (__builtin_bit_cast(unsigned, v2[TOPK_DBG_K0 + k]) & 0x7Fu)) bad4 = 1; }
      LDS_WAIT(); }
#endif
#if TOPK_DBG_COMPARE >= 6
    { const LAS unsigned char* sl = (const LAS unsigned char*)idxl + 65536 + tid * 8;
      const unsigned a1 = __builtin_bit_cast(unsigned, v1[0]) & 0x7Fu, a2 = __builtin_bit_cast(unsigned, v2[0]) & 0x7Fu;
      if (TOPK_DBG_SEL != 2 && a1 != (unsigned)sl[0] && a1 != (unsigned)sl[4]) bad4 = 1;
      if (TOPK_DBG_SEL != 1 && a2 != (unsigned)sl[2] && a2 != (unsigned)sl[6]) bad4 = 1;
      LDS_WAIT(); }
#endif
    (void)bad4;
    float tv[16]; int tp[16];
#pragma unroll
    for (int k = 0; k < 16; ++k) { tv[k] = -INFINITY; tp[k] = 0; }
#pragma unroll
    for (int i = 0; i < 16; ++i)
#pragma unroll
        for (int j = 0; j < 16; ++j)
            if ((i + 1) * (j + 1) <= 16) {
                const unsigned b1 = __builtin_bit_cast(unsigned, v1[i]), b2 = __builtin_bit_cast(unsigned, v2[j]);
                float x = __builtin_bit_cast(float, b1 & ~0x7Fu) + __builtin_bit_cast(float, b2 & ~0x7Fu);
                int px = (int)((b1 & 0x7Fu) * 128u + (b2 & 0x7Fu));
#pragma unroll
                for (int k = 0; k < 16; ++k) { const bool c = x > tv[k]; const float nv = c ? x : tv[k], nx = c ? tv[k] : x; const int np = c ? px : tp[k], npx = c ? tp[k] : px; tv[k] = nv; x = nx; tp[k] = np; px = npx; }
            }
    float e[16], es = 0.f;
#pragma unroll
    for (int k = 0; k < 16; ++k) { e[k] = __expf(tv[k] - tv[0]); es += e[k]; }
    const float inv = 1.0f / es;
    LAS v4u* ip = (LAS v4u*)(idxl + tl * 128 + h * 16); LAS f32x4* gp = (LAS f32x4*)(gatel + tl * 128 + h * 16);
#if TOPK_DBG_COMPARE
    { int bad = bad4; unsigned hs_old = 0, hs_new = 0, hx_old = 0, hx_new = 0;
#pragma unroll
      for (int k = 0; k < 16; ++k) { const int ni = idxl[tl * 128 + h * 16 + k]; const float ng = gatel[tl * 128 + h * 16 + k];
          hs_old += (unsigned)tp[k]; hs_new += (unsigned)ni; hx_old ^= (unsigned)tp[k] * 2654435761u; hx_new ^= (unsigned)ni * 2654435761u;
          if (TOPK_DBG_COMPARE == 1 && (k >= TOPK_DBG_K0 && k < TOPK_DBG_K1) && ni != tp[k]) bad = 1;
          if (TOPK_DBG_COMPARE == 3 && (k >= TOPK_DBG_K0 && k < TOPK_DBG_K1) && fabsf(ng - e[k] * inv) > 2e-3f) bad = 1; }
      if (TOPK_DBG_COMPARE == 2 && (hs_old != hs_new || hx_old != hx_new)) bad = 1;
      ((LAS int*)((LAS unsigned char*)idxl + 65536 + 4096))[tid] = bad; }
#endif
#pragma unroll
    for (int k = 0; k < 4; ++k) { v4u iv; iv.x = (unsigned)tp[4 * k]; iv.y = (unsigned)tp[4 * k + 1]; iv.z = (unsigned)tp[4 * k + 2]; iv.w = (unsigned)tp[4 * k + 3]; ip[k] = iv;
        f32x4 gv; gv[0] = e[4 * k] * inv; gv[1] = e[4 * k + 1] * inv; gv[2] = e[4 * k + 2] * inv; gv[3] = e[4 * k + 3] * inv; gp[k] = gv; }
}

#if PEER_FP8
typedef float f32x2p __attribute__((ext_vector_type(2)));
__device__ __forceinline__ unsigned fp8lo_bf16(unsigned w) { return __builtin_bit_cast(unsigned, __builtin_amdgcn_cvt_scalef32_pk_bf16_fp8((int)w, 1.0f, false)); }
__device__ __forceinline__ unsigned fp8hi_bf16(unsigned w) { return __builtin_bit_cast(unsigned, __builtin_amdgcn_cvt_scalef32_pk_bf16_fp8((int)w, 1.0f, true)); }
template <bool STORE> __device__ __forceinline__ void peer_gather_token(const Ptrs& P, const LAS int* idxl, const LAS float* gatel, LAS float* al, int tl, size_t t, int lane, int wave) {
    asm volatile("" : "+v"(lane));
    const int sub = lane & 15, grp = lane >> 4;
    v4u hnr[4][2];
#pragma unroll
    for (int j = 0; j < 4; ++j) { const v4u* hp = (const v4u*)(P.HN2 + t * 1024 + (j * 16 + sub) * 16); hnr[j][0] = hp[0]; hnr[j][1] = hp[1]; }
    const LAS int* myidx = idxl + tl * 128;
    v4u w[4][4]; float sc[4];
#define ULOAD(B, Q) do { const int row_ = myidx[4 * (Q) + grp]; const v4u* up_ = (const v4u*)(P.U8 + (size_t)row_ * 1024) + sub; \
        _Pragma("unroll") for (int j = 0; j < 4; ++j) w[B][j] = up_[j * 16]; sc[B] = P.USC[row_]; } while (0)
#define UCOMP(B, Q) do { float a0 = 0.f, a1 = 0.f, a2 = 0.f, a3 = 0.f; \
        _Pragma("unroll") for (int j = 0; j < 4; ++j) { const v4u x_ = w[B][j]; \
            a0 = dot2bf(fp8lo_bf16(x_.x), hnr[j][0].x, a0); a1 = dot2bf(fp8hi_bf16(x_.x), hnr[j][0].y, a1); a2 = dot2bf(fp8lo_bf16(x_.y), hnr[j][0].z, a2); a3 = dot2bf(fp8hi_bf16(x_.y), hnr[j][0].w, a3); \
            a0 = dot2bf(fp8lo_bf16(x_.z), hnr[j][1].x, a0); a1 = dot2bf(fp8hi_bf16(x_.z), hnr[j][1].y, a1); a2 = dot2bf(fp8lo_bf16(x_.w), hnr[j][1].z, a2); a3 = dot2bf(fp8hi_bf16(x_.w), hnr[j][1].w, a3); } \
        float acc_ = row16_sum((a0 + a1) + (a2 + a3)); \
        if (sub == 0) al[wave * 128 + 4 * (Q) + grp] = acc_ * sc[B]; } while (0)
    ULOAD(0, 0); ULOAD(1, 1); ULOAD(2, 2);
#pragma unroll 1
    for (int q = 0; q < 32; q += 4) {
        ULOAD(3, q + 3); UCOMP(0, q);
        if (q + 4 < 32) ULOAD(0, q + 4);
        UCOMP(1, q + 1);
        if (q + 4 < 32) ULOAD(1, q + 5);
        UCOMP(2, q + 2);
        if (q + 4 < 32) ULOAD(2, q + 6);
        UCOMP(3, q + 3);
    }
#undef ULOAD
#undef UCOMP
    LDS_WAIT();
    const int ix0 = myidx[lane], ix1 = myidx[64 + lane];
    const float av0 = al[wave * 128 + lane], av1 = al[wave * 128 + 64 + lane];
    const float act0 = gelu_tanh(av0) * gatel[tl * 128 + lane] * P.VSC[ix0], act1 = gelu_tanh(av1) * gatel[tl * 128 + 64 + lane] * P.VSC[ix1];
    LDS_WAIT();
    float y[16];
#pragma unroll
    for (int k = 0; k < 16; ++k) y[k] = 0.f;
    v4u vb[2][8];
#define VLOAD(B, IX, E0) do { _Pragma("unroll") for (int k = 0; k < 8; ++k) { const int row_ = __builtin_amdgcn_readlane(IX, (E0) + k); vb[B][k] = *((const v4u*)(P.V8 + (size_t)row_ * 1024) + lane); } } while (0)
#define VCOMP(B, ACT, E0) do { _Pragma("unroll") for (int k = 0; k < 8; ++k) { const float a_ = __builtin_bit_cast(float, __builtin_amdgcn_readlane(__builtin_bit_cast(int, ACT), (E0) + k)); const v4u x_ = vb[B][k]; \
        f32x2p d_; d_ = __builtin_amdgcn_cvt_pk_f32_fp8((int)x_.x, false); y[0] += a_ * d_[0]; y[1] += a_ * d_[1]; d_ = __builtin_amdgcn_cvt_pk_f32_fp8((int)x_.x, true); y[2] += a_ * d_[0]; y[3] += a_ * d_[1]; \
        d_ = __builtin_amdgcn_cvt_pk_f32_fp8((int)x_.y, false); y[4] += a_ * d_[0]; y[5] += a_ * d_[1]; d_ = __builtin_amdgcn_cvt_pk_f32_fp8((int)x_.y, true); y[6] += a_ * d_[0]; y[7] += a_ * d_[1]; \
        d_ = __builtin_amdgcn_cvt_pk_f32_fp8((int)x_.z, false); y[8] += a_ * d_[0]; y[9] += a_ * d_[1]; d_ = __builtin_amdgcn_cvt_pk_f32_fp8((int)x_.z, true); y[10] += a_ * d_[0]; y[11] += a_ * d_[1]; \
        d_ = __builtin_amdgcn_cvt_pk_f32_fp8((int)x_.w, false); y[12] += a_ * d_[0]; y[13] += a_ * d_[1]; d_ = __builtin_amdgcn_cvt_pk_f32_fp8((int)x_.w, true); y[14] += a_ * d_[0]; y[15] += a_ * d_[1]; } } while (0)
    VLOAD(0, ix0, 0);
#pragma unroll 1
    for (int e = 0; e < 64; e += 16) { VLOAD(1, ix0, e + 8); VCOMP(0, act0, e); if (e + 16 < 64) VLOAD(0, ix0, e + 16); else VLOAD(0, ix1, 0); VCOMP(1, act0, e + 8); }
#pragma unroll 1
    for (int e = 0; e < 64; e += 16) { VLOAD(1, ix1, e + 8); VCOMP(0, act1, e); if (e + 16 < 64) VLOAD(0, ix1, e + 16); VCOMP(1, act1, e + 8); }
#undef VLOAD
#undef VCOMP
    float* xr = P.out + t * 1024 + lane * 16;
    f32x4 x[4];
#pragma unroll
    for (int k = 0; k < 4; ++k) { x[k] = *(const f32x4*)(xr + 4 * k); x[k][0] += y[4 * k]; x[k][1] += y[4 * k + 1]; x[k][2] += y[4 * k + 2]; x[k][3] += y[4 * k + 3]; }
    float ss = 0.f;
#pragma unroll
    for (int k = 0; k < 4; ++k) ss += (x[k][0] * x[k][0] + x[k][1] * x[k][1]) + (x[k][2] * x[k][2] + x[k][3] * x[k][3]);
    const float rstd = 1.0f / sqrtf(wave_sum(ss) * (1.0f / 1024.0f) + EPS);
    if (STORE) {
#if TOPK_DBG_COMPARE
        { const LAS int* fl = (const LAS int*)((const LAS unsigned char*)idxl + 65536 + 4096) + tl * 8; int bad = 0;
#pragma unroll
          for (int hh = 0; hh < 8; ++hh) bad |= fl[hh];
          if (bad) {
#pragma unroll
              for (int k = 0; k < 4; ++k) x[k] = x[k] * 0.f; } }
#endif
#pragma unroll
        for (int k = 0; k < 4; ++k) { const f32x4 wv = *(const f32x4*)(P.fin_w + lane * 16 + 4 * k); *(f32x4*)(xr + 4 * k) = x[k] * rstd * wv; }
    } else { asm volatile("" :: "v"(rstd), "v"(x[0][0]), "v"(x[1][1]), "v"(x[2][2]), "v"(x[3][3])); }
}
#else
template <bool STORE> __device__ __forceinline__ void peer_gather_token(const Ptrs& P, const LAS int* idxl, const LAS float* gatel, LAS float* al, int tl, size_t t, int lane, int wave) {
    const int sub = lane & 15, grp = lane >> 4;
    v4u hnr[8];
#pragma unroll
    for (int j = 0; j < 8; ++j) hnr[j] = *((const v4u*)(P.HN2 + t * 1024) + j * 16 + sub);
    for (int q = 0; q < 32; ++q) {
        const int row = idxl[tl * 128 + 4 * q + grp];
        const v4u* up = (const v4u*)(P.U + (size_t)row * 1024) + sub;
        float a0 = 0.f, a1 = 0.f, a2 = 0.f, a3 = 0.f;
#pragma unroll
        for (int j = 0; j < 8; ++j) { const v4u w = up[j * 16]; a0 = dot2bf(w.x, hnr[j].x, a0); a1 = dot2bf(w.y, hnr[j].y, a1); a2 = dot2bf(w.z, hnr[j].z, a2); a3 = dot2bf(w.w, hnr[j].w, a3); }
        float acc = (a0 + a1) + (a2 + a3);
        acc += __shfl_xor(acc, 8); acc += __shfl_xor(acc, 4); acc += __shfl_xor(acc, 2); acc += __shfl_xor(acc, 1);
        if (sub == 0) al[wave * 128 + 4 * q + grp] = acc;
    }
    LDS_WAIT();
    const float av0 = al[wave * 128 + lane], av1 = al[wave * 128 + 64 + lane];
    const float act0 = gelu_tanh(av0) * gatel[tl * 128 + lane], act1 = gelu_tanh(av1) * gatel[tl * 128 + 64 + lane];
    const int ix0 = idxl[tl * 128 + lane], ix1 = idxl[tl * 128 + 64 + lane];
    LDS_WAIT();
    float y[16];
#pragma unroll
    for (int k = 0; k < 16; ++k) y[k] = 0.f;
#pragma unroll 4
    for (int e = 0; e < 64; ++e) {
        const int row = __builtin_amdgcn_readlane(ix0, e); const float a = __builtin_bit_cast(float, __builtin_amdgcn_readlane(__builtin_bit_cast(int, act0), e));
        const v4u* vp = (const v4u*)(P.V + (size_t)row * 1024) + lane; const v4u w0 = vp[0], w1 = vp[64];
        y[0] += a * bflo(w0.x); y[1] += a * bfhi(w0.x); y[2] += a * bflo(w0.y); y[3] += a * bfhi(w0.y); y[4] += a * bflo(w0.z); y[5] += a * bfhi(w0.z); y[6] += a * bflo(w0.w); y[7] += a * bfhi(w0.w);
        y[8] += a * bflo(w1.x); y[9] += a * bfhi(w1.x); y[10] += a * bflo(w1.y); y[11] += a * bfhi(w1.y); y[12] += a * bflo(w1.z); y[13] += a * bfhi(w1.z); y[14] += a * bflo(w1.w); y[15] += a * bfhi(w1.w);
    }
#pragma unroll 4
    for (int e = 0; e < 64; ++e) {
        const int row = __builtin_amdgcn_readlane(ix1, e); const float a = __builtin_bit_cast(float, __builtin_amdgcn_readlane(__builtin_bit_cast(int, act1), e));
        const v4u* vp = (const v4u*)(P.V + (size_t)row * 1024) + lane; const v4u w0 = vp[0], w1 = vp[64];
        y[0] += a * bflo(w0.x); y[1] += a * bfhi(w0.x); y[2] += a * bflo(w0.y); y[3] += a * bfhi(w0.y); y[4] += a * bflo(w0.z); y[5] += a * bfhi(w0.z); y[6] += a * bflo(w0.w); y[7] += a * bfhi(w0.w);
        y[8] += a * bflo(w1.x); y[9] += a * bfhi(w1.x); y[10] += a * bflo(w1.y); y[11] += a * bfhi(w1.y); y[12] += a * bflo(w1.z); y[13] += a * bfhi(w1.z); y[14] += a * bflo(w1.w); y[15] += a * bfhi(w1.w);
    }
    float* xr = P.out + t * 1024;
    f32x4 x0 = *(const f32x4*)(xr + lane * 8), x1 = *(const f32x4*)(xr + lane * 8 + 4), x2 = *(const f32x4*)(xr + 512 + lane * 8), x3 = *(const f32x4*)(xr + 512 + lane * 8 + 4);
    x0[0] += y[0]; x0[1] += y[1]; x0[2] += y[2]; x0[3] += y[3]; x1[0] += y[4]; x1[1] += y[5]; x1[2] += y[6]; x1[3] += y[7];
    x2[0] += y[8]; x2[1] += y[9]; x2[2] += y[10]; x2[3] += y[11]; x3[0] += y[12]; x3[1] += y[13]; x3[2] += y[14]; x3[3] += y[15];
    float ss = 0.f;
#pragma unroll
    for (int k = 0; k < 4; ++k) ss += x0[k] * x0[k] + x1[k] * x1[k] + x2[k] * x2[k] + x3[k] * x3[k];
    const float rstd = 1.0f / sqrtf(wave_sum(ss) * (1.0f / 1024.0f) + EPS);
    if (STORE) {
        const f32x4 w0 = *(const f32x4*)(P.fin_w + lane * 8), w1 = *(const f32x4*)(P.fin_w + lane * 8 + 4), w2 = *(const f32x4*)(P.fin_w + 512 + lane * 8), w3 = *(const f32x4*)(P.fin_w + 512 + lane * 8 + 4);
        *(f32x4*)(xr + lane * 8) = x0 * rstd * w0; *(f32x4*)(xr + lane * 8 + 4) = x1 * rstd * w1; *(f32x4*)(xr + 512 + lane * 8) = x2 * rstd * w2; *(f32x4*)(xr + 512 + lane * 8 + 4) = x3 * rstd * w3;
    } else { asm volatile("" :: "v"(rstd), "v"(x0[0]), "v"(x1[1]), "v"(x2[2]), "v"(x3[3])); }
}
#endif

__device__ __forceinline__ void peer_u_token(const Ptrs& P, const LAS int* idxl, LAS float* gatel, LAS float* al, int tl, size_t t, int lane, int wave) {
    asm volatile("" : "+v"(lane));
    const int sub = lane & 15, grp = lane >> 4;
    v4u hnr[4][2];
#pragma unroll
    for (int j = 0; j < 4; ++j) { const v4u* hp = (const v4u*)(P.HN2 + t * 1024 + (j * 16 + sub) * 16); hnr[j][0] = hp[0]; hnr[j][1] = hp[1]; }
    const LAS int* myidx = idxl + tl * 128;
    v4u w[4][4]; float sc[4];
#define ULOAD(B, Q) do { const int row_ = myidx[4 * (Q) + grp]; const v4u* up_ = (const v4u*)(P.U8 + (size_t)row_ * 1024) + sub; \
        _Pragma("unroll") for (int j = 0; j < 4; ++j) w[B][j] = up_[j * 16]; sc[B] = P.USC[row_]; } while (0)
#define UCOMP(B, Q) do { float a0 = 0.f, a1 = 0.f, a2 = 0.f, a3 = 0.f; \
        _Pragma("unroll") for (int j = 0; j < 4; ++j) { const v4u x_ = w[B][j]; \
            a0 = dot2bf(fp8lo_bf16(x_.x), hnr[j][0].x, a0); a1 = dot2bf(fp8hi_bf16(x_.x), hnr[j][0].y, a1); a2 = dot2bf(fp8lo_bf16(x_.y), hnr[j][0].z, a2); a3 = dot2bf(fp8hi_bf16(x_.y), hnr[j][0].w, a3); \
            a0 = dot2bf(fp8lo_bf16(x_.z), hnr[j][1].x, a0); a1 = dot2bf(fp8hi_bf16(x_.z), hnr[j][1].y, a1); a2 = dot2bf(fp8lo_bf16(x_.w), hnr[j][1].z, a2); a3 = dot2bf(fp8hi_bf16(x_.w), hnr[j][1].w, a3); } \
        float acc_ = row16_sum((a0 + a1) + (a2 + a3)); \
        if (sub == 0) al[wave * 128 + 4 * (Q) + grp] = acc_ * sc[B]; } while (0)
    ULOAD(0, 0); ULOAD(1, 1); ULOAD(2, 2);
#pragma unroll 1
    for (int q = 0; q < 32; q += 4) {
        ULOAD(3, q + 3); UCOMP(0, q);
        if (q + 4 < 32) ULOAD(0, q + 4);
        UCOMP(1, q + 1);
        if (q + 4 < 32) ULOAD(1, q + 5);
        UCOMP(2, q + 2);
        if (q + 4 < 32) ULOAD(2, q + 6);
        UCOMP(3, q + 3);
    }
#undef ULOAD
#undef UCOMP
    LDS_WAIT();
    const int ix0 = myidx[lane], ix1 = myidx[64 + lane];
    const float av0 = al[wave * 128 + lane], av1 = al[wave * 128 + 64 + lane];
    const float act0 = gelu_tanh(av0) * gatel[tl * 128 + lane] * P.VSC[ix0], act1 = gelu_tanh(av1) * gatel[tl * 128 + 64 + lane] * P.VSC[ix1];
    gatel[tl * 128 + lane] = act0; gatel[tl * 128 + 64 + lane] = act1;
    LDS_WAIT();
}

#if PEER_FP8
#define PK8(OUT, X) do { OUT[0] = __builtin_amdgcn_cvt_pk_f32_fp8((int)(X).x, false); OUT[1] = __builtin_amdgcn_cvt_pk_f32_fp8((int)(X).x, true); OUT[2] = __builtin_amdgcn_cvt_pk_f32_fp8((int)(X).y, false); OUT[3] = __builtin_amdgcn_cvt_pk_f32_fp8((int)(X).y, true); \
        OUT[4] = __builtin_amdgcn_cvt_pk_f32_fp8((int)(X).z, false); OUT[5] = __builtin_amdgcn_cvt_pk_f32_fp8((int)(X).z, true); OUT[6] = __builtin_amdgcn_cvt_pk_f32_fp8((int)(X).w, false); OUT[7] = __builtin_amdgcn_cvt_pk_f32_fp8((int)(X).w, true); } while (0)
#define ROW_ISSUE(BUF, TAB, W) do { const unsigned char* rp_ = (TAB) + (size_t)((W) & rowand) * 1024; asm volatile("s_nop 4\n\tglobal_load_dwordx4 %0, %1, %2" : "=v"(BUF) : "v"(loff), "s"(rp_) : "memory"); } while (0)
#define ML(d) (16 * ((((d) & 3) == 1) ? 2 : (((d) & 3) == 2) ? 1 : ((d) & 3)) + ((d) >> 2))
__device__ __forceinline__ void peer_gather_sorted(const Ptrs& P, LAS unsigned char* lds, int unit, int lane, int wave, int g_lo = 0, int g_hi = 2) {
    asm volatile("" : "+v"(lane));
    const size_t t0 = (size_t)unit * 64 + wave * 8;
#pragma unroll 1
    for (int gq = g_lo; gq < g_hi; ++gq) {
        int lq = lane; asm volatile("" : "+v"(lq));
        const unsigned loff = (unsigned)lq * 16u;
        LAS int* idxl = (LAS int*)(lds + 65536) + wave * 1024 + gq * 512;
        const LAS float* gatel = (const LAS float*)(lds + 98304) + wave * 1024 + gq * 512;
        LAS unsigned* sw = (LAS unsigned*)idxl; LAS float* sg = (LAS float*)(lds + 98304) + wave * 1024 + gq * 512;
        LAS int* startl = (LAS int*)(lds + 131072 + 4096) + wave * 64;
        {
            int ent[8]; float gv[8], us[8];
#pragma unroll
            for (int j = 0; j < 8; ++j) { ent[j] = idxl[(j >> 1) * 128 + (j & 1) * 64 + lq]; gv[j] = gatel[(j >> 1) * 128 + (j & 1) * 64 + lq]; }
#pragma unroll
            for (int j = 0; j < 8; ++j) { us[j] = P.USC[ent[j]]; gv[j] *= P.VSC[ent[j]]; }
            LDS_WAIT();
            int rk[8]; int run[NSL];
#pragma unroll
            for (int b = 0; b < NSL; ++b) run[b] = 0;
#pragma unroll
            for (int j = 0; j < 8; ++j) { const int bj = ent[j] >> SLSH; int r = 0;
#pragma unroll
                for (int b = 0; b < NSL; ++b) { const unsigned long long m = __ballot(bj == b);
                    const int below = (int)__builtin_amdgcn_mbcnt_hi((unsigned)(m >> 32), __builtin_amdgcn_mbcnt_lo((unsigned)m, 0u));
                    r = (bj == b) ? run[b] + below : r; run[b] += (int)__builtin_popcountll(m); }
                rk[j] = r; }
            { int st = 0;
#pragma unroll
              for (int b = 0; b < NSL; ++b) { if (lq == b) startl[b] = st; st += run[b]; } }
            LDS_WAIT();
#pragma unroll
            for (int j = 0; j < 8; ++j) { const int pos = startl[ent[j] >> SLSH] + rk[j]; sw[pos] = (unsigned)ent[j] | ((unsigned)(j >> 1) << 14) | (f2bf(us[j]) << 16); sg[pos] = gv[j]; }
            LDS_WAIT();
        }
        if (SWEEP_SYNC) __syncthreads();
#if U_MFMA
        {
            const int n = lq & 15, kg = lq >> 4;
            v2u hb[32];
            { const unsigned char* hp = P.HN8 + (t0 + gq * 4 + (n & 3)) * 1024 + 8 * kg;
#pragma unroll
              for (int ks = 0; ks < 32; ++ks) { v2u v = *(const v2u*)(hp + 32 * ks); if (n >= 4) { v.x = 0u; v.y = 0u; } hb[ks] = v; } }
            LAS float* xl = (LAS float*)(lds + 131072) + wave * 128;
            if (lq < 4) xl[64 + lq] = P.HSC[t0 + gq * 4 + lq];
            v4u ua[16], ub[16];
            unsigned mw_a, mw_b; float mg_a, mg_b, mu_a, mu_b;
#define UM_META(i0, W, G, U) do { W = sw[(i0) + n]; G = sg[(i0) + n]; U = __builtin_bit_cast(float, W & 0xffff0000u); } while (0)
#define UM_LOAD(BUF, W) do { const unsigned char* rp_ = P.U8 + (size_t)((W) & umask) * 1024 + 16 * kg; \
        _Pragma("unroll") for (int m = 0; m < 16; ++m) BUF[m] = *(const v4u*)(rp_ + 64 * m); } while (0)
#define UM_COMP(BUF, W, G, U, i0) do { f32x4 acc = {0.f, 0.f, 0.f, 0.f}; \
        _Pragma("unroll") for (int m = 0; m < 16; ++m) { \
            const long a0_ = (long)(((unsigned long long)BUF[m].y << 32) | BUF[m].x), a1_ = (long)(((unsigned long long)BUF[m].w << 32) | BUF[m].z); \
            const long b0_ = (long)(((unsigned long long)hb[2 * m].y << 32) | hb[2 * m].x), b1_ = (long)(((unsigned long long)hb[2 * m + 1].y << 32) | hb[2 * m + 1].x); \
            acc = __builtin_amdgcn_mfma_f32_16x16x32_fp8_fp8(a0_, b0_, acc, 0, 0, 0); acc = __builtin_amdgcn_mfma_f32_16x16x32_fp8_fp8(a1_, b1_, acc, 0, 0, 0); } \
        if (n < 4) { xl[(4 * kg + 0) * 4 + n] = acc[0]; xl[(4 * kg + 1) * 4 + n] = acc[1]; xl[(4 * kg + 2) * 4 + n] = acc[2]; xl[(4 * kg + 3) * 4 + n] = acc[3]; } \
        LDS_WAIT(); \
        { const unsigned tok_ = ((W) >> 14) & 3u; const float a_ = xl[n * 4 + tok_] * (U) * xl[64 + tok_]; const float act_ = gelu_tanh(a_) * (G); \
          if (lq < 16 && pass + 1 == PROBE_U_PASSES) sg[(i0) + n] = act_; asm volatile("" :: "v"(act_)); } \
        LDS_WAIT(); } while (0)
            LDS_WAIT();
#pragma unroll 1
            for (int pass = 0; pass < PROBE_U_PASSES; ++pass) {
            const unsigned umask = (pass + 1 < PROBE_U_PASSES) ? 63u : 16383u;
            UM_META(0, mw_a, mg_a, mu_a); UM_LOAD(ua, mw_a);
#pragma unroll 1
            for (int i0 = 0; i0 < 512; i0 += 32) {
                UM_META(i0 + 16, mw_b, mg_b, mu_b); UM_LOAD(ub, mw_b);
                UM_COMP(ua, mw_a, mg_a, mu_a, i0);
                if (i0 + 32 < 512) { UM_META(i0 + 32, mw_a, mg_a, mu_a); UM_LOAD(ua, mw_a); }
                UM_COMP(ub, mw_b, mg_b, mu_b, i0 + 16);
            }
            }
#undef UM_META
#undef UM_LOAD
#undef UM_COMP
        }
        LDS_WAIT();
        if (SWEEP_SYNC) __syncthreads();
#else
        {
#if U_INT8
            int hf[4][4];
            float hsc[4];
#if P5_ELIM
            { f32x4 wn[4];
#pragma unroll
              for (int k = 0; k < 4; ++k) wn[k] = *(const f32x4*)(P.ffn_w + loff + 4 * k);
#pragma unroll
              for (int tk = 0; tk < 4; ++tk) { const size_t row = t0 + gq * 4 + tk; const float* xr = P.out + row * 1024 + loff;
                  const f32x4* sp_ = (const f32x4*)(P.rowss + row * 16); const f32x4* ap_ = (const f32x4*)(P.rowamax + row * 16);
                  const f32x4 sq_ = (sp_[0] + sp_[1]) + (sp_[2] + sp_[3]); const f32x4 a0_ = ap_[0], a1_ = ap_[1], a2_ = ap_[2], a3_ = ap_[3];
                  float am = 0.f;
#pragma unroll
                  for (int k = 0; k < 4; ++k) am = fmaxf(am, fmaxf(fmaxf(a0_[k], a1_[k]), fmaxf(a2_[k], a3_[k])));
                  const float qs = (am > 1e-30f) ? 127.0f / am : 0.f;
                  const float rstd = 1.0f / sqrtf(((sq_[0] + sq_[1]) + (sq_[2] + sq_[3])) * (1.0f / 1024.0f) + EPS);
                  hsc[tk] = am * rstd * (1.0f / 127.0f);
#pragma unroll
                  for (int k = 0; k < 4; ++k) { const f32x4 v = *(const f32x4*)(xr + 4 * k) * wn[k] * qs; hf[tk][k] = pack_i8x4(v[0], v[1], v[2], v[3]); } } }
#else
#pragma unroll
            for (int tk = 0; tk < 4; ++tk) { const v4u h0 = *(const v4u*)(P.HN8 + (t0 + gq * 4 + tk) * 1024 + loff); hf[tk][0] = (int)h0.x; hf[tk][1] = (int)h0.y; hf[tk][2] = (int)h0.z; hf[tk][3] = (int)h0.w; hsc[tk] = P.HSC[t0 + gq * 4 + tk]; }
#endif
#elif U_DOT2
            unsigned hf[4][8];
#pragma unroll
            for (int tk = 0; tk < 4; ++tk) { const v4u* hp = (const v4u*)((const unsigned char*)(P.HN2 + (t0 + gq * 4 + tk) * 1024) + 2u * loff); const v4u h0 = hp[0], h1 = hp[1];
                hf[tk][0] = h0.x; hf[tk][1] = h0.y; hf[tk][2] = h0.z; hf[tk][3] = h0.w; hf[tk][4] = h1.x; hf[tk][5] = h1.y; hf[tk][6] = h1.z; hf[tk][7] = h1.w; }
#else
            f32x2p hf[4][8];
#pragma unroll
            for (int tk = 0; tk < 4; ++tk) { const v4u* hp = (const v4u*)((const unsigned char*)(P.HN2 + (t0 + gq * 4 + tk) * 1024) + 2u * loff); const v4u h0 = hp[0], h1 = hp[1];
                hf[tk][0][0] = bflo(h0.x); hf[tk][0][1] = bfhi(h0.x); hf[tk][1][0] = bflo(h0.y); hf[tk][1][1] = bfhi(h0.y); hf[tk][2][0] = bflo(h0.z); hf[tk][2][1] = bfhi(h0.z); hf[tk][3][0] = bflo(h0.w); hf[tk][3][1] = bfhi(h0.w);
                hf[tk][4][0] = bflo(h1.x); hf[tk][4][1] = bfhi(h1.x); hf[tk][5][0] = bflo(h1.y); hf[tk][5][1] = bfhi(h1.y); hf[tk][6][0] = bflo(h1.z); hf[tk][6][1] = bfhi(h1.z); hf[tk][7][0] = bflo(h1.w); hf[tk][7][1] = bfhi(h1.w); }
#endif
#if U_INT4
            v2u ub[16]; const unsigned loff8 = (unsigned)lq * 8u;
#else
            v4u ub[16];
#endif
            float p[16];
            const int c4 = lq & 15, rho = lq >> 4;
            const int me = (c4 < 4) ? 4 * c4 + ((rho == 1) ? 2 : (rho == 2) ? 1 : rho) : 0;
            unsigned mw_c, mw_n; float mg_c, mg_n, mu_c, mu_n;
#if U_INT8
#define HSC_OF(W) ((((W) >> 14) & 3u) == 0u ? hsc[0] : (((W) >> 14) & 3u) == 1u ? hsc[1] : (((W) >> 14) & 3u) == 2u ? hsc[2] : hsc[3])
#else
#define HSC_OF(W) 1.0f
#endif
#define U_META(i0, W, G, U) do { W = sw[(i0) + me]; G = sg[(i0) + me]; U = __builtin_bit_cast(float, W & 0xffff0000u); } while (0)
#if U_INT4
#define UROW_ISSUE(BUF, W) do { const unsigned char* rp_ = P.U8 + (size_t)((W) & rowand) * 512; asm volatile("s_nop 4\n\tglobal_load_dwordx2 %0, %1, %2" : "=v"(BUF) : "v"(loff8), "s"(rp_) : "memory"); } while (0)
#define U_DOT(tk) asm volatile("s_cmp_lg_u32 %8, " #tk "\n\ts_cbranch_scc1 .LUSK%=\n\t" \
        "v_dot8_i32_i4 %0, %2, %4, %0\n\tv_dot8_i32_i4 %1, %2, %6, %1\n\tv_dot8_i32_i4 %0, %3, %5, %0\n\tv_dot8_i32_i4 %1, %3, %7, %1\n\ts_nop 2\n.LUSK%=:" \
        : "+v"(a0_), "+v"(a1_) : "v"(x_.x), "v"(x_.y), "v"(hf[tk][0]), "v"(hf[tk][1]), "v"(hf[tk][2]), "v"(hf[tk][3]), "s"(tok) : "scc")
#define U_STEP(d, CNT, ISSUE) do { asm volatile("s_waitcnt vmcnt(" #CNT ")" : "+v"(ub[d]) :: "memory"); \
        { const v2u x_ = ub[d]; \
          const unsigned tok = ((unsigned)__builtin_amdgcn_readlane((int)mw_c, ML(d)) >> 14) & 3u; \
          int a0_ = 0, a1_ = 0; \
          U_DOT(0); U_DOT(1); U_DOT(2); U_DOT(3); \
          p[d] = (float)((a0_ << 4) + a1_); } \
        if (ISSUE) UROW_ISSUE(ub[d], (unsigned)__builtin_amdgcn_readlane((int)mw_n, ML(d))); } while (0)
#elif U_INT8
#define UROW_ISSUE(BUF, W) ROW_ISSUE(BUF, P.U8, W)
#define U_DOT(tk) asm volatile("s_cmp_lg_u32 %10, " #tk "\n\ts_cbranch_scc1 .LUSK%=\n\t" \
        "v_dot4c_i32_i8 %0, %2, %6\n\tv_dot4c_i32_i8 %1, %3, %7\n\tv_dot4c_i32_i8 %0, %4, %8\n\tv_dot4c_i32_i8 %1, %5, %9\n\ts_nop 2\n.LUSK%=:" \
        : "+v"(a0_), "+v"(a1_) : "v"(x_.x), "v"(x_.y), "v"(x_.z), "v"(x_.w), "v"(hf[tk][0]), "v"(hf[tk][1]), "v"(hf[tk][2]), "v"(hf[tk][3]), "s"(tok) : "scc")
#define U_STEP(d, CNT, ISSUE) do { asm volatile("s_waitcnt vmcnt(" #CNT ")" : "+v"(ub[d]) :: "memory"); \
        { const v4u x_ = ub[d]; \
          const unsigned tok = ((unsigned)__builtin_amdgcn_readlane((int)mw_c, ML(d)) >> 14) & 3u; \
          int a0_ = 0, a1_ = 0; \
          U_DOT(0); U_DOT(1); U_DOT(2); U_DOT(3); \
          p[d] = (float)(a0_ + a1_); } \
        if (ISSUE) ROW_ISSUE(ub[d], P.U8, (unsigned)__builtin_amdgcn_readlane((int)mw_n, ML(d))); } while (0)
#elif U_DOT2
#define UROW_ISSUE(BUF, W) ROW_ISSUE(BUF, P.U8, W)
#define U_DOT(tk) asm volatile("s_cmp_lg_u32 %20, " #tk "\n\ts_cbranch_scc1 .LUSK%=\n\t" \
        "v_dot2c_f32_bf16 %0, %4, %12\n\tv_dot2c_f32_bf16 %1, %5, %13\n\tv_dot2c_f32_bf16 %2, %6, %14\n\tv_dot2c_f32_bf16 %3, %7, %15\n\t" \
        "v_dot2c_f32_bf16 %0, %8, %16\n\tv_dot2c_f32_bf16 %1, %9, %17\n\tv_dot2c_f32_bf16 %2, %10, %18\n\tv_dot2c_f32_bf16 %3, %11, %19\n\ts_nop 2\n.LUSK%=:" \
        : "+v"(a0_), "+v"(a1_), "+v"(a2_), "+v"(a3_) \
        : "v"(dk_[0]), "v"(dk_[1]), "v"(dk_[2]), "v"(dk_[3]), "v"(dk_[4]), "v"(dk_[5]), "v"(dk_[6]), "v"(dk_[7]), \
          "v"(hf[tk][0]), "v"(hf[tk][1]), "v"(hf[tk][2]), "v"(hf[tk][3]), "v"(hf[tk][4]), "v"(hf[tk][5]), "v"(hf[tk][6]), "v"(hf[tk][7]), "s"(tok) : "scc")
#define U_STEP(d, CNT, ISSUE) do { asm volatile("s_waitcnt vmcnt(" #CNT ")" : "+v"(ub[d]) :: "memory"); \
        { const v4u x_ = ub[d]; unsigned dk_[8]; dk_[0] = fp8lo_bf16(x_.x); dk_[1] = fp8hi_bf16(x_.x); dk_[2] = fp8lo_bf16(x_.y); dk_[3] = fp8hi_bf16(x_.y); dk_[4] = fp8lo_bf16(x_.z); dk_[5] = fp8hi_bf16(x_.z); dk_[6] = fp8lo_bf16(x_.w); dk_[7] = fp8hi_bf16(x_.w); \
          const unsigned tok = ((unsigned)__builtin_amdgcn_readlane((int)mw_c, ML(d)) >> 14) & 3u; \
          float a0_ = 0.f, a1_ = 0.f, a2_ = 0.f, a3_ = 0.f; \
          U_DOT(0); U_DOT(1); U_DOT(2); U_DOT(3); \
          p[d] = (a0_ + a1_) + (a2_ + a3_); } \
        if (ISSUE) ROW_ISSUE(ub[d], P.U8, (unsigned)__builtin_amdgcn_readlane((int)mw_n, ML(d))); } while (0)
#else
#define UROW_ISSUE(BUF, W) ROW_ISSUE(BUF, P.U8, W)
#define U_DOT(tk) asm volatile("s_cmp_lg_u32 %20, " #tk "\n\ts_cbranch_scc1 .LUSK%=\n\t" \
        "v_pk_fma_f32 %0, %4, %12, %0\n\tv_pk_fma_f32 %1, %5, %13, %1\n\tv_pk_fma_f32 %2, %6, %14, %2\n\tv_pk_fma_f32 %3, %7, %15, %3\n\t" \
        "v_pk_fma_f32 %0, %8, %16, %0\n\tv_pk_fma_f32 %1, %9, %17, %1\n\tv_pk_fma_f32 %2, %10, %18, %2\n\tv_pk_fma_f32 %3, %11, %19, %3\n.LUSK%=:" \
        : "+v"(a0_), "+v"(a1_), "+v"(a2_), "+v"(a3_) \
        : "v"(dk_[0]), "v"(dk_[1]), "v"(dk_[2]), "v"(dk_[3]), "v"(dk_[4]), "v"(dk_[5]), "v"(dk_[6]), "v"(dk_[7]), \
          "v"(hf[tk][0]), "v"(hf[tk][1]), "v"(hf[tk][2]), "v"(hf[tk][3]), "v"(hf[tk][4]), "v"(hf[tk][5]), "v"(hf[tk][6]), "v"(hf[tk][7]), "s"(tok) : "scc")
#define U_STEP(d, CNT, ISSUE) do { asm volatile("s_waitcnt vmcnt(" #CNT ")" : "+v"(ub[d]) :: "memory"); \
        { const v4u x_ = ub[d]; f32x2p dk_[8]; PK8(dk_, x_); \
          const unsigned tok = ((unsigned)__builtin_amdgcn_readlane((int)mw_c, ML(d)) >> 14) & 3u; \
          f32x2p a0_, a1_, a2_, a3_; a0_[0] = 0.f; a0_[1] = 0.f; a1_ = a0_; a2_ = a0_; a3_ = a0_; \
          U_DOT(0); U_DOT(1); U_DOT(2); U_DOT(3); \
          const f32x2p s_ = (a0_ + a1_) + (a2_ + a3_); p[d] = s_[0] + s_[1]; } \
        if (ISSUE) ROW_ISSUE(ub[d], P.U8, (unsigned)__builtin_amdgcn_readlane((int)mw_n, ML(d))); } while (0)
#endif
#pragma unroll 1
            for (int pass = 0; pass < PROBE_U_PASSES; ++pass) {
            const unsigned rowand = (pass + 1 < PROBE_U_PASSES) ? PROBE_ROWAND : 16383u;
            asm volatile("s_waitcnt vmcnt(0)" ::: "memory");
            U_META(0, mw_c, mg_c, mu_c);
#define U_ISSUE0(d) UROW_ISSUE(ub[d], (unsigned)__builtin_amdgcn_readlane((int)mw_c, ML(d)))
            U_ISSUE0(0); U_ISSUE0(1); U_ISSUE0(2); U_ISSUE0(3); U_ISSUE0(4); U_ISSUE0(5); U_ISSUE0(6); U_ISSUE0(7); U_ISSUE0(8); U_ISSUE0(9); U_ISSUE0(10); U_ISSUE0(11); U_ISSUE0(12); U_ISSUE0(13); U_ISSUE0(14); U_ISSUE0(15);
#undef U_ISSUE0
#define U_FINISH(i0) do { float q_[8], r_[4]; \
        _Pragma("unroll") for (int j = 0; j < 8; ++j) { auto rr = __builtin_amdgcn_permlane32_swap(__builtin_bit_cast(unsigned, p[2 * j]), __builtin_bit_cast(unsigned, p[2 * j + 1]), false, false); const unsigned r0 = rr[0], r1 = rr[1]; q_[j] = __builtin_bit_cast(float, r0) + __builtin_bit_cast(float, r1); } \
        _Pragma("unroll") for (int j = 0; j < 4; ++j) { auto rr = __builtin_amdgcn_permlane16_swap(__builtin_bit_cast(unsigned, q_[2 * j]), __builtin_bit_cast(unsigned, q_[2 * j + 1]), false, false); const unsigned r0 = rr[0], r1 = rr[1]; r_[j] = row16_sum(__builtin_bit_cast(float, r0) + __builtin_bit_cast(float, r1)); } \
        const float acol = (c4 == 0) ? r_[0] : (c4 == 1) ? r_[1] : (c4 == 2) ? r_[2] : r_[3]; \
        const float act = gelu_tanh(acol * mu_c * HSC_OF(mw_c)) * mg_c; \
        if (c4 < 4 && pass + 1 == PROBE_U_PASSES) sg[(i0) + me] = act; asm volatile("" :: "v"(act)); } while (0)
#pragma unroll 1
            for (int i0 = 0; i0 < 512 - 16; i0 += 16) {
                U_META(i0 + 16, mw_n, mg_n, mu_n);
                U_STEP(0, 15, 1); U_STEP(1, 15, 1); U_STEP(2, 15, 1); U_STEP(3, 15, 1); U_STEP(4, 15, 1); U_STEP(5, 15, 1); U_STEP(6, 15, 1); U_STEP(7, 15, 1);
                U_STEP(8, 15, 1); U_STEP(9, 15, 1); U_STEP(10, 15, 1); U_STEP(11, 15, 1); U_STEP(12, 15, 1); U_STEP(13, 15, 1); U_STEP(14, 15, 1); U_STEP(15, 15, 1);
                U_FINISH(i0);
                mw_c = mw_n; mg_c = mg_n; mu_c = mu_n;
            }
            mw_n = mw_c;
            U_STEP(0, 15, 0); U_STEP(1, 14, 0); U_STEP(2, 13, 0); U_STEP(3, 12, 0); U_STEP(4, 11, 0); U_STEP(5, 10, 0); U_STEP(6, 9, 0); U_STEP(7, 8, 0);
            U_STEP(8, 7, 0); U_STEP(9, 6, 0); U_STEP(10, 5, 0); U_STEP(11, 4, 0); U_STEP(12, 3, 0); U_STEP(13, 2, 0); U_STEP(14, 1, 0); U_STEP(15, 0, 0);
            U_FINISH(512 - 16);
            }
#undef U_FINISH
#undef U_STEP
#undef U_DOT
#undef UROW_ISSUE
#undef U_META
        }
        LDS_WAIT();
        if (SWEEP_SYNC) __syncthreads();
#endif
        f32x2p y[4][8];
#pragma unroll
        for (int tk = 0; tk < 4; ++tk)
#pragma unroll
            for (int k = 0; k < 8; ++k) { y[tk][k][0] = 0.f; y[tk][k][1] = 0.f; }
        {
            v4u vb[16]; const int ml = lq & 15;
            unsigned mw_c, mw_n, ma_c, ma_n;
#define V_META(i0, W, A) do { W = sw[(i0) + ml]; A = __builtin_bit_cast(unsigned, sg[(i0) + ml]); } while (0)
#define V_FMA(tk) asm volatile("s_cmp_lg_u32 %17, " #tk "\n\ts_cbranch_scc1 .LVSK%=\n\t" \
        "v_pk_fma_f32 %0, %8, %16, %0\n\tv_pk_fma_f32 %1, %9, %16, %1\n\tv_pk_fma_f32 %2, %10, %16, %2\n\tv_pk_fma_f32 %3, %11, %16, %3\n\t" \
        "v_pk_fma_f32 %4, %12, %16, %4\n\tv_pk_fma_f32 %5, %13, %16, %5\n\tv_pk_fma_f32 %6, %14, %16, %6\n\tv_pk_fma_f32 %7, %15, %16, %7\n.LVSK%=:" \
        : "+v"(y[tk][0]), "+v"(y[tk][1]), "+v"(y[tk][2]), "+v"(y[tk][3]), "+v"(y[tk][4]), "+v"(y[tk][5]), "+v"(y[tk][6]), "+v"(y[tk][7]) \
        : "v"(dk_[0]), "v"(dk_[1]), "v"(dk_[2]), "v"(dk_[3]), "v"(dk_[4]), "v"(dk_[5]), "v"(dk_[6]), "v"(dk_[7]), "v"(a2_), "s"(tok) : "scc")
#define V_NOFMA(tk) asm volatile("s_cmp_lg_u32 %17, " #tk "\n\ts_cbranch_scc1 .LVSK%=\n\ts_nop 0\n.LVSK%=:" \
        : "+v"(y[tk][0]), "+v"(y[tk][1]), "+v"(y[tk][2]), "+v"(y[tk][3]), "+v"(y[tk][4]), "+v"(y[tk][5]), "+v"(y[tk][6]), "+v"(y[tk][7]) \
        : "v"(dk_[0]), "v"(dk_[1]), "v"(dk_[2]), "v"(dk_[3]), "v"(dk_[4]), "v"(dk_[5]), "v"(dk_[6]), "v"(dk_[7]), "v"(a2_), "s"(tok) : "scc")
#define V_STEP(d, CNT, ISSUE, FM) do { asm volatile("s_waitcnt vmcnt(" #CNT ")" : "+v"(vb[d]) :: "memory"); \
        { const v4u x_ = vb[d]; f32x2p dk_[8]; PK8(dk_, x_); \
          const unsigned tok = ((unsigned)__builtin_amdgcn_readlane((int)mw_c, d) >> 14) & 3u; const float a_ = __builtin_bit_cast(float, __builtin_amdgcn_readlane((int)ma_c, d)); f32x2p a2_; a2_[0] = a_; a2_[1] = a_; \
          if (FM) { V_FMA(0); V_FMA(1); V_FMA(2); V_FMA(3); } else { V_NOFMA(0); V_NOFMA(1); V_NOFMA(2); V_NOFMA(3); } } \
        if (ISSUE) ROW_ISSUE(vb[d], P.V8, (unsigned)__builtin_amdgcn_readlane((int)mw_n, d)); } while (0)
#pragma unroll 1
            for (int pass = 0; pass < PROBE_V_PASSES; ++pass) {
            const unsigned rowand = (pass + 1 < PROBE_V_PASSES) ? PROBE_ROWAND : 16383u;
#define V_BODY(FM) do { \
            asm volatile("s_waitcnt vmcnt(0)" ::: "memory"); \
            V_META(0, mw_c, ma_c); \
            V_ISSUE0(0); V_ISSUE0(1); V_ISSUE0(2); V_ISSUE0(3); V_ISSUE0(4); V_ISSUE0(5); V_ISSUE0(6); V_ISSUE0(7); V_ISSUE0(8); V_ISSUE0(9); V_ISSUE0(10); V_ISSUE0(11); V_ISSUE0(12); V_ISSUE0(13); V_ISSUE0(14); V_ISSUE0(15); \
            _Pragma("unroll 1") for (int i0 = 0; i0 < 512 - 16; i0 += 16) { \
                V_META(i0 + 16, mw_n, ma_n); \
                V_STEP(0, 15, 1, FM); V_STEP(1, 15, 1, FM); V_STEP(2, 15, 1, FM); V_STEP(3, 15, 1, FM); V_STEP(4, 15, 1, FM); V_STEP(5, 15, 1, FM); V_STEP(6, 15, 1, FM); V_STEP(7, 15, 1, FM); \
                V_STEP(8, 15, 1, FM); V_STEP(9, 15, 1, FM); V_STEP(10, 15, 1, FM); V_STEP(11, 15, 1, FM); V_STEP(12, 15, 1, FM); V_STEP(13, 15, 1, FM); V_STEP(14, 15, 1, FM); V_STEP(15, 15, 1, FM); \
                mw_c = mw_n; ma_c = ma_n; } \
            mw_n = mw_c; \
            V_STEP(0, 15, 0, FM); V_STEP(1, 14, 0, FM); V_STEP(2, 13, 0, FM); V_STEP(3, 12, 0, FM); V_STEP(4, 11, 0, FM); V_STEP(5, 10, 0, FM); V_STEP(6, 9, 0, FM); V_STEP(7, 8, 0, FM); \
            V_STEP(8, 7, 0, FM); V_STEP(9, 6, 0, FM); V_STEP(10, 5, 0, FM); V_STEP(11, 4, 0, FM); V_STEP(12, 3, 0, FM); V_STEP(13, 2, 0, FM); V_STEP(14, 1, 0, FM); V_STEP(15, 0, 0, FM); } while (0)
#define V_ISSUE0(d) ROW_ISSUE(vb[d], P.V8, (unsigned)__builtin_amdgcn_readlane((int)mw_c, d))
            if (pass + 1 < PROBE_V_PASSES) V_BODY(0); else V_BODY(1);
#undef V_ISSUE0
#undef V_BODY
            }
#undef V_STEP
#undef V_META
#undef V_FMA
#undef V_NOFMA
        }
#pragma unroll
        for (int tk = 0; tk < 4; ++tk) {
            float* xr = P.out + (t0 + gq * 4 + tk) * 1024 + loff;
            f32x4 x[4];
#pragma unroll
            for (int k = 0; k < 4; ++k) { x[k] = *(const f32x4*)(xr + 4 * k); x[k][0] += y[tk][2 * k][0]; x[k][1] += y[tk][2 * k][1]; x[k][2] += y[tk][2 * k + 1][0]; x[k][3] += y[tk][2 * k + 1][1]; }
            float ss = 0.f;
#pragma unroll
            for (int k = 0; k < 4; ++k) ss += (x[k][0] * x[k][0] + x[k][1] * x[k][1]) + (x[k][2] * x[k][2] + x[k][3] * x[k][3]);
            const float rstd = 1.0f / sqrtf(wave_sum(ss) * (1.0f / 1024.0f) + EPS);
#pragma unroll
            for (int k = 0; k < 4; ++k) { const f32x4 wv = *(const f32x4*)(P.fin_w + (loff + 4 * k)); *(f32x4*)(xr + 4 * k) = x[k] * rstd * wv; }
        }
    }
}
#undef ML
#undef ROW_ISSUE
#undef PK8
#endif

#if GATHER_HALF
#define HROW_ISSUE(BUF, TAB, W) do { const unsigned vo_ = (((W) & 0x3fffu) << 9) + loff; asm volatile("global_load_dwordx4 %0, %1, %2" : "=v"(BUF) : "v"(vo_), "s"(TAB) : "memory"); } while (0)
__device__ __forceinline__ void peer_gather_half(const Ptrs& P, LAS unsigned char* lds, int unit, int lane, int wave, int g_lo, int g_hi) {
    asm volatile("" : "+v"(lane));
    const size_t t0 = (size_t)unit * 64 + wave * 8;
#pragma unroll 1
    for (int gq = g_lo; gq < g_hi; ++gq) {
        int lq = lane; asm volatile("" : "+v"(lq));
        LAS int* idxl = (LAS int*)(lds + 65536) + wave * 1024 + gq * 512;
        const LAS float* gatel = (const LAS float*)(lds + 98304) + wave * 1024 + gq * 512;
        LAS unsigned* sw = (LAS unsigned*)idxl; LAS float* sg = (LAS float*)(lds + 98304) + wave * 1024 + gq * 512;
        LAS int* startl = (LAS int*)(lds + 131072 + 4096) + wave * 64;
        {
            int ent[8]; float gv[8], us[8];
#pragma unroll
            for (int j = 0; j < 8; ++j) { ent[j] = idxl[(j >> 1) * 128 + (j & 1) * 64 + lq]; gv[j] = gatel[(j >> 1) * 128 + (j & 1) * 64 + lq]; }
#pragma unroll
            for (int j = 0; j < 8; ++j) { us[j] = P.USC[ent[j]]; gv[j] *= P.VSC[ent[j]] * 128.0f; }
            LDS_WAIT();
            int rk[8];
#pragma unroll
            for (int tk = 0; tk < 4; ++tk) {
                int run[NSL];
#pragma unroll
                for (int b = 0; b < NSL; ++b) run[b] = 0;
#pragma unroll
                for (int jj = 0; jj < 2; ++jj) { const int j = 2 * tk + jj; const int bj = ent[j] >> SLSH; int r = 0;
#pragma unroll
                    for (int b = 0; b < NSL; ++b) { const unsigned long long m = __ballot(bj == b);
                        const int below = (int)__builtin_amdgcn_mbcnt_hi((unsigned)(m >> 32), __builtin_amdgcn_mbcnt_lo((unsigned)m, 0u));
                        r = (bj == b) ? run[b] + below : r; run[b] += (int)__builtin_popcountll(m); }
                    rk[j] = r; }
                int st = 0;
#pragma unroll
                for (int b = 0; b < NSL; ++b) { if (lq == b) startl[tk * NSL + b] = st; st += run[b]; }
            }
            LDS_WAIT();
#pragma unroll
            for (int j = 0; j < 8; ++j) { const int pos = (j >> 1) * 128 + startl[(j >> 1) * NSL + (ent[j] >> SLSH)] + rk[j]; sw[pos] = (unsigned)ent[j] | (f2bf(us[j]) << 16); sg[pos] = gv[j]; }
            LDS_WAIT();
        }
#pragma unroll 1
        for (int sub = 0; sub < 2; ++sub) {
            int lr = lane; asm volatile("" : "+v"(lr));
            const int l5 = lr & 31, tk = 2 * sub + (lr >> 5);
            const LAS unsigned* swt = sw + tk * 128; const LAS float* sgt = sg + tk * 128;
            const unsigned loff = (unsigned)l5 * 16u;
            {
                const int c4 = lr & 15, rho = lr >> 4;
                const int mtk = 2 * sub + (rho >> 1), mpos = (c4 < 4) ? 2 * c4 + (rho & 1) : 0;
                const LAS unsigned* swm = sw + mtk * 128 + mpos; LAS float* sgm = sg + mtk * 128 + mpos;
                const v4u* hp = (const v4u*)(P.HN8 + (t0 + gq * 4 + tk) * 1024 + 32 * l5);
                v4u ha = hp[0], hb = hp[1]; float hsc_m = P.HSC[t0 + gq * 4 + mtk];
                asm volatile("s_waitcnt vmcnt(0)" : "+v"(ha), "+v"(hb), "+v"(hsc_m) :: "memory");
                v4u ub[16]; float p[8];
                unsigned mw; float mg;
#define U_STEP(d, CNT, ISSUE, W) do { asm volatile("s_waitcnt vmcnt(" #CNT ")" : "+v"(ub[d]) :: "memory"); \
        { const v4u x_ = ub[d]; int a_ = 0, b_ = 0; \
          a_ = __builtin_amdgcn_sdot8((int)x_.x, (int)ha.x, a_, false); b_ = __builtin_amdgcn_sdot8((int)x_.x, (int)hb.x, b_, false); \
          a_ = __builtin_amdgcn_sdot8((int)x_.y, (int)ha.y, a_, false); b_ = __builtin_amdgcn_sdot8((int)x_.y, (int)hb.y, b_, false); \
          a_ = __builtin_amdgcn_sdot8((int)x_.z, (int)ha.z, a_, false); b_ = __builtin_amdgcn_sdot8((int)x_.z, (int)hb.z, b_, false); \
          a_ = __builtin_amdgcn_sdot8((int)x_.w, (int)ha.w, a_, false); b_ = __builtin_amdgcn_sdot8((int)x_.w, (int)hb.w, b_, false); \
          p[(d) & 7] = (float)((a_ << 4) + b_); } \
        if (ISSUE) HROW_ISSUE(ub[d], P.U8, W); } while (0)
#define U_FINISH(i0) do { float r_[4]; \
        _Pragma("unroll") for (int j = 0; j < 4; ++j) { auto rr = __builtin_amdgcn_permlane16_swap(__builtin_bit_cast(unsigned, p[2 * j]), __builtin_bit_cast(unsigned, p[2 * j + 1]), false, false); const unsigned r0 = rr[0], r1 = rr[1]; r_[j] = row16_sum(__builtin_bit_cast(float, r0) + __builtin_bit_cast(float, r1)); } \
        const float acol = (c4 == 0) ? r_[0] : (c4 == 1) ? r_[1] : (c4 == 2) ? r_[2] : r_[3]; \
        const float act = gelu_tanh(acol * __builtin_bit_cast(float, mw & 0xffff0000u) * hsc_m) * mg; \
        if (c4 < 4) sgm[i0] = act; } while (0)
#define U_CHUNK(i0, B, WA, WB, C0, C1, C2, C3, C4, C5, C6, C7, ISSUE) do { mw = swm[i0]; mg = sgm[i0]; \
        U_STEP(B + 0, C0, ISSUE, WA.x); U_STEP(B + 1, C1, ISSUE, WA.y); U_STEP(B + 2, C2, ISSUE, WA.z); U_STEP(B + 3, C3, ISSUE, WA.w); \
        U_STEP(B + 4, C4, ISSUE, WB.x); U_STEP(B + 5, C5, ISSUE, WB.y); U_STEP(B + 6, C6, ISSUE, WB.z); U_STEP(B + 7, C7, ISSUE, WB.w); \
        U_FINISH(i0); } while (0)
                {
                    const v4u w0 = *(const LAS v4u*)(swt), w1 = *(const LAS v4u*)(swt + 4), w2 = *(const LAS v4u*)(swt + 8), w3 = *(const LAS v4u*)(swt + 12);
                    HROW_ISSUE(ub[0], P.U8, w0.x); HROW_ISSUE(ub[1], P.U8, w0.y); HROW_ISSUE(ub[2], P.U8, w0.z); HROW_ISSUE(ub[3], P.U8, w0.w);
                    HROW_ISSUE(ub[4], P.U8, w1.x); HROW_ISSUE(ub[5], P.U8, w1.y); HROW_ISSUE(ub[6], P.U8, w1.z); HROW_ISSUE(ub[7], P.U8, w1.w);
                    HROW_ISSUE(ub[8], P.U8, w2.x); HROW_ISSUE(ub[9], P.U8, w2.y); HROW_ISSUE(ub[10], P.U8, w2.z); HROW_ISSUE(ub[11], P.U8, w2.w);
                    HROW_ISSUE(ub[12], P.U8, w3.x); HROW_ISSUE(ub[13], P.U8, w3.y); HROW_ISSUE(ub[14], P.U8, w3.z); HROW_ISSUE(ub[15], P.U8, w3.w);
                }
                v4u wa = *(const LAS v4u*)(swt + 16), wb = *(const LAS v4u*)(swt + 20);
#pragma unroll 1
                for (int i0 = 0; i0 < 112; i0 += 16) {
                    const v4u wc = *(const LAS v4u*)(swt + i0 + 24), wd = *(const LAS v4u*)(swt + i0 + 28);
                    U_CHUNK(i0, 0, wa, wb, 15, 15, 15, 15, 15, 15, 15, 15, 1);
                    wa = *(const LAS v4u*)(swt + i0 + 32); wb = *(const LAS v4u*)(swt + i0 + 36);
                    U_CHUNK(i0 + 8, 8, wc, wd, 15, 15, 15, 15, 15, 15, 15, 15, 1);
                }
                U_CHUNK(112, 0, wa, wb, 15, 14, 13, 12, 11, 10, 9, 8, 0);
                U_CHUNK(120, 8, wa, wb, 7, 6, 5, 4, 3, 2, 1, 0, 0);
#undef U_CHUNK
#undef U_FINISH
#undef U_STEP
            }
            LDS_WAIT();
            h2 y[16];
#pragma unroll
            for (int k = 0; k < 16; ++k) { y[k][0] = (_Float16)0.f; y[k][1] = (_Float16)0.f; }
            {
                v4u vb[16];
                asm volatile("s_waitcnt vmcnt(0)" ::: "memory");
#define V_F4(K, X, B) y[K] = __builtin_elementwise_fma(__builtin_bit_cast(h2, __builtin_amdgcn_cvt_scalef32_pk_f16_fp4(X, 1.0f, B)), a2_, y[K])
#define V_STEP(d, CNT, ISSUE, W, A) do { asm volatile("s_waitcnt vmcnt(" #CNT ")" : "+v"(vb[d]) :: "memory"); \
        { const v4u x_ = vb[d]; const h2 a2_ = __builtin_bit_cast(h2, __builtin_amdgcn_cvt_pkrtz(A, A)); \
          V_F4(0, x_.x, 0); V_F4(1, x_.x, 1); V_F4(2, x_.x, 2); V_F4(3, x_.x, 3); V_F4(4, x_.y, 0); V_F4(5, x_.y, 1); V_F4(6, x_.y, 2); V_F4(7, x_.y, 3); \
          V_F4(8, x_.z, 0); V_F4(9, x_.z, 1); V_F4(10, x_.z, 2); V_F4(11, x_.z, 3); V_F4(12, x_.w, 0); V_F4(13, x_.w, 1); V_F4(14, x_.w, 2); V_F4(15, x_.w, 3); } \
        if (ISSUE) HROW_ISSUE(vb[d], P.V8, W); } while (0)
#define V_CHUNK(i0, B, WA, WB, C0, C1, C2, C3, C4, C5, C6, C7, ISSUE) do { const f32x4 aa_ = *(const LAS f32x4*)(sgt + (i0)), ab_ = *(const LAS f32x4*)(sgt + (i0) + 4); \
        V_STEP(B + 0, C0, ISSUE, WA.x, aa_[0]); V_STEP(B + 1, C1, ISSUE, WA.y, aa_[1]); V_STEP(B + 2, C2, ISSUE, WA.z, aa_[2]); V_STEP(B + 3, C3, ISSUE, WA.w, aa_[3]); \
        V_STEP(B + 4, C4, ISSUE, WB.x, ab_[0]); V_STEP(B + 5, C5, ISSUE, WB.y, ab_[1]); V_STEP(B + 6, C6, ISSUE, WB.z, ab_[2]); V_STEP(B + 7, C7, ISSUE, WB.w, ab_[3]); } while (0)
                {
                    const v4u w0 = *(const LAS v4u*)(swt), w1 = *(const LAS v4u*)(swt + 4), w2 = *(const LAS v4u*)(swt + 8), w3 = *(const LAS v4u*)(swt + 12);
                    HROW_ISSUE(vb[0], P.V8, w0.x); HROW_ISSUE(vb[1], P.V8, w0.y); HROW_ISSUE(vb[2], P.V8, w0.z); HROW_ISSUE(vb[3], P.V8, w0.w);
                    HROW_ISSUE(vb[4], P.V8, w1.x); HROW_ISSUE(vb[5], P.V8, w1.y); HROW_ISSUE(vb[6], P.V8, w1.z); HROW_ISSUE(vb[7], P.V8, w1.w);
                    HROW_ISSUE(vb[8], P.V8, w2.x); HROW_ISSUE(vb[9], P.V8, w2.y); HROW_ISSUE(vb[10], P.V8, w2.z); HROW_ISSUE(vb[11], P.V8, w2.w);
                    HROW_ISSUE(vb[12], P.V8, w3.x); HROW_ISSUE(vb[13], P.V8, w3.y); HROW_ISSUE(vb[14], P.V8, w3.z); HROW_ISSUE(vb[15], P.V8, w3.w);
                }
                v4u wa = *(const LAS v4u*)(swt + 16), wb = *(const LAS v4u*)(swt + 20);
#pragma unroll 1
                for (int i0 = 0; i0 < 112; i0 += 16) {
                    const v4u wc = *(const LAS v4u*)(swt + i0 + 24), wd = *(const LAS v4u*)(swt + i0 + 28);
                    V_CHUNK(i0, 0, wa, wb, 15, 15, 15, 15, 15, 15, 15, 15, 1);
                    wa = *(const LAS v4u*)(swt + i0 + 32); wb = *(const LAS v4u*)(swt + i0 + 36);
                    V_CHUNK(i0 + 8, 8, wc, wd, 15, 15, 15, 15, 15, 15, 15, 15, 1);
                }
                V_CHUNK(112, 0, wa, wb, 15, 14, 13, 12, 11, 10, 9, 8, 0);
                V_CHUNK(120, 8, wa, wb, 7, 6, 5, 4, 3, 2, 1, 0, 0);
#undef V_CHUNK
#undef V_STEP
#undef V_F4
            }
            {
                float* xr = P.out + (t0 + gq * 4 + tk) * 1024 + 32 * l5;
                f32x4 x[8]; float ss = 0.f;
#pragma unroll
                for (int m = 0; m < 8; ++m) { x[m] = *(const f32x4*)(xr + 4 * m);
                    x[m][0] += (float)y[2 * m][0] * (1.0f / 128.0f); x[m][1] += (float)y[2 * m][1] * (1.0f / 128.0f); x[m][2] += (float)y[2 * m + 1][0] * (1.0f / 128.0f); x[m][3] += (float)y[2 * m + 1][1] * (1.0f / 128.0f);
                    ss += (x[m][0] * x[m][0] + x[m][1] * x[m][1]) + (x[m][2] * x[m][2] + x[m][3] * x[m][3]); }
                ss = row16_sum(ss);
                ss += __builtin_bit_cast(float, __builtin_amdgcn_ds_swizzle(__builtin_bit_cast(int, ss), 0x401F));
                const float rstd = 1.0f / sqrtf(ss * (1.0f / 1024.0f) + EPS);
#pragma unroll
                for (int m = 0; m < 8; ++m) { const f32x4 wv = *(const f32x4*)(P.fin_w + (32 * l5 + 4 * m)); *(f32x4*)(xr + 4 * m) = x[m] * rstd * wv; }
            }
        }
    }
}
#undef HROW_ISSUE
#endif

__device__ __forceinline__ void p7_peer(LAS unsigned char* lds, const Ptrs& P, int vcu, int G, int tid, int lane, int wave) {
    LAS bf16* k1l = (LAS bf16*)lds;
    LAS bf16* k2l = (LAS bf16*)(lds + 32768);
    LAS int* idxl = (LAS int*)(lds + 65536);
    LAS float* gatel = (LAS float*)(lds + 98304);
    for (int i = tid; i < 2048; i += 512) { const int n = i >> 4, c = i & 15, d = n * 16 + (c ^ (n & 15)); ((LAS v4u*)k1l)[d] = ((const v4u*)P.K1)[i]; ((LAS v4u*)k2l)[d] = ((const v4u*)P.K2)[i]; }
    __syncthreads();
    for (int unit = vcu; unit < M / 64; unit += G) {
#pragma unroll 1
        for (int st = 0; st < 4; ++st) {
            const bool late = P7_STAGGER ? (wave >= 4) : false;
            const bool is_topk = late ? (st < 2) : ((st & 1) == 0);
            const int g = late ? (st & 1) : (st >> 1);
            if (is_topk) peer_topk_unit_mfma(P, (const LAS unsigned char*)k1l, (const LAS unsigned char*)k2l, idxl, gatel, unit, lane, wave, g, g + 1);
#if GATHER_HALF
            else peer_gather_half(P, lds, unit, lane, wave, g, g + 1);
#else
            else peer_gather_sorted(P, lds, unit, lane, wave, g, g + 1);
#endif
        }
        __syncthreads();
    }
}

struct Args { const float* in[19]; float* out; unsigned char* ws; int ph_lo, ph_hi; };
__global__ void __launch_bounds__(NWAVES * 64, 2) mega_fwd(Args args) {
    extern __shared__ __attribute__((aligned(16))) unsigned char lds_raw[];
    LAS unsigned char* lds = (LAS unsigned char*)lds_raw;
    const int tid = threadIdx.x, lane = tid & 63, wave = __builtin_amdgcn_readfirstlane(tid >> 6);
    const int G = gridDim.x; const int bx = blockIdx.x; const int vcu = (G % 8 == 0) ? (bx % 8) * (G / 8) + bx / 8 : bx;
    unsigned char* ws = args.ws;
    Ptrs P;
    P.x = args.in[0]; P.mix_w = args.in[1]; P.w_in = args.in[2]; P.rel_bias = args.in[3]; P.sinks = args.in[4]; P.w_pa = args.in[5]; P.ln_w = args.in[6]; P.ln_b = args.in[7];
    P.w_s = args.in[8]; P.b_s = args.in[9]; P.w_pb = args.in[10]; P.w_out = args.in[11]; P.ffn_w = args.in[12]; P.w_q = args.in[13]; P.keys1 = args.in[14]; P.keys2 = args.in[15];
    P.pu = args.in[16]; P.pv = args.in[17]; P.fin_w = args.in[18]; P.out = args.out;
    P.WIN = (bf16*)(ws + WS_WIN); P.WPA = (bf16*)(ws + WS_WPA); P.WPB = (bf16*)(ws + WS_WPB); P.WOUT = (bf16*)(ws + WS_WOUT); P.WQ = (bf16*)(ws + WS_WQ);
    P.K1 = (bf16*)(ws + WS_K1); P.K2 = (bf16*)(ws + WS_K2); P.WS = (bf16*)(ws + WS_WS); P.U = (bf16*)(ws + WS_U); P.V = (bf16*)(ws + WS_V);
    P.U8 = ws + WS_U; P.V8 = ws + WS_U + 16 * MiB; P.USC = (float*)(ws + WS_V); P.VSC = (float*)(ws + WS_V + 65536); P.HN8 = ws + WS_HN8; P.HSC = (float*)(ws + WS_HSC); P.rowss = (float*)(ws + WS_HN8); P.rowamax = (unsigned*)(ws + WS_HN8 + 2 * MiB);
    P.XN = (bf16*)(ws + WS_R1); P.AOUT = (bf16*)(ws + WS_R1); P.BOUT = P3_FUSED ? (bf16*)(ws + WS_R1) + 512 : (bf16*)(ws + WS_R1 + 16 * MiB); P.HN2 = (bf16*)(ws + WS_R1);
    P.Q = (bf16*)(ws + WS_Q); P.KV = (bf16*)(ws + WS_KV); P.GU = (bf16*)(ws + WS_GU); P.GV = (bf16*)(ws + WS_GV); P.GA = (bf16*)(ws + WS_GA); P.GB = (bf16*)(ws + WS_GB);
    P.MERGED = (bf16*)(ws + WS_MERGED); P.QP = (bf16*)(ws + WS_QP);

    for (int u = tid; u < (LDS_BYTES - MISC_OFF) / 4; u += NWAVES * 64) ((LAS unsigned*)(lds + MISC_OFF))[u] = 0u;
    __syncthreads();
    const int lo = args.ph_lo, hi = args.ph_hi;
    unsigned* barw = (unsigned*)(ws + WS_CTL) + CW_BAR;
    XcdBarrier bar; bar.bar = barw; bar.x = 0; bar.st = nullptr;
    if (hi - lo > 1) bar = xcd_barrier_post(barw, (volatile LAS unsigned*)(lds + MISC_OFF));
#define IN(k) (lo <= (k) && (k) < hi)
#define BOTH(k) (IN(k) && IN((k) + 1))
#define GRID_BAR() do { xcd_barrier(bar); if (PROBE_BAR2) xcd_barrier(bar); } while (0)
#define REPS(k) ((k) == PROBE_PHASE ? 2 : 1)

    if (IN(0)) {
#pragma unroll
        for (int rep = 0; rep < REPS(0); ++rep) { p0_prologue(lds, P, vcu, G, lane, wave); __syncthreads(); }
        if (BOTH(0)) GRID_BAR(); }

    if (IN(1)) {
        pg8::Gemm g{P.XN, P.WIN, M, NZ, D}; pg8::StaticOrder S; S.init(M, NZ, G, bx);
        pg8::EpiZ E{P.Q, P.KV, P.GU, P.GV, P.GA, P.GB};
#pragma unroll
        for (int rep = 0; rep < REPS(1); ++rep) pg8::gemm_phase<pg8::EpiZ, pg8::StaticOrder, PG8_ALIGN, PG8_SP2>(lds, g, S, E);
        if (BOTH(1)) GRID_BAR();
    }

    if (IN(2)) {
        for (int rep = 0; rep < REPS(2); ++rep) {
#if ATTN_MFMA
        p2_attn_mfma(lds, P, vcu, G, tid, lane, wave);
#else
        p2_attn_naive(lds, P, vcu, G, tid, lane, wave);
#endif
#if GMLP_MFMA
        p2_gmlp_mfma(lds, P, vcu, G, tid, lane, wave);
#else
        p2_gmlp_naive(lds, P, vcu, G, tid, lane, wave);
#endif
        }
        if (BOTH(2)) GRID_BAR();
    }

    if (IN(3)) {
#pragma unroll
      for (int rep = 0; rep < REPS(3); ++rep) {
#if P3_FUSED
        { pg8::Gemm g{P.AOUT, P.WPA, M, D, 1024}; pg8::StaticOrder S; S.init(M, D, G, bx);
          pg8::EpiMerge2 E{P.GA, P.GB, P.MERGED};
          pg8::gemm_phase<pg8::EpiMerge2, pg8::StaticOrder, PG8_ALIGN, PG8_SP2>(lds, g, S, E); }
#else
        { pg8::Gemm g{P.AOUT, P.WPA, M, D, 512}; pg8::StaticOrder S; S.init(M, D, G, bx);
          pg8::EpiGateTmp E{P.GA, P.out};
          pg8::gemm_phase<pg8::EpiGateTmp, pg8::StaticOrder, PG8_ALIGN, PG8_SP2>(lds, g, S, E); }
        { pg8::Gemm g{P.BOUT, P.WPB, M, D, 512}; pg8::StaticOrder S; S.init(M, D, G, bx);
          pg8::EpiMerge E{P.GB, P.out, P.MERGED};
          pg8::gemm_phase<pg8::EpiMerge, pg8::StaticOrder, PG8_ALIGN, PG8_SP2>(lds, g, S, E); }
#endif
      }
        if (BOTH(3)) GRID_BAR();
    }

    if (IN(4)) {
        pg8::Gemm g{P.MERGED, P.WOUT, M, D, D}; pg8::StaticOrder S; S.init(M, D, G, bx);
#if P5_ELIM
        pg8::EpiResStats E{P.x, P.out, P.HN2, P.ffn_w, P.rowss, P.rowamax};
        pg8::gemm_phase<pg8::EpiResStats, pg8::StaticOrder, PG8_ALIGN, PG8_SP2>(lds, g, S, E);
#else
        pg8::EpiRes E{P.x, P.out};
#pragma unroll
        for (int rep = 0; rep < REPS(4); ++rep) pg8::gemm_phase<pg8::EpiRes, pg8::StaticOrder, PG8_ALIGN, PG8_SP2>(lds, g, S, E);
#endif
        if (BOTH(4)) GRID_BAR();
    }

    if (IN(5) && !P5_ELIM) {
        const int gw = vcu * NWAVES + wave, NGW = G * NWAVES;
#pragma unroll
        for (int rep = 0; rep < REPS(5); ++rep)
        for (int m = gw; m < M; m += NGW) rms_row_to_bf16_fp8(P.out + (size_t)m * D, P.ffn_w, P.HN2 + (size_t)m * D, P.HN8 + (size_t)m * D, P.HSC + m, lane);
        if (BOTH(5)) GRID_BAR();
    }

    if (IN(6)) {
        pg8::Gemm g{P.HN2, P.WQ, M, 2048, D}; pg8::StaticOrder S; S.init(M, 2048, G, bx);
#if P5_ELIM
        pg8::EpiPlainRstd E{P.QP, 2048, P.rowss};
#pragma unroll
        for (int rep = 0; rep < REPS(6); ++rep) pg8::gemm_phase<pg8::EpiPlainRstd, pg8::StaticOrder, PG8_ALIGN, PG8_SP2>(lds, g, S, E);
#else
        pg8::EpiPlain E{P.QP, 2048};
#pragma unroll
        for (int rep = 0; rep < REPS(6); ++rep) pg8::gemm_phase<pg8::EpiPlain, pg8::StaticOrder, PG8_ALIGN, PG8_SP2>(lds, g, S, E);
#endif
        if (BOTH(6)) GRID_BAR();
    }

    if (IN(7)) p7_peer(lds, P, vcu, G, tid, lane, wave);
#undef IN
#undef BOTH
#undef GRID_BAR
}

extern "C" void kernel_launch(void* const* d_in, const int* in_sizes, int n_in, void* d_out, int out_size, void* d_ws, size_t ws_size, hipStream_t stream) {
    static int grid = 0;
    if (grid == 0) {
        if (n_in != 19 || out_size != M * D || ws_size < WS_END) { fprintf(stderr, "kernel_launch: unexpected shapes (n_in %d, out %d, ws %zu)\n", n_in, out_size, ws_size); grid = -1; return; }
        int dev = 0, cus = 0, per_cu = 0;
        if (hipGetDevice(&dev) != hipSuccess || hipDeviceGetAttribute(&cus, hipDeviceAttributeMultiprocessorCount, dev) != hipSuccess) { grid = -1; return; }
        if (hipFuncSetAttribute((const void*)mega_fwd, hipFuncAttributeMaxDynamicSharedMemorySize, LDS_BYTES) != hipSuccess) { fprintf(stderr, "kernel_launch: hipFuncSetAttribute failed\n"); grid = -1; return; }
        if (hipOccupancyMaxActiveBlocksPerMultiprocessor(&per_cu, (const void*)mega_fwd, NWAVES * 64, LDS_BYTES) != hipSuccess || per_cu < 1)
            fprintf(stderr, "kernel_launch: note: occupancy query reports %d workgroups per CU\n", per_cu);
        (void)hipGetLastError();
        grid = cus;
    }
    if (grid < 0) return;
    if (hipMemsetAsync((char*)d_ws + WS_CTL, 0, CTL_ZERO_BYTES, stream) != hipSuccess) return;
    Args a{};
    for (int i = 0; i < 19; ++i) a.in[i] = (const float*)d_in[i];
    a.out = (float*)d_out; a.ws = (unsigned char*)d_ws;
#if MK_N_LAUNCHES == 1
    a.ph_lo = 0; a.ph_hi = N_PHASES;
    hipLaunchKernelGGL(mega_fwd, dim3(grid), dim3(NWAVES * 64), LDS_BYTES, stream, a);
#else
    for (int li = 0; li < N_PHASES; ++li) { a.ph_lo = li; a.ph_hi = li + 1; hipLaunchKernelGGL(mega_fwd, dim3(grid), dim3(NWAVES * 64), LDS_BYTES, stream, a); }
#endif
}
```

```cpp
#include <hip/hip_runtime.h>
#include <cstdio>
#include <cstdint>
namespace pg8 {
#define PG8_LAS __attribute__((address_space(3)))
typedef unsigned short bf16_t;
typedef short bf16x8 __attribute__((ext_vector_type(8)));
typedef float f32x4 __attribute__((ext_vector_type(4)));
typedef unsigned u32x4 __attribute__((ext_vector_type(4)));
constexpr int BM = 256, BK = 64, HALF = 128, HTB = HALF * BK * 2  , STAGE_BYTES = 8 * HTB, NXCD = 8, WGM = 8;

__host__ __device__ __forceinline__ int lds_byte(int r, int c) { const int st = (r >> 4) * 2 + (c >> 5), rr = r & 15, cc = c & 31, ob = rr * 64 + cc * 2; return st * 1024 + (ob ^ (((ob >> 9) & 1) << 5)); }
__host__ __device__ __forceinline__ void stage_rc(int b, int& R, int& C) { const int st = b / 1024, sb = b % 1024, swz = sb ^ (((sb >> 9) & 1) << 5); R = (st >> 1) * 16 + swz / 64; C = (st & 1) * 32 + (swz % 64) / 2; }
__host__ __device__ __forceinline__ int perm32(int rho) { const int n = rho >> 4, i = rho & 15; return 8 * (i >> 2) + 4 * n + (i & 3); }

struct Unit { int pm, pn; };
struct Gemm { const bf16_t* A; const bf16_t* Bt; int M, N, K; };

struct StaticOrder {
    int nM, nN, nwg, G, c;
    __host__ __device__ void init(int M, int N, int G_, int c_) { nM = M / BM; nN = N / BM; nwg = nM * nN; G = G_; c = c_; }
    __host__ __device__ bool next(int i, Unit& u) const {
        const long L = (long)i * G + c; if (L >= nwg) return false;
        int wgid = (int)L; { const int q = nwg / NXCD, r = nwg % NXCD, xcd = wgid % NXCD, off = wgid / NXCD; wgid = (xcd < r ? xcd * (q + 1) : r * (q + 1) + (xcd - r) * q) + off; }
        const int nig = WGM * nN, gid = wgid / nig, fm = gid * WGM, gsz = (nM - fm) < WGM ? (nM - fm) : WGM;
        u.pm = fm + ((wgid % nig) % gsz); u.pn = (wgid % nig) / gsz; return true;
    }
    __device__ __forceinline__ void a_ready(const Unit&) const {}
    __device__ __forceinline__ void done(const Unit&) const {}
};

__device__ __forceinline__ unsigned cvt_pk_bf16(float lo, float hi) { unsigned r; asm volatile("v_cvt_pk_bf16_f32 %0, %1, %2" : "=v"(r) : "v"(lo), "v"(hi)); return r; }
typedef float f32x2 __attribute__((ext_vector_type(2)));
template <class Epi, class Sched, bool ALIGN_EPI = false, bool SP2 = false>
__device__ __forceinline__ void gemm_phase(PG8_LAS unsigned char* lds, const Gemm g, const Sched& S, const Epi& E) {
    const int tid = threadIdx.x, wid = __builtin_amdgcn_readfirstlane(tid >> 6), lane = tid & 63, wr = wid >> 2, wc = wid & 3, fr = lane & 15, fq = lane >> 4;
    const int K = g.K, nt = K / BK;
    unsigned voffA[2], voffB[2];
#pragma unroll
    for (int i = 0; i < 2; ++i) { int R, C; stage_rc(tid * 16 + i * 8192, R, C); const int Rb = Epi::PERM ? ((R & ~31) + perm32(R & 31)) : R;
        voffA[i] = (unsigned)(R * K + C) * 2u; voffB[i] = (unsigned)(Rb * K + C) * 2u; }
    const size_t kstep = (size_t)(BK * 2);
    const size_t hstep = (size_t)HALF * K * 2;
    const size_t tstep = 2 * hstep;
    const unsigned ldsw = (unsigned)wid * 1024u;
    const int aoff = lds_byte(wr * 64 + fr, fq * 8), boff = lds_byte(wc * 32 + fr, fq * 8);
#define PG8_SA(b, h) (((b) * 2 + (h)) * HTB)
#define PG8_SB(b, h) ((4 + (b) * 2 + (h)) * HTB)
#define PG8_STAGE(bufoff, gbase, voff) do { _Pragma("unroll") for (int _i = 0; _i < 2; ++_i) \
        __builtin_amdgcn_global_load_lds((const unsigned*)((const char*)(gbase) + (voff)[_i]), (PG8_LAS unsigned*)(lds + (bufoff) + ldsw + _i * 8192), 16, 0, 0); } while (0)
#define PG8_LDA(dst, b, h) do { _Pragma("unroll") for (int m = 0; m < 4; ++m) _Pragma("unroll") for (int k = 0; k < 2; ++k) dst[m][k] = *(const PG8_LAS bf16x8*)(lds + PG8_SA(b, h) + aoff + m * 2048 + k * 1024); } while (0)
#define PG8_LDB(dst, b, h) do { _Pragma("unroll") for (int n = 0; n < 2; ++n) _Pragma("unroll") for (int k = 0; k < 2; ++k) dst[n][k] = *(const PG8_LAS bf16x8*)(lds + PG8_SB(b, h) + boff + n * 2048 + k * 1024); } while (0)
#define PG8_MMA(ai, bj, At, Bt) do { __builtin_amdgcn_s_setprio(1); _Pragma("unroll") for (int m = 0; m < 4; ++m) _Pragma("unroll") for (int n = 0; n < 2; ++n) _Pragma("unroll") for (int k = 0; k < 2; ++k) \
        acc[ai][bj][m][n] = __builtin_amdgcn_mfma_f32_16x16x32_bf16(Bt[n][k], At[m][k], acc[ai][bj][m][n], 0, 0, 0); __builtin_amdgcn_s_setprio(0); } while (0)
#define PG8_WAIT_V(n) asm volatile("s_waitcnt vmcnt(" #n ")" ::: "memory")
#define PG8_WAIT_L(n) asm volatile("s_waitcnt lgkmcnt(" #n ")" ::: "memory")
#define PG8_BAR __builtin_amdgcn_s_barrier()
#define PG8_SCHED __builtin_amdgcn_sched_barrier(0)
    Unit cur, nxt; int ui = 0;
    if (!S.next(0, cur)) return;
    f32x4 acc[2][2][4][2];
#pragma unroll
    for (int a = 0; a < 2; ++a)
#pragma unroll
        for (int b = 0; b < 2; ++b)
#pragma unroll
            for (int m = 0; m < 4; ++m)
#pragma unroll
                for (int n = 0; n < 2; ++n) acc[a][b][m][n] = (f32x4){0.f, 0.f, 0.f, 0.f};
    bf16x8 At[4][2], B0[2][2], B1[2][2];
    const char* cA = (const char*)g.A + (size_t)cur.pm * tstep; const char* cB = (const char*)g.Bt + (size_t)cur.pn * tstep;
    S.a_ready(cur);
    if constexpr (SP2) {
        PG8_STAGE(PG8_SB(0, 0), cB, voffB); PG8_STAGE(PG8_SB(0, 1), cB + hstep, voffB); PG8_STAGE(PG8_SA(0, 0), cA, voffA); PG8_STAGE(PG8_SA(0, 1), cA + hstep, voffA);
        if (wr == 1) PG8_BAR;
        PG8_WAIT_V(2); PG8_BAR;
        PG8_STAGE(PG8_SB(1, 0), cB + kstep, voffB); PG8_STAGE(PG8_SA(1, 0), cA + kstep, voffA); PG8_STAGE(PG8_SB(1, 1), cB + hstep + kstep, voffB);
        PG8_WAIT_V(6); PG8_BAR;
    } else {
        PG8_STAGE(PG8_SB(0, 0), cB, voffB); PG8_STAGE(PG8_SA(0, 0), cA, voffA); PG8_STAGE(PG8_SB(0, 1), cB + hstep, voffB); PG8_STAGE(PG8_SA(0, 1), cA + hstep, voffA);
        if (wr == 1) PG8_BAR;
        PG8_WAIT_V(4); PG8_BAR;
        PG8_STAGE(PG8_SB(1, 0), cB + kstep, voffB); PG8_STAGE(PG8_SA(1, 0), cA + kstep, voffA); PG8_STAGE(PG8_SB(1, 1), cB + hstep + kstep, voffB);
        PG8_WAIT_V(6); PG8_BAR;
    }
    for (;;) {
        const bool has_next = S.next(ui + 1, nxt);
        const char* nA = has_next ? (const char*)g.A + (size_t)nxt.pm * tstep : cA; const char* nB = has_next ? (const char*)g.Bt + (size_t)nxt.pn * tstep : cB;
        for (int t = 0; t < nt; t += 2) {
            if constexpr (Epi::HAS_MID) { if (t == (nt >> 1)) E.mid(acc, cur, wr, wc, fr, fq); }
            const bool last = (t == nt - 2);
            const char* a1 = cA + (size_t)(t + 1) * kstep;
            const char* a2 = last ? nA : cA + (size_t)(t + 2) * kstep; const char* b2 = last ? nB : cB + (size_t)(t + 2) * kstep;
            const char* a3 = a2 + kstep; const char* b3 = b2 + kstep;
            if (last && has_next) S.a_ready(nxt);
            if constexpr (SP2) {
            PG8_LDB(B0, 0, 0); PG8_LDB(B1, 0, 1); PG8_SCHED; PG8_LDA(At, 0, 0); PG8_STAGE(PG8_SA(1, 1), a1 + hstep, voffA);
            PG8_WAIT_V(8); PG8_WAIT_L(0); PG8_BAR; PG8_MMA(0, 0, At, B0); PG8_MMA(0, 1, At, B1); PG8_BAR; PG8_SCHED;
            PG8_LDA(At, 0, 1); PG8_STAGE(PG8_SB(0, 0), b2, voffB); PG8_STAGE(PG8_SB(0, 1), b2 + hstep, voffB); PG8_STAGE(PG8_SA(0, 0), a2, voffA);
            PG8_WAIT_V(8); PG8_WAIT_L(0); PG8_BAR; PG8_MMA(1, 0, At, B0); PG8_MMA(1, 1, At, B1); PG8_BAR; PG8_SCHED;
            PG8_LDB(B0, 1, 0); PG8_LDB(B1, 1, 1); PG8_SCHED; PG8_LDA(At, 1, 0); PG8_STAGE(PG8_SA(0, 1), a2 + hstep, voffA);
            PG8_WAIT_V(8); PG8_WAIT_L(0); PG8_BAR; PG8_MMA(0, 0, At, B0); PG8_MMA(0, 1, At, B1); PG8_BAR; PG8_SCHED;
            PG8_LDA(At, 1, 1); PG8_STAGE(PG8_SB(1, 0), b3, voffB); PG8_STAGE(PG8_SB(1, 1), b3 + hstep, voffB); PG8_STAGE(PG8_SA(1, 0), a3, voffA);
            PG8_WAIT_V(8); PG8_WAIT_L(0); PG8_BAR; PG8_MMA(1, 0, At, B0); PG8_MMA(1, 1, At, B1); PG8_BAR; PG8_SCHED;
            } else {
            PG8_LDB(B0, 0, 0); PG8_SCHED; PG8_LDA(At, 0, 0); PG8_STAGE(PG8_SA(1, 1), a1 + hstep, voffA);
            PG8_WAIT_L(8); PG8_BAR; PG8_WAIT_L(0); PG8_MMA(0, 0, At, B0); PG8_BAR; PG8_SCHED;
            PG8_LDB(B1, 0, 1); PG8_STAGE(PG8_SB(0, 0), b2, voffB);
            PG8_BAR; PG8_WAIT_L(0); PG8_MMA(0, 1, At, B1); PG8_BAR;
            PG8_LDA(At, 0, 1); PG8_STAGE(PG8_SA(0, 0), a2, voffA);
            PG8_BAR; PG8_WAIT_L(0); PG8_MMA(1, 0, At, B0); PG8_BAR; PG8_SCHED;
            PG8_STAGE(PG8_SB(0, 1), b2 + hstep, voffB);
            PG8_WAIT_V(6); PG8_BAR; PG8_MMA(1, 1, At, B1); PG8_BAR;
            PG8_LDB(B0, 1, 0); PG8_SCHED; PG8_LDA(At, 1, 0); PG8_STAGE(PG8_SA(0, 1), a2 + hstep, voffA);
            PG8_WAIT_L(8); PG8_BAR; PG8_WAIT_L(0); PG8_MMA(0, 0, At, B0); PG8_BAR; PG8_SCHED;
            PG8_LDB(B1, 1, 1); PG8_STAGE(PG8_SB(1, 0), b3, voffB);
            PG8_BAR; PG8_WAIT_L(0); PG8_MMA(0, 1, At, B1); PG8_BAR;
            PG8_LDA(At, 1, 1); PG8_STAGE(PG8_SA(1, 0), a3, voffA);
            PG8_BAR; PG8_WAIT_L(0); PG8_MMA(1, 0, At, B0); PG8_BAR; PG8_SCHED;
            PG8_STAGE(PG8_SB(1, 1), b3 + hstep, voffB);
            PG8_WAIT_V(6); PG8_BAR; PG8_MMA(1, 1, At, B1); PG8_BAR;
            }
        }
        if constexpr (ALIGN_EPI) { if (wr == 0) PG8_BAR; }
        if constexpr (!Epi::AFTER_DRAIN) { E(acc, cur, wr, wc, fr, fq); S.done(cur); }
        if (!has_next) break;
#pragma unroll
        for (int a = 0; a < 2; ++a)
#pragma unroll
            for (int b = 0; b < 2; ++b)
#pragma unroll
                for (int m = 0; m < 4; ++m)
#pragma unroll
                    for (int n = 0; n < 2; ++n) acc[a][b][m][n] = (f32x4){0.f, 0.f, 0.f, 0.f};
        cur = nxt; cA = nA; cB = nB; ++ui;
        if constexpr (ALIGN_EPI) { if (wr == 1) PG8_BAR; }
    }
    PG8_WAIT_V(0);
    if constexpr (!ALIGN_EPI) { if (wr == 0) PG8_BAR; }
    PG8_BAR;
    if constexpr (Epi::AFTER_DRAIN) { E.fused(acc, cur, wr, wc, fr, fq, lds, wid, lane); S.done(cur); }
#undef PG8_SA
#undef PG8_SB
#undef PG8_STAGE
#undef PG8_LDA
#undef PG8_LDB
#undef PG8_MMA
#undef PG8_WAIT_V
#undef PG8_WAIT_L
#undef PG8_BAR
#undef PG8_SCHED
}
}
#ifndef PG8_SP2
#define PG8_SP2 true
#endif
#ifndef PG8_ALIGN
#define PG8_ALIGN true
#endif

constexpr int NWAVES = 8;
#ifndef MK_N_LAUNCHES
#define MK_N_LAUNCHES 1
#endif
constexpr int N_PHASES = 8;
#ifndef ATTN_MFMA
#define ATTN_MFMA 1
#endif
#ifndef GMLP_MFMA
#define GMLP_MFMA 1
#endif
#ifndef TOPK_DBG_GATES_ONLY
#define TOPK_DBG_GATES_ONLY 0
#endif
#ifndef DBG_SHFL_WAVESUM
#define DBG_SHFL_WAVESUM 0
#endif
#ifndef TOPK_DBG_COMPARE
#define TOPK_DBG_COMPARE 0
#endif
#ifndef TOPK_DBG_SEL
#define TOPK_DBG_SEL 0
#endif
#ifndef TOPK_DBG_K0
#define TOPK_DBG_K0 0
#endif
#ifndef TOPK_DBG_K1
#define TOPK_DBG_K1 16
#endif
#ifndef TOPK_DBG_BRUTE
#define TOPK_DBG_BRUTE 0
#endif
#ifndef TOPK_DBG_INSERT
#define TOPK_DBG_INSERT 0
#endif
#ifndef TOPK_DBG_VALU_SCORES
#define TOPK_DBG_VALU_SCORES 0
#endif
#ifndef KEY_SWZ
#define KEY_SWZ (!TOPK_DBG_GATES_ONLY && !TOPK_DBG_VALU_SCORES && !TOPK_DBG_COMPARE && !TOPK_DBG_BRUTE && TOPK_DBG_INSERT != 3)
#endif
#ifndef TOPK_MFMA
#define TOPK_MFMA 1
#endif
#ifndef U_INT4
#define U_INT4 1
#endif
#ifndef X_PREFETCH
#define X_PREFETCH 0
#endif
#ifndef X1_BF16
#define X1_BF16 1
#endif
#ifndef PROBE_SWEEPS
#define PROBE_SWEEPS 1
#endif
#ifndef GATHER_HALF
#define GATHER_HALF 1
#endif
#ifndef FP4_SELFCHECK
#define FP4_SELFCHECK 0
#endif
#ifndef Q4_USTEP
#define Q4_USTEP 0.36f
#endif
#ifndef Q4_VUNIT
#define Q4_VUNIT 0.5f
#endif
#ifndef FAKEQ_U
#define FAKEQ_U 0
#endif
#ifndef FAKEQ_V
#define FAKEQ_V 0
#endif
#ifndef P7_STAGGER
#define P7_STAGGER 0
#endif
#ifndef SWEEP_SYNC
#define SWEEP_SYNC 0
#endif
#ifndef NSL
#define NSL 8
#endif
#define SLSH (NSL == 4 ? 12 : NSL == 2 ? 13 : NSL == 64 ? 8 : NSL == 32 ? 9 : NSL == 16 ? 10 : 11)
#ifndef PROBE_ROWAND
#define PROBE_ROWAND 16383u
#endif
#ifndef PROBE_V_PASSES
#define PROBE_V_PASSES 1
#endif
#ifndef PROBE_U_PASSES
#define PROBE_U_PASSES 1
#endif
#ifndef GATHER_STAGGER
#define GATHER_STAGGER 0
#endif
#ifndef WT_STORES
#define WT_STORES 0
#endif
#ifndef P5_ELIM
#define P5_ELIM 0
#endif
#ifndef P3_FUSED
#define P3_FUSED 0
#endif
#ifndef U_INT8
#define U_INT8 1
#endif
#ifndef U_DOT2
#define U_DOT2 1
#endif
#ifndef U_MFMA
#define U_MFMA 0
#endif
#ifndef GATHER_SORTED
#define GATHER_SORTED 2
#endif
#ifndef PEER_FP8
#define PEER_FP8 1
#endif
#ifndef PROBE_GATHER_REPS
#define PROBE_GATHER_REPS 1
#endif
#ifndef PROBE_TOPK_REPS
#define PROBE_TOPK_REPS 1
#endif
#ifndef PROBE_BAR2
#define PROBE_BAR2 0
#endif
#ifndef PROBE_PHASE
#define PROBE_PHASE -1
#endif
#ifndef PROBE_P2_REPS
#define PROBE_P2_REPS 1
#endif

constexpr int NB = 2, SEQ = 8192, D = 1024, M = NB * SEQ;
constexpr int NZ = 3840;
constexpr float EPS = 1e-6f;
constexpr int AB_LD = P3_FUSED ? 1024 : 512;

constexpr size_t MiB = 1u << 20;
constexpr size_t WS_CTL = 0, CTL_ZERO_BYTES = 65536;
constexpr size_t WS_WIN = 1 * MiB;
constexpr size_t WS_WPA = 9 * MiB;
constexpr size_t WS_WPB = 10 * MiB;
constexpr size_t WS_WOUT = 11 * MiB;
constexpr size_t WS_WQ = 13 * MiB;
constexpr size_t WS_K1 = 17 * MiB;
constexpr size_t WS_K2 = 17 * MiB + 32768;
constexpr size_t WS_WS = 17 * MiB + 65536;
constexpr size_t WS_U = 18 * MiB;
constexpr size_t WS_V = 50 * MiB;
constexpr size_t WS_R1 = 82 * MiB;
constexpr size_t WS_Q = 114 * MiB;
constexpr size_t WS_KV = 130 * MiB;
constexpr size_t WS_GU = 138 * MiB;
constexpr size_t WS_GV = 154 * MiB;
constexpr size_t WS_GA = 170 * MiB;
constexpr size_t WS_GB = 202 * MiB;
constexpr size_t WS_MERGED = 114 * MiB;
constexpr size_t WS_QP = 170 * MiB;
constexpr size_t WS_HN8 = 146 * MiB;
constexpr size_t WS_HSC = 162 * MiB;
constexpr size_t WS_END = 234 * MiB;
constexpr int CW_BAR = 0;

constexpr int RING_BYTES = 131072;
constexpr int MISC_OFF = 143360;
constexpr int LDS_BYTES = 147456;

#define GAS __attribute__((address_space(1)))
#define LAS __attribute__((address_space(3)))
typedef unsigned short bf16;
typedef unsigned v4u __attribute__((ext_vector_type(4)));
typedef unsigned v2u __attribute__((ext_vector_type(2)));
typedef float f32x4 __attribute__((ext_vector_type(4)));
typedef _Float16 h2 __attribute__((ext_vector_type(2)));
typedef GAS unsigned gu32;
typedef __bf16 bf16x2_t __attribute__((ext_vector_type(2)));
#define RLX_AGENT __ATOMIC_RELAXED, __HIP_MEMORY_SCOPE_AGENT
#define LDS_WAIT() asm volatile("s_waitcnt lgkmcnt(0)" ::: "memory")
#define VM_WAIT() asm volatile("s_waitcnt vmcnt(0)" ::: "memory")
__device__ __forceinline__ unsigned f2bf(float f) { unsigned u = __builtin_bit_cast(unsigned, f); return (u + 0x7fffu + ((u >> 16) & 1u)) >> 16; }
__device__ __forceinline__ unsigned pk2(float lo, float hi) { return f2bf(lo) | (f2bf(hi) << 16); }
__device__ __forceinline__ float bflo(unsigned w) { return __builtin_bit_cast(float, w << 16); }
__device__ __forceinline__ float bfhi(unsigned w) { return __builtin_bit_cast(float, w & 0xffff0000u); }
__device__ __forceinline__ float bf2f(bf16 h) { return __builtin_bit_cast(float, (unsigned)h << 16); }
__device__ __forceinline__ float dot2bf(unsigned a, unsigned b, float c) { return __builtin_amdgcn_fdot2_f32_bf16(__builtin_bit_cast(bf16x2_t, a), __builtin_bit_cast(bf16x2_t, b), c, false); }
__device__ __forceinline__ float gelu_tanh(float v) {
    const float t2 = v * (-2.302208198f + (-0.1029432397f) * v * v);
    return v * __builtin_amdgcn_rcpf(1.0f + __builtin_amdgcn_exp2f(t2));
}
__device__ __forceinline__ float sigmoid_f(float v) { return __builtin_amdgcn_rcpf(1.0f + __builtin_amdgcn_exp2f(-1.4426950409f * v)); }
template <int CTRL> __device__ __forceinline__ float dppmov(float v) { return __builtin_bit_cast(float, __builtin_amdgcn_update_dpp(0, __builtin_bit_cast(int, v), CTRL, 0xF, 0xF, false)); }
__device__ __forceinline__ float row16_sum(float v) {
    v += dppmov<0xB1>(v);
    v += dppmov<0x4E>(v);
    v += dppmov<0x141>(v);
    v += dppmov<0x140>(v);
    return v;
}
__device__ __forceinline__ float xor32_f(float v) {
    const unsigned u = __builtin_bit_cast(unsigned, v);
    auto rr = __builtin_amdgcn_permlane32_swap(u, u, false, false);
    const unsigned r0 = rr[0], r1 = rr[1];
    return __builtin_bit_cast(float, (__lane_id() & 32) ? r0 : r1);
}
__device__ __forceinline__ float wave_sum(float v) {
#if DBG_SHFL_WAVESUM
#pragma unroll
    for (int o = 1; o < 64; o <<= 1) v += __shfl_xor(v, o);
    return v;
#endif
    v = row16_sum(v);
    v += __builtin_bit_cast(float, __builtin_amdgcn_ds_swizzle(__builtin_bit_cast(int, v), 0x401F));
    const unsigned u = __builtin_bit_cast(unsigned, v);
    auto rr = __builtin_amdgcn_permlane32_swap(u, u, false, false);
    const unsigned r0 = rr[0], r1 = rr[1];
    return __builtin_bit_cast(float, r0) + __builtin_bit_cast(float, r1);
}
__device__ __forceinline__ float wave_max(float v) {
    v = fmaxf(v, dppmov<0xB1>(v)); v = fmaxf(v, dppmov<0x4E>(v)); v = fmaxf(v, dppmov<0x141>(v)); v = fmaxf(v, dppmov<0x140>(v));
    v = fmaxf(v, __builtin_bit_cast(float, __builtin_amdgcn_ds_swizzle(__builtin_bit_cast(int, v), 0x401F)));
    const unsigned u = __builtin_bit_cast(unsigned, v);
    auto rr = __builtin_amdgcn_permlane32_swap(u, u, false, false);
    const unsigned r0 = rr[0], r1 = rr[1];
    return fmaxf(__builtin_bit_cast(float, r0), __builtin_bit_cast(float, r1));
}
__device__ const unsigned char T5B[128] = {0, 1, 2, 3, 4, 5, 6, 7, 8, 9, 10, 11, 12, 13, 14, 15, 16, 16, 16, 17, 17, 18, 18, 18, 19, 19, 19, 20, 20, 20, 20, 21, 21, 21, 21, 22, 22, 22, 22, 22, 23, 23, 23, 23, 23, 23, 24, 24, 24, 24, 24, 24, 25, 25, 25, 25, 25, 25, 25, 26, 26, 26, 26, 26, 26, 26, 26, 27, 27, 27, 27, 27, 27, 27, 27, 27, 27, 28, 28, 28, 28, 28, 28, 28, 28, 28, 28, 29, 29, 29, 29, 29, 29, 29, 29, 29, 29, 29, 29, 30, 30, 30, 30, 30, 30, 30, 30, 30, 30, 30, 30, 30, 30, 31, 31, 31, 31, 31, 31, 31, 31, 31, 31, 31, 31, 31, 31, 31};
#define XB_TMO      128
#define XB_XCNT(j)  (256  + 64 * (j))
#define XB_XSUB(j)  (1280 + 64 * (j))
#define XB_XGEN(j)  (2304 + 64 * (j))
#define XB_TOP      3328
#define XB_TOPGEN   3392
#define XCD_BAR_WORDS 3456
#define XB_SPIN_CAP (1u << 18)

__device__ __forceinline__ unsigned xb_ld(unsigned* p)              { return __hip_atomic_load(p, __ATOMIC_RELAXED, __HIP_MEMORY_SCOPE_AGENT); }
__device__ __forceinline__ unsigned xb_add(unsigned* p, unsigned v) { return __hip_atomic_fetch_add(p, v, __ATOMIC_RELAXED, __HIP_MEMORY_SCOPE_AGENT); }
__device__ __forceinline__ unsigned xb_xcc_id() { return (unsigned)__builtin_amdgcn_s_getreg((3 << 11) | 20) & 0xFu; }
#define XB_SPIN(cond, bar) do { unsigned _sp = 0; while (cond) { __builtin_amdgcn_s_sleep(1); \
    if ((++_sp & 255u) == 0u) { if (xb_ld(&(bar)[XB_TMO])) break; if (_sp > XB_SPIN_CAP) { atomicAdd(&(bar)[XB_TMO], 1u); break; } } } } while (0)

struct XcdBarrier {
    unsigned* bar; unsigned x;
    volatile LAS unsigned* st;
};

__device__ __forceinline__ XcdBarrier xcd_barrier_post(unsigned* bar, volatile LAS unsigned* st) {
    XcdBarrier b; b.bar = bar; b.x = xb_xcc_id(); b.st = st;
    if (threadIdx.x == 0) (void)xb_add(&bar[XB_XCNT(b.x)], 1u);
    return b;
}
__device__ __forceinline__ void xcd_barrier_complete(unsigned* bar, unsigned x, unsigned& nloc, unsigned& nx) {
    const unsigned G = gridDim.x * gridDim.y * gridDim.z;
    unsigned sum, cnt, mine, sp = 0u;
    for (;;) {
        sum = 0u; cnt = 0u; mine = 0u;
#pragma unroll
        for (unsigned j = 0; j < 16; ++j) { const unsigned c = xb_ld(&bar[XB_XCNT(j)]); sum += c; cnt += (c > 0u) ? 1u : 0u; mine = (j == x) ? c : mine; }
        if (sum == G) break;
        __builtin_amdgcn_s_sleep(1);
        if ((++sp & 255u) == 0u) { if (xb_ld(&bar[XB_TMO])) break; if (sp > XB_SPIN_CAP) { atomicAdd(&bar[XB_TMO], 1u); break; } }
    }
    nloc = mine > 0u ? mine : 1u; nx = cnt > 0u ? cnt : 1u;
}

__device__ __forceinline__ void xcd_barrier(const XcdBarrier& b) {
    asm volatile("s_waitcnt vmcnt(0)" ::: "memory");
    __syncthreads();
    if (threadIdx.x == 0) {
        unsigned* bar = b.bar;
        __builtin_amdgcn_s_waitcnt(0);
        unsigned nloc = b.st[0], nx = b.st[1];
        if (nloc == 0u) { xcd_barrier_complete(bar, b.x, nloc, nx); b.st[0] = nloc; b.st[1] = nx; }
        const unsigned old = xb_add(&bar[XB_XSUB(b.x)], 1u);
        const unsigned gen = old / nloc;
        if (old + 1u == (gen + 1u) * nloc) {
            __builtin_amdgcn_fence(__ATOMIC_RELEASE, "agent");
            asm volatile("s_waitcnt vmcnt(0)" ::: "memory");
            const unsigned og = xb_add(&bar[XB_TOP], 1u);
            const unsigned tg = og / nx;
            if (og + 1u == (tg + 1u) * nx) xb_add(&bar[XB_TOPGEN], 1u);
            else XB_SPIN(xb_ld(&bar[XB_TOPGEN]) == tg, bar);
            __builtin_amdgcn_fence(__ATOMIC_ACQUIRE, "agent");
            xb_add(&bar[XB_XGEN(b.x)], 1u);
            asm volatile("s_waitcnt vmcnt(0)" ::: "memory");
        } else {
            XB_SPIN(xb_ld(&bar[XB_XGEN(b.x)]) == gen, bar);
            __builtin_amdgcn_fence(__ATOMIC_ACQUIRE, "agent");
            asm volatile("s_waitcnt vmcnt(0)" ::: "memory");
        }
    }
    __syncthreads();
}
#if WT_STORES
#define ST16(PTR, VAL) asm volatile("global_store_dwordx4 %0, %1, off sc1\n\ts_nop 1" :: "v"(PTR), "v"(VAL) : "memory")
#else
#define ST16(PTR, VAL) (*(PTR) = (VAL))
#endif
namespace pg8 {
struct EpiZ {
    static constexpr bool PERM = true, AFTER_DRAIN = false, HAS_MID = false;
    bf16_t *Q, *KV, *GU, *GV, *GA, *GB;
    __device__ __forceinline__ void operator()(const f32x4 (&acc)[2][2][4][2], const Unit& u, int wr, int wc, int fr, int fq) const {
        const int pn = u.pn; bf16_t* base; int ldc, colt, act;
        if (pn < 2)       { base = Q;  ldc = 512;  colt = pn * 256;        act = 0; }
        else if (pn == 2) { base = KV; ldc = 256;  colt = 0;               act = 0; }
        else if (pn < 5)  { base = GU; ldc = 512;  colt = (pn - 3) * 256;  act = 1; }
        else if (pn < 7)  { base = GV; ldc = 512;  colt = (pn - 5) * 256;  act = 1; }
        else if (pn < 11) { base = GA; ldc = 1024; colt = (pn - 7) * 256;  act = 2; }
        else              { base = GB; ldc = 1024; colt = (pn - 11) * 256; act = 2; }
        const int row0 = u.pm * BM + wr * 64 + fr, col0 = colt + wc * 32 + 8 * fq;
#pragma unroll
        for (int ai = 0; ai < 2; ++ai)
#pragma unroll
            for (int m = 0; m < 4; ++m) { bf16_t* rowp = base + (size_t)(row0 + ai * HALF + m * 16) * ldc + col0;
#pragma unroll
                for (int bj = 0; bj < 2; ++bj) { f32x4 v0 = acc[ai][bj][m][0], v1 = acc[ai][bj][m][1];
                    if (act == 1) {
#pragma unroll
                        for (int e = 0; e < 4; ++e) { v0[e] = gelu_tanh(v0[e]); v1[e] = gelu_tanh(v1[e]); }
                    } else if (act == 2) {
#pragma unroll
                        for (int e = 0; e < 4; ++e) { v0[e] = sigmoid_f(v0[e]); v1[e] = sigmoid_f(v1[e]); }
                    }
                    u32x4 w; w.x = cvt_pk_bf16(v0[0], v0[1]); w.y = cvt_pk_bf16(v0[2], v0[3]); w.z = cvt_pk_bf16(v1[0], v1[1]); w.w = cvt_pk_bf16(v1[2], v1[3]);
                    ST16((u32x4*)(rowp + bj * HALF), w); } }
    }
};
struct EpiGateTmp {
    static constexpr bool PERM = true, AFTER_DRAIN = false, HAS_MID = false;
    const bf16_t* gate; float* tmp;
    __device__ __forceinline__ void operator()(const f32x4 (&acc)[2][2][4][2], const Unit& u, int wr, int wc, int fr, int fq) const {
        const int row0 = u.pm * BM + wr * 64 + fr, col0 = u.pn * BM + wc * 32 + 8 * fq;
#pragma unroll
        for (int ai = 0; ai < 2; ++ai)
#pragma unroll
            for (int m = 0; m < 4; ++m) { const size_t ro = (size_t)(row0 + ai * HALF + m * 16) * 1024 + col0;
#pragma unroll
                for (int bj = 0; bj < 2; ++bj) { const u32x4 g = *(const u32x4*)(gate + ro + bj * HALF); f32x4 v0 = acc[ai][bj][m][0], v1 = acc[ai][bj][m][1];
                    v0[0] *= bflo(g.x); v0[1] *= bfhi(g.x); v0[2] *= bflo(g.y); v0[3] *= bfhi(g.y); v1[0] *= bflo(g.z); v1[1] *= bfhi(g.z); v1[2] *= bflo(g.w); v1[3] *= bfhi(g.w);
                    ST16((f32x4*)(tmp + ro + bj * HALF), v0); ST16((f32x4*)(tmp + ro + bj * HALF + 4), v1); } }
    }
};
struct EpiMerge {
    static constexpr bool PERM = true, AFTER_DRAIN = false, HAS_MID = false;
    const bf16_t* gate; const float* tmp; bf16_t* out;
    __device__ __forceinline__ void operator()(const f32x4 (&acc)[2][2][4][2], const Unit& u, int wr, int wc, int fr, int fq) const {
        const int row0 = u.pm * BM + wr * 64 + fr, col0 = u.pn * BM + wc * 32 + 8 * fq;
#pragma unroll
        for (int ai = 0; ai < 2; ++ai)
#pragma unroll
            for (int m = 0; m < 4; ++m) { const size_t ro = (size_t)(row0 + ai * HALF + m * 16) * 1024 + col0;
#pragma unroll
                for (int bj = 0; bj < 2; ++bj) { const u32x4 g = *(const u32x4*)(gate + ro + bj * HALF); f32x4 v0 = acc[ai][bj][m][0], v1 = acc[ai][bj][m][1];
                    const f32x4 t0 = *(const f32x4*)(tmp + ro + bj * HALF), t1 = *(const f32x4*)(tmp + ro + bj * HALF + 4);
                    v0[0] = t0[0] + v0[0] * bflo(g.x); v0[1] = t0[1] + v0[1] * bfhi(g.x); v0[2] = t0[2] + v0[2] * bflo(g.y); v0[3] = t0[3] + v0[3] * bfhi(g.y);
                    v1[0] = t1[0] + v1[0] * bflo(g.z); v1[1] = t1[1] + v1[1] * bfhi(g.z); v1[2] = t1[2] + v1[2] * bflo(g.w); v1[3] = t1[3] + v1[3] * bfhi(g.w);
                    u32x4 w; w.x = cvt_pk_bf16(v0[0], v0[1]); w.y = cvt_pk_bf16(v0[2], v0[3]); w.z = cvt_pk_bf16(v1[0], v1[1]); w.w = cvt_pk_bf16(v1[2], v1[3]);
                    ST16((u32x4*)(out + ro + bj * HALF), w); } }
    }
};
struct EpiMerge2 {
    static constexpr bool PERM = true, AFTER_DRAIN = false, HAS_MID = true;
    const bf16_t* ga; const bf16_t* gb; bf16_t* out;
    __device__ __forceinline__ void mid(f32x4 (&acc)[2][2][4][2], const Unit& u, int wr, int wc, int fr, int fq) const {
        const int row0 = u.pm * BM + wr * 64 + fr, col0 = u.pn * BM + wc * 32 + 8 * fq;
#pragma unroll
        for (int ai = 0; ai < 2; ++ai)
#pragma unroll
            for (int m = 0; m < 4; ++m) { const size_t ro = (size_t)(row0 + ai * HALF + m * 16) * 1024 + col0;
#pragma unroll
                for (int bj = 0; bj < 2; ++bj) { const u32x4 a = *(const u32x4*)(ga + ro + bj * HALF), b = *(const u32x4*)(gb + ro + bj * HALF);
                    f32x4 r0, r1;
                    r0[0] = bflo(a.x) * __builtin_amdgcn_rcpf(fmaxf(bflo(b.x), 1e-20f)); r0[1] = bfhi(a.x) * __builtin_amdgcn_rcpf(fmaxf(bfhi(b.x), 1e-20f)); r0[2] = bflo(a.y) * __builtin_amdgcn_rcpf(fmaxf(bflo(b.y), 1e-20f)); r0[3] = bfhi(a.y) * __builtin_amdgcn_rcpf(fmaxf(bfhi(b.y), 1e-20f));
                    r1[0] = bflo(a.z) * __builtin_amdgcn_rcpf(fmaxf(bflo(b.z), 1e-20f)); r1[1] = bfhi(a.z) * __builtin_amdgcn_rcpf(fmaxf(bfhi(b.z), 1e-20f)); r1[2] = bflo(a.w) * __builtin_amdgcn_rcpf(fmaxf(bflo(b.w), 1e-20f)); r1[3] = bfhi(a.w) * __builtin_amdgcn_rcpf(fmaxf(bfhi(b.w), 1e-20f));
                    acc[ai][bj][m][0] = acc[ai][bj][m][0] * r0; acc[ai][bj][m][1] = acc[ai][bj][m][1] * r1; } }
    }
    __device__ __forceinline__ void operator()(const f32x4 (&acc)[2][2][4][2], const Unit& u, int wr, int wc, int fr, int fq) const {
        const int row0 = u.pm * BM + wr * 64 + fr, col0 = u.pn * BM + wc * 32 + 8 * fq;
#pragma unroll
        for (int ai = 0; ai < 2; ++ai)
#pragma unroll
            for (int m = 0; m < 4; ++m) { const size_t ro = (size_t)(row0 + ai * HALF + m * 16) * 1024 + col0;
#pragma unroll
                for (int bj = 0; bj < 2; ++bj) { const u32x4 b = *(const u32x4*)(gb + ro + bj * HALF); f32x4 v0 = acc[ai][bj][m][0], v1 = acc[ai][bj][m][1];
                    v0[0] *= fmaxf(bflo(b.x), 1e-20f); v0[1] *= fmaxf(bfhi(b.x), 1e-20f); v0[2] *= fmaxf(bflo(b.y), 1e-20f); v0[3] *= fmaxf(bfhi(b.y), 1e-20f);
                    v1[0] *= fmaxf(bflo(b.z), 1e-20f); v1[1] *= fmaxf(bfhi(b.z), 1e-20f); v1[2] *= fmaxf(bflo(b.w), 1e-20f); v1[3] *= fmaxf(bfhi(b.w), 1e-20f);
                    u32x4 w; w.x = cvt_pk_bf16(v0[0], v0[1]); w.y = cvt_pk_bf16(v0[2], v0[3]); w.z = cvt_pk_bf16(v1[0], v1[1]); w.w = cvt_pk_bf16(v1[2], v1[3]);
                    ST16((u32x4*)(out + ro + bj * HALF), w); } }
    }
};
struct EpiRes {
    static constexpr bool PERM = false, AFTER_DRAIN = false, HAS_MID = false;
    const float* base; float* C;
    __device__ __forceinline__ void operator()(const f32x4 (&acc)[2][2][4][2], const Unit& u, int wr, int wc, int fr, int fq) const {
        const int row0 = u.pm * BM + wr * 64 + fr, col0 = u.pn * BM + wc * 32 + 4 * fq;
#pragma unroll
        for (int ai = 0; ai < 2; ++ai)
#pragma unroll
            for (int m = 0; m < 4; ++m) { const size_t ro = (size_t)(row0 + ai * HALF + m * 16) * 1024 + col0;
#pragma unroll
                for (int bj = 0; bj < 2; ++bj)
#pragma unroll
                    for (int n = 0; n < 2; ++n) { const f32x4 v_ = *(const f32x4*)(base + ro + bj * HALF + n * 16) + acc[ai][bj][m][n]; ST16((f32x4*)(C + ro + bj * HALF + n * 16), v_); } }
    }
};
struct EpiResB {
    static constexpr bool PERM = true, AFTER_DRAIN = false, HAS_MID = false;
    const float* base; bf16_t* Cb;
    __device__ __forceinline__ void operator()(const f32x4 (&acc)[2][2][4][2], const Unit& u, int wr, int wc, int fr, int fq) const {
        const int row0 = u.pm * BM + wr * 64 + fr, col0 = u.pn * BM + wc * 32 + 8 * fq;
#pragma unroll
        for (int ai = 0; ai < 2; ++ai)
#pragma unroll
            for (int m = 0; m < 4; ++m) { const size_t ro = (size_t)(row0 + ai * HALF + m * 16) * 1024 + col0;
#pragma unroll
                for (int bj = 0; bj < 2; ++bj) { const f32x4 v0 = *(const f32x4*)(base + ro + bj * HALF) + acc[ai][bj][m][0], v1 = *(const f32x4*)(base + ro + bj * HALF + 4) + acc[ai][bj][m][1];
                    u32x4 w; w.x = cvt_pk_bf16(v0[0], v0[1]); w.y = cvt_pk_bf16(v0[2], v0[3]); w.z = cvt_pk_bf16(v1[0], v1[1]); w.w = cvt_pk_bf16(v1[2], v1[3]);
                    ST16((u32x4*)(Cb + ro + bj * HALF), w); } }
    }
};
struct EpiResStats {
    static constexpr bool PERM = false, AFTER_DRAIN = false, HAS_MID = false;
    const float* base; float* C; bf16_t* Cb; const float* w; float* rowss; unsigned* rowamax;
    __device__ __forceinline__ void operator()(const f32x4 (&acc)[2][2][4][2], const Unit& u, int wr, int wc, int fr, int fq) const {
        const int row0 = u.pm * BM + wr * 64 + fr, col0 = u.pn * BM + wc * 32 + 4 * fq;
        f32x4 wv[2][2];
#pragma unroll
        for (int bj = 0; bj < 2; ++bj)
#pragma unroll
            for (int n = 0; n < 2; ++n) wv[bj][n] = *(const f32x4*)(w + col0 + bj * HALF + n * 16);
#pragma unroll
        for (int ai = 0; ai < 2; ++ai)
#pragma unroll
            for (int m = 0; m < 4; ++m) { const int row = row0 + ai * HALF + m * 16; const size_t ro = (size_t)row * 1024 + col0; float ss = 0.f, am = 0.f;
#pragma unroll
                for (int bj = 0; bj < 2; ++bj)
#pragma unroll
                    for (int n = 0; n < 2; ++n) { const f32x4 v = *(const f32x4*)(base + ro + bj * HALF + n * 16) + acc[ai][bj][m][n];
                        *(f32x4*)(C + ro + bj * HALF + n * 16) = v;
                        typedef unsigned u32x2 __attribute__((ext_vector_type(2))); u32x2 pb; pb.x = cvt_pk_bf16(v[0], v[1]); pb.y = cvt_pk_bf16(v[2], v[3]); *(u32x2*)(Cb + ro + bj * HALF + n * 16) = pb;
                        ss += (v[0] * v[0] + v[1] * v[1]) + (v[2] * v[2] + v[3] * v[3]);
                        const f32x4 t = v * wv[bj][n]; am = fmaxf(am, fmaxf(fmaxf(fabsf(t[0]), fabsf(t[1])), fmaxf(fabsf(t[2]), fabsf(t[3])))); }
                ss += __shfl_xor(ss, 16); ss += __shfl_xor(ss, 32); am = fmaxf(am, __shfl_xor(am, 16)); am = fmaxf(am, __shfl_xor(am, 32));
                if (fq == 0) { rowss[(size_t)row * 16 + u.pn * 4 + wc] = ss; rowamax[(size_t)row * 16 + u.pn * 4 + wc] = __builtin_bit_cast(unsigned, am); } }
    }
};
struct EpiPlainRstd {
    static constexpr bool PERM = true, AFTER_DRAIN = false, HAS_MID = false;
    bf16_t* O; int ldc; const float* rowss;
    __device__ __forceinline__ void operator()(const f32x4 (&acc)[2][2][4][2], const Unit& u, int wr, int wc, int fr, int fq) const {
        const int row0 = u.pm * BM + wr * 64 + fr, col0 = u.pn * BM + wc * 32 + 8 * fq;
#pragma unroll
        for (int ai = 0; ai < 2; ++ai)
#pragma unroll
            for (int m = 0; m < 4; ++m) { const int row = row0 + ai * HALF + m * 16; bf16_t* rowp = O + (size_t)row * ldc + col0;
                const f32x4* rp_ = (const f32x4*)(rowss + (size_t)row * 16); const f32x4 q_ = (rp_[0] + rp_[1]) + (rp_[2] + rp_[3]);
                const float rstd = 1.0f / sqrtf(((q_[0] + q_[1]) + (q_[2] + q_[3])) * (1.0f / 1024.0f) + 1e-6f);
#pragma unroll
                for (int bj = 0; bj < 2; ++bj) { const f32x4 v0 = acc[ai][bj][m][0] * rstd, v1 = acc[ai][bj][m][1] * rstd;
                    u32x4 w; w.x = cvt_pk_bf16(v0[0], v0[1]); w.y = cvt_pk_bf16(v0[2], v0[3]); w.z = cvt_pk_bf16(v1[0], v1[1]); w.w = cvt_pk_bf16(v1[2], v1[3]);
                    ST16((u32x4*)(rowp + bj * HALF), w); } }
    }
};
struct EpiPlain {
    static constexpr bool PERM = true, AFTER_DRAIN = false, HAS_MID = false;
    bf16_t* O; int ldc;
    __device__ __forceinline__ void operator()(const f32x4 (&acc)[2][2][4][2], const Unit& u, int wr, int wc, int fr, int fq) const {
        const int row0 = u.pm * BM + wr * 64 + fr, col0 = u.pn * BM + wc * 32 + 8 * fq;
#pragma unroll
        for (int ai = 0; ai < 2; ++ai)
#pragma unroll
            for (int m = 0; m < 4; ++m) { bf16_t* rowp = O + (size_t)(row0 + ai * HALF + m * 16) * ldc + col0;
#pragma unroll
                for (int bj = 0; bj < 2; ++bj) { const f32x4 v0 = acc[ai][bj][m][0], v1 = acc[ai][bj][m][1];
                    u32x4 w; w.x = cvt_pk_bf16(v0[0], v0[1]); w.y = cvt_pk_bf16(v0[2], v0[3]); w.z = cvt_pk_bf16(v1[0], v1[1]); w.w = cvt_pk_bf16(v1[2], v1[3]);
                    ST16((u32x4*)(rowp + bj * HALF), w); } }
    }
};
}

__device__ __forceinline__ void p0_transpose_item(const float* W, int K, int N, bf16* WT, LAS float* scr, int item, int lane, int ldk = 0, int koff = 0, const float* kscale = nullptr) {
    if (ldk == 0) ldk = K;
    const int nblk = N / 32, kb = item / nblk, nb = item % nblk, k0 = 64 * kb, n0 = 32 * nb;
#pragma unroll 8
    for (int i = 0; i < 32; ++i) { const int kk = 2 * i + (lane >> 5); scr[kk * 33 + (lane & 31)] = W[(size_t)(k0 + kk) * N + n0 + (lane & 31)] * (kscale ? kscale[k0 + kk] : 1.0f); }
    LDS_WAIT(); asm volatile("" ::: "memory");
    const int c = lane & 7;
#pragma unroll
    for (int j = 0; j < 4; ++j) { const int n = (lane >> 3) + 8 * j; const LAS float* s = scr + (8 * c) * 33 + n;
        v4u o; o.x = pk2(s[0 * 33], s[1 * 33]); o.y = pk2(s[2 * 33], s[3 * 33]); o.z = pk2(s[4 * 33], s[5 * 33]); o.w = pk2(s[6 * 33], s[7 * 33]);
        *(v4u*)(WT + (size_t)(n0 + n) * ldk + koff + k0 + 8 * c) = o; }
    LDS_WAIT(); asm volatile("" ::: "memory");
}
__device__ __forceinline__ void cvt_flat(const float* src, bf16* dst, size_t n, int gw, int NGW, int lane) {
    for (size_t i = (size_t)gw * 512 + lane * 8; i < n; i += (size_t)NGW * 512) {
        const f32x4 a = *(const f32x4*)(src + i), b = *(const f32x4*)(src + i + 4);
        v4u o; o.x = pk2(a[0], a[1]); o.y = pk2(a[2], a[3]); o.z = pk2(b[0], b[1]); o.w = pk2(b[2], b[3]);
        *(v4u*)(dst + i) = o;
    }
}
__device__ __forceinline__ void rms_row_to_bf16(const float* xrow, const float* w, bf16* orow, int lane) {
    const f32x4* xr = (const f32x4*)xrow + lane; const f32x4* wr = (const f32x4*)w + lane;
    f32x4 v[4]; float s = 0.f;
#pragma unroll
    for (int j = 0; j < 4; ++j) { v[j] = xr[64 * j]; s += (v[j][0] * v[j][0] + v[j][1] * v[j][1]) + (v[j][2] * v[j][2] + v[j][3] * v[j][3]); }
    const float rstd = 1.0f / sqrtf(wave_sum(s) * (1.0f / 1024.0f) + EPS);
    unsigned long long* o8 = (unsigned long long*)orow + lane;
#pragma unroll
    for (int j = 0; j < 4; ++j) { const f32x4 ww = wr[64 * j];
        o8[64 * j] = (unsigned long long)pk2(v[j][0] * rstd * ww[0], v[j][1] * rstd * ww[1]) | ((unsigned long long)pk2(v[j][2] * rstd * ww[2], v[j][3] * rstd * ww[3]) << 32); }
}

__device__ __forceinline__ int pack_i8x4(float a, float b, float c, float d) {
    const int qa = (int)__builtin_rintf(a), qb = (int)__builtin_rintf(b), qc = (int)__builtin_rintf(c), qd = (int)__builtin_rintf(d);
    return (qa & 255) | ((qb & 255) << 8) | ((qc & 255) << 16) | ((int)((unsigned)qd << 24));
}
__device__ __forceinline__ void rms_row_to_bf16_fp8(const float* xrow, const float* w, bf16* orow, unsigned char* o8row, float* oinv, int lane) {
    const f32x4* xr = (const f32x4*)xrow + lane; const f32x4* wr = (const f32x4*)w + lane;
    f32x4 v[4]; float s = 0.f;
#if X1_BF16
    { const v2u* xb = (const v2u*)xrow + lane;
#pragma unroll
      for (int j = 0; j < 4; ++j) { const v2u q = xb[64 * j]; v[j][0] = bflo(q.x); v[j][1] = bfhi(q.x); v[j][2] = bflo(q.y); v[j][3] = bfhi(q.y); } }
#pragma unroll
    for (int j = 0; j < 4; ++j) s += (v[j][0] * v[j][0] + v[j][1] * v[j][1]) + (v[j][2] * v[j][2] + v[j][3] * v[j][3]);
#else
#pragma unroll
    for (int j = 0; j < 4; ++j) { v[j] = xr[64 * j]; s += (v[j][0] * v[j][0] + v[j][1] * v[j][1]) + (v[j][2] * v[j][2] + v[j][3] * v[j][3]); }
#endif
    const float rstd = 1.0f / sqrtf(wave_sum(s) * (1.0f / 1024.0f) + EPS);
    unsigned long long* o8 = (unsigned long long*)orow + lane; float mx = 0.f;
#pragma unroll
    for (int j = 0; j < 4; ++j) { const f32x4 ww = wr[64 * j]; v[j] = v[j] * rstd * ww;
        o8[64 * j] = (unsigned long long)pk2(v[j][0], v[j][1]) | ((unsigned long long)pk2(v[j][2], v[j][3]) << 32);
        mx = fmaxf(mx, fmaxf(fmaxf(fabsf(v[j][0]), fabsf(v[j][1])), fmaxf(fabsf(v[j][2]), fabsf(v[j][3])))); }
#pragma unroll
    for (int o = 1; o < 64; o <<= 1) mx = fmaxf(mx, __shfl_xor(mx, o));
#if U_INT4
    const bool tiny = mx < 1e-30f;
    const float scale = tiny ? 0.f : 119.0f / mx, inv = tiny ? 0.f : mx * (1.0f / 119.0f);
#pragma unroll
    for (int j = 0; j < 4; ++j) {
        unsigned pa = 0u, pb = 0u;
#pragma unroll
        for (int e = 0; e < 4; ++e) { const int q = (int)__builtin_rintf(v[j][e] * scale); const int b = ((q + 8) & 15) - 8; const int a = (q - b) >> 4;
            pa |= (unsigned)(a & 15) << (4 * e); pb |= (unsigned)(b & 15) << (4 * e); }
        const unsigned na = (unsigned)__shfl_xor((int)pa, 1), nb = (unsigned)__shfl_xor((int)pb, 1);
        const unsigned da = (lane & 1) ? (na | (pa << 16)) : (pa | (na << 16)), db = (lane & 1) ? (nb | (pb << 16)) : (pb | (nb << 16));
        *(unsigned*)(o8row + 32 * ((lane >> 3) + 8 * j) + 4 * ((lane & 7) >> 1) + ((lane & 1) ? 16 : 0)) = (lane & 1) ? db : da;
    }
#elif U_INT8
    const bool tiny = mx < 1e-30f;
    const float scale = tiny ? 0.f : 127.0f / mx, inv = tiny ? 0.f : mx * (1.0f / 127.0f);
#pragma unroll
    for (int j = 0; j < 4; ++j) *(int*)(o8row + 4 * lane + 256 * j) = pack_i8x4(v[j][0] * scale, v[j][1] * scale, v[j][2] * scale, v[j][3] * scale);
#else
    const int ex = (int)((__builtin_bit_cast(unsigned, mx) >> 23) & 0xffu);
    const bool tiny = ex < 32;
    const float scale = tiny ? 1.0f : __builtin_bit_cast(float, (unsigned)(254 + 7 - ex) << 23);
    const float inv = tiny ? 1.0f : __builtin_bit_cast(float, (unsigned)(ex - 7) << 23);
#pragma unroll
    for (int j = 0; j < 4; ++j) { int p = __builtin_amdgcn_cvt_pk_fp8_f32(v[j][0] * scale, v[j][1] * scale, 0, false); p = __builtin_amdgcn_cvt_pk_fp8_f32(v[j][2] * scale, v[j][3] * scale, p, true);
        *(int*)(o8row + 4 * lane + 256 * j) = p; }
#endif
    if (lane == 0) *oinv = inv;
}

struct Ptrs {
    const float *x, *mix_w, *w_in, *rel_bias, *sinks, *w_pa, *ln_w, *ln_b, *w_s, *b_s, *w_pb, *w_out, *ffn_w, *w_q, *keys1, *keys2, *pu, *pv, *fin_w;
    float* out;
    unsigned char *U8, *V8, *HN8; float *USC, *VSC, *HSC; float* rowss; unsigned* rowamax;
    bf16 *WIN, *WPA, *WPB, *WOUT, *WQ, *K1, *K2, *WS, *U, *V, *XN, *AOUT, *BOUT, *HN2, *X1B, *Q, *KV, *GU, *GV, *GA, *GB, *MERGED, *QP;
};

#if U_INT4
__device__ __forceinline__ void p0_quant_row(const Ptrs& P, const f32x4 (&v)[4], int rr, int lane) {
            const int tab = rr >> 14, row = rr & 16383;
            float mx = 0.f, ssq = 0.f;
#pragma unroll
            for (int j = 0; j < 4; ++j) { mx = fmaxf(mx, fmaxf(fmaxf(fabsf(v[j][0]), fabsf(v[j][1])), fmaxf(fabsf(v[j][2]), fabsf(v[j][3]))));
                ssq += (v[j][0] * v[j][0] + v[j][1] * v[j][1]) + (v[j][2] * v[j][2] + v[j][3] * v[j][3]); }
            mx = wave_max(mx); ssq = wave_sum(ssq);
            const float sd = sqrtf(ssq * (1.0f / 1024.0f));
            if (tab == 0) {
                const float step = fmaxf(Q4_USTEP * sd, mx * (1.0f / 14.0f)); const float qs = step > 1e-30f ? 1.0f / step : 0.f;
#pragma unroll
                for (int j = 0; j < 4; ++j) { unsigned pq = 0u;
#pragma unroll
                    for (int e = 0; e < 4; ++e) pq |= (unsigned)((int)fminf(fmaxf(__builtin_rintf(v[j][e] * qs), -7.0f), 7.0f) & 15) << (4 * e);
                    const unsigned nq = (unsigned)__builtin_amdgcn_update_dpp(0, (int)pq, 0xB1, 0xF, 0xF, false);
                    if ((lane & 1) == 0) *(unsigned*)(P.U8 + (size_t)row * 512 + 128 * j + 2 * lane) = pq | (nq << 16); }
                if (lane == 0) P.USC[row] = step;
            } else {
                const float un = fmaxf(Q4_VUNIT * sd, mx * (1.0f / 12.0f)); const float qs = un > 1e-30f ? 1.0f / un : 0.f;
                bool bad = false;
#pragma unroll
                for (int j = 0; j < 4; ++j) {
                    unsigned pq = __builtin_amdgcn_cvt_scalef32_pk_fp4_f32(0u, v[j][0] * qs, v[j][1] * qs, 1.0f, 0);
                    pq = __builtin_amdgcn_cvt_scalef32_pk_fp4_f32(pq, v[j][2] * qs, v[j][3] * qs, 1.0f, 1);
                    pq &= 0xffffu;
#if FP4_SELFCHECK
#pragma unroll
                    for (int e = 0; e < 4; ++e) { const float t = fminf(fmaxf(v[j][e] * qs, -6.0f), 6.0f), a = fabsf(t);
                        const int cs = (int)(a >= 0.25f) + (int)(a >= 0.75f) + (int)(a >= 1.25f) + (int)(a >= 1.75f) + (int)(a >= 2.5f) + (int)(a >= 3.5f) + (int)(a >= 5.0f);
                        const unsigned ch = (pq >> (4 * e)) & 15u;
                        const int ms = cs, mh = (int)(ch & 7u);
                        const float ls = ms == 0 ? 0.f : ms == 1 ? 0.5f : ms == 2 ? 1.0f : ms == 3 ? 1.5f : ms == 4 ? 2.0f : ms == 5 ? 3.0f : ms == 6 ? 4.0f : 6.0f;
                        const float lh = mh == 0 ? 0.f : mh == 1 ? 0.5f : mh == 2 ? 1.0f : mh == 3 ? 1.5f : mh == 4 ? 2.0f : mh == 5 ? 3.0f : mh == 6 ? 4.0f : 6.0f;
                        const float dh = (ch & 8u) ? -lh : lh;
                        if (fabsf(dh - t) > fabsf(ls - a) + 1e-6f) bad = true; }
#endif
                    const unsigned nq = (unsigned)__builtin_amdgcn_update_dpp(0, (int)pq, 0xB1, 0xF, 0xF, false);
                    if ((lane & 1) == 0) *(unsigned*)(P.V8 + (size_t)row * 512 + 128 * j + 2 * lane) = pq | (nq << 16); }
                if (FP4_SELFCHECK && __ballot(bad) != 0ull) { if (lane == 0) P.VSC[row] = __builtin_nanf(""); }
                else if (lane == 0) P.VSC[row] = un;
            }
}
#define TAB_LOAD(V, RR) do { if ((RR) < 2 * 16384) { const float* src_ = (((RR) >> 14) ? P.pv : P.pu) + (size_t)((RR) & 16383) * 1024; \
        _Pragma("unroll") for (int j = 0; j < 4; ++j) V[j] = *(const f32x4*)(src_ + 4 * lane + 256 * j); } } while (0)
#endif
__device__ __forceinline__ void p0_prologue(LAS unsigned char* lds, const Ptrs& P, int vcu, int G, int lane, int wave) {
    LAS float* scr = (LAS float*)(lds + wave * 16384);
    const int gw = vcu * NWAVES + wave, NGW = G * NWAVES;
    constexpr int I_IN = (1024 / 64) * (3840 / 32), I_PA = (512 / 64) * (1024 / 32), I_OUT = (1024 / 64) * (1024 / 32), I_WQ = (1024 / 64) * (2048 / 32);
    constexpr int NITEMS = I_IN + 2 * I_PA + I_OUT + I_WQ;
    for (int it = gw; it < NITEMS; it += NGW) {
        int r = it;
        if (r < I_IN) { p0_transpose_item(P.w_in, 1024, 3840, P.WIN, scr, r, lane); continue; } r -= I_IN;
        if (r < I_PA) { if (P3_FUSED) p0_transpose_item(P.w_pa, 512, 1024, P.WPA, scr, r, lane, 1024, 0); else p0_transpose_item(P.w_pa, 512, 1024, P.WPA, scr, r, lane); continue; } r -= I_PA;
        if (r < I_PA) { if (P3_FUSED) p0_transpose_item(P.w_pb, 512, 1024, P.WPA, scr, r, lane, 1024, 512); else p0_transpose_item(P.w_pb, 512, 1024, P.WPB, scr, r, lane); continue; } r -= I_PA;
        if (r < I_OUT) { p0_transpose_item(P.w_out, 1024, 1024, P.WOUT, scr, r, lane); continue; } r -= I_OUT;
        p0_transpose_item(P.w_q, 1024, 2048, P.WQ, scr, r, lane, 0, 0, P5_ELIM ? P.ffn_w : nullptr);
    }
    cvt_flat(P.keys1, P.K1, 128 * 128, gw, NGW, lane);
    cvt_flat(P.keys2, P.K2, 128 * 128, gw, NGW, lane);
#if U_INT4
    {
        f32x4 va[4], vb[4], vc[4];
        int rr = gw;
        TAB_LOAD(va, rr); TAB_LOAD(vb, rr + NGW);
#pragma unroll 1
        for (; rr < 2 * 16384; rr += 3 * NGW) {
            TAB_LOAD(vc, rr + 2 * NGW); p0_quant_row(P, va, rr, lane);
            TAB_LOAD(va, rr + 3 * NGW); if (rr + NGW < 2 * 16384) p0_quant_row(P, vb, rr + NGW, lane);
            TAB_LOAD(vb, rr + 4 * NGW); if (rr + 2 * NGW < 2 * 16384) p0_quant_row(P, vc, rr + 2 * NGW, lane);
        }
    }
#elif PEER_FP8
    for (int rr = gw; rr < 2 * 16384; rr += NGW) {
        const int tab = rr >> 14, row = rr & 16383;
        const float* src = (tab ? P.pv : P.pu) + (size_t)row * 1024; unsigned char* dst = (tab ? P.V8 : P.U8) + (size_t)row * 1024;
        f32x4 v[4]; float mx = 0.f;
#pragma unroll
        for (int j = 0; j < 4; ++j) { v[j] = *(const f32x4*)(src + 4 * lane + 256 * j); mx = fmaxf(mx, fmaxf(fmaxf(fabsf(v[j][0]), fabsf(v[j][1])), fmaxf(fabsf(v[j][2]), fabsf(v[j][3])))); }
#pragma unroll
        for (int o = 1; o < 64; o <<= 1) mx = fmaxf(mx, __shfl_xor(mx, o));
        const int ex = (int)((__builtin_bit_cast(unsigned, mx) >> 23) & 0xffu);
        const bool tiny = ex < 32;
        float scale = tiny ? 1.0f : __builtin_bit_cast(float, (unsigned)(254 + 7 - ex) << 23);
        float inv = tiny ? 1.0f : __builtin_bit_cast(float, (unsigned)(ex - 7) << 23);
        if (U_INT8 && tab == 0) { scale = tiny ? 0.f : 127.0f / mx; inv = tiny ? 0.f : mx * (1.0f / 127.0f); }
#if FAKEQ_U || FAKEQ_V
        {
            const int fq = tab ? FAKEQ_V : FAKEQ_U;
            if (fq) {
#pragma unroll
                for (int j = 0; j < 4; ++j) {
                    float bm = fmaxf(fmaxf(fabsf(v[j][0]), fabsf(v[j][1])), fmaxf(fabsf(v[j][2]), fabsf(v[j][3])));
                    if (fq == 2 || fq == 3) { bm = fmaxf(bm, __shfl_xor(bm, 1)); bm = fmaxf(bm, __shfl_xor(bm, 2)); }
                    if (fq == 4 || fq == 5) { bm = fmaxf(bm, __shfl_xor(bm, 1)); bm = fmaxf(bm, __shfl_xor(bm, 2)); bm = fmaxf(bm, __shfl_xor(bm, 4)); }
                    if (fq == 1) bm = mx;
                    if (fq == 1 || fq == 2 || fq == 4) {
                        const float qs = bm > 1e-30f ? 7.0f / bm : 0.f, dq = bm * (1.0f / 7.0f);
#pragma unroll
                        for (int e = 0; e < 4; ++e) v[j][e] = __builtin_rintf(v[j][e] * qs) * dq;
                    } else {
                        float sc = bm * (1.0f / 6.0f);
                        if (fq == 5) { const int eb = (int)((__builtin_bit_cast(unsigned, bm) >> 23) & 0xffu); sc = __builtin_bit_cast(float, (unsigned)(eb - 2) << 23); }
                        const float qs = bm > 1e-30f ? 1.0f / sc : 0.f;
#pragma unroll
                        for (int e = 0; e < 4; ++e) { const float a = fabsf(v[j][e]) * qs; float q;
                            if (a < 2.0f) q = __builtin_rintf(a * 2.0f) * 0.5f; else if (a < 4.0f) q = __builtin_rintf(a); else q = fminf(__builtin_rintf(a * 0.5f) * 2.0f, 6.0f);
                            v[j][e] = copysignf(q * sc, v[j][e]); }
                    }
                }
            }
        }
#endif
#if U_INT4
        {
            float ssq = 0.f;
#pragma unroll
            for (int j = 0; j < 4; ++j) ssq += (v[j][0] * v[j][0] + v[j][1] * v[j][1]) + (v[j][2] * v[j][2] + v[j][3] * v[j][3]);
#pragma unroll
            for (int o = 1; o < 64; o <<= 1) ssq += __shfl_xor(ssq, o);
            const float sd = sqrtf(ssq * (1.0f / 1024.0f));
            if (tab == 0) {
                const float step = fmaxf(Q4_USTEP * sd, mx * (1.0f / 14.0f)); const float qs = step > 1e-30f ? 1.0f / step : 0.f;
#pragma unroll
                for (int j = 0; j < 4; ++j) { unsigned pq = 0u;
#pragma unroll
                    for (int e = 0; e < 4; ++e) pq |= (unsigned)((int)fminf(fmaxf(__builtin_rintf(v[j][e] * qs), -7.0f), 7.0f) & 15) << (4 * e);
                    const unsigned nq = (unsigned)__shfl_xor((int)pq, 1);
                    if ((lane & 1) == 0) *(unsigned*)(P.U8 + (size_t)row * 512 + 128 * j + 2 * lane) = pq | (nq << 16); }
                if (lane == 0) P.USC[row] = step;
            } else {
                const float un = fmaxf(Q4_VUNIT * sd, mx * (1.0f / 12.0f)); const float qs = un > 1e-30f ? 1.0f / un : 0.f;
                bool bad = false;
#pragma unroll
                for (int j = 0; j < 4; ++j) { unsigned pq = 0u;
#pragma unroll
                    for (int e = 0; e < 4; ++e) { const float a = fabsf(v[j][e]) * qs;
                        const int c = (int)(a >= 0.25f) + (int)(a >= 0.75f) + (int)(a >= 1.25f) + (int)(a >= 1.75f) + (int)(a >= 2.5f) + (int)(a >= 3.5f) + (int)(a >= 5.0f);
                        pq |= (unsigned)(c | (v[j][e] < 0.f ? 8 : 0)) << (4 * e); }
                    const unsigned nq = (unsigned)__shfl_xor((int)pq, 1);
                    const unsigned wq = pq | (nq << 16);
#if FP4_SELFCHECK
#pragma unroll
                    for (int b = 0; b < 4; ++b) { const h2 dv = b == 0 ? __builtin_amdgcn_cvt_scalef32_pk_f16_fp4(wq, 1.0f, 0) : b == 1 ? __builtin_amdgcn_cvt_scalef32_pk_f16_fp4(wq, 1.0f, 1) : b == 2 ? __builtin_amdgcn_cvt_scalef32_pk_f16_fp4(wq, 1.0f, 2) : __builtin_amdgcn_cvt_scalef32_pk_f16_fp4(wq, 1.0f, 3);
#pragma unroll
                        for (int n = 0; n < 2; ++n) { const unsigned c = (wq >> (8 * b + 4 * n)) & 15u; const unsigned m = c & 7u;
                            const float lv = m == 0 ? 0.f : m == 1 ? 0.5f : m == 2 ? 1.0f : m == 3 ? 1.5f : m == 4 ? 2.0f : m == 5 ? 3.0f : m == 6 ? 4.0f : 6.0f;
                            const float ex_ = (c & 8u) ? -lv : lv; if ((float)dv[n] != ex_) bad = true; } }
#endif
                    if ((lane & 1) == 0) *(unsigned*)(P.V8 + (size_t)row * 512 + 128 * j + 2 * lane) = wq; }
                if (FP4_SELFCHECK && __ballot(bad) != 0ull) { if (lane == 0) P.VSC[row] = __builtin_nanf(""); }
                else if (lane == 0) P.VSC[row] = un;
            }
            continue;
        }
#endif
#pragma unroll
        for (int j = 0; j < 4; ++j) { int p = __builtin_amdgcn_cvt_pk_fp8_f32(v[j][0] * scale, v[j][1] * scale, 0, false); p = __builtin_amdgcn_cvt_pk_fp8_f32(v[j][2] * scale, v[j][3] * scale, p, true);
            if (U_INT8 && tab == 0) p = pack_i8x4(v[j][0] * scale, v[j][1] * scale, v[j][2] * scale, v[j][3] * scale);
            const int c_ = 4 * lane + 256 * j;
            const int o_ = (U_MFMA && tab == 0) ? ((c_ >> 6) * 64 + ((c_ >> 3) & 3) * 16 + ((c_ >> 5) & 1) * 8 + (c_ & 7)) : c_;
            *(int*)(dst + o_) = p; }
        if (lane == 0) (tab ? P.VSC : P.USC)[row] = inv;
    }
#else
    cvt_flat(P.pu, P.U, (size_t)16384 * 1024, gw, NGW, lane);
    cvt_flat(P.pv, P.V, (size_t)16384 * 1024, gw, NGW, lane);
#endif
    for (size_t i = (size_t)gw * 512 + lane * 8; i < (size_t)8 * 128 * 128; i += (size_t)NGW * 512) {
        const int t = (int)((i >> 7) & 127), s0 = (int)(i & 127);
        const f32x4 a = *(const f32x4*)(P.w_s + i), b = *(const f32x4*)(P.w_s + i + 4);
        float e[8] = {a[0], a[1], a[2], a[3], b[0], b[1], b[2], b[3]};
#pragma unroll
        for (int j = 0; j < 8; ++j) e[j] = (s0 + j <= t) ? e[j] : 0.f;
        v4u o; o.x = pk2(e[0], e[1]); o.y = pk2(e[2], e[3]); o.z = pk2(e[4], e[5]); o.w = pk2(e[6], e[7]);
        *(v4u*)(P.WS + i) = o;
    }
    {
        f32x4 va[4], vb[4], vc[4], ww[4];
#pragma unroll
        for (int j = 0; j < 4; ++j) ww[j] = *((const f32x4*)P.mix_w + lane + 64 * j);
#define XN_LOAD(V, MM) do { if ((MM) < M) { _Pragma("unroll") for (int j = 0; j < 4; ++j) V[j] = *((const f32x4*)(P.x + (size_t)(MM) * D) + lane + 64 * j); } } while (0)
#define XN_PROC(V, MM) do { if ((MM) < M) { float s_ = 0.f; \
        _Pragma("unroll") for (int j = 0; j < 4; ++j) s_ += (V[j][0] * V[j][0] + V[j][1] * V[j][1]) + (V[j][2] * V[j][2] + V[j][3] * V[j][3]); \
        const float rstd_ = 1.0f / sqrtf(wave_sum(s_) * (1.0f / 1024.0f) + EPS); \
        unsigned long long* o8_ = (unsigned long long*)(P.XN + (size_t)(MM) * D) + lane; \
        _Pragma("unroll") for (int j = 0; j < 4; ++j) o8_[64 * j] = (unsigned long long)pk2(V[j][0] * rstd_ * ww[j][0], V[j][1] * rstd_ * ww[j][1]) | ((unsigned long long)pk2(V[j][2] * rstd_ * ww[j][2], V[j][3] * rstd_ * ww[j][3]) << 32); } } while (0)
        int m = gw;
        XN_LOAD(va, m); XN_LOAD(vb, m + NGW);
#pragma unroll 1
        for (; m < M; m += 3 * NGW) {
            XN_LOAD(vc, m + 2 * NGW); XN_PROC(va, m);
            XN_LOAD(va, m + 3 * NGW); XN_PROC(vb, m + NGW);
            XN_LOAD(vb, m + 4 * NGW); XN_PROC(vc, m + 2 * NGW);
        }
#undef XN_LOAD
#undef XN_PROC
    }
}

__device__ __forceinline__ void p2_attn_naive(LAS unsigned char* lds, const Ptrs& P, int vcu, int G, int tid, int lane, int wave) {
    LAS float* biasl = (LAS float*)lds;
    for (int i = tid; i < 1024; i += 512) { const int d = i >> 3, h = i & 7; biasl[i] = P.rel_bias[(int)T5B[d] * 8 + h]; }
    __syncthreads();
    const int h = wave, kvh = h >> 2;
    const float sink = P.sinks[h];
    for (int unit = vcu; unit < M / 64; unit += G) {
        const int t = unit * 64 + lane, pos = t & (SEQ - 1);
        float q[64], o[64];
        { const v4u* qp = (const v4u*)(P.Q + (size_t)t * 512 + h * 64);
#pragma unroll
          for (int c = 0; c < 8; ++c) { const v4u w = qp[c]; q[8 * c + 0] = bflo(w.x) * 0.125f; q[8 * c + 1] = bfhi(w.x) * 0.125f; q[8 * c + 2] = bflo(w.y) * 0.125f; q[8 * c + 3] = bfhi(w.y) * 0.125f;
              q[8 * c + 4] = bflo(w.z) * 0.125f; q[8 * c + 5] = bfhi(w.z) * 0.125f; q[8 * c + 6] = bflo(w.w) * 0.125f; q[8 * c + 7] = bfhi(w.w) * 0.125f; } }
#pragma unroll
        for (int i = 0; i < 64; ++i) o[i] = 0.f;
        float m = sink, l = 1.f;
        for (int d = 0; d < 128; ++d) {
            const bool valid = (pos - d) >= 0;
            const int tj = valid ? (t - d) : t;
            const v4u* kp = (const v4u*)(P.KV + (size_t)tj * 256 + kvh * 64);
            float dot = 0.f;
#pragma unroll
            for (int c = 0; c < 8; ++c) { const v4u w = kp[c];
                dot += q[8 * c + 0] * bflo(w.x) + q[8 * c + 1] * bfhi(w.x) + q[8 * c + 2] * bflo(w.y) + q[8 * c + 3] * bfhi(w.y) + q[8 * c + 4] * bflo(w.z) + q[8 * c + 5] * bfhi(w.z) + q[8 * c + 6] * bflo(w.w) + q[8 * c + 7] * bfhi(w.w); }
            const float s = valid ? dot + biasl[d * 8 + h] : -1e30f;
            const float mn = fmaxf(m, s), alpha = __expf(m - mn), p = __expf(s - mn);
            l = l * alpha + p; m = mn;
            const v4u* vp = kp + 16;
#pragma unroll
            for (int c = 0; c < 8; ++c) { const v4u w = vp[c];
                o[8 * c + 0] = o[8 * c + 0] * alpha + p * bflo(w.x); o[8 * c + 1] = o[8 * c + 1] * alpha + p * bfhi(w.x); o[8 * c + 2] = o[8 * c + 2] * alpha + p * bflo(w.y); o[8 * c + 3] = o[8 * c + 3] * alpha + p * bfhi(w.y);
                o[8 * c + 4] = o[8 * c + 4] * alpha + p * bflo(w.z); o[8 * c + 5] = o[8 * c + 5] * alpha + p * bfhi(w.z); o[8 * c + 6] = o[8 * c + 6] * alpha + p * bflo(w.w); o[8 * c + 7] = o[8 * c + 7] * alpha + p * bfhi(w.w); }
        }
        const float inv = 1.0f / l;
        v4u* op = (v4u*)(P.AOUT + (size_t)t * AB_LD + h * 64);
#pragma unroll
        for (int c = 0; c < 8; ++c) { v4u w; w.x = pk2(o[8 * c + 0] * inv, o[8 * c + 1] * inv); w.y = pk2(o[8 * c + 2] * inv, o[8 * c + 3] * inv); w.z = pk2(o[8 * c + 4] * inv, o[8 * c + 5] * inv); w.w = pk2(o[8 * c + 6] * inv, o[8 * c + 7] * inv); op[c] = w; }
    }
    __syncthreads();
}

__device__ __forceinline__ void p2_gmlp_naive(LAS unsigned char* lds, const Ptrs& P, int vcu, int G, int tid, int lane, int wave) {
    LAS bf16* vnl = (LAS bf16*)(lds + 8192);
    for (int unit = vcu; unit < 256; unit += G) {
        const int c = unit >> 1, hh = unit & 1;
        for (int i = 0; i < 16; ++i) {
            const int tt = wave * 16 + i; const size_t row = (size_t)c * 128 + tt;
            const v4u w = *((const v4u*)(P.GV + row * 512) + lane);
            float x[8] = {bflo(w.x), bfhi(w.x), bflo(w.y), bfhi(w.y), bflo(w.z), bfhi(w.z), bflo(w.w), bfhi(w.w)};
            float s = 0.f;
#pragma unroll
            for (int j = 0; j < 8; ++j) s += x[j];
            const float mean = wave_sum(s) * (1.0f / 512.0f);
            float ss = 0.f;
#pragma unroll
            for (int j = 0; j < 8; ++j) { x[j] -= mean; ss += x[j] * x[j]; }
            const float rstd = 1.0f / sqrtf(wave_sum(ss) * (1.0f / 512.0f) + EPS);
            if ((lane >> 5) == hh) {
                const f32x4 w0 = *(const f32x4*)(P.ln_w + lane * 8), w1 = *(const f32x4*)(P.ln_w + lane * 8 + 4), b0 = *(const f32x4*)(P.ln_b + lane * 8), b1 = *(const f32x4*)(P.ln_b + lane * 8 + 4);
                v4u o; o.x = pk2(x[0] * rstd * w0[0] + b0[0], x[1] * rstd * w0[1] + b0[1]); o.y = pk2(x[2] * rstd * w0[2] + b0[2], x[3] * rstd * w0[3] + b0[3]);
                o.z = pk2(x[4] * rstd * w1[0] + b1[0], x[5] * rstd * w1[1] + b1[1]); o.w = pk2(x[6] * rstd * w1[2] + b1[2], x[7] * rstd * w1[3] + b1[3]);
                *(LAS v4u*)(vnl + tt * 256 + (lane & 31) * 8) = o;
            }
        }
        __syncthreads();
        const int ch = tid & 255, th = tid >> 8, g = hh * 4 + (ch >> 6);
        for (int t = th * 64; t < th * 64 + 64; ++t) {
            const v4u* wrow = (const v4u*)(P.WS + ((size_t)g * 128 + t) * 128);
            float acc = 0.f;
            for (int s8 = 0; s8 <= (t >> 3); ++s8) {
                const v4u w = wrow[s8];
                const LAS bf16* vp = vnl + (s8 * 8) * 256 + ch;
                acc += bflo(w.x) * bf2f(vp[0]) + bfhi(w.x) * bf2f(vp[256]) + bflo(w.y) * bf2f(vp[512]) + bfhi(w.y) * bf2f(vp[768])
                     + bflo(w.z) * bf2f(vp[1024]) + bfhi(w.z) * bf2f(vp[1280]) + bflo(w.w) * bf2f(vp[1536]) + bfhi(w.w) * bf2f(vp[1792]);
            }
            const size_t row = (size_t)c * 128 + t;
            const float uval = bf2f(P.GU[row * 512 + hh * 256 + ch]);
            P.BOUT[row * AB_LD + hh * 256 + ch] = (bf16)f2bf(uval * (acc + P.b_s[g * 128 + t]));
        }
        __syncthreads();
    }
}

typedef short s16x8 __attribute__((ext_vector_type(8)));
typedef short s16x4 __attribute__((ext_vector_type(4)));
typedef float f32x16 __attribute__((ext_vector_type(16)));
typedef float f32x2v __attribute__((ext_vector_type(2)));
#define MFMA32(a, b, c) __builtin_amdgcn_mfma_f32_32x32x16_bf16((a), (b), (c), 0, 0, 0)
__device__ __forceinline__ s16x4 tr16(const LAS unsigned char* p) { return __builtin_bit_cast(s16x4, __builtin_amdgcn_ds_read_tr16_b64_v4i16((LAS s16x4*)p)); }
__device__ __forceinline__ unsigned cvtpk(float lo, float hi) { f32x2v v = {lo, hi}; bf16x2_t b = __builtin_convertvector(v, bf16x2_t); return __builtin_bit_cast(unsigned, b); }
__device__ __forceinline__ int crow(int reg, int h) { return (reg & 3) + 8 * (reg >> 2) + 4 * h; }
constexpr float LOG2E = 1.4426950408889634f;

__device__ __forceinline__ void p2_attn_mfma(LAS unsigned char* lds, const Ptrs& P, int vcu, int G, int tid, int lane, int wave) {
    LAS unsigned char* Kl = lds;
    LAS unsigned char* Vl = lds + 32768;
    LAS float* biasl = (LAS float*)(lds + 32768 + 49152);
    const int r = lane & 31, h = lane >> 5, i16 = lane & 15, q4 = i16 >> 2, p4 = i16 & 3, blk = (lane >> 4) & 1;
    for (int unit = vcu; unit < 256; unit += G) {
        const int kvh = unit & 1, blkid = unit >> 1, nb = blkid & 63; const int tok0 = blkid * 128;
#pragma unroll
        for (int i = 0; i < 4; ++i) {
            const int cidx = tid + 512 * i, row = cidx >> 3, c = cidx & 7;
            v4u kw = {0u, 0u, 0u, 0u}, vw = {0u, 0u, 0u, 0u};
            if (nb > 0 || row >= 128) { const bf16* src = P.KV + (size_t)(tok0 - 128 + row) * 256 + kvh * 64 + c * 8; kw = *(const v4u*)src; vw = *(const v4u*)(src + 128); }
            *(LAS v4u*)(Kl + row * 128 + ((c ^ ((row >> 1) & 7)) << 4)) = kw;
            *(LAS v4u*)(Vl + row * 192 + c * 16) = vw;
        }
        biasl[tid] = P.rel_bias[(int)T5B[tid & 127] * 8 + kvh * 4 + (tid >> 7)] * LOG2E;
        __syncthreads();
        const int g = wave >> 1, qh = wave & 1, hq = kvh * 4 + g;
        const float sink2 = P.sinks[hq] * LOG2E;
#pragma unroll 1
        for (int qs = 0; qs < 2; ++qs) {
            const int qi0 = 64 * qh + 32 * qs, kt0 = 2 * qh + qs;
            s16x8 qf[4];
            { const bf16* qrow = P.Q + (size_t)(tok0 + qi0 + r) * 512 + hq * 64 + 8 * h;
#pragma unroll
              for (int ks = 0; ks < 4; ++ks) qf[ks] = *(const s16x8*)(qrow + 16 * ks); }
            f32x16 s[5];
#pragma unroll
            for (int i = 0; i < 5; ++i) {
#pragma unroll
                for (int e = 0; e < 16; ++e) s[i][e] = 0.f;
                const int key = 32 * (kt0 + i) + r; const LAS unsigned char* kp = Kl + key * 128; const int sw = (key >> 1) & 7;
#pragma unroll
                for (int ks = 0; ks < 4; ++ks) { const s16x8 kf = *(const LAS s16x8*)(kp + (((2 * ks + h) ^ sw) << 4)); s[i] = MFMA32(kf, qf[ks], s[i]); }
            }
            const int qi = qi0 + r;
            float mx = sink2;
#pragma unroll
            for (int i = 0; i < 5; ++i)
#pragma unroll
                for (int e = 0; e < 16; ++e) {
                    const int kj = 32 * (kt0 + i) + crow(e, h), dist = 128 + qi - kj;
                    const bool valid = (dist >= 0) && (dist < 128) && (nb > 0 || kj >= 128);
                    const float b = biasl[g * 128 + (dist & 127)];
                    const float v = valid ? s[i][e] * (0.125f * LOG2E) + b : -1e30f;
                    s[i][e] = v; mx = fmaxf(mx, v);
                }
            mx = fmaxf(mx, xor32_f(mx));
            float l = 0.f;
#pragma unroll
            for (int i = 0; i < 5; ++i)
#pragma unroll
                for (int e = 0; e < 16; ++e) { const float p = __builtin_amdgcn_exp2f(s[i][e] - mx); s[i][e] = p; l += p; }
            l += xor32_f(l);
            l += __builtin_amdgcn_exp2f(sink2 - mx);
            f32x16 o0, o1;
#pragma unroll
            for (int e = 0; e < 16; ++e) { o0[e] = 0.f; o1[e] = 0.f; }
#pragma unroll
            for (int i = 0; i < 5; ++i)
#pragma unroll
                for (int st = 0; st < 2; ++st) {
                    v4u pw; pw.x = cvtpk(s[i][8 * st], s[i][8 * st + 1]); pw.y = cvtpk(s[i][8 * st + 2], s[i][8 * st + 3]); pw.z = cvtpk(s[i][8 * st + 4], s[i][8 * st + 5]); pw.w = cvtpk(s[i][8 * st + 6], s[i][8 * st + 7]);
                    const s16x8 pf = __builtin_bit_cast(s16x8, pw);
                    const LAS unsigned char* vb = Vl + (32 * (kt0 + i) + 16 * st + 4 * h + q4) * 192 + 32 * blk + 8 * p4;
                    { const s16x4 lo = tr16(vb), hi = tr16(vb + 8 * 192); const s16x8 vf = __builtin_shufflevector(lo, hi, 0, 1, 2, 3, 4, 5, 6, 7); o0 = MFMA32(vf, pf, o0); }
                    { const s16x4 lo = tr16(vb + 64), hi = tr16(vb + 64 + 8 * 192); const s16x8 vf = __builtin_shufflevector(lo, hi, 0, 1, 2, 3, 4, 5, 6, 7); o1 = MFMA32(vf, pf, o1); }
                }
            const float inv = 1.0f / l;
            bf16* orow = P.AOUT + (size_t)(tok0 + qi) * AB_LD + hq * 64 + 4 * h;
#pragma unroll
            for (int r4 = 0; r4 < 4; ++r4) {
                v2u w0; w0.x = cvtpk(o0[4 * r4] * inv, o0[4 * r4 + 1] * inv); w0.y = cvtpk(o0[4 * r4 + 2] * inv, o0[4 * r4 + 3] * inv); *(v2u*)(orow + 8 * r4) = w0;
                v2u w1; w1.x = cvtpk(o1[4 * r4] * inv, o1[4 * r4 + 1] * inv); w1.y = cvtpk(o1[4 * r4 + 2] * inv, o1[4 * r4 + 3] * inv); *(v2u*)(orow + 32 + 8 * r4) = w1;
            }
        }
        __syncthreads();
    }
}

__device__ __forceinline__ void p2_gmlp_mfma(LAS unsigned char* lds, const Ptrs& P, int vcu, int G, int tid, int lane, int wave) {
    LAS unsigned char* vnl = lds;
    const int r = lane & 31, h = lane >> 5, i16 = lane & 15, q4 = i16 >> 2, p4 = i16 & 3, blk = (lane >> 4) & 1;
    for (int unit = vcu; unit < 256; unit += G) {
        const int c = unit >> 1, hh = unit & 1;
        v4u gvw[16];
#pragma unroll
        for (int i = 0; i < 16; ++i) gvw[i] = *((const v4u*)(P.GV + ((size_t)c * 128 + wave * 16 + i) * 512) + lane);
        const f32x4 lw0 = *(const f32x4*)(P.ln_w + lane * 8), lw1 = *(const f32x4*)(P.ln_w + lane * 8 + 4), lb0 = *(const f32x4*)(P.ln_b + lane * 8), lb1 = *(const f32x4*)(P.ln_b + lane * 8 + 4);
#pragma unroll
        for (int i = 0; i < 16; ++i) {
            const int tt = wave * 16 + i;
            const v4u w = gvw[i];
            float x[8] = {bflo(w.x), bfhi(w.x), bflo(w.y), bfhi(w.y), bflo(w.z), bfhi(w.z), bflo(w.w), bfhi(w.w)};
            float s = 0.f;
#pragma unroll
            for (int j = 0; j < 8; ++j) s += x[j];
            const float mean = wave_sum(s) * (1.0f / 512.0f);
            float ss = 0.f;
#pragma unroll
            for (int j = 0; j < 8; ++j) { x[j] -= mean; ss += x[j] * x[j]; }
            const float rstd = 1.0f / sqrtf(wave_sum(ss) * (1.0f / 512.0f) + EPS);
            if ((lane >> 5) == hh) {
                const f32x4 w0 = lw0, w1 = lw1, b0 = lb0, b1 = lb1;
                v4u o; o.x = pk2(x[0] * rstd * w0[0] + b0[0], x[1] * rstd * w0[1] + b0[1]); o.y = pk2(x[2] * rstd * w0[2] + b0[2], x[3] * rstd * w0[3] + b0[3]);
                o.z = pk2(x[4] * rstd * w1[0] + b1[0], x[5] * rstd * w1[1] + b1[1]); o.w = pk2(x[6] * rstd * w1[2] + b1[2], x[7] * rstd * w1[3] + b1[3]);
                *(LAS v4u*)(vnl + tt * 576 + (lane & 31) * 16) = o;
            }
        }
        __syncthreads();
        const int gi = wave >> 1, dblk = wave & 1, g = hh * 4 + gi;
        s16x8 af[8];
#pragma unroll
        for (int ks = 0; ks < 8; ++ks) { const LAS unsigned char* vb = vnl + (16 * ks + 8 * h + q4) * 576 + (gi * 64 + dblk * 32 + 16 * blk) * 2 + 8 * p4;
            const s16x4 lo = tr16(vb), hi = tr16(vb + 4 * 576); af[ks] = __builtin_shufflevector(lo, hi, 0, 1, 2, 3, 4, 5, 6, 7); }
#pragma unroll
        for (int tt = 0; tt < 4; ++tt) {
            f32x16 acc;
#pragma unroll
            for (int e = 0; e < 16; ++e) acc[e] = 0.f;
            const bf16* wrow = P.WS + ((size_t)g * 128 + 32 * tt + r) * 128 + 8 * h;
#pragma unroll
            for (int ks = 0; ks < 2 * (tt + 1); ++ks) acc = MFMA32(af[ks], *(const s16x8*)(wrow + 16 * ks), acc);
            const int t = 32 * tt + r; const size_t row = (size_t)c * 128 + t; const float b = P.b_s[g * 128 + t];
#pragma unroll
            for (int r4 = 0; r4 < 4; ++r4) {
                const int ch = g * 64 + dblk * 32 + 8 * r4 + 4 * h;
                const v2u uw = *(const v2u*)(P.GU + row * 512 + ch);
                v2u ow; ow.x = cvtpk(bflo(uw.x) * (acc[4 * r4] + b), bfhi(uw.x) * (acc[4 * r4 + 1] + b)); ow.y = cvtpk(bflo(uw.y) * (acc[4 * r4 + 2] + b), bfhi(uw.y) * (acc[4 * r4 + 3] + b));
                *(v2u*)(P.BOUT + row * AB_LD + ch) = ow;
            }
        }
        __syncthreads();
    }
}

__device__ __forceinline__ void topk_half(const bf16* q, const LAS bf16* kl, float (&v)[16]) {
    v4u qv[16];
#pragma unroll
    for (int c = 0; c < 16; ++c) qv[c] = ((const v4u*)q)[c];
#pragma unroll
    for (int i = 0; i < 16; ++i) v[i] = -INFINITY;
    for (int n = 0; n < 128; ++n) {
        const LAS v4u* kr = (const LAS v4u*)(kl + n * 128);
        float a0 = 0.f, a1 = 0.f, a2 = 0.f, a3 = 0.f;
#pragma unroll
        for (int c = 0; c < 16; ++c) { const v4u kk = kr[c]; a0 = dot2bf(qv[c].x, kk.x, a0); a1 = dot2bf(qv[c].y, kk.y, a1); a2 = dot2bf(qv[c].z, kk.z, a2); a3 = dot2bf(qv[c].w, kk.w, a3); }
        const float acc = (a0 + a1) + (a2 + a3);
        float x = __builtin_bit_cast(float, (__builtin_bit_cast(unsigned, acc) & ~0x7Fu) | (unsigned)n);
#pragma unroll
        for (int i = 0; i < 16; ++i) { const float hi = fmaxf(v[i], x); x = fminf(v[i], x); v[i] = hi; }
    }
}

__host__ __device__ constexpr int cand_slot(int i, int j) { int c = 0; for (int a = 0; a < 16; ++a) for (int b = 0; b < 16; ++b) { if (a == i && b == j) return c; if ((a + 1) * (b + 1) <= 16) ++c; } return c; }
#define CE_DESC(a, b) do { const float hi_ = fmaxf((a), (b)); const float lo_ = fminf((a), (b)); (a) = hi_; (b) = lo_; } while (0)
__device__ __forceinline__ void sort16_desc(float (&v)[16]) {
    CE_DESC(v[0], v[1]); CE_DESC(v[3], v[2]); CE_DESC(v[4], v[5]); CE_DESC(v[7], v[6]); CE_DESC(v[8], v[9]); CE_DESC(v[11], v[10]); CE_DESC(v[12], v[13]); CE_DESC(v[15], v[14]); CE_DESC(v[0], v[2]); CE_DESC(v[1], v[3]); CE_DESC(v[6], v[4]); CE_DESC(v[7], v[5]); CE_DESC(v[8], v[10]); CE_DESC(v[9], v[11]); CE_DESC(v[14], v[12]); CE_DESC(v[15], v[13]); CE_DESC(v[0], v[1]); CE_DESC(v[2], v[3]); CE_DESC(v[5], v[4]); CE_DESC(v[7], v[6]); CE_DESC(v[8], v[9]); CE_DESC(v[10], v[11]); CE_DESC(v[13], v[12]); CE_DESC(v[15], v[14]); CE_DESC(v[0], v[4]); CE_DESC(v[1], v[5]); CE_DESC(v[2], v[6]); CE_DESC(v[3], v[7]); CE_DESC(v[12], v[8]); CE_DESC(v[13], v[9]); CE_DESC(v[14], v[10]); CE_DESC(v[15], v[11]); CE_DESC(v[0], v[2]); CE_DESC(v[1], v[3]); CE_DESC(v[4], v[6]); CE_DESC(v[5], v[7]); CE_DESC(v[10], v[8]); CE_DESC(v[11], v[9]); CE_DESC(v[14], v[12]); CE_DESC(v[15], v[13]); CE_DESC(v[0], v[1]); CE_DESC(v[2], v[3]); CE_DESC(v[4], v[5]); CE_DESC(v[6], v[7]); CE_DESC(v[9], v[8]); CE_DESC(v[11], v[10]); CE_DESC(v[13], v[12]); CE_DESC(v[15], v[14]); CE_DESC(v[0], v[8]); CE_DESC(v[1], v[9]); CE_DESC(v[2], v[10]); CE_DESC(v[3], v[11]); CE_DESC(v[4], v[12]); CE_DESC(v[5], v[13]); CE_DESC(v[6], v[14]); CE_DESC(v[7], v[15]); CE_DESC(v[0], v[4]); CE_DESC(v[1], v[5]); CE_DESC(v[2], v[6]); CE_DESC(v[3], v[7]); CE_DESC(v[8], v[12]); CE_DESC(v[9], v[13]); CE_DESC(v[10], v[14]); CE_DESC(v[11], v[15]); CE_DESC(v[0], v[2]); CE_DESC(v[1], v[3]); CE_DESC(v[4], v[6]); CE_DESC(v[5], v[7]); CE_DESC(v[8], v[10]); CE_DESC(v[9], v[11]); CE_DESC(v[12], v[14]); CE_DESC(v[13], v[15]); CE_DESC(v[0], v[1]); CE_DESC(v[2], v[3]); CE_DESC(v[4], v[5]); CE_DESC(v[6], v[7]); CE_DESC(v[8], v[9]); CE_DESC(v[10], v[11]); CE_DESC(v[12], v[13]); CE_DESC(v[14], v[15]);
}
__device__ __forceinline__ void merge_top16(float (&a)[16], const float (&b)[16]) {
    a[0] = fmaxf(a[0], b[15]); a[1] = fmaxf(a[1], b[14]); a[2] = fmaxf(a[2], b[13]); a[3] = fmaxf(a[3], b[12]); a[4] = fmaxf(a[4], b[11]); a[5] = fmaxf(a[5], b[10]); a[6] = fmaxf(a[6], b[9]); a[7] = fmaxf(a[7], b[8]); a[8] = fmaxf(a[8], b[7]); a[9] = fmaxf(a[9], b[6]); a[10] = fmaxf(a[10], b[5]); a[11] = fmaxf(a[11], b[4]); a[12] = fmaxf(a[12], b[3]); a[13] = fmaxf(a[13], b[2]); a[14] = fmaxf(a[14], b[1]); a[15] = fmaxf(a[15], b[0]); CE_DESC(a[0], a[8]); CE_DESC(a[1], a[9]); CE_DESC(a[2], a[10]); CE_DESC(a[3], a[11]); CE_DESC(a[4], a[12]); CE_DESC(a[5], a[13]); CE_DESC(a[6], a[14]); CE_DESC(a[7], a[15]); CE_DESC(a[0], a[4]); CE_DESC(a[1], a[5]); CE_DESC(a[2], a[6]); CE_DESC(a[3], a[7]); CE_DESC(a[8], a[12]); CE_DESC(a[9], a[13]); CE_DESC(a[10], a[14]); CE_DESC(a[11], a[15]); CE_DESC(a[0], a[2]); CE_DESC(a[1], a[3]); CE_DESC(a[4], a[6]); CE_DESC(a[5], a[7]); CE_DESC(a[8], a[10]); CE_DESC(a[9], a[11]); CE_DESC(a[12], a[14]); CE_DESC(a[13], a[15]); CE_DESC(a[0], a[1]); CE_DESC(a[2], a[3]); CE_DESC(a[4], a[5]); CE_DESC(a[6], a[7]); CE_DESC(a[8], a[9]); CE_DESC(a[10], a[11]); CE_DESC(a[12], a[13]); CE_DESC(a[14], a[15]);
}
__device__ __forceinline__ void scores_top16(const bf16* qbase, const LAS unsigned char* kl, int r, int h, float (&t)[16]) {
#if TOPK_DBG_INSERT == 3
#pragma unroll
    for (int k = 0; k < 16; ++k) t[k] = -1e30f;
#pragma unroll 1
    for (int key = 0; key < 128; ++key) { float a = 0.f;
        if (((key >> 2) & 1) != h) continue;
        for (int c = 0; c < 16; ++c) { const v4u q1 = *(const v4u*)(qbase + (size_t)r * 256 + 8 * c); const v4u kk1 = *(const LAS v4u*)(kl + key * 256 + 16 * c);
            a = dot2bf(q1.x, kk1.x, a); a = dot2bf(q1.y, kk1.y, a); a = dot2bf(q1.z, kk1.z, a); a = dot2bf(q1.w, kk1.w, a); }
        float x = __builtin_bit_cast(float, (__builtin_bit_cast(unsigned, a) & ~0x7Fu) | (unsigned)key);
#pragma unroll
        for (int i = 0; i < 16; ++i) { const float hi = fmaxf(t[i], x); x = fminf(t[i], x); t[i] = hi; } }
    return;
#endif
    f32x16 acc[4];
#pragma unroll
    for (int kt = 0; kt < 4; ++kt)
#pragma unroll
        for (int e = 0; e < 16; ++e) acc[kt][e] = 0.f;
    const LAS unsigned char* kp0 = kl + r * 256; const int sw = KEY_SWZ ? (r & 15) : 0;
#pragma unroll
    for (int ks = 0; ks < 8; ++ks) {
        const s16x8 qf = *(const s16x8*)(qbase + (size_t)r * 256 + 16 * ks + 8 * h);
#pragma unroll
        for (int kt = 0; kt < 4; ++kt) { const s16x8 kf = *(const LAS s16x8*)(kp0 + kt * 8192 + (((2 * ks + h) ^ sw) << 4)); acc[kt] = MFMA32(kf, qf, acc[kt]); }
    }
    float g[4][16];
#pragma unroll
    for (int kt = 0; kt < 4; ++kt) {
#pragma unroll
        for (int e = 0; e < 16; ++e) { const float av_ = acc[kt][e];
            g[kt][e] = __builtin_bit_cast(float, (__builtin_bit_cast(unsigned, av_) & ~0x7Fu) | (unsigned)(32 * kt + (e & 3) + 8 * (e >> 2))); }
#if !TOPK_DBG_INSERT
        sort16_desc(g[kt]);
#endif
    }
#if TOPK_DBG_INSERT == 2
#pragma unroll
    for (int k = 0; k < 16; ++k) t[k] = -1e30f;
#pragma unroll
    for (int kt = 0; kt < 4; ++kt)
#pragma unroll
        for (int e = 0; e < 16; ++e) t[0] = fmaxf(t[0], g[kt][e]);
#elif TOPK_DBG_INSERT
#pragma unroll
    for (int k = 0; k < 16; ++k) t[k] = -1e30f;
#pragma unroll
    for (int kt = 0; kt < 4; ++kt)
#pragma unroll
        for (int e = 0; e < 16; ++e) { float x = g[kt][e];
#pragma unroll
            for (int i = 0; i < 16; ++i) { const float hi = fmaxf(t[i], x); x = fminf(t[i], x); t[i] = hi; } }
#else
    merge_top16(g[0], g[1]); merge_top16(g[2], g[3]); merge_top16(g[0], g[2]);
#pragma unroll
    for (int k = 0; k < 16; ++k) t[k] = __builtin_bit_cast(float, __builtin_bit_cast(unsigned, g[0][k]) | ((unsigned)h << 2));
#endif
}
__device__ __forceinline__ void peer_topk_unit_mfma(const Ptrs& P, const LAS unsigned char* k1l, const LAS unsigned char* k2l, LAS int* idxl, LAS float* gatel, int unit, int lane, int wave, int rb_lo = 0, int rb_hi = 2) {
    asm volatile("" : "+v"(lane));
    const int r = lane & 31, h = lane >> 5;
#pragma unroll 1
    for (int rbi = rb_lo; rbi < rb_hi; ++rbi) {
        const int rb = wave * 2 + rbi, R = rb * 32 + r;
        const bf16* qbase = P.QP + ((size_t)unit * 512 + rb * 32) * 256;
        float t1[16], t2[16];
#if TOPK_DBG_BRUTE
#pragma unroll
        for (int k = 0; k < 16; ++k) { t1[k] = -1e30f; t2[k] = -1e30f; }
#pragma unroll 1
        for (int key = 0; key < 128; ++key) { float a = 0.f, b = 0.f;
            if (((key >> 2) & 1) != h) continue;
            for (int c = 0; c < 16; ++c) { const v4u q1 = *(const v4u*)(qbase + (size_t)r * 256 + 8 * c), q2 = *(const v4u*)(qbase + 128 + (size_t)r * 256 + 8 * c);
                const v4u kk1 = *(const LAS v4u*)(k1l + key * 256 + 16 * c), kk2 = *(const LAS v4u*)(k2l + key * 256 + 16 * c);
                a = dot2bf(q1.x, kk1.x, a); a = dot2bf(q1.y, kk1.y, a); a = dot2bf(q1.z, kk1.z, a); a = dot2bf(q1.w, kk1.w, a);
                b = dot2bf(q2.x, kk2.x, b); b = dot2bf(q2.y, kk2.y, b); b = dot2bf(q2.z, kk2.z, b); b = dot2bf(q2.w, kk2.w, b); }
            float x = __builtin_bit_cast(float, (__builtin_bit_cast(unsigned, a) & ~0x7Fu) | (unsigned)key), y = __builtin_bit_cast(float, (__builtin_bit_cast(unsigned, b) & ~0x7Fu) | (unsigned)key);
#pragma unroll
            for (int i = 0; i < 16; ++i) { const float hi = fmaxf(t1[i], x); x = fminf(t1[i], x); t1[i] = hi; const float hj = fmaxf(t2[i], y); y = fminf(t2[i], y); t2[i] = hj; } }
#else
        scores_top16(qbase, k1l, r, h, t1);
        __builtin_amdgcn_sched_barrier(0);
        scores_top16(qbase + 128, k2l, r, h, t2);
        __builtin_amdgcn_sched_barrier(0);
#endif
        float F[16], recv[16];
#pragma unroll
        for (int k = 0; k < 16; ++k) { auto rr = __builtin_amdgcn_permlane32_swap(__builtin_bit_cast(unsigned, t1[k]), __builtin_bit_cast(unsigned, t2[k]), false, false);
            const unsigned r0 = rr[0], r1 = rr[1]; F[k] = __builtin_bit_cast(float, r0); recv[k] = __builtin_bit_cast(float, r1); }
        merge_top16(F, recv);
        LAS unsigned char* slot = (LAS unsigned char*)(idxl + R * 16);
        { v4u b;
          b.x = (__builtin_bit_cast(unsigned, F[0]) & 0x7Fu) | ((__builtin_bit_cast(unsigned, F[1]) & 0x7Fu) << 8) | ((__builtin_bit_cast(unsigned, F[2]) & 0x7Fu) << 16) | ((__builtin_bit_cast(unsigned, F[3]) & 0x7Fu) << 24);
          b.y = (__builtin_bit_cast(unsigned, F[4]) & 0x7Fu) | ((__builtin_bit_cast(unsigned, F[5]) & 0x7Fu) << 8) | ((__builtin_bit_cast(unsigned, F[6]) & 0x7Fu) << 16) | ((__builtin_bit_cast(unsigned, F[7]) & 0x7Fu) << 24);
          b.z = (__builtin_bit_cast(unsigned, F[8]) & 0x7Fu) | ((__builtin_bit_cast(unsigned, F[9]) & 0x7Fu) << 8) | ((__builtin_bit_cast(unsigned, F[10]) & 0x7Fu) << 16) | ((__builtin_bit_cast(unsigned, F[11]) & 0x7Fu) << 24);
          b.w = (__builtin_bit_cast(unsigned, F[12]) & 0x7Fu) | ((__builtin_bit_cast(unsigned, F[13]) & 0x7Fu) << 8) | ((__builtin_bit_cast(unsigned, F[14]) & 0x7Fu) << 16) | ((__builtin_bit_cast(unsigned, F[15]) & 0x7Fu) << 24);
#if !TOPK_DBG_GATES_ONLY
          *(LAS v4u*)(slot + 16 * h) = b;
#endif
          (void)b; }
#if TOPK_DBG_COMPARE == 7 || TOPK_DBG_COMPARE == 8
        { float best1 = -1e30f, best2 = -1e30f;
#pragma unroll 1
          for (int key = 0; key < 128; ++key) { float a = 0.f, b = 0.f;
              if (TOPK_DBG_COMPARE == 8 && ((key >> 2) & 1) != h) continue;
              for (int c = 0; c < 16; ++c) { const v4u q1 = *(const v4u*)(qbase + (size_t)r * 256 + 8 * c), q2 = *(const v4u*)(qbase + 128 + (size_t)r * 256 + 8 * c);
                  const v4u kk1 = *(const LAS v4u*)(k1l + key * 256 + 16 * c), kk2 = *(const LAS v4u*)(k2l + key * 256 + 16 * c);
                  a = dot2bf(q1.x, kk1.x, a); a = dot2bf(q1.y, kk1.y, a); a = dot2bf(q1.z, kk1.z, a); a = dot2bf(q1.w, kk1.w, a);
                  b = dot2bf(q2.x, kk2.x, b); b = dot2bf(q2.y, kk2.y, b); b = dot2bf(q2.z, kk2.z, b); b = dot2bf(q2.w, kk2.w, b); }
              best1 = fmaxf(best1, __builtin_bit_cast(float, (__builtin_bit_cast(unsigned, a) & ~0x7Fu) | (unsigned)key));
              best2 = fmaxf(best2, __builtin_bit_cast(float, (__builtin_bit_cast(unsigned, b) & ~0x7Fu) | (unsigned)key)); }
          *(LAS unsigned*)((LAS unsigned char*)idxl + 65536 + R * 8 + 4 * h) = (__builtin_bit_cast(unsigned, best1) & 0x7Fu) | ((__builtin_bit_cast(unsigned, best2) & 0x7Fu) << 16); }
#endif
#if TOPK_DBG_COMPARE == 9
        { float m1 = t1[0], m2 = t2[0];
#pragma unroll
          for (int k = 1; k < 16; ++k) { m1 = fmaxf(m1, t1[k]); m2 = fmaxf(m2, t2[k]); }
          *(LAS unsigned*)((LAS unsigned char*)idxl + 65536 + R * 8 + 4 * h) = (__builtin_bit_cast(unsigned, m1) & 0x7Fu) | ((__builtin_bit_cast(unsigned, m2) & 0x7Fu) << 16); }
#endif
#if TOPK_DBG_COMPARE == 6
        *(LAS unsigned*)((LAS unsigned char*)idxl + 65536 + R * 8 + 4 * h) = (__builtin_bit_cast(unsigned, t1[0]) & 0x7Fu) | ((__builtin_bit_cast(unsigned, t1[1]) & 0x7Fu) << 8) | ((__builtin_bit_cast(unsigned, t2[0]) & 0x7Fu) << 16) | ((__builtin_bit_cast(unsigned, t2[1]) & 0x7Fu) << 24);
#endif
#if TOPK_DBG_COMPARE == 4
        *(LAS unsigned*)((LAS unsigned char*)idxl + 65536 + R * 8 + 4 * h) = (__builtin_bit_cast(unsigned, F[TOPK_DBG_K0]) & 0x7Fu) | ((__builtin_bit_cast(unsigned, F[TOPK_DBG_K0 + 1]) & 0x7Fu) << 8) | ((__builtin_bit_cast(unsigned, F[TOPK_DBG_K0 + 2]) & 0x7Fu) << 16) | ((__builtin_bit_cast(unsigned, F[TOPK_DBG_K0 + 3]) & 0x7Fu) << 24);
#endif
        float v1[16], v2[16];
#pragma unroll
        for (int k = 0; k < 16; ++k) { auto rr = __builtin_amdgcn_permlane32_swap(__builtin_bit_cast(unsigned, F[k]), __builtin_bit_cast(unsigned, F[k]), false, false);
            const unsigned r0 = rr[0], r1 = rr[1]; v1[k] = __builtin_bit_cast(float, r0 & ~0x7Fu); v2[k] = __builtin_bit_cast(float, r1 & ~0x7Fu); }
        float cg[4][16];
#pragma unroll
        for (int a = 0; a < 4; ++a)
#pragma unroll
            for (int k = 0; k < 16; ++k) cg[a][k] = -1e30f;
#define CAND(i, j) __builtin_bit_cast(float, (__builtin_bit_cast(unsigned, v1[i] + v2[j]) & ~0xFFu) | (unsigned)((i) * 16 + (j)))
        cg[0][0] = CAND(0, 0);
        cg[0][1] = CAND(0, 1);
        cg[0][2] = CAND(0, 2);
        cg[0][3] = CAND(0, 3);
        cg[0][4] = CAND(0, 4);
        cg[0][5] = CAND(0, 5);
        cg[0][6] = CAND(0, 6);
        cg[0][7] = CAND(0, 7);
        cg[0][8] = CAND(0, 8);
        cg[0][9] = CAND(0, 9);
        cg[0][10] = CAND(0, 10);
        cg[0][11] = CAND(0, 11);
        cg[0][12] = CAND(0, 12);
        cg[0][13] = CAND(0, 13);
        cg[0][14] = CAND(0, 14);
        cg[0][15] = CAND(0, 15);
        cg[1][0] = CAND(1, 0);
        cg[1][1] = CAND(1, 1);
        cg[1][2] = CAND(1, 2);
        cg[1][3] = CAND(1, 3);
        cg[1][4] = CAND(1, 4);
        cg[1][5] = CAND(1, 5);
        cg[1][6] = CAND(1, 6);
        cg[1][7] = CAND(1, 7);
        cg[1][8] = CAND(2, 0);
        cg[1][9] = CAND(2, 1);
        cg[1][10] = CAND(2, 2);
        cg[1][11] = CAND(2, 3);
        cg[1][12] = CAND(2, 4);
        cg[1][13] = CAND(3, 0);
        cg[1][14] = CAND(3, 1);
        cg[1][15] = CAND(3, 2);
        cg[2][0] = CAND(3, 3);
        cg[2][1] = CAND(4, 0);
        cg[2][2] = CAND(4, 1);
        cg[2][3] = CAND(4, 2);
        cg[2][4] = CAND(5, 0);
        cg[2][5] = CAND(5, 1);
        cg[2][6] = CAND(6, 0);
        cg[2][7] = CAND(6, 1);
        cg[2][8] = CAND(7, 0);
        cg[2][9] = CAND(7, 1);
        cg[2][10] = CAND(8, 0);
        cg[2][11] = CAND(9, 0);
        cg[2][12] = CAND(10, 0);
        cg[2][13] = CAND(11, 0);
        cg[2][14] = CAND(12, 0);
        cg[2][15] = CAND(13, 0);
        cg[3][0] = CAND(14, 0);
        cg[3][1] = CAND(15, 0);
#undef CAND
        sort16_desc(cg[0]); sort16_desc(cg[1]); sort16_desc(cg[2]); sort16_desc(cg[3]);
        merge_top16(cg[0], cg[1]); merge_top16(cg[2], cg[3]); merge_top16(cg[0], cg[2]);
        float es = 0.f, e[16];
        const float top = __builtin_bit_cast(float, __builtin_bit_cast(unsigned, cg[0][0]) & ~0xFFu);
#pragma unroll
        for (int k = 0; k < 16; ++k) { e[k] = __expf(__builtin_bit_cast(float, __builtin_bit_cast(unsigned, cg[0][k]) & ~0xFFu) - top); es += e[k]; }
        const float inv = 1.0f / es;
        LDS_WAIT();
        unsigned id[8]; float gt[8];
#pragma unroll
        for (int k = 0; k < 8; ++k) { const float clo_ = cg[0][k], chi_ = cg[0][8 + k], elo_ = e[k], ehi_ = e[8 + k]; const unsigned code = __builtin_bit_cast(unsigned, h ? chi_ : clo_) & 0xFFu; gt[k] = (h ? ehi_ : elo_) * inv;
            id[k] = (unsigned)slot[code >> 4] * 128u + (unsigned)slot[16 + (code & 15u)]; }
        LDS_WAIT();
        LAS v4u* ip = (LAS v4u*)(idxl + R * 16 + 8 * h); LAS f32x4* gp = (LAS f32x4*)(gatel + R * 16 + 8 * h);
#if !TOPK_DBG_GATES_ONLY
        { v4u a; a.x = id[0]; a.y = id[1]; a.z = id[2]; a.w = id[3]; ip[0] = a; v4u b; b.x = id[4]; b.y = id[5]; b.z = id[6]; b.w = id[7]; ip[1] = b; }
#else
        (void)ip;
#endif
        { f32x4 a; a[0] = gt[0]; a[1] = gt[1]; a[2] = gt[2]; a[3] = gt[3]; gp[0] = a; f32x4 b; b[0] = gt[4]; b[1] = gt[5]; b[2] = gt[6]; b[3] = gt[7]; gp[1] = b; }
    }
}

__device__ __forceinline__ void peer_topk_unit(const Ptrs& P, const LAS bf16* k1l, const LAS bf16* k2l, LAS int* idxl, LAS float* gatel, int unit, int tid) {
    const int tl = tid >> 3, h = tid & 7;
    const bf16* qrow = P.QP + (size_t)(unit * 64 + tl) * 2048 + h * 256;
    float v1[16], v2[16];
    topk_half(qrow, k1l, v1);
    topk_half(qrow + 128, k2l, v2);
    int bad4 = 0;
#if TOPK_DBG_COMPARE == 4
    { const LAS unsigned char* sl = (const LAS unsigned char*)idxl + 65536 + tid * 8;
#pragma unroll
      for (int k = 0; k < 4; ++k) {
          if (TOPK_DBG_SEL != 2 && (unsigned)sl[k] != (__builtin_bit_cast(unsigned, v1[TOPK_DBG_K0 + k]) & 0x7Fu)) bad4 = 1;
          if (TOPK_DBG_SEL != 1 && (unsigned)sl[4 + k] != (__builtin_bit_cast(unsigned, v2[TOPK_DBG_K0 + k]) & 0x7Fu)) bad4 = 1; }
      LDS_WAIT(); }
#endif
#if TOPK_DBG_COMPARE >= 6
    { const LAS unsigned char* sl = (const LAS unsigned char*)idxl + 65536 + tid * 8;
      const unsigned a1 = __builtin_bit_cast(unsigned, v1[0]) & 0x7Fu, a2 = __builtin_bit_cast(unsigned, v2[0]) & 0x7Fu;
      if (TOPK_DBG_SEL != 2 && a1 != (unsigned)sl[0] && a1 != (unsigned)sl[4]) bad4 = 1;
      if (TOPK_DBG_SEL != 1 && a2 != (unsigned)sl[2] && a2 != (unsigned)sl[6]) bad4 = 1;
      LDS_WAIT(); }
#endif
    (void)bad4;
    float tv[16]; int tp[16];
#pragma unroll
    for (int k = 0; k < 16; ++k) { tv[k] = -INFINITY; tp[k] = 0; }
#pragma unroll
    for (int i = 0; i < 16; ++i)
#pragma unroll
        for (int j = 0; j < 16; ++j)
            if ((i + 1) * (j + 1) <= 16) {
                const unsigned b1 = __builtin_bit_cast(unsigned, v1[i]), b2 = __builtin_bit_cast(unsigned, v2[j]);
                float x = __builtin_bit_cast(float, b1 & ~0x7Fu) + __builtin_bit_cast(float, b2 & ~0x7Fu);
                int px = (int)((b1 & 0x7Fu) * 128u + (b2 & 0x7Fu));
#pragma unroll
                for (int k = 0; k < 16; ++k) { const bool c = x > tv[k]; const float nv = c ? x : tv[k], nx = c ? tv[k] : x; const int np = c ? px : tp[k], npx = c ? tp[k] : px; tv[k] = nv; x = nx; tp[k] = np; px = npx; }
            }
    float e[16], es = 0.f;
#pragma unroll
    for (int k = 0; k < 16; ++k) { e[k] = __expf(tv[k] - tv[0]); es += e[k]; }
    const float inv = 1.0f / es;
    LAS v4u* ip = (LAS v4u*)(idxl + tl * 128 + h * 16); LAS f32x4* gp = (LAS f32x4*)(gatel + tl * 128 + h * 16);
#if TOPK_DBG_COMPARE
    { int bad = bad4; unsigned hs_old = 0, hs_new = 0, hx_old = 0, hx_new = 0;
#pragma unroll
      for (int k = 0; k < 16; ++k) { const int ni = idxl[tl * 128 + h * 16 + k]; const float ng = gatel[tl * 128 + h * 16 + k];
          hs_old += (unsigned)tp[k]; hs_new += (unsigned)ni; hx_old ^= (unsigned)tp[k] * 2654435761u; hx_new ^= (unsigned)ni * 2654435761u;
          if (TOPK_DBG_COMPARE == 1 && (k >= TOPK_DBG_K0 && k < TOPK_DBG_K1) && ni != tp[k]) bad = 1;
          if (TOPK_DBG_COMPARE == 3 && (k >= TOPK_DBG_K0 && k < TOPK_DBG_K1) && fabsf(ng - e[k] * inv) > 2e-3f) bad = 1; }
      if (TOPK_DBG_COMPARE == 2 && (hs_old != hs_new || hx_old != hx_new)) bad = 1;
      ((LAS int*)((LAS unsigned char*)idxl + 65536 + 4096))[tid] = bad; }
#endif
#pragma unroll
    for (int k = 0; k < 4; ++k) { v4u iv; iv.x = (unsigned)tp[4 * k]; iv.y = (unsigned)tp[4 * k + 1]; iv.z = (unsigned)tp[4 * k + 2]; iv.w = (unsigned)tp[4 * k + 3]; ip[k] = iv;
        f32x4 gv; gv[0] = e[4 * k] * inv; gv[1] = e[4 * k + 1] * inv; gv[2] = e[4 * k + 2] * inv; gv[3] = e[4 * k + 3] * inv; gp[k] = gv; }
}

#if PEER_FP8
typedef float f32x2p __attribute__((ext_vector_type(2)));
__device__ __forceinline__ unsigned fp8lo_bf16(unsigned w) { return __builtin_bit_cast(unsigned, __builtin_amdgcn_cvt_scalef32_pk_bf16_fp8((int)w, 1.0f, false)); }
__device__ __forceinline__ unsigned fp8hi_bf16(unsigned w) { return __builtin_bit_cast(unsigned, __builtin_amdgcn_cvt_scalef32_pk_bf16_fp8((int)w, 1.0f, true)); }
template <bool STORE> __device__ __forceinline__ void peer_gather_token(const Ptrs& P, const LAS int* idxl, const LAS float* gatel, LAS float* al, int tl, size_t t, int lane, int wave) {
    asm volatile("" : "+v"(lane));
    const int sub = lane & 15, grp = lane >> 4;
    v4u hnr[4][2];
#pragma unroll
    for (int j = 0; j < 4; ++j) { const v4u* hp = (const v4u*)(P.HN2 + t * 1024 + (j * 16 + sub) * 16); hnr[j][0] = hp[0]; hnr[j][1] = hp[1]; }
    const LAS int* myidx = idxl + tl * 128;
    v4u w[4][4]; float sc[4];
#define ULOAD(B, Q) do { const int row_ = myidx[4 * (Q) + grp]; const v4u* up_ = (const v4u*)(P.U8 + (size_t)row_ * 1024) + sub; \
        _Pragma("unroll") for (int j = 0; j < 4; ++j) w[B][j] = up_[j * 16]; sc[B] = P.USC[row_]; } while (0)
#define UCOMP(B, Q) do { float a0 = 0.f, a1 = 0.f, a2 = 0.f, a3 = 0.f; \
        _Pragma("unroll") for (int j = 0; j < 4; ++j) { const v4u x_ = w[B][j]; \
            a0 = dot2bf(fp8lo_bf16(x_.x), hnr[j][0].x, a0); a1 = dot2bf(fp8hi_bf16(x_.x), hnr[j][0].y, a1); a2 = dot2bf(fp8lo_bf16(x_.y), hnr[j][0].z, a2); a3 = dot2bf(fp8hi_bf16(x_.y), hnr[j][0].w, a3); \
            a0 = dot2bf(fp8lo_bf16(x_.z), hnr[j][1].x, a0); a1 = dot2bf(fp8hi_bf16(x_.z), hnr[j][1].y, a1); a2 = dot2bf(fp8lo_bf16(x_.w), hnr[j][1].z, a2); a3 = dot2bf(fp8hi_bf16(x_.w), hnr[j][1].w, a3); } \
        float acc_ = row16_sum((a0 + a1) + (a2 + a3)); \
        if (sub == 0) al[wave * 128 + 4 * (Q) + grp] = acc_ * sc[B]; } while (0)
    ULOAD(0, 0); ULOAD(1, 1); ULOAD(2, 2);
#pragma unroll 1
    for (int q = 0; q < 32; q += 4) {
        ULOAD(3, q + 3); UCOMP(0, q);
        if (q + 4 < 32) ULOAD(0, q + 4);
        UCOMP(1, q + 1);
        if (q + 4 < 32) ULOAD(1, q + 5);
        UCOMP(2, q + 2);
        if (q + 4 < 32) ULOAD(2, q + 6);
        UCOMP(3, q + 3);
    }
#undef ULOAD
#undef UCOMP
    LDS_WAIT();
    const int ix0 = myidx[lane], ix1 = myidx[64 + lane];
    const float av0 = al[wave * 128 + lane], av1 = al[wave * 128 + 64 + lane];
    const float act0 = gelu_tanh(av0) * gatel[tl * 128 + lane] * P.VSC[ix0], act1 = gelu_tanh(av1) * gatel[tl * 128 + 64 + lane] * P.VSC[ix1];
    LDS_WAIT();
    float y[16];
#pragma unroll
    for (int k = 0; k < 16; ++k) y[k] = 0.f;
    v4u vb[2][8];
#define VLOAD(B, IX, E0) do { _Pragma("unroll") for (int k = 0; k < 8; ++k) { const int row_ = __builtin_amdgcn_readlane(IX, (E0) + k); vb[B][k] = *((const v4u*)(P.V8 + (size_t)row_ * 1024) + lane); } } while (0)
#define VCOMP(B, ACT, E0) do { _Pragma("unroll") for (int k = 0; k < 8; ++k) { const float a_ = __builtin_bit_cast(float, __builtin_amdgcn_readlane(__builtin_bit_cast(int, ACT), (E0) + k)); const v4u x_ = vb[B][k]; \
        f32x2p d_; d_ = __builtin_amdgcn_cvt_pk_f32_fp8((int)x_.x, false); y[0] += a_ * d_[0]; y[1] += a_ * d_[1]; d_ = __builtin_amdgcn_cvt_pk_f32_fp8((int)x_.x, true); y[2] += a_ * d_[0]; y[3] += a_ * d_[1]; \
        d_ = __builtin_amdgcn_cvt_pk_f32_fp8((int)x_.y, false); y[4] += a_ * d_[0]; y[5] += a_ * d_[1]; d_ = __builtin_amdgcn_cvt_pk_f32_fp8((int)x_.y, true); y[6] += a_ * d_[0]; y[7] += a_ * d_[1]; \
        d_ = __builtin_amdgcn_cvt_pk_f32_fp8((int)x_.z, false); y[8] += a_ * d_[0]; y[9] += a_ * d_[1]; d_ = __builtin_amdgcn_cvt_pk_f32_fp8((int)x_.z, true); y[10] += a_ * d_[0]; y[11] += a_ * d_[1]; \
        d_ = __builtin_amdgcn_cvt_pk_f32_fp8((int)x_.w, false); y[12] += a_ * d_[0]; y[13] += a_ * d_[1]; d_ = __builtin_amdgcn_cvt_pk_f32_fp8((int)x_.w, true); y[14] += a_ * d_[0]; y[15] += a_ * d_[1]; } } while (0)
    VLOAD(0, ix0, 0);
#pragma unroll 1
    for (int e = 0; e < 64; e += 16) { VLOAD(1, ix0, e + 8); VCOMP(0, act0, e); if (e + 16 < 64) VLOAD(0, ix0, e + 16); else VLOAD(0, ix1, 0); VCOMP(1, act0, e + 8); }
#pragma unroll 1
    for (int e = 0; e < 64; e += 16) { VLOAD(1, ix1, e + 8); VCOMP(0, act1, e); if (e + 16 < 64) VLOAD(0, ix1, e + 16); VCOMP(1, act1, e + 8); }
#undef VLOAD
#undef VCOMP
    float* xr = P.out + t * 1024 + lane * 16;
    f32x4 x[4];
#pragma unroll
    for (int k = 0; k < 4; ++k) { x[k] = *(const f32x4*)(xr + 4 * k); x[k][0] += y[4 * k]; x[k][1] += y[4 * k + 1]; x[k][2] += y[4 * k + 2]; x[k][3] += y[4 * k + 3]; }
    float ss = 0.f;
#pragma unroll
    for (int k = 0; k < 4; ++k) ss += (x[k][0] * x[k][0] + x[k][1] * x[k][1]) + (x[k][2] * x[k][2] + x[k][3] * x[k][3]);
    const float rstd = 1.0f / sqrtf(wave_sum(ss) * (1.0f / 1024.0f) + EPS);
    if (STORE) {
#if TOPK_DBG_COMPARE
        { const LAS int* fl = (const LAS int*)((const LAS unsigned char*)idxl + 65536 + 4096) + tl * 8; int bad = 0;
#pragma unroll
          for (int hh = 0; hh < 8; ++hh) bad |= fl[hh];
          if (bad) {
#pragma unroll
              for (int k = 0; k < 4; ++k) x[k] = x[k] * 0.f; } }
#endif
#pragma unroll
        for (int k = 0; k < 4; ++k) { const f32x4 wv = *(const f32x4*)(P.fin_w + lane * 16 + 4 * k); *(f32x4*)(xr + 4 * k) = x[k] * rstd * wv; }
    } else { asm volatile("" :: "v"(rstd), "v"(x[0][0]), "v"(x[1][1]), "v"(x[2][2]), "v"(x[3][3])); }
}
#else
template <bool STORE> __device__ __forceinline__ void peer_gather_token(const Ptrs& P, const LAS int* idxl, const LAS float* gatel, LAS float* al, int tl, size_t t, int lane, int wave) {
    const int sub = lane & 15, grp = lane >> 4;
    v4u hnr[8];
#pragma unroll
    for (int j = 0; j < 8; ++j) hnr[j] = *((const v4u*)(P.HN2 + t * 1024) + j * 16 + sub);
    for (int q = 0; q < 32; ++q) {
        const int row = idxl[tl * 128 + 4 * q + grp];
        const v4u* up = (const v4u*)(P.U + (size_t)row * 1024) + sub;
        float a0 = 0.f, a1 = 0.f, a2 = 0.f, a3 = 0.f;
#pragma unroll
        for (int j = 0; j < 8; ++j) { const v4u w = up[j * 16]; a0 = dot2bf(w.x, hnr[j].x, a0); a1 = dot2bf(w.y, hnr[j].y, a1); a2 = dot2bf(w.z, hnr[j].z, a2); a3 = dot2bf(w.w, hnr[j].w, a3); }
        float acc = (a0 + a1) + (a2 + a3);
        acc += __shfl_xor(acc, 8); acc += __shfl_xor(acc, 4); acc += __shfl_xor(acc, 2); acc += __shfl_xor(acc, 1);
        if (sub == 0) al[wave * 128 + 4 * q + grp] = acc;
    }
    LDS_WAIT();
    const float av0 = al[wave * 128 + lane], av1 = al[wave * 128 + 64 + lane];
    const float act0 = gelu_tanh(av0) * gatel[tl * 128 + lane], act1 = gelu_tanh(av1) * gatel[tl * 128 + 64 + lane];
    const int ix0 = idxl[tl * 128 + lane], ix1 = idxl[tl * 128 + 64 + lane];
    LDS_WAIT();
    float y[16];
#pragma unroll
    for (int k = 0; k < 16; ++k) y[k] = 0.f;
#pragma unroll 4
    for (int e = 0; e < 64; ++e) {
        const int row = __builtin_amdgcn_readlane(ix0, e); const float a = __builtin_bit_cast(float, __builtin_amdgcn_readlane(__builtin_bit_cast(int, act0), e));
        const v4u* vp = (const v4u*)(P.V + (size_t)row * 1024) + lane; const v4u w0 = vp[0], w1 = vp[64];
        y[0] += a * bflo(w0.x); y[1] += a * bfhi(w0.x); y[2] += a * bflo(w0.y); y[3] += a * bfhi(w0.y); y[4] += a * bflo(w0.z); y[5] += a * bfhi(w0.z); y[6] += a * bflo(w0.w); y[7] += a * bfhi(w0.w);
        y[8] += a * bflo(w1.x); y[9] += a * bfhi(w1.x); y[10] += a * bflo(w1.y); y[11] += a * bfhi(w1.y); y[12] += a * bflo(w1.z); y[13] += a * bfhi(w1.z); y[14] += a * bflo(w1.w); y[15] += a * bfhi(w1.w);
    }
#pragma unroll 4
    for (int e = 0; e < 64; ++e) {
        const int row = __builtin_amdgcn_readlane(ix1, e); const float a = __builtin_bit_cast(float, __builtin_amdgcn_readlane(__builtin_bit_cast(int, act1), e));
        const v4u* vp = (const v4u*)(P.V + (size_t)row * 1024) + lane; const v4u w0 = vp[0], w1 = vp[64];
        y[0] += a * bflo(w0.x); y[1] += a * bfhi(w0.x); y[2] += a * bflo(w0.y); y[3] += a * bfhi(w0.y); y[4] += a * bflo(w0.z); y[5] += a * bfhi(w0.z); y[6] += a * bflo(w0.w); y[7] += a * bfhi(w0.w);
        y[8] += a * bflo(w1.x); y[9] += a * bfhi(w1.x); y[10] += a * bflo(w1.y); y[11] += a * bfhi(w1.y); y[12] += a * bflo(w1.z); y[13] += a * bfhi(w1.z); y[14] += a * bflo(w1.w); y[15] += a * bfhi(w1.w);
    }
    float* xr = P.out + t * 1024;
    f32x4 x0 = *(const f32x4*)(xr + lane * 8), x1 = *(const f32x4*)(xr + lane * 8 + 4), x2 = *(const f32x4*)(xr + 512 + lane * 8), x3 = *(const f32x4*)(xr + 512 + lane * 8 + 4);
    x0[0] += y[0]; x0[1] += y[1]; x0[2] += y[2]; x0[3] += y[3]; x1[0] += y[4]; x1[1] += y[5]; x1[2] += y[6]; x1[3] += y[7];
    x2[0] += y[8]; x2[1] += y[9]; x2[2] += y[10]; x2[3] += y[11]; x3[0] += y[12]; x3[1] += y[13]; x3[2] += y[14]; x3[3] += y[15];
    float ss = 0.f;
#pragma unroll
    for (int k = 0; k < 4; ++k) ss += x0[k] * x0[k] + x1[k] * x1[k] + x2[k] * x2[k] + x3[k] * x3[k];
    const float rstd = 1.0f / sqrtf(wave_sum(ss) * (1.0f / 1024.0f) + EPS);
    if (STORE) {
        const f32x4 w0 = *(const f32x4*)(P.fin_w + lane * 8), w1 = *(const f32x4*)(P.fin_w + lane * 8 + 4), w2 = *(const f32x4*)(P.fin_w + 512 + lane * 8), w3 = *(const f32x4*)(P.fin_w + 512 + lane * 8 + 4);
        *(f32x4*)(xr + lane * 8) = x0 * rstd * w0; *(f32x4*)(xr + lane * 8 + 4) = x1 * rstd * w1; *(f32x4*)(xr + 512 + lane * 8) = x2 * rstd * w2; *(f32x4*)(xr + 512 + lane * 8 + 4) = x3 * rstd * w3;
    } else { asm volatile("" :: "v"(rstd), "v"(x0[0]), "v"(x1[1]), "v"(x2[2]), "v"(x3[3])); }
}
#endif

__device__ __forceinline__ void peer_u_token(const Ptrs& P, const LAS int* idxl, LAS float* gatel, LAS float* al, int tl, size_t t, int lane, int wave) {
    asm volatile("" : "+v"(lane));
    const int sub = lane & 15, grp = lane >> 4;
    v4u hnr[4][2];
#pragma unroll
    for (int j = 0; j < 4; ++j) { const v4u* hp = (const v4u*)(P.HN2 + t * 1024 + (j * 16 + sub) * 16); hnr[j][0] = hp[0]; hnr[j][1] = hp[1]; }
    const LAS int* myidx = idxl + tl * 128;
    v4u w[4][4]; float sc[4];
#define ULOAD(B, Q) do { const int row_ = myidx[4 * (Q) + grp]; const v4u* up_ = (const v4u*)(P.U8 + (size_t)row_ * 1024) + sub; \
        _Pragma("unroll") for (int j = 0; j < 4; ++j) w[B][j] = up_[j * 16]; sc[B] = P.USC[row_]; } while (0)
#define UCOMP(B, Q) do { float a0 = 0.f, a1 = 0.f, a2 = 0.f, a3 = 0.f; \
        _Pragma("unroll") for (int j = 0; j < 4; ++j) { const v4u x_ = w[B][j]; \
            a0 = dot2bf(fp8lo_bf16(x_.x), hnr[j][0].x, a0); a1 = dot2bf(fp8hi_bf16(x_.x), hnr[j][0].y, a1); a2 = dot2bf(fp8lo_bf16(x_.y), hnr[j][0].z, a2); a3 = dot2bf(fp8hi_bf16(x_.y), hnr[j][0].w, a3); \
            a0 = dot2bf(fp8lo_bf16(x_.z), hnr[j][1].x, a0); a1 = dot2bf(fp8hi_bf16(x_.z), hnr[j][1].y, a1); a2 = dot2bf(fp8lo_bf16(x_.w), hnr[j][1].z, a2); a3 = dot2bf(fp8hi_bf16(x_.w), hnr[j][1].w, a3); } \
        float acc_ = row16_sum((a0 + a1) + (a2 + a3)); \
        if (sub == 0) al[wave * 128 + 4 * (Q) + grp] = acc_ * sc[B]; } while (0)
    ULOAD(0, 0); ULOAD(1, 1); ULOAD(2, 2);
#pragma unroll 1
    for (int q = 0; q < 32; q += 4) {
        ULOAD(3, q + 3); UCOMP(0, q);
        if (q + 4 < 32) ULOAD(0, q + 4);
        UCOMP(1, q + 1);
        if (q + 4 < 32) ULOAD(1, q + 5);
        UCOMP(2, q + 2);
        if (q + 4 < 32) ULOAD(2, q + 6);
        UCOMP(3, q + 3);
    }
#undef ULOAD
#undef UCOMP
    LDS_WAIT();
    const int ix0 = myidx[lane], ix1 = myidx[64 + lane];
    const float av0 = al[wave * 128 + lane], av1 = al[wave * 128 + 64 + lane];
    const float act0 = gelu_tanh(av0) * gatel[tl * 128 + lane] * P.VSC[ix0], act1 = gelu_tanh(av1) * gatel[tl * 128 + 64 + lane] * P.VSC[ix1];
    gatel[tl * 128 + lane] = act0; gatel[tl * 128 + 64 + lane] = act1;
    LDS_WAIT();
}

#if PEER_FP8
#define PK8(OUT, X) do { OUT[0] = __builtin_amdgcn_cvt_pk_f32_fp8((int)(X).x, false); OUT[1] = __builtin_amdgcn_cvt_pk_f32_fp8((int)(X).x, true); OUT[2] = __builtin_amdgcn_cvt_pk_f32_fp8((int)(X).y, false); OUT[3] = __builtin_amdgcn_cvt_pk_f32_fp8((int)(X).y, true); \
        OUT[4] = __builtin_amdgcn_cvt_pk_f32_fp8((int)(X).z, false); OUT[5] = __builtin_amdgcn_cvt_pk_f32_fp8((int)(X).z, true); OUT[6] = __builtin_amdgcn_cvt_pk_f32_fp8((int)(X).w, false); OUT[7] = __builtin_amdgcn_cvt_pk_f32_fp8((int)(X).w, true); } while (0)
#define ROW_ISSUE(BUF, TAB, W) do { const unsigned char* rp_ = (TAB) + (size_t)((W) & rowand) * 1024; asm volatile("s_nop 4\n\tglobal_load_dwordx4 %0, %1, %2" : "=v"(BUF) : "v"(loff), "s"(rp_) : "memory"); } while (0)
#define ML(d) (16 * ((((d) & 3) == 1) ? 2 : (((d) & 3) == 2) ? 1 : ((d) & 3)) + ((d) >> 2))
__device__ __forceinline__ void peer_gather_sorted(const Ptrs& P, LAS unsigned char* lds, int unit, int lane, int wave, int g_lo = 0, int g_hi = 2) {
    asm volatile("" : "+v"(lane));
    const size_t t0 = (size_t)unit * 64 + wave * 8;
#pragma unroll 1
    for (int gq = g_lo; gq < g_hi; ++gq) {
        int lq = lane; asm volatile("" : "+v"(lq));
        const unsigned loff = (unsigned)lq * 16u;
        LAS int* idxl = (LAS int*)(lds + 65536) + wave * 1024 + gq * 512;
        const LAS float* gatel = (const LAS float*)(lds + 98304) + wave * 1024 + gq * 512;
        LAS unsigned* sw = (LAS unsigned*)idxl; LAS float* sg = (LAS float*)(lds + 98304) + wave * 1024 + gq * 512;
        LAS int* startl = (LAS int*)(lds + 131072 + 4096) + wave * 64;
        {
            int ent[8]; float gv[8], us[8];
#pragma unroll
            for (int j = 0; j < 8; ++j) { ent[j] = idxl[(j >> 1) * 128 + (j & 1) * 64 + lq]; gv[j] = gatel[(j >> 1) * 128 + (j & 1) * 64 + lq]; }
#pragma unroll
            for (int j = 0; j < 8; ++j) { us[j] = P.USC[ent[j]]; gv[j] *= P.VSC[ent[j]]; }
            LDS_WAIT();
            int rk[8]; int run[NSL];
#pragma unroll
            for (int b = 0; b < NSL; ++b) run[b] = 0;
#pragma unroll
            for (int j = 0; j < 8; ++j) { const int bj = ent[j] >> SLSH; int r = 0;
#pragma unroll
                for (int b = 0; b < NSL; ++b) { const unsigned long long m = __ballot(bj == b);
                    const int below = (int)__builtin_amdgcn_mbcnt_hi((unsigned)(m >> 32), __builtin_amdgcn_mbcnt_lo((unsigned)m, 0u));
                    r = (bj == b) ? run[b] + below : r; run[b] += (int)__builtin_popcountll(m); }
                rk[j] = r; }
            { int st = 0;
#pragma unroll
              for (int b = 0; b < NSL; ++b) { if (lq == b) startl[b] = st; st += run[b]; } }
            LDS_WAIT();
#pragma unroll
            for (int j = 0; j < 8; ++j) { const int pos = startl[ent[j] >> SLSH] + rk[j]; sw[pos] = (unsigned)ent[j] | ((unsigned)(j >> 1) << 14) | (f2bf(us[j]) << 16); sg[pos] = gv[j]; }
            LDS_WAIT();
        }
        if (SWEEP_SYNC) __syncthreads();
#if U_MFMA
        {
            const int n = lq & 15, kg = lq >> 4;
            v2u hb[32];
            { const unsigned char* hp = P.HN8 + (t0 + gq * 4 + (n & 3)) * 1024 + 8 * kg;
#pragma unroll
              for (int ks = 0; ks < 32; ++ks) { v2u v = *(const v2u*)(hp + 32 * ks); if (n >= 4) { v.x = 0u; v.y = 0u; } hb[ks] = v; } }
            LAS float* xl = (LAS float*)(lds + 131072) + wave * 128;
            if (lq < 4) xl[64 + lq] = P.HSC[t0 + gq * 4 + lq];
            v4u ua[16], ub[16];
            unsigned mw_a, mw_b; float mg_a, mg_b, mu_a, mu_b;
#define UM_META(i0, W, G, U) do { W = sw[(i0) + n]; G = sg[(i0) + n]; U = __builtin_bit_cast(float, W & 0xffff0000u); } while (0)
#define UM_LOAD(BUF, W) do { const unsigned char* rp_ = P.U8 + (size_t)((W) & umask) * 1024 + 16 * kg; \
        _Pragma("unroll") for (int m = 0; m < 16; ++m) BUF[m] = *(const v4u*)(rp_ + 64 * m); } while (0)
#define UM_COMP(BUF, W, G, U, i0) do { f32x4 acc = {0.f, 0.f, 0.f, 0.f}; \
        _Pragma("unroll") for (int m = 0; m < 16; ++m) { \
            const long a0_ = (long)(((unsigned long long)BUF[m].y << 32) | BUF[m].x), a1_ = (long)(((unsigned long long)BUF[m].w << 32) | BUF[m].z); \
            const long b0_ = (long)(((unsigned long long)hb[2 * m].y << 32) | hb[2 * m].x), b1_ = (long)(((unsigned long long)hb[2 * m + 1].y << 32) | hb[2 * m + 1].x); \
            acc = __builtin_amdgcn_mfma_f32_16x16x32_fp8_fp8(a0_, b0_, acc, 0, 0, 0); acc = __builtin_amdgcn_mfma_f32_16x16x32_fp8_fp8(a1_, b1_, acc, 0, 0, 0); } \
        if (n < 4) { xl[(4 * kg + 0) * 4 + n] = acc[0]; xl[(4 * kg + 1) * 4 + n] = acc[1]; xl[(4 * kg + 2) * 4 + n] = acc[2]; xl[(4 * kg + 3) * 4 + n] = acc[3]; } \
        LDS_WAIT(); \
        { const unsigned tok_ = ((W) >> 14) & 3u; const float a_ = xl[n * 4 + tok_] * (U) * xl[64 + tok_]; const float act_ = gelu_tanh(a_) * (G); \
          if (lq < 16 && pass + 1 == PROBE_U_PASSES) sg[(i0) + n] = act_; asm volatile("" :: "v"(act_)); } \
        LDS_WAIT(); } while (0)
            LDS_WAIT();
#pragma unroll 1
            for (int pass = 0; pass < PROBE_U_PASSES; ++pass) {
            const unsigned umask = (pass + 1 < PROBE_U_PASSES) ? 63u : 16383u;
            UM_META(0, mw_a, mg_a, mu_a); UM_LOAD(ua, mw_a);
#pragma unroll 1
            for (int i0 = 0; i0 < 512; i0 += 32) {
                UM_META(i0 + 16, mw_b, mg_b, mu_b); UM_LOAD(ub, mw_b);
                UM_COMP(ua, mw_a, mg_a, mu_a, i0);
                if (i0 + 32 < 512) { UM_META(i0 + 32, mw_a, mg_a, mu_a); UM_LOAD(ua, mw_a); }
                UM_COMP(ub, mw_b, mg_b, mu_b, i0 + 16);
            }
            }
#undef UM_META
#undef UM_LOAD
#undef UM_COMP
        }
        LDS_WAIT();
        if (SWEEP_SYNC) __syncthreads();
#else
        {
#if U_INT8
            int hf[4][4];
            float hsc[4];
#if P5_ELIM
            { f32x4 wn[4];
#pragma unroll
              for (int k = 0; k < 4; ++k) wn[k] = *(const f32x4*)(P.ffn_w + loff + 4 * k);
#pragma unroll
              for (int tk = 0; tk < 4; ++tk) { const size_t row = t0 + gq * 4 + tk; const float* xr = P.out + row * 1024 + loff;
                  const f32x4* sp_ = (const f32x4*)(P.rowss + row * 16); const f32x4* ap_ = (const f32x4*)(P.rowamax + row * 16);
                  const f32x4 sq_ = (sp_[0] + sp_[1]) + (sp_[2] + sp_[3]); const f32x4 a0_ = ap_[0], a1_ = ap_[1], a2_ = ap_[2], a3_ = ap_[3];
                  float am = 0.f;
#pragma unroll
                  for (int k = 0; k < 4; ++k) am = fmaxf(am, fmaxf(fmaxf(a0_[k], a1_[k]), fmaxf(a2_[k], a3_[k])));
                  const float qs = (am > 1e-30f) ? 127.0f / am : 0.f;
                  const float rstd = 1.0f / sqrtf(((sq_[0] + sq_[1]) + (sq_[2] + sq_[3])) * (1.0f / 1024.0f) + EPS);
                  hsc[tk] = am * rstd * (1.0f / 127.0f);
#pragma unroll
                  for (int k = 0; k < 4; ++k) { const f32x4 v = *(const f32x4*)(xr + 4 * k) * wn[k] * qs; hf[tk][k] = pack_i8x4(v[0], v[1], v[2], v[3]); } } }
#else
#pragma unroll
            for (int tk = 0; tk < 4; ++tk) { const v4u h0 = *(const v4u*)(P.HN8 + (t0 + gq * 4 + tk) * 1024 + loff); hf[tk][0] = (int)h0.x; hf[tk][1] = (int)h0.y; hf[tk][2] = (int)h0.z; hf[tk][3] = (int)h0.w; hsc[tk] = P.HSC[t0 + gq * 4 + tk]; }
#endif
#elif U_DOT2
            unsigned hf[4][8];
#pragma unroll
            for (int tk = 0; tk < 4; ++tk) { const v4u* hp = (const v4u*)((const unsigned char*)(P.HN2 + (t0 + gq * 4 + tk) * 1024) + 2u * loff); const v4u h0 = hp[0], h1 = hp[1];
                hf[tk][0] = h0.x; hf[tk][1] = h0.y; hf[tk][2] = h0.z; hf[tk][3] = h0.w; hf[tk][4] = h1.x; hf[tk][5] = h1.y; hf[tk][6] = h1.z; hf[tk][7] = h1.w; }
#else
            f32x2p hf[4][8];
#pragma unroll
            for (int tk = 0; tk < 4; ++tk) { const v4u* hp = (const v4u*)((const unsigned char*)(P.HN2 + (t0 + gq * 4 + tk) * 1024) + 2u * loff); const v4u h0 = hp[0], h1 = hp[1];
                hf[tk][0][0] = bflo(h0.x); hf[tk][0][1] = bfhi(h0.x); hf[tk][1][0] = bflo(h0.y); hf[tk][1][1] = bfhi(h0.y); hf[tk][2][0] = bflo(h0.z); hf[tk][2][1] = bfhi(h0.z); hf[tk][3][0] = bflo(h0.w); hf[tk][3][1] = bfhi(h0.w);
                hf[tk][4][0] = bflo(h1.x); hf[tk][4][1] = bfhi(h1.x); hf[tk][5][0] = bflo(h1.y); hf[tk][5][1] = bfhi(h1.y); hf[tk][6][0] = bflo(h1.z); hf[tk][6][1] = bfhi(h1.z); hf[tk][7][0] = bflo(h1.w); hf[tk][7][1] = bfhi(h1.w); }
#endif
#if U_INT4
            v2u ub[16]; const unsigned loff8 = (unsigned)lq * 8u;
#else
            v4u ub[16];
#endif
            float p[16];
            const int c4 = lq & 15, rho = lq >> 4;
            const int me = (c4 < 4) ? 4 * c4 + ((rho == 1) ? 2 : (rho == 2) ? 1 : rho) : 0;
            unsigned mw_c, mw_n; float mg_c, mg_n, mu_c, mu_n;
#if U_INT8
#define HSC_OF(W) ((((W) >> 14) & 3u) == 0u ? hsc[0] : (((W) >> 14) & 3u) == 1u ? hsc[1] : (((W) >> 14) & 3u) == 2u ? hsc[2] : hsc[3])
#else
#define HSC_OF(W) 1.0f
#endif
#define U_META(i0, W, G, U) do { W = sw[(i0) + me]; G = sg[(i0) + me]; U = __builtin_bit_cast(float, W & 0xffff0000u); } while (0)
#if U_INT4
#define UROW_ISSUE(BUF, W) do { const unsigned char* rp_ = P.U8 + (size_t)((W) & rowand) * 512; asm volatile("s_nop 4\n\tglobal_load_dwordx2 %0, %1, %2" : "=v"(BUF) : "v"(loff8), "s"(rp_) : "memory"); } while (0)
#define U_DOT(tk) asm volatile("s_cmp_lg_u32 %8, " #tk "\n\ts_cbranch_scc1 .LUSK%=\n\t" \
        "v_dot8_i32_i4 %0, %2, %4, %0\n\tv_dot8_i32_i4 %1, %2, %6, %1\n\tv_dot8_i32_i4 %0, %3, %5, %0\n\tv_dot8_i32_i4 %1, %3, %7, %1\n\ts_nop 2\n.LUSK%=:" \
        : "+v"(a0_), "+v"(a1_) : "v"(x_.x), "v"(x_.y), "v"(hf[tk][0]), "v"(hf[tk][1]), "v"(hf[tk][2]), "v"(hf[tk][3]), "s"(tok) : "scc")
#define U_STEP(d, CNT, ISSUE) do { asm volatile("s_waitcnt vmcnt(" #CNT ")" : "+v"(ub[d]) :: "memory"); \
        { const v2u x_ = ub[d]; \
          const unsigned tok = ((unsigned)__builtin_amdgcn_readlane((int)mw_c, ML(d)) >> 14) & 3u; \
          int a0_ = 0, a1_ = 0; \
          U_DOT(0); U_DOT(1); U_DOT(2); U_DOT(3); \
          p[d] = (float)((a0_ << 4) + a1_); } \
        if (ISSUE) UROW_ISSUE(ub[d], (unsigned)__builtin_amdgcn_readlane((int)mw_n, ML(d))); } while (0)
#elif U_INT8
#define UROW_ISSUE(BUF, W) ROW_ISSUE(BUF, P.U8, W)
#define U_DOT(tk) asm volatile("s_cmp_lg_u32 %10, " #tk "\n\ts_cbranch_scc1 .LUSK%=\n\t" \
        "v_dot4c_i32_i8 %0, %2, %6\n\tv_dot4c_i32_i8 %1, %3, %7\n\tv_dot4c_i32_i8 %0, %4, %8\n\tv_dot4c_i32_i8 %1, %5, %9\n\ts_nop 2\n.LUSK%=:" \
        : "+v"(a0_), "+v"(a1_) : "v"(x_.x), "v"(x_.y), "v"(x_.z), "v"(x_.w), "v"(hf[tk][0]), "v"(hf[tk][1]), "v"(hf[tk][2]), "v"(hf[tk][3]), "s"(tok) : "scc")
#define U_STEP(d, CNT, ISSUE) do { asm volatile("s_waitcnt vmcnt(" #CNT ")" : "+v"(ub[d]) :: "memory"); \
        { const v4u x_ = ub[d]; \
          const unsigned tok = ((unsigned)__builtin_amdgcn_readlane((int)mw_c, ML(d)) >> 14) & 3u; \
          int a0_ = 0, a1_ = 0; \
          U_DOT(0); U_DOT(1); U_DOT(2); U_DOT(3); \
          p[d] = (float)(a0_ + a1_); } \
        if (ISSUE) ROW_ISSUE(ub[d], P.U8, (unsigned)__builtin_amdgcn_readlane((int)mw_n, ML(d))); } while (0)
#elif U_DOT2
#define UROW_ISSUE(BUF, W) ROW_ISSUE(BUF, P.U8, W)
#define U_DOT(tk) asm volatile("s_cmp_lg_u32 %20, " #tk "\n\ts_cbranch_scc1 .LUSK%=\n\t" \
        "v_dot2c_f32_bf16 %0, %4, %12\n\tv_dot2c_f32_bf16 %1, %5, %13\n\tv_dot2c_f32_bf16 %2, %6, %14\n\tv_dot2c_f32_bf16 %3, %7, %15\n\t" \
        "v_dot2c_f32_bf16 %0, %8, %16\n\tv_dot2c_f32_bf16 %1, %9, %17\n\tv_dot2c_f32_bf16 %2, %10, %18\n\tv_dot2c_f32_bf16 %3, %11, %19\n\ts_nop 2\n.LUSK%=:" \
        : "+v"(a0_), "+v"(a1_), "+v"(a2_), "+v"(a3_) \
        : "v"(dk_[0]), "v"(dk_[1]), "v"(dk_[2]), "v"(dk_[3]), "v"(dk_[4]), "v"(dk_[5]), "v"(dk_[6]), "v"(dk_[7]), \
          "v"(hf[tk][0]), "v"(hf[tk][1]), "v"(hf[tk][2]), "v"(hf[tk][3]), "v"(hf[tk][4]), "v"(hf[tk][5]), "v"(hf[tk][6]), "v"(hf[tk][7]), "s"(tok) : "scc")
#define U_STEP(d, CNT, ISSUE) do { asm volatile("s_waitcnt vmcnt(" #CNT ")" : "+v"(ub[d]) :: "memory"); \
        { const v4u x_ = ub[d]; unsigned dk_[8]; dk_[0] = fp8lo_bf16(x_.x); dk_[1] = fp8hi_bf16(x_.x); dk_[2] = fp8lo_bf16(x_.y); dk_[3] = fp8hi_bf16(x_.y); dk_[4] = fp8lo_bf16(x_.z); dk_[5] = fp8hi_bf16(x_.z); dk_[6] = fp8lo_bf16(x_.w); dk_[7] = fp8hi_bf16(x_.w); \
          const unsigned tok = ((unsigned)__builtin_amdgcn_readlane((int)mw_c, ML(d)) >> 14) & 3u; \
          float a0_ = 0.f, a1_ = 0.f, a2_ = 0.f, a3_ = 0.f; \
          U_DOT(0); U_DOT(1); U_DOT(2); U_DOT(3); \
          p[d] = (a0_ + a1_) + (a2_ + a3_); } \
        if (ISSUE) ROW_ISSUE(ub[d], P.U8, (unsigned)__builtin_amdgcn_readlane((int)mw_n, ML(d))); } while (0)
#else
#define UROW_ISSUE(BUF, W) ROW_ISSUE(BUF, P.U8, W)
#define U_DOT(tk) asm volatile("s_cmp_lg_u32 %20, " #tk "\n\ts_cbranch_scc1 .LUSK%=\n\t" \
        "v_pk_fma_f32 %0, %4, %12, %0\n\tv_pk_fma_f32 %1, %5, %13, %1\n\tv_pk_fma_f32 %2, %6, %14, %2\n\tv_pk_fma_f32 %3, %7, %15, %3\n\t" \
        "v_pk_fma_f32 %0, %8, %16, %0\n\tv_pk_fma_f32 %1, %9, %17, %1\n\tv_pk_fma_f32 %2, %10, %18, %2\n\tv_pk_fma_f32 %3, %11, %19, %3\n.LUSK%=:" \
        : "+v"(a0_), "+v"(a1_), "+v"(a2_), "+v"(a3_) \
        : "v"(dk_[0]), "v"(dk_[1]), "v"(dk_[2]), "v"(dk_[3]), "v"(dk_[4]), "v"(dk_[5]), "v"(dk_[6]), "v"(dk_[7]), \
          "v"(hf[tk][0]), "v"(hf[tk][1]), "v"(hf[tk][2]), "v"(hf[tk][3]), "v"(hf[tk][4]), "v"(hf[tk][5]), "v"(hf[tk][6]), "v"(hf[tk][7]), "s"(tok) : "scc")
#define U_STEP(d, CNT, ISSUE) do { asm volatile("s_waitcnt vmcnt(" #CNT ")" : "+v"(ub[d]) :: "memory"); \
        { const v4u x_ = ub[d]; f32x2p dk_[8]; PK8(dk_, x_); \
          const unsigned tok = ((unsigned)__builtin_amdgcn_readlane((int)mw_c, ML(d)) >> 14) & 3u; \
          f32x2p a0_, a1_, a2_, a3_; a0_[0] = 0.f; a0_[1] = 0.f; a1_ = a0_; a2_ = a0_; a3_ = a0_; \
          U_DOT(0); U_DOT(1); U_DOT(2); U_DOT(3); \
          const f32x2p s_ = (a0_ + a1_) + (a2_ + a3_); p[d] = s_[0] + s_[1]; } \
        if (ISSUE) ROW_ISSUE(ub[d], P.U8, (unsigned)__builtin_amdgcn_readlane((int)mw_n, ML(d))); } while (0)
#endif
#pragma unroll 1
            for (int pass = 0; pass < PROBE_U_PASSES; ++pass) {
            const unsigned rowand = (pass + 1 < PROBE_U_PASSES) ? PROBE_ROWAND : 16383u;
            asm volatile("s_waitcnt vmcnt(0)" ::: "memory");
            U_META(0, mw_c, mg_c, mu_c);
#define U_ISSUE0(d) UROW_ISSUE(ub[d], (unsigned)__builtin_amdgcn_readlane((int)mw_c, ML(d)))
            U_ISSUE0(0); U_ISSUE0(1); U_ISSUE0(2); U_ISSUE0(3); U_ISSUE0(4); U_ISSUE0(5); U_ISSUE0(6); U_ISSUE0(7); U_ISSUE0(8); U_ISSUE0(9); U_ISSUE0(10); U_ISSUE0(11); U_ISSUE0(12); U_ISSUE0(13); U_ISSUE0(14); U_ISSUE0(15);
#undef U_ISSUE0
#define U_FINISH(i0) do { float q_[8], r_[4]; \
        _Pragma("unroll") for (int j = 0; j < 8; ++j) { auto rr = __builtin_amdgcn_permlane32_swap(__builtin_bit_cast(unsigned, p[2 * j]), __builtin_bit_cast(unsigned, p[2 * j + 1]), false, false); const unsigned r0 = rr[0], r1 = rr[1]; q_[j] = __builtin_bit_cast(float, r0) + __builtin_bit_cast(float, r1); } \
        _Pragma("unroll") for (int j = 0; j < 4; ++j) { auto rr = __builtin_amdgcn_permlane16_swap(__builtin_bit_cast(unsigned, q_[2 * j]), __builtin_bit_cast(unsigned, q_[2 * j + 1]), false, false); const unsigned r0 = rr[0], r1 = rr[1]; r_[j] = row16_sum(__builtin_bit_cast(float, r0) + __builtin_bit_cast(float, r1)); } \
        const float acol = (c4 == 0) ? r_[0] : (c4 == 1) ? r_[1] : (c4 == 2) ? r_[2] : r_[3]; \
        const float act = gelu_tanh(acol * mu_c * HSC_OF(mw_c)) * mg_c; \
        if (c4 < 4 && pass + 1 == PROBE_U_PASSES) sg[(i0) + me] = act; asm volatile("" :: "v"(act)); } while (0)
#pragma unroll 1
            for (int i0 = 0; i0 < 512 - 16; i0 += 16) {
                U_META(i0 + 16, mw_n, mg_n, mu_n);
                U_STEP(0, 15, 1); U_STEP(1, 15, 1); U_STEP(2, 15, 1); U_STEP(3, 15, 1); U_STEP(4, 15, 1); U_STEP(5, 15, 1); U_STEP(6, 15, 1); U_STEP(7, 15, 1);
                U_STEP(8, 15, 1); U_STEP(9, 15, 1); U_STEP(10, 15, 1); U_STEP(11, 15, 1); U_STEP(12, 15, 1); U_STEP(13, 15, 1); U_STEP(14, 15, 1); U_STEP(15, 15, 1);
                U_FINISH(i0);
                mw_c = mw_n; mg_c = mg_n; mu_c = mu_n;
            }
            mw_n = mw_c;
            U_STEP(0, 15, 0); U_STEP(1, 14, 0); U_STEP(2, 13, 0); U_STEP(3, 12, 0); U_STEP(4, 11, 0); U_STEP(5, 10, 0); U_STEP(6, 9, 0); U_STEP(7, 8, 0);
            U_STEP(8, 7, 0); U_STEP(9, 6, 0); U_STEP(10, 5, 0); U_STEP(11, 4, 0); U_STEP(12, 3, 0); U_STEP(13, 2, 0); U_STEP(14, 1, 0); U_STEP(15, 0, 0);
            U_FINISH(512 - 16);
            }
#undef U_FINISH
#undef U_STEP
#undef U_DOT
#undef UROW_ISSUE
#undef U_META
        }
        LDS_WAIT();
        if (SWEEP_SYNC) __syncthreads();
#endif
        f32x2p y[4][8];
#pragma unroll
        for (int tk = 0; tk < 4; ++tk)
#pragma unroll
            for (int k = 0; k < 8; ++k) { y[tk][k][0] = 0.f; y[tk][k][1] = 0.f; }
        {
            v4u vb[16]; const int ml = lq & 15;
            unsigned mw_c, mw_n, ma_c, ma_n;
#define V_META(i0, W, A) do { W = sw[(i0) + ml]; A = __builtin_bit_cast(unsigned, sg[(i0) + ml]); } while (0)
#define V_FMA(tk) asm volatile("s_cmp_lg_u32 %17, " #tk "\n\ts_cbranch_scc1 .LVSK%=\n\t" \
        "v_pk_fma_f32 %0, %8, %16, %0\n\tv_pk_fma_f32 %1, %9, %16, %1\n\tv_pk_fma_f32 %2, %10, %16, %2\n\tv_pk_fma_f32 %3, %11, %16, %3\n\t" \
        "v_pk_fma_f32 %4, %12, %16, %4\n\tv_pk_fma_f32 %5, %13, %16, %5\n\tv_pk_fma_f32 %6, %14, %16, %6\n\tv_pk_fma_f32 %7, %15, %16, %7\n.LVSK%=:" \
        : "+v"(y[tk][0]), "+v"(y[tk][1]), "+v"(y[tk][2]), "+v"(y[tk][3]), "+v"(y[tk][4]), "+v"(y[tk][5]), "+v"(y[tk][6]), "+v"(y[tk][7]) \
        : "v"(dk_[0]), "v"(dk_[1]), "v"(dk_[2]), "v"(dk_[3]), "v"(dk_[4]), "v"(dk_[5]), "v"(dk_[6]), "v"(dk_[7]), "v"(a2_), "s"(tok) : "scc")
#define V_NOFMA(tk) asm volatile("s_cmp_lg_u32 %17, " #tk "\n\ts_cbranch_scc1 .LVSK%=\n\ts_nop 0\n.LVSK%=:" \
        : "+v"(y[tk][0]), "+v"(y[tk][1]), "+v"(y[tk][2]), "+v"(y[tk][3]), "+v"(y[tk][4]), "+v"(y[tk][5]), "+v"(y[tk][6]), "+v"(y[tk][7]) \
        : "v"(dk_[0]), "v"(dk_[1]), "v"(dk_[2]), "v"(dk_[3]), "v"(dk_[4]), "v"(dk_[5]), "v"(dk_[6]), "v"(dk_[7]), "v"(a2_), "s"(tok) : "scc")
#define V_STEP(d, CNT, ISSUE, FM) do { asm volatile("s_waitcnt vmcnt(" #CNT ")" : "+v"(vb[d]) :: "memory"); \
        { const v4u x_ = vb[d]; f32x2p dk_[8]; PK8(dk_, x_); \
          const unsigned tok = ((unsigned)__builtin_amdgcn_readlane((int)mw_c, d) >> 14) & 3u; const float a_ = __builtin_bit_cast(float, __builtin_amdgcn_readlane((int)ma_c, d)); f32x2p a2_; a2_[0] = a_; a2_[1] = a_; \
          if (FM) { V_FMA(0); V_FMA(1); V_FMA(2); V_FMA(3); } else { V_NOFMA(0); V_NOFMA(1); V_NOFMA(2); V_NOFMA(3); } } \
        if (ISSUE) ROW_ISSUE(vb[d], P.V8, (unsigned)__builtin_amdgcn_readlane((int)mw_n, d)); } while (0)
#pragma unroll 1
            for (int pass = 0; pass < PROBE_V_PASSES; ++pass) {
            const unsigned rowand = (pass + 1 < PROBE_V_PASSES) ? PROBE_ROWAND : 16383u;
#define V_BODY(FM) do { \
            asm volatile("s_waitcnt vmcnt(0)" ::: "memory"); \
            V_META(0, mw_c, ma_c); \
            V_ISSUE0(0); V_ISSUE0(1); V_ISSUE0(2); V_ISSUE0(3); V_ISSUE0(4); V_ISSUE0(5); V_ISSUE0(6); V_ISSUE0(7); V_ISSUE0(8); V_ISSUE0(9); V_ISSUE0(10); V_ISSUE0(11); V_ISSUE0(12); V_ISSUE0(13); V_ISSUE0(14); V_ISSUE0(15); \
            _Pragma("unroll 1") for (int i0 = 0; i0 < 512 - 16; i0 += 16) { \
                V_META(i0 + 16, mw_n, ma_n); \
                V_STEP(0, 15, 1, FM); V_STEP(1, 15, 1, FM); V_STEP(2, 15, 1, FM); V_STEP(3, 15, 1, FM); V_STEP(4, 15, 1, FM); V_STEP(5, 15, 1, FM); V_STEP(6, 15, 1, FM); V_STEP(7, 15, 1, FM); \
                V_STEP(8, 15, 1, FM); V_STEP(9, 15, 1, FM); V_STEP(10, 15, 1, FM); V_STEP(11, 15, 1, FM); V_STEP(12, 15, 1, FM); V_STEP(13, 15, 1, FM); V_STEP(14, 15, 1, FM); V_STEP(15, 15, 1, FM); \
                mw_c = mw_n; ma_c = ma_n; } \
            mw_n = mw_c; \
            V_STEP(0, 15, 0, FM); V_STEP(1, 14, 0, FM); V_STEP(2, 13, 0, FM); V_STEP(3, 12, 0, FM); V_STEP(4, 11, 0, FM); V_STEP(5, 10, 0, FM); V_STEP(6, 9, 0, FM); V_STEP(7, 8, 0, FM); \
            V_STEP(8, 7, 0, FM); V_STEP(9, 6, 0, FM); V_STEP(10, 5, 0, FM); V_STEP(11, 4, 0, FM); V_STEP(12, 3, 0, FM); V_STEP(13, 2, 0, FM); V_STEP(14, 1, 0, FM); V_STEP(15, 0, 0, FM); } while (0)
#define V_ISSUE0(d) ROW_ISSUE(vb[d], P.V8, (unsigned)__builtin_amdgcn_readlane((int)mw_c, d))
            if (pass + 1 < PROBE_V_PASSES) V_BODY(0); else V_BODY(1);
#undef V_ISSUE0
#undef V_BODY
            }
#undef V_STEP
#undef V_META
#undef V_FMA
#undef V_NOFMA
        }
#pragma unroll
        for (int tk = 0; tk < 4; ++tk) {
            float* xr = P.out + (t0 + gq * 4 + tk) * 1024 + loff;
            f32x4 x[4];
#pragma unroll
            for (int k = 0; k < 4; ++k) { x[k] = *(const f32x4*)(xr + 4 * k); x[k][0] += y[tk][2 * k][0]; x[k][1] += y[tk][2 * k][1]; x[k][2] += y[tk][2 * k + 1][0]; x[k][3] += y[tk][2 * k + 1][1]; }
            float ss = 0.f;
#pragma unroll
            for (int k = 0; k < 4; ++k) ss += (x[k][0] * x[k][0] + x[k][1] * x[k][1]) + (x[k][2] * x[k][2] + x[k][3] * x[k][3]);
            const float rstd = 1.0f / sqrtf(wave_sum(ss) * (1.0f / 1024.0f) + EPS);
#pragma unroll
            for (int k = 0; k < 4; ++k) { const f32x4 wv = *(const f32x4*)(P.fin_w + (loff + 4 * k)); *(f32x4*)(xr + 4 * k) = x[k] * rstd * wv; }
        }
    }
}
#undef ML
#undef ROW_ISSUE
#undef PK8
#endif

#if GATHER_HALF
#define HROW_ISSUE(BUF, TAB, W) do { const unsigned vo_ = (((W) & 0x3fffu) << 9) + loff; asm volatile("global_load_dwordx4 %0, %1, %2" : "=v"(BUF) : "v"(vo_), "s"(TAB) : "memory"); } while (0)
__device__ __forceinline__ void peer_gather_half(const Ptrs& P, LAS unsigned char* lds, int unit, int lane, int wave, int g_lo, int g_hi) {
    asm volatile("" : "+v"(lane));
    const size_t t0 = (size_t)unit * 64 + wave * 8;
#pragma unroll 1
    for (int gq = g_lo; gq < g_hi; ++gq) {
        int lq = lane; asm volatile("" : "+v"(lq));
        LAS int* idxl = (LAS int*)(lds + 65536) + wave * 1024 + gq * 512;
        const LAS float* gatel = (const LAS float*)(lds + 98304) + wave * 1024 + gq * 512;
        LAS unsigned* sw = (LAS unsigned*)idxl; LAS float* sg = (LAS float*)(lds + 98304) + wave * 1024 + gq * 512;
        LAS int* startl = (LAS int*)(lds + 131072 + 4096) + wave * 64;
        {
            int ent[8]; float gv[8], us[8];
#pragma unroll
            for (int j = 0; j < 8; ++j) { ent[j] = idxl[(j >> 1) * 128 + (j & 1) * 64 + lq]; gv[j] = gatel[(j >> 1) * 128 + (j & 1) * 64 + lq]; }
#pragma unroll
            for (int j = 0; j < 8; ++j) { us[j] = P.USC[ent[j]]; gv[j] *= P.VSC[ent[j]] * 128.0f; }
            LDS_WAIT();
            int rk[8];
#pragma unroll
            for (int tk = 0; tk < 4; ++tk) {
                int run[NSL];
#pragma unroll
                for (int b = 0; b < NSL; ++b) run[b] = 0;
#pragma unroll
                for (int jj = 0; jj < 2; ++jj) { const int j = 2 * tk + jj; const int bj = ent[j] >> SLSH; int r = 0;
#pragma unroll
                    for (int b = 0; b < NSL; ++b) { const unsigned long long m = __ballot(bj == b);
                        const int below = (int)__builtin_amdgcn_mbcnt_hi((unsigned)(m >> 32), __builtin_amdgcn_mbcnt_lo((unsigned)m, 0u));
                        r = (bj == b) ? run[b] + below : r; run[b] += (int)__builtin_popcountll(m); }
                    rk[j] = r; }
                int st = 0;
#pragma unroll
                for (int b = 0; b < NSL; ++b) { if (lq == b) startl[tk * NSL + b] = st; st += run[b]; }
            }
            LDS_WAIT();
#pragma unroll
            for (int j = 0; j < 8; ++j) { const int pos = (j >> 1) * 128 + startl[(j >> 1) * NSL + (ent[j] >> SLSH)] + rk[j]; sw[pos] = (unsigned)ent[j] | (f2bf(us[j]) << 16); sg[pos] = gv[j]; }
            LDS_WAIT();
        }
#pragma unroll 1
        for (int sub = 0; sub < 2; ++sub) {
            int lr = lane; asm volatile("" : "+v"(lr));
            const int l5 = lr & 31, tk = 2 * sub + (lr >> 5);
            const LAS unsigned* swt = sw + tk * 128; const LAS float* sgt = sg + tk * 128;
            const unsigned loff = (unsigned)l5 * 16u;
            {
                const int c4 = lr & 15, rho = lr >> 4;
                const int mtk = 2 * sub + (rho >> 1), mpos = (c4 < 4) ? 2 * c4 + (rho & 1) : 0;
                const LAS unsigned* swm = sw + mtk * 128 + mpos; LAS float* sgm = sg + mtk * 128 + mpos;
                const v4u* hp = (const v4u*)(P.HN8 + (t0 + gq * 4 + tk) * 1024 + 32 * l5);
                v4u ha = hp[0], hb = hp[1]; float hsc_m = P.HSC[t0 + gq * 4 + mtk];
                asm volatile("s_waitcnt vmcnt(0)" : "+v"(ha), "+v"(hb), "+v"(hsc_m) :: "memory");
                v4u ub[16]; float p[8];
                unsigned mw; float mg;
#pragma unroll 1
                for (int pass = 0; pass < PROBE_SWEEPS; ++pass) {
                const bool lastp = (pass + 1 == PROBE_SWEEPS);
#define U_STEP(d, CNT, ISSUE, W) do { asm volatile("s_waitcnt vmcnt(" #CNT ")" : "+v"(ub[d]) :: "memory"); \
        { const v4u x_ = ub[d]; int a_ = 0, b_ = 0; \
          a_ = __builtin_amdgcn_sdot8((int)x_.x, (int)ha.x, a_, false); b_ = __builtin_amdgcn_sdot8((int)x_.x, (int)hb.x, b_, false); \
          a_ = __builtin_amdgcn_sdot8((int)x_.y, (int)ha.y, a_, false); b_ = __builtin_amdgcn_sdot8((int)x_.y, (int)hb.y, b_, false); \
          a_ = __builtin_amdgcn_sdot8((int)x_.z, (int)ha.z, a_, false); b_ = __builtin_amdgcn_sdot8((int)x_.z, (int)hb.z, b_, false); \
          a_ = __builtin_amdgcn_sdot8((int)x_.w, (int)ha.w, a_, false); b_ = __builtin_amdgcn_sdot8((int)x_.w, (int)hb.w, b_, false); \
          p[(d) & 7] = (float)((a_ << 4) + b_); } \
        if (ISSUE) HROW_ISSUE(ub[d], P.U8, W); } while (0)
#define U_FINISH(i0) do { float r_[4]; \
        _Pragma("unroll") for (int j = 0; j < 4; ++j) { auto rr = __builtin_amdgcn_permlane16_swap(__builtin_bit_cast(unsigned, p[2 * j]), __builtin_bit_cast(unsigned, p[2 * j + 1]), false, false); const unsigned r0 = rr[0], r1 = rr[1]; r_[j] = row16_sum(__builtin_bit_cast(float, r0) + __builtin_bit_cast(float, r1)); } \
        const float acol = (c4 == 0) ? r_[0] : (c4 == 1) ? r_[1] : (c4 == 2) ? r_[2] : r_[3]; \
        const float act = gelu_tanh(acol * __builtin_bit_cast(float, mw & 0xffff0000u) * hsc_m) * mg; \
        if (c4 < 4 && lastp) sgm[i0] = act; asm volatile("" :: "v"(act)); } while (0)
#define U_CHUNK(i0, B, WA, WB, C0, C1, C2, C3, C4, C5, C6, C7, ISSUE) do { mw = swm[i0]; mg = sgm[i0]; \
        U_STEP(B + 0, C0, ISSUE, WA.x); U_STEP(B + 1, C1, ISSUE, WA.y); U_STEP(B + 2, C2, ISSUE, WA.z); U_STEP(B + 3, C3, ISSUE, WA.w); \
        U_STEP(B + 4, C4, ISSUE, WB.x); U_STEP(B + 5, C5, ISSUE, WB.y); U_STEP(B + 6, C6, ISSUE, WB.z); U_STEP(B + 7, C7, ISSUE, WB.w); \
        U_FINISH(i0); } while (0)
                {
                    const v4u w0 = *(const LAS v4u*)(swt), w1 = *(const LAS v4u*)(swt + 4), w2 = *(const LAS v4u*)(swt + 8), w3 = *(const LAS v4u*)(swt + 12);
                    HROW_ISSUE(ub[0], P.U8, w0.x); HROW_ISSUE(ub[1], P.U8, w0.y); HROW_ISSUE(ub[2], P.U8, w0.z); HROW_ISSUE(ub[3], P.U8, w0.w);
                    HROW_ISSUE(ub[4], P.U8, w1.x); HROW_ISSUE(ub[5], P.U8, w1.y); HROW_ISSUE(ub[6], P.U8, w1.z); HROW_ISSUE(ub[7], P.U8, w1.w);
                    HROW_ISSUE(ub[8], P.U8, w2.x); HROW_ISSUE(ub[9], P.U8, w2.y); HROW_ISSUE(ub[10], P.U8, w2.z); HROW_ISSUE(ub[11], P.U8, w2.w);
                    HROW_ISSUE(ub[12], P.U8, w3.x); HROW_ISSUE(ub[13], P.U8, w3.y); HROW_ISSUE(ub[14], P.U8, w3.z); HROW_ISSUE(ub[15], P.U8, w3.w);
                }
                v4u wa = *(const LAS v4u*)(swt + 16), wb = *(const LAS v4u*)(swt + 20);
#pragma unroll 1
                for (int i0 = 0; i0 < 112; i0 += 16) {
                    const v4u wc = *(const LAS v4u*)(swt + i0 + 24), wd = *(const LAS v4u*)(swt + i0 + 28);
                    U_CHUNK(i0, 0, wa, wb, 15, 15, 15, 15, 15, 15, 15, 15, 1);
                    wa = *(const LAS v4u*)(swt + i0 + 32); wb = *(const LAS v4u*)(swt + i0 + 36);
                    U_CHUNK(i0 + 8, 8, wc, wd, 15, 15, 15, 15, 15, 15, 15, 15, 1);
                }
                U_CHUNK(112, 0, wa, wb, 15, 14, 13, 12, 11, 10, 9, 8, 0);
                U_CHUNK(120, 8, wa, wb, 7, 6, 5, 4, 3, 2, 1, 0, 0);
                }
#undef U_CHUNK
#undef U_FINISH
#undef U_STEP
            }
            LDS_WAIT();
            h2 y[16];
#pragma unroll
            for (int k = 0; k < 16; ++k) { y[k][0] = (_Float16)0.f; y[k][1] = (_Float16)0.f; }
#if X_PREFETCH
            f32x4 xq[8];
#endif
            {
                v4u vb[16];
#pragma unroll 1
                for (int pass = 0; pass < PROBE_SWEEPS; ++pass) {
                if (pass > 0) {
#pragma unroll
                    for (int k = 0; k < 16; ++k) { y[k][0] = (_Float16)0.f; y[k][1] = (_Float16)0.f; } }
                asm volatile("s_waitcnt vmcnt(0)" ::: "memory");
#define V_F4(K, X, B) y[K] = __builtin_elementwise_fma(__builtin_bit_cast(h2, __builtin_amdgcn_cvt_scalef32_pk_f16_fp4(X, 1.0f, B)), a2_, y[K])
#define V_STEP(d, CNT, ISSUE, W, A) do { asm volatile("s_waitcnt vmcnt(" #CNT ")" : "+v"(vb[d]) :: "memory"); \
        { const v4u x_ = vb[d]; const h2 a2_ = __builtin_bit_cast(h2, __builtin_amdgcn_cvt_pkrtz(A, A)); \
          V_F4(0, x_.x, 0); V_F4(1, x_.x, 1); V_F4(2, x_.x, 2); V_F4(3, x_.x, 3); V_F4(4, x_.y, 0); V_F4(5, x_.y, 1); V_F4(6, x_.y, 2); V_F4(7, x_.y, 3); \
          V_F4(8, x_.z, 0); V_F4(9, x_.z, 1); V_F4(10, x_.z, 2); V_F4(11, x_.z, 3); V_F4(12, x_.w, 0); V_F4(13, x_.w, 1); V_F4(14, x_.w, 2); V_F4(15, x_.w, 3); } \
        if (ISSUE) HROW_ISSUE(vb[d], P.V8, W); } while (0)
#define V_CHUNK(i0, B, WA, WB, C0, C1, C2, C3, C4, C5, C6, C7, ISSUE) do { const f32x4 aa_ = *(const LAS f32x4*)(sgt + (i0)), ab_ = *(const LAS f32x4*)(sgt + (i0) + 4); \
        V_STEP(B + 0, C0, ISSUE, WA.x, aa_[0]); V_STEP(B + 1, C1, ISSUE, WA.y, aa_[1]); V_STEP(B + 2, C2, ISSUE, WA.z, aa_[2]); V_STEP(B + 3, C3, ISSUE, WA.w, aa_[3]); \
        V_STEP(B + 4, C4, ISSUE, WB.x, ab_[0]); V_STEP(B + 5, C5, ISSUE, WB.y, ab_[1]); V_STEP(B + 6, C6, ISSUE, WB.z, ab_[2]); V_STEP(B + 7, C7, ISSUE, WB.w, ab_[3]); } while (0)
                {
                    const v4u w0 = *(const LAS v4u*)(swt), w1 = *(const LAS v4u*)(swt + 4), w2 = *(const LAS v4u*)(swt + 8), w3 = *(const LAS v4u*)(swt + 12);
                    HROW_ISSUE(vb[0], P.V8, w0.x); HROW_ISSUE(vb[1], P.V8, w0.y); HROW_ISSUE(vb[2], P.V8, w0.z); HROW_ISSUE(vb[3], P.V8, w0.w);
                    HROW_ISSUE(vb[4], P.V8, w1.x); HROW_ISSUE(vb[5], P.V8, w1.y); HROW_ISSUE(vb[6], P.V8, w1.z); HROW_ISSUE(vb[7], P.V8, w1.w);
                    HROW_ISSUE(vb[8], P.V8, w2.x); HROW_ISSUE(vb[9], P.V8, w2.y); HROW_ISSUE(vb[10], P.V8, w2.z); HROW_ISSUE(vb[11], P.V8, w2.w);
                    HROW_ISSUE(vb[12], P.V8, w3.x); HROW_ISSUE(vb[13], P.V8, w3.y); HROW_ISSUE(vb[14], P.V8, w3.z); HROW_ISSUE(vb[15], P.V8, w3.w);
                }
                v4u wa = *(const LAS v4u*)(swt + 16), wb = *(const LAS v4u*)(swt + 20);
#if X_PREFETCH
                {
                    const float* xp_ = P.out + (t0 + gq * 4 + tk) * 1024 + 32 * l5;
                    asm volatile("global_load_dwordx4 %0, %8, off\n\tglobal_load_dwordx4 %1, %8, off offset:16\n\tglobal_load_dwordx4 %2, %8, off offset:32\n\tglobal_load_dwordx4 %3, %8, off offset:48\n\t"
                                 "global_load_dwordx4 %4, %8, off offset:64\n\tglobal_load_dwordx4 %5, %8, off offset:80\n\tglobal_load_dwordx4 %6, %8, off offset:96\n\tglobal_load_dwordx4 %7, %8, off offset:112"
                                 : "=&v"(xq[0]), "=&v"(xq[1]), "=&v"(xq[2]), "=&v"(xq[3]), "=&v"(xq[4]), "=&v"(xq[5]), "=&v"(xq[6]), "=&v"(xq[7]) : "v"(xp_) : "memory");
                    const v4u wc = *(const LAS v4u*)(swt + 24), wd = *(const LAS v4u*)(swt + 28);
                    V_CHUNK(0, 0, wa, wb, 23, 23, 23, 23, 23, 23, 23, 23, 1);
                    wa = *(const LAS v4u*)(swt + 32); wb = *(const LAS v4u*)(swt + 36);
                    V_CHUNK(8, 8, wc, wd, 23, 23, 23, 23, 23, 23, 23, 23, 1);
                }
#pragma unroll 1
                for (int i0 = 16; i0 < 112; i0 += 16) {
#else
#pragma unroll 1
                for (int i0 = 0; i0 < 112; i0 += 16) {
#endif
                    const v4u wc = *(const LAS v4u*)(swt + i0 + 24), wd = *(const LAS v4u*)(swt + i0 + 28);
                    V_CHUNK(i0, 0, wa, wb, 15, 15, 15, 15, 15, 15, 15, 15, 1);
                    wa = *(const LAS v4u*)(swt + i0 + 32); wb = *(const LAS v4u*)(swt + i0 + 36);
                    V_CHUNK(i0 + 8, 8, wc, wd, 15, 15, 15, 15, 15, 15, 15, 15, 1);
                }
                V_CHUNK(112, 0, wa, wb, 15, 14, 13, 12, 11, 10, 9, 8, 0);
                V_CHUNK(120, 8, wa, wb, 7, 6, 5, 4, 3, 2, 1, 0, 0);
                }
#undef V_CHUNK
#undef V_STEP
#undef V_F4
            }
            {
                float* xr = P.out + (t0 + gq * 4 + tk) * 1024 + 32 * l5;
                f32x4 x[8]; float ss = 0.f;
#pragma unroll
                for (int m = 0; m < 8; ++m) {
#if X_PREFETCH
                    asm volatile("" : "+v"(xq[m])); x[m] = xq[m];
#elif X1_BF16
                    { const v2u q = *((const v2u*)(P.X1B + (t0 + gq * 4 + tk) * 1024 + 32 * l5) + m); x[m][0] = bflo(q.x); x[m][1] = bfhi(q.x); x[m][2] = bflo(q.y); x[m][3] = bfhi(q.y); }
#else
                    x[m] = *(const f32x4*)(xr + 4 * m);
#endif
                    x[m][0] += (float)y[2 * m][0] * (1.0f / 128.0f); x[m][1] += (float)y[2 * m][1] * (1.0f / 128.0f); x[m][2] += (float)y[2 * m + 1][0] * (1.0f / 128.0f); x[m][3] += (float)y[2 * m + 1][1] * (1.0f / 128.0f);
                    ss += (x[m][0] * x[m][0] + x[m][1] * x[m][1]) + (x[m][2] * x[m][2] + x[m][3] * x[m][3]); }
                ss = row16_sum(ss);
                ss += __builtin_bit_cast(float, __builtin_amdgcn_ds_swizzle(__builtin_bit_cast(int, ss), 0x401F));
                const float rstd = 1.0f / sqrtf(ss * (1.0f / 1024.0f) + EPS);
#pragma unroll
                for (int m = 0; m < 8; ++m) { const f32x4 wv = *(const f32x4*)(P.fin_w + (32 * l5 + 4 * m)); *(f32x4*)(xr + 4 * m) = x[m] * rstd * wv; }
            }
        }
    }
}
#undef HROW_ISSUE
#endif

__device__ __forceinline__ void p7_peer(LAS unsigned char* lds, const Ptrs& P, int vcu, int G, int tid, int lane, int wave) {
    LAS bf16* k1l = (LAS bf16*)lds;
    LAS bf16* k2l = (LAS bf16*)(lds + 32768);
    LAS int* idxl = (LAS int*)(lds + 65536);
    LAS float* gatel = (LAS float*)(lds + 98304);
    for (int i = tid; i < 2048; i += 512) { const int n = i >> 4, c = i & 15, d = n * 16 + (c ^ (n & 15)); ((LAS v4u*)k1l)[d] = ((const v4u*)P.K1)[i]; ((LAS v4u*)k2l)[d] = ((const v4u*)P.K2)[i]; }
    __syncthreads();
    for (int unit = vcu; unit < M / 64; unit += G) {
#pragma unroll 1
        for (int st = 0; st < 4; ++st) {
            const bool late = P7_STAGGER ? (wave >= 4) : false;
            const bool is_topk = late ? (st < 2) : ((st & 1) == 0);
            const int g = late ? (st & 1) : (st >> 1);
            if (is_topk) peer_topk_unit_mfma(P, (const LAS unsigned char*)k1l, (const LAS unsigned char*)k2l, idxl, gatel, unit, lane, wave, g, g + 1);
#if GATHER_HALF
            else peer_gather_half(P, lds, unit, lane, wave, g, g + 1);
#else
            else peer_gather_sorted(P, lds, unit, lane, wave, g, g + 1);
#endif
        }
        __syncthreads();
    }
}

struct Args { const float* in[19]; float* out; unsigned char* ws; int ph_lo, ph_hi; };
__global__ void __launch_bounds__(NWAVES * 64, 2) mega_fwd(Args args) {
    extern __shared__ __attribute__((aligned(16))) unsigned char lds_raw[];
    LAS unsigned char* lds = (LAS unsigned char*)lds_raw;
    const int tid = threadIdx.x, lane = tid & 63, wave = __builtin_amdgcn_readfirstlane(tid >> 6);
    const int G = gridDim.x; const int bx = blockIdx.x; const int vcu = (G % 8 == 0) ? (bx % 8) * (G / 8) + bx / 8 : bx;
    unsigned char* ws = args.ws;
    Ptrs P;
    P.x = args.in[0]; P.mix_w = args.in[1]; P.w_in = args.in[2]; P.rel_bias = args.in[3]; P.sinks = args.in[4]; P.w_pa = args.in[5]; P.ln_w = args.in[6]; P.ln_b = args.in[7];
    P.w_s = args.in[8]; P.b_s = args.in[9]; P.w_pb = args.in[10]; P.w_out = args.in[11]; P.ffn_w = args.in[12]; P.w_q = args.in[13]; P.keys1 = args.in[14]; P.keys2 = args.in[15];
    P.pu = args.in[16]; P.pv = args.in[17]; P.fin_w = args.in[18]; P.out = args.out;
    P.WIN = (bf16*)(ws + WS_WIN); P.WPA = (bf16*)(ws + WS_WPA); P.WPB = (bf16*)(ws + WS_WPB); P.WOUT = (bf16*)(ws + WS_WOUT); P.WQ = (bf16*)(ws + WS_WQ);
    P.K1 = (bf16*)(ws + WS_K1); P.K2 = (bf16*)(ws + WS_K2); P.WS = (bf16*)(ws + WS_WS); P.U = (bf16*)(ws + WS_U); P.V = (bf16*)(ws + WS_V);
    P.U8 = ws + WS_U; P.V8 = ws + WS_U + 16 * MiB; P.USC = (float*)(ws + WS_V); P.VSC = (float*)(ws + WS_V + 65536); P.HN8 = ws + WS_HN8; P.HSC = (float*)(ws + WS_HSC); P.rowss = (float*)(ws + WS_HN8); P.rowamax = (unsigned*)(ws + WS_HN8 + 2 * MiB);
    P.XN = (bf16*)(ws + WS_R1); P.AOUT = (bf16*)(ws + WS_R1); P.BOUT = P3_FUSED ? (bf16*)(ws + WS_R1) + 512 : (bf16*)(ws + WS_R1 + 16 * MiB); P.HN2 = X1_BF16 ? (bf16*)(ws + WS_MERGED) : (bf16*)(ws + WS_R1); P.X1B = (bf16*)(ws + WS_R1);
    P.Q = (bf16*)(ws + WS_Q); P.KV = (bf16*)(ws + WS_KV); P.GU = (bf16*)(ws + WS_GU); P.GV = (bf16*)(ws + WS_GV); P.GA = (bf16*)(ws + WS_GA); P.GB = (bf16*)(ws + WS_GB);
    P.MERGED = (bf16*)(ws + WS_MERGED); P.QP = (bf16*)(ws + WS_QP);

    for (int u = tid; u < (LDS_BYTES - MISC_OFF) / 4; u += NWAVES * 64) ((LAS unsigned*)(lds + MISC_OFF))[u] = 0u;
    __syncthreads();
    const int lo = args.ph_lo, hi = args.ph_hi;
    unsigned* barw = (unsigned*)(ws + WS_CTL) + CW_BAR;
    XcdBarrier bar; bar.bar = barw; bar.x = 0; bar.st = nullptr;
    if (hi - lo > 1) bar = xcd_barrier_post(barw, (volatile LAS unsigned*)(lds + MISC_OFF));
#define IN(k) (lo <= (k) && (k) < hi)
#define BOTH(k) (IN(k) && IN((k) + 1))
#define GRID_BAR() do { xcd_barrier(bar); if (PROBE_BAR2) xcd_barrier(bar); } while (0)
#define REPS(k) ((k) == PROBE_PHASE ? 2 : 1)

    if (IN(0)) {
#pragma unroll
        for (int rep = 0; rep < REPS(0); ++rep) { p0_prologue(lds, P, vcu, G, lane, wave); __syncthreads(); }
        if (BOTH(0)) GRID_BAR(); }

    if (IN(1)) {
        pg8::Gemm g{P.XN, P.WIN, M, NZ, D}; pg8::StaticOrder S; S.init(M, NZ, G, bx);
        pg8::EpiZ E{P.Q, P.KV, P.GU, P.GV, P.GA, P.GB};
#pragma unroll
        for (int rep = 0; rep < REPS(1); ++rep) pg8::gemm_phase<pg8::EpiZ, pg8::StaticOrder, PG8_ALIGN, PG8_SP2>(lds, g, S, E);
        if (BOTH(1)) GRID_BAR();
    }

    if (IN(2)) {
        for (int rep = 0; rep < REPS(2); ++rep) {
#if ATTN_MFMA
        p2_attn_mfma(lds, P, vcu, G, tid, lane, wave);
#else
        p2_attn_naive(lds, P, vcu, G, tid, lane, wave);
#endif
#if GMLP_MFMA
        p2_gmlp_mfma(lds, P, vcu, G, tid, lane, wave);
#else
        p2_gmlp_naive(lds, P, vcu, G, tid, lane, wave);
#endif
        }
        if (BOTH(2)) GRID_BAR();
    }

    if (IN(3)) {
#pragma unroll
      for (int rep = 0; rep < REPS(3); ++rep) {
#if P3_FUSED
        { pg8::Gemm g{P.AOUT, P.WPA, M, D, 1024}; pg8::StaticOrder S; S.init(M, D, G, bx);
          pg8::EpiMerge2 E{P.GA, P.GB, P.MERGED};
          pg8::gemm_phase<pg8::EpiMerge2, pg8::StaticOrder, PG8_ALIGN, PG8_SP2>(lds, g, S, E); }
#else
        { pg8::Gemm g{P.AOUT, P.WPA, M, D, 512}; pg8::StaticOrder S; S.init(M, D, G, bx);
          pg8::EpiGateTmp E{P.GA, P.out};
          pg8::gemm_phase<pg8::EpiGateTmp, pg8::StaticOrder, PG8_ALIGN, PG8_SP2>(lds, g, S, E); }
        { pg8::Gemm g{P.BOUT, P.WPB, M, D, 512}; pg8::StaticOrder S; S.init(M, D, G, bx);
          pg8::EpiMerge E{P.GB, P.out, P.MERGED};
          pg8::gemm_phase<pg8::EpiMerge, pg8::StaticOrder, PG8_ALIGN, PG8_SP2>(lds, g, S, E); }
#endif
      }
        if (BOTH(3)) GRID_BAR();
    }

    if (IN(4)) {
        pg8::Gemm g{P.MERGED, P.WOUT, M, D, D}; pg8::StaticOrder S; S.init(M, D, G, bx);
#if P5_ELIM
        pg8::EpiResStats E{P.x, P.out, P.HN2, P.ffn_w, P.rowss, P.rowamax};
        pg8::gemm_phase<pg8::EpiResStats, pg8::StaticOrder, PG8_ALIGN, PG8_SP2>(lds, g, S, E);
#else
#if X1_BF16
        pg8::EpiResB E{P.x, (pg8::bf16_t*)P.X1B};
#pragma unroll
        for (int rep = 0; rep < REPS(4); ++rep) pg8::gemm_phase<pg8::EpiResB, pg8::StaticOrder, PG8_ALIGN, PG8_SP2>(lds, g, S, E);
#else
        pg8::EpiRes E{P.x, P.out};
#pragma unroll
        for (int rep = 0; rep < REPS(4); ++rep) pg8::gemm_phase<pg8::EpiRes, pg8::StaticOrder, PG8_ALIGN, PG8_SP2>(lds, g, S, E);
#endif
#endif
        if (BOTH(4)) GRID_BAR();
    }

    if (IN(5) && !P5_ELIM) {
        const int gw = vcu * NWAVES + wave, NGW = G * NWAVES;
#pragma unroll
        for (int rep = 0; rep < REPS(5); ++rep)
        for (int m = gw; m < M; m += NGW) rms_row_to_bf16_fp8(X1_BF16 ? (const float*)(P.X1B + (size_t)m * D) : P.out + (size_t)m * D, P.ffn_w, P.HN2 + (size_t)m * D, P.HN8 + (size_t)m * D, P.HSC + m, lane);
        if (BOTH(5)) GRID_BAR();
    }

    if (IN(6)) {
        pg8::Gemm g{P.HN2, P.WQ, M, 2048, D}; pg8::StaticOrder S; S.init(M, 2048, G, bx);
#if P5_ELIM
        pg8::EpiPlainRstd E{P.QP, 2048, P.rowss};
#pragma unroll
        for (int rep = 0; rep < REPS(6); ++rep) pg8::gemm_phase<pg8::EpiPlainRstd, pg8::StaticOrder, PG8_ALIGN, PG8_SP2>(lds, g, S, E);
#else
        pg8::EpiPlain E{P.QP, 2048};
#pragma unroll
        for (int rep = 0; rep < REPS(6); ++rep) pg8::gemm_phase<pg8::EpiPlain, pg8::StaticOrder, PG8_ALIGN, PG8_SP2>(lds, g, S, E);
#endif
        if (BOTH(6)) GRID_BAR();
    }

    if (IN(7)) p7_peer(lds, P, vcu, G, tid, lane, wave);
#undef IN
#undef BOTH
#undef GRID_BAR
}

extern "C" void kernel_launch(void* const* d_in, const int* in_sizes, int n_in, void* d_out, int out_size, void* d_ws, size_t ws_size, hipStream_t stream) {
    static int grid = 0;
    if (grid == 0) {
        if (n_in != 19 || out_size != M * D || ws_size < WS_END) { fprintf(stderr, "kernel_launch: unexpected shapes (n_in %d, out %d, ws %zu)\n", n_in, out_size, ws_size); grid = -1; return; }
        int dev = 0, cus = 0, per_cu = 0;
        if (hipGetDevice(&dev) != hipSuccess || hipDeviceGetAttribute(&cus, hipDeviceAttributeMultiprocessorCount, dev) != hipSuccess) { grid = -1; return; }
        if (hipFuncSetAttribute((const void*)mega_fwd, hipFuncAttributeMaxDynamicSharedMemorySize, LDS_BYTES) != hipSuccess) { fprintf(stderr, "kernel_launch: hipFuncSetAttribute failed\n"); grid = -1; return; }
        if (hipOccupancyMaxActiveBlocksPerMultiprocessor(&per_cu, (const void*)mega_fwd, NWAVES * 64, LDS_BYTES) != hipSuccess || per_cu < 1)
            fprintf(stderr, "kernel_launch: note: occupancy query reports %d workgroups per CU\n", per_cu);
        (void)hipGetLastError();
        grid = cus;
    }
    if (grid < 0) return;
    if (hipMemsetAsync((char*)d_ws + WS_CTL, 0, CTL_ZERO_BYTES, stream) != hipSuccess) return;
    Args a{};
    for (int i = 0; i < 19; ++i) a.in[i] = (const float*)d_in[i];
    a.out = (float*)d_out; a.ws = (unsigned char*)d_ws;
#if MK_N_LAUNCHES == 1
    a.ph_lo = 0; a.ph_hi = N_PHASES;
    hipLaunchKernelGGL(mega_fwd, dim3(grid), dim3(NWAVES * 64), LDS_BYTES, stream, a);
#else
    for (int li = 0; li < N_PHASES; ++li) { a.ph_lo = li; a.ph_hi = li + 1; hipLaunchKernelGGL(mega_fwd, dim3(grid), dim3(NWAVES * 64), LDS_BYTES, stream, a); }
#endif
}
```

```cpp
#include <hip/hip_runtime.h>
#include <cstdio>
#include <cstdint>
#ifndef PROBE_SWEEPS
#define PROBE_SWEEPS 1
#endif
#ifndef PROBE_PHASE
#define PROBE_PHASE -1
#endif
#ifndef FP4_SELFCHECK
#define FP4_SELFCHECK 0
#endif
#ifndef NSL
#define NSL 8
#endif
#ifndef Q4_USTEP
#define Q4_USTEP 0.36f
#endif
#ifndef Q4_VUNIT
#define Q4_VUNIT 0.5f
#endif
namespace pg8 {
#define PG8_LAS __attribute__((address_space(3)))
typedef unsigned short bf16_t;
typedef short bf16x8 __attribute__((ext_vector_type(8)));
typedef float f32x4 __attribute__((ext_vector_type(4)));
typedef unsigned u32x4 __attribute__((ext_vector_type(4)));
constexpr int BM = 256, BK = 64, HALF = 128, HTB = HALF * BK * 2  , STAGE_BYTES = 8 * HTB, NXCD = 8, WGM = 8;

__host__ __device__ __forceinline__ int lds_byte(int r, int c) { const int st = (r >> 4) * 2 + (c >> 5), rr = r & 15, cc = c & 31, ob = rr * 64 + cc * 2; return st * 1024 + (ob ^ (((ob >> 9) & 1) << 5)); }
__host__ __device__ __forceinline__ void stage_rc(int b, int& R, int& C) { const int st = b / 1024, sb = b % 1024, swz = sb ^ (((sb >> 9) & 1) << 5); R = (st >> 1) * 16 + swz / 64; C = (st & 1) * 32 + (swz % 64) / 2; }
__host__ __device__ __forceinline__ int perm32(int rho) { const int n = rho >> 4, i = rho & 15; return 8 * (i >> 2) + 4 * n + (i & 3); }

struct Unit { int pm, pn; };
struct Gemm { const bf16_t* A; const bf16_t* Bt; int M, N, K; };

struct StaticOrder {
    int nM, nN, nwg, G, c;
    __host__ __device__ void init(int M, int N, int G_, int c_) { nM = M / BM; nN = N / BM; nwg = nM * nN; G = G_; c = c_; }
    __host__ __device__ bool next(int i, Unit& u) const {
        const long L = (long)i * G + c; if (L >= nwg) return false;
        int wgid = (int)L; { const int q = nwg / NXCD, r = nwg % NXCD, xcd = wgid % NXCD, off = wgid / NXCD; wgid = (xcd < r ? xcd * (q + 1) : r * (q + 1) + (xcd - r) * q) + off; }
        const int nig = WGM * nN, gid = wgid / nig, fm = gid * WGM, gsz = (nM - fm) < WGM ? (nM - fm) : WGM;
        u.pm = fm + ((wgid % nig) % gsz); u.pn = (wgid % nig) / gsz; return true;
    }
    __device__ __forceinline__ void a_ready(const Unit&) const {}
    __device__ __forceinline__ void done(const Unit&) const {}
};

__device__ __forceinline__ unsigned cvt_pk_bf16(float lo, float hi) { unsigned r; asm volatile("v_cvt_pk_bf16_f32 %0, %1, %2" : "=v"(r) : "v"(lo), "v"(hi)); return r; }
typedef float f32x2 __attribute__((ext_vector_type(2)));
template <class Epi, class Sched, bool ALIGN_EPI = false, bool SP2 = false>
__device__ __forceinline__ void gemm_phase(PG8_LAS unsigned char* lds, const Gemm g, const Sched& S, const Epi& E) {
    const int tid = threadIdx.x, wid = __builtin_amdgcn_readfirstlane(tid >> 6), lane = tid & 63, wr = wid >> 2, wc = wid & 3, fr = lane & 15, fq = lane >> 4;
    const int K = g.K, nt = K / BK;
    unsigned voffA[2], voffB[2];
#pragma unroll
    for (int i = 0; i < 2; ++i) { int R, C; stage_rc(tid * 16 + i * 8192, R, C); const int Rb = Epi::PERM ? ((R & ~31) + perm32(R & 31)) : R;
        voffA[i] = (unsigned)(R * K + C) * 2u; voffB[i] = (unsigned)(Rb * K + C) * 2u; }
    const size_t kstep = (size_t)(BK * 2);
    const size_t hstep = (size_t)HALF * K * 2;
    const size_t tstep = 2 * hstep;
    const unsigned ldsw = (unsigned)wid * 1024u;
    const int aoff = lds_byte(wr * 64 + fr, fq * 8), boff = lds_byte(wc * 32 + fr, fq * 8);
#define PG8_SA(b, h) (((b) * 2 + (h)) * HTB)
#define PG8_SB(b, h) ((4 + (b) * 2 + (h)) * HTB)
#define PG8_STAGE(bufoff, gbase, voff) do { _Pragma("unroll") for (int _i = 0; _i < 2; ++_i) \
        __builtin_amdgcn_global_load_lds((const unsigned*)((const char*)(gbase) + (voff)[_i]), (PG8_LAS unsigned*)(lds + (bufoff) + ldsw + _i * 8192), 16, 0, 0); } while (0)
#define PG8_LDA(dst, b, h) do { _Pragma("unroll") for (int m = 0; m < 4; ++m) _Pragma("unroll") for (int k = 0; k < 2; ++k) dst[m][k] = *(const PG8_LAS bf16x8*)(lds + PG8_SA(b, h) + aoff + m * 2048 + k * 1024); } while (0)
#define PG8_LDB(dst, b, h) do { _Pragma("unroll") for (int n = 0; n < 2; ++n) _Pragma("unroll") for (int k = 0; k < 2; ++k) dst[n][k] = *(const PG8_LAS bf16x8*)(lds + PG8_SB(b, h) + boff + n * 2048 + k * 1024); } while (0)
#define PG8_MMA(ai, bj, At, Bt) do { __builtin_amdgcn_s_setprio(1); _Pragma("unroll") for (int m = 0; m < 4; ++m) _Pragma("unroll") for (int n = 0; n < 2; ++n) _Pragma("unroll") for (int k = 0; k < 2; ++k) \
        acc[ai][bj][m][n] = __builtin_amdgcn_mfma_f32_16x16x32_bf16(Bt[n][k], At[m][k], acc[ai][bj][m][n], 0, 0, 0); __builtin_amdgcn_s_setprio(0); } while (0)
#define PG8_WAIT_V(n) asm volatile("s_waitcnt vmcnt(" #n ")" ::: "memory")
#define PG8_WAIT_L(n) asm volatile("s_waitcnt lgkmcnt(" #n ")" ::: "memory")
#define PG8_BAR __builtin_amdgcn_s_barrier()
#define PG8_SCHED __builtin_amdgcn_sched_barrier(0)
    Unit cur, nxt; int ui = 0;
    if (!S.next(0, cur)) return;
    f32x4 acc[2][2][4][2];
#pragma unroll
    for (int a = 0; a < 2; ++a)
#pragma unroll
        for (int b = 0; b < 2; ++b)
#pragma unroll
            for (int m = 0; m < 4; ++m)
#pragma unroll
                for (int n = 0; n < 2; ++n) acc[a][b][m][n] = (f32x4){0.f, 0.f, 0.f, 0.f};
    bf16x8 At[4][2], B0[2][2], B1[2][2];
    const char* cA = (const char*)g.A + (size_t)cur.pm * tstep; const char* cB = (const char*)g.Bt + (size_t)cur.pn * tstep;
    S.a_ready(cur);
    if constexpr (SP2) {
        PG8_STAGE(PG8_SB(0, 0), cB, voffB); PG8_STAGE(PG8_SB(0, 1), cB + hstep, voffB); PG8_STAGE(PG8_SA(0, 0), cA, voffA); PG8_STAGE(PG8_SA(0, 1), cA + hstep, voffA);
        if (wr == 1) PG8_BAR;
        PG8_WAIT_V(2); PG8_BAR;
        PG8_STAGE(PG8_SB(1, 0), cB + kstep, voffB); PG8_STAGE(PG8_SA(1, 0), cA + kstep, voffA); PG8_STAGE(PG8_SB(1, 1), cB + hstep + kstep, voffB);
        PG8_WAIT_V(6); PG8_BAR;
    } else {
        PG8_STAGE(PG8_SB(0, 0), cB, voffB); PG8_STAGE(PG8_SA(0, 0), cA, voffA); PG8_STAGE(PG8_SB(0, 1), cB + hstep, voffB); PG8_STAGE(PG8_SA(0, 1), cA + hstep, voffA);
        if (wr == 1) PG8_BAR;
        PG8_WAIT_V(4); PG8_BAR;
        PG8_STAGE(PG8_SB(1, 0), cB + kstep, voffB); PG8_STAGE(PG8_SA(1, 0), cA + kstep, voffA); PG8_STAGE(PG8_SB(1, 1), cB + hstep + kstep, voffB);
        PG8_WAIT_V(6); PG8_BAR;
    }
    for (;;) {
        const bool has_next = S.next(ui + 1, nxt);
        const char* nA = has_next ? (const char*)g.A + (size_t)nxt.pm * tstep : cA; const char* nB = has_next ? (const char*)g.Bt + (size_t)nxt.pn * tstep : cB;
        for (int t = 0; t < nt; t += 2) {
            if constexpr (Epi::HAS_MID) { if (t == (nt >> 1)) E.mid(acc, cur, wr, wc, fr, fq); }
            const bool last = (t == nt - 2);
            const char* a1 = cA + (size_t)(t + 1) * kstep;
            const char* a2 = last ? nA : cA + (size_t)(t + 2) * kstep; const char* b2 = last ? nB : cB + (size_t)(t + 2) * kstep;
            const char* a3 = a2 + kstep; const char* b3 = b2 + kstep;
            if (last && has_next) S.a_ready(nxt);
            if constexpr (SP2) {
            PG8_LDB(B0, 0, 0); PG8_LDB(B1, 0, 1); PG8_SCHED; PG8_LDA(At, 0, 0); PG8_STAGE(PG8_SA(1, 1), a1 + hstep, voffA);
            PG8_WAIT_V(8); PG8_WAIT_L(0); PG8_BAR; PG8_MMA(0, 0, At, B0); PG8_MMA(0, 1, At, B1); PG8_BAR; PG8_SCHED;
            PG8_LDA(At, 0, 1); PG8_STAGE(PG8_SB(0, 0), b2, voffB); PG8_STAGE(PG8_SB(0, 1), b2 + hstep, voffB); PG8_STAGE(PG8_SA(0, 0), a2, voffA);
            PG8_WAIT_V(8); PG8_WAIT_L(0); PG8_BAR; PG8_MMA(1, 0, At, B0); PG8_MMA(1, 1, At, B1); PG8_BAR; PG8_SCHED;
            PG8_LDB(B0, 1, 0); PG8_LDB(B1, 1, 1); PG8_SCHED; PG8_LDA(At, 1, 0); PG8_STAGE(PG8_SA(0, 1), a2 + hstep, voffA);
            PG8_WAIT_V(8); PG8_WAIT_L(0); PG8_BAR; PG8_MMA(0, 0, At, B0); PG8_MMA(0, 1, At, B1); PG8_BAR; PG8_SCHED;
            PG8_LDA(At, 1, 1); PG8_STAGE(PG8_SB(1, 0), b3, voffB); PG8_STAGE(PG8_SB(1, 1), b3 + hstep, voffB); PG8_STAGE(PG8_SA(1, 0), a3, voffA);
            PG8_WAIT_V(8); PG8_WAIT_L(0); PG8_BAR; PG8_MMA(1, 0, At, B0); PG8_MMA(1, 1, At, B1); PG8_BAR; PG8_SCHED;
            } else {
            PG8_LDB(B0, 0, 0); PG8_SCHED; PG8_LDA(At, 0, 0); PG8_STAGE(PG8_SA(1, 1), a1 + hstep, voffA);
            PG8_WAIT_L(8); PG8_BAR; PG8_WAIT_L(0); PG8_MMA(0, 0, At, B0); PG8_BAR; PG8_SCHED;
            PG8_LDB(B1, 0, 1); PG8_STAGE(PG8_SB(0, 0), b2, voffB);
            PG8_BAR; PG8_WAIT_L(0); PG8_MMA(0, 1, At, B1); PG8_BAR;
            PG8_LDA(At, 0, 1); PG8_STAGE(PG8_SA(0, 0), a2, voffA);
            PG8_BAR; PG8_WAIT_L(0); PG8_MMA(1, 0, At, B0); PG8_BAR; PG8_SCHED;
            PG8_STAGE(PG8_SB(0, 1), b2 + hstep, voffB);
            PG8_WAIT_V(6); PG8_BAR; PG8_MMA(1, 1, At, B1); PG8_BAR;
            PG8_LDB(B0, 1, 0); PG8_SCHED; PG8_LDA(At, 1, 0); PG8_STAGE(PG8_SA(0, 1), a2 + hstep, voffA);
            PG8_WAIT_L(8); PG8_BAR; PG8_WAIT_L(0); PG8_MMA(0, 0, At, B0); PG8_BAR; PG8_SCHED;
            PG8_LDB(B1, 1, 1); PG8_STAGE(PG8_SB(1, 0), b3, voffB);
            PG8_BAR; PG8_WAIT_L(0); PG8_MMA(0, 1, At, B1); PG8_BAR;
            PG8_LDA(At, 1, 1); PG8_STAGE(PG8_SA(1, 0), a3, voffA);
            PG8_BAR; PG8_WAIT_L(0); PG8_MMA(1, 0, At, B0); PG8_BAR; PG8_SCHED;
            PG8_STAGE(PG8_SB(1, 1), b3 + hstep, voffB);
            PG8_WAIT_V(6); PG8_BAR; PG8_MMA(1, 1, At, B1); PG8_BAR;
            }
        }
        if constexpr (ALIGN_EPI) { if (wr == 0) PG8_BAR; }
        if constexpr (!Epi::AFTER_DRAIN) { E(acc, cur, wr, wc, fr, fq); S.done(cur); }
        if (!has_next) break;
#pragma unroll
        for (int a = 0; a < 2; ++a)
#pragma unroll
            for (int b = 0; b < 2; ++b)
#pragma unroll
                for (int m = 0; m < 4; ++m)
#pragma unroll
                    for (int n = 0; n < 2; ++n) acc[a][b][m][n] = (f32x4){0.f, 0.f, 0.f, 0.f};
        cur = nxt; cA = nA; cB = nB; ++ui;
        if constexpr (ALIGN_EPI) { if (wr == 1) PG8_BAR; }
    }
    PG8_WAIT_V(0);
    if constexpr (!ALIGN_EPI) { if (wr == 0) PG8_BAR; }
    PG8_BAR;
    if constexpr (Epi::AFTER_DRAIN) { E.fused(acc, cur, wr, wc, fr, fq, lds, wid, lane); S.done(cur); }
#undef PG8_SA
#undef PG8_SB
#undef PG8_STAGE
#undef PG8_LDA
#undef PG8_LDB
#undef PG8_MMA
#undef PG8_WAIT_V
#undef PG8_WAIT_L
#undef PG8_BAR
#undef PG8_SCHED
}
}
#ifndef PG8_SP2
#define PG8_SP2 true
#endif
#ifndef PG8_ALIGN
#define PG8_ALIGN true
#endif

constexpr int NWAVES = 8;
constexpr int N_PHASES = 8;
#define SLSH (NSL == 4 ? 12 : NSL == 2 ? 13 : NSL == 64 ? 8 : NSL == 32 ? 9 : NSL == 16 ? 10 : 11)

constexpr int NB = 2, SEQ = 8192, D = 1024, M = NB * SEQ;
constexpr int NZ = 3840;
constexpr float EPS = 1e-6f;
constexpr int AB_LD = 512;

constexpr size_t MiB = 1u << 20;
constexpr size_t WS_CTL = 0, CTL_ZERO_BYTES = 65536;
constexpr size_t WS_WIN = 1 * MiB;
constexpr size_t WS_WPA = 9 * MiB;
constexpr size_t WS_WPB = 10 * MiB;
constexpr size_t WS_WOUT = 11 * MiB;
constexpr size_t WS_WQ = 13 * MiB;
constexpr size_t WS_K1 = 17 * MiB;
constexpr size_t WS_K2 = 17 * MiB + 32768;
constexpr size_t WS_WS = 17 * MiB + 65536;
constexpr size_t WS_U = 18 * MiB;
constexpr size_t WS_V = 50 * MiB;
constexpr size_t WS_R1 = 82 * MiB;
constexpr size_t WS_Q = 114 * MiB;
constexpr size_t WS_KV = 130 * MiB;
constexpr size_t WS_GU = 138 * MiB;
constexpr size_t WS_GV = 154 * MiB;
constexpr size_t WS_GA = 170 * MiB;
constexpr size_t WS_GB = 202 * MiB;
constexpr size_t WS_MERGED = 114 * MiB;
constexpr size_t WS_QP = 170 * MiB;
constexpr size_t WS_HN8 = 146 * MiB;
constexpr size_t WS_HSC = 162 * MiB;
constexpr size_t WS_END = 234 * MiB;
constexpr int CW_BAR = 0;

constexpr int RING_BYTES = 131072;
constexpr int MISC_OFF = 143360;
constexpr int LDS_BYTES = 147456;

#define GAS __attribute__((address_space(1)))
#define LAS __attribute__((address_space(3)))
typedef unsigned short bf16;
typedef unsigned v4u __attribute__((ext_vector_type(4)));
typedef unsigned v2u __attribute__((ext_vector_type(2)));
typedef float f32x4 __attribute__((ext_vector_type(4)));
typedef _Float16 h2 __attribute__((ext_vector_type(2)));
typedef GAS unsigned gu32;
typedef __bf16 bf16x2_t __attribute__((ext_vector_type(2)));
#define RLX_AGENT __ATOMIC_RELAXED, __HIP_MEMORY_SCOPE_AGENT
#define LDS_WAIT() asm volatile("s_waitcnt lgkmcnt(0)" ::: "memory")
#define VM_WAIT() asm volatile("s_waitcnt vmcnt(0)" ::: "memory")
__device__ __forceinline__ unsigned f2bf(float f) { unsigned u = __builtin_bit_cast(unsigned, f); return (u + 0x7fffu + ((u >> 16) & 1u)) >> 16; }
__device__ __forceinline__ unsigned pk2(float lo, float hi) { return f2bf(lo) | (f2bf(hi) << 16); }
__device__ __forceinline__ float bflo(unsigned w) { return __builtin_bit_cast(float, w << 16); }
__device__ __forceinline__ float bfhi(unsigned w) { return __builtin_bit_cast(float, w & 0xffff0000u); }
__device__ __forceinline__ float bf2f(bf16 h) { return __builtin_bit_cast(float, (unsigned)h << 16); }
__device__ __forceinline__ float dot2bf(unsigned a, unsigned b, float c) { return __builtin_amdgcn_fdot2_f32_bf16(__builtin_bit_cast(bf16x2_t, a), __builtin_bit_cast(bf16x2_t, b), c, false); }
__device__ __forceinline__ float gelu_tanh(float v) {
    const float t2 = v * (-2.302208198f + (-0.1029432397f) * v * v);
    return v * __builtin_amdgcn_rcpf(1.0f + __builtin_amdgcn_exp2f(t2));
}
__device__ __forceinline__ float sigmoid_f(float v) { return __builtin_amdgcn_rcpf(1.0f + __builtin_amdgcn_exp2f(-1.4426950409f * v)); }
template <int CTRL> __device__ __forceinline__ float dppmov(float v) { return __builtin_bit_cast(float, __builtin_amdgcn_update_dpp(0, __builtin_bit_cast(int, v), CTRL, 0xF, 0xF, false)); }
__device__ __forceinline__ float row16_sum(float v) {
    v += dppmov<0xB1>(v);
    v += dppmov<0x4E>(v);
    v += dppmov<0x141>(v);
    v += dppmov<0x140>(v);
    return v;
}
__device__ __forceinline__ float xor32_f(float v) {
    const unsigned u = __builtin_bit_cast(unsigned, v);
    auto rr = __builtin_amdgcn_permlane32_swap(u, u, false, false);
    const unsigned r0 = rr[0], r1 = rr[1];
    return __builtin_bit_cast(float, (__lane_id() & 32) ? r0 : r1);
}
__device__ __forceinline__ float wave_sum(float v) {
    v = row16_sum(v);
    v += __builtin_bit_cast(float, __builtin_amdgcn_ds_swizzle(__builtin_bit_cast(int, v), 0x401F));
    const unsigned u = __builtin_bit_cast(unsigned, v);
    auto rr = __builtin_amdgcn_permlane32_swap(u, u, false, false);
    const unsigned r0 = rr[0], r1 = rr[1];
    return __builtin_bit_cast(float, r0) + __builtin_bit_cast(float, r1);
}
__device__ __forceinline__ float wave_max(float v) {
    v = fmaxf(v, dppmov<0xB1>(v)); v = fmaxf(v, dppmov<0x4E>(v)); v = fmaxf(v, dppmov<0x141>(v)); v = fmaxf(v, dppmov<0x140>(v));
    v = fmaxf(v, __builtin_bit_cast(float, __builtin_amdgcn_ds_swizzle(__builtin_bit_cast(int, v), 0x401F)));
    const unsigned u = __builtin_bit_cast(unsigned, v);
    auto rr = __builtin_amdgcn_permlane32_swap(u, u, false, false);
    const unsigned r0 = rr[0], r1 = rr[1];
    return fmaxf(__builtin_bit_cast(float, r0), __builtin_bit_cast(float, r1));
}
__device__ const unsigned char T5B[128] = {0, 1, 2, 3, 4, 5, 6, 7, 8, 9, 10, 11, 12, 13, 14, 15, 16, 16, 16, 17, 17, 18, 18, 18, 19, 19, 19, 20, 20, 20, 20, 21, 21, 21, 21, 22, 22, 22, 22, 22, 23, 23, 23, 23, 23, 23, 24, 24, 24, 24, 24, 24, 25, 25, 25, 25, 25, 25, 25, 26, 26, 26, 26, 26, 26, 26, 26, 27, 27, 27, 27, 27, 27, 27, 27, 27, 27, 28, 28, 28, 28, 28, 28, 28, 28, 28, 28, 29, 29, 29, 29, 29, 29, 29, 29, 29, 29, 29, 29, 30, 30, 30, 30, 30, 30, 30, 30, 30, 30, 30, 30, 30, 30, 31, 31, 31, 31, 31, 31, 31, 31, 31, 31, 31, 31, 31, 31, 31};
#define XB_TMO      128
#define XB_XCNT(j)  (256  + 64 * (j))
#define XB_XSUB(j)  (1280 + 64 * (j))
#define XB_XGEN(j)  (2304 + 64 * (j))
#define XB_TOP      3328
#define XB_TOPGEN   3392
#define XCD_BAR_WORDS 3456
#define XB_SPIN_CAP (1u << 18)

__device__ __forceinline__ unsigned xb_ld(unsigned* p)              { return __hip_atomic_load(p, __ATOMIC_RELAXED, __HIP_MEMORY_SCOPE_AGENT); }
__device__ __forceinline__ unsigned xb_add(unsigned* p, unsigned v) { return __hip_atomic_fetch_add(p, v, __ATOMIC_RELAXED, __HIP_MEMORY_SCOPE_AGENT); }
__device__ __forceinline__ unsigned xb_xcc_id() { return (unsigned)__builtin_amdgcn_s_getreg((3 << 11) | 20) & 0xFu; }
#define XB_SPIN(cond, bar) do { unsigned _sp = 0; while (cond) { __builtin_amdgcn_s_sleep(1); \
    if ((++_sp & 255u) == 0u) { if (xb_ld(&(bar)[XB_TMO])) break; if (_sp > XB_SPIN_CAP) { atomicAdd(&(bar)[XB_TMO], 1u); break; } } } } while (0)

struct XcdBarrier {
    unsigned* bar; unsigned x;
    volatile LAS unsigned* st;
};

__device__ __forceinline__ XcdBarrier xcd_barrier_post(unsigned* bar, volatile LAS unsigned* st) {
    XcdBarrier b; b.bar = bar; b.x = xb_xcc_id(); b.st = st;
    if (threadIdx.x == 0) (void)xb_add(&bar[XB_XCNT(b.x)], 1u);
    return b;
}
__device__ __forceinline__ void xcd_barrier_complete(unsigned* bar, unsigned x, unsigned& nloc, unsigned& nx) {
    const unsigned G = gridDim.x * gridDim.y * gridDim.z;
    unsigned sum, cnt, mine, sp = 0u;
    for (;;) {
        sum = 0u; cnt = 0u; mine = 0u;
#pragma unroll
        for (unsigned j = 0; j < 16; ++j) { const unsigned c = xb_ld(&bar[XB_XCNT(j)]); sum += c; cnt += (c > 0u) ? 1u : 0u; mine = (j == x) ? c : mine; }
        if (sum == G) break;
        __builtin_amdgcn_s_sleep(1);
        if ((++sp & 255u) == 0u) { if (xb_ld(&bar[XB_TMO])) break; if (sp > XB_SPIN_CAP) { atomicAdd(&bar[XB_TMO], 1u); break; } }
    }
    nloc = mine > 0u ? mine : 1u; nx = cnt > 0u ? cnt : 1u;
}

__device__ __forceinline__ void xcd_barrier(const XcdBarrier& b) {
    asm volatile("s_waitcnt vmcnt(0)" ::: "memory");
    __syncthreads();
    if (threadIdx.x == 0) {
        unsigned* bar = b.bar;
        __builtin_amdgcn_s_waitcnt(0);
        unsigned nloc = b.st[0], nx = b.st[1];
        if (nloc == 0u) { xcd_barrier_complete(bar, b.x, nloc, nx); b.st[0] = nloc; b.st[1] = nx; }
        const unsigned old = xb_add(&bar[XB_XSUB(b.x)], 1u);
        const unsigned gen = old / nloc;
        if (old + 1u == (gen + 1u) * nloc) {
            __builtin_amdgcn_fence(__ATOMIC_RELEASE, "agent");
            asm volatile("s_waitcnt vmcnt(0)" ::: "memory");
            const unsigned og = xb_add(&bar[XB_TOP], 1u);
            const unsigned tg = og / nx;
            if (og + 1u == (tg + 1u) * nx) xb_add(&bar[XB_TOPGEN], 1u);
            else XB_SPIN(xb_ld(&bar[XB_TOPGEN]) == tg, bar);
            __builtin_amdgcn_fence(__ATOMIC_ACQUIRE, "agent");
            xb_add(&bar[XB_XGEN(b.x)], 1u);
            asm volatile("s_waitcnt vmcnt(0)" ::: "memory");
        } else {
            XB_SPIN(xb_ld(&bar[XB_XGEN(b.x)]) == gen, bar);
            __builtin_amdgcn_fence(__ATOMIC_ACQUIRE, "agent");
            asm volatile("s_waitcnt vmcnt(0)" ::: "memory");
        }
    }
    __syncthreads();
}
#define ST16(PTR, VAL) (*(PTR) = (VAL))
namespace pg8 {
struct EpiZ {
    static constexpr bool PERM = true, AFTER_DRAIN = false, HAS_MID = false;
    bf16_t *Q, *KV, *GU, *GV, *GA, *GB;
    __device__ __forceinline__ void operator()(const f32x4 (&acc)[2][2][4][2], const Unit& u, int wr, int wc, int fr, int fq) const {
        const int pn = u.pn; bf16_t* base; int ldc, colt, act;
        if (pn < 2)       { base = Q;  ldc = 512;  colt = pn * 256;        act = 0; }
        else if (pn == 2) { base = KV; ldc = 256;  colt = 0;               act = 0; }
        else if (pn < 5)  { base = GU; ldc = 512;  colt = (pn - 3) * 256;  act = 1; }
        else if (pn < 7)  { base = GV; ldc = 512;  colt = (pn - 5) * 256;  act = 1; }
        else if (pn < 11) { base = GA; ldc = 1024; colt = (pn - 7) * 256;  act = 2; }
        else              { base = GB; ldc = 1024; colt = (pn - 11) * 256; act = 2; }
        const int row0 = u.pm * BM + wr * 64 + fr, col0 = colt + wc * 32 + 8 * fq;
#pragma unroll
        for (int ai = 0; ai < 2; ++ai)
#pragma unroll
            for (int m = 0; m < 4; ++m) { bf16_t* rowp = base + (size_t)(row0 + ai * HALF + m * 16) * ldc + col0;
#pragma unroll
                for (int bj = 0; bj < 2; ++bj) { f32x4 v0 = acc[ai][bj][m][0], v1 = acc[ai][bj][m][1];
                    if (act == 1) {
#pragma unroll
                        for (int e = 0; e < 4; ++e) { v0[e] = gelu_tanh(v0[e]); v1[e] = gelu_tanh(v1[e]); }
                    } else if (act == 2) {
#pragma unroll
                        for (int e = 0; e < 4; ++e) { v0[e] = sigmoid_f(v0[e]); v1[e] = sigmoid_f(v1[e]); }
                    }
                    u32x4 w; w.x = cvt_pk_bf16(v0[0], v0[1]); w.y = cvt_pk_bf16(v0[2], v0[3]); w.z = cvt_pk_bf16(v1[0], v1[1]); w.w = cvt_pk_bf16(v1[2], v1[3]);
                    ST16((u32x4*)(rowp + bj * HALF), w); } }
    }
};
struct EpiGateTmp {
    static constexpr bool PERM = true, AFTER_DRAIN = false, HAS_MID = false;
    const bf16_t* gate; bf16_t* tmp;
    __device__ __forceinline__ void operator()(const f32x4 (&acc)[2][2][4][2], const Unit& u, int wr, int wc, int fr, int fq) const {
        const int row0 = u.pm * BM + wr * 64 + fr, col0 = u.pn * BM + wc * 32 + 8 * fq;
#pragma unroll
        for (int ai = 0; ai < 2; ++ai)
#pragma unroll
            for (int m = 0; m < 4; ++m) { const size_t ro = (size_t)(row0 + ai * HALF + m * 16) * 1024 + col0;
#pragma unroll
                for (int bj = 0; bj < 2; ++bj) { const u32x4 g = *(const u32x4*)(gate + ro + bj * HALF); f32x4 v0 = acc[ai][bj][m][0], v1 = acc[ai][bj][m][1];
                    v0[0] *= bflo(g.x); v0[1] *= bfhi(g.x); v0[2] *= bflo(g.y); v0[3] *= bfhi(g.y); v1[0] *= bflo(g.z); v1[1] *= bfhi(g.z); v1[2] *= bflo(g.w); v1[3] *= bfhi(g.w);
                    u32x4 w; w.x = cvt_pk_bf16(v0[0], v0[1]); w.y = cvt_pk_bf16(v0[2], v0[3]); w.z = cvt_pk_bf16(v1[0], v1[1]); w.w = cvt_pk_bf16(v1[2], v1[3]);
                    ST16((u32x4*)(tmp + ro + bj * HALF), w); } }
    }
};
struct EpiMerge {
    static constexpr bool PERM = true, AFTER_DRAIN = false, HAS_MID = false;
    const bf16_t* gate; const bf16_t* tmp; bf16_t* out;
    __device__ __forceinline__ void operator()(const f32x4 (&acc)[2][2][4][2], const Unit& u, int wr, int wc, int fr, int fq) const {
        const int row0 = u.pm * BM + wr * 64 + fr, col0 = u.pn * BM + wc * 32 + 8 * fq;
#pragma unroll
        for (int ai = 0; ai < 2; ++ai)
#pragma unroll
            for (int m = 0; m < 4; ++m) { const size_t ro = (size_t)(row0 + ai * HALF + m * 16) * 1024 + col0;
#pragma unroll
                for (int bj = 0; bj < 2; ++bj) { const u32x4 g = *(const u32x4*)(gate + ro + bj * HALF); f32x4 v0 = acc[ai][bj][m][0], v1 = acc[ai][bj][m][1];
                    const u32x4 t = *(const u32x4*)(tmp + ro + bj * HALF);
                    v0[0] = bflo(t.x) + v0[0] * bflo(g.x); v0[1] = bfhi(t.x) + v0[1] * bfhi(g.x); v0[2] = bflo(t.y) + v0[2] * bflo(g.y); v0[3] = bfhi(t.y) + v0[3] * bfhi(g.y);
                    v1[0] = bflo(t.z) + v1[0] * bflo(g.z); v1[1] = bfhi(t.z) + v1[1] * bfhi(g.z); v1[2] = bflo(t.w) + v1[2] * bflo(g.w); v1[3] = bfhi(t.w) + v1[3] * bfhi(g.w);
                    u32x4 w; w.x = cvt_pk_bf16(v0[0], v0[1]); w.y = cvt_pk_bf16(v0[2], v0[3]); w.z = cvt_pk_bf16(v1[0], v1[1]); w.w = cvt_pk_bf16(v1[2], v1[3]);
                    ST16((u32x4*)(out + ro + bj * HALF), w); } }
    }
};
struct EpiResB {
    static constexpr bool PERM = true, AFTER_DRAIN = false, HAS_MID = false;
    const float* base; bf16_t* Cb;
    __device__ __forceinline__ void operator()(const f32x4 (&acc)[2][2][4][2], const Unit& u, int wr, int wc, int fr, int fq) const {
        const int row0 = u.pm * BM + wr * 64 + fr, col0 = u.pn * BM + wc * 32 + 8 * fq;
#pragma unroll
        for (int ai = 0; ai < 2; ++ai)
#pragma unroll
            for (int m = 0; m < 4; ++m) { const size_t ro = (size_t)(row0 + ai * HALF + m * 16) * 1024 + col0;
#pragma unroll
                for (int bj = 0; bj < 2; ++bj) { const f32x4 v0 = *(const f32x4*)(base + ro + bj * HALF) + acc[ai][bj][m][0], v1 = *(const f32x4*)(base + ro + bj * HALF + 4) + acc[ai][bj][m][1];
                    u32x4 w; w.x = cvt_pk_bf16(v0[0], v0[1]); w.y = cvt_pk_bf16(v0[2], v0[3]); w.z = cvt_pk_bf16(v1[0], v1[1]); w.w = cvt_pk_bf16(v1[2], v1[3]);
                    ST16((u32x4*)(Cb + ro + bj * HALF), w); } }
    }
};
struct EpiPlain {
    static constexpr bool PERM = true, AFTER_DRAIN = false, HAS_MID = false;
    bf16_t* O; int ldc;
    __device__ __forceinline__ void operator()(const f32x4 (&acc)[2][2][4][2], const Unit& u, int wr, int wc, int fr, int fq) const {
        const int row0 = u.pm * BM + wr * 64 + fr, col0 = u.pn * BM + wc * 32 + 8 * fq;
#pragma unroll
        for (int ai = 0; ai < 2; ++ai)
#pragma unroll
            for (int m = 0; m < 4; ++m) { bf16_t* rowp = O + (size_t)(row0 + ai * HALF + m * 16) * ldc + col0;
#pragma unroll
                for (int bj = 0; bj < 2; ++bj) { const f32x4 v0 = acc[ai][bj][m][0], v1 = acc[ai][bj][m][1];
                    u32x4 w; w.x = cvt_pk_bf16(v0[0], v0[1]); w.y = cvt_pk_bf16(v0[2], v0[3]); w.z = cvt_pk_bf16(v1[0], v1[1]); w.w = cvt_pk_bf16(v1[2], v1[3]);
                    ST16((u32x4*)(rowp + bj * HALF), w); } }
    }
};
}

__device__ __forceinline__ void p0_transpose_item(const float* W, int K, int N, bf16* WT, LAS float* scr, int item, int lane, int ldk = 0, int koff = 0, const float* kscale = nullptr) {
    if (ldk == 0) ldk = K;
    const int nblk = N / 32, kb = item / nblk, nb = item % nblk, k0 = 64 * kb, n0 = 32 * nb;
#pragma unroll 8
    for (int i = 0; i < 32; ++i) { const int kk = 2 * i + (lane >> 5); scr[kk * 33 + (lane & 31)] = W[(size_t)(k0 + kk) * N + n0 + (lane & 31)] * (kscale ? kscale[k0 + kk] : 1.0f); }
    LDS_WAIT(); asm volatile("" ::: "memory");
    const int c = lane & 7;
#pragma unroll
    for (int j = 0; j < 4; ++j) { const int n = (lane >> 3) + 8 * j; const LAS float* s = scr + (8 * c) * 33 + n;
        v4u o; o.x = pk2(s[0 * 33], s[1 * 33]); o.y = pk2(s[2 * 33], s[3 * 33]); o.z = pk2(s[4 * 33], s[5 * 33]); o.w = pk2(s[6 * 33], s[7 * 33]);
        *(v4u*)(WT + (size_t)(n0 + n) * ldk + koff + k0 + 8 * c) = o; }
    LDS_WAIT(); asm volatile("" ::: "memory");
}
__device__ __forceinline__ void cvt_flat(const float* src, bf16* dst, size_t n, int gw, int NGW, int lane) {
    for (size_t i = (size_t)gw * 512 + lane * 8; i < n; i += (size_t)NGW * 512) {
        const f32x4 a = *(const f32x4*)(src + i), b = *(const f32x4*)(src + i + 4);
        v4u o; o.x = pk2(a[0], a[1]); o.y = pk2(a[2], a[3]); o.z = pk2(b[0], b[1]); o.w = pk2(b[2], b[3]);
        *(v4u*)(dst + i) = o;
    }
}

__device__ __forceinline__ void rms_x1_row(const bf16* xrow, const float* w, bf16* orow, unsigned char* o8row, float* oinv, int lane) {
    const f32x4* wr = (const f32x4*)w + lane;
    f32x4 v[4]; float s = 0.f;
    { const v2u* xb = (const v2u*)xrow + lane;
#pragma unroll
      for (int j = 0; j < 4; ++j) { const v2u q = xb[64 * j]; v[j][0] = bflo(q.x); v[j][1] = bfhi(q.x); v[j][2] = bflo(q.y); v[j][3] = bfhi(q.y); } }
#pragma unroll
    for (int j = 0; j < 4; ++j) s += (v[j][0] * v[j][0] + v[j][1] * v[j][1]) + (v[j][2] * v[j][2] + v[j][3] * v[j][3]);
    const float rstd = 1.0f / sqrtf(wave_sum(s) * (1.0f / 1024.0f) + EPS);
    unsigned long long* o8 = (unsigned long long*)orow + lane; float mx = 0.f;
#pragma unroll
    for (int j = 0; j < 4; ++j) { const f32x4 ww = wr[64 * j]; v[j] = v[j] * rstd * ww;
        o8[64 * j] = (unsigned long long)pk2(v[j][0], v[j][1]) | ((unsigned long long)pk2(v[j][2], v[j][3]) << 32);
        mx = fmaxf(mx, fmaxf(fmaxf(fabsf(v[j][0]), fabsf(v[j][1])), fmaxf(fabsf(v[j][2]), fabsf(v[j][3])))); }
#pragma unroll
    for (int o = 1; o < 64; o <<= 1) mx = fmaxf(mx, __shfl_xor(mx, o));
    const bool tiny = mx < 1e-30f;
    const float scale = tiny ? 0.f : 119.0f / mx, inv = tiny ? 0.f : mx * (1.0f / 119.0f);
#pragma unroll
    for (int j = 0; j < 4; ++j) {
        unsigned pa = 0u, pb = 0u;
#pragma unroll
        for (int e = 0; e < 4; ++e) { const int q = (int)__builtin_rintf(v[j][e] * scale); const int b = ((q + 8) & 15) - 8; const int a = (q - b) >> 4;
            pa |= (unsigned)(a & 15) << (4 * e); pb |= (unsigned)(b & 15) << (4 * e); }
        const unsigned na = (unsigned)__shfl_xor((int)pa, 1), nb = (unsigned)__shfl_xor((int)pb, 1);
        const unsigned da = (lane & 1) ? (na | (pa << 16)) : (pa | (na << 16)), db = (lane & 1) ? (nb | (pb << 16)) : (pb | (nb << 16));
        *(unsigned*)(o8row + 32 * ((lane >> 3) + 8 * j) + 4 * ((lane & 7) >> 1) + ((lane & 1) ? 16 : 0)) = (lane & 1) ? db : da;
    }
    if (lane == 0) *oinv = inv;
}

struct Ptrs {
    const float *x, *mix_w, *w_in, *rel_bias, *sinks, *w_pa, *ln_w, *ln_b, *w_s, *b_s, *w_pb, *w_out, *ffn_w, *w_q, *keys1, *keys2, *pu, *pv, *fin_w;
    float* out;
    unsigned char *U8, *V8, *HN8; float *USC, *VSC, *HSC;
    bf16 *WIN, *WPA, *WPB, *WOUT, *WQ, *K1, *K2, *WS, *XN, *AOUT, *BOUT, *HN2, *X1B, *Q, *KV, *GU, *GV, *GA, *GB, *MERGED, *QP;
};

__device__ __forceinline__ void p0_quant_row(const Ptrs& P, const f32x4 (&v)[4], int rr, int lane) {
            const int tab = rr >> 14, row = rr & 16383;
            float mx = 0.f, ssq = 0.f;
#pragma unroll
            for (int j = 0; j < 4; ++j) { mx = fmaxf(mx, fmaxf(fmaxf(fabsf(v[j][0]), fabsf(v[j][1])), fmaxf(fabsf(v[j][2]), fabsf(v[j][3]))));
                ssq += (v[j][0] * v[j][0] + v[j][1] * v[j][1]) + (v[j][2] * v[j][2] + v[j][3] * v[j][3]); }
            mx = wave_max(mx); ssq = wave_sum(ssq);
            const float sd = sqrtf(ssq * (1.0f / 1024.0f));
            if (tab == 0) {
                const float step = fmaxf(Q4_USTEP * sd, mx * (1.0f / 14.0f)); const float qs = step > 1e-30f ? 1.0f / step : 0.f;
#pragma unroll
                for (int j = 0; j < 4; ++j) { unsigned pq = 0u;
#pragma unroll
                    for (int e = 0; e < 4; ++e) pq |= (unsigned)((int)fminf(fmaxf(__builtin_rintf(v[j][e] * qs), -7.0f), 7.0f) & 15) << (4 * e);
                    const unsigned nq = (unsigned)__builtin_amdgcn_update_dpp(0, (int)pq, 0xB1, 0xF, 0xF, false);
                    if ((lane & 1) == 0) *(unsigned*)(P.U8 + (size_t)row * 512 + 128 * j + 2 * lane) = pq | (nq << 16); }
                if (lane == 0) P.USC[row] = step;
            } else {
                const float un = fmaxf(Q4_VUNIT * sd, mx * (1.0f / 12.0f)); const float qs = un > 1e-30f ? 1.0f / un : 0.f;
                bool bad = false;
#pragma unroll
                for (int j = 0; j < 4; ++j) {
                    unsigned pq = __builtin_amdgcn_cvt_scalef32_pk_fp4_f32(0u, v[j][0] * qs, v[j][1] * qs, 1.0f, 0);
                    pq = __builtin_amdgcn_cvt_scalef32_pk_fp4_f32(pq, v[j][2] * qs, v[j][3] * qs, 1.0f, 1);
                    pq &= 0xffffu;
                    const unsigned nq = (unsigned)__builtin_amdgcn_update_dpp(0, (int)pq, 0xB1, 0xF, 0xF, false);
                    if ((lane & 1) == 0) *(unsigned*)(P.V8 + (size_t)row * 512 + 128 * j + 2 * lane) = pq | (nq << 16); }
                if (FP4_SELFCHECK && __ballot(bad) != 0ull) { if (lane == 0) P.VSC[row] = __builtin_nanf(""); }
                else if (lane == 0) P.VSC[row] = un;
            }
}
#define TAB_LOAD(V, RR) do { if ((RR) < 2 * 16384) { const float* src_ = (((RR) >> 14) ? P.pv : P.pu) + (size_t)((RR) & 16383) * 1024; \
        _Pragma("unroll") for (int j = 0; j < 4; ++j) V[j] = *(const f32x4*)(src_ + 4 * lane + 256 * j); } } while (0)
__device__ __forceinline__ void p0_prologue(LAS unsigned char* lds, const Ptrs& P, int vcu, int G, int lane, int wave) {
    LAS float* scr = (LAS float*)(lds + wave * 16384);
    const int gw = vcu * NWAVES + wave, NGW = G * NWAVES;
    constexpr int I_IN = (1024 / 64) * (3840 / 32), I_PA = (512 / 64) * (1024 / 32), I_OUT = (1024 / 64) * (1024 / 32), I_WQ = (1024 / 64) * (2048 / 32);
    constexpr int NITEMS = I_IN + 2 * I_PA + I_OUT + I_WQ;
    for (int it = gw; it < NITEMS; it += NGW) {
        int r = it;
        if (r < I_IN) { p0_transpose_item(P.w_in, 1024, 3840, P.WIN, scr, r, lane); continue; } r -= I_IN;
        if (r < I_PA) { p0_transpose_item(P.w_pa, 512, 1024, P.WPA, scr, r, lane); continue; } r -= I_PA;
        if (r < I_PA) { p0_transpose_item(P.w_pb, 512, 1024, P.WPB, scr, r, lane); continue; } r -= I_PA;
        if (r < I_OUT) { p0_transpose_item(P.w_out, 1024, 1024, P.WOUT, scr, r, lane); continue; } r -= I_OUT;
        p0_transpose_item(P.w_q, 1024, 2048, P.WQ, scr, r, lane);
    }
    cvt_flat(P.keys1, P.K1, 128 * 128, gw, NGW, lane);
    cvt_flat(P.keys2, P.K2, 128 * 128, gw, NGW, lane);
    {
        f32x4 va[4], vb[4], vc[4];
        int rr = gw;
        TAB_LOAD(va, rr); TAB_LOAD(vb, rr + NGW);
#pragma unroll 1
        for (; rr < 2 * 16384; rr += 3 * NGW) {
            TAB_LOAD(vc, rr + 2 * NGW); p0_quant_row(P, va, rr, lane);
            TAB_LOAD(va, rr + 3 * NGW); if (rr + NGW < 2 * 16384) p0_quant_row(P, vb, rr + NGW, lane);
            TAB_LOAD(vb, rr + 4 * NGW); if (rr + 2 * NGW < 2 * 16384) p0_quant_row(P, vc, rr + 2 * NGW, lane);
        }
    }
    for (size_t i = (size_t)gw * 512 + lane * 8; i < (size_t)8 * 128 * 128; i += (size_t)NGW * 512) {
        const int t = (int)((i >> 7) & 127), s0 = (int)(i & 127);
        const f32x4 a = *(const f32x4*)(P.w_s + i), b = *(const f32x4*)(P.w_s + i + 4);
        float e[8] = {a[0], a[1], a[2], a[3], b[0], b[1], b[2], b[3]};
#pragma unroll
        for (int j = 0; j < 8; ++j) e[j] = (s0 + j <= t) ? e[j] : 0.f;
        v4u o; o.x = pk2(e[0], e[1]); o.y = pk2(e[2], e[3]); o.z = pk2(e[4], e[5]); o.w = pk2(e[6], e[7]);
        *(v4u*)(P.WS + i) = o;
    }
    {
        f32x4 va[4], vb[4], vc[4], ww[4];
#pragma unroll
        for (int j = 0; j < 4; ++j) ww[j] = *((const f32x4*)P.mix_w + lane + 64 * j);
#define XN_LOAD(V, MM) do { if ((MM) < M) { _Pragma("unroll") for (int j = 0; j < 4; ++j) V[j] = *((const f32x4*)(P.x + (size_t)(MM) * D) + lane + 64 * j); } } while (0)
#define XN_PROC(V, MM) do { if ((MM) < M) { float s_ = 0.f; \
        _Pragma("unroll") for (int j = 0; j < 4; ++j) s_ += (V[j][0] * V[j][0] + V[j][1] * V[j][1]) + (V[j][2] * V[j][2] + V[j][3] * V[j][3]); \
        const float rstd_ = 1.0f / sqrtf(wave_sum(s_) * (1.0f / 1024.0f) + EPS); \
        unsigned long long* o8_ = (unsigned long long*)(P.XN + (size_t)(MM) * D) + lane; \
        _Pragma("unroll") for (int j = 0; j < 4; ++j) o8_[64 * j] = (unsigned long long)pk2(V[j][0] * rstd_ * ww[j][0], V[j][1] * rstd_ * ww[j][1]) | ((unsigned long long)pk2(V[j][2] * rstd_ * ww[j][2], V[j][3] * rstd_ * ww[j][3]) << 32); } } while (0)
        int m = gw;
        XN_LOAD(va, m); XN_LOAD(vb, m + NGW);
#pragma unroll 1
        for (; m < M; m += 3 * NGW) {
            XN_LOAD(vc, m + 2 * NGW); XN_PROC(va, m);
            XN_LOAD(va, m + 3 * NGW); XN_PROC(vb, m + NGW);
            XN_LOAD(vb, m + 4 * NGW); XN_PROC(vc, m + 2 * NGW);
        }
#undef XN_LOAD
#undef XN_PROC
    }
}

typedef short s16x8 __attribute__((ext_vector_type(8)));
typedef short s16x4 __attribute__((ext_vector_type(4)));
typedef float f32x16 __attribute__((ext_vector_type(16)));
typedef float f32x2v __attribute__((ext_vector_type(2)));
#define MFMA32(a, b, c) __builtin_amdgcn_mfma_f32_32x32x16_bf16((a), (b), (c), 0, 0, 0)
__device__ __forceinline__ s16x4 tr16(const LAS unsigned char* p) { return __builtin_bit_cast(s16x4, __builtin_amdgcn_ds_read_tr16_b64_v4i16((LAS s16x4*)p)); }
__device__ __forceinline__ unsigned cvtpk(float lo, float hi) { f32x2v v = {lo, hi}; bf16x2_t b = __builtin_convertvector(v, bf16x2_t); return __builtin_bit_cast(unsigned, b); }
__device__ __forceinline__ int crow(int reg, int h) { return (reg & 3) + 8 * (reg >> 2) + 4 * h; }
constexpr float LOG2E = 1.4426950408889634f;

__device__ __forceinline__ void p2_attn_mfma(LAS unsigned char* lds, const Ptrs& P, int vcu, int G, int tid, int lane, int wave) {
    LAS unsigned char* Kl = lds;
    LAS unsigned char* Vl = lds + 32768;
    LAS float* biasl = (LAS float*)(lds + 32768 + 49152);
    const int r = lane & 31, h = lane >> 5, i16 = lane & 15, q4 = i16 >> 2, p4 = i16 & 3, blk = (lane >> 4) & 1;
    for (int unit = vcu; unit < 256; unit += G) {
        const int kvh = unit & 1, blkid = unit >> 1, nb = blkid & 63; const int tok0 = blkid * 128;
#pragma unroll
        for (int i = 0; i < 4; ++i) {
            const int cidx = tid + 512 * i, row = cidx >> 3, c = cidx & 7;
            v4u kw = {0u, 0u, 0u, 0u}, vw = {0u, 0u, 0u, 0u};
            if (nb > 0 || row >= 128) { const bf16* src = P.KV + (size_t)(tok0 - 128 + row) * 256 + kvh * 64 + c * 8; kw = *(const v4u*)src; vw = *(const v4u*)(src + 128); }
            *(LAS v4u*)(Kl + row * 128 + ((c ^ ((row >> 1) & 7)) << 4)) = kw;
            *(LAS v4u*)(Vl + row * 192 + c * 16) = vw;
        }
        biasl[tid] = P.rel_bias[(int)T5B[tid & 127] * 8 + kvh * 4 + (tid >> 7)] * LOG2E;
        __syncthreads();
        const int g = wave >> 1, qh = wave & 1, hq = kvh * 4 + g;
        const float sink2 = P.sinks[hq] * LOG2E;
#pragma unroll 1
        for (int qs = 0; qs < 2; ++qs) {
            const int qi0 = 64 * qh + 32 * qs, kt0 = 2 * qh + qs;
            s16x8 qf[4];
            { const bf16* qrow = P.Q + (size_t)(tok0 + qi0 + r) * 512 + hq * 64 + 8 * h;
#pragma unroll
              for (int ks = 0; ks < 4; ++ks) qf[ks] = *(const s16x8*)(qrow + 16 * ks); }
            f32x16 s[5];
#pragma unroll
            for (int i = 0; i < 5; ++i) {
#pragma unroll
                for (int e = 0; e < 16; ++e) s[i][e] = 0.f;
                const int key = 32 * (kt0 + i) + r; const LAS unsigned char* kp = Kl + key * 128; const int sw = (key >> 1) & 7;
#pragma unroll
                for (int ks = 0; ks < 4; ++ks) { const s16x8 kf = *(const LAS s16x8*)(kp + (((2 * ks + h) ^ sw) << 4)); s[i] = MFMA32(kf, qf[ks], s[i]); }
            }
            const int qi = qi0 + r;
            float mx = sink2;
#pragma unroll
            for (int i = 0; i < 5; ++i)
#pragma unroll
                for (int e = 0; e < 16; ++e) {
                    const int kj = 32 * (kt0 + i) + crow(e, h), dist = 128 + qi - kj;
                    const bool valid = (dist >= 0) && (dist < 128) && (nb > 0 || kj >= 128);
                    const float b = biasl[g * 128 + (dist & 127)];
                    const float v = valid ? s[i][e] * (0.125f * LOG2E) + b : -1e30f;
                    s[i][e] = v; mx = fmaxf(mx, v);
                }
            mx = fmaxf(mx, xor32_f(mx));
            float l = 0.f;
#pragma unroll
            for (int i = 0; i < 5; ++i)
#pragma unroll
                for (int e = 0; e < 16; ++e) { const float p = __builtin_amdgcn_exp2f(s[i][e] - mx); s[i][e] = p; l += p; }
            l += xor32_f(l);
            l += __builtin_amdgcn_exp2f(sink2 - mx);
            f32x16 o0, o1;
#pragma unroll
            for (int e = 0; e < 16; ++e) { o0[e] = 0.f; o1[e] = 0.f; }
#pragma unroll
            for (int i = 0; i < 5; ++i)
#pragma unroll
                for (int st = 0; st < 2; ++st) {
                    v4u pw; pw.x = cvtpk(s[i][8 * st], s[i][8 * st + 1]); pw.y = cvtpk(s[i][8 * st + 2], s[i][8 * st + 3]); pw.z = cvtpk(s[i][8 * st + 4], s[i][8 * st + 5]); pw.w = cvtpk(s[i][8 * st + 6], s[i][8 * st + 7]);
                    const s16x8 pf = __builtin_bit_cast(s16x8, pw);
                    const LAS unsigned char* vb = Vl + (32 * (kt0 + i) + 16 * st + 4 * h + q4) * 192 + 32 * blk + 8 * p4;
                    { const s16x4 lo = tr16(vb), hi = tr16(vb + 8 * 192); const s16x8 vf = __builtin_shufflevector(lo, hi, 0, 1, 2, 3, 4, 5, 6, 7); o0 = MFMA32(vf, pf, o0); }
                    { const s16x4 lo = tr16(vb + 64), hi = tr16(vb + 64 + 8 * 192); const s16x8 vf = __builtin_shufflevector(lo, hi, 0, 1, 2, 3, 4, 5, 6, 7); o1 = MFMA32(vf, pf, o1); }
                }
            const float inv = 1.0f / l;
            bf16* orow = P.AOUT + (size_t)(tok0 + qi) * AB_LD + hq * 64 + 4 * h;
#pragma unroll
            for (int r4 = 0; r4 < 4; ++r4) {
                v2u w0; w0.x = cvtpk(o0[4 * r4] * inv, o0[4 * r4 + 1] * inv); w0.y = cvtpk(o0[4 * r4 + 2] * inv, o0[4 * r4 + 3] * inv); *(v2u*)(orow + 8 * r4) = w0;
                v2u w1; w1.x = cvtpk(o1[4 * r4] * inv, o1[4 * r4 + 1] * inv); w1.y = cvtpk(o1[4 * r4 + 2] * inv, o1[4 * r4 + 3] * inv); *(v2u*)(orow + 32 + 8 * r4) = w1;
            }
        }
        __syncthreads();
    }
}

__device__ __forceinline__ void p2_gmlp_mfma(LAS unsigned char* lds, const Ptrs& P, int vcu, int G, int tid, int lane, int wave) {
    LAS unsigned char* vnl = lds;
    const int r = lane & 31, h = lane >> 5, i16 = lane & 15, q4 = i16 >> 2, p4 = i16 & 3, blk = (lane >> 4) & 1;
    for (int unit = vcu; unit < 256; unit += G) {
        const int c = unit >> 1, hh = unit & 1;
        v4u gvw[16];
#pragma unroll
        for (int i = 0; i < 16; ++i) gvw[i] = *((const v4u*)(P.GV + ((size_t)c * 128 + wave * 16 + i) * 512) + lane);
        const f32x4 lw0 = *(const f32x4*)(P.ln_w + lane * 8), lw1 = *(const f32x4*)(P.ln_w + lane * 8 + 4), lb0 = *(const f32x4*)(P.ln_b + lane * 8), lb1 = *(const f32x4*)(P.ln_b + lane * 8 + 4);
#pragma unroll
        for (int i = 0; i < 16; ++i) {
            const int tt = wave * 16 + i;
            const v4u w = gvw[i];
            float x[8] = {bflo(w.x), bfhi(w.x), bflo(w.y), bfhi(w.y), bflo(w.z), bfhi(w.z), bflo(w.w), bfhi(w.w)};
            float s = 0.f;
#pragma unroll
            for (int j = 0; j < 8; ++j) s += x[j];
            const float mean = wave_sum(s) * (1.0f / 512.0f);
            float ss = 0.f;
#pragma unroll
            for (int j = 0; j < 8; ++j) { x[j] -= mean; ss += x[j] * x[j]; }
            const float rstd = 1.0f / sqrtf(wave_sum(ss) * (1.0f / 512.0f) + EPS);
            if ((lane >> 5) == hh) {
                const f32x4 w0 = lw0, w1 = lw1, b0 = lb0, b1 = lb1;
                v4u o; o.x = pk2(x[0] * rstd * w0[0] + b0[0], x[1] * rstd * w0[1] + b0[1]); o.y = pk2(x[2] * rstd * w0[2] + b0[2], x[3] * rstd * w0[3] + b0[3]);
                o.z = pk2(x[4] * rstd * w1[0] + b1[0], x[5] * rstd * w1[1] + b1[1]); o.w = pk2(x[6] * rstd * w1[2] + b1[2], x[7] * rstd * w1[3] + b1[3]);
                *(LAS v4u*)(vnl + tt * 576 + (lane & 31) * 16) = o;
            }
        }
        __syncthreads();
        const int gi = wave >> 1, dblk = wave & 1, g = hh * 4 + gi;
        s16x8 af[8];
#pragma unroll
        for (int ks = 0; ks < 8; ++ks) { const LAS unsigned char* vb = vnl + (16 * ks + 8 * h + q4) * 576 + (gi * 64 + dblk * 32 + 16 * blk) * 2 + 8 * p4;
            const s16x4 lo = tr16(vb), hi = tr16(vb + 4 * 576); af[ks] = __builtin_shufflevector(lo, hi, 0, 1, 2, 3, 4, 5, 6, 7); }
#pragma unroll
        for (int tt = 0; tt < 4; ++tt) {
            f32x16 acc;
#pragma unroll
            for (int e = 0; e < 16; ++e) acc[e] = 0.f;
            const bf16* wrow = P.WS + ((size_t)g * 128 + 32 * tt + r) * 128 + 8 * h;
#pragma unroll
            for (int ks = 0; ks < 2 * (tt + 1); ++ks) acc = MFMA32(af[ks], *(const s16x8*)(wrow + 16 * ks), acc);
            const int t = 32 * tt + r; const size_t row = (size_t)c * 128 + t; const float b = P.b_s[g * 128 + t];
#pragma unroll
            for (int r4 = 0; r4 < 4; ++r4) {
                const int ch = g * 64 + dblk * 32 + 8 * r4 + 4 * h;
                const v2u uw = *(const v2u*)(P.GU + row * 512 + ch);
                v2u ow; ow.x = cvtpk(bflo(uw.x) * (acc[4 * r4] + b), bfhi(uw.x) * (acc[4 * r4 + 1] + b)); ow.y = cvtpk(bflo(uw.y) * (acc[4 * r4 + 2] + b), bfhi(uw.y) * (acc[4 * r4 + 3] + b));
                *(v2u*)(P.BOUT + row * AB_LD + ch) = ow;
            }
        }
        __syncthreads();
    }
}

__device__ __forceinline__ void topk_half(const bf16* q, const LAS bf16* kl, float (&v)[16]) {
    v4u qv[16];
#pragma unroll
    for (int c = 0; c < 16; ++c) qv[c] = ((const v4u*)q)[c];
#pragma unroll
    for (int i = 0; i < 16; ++i) v[i] = -INFINITY;
    for (int n = 0; n < 128; ++n) {
        const LAS v4u* kr = (const LAS v4u*)(kl + n * 128);
        float a0 = 0.f, a1 = 0.f, a2 = 0.f, a3 = 0.f;
#pragma unroll
        for (int c = 0; c < 16; ++c) { const v4u kk = kr[c]; a0 = dot2bf(qv[c].x, kk.x, a0); a1 = dot2bf(qv[c].y, kk.y, a1); a2 = dot2bf(qv[c].z, kk.z, a2); a3 = dot2bf(qv[c].w, kk.w, a3); }
        const float acc = (a0 + a1) + (a2 + a3);
        float x = __builtin_bit_cast(float, (__builtin_bit_cast(unsigned, acc) & ~0x7Fu) | (unsigned)n);
#pragma unroll
        for (int i = 0; i < 16; ++i) { const float hi = fmaxf(v[i], x); x = fminf(v[i], x); v[i] = hi; }
    }
}

__host__ __device__ constexpr int cand_slot(int i, int j) { int c = 0; for (int a = 0; a < 16; ++a) for (int b = 0; b < 16; ++b) { if (a == i && b == j) return c; if ((a + 1) * (b + 1) <= 16) ++c; } return c; }
#define CE_DESC(a, b) do { const float hi_ = fmaxf((a), (b)); const float lo_ = fminf((a), (b)); (a) = hi_; (b) = lo_; } while (0)
__device__ __forceinline__ void sort16_desc(float (&v)[16]) {
    CE_DESC(v[0], v[1]); CE_DESC(v[3], v[2]); CE_DESC(v[4], v[5]); CE_DESC(v[7], v[6]); CE_DESC(v[8], v[9]); CE_DESC(v[11], v[10]); CE_DESC(v[12], v[13]); CE_DESC(v[15], v[14]); CE_DESC(v[0], v[2]); CE_DESC(v[1], v[3]); CE_DESC(v[6], v[4]); CE_DESC(v[7], v[5]); CE_DESC(v[8], v[10]); CE_DESC(v[9], v[11]); CE_DESC(v[14], v[12]); CE_DESC(v[15], v[13]); CE_DESC(v[0], v[1]); CE_DESC(v[2], v[3]); CE_DESC(v[5], v[4]); CE_DESC(v[7], v[6]); CE_DESC(v[8], v[9]); CE_DESC(v[10], v[11]); CE_DESC(v[13], v[12]); CE_DESC(v[15], v[14]); CE_DESC(v[0], v[4]); CE_DESC(v[1], v[5]); CE_DESC(v[2], v[6]); CE_DESC(v[3], v[7]); CE_DESC(v[12], v[8]); CE_DESC(v[13], v[9]); CE_DESC(v[14], v[10]); CE_DESC(v[15], v[11]); CE_DESC(v[0], v[2]); CE_DESC(v[1], v[3]); CE_DESC(v[4], v[6]); CE_DESC(v[5], v[7]); CE_DESC(v[10], v[8]); CE_DESC(v[11], v[9]); CE_DESC(v[14], v[12]); CE_DESC(v[15], v[13]); CE_DESC(v[0], v[1]); CE_DESC(v[2], v[3]); CE_DESC(v[4], v[5]); CE_DESC(v[6], v[7]); CE_DESC(v[9], v[8]); CE_DESC(v[11], v[10]); CE_DESC(v[13], v[12]); CE_DESC(v[15], v[14]); CE_DESC(v[0], v[8]); CE_DESC(v[1], v[9]); CE_DESC(v[2], v[10]); CE_DESC(v[3], v[11]); CE_DESC(v[4], v[12]); CE_DESC(v[5], v[13]); CE_DESC(v[6], v[14]); CE_DESC(v[7], v[15]); CE_DESC(v[0], v[4]); CE_DESC(v[1], v[5]); CE_DESC(v[2], v[6]); CE_DESC(v[3], v[7]); CE_DESC(v[8], v[12]); CE_DESC(v[9], v[13]); CE_DESC(v[10], v[14]); CE_DESC(v[11], v[15]); CE_DESC(v[0], v[2]); CE_DESC(v[1], v[3]); CE_DESC(v[4], v[6]); CE_DESC(v[5], v[7]); CE_DESC(v[8], v[10]); CE_DESC(v[9], v[11]); CE_DESC(v[12], v[14]); CE_DESC(v[13], v[15]); CE_DESC(v[0], v[1]); CE_DESC(v[2], v[3]); CE_DESC(v[4], v[5]); CE_DESC(v[6], v[7]); CE_DESC(v[8], v[9]); CE_DESC(v[10], v[11]); CE_DESC(v[12], v[13]); CE_DESC(v[14], v[15]);
}
__device__ __forceinline__ void merge_top16(float (&a)[16], const float (&b)[16]) {
    a[0] = fmaxf(a[0], b[15]); a[1] = fmaxf(a[1], b[14]); a[2] = fmaxf(a[2], b[13]); a[3] = fmaxf(a[3], b[12]); a[4] = fmaxf(a[4], b[11]); a[5] = fmaxf(a[5], b[10]); a[6] = fmaxf(a[6], b[9]); a[7] = fmaxf(a[7], b[8]); a[8] = fmaxf(a[8], b[7]); a[9] = fmaxf(a[9], b[6]); a[10] = fmaxf(a[10], b[5]); a[11] = fmaxf(a[11], b[4]); a[12] = fmaxf(a[12], b[3]); a[13] = fmaxf(a[13], b[2]); a[14] = fmaxf(a[14], b[1]); a[15] = fmaxf(a[15], b[0]); CE_DESC(a[0], a[8]); CE_DESC(a[1], a[9]); CE_DESC(a[2], a[10]); CE_DESC(a[3], a[11]); CE_DESC(a[4], a[12]); CE_DESC(a[5], a[13]); CE_DESC(a[6], a[14]); CE_DESC(a[7], a[15]); CE_DESC(a[0], a[4]); CE_DESC(a[1], a[5]); CE_DESC(a[2], a[6]); CE_DESC(a[3], a[7]); CE_DESC(a[8], a[12]); CE_DESC(a[9], a[13]); CE_DESC(a[10], a[14]); CE_DESC(a[11], a[15]); CE_DESC(a[0], a[2]); CE_DESC(a[1], a[3]); CE_DESC(a[4], a[6]); CE_DESC(a[5], a[7]); CE_DESC(a[8], a[10]); CE_DESC(a[9], a[11]); CE_DESC(a[12], a[14]); CE_DESC(a[13], a[15]); CE_DESC(a[0], a[1]); CE_DESC(a[2], a[3]); CE_DESC(a[4], a[5]); CE_DESC(a[6], a[7]); CE_DESC(a[8], a[9]); CE_DESC(a[10], a[11]); CE_DESC(a[12], a[13]); CE_DESC(a[14], a[15]);
}
__device__ __forceinline__ void scores_top16(const bf16* qbase, const LAS unsigned char* kl, int r, int h, float (&t)[16]) {
    f32x16 acc[4];
#pragma unroll
    for (int kt = 0; kt < 4; ++kt)
#pragma unroll
        for (int e = 0; e < 16; ++e) acc[kt][e] = 0.f;
    const LAS unsigned char* kp0 = kl + r * 256; const int sw = r & 15;
#pragma unroll
    for (int ks = 0; ks < 8; ++ks) {
        const s16x8 qf = *(const s16x8*)(qbase + (size_t)r * 256 + 16 * ks + 8 * h);
#pragma unroll
        for (int kt = 0; kt < 4; ++kt) { const s16x8 kf = *(const LAS s16x8*)(kp0 + kt * 8192 + (((2 * ks + h) ^ sw) << 4)); acc[kt] = MFMA32(kf, qf, acc[kt]); }
    }
    float g[4][16];
#pragma unroll
    for (int kt = 0; kt < 4; ++kt) {
#pragma unroll
        for (int e = 0; e < 16; ++e) { const float av_ = acc[kt][e];
            g[kt][e] = __builtin_bit_cast(float, (__builtin_bit_cast(unsigned, av_) & ~0x7Fu) | (unsigned)(32 * kt + (e & 3) + 8 * (e >> 2))); }
        sort16_desc(g[kt]);
    }
    merge_top16(g[0], g[1]); merge_top16(g[2], g[3]); merge_top16(g[0], g[2]);
#pragma unroll
    for (int k = 0; k < 16; ++k) t[k] = __builtin_bit_cast(float, __builtin_bit_cast(unsigned, g[0][k]) | ((unsigned)h << 2));
}
__device__ __forceinline__ void peer_topk_unit_mfma(const Ptrs& P, const LAS unsigned char* k1l, const LAS unsigned char* k2l, LAS int* idxl, LAS float* gatel, int unit, int lane, int wave, int rb_lo = 0, int rb_hi = 2) {
    asm volatile("" : "+v"(lane));
    const int r = lane & 31, h = lane >> 5;
#pragma unroll 1
    for (int rbi = rb_lo; rbi < rb_hi; ++rbi) {
        const int rb = wave * 2 + rbi, R = rb * 32 + r;
        const bf16* qbase = P.QP + ((size_t)unit * 512 + rb * 32) * 256;
        float t1[16], t2[16];
        scores_top16(qbase, k1l, r, h, t1);
        __builtin_amdgcn_sched_barrier(0);
        scores_top16(qbase + 128, k2l, r, h, t2);
        __builtin_amdgcn_sched_barrier(0);
        float F[16], recv[16];
#pragma unroll
        for (int k = 0; k < 16; ++k) { auto rr = __builtin_amdgcn_permlane32_swap(__builtin_bit_cast(unsigned, t1[k]), __builtin_bit_cast(unsigned, t2[k]), false, false);
            const unsigned r0 = rr[0], r1 = rr[1]; F[k] = __builtin_bit_cast(float, r0); recv[k] = __builtin_bit_cast(float, r1); }
        merge_top16(F, recv);
        LAS unsigned char* slot = (LAS unsigned char*)(idxl + R * 16);
        { v4u b;
          b.x = (__builtin_bit_cast(unsigned, F[0]) & 0x7Fu) | ((__builtin_bit_cast(unsigned, F[1]) & 0x7Fu) << 8) | ((__builtin_bit_cast(unsigned, F[2]) & 0x7Fu) << 16) | ((__builtin_bit_cast(unsigned, F[3]) & 0x7Fu) << 24);
          b.y = (__builtin_bit_cast(unsigned, F[4]) & 0x7Fu) | ((__builtin_bit_cast(unsigned, F[5]) & 0x7Fu) << 8) | ((__builtin_bit_cast(unsigned, F[6]) & 0x7Fu) << 16) | ((__builtin_bit_cast(unsigned, F[7]) & 0x7Fu) << 24);
          b.z = (__builtin_bit_cast(unsigned, F[8]) & 0x7Fu) | ((__builtin_bit_cast(unsigned, F[9]) & 0x7Fu) << 8) | ((__builtin_bit_cast(unsigned, F[10]) & 0x7Fu) << 16) | ((__builtin_bit_cast(unsigned, F[11]) & 0x7Fu) << 24);
          b.w = (__builtin_bit_cast(unsigned, F[12]) & 0x7Fu) | ((__builtin_bit_cast(unsigned, F[13]) & 0x7Fu) << 8) | ((__builtin_bit_cast(unsigned, F[14]) & 0x7Fu) << 16) | ((__builtin_bit_cast(unsigned, F[15]) & 0x7Fu) << 24);
          *(LAS v4u*)(slot + 16 * h) = b;
          (void)b; }
        float v1[16], v2[16];
#pragma unroll
        for (int k = 0; k < 16; ++k) { auto rr = __builtin_amdgcn_permlane32_swap(__builtin_bit_cast(unsigned, F[k]), __builtin_bit_cast(unsigned, F[k]), false, false);
            const unsigned r0 = rr[0], r1 = rr[1]; v1[k] = __builtin_bit_cast(float, r0 & ~0x7Fu); v2[k] = __builtin_bit_cast(float, r1 & ~0x7Fu); }
        float cg[4][16];
#pragma unroll
        for (int a = 0; a < 4; ++a)
#pragma unroll
            for (int k = 0; k < 16; ++k) cg[a][k] = -1e30f;
#define CAND(i, j) __builtin_bit_cast(float, (__builtin_bit_cast(unsigned, v1[i] + v2[j]) & ~0xFFu) | (unsigned)((i) * 16 + (j)))
        cg[0][0] = CAND(0, 0);
        cg[0][1] = CAND(0, 1);
        cg[0][2] = CAND(0, 2);
        cg[0][3] = CAND(0, 3);
        cg[0][4] = CAND(0, 4);
        cg[0][5] = CAND(0, 5);
        cg[0][6] = CAND(0, 6);
        cg[0][7] = CAND(0, 7);
        cg[0][8] = CAND(0, 8);
        cg[0][9] = CAND(0, 9);
        cg[0][10] = CAND(0, 10);
        cg[0][11] = CAND(0, 11);
        cg[0][12] = CAND(0, 12);
        cg[0][13] = CAND(0, 13);
        cg[0][14] = CAND(0, 14);
        cg[0][15] = CAND(0, 15);
        cg[1][0] = CAND(1, 0);
        cg[1][1] = CAND(1, 1);
        cg[1][2] = CAND(1, 2);
        cg[1][3] = CAND(1, 3);
        cg[1][4] = CAND(1, 4);
        cg[1][5] = CAND(1, 5);
        cg[1][6] = CAND(1, 6);
        cg[1][7] = CAND(1, 7);
        cg[1][8] = CAND(2, 0);
        cg[1][9] = CAND(2, 1);
        cg[1][10] = CAND(2, 2);
        cg[1][11] = CAND(2, 3);
        cg[1][12] = CAND(2, 4);
        cg[1][13] = CAND(3, 0);
        cg[1][14] = CAND(3, 1);
        cg[1][15] = CAND(3, 2);
        cg[2][0] = CAND(3, 3);
        cg[2][1] = CAND(4, 0);
        cg[2][2] = CAND(4, 1);
        cg[2][3] = CAND(4, 2);
        cg[2][4] = CAND(5, 0);
        cg[2][5] = CAND(5, 1);
        cg[2][6] = CAND(6, 0);
        cg[2][7] = CAND(6, 1);
        cg[2][8] = CAND(7, 0);
        cg[2][9] = CAND(7, 1);
        cg[2][10] = CAND(8, 0);
        cg[2][11] = CAND(9, 0);
        cg[2][12] = CAND(10, 0);
        cg[2][13] = CAND(11, 0);
        cg[2][14] = CAND(12, 0);
        cg[2][15] = CAND(13, 0);
        cg[3][0] = CAND(14, 0);
        cg[3][1] = CAND(15, 0);
#undef CAND
        sort16_desc(cg[0]); sort16_desc(cg[1]); sort16_desc(cg[2]); sort16_desc(cg[3]);
        merge_top16(cg[0], cg[1]); merge_top16(cg[2], cg[3]); merge_top16(cg[0], cg[2]);
        float es = 0.f, e[16];
        const float top = __builtin_bit_cast(float, __builtin_bit_cast(unsigned, cg[0][0]) & ~0xFFu);
#pragma unroll
        for (int k = 0; k < 16; ++k) { e[k] = __expf(__builtin_bit_cast(float, __builtin_bit_cast(unsigned, cg[0][k]) & ~0xFFu) - top); es += e[k]; }
        const float inv = 1.0f / es;
        LDS_WAIT();
        unsigned id[8]; float gt[8];
#pragma unroll
        for (int k = 0; k < 8; ++k) { const float clo_ = cg[0][k], chi_ = cg[0][8 + k], elo_ = e[k], ehi_ = e[8 + k]; const unsigned code = __builtin_bit_cast(unsigned, h ? chi_ : clo_) & 0xFFu; gt[k] = (h ? ehi_ : elo_) * inv;
            id[k] = (unsigned)slot[code >> 4] * 128u + (unsigned)slot[16 + (code & 15u)]; }
        LDS_WAIT();
        LAS v4u* ip = (LAS v4u*)(idxl + R * 16 + 8 * h); LAS f32x4* gp = (LAS f32x4*)(gatel + R * 16 + 8 * h);
        { v4u a; a.x = id[0]; a.y = id[1]; a.z = id[2]; a.w = id[3]; ip[0] = a; v4u b; b.x = id[4]; b.y = id[5]; b.z = id[6]; b.w = id[7]; ip[1] = b; }
        { f32x4 a; a[0] = gt[0]; a[1] = gt[1]; a[2] = gt[2]; a[3] = gt[3]; gp[0] = a; f32x4 b; b[0] = gt[4]; b[1] = gt[5]; b[2] = gt[6]; b[3] = gt[7]; gp[1] = b; }
    }
}

#define HROW_ISSUE(BUF, TAB, W) do { const unsigned vo_ = (((W) & 0x3fffu) << 9) + loff; asm volatile("global_load_dwordx4 %0, %1, %2" : "=v"(BUF) : "v"(vo_), "s"(TAB) : "memory"); } while (0)
__device__ __forceinline__ void peer_gather_half(const Ptrs& P, LAS unsigned char* lds, int unit, int lane, int wave, int g_lo, int g_hi) {
    asm volatile("" : "+v"(lane));
    const size_t t0 = (size_t)unit * 64 + wave * 8;
#pragma unroll 1
    for (int gq = g_lo; gq < g_hi; ++gq) {
        int lq = lane; asm volatile("" : "+v"(lq));
        LAS int* idxl = (LAS int*)(lds + 65536) + wave * 1024 + gq * 512;
        const LAS float* gatel = (const LAS float*)(lds + 98304) + wave * 1024 + gq * 512;
        LAS unsigned* sw = (LAS unsigned*)idxl; LAS float* sg = (LAS float*)(lds + 98304) + wave * 1024 + gq * 512;
        LAS int* startl = (LAS int*)(lds + 131072 + 4096) + wave * 64;
        {
            int ent[8]; float gv[8], us[8];
#pragma unroll
            for (int j = 0; j < 8; ++j) { ent[j] = idxl[(j >> 1) * 128 + (j & 1) * 64 + lq]; gv[j] = gatel[(j >> 1) * 128 + (j & 1) * 64 + lq]; }
#pragma unroll
            for (int j = 0; j < 8; ++j) { us[j] = P.USC[ent[j]]; gv[j] *= P.VSC[ent[j]] * 128.0f; }
            LDS_WAIT();
            int rk[8];
#pragma unroll
            for (int tk = 0; tk < 4; ++tk) {
                int run[NSL];
#pragma unroll
                for (int b = 0; b < NSL; ++b) run[b] = 0;
#pragma unroll
                for (int jj = 0; jj < 2; ++jj) { const int j = 2 * tk + jj; const int bj = ent[j] >> SLSH; int r = 0;
#pragma unroll
                    for (int b = 0; b < NSL; ++b) { const unsigned long long m = __ballot(bj == b);
                        const int below = (int)__builtin_amdgcn_mbcnt_hi((unsigned)(m >> 32), __builtin_amdgcn_mbcnt_lo((unsigned)m, 0u));
                        r = (bj == b) ? run[b] + below : r; run[b] += (int)__builtin_popcountll(m); }
                    rk[j] = r; }
                int st = 0;
#pragma unroll
                for (int b = 0; b < NSL; ++b) { if (lq == b) startl[tk * NSL + b] = st; st += run[b]; }
            }
            LDS_WAIT();
#pragma unroll
            for (int j = 0; j < 8; ++j) { const int pos = (j >> 1) * 128 + startl[(j >> 1) * NSL + (ent[j] >> SLSH)] + rk[j]; sw[pos] = (unsigned)ent[j] | (f2bf(us[j]) << 16); sg[pos] = gv[j]; }
            LDS_WAIT();
        }
#pragma unroll 1
        for (int sub = 0; sub < 2; ++sub) {
            int lr = lane; asm volatile("" : "+v"(lr));
            const int l5 = lr & 31, tk = 2 * sub + (lr >> 5);
            const LAS unsigned* swt = sw + tk * 128; const LAS float* sgt = sg + tk * 128;
            const unsigned loff = (unsigned)l5 * 16u;
            {
                const int c4 = lr & 15, rho = lr >> 4;
                const int mtk = 2 * sub + (rho >> 1), mpos = (c4 < 4) ? 2 * c4 + (rho & 1) : 0;
                const LAS unsigned* swm = sw + mtk * 128 + mpos; LAS float* sgm = sg + mtk * 128 + mpos;
                const v4u* hp = (const v4u*)(P.HN8 + (t0 + gq * 4 + tk) * 1024 + 32 * l5);
                v4u ha = hp[0], hb = hp[1]; float hsc_m = P.HSC[t0 + gq * 4 + mtk];
                asm volatile("s_waitcnt vmcnt(0)" : "+v"(ha), "+v"(hb), "+v"(hsc_m) :: "memory");
                v4u ub[16]; float p[8];
                unsigned mw; float mg;
#pragma unroll 1
                for (int pass = 0; pass < PROBE_SWEEPS; ++pass) {
                const bool lastp = (pass + 1 == PROBE_SWEEPS);
#define U_STEP(d, CNT, ISSUE, W) do { asm volatile("s_waitcnt vmcnt(" #CNT ")" : "+v"(ub[d]) :: "memory"); \
        { const v4u x_ = ub[d]; int a_ = 0, b_ = 0; \
          a_ = __builtin_amdgcn_sdot8((int)x_.x, (int)ha.x, a_, false); b_ = __builtin_amdgcn_sdot8((int)x_.x, (int)hb.x, b_, false); \
          a_ = __builtin_amdgcn_sdot8((int)x_.y, (int)ha.y, a_, false); b_ = __builtin_amdgcn_sdot8((int)x_.y, (int)hb.y, b_, false); \
          a_ = __builtin_amdgcn_sdot8((int)x_.z, (int)ha.z, a_, false); b_ = __builtin_amdgcn_sdot8((int)x_.z, (int)hb.z, b_, false); \
          a_ = __builtin_amdgcn_sdot8((int)x_.w, (int)ha.w, a_, false); b_ = __builtin_amdgcn_sdot8((int)x_.w, (int)hb.w, b_, false); \
          p[(d) & 7] = (float)((a_ << 4) + b_); } \
        if (ISSUE) HROW_ISSUE(ub[d], P.U8, W); } while (0)
#define U_FINISH(i0) do { float r_[4]; \
        _Pragma("unroll") for (int j = 0; j < 4; ++j) { auto rr = __builtin_amdgcn_permlane16_swap(__builtin_bit_cast(unsigned, p[2 * j]), __builtin_bit_cast(unsigned, p[2 * j + 1]), false, false); const unsigned r0 = rr[0], r1 = rr[1]; r_[j] = row16_sum(__builtin_bit_cast(float, r0) + __builtin_bit_cast(float, r1)); } \
        const float acol = (c4 == 0) ? r_[0] : (c4 == 1) ? r_[1] : (c4 == 2) ? r_[2] : r_[3]; \
        const float act = gelu_tanh(acol * __builtin_bit_cast(float, mw & 0xffff0000u) * hsc_m) * mg; \
        if (c4 < 4 && lastp) sgm[i0] = act; asm volatile("" :: "v"(act)); } while (0)
#define U_CHUNK(i0, B, WA, WB, C0, C1, C2, C3, C4, C5, C6, C7, ISSUE) do { mw = swm[i0]; mg = sgm[i0]; \
        U_STEP(B + 0, C0, ISSUE, WA.x); U_STEP(B + 1, C1, ISSUE, WA.y); U_STEP(B + 2, C2, ISSUE, WA.z); U_STEP(B + 3, C3, ISSUE, WA.w); \
        U_STEP(B + 4, C4, ISSUE, WB.x); U_STEP(B + 5, C5, ISSUE, WB.y); U_STEP(B + 6, C6, ISSUE, WB.z); U_STEP(B + 7, C7, ISSUE, WB.w); \
        U_FINISH(i0); } while (0)
                {
                    const v4u w0 = *(const LAS v4u*)(swt), w1 = *(const LAS v4u*)(swt + 4), w2 = *(const LAS v4u*)(swt + 8), w3 = *(const LAS v4u*)(swt + 12);
                    HROW_ISSUE(ub[0], P.U8, w0.x); HROW_ISSUE(ub[1], P.U8, w0.y); HROW_ISSUE(ub[2], P.U8, w0.z); HROW_ISSUE(ub[3], P.U8, w0.w);
                    HROW_ISSUE(ub[4], P.U8, w1.x); HROW_ISSUE(ub[5], P.U8, w1.y); HROW_ISSUE(ub[6], P.U8, w1.z); HROW_ISSUE(ub[7], P.U8, w1.w);
                    HROW_ISSUE(ub[8], P.U8, w2.x); HROW_ISSUE(ub[9], P.U8, w2.y); HROW_ISSUE(ub[10], P.U8, w2.z); HROW_ISSUE(ub[11], P.U8, w2.w);
                    HROW_ISSUE(ub[12], P.U8, w3.x); HROW_ISSUE(ub[13], P.U8, w3.y); HROW_ISSUE(ub[14], P.U8, w3.z); HROW_ISSUE(ub[15], P.U8, w3.w);
                }
                v4u wa = *(const LAS v4u*)(swt + 16), wb = *(const LAS v4u*)(swt + 20);
#pragma unroll 1
                for (int i0 = 0; i0 < 112; i0 += 16) {
                    const v4u wc = *(const LAS v4u*)(swt + i0 + 24), wd = *(const LAS v4u*)(swt + i0 + 28);
                    U_CHUNK(i0, 0, wa, wb, 15, 15, 15, 15, 15, 15, 15, 15, 1);
                    wa = *(const LAS v4u*)(swt + i0 + 32); wb = *(const LAS v4u*)(swt + i0 + 36);
                    U_CHUNK(i0 + 8, 8, wc, wd, 15, 15, 15, 15, 15, 15, 15, 15, 1);
                }
                U_CHUNK(112, 0, wa, wb, 15, 14, 13, 12, 11, 10, 9, 8, 0);
                U_CHUNK(120, 8, wa, wb, 7, 6, 5, 4, 3, 2, 1, 0, 0);
                }
#undef U_CHUNK
#undef U_FINISH
#undef U_STEP
            }
            LDS_WAIT();
            h2 y[16];
#pragma unroll
            for (int k = 0; k < 16; ++k) { y[k][0] = (_Float16)0.f; y[k][1] = (_Float16)0.f; }
            {
                v4u vb[16];
#pragma unroll 1
                for (int pass = 0; pass < PROBE_SWEEPS; ++pass) {
                if (pass > 0) {
#pragma unroll
                    for (int k = 0; k < 16; ++k) { y[k][0] = (_Float16)0.f; y[k][1] = (_Float16)0.f; } }
                asm volatile("s_waitcnt vmcnt(0)" ::: "memory");
#define V_F4(K, X, B) y[K] = __builtin_elementwise_fma(__builtin_bit_cast(h2, __builtin_amdgcn_cvt_scalef32_pk_f16_fp4(X, 1.0f, B)), a2_, y[K])
#define V_STEP(d, CNT, ISSUE, W, A) do { asm volatile("s_waitcnt vmcnt(" #CNT ")" : "+v"(vb[d]) :: "memory"); \
        { const v4u x_ = vb[d]; const h2 a2_ = __builtin_bit_cast(h2, __builtin_amdgcn_cvt_pkrtz(A, A)); \
          V_F4(0, x_.x, 0); V_F4(1, x_.x, 1); V_F4(2, x_.x, 2); V_F4(3, x_.x, 3); V_F4(4, x_.y, 0); V_F4(5, x_.y, 1); V_F4(6, x_.y, 2); V_F4(7, x_.y, 3); \
          V_F4(8, x_.z, 0); V_F4(9, x_.z, 1); V_F4(10, x_.z, 2); V_F4(11, x_.z, 3); V_F4(12, x_.w, 0); V_F4(13, x_.w, 1); V_F4(14, x_.w, 2); V_F4(15, x_.w, 3); } \
        if (ISSUE) HROW_ISSUE(vb[d], P.V8, W); } while (0)
#define V_CHUNK(i0, B, WA, WB, C0, C1, C2, C3, C4, C5, C6, C7, ISSUE) do { const f32x4 aa_ = *(const LAS f32x4*)(sgt + (i0)), ab_ = *(const LAS f32x4*)(sgt + (i0) + 4); \
        V_STEP(B + 0, C0, ISSUE, WA.x, aa_[0]); V_STEP(B + 1, C1, ISSUE, WA.y, aa_[1]); V_STEP(B + 2, C2, ISSUE, WA.z, aa_[2]); V_STEP(B + 3, C3, ISSUE, WA.w, aa_[3]); \
        V_STEP(B + 4, C4, ISSUE, WB.x, ab_[0]); V_STEP(B + 5, C5, ISSUE, WB.y, ab_[1]); V_STEP(B + 6, C6, ISSUE, WB.z, ab_[2]); V_STEP(B + 7, C7, ISSUE, WB.w, ab_[3]); } while (0)
                {
                    const v4u w0 = *(const LAS v4u*)(swt), w1 = *(const LAS v4u*)(swt + 4), w2 = *(const LAS v4u*)(swt + 8), w3 = *(const LAS v4u*)(swt + 12);
                    HROW_ISSUE(vb[0], P.V8, w0.x); HROW_ISSUE(vb[1], P.V8, w0.y); HROW_ISSUE(vb[2], P.V8, w0.z); HROW_ISSUE(vb[3], P.V8, w0.w);
                    HROW_ISSUE(vb[4], P.V8, w1.x); HROW_ISSUE(vb[5], P.V8, w1.y); HROW_ISSUE(vb[6], P.V8, w1.z); HROW_ISSUE(vb[7], P.V8, w1.w);
                    HROW_ISSUE(vb[8], P.V8, w2.x); HROW_ISSUE(vb[9], P.V8, w2.y); HROW_ISSUE(vb[10], P.V8, w2.z); HROW_ISSUE(vb[11], P.V8, w2.w);
                    HROW_ISSUE(vb[12], P.V8, w3.x); HROW_ISSUE(vb[13], P.V8, w3.y); HROW_ISSUE(vb[14], P.V8, w3.z); HROW_ISSUE(vb[15], P.V8, w3.w);
                }
                v4u wa = *(const LAS v4u*)(swt + 16), wb = *(const LAS v4u*)(swt + 20);
#pragma unroll 1
                for (int i0 = 0; i0 < 112; i0 += 16) {
                    const v4u wc = *(const LAS v4u*)(swt + i0 + 24), wd = *(const LAS v4u*)(swt + i0 + 28);
                    V_CHUNK(i0, 0, wa, wb, 15, 15, 15, 15, 15, 15, 15, 15, 1);
                    wa = *(const LAS v4u*)(swt + i0 + 32); wb = *(const LAS v4u*)(swt + i0 + 36);
                    V_CHUNK(i0 + 8, 8, wc, wd, 15, 15, 15, 15, 15, 15, 15, 15, 1);
                }
                V_CHUNK(112, 0, wa, wb, 15, 14, 13, 12, 11, 10, 9, 8, 0);
                V_CHUNK(120, 8, wa, wb, 7, 6, 5, 4, 3, 2, 1, 0, 0);
                }
#undef V_CHUNK
#undef V_STEP
#undef V_F4
            }
            {
                float* xr = P.out + (t0 + gq * 4 + tk) * 1024 + 32 * l5;
                f32x4 x[8]; float ss = 0.f;
#pragma unroll
                for (int m = 0; m < 8; ++m) {
                    { const v2u q = *((const v2u*)(P.X1B + (t0 + gq * 4 + tk) * 1024 + 32 * l5) + m); x[m][0] = bflo(q.x); x[m][1] = bfhi(q.x); x[m][2] = bflo(q.y); x[m][3] = bfhi(q.y); }
                    x[m][0] += (float)y[2 * m][0] * (1.0f / 128.0f); x[m][1] += (float)y[2 * m][1] * (1.0f / 128.0f); x[m][2] += (float)y[2 * m + 1][0] * (1.0f / 128.0f); x[m][3] += (float)y[2 * m + 1][1] * (1.0f / 128.0f);
                    ss += (x[m][0] * x[m][0] + x[m][1] * x[m][1]) + (x[m][2] * x[m][2] + x[m][3] * x[m][3]); }
                ss = row16_sum(ss);
                ss += __builtin_bit_cast(float, __builtin_amdgcn_ds_swizzle(__builtin_bit_cast(int, ss), 0x401F));
                const float rstd = 1.0f / sqrtf(ss * (1.0f / 1024.0f) + EPS);
#pragma unroll
                for (int m = 0; m < 8; ++m) { const f32x4 wv = *(const f32x4*)(P.fin_w + (32 * l5 + 4 * m)); *(f32x4*)(xr + 4 * m) = x[m] * rstd * wv; }
            }
        }
    }
}
#undef HROW_ISSUE

__device__ __forceinline__ void p7_peer(LAS unsigned char* lds, const Ptrs& P, int vcu, int G, int tid, int lane, int wave) {
    LAS bf16* k1l = (LAS bf16*)lds;
    LAS bf16* k2l = (LAS bf16*)(lds + 32768);
    LAS int* idxl = (LAS int*)(lds + 65536);
    LAS float* gatel = (LAS float*)(lds + 98304);
    for (int i = tid; i < 2048; i += 512) { const int n = i >> 4, c = i & 15, d = n * 16 + (c ^ (n & 15)); ((LAS v4u*)k1l)[d] = ((const v4u*)P.K1)[i]; ((LAS v4u*)k2l)[d] = ((const v4u*)P.K2)[i]; }
    __syncthreads();
    for (int unit = vcu; unit < M / 64; unit += G) {
#pragma unroll 1
        for (int st = 0; st < 4; ++st) {
            const int g = st >> 1;
            if ((st & 1) == 0) peer_topk_unit_mfma(P, (const LAS unsigned char*)k1l, (const LAS unsigned char*)k2l, idxl, gatel, unit, lane, wave, g, g + 1);
            else peer_gather_half(P, lds, unit, lane, wave, g, g + 1);
        }
        __syncthreads();
    }
}

struct Args { const float* in[19]; float* out; unsigned char* ws; int ph_lo, ph_hi; };
__global__ void __launch_bounds__(NWAVES * 64, 2) mega_fwd(Args args) {
    extern __shared__ __attribute__((aligned(16))) unsigned char lds_raw[];
    LAS unsigned char* lds = (LAS unsigned char*)lds_raw;
    const int tid = threadIdx.x, lane = tid & 63, wave = __builtin_amdgcn_readfirstlane(tid >> 6);
    const int G = gridDim.x; const int bx = blockIdx.x; const int vcu = (G % 8 == 0) ? (bx % 8) * (G / 8) + bx / 8 : bx;
    unsigned char* ws = args.ws;
    Ptrs P;
    P.x = args.in[0]; P.mix_w = args.in[1]; P.w_in = args.in[2]; P.rel_bias = args.in[3]; P.sinks = args.in[4]; P.w_pa = args.in[5]; P.ln_w = args.in[6]; P.ln_b = args.in[7];
    P.w_s = args.in[8]; P.b_s = args.in[9]; P.w_pb = args.in[10]; P.w_out = args.in[11]; P.ffn_w = args.in[12]; P.w_q = args.in[13]; P.keys1 = args.in[14]; P.keys2 = args.in[15];
    P.pu = args.in[16]; P.pv = args.in[17]; P.fin_w = args.in[18]; P.out = args.out;
    P.WIN = (bf16*)(ws + WS_WIN); P.WPA = (bf16*)(ws + WS_WPA); P.WPB = (bf16*)(ws + WS_WPB); P.WOUT = (bf16*)(ws + WS_WOUT); P.WQ = (bf16*)(ws + WS_WQ);
    P.K1 = (bf16*)(ws + WS_K1); P.K2 = (bf16*)(ws + WS_K2); P.WS = (bf16*)(ws + WS_WS);
    P.U8 = ws + WS_U; P.V8 = ws + WS_U + 16 * MiB; P.USC = (float*)(ws + WS_V); P.VSC = (float*)(ws + WS_V + 65536); P.HN8 = ws + WS_HN8; P.HSC = (float*)(ws + WS_HSC);
    P.XN = (bf16*)(ws + WS_R1); P.AOUT = (bf16*)(ws + WS_R1); P.BOUT = (bf16*)(ws + WS_R1 + 16 * MiB); P.HN2 = (bf16*)(ws + WS_MERGED); P.X1B = (bf16*)(ws + WS_R1);
    P.Q = (bf16*)(ws + WS_Q); P.KV = (bf16*)(ws + WS_KV); P.GU = (bf16*)(ws + WS_GU); P.GV = (bf16*)(ws + WS_GV); P.GA = (bf16*)(ws + WS_GA); P.GB = (bf16*)(ws + WS_GB);
    P.MERGED = (bf16*)(ws + WS_MERGED); P.QP = (bf16*)(ws + WS_QP);

    for (int u = tid; u < (LDS_BYTES - MISC_OFF) / 4; u += NWAVES * 64) ((LAS unsigned*)(lds + MISC_OFF))[u] = 0u;
    __syncthreads();
    const int lo = args.ph_lo, hi = args.ph_hi;
    unsigned* barw = (unsigned*)(ws + WS_CTL) + CW_BAR;
    XcdBarrier bar; bar.bar = barw; bar.x = 0; bar.st = nullptr;
    if (hi - lo > 1) bar = xcd_barrier_post(barw, (volatile LAS unsigned*)(lds + MISC_OFF));
#define IN(k) (lo <= (k) && (k) < hi)
#define BOTH(k) (IN(k) && IN((k) + 1))
#define GRID_BAR() xcd_barrier(bar)
#define REPS(k) ((k) == PROBE_PHASE ? 2 : 1)

    if (IN(0)) {
#pragma unroll
        for (int rep = 0; rep < REPS(0); ++rep) { p0_prologue(lds, P, vcu, G, lane, wave); __syncthreads(); }
        if (BOTH(0)) GRID_BAR(); }

    if (IN(1)) {
        pg8::Gemm g{P.XN, P.WIN, M, NZ, D}; pg8::StaticOrder S; S.init(M, NZ, G, bx);
        pg8::EpiZ E{P.Q, P.KV, P.GU, P.GV, P.GA, P.GB};
#pragma unroll
        for (int rep = 0; rep < REPS(1); ++rep) pg8::gemm_phase<pg8::EpiZ, pg8::StaticOrder, PG8_ALIGN, PG8_SP2>(lds, g, S, E);
        if (BOTH(1)) GRID_BAR();
    }

    if (IN(2)) {
        for (int rep = 0; rep < REPS(2); ++rep) {
        p2_attn_mfma(lds, P, vcu, G, tid, lane, wave);
        p2_gmlp_mfma(lds, P, vcu, G, tid, lane, wave);
        }
        if (BOTH(2)) GRID_BAR();
    }

    if (IN(3)) {
#pragma unroll
      for (int rep = 0; rep < REPS(3); ++rep) {
        { pg8::Gemm g{P.AOUT, P.WPA, M, D, 512}; pg8::StaticOrder S; S.init(M, D, G, bx);
          pg8::EpiGateTmp E{P.GA, (pg8::bf16_t*)P.out};
          pg8::gemm_phase<pg8::EpiGateTmp, pg8::StaticOrder, PG8_ALIGN, PG8_SP2>(lds, g, S, E); }
        { pg8::Gemm g{P.BOUT, P.WPB, M, D, 512}; pg8::StaticOrder S; S.init(M, D, G, bx);
          pg8::EpiMerge E{P.GB, (const pg8::bf16_t*)P.out, P.MERGED};
          pg8::gemm_phase<pg8::EpiMerge, pg8::StaticOrder, PG8_ALIGN, PG8_SP2>(lds, g, S, E); }
      }
        if (BOTH(3)) GRID_BAR();
    }

    if (IN(4)) {
        pg8::Gemm g{P.MERGED, P.WOUT, M, D, D}; pg8::StaticOrder S; S.init(M, D, G, bx);
        pg8::EpiResB E{P.x, (pg8::bf16_t*)P.X1B};
#pragma unroll
        for (int rep = 0; rep < REPS(4); ++rep) pg8::gemm_phase<pg8::EpiResB, pg8::StaticOrder, PG8_ALIGN, PG8_SP2>(lds, g, S, E);
        if (BOTH(4)) GRID_BAR();
    }

    if (IN(5)) {
        const int gw = vcu * NWAVES + wave, NGW = G * NWAVES;
#pragma unroll
        for (int rep = 0; rep < REPS(5); ++rep)
        for (int m = gw; m < M; m += NGW) rms_x1_row(P.X1B + (size_t)m * D, P.ffn_w, P.HN2 + (size_t)m * D, P.HN8 + (size_t)m * D, P.HSC + m, lane);
        if (BOTH(5)) GRID_BAR();
    }

    if (IN(6)) {
        pg8::Gemm g{P.HN2, P.WQ, M, 2048, D}; pg8::StaticOrder S; S.init(M, 2048, G, bx);
        pg8::EpiPlain E{P.QP, 2048};
#pragma unroll
        for (int rep = 0; rep < REPS(6); ++rep) pg8::gemm_phase<pg8::EpiPlain, pg8::StaticOrder, PG8_ALIGN, PG8_SP2>(lds, g, S, E);
        if (BOTH(6)) GRID_BAR();
    }

    if (IN(7)) p7_peer(lds, P, vcu, G, tid, lane, wave);
#undef IN
#undef BOTH
#undef GRID_BAR
}

extern "C" void kernel_launch(void* const* d_in, const int* in_sizes, int n_in, void* d_out, int out_size, void* d_ws, size_t ws_size, hipStream_t stream) {
    static int grid = 0;
    if (grid == 0) {
        if (n_in != 19 || out_size != M * D || ws_size < WS_END) { fprintf(stderr, "kernel_launch: unexpected shapes (n_in %d, out %d, ws %zu)\n", n_in, out_size, ws_size); grid = -1; return; }
        int dev = 0, cus = 0, per_cu = 0;
        if (hipGetDevice(&dev) != hipSuccess || hipDeviceGetAttribute(&cus, hipDeviceAttributeMultiprocessorCount, dev) != hipSuccess) { grid = -1; return; }
        if (hipFuncSetAttribute((const void*)mega_fwd, hipFuncAttributeMaxDynamicSharedMemorySize, LDS_BYTES) != hipSuccess) { fprintf(stderr, "kernel_launch: hipFuncSetAttribute failed\n"); grid = -1; return; }
        if (hipOccupancyMaxActiveBlocksPerMultiprocessor(&per_cu, (const void*)mega_fwd, NWAVES * 64, LDS_BYTES) != hipSuccess || per_cu < 1)
            fprintf(stderr, "kernel_launch: note: occupancy query reports %d workgroups per CU\n", per_cu);
        (void)hipGetLastError();
        grid = cus;
    }
    if (grid < 0) return;
    if (hipMemsetAsync((char*)d_ws + WS_CTL, 0, CTL_ZERO_BYTES, stream) != hipSuccess) return;
    Args a{};
    for (int i = 0; i < 19; ++i) a.in[i] = (const float*)d_in[i];
    a.out = (float*)d_out; a.ws = (unsigned char*)d_ws;
    a.ph_lo = 0; a.ph_hi = N_PHASES;
    hipLaunchKernelGGL(mega_fwd, dim3(grid), dim3(NWAVES * 64), LDS_BYTES, stream, a);
}
```

```cpp
#include <hip/hip_runtime.h>
#include <cstdio>
#include <cstdint>
#ifndef PROBE_SWEEPS
#define PROBE_SWEEPS 1
#endif
#ifndef PROBE_TOPK
#define PROBE_TOPK 1
#endif
#ifndef PROBE_PHASE
#define PROBE_PHASE -1
#endif
#ifndef FP4_SELFCHECK
#define FP4_SELFCHECK 0
#endif
#ifndef NSL
#define NSL 8
#endif
#ifndef Q4_USTEP
#define Q4_USTEP 0.36f
#endif
#ifndef Q4_VUNIT
#define Q4_VUNIT 0.5f
#endif
namespace pg8 {
#define PG8_LAS __attribute__((address_space(3)))
typedef unsigned short bf16_t;
typedef short bf16x8 __attribute__((ext_vector_type(8)));
typedef float f32x4 __attribute__((ext_vector_type(4)));
typedef unsigned u32x4 __attribute__((ext_vector_type(4)));
typedef int i32x4 __attribute__((ext_vector_type(4)));
constexpr int BM = 256, BK = 64, HALF = 128, HTB = HALF * BK * 2  , STAGE_BYTES = 8 * HTB, NXCD = 8, WGM = 8;

__host__ __device__ __forceinline__ int lds_byte(int r, int c) { const int st = (r >> 4) * 2 + (c >> 5), rr = r & 15, cc = c & 31, ob = rr * 64 + cc * 2; return st * 1024 + (ob ^ (((ob >> 9) & 1) << 5)); }
__host__ __device__ __forceinline__ void stage_rc(int b, int& R, int& C) { const int st = b / 1024, sb = b % 1024, swz = sb ^ (((sb >> 9) & 1) << 5); R = (st >> 1) * 16 + swz / 64; C = (st & 1) * 32 + (swz % 64) / 2; }
__host__ __device__ __forceinline__ int perm32(int rho) { const int n = rho >> 4, i = rho & 15; return 8 * (i >> 2) + 4 * n + (i & 3); }

struct Unit { int pm, pn; };
struct Gemm { const bf16_t* A; const bf16_t* Bt; int M, N, K, lda; const float* rs; const float* cs; };

struct StaticOrder {
    int nM, nN, nwg, G, c;
    __host__ __device__ void init(int M, int N, int G_, int c_) { nM = M / BM; nN = N / BM; nwg = nM * nN; G = G_; c = c_; }
    __host__ __device__ bool next(int i, Unit& u) const {
        const long L = (long)i * G + c; if (L >= nwg) return false;
        int wgid = (int)L; { const int q = nwg / NXCD, r = nwg % NXCD, xcd = wgid % NXCD, off = wgid / NXCD; wgid = (xcd < r ? xcd * (q + 1) : r * (q + 1) + (xcd - r) * q) + off; }
        const int nig = WGM * nN, gid = wgid / nig, fm = gid * WGM, gsz = (nM - fm) < WGM ? (nM - fm) : WGM;
        u.pm = fm + ((wgid % nig) % gsz); u.pn = (wgid % nig) / gsz; return true;
    }
    __device__ __forceinline__ void a_ready(const Unit&) const {}
    __device__ __forceinline__ void done(const Unit&) const {}
};

__device__ __forceinline__ unsigned cvt_pk_bf16(float lo, float hi) { unsigned r; asm volatile("v_cvt_pk_bf16_f32 %0, %1, %2" : "=v"(r) : "v"(lo), "v"(hi)); return r; }
typedef float f32x2 __attribute__((ext_vector_type(2)));
template <class Epi, class Sched, bool ALIGN_EPI = false, bool SP2 = false, bool I8 = false>
__device__ __forceinline__ void gemm_phase(PG8_LAS unsigned char* lds, const Gemm g, const Sched& S, const Epi& E) {
    const int tid = threadIdx.x, wid = __builtin_amdgcn_readfirstlane(tid >> 6), lane = tid & 63, wr = wid >> 2, wc = wid & 3, fr = lane & 15, fq = lane >> 4;
    const int K = g.K, nt = K / BK;
    unsigned voffA[2], voffB[2];
#pragma unroll
    for (int i = 0; i < 2; ++i) { int R, C; stage_rc(tid * 16 + i * 8192, R, C); const int Rb = Epi::PERM ? ((R & ~31) + perm32(R & 31)) : R;
        voffA[i] = (unsigned)(R * g.lda + C) * 2u; voffB[i] = (unsigned)(Rb * K + C) * 2u; }
    const size_t kstep = (size_t)(BK * 2);
    const size_t hstep = (size_t)HALF * K * 2;
    const size_t tstep = 2 * hstep;
    const size_t hstepA = (size_t)HALF * g.lda * 2, tstepA = 2 * hstepA;
    const unsigned ldsw = (unsigned)wid * 1024u;
    const int aoff = lds_byte(wr * 64 + fr, fq * 8), boff = lds_byte(wc * 32 + fr, fq * 8);
#define PG8_SA(b, h) (((b) * 2 + (h)) * HTB)
#define PG8_SB(b, h) ((4 + (b) * 2 + (h)) * HTB)
#define PG8_STAGE(bufoff, gbase, voff) do { _Pragma("unroll") for (int _i = 0; _i < 2; ++_i) \
        __builtin_amdgcn_global_load_lds((const unsigned*)((const char*)(gbase) + (voff)[_i]), (PG8_LAS unsigned*)(lds + (bufoff) + ldsw + _i * 8192), 16, 0, 0); } while (0)
#define PG8_LDA(dst, b, h) do { _Pragma("unroll") for (int m = 0; m < 4; ++m) _Pragma("unroll") for (int k = 0; k < 2; ++k) dst[m][k] = *(const PG8_LAS bf16x8*)(lds + PG8_SA(b, h) + aoff + m * 2048 + k * 1024); } while (0)
#define PG8_LDB(dst, b, h) do { _Pragma("unroll") for (int n = 0; n < 2; ++n) _Pragma("unroll") for (int k = 0; k < 2; ++k) dst[n][k] = *(const PG8_LAS bf16x8*)(lds + PG8_SB(b, h) + boff + n * 2048 + k * 1024); } while (0)
#define PG8_MMA(ai, bj, At, Bt) do { __builtin_amdgcn_s_setprio(1); _Pragma("unroll") for (int m = 0; m < 4; ++m) _Pragma("unroll") for (int n = 0; n < 2; ++n) _Pragma("unroll") for (int k = 0; k < 2; ++k) \
        { if constexpr (I8) acc[ai][bj][m][n] = __builtin_bit_cast(f32x4, __builtin_amdgcn_mfma_i32_16x16x64_i8(__builtin_bit_cast(i32x4, Bt[n][k]), __builtin_bit_cast(i32x4, At[m][k]), __builtin_bit_cast(i32x4, acc[ai][bj][m][n]), 0, 0, 0)); \
          else acc[ai][bj][m][n] = __builtin_amdgcn_mfma_f32_16x16x32_bf16(Bt[n][k], At[m][k], acc[ai][bj][m][n], 0, 0, 0); } __builtin_amdgcn_s_setprio(0); } while (0)
#define PG8_WAIT_V(n) asm volatile("s_waitcnt vmcnt(" #n ")" ::: "memory")
#define PG8_WAIT_L(n) asm volatile("s_waitcnt lgkmcnt(" #n ")" ::: "memory")
#define PG8_BAR __builtin_amdgcn_s_barrier()
#define PG8_SCHED __builtin_amdgcn_sched_barrier(0)
    Unit cur, nxt; int ui = 0;
    if (!S.next(0, cur)) return;
    f32x4 acc[2][2][4][2];
#pragma unroll
    for (int a = 0; a < 2; ++a)
#pragma unroll
        for (int b = 0; b < 2; ++b)
#pragma unroll
            for (int m = 0; m < 4; ++m)
#pragma unroll
                for (int n = 0; n < 2; ++n) acc[a][b][m][n] = (f32x4){0.f, 0.f, 0.f, 0.f};
    bf16x8 At[4][2], B0[2][2], B1[2][2];
    const char* cA = (const char*)g.A + (size_t)cur.pm * tstepA; const char* cB = (const char*)g.Bt + (size_t)cur.pn * tstep;
    S.a_ready(cur);
    if constexpr (SP2) {
        PG8_STAGE(PG8_SB(0, 0), cB, voffB); PG8_STAGE(PG8_SB(0, 1), cB + hstep, voffB); PG8_STAGE(PG8_SA(0, 0), cA, voffA); PG8_STAGE(PG8_SA(0, 1), cA + hstepA, voffA);
        if (wr == 1) PG8_BAR;
        PG8_WAIT_V(2); PG8_BAR;
        PG8_STAGE(PG8_SB(1, 0), cB + kstep, voffB); PG8_STAGE(PG8_SA(1, 0), cA + kstep, voffA); PG8_STAGE(PG8_SB(1, 1), cB + hstep + kstep, voffB);
        PG8_WAIT_V(6); PG8_BAR;
    } else {
        PG8_STAGE(PG8_SB(0, 0), cB, voffB); PG8_STAGE(PG8_SA(0, 0), cA, voffA); PG8_STAGE(PG8_SB(0, 1), cB + hstep, voffB); PG8_STAGE(PG8_SA(0, 1), cA + hstepA, voffA);
        if (wr == 1) PG8_BAR;
        PG8_WAIT_V(4); PG8_BAR;
        PG8_STAGE(PG8_SB(1, 0), cB + kstep, voffB); PG8_STAGE(PG8_SA(1, 0), cA + kstep, voffA); PG8_STAGE(PG8_SB(1, 1), cB + hstep + kstep, voffB);
        PG8_WAIT_V(6); PG8_BAR;
    }
    for (;;) {
        const bool has_next = S.next(ui + 1, nxt);
        const char* nA = has_next ? (const char*)g.A + (size_t)nxt.pm * tstepA : cA; const char* nB = has_next ? (const char*)g.Bt + (size_t)nxt.pn * tstep : cB;
        for (int t = 0; t < nt; t += 2) {
            if constexpr (Epi::HAS_MID) { if (t == (nt >> 1)) E.mid(acc, cur, wr, wc, fr, fq); }
            const bool last = (t == nt - 2);
            const char* a1 = cA + (size_t)(t + 1) * kstep;
            const char* a2 = last ? nA : cA + (size_t)(t + 2) * kstep; const char* b2 = last ? nB : cB + (size_t)(t + 2) * kstep;
            const char* a3 = a2 + kstep; const char* b3 = b2 + kstep;
            if (last && has_next) S.a_ready(nxt);
            if constexpr (SP2) {
            PG8_LDB(B0, 0, 0); PG8_LDB(B1, 0, 1); PG8_SCHED; PG8_LDA(At, 0, 0); PG8_STAGE(PG8_SA(1, 1), a1 + hstepA, voffA);
            PG8_WAIT_V(8); PG8_WAIT_L(0); PG8_BAR; PG8_MMA(0, 0, At, B0); PG8_MMA(0, 1, At, B1); PG8_BAR; PG8_SCHED;
            PG8_LDA(At, 0, 1); PG8_STAGE(PG8_SB(0, 0), b2, voffB); PG8_STAGE(PG8_SB(0, 1), b2 + hstep, voffB); PG8_STAGE(PG8_SA(0, 0), a2, voffA);
            PG8_WAIT_V(8); PG8_WAIT_L(0); PG8_BAR; PG8_MMA(1, 0, At, B0); PG8_MMA(1, 1, At, B1); PG8_BAR; PG8_SCHED;
            PG8_LDB(B0, 1, 0); PG8_LDB(B1, 1, 1); PG8_SCHED; PG8_LDA(At, 1, 0); PG8_STAGE(PG8_SA(0, 1), a2 + hstepA, voffA);
            PG8_WAIT_V(8); PG8_WAIT_L(0); PG8_BAR; PG8_MMA(0, 0, At, B0); PG8_MMA(0, 1, At, B1); PG8_BAR; PG8_SCHED;
            PG8_LDA(At, 1, 1); PG8_STAGE(PG8_SB(1, 0), b3, voffB); PG8_STAGE(PG8_SB(1, 1), b3 + hstep, voffB); PG8_STAGE(PG8_SA(1, 0), a3, voffA);
            PG8_WAIT_V(8); PG8_WAIT_L(0); PG8_BAR; PG8_MMA(1, 0, At, B0); PG8_MMA(1, 1, At, B1); PG8_BAR; PG8_SCHED;
            } else {
            PG8_LDB(B0, 0, 0); PG8_SCHED; PG8_LDA(At, 0, 0); PG8_STAGE(PG8_SA(1, 1), a1 + hstepA, voffA);
            PG8_WAIT_L(8); PG8_BAR; PG8_WAIT_L(0); PG8_MMA(0, 0, At, B0); PG8_BAR; PG8_SCHED;
            PG8_LDB(B1, 0, 1); PG8_STAGE(PG8_SB(0, 0), b2, voffB);
            PG8_BAR; PG8_WAIT_L(0); PG8_MMA(0, 1, At, B1); PG8_BAR;
            PG8_LDA(At, 0, 1); PG8_STAGE(PG8_SA(0, 0), a2, voffA);
            PG8_BAR; PG8_WAIT_L(0); PG8_MMA(1, 0, At, B0); PG8_BAR; PG8_SCHED;
            PG8_STAGE(PG8_SB(0, 1), b2 + hstep, voffB);
            PG8_WAIT_V(6); PG8_BAR; PG8_MMA(1, 1, At, B1); PG8_BAR;
            PG8_LDB(B0, 1, 0); PG8_SCHED; PG8_LDA(At, 1, 0); PG8_STAGE(PG8_SA(0, 1), a2 + hstepA, voffA);
            PG8_WAIT_L(8); PG8_BAR; PG8_WAIT_L(0); PG8_MMA(0, 0, At, B0); PG8_BAR; PG8_SCHED;
            PG8_LDB(B1, 1, 1); PG8_STAGE(PG8_SB(1, 0), b3, voffB);
            PG8_BAR; PG8_WAIT_L(0); PG8_MMA(0, 1, At, B1); PG8_BAR;
            PG8_LDA(At, 1, 1); PG8_STAGE(PG8_SA(1, 0), a3, voffA);
            PG8_BAR; PG8_WAIT_L(0); PG8_MMA(1, 0, At, B0); PG8_BAR; PG8_SCHED;
            PG8_STAGE(PG8_SB(1, 1), b3 + hstep, voffB);
            PG8_WAIT_V(6); PG8_BAR; PG8_MMA(1, 1, At, B1); PG8_BAR;
            }
        }
        if constexpr (ALIGN_EPI) { if (wr == 0) PG8_BAR; }
        if constexpr (I8) {
            f32x4 csv[2][2];
#pragma unroll
            for (int bj = 0; bj < 2; ++bj)
#pragma unroll
                for (int n = 0; n < 2; ++n) csv[bj][n] = *(const f32x4*)(g.cs + cur.pn * BM + bj * HALF + wc * 32 + (Epi::PERM ? 8 * fq + 4 * n : 16 * n + 4 * fq));
#pragma unroll
            for (int ai = 0; ai < 2; ++ai)
#pragma unroll
                for (int m = 0; m < 4; ++m) { const float rsv = g.rs[cur.pm * BM + ai * HALF + wr * 64 + m * 16 + fr];
#pragma unroll
                    for (int bj = 0; bj < 2; ++bj)
#pragma unroll
                        for (int n = 0; n < 2; ++n) { const i32x4 iv = __builtin_bit_cast(i32x4, acc[ai][bj][m][n]); f32x4 fv;
                            fv[0] = (float)iv[0]; fv[1] = (float)iv[1]; fv[2] = (float)iv[2]; fv[3] = (float)iv[3];
                            acc[ai][bj][m][n] = fv * rsv * csv[bj][n]; } }
        }
        if constexpr (!Epi::AFTER_DRAIN) { E(acc, cur, wr, wc, fr, fq); S.done(cur); }
        if (!has_next) break;
#pragma unroll
        for (int a = 0; a < 2; ++a)
#pragma unroll
            for (int b = 0; b < 2; ++b)
#pragma unroll
                for (int m = 0; m < 4; ++m)
#pragma unroll
                    for (int n = 0; n < 2; ++n) acc[a][b][m][n] = (f32x4){0.f, 0.f, 0.f, 0.f};
        cur = nxt; cA = nA; cB = nB; ++ui;
        if constexpr (ALIGN_EPI) { if (wr == 1) PG8_BAR; }
    }
    PG8_WAIT_V(0);
    if constexpr (!ALIGN_EPI) { if (wr == 0) PG8_BAR; }
    PG8_BAR;
    if constexpr (Epi::AFTER_DRAIN) { E.fused(acc, cur, wr, wc, fr, fq, lds, wid, lane); S.done(cur); }
#undef PG8_SA
#undef PG8_SB
#undef PG8_STAGE
#undef PG8_LDA
#undef PG8_LDB
#undef PG8_MMA
#undef PG8_WAIT_V
#undef PG8_WAIT_L
#undef PG8_BAR
#undef PG8_SCHED
}
}
#ifndef PG8_SP2
#define PG8_SP2 true
#endif
#ifndef PG8_ALIGN
#define PG8_ALIGN true
#endif

constexpr int NWAVES = 8;
constexpr int N_PHASES = 8;
#define SLSH (NSL == 4 ? 12 : NSL == 2 ? 13 : NSL == 64 ? 8 : NSL == 32 ? 9 : NSL == 16 ? 10 : 11)

constexpr int NB = 2, SEQ = 8192, D = 1024, M = NB * SEQ;
constexpr int NZ = 3840;
constexpr float EPS = 1e-6f;
constexpr int AB_LD = 1024;

constexpr size_t MiB = 1u << 20;
constexpr size_t WS_CTL = 0, CTL_ZERO_BYTES = 65536;
constexpr size_t WS_WIN = 1 * MiB;
constexpr size_t WS_WPA = 9 * MiB;
constexpr size_t WS_WOUT = 11 * MiB;
constexpr size_t WS_WQ = 13 * MiB;
constexpr size_t WS_K1 = 17 * MiB;
constexpr size_t WS_K2 = 17 * MiB + 32768;
constexpr size_t WS_WS = 17 * MiB + 65536;
constexpr size_t WS_U = 18 * MiB;
constexpr size_t WS_V = 34 * MiB;
constexpr size_t WS_G1 = 36 * MiB;
constexpr size_t WS_G2 = 68 * MiB;
constexpr size_t WS_G3 = 132 * MiB;
constexpr size_t WS_Q = 164 * MiB;
constexpr size_t WS_KV = 180 * MiB;
constexpr size_t WS_GU = 188 * MiB;
constexpr size_t WS_GV = 204 * MiB;
constexpr size_t WS_HSC = 220 * MiB;
constexpr size_t WS_END = 221 * MiB;
constexpr int CW_BAR = 0;

constexpr int RING_BYTES = 131072;
constexpr int MISC_OFF = 159744;
constexpr int LDS_BYTES = 163840;

#define GAS __attribute__((address_space(1)))
#define LAS __attribute__((address_space(3)))
typedef unsigned short bf16;
typedef unsigned v4u __attribute__((ext_vector_type(4)));
typedef unsigned v2u __attribute__((ext_vector_type(2)));
typedef float f32x4 __attribute__((ext_vector_type(4)));
typedef _Float16 h2 __attribute__((ext_vector_type(2)));
typedef GAS unsigned gu32;
typedef __bf16 bf16x2_t __attribute__((ext_vector_type(2)));
#define RLX_AGENT __ATOMIC_RELAXED, __HIP_MEMORY_SCOPE_AGENT
#define LDS_WAIT() asm volatile("s_waitcnt lgkmcnt(0)" ::: "memory")
#define VM_WAIT() asm volatile("s_waitcnt vmcnt(0)" ::: "memory")
__device__ __forceinline__ unsigned f2bf(float f) { unsigned u = __builtin_bit_cast(unsigned, f); return (u + 0x7fffu + ((u >> 16) & 1u)) >> 16; }
__device__ __forceinline__ unsigned pk2(float lo, float hi) { return f2bf(lo) | (f2bf(hi) << 16); }
__device__ __forceinline__ float bflo(unsigned w) { return __builtin_bit_cast(float, w << 16); }
__device__ __forceinline__ float bfhi(unsigned w) { return __builtin_bit_cast(float, w & 0xffff0000u); }
__device__ __forceinline__ float bf2f(bf16 h) { return __builtin_bit_cast(float, (unsigned)h << 16); }
__device__ __forceinline__ float dot2bf(unsigned a, unsigned b, float c) { return __builtin_amdgcn_fdot2_f32_bf16(__builtin_bit_cast(bf16x2_t, a), __builtin_bit_cast(bf16x2_t, b), c, false); }
__device__ __forceinline__ float gelu_tanh(float v) {
    const float t2 = v * (-2.302208198f + (-0.1029432397f) * v * v);
    return v * __builtin_amdgcn_rcpf(1.0f + __builtin_amdgcn_exp2f(t2));
}
__device__ __forceinline__ float sigmoid_f(float v) { return __builtin_amdgcn_rcpf(1.0f + __builtin_amdgcn_exp2f(-1.4426950409f * v)); }
template <int CTRL> __device__ __forceinline__ float dppmov(float v) { return __builtin_bit_cast(float, __builtin_amdgcn_update_dpp(0, __builtin_bit_cast(int, v), CTRL, 0xF, 0xF, false)); }
__device__ __forceinline__ float row16_sum(float v) {
    v += dppmov<0xB1>(v);
    v += dppmov<0x4E>(v);
    v += dppmov<0x141>(v);
    v += dppmov<0x140>(v);
    return v;
}
__device__ __forceinline__ float xor32_f(float v) {
    const unsigned u = __builtin_bit_cast(unsigned, v);
    auto rr = __builtin_amdgcn_permlane32_swap(u, u, false, false);
    const unsigned r0 = rr[0], r1 = rr[1];
    return __builtin_bit_cast(float, (__lane_id() & 32) ? r0 : r1);
}
__device__ __forceinline__ float wave_sum(float v) {
    v = row16_sum(v);
    v += __builtin_bit_cast(float, __builtin_amdgcn_ds_swizzle(__builtin_bit_cast(int, v), 0x401F));
    const unsigned u = __builtin_bit_cast(unsigned, v);
    auto rr = __builtin_amdgcn_permlane32_swap(u, u, false, false);
    const unsigned r0 = rr[0], r1 = rr[1];
    return __builtin_bit_cast(float, r0) + __builtin_bit_cast(float, r1);
}
__device__ __forceinline__ float wave_max(float v) {
    v = fmaxf(v, dppmov<0xB1>(v)); v = fmaxf(v, dppmov<0x4E>(v)); v = fmaxf(v, dppmov<0x141>(v)); v = fmaxf(v, dppmov<0x140>(v));
    v = fmaxf(v, __builtin_bit_cast(float, __builtin_amdgcn_ds_swizzle(__builtin_bit_cast(int, v), 0x401F)));
    const unsigned u = __builtin_bit_cast(unsigned, v);
    auto rr = __builtin_amdgcn_permlane32_swap(u, u, false, false);
    const unsigned r0 = rr[0], r1 = rr[1];
    return fmaxf(__builtin_bit_cast(float, r0), __builtin_bit_cast(float, r1));
}
__device__ const unsigned char T5B[128] = {0, 1, 2, 3, 4, 5, 6, 7, 8, 9, 10, 11, 12, 13, 14, 15, 16, 16, 16, 17, 17, 18, 18, 18, 19, 19, 19, 20, 20, 20, 20, 21, 21, 21, 21, 22, 22, 22, 22, 22, 23, 23, 23, 23, 23, 23, 24, 24, 24, 24, 24, 24, 25, 25, 25, 25, 25, 25, 25, 26, 26, 26, 26, 26, 26, 26, 26, 27, 27, 27, 27, 27, 27, 27, 27, 27, 27, 28, 28, 28, 28, 28, 28, 28, 28, 28, 28, 29, 29, 29, 29, 29, 29, 29, 29, 29, 29, 29, 29, 30, 30, 30, 30, 30, 30, 30, 30, 30, 30, 30, 30, 30, 30, 31, 31, 31, 31, 31, 31, 31, 31, 31, 31, 31, 31, 31, 31, 31};
#define XB_TMO      128
#define XB_XCNT(j)  (256  + 64 * (j))
#define XB_XSUB(j)  (1280 + 64 * (j))
#define XB_XGEN(j)  (2304 + 64 * (j))
#define XB_TOP      3328
#define XB_TOPGEN   3392
#define XCD_BAR_WORDS 3456
#define XB_SPIN_CAP (1u << 18)

__device__ __forceinline__ unsigned xb_ld(unsigned* p)              { return __hip_atomic_load(p, __ATOMIC_RELAXED, __HIP_MEMORY_SCOPE_AGENT); }
__device__ __forceinline__ unsigned xb_add(unsigned* p, unsigned v) { return __hip_atomic_fetch_add(p, v, __ATOMIC_RELAXED, __HIP_MEMORY_SCOPE_AGENT); }
__device__ __forceinline__ unsigned xb_xcc_id() { return (unsigned)__builtin_amdgcn_s_getreg((3 << 11) | 20) & 0xFu; }
#define XB_SPIN(cond, bar) do { unsigned _sp = 0; while (cond) { __builtin_amdgcn_s_sleep(1); \
    if ((++_sp & 255u) == 0u) { if (xb_ld(&(bar)[XB_TMO])) break; if (_sp > XB_SPIN_CAP) { atomicAdd(&(bar)[XB_TMO], 1u); break; } } } } while (0)

struct XcdBarrier {
    unsigned* bar; unsigned x;
    volatile LAS unsigned* st;
};

__device__ __forceinline__ XcdBarrier xcd_barrier_post(unsigned* bar, volatile LAS unsigned* st) {
    XcdBarrier b; b.bar = bar; b.x = xb_xcc_id(); b.st = st;
    if (threadIdx.x == 0) (void)xb_add(&bar[XB_XCNT(b.x)], 1u);
    return b;
}
__device__ __forceinline__ void xcd_barrier_complete(unsigned* bar, unsigned x, unsigned& nloc, unsigned& nx) {
    const unsigned G = gridDim.x * gridDim.y * gridDim.z;
    unsigned sum, cnt, mine, sp = 0u;
    for (;;) {
        sum = 0u; cnt = 0u; mine = 0u;
#pragma unroll
        for (unsigned j = 0; j < 16; ++j) { const unsigned c = xb_ld(&bar[XB_XCNT(j)]); sum += c; cnt += (c > 0u) ? 1u : 0u; mine = (j == x) ? c : mine; }
        if (sum == G) break;
        __builtin_amdgcn_s_sleep(1);
        if ((++sp & 255u) == 0u) { if (xb_ld(&bar[XB_TMO])) break; if (sp > XB_SPIN_CAP) { atomicAdd(&bar[XB_TMO], 1u); break; } }
    }
    nloc = mine > 0u ? mine : 1u; nx = cnt > 0u ? cnt : 1u;
}

__device__ __forceinline__ void xcd_barrier(const XcdBarrier& b) {
    asm volatile("s_waitcnt vmcnt(0)" ::: "memory");
    __syncthreads();
    if (threadIdx.x == 0) {
        unsigned* bar = b.bar;
        __builtin_amdgcn_s_waitcnt(0);
        unsigned nloc = b.st[0], nx = b.st[1];
        if (nloc == 0u) { xcd_barrier_complete(bar, b.x, nloc, nx); b.st[0] = nloc; b.st[1] = nx; }
        const unsigned old = xb_add(&bar[XB_XSUB(b.x)], 1u);
        const unsigned gen = old / nloc;
        if (old + 1u == (gen + 1u) * nloc) {
            __builtin_amdgcn_fence(__ATOMIC_RELEASE, "agent");
            asm volatile("s_waitcnt vmcnt(0)" ::: "memory");
            const unsigned og = xb_add(&bar[XB_TOP], 1u);
            const unsigned tg = og / nx;
            if (og + 1u == (tg + 1u) * nx) xb_add(&bar[XB_TOPGEN], 1u);
            else XB_SPIN(xb_ld(&bar[XB_TOPGEN]) == tg, bar);
            __builtin_amdgcn_fence(__ATOMIC_ACQUIRE, "agent");
            xb_add(&bar[XB_XGEN(b.x)], 1u);
            asm volatile("s_waitcnt vmcnt(0)" ::: "memory");
        } else {
            XB_SPIN(xb_ld(&bar[XB_XGEN(b.x)]) == gen, bar);
            __builtin_amdgcn_fence(__ATOMIC_ACQUIRE, "agent");
            asm volatile("s_waitcnt vmcnt(0)" ::: "memory");
        }
    }
    __syncthreads();
}
#define ST16(PTR, VAL) (*(PTR) = (VAL))
namespace pg8 {
struct EpiZ {
    static constexpr bool PERM = true, AFTER_DRAIN = false, HAS_MID = false;
    bf16_t *Q, *KV, *GU, *GV, *GA, *GB;
    __device__ __forceinline__ void operator()(const f32x4 (&acc)[2][2][4][2], const Unit& u, int wr, int wc, int fr, int fq) const {
        const int pn = u.pn; bf16_t* base; int ldc, colt, act;
        if (pn < 2)       { base = Q;  ldc = 512;  colt = pn * 256;        act = 0; }
        else if (pn == 2) { base = KV; ldc = 256;  colt = 0;               act = 0; }
        else if (pn < 5)  { base = GU; ldc = 512;  colt = (pn - 3) * 256;  act = 1; }
        else if (pn < 7)  { base = GV; ldc = 512;  colt = (pn - 5) * 256;  act = 1; }
        else if (pn < 11) { base = GA; ldc = 2048; colt = (pn - 7) * 256;  act = 2; }
        else              { base = GB; ldc = 2048; colt = (pn - 11) * 256; act = 2; }
        const int row0 = u.pm * BM + wr * 64 + fr, col0 = colt + wc * 32 + 8 * fq;
#pragma unroll
        for (int ai = 0; ai < 2; ++ai)
#pragma unroll
            for (int m = 0; m < 4; ++m) { bf16_t* rowp = base + (size_t)(row0 + ai * HALF + m * 16) * ldc + col0;
#pragma unroll
                for (int bj = 0; bj < 2; ++bj) { f32x4 v0 = acc[ai][bj][m][0], v1 = acc[ai][bj][m][1];
                    if (act == 1) {
#pragma unroll
                        for (int e = 0; e < 4; ++e) { v0[e] = gelu_tanh(v0[e]); v1[e] = gelu_tanh(v1[e]); }
                    } else if (act == 2) {
#pragma unroll
                        for (int e = 0; e < 4; ++e) { v0[e] = sigmoid_f(v0[e]); v1[e] = sigmoid_f(v1[e]); }
                    }
                    u32x4 w; w.x = cvt_pk_bf16(v0[0], v0[1]); w.y = cvt_pk_bf16(v0[2], v0[3]); w.z = cvt_pk_bf16(v1[0], v1[1]); w.w = cvt_pk_bf16(v1[2], v1[3]);
                    ST16((u32x4*)(rowp + bj * HALF), w); } }
    }
};
struct EpiMerge2 {
    static constexpr bool PERM = true, AFTER_DRAIN = false, HAS_MID = true;
    const bf16_t* ga; bf16_t* out;
    __device__ __forceinline__ void mid(f32x4 (&acc)[2][2][4][2], const Unit& u, int wr, int wc, int fr, int fq) const {
        int row0 = u.pm * BM + wr * 64 + fr, col0 = u.pn * BM + wc * 32 + 8 * fq;
        asm volatile("" : "+v"(row0), "+v"(col0));
#pragma unroll
        for (int ai = 0; ai < 2; ++ai)
#pragma unroll
            for (int m = 0; m < 4; ++m) { const bf16_t* gp = ga + (size_t)(row0 + ai * HALF + m * 16) * 2048 + col0;
#pragma unroll
                for (int bj = 0; bj < 2; ++bj) { const u32x4 a = *(const u32x4*)(gp + bj * HALF), b = *(const u32x4*)(gp + 1024 + bj * HALF);
                    f32x4 r0, r1;
                    r0[0] = bflo(a.x) * __builtin_amdgcn_rcpf(fmaxf(bflo(b.x), 1e-20f)); r0[1] = bfhi(a.x) * __builtin_amdgcn_rcpf(fmaxf(bfhi(b.x), 1e-20f)); r0[2] = bflo(a.y) * __builtin_amdgcn_rcpf(fmaxf(bflo(b.y), 1e-20f)); r0[3] = bfhi(a.y) * __builtin_amdgcn_rcpf(fmaxf(bfhi(b.y), 1e-20f));
                    r1[0] = bflo(a.z) * __builtin_amdgcn_rcpf(fmaxf(bflo(b.z), 1e-20f)); r1[1] = bfhi(a.z) * __builtin_amdgcn_rcpf(fmaxf(bfhi(b.z), 1e-20f)); r1[2] = bflo(a.w) * __builtin_amdgcn_rcpf(fmaxf(bflo(b.w), 1e-20f)); r1[3] = bfhi(a.w) * __builtin_amdgcn_rcpf(fmaxf(bfhi(b.w), 1e-20f));
                    acc[ai][bj][m][0] = acc[ai][bj][m][0] * r0; acc[ai][bj][m][1] = acc[ai][bj][m][1] * r1;
                    asm volatile("" ::: "memory"); } }
    }
    __device__ __forceinline__ void operator()(const f32x4 (&acc)[2][2][4][2], const Unit& u, int wr, int wc, int fr, int fq) const {
        const int row0 = u.pm * BM + wr * 64 + fr, col0 = u.pn * BM + wc * 32 + 8 * fq;
#pragma unroll
        for (int ai = 0; ai < 2; ++ai)
#pragma unroll
            for (int m = 0; m < 4; ++m) { const size_t rr = (size_t)(row0 + ai * HALF + m * 16);
#pragma unroll
                for (int bj = 0; bj < 2; ++bj) { const u32x4 b = *(const u32x4*)(ga + rr * 2048 + 1024 + col0 + bj * HALF); f32x4 v0 = acc[ai][bj][m][0], v1 = acc[ai][bj][m][1];
                    v0[0] *= fmaxf(bflo(b.x), 1e-20f); v0[1] *= fmaxf(bfhi(b.x), 1e-20f); v0[2] *= fmaxf(bflo(b.y), 1e-20f); v0[3] *= fmaxf(bfhi(b.y), 1e-20f);
                    v1[0] *= fmaxf(bflo(b.z), 1e-20f); v1[1] *= fmaxf(bfhi(b.z), 1e-20f); v1[2] *= fmaxf(bflo(b.w), 1e-20f); v1[3] *= fmaxf(bfhi(b.w), 1e-20f);
                    u32x4 w; w.x = cvt_pk_bf16(v0[0], v0[1]); w.y = cvt_pk_bf16(v0[2], v0[3]); w.z = cvt_pk_bf16(v1[0], v1[1]); w.w = cvt_pk_bf16(v1[2], v1[3]);
                    ST16((u32x4*)(out + rr * 1024 + col0 + bj * HALF), w); } }
    }
};
struct EpiResB {
    static constexpr bool PERM = true, AFTER_DRAIN = false, HAS_MID = false;
    const float* base; bf16_t* Cb;
    __device__ __forceinline__ void operator()(const f32x4 (&acc)[2][2][4][2], const Unit& u, int wr, int wc, int fr, int fq) const {
        const int row0 = u.pm * BM + wr * 64 + fr, col0 = u.pn * BM + wc * 32 + 8 * fq;
#pragma unroll
        for (int ai = 0; ai < 2; ++ai)
#pragma unroll
            for (int m = 0; m < 4; ++m) { const size_t ro = (size_t)(row0 + ai * HALF + m * 16) * 1024 + col0;
#pragma unroll
                for (int bj = 0; bj < 2; ++bj) { const f32x4 v0 = *(const f32x4*)(base + ro + bj * HALF) + acc[ai][bj][m][0], v1 = *(const f32x4*)(base + ro + bj * HALF + 4) + acc[ai][bj][m][1];
                    u32x4 w; w.x = cvt_pk_bf16(v0[0], v0[1]); w.y = cvt_pk_bf16(v0[2], v0[3]); w.z = cvt_pk_bf16(v1[0], v1[1]); w.w = cvt_pk_bf16(v1[2], v1[3]);
                    ST16((u32x4*)(Cb + ro + bj * HALF), w); } }
    }
};
struct EpiPlain {
    static constexpr bool PERM = true, AFTER_DRAIN = false, HAS_MID = false;
    bf16_t* O; int ldc;
    __device__ __forceinline__ void operator()(const f32x4 (&acc)[2][2][4][2], const Unit& u, int wr, int wc, int fr, int fq) const {
        const int row0 = u.pm * BM + wr * 64 + fr, col0 = u.pn * BM + wc * 32 + 8 * fq;
#pragma unroll
        for (int ai = 0; ai < 2; ++ai)
#pragma unroll
            for (int m = 0; m < 4; ++m) { bf16_t* rowp = O + (size_t)(row0 + ai * HALF + m * 16) * ldc + col0;
#pragma unroll
                for (int bj = 0; bj < 2; ++bj) { const f32x4 v0 = acc[ai][bj][m][0], v1 = acc[ai][bj][m][1];
                    u32x4 w; w.x = cvt_pk_bf16(v0[0], v0[1]); w.y = cvt_pk_bf16(v0[2], v0[3]); w.z = cvt_pk_bf16(v1[0], v1[1]); w.w = cvt_pk_bf16(v1[2], v1[3]);
                    ST16((u32x4*)(rowp + bj * HALF), w); } }
    }
};
}

__device__ __forceinline__ void p0_transpose_item(const float* W, int K, int N, bf16* WT, LAS float* scr, int item, int lane, int ldk = 0, int koff = 0, const float* kscale = nullptr) {
    if (ldk == 0) ldk = K;
    const int nblk = N / 32, kb = item / nblk, nb = item % nblk, k0 = 64 * kb, n0 = 32 * nb;
#pragma unroll 8
    for (int i = 0; i < 32; ++i) { const int kk = 2 * i + (lane >> 5); scr[kk * 33 + (lane & 31)] = W[(size_t)(k0 + kk) * N + n0 + (lane & 31)] * (kscale ? kscale[k0 + kk] : 1.0f); }
    LDS_WAIT(); asm volatile("" ::: "memory");
    const int c = lane & 7;
#pragma unroll
    for (int j = 0; j < 4; ++j) { const int n = (lane >> 3) + 8 * j; const LAS float* s = scr + (8 * c) * 33 + n;
        v4u o; o.x = pk2(s[0 * 33], s[1 * 33]); o.y = pk2(s[2 * 33], s[3 * 33]); o.z = pk2(s[4 * 33], s[5 * 33]); o.w = pk2(s[6 * 33], s[7 * 33]);
        *(v4u*)(WT + (size_t)(n0 + n) * ldk + koff + k0 + 8 * c) = o; }
    LDS_WAIT(); asm volatile("" ::: "memory");
}
__device__ __forceinline__ void cvt_flat(const float* src, bf16* dst, size_t n, int gw, int NGW, int lane) {
    for (size_t i = (size_t)gw * 512 + lane * 8; i < n; i += (size_t)NGW * 512) {
        const f32x4 a = *(const f32x4*)(src + i), b = *(const f32x4*)(src + i + 4);
        v4u o; o.x = pk2(a[0], a[1]); o.y = pk2(a[2], a[3]); o.z = pk2(b[0], b[1]); o.w = pk2(b[2], b[3]);
        *(v4u*)(dst + i) = o;
    }
}

__device__ __forceinline__ void rms_x1_row(const bf16* xrow, const float* w, unsigned char* oqrow, unsigned char* o8row, float* oinv, int lane) {
    const f32x4* wr = (const f32x4*)w + lane;
    f32x4 v[4]; float s = 0.f;
    { const v2u* xb = (const v2u*)xrow + lane;
#pragma unroll
      for (int j = 0; j < 4; ++j) { const v2u q = xb[64 * j]; v[j][0] = bflo(q.x); v[j][1] = bfhi(q.x); v[j][2] = bflo(q.y); v[j][3] = bfhi(q.y); } }
#pragma unroll
    for (int j = 0; j < 4; ++j) s += (v[j][0] * v[j][0] + v[j][1] * v[j][1]) + (v[j][2] * v[j][2] + v[j][3] * v[j][3]);
    const float rstd = 1.0f / sqrtf(wave_sum(s) * (1.0f / 1024.0f) + EPS);
    float mx = 0.f;
#pragma unroll
    for (int j = 0; j < 4; ++j) { const f32x4 ww = wr[64 * j]; v[j] = v[j] * rstd * ww;
        mx = fmaxf(mx, fmaxf(fmaxf(fabsf(v[j][0]), fabsf(v[j][1])), fmaxf(fabsf(v[j][2]), fabsf(v[j][3])))); }
#pragma unroll
    for (int o = 1; o < 64; o <<= 1) mx = fmaxf(mx, __shfl_xor(mx, o));
    const bool tiny = mx < 1e-30f;
    const float scale = tiny ? 0.f : 119.0f / mx, inv = tiny ? 0.f : mx * (1.0f / 119.0f);
#pragma unroll
    for (int j = 0; j < 4; ++j) {
        unsigned pa = 0u, pb = 0u, pq = 0u;
#pragma unroll
        for (int e = 0; e < 4; ++e) { const int q = (int)__builtin_rintf(v[j][e] * scale); const int b = ((q + 8) & 15) - 8; const int a = (q - b) >> 4;
            pa |= (unsigned)(a & 15) << (4 * e); pb |= (unsigned)(b & 15) << (4 * e); pq |= (unsigned)(q & 255) << (8 * e); }
        *(unsigned*)(oqrow + 4 * lane + 256 * j) = pq;
        const unsigned na = (unsigned)__shfl_xor((int)pa, 1), nb = (unsigned)__shfl_xor((int)pb, 1);
        const unsigned da = (lane & 1) ? (na | (pa << 16)) : (pa | (na << 16)), db = (lane & 1) ? (nb | (pb << 16)) : (pb | (nb << 16));
        *(unsigned*)(o8row + 32 * ((lane >> 3) + 8 * j) + 4 * ((lane & 7) >> 1) + ((lane & 1) ? 16 : 0)) = (lane & 1) ? db : da;
    }
    if (lane == 0) *oinv = inv;
}

struct Ptrs {
    const float *x, *mix_w, *w_in, *rel_bias, *sinks, *w_pa, *ln_w, *ln_b, *w_s, *b_s, *w_pb, *w_out, *ffn_w, *w_q, *keys1, *keys2, *pu, *pv, *fin_w;
    float* out;
    unsigned char *U8, *V8, *HN8, *XN8, *HNQ, *WIN8, *WQ8; float *USC, *VSC, *HSC, *XSC, *WINSC, *WQSC;
    bf16 *WPAB, *WOUT, *K1, *K2, *WS, *AOUT, *BOUT, *X1B, *Q, *KV, *GU, *GV, *GA, *GB, *MERGED, *QP;
};

__device__ __forceinline__ void p0_quant_row(const Ptrs& P, const f32x4 (&v)[4], int rr, int lane) {
            const int tab = rr >> 14, row = rr & 16383;
            float mx = 0.f, ssq = 0.f;
#pragma unroll
            for (int j = 0; j < 4; ++j) { mx = fmaxf(mx, fmaxf(fmaxf(fabsf(v[j][0]), fabsf(v[j][1])), fmaxf(fabsf(v[j][2]), fabsf(v[j][3]))));
                ssq += (v[j][0] * v[j][0] + v[j][1] * v[j][1]) + (v[j][2] * v[j][2] + v[j][3] * v[j][3]); }
            mx = wave_max(mx); ssq = wave_sum(ssq);
            const float sd = sqrtf(ssq * (1.0f / 1024.0f));
            if (tab == 0) {
                const float step = fmaxf(Q4_USTEP * sd, mx * (1.0f / 14.0f)); const float qs = step > 1e-30f ? 1.0f / step : 0.f;
#pragma unroll
                for (int j = 0; j < 4; ++j) { unsigned pq = 0u;
#pragma unroll
                    for (int e = 0; e < 4; ++e) pq |= (unsigned)((int)fminf(fmaxf(__builtin_rintf(v[j][e] * qs), -7.0f), 7.0f) & 15) << (4 * e);
                    const unsigned nq = (unsigned)__builtin_amdgcn_update_dpp(0, (int)pq, 0xB1, 0xF, 0xF, false);
                    if ((lane & 1) == 0) *(unsigned*)(P.U8 + (size_t)row * 512 + 128 * j + 2 * lane) = pq | (nq << 16); }
                if (lane == 0) P.USC[row] = step;
            } else {
                const float un = fmaxf(Q4_VUNIT * sd, mx * (1.0f / 12.0f)); const float qs = un > 1e-30f ? 1.0f / un : 0.f;
                bool bad = false;
#pragma unroll
                for (int j = 0; j < 4; ++j) {
                    unsigned pq = __builtin_amdgcn_cvt_scalef32_pk_fp4_f32(0u, v[j][0] * qs, v[j][1] * qs, 1.0f, 0);
                    pq = __builtin_amdgcn_cvt_scalef32_pk_fp4_f32(pq, v[j][2] * qs, v[j][3] * qs, 1.0f, 1);
                    pq &= 0xffffu;
                    const unsigned nq = (unsigned)__builtin_amdgcn_update_dpp(0, (int)pq, 0xB1, 0xF, 0xF, false);
                    if ((lane & 1) == 0) *(unsigned*)(P.V8 + (size_t)row * 512 + 128 * j + 2 * lane) = pq | (nq << 16); }
                if (FP4_SELFCHECK && __ballot(bad) != 0ull) { if (lane == 0) P.VSC[row] = __builtin_nanf(""); }
                else if (lane == 0) P.VSC[row] = un;
            }
}
__device__ __forceinline__ unsigned pack_i8x4(float a, float b, float c, float d) {
    const int qa = (int)__builtin_rintf(a), qb = (int)__builtin_rintf(b), qc = (int)__builtin_rintf(c), qd = (int)__builtin_rintf(d);
    return (unsigned)(qa & 255) | ((unsigned)(qb & 255) << 8) | ((unsigned)(qc & 255) << 16) | ((unsigned)qd << 24);
}
__device__ __forceinline__ void p0_quant_wt_item(const float* W, int N, unsigned char* WT8, float* cs, int item, int lane, int wave, LAS float* cml) {
    const int n0 = 32 * item, c4 = lane & 7, kr = lane >> 3;
    const float* wp = W + (size_t)(128 * wave + 16 * kr) * N + n0 + 4 * c4;
    f32x4 v[16]; f32x4 mx = {0.f, 0.f, 0.f, 0.f};
#pragma unroll
    for (int t = 0; t < 16; ++t) v[t] = *(const f32x4*)(wp + (size_t)t * N);
#pragma unroll
    for (int t = 0; t < 16; ++t) { mx[0] = fmaxf(mx[0], fabsf(v[t][0])); mx[1] = fmaxf(mx[1], fabsf(v[t][1])); mx[2] = fmaxf(mx[2], fabsf(v[t][2])); mx[3] = fmaxf(mx[3], fabsf(v[t][3])); }
#pragma unroll
    for (int e = 0; e < 4; ++e) { float m_ = mx[e]; m_ = fmaxf(m_, __shfl_xor(m_, 8)); m_ = fmaxf(m_, __shfl_xor(m_, 16)); m_ = fmaxf(m_, __shfl_xor(m_, 32)); mx[e] = m_; }
    if (kr == 0) *(LAS f32x4*)(cml + wave * 32 + 4 * c4) = mx;
    __syncthreads();
#pragma unroll
    for (int w = 0; w < 8; ++w) { const f32x4 o = *(const LAS f32x4*)(cml + w * 32 + 4 * c4); mx[0] = fmaxf(mx[0], o[0]); mx[1] = fmaxf(mx[1], o[1]); mx[2] = fmaxf(mx[2], o[2]); mx[3] = fmaxf(mx[3], o[3]); }
    f32x4 inv;
#pragma unroll
    for (int e = 0; e < 4; ++e) inv[e] = mx[e] > 1e-30f ? 127.0f / mx[e] : 0.f;
    if (wave == 0 && kr == 0) *(f32x4*)(cs + n0 + 4 * c4) = mx * (1.0f / 127.0f);
#pragma unroll
    for (int e = 0; e < 4; ++e) { v4u o;
        o.x = pack_i8x4(v[0][e] * inv[e], v[1][e] * inv[e], v[2][e] * inv[e], v[3][e] * inv[e]); o.y = pack_i8x4(v[4][e] * inv[e], v[5][e] * inv[e], v[6][e] * inv[e], v[7][e] * inv[e]);
        o.z = pack_i8x4(v[8][e] * inv[e], v[9][e] * inv[e], v[10][e] * inv[e], v[11][e] * inv[e]); o.w = pack_i8x4(v[12][e] * inv[e], v[13][e] * inv[e], v[14][e] * inv[e], v[15][e] * inv[e]);
        *(v4u*)(WT8 + (size_t)(n0 + 4 * c4 + e) * 1024 + 128 * wave + 16 * kr) = o; }
    __syncthreads();
}
#define TAB_LOAD(V, RR) do { if ((RR) < 2 * 16384) { const float* src_ = (((RR) >> 14) ? P.pv : P.pu) + (size_t)((RR) & 16383) * 1024; \
        _Pragma("unroll") for (int j = 0; j < 4; ++j) V[j] = *(const f32x4*)(src_ + 4 * lane + 256 * j); } } while (0)
__device__ __forceinline__ void p0_prologue(LAS unsigned char* lds, const Ptrs& P, int vcu, int G, int lane, int wave) {
    LAS float* scr = (LAS float*)(lds + wave * 16384);
    const int gw = vcu * NWAVES + wave, NGW = G * NWAVES;
    for (int it = vcu; it < 184; it += G) {
        if (it < 120) p0_quant_wt_item(P.w_in, 3840, P.WIN8, P.WINSC, it, lane, wave, (LAS float*)(lds + 131072));
        else p0_quant_wt_item(P.w_q, 2048, P.WQ8, P.WQSC, it - 120, lane, wave, (LAS float*)(lds + 131072)); }
    constexpr int I_PA = (512 / 64) * (1024 / 32), I_OUT = (1024 / 64) * (1024 / 32);
    constexpr int NITEMS = 2 * I_PA + I_OUT;
    for (int it = gw; it < NITEMS; it += NGW) {
        int r = it;
        if (r < I_PA) { p0_transpose_item(P.w_pa, 512, 1024, P.WPAB, scr, r, lane, 1024, 0); continue; } r -= I_PA;
        if (r < I_PA) { p0_transpose_item(P.w_pb, 512, 1024, P.WPAB, scr, r, lane, 1024, 512); continue; } r -= I_PA;
        p0_transpose_item(P.w_out, 1024, 1024, P.WOUT, scr, r, lane);
    }
    cvt_flat(P.keys1, P.K1, 128 * 128, gw, NGW, lane);
    cvt_flat(P.keys2, P.K2, 128 * 128, gw, NGW, lane);
    {
        f32x4 va[4], vb[4], vc[4];
        int rr = gw;
        TAB_LOAD(va, rr); TAB_LOAD(vb, rr + NGW);
#pragma unroll 1
        for (; rr < 2 * 16384; rr += 3 * NGW) {
            TAB_LOAD(vc, rr + 2 * NGW); p0_quant_row(P, va, rr, lane);
            TAB_LOAD(va, rr + 3 * NGW); if (rr + NGW < 2 * 16384) p0_quant_row(P, vb, rr + NGW, lane);
            TAB_LOAD(vb, rr + 4 * NGW); if (rr + 2 * NGW < 2 * 16384) p0_quant_row(P, vc, rr + 2 * NGW, lane);
        }
    }
    for (size_t i = (size_t)gw * 512 + lane * 8; i < (size_t)8 * 128 * 128; i += (size_t)NGW * 512) {
        const int t = (int)((i >> 7) & 127), s0 = (int)(i & 127);
        const f32x4 a = *(const f32x4*)(P.w_s + i), b = *(const f32x4*)(P.w_s + i + 4);
        float e[8] = {a[0], a[1], a[2], a[3], b[0], b[1], b[2], b[3]};
#pragma unroll
        for (int j = 0; j < 8; ++j) e[j] = (s0 + j <= t) ? e[j] : 0.f;
        v4u o; o.x = pk2(e[0], e[1]); o.y = pk2(e[2], e[3]); o.z = pk2(e[4], e[5]); o.w = pk2(e[6], e[7]);
        *(v4u*)(P.WS + i) = o;
    }
    {
        f32x4 va[4], vb[4], vc[4], ww[4];
#pragma unroll
        for (int j = 0; j < 4; ++j) ww[j] = *((const f32x4*)P.mix_w + lane + 64 * j);
#define XN_LOAD(V, MM) do { if ((MM) < M) { _Pragma("unroll") for (int j = 0; j < 4; ++j) V[j] = *((const f32x4*)(P.x + (size_t)(MM) * D) + lane + 64 * j); } } while (0)
#define XN_PROC(V, MM) do { if ((MM) < M) { float s_ = 0.f; \
        _Pragma("unroll") for (int j = 0; j < 4; ++j) s_ += (V[j][0] * V[j][0] + V[j][1] * V[j][1]) + (V[j][2] * V[j][2] + V[j][3] * V[j][3]); \
        const float rstd_ = 1.0f / sqrtf(wave_sum(s_) * (1.0f / 1024.0f) + EPS); float mx_ = 0.f; \
        _Pragma("unroll") for (int j = 0; j < 4; ++j) { V[j] = V[j] * rstd_ * ww[j]; mx_ = fmaxf(mx_, fmaxf(fmaxf(fabsf(V[j][0]), fabsf(V[j][1])), fmaxf(fabsf(V[j][2]), fabsf(V[j][3])))); } \
        mx_ = wave_max(mx_); const float qs_ = mx_ > 1e-30f ? 127.0f / mx_ : 0.f; \
        _Pragma("unroll") for (int j = 0; j < 4; ++j) *(unsigned*)(P.XN8 + (size_t)(MM) * D + 4 * lane + 256 * j) = pack_i8x4(V[j][0] * qs_, V[j][1] * qs_, V[j][2] * qs_, V[j][3] * qs_); \
        if (lane == 0) P.XSC[MM] = mx_ * (1.0f / 127.0f); } } while (0)
        int m = gw;
        XN_LOAD(va, m); XN_LOAD(vb, m + NGW);
#pragma unroll 1
        for (; m < M; m += 3 * NGW) {
            XN_LOAD(vc, m + 2 * NGW); XN_PROC(va, m);
            XN_LOAD(va, m + 3 * NGW); XN_PROC(vb, m + NGW);
            XN_LOAD(vb, m + 4 * NGW); XN_PROC(vc, m + 2 * NGW);
        }
#undef XN_LOAD
#undef XN_PROC
    }
}

typedef short s16x8 __attribute__((ext_vector_type(8)));
typedef short s16x4 __attribute__((ext_vector_type(4)));
typedef float f32x16 __attribute__((ext_vector_type(16)));
typedef float f32x2v __attribute__((ext_vector_type(2)));
#define MFMA32(a, b, c) __builtin_amdgcn_mfma_f32_32x32x16_bf16((a), (b), (c), 0, 0, 0)
__device__ __forceinline__ s16x4 tr16(const LAS unsigned char* p) { return __builtin_bit_cast(s16x4, __builtin_amdgcn_ds_read_tr16_b64_v4i16((LAS s16x4*)p)); }
__device__ __forceinline__ unsigned cvtpk(float lo, float hi) { f32x2v v = {lo, hi}; bf16x2_t b = __builtin_convertvector(v, bf16x2_t); return __builtin_bit_cast(unsigned, b); }
__device__ __forceinline__ int crow(int reg, int h) { return (reg & 3) + 8 * (reg >> 2) + 4 * h; }
constexpr float LOG2E = 1.4426950408889634f;

__device__ __forceinline__ void p2_attn_mfma(LAS unsigned char* lds, const Ptrs& P, int vcu, int G, int tid, int lane, int wave) {
    LAS unsigned char* Kl = lds;
    LAS unsigned char* Vl = lds + 32768;
    LAS float* biasl = (LAS float*)(lds + 32768 + 49152);
    const int r = lane & 31, h = lane >> 5, i16 = lane & 15, q4 = i16 >> 2, p4 = i16 & 3, blk = (lane >> 4) & 1;
    for (int unit = vcu; unit < 256; unit += G) {
        const int kvh = unit & 1, blkid = unit >> 1, nb = blkid & 63; const int tok0 = blkid * 128;
#pragma unroll
        for (int i = 0; i < 4; ++i) {
            const int cidx = tid + 512 * i, row = cidx >> 3, c = cidx & 7;
            v4u kw = {0u, 0u, 0u, 0u}, vw = {0u, 0u, 0u, 0u};
            if (nb > 0 || row >= 128) { const bf16* src = P.KV + (size_t)(tok0 - 128 + row) * 256 + kvh * 64 + c * 8; kw = *(const v4u*)src; vw = *(const v4u*)(src + 128); }
            *(LAS v4u*)(Kl + row * 128 + ((c ^ ((row >> 1) & 7)) << 4)) = kw;
            *(LAS v4u*)(Vl + row * 192 + c * 16) = vw;
        }
        biasl[tid] = P.rel_bias[(int)T5B[tid & 127] * 8 + kvh * 4 + (tid >> 7)] * LOG2E;
        __syncthreads();
        const int g = wave >> 1, qh = wave & 1, hq = kvh * 4 + g;
        const float sink2 = P.sinks[hq] * LOG2E;
#pragma unroll 1
        for (int qs = 0; qs < 2; ++qs) {
            const int qi0 = 64 * qh + 32 * qs, kt0 = 2 * qh + qs;
            s16x8 qf[4];
            { const bf16* qrow = P.Q + (size_t)(tok0 + qi0 + r) * 512 + hq * 64 + 8 * h;
#pragma unroll
              for (int ks = 0; ks < 4; ++ks) qf[ks] = *(const s16x8*)(qrow + 16 * ks); }
            f32x16 s[5];
#pragma unroll
            for (int i = 0; i < 5; ++i) {
#pragma unroll
                for (int e = 0; e < 16; ++e) s[i][e] = 0.f;
                const int key = 32 * (kt0 + i) + r; const LAS unsigned char* kp = Kl + key * 128; const int sw = (key >> 1) & 7;
#pragma unroll
                for (int ks = 0; ks < 4; ++ks) { const s16x8 kf = *(const LAS s16x8*)(kp + (((2 * ks + h) ^ sw) << 4)); s[i] = MFMA32(kf, qf[ks], s[i]); }
            }
            const int qi = qi0 + r;
            float mx = sink2;
#pragma unroll
            for (int i = 0; i < 5; ++i)
#pragma unroll
                for (int e = 0; e < 16; ++e) {
                    const int kj = 32 * (kt0 + i) + crow(e, h), dist = 128 + qi - kj;
                    const bool valid = (dist >= 0) && (dist < 128) && (nb > 0 || kj >= 128);
                    const float b = biasl[g * 128 + (dist & 127)];
                    const float v = valid ? s[i][e] * (0.125f * LOG2E) + b : -1e30f;
                    s[i][e] = v; mx = fmaxf(mx, v);
                }
            mx = fmaxf(mx, xor32_f(mx));
            float l = 0.f;
#pragma unroll
            for (int i = 0; i < 5; ++i)
#pragma unroll
                for (int e = 0; e < 16; ++e) { const float p = __builtin_amdgcn_exp2f(s[i][e] - mx); s[i][e] = p; l += p; }
            l += xor32_f(l);
            l += __builtin_amdgcn_exp2f(sink2 - mx);
            f32x16 o0, o1;
#pragma unroll
            for (int e = 0; e < 16; ++e) { o0[e] = 0.f; o1[e] = 0.f; }
#pragma unroll
            for (int i = 0; i < 5; ++i)
#pragma unroll
                for (int st = 0; st < 2; ++st) {
                    v4u pw; pw.x = cvtpk(s[i][8 * st], s[i][8 * st + 1]); pw.y = cvtpk(s[i][8 * st + 2], s[i][8 * st + 3]); pw.z = cvtpk(s[i][8 * st + 4], s[i][8 * st + 5]); pw.w = cvtpk(s[i][8 * st + 6], s[i][8 * st + 7]);
                    const s16x8 pf = __builtin_bit_cast(s16x8, pw);
                    const LAS unsigned char* vb = Vl + (32 * (kt0 + i) + 16 * st + 4 * h + q4) * 192 + 32 * blk + 8 * p4;
                    { const s16x4 lo = tr16(vb), hi = tr16(vb + 8 * 192); const s16x8 vf = __builtin_shufflevector(lo, hi, 0, 1, 2, 3, 4, 5, 6, 7); o0 = MFMA32(vf, pf, o0); }
                    { const s16x4 lo = tr16(vb + 64), hi = tr16(vb + 64 + 8 * 192); const s16x8 vf = __builtin_shufflevector(lo, hi, 0, 1, 2, 3, 4, 5, 6, 7); o1 = MFMA32(vf, pf, o1); }
                }
            const float inv = 1.0f / l;
            bf16* orow = P.AOUT + (size_t)(tok0 + qi) * AB_LD + hq * 64 + 4 * h;
#pragma unroll
            for (int r4 = 0; r4 < 4; ++r4) {
                v2u w0; w0.x = cvtpk(o0[4 * r4] * inv, o0[4 * r4 + 1] * inv); w0.y = cvtpk(o0[4 * r4 + 2] * inv, o0[4 * r4 + 3] * inv); *(v2u*)(orow + 8 * r4) = w0;
                v2u w1; w1.x = cvtpk(o1[4 * r4] * inv, o1[4 * r4 + 1] * inv); w1.y = cvtpk(o1[4 * r4 + 2] * inv, o1[4 * r4 + 3] * inv); *(v2u*)(orow + 32 + 8 * r4) = w1;
            }
        }
        __syncthreads();
    }
}

__device__ __forceinline__ void p2_gmlp_mfma(LAS unsigned char* lds, const Ptrs& P, int vcu, int G, int tid, int lane, int wave) {
    LAS unsigned char* vnl = lds;
    const int r = lane & 31, h = lane >> 5, i16 = lane & 15, q4 = i16 >> 2, p4 = i16 & 3, blk = (lane >> 4) & 1;
    for (int unit = vcu; unit < 256; unit += G) {
        const int c = unit >> 1, hh = unit & 1;
        v4u gvw[16];
#pragma unroll
        for (int i = 0; i < 16; ++i) gvw[i] = *((const v4u*)(P.GV + ((size_t)c * 128 + wave * 16 + i) * 512) + lane);
        const f32x4 lw0 = *(const f32x4*)(P.ln_w + lane * 8), lw1 = *(const f32x4*)(P.ln_w + lane * 8 + 4), lb0 = *(const f32x4*)(P.ln_b + lane * 8), lb1 = *(const f32x4*)(P.ln_b + lane * 8 + 4);
#pragma unroll
        for (int i = 0; i < 16; ++i) {
            const int tt = wave * 16 + i;
            const v4u w = gvw[i];
            float x[8] = {bflo(w.x), bfhi(w.x), bflo(w.y), bfhi(w.y), bflo(w.z), bfhi(w.z), bflo(w.w), bfhi(w.w)};
            float s = 0.f;
#pragma unroll
            for (int j = 0; j < 8; ++j) s += x[j];
            const float mean = wave_sum(s) * (1.0f / 512.0f);
            float ss = 0.f;
#pragma unroll
            for (int j = 0; j < 8; ++j) { x[j] -= mean; ss += x[j] * x[j]; }
            const float rstd = 1.0f / sqrtf(wave_sum(ss) * (1.0f / 512.0f) + EPS);
            if ((lane >> 5) == hh) {
                const f32x4 w0 = lw0, w1 = lw1, b0 = lb0, b1 = lb1;
                v4u o; o.x = pk2(x[0] * rstd * w0[0] + b0[0], x[1] * rstd * w0[1] + b0[1]); o.y = pk2(x[2] * rstd * w0[2] + b0[2], x[3] * rstd * w0[3] + b0[3]);
                o.z = pk2(x[4] * rstd * w1[0] + b1[0], x[5] * rstd * w1[1] + b1[1]); o.w = pk2(x[6] * rstd * w1[2] + b1[2], x[7] * rstd * w1[3] + b1[3]);
                *(LAS v4u*)(vnl + tt * 576 + (lane & 31) * 16) = o;
            }
        }
        __syncthreads();
        const int gi = wave >> 1, dblk = wave & 1, g = hh * 4 + gi;
        s16x8 af[8];
#pragma unroll
        for (int ks = 0; ks < 8; ++ks) { const LAS unsigned char* vb = vnl + (16 * ks + 8 * h + q4) * 576 + (gi * 64 + dblk * 32 + 16 * blk) * 2 + 8 * p4;
            const s16x4 lo = tr16(vb), hi = tr16(vb + 4 * 576); af[ks] = __builtin_shufflevector(lo, hi, 0, 1, 2, 3, 4, 5, 6, 7); }
#pragma unroll
        for (int tt = 0; tt < 4; ++tt) {
            f32x16 acc;
#pragma unroll
            for (int e = 0; e < 16; ++e) acc[e] = 0.f;
            const bf16* wrow = P.WS + ((size_t)g * 128 + 32 * tt + r) * 128 + 8 * h;
#pragma unroll
            for (int ks = 0; ks < 2 * (tt + 1); ++ks) acc = MFMA32(af[ks], *(const s16x8*)(wrow + 16 * ks), acc);
            const int t = 32 * tt + r; const size_t row = (size_t)c * 128 + t; const float b = P.b_s[g * 128 + t];
#pragma unroll
            for (int r4 = 0; r4 < 4; ++r4) {
                const int ch = g * 64 + dblk * 32 + 8 * r4 + 4 * h;
                const v2u uw = *(const v2u*)(P.GU + row * 512 + ch);
                v2u ow; ow.x = cvtpk(bflo(uw.x) * (acc[4 * r4] + b), bfhi(uw.x) * (acc[4 * r4 + 1] + b)); ow.y = cvtpk(bflo(uw.y) * (acc[4 * r4 + 2] + b), bfhi(uw.y) * (acc[4 * r4 + 3] + b));
                *(v2u*)(P.BOUT + row * AB_LD + ch) = ow;
            }
        }
        __syncthreads();
    }
}
constexpr int GM_OFF = 83968;
__device__ __forceinline__ void p2_fused(LAS unsigned char* lds, const Ptrs& P, int vcu, int G, int tid, int lane, int wave) {
    LAS unsigned char* Kl = lds;
    LAS unsigned char* Vl = lds + 32768;
    LAS float* biasl = (LAS float*)(lds + 32768 + 49152);
    LAS unsigned char* vnl = lds + GM_OFF;
    const int r = lane & 31, h = lane >> 5, i16 = lane & 15, q4 = i16 >> 2, p4 = i16 & 3, blk = (lane >> 4) & 1;
    const int t4 = tid & 255, w4 = wave & 3; const bool att = wave < 4;
    for (int unit = vcu; unit < 256; unit += G) {
        const int kvh = unit & 1, blkid = unit >> 1, nb = blkid & 63; const int tok0 = blkid * 128;
        const int c = unit >> 1, hh = unit & 1;
        if (att) {
    #pragma unroll
            for (int i = 0; i < 8; ++i) {
                const int cidx = t4 + 256 * i, row = cidx >> 3, c = cidx & 7;
                v4u kw = {0u, 0u, 0u, 0u}, vw = {0u, 0u, 0u, 0u};
                if (nb > 0 || row >= 128) { const bf16* src = P.KV + (size_t)(tok0 - 128 + row) * 256 + kvh * 64 + c * 8; kw = *(const v4u*)src; vw = *(const v4u*)(src + 128); }
                *(LAS v4u*)(Kl + row * 128 + ((c ^ ((row >> 1) & 7)) << 4)) = kw;
                *(LAS v4u*)(Vl + row * 192 + c * 16) = vw;
            }
            biasl[t4] = P.rel_bias[(int)T5B[t4 & 127] * 8 + kvh * 4 + (t4 >> 7)] * LOG2E; biasl[t4 + 256] = P.rel_bias[(int)T5B[t4 & 127] * 8 + kvh * 4 + 2 + (t4 >> 7)] * LOG2E;
        } else {
#pragma unroll 1
            for (int bt = 0; bt < 2; ++bt) {
                v4u gvw[16];
        #pragma unroll
                for (int i = 0; i < 16; ++i) gvw[i] = *((const v4u*)(P.GV + ((size_t)c * 128 + w4 * 32 + bt * 16 + i) * 512) + lane);
                const f32x4 lw0 = *(const f32x4*)(P.ln_w + lane * 8), lw1 = *(const f32x4*)(P.ln_w + lane * 8 + 4), lb0 = *(const f32x4*)(P.ln_b + lane * 8), lb1 = *(const f32x4*)(P.ln_b + lane * 8 + 4);
        #pragma unroll
                for (int i = 0; i < 16; ++i) {
                    const int tt = w4 * 32 + bt * 16 + i;
                    const v4u w = gvw[i];
                    float x[8] = {bflo(w.x), bfhi(w.x), bflo(w.y), bfhi(w.y), bflo(w.z), bfhi(w.z), bflo(w.w), bfhi(w.w)};
                    float s = 0.f;
        #pragma unroll
                    for (int j = 0; j < 8; ++j) s += x[j];
                    const float mean = wave_sum(s) * (1.0f / 512.0f);
                    float ss = 0.f;
        #pragma unroll
                    for (int j = 0; j < 8; ++j) { x[j] -= mean; ss += x[j] * x[j]; }
                    const float rstd = 1.0f / sqrtf(wave_sum(ss) * (1.0f / 512.0f) + EPS);
                    if ((lane >> 5) == hh) {
                        const f32x4 w0 = lw0, w1 = lw1, b0 = lb0, b1 = lb1;
                        v4u o; o.x = pk2(x[0] * rstd * w0[0] + b0[0], x[1] * rstd * w0[1] + b0[1]); o.y = pk2(x[2] * rstd * w0[2] + b0[2], x[3] * rstd * w0[3] + b0[3]);
                        o.z = pk2(x[4] * rstd * w1[0] + b1[0], x[5] * rstd * w1[1] + b1[1]); o.w = pk2(x[6] * rstd * w1[2] + b1[2], x[7] * rstd * w1[3] + b1[3]);
                        *(LAS v4u*)(vnl + tt * 576 + (lane & 31) * 16) = o;
                    }
                }
            }
        }
        __syncthreads();
        if (att) {
            const int g = w4, hq = kvh * 4 + g;
            const float sink2 = P.sinks[hq] * LOG2E;
    #pragma unroll 1
            for (int qb = 0; qb < 4; ++qb) {
                const int qi0 = 32 * qb, kt0 = qb;
                s16x8 qf[4];
                { const bf16* qrow = P.Q + (size_t)(tok0 + qi0 + r) * 512 + hq * 64 + 8 * h;
    #pragma unroll
                  for (int ks = 0; ks < 4; ++ks) qf[ks] = *(const s16x8*)(qrow + 16 * ks); }
                f32x16 s[5];
    #pragma unroll
                for (int i = 0; i < 5; ++i) {
    #pragma unroll
                    for (int e = 0; e < 16; ++e) s[i][e] = 0.f;
                    const int key = 32 * (kt0 + i) + r; const LAS unsigned char* kp = Kl + key * 128; const int sw = (key >> 1) & 7;
    #pragma unroll
                    for (int ks = 0; ks < 4; ++ks) { const s16x8 kf = *(const LAS s16x8*)(kp + (((2 * ks + h) ^ sw) << 4)); s[i] = MFMA32(kf, qf[ks], s[i]); }
                }
                const int qi = qi0 + r;
                float mx = sink2;
    #pragma unroll
                for (int i = 0; i < 5; ++i)
    #pragma unroll
                    for (int e = 0; e < 16; ++e) {
                        const int kj = 32 * (kt0 + i) + crow(e, h), dist = 128 + qi - kj;
                        const bool valid = (dist >= 0) && (dist < 128) && (nb > 0 || kj >= 128);
                        const float b = biasl[g * 128 + (dist & 127)];
                        const float v = valid ? s[i][e] * (0.125f * LOG2E) + b : -1e30f;
                        s[i][e] = v; mx = fmaxf(mx, v);
                    }
                mx = fmaxf(mx, xor32_f(mx));
                float l = 0.f;
    #pragma unroll
                for (int i = 0; i < 5; ++i)
    #pragma unroll
                    for (int e = 0; e < 16; ++e) { const float p = __builtin_amdgcn_exp2f(s[i][e] - mx); s[i][e] = p; l += p; }
                l += xor32_f(l);
                l += __builtin_amdgcn_exp2f(sink2 - mx);
                f32x16 o0, o1;
    #pragma unroll
                for (int e = 0; e < 16; ++e) { o0[e] = 0.f; o1[e] = 0.f; }
    #pragma unroll
                for (int i = 0; i < 5; ++i)
    #pragma unroll
                    for (int st = 0; st < 2; ++st) {
                        v4u pw; pw.x = cvtpk(s[i][8 * st], s[i][8 * st + 1]); pw.y = cvtpk(s[i][8 * st + 2], s[i][8 * st + 3]); pw.z = cvtpk(s[i][8 * st + 4], s[i][8 * st + 5]); pw.w = cvtpk(s[i][8 * st + 6], s[i][8 * st + 7]);
                        const s16x8 pf = __builtin_bit_cast(s16x8, pw);
                        const LAS unsigned char* vb = Vl + (32 * (kt0 + i) + 16 * st + 4 * h + q4) * 192 + 32 * blk + 8 * p4;
                        { const s16x4 lo = tr16(vb), hi = tr16(vb + 8 * 192); const s16x8 vf = __builtin_shufflevector(lo, hi, 0, 1, 2, 3, 4, 5, 6, 7); o0 = MFMA32(vf, pf, o0); }
                        { const s16x4 lo = tr16(vb + 64), hi = tr16(vb + 64 + 8 * 192); const s16x8 vf = __builtin_shufflevector(lo, hi, 0, 1, 2, 3, 4, 5, 6, 7); o1 = MFMA32(vf, pf, o1); }
                    }
                const float inv = 1.0f / l;
                bf16* orow = P.AOUT + (size_t)(tok0 + qi) * AB_LD + hq * 64 + 4 * h;
    #pragma unroll
                for (int r4 = 0; r4 < 4; ++r4) {
                    v2u w0; w0.x = cvtpk(o0[4 * r4] * inv, o0[4 * r4 + 1] * inv); w0.y = cvtpk(o0[4 * r4 + 2] * inv, o0[4 * r4 + 3] * inv); *(v2u*)(orow + 8 * r4) = w0;
                    v2u w1; w1.x = cvtpk(o1[4 * r4] * inv, o1[4 * r4 + 1] * inv); w1.y = cvtpk(o1[4 * r4 + 2] * inv, o1[4 * r4 + 3] * inv); *(v2u*)(orow + 32 + 8 * r4) = w1;
                }
            }
        } else {
#pragma unroll 1
            for (int cb = 0; cb < 2; ++cb) {
                const int w8 = w4 * 2 + cb, gi = w8 >> 1, dblk = w8 & 1, g = hh * 4 + gi;
                s16x8 af[8];
        #pragma unroll
                for (int ks = 0; ks < 8; ++ks) { const LAS unsigned char* vb = vnl + (16 * ks + 8 * h + q4) * 576 + (gi * 64 + dblk * 32 + 16 * blk) * 2 + 8 * p4;
                    const s16x4 lo = tr16(vb), hi = tr16(vb + 4 * 576); af[ks] = __builtin_shufflevector(lo, hi, 0, 1, 2, 3, 4, 5, 6, 7); }
        #pragma unroll
                for (int tt = 0; tt < 4; ++tt) {
                    f32x16 acc;
        #pragma unroll
                    for (int e = 0; e < 16; ++e) acc[e] = 0.f;
                    const bf16* wrow = P.WS + ((size_t)g * 128 + 32 * tt + r) * 128 + 8 * h;
        #pragma unroll
                    for (int ks = 0; ks < 2 * (tt + 1); ++ks) acc = MFMA32(af[ks], *(const s16x8*)(wrow + 16 * ks), acc);
                    const int t = 32 * tt + r; const size_t row = (size_t)c * 128 + t; const float b = P.b_s[g * 128 + t];
        #pragma unroll
                    for (int r4 = 0; r4 < 4; ++r4) {
                        const int ch = g * 64 + dblk * 32 + 8 * r4 + 4 * h;
                        const v2u uw = *(const v2u*)(P.GU + row * 512 + ch);
                        v2u ow; ow.x = cvtpk(bflo(uw.x) * (acc[4 * r4] + b), bfhi(uw.x) * (acc[4 * r4 + 1] + b)); ow.y = cvtpk(bflo(uw.y) * (acc[4 * r4 + 2] + b), bfhi(uw.y) * (acc[4 * r4 + 3] + b));
                        *(v2u*)(P.BOUT + row * AB_LD + ch) = ow;
                    }
                }
            }
        }
        __syncthreads();
    }
}

__device__ __forceinline__ void topk_half(const bf16* q, const LAS bf16* kl, float (&v)[16]) {
    v4u qv[16];
#pragma unroll
    for (int c = 0; c < 16; ++c) qv[c] = ((const v4u*)q)[c];
#pragma unroll
    for (int i = 0; i < 16; ++i) v[i] = -INFINITY;
    for (int n = 0; n < 128; ++n) {
        const LAS v4u* kr = (const LAS v4u*)(kl + n * 128);
        float a0 = 0.f, a1 = 0.f, a2 = 0.f, a3 = 0.f;
#pragma unroll
        for (int c = 0; c < 16; ++c) { const v4u kk = kr[c]; a0 = dot2bf(qv[c].x, kk.x, a0); a1 = dot2bf(qv[c].y, kk.y, a1); a2 = dot2bf(qv[c].z, kk.z, a2); a3 = dot2bf(qv[c].w, kk.w, a3); }
        const float acc = (a0 + a1) + (a2 + a3);
        float x = __builtin_bit_cast(float, (__builtin_bit_cast(unsigned, acc) & ~0x7Fu) | (unsigned)n);
#pragma unroll
        for (int i = 0; i < 16; ++i) { const float hi = fmaxf(v[i], x); x = fminf(v[i], x); v[i] = hi; }
    }
}

__host__ __device__ constexpr int cand_slot(int i, int j) { int c = 0; for (int a = 0; a < 16; ++a) for (int b = 0; b < 16; ++b) { if (a == i && b == j) return c; if ((a + 1) * (b + 1) <= 16) ++c; } return c; }
#define CE_DESC(a, b) do { const float hi_ = fmaxf((a), (b)); const float lo_ = fminf((a), (b)); (a) = hi_; (b) = lo_; } while (0)
__device__ __forceinline__ void sort16_desc(float (&v)[16]) {
    CE_DESC(v[0], v[1]); CE_DESC(v[3], v[2]); CE_DESC(v[4], v[5]); CE_DESC(v[7], v[6]); CE_DESC(v[8], v[9]); CE_DESC(v[11], v[10]); CE_DESC(v[12], v[13]); CE_DESC(v[15], v[14]); CE_DESC(v[0], v[2]); CE_DESC(v[1], v[3]); CE_DESC(v[6], v[4]); CE_DESC(v[7], v[5]); CE_DESC(v[8], v[10]); CE_DESC(v[9], v[11]); CE_DESC(v[14], v[12]); CE_DESC(v[15], v[13]); CE_DESC(v[0], v[1]); CE_DESC(v[2], v[3]); CE_DESC(v[5], v[4]); CE_DESC(v[7], v[6]); CE_DESC(v[8], v[9]); CE_DESC(v[10], v[11]); CE_DESC(v[13], v[12]); CE_DESC(v[15], v[14]); CE_DESC(v[0], v[4]); CE_DESC(v[1], v[5]); CE_DESC(v[2], v[6]); CE_DESC(v[3], v[7]); CE_DESC(v[12], v[8]); CE_DESC(v[13], v[9]); CE_DESC(v[14], v[10]); CE_DESC(v[15], v[11]); CE_DESC(v[0], v[2]); CE_DESC(v[1], v[3]); CE_DESC(v[4], v[6]); CE_DESC(v[5], v[7]); CE_DESC(v[10], v[8]); CE_DESC(v[11], v[9]); CE_DESC(v[14], v[12]); CE_DESC(v[15], v[13]); CE_DESC(v[0], v[1]); CE_DESC(v[2], v[3]); CE_DESC(v[4], v[5]); CE_DESC(v[6], v[7]); CE_DESC(v[9], v[8]); CE_DESC(v[11], v[10]); CE_DESC(v[13], v[12]); CE_DESC(v[15], v[14]); CE_DESC(v[0], v[8]); CE_DESC(v[1], v[9]); CE_DESC(v[2], v[10]); CE_DESC(v[3], v[11]); CE_DESC(v[4], v[12]); CE_DESC(v[5], v[13]); CE_DESC(v[6], v[14]); CE_DESC(v[7], v[15]); CE_DESC(v[0], v[4]); CE_DESC(v[1], v[5]); CE_DESC(v[2], v[6]); CE_DESC(v[3], v[7]); CE_DESC(v[8], v[12]); CE_DESC(v[9], v[13]); CE_DESC(v[10], v[14]); CE_DESC(v[11], v[15]); CE_DESC(v[0], v[2]); CE_DESC(v[1], v[3]); CE_DESC(v[4], v[6]); CE_DESC(v[5], v[7]); CE_DESC(v[8], v[10]); CE_DESC(v[9], v[11]); CE_DESC(v[12], v[14]); CE_DESC(v[13], v[15]); CE_DESC(v[0], v[1]); CE_DESC(v[2], v[3]); CE_DESC(v[4], v[5]); CE_DESC(v[6], v[7]); CE_DESC(v[8], v[9]); CE_DESC(v[10], v[11]); CE_DESC(v[12], v[13]); CE_DESC(v[14], v[15]);
}
__device__ __forceinline__ void merge_top16(float (&a)[16], const float (&b)[16]) {
    a[0] = fmaxf(a[0], b[15]); a[1] = fmaxf(a[1], b[14]); a[2] = fmaxf(a[2], b[13]); a[3] = fmaxf(a[3], b[12]); a[4] = fmaxf(a[4], b[11]); a[5] = fmaxf(a[5], b[10]); a[6] = fmaxf(a[6], b[9]); a[7] = fmaxf(a[7], b[8]); a[8] = fmaxf(a[8], b[7]); a[9] = fmaxf(a[9], b[6]); a[10] = fmaxf(a[10], b[5]); a[11] = fmaxf(a[11], b[4]); a[12] = fmaxf(a[12], b[3]); a[13] = fmaxf(a[13], b[2]); a[14] = fmaxf(a[14], b[1]); a[15] = fmaxf(a[15], b[0]); CE_DESC(a[0], a[8]); CE_DESC(a[1], a[9]); CE_DESC(a[2], a[10]); CE_DESC(a[3], a[11]); CE_DESC(a[4], a[12]); CE_DESC(a[5], a[13]); CE_DESC(a[6], a[14]); CE_DESC(a[7], a[15]); CE_DESC(a[0], a[4]); CE_DESC(a[1], a[5]); CE_DESC(a[2], a[6]); CE_DESC(a[3], a[7]); CE_DESC(a[8], a[12]); CE_DESC(a[9], a[13]); CE_DESC(a[10], a[14]); CE_DESC(a[11], a[15]); CE_DESC(a[0], a[2]); CE_DESC(a[1], a[3]); CE_DESC(a[4], a[6]); CE_DESC(a[5], a[7]); CE_DESC(a[8], a[10]); CE_DESC(a[9], a[11]); CE_DESC(a[12], a[14]); CE_DESC(a[13], a[15]); CE_DESC(a[0], a[1]); CE_DESC(a[2], a[3]); CE_DESC(a[4], a[5]); CE_DESC(a[6], a[7]); CE_DESC(a[8], a[9]); CE_DESC(a[10], a[11]); CE_DESC(a[12], a[13]); CE_DESC(a[14], a[15]);
}
__device__ __forceinline__ void scores_top16(const bf16* qbase, const LAS unsigned char* kl, int r, int h, float (&t)[16]) {
    f32x16 acc[4];
#pragma unroll
    for (int kt = 0; kt < 4; ++kt)
#pragma unroll
        for (int e = 0; e < 16; ++e) acc[kt][e] = 0.f;
    const LAS unsigned char* kp0 = kl + r * 256; const int sw = r & 15;
#pragma unroll
    for (int ks = 0; ks < 8; ++ks) {
        const s16x8 qf = *(const s16x8*)(qbase + (size_t)r * 256 + 16 * ks + 8 * h);
#pragma unroll
        for (int kt = 0; kt < 4; ++kt) { const s16x8 kf = *(const LAS s16x8*)(kp0 + kt * 8192 + (((2 * ks + h) ^ sw) << 4)); acc[kt] = MFMA32(kf, qf, acc[kt]); }
    }
    float g[4][16];
#pragma unroll
    for (int kt = 0; kt < 4; ++kt) {
#pragma unroll
        for (int e = 0; e < 16; ++e) { const float av_ = acc[kt][e];
            g[kt][e] = __builtin_bit_cast(float, (__builtin_bit_cast(unsigned, av_) & ~0x7Fu) | (unsigned)(32 * kt + (e & 3) + 8 * (e >> 2))); }
        sort16_desc(g[kt]);
    }
    merge_top16(g[0], g[1]); merge_top16(g[2], g[3]); merge_top16(g[0], g[2]);
#pragma unroll
    for (int k = 0; k < 16; ++k) t[k] = __builtin_bit_cast(float, __builtin_bit_cast(unsigned, g[0][k]) | ((unsigned)h << 2));
}
__device__ __forceinline__ void peer_topk_unit_mfma(const Ptrs& P, const LAS unsigned char* k1l, const LAS unsigned char* k2l, LAS int* idxl, LAS float* gatel, int unit, int lane, int wave, int rb_lo = 0, int rb_hi = 2) {
    asm volatile("" : "+v"(lane));
    const int r = lane & 31, h = lane >> 5;
#pragma unroll 1
    for (int rbi = rb_lo; rbi < rb_hi; ++rbi) {
        const int rb = wave * 2 + rbi, R = rb * 32 + r;
        const bf16* qbase = P.QP + ((size_t)unit * 512 + rb * 32) * 256;
        float t1[16], t2[16];
        scores_top16(qbase, k1l, r, h, t1);
        __builtin_amdgcn_sched_barrier(0);
        scores_top16(qbase + 128, k2l, r, h, t2);
        __builtin_amdgcn_sched_barrier(0);
        float F[16], recv[16];
#pragma unroll
        for (int k = 0; k < 16; ++k) { auto rr = __builtin_amdgcn_permlane32_swap(__builtin_bit_cast(unsigned, t1[k]), __builtin_bit_cast(unsigned, t2[k]), false, false);
            const unsigned r0 = rr[0], r1 = rr[1]; F[k] = __builtin_bit_cast(float, r0); recv[k] = __builtin_bit_cast(float, r1); }
        merge_top16(F, recv);
        LAS unsigned char* slot = (LAS unsigned char*)(idxl + R * 16);
        { v4u b;
          b.x = (__builtin_bit_cast(unsigned, F[0]) & 0x7Fu) | ((__builtin_bit_cast(unsigned, F[1]) & 0x7Fu) << 8) | ((__builtin_bit_cast(unsigned, F[2]) & 0x7Fu) << 16) | ((__builtin_bit_cast(unsigned, F[3]) & 0x7Fu) << 24);
          b.y = (__builtin_bit_cast(unsigned, F[4]) & 0x7Fu) | ((__builtin_bit_cast(unsigned, F[5]) & 0x7Fu) << 8) | ((__builtin_bit_cast(unsigned, F[6]) & 0x7Fu) << 16) | ((__builtin_bit_cast(unsigned, F[7]) & 0x7Fu) << 24);
          b.z = (__builtin_bit_cast(unsigned, F[8]) & 0x7Fu) | ((__builtin_bit_cast(unsigned, F[9]) & 0x7Fu) << 8) | ((__builtin_bit_cast(unsigned, F[10]) & 0x7Fu) << 16) | ((__builtin_bit_cast(unsigned, F[11]) & 0x7Fu) << 24);
          b.w = (__builtin_bit_cast(unsigned, F[12]) & 0x7Fu) | ((__builtin_bit_cast(unsigned, F[13]) & 0x7Fu) << 8) | ((__builtin_bit_cast(unsigned, F[14]) & 0x7Fu) << 16) | ((__builtin_bit_cast(unsigned, F[15]) & 0x7Fu) << 24);
          *(LAS v4u*)(slot + 16 * h) = b;
          (void)b; }
        float v1[16], v2[16];
#pragma unroll
        for (int k = 0; k < 16; ++k) { auto rr = __builtin_amdgcn_permlane32_swap(__builtin_bit_cast(unsigned, F[k]), __builtin_bit_cast(unsigned, F[k]), false, false);
            const unsigned r0 = rr[0], r1 = rr[1]; v1[k] = __builtin_bit_cast(float, r0 & ~0x7Fu); v2[k] = __builtin_bit_cast(float, r1 & ~0x7Fu); }
        float cg[4][16];
#pragma unroll
        for (int a = 0; a < 4; ++a)
#pragma unroll
            for (int k = 0; k < 16; ++k) cg[a][k] = -1e30f;
#define CAND(i, j) __builtin_bit_cast(float, (__builtin_bit_cast(unsigned, v1[i] + v2[j]) & ~0xFFu) | (unsigned)((i) * 16 + (j)))
        cg[0][0] = CAND(0, 0);
        cg[0][1] = CAND(0, 1);
        cg[0][2] = CAND(0, 2);
        cg[0][3] = CAND(0, 3);
        cg[0][4] = CAND(0, 4);
        cg[0][5] = CAND(0, 5);
        cg[0][6] = CAND(0, 6);
        cg[0][7] = CAND(0, 7);
        cg[0][8] = CAND(0, 8);
        cg[0][9] = CAND(0, 9);
        cg[0][10] = CAND(0, 10);
        cg[0][11] = CAND(0, 11);
        cg[0][12] = CAND(0, 12);
        cg[0][13] = CAND(0, 13);
        cg[0][14] = CAND(0, 14);
        cg[0][15] = CAND(0, 15);
        cg[1][0] = CAND(1, 0);
        cg[1][1] = CAND(1, 1);
        cg[1][2] = CAND(1, 2);
        cg[1][3] = CAND(1, 3);
        cg[1][4] = CAND(1, 4);
        cg[1][5] = CAND(1, 5);
        cg[1][6] = CAND(1, 6);
        cg[1][7] = CAND(1, 7);
        cg[1][8] = CAND(2, 0);
        cg[1][9] = CAND(2, 1);
        cg[1][10] = CAND(2, 2);
        cg[1][11] = CAND(2, 3);
        cg[1][12] = CAND(2, 4);
        cg[1][13] = CAND(3, 0);
        cg[1][14] = CAND(3, 1);
        cg[1][15] = CAND(3, 2);
        cg[2][0] = CAND(3, 3);
        cg[2][1] = CAND(4, 0);
        cg[2][2] = CAND(4, 1);
        cg[2][3] = CAND(4, 2);
        cg[2][4] = CAND(5, 0);
        cg[2][5] = CAND(5, 1);
        cg[2][6] = CAND(6, 0);
        cg[2][7] = CAND(6, 1);
        cg[2][8] = CAND(7, 0);
        cg[2][9] = CAND(7, 1);
        cg[2][10] = CAND(8, 0);
        cg[2][11] = CAND(9, 0);
        cg[2][12] = CAND(10, 0);
        cg[2][13] = CAND(11, 0);
        cg[2][14] = CAND(12, 0);
        cg[2][15] = CAND(13, 0);
        cg[3][0] = CAND(14, 0);
        cg[3][1] = CAND(15, 0);
#undef CAND
        sort16_desc(cg[0]); sort16_desc(cg[1]); sort16_desc(cg[2]); sort16_desc(cg[3]);
        merge_top16(cg[0], cg[1]); merge_top16(cg[2], cg[3]); merge_top16(cg[0], cg[2]);
        float es = 0.f, e[16];
        const float top = __builtin_bit_cast(float, __builtin_bit_cast(unsigned, cg[0][0]) & ~0xFFu);
#pragma unroll
        for (int k = 0; k < 16; ++k) { e[k] = __expf(__builtin_bit_cast(float, __builtin_bit_cast(unsigned, cg[0][k]) & ~0xFFu) - top); es += e[k]; }
        const float inv = 1.0f / es;
        LDS_WAIT();
        unsigned id[8]; float gt[8];
#pragma unroll
        for (int k = 0; k < 8; ++k) { const float clo_ = cg[0][k], chi_ = cg[0][8 + k], elo_ = e[k], ehi_ = e[8 + k]; const unsigned code = __builtin_bit_cast(unsigned, h ? chi_ : clo_) & 0xFFu; gt[k] = (h ? ehi_ : elo_) * inv;
            id[k] = (unsigned)slot[code >> 4] * 128u + (unsigned)slot[16 + (code & 15u)]; }
        LDS_WAIT();
        LAS v4u* ip = (LAS v4u*)(idxl + R * 16 + 8 * h); LAS f32x4* gp = (LAS f32x4*)(gatel + R * 16 + 8 * h);
        { v4u a; a.x = id[0]; a.y = id[1]; a.z = id[2]; a.w = id[3]; ip[0] = a; v4u b; b.x = id[4]; b.y = id[5]; b.z = id[6]; b.w = id[7]; ip[1] = b; }
        { f32x4 a; a[0] = gt[0]; a[1] = gt[1]; a[2] = gt[2]; a[3] = gt[3]; gp[0] = a; f32x4 b; b[0] = gt[4]; b[1] = gt[5]; b[2] = gt[6]; b[3] = gt[7]; gp[1] = b; }
    }
}

#define HROW_ISSUE(BUF, TAB, W) do { const unsigned vo_ = (((W) & 0x3fffu) << 9) + loff; asm volatile("global_load_dwordx4 %0, %1, %2" : "=v"(BUF) : "v"(vo_), "s"(TAB) : "memory"); } while (0)
__device__ __forceinline__ void peer_gather_half(const Ptrs& P, LAS unsigned char* lds, int unit, int lane, int wave, int g_lo, int g_hi) {
    asm volatile("" : "+v"(lane));
    const size_t t0 = (size_t)unit * 64 + wave * 8;
#pragma unroll 1
    for (int gq = g_lo; gq < g_hi; ++gq) {
        int lq = lane; asm volatile("" : "+v"(lq));
        LAS int* idxl = (LAS int*)(lds + 65536) + wave * 1024 + gq * 512;
        const LAS float* gatel = (const LAS float*)(lds + 98304) + wave * 1024 + gq * 512;
        LAS unsigned* sw = (LAS unsigned*)idxl; LAS float* sg = (LAS float*)(lds + 98304) + wave * 1024 + gq * 512;
        LAS int* startl = (LAS int*)(lds + 131072 + 4096) + wave * 64;
        {
            int ent[8]; float gv[8], us[8];
#pragma unroll
            for (int j = 0; j < 8; ++j) { ent[j] = idxl[(j >> 1) * 128 + (j & 1) * 64 + lq]; gv[j] = gatel[(j >> 1) * 128 + (j & 1) * 64 + lq]; }
#pragma unroll
            for (int j = 0; j < 8; ++j) { us[j] = P.USC[ent[j]]; gv[j] *= P.VSC[ent[j]] * 128.0f; }
            LDS_WAIT();
            int rk[8];
#pragma unroll
            for (int tk = 0; tk < 4; ++tk) {
                int run[NSL];
#pragma unroll
                for (int b = 0; b < NSL; ++b) run[b] = 0;
#pragma unroll
                for (int jj = 0; jj < 2; ++jj) { const int j = 2 * tk + jj; const int bj = ent[j] >> SLSH; int r = 0;
#pragma unroll
                    for (int b = 0; b < NSL; ++b) { const unsigned long long m = __ballot(bj == b);
                        const int below = (int)__builtin_amdgcn_mbcnt_hi((unsigned)(m >> 32), __builtin_amdgcn_mbcnt_lo((unsigned)m, 0u));
                        r = (bj == b) ? run[b] + below : r; run[b] += (int)__builtin_popcountll(m); }
                    rk[j] = r; }
                int st = 0;
#pragma unroll
                for (int b = 0; b < NSL; ++b) { if (lq == b) startl[tk * NSL + b] = st; st += run[b]; }
            }
            LDS_WAIT();
#pragma unroll
            for (int j = 0; j < 8; ++j) { const int pos = (j >> 1) * 128 + startl[(j >> 1) * NSL + (ent[j] >> SLSH)] + rk[j]; sw[pos] = (unsigned)ent[j] | (f2bf(us[j]) << 16); sg[pos] = gv[j]; }
            LDS_WAIT();
        }
        v4u hA0, hB0, hA1, hB1; float hs0, hs1;
        { int lg = lane; asm volatile("" : "+v"(lg)); const size_t tr = t0 + gq * 4 + (lg >> 5);
          const v4u* hp0 = (const v4u*)(P.HN8 + tr * 1024 + 32 * (lg & 31)); const v4u* hp1 = (const v4u*)(P.HN8 + (tr + 2) * 1024 + 32 * (lg & 31));
          hA0 = hp0[0]; hB0 = hp0[1]; hA1 = hp1[0]; hB1 = hp1[1]; hs0 = P.HSC[tr]; hs1 = P.HSC[tr + 2]; }
        h2 y0[16];
#pragma unroll 1
        for (int sub = 0; sub < 2; ++sub) {
            int lr = lane; asm volatile("" : "+v"(lr));
            const int l5 = lr & 31, tk = 2 * sub + (lr >> 5);
            const LAS unsigned* swt = sw + tk * 128; const LAS float* sgt = sg + tk * 128;
            const unsigned loff = (unsigned)l5 * 16u;
            {
                const int c4 = lr & 15, rho = lr >> 4;
                const int mtk = 2 * sub + (rho >> 1), mpos = (c4 < 4) ? 2 * c4 + (rho & 1) : 0;
                const LAS unsigned* swm = sw + mtk * 128 + mpos; LAS float* sgm = sg + mtk * 128 + mpos;
                v4u ha = sub ? hA1 : hA0, hb = sub ? hB1 : hB0; float hsc_m = sub ? hs1 : hs0;
                asm volatile("" : "+v"(ha), "+v"(hb), "+v"(hsc_m));
                v4u ub[16]; float p[8];
                unsigned mw; float mg;
#pragma unroll 1
                for (int pass = 0; pass < PROBE_SWEEPS; ++pass) {
                const bool lastp = (pass + 1 == PROBE_SWEEPS);
#define U_STEP(d, CNT, ISSUE, W) do { asm volatile("s_waitcnt vmcnt(" #CNT ")" : "+v"(ub[d]) :: "memory"); \
        { const v4u x_ = ub[d]; int a_ = 0, b_ = 0; \
          a_ = __builtin_amdgcn_sdot8((int)x_.x, (int)ha.x, a_, false); b_ = __builtin_amdgcn_sdot8((int)x_.x, (int)hb.x, b_, false); \
          a_ = __builtin_amdgcn_sdot8((int)x_.y, (int)ha.y, a_, false); b_ = __builtin_amdgcn_sdot8((int)x_.y, (int)hb.y, b_, false); \
          a_ = __builtin_amdgcn_sdot8((int)x_.z, (int)ha.z, a_, false); b_ = __builtin_amdgcn_sdot8((int)x_.z, (int)hb.z, b_, false); \
          a_ = __builtin_amdgcn_sdot8((int)x_.w, (int)ha.w, a_, false); b_ = __builtin_amdgcn_sdot8((int)x_.w, (int)hb.w, b_, false); \
          p[(d) & 7] = (float)((a_ << 4) + b_); } \
        if (ISSUE) HROW_ISSUE(ub[d], P.U8, W); } while (0)
#define U_FINISH(i0) do { float r_[4]; \
        _Pragma("unroll") for (int j = 0; j < 4; ++j) { auto rr = __builtin_amdgcn_permlane16_swap(__builtin_bit_cast(unsigned, p[2 * j]), __builtin_bit_cast(unsigned, p[2 * j + 1]), false, false); const unsigned r0 = rr[0], r1 = rr[1]; r_[j] = row16_sum(__builtin_bit_cast(float, r0) + __builtin_bit_cast(float, r1)); } \
        const float acol = (c4 == 0) ? r_[0] : (c4 == 1) ? r_[1] : (c4 == 2) ? r_[2] : r_[3]; \
        const float act = gelu_tanh(acol * __builtin_bit_cast(float, mw & 0xffff0000u) * hsc_m) * mg; \
        if (c4 < 4 && lastp) sgm[i0] = act; asm volatile("" :: "v"(act)); } while (0)
#define U_CHUNK(i0, B, WA, WB, C0, C1, C2, C3, C4, C5, C6, C7, ISSUE) do { mw = swm[i0]; mg = sgm[i0]; \
        U_STEP(B + 0, C0, ISSUE, WA.x); U_STEP(B + 1, C1, ISSUE, WA.y); U_STEP(B + 2, C2, ISSUE, WA.z); U_STEP(B + 3, C3, ISSUE, WA.w); \
        U_STEP(B + 4, C4, ISSUE, WB.x); U_STEP(B + 5, C5, ISSUE, WB.y); U_STEP(B + 6, C6, ISSUE, WB.z); U_STEP(B + 7, C7, ISSUE, WB.w); \
        U_FINISH(i0); } while (0)
                {
                    const v4u w0 = *(const LAS v4u*)(swt), w1 = *(const LAS v4u*)(swt + 4), w2 = *(const LAS v4u*)(swt + 8), w3 = *(const LAS v4u*)(swt + 12);
                    HROW_ISSUE(ub[0], P.U8, w0.x); HROW_ISSUE(ub[1], P.U8, w0.y); HROW_ISSUE(ub[2], P.U8, w0.z); HROW_ISSUE(ub[3], P.U8, w0.w);
                    HROW_ISSUE(ub[4], P.U8, w1.x); HROW_ISSUE(ub[5], P.U8, w1.y); HROW_ISSUE(ub[6], P.U8, w1.z); HROW_ISSUE(ub[7], P.U8, w1.w);
                    HROW_ISSUE(ub[8], P.U8, w2.x); HROW_ISSUE(ub[9], P.U8, w2.y); HROW_ISSUE(ub[10], P.U8, w2.z); HROW_ISSUE(ub[11], P.U8, w2.w);
                    HROW_ISSUE(ub[12], P.U8, w3.x); HROW_ISSUE(ub[13], P.U8, w3.y); HROW_ISSUE(ub[14], P.U8, w3.z); HROW_ISSUE(ub[15], P.U8, w3.w);
                }
                v4u wa = *(const LAS v4u*)(swt + 16), wb = *(const LAS v4u*)(swt + 20);
#pragma unroll 1
                for (int i0 = 0; i0 < 112; i0 += 16) {
                    const v4u wc = *(const LAS v4u*)(swt + i0 + 24), wd = *(const LAS v4u*)(swt + i0 + 28);
                    U_CHUNK(i0, 0, wa, wb, 15, 15, 15, 15, 15, 15, 15, 15, 1);
                    wa = *(const LAS v4u*)(swt + i0 + 32); wb = *(const LAS v4u*)(swt + i0 + 36);
                    U_CHUNK(i0 + 8, 8, wc, wd, 15, 15, 15, 15, 15, 15, 15, 15, 1);
                }
                U_CHUNK(112, 0, wa, wb, 15, 14, 13, 12, 11, 10, 9, 8, 0);
                U_CHUNK(120, 8, wa, wb, 7, 6, 5, 4, 3, 2, 1, 0, 0);
                }
#undef U_CHUNK
#undef U_FINISH
#undef U_STEP
            }
            LDS_WAIT();
            h2 y[16];
#pragma unroll
            for (int k = 0; k < 16; ++k) { y[k][0] = (_Float16)0.f; y[k][1] = (_Float16)0.f; }
            {
                v4u vb[16];
#pragma unroll 1
                for (int pass = 0; pass < PROBE_SWEEPS; ++pass) {
                if (pass > 0) {
#pragma unroll
                    for (int k = 0; k < 16; ++k) { y[k][0] = (_Float16)0.f; y[k][1] = (_Float16)0.f; } }
#define V_F4(K, X, B) y[K] = __builtin_elementwise_fma(__builtin_bit_cast(h2, __builtin_amdgcn_cvt_scalef32_pk_f16_fp4(X, 1.0f, B)), a2_, y[K])
#define V_STEP(d, CNT, ISSUE, W, A) do { asm volatile("s_waitcnt vmcnt(" #CNT ")" : "+v"(vb[d]) :: "memory"); \
        { const v4u x_ = vb[d]; const h2 a2_ = __builtin_bit_cast(h2, __builtin_amdgcn_cvt_pkrtz(A, A)); \
          V_F4(0, x_.x, 0); V_F4(1, x_.x, 1); V_F4(2, x_.x, 2); V_F4(3, x_.x, 3); V_F4(4, x_.y, 0); V_F4(5, x_.y, 1); V_F4(6, x_.y, 2); V_F4(7, x_.y, 3); \
          V_F4(8, x_.z, 0); V_F4(9, x_.z, 1); V_F4(10, x_.z, 2); V_F4(11, x_.z, 3); V_F4(12, x_.w, 0); V_F4(13, x_.w, 1); V_F4(14, x_.w, 2); V_F4(15, x_.w, 3); } \
        if (ISSUE) HROW_ISSUE(vb[d], P.V8, W); } while (0)
#define V_CHUNK(i0, B, WA, WB, C0, C1, C2, C3, C4, C5, C6, C7, ISSUE) do { const f32x4 aa_ = *(const LAS f32x4*)(sgt + (i0)), ab_ = *(const LAS f32x4*)(sgt + (i0) + 4); \
        V_STEP(B + 0, C0, ISSUE, WA.x, aa_[0]); V_STEP(B + 1, C1, ISSUE, WA.y, aa_[1]); V_STEP(B + 2, C2, ISSUE, WA.z, aa_[2]); V_STEP(B + 3, C3, ISSUE, WA.w, aa_[3]); \
        V_STEP(B + 4, C4, ISSUE, WB.x, ab_[0]); V_STEP(B + 5, C5, ISSUE, WB.y, ab_[1]); V_STEP(B + 6, C6, ISSUE, WB.z, ab_[2]); V_STEP(B + 7, C7, ISSUE, WB.w, ab_[3]); } while (0)
                {
                    const v4u w0 = *(const LAS v4u*)(swt), w1 = *(const LAS v4u*)(swt + 4), w2 = *(const LAS v4u*)(swt + 8), w3 = *(const LAS v4u*)(swt + 12);
                    HROW_ISSUE(vb[0], P.V8, w0.x); HROW_ISSUE(vb[1], P.V8, w0.y); HROW_ISSUE(vb[2], P.V8, w0.z); HROW_ISSUE(vb[3], P.V8, w0.w);
                    HROW_ISSUE(vb[4], P.V8, w1.x); HROW_ISSUE(vb[5], P.V8, w1.y); HROW_ISSUE(vb[6], P.V8, w1.z); HROW_ISSUE(vb[7], P.V8, w1.w);
                    HROW_ISSUE(vb[8], P.V8, w2.x); HROW_ISSUE(vb[9], P.V8, w2.y); HROW_ISSUE(vb[10], P.V8, w2.z); HROW_ISSUE(vb[11], P.V8, w2.w);
                    HROW_ISSUE(vb[12], P.V8, w3.x); HROW_ISSUE(vb[13], P.V8, w3.y); HROW_ISSUE(vb[14], P.V8, w3.z); HROW_ISSUE(vb[15], P.V8, w3.w);
                }
                v4u wa = *(const LAS v4u*)(swt + 16), wb = *(const LAS v4u*)(swt + 20);
#pragma unroll 1
                for (int i0 = 0; i0 < 112; i0 += 16) {
                    const v4u wc = *(const LAS v4u*)(swt + i0 + 24), wd = *(const LAS v4u*)(swt + i0 + 28);
                    V_CHUNK(i0, 0, wa, wb, 15, 15, 15, 15, 15, 15, 15, 15, 1);
                    wa = *(const LAS v4u*)(swt + i0 + 32); wb = *(const LAS v4u*)(swt + i0 + 36);
                    V_CHUNK(i0 + 8, 8, wc, wd, 15, 15, 15, 15, 15, 15, 15, 15, 1);
                }
                V_CHUNK(112, 0, wa, wb, 15, 14, 13, 12, 11, 10, 9, 8, 0);
                V_CHUNK(120, 8, wa, wb, 7, 6, 5, 4, 3, 2, 1, 0, 0);
                }
#undef V_CHUNK
#undef V_STEP
#undef V_F4
            }
            if (sub == 0) {
#pragma unroll
                for (int k = 0; k < 16; ++k) y0[k] = y[k]; }
            else {
                v4u xb[2][4]; f32x4 wv[8];
#pragma unroll
                for (int tt = 0; tt < 2; ++tt)
#pragma unroll
                    for (int m = 0; m < 4; ++m) xb[tt][m] = *((const v4u*)(P.X1B + (t0 + gq * 4 + 2 * tt + (lr >> 5)) * 1024 + 32 * l5) + m);
#pragma unroll
                for (int m = 0; m < 8; ++m) wv[m] = *(const f32x4*)(P.fin_w + (32 * l5 + 4 * m));
#pragma unroll
                for (int tt = 0; tt < 2; ++tt) {
                    float* xr = P.out + (t0 + gq * 4 + 2 * tt + (lr >> 5)) * 1024 + 32 * l5;
                    f32x4 x[8]; float ss = 0.f;
#pragma unroll
                    for (int m = 0; m < 8; ++m) { const unsigned q0 = (m & 1) ? xb[tt][m >> 1].z : xb[tt][m >> 1].x, q1 = (m & 1) ? xb[tt][m >> 1].w : xb[tt][m >> 1].y;
                        const h2 ya = tt ? y[2 * m] : y0[2 * m], yb = tt ? y[2 * m + 1] : y0[2 * m + 1];
                        x[m][0] = bflo(q0) + (float)ya[0] * (1.0f / 128.0f); x[m][1] = bfhi(q0) + (float)ya[1] * (1.0f / 128.0f); x[m][2] = bflo(q1) + (float)yb[0] * (1.0f / 128.0f); x[m][3] = bfhi(q1) + (float)yb[1] * (1.0f / 128.0f);
                        ss += (x[m][0] * x[m][0] + x[m][1] * x[m][1]) + (x[m][2] * x[m][2] + x[m][3] * x[m][3]); }
                    ss = row16_sum(ss);
                    ss += __builtin_bit_cast(float, __builtin_amdgcn_ds_swizzle(__builtin_bit_cast(int, ss), 0x401F));
                    const float rstd = 1.0f / sqrtf(ss * (1.0f / 1024.0f) + EPS);
#pragma unroll
                    for (int m = 0; m < 8; ++m) *(f32x4*)(xr + 4 * m) = x[m] * rstd * wv[m];
                }
            }
        }
    }
}
#undef HROW_ISSUE

__device__ __forceinline__ void p7_peer(LAS unsigned char* lds, const Ptrs& P, int vcu, int G, int tid, int lane, int wave) {
    LAS bf16* k1l = (LAS bf16*)lds;
    LAS bf16* k2l = (LAS bf16*)(lds + 32768);
    LAS int* idxl = (LAS int*)(lds + 65536);
    LAS float* gatel = (LAS float*)(lds + 98304);
    for (int i = tid; i < 2048; i += 512) { const int n = i >> 4, c = i & 15, d = n * 16 + (c ^ (n & 15)); ((LAS v4u*)k1l)[d] = ((const v4u*)P.K1)[i]; ((LAS v4u*)k2l)[d] = ((const v4u*)P.K2)[i]; }
    __syncthreads();
    for (int unit = vcu; unit < M / 64; unit += G) {
#pragma unroll 1
        for (int st = 0; st < 4; ++st) {
            const int g = st >> 1;
            if ((st & 1) == 0)
#pragma unroll 1
              for (int rep = 0; rep < PROBE_TOPK; ++rep) peer_topk_unit_mfma(P, (const LAS unsigned char*)k1l, (const LAS unsigned char*)k2l, idxl, gatel, unit, lane, wave, g, g + 1);
            else peer_gather_half(P, lds, unit, lane, wave, g, g + 1);
        }
        __syncthreads();
    }
}

struct Args { const float* in[19]; float* out; unsigned char* ws; int ph_lo, ph_hi; };
__global__ void __launch_bounds__(NWAVES * 64, 2) mega_fwd(Args args) {
    extern __shared__ __attribute__((aligned(16))) unsigned char lds_raw[];
    LAS unsigned char* lds = (LAS unsigned char*)lds_raw;
    const int tid = threadIdx.x, lane = tid & 63, wave = __builtin_amdgcn_readfirstlane(tid >> 6);
    const int G = gridDim.x; const int bx = blockIdx.x; const int vcu = (G % 8 == 0) ? (bx % 8) * (G / 8) + bx / 8 : bx;
    unsigned char* ws = args.ws;
    Ptrs P;
    P.x = args.in[0]; P.mix_w = args.in[1]; P.w_in = args.in[2]; P.rel_bias = args.in[3]; P.sinks = args.in[4]; P.w_pa = args.in[5]; P.ln_w = args.in[6]; P.ln_b = args.in[7];
    P.w_s = args.in[8]; P.b_s = args.in[9]; P.w_pb = args.in[10]; P.w_out = args.in[11]; P.ffn_w = args.in[12]; P.w_q = args.in[13]; P.keys1 = args.in[14]; P.keys2 = args.in[15];
    P.pu = args.in[16]; P.pv = args.in[17]; P.fin_w = args.in[18]; P.out = args.out;
    P.WIN8 = ws + WS_WIN; P.WPAB = (bf16*)(ws + WS_WPA); P.WOUT = (bf16*)(ws + WS_WOUT); P.WQ8 = ws + WS_WQ;
    P.WINSC = (float*)(ws + WS_V + 131072); P.WQSC = (float*)(ws + WS_V + 163840); P.XSC = (float*)(ws + WS_V + 196608);
    P.K1 = (bf16*)(ws + WS_K1); P.K2 = (bf16*)(ws + WS_K2); P.WS = (bf16*)(ws + WS_WS);
    P.U8 = ws + WS_U; P.V8 = ws + WS_U + 8 * MiB; P.USC = (float*)(ws + WS_V); P.VSC = (float*)(ws + WS_V + 65536); P.HN8 = ws + WS_GU; P.HSC = (float*)(ws + WS_HSC);
    P.XN8 = ws + WS_G1; P.MERGED = (bf16*)(ws + WS_G1); P.HNQ = ws + WS_G1;
    P.GA = (bf16*)(ws + WS_G2); P.GB = (bf16*)(ws + WS_G2) + 1024; P.QP = (bf16*)(ws + WS_G2);
    P.AOUT = (bf16*)(ws + WS_G3); P.BOUT = (bf16*)(ws + WS_G3) + 512; P.X1B = (bf16*)(ws + WS_G3);
    P.Q = (bf16*)(ws + WS_Q); P.KV = (bf16*)(ws + WS_KV); P.GU = (bf16*)(ws + WS_GU); P.GV = (bf16*)(ws + WS_GV);

    for (int u = tid; u < (LDS_BYTES - MISC_OFF) / 4; u += NWAVES * 64) ((LAS unsigned*)(lds + MISC_OFF))[u] = 0u;
    __syncthreads();
    const int lo = args.ph_lo, hi = args.ph_hi;
    unsigned* barw = (unsigned*)(ws + WS_CTL) + CW_BAR;
    XcdBarrier bar; bar.bar = barw; bar.x = 0; bar.st = nullptr;
    if (hi - lo > 1) bar = xcd_barrier_post(barw, (volatile LAS unsigned*)(lds + MISC_OFF));
#define IN(k) (lo <= (k) && (k) < hi)
#define BOTH(k) (IN(k) && IN((k) + 1))
#define GRID_BAR() xcd_barrier(bar)
#define REPS(k) ((k) == PROBE_PHASE ? 2 : 1)

    if (IN(0)) {
#pragma unroll
        for (int rep = 0; rep < REPS(0); ++rep) { p0_prologue(lds, P, vcu, G, lane, wave); __syncthreads(); }
        if (BOTH(0)) GRID_BAR(); }

    if (IN(1)) {
        pg8::Gemm g{(const pg8::bf16_t*)P.XN8, (const pg8::bf16_t*)P.WIN8, M, NZ, D / 2, D / 2, P.XSC, P.WINSC}; pg8::StaticOrder S; S.init(M, NZ, G, bx);
        pg8::EpiZ E{P.Q, P.KV, P.GU, P.GV, P.GA, P.GB};
#pragma unroll
        for (int rep = 0; rep < REPS(1); ++rep) pg8::gemm_phase<pg8::EpiZ, pg8::StaticOrder, PG8_ALIGN, PG8_SP2, true>(lds, g, S, E);
        if (BOTH(1)) GRID_BAR();
    }

    if (IN(2)) {
        for (int rep = 0; rep < REPS(2); ++rep) {
        p2_fused(lds, P, vcu, G, tid, lane, wave);
        }
        if (BOTH(2)) GRID_BAR();
    }

    if (IN(3)) {
#pragma unroll
      for (int rep = 0; rep < REPS(3); ++rep) {
        { pg8::Gemm g{P.AOUT, P.WPAB, M, D, 1024, AB_LD, nullptr, nullptr}; pg8::StaticOrder S; S.init(M, D, G, bx);
          pg8::EpiMerge2 E{P.GA, P.MERGED};
          pg8::gemm_phase<pg8::EpiMerge2, pg8::StaticOrder, PG8_ALIGN, PG8_SP2>(lds, g, S, E); }
      }
        if (BOTH(3)) GRID_BAR();
    }

    if (IN(4)) {
        pg8::Gemm g{P.MERGED, P.WOUT, M, D, D, D, nullptr, nullptr}; pg8::StaticOrder S; S.init(M, D, G, bx);
        pg8::EpiResB E{P.x, (pg8::bf16_t*)P.X1B};
#pragma unroll
        for (int rep = 0; rep < REPS(4); ++rep) pg8::gemm_phase<pg8::EpiResB, pg8::StaticOrder, PG8_ALIGN, PG8_SP2>(lds, g, S, E);
        if (BOTH(4)) GRID_BAR();
    }

    if (IN(5)) {
        const int gw = vcu * NWAVES + wave, NGW = G * NWAVES;
#pragma unroll
        for (int rep = 0; rep < REPS(5); ++rep)
        for (int m = gw; m < M; m += NGW)
            rms_x1_row(P.X1B + (size_t)m * D, P.ffn_w, P.HNQ + (size_t)m * D, P.HN8 + (size_t)m * D, P.HSC + m, lane);
        if (BOTH(5)) GRID_BAR();
    }

    if (IN(6)) {
        pg8::Gemm g{(const pg8::bf16_t*)P.HNQ, (const pg8::bf16_t*)P.WQ8, M, 2048, D / 2, D / 2, P.HSC, P.WQSC}; pg8::StaticOrder S; S.init(M, 2048, G, bx);
        pg8::EpiPlain E{P.QP, 2048};
#pragma unroll
        for (int rep = 0; rep < REPS(6); ++rep) pg8::gemm_phase<pg8::EpiPlain, pg8::StaticOrder, PG8_ALIGN, PG8_SP2, true>(lds, g, S, E);
        if (BOTH(6)) GRID_BAR();
    }

    if (IN(7)) {
#pragma unroll 1
        for (int rep = 0; rep < REPS(7); ++rep) p7_peer(lds, P, vcu, G, tid, lane, wave);
    }
#undef IN
#undef BOTH
#undef GRID_BAR
}

extern "C" void kernel_launch(void* const* d_in, const int* in_sizes, int n_in, void* d_out, int out_size, void* d_ws, size_t ws_size, hipStream_t stream) {
    static int grid = 0;
    if (grid == 0) {
        if (n_in != 19 || out_size != M * D || ws_size < WS_END) { fprintf(stderr, "kernel_launch: unexpected shapes (n_in %d, out %d, ws %zu)\n", n_in, out_size, ws_size); grid = -1; return; }
        int dev = 0, cus = 0, per_cu = 0;
        if (hipGetDevice(&dev) != hipSuccess || hipDeviceGetAttribute(&cus, hipDeviceAttributeMultiprocessorCount, dev) != hipSuccess) { grid = -1; return; }
        if (hipFuncSetAttribute((const void*)mega_fwd, hipFuncAttributeMaxDynamicSharedMemorySize, LDS_BYTES) != hipSuccess) { fprintf(stderr, "kernel_launch: hipFuncSetAttribute failed\n"); grid = -1; return; }
        if (hipOccupancyMaxActiveBlocksPerMultiprocessor(&per_cu, (const void*)mega_fwd, NWAVES * 64, LDS_BYTES) != hipSuccess || per_cu < 1)
            fprintf(stderr, "kernel_launch: note: occupancy query reports %d workgroups per CU\n", per_cu);
        (void)hipGetLastError();
        grid = cus;
    }
    if (grid < 0) return;
    if (hipMemsetAsync((char*)d_ws + WS_CTL, 0, CTL_ZERO_BYTES, stream) != hipSuccess) return;
    Args a{};
    for (int i = 0; i < 19; ++i) a.in[i] = (const float*)d_in[i];
    a.out = (float*)d_out; a.ws = (unsigned char*)d_ws;
    a.ph_lo = 0; a.ph_hi = N_PHASES;
    hipLaunchKernelGGL(mega_fwd, dim3(grid), dim3(NWAVES * 64), LDS_BYTES, stream, a);
}
```

```cpp
#include <hip/hip_runtime.h>
#include <cstdio>
#include <cstdint>
#ifndef PROBE_SWEEPS
#define PROBE_SWEEPS 1
#endif
#ifndef PANEL_SEAMS
#define PANEL_SEAMS 1
#endif
#ifndef PANEL_FORCE_RELEASE
#define PANEL_FORCE_RELEASE 0
#endif
#ifndef PROBE_NOACQ
#define PROBE_NOACQ 0
#endif
#ifndef PROBE_TOPK
#define PROBE_TOPK 1
#endif
#ifndef PROBE_PHASE
#define PROBE_PHASE -1
#endif
#ifndef FP4_SELFCHECK
#define FP4_SELFCHECK 0
#endif
#ifndef NSL
#define NSL 8
#endif
#ifndef Q4_USTEP
#define Q4_USTEP 0.36f
#endif
#ifndef Q4_VUNIT
#define Q4_VUNIT 0.5f
#endif
namespace pg8 {
#define PG8_LAS __attribute__((address_space(3)))
typedef unsigned short bf16_t;
typedef short bf16x8 __attribute__((ext_vector_type(8)));
typedef float f32x4 __attribute__((ext_vector_type(4)));
typedef unsigned u32x4 __attribute__((ext_vector_type(4)));
typedef int i32x4 __attribute__((ext_vector_type(4)));
constexpr int BM = 256, BK = 64, HALF = 128, HTB = HALF * BK * 2  , STAGE_BYTES = 8 * HTB, NXCD = 8, WGM = 8;

__host__ __device__ __forceinline__ int lds_byte(int r, int c) { const int st = (r >> 4) * 2 + (c >> 5), rr = r & 15, cc = c & 31, ob = rr * 64 + cc * 2; return st * 1024 + (ob ^ (((ob >> 9) & 1) << 5)); }
__host__ __device__ __forceinline__ void stage_rc(int b, int& R, int& C) { const int st = b / 1024, sb = b % 1024, swz = sb ^ (((sb >> 9) & 1) << 5); R = (st >> 1) * 16 + swz / 64; C = (st & 1) * 32 + (swz % 64) / 2; }
__host__ __device__ __forceinline__ int perm32(int rho) { const int n = rho >> 4, i = rho & 15; return 8 * (i >> 2) + 4 * n + (i & 3); }

struct Unit { int pm, pn; };
struct Gemm { const bf16_t* A; const bf16_t* Bt; int M, N, K, lda; const float* rs; const float* cs; };

struct StaticOrder {
    int nM, nN, nwg, G, c;
    __host__ __device__ void init(int M, int N, int G_, int c_) { nM = M / BM; nN = N / BM; nwg = nM * nN; G = G_; c = c_; }
    __host__ __device__ bool next(int i, Unit& u) const {
        const long L = (long)i * G + c; if (L >= nwg) return false;
        int wgid = (int)L; { const int q = nwg / NXCD, r = nwg % NXCD, xcd = wgid % NXCD, off = wgid / NXCD; wgid = (xcd < r ? xcd * (q + 1) : r * (q + 1) + (xcd - r) * q) + off; }
        const int nig = WGM * nN, gid = wgid / nig, fm = gid * WGM, gsz = (nM - fm) < WGM ? (nM - fm) : WGM;
        u.pm = fm + ((wgid % nig) % gsz); u.pn = (wgid % nig) / gsz; return true;
    }
    __device__ __forceinline__ void a_ready(const Unit&) const {}
    __device__ __forceinline__ void done(const Unit&) const {}
};

__device__ __forceinline__ unsigned cvt_pk_bf16(float lo, float hi) { unsigned r; asm volatile("v_cvt_pk_bf16_f32 %0, %1, %2" : "=v"(r) : "v"(lo), "v"(hi)); return r; }
typedef float f32x2 __attribute__((ext_vector_type(2)));
template <class Epi, class Sched, bool ALIGN_EPI = false, bool SP2 = false, bool I8 = false>
__device__ __forceinline__ void gemm_phase(PG8_LAS unsigned char* lds, const Gemm g, const Sched& S, const Epi& E) {
    const int tid = threadIdx.x, wid = __builtin_amdgcn_readfirstlane(tid >> 6), lane = tid & 63, wr = wid >> 2, wc = wid & 3, fr = lane & 15, fq = lane >> 4;
    const int K = g.K, nt = K / BK;
    unsigned voffA[2], voffB[2];
#pragma unroll
    for (int i = 0; i < 2; ++i) { int R, C; stage_rc(tid * 16 + i * 8192, R, C); const int Rb = Epi::PERM ? ((R & ~31) + perm32(R & 31)) : R;
        voffA[i] = (unsigned)(R * g.lda + C) * 2u; voffB[i] = (unsigned)(Rb * K + C) * 2u; }
    const size_t kstep = (size_t)(BK * 2);
    const size_t hstep = (size_t)HALF * K * 2;
    const size_t tstep = 2 * hstep;
    const size_t hstepA = (size_t)HALF * g.lda * 2, tstepA = 2 * hstepA;
    const unsigned ldsw = (unsigned)wid * 1024u;
    const int aoff = lds_byte(wr * 64 + fr, fq * 8), boff = lds_byte(wc * 32 + fr, fq * 8);
#define PG8_SA(b, h) (((b) * 2 + (h)) * HTB)
#define PG8_SB(b, h) ((4 + (b) * 2 + (h)) * HTB)
#define PG8_STAGE(bufoff, gbase, voff) do { _Pragma("unroll") for (int _i = 0; _i < 2; ++_i) \
        __builtin_amdgcn_global_load_lds((const unsigned*)((const char*)(gbase) + (voff)[_i]), (PG8_LAS unsigned*)(lds + (bufoff) + ldsw + _i * 8192), 16, 0, 0); } while (0)
#define PG8_LDA(dst, b, h) do { _Pragma("unroll") for (int m = 0; m < 4; ++m) _Pragma("unroll") for (int k = 0; k < 2; ++k) dst[m][k] = *(const PG8_LAS bf16x8*)(lds + PG8_SA(b, h) + aoff + m * 2048 + k * 1024); } while (0)
#define PG8_LDB(dst, b, h) do { _Pragma("unroll") for (int n = 0; n < 2; ++n) _Pragma("unroll") for (int k = 0; k < 2; ++k) dst[n][k] = *(const PG8_LAS bf16x8*)(lds + PG8_SB(b, h) + boff + n * 2048 + k * 1024); } while (0)
#define PG8_MMA(ai, bj, At, Bt) do { __builtin_amdgcn_s_setprio(1); _Pragma("unroll") for (int m = 0; m < 4; ++m) _Pragma("unroll") for (int n = 0; n < 2; ++n) _Pragma("unroll") for (int k = 0; k < 2; ++k) \
        { if constexpr (I8) acc[ai][bj][m][n] = __builtin_bit_cast(f32x4, __builtin_amdgcn_mfma_i32_16x16x64_i8(__builtin_bit_cast(i32x4, Bt[n][k]), __builtin_bit_cast(i32x4, At[m][k]), __builtin_bit_cast(i32x4, acc[ai][bj][m][n]), 0, 0, 0)); \
          else acc[ai][bj][m][n] = __builtin_amdgcn_mfma_f32_16x16x32_bf16(Bt[n][k], At[m][k], acc[ai][bj][m][n], 0, 0, 0); } __builtin_amdgcn_s_setprio(0); } while (0)
#define PG8_WAIT_V(n) asm volatile("s_waitcnt vmcnt(" #n ")" ::: "memory")
#define PG8_WAIT_L(n) asm volatile("s_waitcnt lgkmcnt(" #n ")" ::: "memory")
#define PG8_BAR __builtin_amdgcn_s_barrier()
#define PG8_SCHED __builtin_amdgcn_sched_barrier(0)
    Unit cur, nxt; int ui = 0;
    if (!S.next(0, cur)) return;
    f32x4 acc[2][2][4][2];
#pragma unroll
    for (int a = 0; a < 2; ++a)
#pragma unroll
        for (int b = 0; b < 2; ++b)
#pragma unroll
            for (int m = 0; m < 4; ++m)
#pragma unroll
                for (int n = 0; n < 2; ++n) acc[a][b][m][n] = (f32x4){0.f, 0.f, 0.f, 0.f};
    bf16x8 At[4][2], B0[2][2], B1[2][2];
    const char* cA = (const char*)g.A + (size_t)cur.pm * tstepA; const char* cB = (const char*)g.Bt + (size_t)cur.pn * tstep;
    S.a_ready(cur);
    if constexpr (SP2) {
        PG8_STAGE(PG8_SB(0, 0), cB, voffB); PG8_STAGE(PG8_SB(0, 1), cB + hstep, voffB); PG8_STAGE(PG8_SA(0, 0), cA, voffA); PG8_STAGE(PG8_SA(0, 1), cA + hstepA, voffA);
        if (wr == 1) PG8_BAR;
        PG8_WAIT_V(2); PG8_BAR;
        PG8_STAGE(PG8_SB(1, 0), cB + kstep, voffB); PG8_STAGE(PG8_SA(1, 0), cA + kstep, voffA); PG8_STAGE(PG8_SB(1, 1), cB + hstep + kstep, voffB);
        PG8_WAIT_V(6); PG8_BAR;
    } else {
        PG8_STAGE(PG8_SB(0, 0), cB, voffB); PG8_STAGE(PG8_SA(0, 0), cA, voffA); PG8_STAGE(PG8_SB(0, 1), cB + hstep, voffB); PG8_STAGE(PG8_SA(0, 1), cA + hstepA, voffA);
        if (wr == 1) PG8_BAR;
        PG8_WAIT_V(4); PG8_BAR;
        PG8_STAGE(PG8_SB(1, 0), cB + kstep, voffB); PG8_STAGE(PG8_SA(1, 0), cA + kstep, voffA); PG8_STAGE(PG8_SB(1, 1), cB + hstep + kstep, voffB);
        PG8_WAIT_V(6); PG8_BAR;
    }
    for (;;) {
        const bool has_next = S.next(ui + 1, nxt);
        const char* nA = has_next ? (const char*)g.A + (size_t)nxt.pm * tstepA : cA; const char* nB = has_next ? (const char*)g.Bt + (size_t)nxt.pn * tstep : cB;
        for (int t = 0; t < nt; t += 2) {
            if constexpr (Epi::HAS_MID) { if (t == (nt >> 1)) E.mid(acc, cur, wr, wc, fr, fq); }
            const bool last = (t == nt - 2);
            const char* a1 = cA + (size_t)(t + 1) * kstep;
            const char* a2 = last ? nA : cA + (size_t)(t + 2) * kstep; const char* b2 = last ? nB : cB + (size_t)(t + 2) * kstep;
            const char* a3 = a2 + kstep; const char* b3 = b2 + kstep;
            if (last && has_next) S.a_ready(nxt);
            if constexpr (SP2) {
            PG8_LDB(B0, 0, 0); PG8_LDB(B1, 0, 1); PG8_SCHED; PG8_LDA(At, 0, 0); PG8_STAGE(PG8_SA(1, 1), a1 + hstepA, voffA);
            PG8_WAIT_V(8); PG8_WAIT_L(0); PG8_BAR; PG8_MMA(0, 0, At, B0); PG8_MMA(0, 1, At, B1); PG8_BAR; PG8_SCHED;
            PG8_LDA(At, 0, 1); PG8_STAGE(PG8_SB(0, 0), b2, voffB); PG8_STAGE(PG8_SB(0, 1), b2 + hstep, voffB); PG8_STAGE(PG8_SA(0, 0), a2, voffA);
            PG8_WAIT_V(8); PG8_WAIT_L(0); PG8_BAR; PG8_MMA(1, 0, At, B0); PG8_MMA(1, 1, At, B1); PG8_BAR; PG8_SCHED;
            PG8_LDB(B0, 1, 0); PG8_LDB(B1, 1, 1); PG8_SCHED; PG8_LDA(At, 1, 0); PG8_STAGE(PG8_SA(0, 1), a2 + hstepA, voffA);
            PG8_WAIT_V(8); PG8_WAIT_L(0); PG8_BAR; PG8_MMA(0, 0, At, B0); PG8_MMA(0, 1, At, B1); PG8_BAR; PG8_SCHED;
            PG8_LDA(At, 1, 1); PG8_STAGE(PG8_SB(1, 0), b3, voffB); PG8_STAGE(PG8_SB(1, 1), b3 + hstep, voffB); PG8_STAGE(PG8_SA(1, 0), a3, voffA);
            PG8_WAIT_V(8); PG8_WAIT_L(0); PG8_BAR; PG8_MMA(1, 0, At, B0); PG8_MMA(1, 1, At, B1); PG8_BAR; PG8_SCHED;
            } else {
            PG8_LDB(B0, 0, 0); PG8_SCHED; PG8_LDA(At, 0, 0); PG8_STAGE(PG8_SA(1, 1), a1 + hstepA, voffA);
            PG8_WAIT_L(8); PG8_BAR; PG8_WAIT_L(0); PG8_MMA(0, 0, At, B0); PG8_BAR; PG8_SCHED;
            PG8_LDB(B1, 0, 1); PG8_STAGE(PG8_SB(0, 0), b2, voffB);
            PG8_BAR; PG8_WAIT_L(0); PG8_MMA(0, 1, At, B1); PG8_BAR;
            PG8_LDA(At, 0, 1); PG8_STAGE(PG8_SA(0, 0), a2, voffA);
            PG8_BAR; PG8_WAIT_L(0); PG8_MMA(1, 0, At, B0); PG8_BAR; PG8_SCHED;
            PG8_STAGE(PG8_SB(0, 1), b2 + hstep, voffB);
            PG8_WAIT_V(6); PG8_BAR; PG8_MMA(1, 1, At, B1); PG8_BAR;
            PG8_LDB(B0, 1, 0); PG8_SCHED; PG8_LDA(At, 1, 0); PG8_STAGE(PG8_SA(0, 1), a2 + hstepA, voffA);
            PG8_WAIT_L(8); PG8_BAR; PG8_WAIT_L(0); PG8_MMA(0, 0, At, B0); PG8_BAR; PG8_SCHED;
            PG8_LDB(B1, 1, 1); PG8_STAGE(PG8_SB(1, 0), b3, voffB);
            PG8_BAR; PG8_WAIT_L(0); PG8_MMA(0, 1, At, B1); PG8_BAR;
            PG8_LDA(At, 1, 1); PG8_STAGE(PG8_SA(1, 0), a3, voffA);
            PG8_BAR; PG8_WAIT_L(0); PG8_MMA(1, 0, At, B0); PG8_BAR; PG8_SCHED;
            PG8_STAGE(PG8_SB(1, 1), b3 + hstep, voffB);
            PG8_WAIT_V(6); PG8_BAR; PG8_MMA(1, 1, At, B1); PG8_BAR;
            }
        }
        if constexpr (ALIGN_EPI) { if (wr == 0) PG8_BAR; }
        if constexpr (I8) {
            f32x4 csv[2][2];
#pragma unroll
            for (int bj = 0; bj < 2; ++bj)
#pragma unroll
                for (int n = 0; n < 2; ++n) csv[bj][n] = *(const f32x4*)(g.cs + cur.pn * BM + bj * HALF + wc * 32 + (Epi::PERM ? 8 * fq + 4 * n : 16 * n + 4 * fq));
#pragma unroll
            for (int ai = 0; ai < 2; ++ai)
#pragma unroll
                for (int m = 0; m < 4; ++m) { const float rsv = g.rs[cur.pm * BM + ai * HALF + wr * 64 + m * 16 + fr];
#pragma unroll
                    for (int bj = 0; bj < 2; ++bj)
#pragma unroll
                        for (int n = 0; n < 2; ++n) { const i32x4 iv = __builtin_bit_cast(i32x4, acc[ai][bj][m][n]); f32x4 fv;
                            fv[0] = (float)iv[0]; fv[1] = (float)iv[1]; fv[2] = (float)iv[2]; fv[3] = (float)iv[3];
                            acc[ai][bj][m][n] = fv * rsv * csv[bj][n]; } }
        }
        if constexpr (!Epi::AFTER_DRAIN) { E(acc, cur, wr, wc, fr, fq); S.done(cur); }
        if (!has_next) break;
#pragma unroll
        for (int a = 0; a < 2; ++a)
#pragma unroll
            for (int b = 0; b < 2; ++b)
#pragma unroll
                for (int m = 0; m < 4; ++m)
#pragma unroll
                    for (int n = 0; n < 2; ++n) acc[a][b][m][n] = (f32x4){0.f, 0.f, 0.f, 0.f};
        cur = nxt; cA = nA; cB = nB; ++ui;
        if constexpr (ALIGN_EPI) { if (wr == 1) PG8_BAR; }
    }
    PG8_WAIT_V(0);
    if constexpr (!ALIGN_EPI) { if (wr == 0) PG8_BAR; }
    PG8_BAR;
    if constexpr (Epi::AFTER_DRAIN) { E.fused(acc, cur, wr, wc, fr, fq, lds, wid, lane); S.done(cur); }
#undef PG8_SA
#undef PG8_SB
#undef PG8_STAGE
#undef PG8_LDA
#undef PG8_LDB
#undef PG8_MMA
#undef PG8_WAIT_V
#undef PG8_WAIT_L
#undef PG8_BAR
#undef PG8_SCHED
}
}
#ifndef PG8_SP2
#define PG8_SP2 true
#endif
#ifndef PG8_ALIGN
#define PG8_ALIGN true
#endif

constexpr int NWAVES = 8;
constexpr int N_PHASES = 8;
#define SLSH (NSL == 4 ? 12 : NSL == 2 ? 13 : NSL == 64 ? 8 : NSL == 32 ? 9 : NSL == 16 ? 10 : 11)

constexpr int NB = 2, SEQ = 8192, D = 1024, M = NB * SEQ;
constexpr int NZ = 3840;
constexpr float EPS = 1e-6f;
constexpr int AB_LD = 1024;

constexpr size_t MiB = 1u << 20;
constexpr size_t WS_CTL = 0, CTL_ZERO_BYTES = 65536;
constexpr size_t WS_WIN = 1 * MiB;
constexpr size_t WS_WPA = 9 * MiB;
constexpr size_t WS_WOUT = 11 * MiB;
constexpr size_t WS_WQ = 13 * MiB;
constexpr size_t WS_K1 = 17 * MiB;
constexpr size_t WS_K2 = 17 * MiB + 32768;
constexpr size_t WS_WS = 17 * MiB + 65536;
constexpr size_t WS_U = 18 * MiB;
constexpr size_t WS_V = 34 * MiB;
constexpr size_t WS_G1 = 36 * MiB;
constexpr size_t WS_G2 = 68 * MiB;
constexpr size_t WS_G3 = 132 * MiB;
constexpr size_t WS_Q = 164 * MiB;
constexpr size_t WS_KV = 180 * MiB;
constexpr size_t WS_GU = 188 * MiB;
constexpr size_t WS_GV = 204 * MiB;
constexpr size_t WS_HSC = 220 * MiB;
constexpr size_t WS_END = 221 * MiB;
constexpr int CW_BAR = 0;

constexpr int RING_BYTES = 131072;
constexpr int MISC_OFF = 143360;
constexpr int LDS_BYTES = 147456;

#define GAS __attribute__((address_space(1)))
#define LAS __attribute__((address_space(3)))
typedef unsigned short bf16;
typedef unsigned v4u __attribute__((ext_vector_type(4)));
typedef unsigned v2u __attribute__((ext_vector_type(2)));
typedef float f32x4 __attribute__((ext_vector_type(4)));
typedef _Float16 h2 __attribute__((ext_vector_type(2)));
typedef GAS unsigned gu32;
typedef __bf16 bf16x2_t __attribute__((ext_vector_type(2)));
#define RLX_AGENT __ATOMIC_RELAXED, __HIP_MEMORY_SCOPE_AGENT
#define LDS_WAIT() asm volatile("s_waitcnt lgkmcnt(0)" ::: "memory")
#define VM_WAIT() asm volatile("s_waitcnt vmcnt(0)" ::: "memory")
__device__ __forceinline__ unsigned f2bf(float f) { unsigned u = __builtin_bit_cast(unsigned, f); return (u + 0x7fffu + ((u >> 16) & 1u)) >> 16; }
__device__ __forceinline__ unsigned pk2(float lo, float hi) { return f2bf(lo) | (f2bf(hi) << 16); }
__device__ __forceinline__ float bflo(unsigned w) { return __builtin_bit_cast(float, w << 16); }
__device__ __forceinline__ float bfhi(unsigned w) { return __builtin_bit_cast(float, w & 0xffff0000u); }
__device__ __forceinline__ float bf2f(bf16 h) { return __builtin_bit_cast(float, (unsigned)h << 16); }
__device__ __forceinline__ float dot2bf(unsigned a, unsigned b, float c) { return __builtin_amdgcn_fdot2_f32_bf16(__builtin_bit_cast(bf16x2_t, a), __builtin_bit_cast(bf16x2_t, b), c, false); }
__device__ __forceinline__ float gelu_tanh(float v) {
    const float t2 = v * (-2.302208198f + (-0.1029432397f) * v * v);
    return v * __builtin_amdgcn_rcpf(1.0f + __builtin_amdgcn_exp2f(t2));
}
__device__ __forceinline__ float sigmoid_f(float v) { return __builtin_amdgcn_rcpf(1.0f + __builtin_amdgcn_exp2f(-1.4426950409f * v)); }
template <int CTRL> __device__ __forceinline__ float dppmov(float v) { return __builtin_bit_cast(float, __builtin_amdgcn_update_dpp(0, __builtin_bit_cast(int, v), CTRL, 0xF, 0xF, false)); }
__device__ __forceinline__ float row16_sum(float v) {
    v += dppmov<0xB1>(v);
    v += dppmov<0x4E>(v);
    v += dppmov<0x141>(v);
    v += dppmov<0x140>(v);
    return v;
}
__device__ __forceinline__ float xor32_f(float v) {
    const unsigned u = __builtin_bit_cast(unsigned, v);
    auto rr = __builtin_amdgcn_permlane32_swap(u, u, false, false);
    const unsigned r0 = rr[0], r1 = rr[1];
    return __builtin_bit_cast(float, (__lane_id() & 32) ? r0 : r1);
}
__device__ __forceinline__ float wave_sum(float v) {
    v = row16_sum(v);
    v += __builtin_bit_cast(float, __builtin_amdgcn_ds_swizzle(__builtin_bit_cast(int, v), 0x401F));
    const unsigned u = __builtin_bit_cast(unsigned, v);
    auto rr = __builtin_amdgcn_permlane32_swap(u, u, false, false);
    const unsigned r0 = rr[0], r1 = rr[1];
    return __builtin_bit_cast(float, r0) + __builtin_bit_cast(float, r1);
}
__device__ __forceinline__ float wave_max(float v) {
    v = fmaxf(v, dppmov<0xB1>(v)); v = fmaxf(v, dppmov<0x4E>(v)); v = fmaxf(v, dppmov<0x141>(v)); v = fmaxf(v, dppmov<0x140>(v));
    v = fmaxf(v, __builtin_bit_cast(float, __builtin_amdgcn_ds_swizzle(__builtin_bit_cast(int, v), 0x401F)));
    const unsigned u = __builtin_bit_cast(unsigned, v);
    auto rr = __builtin_amdgcn_permlane32_swap(u, u, false, false);
    const unsigned r0 = rr[0], r1 = rr[1];
    return fmaxf(__builtin_bit_cast(float, r0), __builtin_bit_cast(float, r1));
}
__device__ const unsigned char T5B[128] = {0, 1, 2, 3, 4, 5, 6, 7, 8, 9, 10, 11, 12, 13, 14, 15, 16, 16, 16, 17, 17, 18, 18, 18, 19, 19, 19, 20, 20, 20, 20, 21, 21, 21, 21, 22, 22, 22, 22, 22, 23, 23, 23, 23, 23, 23, 24, 24, 24, 24, 24, 24, 25, 25, 25, 25, 25, 25, 25, 26, 26, 26, 26, 26, 26, 26, 26, 27, 27, 27, 27, 27, 27, 27, 27, 27, 27, 28, 28, 28, 28, 28, 28, 28, 28, 28, 28, 29, 29, 29, 29, 29, 29, 29, 29, 29, 29, 29, 29, 30, 30, 30, 30, 30, 30, 30, 30, 30, 30, 30, 30, 30, 30, 31, 31, 31, 31, 31, 31, 31, 31, 31, 31, 31, 31, 31, 31, 31};
#define XB_TMO      128
#define XB_XCNT(j)  (256  + 64 * (j))
#define XB_XSUB(j)  (1280 + 64 * (j))
#define XB_XGEN(j)  (2304 + 64 * (j))
#define XB_TOP      3328
#define XB_TOPGEN   3392
#define XCD_BAR_WORDS 3456
#define XB_SPIN_CAP (1u << 18)

__device__ __forceinline__ unsigned xb_ld(unsigned* p)              { return __hip_atomic_load(p, __ATOMIC_RELAXED, __HIP_MEMORY_SCOPE_AGENT); }
__device__ __forceinline__ unsigned xb_add(unsigned* p, unsigned v) { return __hip_atomic_fetch_add(p, v, __ATOMIC_RELAXED, __HIP_MEMORY_SCOPE_AGENT); }
__device__ __forceinline__ unsigned xb_xcc_id() { return (unsigned)__builtin_amdgcn_s_getreg((3 << 11) | 20) & 0xFu; }
#define XB_SPIN(cond, bar) do { unsigned _sp = 0; while (cond) { __builtin_amdgcn_s_sleep(1); \
    if ((++_sp & 255u) == 0u) { if (xb_ld(&(bar)[XB_TMO])) break; if (_sp > XB_SPIN_CAP) { atomicAdd(&(bar)[XB_TMO], 1u); break; } } } } while (0)

struct XcdBarrier {
    unsigned* bar; unsigned x;
    volatile LAS unsigned* st;
};

__device__ __forceinline__ XcdBarrier xcd_barrier_post(unsigned* bar, volatile LAS unsigned* st) {
    XcdBarrier b; b.bar = bar; b.x = xb_xcc_id(); b.st = st;
    if (threadIdx.x == 0) (void)xb_add(&bar[XB_XCNT(b.x)], 1u);
    return b;
}
__device__ __forceinline__ void xcd_barrier_complete(unsigned* bar, unsigned x, unsigned& nloc, unsigned& nx) {
    const unsigned G = gridDim.x * gridDim.y * gridDim.z;
    unsigned sum, cnt, mine, sp = 0u;
    for (;;) {
        sum = 0u; cnt = 0u; mine = 0u;
#pragma unroll
        for (unsigned j = 0; j < 16; ++j) { const unsigned c = xb_ld(&bar[XB_XCNT(j)]); sum += c; cnt += (c > 0u) ? 1u : 0u; mine = (j == x) ? c : mine; }
        if (sum == G) break;
        __builtin_amdgcn_s_sleep(1);
        if ((++sp & 255u) == 0u) { if (xb_ld(&bar[XB_TMO])) break; if (sp > XB_SPIN_CAP) { atomicAdd(&bar[XB_TMO], 1u); break; } }
    }
    nloc = mine > 0u ? mine : 1u; nx = cnt > 0u ? cnt : 1u;
}

__device__ __forceinline__ void xcd_barrier(const XcdBarrier& b) {
    asm volatile("s_waitcnt vmcnt(0)" ::: "memory");
    __syncthreads();
    if (threadIdx.x == 0) {
        unsigned* bar = b.bar;
        __builtin_amdgcn_s_waitcnt(0);
        unsigned nloc = b.st[0], nx = b.st[1];
        if (nloc == 0u) { xcd_barrier_complete(bar, b.x, nloc, nx); b.st[0] = nloc; b.st[1] = nx; }
        const unsigned old = xb_add(&bar[XB_XSUB(b.x)], 1u);
        const unsigned gen = old / nloc;
        if (old + 1u == (gen + 1u) * nloc) {
            __builtin_amdgcn_fence(__ATOMIC_RELEASE, "agent");
            asm volatile("s_waitcnt vmcnt(0)" ::: "memory");
            const unsigned og = xb_add(&bar[XB_TOP], 1u);
            const unsigned tg = og / nx;
            if (og + 1u == (tg + 1u) * nx) xb_add(&bar[XB_TOPGEN], 1u);
            else XB_SPIN(xb_ld(&bar[XB_TOPGEN]) == tg, bar);
            __builtin_amdgcn_fence(__ATOMIC_ACQUIRE, "agent");
            xb_add(&bar[XB_XGEN(b.x)], 1u);
            asm volatile("s_waitcnt vmcnt(0)" ::: "memory");
        } else {
            XB_SPIN(xb_ld(&bar[XB_XGEN(b.x)]) == gen, bar);
            __builtin_amdgcn_fence(__ATOMIC_ACQUIRE, "agent");
            asm volatile("s_waitcnt vmcnt(0)" ::: "memory");
        }
    }
    __syncthreads();
}
#define ST16(PTR, VAL) (*(PTR) = (VAL))
namespace pg8 {
struct EpiZ {
    static constexpr bool PERM = true, AFTER_DRAIN = false, HAS_MID = false;
    bf16_t *Q, *KV, *GU, *GV, *GA, *GB;
    __device__ __forceinline__ void operator()(const f32x4 (&acc)[2][2][4][2], const Unit& u, int wr, int wc, int fr, int fq) const {
        const int pn = u.pn; bf16_t* base; int ldc, colt, act;
        if (pn < 2)       { base = Q;  ldc = 512;  colt = pn * 256;        act = 0; }
        else if (pn == 2) { base = KV; ldc = 256;  colt = 0;               act = 0; }
        else if (pn < 5)  { base = GU; ldc = 512;  colt = (pn - 3) * 256;  act = 1; }
        else if (pn < 7)  { base = GV; ldc = 512;  colt = (pn - 5) * 256;  act = 1; }
        else if (pn < 11) { base = GA; ldc = 2048; colt = (pn - 7) * 256;  act = 2; }
        else              { base = GB; ldc = 2048; colt = (pn - 11) * 256; act = 2; }
        const int row0 = u.pm * BM + wr * 64 + fr, col0 = colt + wc * 32 + 8 * fq;
#pragma unroll
        for (int ai = 0; ai < 2; ++ai)
#pragma unroll
            for (int m = 0; m < 4; ++m) { bf16_t* rowp = base + (size_t)(row0 + ai * HALF + m * 16) * ldc + col0;
#pragma unroll
                for (int bj = 0; bj < 2; ++bj) { f32x4 v0 = acc[ai][bj][m][0], v1 = acc[ai][bj][m][1];
                    if (act == 1) {
#pragma unroll
                        for (int e = 0; e < 4; ++e) { v0[e] = gelu_tanh(v0[e]); v1[e] = gelu_tanh(v1[e]); }
                    } else if (act == 2) {
#pragma unroll
                        for (int e = 0; e < 4; ++e) { v0[e] = sigmoid_f(v0[e]); v1[e] = sigmoid_f(v1[e]); }
                    }
                    u32x4 w; w.x = cvt_pk_bf16(v0[0], v0[1]); w.y = cvt_pk_bf16(v0[2], v0[3]); w.z = cvt_pk_bf16(v1[0], v1[1]); w.w = cvt_pk_bf16(v1[2], v1[3]);
                    ST16((u32x4*)(rowp + bj * HALF), w); } }
    }
};
struct EpiMerge2 {
    static constexpr bool PERM = true, AFTER_DRAIN = false, HAS_MID = true;
    const bf16_t* ga; unsigned char* out8; float* rs;
    unsigned* slots; unsigned* cnt; unsigned* bar; LAS float* tbl;
    __device__ __forceinline__ void mid(f32x4 (&acc)[2][2][4][2], const Unit& u, int wr, int wc, int fr, int fq) const {
        int row0 = u.pm * BM + wr * 64 + fr, col0 = u.pn * BM + wc * 32 + 8 * fq;
        asm volatile("" : "+v"(row0), "+v"(col0));
#pragma unroll
        for (int ai = 0; ai < 2; ++ai)
#pragma unroll
            for (int m = 0; m < 4; ++m) { const bf16_t* gp = ga + (size_t)(row0 + ai * HALF + m * 16) * 2048 + col0;
#pragma unroll
                for (int bj = 0; bj < 2; ++bj) { const u32x4 a = *(const u32x4*)(gp + bj * HALF), b = *(const u32x4*)(gp + 1024 + bj * HALF);
                    f32x4 r0, r1;
                    r0[0] = bflo(a.x) * __builtin_amdgcn_rcpf(fmaxf(bflo(b.x), 1e-20f)); r0[1] = bfhi(a.x) * __builtin_amdgcn_rcpf(fmaxf(bfhi(b.x), 1e-20f)); r0[2] = bflo(a.y) * __builtin_amdgcn_rcpf(fmaxf(bflo(b.y), 1e-20f)); r0[3] = bfhi(a.y) * __builtin_amdgcn_rcpf(fmaxf(bfhi(b.y), 1e-20f));
                    r1[0] = bflo(a.z) * __builtin_amdgcn_rcpf(fmaxf(bflo(b.z), 1e-20f)); r1[1] = bfhi(a.z) * __builtin_amdgcn_rcpf(fmaxf(bfhi(b.z), 1e-20f)); r1[2] = bflo(a.w) * __builtin_amdgcn_rcpf(fmaxf(bflo(b.w), 1e-20f)); r1[3] = bfhi(a.w) * __builtin_amdgcn_rcpf(fmaxf(bfhi(b.w), 1e-20f));
                    acc[ai][bj][m][0] = acc[ai][bj][m][0] * r0; acc[ai][bj][m][1] = acc[ai][bj][m][1] * r1;
                    asm volatile("" ::: "memory"); } }
    }
    __device__ __forceinline__ void operator()(f32x4 (&acc)[2][2][4][2], const Unit& u, int wr, int wc, int fr, int fq) const {
        int tid = threadIdx.x;
        int rl0 = wr * 64 + fr, col0 = u.pn * BM + wc * 32 + 8 * fq;
        asm volatile("" : "+v"(rl0), "+v"(col0), "+v"(tid));
#pragma unroll
        for (int ai = 0; ai < 2; ++ai)
#pragma unroll
            for (int m = 0; m < 4; ++m) { const int rl = rl0 + ai * HALF + m * 16; const size_t rr = (size_t)(u.pm * BM + rl); float mx = 0.f;
#pragma unroll
                for (int bj = 0; bj < 2; ++bj) { const u32x4 b = *(const u32x4*)(ga + rr * 2048 + 1024 + col0 + bj * HALF); f32x4 v0 = acc[ai][bj][m][0], v1 = acc[ai][bj][m][1];
                    v0[0] *= fmaxf(bflo(b.x), 1e-20f); v0[1] *= fmaxf(bfhi(b.x), 1e-20f); v0[2] *= fmaxf(bflo(b.y), 1e-20f); v0[3] *= fmaxf(bfhi(b.y), 1e-20f);
                    v1[0] *= fmaxf(bflo(b.z), 1e-20f); v1[1] *= fmaxf(bfhi(b.z), 1e-20f); v1[2] *= fmaxf(bflo(b.w), 1e-20f); v1[3] *= fmaxf(bfhi(b.w), 1e-20f);
                    acc[ai][bj][m][0] = v0; acc[ai][bj][m][1] = v1;
                    mx = fmaxf(mx, fmaxf(fmaxf(fmaxf(fabsf(v0[0]), fabsf(v0[1])), fmaxf(fabsf(v0[2]), fabsf(v0[3]))), fmaxf(fmaxf(fabsf(v1[0]), fabsf(v1[1])), fmaxf(fabsf(v1[2]), fabsf(v1[3]))))); }
                mx = fmaxf(mx, __builtin_bit_cast(float, __builtin_amdgcn_ds_swizzle(__builtin_bit_cast(int, mx), 0x401F))); mx = fmaxf(mx, xor32_f(mx));
                if (fq == 0) tbl[rl * 4 + wc] = mx; }
        __syncthreads();
        float mx = 0.f;
        if (tid < 256) { const f32x4 t0 = *(const LAS f32x4*)(tbl + tid * 4); mx = fmaxf(fmaxf(t0[0], t0[1]), fmaxf(t0[2], t0[3]));
            __hip_atomic_store(slots + ((size_t)(u.pm * 4 + u.pn) * 256 + tid), __builtin_bit_cast(unsigned, mx), __ATOMIC_RELAXED, __HIP_MEMORY_SCOPE_AGENT); }
        asm volatile("s_waitcnt vmcnt(0)" ::: "memory");
        __syncthreads();
        if (tid == 0) { unsigned* c = cnt + 16 * u.pm; (void)xb_add(c, 1u); XB_SPIN(xb_ld(c) < 4u, bar); }
        __syncthreads();
        if (tid < 256) {
#pragma unroll
            for (int p = 0; p < 4; ++p) if (p != u.pn) mx = fmaxf(mx, __builtin_bit_cast(float, __hip_atomic_load(slots + ((size_t)(u.pm * 4 + p) * 256 + tid), __ATOMIC_RELAXED, __HIP_MEMORY_SCOPE_AGENT)));
            const bool tiny = mx < 1e-30f;
            tbl[1024 + tid] = tiny ? 0.f : 127.0f / mx;
            if (u.pn == 0) rs[u.pm * BM + tid] = tiny ? 0.f : mx * (1.0f / 127.0f); }
        __syncthreads();
#pragma unroll
        for (int ai = 0; ai < 2; ++ai)
#pragma unroll
            for (int m = 0; m < 4; ++m) { const int rl = rl0 + ai * HALF + m * 16; const size_t rg = (size_t)(u.pm * BM + rl) * 1024; const float sc = tbl[1024 + rl];
#pragma unroll
                for (int bj = 0; bj < 2; ++bj) { const f32x4 h0 = acc[ai][bj][m][0] * sc, h1 = acc[ai][bj][m][1] * sc; unsigned q0 = 0u, q1 = 0u;
#pragma unroll
                    for (int e = 0; e < 4; ++e) { q0 |= (unsigned)((int)__builtin_rintf(h0[e]) & 255) << (8 * e); q1 |= (unsigned)((int)__builtin_rintf(h1[e]) & 255) << (8 * e); }
                    *(unsigned long long*)(out8 + rg + col0 + bj * HALF) = (unsigned long long)q0 | ((unsigned long long)q1 << 32); } }
    }
};
struct EpiResB {
    static constexpr bool PERM = true, AFTER_DRAIN = false, HAS_MID = false;
    const float* base; bf16_t* Cb;
    __device__ __forceinline__ void operator()(const f32x4 (&acc)[2][2][4][2], const Unit& u, int wr, int wc, int fr, int fq) const {
        const int row0 = u.pm * BM + wr * 64 + fr, col0 = u.pn * BM + wc * 32 + 8 * fq;
#pragma unroll
        for (int ai = 0; ai < 2; ++ai)
#pragma unroll
            for (int m = 0; m < 4; ++m) { const size_t ro = (size_t)(row0 + ai * HALF + m * 16) * 1024 + col0;
#pragma unroll
                for (int bj = 0; bj < 2; ++bj) { const f32x4 v0 = *(const f32x4*)(base + ro + bj * HALF) + acc[ai][bj][m][0], v1 = *(const f32x4*)(base + ro + bj * HALF + 4) + acc[ai][bj][m][1];
                    u32x4 w; w.x = cvt_pk_bf16(v0[0], v0[1]); w.y = cvt_pk_bf16(v0[2], v0[3]); w.z = cvt_pk_bf16(v1[0], v1[1]); w.w = cvt_pk_bf16(v1[2], v1[3]);
                    ST16((u32x4*)(Cb + ro + bj * HALF), w); } }
    }
};
struct EpiResLn {
    static constexpr bool PERM = true, AFTER_DRAIN = false, HAS_MID = false;
    const float* base; const float* w; bf16_t* Cb; unsigned char* hnq; float* hsc;
    unsigned long long* slots;
    unsigned* cnt;
    unsigned* bar;
    LAS float* tbl;
    __device__ __forceinline__ void operator()(f32x4 (&acc)[2][2][4][2], const Unit& u, int wr, int wc, int fr, int fq) const {
        int tid = threadIdx.x;
        int rl0 = wr * 64 + fr, col0 = u.pn * BM + wc * 32 + 8 * fq;
        asm volatile("" : "+v"(rl0), "+v"(col0), "+v"(tid));
        f32x4 wv[2][2];
#pragma unroll
        for (int bj = 0; bj < 2; ++bj) { wv[bj][0] = *(const f32x4*)(w + col0 + bj * HALF); wv[bj][1] = *(const f32x4*)(w + col0 + bj * HALF + 4); }
#pragma unroll
        for (int ai = 0; ai < 2; ++ai)
#pragma unroll
            for (int m = 0; m < 4; ++m) { const int rl = rl0 + ai * HALF + m * 16; const size_t ro = (size_t)(u.pm * BM + rl) * 1024 + col0;
                float ss = 0.f, mx = 0.f;
#pragma unroll
                for (int bj = 0; bj < 2; ++bj) { const f32x4 v0 = *(const f32x4*)(base + ro + bj * HALF) + acc[ai][bj][m][0], v1 = *(const f32x4*)(base + ro + bj * HALF + 4) + acc[ai][bj][m][1];
                    acc[ai][bj][m][0] = v0; acc[ai][bj][m][1] = v1;
                    ss += ((v0[0] * v0[0] + v0[1] * v0[1]) + (v0[2] * v0[2] + v0[3] * v0[3])) + ((v1[0] * v1[0] + v1[1] * v1[1]) + (v1[2] * v1[2] + v1[3] * v1[3]));
                    const f32x4 a0 = v0 * wv[bj][0], a1 = v1 * wv[bj][1];
                    mx = fmaxf(mx, fmaxf(fmaxf(fmaxf(fabsf(a0[0]), fabsf(a0[1])), fmaxf(fabsf(a0[2]), fabsf(a0[3]))), fmaxf(fmaxf(fabsf(a1[0]), fabsf(a1[1])), fmaxf(fabsf(a1[2]), fabsf(a1[3]))))); }
                ss += __builtin_bit_cast(float, __builtin_amdgcn_ds_swizzle(__builtin_bit_cast(int, ss), 0x401F)); mx = fmaxf(mx, __builtin_bit_cast(float, __builtin_amdgcn_ds_swizzle(__builtin_bit_cast(int, mx), 0x401F)));
                ss += xor32_f(ss); mx = fmaxf(mx, xor32_f(mx));
                if (fq == 0) { tbl[(rl * 4 + wc) * 2] = ss; tbl[(rl * 4 + wc) * 2 + 1] = mx; } }
        __syncthreads();
        float ss = 0.f, mx = 0.f;
        if (tid < 256) { const f32x4 t0 = *(const LAS f32x4*)(tbl + tid * 8), t1 = *(const LAS f32x4*)(tbl + tid * 8 + 4);
            ss = (t0[0] + t0[2]) + (t1[0] + t1[2]); mx = fmaxf(fmaxf(t0[1], t0[3]), fmaxf(t1[1], t1[3]));
            const unsigned long long pk = (unsigned long long)__builtin_bit_cast(unsigned, ss) | ((unsigned long long)__builtin_bit_cast(unsigned, mx) << 32);
            __hip_atomic_store(slots + ((size_t)(u.pm * 4 + u.pn) * 256 + tid), pk, __ATOMIC_RELAXED, __HIP_MEMORY_SCOPE_AGENT); }
        asm volatile("s_waitcnt vmcnt(0)" ::: "memory");
        __syncthreads();
        if (tid == 0) { unsigned* c = cnt + 16 * u.pm; (void)xb_add(c, 1u); XB_SPIN(xb_ld(c) < 4u, bar); }
        __syncthreads();
        if (tid < 256) {
#pragma unroll
            for (int p = 0; p < 4; ++p) if (p != u.pn) { const unsigned long long pk = __hip_atomic_load(slots + ((size_t)(u.pm * 4 + p) * 256 + tid), __ATOMIC_RELAXED, __HIP_MEMORY_SCOPE_AGENT);
                ss += __builtin_bit_cast(float, (unsigned)pk); mx = fmaxf(mx, __builtin_bit_cast(float, (unsigned)(pk >> 32))); }
            const float rstd = 1.0f / sqrtf(ss * (1.0f / 1024.0f) + 1e-6f); const bool tiny = mx < 1e-30f;
            tbl[2048 + tid] = tiny ? 0.f : 119.0f / mx;
            if (u.pn == 0) hsc[u.pm * BM + tid] = tiny ? 0.f : mx * rstd * (1.0f / 119.0f); }
        __syncthreads();
#pragma unroll
        for (int ai = 0; ai < 2; ++ai)
#pragma unroll
            for (int m = 0; m < 4; ++m) { const int rl = rl0 + ai * HALF + m * 16; const size_t rg = (size_t)(u.pm * BM + rl) * 1024; const float sc = tbl[2048 + rl];
#pragma unroll
                for (int bj = 0; bj < 2; ++bj) { const f32x4 v0 = acc[ai][bj][m][0], v1 = acc[ai][bj][m][1]; const int c = col0 + bj * HALF;
                    u32x4 xw; xw.x = cvt_pk_bf16(v0[0], v0[1]); xw.y = cvt_pk_bf16(v0[2], v0[3]); xw.z = cvt_pk_bf16(v1[0], v1[1]); xw.w = cvt_pk_bf16(v1[2], v1[3]);
                    ST16((u32x4*)(Cb + rg + c), xw);
                    const f32x4 h0 = v0 * wv[bj][0] * sc, h1 = v1 * wv[bj][1] * sc;
                    unsigned q0 = 0u, q1 = 0u;
#pragma unroll
                    for (int e = 0; e < 4; ++e) { q0 |= (unsigned)((int)__builtin_rintf(h0[e]) & 255) << (8 * e); q1 |= (unsigned)((int)__builtin_rintf(h1[e]) & 255) << (8 * e); }
                    *(unsigned long long*)(hnq + rg + c) = (unsigned long long)q0 | ((unsigned long long)q1 << 32); } }
    }
};
struct EpiPlain {
    static constexpr bool PERM = true, AFTER_DRAIN = false, HAS_MID = false;
    bf16_t* O; int ldc;
    __device__ __forceinline__ void operator()(const f32x4 (&acc)[2][2][4][2], const Unit& u, int wr, int wc, int fr, int fq) const {
        const int row0 = u.pm * BM + wr * 64 + fr, col0 = u.pn * BM + wc * 32 + 8 * fq;
#pragma unroll
        for (int ai = 0; ai < 2; ++ai)
#pragma unroll
            for (int m = 0; m < 4; ++m) { bf16_t* rowp = O + (size_t)(row0 + ai * HALF + m * 16) * ldc + col0;
#pragma unroll
                for (int bj = 0; bj < 2; ++bj) { const f32x4 v0 = acc[ai][bj][m][0], v1 = acc[ai][bj][m][1];
                    u32x4 w; w.x = cvt_pk_bf16(v0[0], v0[1]); w.y = cvt_pk_bf16(v0[2], v0[3]); w.z = cvt_pk_bf16(v1[0], v1[1]); w.w = cvt_pk_bf16(v1[2], v1[3]);
                    ST16((u32x4*)(rowp + bj * HALF), w); } }
    }
};
}

__device__ __forceinline__ void p0_transpose_item(const float* W, int K, int N, bf16* WT, LAS float* scr, int item, int lane, int ldk = 0, int koff = 0, const float* kscale = nullptr) {
    if (ldk == 0) ldk = K;
    const int nblk = N / 32, kb = item / nblk, nb = item % nblk, k0 = 64 * kb, n0 = 32 * nb;
#pragma unroll 8
    for (int i = 0; i < 32; ++i) { const int kk = 2 * i + (lane >> 5); scr[kk * 33 + (lane & 31)] = W[(size_t)(k0 + kk) * N + n0 + (lane & 31)] * (kscale ? kscale[k0 + kk] : 1.0f); }
    LDS_WAIT(); asm volatile("" ::: "memory");
    const int c = lane & 7;
#pragma unroll
    for (int j = 0; j < 4; ++j) { const int n = (lane >> 3) + 8 * j; const LAS float* s = scr + (8 * c) * 33 + n;
        v4u o; o.x = pk2(s[0 * 33], s[1 * 33]); o.y = pk2(s[2 * 33], s[3 * 33]); o.z = pk2(s[4 * 33], s[5 * 33]); o.w = pk2(s[6 * 33], s[7 * 33]);
        *(v4u*)(WT + (size_t)(n0 + n) * ldk + koff + k0 + 8 * c) = o; }
    LDS_WAIT(); asm volatile("" ::: "memory");
}
__device__ __forceinline__ void cvt_flat(const float* src, bf16* dst, size_t n, int gw, int NGW, int lane) {
    for (size_t i = (size_t)gw * 512 + lane * 8; i < n; i += (size_t)NGW * 512) {
        const f32x4 a = *(const f32x4*)(src + i), b = *(const f32x4*)(src + i + 4);
        v4u o; o.x = pk2(a[0], a[1]); o.y = pk2(a[2], a[3]); o.z = pk2(b[0], b[1]); o.w = pk2(b[2], b[3]);
        *(v4u*)(dst + i) = o;
    }
}


struct Ptrs {
    const float *x, *mix_w, *w_in, *rel_bias, *sinks, *w_pa, *ln_w, *ln_b, *w_s, *b_s, *w_pb, *w_out, *ffn_w, *w_q, *keys1, *keys2, *pu, *pv, *fin_w;
    float* out;
    unsigned char *U8, *V8, *XN8, *HNQ, *WIN8, *WQ8, *WOUT8, *MERGED8; float *USC, *VSC, *HSC, *XSC, *WINSC, *WQSC, *WOUTSC, *MSC;
    bf16 *WPAB, *K1, *K2, *WS, *AOUT, *BOUT, *X1B, *Q, *KV, *GU, *GV, *GA, *GB, *QP;
};

__device__ __forceinline__ void p0_quant_row(const Ptrs& P, const f32x4 (&v)[4], int rr, int lane) {
            const int tab = rr >> 14, row = rr & 16383;
            float mx = 0.f, ssq = 0.f;
#pragma unroll
            for (int j = 0; j < 4; ++j) { mx = fmaxf(mx, fmaxf(fmaxf(fabsf(v[j][0]), fabsf(v[j][1])), fmaxf(fabsf(v[j][2]), fabsf(v[j][3]))));
                ssq += (v[j][0] * v[j][0] + v[j][1] * v[j][1]) + (v[j][2] * v[j][2] + v[j][3] * v[j][3]); }
            mx = wave_max(mx); ssq = wave_sum(ssq);
            const float sd = sqrtf(ssq * (1.0f / 1024.0f));
            if (tab == 0) {
                const float step = fmaxf(Q4_USTEP * sd, mx * (1.0f / 14.0f)); const float qs = step > 1e-30f ? 1.0f / step : 0.f;
#pragma unroll
                for (int j = 0; j < 4; ++j) { unsigned pq = 0u;
#pragma unroll
                    for (int e = 0; e < 4; ++e) pq |= (unsigned)((int)fminf(fmaxf(__builtin_rintf(v[j][e] * qs), -7.0f), 7.0f) & 15) << (4 * e);
                    const unsigned nq = (unsigned)__builtin_amdgcn_update_dpp(0, (int)pq, 0xB1, 0xF, 0xF, false);
                    if ((lane & 1) == 0) *(unsigned*)(P.U8 + (size_t)row * 512 + 128 * j + 2 * lane) = pq | (nq << 16); }
                if (lane == 0) P.USC[row] = step;
            } else {
                const float un = fmaxf(Q4_VUNIT * sd, mx * (1.0f / 12.0f)); const float qs = un > 1e-30f ? 1.0f / un : 0.f;
                bool bad = false;
#pragma unroll
                for (int j = 0; j < 4; ++j) {
                    unsigned pq = __builtin_amdgcn_cvt_scalef32_pk_fp4_f32(0u, v[j][0] * qs, v[j][1] * qs, 1.0f, 0);
                    pq = __builtin_amdgcn_cvt_scalef32_pk_fp4_f32(pq, v[j][2] * qs, v[j][3] * qs, 1.0f, 1);
                    pq &= 0xffffu;
                    const unsigned nq = (unsigned)__builtin_amdgcn_update_dpp(0, (int)pq, 0xB1, 0xF, 0xF, false);
                    if ((lane & 1) == 0) *(unsigned*)(P.V8 + (size_t)row * 512 + 128 * j + 2 * lane) = pq | (nq << 16); }
                if (FP4_SELFCHECK && __ballot(bad) != 0ull) { if (lane == 0) P.VSC[row] = __builtin_nanf(""); }
                else if (lane == 0) P.VSC[row] = un;
            }
}
__device__ __forceinline__ unsigned pack_i8x4(float a, float b, float c, float d) {
    const int qa = (int)__builtin_rintf(a), qb = (int)__builtin_rintf(b), qc = (int)__builtin_rintf(c), qd = (int)__builtin_rintf(d);
    return (unsigned)(qa & 255) | ((unsigned)(qb & 255) << 8) | ((unsigned)(qc & 255) << 16) | ((unsigned)qd << 24);
}
__device__ __forceinline__ void p0_quant_wt_item(const float* W, int N, unsigned char* WT8, float* cs, int item, int lane, int wave, LAS float* cml) {
    const int n0 = 32 * item, c4 = lane & 7, kr = lane >> 3;
    const float* wp = W + (size_t)(128 * wave + 16 * kr) * N + n0 + 4 * c4;
    f32x4 v[16]; f32x4 mx = {0.f, 0.f, 0.f, 0.f};
#pragma unroll
    for (int t = 0; t < 16; ++t) v[t] = *(const f32x4*)(wp + (size_t)t * N);
#pragma unroll
    for (int t = 0; t < 16; ++t) { mx[0] = fmaxf(mx[0], fabsf(v[t][0])); mx[1] = fmaxf(mx[1], fabsf(v[t][1])); mx[2] = fmaxf(mx[2], fabsf(v[t][2])); mx[3] = fmaxf(mx[3], fabsf(v[t][3])); }
#pragma unroll
    for (int e = 0; e < 4; ++e) { float m_ = mx[e]; m_ = fmaxf(m_, __shfl_xor(m_, 8)); m_ = fmaxf(m_, __shfl_xor(m_, 16)); m_ = fmaxf(m_, __shfl_xor(m_, 32)); mx[e] = m_; }
    if (kr == 0) *(LAS f32x4*)(cml + wave * 32 + 4 * c4) = mx;
    __syncthreads();
#pragma unroll
    for (int w = 0; w < 8; ++w) { const f32x4 o = *(const LAS f32x4*)(cml + w * 32 + 4 * c4); mx[0] = fmaxf(mx[0], o[0]); mx[1] = fmaxf(mx[1], o[1]); mx[2] = fmaxf(mx[2], o[2]); mx[3] = fmaxf(mx[3], o[3]); }
    f32x4 inv;
#pragma unroll
    for (int e = 0; e < 4; ++e) inv[e] = mx[e] > 1e-30f ? 127.0f / mx[e] : 0.f;
    if (wave == 0 && kr == 0) *(f32x4*)(cs + n0 + 4 * c4) = mx * (1.0f / 127.0f);
#pragma unroll
    for (int e = 0; e < 4; ++e) { v4u o;
        o.x = pack_i8x4(v[0][e] * inv[e], v[1][e] * inv[e], v[2][e] * inv[e], v[3][e] * inv[e]); o.y = pack_i8x4(v[4][e] * inv[e], v[5][e] * inv[e], v[6][e] * inv[e], v[7][e] * inv[e]);
        o.z = pack_i8x4(v[8][e] * inv[e], v[9][e] * inv[e], v[10][e] * inv[e], v[11][e] * inv[e]); o.w = pack_i8x4(v[12][e] * inv[e], v[13][e] * inv[e], v[14][e] * inv[e], v[15][e] * inv[e]);
        *(v4u*)(WT8 + (size_t)(n0 + 4 * c4 + e) * 1024 + 128 * wave + 16 * kr) = o; }
    __syncthreads();
}
#define TAB_LOAD(V, RR) do { if ((RR) < 2 * 16384) { const float* src_ = (((RR) >> 14) ? P.pv : P.pu) + (size_t)((RR) & 16383) * 1024; \
        _Pragma("unroll") for (int j = 0; j < 4; ++j) V[j] = *(const f32x4*)(src_ + 4 * lane + 256 * j); } } while (0)
__device__ __forceinline__ void p0_prologue(LAS unsigned char* lds, const Ptrs& P, int vcu, int G, int lane, int wave) {
    LAS float* scr = (LAS float*)(lds + wave * 16384);
    const int gw = vcu * NWAVES + wave, NGW = G * NWAVES;
    for (int it = vcu; it < 216; it += G) {
        if (it < 120) p0_quant_wt_item(P.w_in, 3840, P.WIN8, P.WINSC, it, lane, wave, (LAS float*)(lds + 131072));
        else if (it < 184) p0_quant_wt_item(P.w_q, 2048, P.WQ8, P.WQSC, it - 120, lane, wave, (LAS float*)(lds + 131072));
        else p0_quant_wt_item(P.w_out, 1024, P.WOUT8, P.WOUTSC, it - 184, lane, wave, (LAS float*)(lds + 131072)); }
    constexpr int I_PA = (512 / 64) * (1024 / 32);
    constexpr int NITEMS = 2 * I_PA;
    for (int it = gw; it < NITEMS; it += NGW) {
        int r = it;
        if (r < I_PA) { p0_transpose_item(P.w_pa, 512, 1024, P.WPAB, scr, r, lane, 1024, 0); continue; } r -= I_PA;
        p0_transpose_item(P.w_pb, 512, 1024, P.WPAB, scr, r, lane, 1024, 512);
    }
    cvt_flat(P.keys1, P.K1, 128 * 128, gw, NGW, lane);
    cvt_flat(P.keys2, P.K2, 128 * 128, gw, NGW, lane);
    {
        f32x4 va[4], vb[4], vc[4];
        int rr = gw;
        TAB_LOAD(va, rr); TAB_LOAD(vb, rr + NGW);
#pragma unroll 1
        for (; rr < 2 * 16384; rr += 3 * NGW) {
            TAB_LOAD(vc, rr + 2 * NGW); p0_quant_row(P, va, rr, lane);
            TAB_LOAD(va, rr + 3 * NGW); if (rr + NGW < 2 * 16384) p0_quant_row(P, vb, rr + NGW, lane);
            TAB_LOAD(vb, rr + 4 * NGW); if (rr + 2 * NGW < 2 * 16384) p0_quant_row(P, vc, rr + 2 * NGW, lane);
        }
    }
    for (size_t i = (size_t)gw * 512 + lane * 8; i < (size_t)8 * 128 * 128; i += (size_t)NGW * 512) {
        const int t = (int)((i >> 7) & 127), s0 = (int)(i & 127);
        const f32x4 a = *(const f32x4*)(P.w_s + i), b = *(const f32x4*)(P.w_s + i + 4);
        float e[8] = {a[0], a[1], a[2], a[3], b[0], b[1], b[2], b[3]};
#pragma unroll
        for (int j = 0; j < 8; ++j) e[j] = (s0 + j <= t) ? e[j] : 0.f;
        v4u o; o.x = pk2(e[0], e[1]); o.y = pk2(e[2], e[3]); o.z = pk2(e[4], e[5]); o.w = pk2(e[6], e[7]);
        *(v4u*)(P.WS + i) = o;
    }
    {
        f32x4 va[4], vb[4], vc[4], ww[4];
#pragma unroll
        for (int j = 0; j < 4; ++j) ww[j] = *((const f32x4*)P.mix_w + lane + 64 * j);
#define XN_LOAD(V, MM) do { if ((MM) < M) { _Pragma("unroll") for (int j = 0; j < 4; ++j) V[j] = *((const f32x4*)(P.x + (size_t)(MM) * D) + lane + 64 * j); } } while (0)
#define XN_PROC(V, MM) do { if ((MM) < M) { float s_ = 0.f; \
        _Pragma("unroll") for (int j = 0; j < 4; ++j) s_ += (V[j][0] * V[j][0] + V[j][1] * V[j][1]) + (V[j][2] * V[j][2] + V[j][3] * V[j][3]); \
        const float rstd_ = 1.0f / sqrtf(wave_sum(s_) * (1.0f / 1024.0f) + EPS); float mx_ = 0.f; \
        _Pragma("unroll") for (int j = 0; j < 4; ++j) { V[j] = V[j] * rstd_ * ww[j]; mx_ = fmaxf(mx_, fmaxf(fmaxf(fabsf(V[j][0]), fabsf(V[j][1])), fmaxf(fabsf(V[j][2]), fabsf(V[j][3])))); } \
        mx_ = wave_max(mx_); const float qs_ = mx_ > 1e-30f ? 127.0f / mx_ : 0.f; \
        _Pragma("unroll") for (int j = 0; j < 4; ++j) *(unsigned*)(P.XN8 + (size_t)(MM) * D + 4 * lane + 256 * j) = pack_i8x4(V[j][0] * qs_, V[j][1] * qs_, V[j][2] * qs_, V[j][3] * qs_); \
        if (lane == 0) P.XSC[MM] = mx_ * (1.0f / 127.0f); } } while (0)
        int m = gw;
        XN_LOAD(va, m); XN_LOAD(vb, m + NGW);
#pragma unroll 1
        for (; m < M; m += 3 * NGW) {
            XN_LOAD(vc, m + 2 * NGW); XN_PROC(va, m);
            XN_LOAD(va, m + 3 * NGW); XN_PROC(vb, m + NGW);
            XN_LOAD(vb, m + 4 * NGW); XN_PROC(vc, m + 2 * NGW);
        }
#undef XN_LOAD
#undef XN_PROC
    }
}

typedef short s16x8 __attribute__((ext_vector_type(8)));
typedef short s16x4 __attribute__((ext_vector_type(4)));
typedef float f32x16 __attribute__((ext_vector_type(16)));
typedef float f32x2v __attribute__((ext_vector_type(2)));
#define MFMA32(a, b, c) __builtin_amdgcn_mfma_f32_32x32x16_bf16((a), (b), (c), 0, 0, 0)
__device__ __forceinline__ s16x4 tr16(const LAS unsigned char* p) { return __builtin_bit_cast(s16x4, __builtin_amdgcn_ds_read_tr16_b64_v4i16((LAS s16x4*)p)); }
__device__ __forceinline__ unsigned cvtpk(float lo, float hi) { f32x2v v = {lo, hi}; bf16x2_t b = __builtin_convertvector(v, bf16x2_t); return __builtin_bit_cast(unsigned, b); }
__device__ __forceinline__ int crow(int reg, int h) { return (reg & 3) + 8 * (reg >> 2) + 4 * h; }
constexpr float LOG2E = 1.4426950408889634f;

__device__ __forceinline__ void p2_attn_mfma(LAS unsigned char* lds, const Ptrs& P, int vcu, int G, int tid, int lane, int wave) {
    LAS unsigned char* Kl = lds;
    LAS unsigned char* Vl = lds + 32768;
    LAS float* biasl = (LAS float*)(lds + 32768 + 49152);
    const int r = lane & 31, h = lane >> 5, i16 = lane & 15, q4 = i16 >> 2, p4 = i16 & 3, blk = (lane >> 4) & 1;
    for (int unit = vcu; unit < 256; unit += G) {
        const int kvh = unit & 1, blkid = unit >> 1, nb = blkid & 63; const int tok0 = blkid * 128;
#pragma unroll
        for (int i = 0; i < 4; ++i) {
            const int cidx = tid + 512 * i, row = cidx >> 3, c = cidx & 7;
            v4u kw = {0u, 0u, 0u, 0u}, vw = {0u, 0u, 0u, 0u};
            if (nb > 0 || row >= 128) { const bf16* src = P.KV + (size_t)(tok0 - 128 + row) * 256 + kvh * 64 + c * 8; kw = *(const v4u*)src; vw = *(const v4u*)(src + 128); }
            *(LAS v4u*)(Kl + row * 128 + ((c ^ ((row >> 1) & 7)) << 4)) = kw;
            *(LAS v4u*)(Vl + row * 192 + c * 16) = vw;
        }
        biasl[tid] = P.rel_bias[(int)T5B[tid & 127] * 8 + kvh * 4 + (tid >> 7)] * LOG2E;
        __syncthreads();
        const int g = wave >> 1, qh = wave & 1, hq = kvh * 4 + g;
        const float sink2 = P.sinks[hq] * LOG2E;
#pragma unroll 1
        for (int qs = 0; qs < 2; ++qs) {
            const int qi0 = 64 * qh + 32 * qs, kt0 = 2 * qh + qs;
            s16x8 qf[4];
            { const bf16* qrow = P.Q + (size_t)(tok0 + qi0 + r) * 512 + hq * 64 + 8 * h;
#pragma unroll
              for (int ks = 0; ks < 4; ++ks) qf[ks] = *(const s16x8*)(qrow + 16 * ks); }
            f32x16 s[5];
#pragma unroll
            for (int i = 0; i < 5; ++i) {
#pragma unroll
                for (int e = 0; e < 16; ++e) s[i][e] = 0.f;
                const int key = 32 * (kt0 + i) + r; const LAS unsigned char* kp = Kl + key * 128; const int sw = (key >> 1) & 7;
#pragma unroll
                for (int ks = 0; ks < 4; ++ks) { const s16x8 kf = *(const LAS s16x8*)(kp + (((2 * ks + h) ^ sw) << 4)); s[i] = MFMA32(kf, qf[ks], s[i]); }
            }
            const int qi = qi0 + r;
            float mx = sink2;
#pragma unroll
            for (int i = 0; i < 5; ++i)
#pragma unroll
                for (int e = 0; e < 16; ++e) {
                    const int kj = 32 * (kt0 + i) + crow(e, h), dist = 128 + qi - kj;
                    const bool valid = (dist >= 0) && (dist < 128) && (nb > 0 || kj >= 128);
                    const float b = biasl[g * 128 + (dist & 127)];
                    const float v = valid ? s[i][e] * (0.125f * LOG2E) + b : -1e30f;
                    s[i][e] = v; mx = fmaxf(mx, v);
                }
            mx = fmaxf(mx, xor32_f(mx));
            float l = 0.f;
#pragma unroll
            for (int i = 0; i < 5; ++i)
#pragma unroll
                for (int e = 0; e < 16; ++e) { const float p = __builtin_amdgcn_exp2f(s[i][e] - mx); s[i][e] = p; l += p; }
            l += xor32_f(l);
            l += __builtin_amdgcn_exp2f(sink2 - mx);
            f32x16 o0, o1;
#pragma unroll
            for (int e = 0; e < 16; ++e) { o0[e] = 0.f; o1[e] = 0.f; }
#pragma unroll
            for (int i = 0; i < 5; ++i)
#pragma unroll
                for (int st = 0; st < 2; ++st) {
                    v4u pw; pw.x = cvtpk(s[i][8 * st], s[i][8 * st + 1]); pw.y = cvtpk(s[i][8 * st + 2], s[i][8 * st + 3]); pw.z = cvtpk(s[i][8 * st + 4], s[i][8 * st + 5]); pw.w = cvtpk(s[i][8 * st + 6], s[i][8 * st + 7]);
                    const s16x8 pf = __builtin_bit_cast(s16x8, pw);
                    const LAS unsigned char* vb = Vl + (32 * (kt0 + i) + 16 * st + 4 * h + q4) * 192 + 32 * blk + 8 * p4;
                    { const s16x4 lo = tr16(vb), hi = tr16(vb + 8 * 192); const s16x8 vf = __builtin_shufflevector(lo, hi, 0, 1, 2, 3, 4, 5, 6, 7); o0 = MFMA32(vf, pf, o0); }
                    { const s16x4 lo = tr16(vb + 64), hi = tr16(vb + 64 + 8 * 192); const s16x8 vf = __builtin_shufflevector(lo, hi, 0, 1, 2, 3, 4, 5, 6, 7); o1 = MFMA32(vf, pf, o1); }
                }
            const float inv = 1.0f / l;
            bf16* orow = P.AOUT + (size_t)(tok0 + qi) * AB_LD + hq * 64 + 4 * h;
#pragma unroll
            for (int r4 = 0; r4 < 4; ++r4) {
                v2u w0; w0.x = cvtpk(o0[4 * r4] * inv, o0[4 * r4 + 1] * inv); w0.y = cvtpk(o0[4 * r4 + 2] * inv, o0[4 * r4 + 3] * inv); *(v2u*)(orow + 8 * r4) = w0;
                v2u w1; w1.x = cvtpk(o1[4 * r4] * inv, o1[4 * r4 + 1] * inv); w1.y = cvtpk(o1[4 * r4 + 2] * inv, o1[4 * r4 + 3] * inv); *(v2u*)(orow + 32 + 8 * r4) = w1;
            }
        }
        __syncthreads();
    }
}

__device__ __forceinline__ void p2_gmlp_mfma(LAS unsigned char* lds, const Ptrs& P, int vcu, int G, int tid, int lane, int wave) {
    LAS unsigned char* vnl = lds;
    const int r = lane & 31, h = lane >> 5, i16 = lane & 15, q4 = i16 >> 2, p4 = i16 & 3, blk = (lane >> 4) & 1;
    for (int unit = vcu; unit < 256; unit += G) {
        const int c = unit >> 1, hh = unit & 1;
        v4u gvw[16];
#pragma unroll
        for (int i = 0; i < 16; ++i) gvw[i] = *((const v4u*)(P.GV + ((size_t)c * 128 + wave * 16 + i) * 512) + lane);
        const f32x4 lw0 = *(const f32x4*)(P.ln_w + lane * 8), lw1 = *(const f32x4*)(P.ln_w + lane * 8 + 4), lb0 = *(const f32x4*)(P.ln_b + lane * 8), lb1 = *(const f32x4*)(P.ln_b + lane * 8 + 4);
#pragma unroll
        for (int i = 0; i < 16; ++i) {
            const int tt = wave * 16 + i;
            const v4u w = gvw[i];
            float x[8] = {bflo(w.x), bfhi(w.x), bflo(w.y), bfhi(w.y), bflo(w.z), bfhi(w.z), bflo(w.w), bfhi(w.w)};
            float s = 0.f;
#pragma unroll
            for (int j = 0; j < 8; ++j) s += x[j];
            const float mean = wave_sum(s) * (1.0f / 512.0f);
            float ss = 0.f;
#pragma unroll
            for (int j = 0; j < 8; ++j) { x[j] -= mean; ss += x[j] * x[j]; }
            const float rstd = 1.0f / sqrtf(wave_sum(ss) * (1.0f / 512.0f) + EPS);
            if ((lane >> 5) == hh) {
                const f32x4 w0 = lw0, w1 = lw1, b0 = lb0, b1 = lb1;
                v4u o; o.x = pk2(x[0] * rstd * w0[0] + b0[0], x[1] * rstd * w0[1] + b0[1]); o.y = pk2(x[2] * rstd * w0[2] + b0[2], x[3] * rstd * w0[3] + b0[3]);
                o.z = pk2(x[4] * rstd * w1[0] + b1[0], x[5] * rstd * w1[1] + b1[1]); o.w = pk2(x[6] * rstd * w1[2] + b1[2], x[7] * rstd * w1[3] + b1[3]);
                *(LAS v4u*)(vnl + tt * 576 + (lane & 31) * 16) = o;
            }
        }
        __syncthreads();
        const int gi = wave >> 1, dblk = wave & 1, g = hh * 4 + gi;
        s16x8 af[8];
#pragma unroll
        for (int ks = 0; ks < 8; ++ks) { const LAS unsigned char* vb = vnl + (16 * ks + 8 * h + q4) * 576 + (gi * 64 + dblk * 32 + 16 * blk) * 2 + 8 * p4;
            const s16x4 lo = tr16(vb), hi = tr16(vb + 4 * 576); af[ks] = __builtin_shufflevector(lo, hi, 0, 1, 2, 3, 4, 5, 6, 7); }
#pragma unroll
        for (int tt = 0; tt < 4; ++tt) {
            f32x16 acc;
#pragma unroll
            for (int e = 0; e < 16; ++e) acc[e] = 0.f;
            const bf16* wrow = P.WS + ((size_t)g * 128 + 32 * tt + r) * 128 + 8 * h;
#pragma unroll
            for (int ks = 0; ks < 2 * (tt + 1); ++ks) acc = MFMA32(af[ks], *(const s16x8*)(wrow + 16 * ks), acc);
            const int t = 32 * tt + r; const size_t row = (size_t)c * 128 + t; const float b = P.b_s[g * 128 + t];
#pragma unroll
            for (int r4 = 0; r4 < 4; ++r4) {
                const int ch = g * 64 + dblk * 32 + 8 * r4 + 4 * h;
                const v2u uw = *(const v2u*)(P.GU + row * 512 + ch);
                v2u ow; ow.x = cvtpk(bflo(uw.x) * (acc[4 * r4] + b), bfhi(uw.x) * (acc[4 * r4 + 1] + b)); ow.y = cvtpk(bflo(uw.y) * (acc[4 * r4 + 2] + b), bfhi(uw.y) * (acc[4 * r4 + 3] + b));
                *(v2u*)(P.BOUT + row * AB_LD + ch) = ow;
            }
        }
        __syncthreads();
    }
}

__device__ __forceinline__ void topk_half(const bf16* q, const LAS bf16* kl, float (&v)[16]) {
    v4u qv[16];
#pragma unroll
    for (int c = 0; c < 16; ++c) qv[c] = ((const v4u*)q)[c];
#pragma unroll
    for (int i = 0; i < 16; ++i) v[i] = -INFINITY;
    for (int n = 0; n < 128; ++n) {
        const LAS v4u* kr = (const LAS v4u*)(kl + n * 128);
        float a0 = 0.f, a1 = 0.f, a2 = 0.f, a3 = 0.f;
#pragma unroll
        for (int c = 0; c < 16; ++c) { const v4u kk = kr[c]; a0 = dot2bf(qv[c].x, kk.x, a0); a1 = dot2bf(qv[c].y, kk.y, a1); a2 = dot2bf(qv[c].z, kk.z, a2); a3 = dot2bf(qv[c].w, kk.w, a3); }
        const float acc = (a0 + a1) + (a2 + a3);
        float x = __builtin_bit_cast(float, (__builtin_bit_cast(unsigned, acc) & ~0x7Fu) | (unsigned)n);
#pragma unroll
        for (int i = 0; i < 16; ++i) { const float hi = fmaxf(v[i], x); x = fminf(v[i], x); v[i] = hi; }
    }
}

__host__ __device__ constexpr int cand_slot(int i, int j) { int c = 0; for (int a = 0; a < 16; ++a) for (int b = 0; b < 16; ++b) { if (a == i && b == j) return c; if ((a + 1) * (b + 1) <= 16) ++c; } return c; }
#define CE_DESC(a, b) do { const float hi_ = fmaxf((a), (b)); const float lo_ = fminf((a), (b)); (a) = hi_; (b) = lo_; } while (0)
__device__ __forceinline__ void sort16_desc(float (&v)[16]) {
    CE_DESC(v[0], v[1]); CE_DESC(v[3], v[2]); CE_DESC(v[4], v[5]); CE_DESC(v[7], v[6]); CE_DESC(v[8], v[9]); CE_DESC(v[11], v[10]); CE_DESC(v[12], v[13]); CE_DESC(v[15], v[14]); CE_DESC(v[0], v[2]); CE_DESC(v[1], v[3]); CE_DESC(v[6], v[4]); CE_DESC(v[7], v[5]); CE_DESC(v[8], v[10]); CE_DESC(v[9], v[11]); CE_DESC(v[14], v[12]); CE_DESC(v[15], v[13]); CE_DESC(v[0], v[1]); CE_DESC(v[2], v[3]); CE_DESC(v[5], v[4]); CE_DESC(v[7], v[6]); CE_DESC(v[8], v[9]); CE_DESC(v[10], v[11]); CE_DESC(v[13], v[12]); CE_DESC(v[15], v[14]); CE_DESC(v[0], v[4]); CE_DESC(v[1], v[5]); CE_DESC(v[2], v[6]); CE_DESC(v[3], v[7]); CE_DESC(v[12], v[8]); CE_DESC(v[13], v[9]); CE_DESC(v[14], v[10]); CE_DESC(v[15], v[11]); CE_DESC(v[0], v[2]); CE_DESC(v[1], v[3]); CE_DESC(v[4], v[6]); CE_DESC(v[5], v[7]); CE_DESC(v[10], v[8]); CE_DESC(v[11], v[9]); CE_DESC(v[14], v[12]); CE_DESC(v[15], v[13]); CE_DESC(v[0], v[1]); CE_DESC(v[2], v[3]); CE_DESC(v[4], v[5]); CE_DESC(v[6], v[7]); CE_DESC(v[9], v[8]); CE_DESC(v[11], v[10]); CE_DESC(v[13], v[12]); CE_DESC(v[15], v[14]); CE_DESC(v[0], v[8]); CE_DESC(v[1], v[9]); CE_DESC(v[2], v[10]); CE_DESC(v[3], v[11]); CE_DESC(v[4], v[12]); CE_DESC(v[5], v[13]); CE_DESC(v[6], v[14]); CE_DESC(v[7], v[15]); CE_DESC(v[0], v[4]); CE_DESC(v[1], v[5]); CE_DESC(v[2], v[6]); CE_DESC(v[3], v[7]); CE_DESC(v[8], v[12]); CE_DESC(v[9], v[13]); CE_DESC(v[10], v[14]); CE_DESC(v[11], v[15]); CE_DESC(v[0], v[2]); CE_DESC(v[1], v[3]); CE_DESC(v[4], v[6]); CE_DESC(v[5], v[7]); CE_DESC(v[8], v[10]); CE_DESC(v[9], v[11]); CE_DESC(v[12], v[14]); CE_DESC(v[13], v[15]); CE_DESC(v[0], v[1]); CE_DESC(v[2], v[3]); CE_DESC(v[4], v[5]); CE_DESC(v[6], v[7]); CE_DESC(v[8], v[9]); CE_DESC(v[10], v[11]); CE_DESC(v[12], v[13]); CE_DESC(v[14], v[15]);
}
__device__ __forceinline__ void merge_top16(float (&a)[16], const float (&b)[16]) {
    a[0] = fmaxf(a[0], b[15]); a[1] = fmaxf(a[1], b[14]); a[2] = fmaxf(a[2], b[13]); a[3] = fmaxf(a[3], b[12]); a[4] = fmaxf(a[4], b[11]); a[5] = fmaxf(a[5], b[10]); a[6] = fmaxf(a[6], b[9]); a[7] = fmaxf(a[7], b[8]); a[8] = fmaxf(a[8], b[7]); a[9] = fmaxf(a[9], b[6]); a[10] = fmaxf(a[10], b[5]); a[11] = fmaxf(a[11], b[4]); a[12] = fmaxf(a[12], b[3]); a[13] = fmaxf(a[13], b[2]); a[14] = fmaxf(a[14], b[1]); a[15] = fmaxf(a[15], b[0]); CE_DESC(a[0], a[8]); CE_DESC(a[1], a[9]); CE_DESC(a[2], a[10]); CE_DESC(a[3], a[11]); CE_DESC(a[4], a[12]); CE_DESC(a[5], a[13]); CE_DESC(a[6], a[14]); CE_DESC(a[7], a[15]); CE_DESC(a[0], a[4]); CE_DESC(a[1], a[5]); CE_DESC(a[2], a[6]); CE_DESC(a[3], a[7]); CE_DESC(a[8], a[12]); CE_DESC(a[9], a[13]); CE_DESC(a[10], a[14]); CE_DESC(a[11], a[15]); CE_DESC(a[0], a[2]); CE_DESC(a[1], a[3]); CE_DESC(a[4], a[6]); CE_DESC(a[5], a[7]); CE_DESC(a[8], a[10]); CE_DESC(a[9], a[11]); CE_DESC(a[12], a[14]); CE_DESC(a[13], a[15]); CE_DESC(a[0], a[1]); CE_DESC(a[2], a[3]); CE_DESC(a[4], a[5]); CE_DESC(a[6], a[7]); CE_DESC(a[8], a[9]); CE_DESC(a[10], a[11]); CE_DESC(a[12], a[13]); CE_DESC(a[14], a[15]);
}
__device__ __forceinline__ void scores_top16(const bf16* qbase, const LAS unsigned char* kl, int r, int h, float (&t)[16]) {
    f32x16 acc[4];
#pragma unroll
    for (int kt = 0; kt < 4; ++kt)
#pragma unroll
        for (int e = 0; e < 16; ++e) acc[kt][e] = 0.f;
    const LAS unsigned char* kp0 = kl + r * 256; const int sw = r & 15;
#pragma unroll
    for (int ks = 0; ks < 8; ++ks) {
        const s16x8 qf = *(const s16x8*)(qbase + (size_t)r * 256 + 16 * ks + 8 * h);
#pragma unroll
        for (int kt = 0; kt < 4; ++kt) { const s16x8 kf = *(const LAS s16x8*)(kp0 + kt * 8192 + (((2 * ks + h) ^ sw) << 4)); acc[kt] = MFMA32(kf, qf, acc[kt]); }
    }
    float g[4][16];
#pragma unroll
    for (int kt = 0; kt < 4; ++kt) {
#pragma unroll
        for (int e = 0; e < 16; ++e) { const float av_ = acc[kt][e];
            g[kt][e] = __builtin_bit_cast(float, (__builtin_bit_cast(unsigned, av_) & ~0x7Fu) | (unsigned)(32 * kt + (e & 3) + 8 * (e >> 2))); }
        sort16_desc(g[kt]);
    }
    merge_top16(g[0], g[1]); merge_top16(g[2], g[3]); merge_top16(g[0], g[2]);
#pragma unroll
    for (int k = 0; k < 16; ++k) t[k] = __builtin_bit_cast(float, __builtin_bit_cast(unsigned, g[0][k]) | ((unsigned)h << 2));
}
__device__ __forceinline__ void peer_topk_unit_mfma(const Ptrs& P, const LAS unsigned char* k1l, const LAS unsigned char* k2l, LAS int* idxl, LAS float* gatel, int unit, int lane, int wave, int rb_lo = 0, int rb_hi = 2) {
    asm volatile("" : "+v"(lane));
    const int r = lane & 31, h = lane >> 5;
#pragma unroll 1
    for (int rbi = rb_lo; rbi < rb_hi; ++rbi) {
        const int rb = wave * 2 + rbi, R = rb * 32 + r;
        const bf16* qbase = P.QP + ((size_t)unit * 512 + rb * 32) * 256;
        float t1[16], t2[16];
        scores_top16(qbase, k1l, r, h, t1);
        __builtin_amdgcn_sched_barrier(0);
        scores_top16(qbase + 128, k2l, r, h, t2);
        __builtin_amdgcn_sched_barrier(0);
        float F[16], recv[16];
#pragma unroll
        for (int k = 0; k < 16; ++k) { auto rr = __builtin_amdgcn_permlane32_swap(__builtin_bit_cast(unsigned, t1[k]), __builtin_bit_cast(unsigned, t2[k]), false, false);
            const unsigned r0 = rr[0], r1 = rr[1]; F[k] = __builtin_bit_cast(float, r0); recv[k] = __builtin_bit_cast(float, r1); }
        merge_top16(F, recv);
        LAS unsigned char* slot = (LAS unsigned char*)(idxl + R * 16);
        { v4u b;
          b.x = (__builtin_bit_cast(unsigned, F[0]) & 0x7Fu) | ((__builtin_bit_cast(unsigned, F[1]) & 0x7Fu) << 8) | ((__builtin_bit_cast(unsigned, F[2]) & 0x7Fu) << 16) | ((__builtin_bit_cast(unsigned, F[3]) & 0x7Fu) << 24);
          b.y = (__builtin_bit_cast(unsigned, F[4]) & 0x7Fu) | ((__builtin_bit_cast(unsigned, F[5]) & 0x7Fu) << 8) | ((__builtin_bit_cast(unsigned, F[6]) & 0x7Fu) << 16) | ((__builtin_bit_cast(unsigned, F[7]) & 0x7Fu) << 24);
          b.z = (__builtin_bit_cast(unsigned, F[8]) & 0x7Fu) | ((__builtin_bit_cast(unsigned, F[9]) & 0x7Fu) << 8) | ((__builtin_bit_cast(unsigned, F[10]) & 0x7Fu) << 16) | ((__builtin_bit_cast(unsigned, F[11]) & 0x7Fu) << 24);
          b.w = (__builtin_bit_cast(unsigned, F[12]) & 0x7Fu) | ((__builtin_bit_cast(unsigned, F[13]) & 0x7Fu) << 8) | ((__builtin_bit_cast(unsigned, F[14]) & 0x7Fu) << 16) | ((__builtin_bit_cast(unsigned, F[15]) & 0x7Fu) << 24);
          *(LAS v4u*)(slot + 16 * h) = b;
          (void)b; }
        float v1[16], v2[16];
#pragma unroll
        for (int k = 0; k < 16; ++k) { auto rr = __builtin_amdgcn_permlane32_swap(__builtin_bit_cast(unsigned, F[k]), __builtin_bit_cast(unsigned, F[k]), false, false);
            const unsigned r0 = rr[0], r1 = rr[1]; v1[k] = __builtin_bit_cast(float, r0 & ~0x7Fu); v2[k] = __builtin_bit_cast(float, r1 & ~0x7Fu); }
        float cg[4][16];
#pragma unroll
        for (int a = 0; a < 4; ++a)
#pragma unroll
            for (int k = 0; k < 16; ++k) cg[a][k] = -1e30f;
#define CAND(i, j) __builtin_bit_cast(float, (__builtin_bit_cast(unsigned, v1[i] + v2[j]) & ~0xFFu) | (unsigned)((i) * 16 + (j)))
        cg[0][0] = CAND(0, 0);
        cg[0][1] = CAND(0, 1);
        cg[0][2] = CAND(0, 2);
        cg[0][3] = CAND(0, 3);
        cg[0][4] = CAND(0, 4);
        cg[0][5] = CAND(0, 5);
        cg[0][6] = CAND(0, 6);
        cg[0][7] = CAND(0, 7);
        cg[0][8] = CAND(0, 8);
        cg[0][9] = CAND(0, 9);
        cg[0][10] = CAND(0, 10);
        cg[0][11] = CAND(0, 11);
        cg[0][12] = CAND(0, 12);
        cg[0][13] = CAND(0, 13);
        cg[0][14] = CAND(0, 14);
        cg[0][15] = CAND(0, 15);
        cg[1][0] = CAND(1, 0);
        cg[1][1] = CAND(1, 1);
        cg[1][2] = CAND(1, 2);
        cg[1][3] = CAND(1, 3);
        cg[1][4] = CAND(1, 4);
        cg[1][5] = CAND(1, 5);
        cg[1][6] = CAND(1, 6);
        cg[1][7] = CAND(1, 7);
        cg[1][8] = CAND(2, 0);
        cg[1][9] = CAND(2, 1);
        cg[1][10] = CAND(2, 2);
        cg[1][11] = CAND(2, 3);
        cg[1][12] = CAND(2, 4);
        cg[1][13] = CAND(3, 0);
        cg[1][14] = CAND(3, 1);
        cg[1][15] = CAND(3, 2);
        cg[2][0] = CAND(3, 3);
        cg[2][1] = CAND(4, 0);
        cg[2][2] = CAND(4, 1);
        cg[2][3] = CAND(4, 2);
        cg[2][4] = CAND(5, 0);
        cg[2][5] = CAND(5, 1);
        cg[2][6] = CAND(6, 0);
        cg[2][7] = CAND(6, 1);
        cg[2][8] = CAND(7, 0);
        cg[2][9] = CAND(7, 1);
        cg[2][10] = CAND(8, 0);
        cg[2][11] = CAND(9, 0);
        cg[2][12] = CAND(10, 0);
        cg[2][13] = CAND(11, 0);
        cg[2][14] = CAND(12, 0);
        cg[2][15] = CAND(13, 0);
        cg[3][0] = CAND(14, 0);
        cg[3][1] = CAND(15, 0);
#undef CAND
        sort16_desc(cg[0]); sort16_desc(cg[1]); sort16_desc(cg[2]); sort16_desc(cg[3]);
        merge_top16(cg[0], cg[1]); merge_top16(cg[2], cg[3]); merge_top16(cg[0], cg[2]);
        float es = 0.f, e[16];
        const float top = __builtin_bit_cast(float, __builtin_bit_cast(unsigned, cg[0][0]) & ~0xFFu);
#pragma unroll
        for (int k = 0; k < 16; ++k) { e[k] = __expf(__builtin_bit_cast(float, __builtin_bit_cast(unsigned, cg[0][k]) & ~0xFFu) - top); es += e[k]; }
        const float inv = 1.0f / es;
        LDS_WAIT();
        unsigned id[8]; float gt[8];
#pragma unroll
        for (int k = 0; k < 8; ++k) { const float clo_ = cg[0][k], chi_ = cg[0][8 + k], elo_ = e[k], ehi_ = e[8 + k]; const unsigned code = __builtin_bit_cast(unsigned, h ? chi_ : clo_) & 0xFFu; gt[k] = (h ? ehi_ : elo_) * inv;
            id[k] = (unsigned)slot[code >> 4] * 128u + (unsigned)slot[16 + (code & 15u)]; }
        LDS_WAIT();
        LAS v4u* ip = (LAS v4u*)(idxl + R * 16 + 8 * h); LAS f32x4* gp = (LAS f32x4*)(gatel + R * 16 + 8 * h);
        { v4u a; a.x = id[0]; a.y = id[1]; a.z = id[2]; a.w = id[3]; ip[0] = a; v4u b; b.x = id[4]; b.y = id[5]; b.z = id[6]; b.w = id[7]; ip[1] = b; }
        { f32x4 a; a[0] = gt[0]; a[1] = gt[1]; a[2] = gt[2]; a[3] = gt[3]; gp[0] = a; f32x4 b; b[0] = gt[4]; b[1] = gt[5]; b[2] = gt[6]; b[3] = gt[7]; gp[1] = b; }
    }
}

__device__ __forceinline__ unsigned nib_pack(unsigned x) { x = (x | (x >> 4)) & 0x00FF00FFu; return (x | (x >> 8)) & 0xFFFFu; }
__device__ __forceinline__ void hn_planes(unsigned q0, unsigned q1, unsigned& pa, unsigned& pb) {
    const unsigned b0 = q0 & 0x0F0F0F0Fu, b1 = q1 & 0x0F0F0F0Fu;
    const unsigned a0 = (((q0 >> 4) & 0x0F0F0F0Fu) + ((q0 >> 3) & 0x01010101u)) & 0x0F0F0F0Fu, a1 = (((q1 >> 4) & 0x0F0F0F0Fu) + ((q1 >> 3) & 0x01010101u)) & 0x0F0F0F0Fu;
    pa = nib_pack(a0) | (nib_pack(a1) << 16); pb = nib_pack(b0) | (nib_pack(b1) << 16);
}
#define HROW_ISSUE(BUF, TAB, W) do { const unsigned vo_ = (((W) & 0x3fffu) << 9) + loff; asm volatile("global_load_dwordx4 %0, %1, %2" : "=v"(BUF) : "v"(vo_), "s"(TAB) : "memory"); } while (0)
__device__ __forceinline__ void peer_gather_half(const Ptrs& P, LAS unsigned char* lds, int unit, int lane, int wave, int g_lo, int g_hi) {
    asm volatile("" : "+v"(lane));
    const size_t t0 = (size_t)unit * 64 + wave * 8;
#pragma unroll 1
    for (int gq = g_lo; gq < g_hi; ++gq) {
        int lq = lane; asm volatile("" : "+v"(lq));
        LAS int* idxl = (LAS int*)(lds + 65536) + wave * 1024 + gq * 512;
        const LAS float* gatel = (const LAS float*)(lds + 98304) + wave * 1024 + gq * 512;
        LAS unsigned* sw = (LAS unsigned*)idxl; LAS float* sg = (LAS float*)(lds + 98304) + wave * 1024 + gq * 512;
        LAS int* startl = (LAS int*)(lds + 131072 + 4096) + wave * 64;
        {
            int ent[8]; float gv[8], us[8];
#pragma unroll
            for (int j = 0; j < 8; ++j) { ent[j] = idxl[(j >> 1) * 128 + (j & 1) * 64 + lq]; gv[j] = gatel[(j >> 1) * 128 + (j & 1) * 64 + lq]; }
#pragma unroll
            for (int j = 0; j < 8; ++j) { us[j] = P.USC[ent[j]]; gv[j] *= P.VSC[ent[j]] * 128.0f; }
            LDS_WAIT();
            int rk[8];
#pragma unroll
            for (int tk = 0; tk < 4; ++tk) {
                int run[NSL];
#pragma unroll
                for (int b = 0; b < NSL; ++b) run[b] = 0;
#pragma unroll
                for (int jj = 0; jj < 2; ++jj) { const int j = 2 * tk + jj; const int bj = ent[j] >> SLSH; int r = 0;
#pragma unroll
                    for (int b = 0; b < NSL; ++b) { const unsigned long long m = __ballot(bj == b);
                        const int below = (int)__builtin_amdgcn_mbcnt_hi((unsigned)(m >> 32), __builtin_amdgcn_mbcnt_lo((unsigned)m, 0u));
                        r = (bj == b) ? run[b] + below : r; run[b] += (int)__builtin_popcountll(m); }
                    rk[j] = r; }
                int st = 0;
#pragma unroll
                for (int b = 0; b < NSL; ++b) { if (lq == b) startl[tk * NSL + b] = st; st += run[b]; }
            }
            LDS_WAIT();
#pragma unroll
            for (int j = 0; j < 8; ++j) { const int pos = (j >> 1) * 128 + startl[(j >> 1) * NSL + (ent[j] >> SLSH)] + rk[j]; sw[pos] = (unsigned)ent[j] | (f2bf(us[j]) << 16); sg[pos] = gv[j]; }
            LDS_WAIT();
        }
        v4u hA0, hB0, hA1, hB1; float hs0, hs1;
        { int lg = lane; asm volatile("" : "+v"(lg)); const size_t tr = t0 + gq * 4 + (lg >> 5);
          const v4u* hp0 = (const v4u*)(P.HNQ + tr * 1024 + 32 * (lg & 31)); const v4u* hp1 = (const v4u*)(P.HNQ + (tr + 2) * 1024 + 32 * (lg & 31));
          const v4u x0 = hp0[0], x1 = hp0[1], z0 = hp1[0], z1 = hp1[1]; hs0 = P.HSC[tr]; hs1 = P.HSC[tr + 2];
          unsigned pa_[8], pb_[8];
          hn_planes(x0.x, x0.y, pa_[0], pb_[0]); hn_planes(x0.z, x0.w, pa_[1], pb_[1]); hn_planes(x1.x, x1.y, pa_[2], pb_[2]); hn_planes(x1.z, x1.w, pa_[3], pb_[3]);
          hn_planes(z0.x, z0.y, pa_[4], pb_[4]); hn_planes(z0.z, z0.w, pa_[5], pb_[5]); hn_planes(z1.x, z1.y, pa_[6], pb_[6]); hn_planes(z1.z, z1.w, pa_[7], pb_[7]);
          hA0.x = pa_[0]; hA0.y = pa_[1]; hA0.z = pa_[2]; hA0.w = pa_[3]; hB0.x = pb_[0]; hB0.y = pb_[1]; hB0.z = pb_[2]; hB0.w = pb_[3];
          hA1.x = pa_[4]; hA1.y = pa_[5]; hA1.z = pa_[6]; hA1.w = pa_[7]; hB1.x = pb_[4]; hB1.y = pb_[5]; hB1.z = pb_[6]; hB1.w = pb_[7]; }
        h2 y0[16];
#pragma unroll 1
        for (int sub = 0; sub < 2; ++sub) {
            int lr = lane; asm volatile("" : "+v"(lr));
            const int l5 = lr & 31, tk = 2 * sub + (lr >> 5);
            const LAS unsigned* swt = sw + tk * 128; const LAS float* sgt = sg + tk * 128;
            const unsigned loff = (unsigned)l5 * 16u;
            {
                const int c4 = lr & 15, rho = lr >> 4;
                const int mtk = 2 * sub + (rho >> 1), mpos = (c4 < 4) ? 2 * c4 + (rho & 1) : 0;
                const LAS unsigned* swm = sw + mtk * 128 + mpos; LAS float* sgm = sg + mtk * 128 + mpos;
                v4u ha = sub ? hA1 : hA0, hb = sub ? hB1 : hB0; float hsc_m = sub ? hs1 : hs0;
                asm volatile("" : "+v"(ha), "+v"(hb), "+v"(hsc_m));
                v4u ub[16]; float p[8];
                unsigned mw; float mg;
#pragma unroll 1
                for (int pass = 0; pass < PROBE_SWEEPS; ++pass) {
                const bool lastp = (pass + 1 == PROBE_SWEEPS);
#define U_STEP(d, CNT, ISSUE, W) do { asm volatile("s_waitcnt vmcnt(" #CNT ")" : "+v"(ub[d]) :: "memory"); \
        { const v4u x_ = ub[d]; int a_ = 0, b_ = 0; \
          a_ = __builtin_amdgcn_sdot8((int)x_.x, (int)ha.x, a_, false); b_ = __builtin_amdgcn_sdot8((int)x_.x, (int)hb.x, b_, false); \
          a_ = __builtin_amdgcn_sdot8((int)x_.y, (int)ha.y, a_, false); b_ = __builtin_amdgcn_sdot8((int)x_.y, (int)hb.y, b_, false); \
          a_ = __builtin_amdgcn_sdot8((int)x_.z, (int)ha.z, a_, false); b_ = __builtin_amdgcn_sdot8((int)x_.z, (int)hb.z, b_, false); \
          a_ = __builtin_amdgcn_sdot8((int)x_.w, (int)ha.w, a_, false); b_ = __builtin_amdgcn_sdot8((int)x_.w, (int)hb.w, b_, false); \
          p[(d) & 7] = (float)((a_ << 4) + b_); } \
        if (ISSUE) HROW_ISSUE(ub[d], P.U8, W); } while (0)
#define U_FINISH(i0) do { float r_[4]; \
        _Pragma("unroll") for (int j = 0; j < 4; ++j) { auto rr = __builtin_amdgcn_permlane16_swap(__builtin_bit_cast(unsigned, p[2 * j]), __builtin_bit_cast(unsigned, p[2 * j + 1]), false, false); const unsigned r0 = rr[0], r1 = rr[1]; r_[j] = row16_sum(__builtin_bit_cast(float, r0) + __builtin_bit_cast(float, r1)); } \
        const float acol = (c4 == 0) ? r_[0] : (c4 == 1) ? r_[1] : (c4 == 2) ? r_[2] : r_[3]; \
        const float act = gelu_tanh(acol * __builtin_bit_cast(float, mw & 0xffff0000u) * hsc_m) * mg; \
        if (c4 < 4 && lastp) sgm[i0] = act; asm volatile("" :: "v"(act)); } while (0)
#define U_CHUNK(i0, B, WA, WB, C0, C1, C2, C3, C4, C5, C6, C7, ISSUE) do { mw = swm[i0]; mg = sgm[i0]; \
        U_STEP(B + 0, C0, ISSUE, WA.x); U_STEP(B + 1, C1, ISSUE, WA.y); U_STEP(B + 2, C2, ISSUE, WA.z); U_STEP(B + 3, C3, ISSUE, WA.w); \
        U_STEP(B + 4, C4, ISSUE, WB.x); U_STEP(B + 5, C5, ISSUE, WB.y); U_STEP(B + 6, C6, ISSUE, WB.z); U_STEP(B + 7, C7, ISSUE, WB.w); \
        U_FINISH(i0); } while (0)
                {
                    const v4u w0 = *(const LAS v4u*)(swt), w1 = *(const LAS v4u*)(swt + 4), w2 = *(const LAS v4u*)(swt + 8), w3 = *(const LAS v4u*)(swt + 12);
                    HROW_ISSUE(ub[0], P.U8, w0.x); HROW_ISSUE(ub[1], P.U8, w0.y); HROW_ISSUE(ub[2], P.U8, w0.z); HROW_ISSUE(ub[3], P.U8, w0.w);
                    HROW_ISSUE(ub[4], P.U8, w1.x); HROW_ISSUE(ub[5], P.U8, w1.y); HROW_ISSUE(ub[6], P.U8, w1.z); HROW_ISSUE(ub[7], P.U8, w1.w);
                    HROW_ISSUE(ub[8], P.U8, w2.x); HROW_ISSUE(ub[9], P.U8, w2.y); HROW_ISSUE(ub[10], P.U8, w2.z); HROW_ISSUE(ub[11], P.U8, w2.w);
                    HROW_ISSUE(ub[12], P.U8, w3.x); HROW_ISSUE(ub[13], P.U8, w3.y); HROW_ISSUE(ub[14], P.U8, w3.z); HROW_ISSUE(ub[15], P.U8, w3.w);
                }
                v4u wa = *(const LAS v4u*)(swt + 16), wb = *(const LAS v4u*)(swt + 20);
#pragma unroll 1
                for (int i0 = 0; i0 < 112; i0 += 16) {
                    const v4u wc = *(const LAS v4u*)(swt + i0 + 24), wd = *(const LAS v4u*)(swt + i0 + 28);
                    U_CHUNK(i0, 0, wa, wb, 15, 15, 15, 15, 15, 15, 15, 15, 1);
                    wa = *(const LAS v4u*)(swt + i0 + 32); wb = *(const LAS v4u*)(swt + i0 + 36);
                    U_CHUNK(i0 + 8, 8, wc, wd, 15, 15, 15, 15, 15, 15, 15, 15, 1);
                }
                U_CHUNK(112, 0, wa, wb, 15, 14, 13, 12, 11, 10, 9, 8, 0);
                U_CHUNK(120, 8, wa, wb, 7, 6, 5, 4, 3, 2, 1, 0, 0);
                }
#undef U_CHUNK
#undef U_FINISH
#undef U_STEP
            }
            LDS_WAIT();
            h2 y[16];
#pragma unroll
            for (int k = 0; k < 16; ++k) { y[k][0] = (_Float16)0.f; y[k][1] = (_Float16)0.f; }
            {
                v4u vb[16];
#pragma unroll 1
                for (int pass = 0; pass < PROBE_SWEEPS; ++pass) {
                if (pass > 0) {
#pragma unroll
                    for (int k = 0; k < 16; ++k) { y[k][0] = (_Float16)0.f; y[k][1] = (_Float16)0.f; } }
#define V_F4(K, X, B) y[K] = __builtin_elementwise_fma(__builtin_bit_cast(h2, __builtin_amdgcn_cvt_scalef32_pk_f16_fp4(X, 1.0f, B)), a2_, y[K])
#define V_STEP(d, CNT, ISSUE, W, A) do { asm volatile("s_waitcnt vmcnt(" #CNT ")" : "+v"(vb[d]) :: "memory"); \
        { const v4u x_ = vb[d]; const h2 a2_ = __builtin_bit_cast(h2, __builtin_amdgcn_cvt_pkrtz(A, A)); \
          V_F4(0, x_.x, 0); V_F4(1, x_.x, 1); V_F4(2, x_.x, 2); V_F4(3, x_.x, 3); V_F4(4, x_.y, 0); V_F4(5, x_.y, 1); V_F4(6, x_.y, 2); V_F4(7, x_.y, 3); \
          V_F4(8, x_.z, 0); V_F4(9, x_.z, 1); V_F4(10, x_.z, 2); V_F4(11, x_.z, 3); V_F4(12, x_.w, 0); V_F4(13, x_.w, 1); V_F4(14, x_.w, 2); V_F4(15, x_.w, 3); } \
        if (ISSUE) HROW_ISSUE(vb[d], P.V8, W); } while (0)
#define V_CHUNK(i0, B, WA, WB, C0, C1, C2, C3, C4, C5, C6, C7, ISSUE) do { const f32x4 aa_ = *(const LAS f32x4*)(sgt + (i0)), ab_ = *(const LAS f32x4*)(sgt + (i0) + 4); \
        V_STEP(B + 0, C0, ISSUE, WA.x, aa_[0]); V_STEP(B + 1, C1, ISSUE, WA.y, aa_[1]); V_STEP(B + 2, C2, ISSUE, WA.z, aa_[2]); V_STEP(B + 3, C3, ISSUE, WA.w, aa_[3]); \
        V_STEP(B + 4, C4, ISSUE, WB.x, ab_[0]); V_STEP(B + 5, C5, ISSUE, WB.y, ab_[1]); V_STEP(B + 6, C6, ISSUE, WB.z, ab_[2]); V_STEP(B + 7, C7, ISSUE, WB.w, ab_[3]); } while (0)
                {
                    const v4u w0 = *(const LAS v4u*)(swt), w1 = *(const LAS v4u*)(swt + 4), w2 = *(const LAS v4u*)(swt + 8), w3 = *(const LAS v4u*)(swt + 12);
                    HROW_ISSUE(vb[0], P.V8, w0.x); HROW_ISSUE(vb[1], P.V8, w0.y); HROW_ISSUE(vb[2], P.V8, w0.z); HROW_ISSUE(vb[3], P.V8, w0.w);
                    HROW_ISSUE(vb[4], P.V8, w1.x); HROW_ISSUE(vb[5], P.V8, w1.y); HROW_ISSUE(vb[6], P.V8, w1.z); HROW_ISSUE(vb[7], P.V8, w1.w);
                    HROW_ISSUE(vb[8], P.V8, w2.x); HROW_ISSUE(vb[9], P.V8, w2.y); HROW_ISSUE(vb[10], P.V8, w2.z); HROW_ISSUE(vb[11], P.V8, w2.w);
                    HROW_ISSUE(vb[12], P.V8, w3.x); HROW_ISSUE(vb[13], P.V8, w3.y); HROW_ISSUE(vb[14], P.V8, w3.z); HROW_ISSUE(vb[15], P.V8, w3.w);
                }
                v4u wa = *(const LAS v4u*)(swt + 16), wb = *(const LAS v4u*)(swt + 20);
#pragma unroll 1
                for (int i0 = 0; i0 < 112; i0 += 16) {
                    const v4u wc = *(const LAS v4u*)(swt + i0 + 24), wd = *(const LAS v4u*)(swt + i0 + 28);
                    V_CHUNK(i0, 0, wa, wb, 15, 15, 15, 15, 15, 15, 15, 15, 1);
                    wa = *(const LAS v4u*)(swt + i0 + 32); wb = *(const LAS v4u*)(swt + i0 + 36);
                    V_CHUNK(i0 + 8, 8, wc, wd, 15, 15, 15, 15, 15, 15, 15, 15, 1);
                }
                V_CHUNK(112, 0, wa, wb, 15, 14, 13, 12, 11, 10, 9, 8, 0);
                V_CHUNK(120, 8, wa, wb, 7, 6, 5, 4, 3, 2, 1, 0, 0);
                }
#undef V_CHUNK
#undef V_STEP
#undef V_F4
            }
            if (sub == 0) {
#pragma unroll
                for (int k = 0; k < 16; ++k) y0[k] = y[k]; }
            else {
                v4u xb[2][4]; f32x4 wv[8];
#pragma unroll
                for (int tt = 0; tt < 2; ++tt)
#pragma unroll
                    for (int m = 0; m < 4; ++m) xb[tt][m] = *((const v4u*)(P.X1B + (t0 + gq * 4 + 2 * tt + (lr >> 5)) * 1024 + 32 * l5) + m);
#pragma unroll
                for (int m = 0; m < 8; ++m) wv[m] = *(const f32x4*)(P.fin_w + (32 * l5 + 4 * m));
#pragma unroll
                for (int tt = 0; tt < 2; ++tt) {
                    float* xr = P.out + (t0 + gq * 4 + 2 * tt + (lr >> 5)) * 1024 + 32 * l5;
                    f32x4 x[8]; float ss = 0.f;
#pragma unroll
                    for (int m = 0; m < 8; ++m) { const unsigned q0 = (m & 1) ? xb[tt][m >> 1].z : xb[tt][m >> 1].x, q1 = (m & 1) ? xb[tt][m >> 1].w : xb[tt][m >> 1].y;
                        const h2 ya = tt ? y[2 * m] : y0[2 * m], yb = tt ? y[2 * m + 1] : y0[2 * m + 1];
                        x[m][0] = bflo(q0) + (float)ya[0] * (1.0f / 128.0f); x[m][1] = bfhi(q0) + (float)ya[1] * (1.0f / 128.0f); x[m][2] = bflo(q1) + (float)yb[0] * (1.0f / 128.0f); x[m][3] = bfhi(q1) + (float)yb[1] * (1.0f / 128.0f);
                        ss += (x[m][0] * x[m][0] + x[m][1] * x[m][1]) + (x[m][2] * x[m][2] + x[m][3] * x[m][3]); }
                    ss = row16_sum(ss);
                    ss += __builtin_bit_cast(float, __builtin_amdgcn_ds_swizzle(__builtin_bit_cast(int, ss), 0x401F));
                    const float rstd = 1.0f / sqrtf(ss * (1.0f / 1024.0f) + EPS);
#pragma unroll
                    for (int m = 0; m < 8; ++m) *(f32x4*)(xr + 4 * m) = x[m] * rstd * wv[m];
                }
            }
        }
    }
}
#undef HROW_ISSUE

__device__ __forceinline__ void p7_peer(LAS unsigned char* lds, const Ptrs& P, int vcu, int G, int tid, int lane, int wave) {
    LAS bf16* k1l = (LAS bf16*)lds;
    LAS bf16* k2l = (LAS bf16*)(lds + 32768);
    LAS int* idxl = (LAS int*)(lds + 65536);
    LAS float* gatel = (LAS float*)(lds + 98304);
    for (int i = tid; i < 2048; i += 512) { const int n = i >> 4, c = i & 15, d = n * 16 + (c ^ (n & 15)); ((LAS v4u*)k1l)[d] = ((const v4u*)P.K1)[i]; ((LAS v4u*)k2l)[d] = ((const v4u*)P.K2)[i]; }
    __syncthreads();
    for (int unit = vcu; unit < M / 64; unit += G) {
#pragma unroll 1
        for (int st = 0; st < 4; ++st) {
            const int g = st >> 1;
            if ((st & 1) == 0)
#pragma unroll 1
              for (int rep = 0; rep < PROBE_TOPK; ++rep) peer_topk_unit_mfma(P, (const LAS unsigned char*)k1l, (const LAS unsigned char*)k2l, idxl, gatel, unit, lane, wave, g, g + 1);
            else peer_gather_half(P, lds, unit, lane, wave, g, g + 1);
        }
        __syncthreads();
    }
}

struct Args { const float* in[19]; float* out; unsigned char* ws; int ph_lo, ph_hi; };
__global__ void __launch_bounds__(NWAVES * 64, 2) mega_fwd(Args args) {
    extern __shared__ __attribute__((aligned(16))) unsigned char lds_raw[];
    LAS unsigned char* lds = (LAS unsigned char*)lds_raw;
    const int tid = threadIdx.x, lane = tid & 63, wave = __builtin_amdgcn_readfirstlane(tid >> 6);
    const int G = gridDim.x; const int bx = blockIdx.x; const int vcu = (G % 8 == 0) ? (bx % 8) * (G / 8) + bx / 8 : bx;
    unsigned char* ws = args.ws;
    Ptrs P;
    P.x = args.in[0]; P.mix_w = args.in[1]; P.w_in = args.in[2]; P.rel_bias = args.in[3]; P.sinks = args.in[4]; P.w_pa = args.in[5]; P.ln_w = args.in[6]; P.ln_b = args.in[7];
    P.w_s = args.in[8]; P.b_s = args.in[9]; P.w_pb = args.in[10]; P.w_out = args.in[11]; P.ffn_w = args.in[12]; P.w_q = args.in[13]; P.keys1 = args.in[14]; P.keys2 = args.in[15];
    P.pu = args.in[16]; P.pv = args.in[17]; P.fin_w = args.in[18]; P.out = args.out;
    P.WIN8 = ws + WS_WIN; P.WPAB = (bf16*)(ws + WS_WPA); P.WOUT8 = ws + WS_WOUT; P.WQ8 = ws + WS_WQ;
    P.WINSC = (float*)(ws + WS_V + 131072); P.WQSC = (float*)(ws + WS_V + 163840); P.XSC = (float*)(ws + WS_V + 196608); P.WOUTSC = (float*)(ws + WS_V + 262144); P.MSC = (float*)(ws + WS_V + 327680);
    P.K1 = (bf16*)(ws + WS_K1); P.K2 = (bf16*)(ws + WS_K2); P.WS = (bf16*)(ws + WS_WS);
    P.U8 = ws + WS_U; P.V8 = ws + WS_U + 8 * MiB; P.USC = (float*)(ws + WS_V); P.VSC = (float*)(ws + WS_V + 65536); P.HSC = (float*)(ws + WS_HSC);
    P.XN8 = ws + WS_G1; P.MERGED8 = ws + WS_G1; P.HNQ = ws + WS_Q;
    P.GA = (bf16*)(ws + WS_G2); P.GB = (bf16*)(ws + WS_G2) + 1024; P.QP = (bf16*)(ws + WS_G2);
    P.AOUT = (bf16*)(ws + WS_G3); P.BOUT = (bf16*)(ws + WS_G3) + 512; P.X1B = (bf16*)(ws + WS_G3);
    P.Q = (bf16*)(ws + WS_Q); P.KV = (bf16*)(ws + WS_KV); P.GU = (bf16*)(ws + WS_GU); P.GV = (bf16*)(ws + WS_GV);

    for (int u = tid; u < (LDS_BYTES - MISC_OFF) / 4; u += NWAVES * 64) ((LAS unsigned*)(lds + MISC_OFF))[u] = 0u;
    __syncthreads();
    const int lo = args.ph_lo, hi = args.ph_hi;
    unsigned* barw = (unsigned*)(ws + WS_CTL) + CW_BAR;
    XcdBarrier bar; bar.bar = barw; bar.x = 0; bar.st = nullptr;
    if (hi - lo > 1) bar = xcd_barrier_post(barw, (volatile LAS unsigned*)(lds + MISC_OFF));
#define IN(k) (lo <= (k) && (k) < hi)
#define BOTH(k) (IN(k) && IN((k) + 1))
#define GRID_BAR() xcd_barrier(bar)
#define REPS(k) ((k) == PROBE_PHASE ? 2 : 1)
    unsigned* ctl = (unsigned*)(ws + WS_CTL);
    const bool grp = PANEL_SEAMS && (G == 256) && (lo == 0) && (hi == N_PHASES);
    const int pmb = 8 * (bx & 7) + ((bx >> 3) & 7), ucu = grp ? 4 * pmb + (bx >> 6) : vcu;
    bool rel_own = true, rel_kv = true;
    if (grp && tid == 0) __hip_atomic_store(ctl + 6144 + bx, 1u + xb_xcc_id(), __ATOMIC_RELAXED, __HIP_MEMORY_SCOPE_AGENT);
#define SEAM(k) do { if (grp) { asm volatile("s_waitcnt vmcnt(0)" ::: "memory"); __syncthreads(); \
        if (tid == 0) { if ((k) == 1 ? rel_kv : rel_own) { __builtin_amdgcn_fence(__ATOMIC_RELEASE, "agent"); asm volatile("s_waitcnt vmcnt(0)" ::: "memory"); } \
            unsigned* c_ = ctl + 8192 + 16 * (64 * (k) + pmb); (void)xb_add(c_, 1u); XB_SPIN(xb_ld(c_) < 4u, barw); \
            if ((k) == 1 && (pmb & 31) != 0) XB_SPIN(xb_ld(c_ - 16) < 4u, barw); \
            if (!PROBE_NOACQ) { __builtin_amdgcn_fence(__ATOMIC_ACQUIRE, "agent"); asm volatile("s_waitcnt vmcnt(0)" ::: "memory"); } } \
        __syncthreads(); } else if (BOTH(k)) GRID_BAR(); } while (0)

    if (IN(0)) {
#pragma unroll
        for (int rep = 0; rep < REPS(0); ++rep) { p0_prologue(lds, P, vcu, G, lane, wave); __syncthreads(); }
        if (BOTH(0)) GRID_BAR();
        if (grp) {
            const unsigned mine = 1u + xb_xcc_id(); bool own = true, nxt = true;
            for (int k = 0; k < 4; ++k) own = own && (__hip_atomic_load(ctl + 6144 + (pmb >> 3) + 8 * (pmb & 7) + 64 * k, __ATOMIC_RELAXED, __HIP_MEMORY_SCOPE_AGENT) == mine);
            const int pn_ = pmb + 1;
            if (pn_ < 64 && (pn_ & 31) != 0)
                for (int k = 0; k < 4; ++k) nxt = nxt && (__hip_atomic_load(ctl + 6144 + (pn_ >> 3) + 8 * (pn_ & 7) + 64 * k, __ATOMIC_RELAXED, __HIP_MEMORY_SCOPE_AGENT) == mine);
            rel_own = !own || PANEL_FORCE_RELEASE; rel_kv = !own || !nxt || PANEL_FORCE_RELEASE; } }

    if (IN(1)) {
        pg8::Gemm g{(const pg8::bf16_t*)P.XN8, (const pg8::bf16_t*)P.WIN8, M, NZ, D / 2, D / 2, P.XSC, P.WINSC}; pg8::StaticOrder S; S.init(M, NZ, G, bx);
        pg8::EpiZ E{P.Q, P.KV, P.GU, P.GV, P.GA, P.GB};
#pragma unroll
        for (int rep = 0; rep < REPS(1); ++rep) pg8::gemm_phase<pg8::EpiZ, pg8::StaticOrder, PG8_ALIGN, PG8_SP2, true>(lds, g, S, E);
        SEAM(1);
    }

    if (IN(2)) {
        for (int rep = 0; rep < REPS(2); ++rep) {
        p2_attn_mfma(lds, P, ucu, G, tid, lane, wave);
        p2_gmlp_mfma(lds, P, ucu, G, tid, lane, wave);
        }
        SEAM(2);
    }

    if (IN(3)) {
#pragma unroll
      for (int rep = 0; rep < REPS(3); ++rep) {
        { pg8::Gemm g{P.AOUT, P.WPAB, M, D, 1024, AB_LD, nullptr, nullptr}; pg8::StaticOrder S; S.init(M, D, G, bx);
          pg8::EpiMerge2 E{P.GA, P.MERGED8, P.MSC, (unsigned*)(ws + WS_END + 524288), (unsigned*)(ws + WS_CTL) + 4096 + 1024, barw, (LAS float*)(lds + 131072)};
          pg8::gemm_phase<pg8::EpiMerge2, pg8::StaticOrder, PG8_ALIGN, PG8_SP2>(lds, g, S, E); }
      }
        SEAM(3);
    }

    if (IN(4)) {
        pg8::Gemm g{(const pg8::bf16_t*)P.MERGED8, (const pg8::bf16_t*)P.WOUT8, M, D, D / 2, D / 2, P.MSC, P.WOUTSC}; pg8::StaticOrder S; S.init(M, D, G, bx);
        pg8::EpiResLn E{P.x, P.ffn_w, (pg8::bf16_t*)P.X1B, P.HNQ, P.HSC, (unsigned long long*)(ws + WS_END), (unsigned*)(ws + WS_CTL) + 4096, barw, (LAS float*)(lds + 131072)};
#pragma unroll
        for (int rep = 0; rep < REPS(4); ++rep) pg8::gemm_phase<pg8::EpiResLn, pg8::StaticOrder, PG8_ALIGN, PG8_SP2, true>(lds, g, S, E);
        SEAM(4);
    }

    if (IN(6)) {
        pg8::Gemm g{(const pg8::bf16_t*)P.HNQ, (const pg8::bf16_t*)P.WQ8, M, 2048, D / 2, D / 2, P.HSC, P.WQSC}; pg8::StaticOrder S; S.init(M, 2048, G, bx);
        pg8::EpiPlain E{P.QP, 2048};
#pragma unroll
        for (int rep = 0; rep < REPS(6); ++rep) pg8::gemm_phase<pg8::EpiPlain, pg8::StaticOrder, PG8_ALIGN, PG8_SP2, true>(lds, g, S, E);
        SEAM(6);
    }

    if (IN(7)) {
#pragma unroll 1
        for (int rep = 0; rep < REPS(7); ++rep) p7_peer(lds, P, ucu, G, tid, lane, wave);
    }
#undef IN
#undef BOTH
#undef GRID_BAR
}

extern "C" void kernel_launch(void* const* d_in, const int* in_sizes, int n_in, void* d_out, int out_size, void* d_ws, size_t ws_size, hipStream_t stream) {
    static int grid = 0;
    if (grid == 0) {
        if (n_in != 19 || out_size != M * D || ws_size < WS_END + MiB) { fprintf(stderr, "kernel_launch: unexpected shapes (n_in %d, out %d, ws %zu)\n", n_in, out_size, ws_size); grid = -1; return; }
        int dev = 0, cus = 0, per_cu = 0;
        if (hipGetDevice(&dev) != hipSuccess || hipDeviceGetAttribute(&cus, hipDeviceAttributeMultiprocessorCount, dev) != hipSuccess) { grid = -1; return; }
        if (hipFuncSetAttribute((const void*)mega_fwd, hipFuncAttributeMaxDynamicSharedMemorySize, LDS_BYTES) != hipSuccess) { fprintf(stderr, "kernel_launch: hipFuncSetAttribute failed\n"); grid = -1; return; }
        if (hipOccupancyMaxActiveBlocksPerMultiprocessor(&per_cu, (const void*)mega_fwd, NWAVES * 64, LDS_BYTES) != hipSuccess || per_cu < 1)
            fprintf(stderr, "kernel_launch: note: occupancy query reports %d workgroups per CU\n", per_cu);
        (void)hipGetLastError();
        grid = cus;
    }
    if (grid < 0) return;
    if (hipMemsetAsync((char*)d_ws + WS_CTL, 0, CTL_ZERO_BYTES, stream) != hipSuccess) return;
    Args a{};
    for (int i = 0; i < 19; ++i) a.in[i] = (const float*)d_in[i];
    a.out = (float*)d_out; a.ws = (unsigned char*)d_ws;
    a.ph_lo = 0; a.ph_hi = N_PHASES;
    hipLaunchKernelGGL(mega_fwd, dim3(grid), dim3(NWAVES * 64), LDS_BYTES, stream, a);
}
```

```cpp
#include <hip/hip_runtime.h>
#include <cstdio>
#include <cstdint>
#ifndef PROBE_SWEEPS
#define PROBE_SWEEPS 1
#endif
#ifndef PANEL_SEAMS
#define PANEL_SEAMS 1
#endif
#ifndef PANEL_FORCE_RELEASE
#define PANEL_FORCE_RELEASE 0
#endif
#ifndef PROBE_NOACQ
#define PROBE_NOACQ 0
#endif
#ifndef XB
#define XB 2
#endif
#ifndef MIDB
#define MIDB 4
#endif
#ifndef PROBE_TOPK
#define PROBE_TOPK 1
#endif
#ifndef PROBE_PHASE
#define PROBE_PHASE -1
#endif
#ifndef FP4_SELFCHECK
#define FP4_SELFCHECK 0
#endif
#ifndef NSL
#define NSL 8
#endif
#ifndef Q4_USTEP
#define Q4_USTEP 0.36f
#endif
#ifndef Q4_VUNIT
#define Q4_VUNIT 0.5f
#endif
namespace pg8 {
#define PG8_LAS __attribute__((address_space(3)))
typedef unsigned short bf16_t;
typedef short bf16x8 __attribute__((ext_vector_type(8)));
typedef float f32x4 __attribute__((ext_vector_type(4)));
typedef unsigned u32x4 __attribute__((ext_vector_type(4)));
typedef int i32x4 __attribute__((ext_vector_type(4)));
constexpr int BM = 256, BK = 64, HALF = 128, HTB = HALF * BK * 2  , STAGE_BYTES = 8 * HTB, NXCD = 8, WGM = 8;

__host__ __device__ __forceinline__ int lds_byte(int r, int c) { const int st = (r >> 4) * 2 + (c >> 5), rr = r & 15, cc = c & 31, ob = rr * 64 + cc * 2; return st * 1024 + (ob ^ (((ob >> 9) & 1) << 5)); }
__host__ __device__ __forceinline__ void stage_rc(int b, int& R, int& C) { const int st = b / 1024, sb = b % 1024, swz = sb ^ (((sb >> 9) & 1) << 5); R = (st >> 1) * 16 + swz / 64; C = (st & 1) * 32 + (swz % 64) / 2; }
__host__ __device__ __forceinline__ int perm32(int rho) { const int n = rho >> 4, i = rho & 15; return 8 * (i >> 2) + 4 * n + (i & 3); }

struct Unit { int pm, pn; };
struct Gemm { const bf16_t* A; const bf16_t* Bt; int M, N, K, lda; const float* rs; const float* cs; };

struct StaticOrder {
    int nM, nN, nwg, G, c;
    __host__ __device__ void init(int M, int N, int G_, int c_) { nM = M / BM; nN = N / BM; nwg = nM * nN; G = G_; c = c_; }
    __host__ __device__ bool next(int i, Unit& u) const {
        const long L = (long)i * G + c; if (L >= nwg) return false;
        int wgid = (int)L; { const int q = nwg / NXCD, r = nwg % NXCD, xcd = wgid % NXCD, off = wgid / NXCD; wgid = (xcd < r ? xcd * (q + 1) : r * (q + 1) + (xcd - r) * q) + off; }
        const int nig = WGM * nN, gid = wgid / nig, fm = gid * WGM, gsz = (nM - fm) < WGM ? (nM - fm) : WGM;
        u.pm = fm + ((wgid % nig) % gsz); u.pn = (wgid % nig) / gsz; return true;
    }
    __device__ __forceinline__ void a_ready(const Unit&) const {}
    __device__ __forceinline__ void done(const Unit&) const {}
};

__device__ __forceinline__ unsigned cvt_pk_bf16(float lo, float hi) { unsigned r; asm volatile("v_cvt_pk_bf16_f32 %0, %1, %2" : "=v"(r) : "v"(lo), "v"(hi)); return r; }
typedef float f32x2 __attribute__((ext_vector_type(2)));
template <class Epi, class Sched, bool ALIGN_EPI = false, bool SP2 = false, bool I8 = false>
__device__ __forceinline__ void gemm_phase(PG8_LAS unsigned char* lds, const Gemm g, const Sched& S, const Epi& E) {
    const int tid = threadIdx.x, wid = __builtin_amdgcn_readfirstlane(tid >> 6), lane = tid & 63, wr = wid >> 2, wc = wid & 3, fr = lane & 15, fq = lane >> 4;
    const int K = g.K, nt = K / BK;
    unsigned voffA[2], voffB[2];
#pragma unroll
    for (int i = 0; i < 2; ++i) { int R, C; stage_rc(tid * 16 + i * 8192, R, C); const int Rb = Epi::PERM ? ((R & ~31) + perm32(R & 31)) : R;
        voffA[i] = (unsigned)(R * g.lda + C) * 2u; voffB[i] = (unsigned)(Rb * K + C) * 2u; }
    const size_t kstep = (size_t)(BK * 2);
    const size_t hstep = (size_t)HALF * K * 2;
    const size_t tstep = 2 * hstep;
    const size_t hstepA = (size_t)HALF * g.lda * 2, tstepA = 2 * hstepA;
    const unsigned ldsw = (unsigned)wid * 1024u;
    const int aoff = lds_byte(wr * 64 + fr, fq * 8), boff = lds_byte(wc * 32 + fr, fq * 8);
#define PG8_SA(b, h) (((b) * 2 + (h)) * HTB)
#define PG8_SB(b, h) ((4 + (b) * 2 + (h)) * HTB)
#define PG8_STAGE(bufoff, gbase, voff) do { _Pragma("unroll") for (int _i = 0; _i < 2; ++_i) \
        __builtin_amdgcn_global_load_lds((const unsigned*)((const char*)(gbase) + (voff)[_i]), (PG8_LAS unsigned*)(lds + (bufoff) + ldsw + _i * 8192), 16, 0, 0); } while (0)
#define PG8_LDA(dst, b, h) do { _Pragma("unroll") for (int m = 0; m < 4; ++m) _Pragma("unroll") for (int k = 0; k < 2; ++k) dst[m][k] = *(const PG8_LAS bf16x8*)(lds + PG8_SA(b, h) + aoff + m * 2048 + k * 1024); } while (0)
#define PG8_LDB(dst, b, h) do { _Pragma("unroll") for (int n = 0; n < 2; ++n) _Pragma("unroll") for (int k = 0; k < 2; ++k) dst[n][k] = *(const PG8_LAS bf16x8*)(lds + PG8_SB(b, h) + boff + n * 2048 + k * 1024); } while (0)
#define PG8_MMA(ai, bj, At, Bt) do { __builtin_amdgcn_s_setprio(1); _Pragma("unroll") for (int m = 0; m < 4; ++m) _Pragma("unroll") for (int n = 0; n < 2; ++n) _Pragma("unroll") for (int k = 0; k < 2; ++k) \
        { if constexpr (I8) acc[ai][bj][m][n] = __builtin_bit_cast(f32x4, __builtin_amdgcn_mfma_i32_16x16x64_i8(__builtin_bit_cast(i32x4, Bt[n][k]), __builtin_bit_cast(i32x4, At[m][k]), __builtin_bit_cast(i32x4, acc[ai][bj][m][n]), 0, 0, 0)); \
          else acc[ai][bj][m][n] = __builtin_amdgcn_mfma_f32_16x16x32_bf16(Bt[n][k], At[m][k], acc[ai][bj][m][n], 0, 0, 0); } __builtin_amdgcn_s_setprio(0); } while (0)
#define PG8_WAIT_V(n) asm volatile("s_waitcnt vmcnt(" #n ")" ::: "memory")
#define PG8_WAIT_L(n) asm volatile("s_waitcnt lgkmcnt(" #n ")" ::: "memory")
#define PG8_BAR __builtin_amdgcn_s_barrier()
#define PG8_SCHED __builtin_amdgcn_sched_barrier(0)
    Unit cur, nxt; int ui = 0;
    if (!S.next(0, cur)) return;
    f32x4 acc[2][2][4][2];
#pragma unroll
    for (int a = 0; a < 2; ++a)
#pragma unroll
        for (int b = 0; b < 2; ++b)
#pragma unroll
            for (int m = 0; m < 4; ++m)
#pragma unroll
                for (int n = 0; n < 2; ++n) acc[a][b][m][n] = (f32x4){0.f, 0.f, 0.f, 0.f};
    bf16x8 At[4][2], B0[2][2], B1[2][2];
    const char* cA = (const char*)g.A + (size_t)cur.pm * tstepA; const char* cB = (const char*)g.Bt + (size_t)cur.pn * tstep;
    S.a_ready(cur);
    if constexpr (SP2) {
        PG8_STAGE(PG8_SB(0, 0), cB, voffB); PG8_STAGE(PG8_SB(0, 1), cB + hstep, voffB); PG8_STAGE(PG8_SA(0, 0), cA, voffA); PG8_STAGE(PG8_SA(0, 1), cA + hstepA, voffA);
        if (wr == 1) PG8_BAR;
        PG8_WAIT_V(2); PG8_BAR;
        PG8_STAGE(PG8_SB(1, 0), cB + kstep, voffB); PG8_STAGE(PG8_SA(1, 0), cA + kstep, voffA); PG8_STAGE(PG8_SB(1, 1), cB + hstep + kstep, voffB);
        PG8_WAIT_V(6); PG8_BAR;
    } else {
        PG8_STAGE(PG8_SB(0, 0), cB, voffB); PG8_STAGE(PG8_SA(0, 0), cA, voffA); PG8_STAGE(PG8_SB(0, 1), cB + hstep, voffB); PG8_STAGE(PG8_SA(0, 1), cA + hstepA, voffA);
        if (wr == 1) PG8_BAR;
        PG8_WAIT_V(4); PG8_BAR;
        PG8_STAGE(PG8_SB(1, 0), cB + kstep, voffB); PG8_STAGE(PG8_SA(1, 0), cA + kstep, voffA); PG8_STAGE(PG8_SB(1, 1), cB + hstep + kstep, voffB);
        PG8_WAIT_V(6); PG8_BAR;
    }
    for (;;) {
        const bool has_next = S.next(ui + 1, nxt);
        const char* nA = has_next ? (const char*)g.A + (size_t)nxt.pm * tstepA : cA; const char* nB = has_next ? (const char*)g.Bt + (size_t)nxt.pn * tstep : cB;
        for (int t = 0; t < nt; t += 2) {
            if constexpr (Epi::HAS_MID) { if (t == (nt >> 1)) E.mid(acc, cur, wr, wc, fr, fq); }
            const bool last = (t == nt - 2);
            const char* a1 = cA + (size_t)(t + 1) * kstep;
            const char* a2 = last ? nA : cA + (size_t)(t + 2) * kstep; const char* b2 = last ? nB : cB + (size_t)(t + 2) * kstep;
            const char* a3 = a2 + kstep; const char* b3 = b2 + kstep;
            if (last && has_next) S.a_ready(nxt);
            if constexpr (SP2) {
            PG8_LDB(B0, 0, 0); PG8_LDB(B1, 0, 1); PG8_SCHED; PG8_LDA(At, 0, 0); PG8_STAGE(PG8_SA(1, 1), a1 + hstepA, voffA);
            PG8_WAIT_V(8); PG8_WAIT_L(0); PG8_BAR; PG8_MMA(0, 0, At, B0); PG8_MMA(0, 1, At, B1); PG8_BAR; PG8_SCHED;
            PG8_LDA(At, 0, 1); PG8_STAGE(PG8_SB(0, 0), b2, voffB); PG8_STAGE(PG8_SB(0, 1), b2 + hstep, voffB); PG8_STAGE(PG8_SA(0, 0), a2, voffA);
            PG8_WAIT_V(8); PG8_WAIT_L(0); PG8_BAR; PG8_MMA(1, 0, At, B0); PG8_MMA(1, 1, At, B1); PG8_BAR; PG8_SCHED;
            PG8_LDB(B0, 1, 0); PG8_LDB(B1, 1, 1); PG8_SCHED; PG8_LDA(At, 1, 0); PG8_STAGE(PG8_SA(0, 1), a2 + hstepA, voffA);
            PG8_WAIT_V(8); PG8_WAIT_L(0); PG8_BAR; PG8_MMA(0, 0, At, B0); PG8_MMA(0, 1, At, B1); PG8_BAR; PG8_SCHED;
            PG8_LDA(At, 1, 1); PG8_STAGE(PG8_SB(1, 0), b3, voffB); PG8_STAGE(PG8_SB(1, 1), b3 + hstep, voffB); PG8_STAGE(PG8_SA(1, 0), a3, voffA);
            PG8_WAIT_V(8); PG8_WAIT_L(0); PG8_BAR; PG8_MMA(1, 0, At, B0); PG8_MMA(1, 1, At, B1); PG8_BAR; PG8_SCHED;
            } else {
            PG8_LDB(B0, 0, 0); PG8_SCHED; PG8_LDA(At, 0, 0); PG8_STAGE(PG8_SA(1, 1), a1 + hstepA, voffA);
            PG8_WAIT_L(8); PG8_BAR; PG8_WAIT_L(0); PG8_MMA(0, 0, At, B0); PG8_BAR; PG8_SCHED;
            PG8_LDB(B1, 0, 1); PG8_STAGE(PG8_SB(0, 0), b2, voffB);
            PG8_BAR; PG8_WAIT_L(0); PG8_MMA(0, 1, At, B1); PG8_BAR;
            PG8_LDA(At, 0, 1); PG8_STAGE(PG8_SA(0, 0), a2, voffA);
            PG8_BAR; PG8_WAIT_L(0); PG8_MMA(1, 0, At, B0); PG8_BAR; PG8_SCHED;
            PG8_STAGE(PG8_SB(0, 1), b2 + hstep, voffB);
            PG8_WAIT_V(6); PG8_BAR; PG8_MMA(1, 1, At, B1); PG8_BAR;
            PG8_LDB(B0, 1, 0); PG8_SCHED; PG8_LDA(At, 1, 0); PG8_STAGE(PG8_SA(0, 1), a2 + hstepA, voffA);
            PG8_WAIT_L(8); PG8_BAR; PG8_WAIT_L(0); PG8_MMA(0, 0, At, B0); PG8_BAR; PG8_SCHED;
            PG8_LDB(B1, 1, 1); PG8_STAGE(PG8_SB(1, 0), b3, voffB);
            PG8_BAR; PG8_WAIT_L(0); PG8_MMA(0, 1, At, B1); PG8_BAR;
            PG8_LDA(At, 1, 1); PG8_STAGE(PG8_SA(1, 0), a3, voffA);
            PG8_BAR; PG8_WAIT_L(0); PG8_MMA(1, 0, At, B0); PG8_BAR; PG8_SCHED;
            PG8_STAGE(PG8_SB(1, 1), b3 + hstep, voffB);
            PG8_WAIT_V(6); PG8_BAR; PG8_MMA(1, 1, At, B1); PG8_BAR;
            }
        }
        if constexpr (ALIGN_EPI) { if (wr == 0) PG8_BAR; }
        if constexpr (I8) {
            f32x4 csv[2][2];
#pragma unroll
            for (int bj = 0; bj < 2; ++bj)
#pragma unroll
                for (int n = 0; n < 2; ++n) csv[bj][n] = *(const f32x4*)(g.cs + cur.pn * BM + bj * HALF + wc * 32 + (Epi::PERM ? 8 * fq + 4 * n : 16 * n + 4 * fq));
#pragma unroll
            for (int ai = 0; ai < 2; ++ai)
#pragma unroll
                for (int m = 0; m < 4; ++m) { const float rsv = g.rs[cur.pm * BM + ai * HALF + wr * 64 + m * 16 + fr];
#pragma unroll
                    for (int bj = 0; bj < 2; ++bj)
#pragma unroll
                        for (int n = 0; n < 2; ++n) { const i32x4 iv = __builtin_bit_cast(i32x4, acc[ai][bj][m][n]); f32x4 fv;
                            fv[0] = (float)iv[0]; fv[1] = (float)iv[1]; fv[2] = (float)iv[2]; fv[3] = (float)iv[3];
                            acc[ai][bj][m][n] = fv * rsv * csv[bj][n]; } }
        }
        if constexpr (!Epi::AFTER_DRAIN) { E(acc, cur, wr, wc, fr, fq); S.done(cur); }
        if (!has_next) break;
#pragma unroll
        for (int a = 0; a < 2; ++a)
#pragma unroll
            for (int b = 0; b < 2; ++b)
#pragma unroll
                for (int m = 0; m < 4; ++m)
#pragma unroll
                    for (int n = 0; n < 2; ++n) acc[a][b][m][n] = (f32x4){0.f, 0.f, 0.f, 0.f};
        cur = nxt; cA = nA; cB = nB; ++ui;
        if constexpr (ALIGN_EPI) { if (wr == 1) PG8_BAR; }
    }
    PG8_WAIT_V(0);
    if constexpr (!ALIGN_EPI) { if (wr == 0) PG8_BAR; }
    PG8_BAR;
    if constexpr (Epi::AFTER_DRAIN) { E.fused(acc, cur, wr, wc, fr, fq, lds, wid, lane); S.done(cur); }
#undef PG8_SA
#undef PG8_SB
#undef PG8_STAGE
#undef PG8_LDA
#undef PG8_LDB
#undef PG8_MMA
#undef PG8_WAIT_V
#undef PG8_WAIT_L
#undef PG8_BAR
#undef PG8_SCHED
}
}
#ifndef PG8_SP2
#define PG8_SP2 true
#endif
#ifndef PG8_ALIGN
#define PG8_ALIGN true
#endif

constexpr int NWAVES = 8;
constexpr int N_PHASES = 8;
#define SLSH (NSL == 4 ? 12 : NSL == 2 ? 13 : NSL == 64 ? 8 : NSL == 32 ? 9 : NSL == 16 ? 10 : 11)

constexpr int NB = 2, SEQ = 8192, D = 1024, M = NB * SEQ;
constexpr int NZ = 3840;
constexpr float EPS = 1e-6f;
constexpr int AB_LD = 1024;

constexpr size_t MiB = 1u << 20;
constexpr size_t WS_CTL = 0, CTL_ZERO_BYTES = 65536;
constexpr size_t WS_WIN = 1 * MiB;
constexpr size_t WS_WPA = 9 * MiB;
constexpr size_t WS_WOUT = 11 * MiB;
constexpr size_t WS_WQ = 13 * MiB;
constexpr size_t WS_K1 = 17 * MiB;
constexpr size_t WS_K2 = 17 * MiB + 32768;
constexpr size_t WS_WS = 17 * MiB + 65536;
constexpr size_t WS_U = 18 * MiB;
constexpr size_t WS_V = 34 * MiB;
constexpr size_t WS_G1 = 36 * MiB;
constexpr size_t WS_G2 = 68 * MiB;
constexpr size_t WS_G3 = 132 * MiB;
constexpr size_t WS_Q = 164 * MiB;
constexpr size_t WS_KV = 180 * MiB;
constexpr size_t WS_GU = 188 * MiB;
constexpr size_t WS_GV = 204 * MiB;
constexpr size_t WS_HSC = 220 * MiB;
constexpr size_t WS_END = 221 * MiB;
constexpr int CW_BAR = 0;

constexpr int RING_BYTES = 131072;
constexpr int MISC_OFF = 143360;
constexpr int LDS_BYTES = 147456;

#define GAS __attribute__((address_space(1)))
#define LAS __attribute__((address_space(3)))
typedef unsigned short bf16;
typedef unsigned v4u __attribute__((ext_vector_type(4)));
typedef unsigned v2u __attribute__((ext_vector_type(2)));
typedef float f32x4 __attribute__((ext_vector_type(4)));
typedef _Float16 h2 __attribute__((ext_vector_type(2)));
typedef GAS unsigned gu32;
typedef __bf16 bf16x2_t __attribute__((ext_vector_type(2)));
#define RLX_AGENT __ATOMIC_RELAXED, __HIP_MEMORY_SCOPE_AGENT
#define LDS_WAIT() asm volatile("s_waitcnt lgkmcnt(0)" ::: "memory")
#define VM_WAIT() asm volatile("s_waitcnt vmcnt(0)" ::: "memory")
__device__ __forceinline__ unsigned f2bf(float f) { unsigned u = __builtin_bit_cast(unsigned, f); return (u + 0x7fffu + ((u >> 16) & 1u)) >> 16; }
__device__ __forceinline__ unsigned pk2(float lo, float hi) { return f2bf(lo) | (f2bf(hi) << 16); }
__device__ __forceinline__ float bflo(unsigned w) { return __builtin_bit_cast(float, w << 16); }
__device__ __forceinline__ float bfhi(unsigned w) { return __builtin_bit_cast(float, w & 0xffff0000u); }
__device__ __forceinline__ float bf2f(bf16 h) { return __builtin_bit_cast(float, (unsigned)h << 16); }
__device__ __forceinline__ float dot2bf(unsigned a, unsigned b, float c) { return __builtin_amdgcn_fdot2_f32_bf16(__builtin_bit_cast(bf16x2_t, a), __builtin_bit_cast(bf16x2_t, b), c, false); }
__device__ __forceinline__ float gelu_tanh(float v) {
    const float t2 = v * (-2.302208198f + (-0.1029432397f) * v * v);
    return v * __builtin_amdgcn_rcpf(1.0f + __builtin_amdgcn_exp2f(t2));
}
__device__ __forceinline__ float sigmoid_f(float v) { return __builtin_amdgcn_rcpf(1.0f + __builtin_amdgcn_exp2f(-1.4426950409f * v)); }
template <int CTRL> __device__ __forceinline__ float dppmov(float v) { return __builtin_bit_cast(float, __builtin_amdgcn_update_dpp(0, __builtin_bit_cast(int, v), CTRL, 0xF, 0xF, false)); }
__device__ __forceinline__ float row16_sum(float v) {
    v += dppmov<0xB1>(v);
    v += dppmov<0x4E>(v);
    v += dppmov<0x141>(v);
    v += dppmov<0x140>(v);
    return v;
}
__device__ __forceinline__ float xor32_f(float v) {
    const unsigned u = __builtin_bit_cast(unsigned, v);
    auto rr = __builtin_amdgcn_permlane32_swap(u, u, false, false);
    const unsigned r0 = rr[0], r1 = rr[1];
    return __builtin_bit_cast(float, (__lane_id() & 32) ? r0 : r1);
}
__device__ __forceinline__ float wave_sum(float v) {
    v = row16_sum(v);
    v += __builtin_bit_cast(float, __builtin_amdgcn_ds_swizzle(__builtin_bit_cast(int, v), 0x401F));
    const unsigned u = __builtin_bit_cast(unsigned, v);
    auto rr = __builtin_amdgcn_permlane32_swap(u, u, false, false);
    const unsigned r0 = rr[0], r1 = rr[1];
    return __builtin_bit_cast(float, r0) + __builtin_bit_cast(float, r1);
}
__device__ __forceinline__ float wave_max(float v) {
    v = fmaxf(v, dppmov<0xB1>(v)); v = fmaxf(v, dppmov<0x4E>(v)); v = fmaxf(v, dppmov<0x141>(v)); v = fmaxf(v, dppmov<0x140>(v));
    v = fmaxf(v, __builtin_bit_cast(float, __builtin_amdgcn_ds_swizzle(__builtin_bit_cast(int, v), 0x401F)));
    const unsigned u = __builtin_bit_cast(unsigned, v);
    auto rr = __builtin_amdgcn_permlane32_swap(u, u, false, false);
    const unsigned r0 = rr[0], r1 = rr[1];
    return fmaxf(__builtin_bit_cast(float, r0), __builtin_bit_cast(float, r1));
}
__device__ const unsigned char T5B[128] = {0, 1, 2, 3, 4, 5, 6, 7, 8, 9, 10, 11, 12, 13, 14, 15, 16, 16, 16, 17, 17, 18, 18, 18, 19, 19, 19, 20, 20, 20, 20, 21, 21, 21, 21, 22, 22, 22, 22, 22, 23, 23, 23, 23, 23, 23, 24, 24, 24, 24, 24, 24, 25, 25, 25, 25, 25, 25, 25, 26, 26, 26, 26, 26, 26, 26, 26, 27, 27, 27, 27, 27, 27, 27, 27, 27, 27, 28, 28, 28, 28, 28, 28, 28, 28, 28, 28, 29, 29, 29, 29, 29, 29, 29, 29, 29, 29, 29, 29, 30, 30, 30, 30, 30, 30, 30, 30, 30, 30, 30, 30, 30, 30, 31, 31, 31, 31, 31, 31, 31, 31, 31, 31, 31, 31, 31, 31, 31};
#define XB_TMO      128
#define XB_XCNT(j)  (256  + 64 * (j))
#define XB_XSUB(j)  (1280 + 64 * (j))
#define XB_XGEN(j)  (2304 + 64 * (j))
#define XB_TOP      3328
#define XB_TOPGEN   3392
#define XCD_BAR_WORDS 3456
#define XB_SPIN_CAP (1u << 18)

__device__ __forceinline__ unsigned xb_ld(unsigned* p)              { return __hip_atomic_load(p, __ATOMIC_RELAXED, __HIP_MEMORY_SCOPE_AGENT); }
__device__ __forceinline__ unsigned xb_add(unsigned* p, unsigned v) { return __hip_atomic_fetch_add(p, v, __ATOMIC_RELAXED, __HIP_MEMORY_SCOPE_AGENT); }
__device__ __forceinline__ unsigned xb_xcc_id() { return (unsigned)__builtin_amdgcn_s_getreg((3 << 11) | 20) & 0xFu; }
#define XB_SPIN(cond, bar) do { unsigned _sp = 0; while (cond) { __builtin_amdgcn_s_sleep(1); \
    if ((++_sp & 255u) == 0u) { if (xb_ld(&(bar)[XB_TMO])) break; if (_sp > XB_SPIN_CAP) { atomicAdd(&(bar)[XB_TMO], 1u); break; } } } } while (0)

struct XcdBarrier {
    unsigned* bar; unsigned x;
    volatile LAS unsigned* st;
};

__device__ __forceinline__ XcdBarrier xcd_barrier_post(unsigned* bar, volatile LAS unsigned* st) {
    XcdBarrier b; b.bar = bar; b.x = xb_xcc_id(); b.st = st;
    if (threadIdx.x == 0) (void)xb_add(&bar[XB_XCNT(b.x)], 1u);
    return b;
}
__device__ __forceinline__ void xcd_barrier_complete(unsigned* bar, unsigned x, unsigned& nloc, unsigned& nx) {
    const unsigned G = gridDim.x * gridDim.y * gridDim.z;
    unsigned sum, cnt, mine, sp = 0u;
    for (;;) {
        sum = 0u; cnt = 0u; mine = 0u;
#pragma unroll
        for (unsigned j = 0; j < 16; ++j) { const unsigned c = xb_ld(&bar[XB_XCNT(j)]); sum += c; cnt += (c > 0u) ? 1u : 0u; mine = (j == x) ? c : mine; }
        if (sum == G) break;
        __builtin_amdgcn_s_sleep(1);
        if ((++sp & 255u) == 0u) { if (xb_ld(&bar[XB_TMO])) break; if (sp > XB_SPIN_CAP) { atomicAdd(&bar[XB_TMO], 1u); break; } }
    }
    nloc = mine > 0u ? mine : 1u; nx = cnt > 0u ? cnt : 1u;
}

__device__ __forceinline__ void xcd_barrier(const XcdBarrier& b) {
    asm volatile("s_waitcnt vmcnt(0)" ::: "memory");
    __syncthreads();
    if (threadIdx.x == 0) {
        unsigned* bar = b.bar;
        __builtin_amdgcn_s_waitcnt(0);
        unsigned nloc = b.st[0], nx = b.st[1];
        if (nloc == 0u) { xcd_barrier_complete(bar, b.x, nloc, nx); b.st[0] = nloc; b.st[1] = nx; }
        const unsigned old = xb_add(&bar[XB_XSUB(b.x)], 1u);
        const unsigned gen = old / nloc;
        if (old + 1u == (gen + 1u) * nloc) {
            __builtin_amdgcn_fence(__ATOMIC_RELEASE, "agent");
            asm volatile("s_waitcnt vmcnt(0)" ::: "memory");
            const unsigned og = xb_add(&bar[XB_TOP], 1u);
            const unsigned tg = og / nx;
            if (og + 1u == (tg + 1u) * nx) xb_add(&bar[XB_TOPGEN], 1u);
            else XB_SPIN(xb_ld(&bar[XB_TOPGEN]) == tg, bar);
            __builtin_amdgcn_fence(__ATOMIC_ACQUIRE, "agent");
            xb_add(&bar[XB_XGEN(b.x)], 1u);
            asm volatile("s_waitcnt vmcnt(0)" ::: "memory");
        } else {
            XB_SPIN(xb_ld(&bar[XB_XGEN(b.x)]) == gen, bar);
            __builtin_amdgcn_fence(__ATOMIC_ACQUIRE, "agent");
            asm volatile("s_waitcnt vmcnt(0)" ::: "memory");
        }
    }
    __syncthreads();
}
#define ST16(PTR, VAL) (*(PTR) = (VAL))
namespace pg8 {
struct EpiZ {
    static constexpr bool PERM = true, AFTER_DRAIN = false, HAS_MID = false;
    bf16_t *Q, *KV, *GU, *GV, *GA, *GB;
    __device__ __forceinline__ void operator()(const f32x4 (&acc)[2][2][4][2], const Unit& u, int wr, int wc, int fr, int fq) const {
        const int pn = u.pn; bf16_t* base; int ldc, colt, act;
        if (pn < 2)       { base = Q;  ldc = 512;  colt = pn * 256;        act = 0; }
        else if (pn == 2) { base = KV; ldc = 256;  colt = 0;               act = 0; }
        else if (pn < 5)  { base = GU; ldc = 512;  colt = (pn - 3) * 256;  act = 1; }
        else if (pn < 7)  { base = GV; ldc = 512;  colt = (pn - 5) * 256;  act = 1; }
        else if (pn < 11) { base = GA; ldc = 2048; colt = (pn - 7) * 256;  act = 2; }
        else              { base = GB; ldc = 2048; colt = (pn - 11) * 256; act = 2; }
        const int row0 = u.pm * BM + wr * 64 + fr, col0 = colt + wc * 32 + 8 * fq;
#pragma unroll
        for (int ai = 0; ai < 2; ++ai)
#pragma unroll
            for (int m = 0; m < 4; ++m) { bf16_t* rowp = base + (size_t)(row0 + ai * HALF + m * 16) * ldc + col0;
#pragma unroll
                for (int bj = 0; bj < 2; ++bj) { f32x4 v0 = acc[ai][bj][m][0], v1 = acc[ai][bj][m][1];
                    if (act == 1) {
#pragma unroll
                        for (int e = 0; e < 4; ++e) { v0[e] = gelu_tanh(v0[e]); v1[e] = gelu_tanh(v1[e]); }
                    } else if (act == 2) {
#pragma unroll
                        for (int e = 0; e < 4; ++e) { v0[e] = sigmoid_f(v0[e]); v1[e] = sigmoid_f(v1[e]); }
                    }
                    u32x4 w; w.x = cvt_pk_bf16(v0[0], v0[1]); w.y = cvt_pk_bf16(v0[2], v0[3]); w.z = cvt_pk_bf16(v1[0], v1[1]); w.w = cvt_pk_bf16(v1[2], v1[3]);
                    ST16((u32x4*)(rowp + bj * HALF), w); } }
    }
};
struct EpiMerge2 {
    static constexpr bool PERM = true, AFTER_DRAIN = false, HAS_MID = true;
    const bf16_t* ga; unsigned char* out8; float* rs;
    unsigned* slots; unsigned* cnt; unsigned* bar; LAS float* tbl;
    __device__ __forceinline__ void mid(f32x4 (&acc)[2][2][4][2], const Unit& u, int wr, int wc, int fr, int fq) const {
        int row0 = u.pm * BM + wr * 64 + fr, col0 = u.pn * BM + wc * 32 + 8 * fq;
        asm volatile("" : "+v"(row0), "+v"(col0));
#pragma unroll
        for (int ai = 0; ai < 2; ++ai)
#pragma unroll
          for (int m0 = 0; m0 < 4; m0 += MIDB) {
            u32x4 ga_[MIDB][2], gb_[MIDB][2];
#pragma unroll
            for (int mm = 0; mm < MIDB; ++mm) { const bf16_t* gp = ga + (size_t)(row0 + ai * HALF + (m0 + mm) * 16) * 2048 + col0;
#pragma unroll
                for (int bj = 0; bj < 2; ++bj) { ga_[mm][bj] = *(const u32x4*)(gp + bj * HALF); gb_[mm][bj] = *(const u32x4*)(gp + 1024 + bj * HALF); } }
#pragma unroll
            for (int mm = 0; mm < MIDB; ++mm)
#pragma unroll
                for (int bj = 0; bj < 2; ++bj) { const u32x4 a = ga_[mm][bj], b = gb_[mm][bj]; const int m = m0 + mm;
                    f32x4 r0, r1;
                    r0[0] = bflo(a.x) * __builtin_amdgcn_rcpf(fmaxf(bflo(b.x), 1e-20f)); r0[1] = bfhi(a.x) * __builtin_amdgcn_rcpf(fmaxf(bfhi(b.x), 1e-20f)); r0[2] = bflo(a.y) * __builtin_amdgcn_rcpf(fmaxf(bflo(b.y), 1e-20f)); r0[3] = bfhi(a.y) * __builtin_amdgcn_rcpf(fmaxf(bfhi(b.y), 1e-20f));
                    r1[0] = bflo(a.z) * __builtin_amdgcn_rcpf(fmaxf(bflo(b.z), 1e-20f)); r1[1] = bfhi(a.z) * __builtin_amdgcn_rcpf(fmaxf(bfhi(b.z), 1e-20f)); r1[2] = bflo(a.w) * __builtin_amdgcn_rcpf(fmaxf(bflo(b.w), 1e-20f)); r1[3] = bfhi(a.w) * __builtin_amdgcn_rcpf(fmaxf(bfhi(b.w), 1e-20f));
                    acc[ai][bj][m][0] = acc[ai][bj][m][0] * r0; acc[ai][bj][m][1] = acc[ai][bj][m][1] * r1; }
            asm volatile("" ::: "memory");
          }
    }
    __device__ __forceinline__ void operator()(f32x4 (&acc)[2][2][4][2], const Unit& u, int wr, int wc, int fr, int fq) const {
        int tid = threadIdx.x;
        int rl0 = wr * 64 + fr, col0 = u.pn * BM + wc * 32 + 8 * fq;
        asm volatile("" : "+v"(rl0), "+v"(col0), "+v"(tid));
        u32x4 gb_[2][4][2];
#pragma unroll
        for (int ai = 0; ai < 2; ++ai)
#pragma unroll
            for (int m = 0; m < 4; ++m)
#pragma unroll
                for (int bj = 0; bj < 2; ++bj) gb_[ai][m][bj] = *(const u32x4*)(ga + (size_t)(u.pm * BM + rl0 + ai * HALF + m * 16) * 2048 + 1024 + col0 + bj * HALF);
#pragma unroll
        for (int ai = 0; ai < 2; ++ai)
#pragma unroll
            for (int m = 0; m < 4; ++m) { const int rl = rl0 + ai * HALF + m * 16; float mx = 0.f;
#pragma unroll
                for (int bj = 0; bj < 2; ++bj) { const u32x4 b = gb_[ai][m][bj]; f32x4 v0 = acc[ai][bj][m][0], v1 = acc[ai][bj][m][1];
                    v0[0] *= fmaxf(bflo(b.x), 1e-20f); v0[1] *= fmaxf(bfhi(b.x), 1e-20f); v0[2] *= fmaxf(bflo(b.y), 1e-20f); v0[3] *= fmaxf(bfhi(b.y), 1e-20f);
                    v1[0] *= fmaxf(bflo(b.z), 1e-20f); v1[1] *= fmaxf(bfhi(b.z), 1e-20f); v1[2] *= fmaxf(bflo(b.w), 1e-20f); v1[3] *= fmaxf(bfhi(b.w), 1e-20f);
                    acc[ai][bj][m][0] = v0; acc[ai][bj][m][1] = v1;
                    mx = fmaxf(mx, fmaxf(fmaxf(fmaxf(fabsf(v0[0]), fabsf(v0[1])), fmaxf(fabsf(v0[2]), fabsf(v0[3]))), fmaxf(fmaxf(fabsf(v1[0]), fabsf(v1[1])), fmaxf(fabsf(v1[2]), fabsf(v1[3]))))); }
                mx = fmaxf(mx, __builtin_bit_cast(float, __builtin_amdgcn_ds_swizzle(__builtin_bit_cast(int, mx), 0x401F))); mx = fmaxf(mx, xor32_f(mx));
                if (fq == 0) tbl[rl * 4 + wc] = mx; }
        __syncthreads();
        float mx = 0.f;
        if (tid < 256) { const f32x4 t0 = *(const LAS f32x4*)(tbl + tid * 4); mx = fmaxf(fmaxf(t0[0], t0[1]), fmaxf(t0[2], t0[3]));
            __hip_atomic_store(slots + ((size_t)(u.pm * 4 + u.pn) * 256 + tid), __builtin_bit_cast(unsigned, mx), __ATOMIC_RELAXED, __HIP_MEMORY_SCOPE_AGENT); }
        asm volatile("s_waitcnt vmcnt(0)" ::: "memory");
        __syncthreads();
        if (tid == 0) { unsigned* c = cnt + 16 * u.pm; (void)xb_add(c, 1u); XB_SPIN(xb_ld(c) < 4u, bar); }
        __syncthreads();
        if (tid < 256) {
#pragma unroll
            for (int p = 0; p < 4; ++p) if (p != u.pn) mx = fmaxf(mx, __builtin_bit_cast(float, __hip_atomic_load(slots + ((size_t)(u.pm * 4 + p) * 256 + tid), __ATOMIC_RELAXED, __HIP_MEMORY_SCOPE_AGENT)));
            const bool tiny = mx < 1e-30f;
            tbl[1024 + tid] = tiny ? 0.f : 127.0f / mx;
            if (u.pn == 0) rs[u.pm * BM + tid] = tiny ? 0.f : mx * (1.0f / 127.0f); }
        __syncthreads();
#pragma unroll
        for (int ai = 0; ai < 2; ++ai)
#pragma unroll
            for (int m = 0; m < 4; ++m) { const int rl = rl0 + ai * HALF + m * 16; const size_t rg = (size_t)(u.pm * BM + rl) * 1024; const float sc = tbl[1024 + rl];
#pragma unroll
                for (int bj = 0; bj < 2; ++bj) { const f32x4 h0 = acc[ai][bj][m][0] * sc, h1 = acc[ai][bj][m][1] * sc; unsigned q0 = 0u, q1 = 0u;
#pragma unroll
                    for (int e = 0; e < 4; ++e) { q0 |= (unsigned)((int)__builtin_rintf(h0[e]) & 255) << (8 * e); q1 |= (unsigned)((int)__builtin_rintf(h1[e]) & 255) << (8 * e); }
                    *(unsigned long long*)(out8 + rg + col0 + bj * HALF) = (unsigned long long)q0 | ((unsigned long long)q1 << 32); } }
    }
};
struct EpiResB {
    static constexpr bool PERM = true, AFTER_DRAIN = false, HAS_MID = false;
    const float* base; bf16_t* Cb;
    __device__ __forceinline__ void operator()(const f32x4 (&acc)[2][2][4][2], const Unit& u, int wr, int wc, int fr, int fq) const {
        const int row0 = u.pm * BM + wr * 64 + fr, col0 = u.pn * BM + wc * 32 + 8 * fq;
#pragma unroll
        for (int ai = 0; ai < 2; ++ai)
#pragma unroll
            for (int m = 0; m < 4; ++m) { const size_t ro = (size_t)(row0 + ai * HALF + m * 16) * 1024 + col0;
#pragma unroll
                for (int bj = 0; bj < 2; ++bj) { const f32x4 v0 = *(const f32x4*)(base + ro + bj * HALF) + acc[ai][bj][m][0], v1 = *(const f32x4*)(base + ro + bj * HALF + 4) + acc[ai][bj][m][1];
                    u32x4 w; w.x = cvt_pk_bf16(v0[0], v0[1]); w.y = cvt_pk_bf16(v0[2], v0[3]); w.z = cvt_pk_bf16(v1[0], v1[1]); w.w = cvt_pk_bf16(v1[2], v1[3]);
                    ST16((u32x4*)(Cb + ro + bj * HALF), w); } }
    }
};
struct EpiResLn {
    static constexpr bool PERM = true, AFTER_DRAIN = false, HAS_MID = false;
    const float* base; const float* w; bf16_t* Cb; unsigned char* hnq; float* hsc;
    unsigned long long* slots;
    unsigned* cnt;
    unsigned* bar;
    LAS float* tbl;
    __device__ __forceinline__ void operator()(f32x4 (&acc)[2][2][4][2], const Unit& u, int wr, int wc, int fr, int fq) const {
        int tid = threadIdx.x;
        int rl0 = wr * 64 + fr, col0 = u.pn * BM + wc * 32 + 8 * fq;
        asm volatile("" : "+v"(rl0), "+v"(col0), "+v"(tid));
        f32x4 wv[2][2];
#pragma unroll
        for (int bj = 0; bj < 2; ++bj) { wv[bj][0] = *(const f32x4*)(w + col0 + bj * HALF); wv[bj][1] = *(const f32x4*)(w + col0 + bj * HALF + 4); }
#pragma unroll
        for (int ai = 0; ai < 2; ++ai)
#pragma unroll
          for (int m0 = 0; m0 < 4; m0 += XB) {
            f32x4 xv[XB][2][2];
#pragma unroll
            for (int mm = 0; mm < XB; ++mm) { const size_t ro = (size_t)(u.pm * BM + rl0 + ai * HALF + (m0 + mm) * 16) * 1024 + col0;
#pragma unroll
                for (int bj = 0; bj < 2; ++bj) { xv[mm][bj][0] = *(const f32x4*)(base + ro + bj * HALF); xv[mm][bj][1] = *(const f32x4*)(base + ro + bj * HALF + 4); } }
#pragma unroll
            for (int mm = 0; mm < XB; ++mm) { const int m = m0 + mm; const int rl = rl0 + ai * HALF + m * 16;
                float ss = 0.f, mx = 0.f;
#pragma unroll
                for (int bj = 0; bj < 2; ++bj) { const f32x4 v0 = xv[mm][bj][0] + acc[ai][bj][m][0], v1 = xv[mm][bj][1] + acc[ai][bj][m][1];
                    acc[ai][bj][m][0] = v0; acc[ai][bj][m][1] = v1;
                    ss += ((v0[0] * v0[0] + v0[1] * v0[1]) + (v0[2] * v0[2] + v0[3] * v0[3])) + ((v1[0] * v1[0] + v1[1] * v1[1]) + (v1[2] * v1[2] + v1[3] * v1[3]));
                    const f32x4 a0 = v0 * wv[bj][0], a1 = v1 * wv[bj][1];
                    mx = fmaxf(mx, fmaxf(fmaxf(fmaxf(fabsf(a0[0]), fabsf(a0[1])), fmaxf(fabsf(a0[2]), fabsf(a0[3]))), fmaxf(fmaxf(fabsf(a1[0]), fabsf(a1[1])), fmaxf(fabsf(a1[2]), fabsf(a1[3]))))); }
                ss += __builtin_bit_cast(float, __builtin_amdgcn_ds_swizzle(__builtin_bit_cast(int, ss), 0x401F)); mx = fmaxf(mx, __builtin_bit_cast(float, __builtin_amdgcn_ds_swizzle(__builtin_bit_cast(int, mx), 0x401F)));
                ss += xor32_f(ss); mx = fmaxf(mx, xor32_f(mx));
                if (fq == 0) { tbl[(rl * 4 + wc) * 2] = ss; tbl[(rl * 4 + wc) * 2 + 1] = mx; } }
            asm volatile("" ::: "memory");
          }
        __syncthreads();
        float ss = 0.f, mx = 0.f;
        if (tid < 256) { const f32x4 t0 = *(const LAS f32x4*)(tbl + tid * 8), t1 = *(const LAS f32x4*)(tbl + tid * 8 + 4);
            ss = (t0[0] + t0[2]) + (t1[0] + t1[2]); mx = fmaxf(fmaxf(t0[1], t0[3]), fmaxf(t1[1], t1[3]));
            const unsigned long long pk = (unsigned long long)__builtin_bit_cast(unsigned, ss) | ((unsigned long long)__builtin_bit_cast(unsigned, mx) << 32);
            __hip_atomic_store(slots + ((size_t)(u.pm * 4 + u.pn) * 256 + tid), pk, __ATOMIC_RELAXED, __HIP_MEMORY_SCOPE_AGENT); }
        asm volatile("s_waitcnt vmcnt(0)" ::: "memory");
        __syncthreads();
        if (tid == 0) { unsigned* c = cnt + 16 * u.pm; (void)xb_add(c, 1u); XB_SPIN(xb_ld(c) < 4u, bar); }
        __syncthreads();
        if (tid < 256) {
#pragma unroll
            for (int p = 0; p < 4; ++p) if (p != u.pn) { const unsigned long long pk = __hip_atomic_load(slots + ((size_t)(u.pm * 4 + p) * 256 + tid), __ATOMIC_RELAXED, __HIP_MEMORY_SCOPE_AGENT);
                ss += __builtin_bit_cast(float, (unsigned)pk); mx = fmaxf(mx, __builtin_bit_cast(float, (unsigned)(pk >> 32))); }
            const float rstd = 1.0f / sqrtf(ss * (1.0f / 1024.0f) + 1e-6f); const bool tiny = mx < 1e-30f;
            tbl[2048 + tid] = tiny ? 0.f : 119.0f / mx;
            if (u.pn == 0) hsc[u.pm * BM + tid] = tiny ? 0.f : mx * rstd * (1.0f / 119.0f); }
        __syncthreads();
#pragma unroll
        for (int ai = 0; ai < 2; ++ai)
#pragma unroll
            for (int m = 0; m < 4; ++m) { const int rl = rl0 + ai * HALF + m * 16; const size_t rg = (size_t)(u.pm * BM + rl) * 1024; const float sc = tbl[2048 + rl];
#pragma unroll
                for (int bj = 0; bj < 2; ++bj) { const f32x4 v0 = acc[ai][bj][m][0], v1 = acc[ai][bj][m][1]; const int c = col0 + bj * HALF;
                    u32x4 xw; xw.x = cvt_pk_bf16(v0[0], v0[1]); xw.y = cvt_pk_bf16(v0[2], v0[3]); xw.z = cvt_pk_bf16(v1[0], v1[1]); xw.w = cvt_pk_bf16(v1[2], v1[3]);
                    ST16((u32x4*)(Cb + rg + c), xw);
                    const f32x4 h0 = v0 * wv[bj][0] * sc, h1 = v1 * wv[bj][1] * sc;
                    unsigned q0 = 0u, q1 = 0u;
#pragma unroll
                    for (int e = 0; e < 4; ++e) { q0 |= (unsigned)((int)__builtin_rintf(h0[e]) & 255) << (8 * e); q1 |= (unsigned)((int)__builtin_rintf(h1[e]) & 255) << (8 * e); }
                    *(unsigned long long*)(hnq + rg + c) = (unsigned long long)q0 | ((unsigned long long)q1 << 32); } }
    }
};
struct EpiPlain {
    static constexpr bool PERM = true, AFTER_DRAIN = false, HAS_MID = false;
    bf16_t* O; int ldc;
    __device__ __forceinline__ void operator()(const f32x4 (&acc)[2][2][4][2], const Unit& u, int wr, int wc, int fr, int fq) const {
        const int row0 = u.pm * BM + wr * 64 + fr, col0 = u.pn * BM + wc * 32 + 8 * fq;
#pragma unroll
        for (int ai = 0; ai < 2; ++ai)
#pragma unroll
            for (int m = 0; m < 4; ++m) { bf16_t* rowp = O + (size_t)(row0 + ai * HALF + m * 16) * ldc + col0;
#pragma unroll
                for (int bj = 0; bj < 2; ++bj) { const f32x4 v0 = acc[ai][bj][m][0], v1 = acc[ai][bj][m][1];
                    u32x4 w; w.x = cvt_pk_bf16(v0[0], v0[1]); w.y = cvt_pk_bf16(v0[2], v0[3]); w.z = cvt_pk_bf16(v1[0], v1[1]); w.w = cvt_pk_bf16(v1[2], v1[3]);
                    ST16((u32x4*)(rowp + bj * HALF), w); } }
    }
};
}

__device__ __forceinline__ void p0_transpose_item(const float* W, int K, int N, bf16* WT, LAS float* scr, int item, int lane, int ldk = 0, int koff = 0, const float* kscale = nullptr) {
    if (ldk == 0) ldk = K;
    const int nblk = N / 32, kb = item / nblk, nb = item % nblk, k0 = 64 * kb, n0 = 32 * nb;
#pragma unroll 8
    for (int i = 0; i < 32; ++i) { const int kk = 2 * i + (lane >> 5); scr[kk * 33 + (lane & 31)] = W[(size_t)(k0 + kk) * N + n0 + (lane & 31)] * (kscale ? kscale[k0 + kk] : 1.0f); }
    LDS_WAIT(); asm volatile("" ::: "memory");
    const int c = lane & 7;
#pragma unroll
    for (int j = 0; j < 4; ++j) { const int n = (lane >> 3) + 8 * j; const LAS float* s = scr + (8 * c) * 33 + n;
        v4u o; o.x = pk2(s[0 * 33], s[1 * 33]); o.y = pk2(s[2 * 33], s[3 * 33]); o.z = pk2(s[4 * 33], s[5 * 33]); o.w = pk2(s[6 * 33], s[7 * 33]);
        *(v4u*)(WT + (size_t)(n0 + n) * ldk + koff + k0 + 8 * c) = o; }
    LDS_WAIT(); asm volatile("" ::: "memory");
}
__device__ __forceinline__ void cvt_flat(const float* src, bf16* dst, size_t n, int gw, int NGW, int lane) {
    for (size_t i = (size_t)gw * 512 + lane * 8; i < n; i += (size_t)NGW * 512) {
        const f32x4 a = *(const f32x4*)(src + i), b = *(const f32x4*)(src + i + 4);
        v4u o; o.x = pk2(a[0], a[1]); o.y = pk2(a[2], a[3]); o.z = pk2(b[0], b[1]); o.w = pk2(b[2], b[3]);
        *(v4u*)(dst + i) = o;
    }
}


struct Ptrs {
    const float *x, *mix_w, *w_in, *rel_bias, *sinks, *w_pa, *ln_w, *ln_b, *w_s, *b_s, *w_pb, *w_out, *ffn_w, *w_q, *keys1, *keys2, *pu, *pv, *fin_w;
    float* out;
    unsigned char *U8, *V8, *XN8, *HNQ, *WIN8, *WQ8, *WOUT8, *MERGED8; float *USC, *VSC, *HSC, *XSC, *WINSC, *WQSC, *WOUTSC, *MSC;
    bf16 *WPAB, *K1, *K2, *WS, *AOUT, *BOUT, *X1B, *Q, *KV, *GU, *GV, *GA, *GB, *QP;
};

__device__ __forceinline__ void p0_quant_row(const Ptrs& P, const f32x4 (&v)[4], int rr, int lane) {
            const int tab = rr >> 14, row = rr & 16383;
            float mx = 0.f, ssq = 0.f;
#pragma unroll
            for (int j = 0; j < 4; ++j) { mx = fmaxf(mx, fmaxf(fmaxf(fabsf(v[j][0]), fabsf(v[j][1])), fmaxf(fabsf(v[j][2]), fabsf(v[j][3]))));
                ssq += (v[j][0] * v[j][0] + v[j][1] * v[j][1]) + (v[j][2] * v[j][2] + v[j][3] * v[j][3]); }
            mx = wave_max(mx); ssq = wave_sum(ssq);
            const float sd = sqrtf(ssq * (1.0f / 1024.0f));
            if (tab == 0) {
                const float step = fmaxf(Q4_USTEP * sd, mx * (1.0f / 14.0f)); const float qs = step > 1e-30f ? 1.0f / step : 0.f;
#pragma unroll
                for (int j = 0; j < 4; ++j) { unsigned pq = 0u;
#pragma unroll
                    for (int e = 0; e < 4; ++e) pq |= (unsigned)((int)fminf(fmaxf(__builtin_rintf(v[j][e] * qs), -7.0f), 7.0f) & 15) << (4 * e);
                    const unsigned nq = (unsigned)__builtin_amdgcn_update_dpp(0, (int)pq, 0xB1, 0xF, 0xF, false);
                    if ((lane & 1) == 0) *(unsigned*)(P.U8 + (size_t)row * 512 + 128 * j + 2 * lane) = pq | (nq << 16); }
                if (lane == 0) P.USC[row] = step;
            } else {
                const float un = fmaxf(Q4_VUNIT * sd, mx * (1.0f / 12.0f)); const float qs = un > 1e-30f ? 1.0f / un : 0.f;
                bool bad = false;
#pragma unroll
                for (int j = 0; j < 4; ++j) {
                    unsigned pq = __builtin_amdgcn_cvt_scalef32_pk_fp4_f32(0u, v[j][0] * qs, v[j][1] * qs, 1.0f, 0);
                    pq = __builtin_amdgcn_cvt_scalef32_pk_fp4_f32(pq, v[j][2] * qs, v[j][3] * qs, 1.0f, 1);
                    pq &= 0xffffu;
                    const unsigned nq = (unsigned)__builtin_amdgcn_update_dpp(0, (int)pq, 0xB1, 0xF, 0xF, false);
                    if ((lane & 1) == 0) *(unsigned*)(P.V8 + (size_t)row * 512 + 128 * j + 2 * lane) = pq | (nq << 16); }
                if (FP4_SELFCHECK && __ballot(bad) != 0ull) { if (lane == 0) P.VSC[row] = __builtin_nanf(""); }
                else if (lane == 0) P.VSC[row] = un;
            }
}
__device__ __forceinline__ unsigned pack_i8x4(float a, float b, float c, float d) {
    const int qa = (int)__builtin_rintf(a), qb = (int)__builtin_rintf(b), qc = (int)__builtin_rintf(c), qd = (int)__builtin_rintf(d);
    return (unsigned)(qa & 255) | ((unsigned)(qb & 255) << 8) | ((unsigned)(qc & 255) << 16) | ((unsigned)qd << 24);
}
__device__ __forceinline__ void p0_quant_wt_item(const float* W, int N, unsigned char* WT8, float* cs, int item, int lane, int wave, LAS float* cml) {
    const int n0 = 32 * item, c4 = lane & 7, kr = lane >> 3;
    const float* wp = W + (size_t)(128 * wave + 16 * kr) * N + n0 + 4 * c4;
    f32x4 v[16]; f32x4 mx = {0.f, 0.f, 0.f, 0.f};
#pragma unroll
    for (int t = 0; t < 16; ++t) v[t] = *(const f32x4*)(wp + (size_t)t * N);
#pragma unroll
    for (int t = 0; t < 16; ++t) { mx[0] = fmaxf(mx[0], fabsf(v[t][0])); mx[1] = fmaxf(mx[1], fabsf(v[t][1])); mx[2] = fmaxf(mx[2], fabsf(v[t][2])); mx[3] = fmaxf(mx[3], fabsf(v[t][3])); }
#pragma unroll
    for (int e = 0; e < 4; ++e) { float m_ = mx[e]; m_ = fmaxf(m_, __shfl_xor(m_, 8)); m_ = fmaxf(m_, __shfl_xor(m_, 16)); m_ = fmaxf(m_, __shfl_xor(m_, 32)); mx[e] = m_; }
    if (kr == 0) *(LAS f32x4*)(cml + wave * 32 + 4 * c4) = mx;
    __syncthreads();
#pragma unroll
    for (int w = 0; w < 8; ++w) { const f32x4 o = *(const LAS f32x4*)(cml + w * 32 + 4 * c4); mx[0] = fmaxf(mx[0], o[0]); mx[1] = fmaxf(mx[1], o[1]); mx[2] = fmaxf(mx[2], o[2]); mx[3] = fmaxf(mx[3], o[3]); }
    f32x4 inv;
#pragma unroll
    for (int e = 0; e < 4; ++e) inv[e] = mx[e] > 1e-30f ? 127.0f / mx[e] : 0.f;
    if (wave == 0 && kr == 0) *(f32x4*)(cs + n0 + 4 * c4) = mx * (1.0f / 127.0f);
#pragma unroll
    for (int e = 0; e < 4; ++e) { v4u o;
        o.x = pack_i8x4(v[0][e] * inv[e], v[1][e] * inv[e], v[2][e] * inv[e], v[3][e] * inv[e]); o.y = pack_i8x4(v[4][e] * inv[e], v[5][e] * inv[e], v[6][e] * inv[e], v[7][e] * inv[e]);
        o.z = pack_i8x4(v[8][e] * inv[e], v[9][e] * inv[e], v[10][e] * inv[e], v[11][e] * inv[e]); o.w = pack_i8x4(v[12][e] * inv[e], v[13][e] * inv[e], v[14][e] * inv[e], v[15][e] * inv[e]);
        *(v4u*)(WT8 + (size_t)(n0 + 4 * c4 + e) * 1024 + 128 * wave + 16 * kr) = o; }
    __syncthreads();
}
#define TAB_LOAD(V, RR) do { if ((RR) < 2 * 16384) { const float* src_ = (((RR) >> 14) ? P.pv : P.pu) + (size_t)((RR) & 16383) * 1024; \
        _Pragma("unroll") for (int j = 0; j < 4; ++j) V[j] = *(const f32x4*)(src_ + 4 * lane + 256 * j); } } while (0)
__device__ __forceinline__ void p0_prologue(LAS unsigned char* lds, const Ptrs& P, int vcu, int G, int lane, int wave) {
    LAS float* scr = (LAS float*)(lds + wave * 16384);
    const int gw = vcu * NWAVES + wave, NGW = G * NWAVES;
    for (int it = vcu; it < 216; it += G) {
        if (it < 120) p0_quant_wt_item(P.w_in, 3840, P.WIN8, P.WINSC, it, lane, wave, (LAS float*)(lds + 131072));
        else if (it < 184) p0_quant_wt_item(P.w_q, 2048, P.WQ8, P.WQSC, it - 120, lane, wave, (LAS float*)(lds + 131072));
        else p0_quant_wt_item(P.w_out, 1024, P.WOUT8, P.WOUTSC, it - 184, lane, wave, (LAS float*)(lds + 131072)); }
    constexpr int I_PA = (512 / 64) * (1024 / 32);
    constexpr int NITEMS = 2 * I_PA;
    for (int it = gw; it < NITEMS; it += NGW) {
        int r = it;
        if (r < I_PA) { p0_transpose_item(P.w_pa, 512, 1024, P.WPAB, scr, r, lane, 1024, 0); continue; } r -= I_PA;
        p0_transpose_item(P.w_pb, 512, 1024, P.WPAB, scr, r, lane, 1024, 512);
    }
    cvt_flat(P.keys1, P.K1, 128 * 128, gw, NGW, lane);
    cvt_flat(P.keys2, P.K2, 128 * 128, gw, NGW, lane);
    {
        f32x4 va[4], vb[4], vc[4];
        int rr = gw;
        TAB_LOAD(va, rr); TAB_LOAD(vb, rr + NGW);
#pragma unroll 1
        for (; rr < 2 * 16384; rr += 3 * NGW) {
            TAB_LOAD(vc, rr + 2 * NGW); p0_quant_row(P, va, rr, lane);
            TAB_LOAD(va, rr + 3 * NGW); if (rr + NGW < 2 * 16384) p0_quant_row(P, vb, rr + NGW, lane);
            TAB_LOAD(vb, rr + 4 * NGW); if (rr + 2 * NGW < 2 * 16384) p0_quant_row(P, vc, rr + 2 * NGW, lane);
        }
    }
    for (size_t i = (size_t)gw * 512 + lane * 8; i < (size_t)8 * 128 * 128; i += (size_t)NGW * 512) {
        const int t = (int)((i >> 7) & 127), s0 = (int)(i & 127);
        const f32x4 a = *(const f32x4*)(P.w_s + i), b = *(const f32x4*)(P.w_s + i + 4);
        float e[8] = {a[0], a[1], a[2], a[3], b[0], b[1], b[2], b[3]};
#pragma unroll
        for (int j = 0; j < 8; ++j) e[j] = (s0 + j <= t) ? e[j] : 0.f;
        v4u o; o.x = pk2(e[0], e[1]); o.y = pk2(e[2], e[3]); o.z = pk2(e[4], e[5]); o.w = pk2(e[6], e[7]);
        *(v4u*)(P.WS + i) = o;
    }
    {
        f32x4 va[4], vb[4], vc[4], ww[4];
#pragma unroll
        for (int j = 0; j < 4; ++j) ww[j] = *((const f32x4*)P.mix_w + lane + 64 * j);
#define XN_LOAD(V, MM) do { if ((MM) < M) { _Pragma("unroll") for (int j = 0; j < 4; ++j) V[j] = *((const f32x4*)(P.x + (size_t)(MM) * D) + lane + 64 * j); } } while (0)
#define XN_PROC(V, MM) do { if ((MM) < M) { float s_ = 0.f; \
        _Pragma("unroll") for (int j = 0; j < 4; ++j) s_ += (V[j][0] * V[j][0] + V[j][1] * V[j][1]) + (V[j][2] * V[j][2] + V[j][3] * V[j][3]); \
        const float rstd_ = 1.0f / sqrtf(wave_sum(s_) * (1.0f / 1024.0f) + EPS); float mx_ = 0.f; \
        _Pragma("unroll") for (int j = 0; j < 4; ++j) { V[j] = V[j] * rstd_ * ww[j]; mx_ = fmaxf(mx_, fmaxf(fmaxf(fabsf(V[j][0]), fabsf(V[j][1])), fmaxf(fabsf(V[j][2]), fabsf(V[j][3])))); } \
        mx_ = wave_max(mx_); const float qs_ = mx_ > 1e-30f ? 127.0f / mx_ : 0.f; \
        _Pragma("unroll") for (int j = 0; j < 4; ++j) *(unsigned*)(P.XN8 + (size_t)(MM) * D + 4 * lane + 256 * j) = pack_i8x4(V[j][0] * qs_, V[j][1] * qs_, V[j][2] * qs_, V[j][3] * qs_); \
        if (lane == 0) P.XSC[MM] = mx_ * (1.0f / 127.0f); } } while (0)
        int m = gw;
        XN_LOAD(va, m); XN_LOAD(vb, m + NGW);
#pragma unroll 1
        for (; m < M; m += 3 * NGW) {
            XN_LOAD(vc, m + 2 * NGW); XN_PROC(va, m);
            XN_LOAD(va, m + 3 * NGW); XN_PROC(vb, m + NGW);
            XN_LOAD(vb, m + 4 * NGW); XN_PROC(vc, m + 2 * NGW);
        }
#undef XN_LOAD
#undef XN_PROC
    }
}

typedef short s16x8 __attribute__((ext_vector_type(8)));
typedef short s16x4 __attribute__((ext_vector_type(4)));
typedef float f32x16 __attribute__((ext_vector_type(16)));
typedef float f32x2v __attribute__((ext_vector_type(2)));
#define MFMA32(a, b, c) __builtin_amdgcn_mfma_f32_32x32x16_bf16((a), (b), (c), 0, 0, 0)
__device__ __forceinline__ s16x4 tr16(const LAS unsigned char* p) { return __builtin_bit_cast(s16x4, __builtin_amdgcn_ds_read_tr16_b64_v4i16((LAS s16x4*)p)); }
__device__ __forceinline__ unsigned cvtpk(float lo, float hi) { f32x2v v = {lo, hi}; bf16x2_t b = __builtin_convertvector(v, bf16x2_t); return __builtin_bit_cast(unsigned, b); }
__device__ __forceinline__ int crow(int reg, int h) { return (reg & 3) + 8 * (reg >> 2) + 4 * h; }
constexpr float LOG2E = 1.4426950408889634f;

__device__ __forceinline__ void p2_attn_mfma(LAS unsigned char* lds, const Ptrs& P, int vcu, int G, int tid, int lane, int wave) {
    LAS unsigned char* Kl = lds;
    LAS unsigned char* Vl = lds + 32768;
    LAS float* biasl = (LAS float*)(lds + 32768 + 49152);
    const int r = lane & 31, h = lane >> 5, i16 = lane & 15, q4 = i16 >> 2, p4 = i16 & 3, blk = (lane >> 4) & 1;
    for (int unit = vcu; unit < 256; unit += G) {
        const int kvh = unit & 1, blkid = unit >> 1, nb = blkid & 63; const int tok0 = blkid * 128;
#pragma unroll
        for (int i = 0; i < 4; ++i) {
            const int cidx = tid + 512 * i, row = cidx >> 3, c = cidx & 7;
            v4u kw = {0u, 0u, 0u, 0u}, vw = {0u, 0u, 0u, 0u};
            if (nb > 0 || row >= 128) { const bf16* src = P.KV + (size_t)(tok0 - 128 + row) * 256 + kvh * 64 + c * 8; kw = *(const v4u*)src; vw = *(const v4u*)(src + 128); }
            *(LAS v4u*)(Kl + row * 128 + ((c ^ ((row >> 1) & 7)) << 4)) = kw;
            *(LAS v4u*)(Vl + row * 192 + c * 16) = vw;
        }
        biasl[tid] = P.rel_bias[(int)T5B[tid & 127] * 8 + kvh * 4 + (tid >> 7)] * LOG2E;
        __syncthreads();
        const int g = wave >> 1, qh = wave & 1, hq = kvh * 4 + g;
        const float sink2 = P.sinks[hq] * LOG2E;
#pragma unroll 1
        for (int qs = 0; qs < 2; ++qs) {
            const int qi0 = 64 * qh + 32 * qs, kt0 = 2 * qh + qs;
            s16x8 qf[4];
            { const bf16* qrow = P.Q + (size_t)(tok0 + qi0 + r) * 512 + hq * 64 + 8 * h;
#pragma unroll
              for (int ks = 0; ks < 4; ++ks) qf[ks] = *(const s16x8*)(qrow + 16 * ks); }
            f32x16 s[5];
#pragma unroll
            for (int i = 0; i < 5; ++i) {
#pragma unroll
                for (int e = 0; e < 16; ++e) s[i][e] = 0.f;
                const int key = 32 * (kt0 + i) + r; const LAS unsigned char* kp = Kl + key * 128; const int sw = (key >> 1) & 7;
#pragma unroll
                for (int ks = 0; ks < 4; ++ks) { const s16x8 kf = *(const LAS s16x8*)(kp + (((2 * ks + h) ^ sw) << 4)); s[i] = MFMA32(kf, qf[ks], s[i]); }
            }
            const int qi = qi0 + r;
            float mx = sink2;
#pragma unroll
            for (int i = 0; i < 5; ++i)
#pragma unroll
                for (int e = 0; e < 16; ++e) {
                    const int kj = 32 * (kt0 + i) + crow(e, h), dist = 128 + qi - kj;
                    const bool valid = (dist >= 0) && (dist < 128) && (nb > 0 || kj >= 128);
                    const float b = biasl[g * 128 + (dist & 127)];
                    const float v = valid ? s[i][e] * (0.125f * LOG2E) + b : -1e30f;
                    s[i][e] = v; mx = fmaxf(mx, v);
                }
            mx = fmaxf(mx, xor32_f(mx));
            float l = 0.f;
#pragma unroll
            for (int i = 0; i < 5; ++i)
#pragma unroll
                for (int e = 0; e < 16; ++e) { const float p = __builtin_amdgcn_exp2f(s[i][e] - mx); s[i][e] = p; l += p; }
            l += xor32_f(l);
            l += __builtin_amdgcn_exp2f(sink2 - mx);
            f32x16 o0, o1;
#pragma unroll
            for (int e = 0; e < 16; ++e) { o0[e] = 0.f; o1[e] = 0.f; }
#pragma unroll
            for (int i = 0; i < 5; ++i)
#pragma unroll
                for (int st = 0; st < 2; ++st) {
                    v4u pw; pw.x = cvtpk(s[i][8 * st], s[i][8 * st + 1]); pw.y = cvtpk(s[i][8 * st + 2], s[i][8 * st + 3]); pw.z = cvtpk(s[i][8 * st + 4], s[i][8 * st + 5]); pw.w = cvtpk(s[i][8 * st + 6], s[i][8 * st + 7]);
                    const s16x8 pf = __builtin_bit_cast(s16x8, pw);
                    const LAS unsigned char* vb = Vl + (32 * (kt0 + i) + 16 * st + 4 * h + q4) * 192 + 32 * blk + 8 * p4;
                    { const s16x4 lo = tr16(vb), hi = tr16(vb + 8 * 192); const s16x8 vf = __builtin_shufflevector(lo, hi, 0, 1, 2, 3, 4, 5, 6, 7); o0 = MFMA32(vf, pf, o0); }
                    { const s16x4 lo = tr16(vb + 64), hi = tr16(vb + 64 + 8 * 192); const s16x8 vf = __builtin_shufflevector(lo, hi, 0, 1, 2, 3, 4, 5, 6, 7); o1 = MFMA32(vf, pf, o1); }
                }
            const float inv = 1.0f / l;
            bf16* orow = P.AOUT + (size_t)(tok0 + qi) * AB_LD + hq * 64 + 4 * h;
#pragma unroll
            for (int r4 = 0; r4 < 4; ++r4) {
                v2u w0; w0.x = cvtpk(o0[4 * r4] * inv, o0[4 * r4 + 1] * inv); w0.y = cvtpk(o0[4 * r4 + 2] * inv, o0[4 * r4 + 3] * inv); *(v2u*)(orow + 8 * r4) = w0;
                v2u w1; w1.x = cvtpk(o1[4 * r4] * inv, o1[4 * r4 + 1] * inv); w1.y = cvtpk(o1[4 * r4 + 2] * inv, o1[4 * r4 + 3] * inv); *(v2u*)(orow + 32 + 8 * r4) = w1;
            }
        }
        __syncthreads();
    }
}

__device__ __forceinline__ void p2_gmlp_mfma(LAS unsigned char* lds, const Ptrs& P, int vcu, int G, int tid, int lane, int wave) {
    LAS unsigned char* vnl = lds;
    const int r = lane & 31, h = lane >> 5, i16 = lane & 15, q4 = i16 >> 2, p4 = i16 & 3, blk = (lane >> 4) & 1;
    for (int unit = vcu; unit < 256; unit += G) {
        const int c = unit >> 1, hh = unit & 1;
        v4u gvw[16];
#pragma unroll
        for (int i = 0; i < 16; ++i) gvw[i] = *((const v4u*)(P.GV + ((size_t)c * 128 + wave * 16 + i) * 512) + lane);
        const f32x4 lw0 = *(const f32x4*)(P.ln_w + lane * 8), lw1 = *(const f32x4*)(P.ln_w + lane * 8 + 4), lb0 = *(const f32x4*)(P.ln_b + lane * 8), lb1 = *(const f32x4*)(P.ln_b + lane * 8 + 4);
#pragma unroll
        for (int i = 0; i < 16; ++i) {
            const int tt = wave * 16 + i;
            const v4u w = gvw[i];
            float x[8] = {bflo(w.x), bfhi(w.x), bflo(w.y), bfhi(w.y), bflo(w.z), bfhi(w.z), bflo(w.w), bfhi(w.w)};
            float s = 0.f;
#pragma unroll
            for (int j = 0; j < 8; ++j) s += x[j];
            const float mean = wave_sum(s) * (1.0f / 512.0f);
            float ss = 0.f;
#pragma unroll
            for (int j = 0; j < 8; ++j) { x[j] -= mean; ss += x[j] * x[j]; }
            const float rstd = 1.0f / sqrtf(wave_sum(ss) * (1.0f / 512.0f) + EPS);
            if ((lane >> 5) == hh) {
                const f32x4 w0 = lw0, w1 = lw1, b0 = lb0, b1 = lb1;
                v4u o; o.x = pk2(x[0] * rstd * w0[0] + b0[0], x[1] * rstd * w0[1] + b0[1]); o.y = pk2(x[2] * rstd * w0[2] + b0[2], x[3] * rstd * w0[3] + b0[3]);
                o.z = pk2(x[4] * rstd * w1[0] + b1[0], x[5] * rstd * w1[1] + b1[1]); o.w = pk2(x[6] * rstd * w1[2] + b1[2], x[7] * rstd * w1[3] + b1[3]);
                *(LAS v4u*)(vnl + tt * 576 + (lane & 31) * 16) = o;
            }
        }
        __syncthreads();
        const int gi = wave >> 1, dblk = wave & 1, g = hh * 4 + gi;
        s16x8 af[8];
#pragma unroll
        for (int ks = 0; ks < 8; ++ks) { const LAS unsigned char* vb = vnl + (16 * ks + 8 * h + q4) * 576 + (gi * 64 + dblk * 32 + 16 * blk) * 2 + 8 * p4;
            const s16x4 lo = tr16(vb), hi = tr16(vb + 4 * 576); af[ks] = __builtin_shufflevector(lo, hi, 0, 1, 2, 3, 4, 5, 6, 7); }
#pragma unroll
        for (int tt = 0; tt < 4; ++tt) {
            f32x16 acc;
#pragma unroll
            for (int e = 0; e < 16; ++e) acc[e] = 0.f;
            const bf16* wrow = P.WS + ((size_t)g * 128 + 32 * tt + r) * 128 + 8 * h;
#pragma unroll
            for (int ks = 0; ks < 2 * (tt + 1); ++ks) acc = MFMA32(af[ks], *(const s16x8*)(wrow + 16 * ks), acc);
            const int t = 32 * tt + r; const size_t row = (size_t)c * 128 + t; const float b = P.b_s[g * 128 + t];
#pragma unroll
            for (int r4 = 0; r4 < 4; ++r4) {
                const int ch = g * 64 + dblk * 32 + 8 * r4 + 4 * h;
                const v2u uw = *(const v2u*)(P.GU + row * 512 + ch);
                v2u ow; ow.x = cvtpk(bflo(uw.x) * (acc[4 * r4] + b), bfhi(uw.x) * (acc[4 * r4 + 1] + b)); ow.y = cvtpk(bflo(uw.y) * (acc[4 * r4 + 2] + b), bfhi(uw.y) * (acc[4 * r4 + 3] + b));
                *(v2u*)(P.BOUT + row * AB_LD + ch) = ow;
            }
        }
        __syncthreads();
    }
}

__device__ __forceinline__ void topk_half(const bf16* q, const LAS bf16* kl, float (&v)[16]) {
    v4u qv[16];
#pragma unroll
    for (int c = 0; c < 16; ++c) qv[c] = ((const v4u*)q)[c];
#pragma unroll
    for (int i = 0; i < 16; ++i) v[i] = -INFINITY;
    for (int n = 0; n < 128; ++n) {
        const LAS v4u* kr = (const LAS v4u*)(kl + n * 128);
        float a0 = 0.f, a1 = 0.f, a2 = 0.f, a3 = 0.f;
#pragma unroll
        for (int c = 0; c < 16; ++c) { const v4u kk = kr[c]; a0 = dot2bf(qv[c].x, kk.x, a0); a1 = dot2bf(qv[c].y, kk.y, a1); a2 = dot2bf(qv[c].z, kk.z, a2); a3 = dot2bf(qv[c].w, kk.w, a3); }
        const float acc = (a0 + a1) + (a2 + a3);
        float x = __builtin_bit_cast(float, (__builtin_bit_cast(unsigned, acc) & ~0x7Fu) | (unsigned)n);
#pragma unroll
        for (int i = 0; i < 16; ++i) { const float hi = fmaxf(v[i], x); x = fminf(v[i], x); v[i] = hi; }
    }
}

__host__ __device__ constexpr int cand_slot(int i, int j) { int c = 0; for (int a = 0; a < 16; ++a) for (int b = 0; b < 16; ++b) { if (a == i && b == j) return c; if ((a + 1) * (b + 1) <= 16) ++c; } return c; }
#define CE_DESC(a, b) do { const float hi_ = fmaxf((a), (b)); const float lo_ = fminf((a), (b)); (a) = hi_; (b) = lo_; } while (0)
__device__ __forceinline__ void sort16_desc(float (&v)[16]) {
    CE_DESC(v[0], v[1]); CE_DESC(v[3], v[2]); CE_DESC(v[4], v[5]); CE_DESC(v[7], v[6]); CE_DESC(v[8], v[9]); CE_DESC(v[11], v[10]); CE_DESC(v[12], v[13]); CE_DESC(v[15], v[14]); CE_DESC(v[0], v[2]); CE_DESC(v[1], v[3]); CE_DESC(v[6], v[4]); CE_DESC(v[7], v[5]); CE_DESC(v[8], v[10]); CE_DESC(v[9], v[11]); CE_DESC(v[14], v[12]); CE_DESC(v[15], v[13]); CE_DESC(v[0], v[1]); CE_DESC(v[2], v[3]); CE_DESC(v[5], v[4]); CE_DESC(v[7], v[6]); CE_DESC(v[8], v[9]); CE_DESC(v[10], v[11]); CE_DESC(v[13], v[12]); CE_DESC(v[15], v[14]); CE_DESC(v[0], v[4]); CE_DESC(v[1], v[5]); CE_DESC(v[2], v[6]); CE_DESC(v[3], v[7]); CE_DESC(v[12], v[8]); CE_DESC(v[13], v[9]); CE_DESC(v[14], v[10]); CE_DESC(v[15], v[11]); CE_DESC(v[0], v[2]); CE_DESC(v[1], v[3]); CE_DESC(v[4], v[6]); CE_DESC(v[5], v[7]); CE_DESC(v[10], v[8]); CE_DESC(v[11], v[9]); CE_DESC(v[14], v[12]); CE_DESC(v[15], v[13]); CE_DESC(v[0], v[1]); CE_DESC(v[2], v[3]); CE_DESC(v[4], v[5]); CE_DESC(v[6], v[7]); CE_DESC(v[9], v[8]); CE_DESC(v[11], v[10]); CE_DESC(v[13], v[12]); CE_DESC(v[15], v[14]); CE_DESC(v[0], v[8]); CE_DESC(v[1], v[9]); CE_DESC(v[2], v[10]); CE_DESC(v[3], v[11]); CE_DESC(v[4], v[12]); CE_DESC(v[5], v[13]); CE_DESC(v[6], v[14]); CE_DESC(v[7], v[15]); CE_DESC(v[0], v[4]); CE_DESC(v[1], v[5]); CE_DESC(v[2], v[6]); CE_DESC(v[3], v[7]); CE_DESC(v[8], v[12]); CE_DESC(v[9], v[13]); CE_DESC(v[10], v[14]); CE_DESC(v[11], v[15]); CE_DESC(v[0], v[2]); CE_DESC(v[1], v[3]); CE_DESC(v[4], v[6]); CE_DESC(v[5], v[7]); CE_DESC(v[8], v[10]); CE_DESC(v[9], v[11]); CE_DESC(v[12], v[14]); CE_DESC(v[13], v[15]); CE_DESC(v[0], v[1]); CE_DESC(v[2], v[3]); CE_DESC(v[4], v[5]); CE_DESC(v[6], v[7]); CE_DESC(v[8], v[9]); CE_DESC(v[10], v[11]); CE_DESC(v[12], v[13]); CE_DESC(v[14], v[15]);
}
__device__ __forceinline__ void merge_top16(float (&a)[16], const float (&b)[16]) {
    a[0] = fmaxf(a[0], b[15]); a[1] = fmaxf(a[1], b[14]); a[2] = fmaxf(a[2], b[13]); a[3] = fmaxf(a[3], b[12]); a[4] = fmaxf(a[4], b[11]); a[5] = fmaxf(a[5], b[10]); a[6] = fmaxf(a[6], b[9]); a[7] = fmaxf(a[7], b[8]); a[8] = fmaxf(a[8], b[7]); a[9] = fmaxf(a[9], b[6]); a[10] = fmaxf(a[10], b[5]); a[11] = fmaxf(a[11], b[4]); a[12] = fmaxf(a[12], b[3]); a[13] = fmaxf(a[13], b[2]); a[14] = fmaxf(a[14], b[1]); a[15] = fmaxf(a[15], b[0]); CE_DESC(a[0], a[8]); CE_DESC(a[1], a[9]); CE_DESC(a[2], a[10]); CE_DESC(a[3], a[11]); CE_DESC(a[4], a[12]); CE_DESC(a[5], a[13]); CE_DESC(a[6], a[14]); CE_DESC(a[7], a[15]); CE_DESC(a[0], a[4]); CE_DESC(a[1], a[5]); CE_DESC(a[2], a[6]); CE_DESC(a[3], a[7]); CE_DESC(a[8], a[12]); CE_DESC(a[9], a[13]); CE_DESC(a[10], a[14]); CE_DESC(a[11], a[15]); CE_DESC(a[0], a[2]); CE_DESC(a[1], a[3]); CE_DESC(a[4], a[6]); CE_DESC(a[5], a[7]); CE_DESC(a[8], a[10]); CE_DESC(a[9], a[11]); CE_DESC(a[12], a[14]); CE_DESC(a[13], a[15]); CE_DESC(a[0], a[1]); CE_DESC(a[2], a[3]); CE_DESC(a[4], a[5]); CE_DESC(a[6], a[7]); CE_DESC(a[8], a[9]); CE_DESC(a[10], a[11]); CE_DESC(a[12], a[13]); CE_DESC(a[14], a[15]);
}
__device__ __forceinline__ void scores_top16(const bf16* qbase, const LAS unsigned char* kl, int r, int h, float (&t)[16]) {
    f32x16 acc[4];
#pragma unroll
    for (int kt = 0; kt < 4; ++kt)
#pragma unroll
        for (int e = 0; e < 16; ++e) acc[kt][e] = 0.f;
    const LAS unsigned char* kp0 = kl + r * 256; const int sw = r & 15;
#pragma unroll
    for (int ks = 0; ks < 8; ++ks) {
        const s16x8 qf = *(const s16x8*)(qbase + (size_t)r * 256 + 16 * ks + 8 * h);
#pragma unroll
        for (int kt = 0; kt < 4; ++kt) { const s16x8 kf = *(const LAS s16x8*)(kp0 + kt * 8192 + (((2 * ks + h) ^ sw) << 4)); acc[kt] = MFMA32(kf, qf, acc[kt]); }
    }
    float g[4][16];
#pragma unroll
    for (int kt = 0; kt < 4; ++kt) {
#pragma unroll
        for (int e = 0; e < 16; ++e) { const float av_ = acc[kt][e];
            g[kt][e] = __builtin_bit_cast(float, (__builtin_bit_cast(unsigned, av_) & ~0x7Fu) | (unsigned)(32 * kt + (e & 3) + 8 * (e >> 2))); }
        sort16_desc(g[kt]);
    }
    merge_top16(g[0], g[1]); merge_top16(g[2], g[3]); merge_top16(g[0], g[2]);
#pragma unroll
    for (int k = 0; k < 16; ++k) t[k] = __builtin_bit_cast(float, __builtin_bit_cast(unsigned, g[0][k]) | ((unsigned)h << 2));
}
__device__ __forceinline__ void peer_topk_unit_mfma(const Ptrs& P, const LAS unsigned char* k1l, const LAS unsigned char* k2l, LAS int* idxl, LAS float* gatel, int unit, int lane, int wave, int rb_lo = 0, int rb_hi = 2) {
    asm volatile("" : "+v"(lane));
    const int r = lane & 31, h = lane >> 5;
#pragma unroll 1
    for (int rbi = rb_lo; rbi < rb_hi; ++rbi) {
        const int rb = wave * 2 + rbi, R = rb * 32 + r;
        const bf16* qbase = P.QP + ((size_t)unit * 512 + rb * 32) * 256;
        float t1[16], t2[16];
        scores_top16(qbase, k1l, r, h, t1);
        __builtin_amdgcn_sched_barrier(0);
        scores_top16(qbase + 128, k2l, r, h, t2);
        __builtin_amdgcn_sched_barrier(0);
        float F[16], recv[16];
#pragma unroll
        for (int k = 0; k < 16; ++k) { auto rr = __builtin_amdgcn_permlane32_swap(__builtin_bit_cast(unsigned, t1[k]), __builtin_bit_cast(unsigned, t2[k]), false, false);
            const unsigned r0 = rr[0], r1 = rr[1]; F[k] = __builtin_bit_cast(float, r0); recv[k] = __builtin_bit_cast(float, r1); }
        merge_top16(F, recv);
        LAS unsigned char* slot = (LAS unsigned char*)(idxl + R * 16);
        { v4u b;
          b.x = (__builtin_bit_cast(unsigned, F[0]) & 0x7Fu) | ((__builtin_bit_cast(unsigned, F[1]) & 0x7Fu) << 8) | ((__builtin_bit_cast(unsigned, F[2]) & 0x7Fu) << 16) | ((__builtin_bit_cast(unsigned, F[3]) & 0x7Fu) << 24);
          b.y = (__builtin_bit_cast(unsigned, F[4]) & 0x7Fu) | ((__builtin_bit_cast(unsigned, F[5]) & 0x7Fu) << 8) | ((__builtin_bit_cast(unsigned, F[6]) & 0x7Fu) << 16) | ((__builtin_bit_cast(unsigned, F[7]) & 0x7Fu) << 24);
          b.z = (__builtin_bit_cast(unsigned, F[8]) & 0x7Fu) | ((__builtin_bit_cast(unsigned, F[9]) & 0x7Fu) << 8) | ((__builtin_bit_cast(unsigned, F[10]) & 0x7Fu) << 16) | ((__builtin_bit_cast(unsigned, F[11]) & 0x7Fu) << 24);
          b.w = (__builtin_bit_cast(unsigned, F[12]) & 0x7Fu) | ((__builtin_bit_cast(unsigned, F[13]) & 0x7Fu) << 8) | ((__builtin_bit_cast(unsigned, F[14]) & 0x7Fu) << 16) | ((__builtin_bit_cast(unsigned, F[15]) & 0x7Fu) << 24);
          *(LAS v4u*)(slot + 16 * h) = b;
          (void)b; }
        float v1[16], v2[16];
#pragma unroll
        for (int k = 0; k < 16; ++k) { auto rr = __builtin_amdgcn_permlane32_swap(__builtin_bit_cast(unsigned, F[k]), __builtin_bit_cast(unsigned, F[k]), false, false);
            const unsigned r0 = rr[0], r1 = rr[1]; v1[k] = __builtin_bit_cast(float, r0 & ~0x7Fu); v2[k] = __builtin_bit_cast(float, r1 & ~0x7Fu); }
        float cg[4][16];
#pragma unroll
        for (int a = 0; a < 4; ++a)
#pragma unroll
            for (int k = 0; k < 16; ++k) cg[a][k] = -1e30f;
#define CAND(i, j) __builtin_bit_cast(float, (__builtin_bit_cast(unsigned, v1[i] + v2[j]) & ~0xFFu) | (unsigned)((i) * 16 + (j)))
        cg[0][0] = CAND(0, 0);
        cg[0][1] = CAND(0, 1);
        cg[0][2] = CAND(0, 2);
        cg[0][3] = CAND(0, 3);
        cg[0][4] = CAND(0, 4);
        cg[0][5] = CAND(0, 5);
        cg[0][6] = CAND(0, 6);
        cg[0][7] = CAND(0, 7);
        cg[0][8] = CAND(0, 8);
        cg[0][9] = CAND(0, 9);
        cg[0][10] = CAND(0, 10);
        cg[0][11] = CAND(0, 11);
        cg[0][12] = CAND(0, 12);
        cg[0][13] = CAND(0, 13);
        cg[0][14] = CAND(0, 14);
        cg[0][15] = CAND(0, 15);
        cg[1][0] = CAND(1, 0);
        cg[1][1] = CAND(1, 1);
        cg[1][2] = CAND(1, 2);
        cg[1][3] = CAND(1, 3);
        cg[1][4] = CAND(1, 4);
        cg[1][5] = CAND(1, 5);
        cg[1][6] = CAND(1, 6);
        cg[1][7] = CAND(1, 7);
        cg[1][8] = CAND(2, 0);
        cg[1][9] = CAND(2, 1);
        cg[1][10] = CAND(2, 2);
        cg[1][11] = CAND(2, 3);
        cg[1][12] = CAND(2, 4);
        cg[1][13] = CAND(3, 0);
        cg[1][14] = CAND(3, 1);
        cg[1][15] = CAND(3, 2);
        cg[2][0] = CAND(3, 3);
        cg[2][1] = CAND(4, 0);
        cg[2][2] = CAND(4, 1);
        cg[2][3] = CAND(4, 2);
        cg[2][4] = CAND(5, 0);
        cg[2][5] = CAND(5, 1);
        cg[2][6] = CAND(6, 0);
        cg[2][7] = CAND(6, 1);
        cg[2][8] = CAND(7, 0);
        cg[2][9] = CAND(7, 1);
        cg[2][10] = CAND(8, 0);
        cg[2][11] = CAND(9, 0);
        cg[2][12] = CAND(10, 0);
        cg[2][13] = CAND(11, 0);
        cg[2][14] = CAND(12, 0);
        cg[2][15] = CAND(13, 0);
        cg[3][0] = CAND(14, 0);
        cg[3][1] = CAND(15, 0);
#undef CAND
        sort16_desc(cg[0]); sort16_desc(cg[1]); sort16_desc(cg[2]); sort16_desc(cg[3]);
        merge_top16(cg[0], cg[1]); merge_top16(cg[2], cg[3]); merge_top16(cg[0], cg[2]);
        float es = 0.f, e[16];
        const float top = __builtin_bit_cast(float, __builtin_bit_cast(unsigned, cg[0][0]) & ~0xFFu);
#pragma unroll
        for (int k = 0; k < 16; ++k) { e[k] = __expf(__builtin_bit_cast(float, __builtin_bit_cast(unsigned, cg[0][k]) & ~0xFFu) - top); es += e[k]; }
        const float inv = 1.0f / es;
        LDS_WAIT();
        unsigned id[8]; float gt[8];
#pragma unroll
        for (int k = 0; k < 8; ++k) { const float clo_ = cg[0][k], chi_ = cg[0][8 + k], elo_ = e[k], ehi_ = e[8 + k]; const unsigned code = __builtin_bit_cast(unsigned, h ? chi_ : clo_) & 0xFFu; gt[k] = (h ? ehi_ : elo_) * inv;
            id[k] = (unsigned)slot[code >> 4] * 128u + (unsigned)slot[16 + (code & 15u)]; }
        LDS_WAIT();
        LAS v4u* ip = (LAS v4u*)(idxl + R * 16 + 8 * h); LAS f32x4* gp = (LAS f32x4*)(gatel + R * 16 + 8 * h);
        { v4u a; a.x = id[0]; a.y = id[1]; a.z = id[2]; a.w = id[3]; ip[0] = a; v4u b; b.x = id[4]; b.y = id[5]; b.z = id[6]; b.w = id[7]; ip[1] = b; }
        { f32x4 a; a[0] = gt[0]; a[1] = gt[1]; a[2] = gt[2]; a[3] = gt[3]; gp[0] = a; f32x4 b; b[0] = gt[4]; b[1] = gt[5]; b[2] = gt[6]; b[3] = gt[7]; gp[1] = b; }
    }
}

__device__ __forceinline__ unsigned nib_pack(unsigned x) { x = (x | (x >> 4)) & 0x00FF00FFu; return (x | (x >> 8)) & 0xFFFFu; }
__device__ __forceinline__ void hn_planes(unsigned q0, unsigned q1, unsigned& pa, unsigned& pb) {
    const unsigned b0 = q0 & 0x0F0F0F0Fu, b1 = q1 & 0x0F0F0F0Fu;
    const unsigned a0 = (((q0 >> 4) & 0x0F0F0F0Fu) + ((q0 >> 3) & 0x01010101u)) & 0x0F0F0F0Fu, a1 = (((q1 >> 4) & 0x0F0F0F0Fu) + ((q1 >> 3) & 0x01010101u)) & 0x0F0F0F0Fu;
    pa = nib_pack(a0) | (nib_pack(a1) << 16); pb = nib_pack(b0) | (nib_pack(b1) << 16);
}
#define HROW_ISSUE(BUF, TAB, W) do { const unsigned vo_ = (((W) & 0x3fffu) << 9) + loff; asm volatile("global_load_dwordx4 %0, %1, %2" : "=v"(BUF) : "v"(vo_), "s"(TAB) : "memory"); } while (0)
__device__ __forceinline__ void peer_gather_half(const Ptrs& P, LAS unsigned char* lds, int unit, int lane, int wave, int g_lo, int g_hi) {
    asm volatile("" : "+v"(lane));
    const size_t t0 = (size_t)unit * 64 + wave * 8;
#pragma unroll 1
    for (int gq = g_lo; gq < g_hi; ++gq) {
        int lq = lane; asm volatile("" : "+v"(lq));
        LAS int* idxl = (LAS int*)(lds + 65536) + wave * 1024 + gq * 512;
        const LAS float* gatel = (const LAS float*)(lds + 98304) + wave * 1024 + gq * 512;
        LAS unsigned* sw = (LAS unsigned*)idxl; LAS float* sg = (LAS float*)(lds + 98304) + wave * 1024 + gq * 512;
        LAS int* startl = (LAS int*)(lds + 131072 + 4096) + wave * 64;
        {
            int ent[8]; float gv[8], us[8];
#pragma unroll
            for (int j = 0; j < 8; ++j) { ent[j] = idxl[(j >> 1) * 128 + (j & 1) * 64 + lq]; gv[j] = gatel[(j >> 1) * 128 + (j & 1) * 64 + lq]; }
#pragma unroll
            for (int j = 0; j < 8; ++j) { us[j] = P.USC[ent[j]]; gv[j] *= P.VSC[ent[j]] * 128.0f; }
            LDS_WAIT();
            int rk[8];
#pragma unroll
            for (int tk = 0; tk < 4; ++tk) {
                int run[NSL];
#pragma unroll
                for (int b = 0; b < NSL; ++b) run[b] = 0;
#pragma unroll
                for (int jj = 0; jj < 2; ++jj) { const int j = 2 * tk + jj; const int bj = ent[j] >> SLSH; int r = 0;
#pragma unroll
                    for (int b = 0; b < NSL; ++b) { const unsigned long long m = __ballot(bj == b);
                        const int below = (int)__builtin_amdgcn_mbcnt_hi((unsigned)(m >> 32), __builtin_amdgcn_mbcnt_lo((unsigned)m, 0u));
                        r = (bj == b) ? run[b] + below : r; run[b] += (int)__builtin_popcountll(m); }
                    rk[j] = r; }
                int st = 0;
#pragma unroll
                for (int b = 0; b < NSL; ++b) { if (lq == b) startl[tk * NSL + b] = st; st += run[b]; }
            }
            LDS_WAIT();
#pragma unroll
            for (int j = 0; j < 8; ++j) { const int pos = (j >> 1) * 128 + startl[(j >> 1) * NSL + (ent[j] >> SLSH)] + rk[j]; sw[pos] = (unsigned)ent[j] | (f2bf(us[j]) << 16); sg[pos] = gv[j]; }
            LDS_WAIT();
        }
        v4u hA0, hB0, hA1, hB1; float hs0, hs1;
        { int lg = lane; asm volatile("" : "+v"(lg)); const size_t tr = t0 + gq * 4 + (lg >> 5);
          const v4u* hp0 = (const v4u*)(P.HNQ + tr * 1024 + 32 * (lg & 31)); const v4u* hp1 = (const v4u*)(P.HNQ + (tr + 2) * 1024 + 32 * (lg & 31));
          const v4u x0 = hp0[0], x1 = hp0[1], z0 = hp1[0], z1 = hp1[1]; hs0 = P.HSC[tr]; hs1 = P.HSC[tr + 2];
          unsigned pa_[8], pb_[8];
          hn_planes(x0.x, x0.y, pa_[0], pb_[0]); hn_planes(x0.z, x0.w, pa_[1], pb_[1]); hn_planes(x1.x, x1.y, pa_[2], pb_[2]); hn_planes(x1.z, x1.w, pa_[3], pb_[3]);
          hn_planes(z0.x, z0.y, pa_[4], pb_[4]); hn_planes(z0.z, z0.w, pa_[5], pb_[5]); hn_planes(z1.x, z1.y, pa_[6], pb_[6]); hn_planes(z1.z, z1.w, pa_[7], pb_[7]);
          hA0.x = pa_[0]; hA0.y = pa_[1]; hA0.z = pa_[2]; hA0.w = pa_[3]; hB0.x = pb_[0]; hB0.y = pb_[1]; hB0.z = pb_[2]; hB0.w = pb_[3];
          hA1.x = pa_[4]; hA1.y = pa_[5]; hA1.z = pa_[6]; hA1.w = pa_[7]; hB1.x = pb_[4]; hB1.y = pb_[5]; hB1.z = pb_[6]; hB1.w = pb_[7]; }
        h2 y0[16];
#pragma unroll 1
        for (int sub = 0; sub < 2; ++sub) {
            int lr = lane; asm volatile("" : "+v"(lr));
            const int l5 = lr & 31, tk = 2 * sub + (lr >> 5);
            const LAS unsigned* swt = sw + tk * 128; const LAS float* sgt = sg + tk * 128;
            const unsigned loff = (unsigned)l5 * 16u;
            {
                const int c4 = lr & 15, rho = lr >> 4;
                const int mtk = 2 * sub + (rho >> 1), mpos = (c4 < 4) ? 2 * c4 + (rho & 1) : 0;
                const LAS unsigned* swm = sw + mtk * 128 + mpos; LAS float* sgm = sg + mtk * 128 + mpos;
                v4u ha = sub ? hA1 : hA0, hb = sub ? hB1 : hB0; float hsc_m = sub ? hs1 : hs0;
                asm volatile("" : "+v"(ha), "+v"(hb), "+v"(hsc_m));
                v4u ub[16]; float p[8];
                unsigned mw; float mg;
#pragma unroll 1
                for (int pass = 0; pass < PROBE_SWEEPS; ++pass) {
                const bool lastp = (pass + 1 == PROBE_SWEEPS);
#define U_STEP(d, CNT, ISSUE, W) do { asm volatile("s_waitcnt vmcnt(" #CNT ")" : "+v"(ub[d]) :: "memory"); \
        { const v4u x_ = ub[d]; int a_ = 0, b_ = 0; \
          a_ = __builtin_amdgcn_sdot8((int)x_.x, (int)ha.x, a_, false); b_ = __builtin_amdgcn_sdot8((int)x_.x, (int)hb.x, b_, false); \
          a_ = __builtin_amdgcn_sdot8((int)x_.y, (int)ha.y, a_, false); b_ = __builtin_amdgcn_sdot8((int)x_.y, (int)hb.y, b_, false); \
          a_ = __builtin_amdgcn_sdot8((int)x_.z, (int)ha.z, a_, false); b_ = __builtin_amdgcn_sdot8((int)x_.z, (int)hb.z, b_, false); \
          a_ = __builtin_amdgcn_sdot8((int)x_.w, (int)ha.w, a_, false); b_ = __builtin_amdgcn_sdot8((int)x_.w, (int)hb.w, b_, false); \
          p[(d) & 7] = (float)((a_ << 4) + b_); } \
        if (ISSUE) HROW_ISSUE(ub[d], P.U8, W); } while (0)
#define U_FINISH(i0) do { float r_[4]; \
        _Pragma("unroll") for (int j = 0; j < 4; ++j) { auto rr = __builtin_amdgcn_permlane16_swap(__builtin_bit_cast(unsigned, p[2 * j]), __builtin_bit_cast(unsigned, p[2 * j + 1]), false, false); const unsigned r0 = rr[0], r1 = rr[1]; r_[j] = row16_sum(__builtin_bit_cast(float, r0) + __builtin_bit_cast(float, r1)); } \
        const float acol = (c4 == 0) ? r_[0] : (c4 == 1) ? r_[1] : (c4 == 2) ? r_[2] : r_[3]; \
        const float act = gelu_tanh(acol * __builtin_bit_cast(float, mw & 0xffff0000u) * hsc_m) * mg; \
        if (c4 < 4 && lastp) sgm[i0] = act; asm volatile("" :: "v"(act)); } while (0)
#define U_CHUNK(i0, B, WA, WB, C0, C1, C2, C3, C4, C5, C6, C7, ISSUE) do { mw = swm[i0]; mg = sgm[i0]; \
        U_STEP(B + 0, C0, ISSUE, WA.x); U_STEP(B + 1, C1, ISSUE, WA.y); U_STEP(B + 2, C2, ISSUE, WA.z); U_STEP(B + 3, C3, ISSUE, WA.w); \
        U_STEP(B + 4, C4, ISSUE, WB.x); U_STEP(B + 5, C5, ISSUE, WB.y); U_STEP(B + 6, C6, ISSUE, WB.z); U_STEP(B + 7, C7, ISSUE, WB.w); \
        U_FINISH(i0); } while (0)
                {
                    const v4u w0 = *(const LAS v4u*)(swt), w1 = *(const LAS v4u*)(swt + 4), w2 = *(const LAS v4u*)(swt + 8), w3 = *(const LAS v4u*)(swt + 12);
                    HROW_ISSUE(ub[0], P.U8, w0.x); HROW_ISSUE(ub[1], P.U8, w0.y); HROW_ISSUE(ub[2], P.U8, w0.z); HROW_ISSUE(ub[3], P.U8, w0.w);
                    HROW_ISSUE(ub[4], P.U8, w1.x); HROW_ISSUE(ub[5], P.U8, w1.y); HROW_ISSUE(ub[6], P.U8, w1.z); HROW_ISSUE(ub[7], P.U8, w1.w);
                    HROW_ISSUE(ub[8], P.U8, w2.x); HROW_ISSUE(ub[9], P.U8, w2.y); HROW_ISSUE(ub[10], P.U8, w2.z); HROW_ISSUE(ub[11], P.U8, w2.w);
                    HROW_ISSUE(ub[12], P.U8, w3.x); HROW_ISSUE(ub[13], P.U8, w3.y); HROW_ISSUE(ub[14], P.U8, w3.z); HROW_ISSUE(ub[15], P.U8, w3.w);
                }
                v4u wa = *(const LAS v4u*)(swt + 16), wb = *(const LAS v4u*)(swt + 20);
#pragma unroll 1
                for (int i0 = 0; i0 < 112; i0 += 16) {
                    const v4u wc = *(const LAS v4u*)(swt + i0 + 24), wd = *(const LAS v4u*)(swt + i0 + 28);
                    U_CHUNK(i0, 0, wa, wb, 15, 15, 15, 15, 15, 15, 15, 15, 1);
                    wa = *(const LAS v4u*)(swt + i0 + 32); wb = *(const LAS v4u*)(swt + i0 + 36);
                    U_CHUNK(i0 + 8, 8, wc, wd, 15, 15, 15, 15, 15, 15, 15, 15, 1);
                }
                U_CHUNK(112, 0, wa, wb, 15, 14, 13, 12, 11, 10, 9, 8, 0);
                U_CHUNK(120, 8, wa, wb, 7, 6, 5, 4, 3, 2, 1, 0, 0);
                }
#undef U_CHUNK
#undef U_FINISH
#undef U_STEP
            }
            LDS_WAIT();
            h2 y[16];
#pragma unroll
            for (int k = 0; k < 16; ++k) { y[k][0] = (_Float16)0.f; y[k][1] = (_Float16)0.f; }
            {
                v4u vb[16];
#pragma unroll 1
                for (int pass = 0; pass < PROBE_SWEEPS; ++pass) {
                if (pass > 0) {
#pragma unroll
                    for (int k = 0; k < 16; ++k) { y[k][0] = (_Float16)0.f; y[k][1] = (_Float16)0.f; } }
#define V_F4(K, X, B) y[K] = __builtin_elementwise_fma(__builtin_bit_cast(h2, __builtin_amdgcn_cvt_scalef32_pk_f16_fp4(X, 1.0f, B)), a2_, y[K])
#define V_STEP(d, CNT, ISSUE, W, A) do { asm volatile("s_waitcnt vmcnt(" #CNT ")" : "+v"(vb[d]) :: "memory"); \
        { const v4u x_ = vb[d]; const h2 a2_ = __builtin_bit_cast(h2, __builtin_amdgcn_cvt_pkrtz(A, A)); \
          V_F4(0, x_.x, 0); V_F4(1, x_.x, 1); V_F4(2, x_.x, 2); V_F4(3, x_.x, 3); V_F4(4, x_.y, 0); V_F4(5, x_.y, 1); V_F4(6, x_.y, 2); V_F4(7, x_.y, 3); \
          V_F4(8, x_.z, 0); V_F4(9, x_.z, 1); V_F4(10, x_.z, 2); V_F4(11, x_.z, 3); V_F4(12, x_.w, 0); V_F4(13, x_.w, 1); V_F4(14, x_.w, 2); V_F4(15, x_.w, 3); } \
        if (ISSUE) HROW_ISSUE(vb[d], P.V8, W); } while (0)
#define V_CHUNK(i0, B, WA, WB, C0, C1, C2, C3, C4, C5, C6, C7, ISSUE) do { const f32x4 aa_ = *(const LAS f32x4*)(sgt + (i0)), ab_ = *(const LAS f32x4*)(sgt + (i0) + 4); \
        V_STEP(B + 0, C0, ISSUE, WA.x, aa_[0]); V_STEP(B + 1, C1, ISSUE, WA.y, aa_[1]); V_STEP(B + 2, C2, ISSUE, WA.z, aa_[2]); V_STEP(B + 3, C3, ISSUE, WA.w, aa_[3]); \
        V_STEP(B + 4, C4, ISSUE, WB.x, ab_[0]); V_STEP(B + 5, C5, ISSUE, WB.y, ab_[1]); V_STEP(B + 6, C6, ISSUE, WB.z, ab_[2]); V_STEP(B + 7, C7, ISSUE, WB.w, ab_[3]); } while (0)
                {
                    const v4u w0 = *(const LAS v4u*)(swt), w1 = *(const LAS v4u*)(swt + 4), w2 = *(const LAS v4u*)(swt + 8), w3 = *(const LAS v4u*)(swt + 12);
                    HROW_ISSUE(vb[0], P.V8, w0.x); HROW_ISSUE(vb[1], P.V8, w0.y); HROW_ISSUE(vb[2], P.V8, w0.z); HROW_ISSUE(vb[3], P.V8, w0.w);
                    HROW_ISSUE(vb[4], P.V8, w1.x); HROW_ISSUE(vb[5], P.V8, w1.y); HROW_ISSUE(vb[6], P.V8, w1.z); HROW_ISSUE(vb[7], P.V8, w1.w);
                    HROW_ISSUE(vb[8], P.V8, w2.x); HROW_ISSUE(vb[9], P.V8, w2.y); HROW_ISSUE(vb[10], P.V8, w2.z); HROW_ISSUE(vb[11], P.V8, w2.w);
                    HROW_ISSUE(vb[12], P.V8, w3.x); HROW_ISSUE(vb[13], P.V8, w3.y); HROW_ISSUE(vb[14], P.V8, w3.z); HROW_ISSUE(vb[15], P.V8, w3.w);
                }
                v4u wa = *(const LAS v4u*)(swt + 16), wb = *(const LAS v4u*)(swt + 20);
#pragma unroll 1
                for (int i0 = 0; i0 < 112; i0 += 16) {
                    const v4u wc = *(const LAS v4u*)(swt + i0 + 24), wd = *(const LAS v4u*)(swt + i0 + 28);
                    V_CHUNK(i0, 0, wa, wb, 15, 15, 15, 15, 15, 15, 15, 15, 1);
                    wa = *(const LAS v4u*)(swt + i0 + 32); wb = *(const LAS v4u*)(swt + i0 + 36);
                    V_CHUNK(i0 + 8, 8, wc, wd, 15, 15, 15, 15, 15, 15, 15, 15, 1);
                }
                V_CHUNK(112, 0, wa, wb, 15, 14, 13, 12, 11, 10, 9, 8, 0);
                V_CHUNK(120, 8, wa, wb, 7, 6, 5, 4, 3, 2, 1, 0, 0);
                }
#undef V_CHUNK
#undef V_STEP
#undef V_F4
            }
            if (sub == 0) {
#pragma unroll
                for (int k = 0; k < 16; ++k) y0[k] = y[k]; }
            else {
                v4u xb[2][4]; f32x4 wv[8];
#pragma unroll
                for (int tt = 0; tt < 2; ++tt)
#pragma unroll
                    for (int m = 0; m < 4; ++m) xb[tt][m] = *((const v4u*)(P.X1B + (t0 + gq * 4 + 2 * tt + (lr >> 5)) * 1024 + 32 * l5) + m);
#pragma unroll
                for (int m = 0; m < 8; ++m) wv[m] = *(const f32x4*)(P.fin_w + (32 * l5 + 4 * m));
#pragma unroll
                for (int tt = 0; tt < 2; ++tt) {
                    float* xr = P.out + (t0 + gq * 4 + 2 * tt + (lr >> 5)) * 1024 + 32 * l5;
                    f32x4 x[8]; float ss = 0.f;
#pragma unroll
                    for (int m = 0; m < 8; ++m) { const unsigned q0 = (m & 1) ? xb[tt][m >> 1].z : xb[tt][m >> 1].x, q1 = (m & 1) ? xb[tt][m >> 1].w : xb[tt][m >> 1].y;
                        const h2 ya = tt ? y[2 * m] : y0[2 * m], yb = tt ? y[2 * m + 1] : y0[2 * m + 1];
                        x[m][0] = bflo(q0) + (float)ya[0] * (1.0f / 128.0f); x[m][1] = bfhi(q0) + (float)ya[1] * (1.0f / 128.0f); x[m][2] = bflo(q1) + (float)yb[0] * (1.0f / 128.0f); x[m][3] = bfhi(q1) + (float)yb[1] * (1.0f / 128.0f);
                        ss += (x[m][0] * x[m][0] + x[m][1] * x[m][1]) + (x[m][2] * x[m][2] + x[m][3] * x[m][3]); }
                    ss = row16_sum(ss);
                    ss += __builtin_bit_cast(float, __builtin_amdgcn_ds_swizzle(__builtin_bit_cast(int, ss), 0x401F));
                    const float rstd = 1.0f / sqrtf(ss * (1.0f / 1024.0f) + EPS);
#pragma unroll
                    for (int m = 0; m < 8; ++m) *(f32x4*)(xr + 4 * m) = x[m] * rstd * wv[m];
                }
            }
        }
    }
}
#undef HROW_ISSUE

__device__ __forceinline__ void p7_peer(LAS unsigned char* lds, const Ptrs& P, int vcu, int G, int tid, int lane, int wave) {
    LAS bf16* k1l = (LAS bf16*)lds;
    LAS bf16* k2l = (LAS bf16*)(lds + 32768);
    LAS int* idxl = (LAS int*)(lds + 65536);
    LAS float* gatel = (LAS float*)(lds + 98304);
    for (int i = tid; i < 2048; i += 512) { const int n = i >> 4, c = i & 15, d = n * 16 + (c ^ (n & 15)); ((LAS v4u*)k1l)[d] = ((const v4u*)P.K1)[i]; ((LAS v4u*)k2l)[d] = ((const v4u*)P.K2)[i]; }
    __syncthreads();
    for (int unit = vcu; unit < M / 64; unit += G) {
#pragma unroll 1
        for (int st = 0; st < 4; ++st) {
            const int g = st >> 1;
            if ((st & 1) == 0)
#pragma unroll 1
              for (int rep = 0; rep < PROBE_TOPK; ++rep) peer_topk_unit_mfma(P, (const LAS unsigned char*)k1l, (const LAS unsigned char*)k2l, idxl, gatel, unit, lane, wave, g, g + 1);
            else peer_gather_half(P, lds, unit, lane, wave, g, g + 1);
        }
        __syncthreads();
    }
}

struct Args { const float* in[19]; float* out; unsigned char* ws; int ph_lo, ph_hi; };
__global__ void __launch_bounds__(NWAVES * 64, 2) mega_fwd(Args args) {
    extern __shared__ __attribute__((aligned(16))) unsigned char lds_raw[];
    LAS unsigned char* lds = (LAS unsigned char*)lds_raw;
    const int tid = threadIdx.x, lane = tid & 63, wave = __builtin_amdgcn_readfirstlane(tid >> 6);
    const int G = gridDim.x; const int bx = blockIdx.x; const int vcu = (G % 8 == 0) ? (bx % 8) * (G / 8) + bx / 8 : bx;
    unsigned char* ws = args.ws;
    Ptrs P;
    P.x = args.in[0]; P.mix_w = args.in[1]; P.w_in = args.in[2]; P.rel_bias = args.in[3]; P.sinks = args.in[4]; P.w_pa = args.in[5]; P.ln_w = args.in[6]; P.ln_b = args.in[7];
    P.w_s = args.in[8]; P.b_s = args.in[9]; P.w_pb = args.in[10]; P.w_out = args.in[11]; P.ffn_w = args.in[12]; P.w_q = args.in[13]; P.keys1 = args.in[14]; P.keys2 = args.in[15];
    P.pu = args.in[16]; P.pv = args.in[17]; P.fin_w = args.in[18]; P.out = args.out;
    P.WIN8 = ws + WS_WIN; P.WPAB = (bf16*)(ws + WS_WPA); P.WOUT8 = ws + WS_WOUT; P.WQ8 = ws + WS_WQ;
    P.WINSC = (float*)(ws + WS_V + 131072); P.WQSC = (float*)(ws + WS_V + 163840); P.XSC = (float*)(ws + WS_V + 196608); P.WOUTSC = (float*)(ws + WS_V + 262144); P.MSC = (float*)(ws + WS_V + 327680);
    P.K1 = (bf16*)(ws + WS_K1); P.K2 = (bf16*)(ws + WS_K2); P.WS = (bf16*)(ws + WS_WS);
    P.U8 = ws + WS_U; P.V8 = ws + WS_U + 8 * MiB; P.USC = (float*)(ws + WS_V); P.VSC = (float*)(ws + WS_V + 65536); P.HSC = (float*)(ws + WS_HSC);
    P.XN8 = ws + WS_G1; P.MERGED8 = ws + WS_G1; P.HNQ = ws + WS_Q;
    P.GA = (bf16*)(ws + WS_G2); P.GB = (bf16*)(ws + WS_G2) + 1024; P.QP = (bf16*)(ws + WS_G2);
    P.AOUT = (bf16*)(ws + WS_G3); P.BOUT = (bf16*)(ws + WS_G3) + 512; P.X1B = (bf16*)(ws + WS_G3);
    P.Q = (bf16*)(ws + WS_Q); P.KV = (bf16*)(ws + WS_KV); P.GU = (bf16*)(ws + WS_GU); P.GV = (bf16*)(ws + WS_GV);

    for (int u = tid; u < (LDS_BYTES - MISC_OFF) / 4; u += NWAVES * 64) ((LAS unsigned*)(lds + MISC_OFF))[u] = 0u;
    __syncthreads();
    const int lo = args.ph_lo, hi = args.ph_hi;
    unsigned* barw = (unsigned*)(ws + WS_CTL) + CW_BAR;
    XcdBarrier bar; bar.bar = barw; bar.x = 0; bar.st = nullptr;
    if (hi - lo > 1) bar = xcd_barrier_post(barw, (volatile LAS unsigned*)(lds + MISC_OFF));
#define IN(k) (lo <= (k) && (k) < hi)
#define BOTH(k) (IN(k) && IN((k) + 1))
#define GRID_BAR() xcd_barrier(bar)
#define REPS(k) ((k) == PROBE_PHASE ? 2 : 1)
    unsigned* ctl = (unsigned*)(ws + WS_CTL);
    const bool grp = PANEL_SEAMS && (G == 256) && (lo == 0) && (hi == N_PHASES);
    const int pmb = 8 * (bx & 7) + ((bx >> 3) & 7), ucu = grp ? 4 * pmb + (bx >> 6) : vcu;
    bool rel_own = true, rel_kv = true;
    if (grp && tid == 0) __hip_atomic_store(ctl + 6144 + bx, 1u + xb_xcc_id(), __ATOMIC_RELAXED, __HIP_MEMORY_SCOPE_AGENT);
#define SEAM(k) do { if (grp) { asm volatile("s_waitcnt vmcnt(0)" ::: "memory"); __syncthreads(); \
        if (tid == 0) { if ((k) == 1 ? rel_kv : rel_own) { __builtin_amdgcn_fence(__ATOMIC_RELEASE, "agent"); asm volatile("s_waitcnt vmcnt(0)" ::: "memory"); } \
            unsigned* c_ = ctl + 8192 + 16 * (64 * (k) + pmb); (void)xb_add(c_, 1u); XB_SPIN(xb_ld(c_) < 4u, barw); \
            if ((k) == 1 && (pmb & 31) != 0) XB_SPIN(xb_ld(c_ - 16) < 4u, barw); \
            if (!PROBE_NOACQ) { __builtin_amdgcn_fence(__ATOMIC_ACQUIRE, "agent"); asm volatile("s_waitcnt vmcnt(0)" ::: "memory"); } } \
        __syncthreads(); } else if (BOTH(k)) GRID_BAR(); } while (0)

    if (IN(0)) {
#pragma unroll
        for (int rep = 0; rep < REPS(0); ++rep) { p0_prologue(lds, P, vcu, G, lane, wave); __syncthreads(); }
        if (BOTH(0)) GRID_BAR();
        if (grp) {
            const unsigned mine = 1u + xb_xcc_id(); bool own = true, nxt = true;
            for (int k = 0; k < 4; ++k) own = own && (__hip_atomic_load(ctl + 6144 + (pmb >> 3) + 8 * (pmb & 7) + 64 * k, __ATOMIC_RELAXED, __HIP_MEMORY_SCOPE_AGENT) == mine);
            const int pn_ = pmb + 1;
            if (pn_ < 64 && (pn_ & 31) != 0)
                for (int k = 0; k < 4; ++k) nxt = nxt && (__hip_atomic_load(ctl + 6144 + (pn_ >> 3) + 8 * (pn_ & 7) + 64 * k, __ATOMIC_RELAXED, __HIP_MEMORY_SCOPE_AGENT) == mine);
            rel_own = !own || PANEL_FORCE_RELEASE; rel_kv = !own || !nxt || PANEL_FORCE_RELEASE; } }

    if (IN(1)) {
        pg8::Gemm g{(const pg8::bf16_t*)P.XN8, (const pg8::bf16_t*)P.WIN8, M, NZ, D / 2, D / 2, P.XSC, P.WINSC}; pg8::StaticOrder S; S.init(M, NZ, G, bx);
        pg8::EpiZ E{P.Q, P.KV, P.GU, P.GV, P.GA, P.GB};
#pragma unroll
        for (int rep = 0; rep < REPS(1); ++rep) pg8::gemm_phase<pg8::EpiZ, pg8::StaticOrder, PG8_ALIGN, PG8_SP2, true>(lds, g, S, E);
        SEAM(1);
    }

    if (IN(2)) {
        for (int rep = 0; rep < REPS(2); ++rep) {
        p2_attn_mfma(lds, P, ucu, G, tid, lane, wave);
        p2_gmlp_mfma(lds, P, ucu, G, tid, lane, wave);
        }
        SEAM(2);
    }

    if (IN(3)) {
#pragma unroll
      for (int rep = 0; rep < REPS(3); ++rep) {
        { pg8::Gemm g{P.AOUT, P.WPAB, M, D, 1024, AB_LD, nullptr, nullptr}; pg8::StaticOrder S; S.init(M, D, G, bx);
          pg8::EpiMerge2 E{P.GA, P.MERGED8, P.MSC, (unsigned*)(ws + WS_END + 524288), (unsigned*)(ws + WS_CTL) + 4096 + 1024, barw, (LAS float*)(lds + 131072)};
          pg8::gemm_phase<pg8::EpiMerge2, pg8::StaticOrder, PG8_ALIGN, PG8_SP2>(lds, g, S, E); }
      }
        SEAM(3);
    }

    if (IN(4)) {
        pg8::Gemm g{(const pg8::bf16_t*)P.MERGED8, (const pg8::bf16_t*)P.WOUT8, M, D, D / 2, D / 2, P.MSC, P.WOUTSC}; pg8::StaticOrder S; S.init(M, D, G, bx);
        pg8::EpiResLn E{P.x, P.ffn_w, (pg8::bf16_t*)P.X1B, P.HNQ, P.HSC, (unsigned long long*)(ws + WS_END), (unsigned*)(ws + WS_CTL) + 4096, barw, (LAS float*)(lds + 131072)};
#pragma unroll
        for (int rep = 0; rep < REPS(4); ++rep) pg8::gemm_phase<pg8::EpiResLn, pg8::StaticOrder, PG8_ALIGN, PG8_SP2, true>(lds, g, S, E);
        SEAM(4);
    }

    if (IN(6)) {
        pg8::Gemm g{(const pg8::bf16_t*)P.HNQ, (const pg8::bf16_t*)P.WQ8, M, 2048, D / 2, D / 2, P.HSC, P.WQSC}; pg8::StaticOrder S; S.init(M, 2048, G, bx);
        pg8::EpiPlain E{P.QP, 2048};
#pragma unroll
        for (int rep = 0; rep < REPS(6); ++rep) pg8::gemm_phase<pg8::EpiPlain, pg8::StaticOrder, PG8_ALIGN, PG8_SP2, true>(lds, g, S, E);
        SEAM(6);
    }

    if (IN(7)) {
#pragma unroll 1
        for (int rep = 0; rep < REPS(7); ++rep) p7_peer(lds, P, ucu, G, tid, lane, wave);
    }
#undef IN
#undef BOTH
#undef GRID_BAR
}

extern "C" void kernel_launch(void* const* d_in, const int* in_sizes, int n_in, void* d_out, int out_size, void* d_ws, size_t ws_size, hipStream_t stream) {
    static int grid = 0;
    if (grid == 0) {
        if (n_in != 19 || out_size != M * D || ws_size < WS_END + MiB) { fprintf(stderr, "kernel_launch: unexpected shapes (n_in %d, out %d, ws %zu)\n", n_in, out_size, ws_size); grid = -1; return; }
        int dev = 0, cus = 0, per_cu = 0;
        if (hipGetDevice(&dev) != hipSuccess || hipDeviceGetAttribute(&cus, hipDeviceAttributeMultiprocessorCount, dev) != hipSuccess) { grid = -1; return; }
        if (hipFuncSetAttribute((const void*)mega_fwd, hipFuncAttributeMaxDynamicSharedMemorySize, LDS_BYTES) != hipSuccess) { fprintf(stderr, "kernel_launch: hipFuncSetAttribute failed\n"); grid = -1; return; }
        if (hipOccupancyMaxActiveBlocksPerMultiprocessor(&per_cu, (const void*)mega_fwd, NWAVES * 64, LDS_BYTES) != hipSuccess || per_cu < 1)
            fprintf(stderr, "kernel_launch: note: occupancy query reports %d workgroups per CU\n", per_cu);
        (void)hipGetLastError();
        grid = cus;
    }
    if (grid < 0) return;
    if (hipMemsetAsync((char*)d_ws + WS_CTL, 0, CTL_ZERO_BYTES, stream) != hipSuccess) return;
    Args a{};
    for (int i = 0; i < 19; ++i) a.in[i] = (const float*)d_in[i];
    a.out = (float*)d_out; a.ws = (unsigned char*)d_ws;
    a.ph_lo = 0; a.ph_hi = N_PHASES;
    hipLaunchKernelGGL(mega_fwd, dim3(grid), dim3(NWAVES * 64), LDS_BYTES, stream, a);
}
```

```cpp
#include <hip/hip_runtime.h>
#include <cstdio>
#include <cstdint>
#define TAB_P0_ROWS 26624
#ifndef PROBE_SWEEPS
#define PROBE_SWEEPS 1
#endif
#ifndef PANEL_SEAMS
#define PANEL_SEAMS 1
#endif
#ifndef PANEL_FORCE_RELEASE
#define PANEL_FORCE_RELEASE 0
#endif
#ifndef PROBE_NOACQ
#define PROBE_NOACQ 0
#endif
#ifndef XB
#define XB 2
#endif
#ifndef MIDB
#define MIDB 4
#endif
#ifndef PROBE_TOPK
#define PROBE_TOPK 1
#endif
#ifndef TAB_P0_ROWS
#define TAB_P0_ROWS 24576
#endif
#ifndef STAGE_ORDER_B
#define STAGE_ORDER_B 2
#endif
#ifndef NT_P7
#define NT_P7 4
#endif
#define NT_LD(PTR) ((NT_P7 == 1 || NT_P7 == 2) ? __builtin_nontemporal_load(PTR) : *(PTR))
#define NT_ST(PTR, VAL) do { if (NT_P7 >= 2) __builtin_nontemporal_store((VAL), (PTR)); else *(PTR) = (VAL); } while (0)
#ifndef NT_EPI
#define NT_EPI 0
#endif
#ifndef TAB_LATE
#define TAB_LATE 1
#endif
#ifndef PROBE_DUP
#define PROBE_DUP 0
#endif
#ifndef PROBE_PHASE
#define PROBE_PHASE -1
#endif
#ifndef FP4_SELFCHECK
#define FP4_SELFCHECK 0
#endif
#ifndef NSL
#define NSL 8
#endif
#ifndef Q4_USTEP
#define Q4_USTEP 0.36f
#endif
#ifndef Q4_VUNIT
#define Q4_VUNIT 0.5f
#endif
namespace pg8 {
#define PG8_LAS __attribute__((address_space(3)))
typedef unsigned short bf16_t;
typedef short bf16x8 __attribute__((ext_vector_type(8)));
typedef float f32x4 __attribute__((ext_vector_type(4)));
typedef unsigned u32x4 __attribute__((ext_vector_type(4)));
typedef int i32x4 __attribute__((ext_vector_type(4)));
constexpr int BM = 256, BK = 64, HALF = 128, HTB = HALF * BK * 2  , STAGE_BYTES = 8 * HTB, NXCD = 8, WGM = 8;

__host__ __device__ __forceinline__ int lds_byte(int r, int c) { const int st = (r >> 4) * 2 + (c >> 5), rr = r & 15, cc = c & 31, ob = rr * 64 + cc * 2; return st * 1024 + (ob ^ (((ob >> 9) & 1) << 5)); }
__host__ __device__ __forceinline__ void stage_rc(int b, int& R, int& C) { const int st = b / 1024, sb = b % 1024, swz = sb ^ (((sb >> 9) & 1) << 5); R = (st >> 1) * 16 + swz / 64; C = (st & 1) * 32 + (swz % 64) / 2; }
__host__ __device__ __forceinline__ int perm32(int rho) { const int n = rho >> 4, i = rho & 15; return 8 * (i >> 2) + 4 * n + (i & 3); }

struct Unit { int pm, pn; };
struct Gemm { const bf16_t* A; const bf16_t* Bt; int M, N, K, lda; const float* rs; const float* cs; };

struct StaticOrder {
    int nM, nN, nwg, G, c;
    __host__ __device__ void init(int M, int N, int G_, int c_) { nM = M / BM; nN = N / BM; nwg = nM * nN; G = G_; c = c_; }
    __host__ __device__ bool next(int i, Unit& u) const {
        const long L = (long)i * G + c; if (L >= nwg) return false;
        int wgid = (int)L; { const int q = nwg / NXCD, r = nwg % NXCD, xcd = wgid % NXCD, off = wgid / NXCD; wgid = (xcd < r ? xcd * (q + 1) : r * (q + 1) + (xcd - r) * q) + off; }
        const int nig = WGM * nN, gid = wgid / nig, fm = gid * WGM, gsz = (nM - fm) < WGM ? (nM - fm) : WGM;
        u.pm = fm + ((wgid % nig) % gsz); u.pn = (wgid % nig) / gsz; return true;
    }
    __device__ __forceinline__ void a_ready(const Unit&) const {}
    __device__ __forceinline__ void done(const Unit&) const {}
};

__device__ __forceinline__ unsigned cvt_pk_bf16(float lo, float hi) { unsigned r; asm volatile("v_cvt_pk_bf16_f32 %0, %1, %2" : "=v"(r) : "v"(lo), "v"(hi)); return r; }
typedef float f32x2 __attribute__((ext_vector_type(2)));
template <class Epi, class Sched, bool ALIGN_EPI = false, bool SP2 = false, bool I8 = false>
__device__ __forceinline__ void gemm_phase(PG8_LAS unsigned char* lds, const Gemm g, const Sched& S, const Epi& E) {
    const int tid = threadIdx.x, wid = __builtin_amdgcn_readfirstlane(tid >> 6), lane = tid & 63, wr = wid >> 2, wc = wid & 3, fr = lane & 15, fq = lane >> 4;
    const int K = g.K, nt = K / BK;
    unsigned voffA[2], voffB[2];
#pragma unroll
    for (int i = 0; i < 2; ++i) { int R, C; stage_rc(tid * 16 + i * 8192, R, C); const int Rb = Epi::PERM ? ((R & ~31) + perm32(R & 31)) : R;
        voffA[i] = (unsigned)(R * g.lda + C) * 2u; voffB[i] = (unsigned)(Rb * K + C) * 2u; }
    const size_t kstep = (size_t)(BK * 2);
    const size_t hstep = (size_t)HALF * K * 2;
    const size_t tstep = 2 * hstep;
    const size_t hstepA = (size_t)HALF * g.lda * 2, tstepA = 2 * hstepA;
    const unsigned ldsw = (unsigned)wid * 1024u;
    const int aoff = lds_byte(wr * 64 + fr, fq * 8), boff = lds_byte(wc * 32 + fr, fq * 8);
#define PG8_SA(b, h) (((b) * 2 + (h)) * HTB)
#define PG8_SB(b, h) ((4 + (b) * 2 + (h)) * HTB)
#define PG8_STAGE(bufoff, gbase, voff) do { _Pragma("unroll") for (int _i = 0; _i < 2; ++_i) \
        __builtin_amdgcn_global_load_lds((const unsigned*)((const char*)(gbase) + (voff)[_i]), (PG8_LAS unsigned*)(lds + (bufoff) + ldsw + _i * 8192), 16, 0, 0); } while (0)
#define PG8_LDA(dst, b, h) do { _Pragma("unroll") for (int m = 0; m < 4; ++m) _Pragma("unroll") for (int k = 0; k < 2; ++k) dst[m][k] = *(const PG8_LAS bf16x8*)(lds + PG8_SA(b, h) + aoff + m * 2048 + k * 1024); } while (0)
#define PG8_LDB(dst, b, h) do { _Pragma("unroll") for (int n = 0; n < 2; ++n) _Pragma("unroll") for (int k = 0; k < 2; ++k) dst[n][k] = *(const PG8_LAS bf16x8*)(lds + PG8_SB(b, h) + boff + n * 2048 + k * 1024); } while (0)
#define PG8_MMA(ai, bj, At, Bt) do { __builtin_amdgcn_s_setprio(1); _Pragma("unroll") for (int m = 0; m < 4; ++m) _Pragma("unroll") for (int n = 0; n < 2; ++n) _Pragma("unroll") for (int k = 0; k < 2; ++k) \
        { if constexpr (I8) acc[ai][bj][m][n] = __builtin_bit_cast(f32x4, __builtin_amdgcn_mfma_i32_16x16x64_i8(__builtin_bit_cast(i32x4, Bt[n][k]), __builtin_bit_cast(i32x4, At[m][k]), __builtin_bit_cast(i32x4, acc[ai][bj][m][n]), 0, 0, 0)); \
          else acc[ai][bj][m][n] = __builtin_amdgcn_mfma_f32_16x16x32_bf16(Bt[n][k], At[m][k], acc[ai][bj][m][n], 0, 0, 0); } __builtin_amdgcn_s_setprio(0); } while (0)
#define PG8_WAIT_V(n) asm volatile("s_waitcnt vmcnt(" #n ")" ::: "memory")
#define PG8_WAIT_L(n) asm volatile("s_waitcnt lgkmcnt(" #n ")" ::: "memory")
#define PG8_BAR __builtin_amdgcn_s_barrier()
#define PG8_SCHED __builtin_amdgcn_sched_barrier(0)
    Unit cur, nxt; int ui = 0;
    if (!S.next(0, cur)) return;
    f32x4 acc[2][2][4][2];
#pragma unroll
    for (int a = 0; a < 2; ++a)
#pragma unroll
        for (int b = 0; b < 2; ++b)
#pragma unroll
            for (int m = 0; m < 4; ++m)
#pragma unroll
                for (int n = 0; n < 2; ++n) acc[a][b][m][n] = (f32x4){0.f, 0.f, 0.f, 0.f};
    bf16x8 At[4][2], B0[2][2], B1[2][2];
    const char* cA = (const char*)g.A + (size_t)cur.pm * tstepA; const char* cB = (const char*)g.Bt + (size_t)cur.pn * tstep;
    S.a_ready(cur);
    float sreg = 0.f; PG8_LAS float* scl = (PG8_LAS float*)(lds + 147456);
    if constexpr (I8) sreg = (tid < 256) ? g.rs[cur.pm * BM + tid] : g.cs[cur.pn * BM + tid - 256];
    if constexpr (SP2) {
        PG8_STAGE(PG8_SB(0, 0), cB, voffB); PG8_STAGE(PG8_SB(0, 1), cB + hstep, voffB); PG8_STAGE(PG8_SA(0, 0), cA, voffA); PG8_STAGE(PG8_SA(0, 1), cA + hstepA, voffA);
        if (wr == 1) PG8_BAR;
        PG8_WAIT_V(2); PG8_BAR;
        PG8_STAGE(PG8_SB(1, 0), cB + kstep, voffB); PG8_STAGE(PG8_SA(1, 0), cA + kstep, voffA); PG8_STAGE(PG8_SB(1, 1), cB + hstep + kstep, voffB);
        PG8_WAIT_V(6); PG8_BAR;
    } else {
        PG8_STAGE(PG8_SB(0, 0), cB, voffB); PG8_STAGE(PG8_SA(0, 0), cA, voffA); PG8_STAGE(PG8_SB(0, 1), cB + hstep, voffB); PG8_STAGE(PG8_SA(0, 1), cA + hstepA, voffA);
        if (wr == 1) PG8_BAR;
        PG8_WAIT_V(4); PG8_BAR;
        PG8_STAGE(PG8_SB(1, 0), cB + kstep, voffB); PG8_STAGE(PG8_SA(1, 0), cA + kstep, voffA); PG8_STAGE(PG8_SB(1, 1), cB + hstep + kstep, voffB);
        PG8_WAIT_V(6); PG8_BAR;
    }
    if constexpr (I8) scl[tid] = sreg;
    for (;;) {
        const bool has_next = S.next(ui + 1, nxt);
        const char* nA = has_next ? (const char*)g.A + (size_t)nxt.pm * tstepA : cA; const char* nB = has_next ? (const char*)g.Bt + (size_t)nxt.pn * tstep : cB;
        for (int t = 0; t < nt; t += 2) {
            if constexpr (Epi::HAS_MID) { if (t == (nt >> 1)) E.mid(acc, cur, wr, wc, fr, fq); }
            const bool last = (t == nt - 2);
            const char* a1 = cA + (size_t)(t + 1) * kstep;
            const char* a2 = last ? nA : cA + (size_t)(t + 2) * kstep; const char* b2 = last ? nB : cB + (size_t)(t + 2) * kstep;
            const char* a3 = a2 + kstep; const char* b3 = b2 + kstep;
            if (last && has_next) S.a_ready(nxt);
            if constexpr (SP2) {
            PG8_LDB(B0, 0, 0); PG8_LDB(B1, 0, 1); PG8_SCHED; PG8_LDA(At, 0, 0); PG8_STAGE(PG8_SA(1, 1), a1 + hstepA, voffA);
            PG8_WAIT_V(8); PG8_WAIT_L(0); PG8_BAR; PG8_MMA(0, 0, At, B0); PG8_MMA(0, 1, At, B1); PG8_BAR; PG8_SCHED;
            PG8_LDA(At, 0, 1); PG8_STAGE(PG8_SB(0, 0), b2, voffB); PG8_STAGE(PG8_SB(0, 1), b2 + hstep, voffB); PG8_STAGE(PG8_SA(0, 0), a2, voffA);
            PG8_WAIT_V(8); PG8_WAIT_L(0); PG8_BAR; PG8_MMA(1, 0, At, B0); PG8_MMA(1, 1, At, B1); PG8_BAR; PG8_SCHED;
            PG8_LDB(B0, 1, 0); PG8_LDB(B1, 1, 1); PG8_SCHED; PG8_LDA(At, 1, 0); PG8_STAGE(PG8_SA(0, 1), a2 + hstepA, voffA);
            PG8_WAIT_V(8); PG8_WAIT_L(0); PG8_BAR; PG8_MMA(0, 0, At, B0); PG8_MMA(0, 1, At, B1); PG8_BAR; PG8_SCHED;
            PG8_LDA(At, 1, 1); PG8_STAGE(PG8_SB(1, 0), b3, voffB); PG8_STAGE(PG8_SB(1, 1), b3 + hstep, voffB); PG8_STAGE(PG8_SA(1, 0), a3, voffA);
            PG8_WAIT_V(8); PG8_WAIT_L(0); PG8_BAR; PG8_MMA(1, 0, At, B0); PG8_MMA(1, 1, At, B1); PG8_BAR; PG8_SCHED;
            } else {
            PG8_LDB(B0, 0, 0); PG8_SCHED; PG8_LDA(At, 0, 0); PG8_STAGE(PG8_SA(1, 1), a1 + hstepA, voffA);
            PG8_WAIT_L(8); PG8_BAR; PG8_WAIT_L(0); PG8_MMA(0, 0, At, B0); PG8_BAR; PG8_SCHED;
            PG8_LDB(B1, 0, 1); PG8_STAGE(PG8_SB(0, 0), b2, voffB);
            PG8_BAR; PG8_WAIT_L(0); PG8_MMA(0, 1, At, B1); PG8_BAR;
            PG8_LDA(At, 0, 1); PG8_STAGE(PG8_SA(0, 0), a2, voffA);
            PG8_BAR; PG8_WAIT_L(0); PG8_MMA(1, 0, At, B0); PG8_BAR; PG8_SCHED;
            PG8_STAGE(PG8_SB(0, 1), b2 + hstep, voffB);
            PG8_WAIT_V(6); PG8_BAR; PG8_MMA(1, 1, At, B1); PG8_BAR;
            PG8_LDB(B0, 1, 0); PG8_SCHED; PG8_LDA(At, 1, 0); PG8_STAGE(PG8_SA(0, 1), a2 + hstepA, voffA);
            PG8_WAIT_L(8); PG8_BAR; PG8_WAIT_L(0); PG8_MMA(0, 0, At, B0); PG8_BAR; PG8_SCHED;
            PG8_LDB(B1, 1, 1); PG8_STAGE(PG8_SB(1, 0), b3, voffB);
            PG8_BAR; PG8_WAIT_L(0); PG8_MMA(0, 1, At, B1); PG8_BAR;
            PG8_LDA(At, 1, 1); PG8_STAGE(PG8_SA(1, 0), a3, voffA);
            PG8_BAR; PG8_WAIT_L(0); PG8_MMA(1, 0, At, B0); PG8_BAR; PG8_SCHED;
            PG8_STAGE(PG8_SB(1, 1), b3 + hstep, voffB);
            PG8_WAIT_V(6); PG8_BAR; PG8_MMA(1, 1, At, B1); PG8_BAR;
            }
        }
        if constexpr (ALIGN_EPI) { if (wr == 0) PG8_BAR; }
        if constexpr (I8) {
            if (has_next) sreg = (tid < 256) ? g.rs[nxt.pm * BM + tid] : g.cs[nxt.pn * BM + tid - 256];
            f32x4 csv[2][2];
#pragma unroll
            for (int bj = 0; bj < 2; ++bj)
#pragma unroll
                for (int n = 0; n < 2; ++n) csv[bj][n] = *(const PG8_LAS f32x4*)(scl + (ui & 1) * 512 + 256 + bj * HALF + wc * 32 + (Epi::PERM ? 8 * fq + 4 * n : 16 * n + 4 * fq));
#pragma unroll
            for (int ai = 0; ai < 2; ++ai)
#pragma unroll
                for (int m = 0; m < 4; ++m) { const float rsv = scl[(ui & 1) * 512 + ai * HALF + wr * 64 + m * 16 + fr];
#pragma unroll
                    for (int bj = 0; bj < 2; ++bj)
#pragma unroll
                        for (int n = 0; n < 2; ++n) { const i32x4 iv = __builtin_bit_cast(i32x4, acc[ai][bj][m][n]); f32x4 fv;
                            fv[0] = (float)iv[0]; fv[1] = (float)iv[1]; fv[2] = (float)iv[2]; fv[3] = (float)iv[3];
                            acc[ai][bj][m][n] = fv * rsv * csv[bj][n]; } }
        }
        if constexpr (!Epi::AFTER_DRAIN) { E(acc, cur, wr, wc, fr, fq); S.done(cur); }
        if (!has_next) break;
        if constexpr (I8) scl[((ui + 1) & 1) * 512 + tid] = sreg;
#pragma unroll
        for (int a = 0; a < 2; ++a)
#pragma unroll
            for (int b = 0; b < 2; ++b)
#pragma unroll
                for (int m = 0; m < 4; ++m)
#pragma unroll
                    for (int n = 0; n < 2; ++n) acc[a][b][m][n] = (f32x4){0.f, 0.f, 0.f, 0.f};
        cur = nxt; cA = nA; cB = nB; ++ui;
        if constexpr (ALIGN_EPI) { if (wr == 1) PG8_BAR; }
    }
    PG8_WAIT_V(0);
    if constexpr (!ALIGN_EPI) { if (wr == 0) PG8_BAR; }
    PG8_BAR;
    if constexpr (Epi::AFTER_DRAIN) { E.fused(acc, cur, wr, wc, fr, fq, lds, wid, lane); S.done(cur); }
#undef PG8_SA
#undef PG8_SB
#undef PG8_STAGE
#undef PG8_LDA
#undef PG8_LDB
#undef PG8_MMA
#undef PG8_WAIT_V
#undef PG8_WAIT_L
#undef PG8_BAR
#undef PG8_SCHED
}
}
#ifndef PG8_SP2
#define PG8_SP2 true
#endif
#ifndef PG8_ALIGN
#define PG8_ALIGN true
#endif

constexpr int NWAVES = 8;
constexpr int N_PHASES = 8;
#define SLSH (NSL == 4 ? 12 : NSL == 2 ? 13 : NSL == 64 ? 8 : NSL == 32 ? 9 : NSL == 16 ? 10 : 11)

constexpr int NB = 2, SEQ = 8192, D = 1024, M = NB * SEQ;
constexpr int NZ = 3840;
constexpr float EPS = 1e-6f;
constexpr int AB_LD = 1024;

constexpr size_t MiB = 1u << 20;
constexpr size_t WS_CTL = 0, CTL_ZERO_BYTES = 65536;
constexpr size_t WS_WIN = 1 * MiB;
constexpr size_t WS_WPA = 9 * MiB;
constexpr size_t WS_WOUT = 11 * MiB;
constexpr size_t WS_WQ = 13 * MiB;
constexpr size_t WS_K1 = 17 * MiB;
constexpr size_t WS_K2 = 17 * MiB + 32768;
constexpr size_t WS_WS = 17 * MiB + 65536;
constexpr size_t WS_U = 18 * MiB;
constexpr size_t WS_V = 34 * MiB;
constexpr size_t WS_G1 = 36 * MiB;
constexpr size_t WS_G2 = 68 * MiB;
constexpr size_t WS_G3 = 132 * MiB;
constexpr size_t WS_Q = 164 * MiB;
constexpr size_t WS_KV = 180 * MiB;
constexpr size_t WS_GU = 188 * MiB;
constexpr size_t WS_GV = 204 * MiB;
constexpr size_t WS_HSC = 220 * MiB;
constexpr size_t WS_END = 221 * MiB;
constexpr int CW_BAR = 0;

constexpr int RING_BYTES = 131072;
constexpr int MISC_OFF = 143360;
constexpr int LDS_BYTES = 151552;

#define GAS __attribute__((address_space(1)))
#define LAS __attribute__((address_space(3)))
typedef unsigned short bf16;
typedef unsigned v4u __attribute__((ext_vector_type(4)));
typedef unsigned v2u __attribute__((ext_vector_type(2)));
typedef float f32x4 __attribute__((ext_vector_type(4)));
typedef _Float16 h2 __attribute__((ext_vector_type(2)));
typedef GAS unsigned gu32;
typedef __bf16 bf16x2_t __attribute__((ext_vector_type(2)));
#define RLX_AGENT __ATOMIC_RELAXED, __HIP_MEMORY_SCOPE_AGENT
#define LDS_WAIT() asm volatile("s_waitcnt lgkmcnt(0)" ::: "memory")
#define VM_WAIT() asm volatile("s_waitcnt vmcnt(0)" ::: "memory")
__device__ __forceinline__ unsigned f2bf(float f) { unsigned u = __builtin_bit_cast(unsigned, f); return (u + 0x7fffu + ((u >> 16) & 1u)) >> 16; }
__device__ __forceinline__ unsigned pk2(float lo, float hi) { return f2bf(lo) | (f2bf(hi) << 16); }
__device__ __forceinline__ float bflo(unsigned w) { return __builtin_bit_cast(float, w << 16); }
__device__ __forceinline__ float bfhi(unsigned w) { return __builtin_bit_cast(float, w & 0xffff0000u); }
__device__ __forceinline__ float bf2f(bf16 h) { return __builtin_bit_cast(float, (unsigned)h << 16); }
__device__ __forceinline__ float dot2bf(unsigned a, unsigned b, float c) { return __builtin_amdgcn_fdot2_f32_bf16(__builtin_bit_cast(bf16x2_t, a), __builtin_bit_cast(bf16x2_t, b), c, false); }
__device__ __forceinline__ float gelu_tanh(float v) {
    const float t2 = v * (-2.302208198f + (-0.1029432397f) * v * v);
    return v * __builtin_amdgcn_rcpf(1.0f + __builtin_amdgcn_exp2f(t2));
}
__device__ __forceinline__ float sigmoid_f(float v) { return __builtin_amdgcn_rcpf(1.0f + __builtin_amdgcn_exp2f(-1.4426950409f * v)); }
template <int CTRL> __device__ __forceinline__ float dppmov(float v) { return __builtin_bit_cast(float, __builtin_amdgcn_update_dpp(0, __builtin_bit_cast(int, v), CTRL, 0xF, 0xF, false)); }
__device__ __forceinline__ float row16_sum(float v) {
    v += dppmov<0xB1>(v);
    v += dppmov<0x4E>(v);
    v += dppmov<0x141>(v);
    v += dppmov<0x140>(v);
    return v;
}
__device__ __forceinline__ int row16_isum(int v) {
    v += __builtin_amdgcn_update_dpp(0, v, 0xB1, 0xF, 0xF, false);
    v += __builtin_amdgcn_update_dpp(0, v, 0x4E, 0xF, 0xF, false);
    v += __builtin_amdgcn_update_dpp(0, v, 0x141, 0xF, 0xF, false);
    v += __builtin_amdgcn_update_dpp(0, v, 0x140, 0xF, 0xF, false);
    return v;
}
__device__ __forceinline__ float xor32_f(float v) {
    const unsigned u = __builtin_bit_cast(unsigned, v);
    auto rr = __builtin_amdgcn_permlane32_swap(u, u, false, false);
    const unsigned r0 = rr[0], r1 = rr[1];
    return __builtin_bit_cast(float, (__lane_id() & 32) ? r0 : r1);
}
__device__ __forceinline__ float wave_sum(float v) {
    v = row16_sum(v);
    v += __builtin_bit_cast(float, __builtin_amdgcn_ds_swizzle(__builtin_bit_cast(int, v), 0x401F));
    const unsigned u = __builtin_bit_cast(unsigned, v);
    auto rr = __builtin_amdgcn_permlane32_swap(u, u, false, false);
    const unsigned r0 = rr[0], r1 = rr[1];
    return __builtin_bit_cast(float, r0) + __builtin_bit_cast(float, r1);
}
template <int N> __device__ __forceinline__ void wave_sum_n(float (&v)[N]) {
#pragma unroll
    for (int k = 0; k < N; ++k) v[k] += dppmov<0xB1>(v[k]);
#pragma unroll
    for (int k = 0; k < N; ++k) v[k] += dppmov<0x4E>(v[k]);
#pragma unroll
    for (int k = 0; k < N; ++k) v[k] += dppmov<0x141>(v[k]);
#pragma unroll
    for (int k = 0; k < N; ++k) v[k] += dppmov<0x140>(v[k]);
#pragma unroll
    for (int k = 0; k < N; ++k) v[k] += __builtin_bit_cast(float, __builtin_amdgcn_ds_swizzle(__builtin_bit_cast(int, v[k]), 0x401F));
#pragma unroll
    for (int k = 0; k < N; ++k) { const unsigned u = __builtin_bit_cast(unsigned, v[k]); auto rr = __builtin_amdgcn_permlane32_swap(u, u, false, false); const unsigned r0 = rr[0], r1 = rr[1];
        v[k] = __builtin_bit_cast(float, r0) + __builtin_bit_cast(float, r1); }
}
__device__ __forceinline__ float wave_max(float v) {
    v = fmaxf(v, dppmov<0xB1>(v)); v = fmaxf(v, dppmov<0x4E>(v)); v = fmaxf(v, dppmov<0x141>(v)); v = fmaxf(v, dppmov<0x140>(v));
    v = fmaxf(v, __builtin_bit_cast(float, __builtin_amdgcn_ds_swizzle(__builtin_bit_cast(int, v), 0x401F)));
    const unsigned u = __builtin_bit_cast(unsigned, v);
    auto rr = __builtin_amdgcn_permlane32_swap(u, u, false, false);
    const unsigned r0 = rr[0], r1 = rr[1];
    return fmaxf(__builtin_bit_cast(float, r0), __builtin_bit_cast(float, r1));
}
__device__ const unsigned char T5B[128] = {0, 1, 2, 3, 4, 5, 6, 7, 8, 9, 10, 11, 12, 13, 14, 15, 16, 16, 16, 17, 17, 18, 18, 18, 19, 19, 19, 20, 20, 20, 20, 21, 21, 21, 21, 22, 22, 22, 22, 22, 23, 23, 23, 23, 23, 23, 24, 24, 24, 24, 24, 24, 25, 25, 25, 25, 25, 25, 25, 26, 26, 26, 26, 26, 26, 26, 26, 27, 27, 27, 27, 27, 27, 27, 27, 27, 27, 28, 28, 28, 28, 28, 28, 28, 28, 28, 28, 29, 29, 29, 29, 29, 29, 29, 29, 29, 29, 29, 29, 30, 30, 30, 30, 30, 30, 30, 30, 30, 30, 30, 30, 30, 30, 31, 31, 31, 31, 31, 31, 31, 31, 31, 31, 31, 31, 31, 31, 31};
#define XB_TMO      128
#define XB_XCNT(j)  (256  + 64 * (j))
#define XB_XSUB(j)  (1280 + 64 * (j))
#define XB_XGEN(j)  (2304 + 64 * (j))
#define XB_TOP      3328
#define XB_TOPGEN   3392
#define XCD_BAR_WORDS 3456
#define XB_SPIN_CAP (1u << 18)

__device__ __forceinline__ unsigned xb_ld(unsigned* p)              { return __hip_atomic_load(p, __ATOMIC_RELAXED, __HIP_MEMORY_SCOPE_AGENT); }
__device__ __forceinline__ unsigned xb_add(unsigned* p, unsigned v) { return __hip_atomic_fetch_add(p, v, __ATOMIC_RELAXED, __HIP_MEMORY_SCOPE_AGENT); }
__device__ __forceinline__ unsigned xb_xcc_id() { return (unsigned)__builtin_amdgcn_s_getreg((3 << 11) | 20) & 0xFu; }
#define XB_SPIN(cond, bar) do { unsigned _sp = 0; while (cond) { __builtin_amdgcn_s_sleep(1); \
    if ((++_sp & 255u) == 0u) { if (xb_ld(&(bar)[XB_TMO])) break; if (_sp > XB_SPIN_CAP) { atomicAdd(&(bar)[XB_TMO], 1u); break; } } } } while (0)

struct XcdBarrier {
    unsigned* bar; unsigned x;
    volatile LAS unsigned* st;
};

__device__ __forceinline__ XcdBarrier xcd_barrier_post(unsigned* bar, volatile LAS unsigned* st) {
    XcdBarrier b; b.bar = bar; b.x = xb_xcc_id(); b.st = st;
    if (threadIdx.x == 0) (void)xb_add(&bar[XB_XCNT(b.x)], 1u);
    return b;
}
__device__ __forceinline__ void xcd_barrier_complete(unsigned* bar, unsigned x, unsigned& nloc, unsigned& nx) {
    const unsigned G = gridDim.x * gridDim.y * gridDim.z;
    unsigned sum, cnt, mine, sp = 0u;
    for (;;) {
        sum = 0u; cnt = 0u; mine = 0u;
#pragma unroll
        for (unsigned j = 0; j < 16; ++j) { const unsigned c = xb_ld(&bar[XB_XCNT(j)]); sum += c; cnt += (c > 0u) ? 1u : 0u; mine = (j == x) ? c : mine; }
        if (sum == G) break;
        __builtin_amdgcn_s_sleep(1);
        if ((++sp & 255u) == 0u) { if (xb_ld(&bar[XB_TMO])) break; if (sp > XB_SPIN_CAP) { atomicAdd(&bar[XB_TMO], 1u); break; } }
    }
    nloc = mine > 0u ? mine : 1u; nx = cnt > 0u ? cnt : 1u;
}

__device__ __forceinline__ void xcd_barrier(const XcdBarrier& b) {
    asm volatile("s_waitcnt vmcnt(0)" ::: "memory");
    __syncthreads();
    if (threadIdx.x == 0) {
        unsigned* bar = b.bar;
        __builtin_amdgcn_s_waitcnt(0);
        unsigned nloc = b.st[0], nx = b.st[1];
        if (nloc == 0u) { xcd_barrier_complete(bar, b.x, nloc, nx); b.st[0] = nloc; b.st[1] = nx; }
        const unsigned old = xb_add(&bar[XB_XSUB(b.x)], 1u);
        const unsigned gen = old / nloc;
        if (old + 1u == (gen + 1u) * nloc) {
            __builtin_amdgcn_fence(__ATOMIC_RELEASE, "agent");
            asm volatile("s_waitcnt vmcnt(0)" ::: "memory");
            const unsigned og = xb_add(&bar[XB_TOP], 1u);
            const unsigned tg = og / nx;
            if (og + 1u == (tg + 1u) * nx) xb_add(&bar[XB_TOPGEN], 1u);
            else XB_SPIN(xb_ld(&bar[XB_TOPGEN]) == tg, bar);
            __builtin_amdgcn_fence(__ATOMIC_ACQUIRE, "agent");
            xb_add(&bar[XB_XGEN(b.x)], 1u);
            asm volatile("s_waitcnt vmcnt(0)" ::: "memory");
        } else {
            XB_SPIN(xb_ld(&bar[XB_XGEN(b.x)]) == gen, bar);
            __builtin_amdgcn_fence(__ATOMIC_ACQUIRE, "agent");
            asm volatile("s_waitcnt vmcnt(0)" ::: "memory");
        }
    }
    __syncthreads();
}
#define ST16(PTR, VAL) (*(PTR) = (VAL))
#define ST16NT(PTR, VAL) do { if (NT_EPI) __builtin_nontemporal_store((VAL), (PTR)); else *(PTR) = (VAL); } while (0)
namespace pg8 {
struct EpiZ {
    static constexpr bool PERM = true, AFTER_DRAIN = false, HAS_MID = false;
    bf16_t *Q, *KV, *GU, *GV, *GA, *GB;
    __device__ __forceinline__ void operator()(const f32x4 (&acc)[2][2][4][2], const Unit& u, int wr, int wc, int fr, int fq) const {
        const int pn = u.pn; bf16_t* base; int ldc, colt, act;
        if (pn < 2)       { base = Q;  ldc = 512;  colt = pn * 256;        act = 0; }
        else if (pn == 2) { base = KV; ldc = 256;  colt = 0;               act = 0; }
        else if (pn < 5)  { base = GU; ldc = 512;  colt = (pn - 3) * 256;  act = 1; }
        else if (pn < 7)  { base = GV; ldc = 512;  colt = (pn - 5) * 256;  act = 1; }
        else if (pn < 11) { base = GA; ldc = 2048; colt = (pn - 7) * 256;  act = 2; }
        else              { base = GB; ldc = 2048; colt = (pn - 11) * 256; act = 2; }
        const int row0 = u.pm * BM + wr * 64 + fr, col0 = colt + wc * 32 + 8 * fq;
        bf16_t* gtile = GA + ((size_t)(u.pm * 8 + (pn - 7)) * 16 * 512 + threadIdx.x) * 8;
#pragma unroll
        for (int ai = 0; ai < 2; ++ai)
#pragma unroll
            for (int m = 0; m < 4; ++m) { bf16_t* rowp = base + (size_t)(row0 + ai * HALF + m * 16) * ldc + col0;
#pragma unroll
                for (int bj = 0; bj < 2; ++bj) { f32x4 v0 = acc[ai][bj][m][0], v1 = acc[ai][bj][m][1];
                    if (act == 1) {
#pragma unroll
                        for (int e = 0; e < 4; ++e) { v0[e] = gelu_tanh(v0[e]); v1[e] = gelu_tanh(v1[e]); }
                    } else if (act == 2) {
#pragma unroll
                        for (int e = 0; e < 4; ++e) { v0[e] = sigmoid_f(v0[e]); v1[e] = sigmoid_f(v1[e]); }
                    }
                    u32x4 w; w.x = cvt_pk_bf16(v0[0], v0[1]); w.y = cvt_pk_bf16(v0[2], v0[3]); w.z = cvt_pk_bf16(v1[0], v1[1]); w.w = cvt_pk_bf16(v1[2], v1[3]);
                    if (act == 2) ST16((u32x4*)(gtile + (size_t)((ai * 4 + m) * 2 + bj) * 4096), w); else ST16((u32x4*)(rowp + bj * HALF), w); } }
    }
};
struct EpiMerge2 {
    static constexpr bool PERM = true, AFTER_DRAIN = false, HAS_MID = true;
    const bf16_t* ga; unsigned char* out8; float* rs;
    unsigned* slots; unsigned* cnt; unsigned* bar; LAS float* tbl;
    __device__ __forceinline__ void mid(f32x4 (&acc)[2][2][4][2], const Unit& u, int wr, int wc, int fr, int fq) const {
        int tidm = threadIdx.x;
        asm volatile("" : "+v"(tidm));
#pragma unroll
        for (int ai = 0; ai < 2; ++ai)
#pragma unroll
          for (int m0 = 0; m0 < 4; m0 += MIDB) {
            u32x4 ga_[MIDB][2], gb_[MIDB][2];
#pragma unroll
            for (int mm = 0; mm < MIDB; ++mm) { const bf16_t* gp = ga + ((size_t)((u.pm * 8 + u.pn) * 16 + (ai * 4 + m0 + mm) * 2) * 512 + tidm) * 8;
#pragma unroll
                for (int bj = 0; bj < 2; ++bj) { ga_[mm][bj] = __builtin_nontemporal_load((const u32x4*)(gp + bj * 4096)); gb_[mm][bj] = *(const u32x4*)(gp + (size_t)4 * 16 * 4096 + bj * 4096); } }
#pragma unroll
            for (int mm = 0; mm < MIDB; ++mm)
#pragma unroll
                for (int bj = 0; bj < 2; ++bj) { const u32x4 a = ga_[mm][bj], b = gb_[mm][bj]; const int m = m0 + mm;
                    f32x4 r0, r1;
                    r0[0] = bflo(a.x) * __builtin_amdgcn_rcpf(fmaxf(bflo(b.x), 1e-20f)); r0[1] = bfhi(a.x) * __builtin_amdgcn_rcpf(fmaxf(bfhi(b.x), 1e-20f)); r0[2] = bflo(a.y) * __builtin_amdgcn_rcpf(fmaxf(bflo(b.y), 1e-20f)); r0[3] = bfhi(a.y) * __builtin_amdgcn_rcpf(fmaxf(bfhi(b.y), 1e-20f));
                    r1[0] = bflo(a.z) * __builtin_amdgcn_rcpf(fmaxf(bflo(b.z), 1e-20f)); r1[1] = bfhi(a.z) * __builtin_amdgcn_rcpf(fmaxf(bfhi(b.z), 1e-20f)); r1[2] = bflo(a.w) * __builtin_amdgcn_rcpf(fmaxf(bflo(b.w), 1e-20f)); r1[3] = bfhi(a.w) * __builtin_amdgcn_rcpf(fmaxf(bfhi(b.w), 1e-20f));
                    acc[ai][bj][m][0] = acc[ai][bj][m][0] * r0; acc[ai][bj][m][1] = acc[ai][bj][m][1] * r1; }
            asm volatile("" ::: "memory");
          }
    }
    __device__ __forceinline__ void operator()(f32x4 (&acc)[2][2][4][2], const Unit& u, int wr, int wc, int fr, int fq) const {
        int tid = threadIdx.x;
        int rl0 = wr * 64 + fr, col0 = u.pn * BM + wc * 32 + 8 * fq;
        asm volatile("" : "+v"(rl0), "+v"(col0), "+v"(tid));
        u32x4 gb_[2][4][2];
#pragma unroll
        for (int ai = 0; ai < 2; ++ai)
#pragma unroll
            for (int m = 0; m < 4; ++m)
#pragma unroll
                for (int bj = 0; bj < 2; ++bj) gb_[ai][m][bj] = __builtin_nontemporal_load((const u32x4*)(ga + ((size_t)((u.pm * 8 + 4 + u.pn) * 16 + (ai * 4 + m) * 2 + bj) * 512 + tid) * 8));
#pragma unroll
        for (int ai = 0; ai < 2; ++ai)
#pragma unroll
            for (int m = 0; m < 4; ++m) { const int rl = rl0 + ai * HALF + m * 16; float mx = 0.f;
#pragma unroll
                for (int bj = 0; bj < 2; ++bj) { const u32x4 b = gb_[ai][m][bj]; f32x4 v0 = acc[ai][bj][m][0], v1 = acc[ai][bj][m][1];
                    v0[0] *= fmaxf(bflo(b.x), 1e-20f); v0[1] *= fmaxf(bfhi(b.x), 1e-20f); v0[2] *= fmaxf(bflo(b.y), 1e-20f); v0[3] *= fmaxf(bfhi(b.y), 1e-20f);
                    v1[0] *= fmaxf(bflo(b.z), 1e-20f); v1[1] *= fmaxf(bfhi(b.z), 1e-20f); v1[2] *= fmaxf(bflo(b.w), 1e-20f); v1[3] *= fmaxf(bfhi(b.w), 1e-20f);
                    acc[ai][bj][m][0] = v0; acc[ai][bj][m][1] = v1;
                    mx = fmaxf(mx, fmaxf(fmaxf(fmaxf(fabsf(v0[0]), fabsf(v0[1])), fmaxf(fabsf(v0[2]), fabsf(v0[3]))), fmaxf(fmaxf(fabsf(v1[0]), fabsf(v1[1])), fmaxf(fabsf(v1[2]), fabsf(v1[3]))))); }
                mx = fmaxf(mx, __builtin_bit_cast(float, __builtin_amdgcn_ds_swizzle(__builtin_bit_cast(int, mx), 0x401F))); mx = fmaxf(mx, xor32_f(mx));
                if (fq == 0) tbl[rl * 4 + wc] = mx; }
        __syncthreads();
        float mx = 0.f;
        if (tid < 256) { const f32x4 t0 = *(const LAS f32x4*)(tbl + tid * 4); mx = fmaxf(fmaxf(t0[0], t0[1]), fmaxf(t0[2], t0[3]));
            __hip_atomic_store(slots + ((size_t)(u.pm * 4 + u.pn) * 256 + tid), __builtin_bit_cast(unsigned, mx), __ATOMIC_RELAXED, __HIP_MEMORY_SCOPE_AGENT); }
        asm volatile("s_waitcnt vmcnt(0)" ::: "memory");
        __syncthreads();
        if (tid == 0) { unsigned* c = cnt + 16 * u.pm; (void)xb_add(c, 1u); XB_SPIN(xb_ld(c) < 4u, bar); }
        __syncthreads();
        if (tid < 256) {
            unsigned pm_[4];
#pragma unroll
            for (int p = 0; p < 4; ++p) pm_[p] = __hip_atomic_load(slots + ((size_t)(u.pm * 4 + p) * 256 + tid), __ATOMIC_RELAXED, __HIP_MEMORY_SCOPE_AGENT);
            mx = fmaxf(fmaxf(__builtin_bit_cast(float, pm_[0]), __builtin_bit_cast(float, pm_[1])), fmaxf(__builtin_bit_cast(float, pm_[2]), __builtin_bit_cast(float, pm_[3])));
            const bool tiny = mx < 1e-30f;
            tbl[1024 + tid] = tiny ? 0.f : 127.0f / mx;
            if (u.pn == 0) rs[u.pm * BM + tid] = tiny ? 0.f : mx * (1.0f / 127.0f); }
        __syncthreads();
#pragma unroll
        for (int ai = 0; ai < 2; ++ai)
#pragma unroll
            for (int m = 0; m < 4; ++m) { const int rl = rl0 + ai * HALF + m * 16; const size_t rg = (size_t)(u.pm * BM + rl) * 1024; const float sc = tbl[1024 + rl];
#pragma unroll
                for (int bj = 0; bj < 2; ++bj) { const f32x4 h0 = acc[ai][bj][m][0] * sc, h1 = acc[ai][bj][m][1] * sc; unsigned q0 = 0u, q1 = 0u;
#pragma unroll
                    for (int e = 0; e < 4; ++e) { q0 |= (unsigned)((int)__builtin_rintf(h0[e]) & 255) << (8 * e); q1 |= (unsigned)((int)__builtin_rintf(h1[e]) & 255) << (8 * e); }
                    *(unsigned long long*)(out8 + rg + col0 + bj * HALF) = (unsigned long long)q0 | ((unsigned long long)q1 << 32); } }
    }
};
struct EpiResB {
    static constexpr bool PERM = true, AFTER_DRAIN = false, HAS_MID = false;
    const float* base; bf16_t* Cb;
    __device__ __forceinline__ void operator()(const f32x4 (&acc)[2][2][4][2], const Unit& u, int wr, int wc, int fr, int fq) const {
        const int row0 = u.pm * BM + wr * 64 + fr, col0 = u.pn * BM + wc * 32 + 8 * fq;
#pragma unroll
        for (int ai = 0; ai < 2; ++ai)
#pragma unroll
            for (int m = 0; m < 4; ++m) { const size_t ro = (size_t)(row0 + ai * HALF + m * 16) * 1024 + col0;
#pragma unroll
                for (int bj = 0; bj < 2; ++bj) { const f32x4 v0 = *(const f32x4*)(base + ro + bj * HALF) + acc[ai][bj][m][0], v1 = *(const f32x4*)(base + ro + bj * HALF + 4) + acc[ai][bj][m][1];
                    u32x4 w; w.x = cvt_pk_bf16(v0[0], v0[1]); w.y = cvt_pk_bf16(v0[2], v0[3]); w.z = cvt_pk_bf16(v1[0], v1[1]); w.w = cvt_pk_bf16(v1[2], v1[3]);
                    ST16((u32x4*)(Cb + ro + bj * HALF), w); } }
    }
};
struct EpiResLn {
    static constexpr bool PERM = true, AFTER_DRAIN = false, HAS_MID = false;
    const float* base; const float* w; bf16_t* Cb; unsigned char* hnq; float* hsc;
    unsigned long long* slots;
    unsigned* cnt;
    unsigned* bar;
    LAS float* tbl;
    __device__ __forceinline__ void operator()(f32x4 (&acc)[2][2][4][2], const Unit& u, int wr, int wc, int fr, int fq) const {
        int tid = threadIdx.x;
        int rl0 = wr * 64 + fr, col0 = u.pn * BM + wc * 32 + 8 * fq;
        asm volatile("" : "+v"(rl0), "+v"(col0), "+v"(tid));
        f32x4 wv[2][2];
#pragma unroll
        for (int bj = 0; bj < 2; ++bj) { wv[bj][0] = *(const f32x4*)(w + col0 + bj * HALF); wv[bj][1] = *(const f32x4*)(w + col0 + bj * HALF + 4); }
#pragma unroll
        for (int ai = 0; ai < 2; ++ai)
#pragma unroll
          for (int m0 = 0; m0 < 4; m0 += XB) {
            f32x4 xv[XB][2][2];
#pragma unroll
            for (int mm = 0; mm < XB; ++mm) { const size_t ro = (size_t)(u.pm * BM + rl0 + ai * HALF + (m0 + mm) * 16) * 1024 + col0;
#pragma unroll
                for (int bj = 0; bj < 2; ++bj) { xv[mm][bj][0] = *(const f32x4*)(base + ro + bj * HALF); xv[mm][bj][1] = *(const f32x4*)(base + ro + bj * HALF + 4); } }
#pragma unroll
            for (int mm = 0; mm < XB; ++mm) { const int m = m0 + mm; const int rl = rl0 + ai * HALF + m * 16;
                float ss = 0.f, mx = 0.f;
#pragma unroll
                for (int bj = 0; bj < 2; ++bj) { const f32x4 v0 = xv[mm][bj][0] + acc[ai][bj][m][0], v1 = xv[mm][bj][1] + acc[ai][bj][m][1];
                    acc[ai][bj][m][0] = v0; acc[ai][bj][m][1] = v1;
                    ss += ((v0[0] * v0[0] + v0[1] * v0[1]) + (v0[2] * v0[2] + v0[3] * v0[3])) + ((v1[0] * v1[0] + v1[1] * v1[1]) + (v1[2] * v1[2] + v1[3] * v1[3]));
                    const f32x4 a0 = v0 * wv[bj][0], a1 = v1 * wv[bj][1];
                    mx = fmaxf(mx, fmaxf(fmaxf(fmaxf(fabsf(a0[0]), fabsf(a0[1])), fmaxf(fabsf(a0[2]), fabsf(a0[3]))), fmaxf(fmaxf(fabsf(a1[0]), fabsf(a1[1])), fmaxf(fabsf(a1[2]), fabsf(a1[3]))))); }
                ss += __builtin_bit_cast(float, __builtin_amdgcn_ds_swizzle(__builtin_bit_cast(int, ss), 0x401F)); mx = fmaxf(mx, __builtin_bit_cast(float, __builtin_amdgcn_ds_swizzle(__builtin_bit_cast(int, mx), 0x401F)));
                ss += xor32_f(ss); mx = fmaxf(mx, xor32_f(mx));
                if (fq == 0) { tbl[(rl * 4 + wc) * 2] = ss; tbl[(rl * 4 + wc) * 2 + 1] = mx; } }
            asm volatile("" ::: "memory");
          }
        __syncthreads();
        float ss = 0.f, mx = 0.f;
        if (tid < 256) { const f32x4 t0 = *(const LAS f32x4*)(tbl + tid * 8), t1 = *(const LAS f32x4*)(tbl + tid * 8 + 4);
            ss = (t0[0] + t0[2]) + (t1[0] + t1[2]); mx = fmaxf(fmaxf(t0[1], t0[3]), fmaxf(t1[1], t1[3]));
            const unsigned long long pk = (unsigned long long)__builtin_bit_cast(unsigned, ss) | ((unsigned long long)__builtin_bit_cast(unsigned, mx) << 32);
            __hip_atomic_store(slots + ((size_t)(u.pm * 4 + u.pn) * 256 + tid), pk, __ATOMIC_RELAXED, __HIP_MEMORY_SCOPE_AGENT); }
        asm volatile("s_waitcnt vmcnt(0)" ::: "memory");
        __syncthreads();
        if (tid == 0) { unsigned* c = cnt + 16 * u.pm; (void)xb_add(c, 1u); XB_SPIN(xb_ld(c) < 4u, bar); }
        __syncthreads();
        if (tid < 256) {
            unsigned long long pk[4];
#pragma unroll
            for (int p = 0; p < 4; ++p) pk[p] = __hip_atomic_load(slots + ((size_t)(u.pm * 4 + p) * 256 + tid), __ATOMIC_RELAXED, __HIP_MEMORY_SCOPE_AGENT);
            ss = 0.f; mx = 0.f;
#pragma unroll
            for (int p = 0; p < 4; ++p) { ss += __builtin_bit_cast(float, (unsigned)pk[p]); mx = fmaxf(mx, __builtin_bit_cast(float, (unsigned)(pk[p] >> 32))); }
            const float rstd = 1.0f / sqrtf(ss * (1.0f / 1024.0f) + 1e-6f); const bool tiny = mx < 1e-30f;
            tbl[2048 + tid] = tiny ? 0.f : 119.0f / mx;
            if (u.pn == 0) hsc[u.pm * BM + tid] = tiny ? 0.f : mx * rstd * (1.0f / 119.0f); }
        __syncthreads();
#pragma unroll
        for (int ai = 0; ai < 2; ++ai)
#pragma unroll
            for (int m = 0; m < 4; ++m) { const int rl = rl0 + ai * HALF + m * 16; const size_t rg = (size_t)(u.pm * BM + rl) * 1024; const float sc = tbl[2048 + rl];
#pragma unroll
                for (int bj = 0; bj < 2; ++bj) { const f32x4 v0 = acc[ai][bj][m][0], v1 = acc[ai][bj][m][1]; const int c = col0 + bj * HALF;
                    u32x4 xw; xw.x = cvt_pk_bf16(v0[0], v0[1]); xw.y = cvt_pk_bf16(v0[2], v0[3]); xw.z = cvt_pk_bf16(v1[0], v1[1]); xw.w = cvt_pk_bf16(v1[2], v1[3]);
                    ST16NT((u32x4*)(Cb + rg + c), xw);
                    const f32x4 h0 = v0 * wv[bj][0] * sc, h1 = v1 * wv[bj][1] * sc;
                    unsigned q0 = 0u, q1 = 0u;
#pragma unroll
                    for (int e = 0; e < 4; ++e) { q0 |= (unsigned)((int)__builtin_rintf(h0[e]) & 255) << (8 * e); q1 |= (unsigned)((int)__builtin_rintf(h1[e]) & 255) << (8 * e); }
                    *(unsigned long long*)(hnq + rg + c) = (unsigned long long)q0 | ((unsigned long long)q1 << 32); } }
    }
};
struct EpiPlain {
    static constexpr bool PERM = true, AFTER_DRAIN = false, HAS_MID = false;
    bf16_t* O; int ldc;
    __device__ __forceinline__ void operator()(const f32x4 (&acc)[2][2][4][2], const Unit& u, int wr, int wc, int fr, int fq) const {
        const int row0 = u.pm * BM + wr * 64 + fr, col0 = u.pn * BM + wc * 32 + 8 * fq;
#pragma unroll
        for (int ai = 0; ai < 2; ++ai)
#pragma unroll
            for (int m = 0; m < 4; ++m) {
                const int T = row0 + ai * HALF + m * 16;
                bf16_t* rowp = O + ((((size_t)(T >> 2) * 32 + (wc * 4 + fq)) * 8 + u.pn) * 4 + (T & 3)) * 8;
#pragma unroll
                for (int bj = 0; bj < 2; ++bj) { const f32x4 v0 = acc[ai][bj][m][0], v1 = acc[ai][bj][m][1];
                    u32x4 w; w.x = cvt_pk_bf16(v0[0], v0[1]); w.y = cvt_pk_bf16(v0[2], v0[3]); w.z = cvt_pk_bf16(v1[0], v1[1]); w.w = cvt_pk_bf16(v1[2], v1[3]);
                    ST16((u32x4*)(rowp + (size_t)bj * 16 * 8 * 4 * 8), w); } }
    }
};
}

__device__ __forceinline__ void p0_transpose_item(const float* W, int K, int N, bf16* WT, LAS float* scr, int item, int lane, int ldk = 0, int koff = 0, const float* kscale = nullptr) {
    if (ldk == 0) ldk = K;
    const int nblk = N / 32, kb = item / nblk, nb = item % nblk, k0 = 64 * kb, n0 = 32 * nb;
#pragma unroll 8
    for (int i = 0; i < 32; ++i) { const int kk = 2 * i + (lane >> 5); scr[kk * 33 + (lane & 31)] = __builtin_nontemporal_load(W + (size_t)(k0 + kk) * N + n0 + (lane & 31)) * (kscale ? kscale[k0 + kk] : 1.0f); }
    LDS_WAIT(); asm volatile("" ::: "memory");
    const int c = lane & 7;
#pragma unroll
    for (int j = 0; j < 4; ++j) { const int n = (lane >> 3) + 8 * j; const LAS float* s = scr + (8 * c) * 33 + n;
        v4u o; o.x = pk2(s[0 * 33], s[1 * 33]); o.y = pk2(s[2 * 33], s[3 * 33]); o.z = pk2(s[4 * 33], s[5 * 33]); o.w = pk2(s[6 * 33], s[7 * 33]);
        *(v4u*)(WT + (size_t)(n0 + n) * ldk + koff + k0 + 8 * c) = o; }
    LDS_WAIT(); asm volatile("" ::: "memory");
}
__device__ __forceinline__ void cvt_flat(const float* src, bf16* dst, size_t n, int gw, int NGW, int lane) {
    for (size_t i = (size_t)gw * 512 + lane * 8; i < n; i += (size_t)NGW * 512) {
        const f32x4 a = *(const f32x4*)(src + i), b = *(const f32x4*)(src + i + 4);
        v4u o; o.x = pk2(a[0], a[1]); o.y = pk2(a[2], a[3]); o.z = pk2(b[0], b[1]); o.w = pk2(b[2], b[3]);
        *(v4u*)(dst + i) = o;
    }
}


struct Ptrs {
    const float *x, *mix_w, *w_in, *rel_bias, *sinks, *w_pa, *ln_w, *ln_b, *w_s, *b_s, *w_pb, *w_out, *ffn_w, *w_q, *keys1, *keys2, *pu, *pv, *fin_w;
    float* out;
    unsigned char *U8, *V8, *XN8, *HNQ, *WIN8, *WQ8, *WOUT8, *MERGED8; float *USC, *HSC, *XSC, *WINSC, *WQSC, *WOUTSC, *MSC;
    bf16 *WPAB, *K1, *K2, *WS, *AOUT, *BOUT, *X1B, *Q, *KV, *GU, *GV, *GA, *GB, *QP;
};

#define TAB_ST(PTR, VAL) do { if (WT) __hip_atomic_store((PTR), (VAL), __ATOMIC_RELAXED, __HIP_MEMORY_SCOPE_AGENT); else *(PTR) = (VAL); } while (0)
template <bool WT = false>
__device__ __forceinline__ void p0_quant_row(const Ptrs& P, const f32x4 (&v)[4], int rr, int lane) {
            const int tab = rr >> 14, row = rr & 16383;
            float mx = 0.f, ssq = 0.f;
#pragma unroll
            for (int j = 0; j < 4; ++j) { mx = fmaxf(mx, fmaxf(fmaxf(fabsf(v[j][0]), fabsf(v[j][1])), fmaxf(fabsf(v[j][2]), fabsf(v[j][3]))));
                ssq += (v[j][0] * v[j][0] + v[j][1] * v[j][1]) + (v[j][2] * v[j][2] + v[j][3] * v[j][3]); }
            mx = wave_max(mx); ssq = wave_sum(ssq);
            const float sd = sqrtf(ssq * (1.0f / 1024.0f));
            if (tab == 0) {
                const float step = fmaxf(Q4_USTEP * sd, mx * (1.0f / 14.0f)); const float qs = step > 1e-30f ? 1.0f / step : 0.f;
#pragma unroll
                for (int j = 0; j < 4; ++j) { unsigned pq = 0u;
#pragma unroll
                    for (int e = 0; e < 4; ++e) pq |= (unsigned)((int)fminf(fmaxf(__builtin_rintf(v[j][e] * qs), -7.0f), 7.0f) & 15) << (4 * e);
                    const unsigned nq = (unsigned)__builtin_amdgcn_update_dpp(0, (int)pq, 0xB1, 0xF, 0xF, false);
                    if ((lane & 1) == 0) TAB_ST((unsigned*)(P.U8 + (size_t)row * 512 + 128 * j + 2 * lane), pq | (nq << 16)); }
                if (lane == 0) TAB_ST(P.USC + 2 * row, step);
            } else {
                const float un = fmaxf(Q4_VUNIT * sd, mx * (1.0f / 12.0f)); const float qs = un > 1e-30f ? 1.0f / un : 0.f;
                bool bad = false;
#pragma unroll
                for (int j = 0; j < 4; ++j) {
                    unsigned pq = __builtin_amdgcn_cvt_scalef32_pk_fp4_f32(0u, v[j][0] * qs, v[j][1] * qs, 1.0f, 0);
                    pq = __builtin_amdgcn_cvt_scalef32_pk_fp4_f32(pq, v[j][2] * qs, v[j][3] * qs, 1.0f, 1);
                    pq &= 0xffffu;
                    const unsigned nq = __builtin_bit_cast(unsigned, xor32_f(__builtin_bit_cast(float, pq)));
                    if (lane < 32) TAB_ST((unsigned*)(P.V8 + (size_t)row * 512 + 16 * lane + 4 * j), pq | (nq << 16)); }
                if (FP4_SELFCHECK && __ballot(bad) != 0ull) { if (lane == 0) TAB_ST(P.USC + 2 * row + 1, __builtin_nanf("")); }
                else if (lane == 0) TAB_ST(P.USC + 2 * row + 1, un);
            }
}
__device__ __forceinline__ unsigned pack_i8x4(float a, float b, float c, float d) {
    const int qa = (int)__builtin_rintf(a), qb = (int)__builtin_rintf(b), qc = (int)__builtin_rintf(c), qd = (int)__builtin_rintf(d);
    return (unsigned)(qa & 255) | ((unsigned)(qb & 255) << 8) | ((unsigned)(qc & 255) << 16) | ((unsigned)qd << 24);
}
__device__ __forceinline__ void p0_quant_wt_item(const float* W, int N, unsigned char* WT8, float* cs, int item, int lane, int wave, LAS float* cml) {
    const int n0 = 32 * item, c4 = lane & 7, kr = lane >> 3;
    const float* wp = W + (size_t)(128 * wave + 16 * kr) * N + n0 + 4 * c4;
    f32x4 v[16]; f32x4 mx = {0.f, 0.f, 0.f, 0.f};
#pragma unroll
    for (int t = 0; t < 16; ++t) v[t] = __builtin_nontemporal_load((const f32x4*)(wp + (size_t)t * N));
#pragma unroll
    for (int t = 0; t < 16; ++t) { mx[0] = fmaxf(mx[0], fabsf(v[t][0])); mx[1] = fmaxf(mx[1], fabsf(v[t][1])); mx[2] = fmaxf(mx[2], fabsf(v[t][2])); mx[3] = fmaxf(mx[3], fabsf(v[t][3])); }
#pragma unroll
    for (int e = 0; e < 4; ++e) { float m_ = mx[e]; m_ = fmaxf(m_, __shfl_xor(m_, 8)); m_ = fmaxf(m_, __shfl_xor(m_, 16)); m_ = fmaxf(m_, __shfl_xor(m_, 32)); mx[e] = m_; }
    if (kr == 0) *(LAS f32x4*)(cml + wave * 32 + 4 * c4) = mx;
    __syncthreads();
#pragma unroll
    for (int w = 0; w < 8; ++w) { const f32x4 o = *(const LAS f32x4*)(cml + w * 32 + 4 * c4); mx[0] = fmaxf(mx[0], o[0]); mx[1] = fmaxf(mx[1], o[1]); mx[2] = fmaxf(mx[2], o[2]); mx[3] = fmaxf(mx[3], o[3]); }
    f32x4 inv;
#pragma unroll
    for (int e = 0; e < 4; ++e) inv[e] = mx[e] > 1e-30f ? 127.0f / mx[e] : 0.f;
    if (wave == 0 && kr == 0) *(f32x4*)(cs + n0 + 4 * c4) = mx * (1.0f / 127.0f);
#pragma unroll
    for (int e = 0; e < 4; ++e) { v4u o;
        o.x = pack_i8x4(v[0][e] * inv[e], v[1][e] * inv[e], v[2][e] * inv[e], v[3][e] * inv[e]); o.y = pack_i8x4(v[4][e] * inv[e], v[5][e] * inv[e], v[6][e] * inv[e], v[7][e] * inv[e]);
        o.z = pack_i8x4(v[8][e] * inv[e], v[9][e] * inv[e], v[10][e] * inv[e], v[11][e] * inv[e]); o.w = pack_i8x4(v[12][e] * inv[e], v[13][e] * inv[e], v[14][e] * inv[e], v[15][e] * inv[e]);
        *(v4u*)(WT8 + (size_t)(n0 + 4 * c4 + e) * 1024 + 128 * wave + 16 * kr) = o; }
    __syncthreads();
}
#define TAB_LOAD(V, RR) do { if ((RR) < tab_end_) { const float* src_ = (((RR) >> 14) ? P.pv : P.pu) + (size_t)((RR) & 16383) * 1024; \
        _Pragma("unroll") for (int j = 0; j < 4; ++j) V[j] = __builtin_nontemporal_load((const f32x4*)(src_ + 4 * lane + 256 * j)); } } while (0)
template <bool WT>
__device__ __forceinline__ void tab_quant_rows8(const Ptrs& P, int gw0, int ngw, int lane) {
    constexpr int tab_end_ = 2 * 16384;
    f32x4 b0[4], b1[4], b2[4], b3[4], b4[4], b5[4], b6[4], b7[4];
    int rr = gw0;
    TAB_LOAD(b0, rr); TAB_LOAD(b1, rr + ngw); TAB_LOAD(b2, rr + 2 * ngw); TAB_LOAD(b3, rr + 3 * ngw); TAB_LOAD(b4, rr + 4 * ngw); TAB_LOAD(b5, rr + 5 * ngw); TAB_LOAD(b6, rr + 6 * ngw);
#define TQ_STAGE(BN, BL, K) do { TAB_LOAD(BL, rr + ((K) + 7) * ngw); if (rr + (K) * ngw < tab_end_) p0_quant_row<WT>(P, BN, rr + (K) * ngw, lane); } while (0)
#pragma unroll 1
    for (; rr < tab_end_; rr += 8 * ngw) {
        TQ_STAGE(b0, b7, 0); TQ_STAGE(b1, b0, 1); TQ_STAGE(b2, b1, 2); TQ_STAGE(b3, b2, 3); TQ_STAGE(b4, b3, 4); TQ_STAGE(b5, b4, 5); TQ_STAGE(b6, b5, 6); TQ_STAGE(b7, b6, 7);
    }
#undef TQ_STAGE
}
template <int tab_end_ = 2 * 16384>
__device__ __forceinline__ void p0_prologue(LAS unsigned char* lds, const Ptrs& P, int vcu, int G, int lane, int wave) {
    LAS float* scr = (LAS float*)(lds + wave * 16384);
    const int gw = vcu * NWAVES + wave, NGW = G * NWAVES;
    for (int it = vcu; it < 216; it += G) {
        if (it < 120) p0_quant_wt_item(P.w_in, 3840, P.WIN8, P.WINSC, it, lane, wave, (LAS float*)(lds + 131072));
        else if (it < 184) p0_quant_wt_item(P.w_q, 2048, P.WQ8, P.WQSC, it - 120, lane, wave, (LAS float*)(lds + 131072));
        else p0_quant_wt_item(P.w_out, 1024, P.WOUT8, P.WOUTSC, it - 184, lane, wave, (LAS float*)(lds + 131072)); }
    constexpr int I_PA = (512 / 64) * (1024 / 32);
    constexpr int NITEMS = 2 * I_PA;
    for (int it = gw; it < NITEMS; it += NGW) {
        int r = it;
        if (r < I_PA) { p0_transpose_item(P.w_pa, 512, 1024, P.WPAB, scr, r, lane, 1024, 0); continue; } r -= I_PA;
        p0_transpose_item(P.w_pb, 512, 1024, P.WPAB, scr, r, lane, 1024, 512);
    }
    cvt_flat(P.keys1, P.K1, 128 * 128, gw, NGW, lane);
    cvt_flat(P.keys2, P.K2, 128 * 128, gw, NGW, lane);
    if (tab_end_ > 0) {
        f32x4 va[4], vb[4], vc[4];
        int rr = gw;
        TAB_LOAD(va, rr); TAB_LOAD(vb, rr + NGW);
#pragma unroll 1
        for (; rr < tab_end_; rr += 3 * NGW) {
            TAB_LOAD(vc, rr + 2 * NGW); p0_quant_row<false>(P, va, rr, lane);
            TAB_LOAD(va, rr + 3 * NGW); if (rr + NGW < tab_end_) p0_quant_row<false>(P, vb, rr + NGW, lane);
            TAB_LOAD(vb, rr + 4 * NGW); if (rr + 2 * NGW < tab_end_) p0_quant_row<false>(P, vc, rr + 2 * NGW, lane);
        }
    }
    for (size_t i = (size_t)gw * 512 + lane * 8; i < (size_t)8 * 128 * 128; i += (size_t)NGW * 512) {
        const int t = (int)((i >> 7) & 127), s0 = (int)(i & 127);
        const f32x4 a = *(const f32x4*)(P.w_s + i), b = *(const f32x4*)(P.w_s + i + 4);
        float e[8] = {a[0], a[1], a[2], a[3], b[0], b[1], b[2], b[3]};
#pragma unroll
        for (int j = 0; j < 8; ++j) e[j] = (s0 + j <= t) ? e[j] : 0.f;
        v4u o; o.x = pk2(e[0], e[1]); o.y = pk2(e[2], e[3]); o.z = pk2(e[4], e[5]); o.w = pk2(e[6], e[7]);
        { const int g_ = (int)(i >> 14); const size_t dst = ((((size_t)g_ * 4 + (t >> 5)) * 8 + (s0 >> 4)) * 64 + (t & 31) + 32 * ((s0 >> 3) & 1)) * 8;
          *(v4u*)(P.WS + dst) = o; }
    }
    {
        f32x4 va[4], vb[4], vc[4], ww[4];
#pragma unroll
        for (int j = 0; j < 4; ++j) ww[j] = *((const f32x4*)P.mix_w + lane + 64 * j);
#define XN_LOAD(V, MM) do { if ((MM) < M) { _Pragma("unroll") for (int j = 0; j < 4; ++j) V[j] = __builtin_nontemporal_load((const f32x4*)(P.x + (size_t)(MM) * D) + lane + 64 * j); } } while (0)
#define XN_PROC(V, MM) do { if ((MM) < M) { float s_ = 0.f; \
        _Pragma("unroll") for (int j = 0; j < 4; ++j) s_ += (V[j][0] * V[j][0] + V[j][1] * V[j][1]) + (V[j][2] * V[j][2] + V[j][3] * V[j][3]); \
        const float rstd_ = 1.0f / sqrtf(wave_sum(s_) * (1.0f / 1024.0f) + EPS); float mx_ = 0.f; \
        _Pragma("unroll") for (int j = 0; j < 4; ++j) { V[j] = V[j] * rstd_ * ww[j]; mx_ = fmaxf(mx_, fmaxf(fmaxf(fabsf(V[j][0]), fabsf(V[j][1])), fmaxf(fabsf(V[j][2]), fabsf(V[j][3])))); } \
        mx_ = wave_max(mx_); const float qs_ = mx_ > 1e-30f ? 127.0f / mx_ : 0.f; \
        _Pragma("unroll") for (int j = 0; j < 4; ++j) *(unsigned*)(P.XN8 + (size_t)(MM) * D + 4 * lane + 256 * j) = pack_i8x4(V[j][0] * qs_, V[j][1] * qs_, V[j][2] * qs_, V[j][3] * qs_); \
        if (lane == 0) P.XSC[MM] = mx_ * (1.0f / 127.0f); } } while (0)
        int m = gw;
        XN_LOAD(va, m); XN_LOAD(vb, m + NGW);
#pragma unroll 1
        for (; m < M; m += 3 * NGW) {
            XN_LOAD(vc, m + 2 * NGW); XN_PROC(va, m);
            XN_LOAD(va, m + 3 * NGW); XN_PROC(vb, m + NGW);
            XN_LOAD(vb, m + 4 * NGW); XN_PROC(vc, m + 2 * NGW);
        }
#undef XN_LOAD
#undef XN_PROC
    }
}

typedef short s16x8 __attribute__((ext_vector_type(8)));
typedef short s16x4 __attribute__((ext_vector_type(4)));
typedef float f32x16 __attribute__((ext_vector_type(16)));
typedef float f32x2v __attribute__((ext_vector_type(2)));
#define MFMA32(a, b, c) __builtin_amdgcn_mfma_f32_32x32x16_bf16((a), (b), (c), 0, 0, 0)
__device__ __forceinline__ s16x4 tr16(const LAS unsigned char* p) { return __builtin_bit_cast(s16x4, __builtin_amdgcn_ds_read_tr16_b64_v4i16((LAS s16x4*)p)); }
__device__ __forceinline__ unsigned cvtpk(float lo, float hi) { f32x2v v = {lo, hi}; bf16x2_t b = __builtin_convertvector(v, bf16x2_t); return __builtin_bit_cast(unsigned, b); }
__device__ __forceinline__ int crow(int reg, int h) { return (reg & 3) + 8 * (reg >> 2) + 4 * h; }
constexpr float LOG2E = 1.4426950408889634f;

__device__ __forceinline__ void p2_attn_mfma(LAS unsigned char* lds, const Ptrs& P, int vcu, int G, int tid, int lane, int wave) {
    LAS unsigned char* Kl = lds;
    LAS unsigned char* Vl = lds + 32768;
    LAS float* biasl = (LAS float*)(lds + 32768 + 49152);
    const int r = lane & 31, h = lane >> 5, i16 = lane & 15, q4 = i16 >> 2, p4 = i16 & 3, blk = (lane >> 4) & 1;
    for (int unit = vcu; unit < 256; unit += G) {
        const int kvh = unit & 1, blkid = unit >> 1, nb = blkid & 63; const int tok0 = blkid * 128;
        const int bj0 = tid, bj1 = tid + 512, bh0 = bj0 / 192, bh1 = bj1 / 192, bd0 = bj0 - 192 * bh0 - 32, bd1 = bj1 - 192 * bh1 - 32;
        const bool bv0 = (bd0 >= 0) && (bd0 < 128), bv1 = (bj1 < 768) && (bd1 >= 0) && (bd1 < 128);
        const int t5a = (int)T5B[bd0 & 127], t5b = (int)T5B[bd1 & 127];
        v4u kw[4], vw[4];
#pragma unroll
        for (int i = 0; i < 4; ++i) {
            const int cidx = tid + 512 * i, row = cidx >> 3, c = cidx & 7;
            const bool ex = (nb > 0 || row >= 128);
            const bf16* src = P.KV + (size_t)(tok0 - (ex ? 128 : 0) + (ex ? row : (row & 127))) * 256 + kvh * 64 + c * 8;
            kw[i] = *(const v4u*)src; vw[i] = *(const v4u*)(src + 128);
            if (!ex) { kw[i] = (v4u){0u, 0u, 0u, 0u}; vw[i] = (v4u){0u, 0u, 0u, 0u}; }
        }
        const float bias_a = bv0 ? P.rel_bias[t5a * 8 + kvh * 4 + bh0] * LOG2E : -1e30f, bias_b = bv1 ? P.rel_bias[t5b * 8 + kvh * 4 + (bh1 & 3)] * LOG2E : -1e30f;
#pragma unroll
        for (int i = 0; i < 4; ++i) {
            const int cidx = tid + 512 * i, row = cidx >> 3, c = cidx & 7;
            *(LAS v4u*)(Kl + row * 128 + ((c ^ ((row >> 1) & 7)) << 4)) = kw[i];
            *(LAS v4u*)(Vl + row * 192 + c * 16) = vw[i];
        }
        biasl[bj0] = bias_a; if (bj1 < 768) biasl[bj1] = bias_b;
        __syncthreads();
        const int g = wave >> 1, qh = wave & 1, hq = kvh * 4 + g;
        const float sink2 = P.sinks[hq] * LOG2E;
#pragma unroll 1
        for (int qs = 0; qs < 2; ++qs) {
            const int qi0 = 64 * qh + 32 * qs, kt0 = 2 * qh + qs;
            s16x8 qf[4];
            { const bf16* qrow = P.Q + (size_t)(tok0 + qi0 + r) * 512 + hq * 64 + 8 * h;
#pragma unroll
              for (int ks = 0; ks < 4; ++ks) qf[ks] = *(const s16x8*)(qrow + 16 * ks); }
            f32x16 s[5];
#pragma unroll
            for (int i = 0; i < 5; ++i) {
#pragma unroll
                for (int e = 0; e < 16; ++e) s[i][e] = 0.f;
                const int key = 32 * (kt0 + i) + r; const LAS unsigned char* kp = Kl + key * 128; const int sw = (key >> 1) & 7;
                s16x8 kf[4];
#pragma unroll
                for (int ks = 0; ks < 4; ++ks) kf[ks] = *(const LAS s16x8*)(kp + (((2 * ks + h) ^ sw) << 4));
#pragma unroll
                for (int ks = 0; ks < 4; ++ks) s[i] = MFMA32(kf[ks], qf[ks], s[i]);
            }
            float mx = sink2;
            const LAS float* bl = biasl + g * 192 + 32 + 128 + r - 4 * h;
#pragma unroll
            for (int i = 0; i < 5; ++i) {
                const LAS float* bli = ((nb > 0) || (kt0 + i >= 4)) ? bl - 32 * i - 27 : biasl + g * 192 + 4;
                asm volatile("" : "+v"(bli));
#pragma unroll
                for (int e = 0; e < 16; ++e) {
                    const float v = s[i][e] * (0.125f * LOG2E) + bli[27 - ((e & 3) + 8 * (e >> 2))];
                    s[i][e] = v; mx = fmaxf(mx, v);
                }
            }
            mx = fmaxf(mx, xor32_f(mx));
            float l = 0.f;
#pragma unroll
            for (int i = 0; i < 5; ++i)
#pragma unroll
                for (int e = 0; e < 16; ++e) { const float p = __builtin_amdgcn_exp2f(s[i][e] - mx); s[i][e] = p; l += p; }
            l += xor32_f(l);
            l += __builtin_amdgcn_exp2f(sink2 - mx);
            f32x16 o0, o1;
#pragma unroll
            for (int e = 0; e < 16; ++e) { o0[e] = 0.f; o1[e] = 0.f; }
#define PV_LOAD(VF, I) do { _Pragma("unroll") for (int st = 0; st < 2; ++st) { const LAS unsigned char* vb = Vl + (32 * (kt0 + (I)) + 16 * st + 4 * h + q4) * 192 + 32 * blk + 8 * p4; \
        { const s16x4 lo = tr16(vb), hi = tr16(vb + 8 * 192); VF[2 * st] = __builtin_shufflevector(lo, hi, 0, 1, 2, 3, 4, 5, 6, 7); } \
        { const s16x4 lo = tr16(vb + 64), hi = tr16(vb + 64 + 8 * 192); VF[2 * st + 1] = __builtin_shufflevector(lo, hi, 0, 1, 2, 3, 4, 5, 6, 7); } } } while (0)
#define PV_MMA(VF, I) do { _Pragma("unroll") for (int st = 0; st < 2; ++st) { \
        v4u pw; pw.x = cvtpk(s[I][8 * st], s[I][8 * st + 1]); pw.y = cvtpk(s[I][8 * st + 2], s[I][8 * st + 3]); pw.z = cvtpk(s[I][8 * st + 4], s[I][8 * st + 5]); pw.w = cvtpk(s[I][8 * st + 6], s[I][8 * st + 7]); \
        const s16x8 pf = __builtin_bit_cast(s16x8, pw); o0 = MFMA32(VF[2 * st], pf, o0); o1 = MFMA32(VF[2 * st + 1], pf, o1); } } while (0)
            { s16x8 va[4], vb2[4];
              PV_LOAD(va, 0); PV_LOAD(vb2, 1); PV_MMA(va, 0); PV_LOAD(va, 2); PV_MMA(vb2, 1); PV_LOAD(vb2, 3); PV_MMA(va, 2); PV_LOAD(va, 4); PV_MMA(vb2, 3); PV_MMA(va, 4); }
#undef PV_LOAD
#undef PV_MMA
            const float inv = __builtin_amdgcn_rcpf(l);
            bf16* orow = P.AOUT + (size_t)(tok0 + qi0 + r) * AB_LD + hq * 64 + 4 * h;
#pragma unroll
            for (int r4 = 0; r4 < 4; ++r4) {
                v2u w0; w0.x = cvtpk(o0[4 * r4] * inv, o0[4 * r4 + 1] * inv); w0.y = cvtpk(o0[4 * r4 + 2] * inv, o0[4 * r4 + 3] * inv); *(v2u*)(orow + 8 * r4) = w0;
                v2u w1; w1.x = cvtpk(o1[4 * r4] * inv, o1[4 * r4 + 1] * inv); w1.y = cvtpk(o1[4 * r4 + 2] * inv, o1[4 * r4 + 3] * inv); *(v2u*)(orow + 32 + 8 * r4) = w1;
            }
        }
        __syncthreads();
    }
}

__device__ __forceinline__ void p2_gmlp_mfma(LAS unsigned char* lds, const Ptrs& P, int vcu, int G, int tid, int lane, int wave) {
    LAS unsigned char* vnl = lds;
    const int r = lane & 31, h = lane >> 5, i16 = lane & 15, q4 = i16 >> 2, p4 = i16 & 3, blk = (lane >> 4) & 1;
    for (int unit = vcu; unit < 256; unit += G) {
        const int c = unit >> 1, hh = unit & 1;
        v4u gvw[16];
#pragma unroll
        for (int i = 0; i < 16; ++i) gvw[i] = __builtin_nontemporal_load((const v4u*)(P.GV + ((size_t)c * 128 + wave * 16 + i) * 512) + lane);
        const f32x4 lw0 = *(const f32x4*)(P.ln_w + lane * 8), lw1 = *(const f32x4*)(P.ln_w + lane * 8 + 4), lb0 = *(const f32x4*)(P.ln_b + lane * 8), lb1 = *(const f32x4*)(P.ln_b + lane * 8 + 4);
        float sm[16], sq[16];
#pragma unroll
        for (int i = 0; i < 16; ++i) {
            const v4u w = gvw[i];
            const float x[8] = {bflo(w.x), bfhi(w.x), bflo(w.y), bfhi(w.y), bflo(w.z), bfhi(w.z), bflo(w.w), bfhi(w.w)};
            sm[i] = ((x[0] + x[1]) + (x[2] + x[3])) + ((x[4] + x[5]) + (x[6] + x[7]));
            sq[i] = ((x[0] * x[0] + x[1] * x[1]) + (x[2] * x[2] + x[3] * x[3])) + ((x[4] * x[4] + x[5] * x[5]) + (x[6] * x[6] + x[7] * x[7]));
        }
#pragma unroll
        for (int b4 = 0; b4 < 4; ++b4) { float t[8] = {sm[4 * b4], sm[4 * b4 + 1], sm[4 * b4 + 2], sm[4 * b4 + 3], sq[4 * b4], sq[4 * b4 + 1], sq[4 * b4 + 2], sq[4 * b4 + 3]};
            wave_sum_n<8>(t);
#pragma unroll
            for (int k = 0; k < 4; ++k) { sm[4 * b4 + k] = t[k]; sq[4 * b4 + k] = t[4 + k]; } }
        const bool mine = (lane >> 5) == hh;
        LAS unsigned char* vdst = mine ? vnl + wave * 16 * 576 + (lane & 31) * 16 : vnl + 128 * 576 + (lane & 31) * 16;
        const int vstep = mine ? 576 : 0;
        const f32x2v wq[4] = {{lw0[0], lw0[1]}, {lw0[2], lw0[3]}, {lw1[0], lw1[1]}, {lw1[2], lw1[3]}}, bq[4] = {{lb0[0], lb0[1]}, {lb0[2], lb0[3]}, {lb1[0], lb1[1]}, {lb1[2], lb1[3]}};
#pragma unroll
        for (int i = 0; i < 16; ++i) {
            const v4u w = gvw[i];
            const float mean = sm[i] * (1.0f / 512.0f), rstd = __builtin_amdgcn_rsqf(fmaxf(sq[i] * (1.0f / 512.0f) - mean * mean, 0.f) + EPS), nm = -mean * rstd;
            const f32x2v rs2 = {rstd, rstd}, nm2 = {nm, nm};
            const f32x2v xq[4] = {{bflo(w.x), bfhi(w.x)}, {bflo(w.y), bfhi(w.y)}, {bflo(w.z), bfhi(w.z)}, {bflo(w.w), bfhi(w.w)}};
            unsigned ow[4];
#pragma unroll
            for (int j = 0; j < 4; ++j) { const f32x2v z = __builtin_elementwise_fma(xq[j], rs2, nm2);
                const f32x2v y2 = __builtin_elementwise_fma(z, wq[j], bq[j]); ow[j] = cvtpk(y2[0], y2[1]); }
            v4u o; o.x = ow[0]; o.y = ow[1]; o.z = ow[2]; o.w = ow[3];
            *(LAS v4u*)(vdst + i * vstep) = o;
        }
        LAS unsigned char* gul = lds + 74240;
        __builtin_amdgcn_sched_barrier(0);
        { v4u gq_[8]; int lq_ = lane; asm volatile("" : "+v"(lq_));
#pragma unroll
          for (int k = 0; k < 8; ++k) gq_[k] = __builtin_nontemporal_load((const v4u*)(P.GU + ((size_t)c * 128 + wave * 16 + 2 * k + (lq_ >> 5)) * 512 + hh * 256 + (lq_ & 31) * 8));
#pragma unroll
          for (int k = 0; k < 8; ++k) *(LAS v4u*)(gul + (wave * 16 + 2 * k + (lq_ >> 5)) * 528 + (lq_ & 31) * 16) = gq_[k]; }
        __syncthreads();
        const int gi = wave >> 1, dblk = wave & 1, g = hh * 4 + gi;
        s16x8 af[8];
#pragma unroll
        for (int ks = 0; ks < 8; ++ks) { const LAS unsigned char* vb = vnl + (16 * ks + 8 * h + q4) * 576 + (gi * 64 + dblk * 32 + 16 * blk) * 2 + 8 * p4;
            const s16x4 lo = tr16(vb), hi = tr16(vb + 4 * 576); af[ks] = __builtin_shufflevector(lo, hi, 0, 1, 2, 3, 4, 5, 6, 7); }
        s16x8 wf[20]; float ba[4];
        int lw_ = lane; asm volatile("" : "+v"(lw_));
#pragma unroll
        for (int tt = 0; tt < 4; ++tt) {
#pragma unroll
            for (int ks = 0; ks < 2 * (tt + 1); ++ks) wf[tt * (tt + 1) + ks] = *(const s16x8*)(P.WS + ((((size_t)g * 4 + tt) * 8 + ks) * 64 + lw_) * 8);
            ba[tt] = P.b_s[g * 128 + 32 * tt + (lw_ & 31)]; }
#pragma unroll
        for (int tt = 0; tt < 4; ++tt) {
            f32x16 acc;
#pragma unroll
            for (int e = 0; e < 16; ++e) acc[e] = 0.f;
#pragma unroll
            for (int ks = 0; ks < 2 * (tt + 1); ++ks) acc = MFMA32(af[ks], wf[tt * (tt + 1) + ks], acc);
            const float b = ba[tt];
#pragma unroll
            for (int r4 = 0; r4 < 4; ++r4) {
                LAS v2u* up = (LAS v2u*)(gul + (32 * tt + r) * 528 + (gi * 64 + dblk * 32 + 8 * r4 + 4 * h) * 2);
                const v2u uw = *up;
                v2u ow; ow.x = cvtpk(bflo(uw.x) * (acc[4 * r4] + b), bfhi(uw.x) * (acc[4 * r4 + 1] + b)); ow.y = cvtpk(bflo(uw.y) * (acc[4 * r4 + 2] + b), bfhi(uw.y) * (acc[4 * r4 + 3] + b));
                *up = ow;
            }
        }
        __syncthreads();
        int ls_ = lane; asm volatile("" : "+v"(ls_));
#pragma unroll
        for (int k = 0; k < 8; ++k) { const int row = wave * 16 + 2 * k + (ls_ >> 5);
            *(v4u*)(P.BOUT + ((size_t)c * 128 + row) * AB_LD + hh * 256 + (ls_ & 31) * 8) = *(const LAS v4u*)(gul + row * 528 + (ls_ & 31) * 16); }
        __syncthreads();
    }
}

__device__ __forceinline__ void topk_half(const bf16* q, const LAS bf16* kl, float (&v)[16]) {
    v4u qv[16];
#pragma unroll
    for (int c = 0; c < 16; ++c) qv[c] = ((const v4u*)q)[c];
#pragma unroll
    for (int i = 0; i < 16; ++i) v[i] = -INFINITY;
    for (int n = 0; n < 128; ++n) {
        const LAS v4u* kr = (const LAS v4u*)(kl + n * 128);
        float a0 = 0.f, a1 = 0.f, a2 = 0.f, a3 = 0.f;
#pragma unroll
        for (int c = 0; c < 16; ++c) { const v4u kk = kr[c]; a0 = dot2bf(qv[c].x, kk.x, a0); a1 = dot2bf(qv[c].y, kk.y, a1); a2 = dot2bf(qv[c].z, kk.z, a2); a3 = dot2bf(qv[c].w, kk.w, a3); }
        const float acc = (a0 + a1) + (a2 + a3);
        float x = __builtin_bit_cast(float, (__builtin_bit_cast(unsigned, acc) & ~0x7Fu) | (unsigned)n);
#pragma unroll
        for (int i = 0; i < 16; ++i) { const float hi = fmaxf(v[i], x); x = fminf(v[i], x); v[i] = hi; }
    }
}

__host__ __device__ constexpr int cand_slot(int i, int j) { int c = 0; for (int a = 0; a < 16; ++a) for (int b = 0; b < 16; ++b) { if (a == i && b == j) return c; if ((a + 1) * (b + 1) <= 16) ++c; } return c; }
#define CE_DESC(a, b) do { const float hi_ = fmaxf((a), (b)); const float lo_ = fminf((a), (b)); (a) = hi_; (b) = lo_; } while (0)
__device__ __forceinline__ void sort16_desc(float (&v)[16]) {
    CE_DESC(v[0], v[13]); CE_DESC(v[1], v[12]); CE_DESC(v[2], v[15]); CE_DESC(v[3], v[14]); CE_DESC(v[4], v[8]); CE_DESC(v[5], v[6]); CE_DESC(v[7], v[11]); CE_DESC(v[9], v[10]); CE_DESC(v[0], v[5]); CE_DESC(v[1], v[7]); CE_DESC(v[2], v[9]); CE_DESC(v[3], v[4]); CE_DESC(v[6], v[13]); CE_DESC(v[8], v[14]); CE_DESC(v[10], v[15]); CE_DESC(v[11], v[12]); CE_DESC(v[0], v[1]); CE_DESC(v[2], v[3]); CE_DESC(v[4], v[5]); CE_DESC(v[6], v[8]); CE_DESC(v[7], v[9]); CE_DESC(v[10], v[11]); CE_DESC(v[12], v[13]); CE_DESC(v[14], v[15]); CE_DESC(v[0], v[2]); CE_DESC(v[1], v[3]); CE_DESC(v[4], v[10]); CE_DESC(v[5], v[11]); CE_DESC(v[6], v[7]); CE_DESC(v[8], v[9]); CE_DESC(v[12], v[14]); CE_DESC(v[13], v[15]); CE_DESC(v[1], v[2]); CE_DESC(v[3], v[12]); CE_DESC(v[4], v[6]); CE_DESC(v[5], v[7]); CE_DESC(v[8], v[10]); CE_DESC(v[9], v[11]); CE_DESC(v[13], v[14]); CE_DESC(v[1], v[4]); CE_DESC(v[2], v[6]); CE_DESC(v[5], v[8]); CE_DESC(v[7], v[10]); CE_DESC(v[9], v[13]); CE_DESC(v[11], v[14]); CE_DESC(v[2], v[4]); CE_DESC(v[3], v[6]); CE_DESC(v[9], v[12]); CE_DESC(v[11], v[13]); CE_DESC(v[3], v[5]); CE_DESC(v[6], v[8]); CE_DESC(v[7], v[9]); CE_DESC(v[10], v[12]); CE_DESC(v[3], v[4]); CE_DESC(v[5], v[6]); CE_DESC(v[7], v[8]); CE_DESC(v[9], v[10]); CE_DESC(v[11], v[12]); CE_DESC(v[6], v[7]); CE_DESC(v[8], v[9]);
}
__device__ __forceinline__ void bitonic16_desc(float (&a)[16]) {
    CE_DESC(a[0], a[8]); CE_DESC(a[1], a[9]); CE_DESC(a[2], a[10]); CE_DESC(a[3], a[11]); CE_DESC(a[4], a[12]); CE_DESC(a[5], a[13]); CE_DESC(a[6], a[14]); CE_DESC(a[7], a[15]); CE_DESC(a[0], a[4]); CE_DESC(a[1], a[5]); CE_DESC(a[2], a[6]); CE_DESC(a[3], a[7]); CE_DESC(a[8], a[12]); CE_DESC(a[9], a[13]); CE_DESC(a[10], a[14]); CE_DESC(a[11], a[15]); CE_DESC(a[0], a[2]); CE_DESC(a[1], a[3]); CE_DESC(a[4], a[6]); CE_DESC(a[5], a[7]); CE_DESC(a[8], a[10]); CE_DESC(a[9], a[11]); CE_DESC(a[12], a[14]); CE_DESC(a[13], a[15]); CE_DESC(a[0], a[1]); CE_DESC(a[2], a[3]); CE_DESC(a[4], a[5]); CE_DESC(a[6], a[7]); CE_DESC(a[8], a[9]); CE_DESC(a[10], a[11]); CE_DESC(a[12], a[13]); CE_DESC(a[14], a[15]);
}
__device__ __forceinline__ void merge_top16(float (&a)[16], const float (&b)[16]) {
    a[0] = fmaxf(a[0], b[15]); a[1] = fmaxf(a[1], b[14]); a[2] = fmaxf(a[2], b[13]); a[3] = fmaxf(a[3], b[12]); a[4] = fmaxf(a[4], b[11]); a[5] = fmaxf(a[5], b[10]); a[6] = fmaxf(a[6], b[9]); a[7] = fmaxf(a[7], b[8]); a[8] = fmaxf(a[8], b[7]); a[9] = fmaxf(a[9], b[6]); a[10] = fmaxf(a[10], b[5]); a[11] = fmaxf(a[11], b[4]); a[12] = fmaxf(a[12], b[3]); a[13] = fmaxf(a[13], b[2]); a[14] = fmaxf(a[14], b[1]); a[15] = fmaxf(a[15], b[0]);
    bitonic16_desc(a);
}
__device__ __forceinline__ void scores_top16(const s16x8 (&qfa)[8], const LAS unsigned char* kl, int r, int h, float (&t)[16]) {
    f32x16 acc[4];
#pragma unroll
    for (int kt = 0; kt < 4; ++kt)
#pragma unroll
        for (int e = 0; e < 16; ++e) acc[kt][e] = 0.f;
    const LAS unsigned char* kp0 = kl + r * 256; const int sw = r & 15;
#pragma unroll
    for (int ks = 0; ks < 8; ++ks) {
        const s16x8 qf = qfa[ks];
#pragma unroll
        for (int kt = 0; kt < 4; ++kt) { const s16x8 kf = *(const LAS s16x8*)(kp0 + kt * 8192 + (((2 * ks + h) ^ sw) << 4)); acc[kt] = MFMA32(kf, qf, acc[kt]); }
    }
    float g[4][16];
#pragma unroll
    for (int kt = 0; kt < 4; ++kt) {
#pragma unroll
        for (int e = 0; e < 16; ++e) { const float av_ = acc[kt][e];
            g[kt][e] = __builtin_bit_cast(float, (__builtin_bit_cast(unsigned, av_) & ~0x7Fu) | (unsigned)(32 * kt + (e & 3) + 8 * (e >> 2))); }
        sort16_desc(g[kt]);
    }
    merge_top16(g[0], g[1]); merge_top16(g[2], g[3]); merge_top16(g[0], g[2]);
#pragma unroll
    for (int k = 0; k < 16; ++k) t[k] = __builtin_bit_cast(float, __builtin_bit_cast(unsigned, g[0][k]) | ((unsigned)h << 2));
}
__device__ __forceinline__ void peer_topk_unit_mfma(const Ptrs& P, const LAS unsigned char* k1l, const LAS unsigned char* k2l, LAS int* idxl, LAS float* gatel, int unit, int lane, int wave, int rb_lo = 0, int rb_hi = 2) {
    asm volatile("" : "+v"(lane));
    const int r = lane & 31, h = lane >> 5;
#pragma unroll 1
    for (int rbi = rb_lo; rbi < rb_hi; ++rbi) {
        const int rb = wave * 2 + rbi, R = (rb * 4 + (r & 3)) * 8 + (r >> 2);
        const bf16* qbase = P.QP + ((size_t)unit * 16 + rb) * 8192;
        float t1[16], t2[16];
        s16x8 qa[8], qb[8];
#pragma unroll
        for (int ks = 0; ks < 8; ++ks) { qa[ks] = NT_LD((const s16x8*)(qbase + (ks * 64 + lane) * 8)); qb[ks] = NT_LD((const s16x8*)(qbase + 4096 + (ks * 64 + lane) * 8)); }
        scores_top16(qa, k1l, r, h, t1);
        __builtin_amdgcn_sched_barrier(0);
        scores_top16(qb, k2l, r, h, t2);
        __builtin_amdgcn_sched_barrier(0);
        float F[16], recv[16];
#pragma unroll
        for (int k = 0; k < 16; ++k) { auto rr = __builtin_amdgcn_permlane32_swap(__builtin_bit_cast(unsigned, t1[k]), __builtin_bit_cast(unsigned, t2[k]), false, false);
            const unsigned r0 = rr[0], r1 = rr[1]; F[k] = __builtin_bit_cast(float, r0); recv[k] = __builtin_bit_cast(float, r1); }
        merge_top16(F, recv);
        LAS unsigned char* slot = (LAS unsigned char*)(idxl + R * 16);
        { v4u b;
          b.x = (__builtin_bit_cast(unsigned, F[0]) & 0x7Fu) | ((__builtin_bit_cast(unsigned, F[1]) & 0x7Fu) << 8) | ((__builtin_bit_cast(unsigned, F[2]) & 0x7Fu) << 16) | ((__builtin_bit_cast(unsigned, F[3]) & 0x7Fu) << 24);
          b.y = (__builtin_bit_cast(unsigned, F[4]) & 0x7Fu) | ((__builtin_bit_cast(unsigned, F[5]) & 0x7Fu) << 8) | ((__builtin_bit_cast(unsigned, F[6]) & 0x7Fu) << 16) | ((__builtin_bit_cast(unsigned, F[7]) & 0x7Fu) << 24);
          b.z = (__builtin_bit_cast(unsigned, F[8]) & 0x7Fu) | ((__builtin_bit_cast(unsigned, F[9]) & 0x7Fu) << 8) | ((__builtin_bit_cast(unsigned, F[10]) & 0x7Fu) << 16) | ((__builtin_bit_cast(unsigned, F[11]) & 0x7Fu) << 24);
          b.w = (__builtin_bit_cast(unsigned, F[12]) & 0x7Fu) | ((__builtin_bit_cast(unsigned, F[13]) & 0x7Fu) << 8) | ((__builtin_bit_cast(unsigned, F[14]) & 0x7Fu) << 16) | ((__builtin_bit_cast(unsigned, F[15]) & 0x7Fu) << 24);
          *(LAS v4u*)(slot + 16 * h) = b;
          (void)b; }
        float v1[16], v2[16];
#pragma unroll
        for (int k = 0; k < 16; ++k) { auto rr = __builtin_amdgcn_permlane32_swap(__builtin_bit_cast(unsigned, F[k]), __builtin_bit_cast(unsigned, F[k]), false, false);
            const unsigned r0 = rr[0], r1 = rr[1]; v1[k] = __builtin_bit_cast(float, r0 & ~0x7Fu); v2[k] = __builtin_bit_cast(float, r1 & ~0x7Fu); }
#define CAND(i, j) __builtin_bit_cast(float, (__builtin_bit_cast(unsigned, v1[i] + v2[j]) & ~0xFFu) | (unsigned)(255 - ((i) * 16 + (j))))
        float c0[16], c1[16], c2[16];
        c0[0] = CAND(0, 0);
        c0[1] = CAND(0, 1);
        c0[2] = CAND(0, 2);
        c0[3] = CAND(0, 3);
        c0[4] = CAND(0, 4);
        c0[5] = CAND(0, 5);
        c0[6] = CAND(0, 6);
        c0[7] = CAND(0, 7);
        c0[8] = CAND(0, 8);
        c0[9] = CAND(0, 9);
        c0[10] = CAND(0, 10);
        c0[11] = CAND(0, 11);
        c0[12] = CAND(0, 12);
        c0[13] = CAND(0, 13);
        c0[14] = CAND(0, 14);
        c0[15] = CAND(0, 15);
        c1[0] = CAND(1, 0);
        c1[1] = CAND(2, 0);
        c1[2] = CAND(3, 0);
        c1[3] = CAND(4, 0);
        c1[4] = CAND(5, 0);
        c1[5] = CAND(6, 0);
        c1[6] = CAND(7, 0);
        c1[7] = CAND(8, 0);
        c1[8] = CAND(9, 0);
        c1[9] = CAND(10, 0);
        c1[10] = CAND(11, 0);
        c1[11] = CAND(12, 0);
        c1[12] = CAND(13, 0);
        c1[13] = CAND(14, 0);
        c1[14] = CAND(15, 0);
        c1[15] = -1e30f;
        c2[0] = CAND(1, 1);
        c2[1] = CAND(1, 2);
        c2[2] = CAND(1, 3);
        c2[3] = CAND(1, 4);
        c2[4] = CAND(1, 5);
        c2[5] = CAND(1, 6);
        c2[6] = CAND(1, 7);
        c2[7] = CAND(2, 1);
        c2[8] = CAND(2, 2);
        c2[9] = CAND(2, 3);
        c2[10] = CAND(2, 4);
        c2[11] = CAND(3, 1);
        c2[12] = CAND(3, 2);
        c2[13] = CAND(3, 3);
        c2[14] = CAND(4, 1);
        c2[15] = CAND(4, 2);
        sort16_desc(c2);
        c2[13] = fmaxf(c2[13], CAND(7, 1)); c2[14] = fmaxf(c2[14], CAND(6, 1)); c2[15] = fmaxf(c2[15], CAND(5, 1));
        bitonic16_desc(c2);
#undef CAND
        merge_top16(c0, c1); merge_top16(c0, c2);
        float es = 0.f, e[16];
        const float top = __builtin_bit_cast(float, __builtin_bit_cast(unsigned, c0[0]) & ~0xFFu);
#pragma unroll
        for (int k = 0; k < 16; ++k) { e[k] = __expf(__builtin_bit_cast(float, __builtin_bit_cast(unsigned, c0[k]) & ~0xFFu) - top); es += e[k]; }
        const float inv = 1.0f / es;
        LDS_WAIT();
        unsigned id[8]; float gt[8];
#pragma unroll
        for (int k = 0; k < 8; ++k) { const float clo_ = c0[k], chi_ = c0[8 + k], elo_ = e[k], ehi_ = e[8 + k]; const unsigned code = ~__builtin_bit_cast(unsigned, h ? chi_ : clo_) & 0xFFu; gt[k] = (h ? ehi_ : elo_) * inv;
            id[k] = (unsigned)slot[code >> 4] * 128u + (unsigned)slot[16 + (code & 15u)]; }
        LDS_WAIT();
        LAS v4u* ip = (LAS v4u*)(idxl + R * 16 + 8 * h); LAS f32x4* gp = (LAS f32x4*)(gatel + R * 16 + 8 * h);
        { v4u a; a.x = id[0]; a.y = id[1]; a.z = id[2]; a.w = id[3]; ip[0] = a; v4u b; b.x = id[4]; b.y = id[5]; b.z = id[6]; b.w = id[7]; ip[1] = b; }
        { f32x4 a; a[0] = gt[0]; a[1] = gt[1]; a[2] = gt[2]; a[3] = gt[3]; gp[0] = a; f32x4 b; b[0] = gt[4]; b[1] = gt[5]; b[2] = gt[6]; b[3] = gt[7]; gp[1] = b; }
    }
}

__device__ __forceinline__ unsigned nib_pack(unsigned x) { x = (x | (x >> 4)) & 0x00FF00FFu; return (x | (x >> 8)) & 0xFFFFu; }
__device__ __forceinline__ void hn_planes(unsigned q0, unsigned q1, unsigned& pa, unsigned& pb) {
    const unsigned b0 = q0 & 0x0F0F0F0Fu, b1 = q1 & 0x0F0F0F0Fu;
    const unsigned a0 = (((q0 >> 4) & 0x0F0F0F0Fu) + ((q0 >> 3) & 0x01010101u)) & 0x0F0F0F0Fu, a1 = (((q1 >> 4) & 0x0F0F0F0Fu) + ((q1 >> 3) & 0x01010101u)) & 0x0F0F0F0Fu;
    pa = nib_pack(a0) | (nib_pack(a1) << 16); pb = nib_pack(b0) | (nib_pack(b1) << 16);
}
#define HROW_ISSUE(BUF, TAB, W) do { const unsigned vo_ = ((W) << 9) + loff; asm volatile("global_load_dwordx4 %0, %1, %2" : "=v"(BUF) : "v"(vo_), "s"(TAB) : "memory"); } while (0)
__device__ __forceinline__ void peer_gather_half(const Ptrs& P, LAS unsigned char* lds, int unit, int lane, int wave, int g_lo, int g_hi) {
    asm volatile("" : "+v"(lane));
    const size_t t0 = (size_t)unit * 64 + wave * 8;
#pragma unroll 1
    for (int gq = g_lo; gq < g_hi; ++gq) {
        int lq = lane; asm volatile("" : "+v"(lq));
        LAS int* idxl = (LAS int*)(lds + 65536) + wave * 1024 + gq * 512;
        const LAS float* gatel = (const LAS float*)(lds + 98304) + wave * 1024 + gq * 512;
        LAS unsigned* sw = (LAS unsigned*)idxl; LAS float* sg = (LAS float*)(lds + 98304) + wave * 1024 + gq * 512;
        LAS int* startl = (LAS int*)(lds + 131072 + 4096) + wave * 64;
        {
            int ent[8]; float gv[8], us[8];
#pragma unroll
            for (int j = 0; j < 8; ++j) { ent[j] = idxl[(j >> 1) * 128 + (j & 1) * 64 + lq]; gv[j] = gatel[(j >> 1) * 128 + (j & 1) * 64 + lq]; }
#pragma unroll
            for (int j = 0; j < 8; ++j) { const f32x2v sc_ = *(const f32x2v*)(P.USC + 2 * ent[j]); us[j] = sc_[0]; gv[j] *= sc_[1] * 128.0f; }
            LDS_WAIT();
#if NSL == 8
            int pos_[8];
#pragma unroll
            for (int tk = 0; tk < 4; ++tk) {
                const unsigned s0 = (unsigned)ent[2 * tk] >> 11, s1 = (unsigned)ent[2 * tk + 1] >> 11;
                const unsigned o0 = 1u << (8 * (s0 & 3)), o1 = 1u << (8 * (s1 & 3));
                const unsigned lo = ((s0 < 4) ? o0 : 0u) + ((s1 < 4) ? o1 : 0u), hi = ((s0 < 4) ? 0u : o0) + ((s1 < 4) ? 0u : o1);
                unsigned il = lo, ih = hi;
#define SCAN_STEP(CTRL, RM) do { il += (unsigned)__builtin_amdgcn_update_dpp(0, (int)il, CTRL, RM, 0xF, false); ih += (unsigned)__builtin_amdgcn_update_dpp(0, (int)ih, CTRL, RM, 0xF, false); } while (0)
                SCAN_STEP(0x111, 0xF); SCAN_STEP(0x112, 0xF); SCAN_STEP(0x114, 0xF); SCAN_STEP(0x118, 0xF);
                SCAN_STEP(0x142, 0xA); SCAN_STEP(0x143, 0xC);
#undef SCAN_STEP
                const unsigned el = il - lo, eh = ih - hi;
                const unsigned tl = (unsigned)__builtin_amdgcn_readlane((int)il, 63), th = (unsigned)__builtin_amdgcn_readlane((int)ih, 63);
                const unsigned stl = tl * 0x01010100u, sth = th * 0x01010100u + ((tl * 0x01010101u) >> 24) * 0x01010101u;
                const unsigned r0 = (((s0 < 4) ? el : eh) >> (8 * (s0 & 3))) & 255u, r1 = ((((s1 < 4) ? el : eh) >> (8 * (s1 & 3))) & 255u) + (s1 == s0 ? 1u : 0u);
                const unsigned b0 = (((s0 < 4) ? stl : sth) >> (8 * (s0 & 3))) & 255u, b1 = (((s1 < 4) ? stl : sth) >> (8 * (s1 & 3))) & 255u;
                pos_[2 * tk] = (int)(128 * tk + b0 + r0); pos_[2 * tk + 1] = (int)(128 * tk + b1 + r1);
            }
            LDS_WAIT();
#pragma unroll
            for (int j = 0; j < 8; ++j) { sw[pos_[j]] = (unsigned)ent[j]; sg[pos_[j]] = __builtin_bit_cast(float, cvtpk(us[j], gv[j])); }
            LDS_WAIT();
        }
#else
            int rk[8];
#pragma unroll
            for (int tk = 0; tk < 4; ++tk) {
                int run[NSL];
#pragma unroll
                for (int b = 0; b < NSL; ++b) run[b] = 0;
#pragma unroll
                for (int jj = 0; jj < 2; ++jj) { const int j = 2 * tk + jj; const int bj = ent[j] >> SLSH; int r = 0;
#pragma unroll
                    for (int b = 0; b < NSL; ++b) { const unsigned long long m = __ballot(bj == b);
                        const int below = (int)__builtin_amdgcn_mbcnt_hi((unsigned)(m >> 32), __builtin_amdgcn_mbcnt_lo((unsigned)m, 0u));
                        r = (bj == b) ? run[b] + below : r; run[b] += (int)__builtin_popcountll(m); }
                    rk[j] = r; }
                int st = 0;
#pragma unroll
                for (int b = 0; b < NSL; ++b) { if (lq == b) startl[tk * NSL + b] = st; st += run[b]; }
            }
            LDS_WAIT();
#pragma unroll
            for (int j = 0; j < 8; ++j) { const int pos = (j >> 1) * 128 + startl[(j >> 1) * NSL + (ent[j] >> SLSH)] + rk[j]; sw[pos] = (unsigned)ent[j]; sg[pos] = __builtin_bit_cast(float, pk2(us[j], gv[j])); }
            LDS_WAIT();
        }
#endif
        v4u hA0, hB0, hA1, hB1; float hs0, hs1;
        { int lg = lane; asm volatile("" : "+v"(lg)); const size_t tr = t0 + gq * 4 + (lg >> 5);
          const v4u* hp0 = (const v4u*)(P.HNQ + tr * 1024 + 32 * (lg & 31)); const v4u* hp1 = (const v4u*)(P.HNQ + (tr + 2) * 1024 + 32 * (lg & 31));
          const v4u x0 = hp0[0], x1 = hp0[1], z0 = hp1[0], z1 = hp1[1]; hs0 = P.HSC[tr]; hs1 = P.HSC[tr + 2];
          unsigned pa_[8], pb_[8];
          hn_planes(x0.x, x0.y, pa_[0], pb_[0]); hn_planes(x0.z, x0.w, pa_[1], pb_[1]); hn_planes(x1.x, x1.y, pa_[2], pb_[2]); hn_planes(x1.z, x1.w, pa_[3], pb_[3]);
          hn_planes(z0.x, z0.y, pa_[4], pb_[4]); hn_planes(z0.z, z0.w, pa_[5], pb_[5]); hn_planes(z1.x, z1.y, pa_[6], pb_[6]); hn_planes(z1.z, z1.w, pa_[7], pb_[7]);
          hA0.x = pa_[0]; hA0.y = pa_[1]; hA0.z = pa_[2]; hA0.w = pa_[3]; hB0.x = pb_[0]; hB0.y = pb_[1]; hB0.z = pb_[2]; hB0.w = pb_[3];
          hA1.x = pa_[4]; hA1.y = pa_[5]; hA1.z = pa_[6]; hA1.w = pa_[7]; hB1.x = pb_[4]; hB1.y = pb_[5]; hB1.z = pb_[6]; hB1.w = pb_[7]; }
        h2 y0[16];
#pragma unroll 1
        for (int sub = 0; sub < 2; ++sub) {
            int lr = lane; asm volatile("" : "+v"(lr));
            const int l5 = lr & 31, tk = 2 * sub + (lr >> 5);
            const LAS unsigned* swt = sw + tk * 128; const LAS float* sgt = sg + tk * 128;
            const unsigned loff = (unsigned)l5 * 16u;
            {
                const int c4 = lr & 15, rho = lr >> 4;
                const int mtk = 2 * sub + (rho >> 1), mpos = (c4 < 4) ? 2 * c4 + (rho & 1) : 0;
                LAS float* sgm = sg + mtk * 128 + mpos;
                v4u ha = sub ? hA1 : hA0, hb = sub ? hB1 : hB0; float hsc_m = sub ? hs1 : hs0;
                asm volatile("" : "+v"(ha), "+v"(hb), "+v"(hsc_m));
                v4u ub[16]; int p[8];
                float mg;
#pragma unroll 1
                for (int pass = 0; pass < PROBE_SWEEPS; ++pass) {
                const bool lastp = (pass + 1 == PROBE_SWEEPS);
#define U_STEP(d, CNT, ISSUE, W) do { asm volatile("s_waitcnt vmcnt(" #CNT ")" : "+v"(ub[d]) :: "memory"); \
        { const v4u x_ = ub[d]; int a_, b_;     \
          a_ = __builtin_amdgcn_sdot8((int)x_.x, (int)ha.x, 0, true); b_ = __builtin_amdgcn_sdot8((int)x_.x, (int)hb.x, 0, true); \
          a_ = __builtin_amdgcn_sdot8((int)x_.y, (int)ha.y, a_, true); b_ = __builtin_amdgcn_sdot8((int)x_.y, (int)hb.y, b_, true); \
          a_ = __builtin_amdgcn_sdot8((int)x_.z, (int)ha.z, a_, true); b_ = __builtin_amdgcn_sdot8((int)x_.z, (int)hb.z, b_, true); \
          a_ = __builtin_amdgcn_sdot8((int)x_.w, (int)ha.w, a_, true); b_ = __builtin_amdgcn_sdot8((int)x_.w, (int)hb.w, b_, true); \
          p[(d) & 7] = (a_ << 4) + b_; } \
        if (ISSUE) HROW_ISSUE(ub[d], P.U8, W); } while (0)
#define U_FINISH(i0) do { int r_[4]; \
        _Pragma("unroll") for (int j = 0; j < 4; ++j) { auto rr = __builtin_amdgcn_permlane16_swap((unsigned)p[2 * j], (unsigned)p[2 * j + 1], false, false); const unsigned r0 = rr[0], r1 = rr[1]; r_[j] = row16_isum((int)(r0 + r1)); } \
        const int acol = (c4 == 0) ? r_[0] : (c4 == 1) ? r_[1] : (c4 == 2) ? r_[2] : r_[3]; const unsigned mgw = __builtin_bit_cast(unsigned, mg); \
        const float act = gelu_tanh((float)acol * __builtin_bit_cast(float, mgw << 16) * hsc_m) * __builtin_bit_cast(float, mgw & 0xffff0000u); \
        if (c4 < 4 && lastp) sgm[i0] = __builtin_bit_cast(float, __builtin_amdgcn_cvt_pkrtz(act, act)); asm volatile("" :: "v"(act)); } while (0)
#define U_CHUNK(i0, B, WA, WB, C0, C1, C2, C3, C4, C5, C6, C7, ISSUE) do { mg = sgm[i0]; \
        U_STEP(B + 0, C0, ISSUE, WA.x); U_STEP(B + 1, C1, ISSUE, WA.y); U_STEP(B + 2, C2, ISSUE, WA.z); U_STEP(B + 3, C3, ISSUE, WA.w); \
        U_STEP(B + 4, C4, ISSUE, WB.x); U_STEP(B + 5, C5, ISSUE, WB.y); U_STEP(B + 6, C6, ISSUE, WB.z); U_STEP(B + 7, C7, ISSUE, WB.w); \
        U_FINISH(i0); } while (0)
                {
                    const v4u w0 = *(const LAS v4u*)(swt), w1 = *(const LAS v4u*)(swt + 4), w2 = *(const LAS v4u*)(swt + 8), w3 = *(const LAS v4u*)(swt + 12);
                    HROW_ISSUE(ub[0], P.U8, w0.x); HROW_ISSUE(ub[1], P.U8, w0.y); HROW_ISSUE(ub[2], P.U8, w0.z); HROW_ISSUE(ub[3], P.U8, w0.w);
                    HROW_ISSUE(ub[4], P.U8, w1.x); HROW_ISSUE(ub[5], P.U8, w1.y); HROW_ISSUE(ub[6], P.U8, w1.z); HROW_ISSUE(ub[7], P.U8, w1.w);
                    HROW_ISSUE(ub[8], P.U8, w2.x); HROW_ISSUE(ub[9], P.U8, w2.y); HROW_ISSUE(ub[10], P.U8, w2.z); HROW_ISSUE(ub[11], P.U8, w2.w);
                    HROW_ISSUE(ub[12], P.U8, w3.x); HROW_ISSUE(ub[13], P.U8, w3.y); HROW_ISSUE(ub[14], P.U8, w3.z); HROW_ISSUE(ub[15], P.U8, w3.w);
                }
                v4u wa = *(const LAS v4u*)(swt + 16), wb = *(const LAS v4u*)(swt + 20);
#pragma unroll 1
                for (int i0 = 0; i0 < 112; i0 += 16) {
                    const v4u wc = *(const LAS v4u*)(swt + i0 + 24), wd = *(const LAS v4u*)(swt + i0 + 28);
                    U_CHUNK(i0, 0, wa, wb, 15, 15, 15, 15, 15, 15, 15, 15, 1);
                    wa = *(const LAS v4u*)(swt + i0 + 32); wb = *(const LAS v4u*)(swt + i0 + 36);
                    U_CHUNK(i0 + 8, 8, wc, wd, 15, 15, 15, 15, 15, 15, 15, 15, 1);
                }
                U_CHUNK(112, 0, wa, wb, 15, 14, 13, 12, 11, 10, 9, 8, 0);
                U_CHUNK(120, 8, wa, wb, 7, 6, 5, 4, 3, 2, 1, 0, 0);
                }
#undef U_CHUNK
#undef U_FINISH
#undef U_STEP
            }
            LDS_WAIT();
            h2 y[16];
#pragma unroll
            for (int k = 0; k < 16; ++k) { y[k][0] = (_Float16)0.f; y[k][1] = (_Float16)0.f; }
            {
                v4u vb[16];
#pragma unroll 1
                for (int pass = 0; pass < PROBE_SWEEPS; ++pass) {
                if (pass > 0) {
#pragma unroll
                    for (int k = 0; k < 16; ++k) { y[k][0] = (_Float16)0.f; y[k][1] = (_Float16)0.f; } }
#if PROBE_DUP == 1
#define V_F4(K, X, B) do { y[K] = __builtin_elementwise_fma(__builtin_bit_cast(h2, __builtin_amdgcn_cvt_scalef32_pk_f16_fp4(X, 1.0f, B)), a2_, y[K]); \
        unsigned xd_ = X; asm volatile("" : "+v"(xd_)); const h2 td_ = __builtin_bit_cast(h2, __builtin_amdgcn_cvt_scalef32_pk_f16_fp4(xd_, 1.0f, B)); asm volatile("" :: "v"(td_)); } while (0)
#elif PROBE_DUP == 2
#define V_F4(K, X, B) do { y[K] = __builtin_elementwise_fma(__builtin_bit_cast(h2, __builtin_amdgcn_cvt_scalef32_pk_f16_fp4(X, 1.0f, B)), a2_, y[K]); \
        unsigned xd_ = X; asm volatile("" : "+v"(xd_)); const h2 td_ = __builtin_elementwise_fma(__builtin_bit_cast(h2, xd_), a2_, y[K]); asm volatile("" :: "v"(td_)); } while (0)
#else
#define V_F4(K, X, B) y[K] = __builtin_elementwise_fma(__builtin_bit_cast(h2, __builtin_amdgcn_cvt_scalef32_pk_f16_fp4(X, 1.0f, B)), a2_, y[K])
#endif
#define V_STEP(d, CNT, ISSUE, W, A) do { asm volatile("s_waitcnt vmcnt(" #CNT ")" : "+v"(vb[d]) :: "memory"); \
        { const v4u x_ = vb[d]; const float af_ = A; const h2 a2_ = __builtin_bit_cast(h2, af_); \
          V_F4(0, x_.x, 0); V_F4(1, x_.x, 1); V_F4(2, x_.x, 2); V_F4(3, x_.x, 3); V_F4(4, x_.y, 0); V_F4(5, x_.y, 1); V_F4(6, x_.y, 2); V_F4(7, x_.y, 3); \
          V_F4(8, x_.z, 0); V_F4(9, x_.z, 1); V_F4(10, x_.z, 2); V_F4(11, x_.z, 3); V_F4(12, x_.w, 0); V_F4(13, x_.w, 1); V_F4(14, x_.w, 2); V_F4(15, x_.w, 3); } \
        if (ISSUE) HROW_ISSUE(vb[d], P.V8, W); } while (0)
#define V_CHUNK(i0, B, WA, WB, C0, C1, C2, C3, C4, C5, C6, C7, ISSUE) do { const f32x4 aa_ = *(const LAS f32x4*)(sgt + (i0)), ab_ = *(const LAS f32x4*)(sgt + (i0) + 4); \
        V_STEP(B + 0, C0, ISSUE, WA.x, aa_[0]); V_STEP(B + 1, C1, ISSUE, WA.y, aa_[1]); V_STEP(B + 2, C2, ISSUE, WA.z, aa_[2]); V_STEP(B + 3, C3, ISSUE, WA.w, aa_[3]); \
        V_STEP(B + 4, C4, ISSUE, WB.x, ab_[0]); V_STEP(B + 5, C5, ISSUE, WB.y, ab_[1]); V_STEP(B + 6, C6, ISSUE, WB.z, ab_[2]); V_STEP(B + 7, C7, ISSUE, WB.w, ab_[3]); } while (0)
                {
                    const v4u w0 = *(const LAS v4u*)(swt), w1 = *(const LAS v4u*)(swt + 4), w2 = *(const LAS v4u*)(swt + 8), w3 = *(const LAS v4u*)(swt + 12);
                    HROW_ISSUE(vb[0], P.V8, w0.x); HROW_ISSUE(vb[1], P.V8, w0.y); HROW_ISSUE(vb[2], P.V8, w0.z); HROW_ISSUE(vb[3], P.V8, w0.w);
                    HROW_ISSUE(vb[4], P.V8, w1.x); HROW_ISSUE(vb[5], P.V8, w1.y); HROW_ISSUE(vb[6], P.V8, w1.z); HROW_ISSUE(vb[7], P.V8, w1.w);
                    HROW_ISSUE(vb[8], P.V8, w2.x); HROW_ISSUE(vb[9], P.V8, w2.y); HROW_ISSUE(vb[10], P.V8, w2.z); HROW_ISSUE(vb[11], P.V8, w2.w);
                    HROW_ISSUE(vb[12], P.V8, w3.x); HROW_ISSUE(vb[13], P.V8, w3.y); HROW_ISSUE(vb[14], P.V8, w3.z); HROW_ISSUE(vb[15], P.V8, w3.w);
                }
                v4u wa = *(const LAS v4u*)(swt + 16), wb = *(const LAS v4u*)(swt + 20);
#pragma unroll 1
                for (int i0 = 0; i0 < 112; i0 += 16) {
                    const v4u wc = *(const LAS v4u*)(swt + i0 + 24), wd = *(const LAS v4u*)(swt + i0 + 28);
                    V_CHUNK(i0, 0, wa, wb, 15, 15, 15, 15, 15, 15, 15, 15, 1);
                    wa = *(const LAS v4u*)(swt + i0 + 32); wb = *(const LAS v4u*)(swt + i0 + 36);
                    V_CHUNK(i0 + 8, 8, wc, wd, 15, 15, 15, 15, 15, 15, 15, 15, 1);
                }
                V_CHUNK(112, 0, wa, wb, 15, 14, 13, 12, 11, 10, 9, 8, 0);
                V_CHUNK(120, 8, wa, wb, 7, 6, 5, 4, 3, 2, 1, 0, 0);
                }
#undef V_CHUNK
#undef V_STEP
#undef V_F4
            }
            if (sub == 0) {
#pragma unroll
                for (int k = 0; k < 16; ++k) y0[k] = y[k]; }
            else {
                v2u xb[2][8]; f32x4 wv[8];
#pragma unroll
                for (int tt = 0; tt < 2; ++tt)
#pragma unroll
                    for (int m = 0; m < 8; ++m) xb[tt][m] = ((NT_P7 == 4) ? __builtin_nontemporal_load((const v2u*)(P.X1B + (t0 + gq * 4 + 2 * tt + (lr >> 5)) * 1024 + 4 * l5 + 128 * m)) : NT_LD((const v2u*)(P.X1B + (t0 + gq * 4 + 2 * tt + (lr >> 5)) * 1024 + 4 * l5 + 128 * m)));
#pragma unroll
                for (int m = 0; m < 8; ++m) wv[m] = *(const f32x4*)(P.fin_w + (4 * l5 + 128 * m));
#pragma unroll
                for (int tt = 0; tt < 2; ++tt) {
                    float* xr = P.out + (t0 + gq * 4 + 2 * tt + (lr >> 5)) * 1024 + 4 * l5;
                    f32x4 x[8]; float ss = 0.f;
#pragma unroll
                    for (int m = 0; m < 8; ++m) { const unsigned q0 = xb[tt][m].x, q1 = xb[tt][m].y;
                        const h2 ya = tt ? y[2 * m] : y0[2 * m], yb = tt ? y[2 * m + 1] : y0[2 * m + 1];
                        x[m][0] = bflo(q0) + (float)ya[0] * (1.0f / 128.0f); x[m][1] = bfhi(q0) + (float)ya[1] * (1.0f / 128.0f); x[m][2] = bflo(q1) + (float)yb[0] * (1.0f / 128.0f); x[m][3] = bfhi(q1) + (float)yb[1] * (1.0f / 128.0f);
                        ss += (x[m][0] * x[m][0] + x[m][1] * x[m][1]) + (x[m][2] * x[m][2] + x[m][3] * x[m][3]); }
                    ss = row16_sum(ss);
                    ss += __builtin_bit_cast(float, __builtin_amdgcn_ds_swizzle(__builtin_bit_cast(int, ss), 0x401F));
                    const float rstd = 1.0f / sqrtf(ss * (1.0f / 1024.0f) + EPS);
#pragma unroll
                    for (int m = 0; m < 8; ++m) NT_ST((f32x4*)(xr + 128 * m), x[m] * rstd * wv[m]);
                }
            }
        }
    }
}
#undef HROW_ISSUE

__device__ __forceinline__ void p7_peer(LAS unsigned char* lds, const Ptrs& P, int vcu, int G, int tid, int lane, int wave) {
    LAS bf16* k1l = (LAS bf16*)lds;
    LAS bf16* k2l = (LAS bf16*)(lds + 32768);
    LAS int* idxl = (LAS int*)(lds + 65536);
    LAS float* gatel = (LAS float*)(lds + 98304);
    { v4u ka[4], kb[4];
#pragma unroll
      for (int j = 0; j < 4; ++j) { ka[j] = ((const v4u*)P.K1)[tid + 512 * j]; kb[j] = ((const v4u*)P.K2)[tid + 512 * j]; }
#pragma unroll
      for (int j = 0; j < 4; ++j) { const int i = tid + 512 * j, n = i >> 4, c = i & 15, d = n * 16 + (c ^ (n & 15)); ((LAS v4u*)k1l)[d] = ka[j]; ((LAS v4u*)k2l)[d] = kb[j]; } }
    __syncthreads();
    for (int unit = vcu; unit < M / 64; unit += G) {
#pragma unroll 1
        for (int st = 0; st < 4; ++st) {
            const bool ordb = STAGE_ORDER_B && (STAGE_ORDER_B == 2 || wave >= 4);
            const int g = ordb ? (st & 1) : (st >> 1);
            if (ordb ? (st < 2) : ((st & 1) == 0))
#pragma unroll 1
              for (int rep = 0; rep < PROBE_TOPK; ++rep) peer_topk_unit_mfma(P, (const LAS unsigned char*)k1l, (const LAS unsigned char*)k2l, idxl, gatel, unit, lane, wave, g, g + 1);
            else peer_gather_half(P, lds, unit, lane, wave, g, g + 1);
        }
        __syncthreads();
    }
}

struct Args { const float* in[19]; float* out; unsigned char* ws; int ph_lo, ph_hi; };
__global__ void __launch_bounds__(NWAVES * 64, 2) mega_fwd(Args args) {
    extern __shared__ __attribute__((aligned(16))) unsigned char lds_raw[];
    LAS unsigned char* lds = (LAS unsigned char*)lds_raw;
    const int tid = threadIdx.x, lane = tid & 63, wave = __builtin_amdgcn_readfirstlane(tid >> 6);
    const int G = gridDim.x; const int bx = blockIdx.x; const int vcu = (G % 8 == 0) ? (bx % 8) * (G / 8) + bx / 8 : bx;
    unsigned char* ws = args.ws;
    Ptrs P;
    P.x = args.in[0]; P.mix_w = args.in[1]; P.w_in = args.in[2]; P.rel_bias = args.in[3]; P.sinks = args.in[4]; P.w_pa = args.in[5]; P.ln_w = args.in[6]; P.ln_b = args.in[7];
    P.w_s = args.in[8]; P.b_s = args.in[9]; P.w_pb = args.in[10]; P.w_out = args.in[11]; P.ffn_w = args.in[12]; P.w_q = args.in[13]; P.keys1 = args.in[14]; P.keys2 = args.in[15];
    P.pu = args.in[16]; P.pv = args.in[17]; P.fin_w = args.in[18]; P.out = args.out;
    P.WIN8 = ws + WS_WIN; P.WPAB = (bf16*)(ws + WS_WPA); P.WOUT8 = ws + WS_WOUT; P.WQ8 = ws + WS_WQ;
    P.WINSC = (float*)(ws + WS_V + 131072); P.WQSC = (float*)(ws + WS_V + 163840); P.XSC = (float*)(ws + WS_V + 196608); P.WOUTSC = (float*)(ws + WS_V + 262144); P.MSC = (float*)(ws + WS_V + 327680);
    P.K1 = (bf16*)(ws + WS_K1); P.K2 = (bf16*)(ws + WS_K2); P.WS = (bf16*)(ws + WS_WS);
    P.U8 = ws + WS_U; P.V8 = ws + WS_U + 8 * MiB; P.USC = (float*)(ws + WS_V); P.HSC = (float*)(ws + WS_HSC);
    P.XN8 = ws + WS_G1; P.MERGED8 = ws + WS_G1; P.HNQ = ws + WS_Q;
    P.GA = (bf16*)(ws + WS_G2); P.GB = (bf16*)(ws + WS_G2) + 1024; P.QP = (bf16*)(ws + WS_G2);
    P.AOUT = (bf16*)(ws + WS_G3); P.BOUT = (bf16*)(ws + WS_G3) + 512; P.X1B = (bf16*)(ws + WS_G3);
    P.Q = (bf16*)(ws + WS_Q); P.KV = (bf16*)(ws + WS_KV); P.GU = (bf16*)(ws + WS_GU); P.GV = (bf16*)(ws + WS_GV);

    for (int u = tid; u < (LDS_BYTES - MISC_OFF) / 4; u += NWAVES * 64) ((LAS unsigned*)(lds + MISC_OFF))[u] = 0u;
    __syncthreads();
    const int lo = args.ph_lo, hi = args.ph_hi;
    unsigned* barw = (unsigned*)(ws + WS_CTL) + CW_BAR;
    XcdBarrier bar; bar.bar = barw; bar.x = 0; bar.st = nullptr;
    if (hi - lo > 1) bar = xcd_barrier_post(barw, (volatile LAS unsigned*)(lds + MISC_OFF));
#define IN(k) (lo <= (k) && (k) < hi)
#define BOTH(k) (IN(k) && IN((k) + 1))
#define GRID_BAR() xcd_barrier(bar)
#define REPS(k) ((k) == PROBE_PHASE ? 2 : 1)
    unsigned* ctl = (unsigned*)(ws + WS_CTL);
    const bool grp = PANEL_SEAMS && (G == 256) && (lo == 0) && (hi == N_PHASES);
    const int pmb = 8 * (bx & 7) + ((bx >> 3) & 7), ucu = grp ? 4 * pmb + (bx >> 6) : vcu;
    const bool tab_late = TAB_LATE && grp;
    bool rel_own = true, rel_kv = true;
    if (grp && tid == 0) __hip_atomic_store(ctl + 6144 + bx, 1u + xb_xcc_id(), __ATOMIC_RELAXED, __HIP_MEMORY_SCOPE_AGENT);
#define SEAM(k) do { if (grp) { asm volatile("s_waitcnt vmcnt(0)" ::: "memory"); __syncthreads(); \
        if (tid == 0) { if ((k) == 1 ? rel_kv : rel_own) { __builtin_amdgcn_fence(__ATOMIC_RELEASE, "agent"); asm volatile("s_waitcnt vmcnt(0)" ::: "memory"); } \
            unsigned* c_ = ctl + 8192 + 16 * (64 * (k) + pmb); (void)xb_add(c_, 1u); XB_SPIN(xb_ld(c_) < 4u, barw); \
            if ((k) == 1 && (pmb & 31) != 0) XB_SPIN(xb_ld(c_ - 16) < 4u, barw); \
            if (!PROBE_NOACQ) { __builtin_amdgcn_fence(__ATOMIC_ACQUIRE, "agent"); asm volatile("s_waitcnt vmcnt(0)" ::: "memory"); } } \
        __syncthreads(); } else if (BOTH(k)) GRID_BAR(); } while (0)

    if (IN(0)) {
#pragma unroll
        for (int rep = 0; rep < REPS(0); ++rep) { if (tab_late) p0_prologue<TAB_P0_ROWS>(lds, P, vcu, G, lane, wave); else p0_prologue<2 * 16384>(lds, P, vcu, G, lane, wave); __syncthreads(); }
        if (BOTH(0)) GRID_BAR();
        if (grp) {
            const unsigned mine = 1u + xb_xcc_id();
            const int pn_ = (pmb + 1 < 64 && ((pmb + 1) & 31) != 0) ? pmb + 1 : pmb;
            unsigned ido[4], idn[4];
#pragma unroll
            for (int k = 0; k < 4; ++k) { ido[k] = __hip_atomic_load(ctl + 6144 + (pmb >> 3) + 8 * (pmb & 7) + 64 * k, __ATOMIC_RELAXED, __HIP_MEMORY_SCOPE_AGENT);
                                          idn[k] = __hip_atomic_load(ctl + 6144 + (pn_ >> 3) + 8 * (pn_ & 7) + 64 * k, __ATOMIC_RELAXED, __HIP_MEMORY_SCOPE_AGENT); }
            const bool own = (ido[0] == mine) & (ido[1] == mine) & (ido[2] == mine) & (ido[3] == mine), nxt = (idn[0] == mine) & (idn[1] == mine) & (idn[2] == mine) & (idn[3] == mine);
            rel_own = !own || PANEL_FORCE_RELEASE; rel_kv = !own || !nxt || PANEL_FORCE_RELEASE; } }

    if (IN(1)) {
        pg8::Gemm g{(const pg8::bf16_t*)P.XN8, (const pg8::bf16_t*)P.WIN8, M, NZ, D / 2, D / 2, P.XSC, P.WINSC}; pg8::StaticOrder S; S.init(M, NZ, G, bx);
        pg8::EpiZ E{P.Q, P.KV, P.GU, P.GV, P.GA, P.GB};
#pragma unroll
        for (int rep = 0; rep < REPS(1); ++rep) pg8::gemm_phase<pg8::EpiZ, pg8::StaticOrder, PG8_ALIGN, PG8_SP2, true>(lds, g, S, E);
        if (tab_late && bx >= 192) {
            tab_quant_rows8<true>(P, TAB_P0_ROWS + (bx - 192) * NWAVES + wave, 64 * NWAVES, lane);
            asm volatile("s_waitcnt vmcnt(0)" ::: "memory"); __syncthreads();
            if (tid == 0) (void)xb_add(ctl + 7168, 1u);
        }
        SEAM(1);
    }

    if (IN(2)) {
        for (int rep = 0; rep < REPS(2); ++rep) {
        p2_attn_mfma(lds, P, ucu, G, tid, lane, wave);
        p2_gmlp_mfma(lds, P, ucu, G, tid, lane, wave);
        }
        SEAM(2);
    }

    if (IN(3)) {
#pragma unroll
      for (int rep = 0; rep < REPS(3); ++rep) {
        { pg8::Gemm g{P.AOUT, P.WPAB, M, D, 1024, AB_LD, nullptr, nullptr}; pg8::StaticOrder S; S.init(M, D, G, bx);
          pg8::EpiMerge2 E{P.GA, P.MERGED8, P.MSC, (unsigned*)(ws + WS_END + 524288), (unsigned*)(ws + WS_CTL) + 4096 + 1024, barw, (LAS float*)(lds + 131072)};
          pg8::gemm_phase<pg8::EpiMerge2, pg8::StaticOrder, PG8_ALIGN, PG8_SP2>(lds, g, S, E); }
      }
        SEAM(3);
    }

    if (IN(4)) {
        pg8::Gemm g{(const pg8::bf16_t*)P.MERGED8, (const pg8::bf16_t*)P.WOUT8, M, D, D / 2, D / 2, P.MSC, P.WOUTSC}; pg8::StaticOrder S; S.init(M, D, G, bx);
        pg8::EpiResLn E{P.x, P.ffn_w, (pg8::bf16_t*)P.X1B, P.HNQ, P.HSC, (unsigned long long*)(ws + WS_END), (unsigned*)(ws + WS_CTL) + 4096, barw, (LAS float*)(lds + 131072)};
#pragma unroll
        for (int rep = 0; rep < REPS(4); ++rep) pg8::gemm_phase<pg8::EpiResLn, pg8::StaticOrder, PG8_ALIGN, PG8_SP2, true>(lds, g, S, E);
        SEAM(4);
    }

    if (IN(6)) {
        pg8::Gemm g{(const pg8::bf16_t*)P.HNQ, (const pg8::bf16_t*)P.WQ8, M, 2048, D / 2, D / 2, P.HSC, P.WQSC}; pg8::StaticOrder S; S.init(M, 2048, G, bx);
        pg8::EpiPlain E{P.QP, 2048};
#pragma unroll
        for (int rep = 0; rep < REPS(6); ++rep) pg8::gemm_phase<pg8::EpiPlain, pg8::StaticOrder, PG8_ALIGN, PG8_SP2, true>(lds, g, S, E);
        SEAM(6);
    }

    if (IN(7)) {
        if (tab_late) { if (tid == 0) XB_SPIN(xb_ld(ctl + 7168) < 64u, barw); __syncthreads(); }
#pragma unroll 1
        for (int rep = 0; rep < REPS(7); ++rep) p7_peer(lds, P, ucu, G, tid, lane, wave);
    }
#undef IN
#undef BOTH
#undef GRID_BAR
}

extern "C" void kernel_launch(void* const* d_in, const int* in_sizes, int n_in, void* d_out, int out_size, void* d_ws, size_t ws_size, hipStream_t stream) {
    static int grid = 0;
    if (grid == 0) {
        if (n_in != 19 || out_size != M * D || ws_size < WS_END + MiB) { fprintf(stderr, "kernel_launch: unexpected shapes (n_in %d, out %d, ws %zu)\n", n_in, out_size, ws_size); grid = -1; return; }
        int dev = 0, cus = 0, per_cu = 0;
        if (hipGetDevice(&dev) != hipSuccess || hipDeviceGetAttribute(&cus, hipDeviceAttributeMultiprocessorCount, dev) != hipSuccess) { grid = -1; return; }
        if (hipFuncSetAttribute((const void*)mega_fwd, hipFuncAttributeMaxDynamicSharedMemorySize, LDS_BYTES) != hipSuccess) { fprintf(stderr, "kernel_launch: hipFuncSetAttribute failed\n"); grid = -1; return; }
        if (hipOccupancyMaxActiveBlocksPerMultiprocessor(&per_cu, (const void*)mega_fwd, NWAVES * 64, LDS_BYTES) != hipSuccess || per_cu < 1)
            fprintf(stderr, "kernel_launch: note: occupancy query reports %d workgroups per CU\n", per_cu);
        (void)hipGetLastError();
        grid = cus;
    }
    if (grid < 0) return;
    if (hipMemsetAsync((char*)d_ws + WS_CTL, 0, CTL_ZERO_BYTES, stream) != hipSuccess) return;
    Args a{};
    for (int i = 0; i < 19; ++i) a.in[i] = (const float*)d_in[i];
    a.out = (float*)d_out; a.ws = (unsigned char*)d_ws;
    a.ph_lo = 0; a.ph_hi = N_PHASES;
    hipLaunchKernelGGL(mega_fwd, dim3(grid), dim3(NWAVES * 64), LDS_BYTES, stream, a);
}
```
